# Optimizing an MI355X kernel written in HIP

```python
import jax, jax.numpy as jnp
from jax import lax
import numpy as np

D_MODEL = 1024
BATCH = 16
SEQ = 2048
DEPTH = 2

CHUNK = 64
Q_BLOCK = 128
MLA_HEADS = 8
MLA_NOPE_DIM = 64
MLA_ROPE_DIM = 32
MLA_V_DIM = 64
MLA_Q_RANK = 256
MLA_KV_RANK = 128
ROPE_THETA = 10000.0
FOX_HEADS = 8
FOX_HEAD_DIM = 64
MLA_OUT = MLA_HEADS * MLA_V_DIM
FOX_OUT = FOX_HEADS * FOX_HEAD_DIM
MIX_WIDTH = MLA_OUT + FOX_OUT
IN_WIDTH = MLA_Q_RANK + MLA_KV_RANK + MLA_ROPE_DIM + 3 * FOX_OUT + FOX_HEADS
N_GROUPS = 4
EXPERTS_PER_GROUP = 8
N_EXPERTS = N_GROUPS * EXPERTS_PER_GROUP
EXPERT_TOP_K = 2
D_EXPERT = 512
EXPERT_BLOCK = 128
NORM_EPS = 1e-6

kernel_name = "hymba_mla_fox_hiermoe_trunk"


def rmsnorm(x, g):
    xf = x.astype(jnp.float32)
    y = xf * lax.rsqrt(jnp.mean(xf * xf, axis=-1, keepdims=True) + NORM_EPS)
    return (y * g.astype(jnp.float32)).astype(x.dtype)


def rope_tables(positions):
    half = MLA_ROPE_DIM // 2
    inv_freq = ROPE_THETA ** (-jnp.arange(half, dtype=jnp.float32) / half)
    ang = positions.astype(jnp.float32)[..., None] * inv_freq
    return jnp.cos(ang), jnp.sin(ang)


def apply_rope(x, cos, sin):
    half = x.shape[-1] // 2
    xf = x.astype(jnp.float32)
    x1, x2 = xf[..., :half], xf[..., half:]
    return jnp.concatenate([x1 * cos - x2 * sin, x1 * sin + x2 * cos], axis=-1).astype(x.dtype)


def block_sweep_attention(q, k, v, scale, chunk_causal, log_decay_cum=None):
    S = q.shape[2]
    outs = []
    for i in range(S // Q_BLOCK):
        qs, qe = i * Q_BLOCK, (i + 1) * Q_BLOCK
        s = jnp.einsum('bhqd,bhkd->bhqk', q[:, :, qs:qe], k[:, :, :qe],
                       preferred_element_type=jnp.float32) * scale
        t_idx = jnp.arange(qs, qe)[:, None]
        s_idx = jnp.arange(qe)[None, :]
        if chunk_causal:
            allowed = (s_idx // CHUNK) <= (t_idx // CHUNK)
        else:
            allowed = s_idx <= t_idx
        if log_decay_cum is not None:
            s = s + (log_decay_cum[:, :, qs:qe, None] - log_decay_cum[:, :, None, :qe])
        s = jnp.where(allowed, s, -jnp.inf)
        p = jax.nn.softmax(s, axis=-1).astype(v.dtype)
        outs.append(jnp.einsum('bhqk,bhkd->bhqd', p, v[:, :, :qe]))
    return jnp.concatenate(outs, axis=2)


def mla_group(q_lat, kv_lat, k_rope, positions, q_norm, w_uq, kv_norm, w_ukv):
    B, S, _ = q_lat.shape
    q = (rmsnorm(q_lat, q_norm) @ w_uq).reshape(B, S, MLA_HEADS, MLA_NOPE_DIM + MLA_ROPE_DIM)
    q = q.transpose(0, 2, 1, 3)
    kv = (rmsnorm(kv_lat, kv_norm) @ w_ukv).reshape(B, S, MLA_HEADS, MLA_NOPE_DIM + MLA_V_DIM)
    kv = kv.transpose(0, 2, 1, 3)
    k_nope, v = kv[..., :MLA_NOPE_DIM], kv[..., MLA_NOPE_DIM:]
    cos, sin = rope_tables(positions)
    q_pe = apply_rope(q[..., MLA_NOPE_DIM:], cos[:, None], sin[:, None])
    k_pe = apply_rope(k_rope, cos, sin)[:, None]
    q = jnp.concatenate([q[..., :MLA_NOPE_DIM], q_pe], axis=-1)
    k = jnp.concatenate([k_nope, jnp.broadcast_to(k_pe, (B, MLA_HEADS, S, MLA_ROPE_DIM))], axis=-1)
    o = block_sweep_attention(q, k, v, (MLA_NOPE_DIM + MLA_ROPE_DIM) ** -0.5, chunk_causal=True)
    return o.transpose(0, 2, 1, 3).reshape(B, S, MLA_OUT)


def fox_group(q, k, v, f_logit, b_forget):
    B, S, _ = q.shape
    def to_heads(t):
        return t.reshape(B, S, FOX_HEADS, FOX_HEAD_DIM).transpose(0, 2, 1, 3)
    log_f = jax.nn.log_sigmoid(f_logit.astype(jnp.float32) + b_forget.astype(jnp.float32))
    c = jnp.cumsum(log_f, axis=1).transpose(0, 2, 1)
    o = block_sweep_attention(to_heads(q), to_heads(k), to_heads(v), FOX_HEAD_DIM ** -0.5,
                              chunk_causal=False, log_decay_cum=c)
    return o.transpose(0, 2, 1, 3).reshape(B, S, FOX_OUT)


def hier_moe(h, w_rg, b_rg, w_re, b_re, w_gate, w_up, w_down):
    B, S, D = h.shape
    N = B * S
    t = h.reshape(N, D)
    g_prob = jax.nn.softmax((t @ w_rg).astype(jnp.float32) + b_rg.astype(jnp.float32), axis=-1)
    g_val, g_idx = lax.top_k(g_prob, 1)
    e_logits = ((t @ w_re).astype(jnp.float32) + b_re.astype(jnp.float32)).reshape(N, N_GROUPS, EXPERTS_PER_GROUP)
    idx = jnp.broadcast_to(g_idx[:, :, None], (N, 1, EXPERTS_PER_GROUP))
    e_prob = jax.nn.softmax(jnp.take_along_axis(e_logits, idx, axis=1)[:, 0], axis=-1)
    e_val, e_local = lax.top_k(e_prob, EXPERT_TOP_K)
    gates = g_val * e_val / jnp.sum(e_val, axis=-1, keepdims=True)
    expert_ids = g_idx * EXPERTS_PER_GROUP + e_local
    A = N * EXPERT_TOP_K
    eid = expert_ids.reshape(A).astype(jnp.int32)
    tok = jnp.repeat(jnp.arange(N, dtype=jnp.int32), EXPERT_TOP_K)
    gate = gates.reshape(A)
    order = jnp.argsort(eid)
    eid_s, tok_s, gate_s = eid[order], tok[order], gate[order]
    counts = jax.ops.segment_sum(jnp.ones((A,), jnp.int32), eid, num_segments=N_EXPERTS)
    start = jnp.cumsum(counts) - counts
    padded = (counts + EXPERT_BLOCK - 1) // EXPERT_BLOCK * EXPERT_BLOCK
    pad_end = jnp.cumsum(padded)
    pad_start = pad_end - padded
    dest = pad_start[eid_s] + (jnp.arange(A, dtype=jnp.int32) - start[eid_s])
    n_blocks = -(-A // EXPERT_BLOCK) + N_EXPERTS
    buf = jnp.zeros((n_blocks * EXPERT_BLOCK, D), t.dtype).at[dest].set(t[tok_s])
    blk_start = jnp.arange(n_blocks, dtype=jnp.int32) * EXPERT_BLOCK
    blk_expert = jnp.clip(jnp.searchsorted(pad_end, blk_start, side='right'), 0, N_EXPERTS - 1)

    def expert_block(args):
        xb, e = args
        return (jax.nn.silu(xb @ w_gate[e]) * (xb @ w_up[e])) @ w_down[e]

    out = lax.map(expert_block, (buf.reshape(n_blocks, EXPERT_BLOCK, D), blk_expert))
    y_s = out.reshape(n_blocks * EXPERT_BLOCK, D)[dest] * gate_s[:, None].astype(t.dtype)
    y = jnp.zeros((N, D), t.dtype).at[tok_s].add(y_s)
    return y.reshape(B, S, D)


def setup_inputs(seed: int = 0) -> dict:
    key = jax.random.key(seed)
    ks = jax.random.split(key, 24)
    f32 = jnp.float32
    L, D = DEPTH, D_MODEL

    def nrm(k, shape, scale):
        return jax.random.normal(k, shape, f32) * scale

    def gain(k, shape):
        return 1.0 + 0.02 * jax.random.normal(k, shape, f32)

    x = jax.random.normal(ks[0], (BATCH, SEQ, D), f32)
    offsets = jax.random.randint(ks[1], (BATCH, 1), 0, 1000, dtype=jnp.int32) * CHUNK
    positions = (offsets + jnp.arange(SEQ, dtype=jnp.int32)[None, :]).astype(jnp.int32)
    return {
        "x": x,
        "positions": positions,
        "attn_norm": gain(ks[2], (L, D)),
        "w_in": nrm(ks[3], (L, D, IN_WIDTH), D ** -0.5),
        "b_forget": 2.0 + 0.1 * jax.random.normal(ks[4], (L, FOX_HEADS), f32),
        "q_norm": gain(ks[5], (L, MLA_Q_RANK)),
        "w_uq": nrm(ks[6], (L, MLA_Q_RANK, MLA_HEADS * (MLA_NOPE_DIM + MLA_ROPE_DIM)), MLA_Q_RANK ** -0.5),
        "kv_norm": gain(ks[7], (L, MLA_KV_RANK)),
        "w_ukv": nrm(ks[8], (L, MLA_KV_RANK, MLA_HEADS * (MLA_NOPE_DIM + MLA_V_DIM)), MLA_KV_RANK ** -0.5),
        "mla_out_norm": gain(ks[9], (L, MLA_OUT)),
        "fox_out_norm": gain(ks[10], (L, FOX_OUT)),
        "w_out": nrm(ks[11], (L, MIX_WIDTH, D), MIX_WIDTH ** -0.5),
        "ffn_norm": gain(ks[12], (L, D)),
        "w_router_group": nrm(ks[13], (L, D, N_GROUPS), D ** -0.5),
        "b_router_group": nrm(ks[14], (L, N_GROUPS), 0.01),
        "w_router_expert": nrm(ks[15], (L, D, N_EXPERTS), D ** -0.5),
        "b_router_expert": nrm(ks[16], (L, N_EXPERTS), 0.01),
        "w_gate": nrm(ks[17], (L, N_EXPERTS, D, D_EXPERT), D ** -0.5),
        "w_up": nrm(ks[18], (L, N_EXPERTS, D, D_EXPERT), D ** -0.5),
        "w_down": nrm(ks[19], (L, N_EXPERTS, D_EXPERT, D), D_EXPERT ** -0.5),
        "final_norm": gain(ks[20], (D,)),
    }


def reference(x, positions, attn_norm, w_in, b_forget, q_norm, w_uq, kv_norm, w_ukv,
              mla_out_norm, fox_out_norm, w_out, ffn_norm, w_router_group, b_router_group,
              w_router_expert, b_router_expert, w_gate, w_up, w_down, final_norm):
    split_at = np.cumsum([MLA_Q_RANK, MLA_KV_RANK, MLA_ROPE_DIM, FOX_OUT, FOX_OUT, FOX_OUT]).tolist()
    for l in range(DEPTH):
        h = rmsnorm(x, attn_norm[l])
        proj = h @ w_in[l]
        q_lat, kv_lat, k_rope, fq, fk, fv, f_logit = jnp.split(proj, split_at, axis=-1)
        o_mla = mla_group(q_lat, kv_lat, k_rope, positions, q_norm[l], w_uq[l], kv_norm[l], w_ukv[l])
        o_fox = fox_group(fq, fk, fv, f_logit, b_forget[l])
        mixed = jnp.concatenate([rmsnorm(o_mla, mla_out_norm[l]), rmsnorm(o_fox, fox_out_norm[l])], axis=-1)
        x = x + mixed @ w_out[l]
        h2 = rmsnorm(x, ffn_norm[l])
        x = x + hier_moe(h2, w_router_group[l], b_router_group[l], w_router_expert[l],
                         b_router_expert[l], w_gate[l], w_up[l], w_down[l])
    return rmsnorm(x, final_norm)
```

```cpp
#include <hip/hip_runtime.h>
#include <cstdio>
#include <cstdint>

#ifndef MK_ONE_LAUNCH
#define MK_ONE_LAUNCH 1
#endif

#define LAS __attribute__((address_space(3)))
#define GAS __attribute__((address_space(1)))
typedef unsigned short bf16;
typedef short bf16x8 __attribute__((ext_vector_type(8)));
typedef short s16x4 __attribute__((ext_vector_type(4)));
typedef float f32x4 __attribute__((ext_vector_type(4)));
typedef float f32x2 __attribute__((ext_vector_type(2)));
typedef float f32x16 __attribute__((ext_vector_type(16)));
typedef unsigned u32x4 __attribute__((ext_vector_type(4)));
typedef unsigned u32x2 __attribute__((ext_vector_type(2)));

constexpr int NB = 16, SEQ = 2048, DM = 1024, NTOK = NB * SEQ, NLAYER = 2;
constexpr int INW = 1960, INP = 2048;
constexpr int NEXP = 32, DEXP = 512;
constexpr int MAXSLOT = 73728;
constexpr float EPS = 1e-6f;
constexpr float LOG2E = 1.4426950408889634f;
constexpr float C2F = 0.125f * LOG2E;
constexpr float C2M = 0.10206207261596575f * LOG2E;

constexpr size_t MiB = 1u << 20, KiB = 1u << 10;
constexpr size_t WS_CTL = 0, CTL_ZERO_BYTES = 64 * KiB;
constexpr size_t WS_COS = 1 * MiB, WS_SIN = 3 * MiB;
constexpr size_t WS_SSQ = 5 * MiB;
constexpr size_t WS_FLOG = 6 * MiB;
constexpr size_t WS_BIAS = 7 * MiB;
constexpr size_t WS_E01 = 8 * MiB;
constexpr size_t WS_G01 = 8 * MiB + 256 * KiB;
constexpr size_t WS_SLOT = 8 * MiB + 512 * KiB;
constexpr size_t WS_TOKOF = 8 * MiB + 768 * KiB;
constexpr size_t WS_GATEOF = 9 * MiB + 256 * KiB;
constexpr size_t WS_CNT = 9 * MiB + 768 * KiB;
constexpr size_t WS_TSTART = 9 * MiB + 800 * KiB;
constexpr size_t WS_KPE = 10 * MiB;
constexpr size_t WS_WIN = 16 * MiB;
constexpr size_t WS_WUQ = 20 * MiB;
constexpr size_t WS_WUKV = 20 * MiB + 512 * KiB;
constexpr size_t WS_WOUT = 21 * MiB;
constexpr size_t WS_WGU = 24 * MiB;
constexpr size_t WS_WD = 88 * MiB;
constexpr size_t WS_XN = 120 * MiB;
constexpr size_t WS_FQKV = 184 * MiB;
constexpr size_t WS_LAT = 280 * MiB;
constexpr size_t WS_QM = 312 * MiB;
constexpr size_t WS_KVM = 360 * MiB;
constexpr size_t WS_Y = 280 * MiB;
constexpr size_t WS_END = 424 * MiB;
static_assert(WS_Y + (size_t)MAXSLOT * 1024 * 2 <= WS_END, "Y fits");
static_assert(WS_FQKV + (size_t)MAXSLOT * 512 * 2 <= WS_LAT, "HH fits");

constexpr int CW_BAR = 1024;

constexpr int RING_BYTES = 147456;
constexpr int MISC_OFF = RING_BYTES;
constexpr int LDS_BYTES = RING_BYTES + 1024;

__device__ __forceinline__ unsigned cvt_pk_bf16(float lo, float hi) { unsigned r; asm volatile("v_cvt_pk_bf16_f32 %0, %1, %2" : "=v"(r) : "v"(lo), "v"(hi)); return r; }
__device__ __forceinline__ float bf2f(unsigned short b) { return __uint_as_float((unsigned)b << 16); }
__device__ __forceinline__ float wave_sum(float v) {
#pragma unroll
    for (int o = 1; o < 64; o <<= 1) v += __shfl_xor(v, o);
    return v;
}
#define LDS_WAIT() asm volatile("s_waitcnt lgkmcnt(0)" ::: "memory")

#define XB_TMO      128
#define XB_XCNT(j)  (256  + 64 * (j))
#define XB_XSUB(j)  (1280 + 64 * (j))
#define XB_XGEN(j)  (2304 + 64 * (j))
#define XB_TOP      3328
#define XB_TOPGEN   3392
#define XCD_BAR_WORDS 3456
#define XB_SPIN_CAP (1u << 18)
__device__ __forceinline__ unsigned xb_ld(unsigned* p)              { return __hip_atomic_load(p, __ATOMIC_RELAXED, __HIP_MEMORY_SCOPE_AGENT); }
__device__ __forceinline__ unsigned xb_add(unsigned* p, unsigned v) { return __hip_atomic_fetch_add(p, v, __ATOMIC_RELAXED, __HIP_MEMORY_SCOPE_AGENT); }
__device__ __forceinline__ unsigned xb_xcc_id() { return (unsigned)__builtin_amdgcn_s_getreg((3 << 11) | 20) & 0xFu; }
#define XB_SPIN(cond, bar) do { unsigned _sp = 0; while (cond) { __builtin_amdgcn_s_sleep(1); \
    if ((++_sp & 255u) == 0u) { if (xb_ld(&(bar)[XB_TMO])) break; if (_sp > XB_SPIN_CAP) { atomicAdd(&(bar)[XB_TMO], 1u); break; } } } } while (0)
struct XcdBarrier { unsigned* bar; unsigned x; volatile LAS unsigned* st; };
__device__ __forceinline__ XcdBarrier xcd_barrier_post(unsigned* bar, volatile LAS unsigned* st) {
    XcdBarrier b; b.bar = bar; b.x = xb_xcc_id(); b.st = st;
    if (threadIdx.x == 0) (void)xb_add(&bar[XB_XCNT(b.x)], 1u);
    return b;
}
__device__ __forceinline__ void xcd_barrier_complete(unsigned* bar, unsigned x, unsigned& nloc, unsigned& nx) {
    const unsigned G = gridDim.x * gridDim.y * gridDim.z;
    unsigned sum, cnt, mine, sp = 0u;
    for (;;) {
        sum = 0u; cnt = 0u; mine = 0u;
#pragma unroll
        for (unsigned j = 0; j < 16; ++j) { const unsigned c = xb_ld(&bar[XB_XCNT(j)]); sum += c; cnt += (c > 0u) ? 1u : 0u; mine = (j == x) ? c : mine; }
        if (sum == G) break;
        __builtin_amdgcn_s_sleep(1);
        if ((++sp & 255u) == 0u) { if (xb_ld(&bar[XB_TMO])) break; if (sp > XB_SPIN_CAP) { atomicAdd(&bar[XB_TMO], 1u); break; } }
    }
    nloc = mine > 0u ? mine : 1u; nx = cnt > 0u ? cnt : 1u;
}
__device__ __forceinline__ void xcd_barrier(const XcdBarrier& b) {
    asm volatile("s_waitcnt vmcnt(0)" ::: "memory");
    __syncthreads();
    if (threadIdx.x == 0) {
        unsigned* bar = b.bar;
        __builtin_amdgcn_s_waitcnt(0);
        unsigned nloc = b.st[0], nx = b.st[1];
        if (nloc == 0u) { xcd_barrier_complete(bar, b.x, nloc, nx); b.st[0] = nloc; b.st[1] = nx; }
        const unsigned old = xb_add(&bar[XB_XSUB(b.x)], 1u);
        const unsigned gen = old / nloc;
        if (old + 1u == (gen + 1u) * nloc) {
            __builtin_amdgcn_fence(__ATOMIC_RELEASE, "agent");
            asm volatile("s_waitcnt vmcnt(0)" ::: "memory");
            const unsigned og = xb_add(&bar[XB_TOP], 1u);
            const unsigned tg = og / nx;
            if (og + 1u == (tg + 1u) * nx) xb_add(&bar[XB_TOPGEN], 1u);
            else XB_SPIN(xb_ld(&bar[XB_TOPGEN]) == tg, bar);
            __builtin_amdgcn_fence(__ATOMIC_ACQUIRE, "agent");
            xb_add(&bar[XB_XGEN(b.x)], 1u);
            asm volatile("s_waitcnt vmcnt(0)" ::: "memory");
        } else {
            XB_SPIN(xb_ld(&bar[XB_XGEN(b.x)]) == gen, bar);
            __builtin_amdgcn_fence(__ATOMIC_ACQUIRE, "agent");
            asm volatile("s_waitcnt vmcnt(0)" ::: "memory");
        }
    }
    __syncthreads();
}

namespace pg8 {
constexpr int BM = 256, BK = 64, HALF = 128, HTB = HALF * BK * 2, STAGE_BYTES = 8 * HTB;
__host__ __device__ __forceinline__ int lds_byte(int r, int c) { const int st = (r >> 4) * 2 + (c >> 5), rr = r & 15, cc = c & 31, ob = rr * 64 + cc * 2; return st * 1024 + (ob ^ (((ob >> 9) & 1) << 5)); }
__host__ __device__ __forceinline__ void stage_rc(int b, int& R, int& C) { const int st = b / 1024, sb = b % 1024, swz = sb ^ (((sb >> 9) & 1) << 5); R = (st >> 1) * 16 + swz / 64; C = (st & 1) * 32 + (swz % 64) / 2; }
__host__ __device__ __forceinline__ int perm32(int rho) { const int n = rho >> 4, i = rho & 15; return 8 * (i >> 2) + 4 * n + (i & 3); }

struct Unit { const char* a; const char* b; int pm, pn, e; };

template <class Epi, class Sched, bool ALIGN_EPI, bool GATHER>
__device__ __forceinline__ void gemm_phase(const int tid, LAS unsigned char* lds, const int K, const int lda, const int ldb, const Sched& S, const Epi& E, const int* __restrict__ tokof) {
    const int wid = __builtin_amdgcn_readfirstlane(tid >> 6), lane = tid & 63, wr = wid >> 2, wc = wid & 3, fr = lane & 15, fq = lane >> 4;
    const int nt = K / BK;
    unsigned voffA[2], voffB[2]; int RA[2], CA2[2];
#pragma unroll
    for (int i = 0; i < 2; ++i) { int R, C; stage_rc(tid * 16 + i * 8192, R, C); const int Rb = Epi::PERM ? ((R & ~31) + perm32(R & 31)) : R;
        voffA[i] = (unsigned)(R * lda + C) * 2u; voffB[i] = (unsigned)(Rb * ldb + C) * 2u; RA[i] = R; CA2[i] = C * 2; }
    const size_t kstep = (size_t)(BK * 2);
    const size_t hstepA = GATHER ? 0 : (size_t)HALF * lda * 2;
    const size_t hstepB = (size_t)HALF * ldb * 2;
    const unsigned ldsw = (unsigned)wid * 1024u;
    const int aoff = lds_byte(wr * 64 + fr, fq * 8), boff = lds_byte(wc * 32 + fr, fq * 8);
    unsigned gcur[2][2], gnxt[2][2];
#define PG8_SA(b, h) (((b) * 2 + (h)) * HTB)
#define PG8_SB(b, h) ((4 + (b) * 2 + (h)) * HTB)
#define PG8_STAGE(bufoff, gbase, voff) do { _Pragma("unroll") for (int _i = 0; _i < 2; ++_i) \
        __builtin_amdgcn_global_load_lds((const unsigned*)((const char*)(gbase) + (voff)[_i]), (LAS unsigned*)(lds + (bufoff) + ldsw + _i * 8192), 16, 0, 0); } while (0)
#define PG8_STAGE_A(bufoff, base, h, nx) do { if constexpr (GATHER) { unsigned _v[2]; _v[0] = (nx) ? gnxt[h][0] : gcur[h][0]; _v[1] = (nx) ? gnxt[h][1] : gcur[h][1]; PG8_STAGE(bufoff, base, _v); } \
        else { PG8_STAGE(bufoff, (base) + (h) * hstepA, voffA); } } while (0)
#define PG8_LDA(dst, b, h) do { _Pragma("unroll") for (int m = 0; m < 4; ++m) _Pragma("unroll") for (int k = 0; k < 2; ++k) dst[m][k] = *(const LAS bf16x8*)(lds + PG8_SA(b, h) + aoff + m * 2048 + k * 1024); } while (0)
#define PG8_LDB(dst, b, h) do { _Pragma("unroll") for (int n = 0; n < 2; ++n) _Pragma("unroll") for (int k = 0; k < 2; ++k) dst[n][k] = *(const LAS bf16x8*)(lds + PG8_SB(b, h) + boff + n * 2048 + k * 1024); } while (0)
#define PG8_MMA(ai, bj, At, Bt) do { __builtin_amdgcn_s_setprio(1); _Pragma("unroll") for (int m = 0; m < 4; ++m) _Pragma("unroll") for (int n = 0; n < 2; ++n) _Pragma("unroll") for (int k = 0; k < 2; ++k) \
        acc[ai][bj][m][n] = __builtin_amdgcn_mfma_f32_16x16x32_bf16(Bt[n][k], At[m][k], acc[ai][bj][m][n], 0, 0, 0); __builtin_amdgcn_s_setprio(0); } while (0)
#define PG8_WAIT_V(n) asm volatile("s_waitcnt vmcnt(" #n ")" ::: "memory")
#define PG8_WAIT_L(n) asm volatile("s_waitcnt lgkmcnt(" #n ")" ::: "memory")
#define PG8_BAR __builtin_amdgcn_s_barrier()
#define PG8_SCHED __builtin_amdgcn_sched_barrier(0)
#define PG8_GLOAD(dst, u) do { if constexpr (GATHER) { _Pragma("unroll") for (int _h = 0; _h < 2; ++_h) _Pragma("unroll") for (int _i = 0; _i < 2; ++_i) \
        dst[_h][_i] = (unsigned)tokof[(u).pm * BM + _h * HALF + RA[_i]] * (unsigned)(lda * 2) + (unsigned)CA2[_i]; } } while (0)
    Unit cur, nxt; int ui = 0;
    if (!S.next(0, cur)) return;
    PG8_GLOAD(gcur, cur);
    f32x4 acc[2][2][4][2];
#pragma unroll
    for (int a = 0; a < 2; ++a)
#pragma unroll
        for (int b = 0; b < 2; ++b)
#pragma unroll
            for (int m = 0; m < 4; ++m)
#pragma unroll
                for (int n = 0; n < 2; ++n) acc[a][b][m][n] = (f32x4){0.f, 0.f, 0.f, 0.f};
    bf16x8 At[4][2], B0[2][2], B1[2][2];
    const char* cA = cur.a; const char* cB = cur.b;
    PG8_STAGE(PG8_SB(0, 0), cB, voffB); PG8_STAGE(PG8_SB(0, 1), cB + hstepB, voffB); PG8_STAGE_A(PG8_SA(0, 0), cA, 0, false); PG8_STAGE_A(PG8_SA(0, 1), cA, 1, false);
    if (wr == 1) PG8_BAR;
    PG8_WAIT_V(2); PG8_BAR;
    PG8_STAGE(PG8_SB(1, 0), cB + kstep, voffB); PG8_STAGE_A(PG8_SA(1, 0), cA + kstep, 0, false); PG8_STAGE(PG8_SB(1, 1), cB + hstepB + kstep, voffB);
    PG8_WAIT_V(6); PG8_BAR;
    for (;;) {
        const bool has_next = S.next(ui + 1, nxt);
        if constexpr (GATHER) { if (has_next) { PG8_GLOAD(gnxt, nxt); } else { _Pragma("unroll") for (int _h = 0; _h < 2; ++_h) _Pragma("unroll") for (int _i = 0; _i < 2; ++_i) gnxt[_h][_i] = gcur[_h][_i]; } }
        const char* nA = has_next ? nxt.a : cA; const char* nB = has_next ? nxt.b : cB;
        for (int t = 0; t < nt; t += 2) {
            const bool last = (t == nt - 2);
            const char* a1 = cA + (size_t)(t + 1) * kstep;
            const char* a2 = last ? nA : cA + (size_t)(t + 2) * kstep; const char* b2 = last ? nB : cB + (size_t)(t + 2) * kstep;
            const char* a3 = a2 + kstep; const char* b3 = b2 + kstep;
            PG8_LDB(B0, 0, 0); PG8_LDB(B1, 0, 1); PG8_SCHED; PG8_LDA(At, 0, 0); PG8_STAGE_A(PG8_SA(1, 1), a1, 1, false);
            PG8_WAIT_V(8); PG8_WAIT_L(0); PG8_BAR; PG8_MMA(0, 0, At, B0); PG8_MMA(0, 1, At, B1); PG8_BAR; PG8_SCHED;
            PG8_LDA(At, 0, 1); PG8_STAGE(PG8_SB(0, 0), b2, voffB); PG8_STAGE(PG8_SB(0, 1), b2 + hstepB, voffB); PG8_STAGE_A(PG8_SA(0, 0), a2, 0, last);
            PG8_WAIT_V(8); PG8_WAIT_L(0); PG8_BAR; PG8_MMA(1, 0, At, B0); PG8_MMA(1, 1, At, B1); PG8_BAR; PG8_SCHED;
            PG8_LDB(B0, 1, 0); PG8_LDB(B1, 1, 1); PG8_SCHED; PG8_LDA(At, 1, 0); PG8_STAGE_A(PG8_SA(0, 1), a2, 1, last);
            PG8_WAIT_V(8); PG8_WAIT_L(0); PG8_BAR; PG8_MMA(0, 0, At, B0); PG8_MMA(0, 1, At, B1); PG8_BAR; PG8_SCHED;
            PG8_LDA(At, 1, 1); PG8_STAGE(PG8_SB(1, 0), b3, voffB); PG8_STAGE(PG8_SB(1, 1), b3 + hstepB, voffB); PG8_STAGE_A(PG8_SA(1, 0), a3, 0, last);
            PG8_WAIT_V(8); PG8_WAIT_L(0); PG8_BAR; PG8_MMA(1, 0, At, B0); PG8_MMA(1, 1, At, B1); PG8_BAR; PG8_SCHED;
        }
        if constexpr (ALIGN_EPI) { if (wr == 0) PG8_BAR; }
        E(acc, cur, wr, wc, fr, fq);
        if (!has_next) break;
#pragma unroll
        for (int a = 0; a < 2; ++a)
#pragma unroll
            for (int b = 0; b < 2; ++b)
#pragma unroll
                for (int m = 0; m < 4; ++m)
#pragma unroll
                    for (int n = 0; n < 2; ++n) acc[a][b][m][n] = (f32x4){0.f, 0.f, 0.f, 0.f};
        cur = nxt; cA = nA; cB = nB; ++ui;
        if constexpr (GATHER) { _Pragma("unroll") for (int _h = 0; _h < 2; ++_h) _Pragma("unroll") for (int _i = 0; _i < 2; ++_i) gcur[_h][_i] = gnxt[_h][_i]; }
        if constexpr (ALIGN_EPI) { if (wr == 1) PG8_BAR; }
    }
    PG8_WAIT_V(0);
    if constexpr (!ALIGN_EPI) { if (wr == 0) PG8_BAR; }
    PG8_BAR;
#undef PG8_SA
#undef PG8_SB
#undef PG8_STAGE
#undef PG8_STAGE_A
#undef PG8_LDA
#undef PG8_LDB
#undef PG8_MMA
#undef PG8_WAIT_V
#undef PG8_WAIT_L
#undef PG8_BAR
#undef PG8_SCHED
#undef PG8_GLOAD
}
}
using pg8::Unit;

struct DenseOrder {
    int nM, nN, nwg, G, c; const char* A; const char* B; size_t aT, bT;
    __device__ __forceinline__ bool next(int i, Unit& u) const {
        const long L = (long)i * G + c; if (L >= nwg) return false;
        int wgid = (int)L; { const int q = nwg / 8, r = nwg % 8, xcd = wgid % 8, off = wgid / 8; wgid = (xcd < r ? xcd * (q + 1) : r * (q + 1) + (xcd - r) * q) + off; }
        const int nig = 8 * nN, gid = wgid / nig, fm = gid * 8, gsz = (nM - fm) < 8 ? (nM - fm) : 8;
        u.pm = fm + ((wgid % nig) % gsz); u.pn = (wgid % nig) / gsz; u.e = 0;
        u.a = A + (size_t)u.pm * aT; u.b = B + (size_t)u.pn * bT; return true;
    }
};
struct UpOrder {
    int G, c; const char* LATp; const char* Wq; const char* Wkv;
    __device__ __forceinline__ bool next(int i, Unit& u) const {
        const int L = i * G + c; if (L >= 128 * 7) return false;
        u.pm = L / 7; const int j = L % 7; const bool kv = j >= 3; u.pn = kv ? j - 3 : j; u.e = kv ? 1 : 0;
        u.a = LATp + (size_t)u.pm * 256 * 512 * 2 + (kv ? 512 : 0);
        u.b = (kv ? Wkv : Wq) + (size_t)u.pn * 256 * 256 * 2; return true;
    }
};
struct MoeOrder {
    int G, c; const volatile LAS int* TS; const char* A; const char* W; size_t aT  , wE  , wT  ;
    __device__ __forceinline__ bool next(int i, Unit& u) const {
        const int L = i * G + c; const int ntile = TS[32]; if (L >= ntile * 4) return false;
        const int rt = L >> 2, ct = L & 3; int e = 0;
        for (int j = 1; j < 32; ++j) e += (TS[j] <= rt) ? 1 : 0;
        u.pm = rt; u.pn = ct; u.e = e; u.a = A + (size_t)rt * aT; u.b = W + (size_t)e * wE + (size_t)ct * wT; return true;
    }
};

__device__ __forceinline__ u32x4 pack8(f32x4 v0, f32x4 v1) { u32x4 w; w.x = cvt_pk_bf16(v0[0], v0[1]); w.y = cvt_pk_bf16(v0[2], v0[3]); w.z = cvt_pk_bf16(v1[0], v1[1]); w.w = cvt_pk_bf16(v1[2], v1[3]); return w; }

struct EpiWin {
    static constexpr bool PERM = true;
    bf16* LAT_; bf16* FQKV_; bf16* KPE_; float* FLOG_; float* SSQ_; const float* COS_; const float* SIN_;
    __device__ __forceinline__ void operator()(const f32x4 (&acc)[2][2][4][2], const Unit& u, int wr, int wc, int fr, int fq) const {
        bf16* LAT = LAT_; bf16* FQKV = FQKV_; bf16* KPE = KPE_; float* FLOG = FLOG_; float* SSQ = SSQ_; const float* COS = COS_; const float* SIN = SIN_;
        asm volatile("" : "+s"(LAT), "+s"(FQKV), "+s"(KPE), "+s"(FLOG), "+s"(SSQ), "+s"(COS), "+s"(SIN));
        const int row0 = u.pm * 256 + wr * 64 + fr; const int pn = u.pn;
        if (pn >= 2) {
            const int ti = pn >> 1; bf16* dst = FQKV + (size_t)(ti - 1) * NTOK * 512; const int colb = (pn & 1) * 256 + wc * 32 + 8 * fq; const float sc = (ti == 1) ? C2F : 1.f;
#pragma unroll
            for (int ai = 0; ai < 2; ++ai)
#pragma unroll
                for (int m = 0; m < 4; ++m) { bf16* rowp = dst + (size_t)(row0 + ai * 128 + m * 16) * 512 + colb;
#pragma unroll
                    for (int bj = 0; bj < 2; ++bj) *(u32x4*)(rowp + bj * 128) = pack8(acc[ai][bj][m][0] * sc, acc[ai][bj][m][1] * sc); }
        } else {
#pragma unroll
            for (int ai = 0; ai < 2; ++ai)
#pragma unroll
                for (int m = 0; m < 4; ++m) { const int row = row0 + ai * 128 + m * 16; bf16* rowp = LAT + (size_t)row * 512 + pn * 256 + wc * 32 + 8 * fq;
#pragma unroll
                    for (int bj = 0; bj < 2; ++bj) *(u32x4*)(rowp + bj * 128) = pack8(acc[ai][bj][m][0], acc[ai][bj][m][1]);
                    float s = 0.f;
#pragma unroll
                    for (int n = 0; n < 2; ++n) { const f32x4 x = acc[ai][0][m][n]; s += (x[0] * x[0] + x[1] * x[1]) + (x[2] * x[2] + x[3] * x[3]); }
                    if (pn == 0) {
#pragma unroll
                        for (int n = 0; n < 2; ++n) { const f32x4 x = acc[ai][1][m][n]; s += (x[0] * x[0] + x[1] * x[1]) + (x[2] * x[2] + x[3] * x[3]); }
                    }
                    s += __shfl_xor(s, 16); s += __shfl_xor(s, 32);
                    if (fq == 0) SSQ[(size_t)row * 8 + pn * 4 + wc] = s;
                    asm volatile("" ::: "memory"); }
            if (pn == 1 && wc == 0) {
#pragma unroll
                for (int ai = 0; ai < 2; ++ai)
#pragma unroll
                    for (int m = 0; m < 4; ++m) { const int row = row0 + ai * 128 + m * 16;
                        const f32x4 c = *(const f32x4*)(COS + (size_t)row * 16 + 4 * fq), sn = *(const f32x4*)(SIN + (size_t)row * 16 + 4 * fq);
                        const f32x4 x1 = acc[ai][1][m][0], x2 = acc[ai][1][m][1];
                        *(u32x4*)(KPE + (size_t)row * 32 + 8 * fq) = pack8(x1 * c - x2 * sn, x1 * sn + x2 * c);
                        asm volatile("" ::: "memory"); }
            }
            if (pn == 1 && wc == 1 && fq == 0) {
#pragma unroll
                for (int ai = 0; ai < 2; ++ai)
#pragma unroll
                    for (int m = 0; m < 4; ++m) { const int row = row0 + ai * 128 + m * 16; *(f32x4*)(FLOG + (size_t)row * 8) = acc[ai][1][m][0]; *(f32x4*)(FLOG + (size_t)row * 8 + 4) = acc[ai][1][m][1]; }
            }
        }
    }
};
struct EpiUp {
    static constexpr bool PERM = true;
    bf16* QM_; bf16* KVM_; const float* SSQ_; const float* COS_; const float* SIN_;
    __device__ __forceinline__ void operator()(const f32x4 (&acc)[2][2][4][2], const Unit& u, int wr, int wc, int fr, int fq) const {
        bf16* QM = QM_; bf16* KVM = KVM_; const float* SSQ = SSQ_; const float* COS = COS_; const float* SIN = SIN_;
        asm volatile("" : "+s"(QM), "+s"(KVM), "+s"(SSQ), "+s"(COS), "+s"(SIN));
        const int row0 = u.pm * 256 + wr * 64 + fr; const int pn = u.pn; const bool kv = u.e != 0;
#pragma unroll
        for (int ai = 0; ai < 2; ++ai)
#pragma unroll
            for (int m = 0; m < 4; ++m) { const int row = row0 + ai * 128 + m * 16;
                const f32x4 sq = *(const f32x4*)(SSQ + (size_t)row * 8 + (kv ? 4 : 0));
                const float ss = (sq[0] + sq[1]) + (sq[2] + sq[3]);
                if (kv) {
                    const float rs = rsqrtf(ss * (1.f / 128.f) + EPS);
                    bf16* rowp = KVM + (size_t)row * 1024 + pn * 256 + wc * 32 + 8 * fq;
#pragma unroll
                    for (int bj = 0; bj < 2; ++bj) *(u32x4*)(rowp + bj * 128) = pack8(acc[ai][bj][m][0] * rs, acc[ai][bj][m][1] * rs);
                } else {
                    const float rs = rsqrtf(ss * (1.f / 256.f) + EPS) * C2M;
                    bf16* rowp = QM + (size_t)row * 768 + pn * 256 + wc * 32 + 8 * fq;
                    const f32x4 c = *(const f32x4*)(COS + (size_t)row * 16 + 4 * fq), sn = *(const f32x4*)(SIN + (size_t)row * 16 + 4 * fq);
#pragma unroll
                    for (int bj = 0; bj < 2; ++bj) { f32x4 v0 = acc[ai][bj][m][0] * rs, v1 = acc[ai][bj][m][1] * rs;
                        const int G = 8 * pn + 4 * bj + wc;
                        if (G % 3 == 2) { const f32x4 x1 = v0, x2 = v1; v0 = x1 * c - x2 * sn; v1 = x1 * sn + x2 * c; }
                        *(u32x4*)(rowp + bj * 128) = pack8(v0, v1); }
                }
                asm volatile("" ::: "memory");
            }
    }
};
struct EpiOut {
    static constexpr bool PERM = false;
    const float* resid_; float* out_;
    __device__ __forceinline__ void operator()(const f32x4 (&acc)[2][2][4][2], const Unit& u, int wr, int wc, int fr, int fq) const {
        const float* resid = resid_; float* out = out_; asm volatile("" : "+s"(resid), "+s"(out));
        const int row0 = u.pm * 256 + wr * 64 + fr, col0 = u.pn * 256 + wc * 32 + 4 * fq;
#pragma unroll
        for (int ai = 0; ai < 2; ++ai)
#pragma unroll
            for (int m = 0; m < 4; ++m) { const size_t off = (size_t)(row0 + ai * 128 + m * 16) * DM + col0;
#pragma unroll
                for (int bj = 0; bj < 2; ++bj)
#pragma unroll
                    for (int n = 0; n < 2; ++n) { const f32x4 r = *(const f32x4*)(resid + off + bj * 128 + n * 16); *(f32x4*)(out + off + bj * 128 + n * 16) = r + acc[ai][bj][m][n]; } }
    }
};
struct EpiGU {
    static constexpr bool PERM = true;
    bf16* HH_;
    __device__ __forceinline__ void operator()(const f32x4 (&acc)[2][2][4][2], const Unit& u, int wr, int wc, int fr, int fq) const {
        bf16* HH = HH_; asm volatile("" : "+s"(HH));
        const int row0 = u.pm * 256 + wr * 64 + fr;
#pragma unroll
        for (int ai = 0; ai < 2; ++ai)
#pragma unroll
            for (int m = 0; m < 4; ++m) { bf16* rowp = HH + (size_t)(row0 + ai * 128 + m * 16) * 512 + u.pn * 128 + wc * 32 + 8 * fq;
                f32x4 h[2];
#pragma unroll
                for (int n = 0; n < 2; ++n) { const f32x4 g = acc[ai][0][m][n], up = acc[ai][1][m][n];
#pragma unroll
                    for (int j = 0; j < 4; ++j) { const float sg = __builtin_amdgcn_rcpf(1.f + __builtin_amdgcn_exp2f(-g[j] * LOG2E)); h[n][j] = g[j] * sg * up[j]; } }
                *(u32x4*)rowp = pack8(h[0], h[1]); }
    }
};
struct EpiDown {
    static constexpr bool PERM = true;
    bf16* Y_; const float* GATEOF_;
    __device__ __forceinline__ void operator()(const f32x4 (&acc)[2][2][4][2], const Unit& u, int wr, int wc, int fr, int fq) const {
        bf16* Y = Y_; const float* GATEOF = GATEOF_; asm volatile("" : "+s"(Y), "+s"(GATEOF));
        const int row0 = u.pm * 256 + wr * 64 + fr;
#pragma unroll
        for (int ai = 0; ai < 2; ++ai)
#pragma unroll
            for (int m = 0; m < 4; ++m) { const int row = row0 + ai * 128 + m * 16; const float g = GATEOF[row]; bf16* rowp = Y + (size_t)row * 1024 + u.pn * 256 + wc * 32 + 8 * fq;
#pragma unroll
                for (int bj = 0; bj < 2; ++bj) *(u32x4*)(rowp + bj * 128) = pack8(acc[ai][bj][m][0] * g, acc[ai][bj][m][1] * g); }
    }
};

namespace att {
constexpr int KSLOT = 12288, VSLOT = 8192;
constexpr int L_K = 0, L_V = 2 * KSLOT, L_BIAS = L_V + 2 * VSLOT, L_WS = L_BIAS + 8192, L_OST = L_WS + 8 * 64 * 4, L_END = L_OST + 8 * 4096;
__device__ __forceinline__ int crow(int r, int hi) { return (r & 3) + 8 * (r >> 2) + 4 * hi; }
typedef short v4i16_t __attribute__((ext_vector_type(4)));
__device__ __forceinline__ s16x4 vtr(const LAS char* p) { return __builtin_bit_cast(s16x4, __builtin_amdgcn_ds_read_tr16_b64_v4i16((LAS v4i16_t*)p)); }

struct Tens { const bf16* Q; int qp; const bf16* K; int kp; const bf16* KPE; const bf16* V; int vp; const float* BIAS; bf16* O; };
template <int MODE>
__device__ __forceinline__ void attn_unit(const int tid, int b, int h, int qb, const Tens& T, LAS char* shm) {
    constexpr int DKS = MODE ? 6 : 4;
    const int lane = tid & 63, r32 = lane & 31, hi = lane >> 5; const int wid = __builtin_amdgcn_readfirstlane(tid >> 6);
    const long rowbase = (long)b * SEQ; const int q0 = qb * 256, qw0 = q0 + wid * 32;
    const int NT = (q0 + 256) / 64, tlast = qw0 / 64;
    const bf16* Qw = T.Q + (rowbase + qw0) * T.qp + h * (MODE ? 96 : 64);
    const bf16* Kh = T.K + rowbase * T.kp + h * (MODE ? 128 : 64);
    const bf16* Vh = T.V + rowbase * T.vp + h * (MODE ? 128 : 64);
    const bf16* KPEb = T.KPE + rowbase * 32;
    LAS float* wsf = (LAS float*)(shm + L_WS) + wid * 64;
    LAS float* biasb = (LAS float*)(shm + L_BIAS);
    bf16x8 qr[DKS];
#pragma unroll
    for (int d0 = 0; d0 < DKS; ++d0) qr[d0] = *(const bf16x8*)(Qw + (long)r32 * T.qp + d0 * 16 + hi * 8);
    if (MODE == 0) { const float* bs = T.BIAS + ((long)b * 8 + h) * SEQ; for (int i = tid; i < q0 + 256; i += 512) biasb[i] = bs[i]; }
    const bf16* ksrc = Kh + (long)lane * T.kp + wid * 8;
    const bf16* k2src = KPEb + (long)lane * 32 + (wid & 3) * 8;
    const bf16* vsrc = Vh + (long)(16 * (wid & 3) + (lane >> 2)) * T.vp + (wid >> 2) * 32 + (lane & 3) * 8;
    u32x4 kreg, k2reg, vreg; k2reg = (u32x4){0u, 0u, 0u, 0u};
    kreg = *(const u32x4*)ksrc; vreg = *(const u32x4*)vsrc; if (MODE && wid < 4) k2reg = *(const u32x4*)k2src;
    float mrun = -1e30f, lrun = 0.f; f32x16 o[2]; o[0] = f32x16{}; o[1] = f32x16{};
    const LAS char* vp0 = shm + L_V + ((lane >> 4) & 1) * 32 + (lane & 3) * 8 + (4 * hi + ((lane & 15) >> 2)) * 64;
    for (int t = 0; t < NT; ++t) {
        const int sl = t & 1;
        *(LAS u32x4*)(shm + L_K + sl * KSLOT + wid * 1024 + lane * 16) = kreg;
        if (MODE && wid < 4) *(LAS u32x4*)(shm + L_K + sl * KSLOT + (8 + wid) * 1024 + lane * 16) = k2reg;
        *(LAS u32x4*)(shm + L_V + sl * VSLOT + wid * 1024 + lane * 16) = vreg;
        __syncthreads();
        if (t + 1 < NT) { kreg = *(const u32x4*)(ksrc + (long)(t + 1) * 64 * T.kp); vreg = *(const u32x4*)(vsrc + (long)(t + 1) * 64 * T.vp); if (MODE && wid < 4) k2reg = *(const u32x4*)(k2src + (long)(t + 1) * 64 * 32); }
        if (t <= tlast) {
            const LAS char* kb = shm + L_K + sl * KSLOT + hi * 1024 + r32 * 16;
            f32x16 p0 = f32x16{}, p1 = f32x16{};
#pragma unroll
            for (int d0 = 0; d0 < DKS; ++d0) {
                const bf16x8 b0 = *(const LAS bf16x8*)(kb + d0 * 2048), b1 = *(const LAS bf16x8*)(kb + d0 * 2048 + 512);
                p0 = __builtin_amdgcn_mfma_f32_32x32x16_bf16(b0, qr[d0], p0, 0, 0, 0); p1 = __builtin_amdgcn_mfma_f32_32x32x16_bf16(b1, qr[d0], p1, 0, 0, 0);
            }
            if (MODE == 0) {
                const LAS float* bb = biasb + t * 64 + 4 * hi;
#pragma unroll
                for (int g = 0; g < 4; ++g) { const f32x4 x0 = *(const LAS f32x4*)(bb + 8 * g), x1 = *(const LAS f32x4*)(bb + 32 + 8 * g);
#pragma unroll
                    for (int j = 0; j < 4; ++j) { p0[4 * g + j] += x0[j]; p1[4 * g + j] += x1[j]; } }
                if (t == tlast) { const int qrel = qw0 + r32 - 64 * t;
#pragma unroll
                    for (int r = 0; r < 16; ++r) { const int kv = crow(r, hi); if (kv > qrel) p0[r] = -INFINITY; if (kv + 32 > qrel) p1[r] = -INFINITY; } }
            }
            float rm = p0[0];
#pragma unroll
            for (int r = 1; r < 16; ++r) rm = fmaxf(rm, p0[r]);
#pragma unroll
            for (int r = 0; r < 16; ++r) rm = fmaxf(rm, p1[r]);
            rm = fmaxf(rm, __shfl_xor(rm, 32));
            const float mnew = fmaxf(mrun, rm); const float f = __builtin_amdgcn_exp2f(mrun - mnew); mrun = mnew;
            float ls = 0.f;
#pragma unroll
            for (int r = 0; r < 16; ++r) { p0[r] = __builtin_amdgcn_exp2f(p0[r] - mnew); p1[r] = __builtin_amdgcn_exp2f(p1[r] - mnew); ls += p0[r] + p1[r]; }
            lrun = lrun * f + ls;
            if (hi == 0) wsf[r32] = f;
            LDS_WAIT();
#pragma unroll
            for (int g = 0; g < 4; ++g) { const f32x4 ff = *(const LAS f32x4*)(wsf + 8 * g + 4 * hi);
#pragma unroll
                for (int j = 0; j < 4; ++j) { o[0][4 * g + j] *= ff[j]; o[1][4 * g + j] *= ff[j]; } }
            bf16x8 pa[4];
            { u32x4 w;
              w.x = cvt_pk_bf16(p0[0], p0[1]); w.y = cvt_pk_bf16(p0[2], p0[3]); w.z = cvt_pk_bf16(p0[4], p0[5]); w.w = cvt_pk_bf16(p0[6], p0[7]); pa[0] = __builtin_bit_cast(bf16x8, w);
              w.x = cvt_pk_bf16(p0[8], p0[9]); w.y = cvt_pk_bf16(p0[10], p0[11]); w.z = cvt_pk_bf16(p0[12], p0[13]); w.w = cvt_pk_bf16(p0[14], p0[15]); pa[1] = __builtin_bit_cast(bf16x8, w);
              w.x = cvt_pk_bf16(p1[0], p1[1]); w.y = cvt_pk_bf16(p1[2], p1[3]); w.z = cvt_pk_bf16(p1[4], p1[5]); w.w = cvt_pk_bf16(p1[6], p1[7]); pa[2] = __builtin_bit_cast(bf16x8, w);
              w.x = cvt_pk_bf16(p1[8], p1[9]); w.y = cvt_pk_bf16(p1[10], p1[11]); w.z = cvt_pk_bf16(p1[12], p1[13]); w.w = cvt_pk_bf16(p1[14], p1[15]); pa[3] = __builtin_bit_cast(bf16x8, w); }
            const LAS char* vp = vp0 + sl * VSLOT;
#pragma unroll
            for (int d0 = 0; d0 < 2; ++d0)
#pragma unroll
                for (int k = 0; k < 4; ++k) { const s16x4 lo = vtr(vp + d0 * 4096 + k * 1024), hh = vtr(vp + d0 * 4096 + k * 1024 + 512);
                    const bf16x8 vf = (bf16x8){lo[0], lo[1], lo[2], lo[3], hh[0], hh[1], hh[2], hh[3]};
                    o[d0] = __builtin_amdgcn_mfma_f32_32x32x16_bf16(pa[k], vf, o[d0], 0, 0, 0); }
        }
    }
    lrun += __shfl_xor(lrun, 32);
    LDS_WAIT();
    if (hi == 0) wsf[32 + r32] = lrun;
    LDS_WAIT();
    float rli[16];
#pragma unroll
    for (int g = 0; g < 4; ++g) { const f32x4 ll = *(const LAS f32x4*)(wsf + 32 + 8 * g + 4 * hi);
#pragma unroll
        for (int j = 0; j < 4; ++j) rli[4 * g + j] = __builtin_amdgcn_rcpf(ll[j]); }
    bf16* Ow = T.O + (rowbase + qw0) * 1024 + (MODE ? 0 : 512) + h * 64;
    { LAS bf16* stg = (LAS bf16*)(shm + L_OST) + wid * 2048;
#pragma unroll
      for (int r = 0; r < 16; ++r) { const int orow = crow(r, hi);
#pragma unroll
          for (int d0 = 0; d0 < 2; ++d0) stg[orow * 64 + d0 * 32 + r32] = (bf16)(cvt_pk_bf16(o[d0][r] * rli[r], 0.f) & 0xffffu); }
      LDS_WAIT();
#pragma unroll
      for (int i = 0; i < 4; ++i) { const int row = i * 8 + (lane >> 3), ch = lane & 7; const u32x4 v = *(const LAS u32x4*)(stg + row * 64 + ch * 8); *(u32x4*)(Ow + (long)row * 1024 + ch * 8) = v; } }
    __syncthreads();
}
}

struct Args { const void* in[21]; float* out; unsigned char* ws; int ph_lo, ph_hi; };

__device__ __forceinline__ void tr_item(const float* __restrict__ W, int ldw, int Ksrc, const float* __restrict__ gain, bf16* __restrict__ WT, int ldk, int k0, int n0, int srccol, LAS float* scr, int lane) {
#pragma unroll 8
    for (int i = 0; i < 32; ++i) { const int kk = 2 * i + (lane >> 5); const int k = k0 + kk;
        float v = 0.f; if (srccol >= 0 && k < Ksrc) { v = W[(size_t)k * ldw + srccol]; if (gain) v *= gain[k]; }
        scr[kk * 33 + (lane & 31)] = v; }
    LDS_WAIT(); asm volatile("" ::: "memory");
    const int c = lane & 7;
#pragma unroll
    for (int j = 0; j < 4; ++j) { const int n = (lane >> 3) + 8 * j; const LAS float* s = scr + (8 * c) * 33 + n;
        u32x4 o; o.x = cvt_pk_bf16(s[0 * 33], s[1 * 33]); o.y = cvt_pk_bf16(s[2 * 33], s[3 * 33]); o.z = cvt_pk_bf16(s[4 * 33], s[5 * 33]); o.w = cvt_pk_bf16(s[6 * 33], s[7 * 33]);
        *(u32x4*)(WT + (size_t)(n0 + n) * ldk + k0 + 8 * c) = o; }
    LDS_WAIT(); asm volatile("" ::: "memory");
}
__device__ __forceinline__ int rope_dim(int p) { const int a = p >> 3, j = p & 7; return j < 4 ? 4 * a + j : 16 + 4 * a + (j - 4); }

#define LDP(i) ((void*)((((unsigned long long)(unsigned)__builtin_amdgcn_readfirstlane((int)(ARGP[i] >> 32))) << 32) | (unsigned long long)(unsigned)__builtin_amdgcn_readfirstlane((int)(unsigned)ARGP[i])))
#define ARGIN(i) ((const void*)LDP(i))
#define P_COS ((float*)(ws + WS_COS))
#define P_SIN ((float*)(ws + WS_SIN))
#define P_SSQ ((float*)(ws + WS_SSQ))
#define P_FLOG ((float*)(ws + WS_FLOG))
#define P_BIAS ((float*)(ws + WS_BIAS))
#define P_E01 ((int*)(ws + WS_E01))
#define P_G01 ((float*)(ws + WS_G01))
#define P_SLOT ((int*)(ws + WS_SLOT))
#define P_TOKOF ((int*)(ws + WS_TOKOF))
#define P_GATEOF ((float*)(ws + WS_GATEOF))
#define P_CNT ((int*)(ws + WS_CNT))
#define P_TSTART ((int*)(ws + WS_TSTART))
#define P_KPE ((bf16*)(ws + WS_KPE))
#define P_WIN ((bf16*)(ws + WS_WIN))
#define P_WUQ ((bf16*)(ws + WS_WUQ))
#define P_WUKV ((bf16*)(ws + WS_WUKV))
#define P_WOUT ((bf16*)(ws + WS_WOUT))
#define P_WGU ((bf16*)(ws + WS_WGU))
#define P_WD ((bf16*)(ws + WS_WD))
#define P_XN ((bf16*)(ws + WS_XN))
#define P_FQKV ((bf16*)(ws + WS_FQKV))
#define P_HH ((bf16*)(ws + WS_FQKV))
#define P_LAT ((bf16*)(ws + WS_LAT))
#define P_QM ((bf16*)(ws + WS_QM))
#define P_KVM ((bf16*)(ws + WS_KVM))
#define P_Y ((bf16*)(ws + WS_Y))
#define IN(k) (lo <= (k) && (k) < hi_)
#if MK_ONE_LAUNCH
#define GRID_BAR() xcd_barrier(bar)
#else
#define GRID_BAR() do {} while (0)
#endif
#define SEAM(k) do { if (IN(k) && IN((k) + 1)) GRID_BAR(); } while (0)
template <int l>
__device__ __forceinline__ void layer_body(const int lo, const int hi_, LAS unsigned char* lds0, const int wave0, const int G0, const int bx0, const XcdBarrier& bar) {
        const int P = 10 * l;
        if (IN(P)) {
            unsigned ldsb_ = (unsigned)(uintptr_t)lds0; asm volatile("" : "+s"(ldsb_)); LAS unsigned char* lds = (LAS unsigned char*)(uintptr_t)ldsb_; volatile LAS unsigned* MISC = (volatile LAS unsigned*)(lds + MISC_OFF); volatile LAS unsigned long long* ARGP = (volatile LAS unsigned long long*)(lds + MISC_OFF + 768); (void)MISC; int wave = wave0, G = G0, bx = bx0; asm volatile("" : "+s"(G), "+s"(bx), "+s"(wave)); const int lane = (int)__builtin_amdgcn_mbcnt_hi(~0u, __builtin_amdgcn_mbcnt_lo(~0u, 0u)); const int tid = wave * 64 + lane; const int vcu = (bx % 8) * (G / 8) + bx / 8; const int gw = vcu * 8 + wave, NGW = G * 8; (void)lane; (void)gw; (void)NGW; (void)vcu;
            unsigned char* ws = (unsigned char*)LDP(22); float* out = (float*)LDP(21); const float* x_in = (const float*)ARGIN(0); const int* positions = (const int*)ARGIN(1);
            if (l < NLAYER) {
                LAS float* scr = (LAS float*)(lds + wave * 16384);
                const float* attn_norm = (const float*)ARGIN(2) + (size_t)l * DM; const float* w_in = (const float*)ARGIN(3) + (size_t)l * DM * INW;
                const float* q_norm = (const float*)ARGIN(5) + (size_t)l * 256; const float* w_uq = (const float*)ARGIN(6) + (size_t)l * 256 * 768;
                const float* kv_norm = (const float*)ARGIN(7) + (size_t)l * 128; const float* w_ukv = (const float*)ARGIN(8) + (size_t)l * 128 * 1024;
                const float* mla_on = (const float*)ARGIN(9) + (size_t)l * 512; const float* fox_on = (const float*)ARGIN(10) + (size_t)l * 512; const float* w_out = (const float*)ARGIN(11) + (size_t)l * DM * DM;
                const float* ffn_norm = (const float*)ARGIN(12) + (size_t)l * DM;
                const float* w_gate = (const float*)ARGIN(17) + (size_t)l * NEXP * DM * DEXP; const float* w_up = (const float*)ARGIN(18) + (size_t)l * NEXP * DM * DEXP; const float* w_down = (const float*)ARGIN(19) + (size_t)l * NEXP * DEXP * DM;
                constexpr int I_IN = 16 * 64, I_UQ = 4 * 24, I_UKV = 4 * 32, I_OUT = 16 * 32, I_GU = 16 * 32 * NEXP, I_D = 8 * 32 * NEXP;
                constexpr int NITEMS = I_IN + I_UQ + I_UKV + I_OUT + I_GU + I_D;
                for (int it = gw; it < NITEMS; it += NGW) {
                    int r = it; const int j = lane & 31;
                    if (r < I_IN) { const int kb = r / 64, nb = r % 64; const int n = nb * 32 + j; int sc;
                        if (n < 384) sc = n; else if (n < 416) sc = 384 + rope_dim(n - 384); else if (n < 424) sc = 1952 + (n - 416); else if (n < 512) sc = -1; else sc = 416 + (n - 512);
                        tr_item(w_in, INW, DM, attn_norm, P_WIN, DM, kb * 64, nb * 32, sc, scr, lane); continue; } r -= I_IN;
                    if (r < I_UQ) { const int kb = r / 24, nb = r % 24; const int n = nb * 32 + j; const int hh = n / 96, d = n % 96; const int sc = d < 64 ? n : hh * 96 + 64 + rope_dim(d - 64);
                        tr_item(w_uq, 768, 256, q_norm, P_WUQ, 256, kb * 64, nb * 32, sc, scr, lane); continue; } r -= I_UQ;
                    if (r < I_UKV) { const int kb = r / 32, nb = r % 32; tr_item(w_ukv, 1024, 128, kv_norm, P_WUKV, 256, kb * 64, nb * 32, nb * 32 + j, scr, lane); continue; } r -= I_UKV;
                    if (r < I_OUT) { const int kb = r / 32, nb = r % 32; const float* gn = kb < 8 ? mla_on : fox_on - 512; tr_item(w_out, DM, DM, gn, P_WOUT, DM, kb * 64, nb * 32, nb * 32 + j, scr, lane); continue; } r -= I_OUT;
                    if (r < I_GU) { const int e = r / 512, q = r % 512, kb = q / 32, nb = q % 32; const int n0 = nb * 32; const int ct = n0 >> 8, which = (n0 >> 7) & 1, jj = n0 & 127;
                        const float* src = (which ? w_up : w_gate) + (size_t)e * DM * DEXP;
                        tr_item(src, DEXP, DM, ffn_norm, P_WGU + (size_t)e * 1024 * 1024, DM, kb * 64, n0, ct * 128 + jj + j, scr, lane); continue; } r -= I_GU;
                    { const int e = r / 256, q = r % 256, kb = q / 32, nb = q % 32;
                        tr_item(w_down + (size_t)e * DEXP * DM, DM, DEXP, nullptr, P_WD + (size_t)e * 1024 * 512, DEXP, kb * 64, nb * 32, nb * 32 + j, scr, lane); }
                }
            }
            const float* fin = (const float*)ARGIN(20);
            for (int m = gw; m < NTOK; m += NGW) {
                const float* xr = (l == 0 ? x_in : out) + (size_t)m * DM;
                f32x4 v[4];
#pragma unroll
                for (int j = 0; j < 4; ++j) v[j] = *(const f32x4*)(xr + 4 * lane + 256 * j);
                if (l > 0) {
                    const int s0 = P_SLOT[2 * m], s1 = P_SLOT[2 * m + 1];
#pragma unroll
                    for (int j = 0; j < 4; ++j) { const u32x2 a = *(const u32x2*)(P_Y + (size_t)s0 * 1024 + 4 * lane + 256 * j), c = *(const u32x2*)(P_Y + (size_t)s1 * 1024 + 4 * lane + 256 * j);
                        v[j][0] += __uint_as_float(a.x << 16) + __uint_as_float(c.x << 16); v[j][1] += __uint_as_float(a.x & 0xffff0000u) + __uint_as_float(c.x & 0xffff0000u);
                        v[j][2] += __uint_as_float(a.y << 16) + __uint_as_float(c.y << 16); v[j][3] += __uint_as_float(a.y & 0xffff0000u) + __uint_as_float(c.y & 0xffff0000u); }
                }
                float s = 0.f;
#pragma unroll
                for (int j = 0; j < 4; ++j) s += (v[j][0] * v[j][0] + v[j][1] * v[j][1]) + (v[j][2] * v[j][2] + v[j][3] * v[j][3]);
                const float rstd = rsqrtf(wave_sum(s) * (1.f / DM) + EPS);
                if (l < NLAYER) {
                    if (l > 0) {
#pragma unroll
                        for (int j = 0; j < 4; ++j) *(f32x4*)(out + (size_t)m * DM + 4 * lane + 256 * j) = v[j];
                    }
#pragma unroll
                    for (int j = 0; j < 4; ++j) { u32x2 w; w.x = cvt_pk_bf16(v[j][0] * rstd, v[j][1] * rstd); w.y = cvt_pk_bf16(v[j][2] * rstd, v[j][3] * rstd); *(u32x2*)(P_XN + (size_t)m * DM + 4 * lane + 256 * j) = w; }
                } else {
#pragma unroll
                    for (int j = 0; j < 4; ++j) { const f32x4 g = *(const f32x4*)(fin + 4 * lane + 256 * j); *(f32x4*)(out + (size_t)m * DM + 4 * lane + 256 * j) = v[j] * rstd * g; }
                }
            }
        }
        if constexpr (l == NLAYER) return;
        SEAM(P);
        if (IN(P + 1)) {
            unsigned ldsb_ = (unsigned)(uintptr_t)lds0; asm volatile("" : "+s"(ldsb_)); LAS unsigned char* lds = (LAS unsigned char*)(uintptr_t)ldsb_; volatile LAS unsigned* MISC = (volatile LAS unsigned*)(lds + MISC_OFF); volatile LAS unsigned long long* ARGP = (volatile LAS unsigned long long*)(lds + MISC_OFF + 768); (void)MISC; int wave = wave0, G = G0, bx = bx0; asm volatile("" : "+s"(G), "+s"(bx), "+s"(wave)); const int lane = (int)__builtin_amdgcn_mbcnt_hi(~0u, __builtin_amdgcn_mbcnt_lo(~0u, 0u)); const int tid = wave * 64 + lane; const int vcu = (bx % 8) * (G / 8) + bx / 8; const int gw = vcu * 8 + wave, NGW = G * 8; (void)lane; (void)gw; (void)NGW; (void)vcu;
            unsigned char* ws = (unsigned char*)LDP(22); float* out = (float*)LDP(21); const float* x_in = (const float*)ARGIN(0); (void)out; (void)x_in; (void)ws;
            DenseOrder S{NTOK / 256, INP / 256, (NTOK / 256) * (INP / 256), G, bx, (const char*)P_XN, (const char*)P_WIN, (size_t)256 * DM * 2, (size_t)256 * DM * 2};
            EpiWin E{P_LAT, P_FQKV, P_KPE, P_FLOG, P_SSQ, P_COS, P_SIN};
            pg8::gemm_phase<EpiWin, DenseOrder, true, false>(tid, lds, DM, DM, DM, S, E, nullptr);
        }
        SEAM(P + 1);
        if (IN(P + 2)) {
            unsigned ldsb_ = (unsigned)(uintptr_t)lds0; asm volatile("" : "+s"(ldsb_)); LAS unsigned char* lds = (LAS unsigned char*)(uintptr_t)ldsb_; volatile LAS unsigned* MISC = (volatile LAS unsigned*)(lds + MISC_OFF); volatile LAS unsigned long long* ARGP = (volatile LAS unsigned long long*)(lds + MISC_OFF + 768); (void)MISC; int wave = wave0, G = G0, bx = bx0; asm volatile("" : "+s"(G), "+s"(bx), "+s"(wave)); const int lane = (int)__builtin_amdgcn_mbcnt_hi(~0u, __builtin_amdgcn_mbcnt_lo(~0u, 0u)); const int tid = wave * 64 + lane; const int vcu = (bx % 8) * (G / 8) + bx / 8; const int gw = vcu * 8 + wave, NGW = G * 8; (void)lane; (void)gw; (void)NGW; (void)vcu;
            unsigned char* ws = (unsigned char*)LDP(22); float* out = (float*)LDP(21); const float* x_in = (const float*)ARGIN(0); (void)out; (void)x_in; (void)ws;
            if (vcu < 128 && wave == 0) {
                const int b = vcu >> 3, h = vcu & 7; const float bf = ((const float*)ARGIN(4))[l * 8 + h];
                const float* fl = P_FLOG + ((size_t)b * SEQ + 32 * lane) * 8 + h;
                double run = 0.0;
                for (int i = 0; i < 32; ++i) { const float f = fl[i * 8] + bf; const float lf = fminf(f, 0.f) - log1pf(expf(-fabsf(f))); run += (double)lf; }
                double tot = run;
#pragma unroll
                for (int o = 1; o < 64; o <<= 1) { const double t = __shfl_up(tot, o); if (lane >= o) tot += t; }
                double c = tot - run;
                float* bo = P_BIAS + ((size_t)b * 8 + h) * SEQ + 32 * lane;
                for (int i = 0; i < 32; ++i) { const float f = fl[i * 8] + bf; const float lf = fminf(f, 0.f) - log1pf(expf(-fabsf(f))); c += (double)lf; bo[i] = (float)(-c * 1.4426950408889634); }
            }
            UpOrder S{G, vcu, (const char*)P_LAT, (const char*)P_WUQ, (const char*)P_WUKV};
            EpiUp E{P_QM, P_KVM, P_SSQ, P_COS, P_SIN};
            pg8::gemm_phase<EpiUp, UpOrder, true, false>(tid, lds, 256, 512, 256, S, E, nullptr);
        }
        SEAM(P + 2);
        if (IN(P + 3)) {
            unsigned ldsb_ = (unsigned)(uintptr_t)lds0; asm volatile("" : "+s"(ldsb_)); LAS unsigned char* lds = (LAS unsigned char*)(uintptr_t)ldsb_; volatile LAS unsigned* MISC = (volatile LAS unsigned*)(lds + MISC_OFF); volatile LAS unsigned long long* ARGP = (volatile LAS unsigned long long*)(lds + MISC_OFF + 768); (void)MISC; int wave = wave0, G = G0, bx = bx0; asm volatile("" : "+s"(G), "+s"(bx), "+s"(wave)); const int lane = (int)__builtin_amdgcn_mbcnt_hi(~0u, __builtin_amdgcn_mbcnt_lo(~0u, 0u)); const int tid = wave * 64 + lane; const int vcu = (bx % 8) * (G / 8) + bx / 8; const int gw = vcu * 8 + wave, NGW = G * 8; (void)lane; (void)gw; (void)NGW; (void)vcu;
            unsigned char* ws = (unsigned char*)LDP(22); float* out = (float*)LDP(21); const float* x_in = (const float*)ARGIN(0); (void)out; (void)x_in; (void)ws;
            bf16* O = P_XN;
            const int b = vcu >> 4, hh = (vcu & 15) >> 1, sub = vcu & 1;
            const att::Tens TM{P_QM, 768, P_KVM, 1024, P_KPE, P_KVM + 64, 1024, nullptr, O};
            const att::Tens TF{P_FQKV, 512, P_FQKV + (size_t)NTOK * 512, 512, nullptr, P_FQKV + (size_t)2 * NTOK * 512, 512, P_BIAS, O};
            for (int i = 0; i < 4; ++i) { const int s = 2 * sub + (i >> 1); const int qb = (i & 1) ? 7 - s : s; att::attn_unit<1>(tid, b, hh, qb, TM, (LAS char*)lds); }
            for (int i = 0; i < 4; ++i) { const int s = 2 * sub + (i >> 1); const int qb = (i & 1) ? 7 - s : s; att::attn_unit<0>(tid, b, hh, qb, TF, (LAS char*)lds); }
        }
        SEAM(P + 3);
        if (IN(P + 4)) {
            unsigned ldsb_ = (unsigned)(uintptr_t)lds0; asm volatile("" : "+s"(ldsb_)); LAS unsigned char* lds = (LAS unsigned char*)(uintptr_t)ldsb_; volatile LAS unsigned* MISC = (volatile LAS unsigned*)(lds + MISC_OFF); volatile LAS unsigned long long* ARGP = (volatile LAS unsigned long long*)(lds + MISC_OFF + 768); (void)MISC; int wave = wave0, G = G0, bx = bx0; asm volatile("" : "+s"(G), "+s"(bx), "+s"(wave)); const int lane = (int)__builtin_amdgcn_mbcnt_hi(~0u, __builtin_amdgcn_mbcnt_lo(~0u, 0u)); const int tid = wave * 64 + lane; const int vcu = (bx % 8) * (G / 8) + bx / 8; const int gw = vcu * 8 + wave, NGW = G * 8; (void)lane; (void)gw; (void)NGW; (void)vcu;
            unsigned char* ws = (unsigned char*)LDP(22); float* out = (float*)LDP(21); const float* x_in = (const float*)ARGIN(0); (void)out; (void)x_in; (void)ws;
            bf16* O = P_XN;
            for (int m = gw; m < NTOK; m += NGW) {
                bf16* orow = O + (size_t)m * DM;
                const u32x4 a = *(const u32x4*)(orow + 8 * lane), c = *(const u32x4*)(orow + 512 + 8 * lane);
                float fa[8], fc[8];
#pragma unroll
                for (int j = 0; j < 4; ++j) { fa[2 * j] = __uint_as_float(a[j] << 16); fa[2 * j + 1] = __uint_as_float(a[j] & 0xffff0000u); fc[2 * j] = __uint_as_float(c[j] << 16); fc[2 * j + 1] = __uint_as_float(c[j] & 0xffff0000u); }
                float sa = 0.f, sc = 0.f;
#pragma unroll
                for (int j = 0; j < 8; ++j) { sa += fa[j] * fa[j]; sc += fc[j] * fc[j]; }
                const float ra = rsqrtf(wave_sum(sa) * (1.f / 512.f) + EPS), rc = rsqrtf(wave_sum(sc) * (1.f / 512.f) + EPS);
                u32x4 oa, oc;
#pragma unroll
                for (int j = 0; j < 4; ++j) { oa[j] = cvt_pk_bf16(fa[2 * j] * ra, fa[2 * j + 1] * ra); oc[j] = cvt_pk_bf16(fc[2 * j] * rc, fc[2 * j + 1] * rc); }
                *(u32x4*)(orow + 8 * lane) = oa; *(u32x4*)(orow + 512 + 8 * lane) = oc;
            }
        }
        SEAM(P + 4);
        if (IN(P + 5)) {
            unsigned ldsb_ = (unsigned)(uintptr_t)lds0; asm volatile("" : "+s"(ldsb_)); LAS unsigned char* lds = (LAS unsigned char*)(uintptr_t)ldsb_; volatile LAS unsigned* MISC = (volatile LAS unsigned*)(lds + MISC_OFF); volatile LAS unsigned long long* ARGP = (volatile LAS unsigned long long*)(lds + MISC_OFF + 768); (void)MISC; int wave = wave0, G = G0, bx = bx0; asm volatile("" : "+s"(G), "+s"(bx), "+s"(wave)); const int lane = (int)__builtin_amdgcn_mbcnt_hi(~0u, __builtin_amdgcn_mbcnt_lo(~0u, 0u)); const int tid = wave * 64 + lane; const int vcu = (bx % 8) * (G / 8) + bx / 8; const int gw = vcu * 8 + wave, NGW = G * 8; (void)lane; (void)gw; (void)NGW; (void)vcu;
            unsigned char* ws = (unsigned char*)LDP(22); float* out = (float*)LDP(21); const float* x_in = (const float*)ARGIN(0); (void)out; (void)x_in; (void)ws;
            DenseOrder S{NTOK / 256, DM / 256, (NTOK / 256) * (DM / 256), G, bx, (const char*)P_XN, (const char*)P_WOUT, (size_t)256 * DM * 2, (size_t)256 * DM * 2};
            EpiOut E{l == 0 ? x_in : out, out};
            pg8::gemm_phase<EpiOut, DenseOrder, true, false>(tid, lds, DM, DM, DM, S, E, nullptr);
        }
        SEAM(P + 5);
        if (IN(P + 6)) {
            unsigned ldsb_ = (unsigned)(uintptr_t)lds0; asm volatile("" : "+s"(ldsb_)); LAS unsigned char* lds = (LAS unsigned char*)(uintptr_t)ldsb_; volatile LAS unsigned* MISC = (volatile LAS unsigned*)(lds + MISC_OFF); volatile LAS unsigned long long* ARGP = (volatile LAS unsigned long long*)(lds + MISC_OFF + 768); (void)MISC; int wave = wave0, G = G0, bx = bx0; asm volatile("" : "+s"(G), "+s"(bx), "+s"(wave)); const int lane = (int)__builtin_amdgcn_mbcnt_hi(~0u, __builtin_amdgcn_mbcnt_lo(~0u, 0u)); const int tid = wave * 64 + lane; const int vcu = (bx % 8) * (G / 8) + bx / 8; const int gw = vcu * 8 + wave, NGW = G * 8; (void)lane; (void)gw; (void)NGW; (void)vcu;
            unsigned char* ws = (unsigned char*)LDP(22); float* out = (float*)LDP(21); const float* x_in = (const float*)ARGIN(0); (void)out; (void)x_in; (void)ws;
            bf16* H2 = P_XN;
            LAS float* WR = (LAS float*)lds;
            const float* ffn_norm = (const float*)ARGIN(12) + (size_t)l * DM; const float* w_rg = (const float*)ARGIN(13) + (size_t)l * DM * 4; const float* b_rg = (const float*)ARGIN(14) + l * 4;
            const float* w_re = (const float*)ARGIN(15) + (size_t)l * DM * 32; const float* b_re = (const float*)ARGIN(16) + l * 32;
            for (int idx = tid; idx < DM * 36; idx += 512) { const int k = idx / 36, e = idx % 36; WR[idx] = ffn_norm[k] * (e < 4 ? w_rg[k * 4 + e] : w_re[k * 32 + (e - 4)]); }
            if (tid < 32) MISC[64 + tid] = 0u;
            __syncthreads();
            for (int i = 0; i < 16; ++i) {
                const int m = vcu * 128 + wave * 16 + i; const float* xr = out + (size_t)m * DM;
                float xv[16]; float s = 0.f;
#pragma unroll
                for (int jj = 0; jj < 16; ++jj) { xv[jj] = xr[lane + 64 * jj]; s += xv[jj] * xv[jj]; }
                const float rstd = rsqrtf(wave_sum(s) * (1.f / DM) + EPS);
                float acc[36];
#pragma unroll
                for (int e = 0; e < 36; ++e) acc[e] = 0.f;
#pragma unroll
                for (int jj = 0; jj < 16; ++jj) { const float xs = xv[jj] * rstd; H2[(size_t)m * DM + lane + 64 * jj] = (bf16)(cvt_pk_bf16(xs, 0.f) & 0xffffu);
                    const LAS float* wrow = WR + (lane + 64 * jj) * 36;
#pragma unroll
                    for (int e4 = 0; e4 < 9; ++e4) { const f32x4 w = *(const LAS f32x4*)(wrow + 4 * e4);
#pragma unroll
                        for (int q = 0; q < 4; ++q) acc[4 * e4 + q] += xs * w[q]; } }
#pragma unroll
                for (int e = 0; e < 36; ++e) acc[e] = wave_sum(acc[e]);
                float gl[4];
#pragma unroll
                for (int g = 0; g < 4; ++g) gl[g] = acc[g] + b_rg[g];
                int gi = 0; float gm = gl[0];
#pragma unroll
                for (int g = 1; g < 4; ++g) if (gl[g] > gm) { gm = gl[g]; gi = g; }
                float gs = 0.f;
#pragma unroll
                for (int g = 0; g < 4; ++g) gs += __expf(gl[g] - gm);
                const float gval = 1.f / gs;
                float el[8];
#pragma unroll
                for (int j = 0; j < 8; ++j) { float v = acc[4 + j] + b_re[j];
#pragma unroll
                    for (int g = 1; g < 4; ++g) { const float vg = acc[4 + 8 * g + j] + b_re[8 * g + j]; v = (gi == g) ? vg : v; }
                    el[j] = v; }
                int i0 = 0; float m0 = el[0];
#pragma unroll
                for (int j = 1; j < 8; ++j) if (el[j] > m0) { m0 = el[j]; i0 = j; }
                int i1 = -1; float m1 = -INFINITY;
#pragma unroll
                for (int j = 0; j < 8; ++j) if (j != i0 && el[j] > m1) { m1 = el[j]; i1 = j; }
                const float e1 = __expf(m1 - m0); const float g0 = gval / (1.f + e1), g1 = gval * e1 / (1.f + e1);
                if (lane == 0) { const int ea = gi * 8 + i0, eb = gi * 8 + i1; P_E01[2 * m] = ea; P_E01[2 * m + 1] = eb; P_G01[2 * m] = g0; P_G01[2 * m + 1] = g1;
                    atomicAdd((unsigned*)&MISC[64 + ea], 1u); atomicAdd((unsigned*)&MISC[64 + eb], 1u); }
            }
            __syncthreads();
            if (tid < 32) P_CNT[vcu * 32 + tid] = (int)MISC[64 + tid];
        }
        SEAM(P + 6);
        if (IN(P + 7)) {
            unsigned ldsb_ = (unsigned)(uintptr_t)lds0; asm volatile("" : "+s"(ldsb_)); LAS unsigned char* lds = (LAS unsigned char*)(uintptr_t)ldsb_; volatile LAS unsigned* MISC = (volatile LAS unsigned*)(lds + MISC_OFF); volatile LAS unsigned long long* ARGP = (volatile LAS unsigned long long*)(lds + MISC_OFF + 768); (void)MISC; int wave = wave0, G = G0, bx = bx0; asm volatile("" : "+s"(G), "+s"(bx), "+s"(wave)); const int lane = (int)__builtin_amdgcn_mbcnt_hi(~0u, __builtin_amdgcn_mbcnt_lo(~0u, 0u)); const int tid = wave * 64 + lane; const int vcu = (bx % 8) * (G / 8) + bx / 8; const int gw = vcu * 8 + wave, NGW = G * 8; (void)lane; (void)gw; (void)NGW; (void)vcu;
            unsigned char* ws = (unsigned char*)LDP(22); float* out = (float*)LDP(21); const float* x_in = (const float*)ARGIN(0); (void)out; (void)x_in; (void)ws;
            LAS int* cnt_all = (LAS int*)lds;
            LAS int* pre_e = (LAS int*)(lds + 32768);
            LAS int* tot_e = pre_e + 32;
            LAS int* pst = pre_e + 64;
            LAS int* eL = pre_e + 128;
            for (int i = tid; i < 256 * 32; i += 512) cnt_all[i] = P_CNT[i];
            if (tid < 256) eL[tid] = P_E01[vcu * 256 + tid];
            __syncthreads();
            if (tid < 32) { int pre = 0, tot = 0; for (int w = 0; w < 256; ++w) { const int c = cnt_all[w * 32 + tid]; pre += (w < vcu) ? c : 0; tot += c; } pre_e[tid] = pre; tot_e[tid] = tot; }
            __syncthreads();
            if (tid == 0) { int acc = 0; for (int e = 0; e < 32; ++e) { pst[e] = acc; acc += (tot_e[e] + 255) / 256 * 256; } pst[32] = acc; }
            __syncthreads();
            if (vcu == 0 && tid <= 32) P_TSTART[tid] = pst[tid] / 256;
            if (tid < 256) { const int e = eL[tid]; int r = 0; for (int a = 0; a < tid; ++a) r += (eL[a] == e) ? 1 : 0;
                const int slot = pst[e] + pre_e[e] + r; const int tok = vcu * 128 + (tid >> 1);
                P_SLOT[vcu * 256 + tid] = slot; P_TOKOF[slot] = tok; P_GATEOF[slot] = P_G01[vcu * 256 + tid]; }
            if (vcu < 32) { const int e = vcu; for (int s = pst[e] + tot_e[e] + tid; s < pst[e + 1]; s += 512) { P_TOKOF[s] = 0; P_GATEOF[s] = 0.f; } }
            __syncthreads();
        }
        SEAM(P + 7);
        if (IN(P + 8)) {
            unsigned ldsb_ = (unsigned)(uintptr_t)lds0; asm volatile("" : "+s"(ldsb_)); LAS unsigned char* lds = (LAS unsigned char*)(uintptr_t)ldsb_; volatile LAS unsigned* MISC = (volatile LAS unsigned*)(lds + MISC_OFF); volatile LAS unsigned long long* ARGP = (volatile LAS unsigned long long*)(lds + MISC_OFF + 768); (void)MISC; int wave = wave0, G = G0, bx = bx0; asm volatile("" : "+s"(G), "+s"(bx), "+s"(wave)); const int lane = (int)__builtin_amdgcn_mbcnt_hi(~0u, __builtin_amdgcn_mbcnt_lo(~0u, 0u)); const int tid = wave * 64 + lane; const int vcu = (bx % 8) * (G / 8) + bx / 8; const int gw = vcu * 8 + wave, NGW = G * 8; (void)lane; (void)gw; (void)NGW; (void)vcu;
            unsigned char* ws = (unsigned char*)LDP(22); float* out = (float*)LDP(21); const float* x_in = (const float*)ARGIN(0); (void)out; (void)x_in; (void)ws;
            volatile LAS int* TS = (volatile LAS int*)(MISC + 128);
            if (tid <= 32) TS[tid] = P_TSTART[tid];
            __syncthreads();
            MoeOrder S{G, vcu, TS, (const char*)P_XN, (const char*)P_WGU, 0, (size_t)1024 * 1024 * 2, (size_t)256 * 1024 * 2};
            EpiGU E{P_HH};
            pg8::gemm_phase<EpiGU, MoeOrder, true, true>(tid, lds, DM, DM, DM, S, E, P_TOKOF);
        }
        SEAM(P + 8);
        if (IN(P + 9)) {
            unsigned ldsb_ = (unsigned)(uintptr_t)lds0; asm volatile("" : "+s"(ldsb_)); LAS unsigned char* lds = (LAS unsigned char*)(uintptr_t)ldsb_; volatile LAS unsigned* MISC = (volatile LAS unsigned*)(lds + MISC_OFF); volatile LAS unsigned long long* ARGP = (volatile LAS unsigned long long*)(lds + MISC_OFF + 768); (void)MISC; int wave = wave0, G = G0, bx = bx0; asm volatile("" : "+s"(G), "+s"(bx), "+s"(wave)); const int lane = (int)__builtin_amdgcn_mbcnt_hi(~0u, __builtin_amdgcn_mbcnt_lo(~0u, 0u)); const int tid = wave * 64 + lane; const int vcu = (bx % 8) * (G / 8) + bx / 8; const int gw = vcu * 8 + wave, NGW = G * 8; (void)lane; (void)gw; (void)NGW; (void)vcu;
            unsigned char* ws = (unsigned char*)LDP(22); float* out = (float*)LDP(21); const float* x_in = (const float*)ARGIN(0); (void)out; (void)x_in; (void)ws;
            volatile LAS int* TS = (volatile LAS int*)(MISC + 128);
            if (tid <= 32) TS[tid] = P_TSTART[tid];
            __syncthreads();
            MoeOrder S{G, vcu, TS, (const char*)P_HH, (const char*)P_WD, (size_t)256 * 512 * 2, (size_t)1024 * 512 * 2, (size_t)256 * 512 * 2};
            EpiDown E{P_Y, P_GATEOF};
            pg8::gemm_phase<EpiDown, MoeOrder, true, false>(tid, lds, DEXP, DEXP, DEXP, S, E, nullptr);
        }
        SEAM(P + 9);
}

__global__ void __launch_bounds__(512, 2) fwd(Args args) {
    extern __shared__ __attribute__((aligned(16))) unsigned char lds_raw[];
    LAS unsigned char* lds0 = (LAS unsigned char*)lds_raw;
    const int tid0 = threadIdx.x; const int wave0 = __builtin_amdgcn_readfirstlane(tid0 >> 6);
    const int G0 = gridDim.x; const int bx0 = blockIdx.x;
    { volatile LAS unsigned* MISC = (volatile LAS unsigned*)(lds0 + MISC_OFF); const int tid = tid0;
    for (int u = tid; u < 256; u += 512) MISC[u] = 0u;
    __syncthreads();
    volatile LAS unsigned long long* ARGP = (volatile LAS unsigned long long*)(lds0 + MISC_OFF + 768);
    if (tid < 21) ARGP[tid] = (unsigned long long)args.in[tid];
    if (tid == 21) ARGP[21] = (unsigned long long)args.out;
    if (tid == 22) ARGP[22] = (unsigned long long)args.ws;
    __syncthreads(); }
#if MK_ONE_LAUNCH
    XcdBarrier bar = xcd_barrier_post((unsigned*)(args.ws + WS_CTL) + CW_BAR, (volatile LAS unsigned*)(lds0 + MISC_OFF) + 8);
#else
    XcdBarrier bar; bar.bar = nullptr; bar.x = 0; bar.st = nullptr;
#endif
    const int lo = args.ph_lo, hi_ = args.ph_hi;
    if (IN(0)) {
        const int* positions = (const int*)args.in[1]; float* COSp = (float*)(args.ws + WS_COS); float* SINp = (float*)(args.ws + WS_SIN);
        for (int i = bx0 * 512 + tid0; i < NTOK * 16; i += G0 * 512) { const int tk = i >> 4, fi = i & 15;
            const double inv = exp2(-(double)fi * (13.287712379549449 / 16.0)); const double ang = (double)positions[tk] * inv;
            COSp[i] = (float)cos(ang); SINp[i] = (float)sin(ang); }
    }
    layer_body<0>(lo, hi_, lds0, wave0, G0, bx0, bar);
    layer_body<1>(lo, hi_, lds0, wave0, G0, bx0, bar);
    layer_body<2>(lo, hi_, lds0, wave0, G0, bx0, bar);
}

extern "C" void kernel_launch(void* const* d_in, const int* in_sizes, int n_in, void* d_out, int out_size, void* d_ws, size_t ws_size, hipStream_t stream) {
    static int grid = 0;
    if (grid == 0) {
        if (n_in != 21 || out_size != NTOK * DM || ws_size < WS_END) { fprintf(stderr, "kernel_launch: unexpected shapes (n_in %d out %d ws %zu)\n", n_in, out_size, ws_size); grid = -1; return; }
        int dev = 0, cus = 0;
        if (hipGetDevice(&dev) != hipSuccess || hipDeviceGetAttribute(&cus, hipDeviceAttributeMultiprocessorCount, dev) != hipSuccess) { grid = -1; return; }
        if (hipFuncSetAttribute((const void*)fwd, hipFuncAttributeMaxDynamicSharedMemorySize, LDS_BYTES) != hipSuccess) { fprintf(stderr, "kernel_launch: hipFuncSetAttribute failed\n"); grid = -1; return; }
        int per_cu = 0;
        if (hipOccupancyMaxActiveBlocksPerMultiprocessor(&per_cu, (const void*)fwd, 512, LDS_BYTES) != hipSuccess || per_cu < 1) fprintf(stderr, "kernel_launch: occupancy query says %d\n", per_cu);
        (void)hipGetLastError();
        grid = cus;
        if (grid != 256) { fprintf(stderr, "kernel_launch: built for 256 CUs, got %d\n", grid); grid = -1; return; }
    }
    if (grid < 0) return;
    if (hipMemsetAsync((char*)d_ws + WS_CTL, 0, CTL_ZERO_BYTES, stream) != hipSuccess) return;
    Args a{};
    for (int i = 0; i < 21; ++i) a.in[i] = d_in[i];
    a.out = (float*)d_out; a.ws = (unsigned char*)d_ws;
#if MK_ONE_LAUNCH
    a.ph_lo = 0; a.ph_hi = 21;
    hipLaunchKernelGGL(fwd, dim3(grid), dim3(512), LDS_BYTES, stream, a);
#else
    for (int p = 0; p <= 20; ++p) { a.ph_lo = p; a.ph_hi = p + 1; hipLaunchKernelGGL(fwd, dim3(grid), dim3(512), LDS_BYTES, stream, a); }
#endif
}
```

```cpp
#include <hip/hip_runtime.h>
#include <cstdio>
#include <cstdint>

#ifndef PROBE_PHASE
#define PROBE_PHASE -1
#endif
#define NREP(k) ((PROBE_PHASE) == (k) ? 2 : 1)
#ifndef MK_ONE_LAUNCH
#define MK_ONE_LAUNCH 1
#endif

#define LAS __attribute__((address_space(3)))
#define GAS __attribute__((address_space(1)))
typedef unsigned short bf16;
typedef short bf16x8 __attribute__((ext_vector_type(8)));
typedef short s16x4 __attribute__((ext_vector_type(4)));
typedef float f32x4 __attribute__((ext_vector_type(4)));
typedef float f32x2 __attribute__((ext_vector_type(2)));
typedef float f32x16 __attribute__((ext_vector_type(16)));
typedef unsigned u32x4 __attribute__((ext_vector_type(4)));
typedef unsigned u32x2 __attribute__((ext_vector_type(2)));

constexpr int NB = 16, SEQ = 2048, DM = 1024, NTOK = NB * SEQ, NLAYER = 2;
constexpr int INW = 1960, INP = 2048;
constexpr int NEXP = 32, DEXP = 512;
constexpr int MAXSLOT = 73728;
constexpr float EPS = 1e-6f;
constexpr float LOG2E = 1.4426950408889634f;
constexpr float C2F = 0.125f * LOG2E;
constexpr float C2M = 0.10206207261596575f * LOG2E;

constexpr size_t MiB = 1u << 20, KiB = 1u << 10;
constexpr size_t WS_CTL = 0, CTL_ZERO_BYTES = 64 * KiB;
constexpr size_t WS_COS = 1 * MiB, WS_SIN = 3 * MiB;
constexpr size_t WS_SSQ = 5 * MiB;
constexpr size_t WS_FLOG = 6 * MiB;
constexpr size_t WS_E01 = 8 * MiB;
constexpr size_t WS_G01 = 8 * MiB + 256 * KiB;
constexpr size_t WS_SLOT = 8 * MiB + 512 * KiB;
constexpr size_t WS_TOKOF = 8 * MiB + 768 * KiB;
constexpr size_t WS_GATEOF = 9 * MiB + 256 * KiB;
constexpr size_t WS_CNT = 9 * MiB + 768 * KiB;
constexpr size_t WS_TSTART = 9 * MiB + 800 * KiB;
constexpr size_t WS_RSTD = 9 * MiB + 832 * KiB;
constexpr size_t WS_RSTDOF = 7 * MiB;
constexpr size_t WS_KPE = 10 * MiB;
constexpr size_t WS_KAUG = 10 * MiB + 2 * MiB;
constexpr size_t WS_WIN = 16 * MiB;
constexpr size_t WS_WUQ = 20 * MiB;
constexpr size_t WS_WUKV = 20 * MiB + 512 * KiB;
constexpr size_t WS_WOUT = 21 * MiB;
constexpr size_t WS_WGU = 24 * MiB;
constexpr size_t WS_WD = 88 * MiB;
constexpr size_t WS_XN = 120 * MiB;
constexpr size_t WS_FQKV = 184 * MiB;
constexpr size_t WS_LAT = 280 * MiB;
constexpr size_t WS_QM = 312 * MiB;
constexpr size_t WS_KVM = 360 * MiB;
constexpr size_t WS_Y = 280 * MiB;
constexpr size_t WS_END = 424 * MiB;
static_assert(WS_Y + (size_t)MAXSLOT * 1024 * 2 <= WS_END, "Y fits");
static_assert(WS_FQKV + (size_t)MAXSLOT * 512 * 2 <= WS_LAT, "HH fits");

constexpr int CW_BAR = 1024;

constexpr int RING_BYTES = 147456;
constexpr int MISC_OFF = RING_BYTES;
constexpr int LDS_BYTES = RING_BYTES + 1024;

__device__ __forceinline__ unsigned cvt_pk_bf16(float lo, float hi) { unsigned r; asm volatile("v_cvt_pk_bf16_f32 %0, %1, %2" : "=v"(r) : "v"(lo), "v"(hi)); return r; }
__device__ __forceinline__ float bf2f(unsigned short b) { return __uint_as_float((unsigned)b << 16); }
__device__ __forceinline__ float wave_sum(float v) {
#pragma unroll
    for (int o = 1; o < 64; o <<= 1) v += __shfl_xor(v, o);
    return v;
}
#define LDS_WAIT() asm volatile("s_waitcnt lgkmcnt(0)" ::: "memory")

#define XB_TMO      128
#define XB_XCNT(j)  (256  + 64 * (j))
#define XB_XSUB(j)  (1280 + 64 * (j))
#define XB_XGEN(j)  (2304 + 64 * (j))
#define XB_TOP      3328
#define XB_TOPGEN   3392
#define XCD_BAR_WORDS 3456
#define XB_SPIN_CAP (1u << 18)
__device__ __forceinline__ unsigned xb_ld(unsigned* p)              { return __hip_atomic_load(p, __ATOMIC_RELAXED, __HIP_MEMORY_SCOPE_AGENT); }
__device__ __forceinline__ unsigned xb_add(unsigned* p, unsigned v) { return __hip_atomic_fetch_add(p, v, __ATOMIC_RELAXED, __HIP_MEMORY_SCOPE_AGENT); }
__device__ __forceinline__ unsigned xb_xcc_id() { return (unsigned)__builtin_amdgcn_s_getreg((3 << 11) | 20) & 0xFu; }
#define XB_SPIN(cond, bar) do { unsigned _sp = 0; while (cond) { __builtin_amdgcn_s_sleep(1); \
    if ((++_sp & 255u) == 0u) { if (xb_ld(&(bar)[XB_TMO])) break; if (_sp > XB_SPIN_CAP) { atomicAdd(&(bar)[XB_TMO], 1u); break; } } } } while (0)
struct XcdBarrier { unsigned* bar; unsigned x; volatile LAS unsigned* st; };
__device__ __forceinline__ XcdBarrier xcd_barrier_post(unsigned* bar, volatile LAS unsigned* st) {
    XcdBarrier b; b.bar = bar; b.x = xb_xcc_id(); b.st = st;
    if (threadIdx.x == 0) (void)xb_add(&bar[XB_XCNT(b.x)], 1u);
    return b;
}
__device__ __forceinline__ void xcd_barrier_complete(unsigned* bar, unsigned x, unsigned& nloc, unsigned& nx) {
    const unsigned G = gridDim.x * gridDim.y * gridDim.z;
    unsigned sum, cnt, mine, sp = 0u;
    for (;;) {
        sum = 0u; cnt = 0u; mine = 0u;
#pragma unroll
        for (unsigned j = 0; j < 16; ++j) { const unsigned c = xb_ld(&bar[XB_XCNT(j)]); sum += c; cnt += (c > 0u) ? 1u : 0u; mine = (j == x) ? c : mine; }
        if (sum == G) break;
        __builtin_amdgcn_s_sleep(1);
        if ((++sp & 255u) == 0u) { if (xb_ld(&bar[XB_TMO])) break; if (sp > XB_SPIN_CAP) { atomicAdd(&bar[XB_TMO], 1u); break; } }
    }
    nloc = mine > 0u ? mine : 1u; nx = cnt > 0u ? cnt : 1u;
}
__device__ __forceinline__ void xcd_barrier(const XcdBarrier& b) {
    asm volatile("s_waitcnt vmcnt(0)" ::: "memory");
    __syncthreads();
    if (threadIdx.x == 0) {
        unsigned* bar = b.bar;
        __builtin_amdgcn_s_waitcnt(0);
        unsigned nloc = b.st[0], nx = b.st[1];
        if (nloc == 0u) { xcd_barrier_complete(bar, b.x, nloc, nx); b.st[0] = nloc; b.st[1] = nx; }
        const unsigned old = xb_add(&bar[XB_XSUB(b.x)], 1u);
        const unsigned gen = old / nloc;
        if (old + 1u == (gen + 1u) * nloc) {
            __builtin_amdgcn_fence(__ATOMIC_RELEASE, "agent");
            asm volatile("s_waitcnt vmcnt(0)" ::: "memory");
            const unsigned og = xb_add(&bar[XB_TOP], 1u);
            const unsigned tg = og / nx;
            if (og + 1u == (tg + 1u) * nx) xb_add(&bar[XB_TOPGEN], 1u);
            else XB_SPIN(xb_ld(&bar[XB_TOPGEN]) == tg, bar);
            __builtin_amdgcn_fence(__ATOMIC_ACQUIRE, "agent");
            xb_add(&bar[XB_XGEN(b.x)], 1u);
            asm volatile("s_waitcnt vmcnt(0)" ::: "memory");
        } else {
            XB_SPIN(xb_ld(&bar[XB_XGEN(b.x)]) == gen, bar);
            __builtin_amdgcn_fence(__ATOMIC_ACQUIRE, "agent");
            asm volatile("s_waitcnt vmcnt(0)" ::: "memory");
        }
    }
    __syncthreads();
}

namespace pg8 {
constexpr int BM = 256, BK = 64, HALF = 128, HTB = HALF * BK * 2, STAGE_BYTES = 8 * HTB;
__host__ __device__ __forceinline__ int lds_byte(int r, int c) { const int st = (r >> 4) * 2 + (c >> 5), rr = r & 15, cc = c & 31, ob = rr * 64 + cc * 2; return st * 1024 + (ob ^ (((ob >> 9) & 1) << 5)); }
__host__ __device__ __forceinline__ void stage_rc(int b, int& R, int& C) { const int st = b / 1024, sb = b % 1024, swz = sb ^ (((sb >> 9) & 1) << 5); R = (st >> 1) * 16 + swz / 64; C = (st & 1) * 32 + (swz % 64) / 2; }
__host__ __device__ __forceinline__ int perm32(int rho) { const int n = rho >> 4, i = rho & 15; return 8 * (i >> 2) + 4 * n + (i & 3); }

struct Unit { const GAS char* a; const GAS char* b; int pm, pn, e; };

template <class Epi, class Sched, bool ALIGN_EPI, bool GATHER>
__device__ __forceinline__ void gemm_phase(const int tid, LAS unsigned char* lds, const int K, const int lda, const int ldb, const Sched& S, const Epi& E, const GAS int* __restrict__ tokof) {
    const int wid = __builtin_amdgcn_readfirstlane(tid >> 6), lane = tid & 63, wr = wid >> 2, wc = wid & 3, fr = lane & 15, fq = lane >> 4;
    const int nt = K / BK;
    unsigned voffA[2], voffB[2]; int RA[2], CA2[2];
#pragma unroll
    for (int i = 0; i < 2; ++i) { int R, C; stage_rc(tid * 16 + i * 8192, R, C); const int Rb = Epi::PERM ? ((R & ~31) + perm32(R & 31)) : R;
        voffA[i] = (unsigned)(R * lda + C) * 2u; voffB[i] = (unsigned)(Rb * ldb + C) * 2u; RA[i] = R; CA2[i] = C * 2; }
    const size_t kstep = (size_t)(BK * 2);
    const size_t hstepA = GATHER ? 0 : (size_t)HALF * lda * 2;
    const size_t hstepB = (size_t)HALF * ldb * 2;
    const unsigned ldsw = (unsigned)wid * 1024u;
    const int aoff = lds_byte(wr * 64 + fr, fq * 8), boff = lds_byte(wc * 32 + fr, fq * 8);
    unsigned gcur[2][2], gnxt[2][2];
#define PG8_SA(b, h) (((b) * 2 + (h)) * HTB)
#define PG8_SB(b, h) ((4 + (b) * 2 + (h)) * HTB)
#define PG8_STAGE(bufoff, gbase, voff) do { _Pragma("unroll") for (int _i = 0; _i < 2; ++_i) \
        __builtin_amdgcn_global_load_lds((const GAS unsigned*)((const GAS char*)(gbase) + (voff)[_i]), (LAS unsigned*)(lds + (bufoff) + ldsw + _i * 8192), 16, 0, 0); } while (0)
#define PG8_STAGE_A(bufoff, base, h, nx) do { if constexpr (GATHER) { unsigned _v[2]; _v[0] = (nx) ? gnxt[h][0] : gcur[h][0]; _v[1] = (nx) ? gnxt[h][1] : gcur[h][1]; PG8_STAGE(bufoff, base, _v); } \
        else { PG8_STAGE(bufoff, (base) + (h) * hstepA, voffA); } } while (0)
#define PG8_LDA(dst, b, h) do { _Pragma("unroll") for (int m = 0; m < 4; ++m) _Pragma("unroll") for (int k = 0; k < 2; ++k) dst[m][k] = *(const LAS bf16x8*)(lds + PG8_SA(b, h) + aoff + m * 2048 + k * 1024); } while (0)
#define PG8_LDB(dst, b, h) do { _Pragma("unroll") for (int n = 0; n < 2; ++n) _Pragma("unroll") for (int k = 0; k < 2; ++k) dst[n][k] = *(const LAS bf16x8*)(lds + PG8_SB(b, h) + boff + n * 2048 + k * 1024); } while (0)
#define PG8_MMA(ai, bj, At, Bt) do { __builtin_amdgcn_s_setprio(1); _Pragma("unroll") for (int m = 0; m < 4; ++m) _Pragma("unroll") for (int n = 0; n < 2; ++n) _Pragma("unroll") for (int k = 0; k < 2; ++k) \
        acc[ai][bj][m][n] = __builtin_amdgcn_mfma_f32_16x16x32_bf16(Bt[n][k], At[m][k], acc[ai][bj][m][n], 0, 0, 0); __builtin_amdgcn_s_setprio(0); } while (0)
#define PG8_WAIT_V(n) asm volatile("s_waitcnt vmcnt(" #n ")" ::: "memory")
#define PG8_WAIT_L(n) asm volatile("s_waitcnt lgkmcnt(" #n ")" ::: "memory")
#define PG8_BAR __builtin_amdgcn_s_barrier()
#define PG8_SCHED __builtin_amdgcn_sched_barrier(0)
#define PG8_GLOAD(dst, u) do { if constexpr (GATHER) { _Pragma("unroll") for (int _h = 0; _h < 2; ++_h) _Pragma("unroll") for (int _i = 0; _i < 2; ++_i) \
        dst[_h][_i] = (unsigned)tokof[(u).pm * BM + _h * HALF + RA[_i]] * (unsigned)(lda * 2) + (unsigned)CA2[_i]; } } while (0)
    Unit cur, nxt; int ui = 0;
    if (!S.next(0, cur)) return;
    PG8_GLOAD(gcur, cur);
    f32x4 acc[2][2][4][2];
#pragma unroll
    for (int a = 0; a < 2; ++a)
#pragma unroll
        for (int b = 0; b < 2; ++b)
#pragma unroll
            for (int m = 0; m < 4; ++m)
#pragma unroll
                for (int n = 0; n < 2; ++n) acc[a][b][m][n] = (f32x4){0.f, 0.f, 0.f, 0.f};
    bf16x8 At[4][2], B0[2][2], B1[2][2];
    const GAS char* cA = cur.a; const GAS char* cB = cur.b;
    PG8_STAGE(PG8_SB(0, 0), cB, voffB); PG8_STAGE(PG8_SB(0, 1), cB + hstepB, voffB); PG8_STAGE_A(PG8_SA(0, 0), cA, 0, false); PG8_STAGE_A(PG8_SA(0, 1), cA, 1, false);
    if (wr == 1) PG8_BAR;
    PG8_WAIT_V(2); PG8_BAR;
    PG8_STAGE(PG8_SB(1, 0), cB + kstep, voffB); PG8_STAGE_A(PG8_SA(1, 0), cA + kstep, 0, false); PG8_STAGE(PG8_SB(1, 1), cB + hstepB + kstep, voffB);
    PG8_WAIT_V(6); PG8_BAR;
    for (;;) {
        const bool has_next = S.next(ui + 1, nxt);
        if constexpr (GATHER) { if (has_next) { PG8_GLOAD(gnxt, nxt); } else { _Pragma("unroll") for (int _h = 0; _h < 2; ++_h) _Pragma("unroll") for (int _i = 0; _i < 2; ++_i) gnxt[_h][_i] = gcur[_h][_i]; } }
        const GAS char* nA = has_next ? nxt.a : cA; const GAS char* nB = has_next ? nxt.b : cB;
        for (int t = 0; t < nt; t += 2) {
            const bool last = (t == nt - 2);
            const GAS char* a1 = cA + (size_t)(t + 1) * kstep;
            const GAS char* a2 = last ? nA : cA + (size_t)(t + 2) * kstep; const GAS char* b2 = last ? nB : cB + (size_t)(t + 2) * kstep;
            const GAS char* a3 = a2 + kstep; const GAS char* b3 = b2 + kstep;
            PG8_LDB(B0, 0, 0); PG8_LDB(B1, 0, 1); PG8_SCHED; PG8_LDA(At, 0, 0); PG8_STAGE_A(PG8_SA(1, 1), a1, 1, false);
            PG8_WAIT_V(8); PG8_WAIT_L(0); PG8_BAR; PG8_MMA(0, 0, At, B0); PG8_MMA(0, 1, At, B1); PG8_BAR; PG8_SCHED;
            PG8_LDA(At, 0, 1); PG8_STAGE(PG8_SB(0, 0), b2, voffB); PG8_STAGE(PG8_SB(0, 1), b2 + hstepB, voffB); PG8_STAGE_A(PG8_SA(0, 0), a2, 0, last);
            PG8_WAIT_V(8); PG8_WAIT_L(0); PG8_BAR; PG8_MMA(1, 0, At, B0); PG8_MMA(1, 1, At, B1); PG8_BAR; PG8_SCHED;
            PG8_LDB(B0, 1, 0); PG8_LDB(B1, 1, 1); PG8_SCHED; PG8_LDA(At, 1, 0); PG8_STAGE_A(PG8_SA(0, 1), a2, 1, last);
            PG8_WAIT_V(8); PG8_WAIT_L(0); PG8_BAR; PG8_MMA(0, 0, At, B0); PG8_MMA(0, 1, At, B1); PG8_BAR; PG8_SCHED;
            PG8_LDA(At, 1, 1); PG8_STAGE(PG8_SB(1, 0), b3, voffB); PG8_STAGE(PG8_SB(1, 1), b3 + hstepB, voffB); PG8_STAGE_A(PG8_SA(1, 0), a3, 0, last);
            PG8_WAIT_V(8); PG8_WAIT_L(0); PG8_BAR; PG8_MMA(1, 0, At, B0); PG8_MMA(1, 1, At, B1); PG8_BAR; PG8_SCHED;
        }
        if constexpr (ALIGN_EPI) { if (wr == 0) PG8_BAR; }
        E(acc, cur, wr, wc, fr, fq);
        if (!has_next) break;
#pragma unroll
        for (int a = 0; a < 2; ++a)
#pragma unroll
            for (int b = 0; b < 2; ++b)
#pragma unroll
                for (int m = 0; m < 4; ++m)
#pragma unroll
                    for (int n = 0; n < 2; ++n) acc[a][b][m][n] = (f32x4){0.f, 0.f, 0.f, 0.f};
        cur = nxt; cA = nA; cB = nB; ++ui;
        if constexpr (GATHER) { _Pragma("unroll") for (int _h = 0; _h < 2; ++_h) _Pragma("unroll") for (int _i = 0; _i < 2; ++_i) gcur[_h][_i] = gnxt[_h][_i]; }
        if constexpr (ALIGN_EPI) { if (wr == 1) PG8_BAR; }
    }
    PG8_WAIT_V(0);
    if constexpr (!ALIGN_EPI) { if (wr == 0) PG8_BAR; }
    PG8_BAR;
#undef PG8_SA
#undef PG8_SB
#undef PG8_STAGE
#undef PG8_STAGE_A
#undef PG8_LDA
#undef PG8_LDB
#undef PG8_MMA
#undef PG8_WAIT_V
#undef PG8_WAIT_L
#undef PG8_BAR
#undef PG8_SCHED
#undef PG8_GLOAD
}
}
using pg8::Unit;

struct DenseOrder {
    int nM, nN, nwg, G, c; const GAS char* A; const GAS char* B; size_t aT, bT;
    __device__ __forceinline__ bool next(int i, Unit& u) const {
        const long L = (long)i * G + c; if (L >= nwg) return false;
        int wgid = (int)L; { const int q = nwg / 8, r = nwg % 8, xcd = wgid % 8, off = wgid / 8; wgid = (xcd < r ? xcd * (q + 1) : r * (q + 1) + (xcd - r) * q) + off; }
        const int nig = 8 * nN, gid = wgid / nig, fm = gid * 8, gsz = (nM - fm) < 8 ? (nM - fm) : 8;
        u.pm = fm + ((wgid % nig) % gsz); u.pn = (wgid % nig) / gsz; u.e = 0;
        u.a = A + (size_t)u.pm * aT; u.b = B + (size_t)u.pn * bT; return true;
    }
};
struct UpOrder {
    int G, c; const GAS char* LATp; const GAS char* Wq; const GAS char* Wkv;
    __device__ __forceinline__ bool next(int i, Unit& u) const {
        const int L = i * G + c; if (L >= 128 * 7) return false;
        u.pm = L / 7; const int j = L % 7; const bool kv = j >= 3; u.pn = kv ? j - 3 : j; u.e = kv ? 1 : 0;
        u.a = LATp + (size_t)u.pm * 256 * 512 * 2 + (kv ? 512 : 0);
        u.b = (kv ? Wkv : Wq) + (size_t)u.pn * 256 * 256 * 2; return true;
    }
};
struct MoeOrder {
    int G, c; const volatile LAS int* TS; const GAS char* A; const GAS char* W; size_t aT  , wE  , wT  ;
    __device__ __forceinline__ bool next(int i, Unit& u) const {
        const int L = i * G + c; const int ntile = TS[32]; if (L >= ntile * 4) return false;
        const int rt = L >> 2, ct = L & 3; int e = 0;
        for (int j = 1; j < 32; ++j) e += (TS[j] <= rt) ? 1 : 0;
        u.pm = rt; u.pn = ct; u.e = e; u.a = A + (size_t)rt * aT; u.b = W + (size_t)e * wE + (size_t)ct * wT; return true;
    }
};

__device__ __forceinline__ u32x4 pack8(f32x4 v0, f32x4 v1) { u32x4 w; w.x = cvt_pk_bf16(v0[0], v0[1]); w.y = cvt_pk_bf16(v0[2], v0[3]); w.z = cvt_pk_bf16(v1[0], v1[1]); w.w = cvt_pk_bf16(v1[2], v1[3]); return w; }

struct EpiWin {
    static constexpr bool PERM = true;
    GAS bf16* LAT_; GAS bf16* FQKV_; GAS bf16* KPE_; GAS float* FLOG_; GAS float* SSQ_; const GAS float* COS_; const GAS float* SIN_;
    __device__ __forceinline__ void operator()(const f32x4 (&acc)[2][2][4][2], const Unit& u, int wr, int wc, int fr, int fq) const {
        GAS bf16* LAT = LAT_; GAS bf16* FQKV = FQKV_; GAS bf16* KPE = KPE_; GAS float* FLOG = FLOG_; GAS float* SSQ = SSQ_; const GAS float* COS = COS_; const GAS float* SIN = SIN_;
        asm volatile("" : "+s"(LAT), "+s"(FQKV), "+s"(KPE), "+s"(FLOG), "+s"(SSQ), "+s"(COS), "+s"(SIN));
        const int row0 = u.pm * 256 + wr * 64 + fr; const int pn = u.pn;
        if (pn >= 2) {
            const int ti = pn >> 1; GAS bf16* dst = FQKV + (size_t)(ti - 1) * NTOK * 512; const int colb = (pn & 1) * 256 + wc * 32 + 8 * fq; const float sc = (ti == 1) ? C2F : 1.f;
#pragma unroll
            for (int ai = 0; ai < 2; ++ai)
#pragma unroll
                for (int m = 0; m < 4; ++m) { GAS bf16* rowp = dst + (size_t)(row0 + ai * 128 + m * 16) * 512 + colb;
#pragma unroll
                    for (int bj = 0; bj < 2; ++bj) *(GAS u32x4*)(rowp + bj * 128) = pack8(acc[ai][bj][m][0] * sc, acc[ai][bj][m][1] * sc); }
        } else {
#pragma unroll
            for (int ai = 0; ai < 2; ++ai)
#pragma unroll
                for (int m = 0; m < 4; ++m) { const int row = row0 + ai * 128 + m * 16; GAS bf16* rowp = LAT + (size_t)row * 512 + pn * 256 + wc * 32 + 8 * fq;
#pragma unroll
                    for (int bj = 0; bj < 2; ++bj) *(GAS u32x4*)(rowp + bj * 128) = pack8(acc[ai][bj][m][0], acc[ai][bj][m][1]);
                    float s = 0.f;
#pragma unroll
                    for (int n = 0; n < 2; ++n) { const f32x4 x = acc[ai][0][m][n]; s += (x[0] * x[0] + x[1] * x[1]) + (x[2] * x[2] + x[3] * x[3]); }
                    if (pn == 0) {
#pragma unroll
                        for (int n = 0; n < 2; ++n) { const f32x4 x = acc[ai][1][m][n]; s += (x[0] * x[0] + x[1] * x[1]) + (x[2] * x[2] + x[3] * x[3]); }
                    }
                    s += __shfl_xor(s, 16); s += __shfl_xor(s, 32);
                    if (fq == 0) SSQ[(size_t)row * 8 + pn * 4 + wc] = s;
                    asm volatile("" ::: "memory"); }
            if (pn == 1 && wc == 0) {
#pragma unroll
                for (int ai = 0; ai < 2; ++ai)
#pragma unroll
                    for (int m = 0; m < 4; ++m) { const int row = row0 + ai * 128 + m * 16;
                        const f32x4 c = *(const GAS f32x4*)(COS + (size_t)row * 16 + 4 * fq), sn = *(const GAS f32x4*)(SIN + (size_t)row * 16 + 4 * fq);
                        const f32x4 x1 = acc[ai][1][m][0], x2 = acc[ai][1][m][1];
                        *(GAS u32x4*)(KPE + (size_t)row * 32 + 8 * fq) = pack8(x1 * c - x2 * sn, x1 * sn + x2 * c);
                        asm volatile("" ::: "memory"); }
            }
            if (pn == 1 && wc == 1 && fq == 0) {
#pragma unroll
                for (int ai = 0; ai < 2; ++ai)
#pragma unroll
                    for (int m = 0; m < 4; ++m) { const int row = row0 + ai * 128 + m * 16; *(GAS f32x4*)(FLOG + (size_t)row * 8) = acc[ai][1][m][0]; *(GAS f32x4*)(FLOG + (size_t)row * 8 + 4) = acc[ai][1][m][1]; }
            }
        }
    }
};
struct EpiUp {
    static constexpr bool PERM = true;
    GAS bf16* QM_; GAS bf16* KVM_; const GAS float* SSQ_; const GAS float* COS_; const GAS float* SIN_;
    __device__ __forceinline__ void operator()(const f32x4 (&acc)[2][2][4][2], const Unit& u, int wr, int wc, int fr, int fq) const {
        GAS bf16* QM = QM_; GAS bf16* KVM = KVM_; const GAS float* SSQ = SSQ_; const GAS float* COS = COS_; const GAS float* SIN = SIN_;
        asm volatile("" : "+s"(QM), "+s"(KVM), "+s"(SSQ), "+s"(COS), "+s"(SIN));
        const int row0 = u.pm * 256 + wr * 64 + fr; const int pn = u.pn; const bool kv = u.e != 0;
#pragma unroll
        for (int ai = 0; ai < 2; ++ai)
#pragma unroll
            for (int m = 0; m < 4; ++m) { const int row = row0 + ai * 128 + m * 16;
                const f32x4 sq = *(const GAS f32x4*)(SSQ + (size_t)row * 8 + (kv ? 4 : 0));
                const float ss = (sq[0] + sq[1]) + (sq[2] + sq[3]);
                if (kv) {
                    const float rs = rsqrtf(ss * (1.f / 128.f) + EPS);
                    GAS bf16* rowp = KVM + (size_t)row * 1024 + pn * 256 + wc * 32 + 8 * fq;
#pragma unroll
                    for (int bj = 0; bj < 2; ++bj) *(GAS u32x4*)(rowp + bj * 128) = pack8(acc[ai][bj][m][0] * rs, acc[ai][bj][m][1] * rs);
                } else {
                    const float rs = rsqrtf(ss * (1.f / 256.f) + EPS) * C2M;
                    GAS bf16* rowp = QM + (size_t)row * 768 + pn * 256 + wc * 32 + 8 * fq;
                    const f32x4 c = *(const GAS f32x4*)(COS + (size_t)row * 16 + 4 * fq), sn = *(const GAS f32x4*)(SIN + (size_t)row * 16 + 4 * fq);
#pragma unroll
                    for (int bj = 0; bj < 2; ++bj) { f32x4 v0 = acc[ai][bj][m][0] * rs, v1 = acc[ai][bj][m][1] * rs;
                        const int G = 8 * pn + 4 * bj + wc;
                        if (G % 3 == 2) { const f32x4 x1 = v0, x2 = v1; v0 = x1 * c - x2 * sn; v1 = x1 * sn + x2 * c; }
                        *(GAS u32x4*)(rowp + bj * 128) = pack8(v0, v1); }
                }
                asm volatile("" ::: "memory");
            }
    }
};
struct EpiOut {
    static constexpr bool PERM = false;
    const GAS float* resid_; GAS float* out_;
    __device__ __forceinline__ void operator()(const f32x4 (&acc)[2][2][4][2], const Unit& u, int wr, int wc, int fr, int fq) const {
        const GAS float* resid = resid_; GAS float* out = out_; asm volatile("" : "+s"(resid), "+s"(out));
        const int row0 = u.pm * 256 + wr * 64 + fr, col0 = u.pn * 256 + wc * 32 + 4 * fq;
#pragma unroll
        for (int ai = 0; ai < 2; ++ai)
#pragma unroll
            for (int m = 0; m < 4; ++m) { const size_t off = (size_t)(row0 + ai * 128 + m * 16) * DM + col0;
#pragma unroll
                for (int bj = 0; bj < 2; ++bj)
#pragma unroll
                    for (int n = 0; n < 2; ++n) { const f32x4 r = *(const GAS f32x4*)(resid + off + bj * 128 + n * 16); *(GAS f32x4*)(out + off + bj * 128 + n * 16) = r + acc[ai][bj][m][n]; } }
    }
};
struct EpiGU {
    static constexpr bool PERM = true;
    GAS bf16* HH_; const GAS float* RS_;
    __device__ __forceinline__ void operator()(const f32x4 (&acc)[2][2][4][2], const Unit& u, int wr, int wc, int fr, int fq) const {
        GAS bf16* HH = HH_; const GAS float* RS = RS_; asm volatile("" : "+s"(HH), "+s"(RS));
        const int row0 = u.pm * 256 + wr * 64 + fr;
#pragma unroll
        for (int ai = 0; ai < 2; ++ai)
#pragma unroll
            for (int m = 0; m < 4; ++m) { GAS bf16* rowp = HH + (size_t)(row0 + ai * 128 + m * 16) * 512 + u.pn * 128 + wc * 32 + 8 * fq; const float rs = RS[row0 + ai * 128 + m * 16];
                f32x4 h[2];
#pragma unroll
                for (int n = 0; n < 2; ++n) { const f32x4 g = acc[ai][0][m][n] * rs, up = acc[ai][1][m][n] * rs;
#pragma unroll
                    for (int j = 0; j < 4; ++j) { const float sg = __builtin_amdgcn_rcpf(1.f + __builtin_amdgcn_exp2f(-g[j] * LOG2E)); h[n][j] = g[j] * sg * up[j]; } }
                *(GAS u32x4*)rowp = pack8(h[0], h[1]); }
    }
};
struct EpiDown {
    static constexpr bool PERM = true;
    GAS bf16* Y_; const GAS float* GATEOF_;
    __device__ __forceinline__ void operator()(const f32x4 (&acc)[2][2][4][2], const Unit& u, int wr, int wc, int fr, int fq) const {
        GAS bf16* Y = Y_; const GAS float* GATEOF = GATEOF_; asm volatile("" : "+s"(Y), "+s"(GATEOF));
        const int row0 = u.pm * 256 + wr * 64 + fr;
#pragma unroll
        for (int ai = 0; ai < 2; ++ai)
#pragma unroll
            for (int m = 0; m < 4; ++m) { const int row = row0 + ai * 128 + m * 16; const float g = GATEOF[row]; GAS bf16* rowp = Y + (size_t)row * 1024 + u.pn * 256 + wc * 32 + 8 * fq;
#pragma unroll
                for (int bj = 0; bj < 2; ++bj) *(GAS u32x4*)(rowp + bj * 128) = pack8(acc[ai][bj][m][0] * g, acc[ai][bj][m][1] * g); }
    }
};

namespace att {
constexpr int KSLOT = 12288, VSLOT = 8192;
constexpr int L_K = 0, L_V = 2 * KSLOT, L_BIAS = L_V + 2 * VSLOT, L_WS = L_BIAS + 8192, L_OST = L_WS + 8 * 64 * 4, L_END = L_OST + 8 * 4096;
__device__ __forceinline__ int crow(int r, int hi) { return (r & 3) + 8 * (r >> 2) + 4 * hi; }
typedef short v4i16_t __attribute__((ext_vector_type(4)));
__device__ __forceinline__ s16x4 vtr(const LAS char* p) { return __builtin_bit_cast(s16x4, __builtin_amdgcn_ds_read_tr16_b64_v4i16((LAS v4i16_t*)p)); }

struct Tens { const GAS bf16* Q; int qp; const GAS bf16* K; int kp; const GAS bf16* KPE; const GAS bf16* V; int vp; const GAS float* BIAS; GAS bf16* O; };
template <int MODE>
__device__ __forceinline__ void attn_unit(const int tid, int b, int h, int qb, const Tens& T, LAS char* shm) {
    constexpr int DKS = MODE ? 6 : 4;
    const int lane = tid & 63, r32 = lane & 31, hi = lane >> 5; const int wid = __builtin_amdgcn_readfirstlane(tid >> 6);
    const long rowbase = (long)b * SEQ; const int q0 = qb * 256, qw0 = q0 + wid * 32;
    const int NT = (q0 + 256) / 64, tlast = qw0 / 64;
    const GAS bf16* Qw = T.Q + (rowbase + qw0) * T.qp + h * (MODE ? 96 : 64);
    const GAS bf16* Kh = T.K + rowbase * T.kp + h * (MODE ? 128 : 64);
    const GAS bf16* Vh = T.V + rowbase * T.vp + h * (MODE ? 128 : 64);
    const GAS bf16* KPEb = T.KPE + rowbase * 32;
    LAS float* wsf = (LAS float*)(shm + L_WS) + wid * 64;
    LAS float* biasb = (LAS float*)(shm + L_BIAS);
    bf16x8 qr[DKS];
#pragma unroll
    for (int d0 = 0; d0 < DKS; ++d0) qr[d0] = *(const GAS bf16x8*)(Qw + (long)r32 * T.qp + d0 * 16 + hi * 8);
    if (MODE == 0) { const GAS float* bs = T.BIAS + ((long)b * 8 + h) * SEQ; for (int i = tid; i < q0 + 256; i += 512) biasb[i] = bs[i]; }
    const GAS bf16* ksrc = Kh + (long)lane * T.kp + wid * 8;
    const GAS bf16* k2src = KPEb + (long)lane * 32 + (wid & 3) * 8;
    const GAS bf16* vsrc = Vh + (long)(16 * (wid & 3) + (lane >> 2)) * T.vp + (wid >> 2) * 32 + (lane & 3) * 8;
    u32x4 kreg, k2reg, vreg; k2reg = (u32x4){0u, 0u, 0u, 0u};
    kreg = *(const GAS u32x4*)ksrc; vreg = *(const GAS u32x4*)vsrc; if (MODE && wid < 4) k2reg = *(const GAS u32x4*)k2src;
    float mrun = -1e30f, lrun = 0.f; f32x16 o[2]; o[0] = f32x16{}; o[1] = f32x16{};
    const LAS char* vp0 = shm + L_V + ((lane >> 4) & 1) * 32 + (lane & 3) * 8 + (4 * hi + ((lane & 15) >> 2)) * 64;
    for (int t = 0; t < NT; ++t) {
        const int sl = t & 1;
        *(LAS u32x4*)(shm + L_K + sl * KSLOT + wid * 1024 + lane * 16) = kreg;
        if (MODE && wid < 4) *(LAS u32x4*)(shm + L_K + sl * KSLOT + (8 + wid) * 1024 + lane * 16) = k2reg;
        *(LAS u32x4*)(shm + L_V + sl * VSLOT + wid * 1024 + lane * 16) = vreg;
        __syncthreads();
        if (t + 1 < NT) { kreg = *(const GAS u32x4*)(ksrc + (long)(t + 1) * 64 * T.kp); vreg = *(const GAS u32x4*)(vsrc + (long)(t + 1) * 64 * T.vp); if (MODE && wid < 4) k2reg = *(const GAS u32x4*)(k2src + (long)(t + 1) * 64 * 32); }
        if (t <= tlast) {
            const LAS char* kb = shm + L_K + sl * KSLOT + hi * 1024 + r32 * 16;
            f32x16 p0 = f32x16{}, p1 = f32x16{};
#pragma unroll
            for (int d0 = 0; d0 < DKS; ++d0) {
                const bf16x8 b0 = *(const LAS bf16x8*)(kb + d0 * 2048), b1 = *(const LAS bf16x8*)(kb + d0 * 2048 + 512);
                p0 = __builtin_amdgcn_mfma_f32_32x32x16_bf16(b0, qr[d0], p0, 0, 0, 0); p1 = __builtin_amdgcn_mfma_f32_32x32x16_bf16(b1, qr[d0], p1, 0, 0, 0);
            }
            if (MODE == 0) {
                const LAS float* bb = biasb + t * 64 + 4 * hi;
#pragma unroll
                for (int g = 0; g < 4; ++g) { const f32x4 x0 = *(const LAS f32x4*)(bb + 8 * g), x1 = *(const LAS f32x4*)(bb + 32 + 8 * g);
#pragma unroll
                    for (int j = 0; j < 4; ++j) { p0[4 * g + j] += x0[j]; p1[4 * g + j] += x1[j]; } }
                if (t == tlast) { const int qrel = qw0 + r32 - 64 * t;
#pragma unroll
                    for (int r = 0; r < 16; ++r) { const int kv = crow(r, hi); if (kv > qrel) p0[r] = -INFINITY; if (kv + 32 > qrel) p1[r] = -INFINITY; } }
            }
            float rm = p0[0];
#pragma unroll
            for (int r = 1; r < 16; ++r) rm = fmaxf(rm, p0[r]);
#pragma unroll
            for (int r = 0; r < 16; ++r) rm = fmaxf(rm, p1[r]);
            rm = fmaxf(rm, __shfl_xor(rm, 32));
            const float mnew = fmaxf(mrun, rm); const float f = __builtin_amdgcn_exp2f(mrun - mnew); mrun = mnew;
            float ls = 0.f;
#pragma unroll
            for (int r = 0; r < 16; ++r) { p0[r] = __builtin_amdgcn_exp2f(p0[r] - mnew); p1[r] = __builtin_amdgcn_exp2f(p1[r] - mnew); ls += p0[r] + p1[r]; }
            lrun = lrun * f + ls;
            if (hi == 0) wsf[r32] = f;
            LDS_WAIT();
#pragma unroll
            for (int g = 0; g < 4; ++g) { const f32x4 ff = *(const LAS f32x4*)(wsf + 8 * g + 4 * hi);
#pragma unroll
                for (int j = 0; j < 4; ++j) { o[0][4 * g + j] *= ff[j]; o[1][4 * g + j] *= ff[j]; } }
            bf16x8 pa[4];
            { u32x4 w;
              w.x = cvt_pk_bf16(p0[0], p0[1]); w.y = cvt_pk_bf16(p0[2], p0[3]); w.z = cvt_pk_bf16(p0[4], p0[5]); w.w = cvt_pk_bf16(p0[6], p0[7]); pa[0] = __builtin_bit_cast(bf16x8, w);
              w.x = cvt_pk_bf16(p0[8], p0[9]); w.y = cvt_pk_bf16(p0[10], p0[11]); w.z = cvt_pk_bf16(p0[12], p0[13]); w.w = cvt_pk_bf16(p0[14], p0[15]); pa[1] = __builtin_bit_cast(bf16x8, w);
              w.x = cvt_pk_bf16(p1[0], p1[1]); w.y = cvt_pk_bf16(p1[2], p1[3]); w.z = cvt_pk_bf16(p1[4], p1[5]); w.w = cvt_pk_bf16(p1[6], p1[7]); pa[2] = __builtin_bit_cast(bf16x8, w);
              w.x = cvt_pk_bf16(p1[8], p1[9]); w.y = cvt_pk_bf16(p1[10], p1[11]); w.z = cvt_pk_bf16(p1[12], p1[13]); w.w = cvt_pk_bf16(p1[14], p1[15]); pa[3] = __builtin_bit_cast(bf16x8, w); }
            const LAS char* vp = vp0 + sl * VSLOT;
#pragma unroll
            for (int d0 = 0; d0 < 2; ++d0)
#pragma unroll
                for (int k = 0; k < 4; ++k) { const s16x4 lo = vtr(vp + d0 * 4096 + k * 1024), hh = vtr(vp + d0 * 4096 + k * 1024 + 512);
                    const bf16x8 vf = (bf16x8){lo[0], lo[1], lo[2], lo[3], hh[0], hh[1], hh[2], hh[3]};
                    o[d0] = __builtin_amdgcn_mfma_f32_32x32x16_bf16(pa[k], vf, o[d0], 0, 0, 0); }
        }
    }
    lrun += __shfl_xor(lrun, 32);
    LDS_WAIT();
    if (hi == 0) wsf[32 + r32] = lrun;
    LDS_WAIT();
    float rli[16];
#pragma unroll
    for (int g = 0; g < 4; ++g) { const f32x4 ll = *(const LAS f32x4*)(wsf + 32 + 8 * g + 4 * hi);
#pragma unroll
        for (int j = 0; j < 4; ++j) rli[4 * g + j] = __builtin_amdgcn_rcpf(ll[j]); }
    GAS bf16* Ow = T.O + (rowbase + qw0) * 1024 + (MODE ? 0 : 512) + h * 64;
    { LAS bf16* stg = (LAS bf16*)(shm + L_OST) + wid * 2048;
#pragma unroll
      for (int r = 0; r < 16; ++r) { const int orow = crow(r, hi);
#pragma unroll
          for (int d0 = 0; d0 < 2; ++d0) stg[orow * 64 + d0 * 32 + r32] = (bf16)(cvt_pk_bf16(o[d0][r] * rli[r], 0.f) & 0xffffu); }
      LDS_WAIT();
#pragma unroll
      for (int i = 0; i < 4; ++i) { const int row = i * 8 + (lane >> 3), ch = lane & 7; const u32x4 v = *(const LAS u32x4*)(stg + row * 64 + ch * 8); *(GAS u32x4*)(Ow + (long)row * 1024 + ch * 8) = v; } }
    __syncthreads();
}

constexpr int R_K = 0, R_V = 3 * KSLOT, R_WS = R_V + 3 * VSLOT, R_OST = R_WS + 8 * 64 * 4, R_END = R_OST + 8 * 4096;
struct Tens2 { const GAS bf16* Q; int qp; const GAS bf16* K; int kp; const GAS bf16* KX; const GAS bf16* V; int vp; GAS bf16* O; };
template <int MODE>
__device__ __forceinline__ void attn_unit2(const int tid, int b, int h, int qb, const Tens2& T, LAS char* shm) {
    constexpr int DKS = MODE ? 6 : 5;
    constexpr float THR = 8.f;
    const int lane = tid & 63, r32 = lane & 31, hi = lane >> 5; const int wid = __builtin_amdgcn_readfirstlane(tid >> 6);
    const long rowbase = (long)b * SEQ; const int q0 = qb * 256, qw0 = q0 + wid * 32;
    const int NT = (q0 + 256) / 64, tlast = qw0 / 64;
    const GAS bf16* Qw = T.Q + (rowbase + qw0) * T.qp + h * (MODE ? 96 : 64);
    const GAS bf16* Kh = T.K + rowbase * T.kp + h * (MODE ? 128 : 64);
    const GAS bf16* Vh = T.V + rowbase * T.vp + h * (MODE ? 128 : 64);
    LAS float* wsf = (LAS float*)(shm + R_WS) + wid * 64;
    bf16x8 qr[DKS];
#pragma unroll
    for (int d0 = 0; d0 < (MODE ? 6 : 4); ++d0) qr[d0] = *(const GAS bf16x8*)(Qw + (long)r32 * T.qp + d0 * 16 + hi * 8);
    if (MODE == 0) { const short one = hi ? (short)0 : (short)0x3F80; qr[DKS - 1] = (bf16x8){one, one, one, 0, 0, 0, 0, 0}; }
    const GAS bf16* ksrc = Kh + (long)lane * T.kp + wid * 8;
    const GAS bf16* xsrc = MODE ? T.KX + (rowbase + lane) * 32 + (wid & 3) * 8 : T.KX + (((long)b * 8 + h) * SEQ + lane) * 8;
    const GAS bf16* vsrc = Vh + (long)(16 * (wid & 3) + (lane >> 2)) * T.vp + (wid >> 2) * 32 + (lane & 3) * 8;
    const int xstep = MODE ? 64 * 32 : 64 * 8;
    LAS char* kdst = shm + R_K + wid * 1024; LAS char* xdst = shm + R_K + (8 + (MODE ? (wid & 3) : 0)) * 1024; LAS char* vdst = shm + R_V + wid * 1024;
#define A2_DMA(t, slot) do { \
        __builtin_amdgcn_global_load_lds((const GAS unsigned*)(ksrc + (long)(t) * 64 * T.kp), (LAS unsigned*)(kdst + (slot) * KSLOT), 16, 0, 0); \
        __builtin_amdgcn_global_load_lds((const GAS unsigned*)(xsrc + (long)(t) * xstep), (LAS unsigned*)(xdst + (slot) * KSLOT), 16, 0, 0); \
        __builtin_amdgcn_global_load_lds((const GAS unsigned*)(vsrc + (long)(t) * 64 * T.vp), (LAS unsigned*)(vdst + (slot) * VSLOT), 16, 0, 0); } while (0)
    float mhat = 0.f, lrun = 0.f; f32x16 o[2]; o[0] = f32x16{}; o[1] = f32x16{}; f32x16 negm = f32x16{};
    const LAS char* vp0 = shm + R_V + ((lane >> 4) & 1) * 32 + (lane & 3) * 8 + (4 * hi + ((lane & 15) >> 2)) * 64;
    A2_DMA(NT - 1, 0); A2_DMA(NT - 2, 1);
    int sl = 0, sl2 = 2;
    for (int i = 0; i < NT; ++i) {
        const int t = NT - 1 - i;
        if (i + 1 < NT) asm volatile("s_waitcnt vmcnt(3)" ::: "memory"); else asm volatile("s_waitcnt vmcnt(0)" ::: "memory");
        __builtin_amdgcn_s_barrier(); asm volatile("" ::: "memory");
        if (i + 2 < NT) A2_DMA(t - 2, sl2);
        if (t <= tlast) {
            const bool first = (t == tlast);
            const LAS char* kb = shm + R_K + sl * KSLOT + r32 * 16;
            f32x16 p0 = negm, p1 = negm;
#pragma unroll
            for (int d0 = 0; d0 < DKS; ++d0) {
                const int off = (MODE == 0 && d0 == 4) ? 8 * 1024 : d0 * 2048 + hi * 1024;
                const bf16x8 b0 = *(const LAS bf16x8*)(kb + off), b1 = *(const LAS bf16x8*)(kb + off + 512);
                p0 = __builtin_amdgcn_mfma_f32_32x32x16_bf16(b0, qr[d0], p0, 0, 0, 0); p1 = __builtin_amdgcn_mfma_f32_32x32x16_bf16(b1, qr[d0], p1, 0, 0, 0);
            }
            if (MODE == 0 && first) { const int qrel = qw0 + r32 - 64 * t;
#pragma unroll
                for (int r = 0; r < 16; ++r) { const int kv = crow(r, hi); if (kv > qrel) p0[r] = -INFINITY; if (kv + 32 > qrel) p1[r] = -INFINITY; } }
            float rm;
            { float a = fmaxf(fmaxf(p0[0], p0[1]), p1[0]), c = fmaxf(fmaxf(p0[2], p0[3]), p1[1]); a = fmaxf(fmaxf(a, p1[2]), p1[3]);
#pragma unroll
              for (int r = 4; r < 16; r += 4) { a = fmaxf(fmaxf(a, p0[r]), p0[r + 1]); c = fmaxf(fmaxf(c, p0[r + 2]), p0[r + 3]); a = fmaxf(fmaxf(a, p1[r]), p1[r + 1]); c = fmaxf(fmaxf(c, p1[r + 2]), p1[r + 3]); }
              rm = fmaxf(a, c); const auto rr = __builtin_amdgcn_permlane32_swap(__float_as_uint(rm), __float_as_uint(rm), false, false); rm = fmaxf(__uint_as_float(rr[0]), __uint_as_float(rr[1])); }
            if (first || __any(rm > THR)) {
                const float dl = first ? rm : fmaxf(rm, 0.f); mhat += dl;
#pragma unroll
                for (int r = 0; r < 16; ++r) { p0[r] -= dl; p1[r] -= dl; }
#pragma unroll
                for (int r = 0; r < 16; ++r) negm[r] = -mhat;
                if (!first) {
                    const float f = __builtin_amdgcn_exp2f(-dl); lrun *= f;
                    if (hi == 0) wsf[r32] = f;
                    LDS_WAIT();
#pragma unroll
                    for (int g = 0; g < 4; ++g) { const f32x4 ff = *(const LAS f32x4*)(wsf + 8 * g + 4 * hi);
#pragma unroll
                        for (int j = 0; j < 4; ++j) { o[0][4 * g + j] *= ff[j]; o[1][4 * g + j] *= ff[j]; } }
                }
            }
            float ls = 0.f;
#pragma unroll
            for (int r = 0; r < 16; ++r) { p0[r] = __builtin_amdgcn_exp2f(p0[r]); p1[r] = __builtin_amdgcn_exp2f(p1[r]); ls += p0[r] + p1[r]; }
            lrun += ls;
            bf16x8 pa[4];
            { u32x4 w;
              w.x = cvt_pk_bf16(p0[0], p0[1]); w.y = cvt_pk_bf16(p0[2], p0[3]); w.z = cvt_pk_bf16(p0[4], p0[5]); w.w = cvt_pk_bf16(p0[6], p0[7]); pa[0] = __builtin_bit_cast(bf16x8, w);
              w.x = cvt_pk_bf16(p0[8], p0[9]); w.y = cvt_pk_bf16(p0[10], p0[11]); w.z = cvt_pk_bf16(p0[12], p0[13]); w.w = cvt_pk_bf16(p0[14], p0[15]); pa[1] = __builtin_bit_cast(bf16x8, w);
              w.x = cvt_pk_bf16(p1[0], p1[1]); w.y = cvt_pk_bf16(p1[2], p1[3]); w.z = cvt_pk_bf16(p1[4], p1[5]); w.w = cvt_pk_bf16(p1[6], p1[7]); pa[2] = __builtin_bit_cast(bf16x8, w);
              w.x = cvt_pk_bf16(p1[8], p1[9]); w.y = cvt_pk_bf16(p1[10], p1[11]); w.z = cvt_pk_bf16(p1[12], p1[13]); w.w = cvt_pk_bf16(p1[14], p1[15]); pa[3] = __builtin_bit_cast(bf16x8, w); }
            const LAS char* vp = vp0 + sl * VSLOT;
#pragma unroll
            for (int d0 = 0; d0 < 2; ++d0)
#pragma unroll
                for (int k = 0; k < 4; ++k) { const s16x4 lo = vtr(vp + d0 * 4096 + k * 1024), hh = vtr(vp + d0 * 4096 + k * 1024 + 512);
                    const bf16x8 vf = (bf16x8){lo[0], lo[1], lo[2], lo[3], hh[0], hh[1], hh[2], hh[3]};
                    o[d0] = __builtin_amdgcn_mfma_f32_32x32x16_bf16(pa[k], vf, o[d0], 0, 0, 0); }
        }
        sl = (sl == 2) ? 0 : sl + 1; sl2 = (sl2 == 2) ? 0 : sl2 + 1;
    }
#undef A2_DMA
    lrun += __shfl_xor(lrun, 32);
    LDS_WAIT();
    if (hi == 0) wsf[32 + r32] = lrun;
    LDS_WAIT();
    float rli[16];
#pragma unroll
    for (int g = 0; g < 4; ++g) { const f32x4 ll = *(const LAS f32x4*)(wsf + 32 + 8 * g + 4 * hi);
#pragma unroll
        for (int j = 0; j < 4; ++j) rli[4 * g + j] = __builtin_amdgcn_rcpf(ll[j]); }
    GAS bf16* Ow = T.O + (rowbase + qw0) * 1024 + (MODE ? 0 : 512) + h * 64;
    { LAS bf16* stg = (LAS bf16*)(shm + R_OST) + wid * 2048;
#pragma unroll
      for (int r = 0; r < 16; ++r) { const int orow = crow(r, hi);
#pragma unroll
          for (int d0 = 0; d0 < 2; ++d0) stg[orow * 64 + d0 * 32 + r32] = (bf16)(cvt_pk_bf16(o[d0][r] * rli[r], 0.f) & 0xffffu); }
      LDS_WAIT();
#pragma unroll
      for (int i = 0; i < 4; ++i) { const int row = i * 8 + (lane >> 3), ch = lane & 7; const u32x4 v = *(const LAS u32x4*)(stg + row * 64 + ch * 8); *(GAS u32x4*)(Ow + (long)row * 1024 + ch * 8) = v; } }
    LDS_WAIT(); __builtin_amdgcn_s_barrier(); asm volatile("" ::: "memory");
}
}

struct Args { const void* in[21]; float* out; unsigned char* ws; int ph_lo, ph_hi; };

__device__ __forceinline__ void tr_item(const GAS float* __restrict__ W, int ldw, int Ksrc, const GAS float* __restrict__ gain, GAS bf16* __restrict__ WT, int ldk, int k0, int n0, int srccol, LAS float* scr, int lane) {
#pragma unroll 8
    for (int i = 0; i < 32; ++i) { const int kk = 2 * i + (lane >> 5); const int k = k0 + kk;
        float v = 0.f; if (srccol >= 0 && k < Ksrc) { v = W[(size_t)k * ldw + srccol]; if (gain) v *= gain[k]; }
        scr[kk * 33 + (lane & 31)] = v; }
    LDS_WAIT(); asm volatile("" ::: "memory");
    const int c = lane & 7;
#pragma unroll
    for (int j = 0; j < 4; ++j) { const int n = (lane >> 3) + 8 * j; const LAS float* s = scr + (8 * c) * 33 + n;
        u32x4 o; o.x = cvt_pk_bf16(s[0 * 33], s[1 * 33]); o.y = cvt_pk_bf16(s[2 * 33], s[3 * 33]); o.z = cvt_pk_bf16(s[4 * 33], s[5 * 33]); o.w = cvt_pk_bf16(s[6 * 33], s[7 * 33]);
        *(GAS u32x4*)(WT + (size_t)(n0 + n) * ldk + k0 + 8 * c) = o; }
    LDS_WAIT(); asm volatile("" ::: "memory");
}
__device__ __forceinline__ void tr_item64(const GAS float* __restrict__ W, int ldw, const GAS float* __restrict__ gain, GAS bf16* __restrict__ WT, int ldk, int k0, int n0src, int n0dst, LAS float* scr, int lane) {
    const int rr = lane >> 4, c4 = (lane & 15) * 4;
    f32x4 v[16];
#pragma unroll
    for (int i = 0; i < 16; ++i) v[i] = *(const GAS f32x4*)(W + (size_t)(k0 + 4 * i + rr) * ldw + n0src + c4);
#pragma unroll
    for (int i = 0; i < 16; ++i) { const int k = 4 * i + rr; const float g = gain ? gain[k0 + k] : 1.f; LAS float* d = scr + k * 65 + c4;
        d[0] = v[i][0] * g; d[1] = v[i][1] * g; d[2] = v[i][2] * g; d[3] = v[i][3] * g; }
    LDS_WAIT(); asm volatile("" ::: "memory");
    const int kc = lane & 7;
#pragma unroll
    for (int j = 0; j < 8; ++j) { const int n = (lane >> 3) + 8 * j; const LAS float* sp = scr + (8 * kc) * 65 + n;
        u32x4 o; o.x = cvt_pk_bf16(sp[0 * 65], sp[1 * 65]); o.y = cvt_pk_bf16(sp[2 * 65], sp[3 * 65]); o.z = cvt_pk_bf16(sp[4 * 65], sp[5 * 65]); o.w = cvt_pk_bf16(sp[6 * 65], sp[7 * 65]);
        *(GAS u32x4*)(WT + (size_t)(n0dst + n) * ldk + k0 + 8 * kc) = o; }
    LDS_WAIT(); asm volatile("" ::: "memory");
}
__device__ __forceinline__ int rope_dim(int p) { const int a = p >> 3, j = p & 7; return j < 4 ? 4 * a + j : 16 + 4 * a + (j - 4); }

#define LDP(i) ((void*)((((unsigned long long)(unsigned)__builtin_amdgcn_readfirstlane((int)(ARGP[i] >> 32))) << 32) | (unsigned long long)(unsigned)__builtin_amdgcn_readfirstlane((int)(unsigned)ARGP[i])))
#define ARGIN(i) ((const void*)LDP(i))
#define P_COS ((GAS float*)(ws + WS_COS))
#define P_SIN ((GAS float*)(ws + WS_SIN))
#define P_SSQ ((GAS float*)(ws + WS_SSQ))
#define P_FLOG ((GAS float*)(ws + WS_FLOG))
#define P_E01 ((GAS int*)(ws + WS_E01))
#define P_G01 ((GAS float*)(ws + WS_G01))
#define P_SLOT ((GAS int*)(ws + WS_SLOT))
#define P_TOKOF ((GAS int*)(ws + WS_TOKOF))
#define P_GATEOF ((GAS float*)(ws + WS_GATEOF))
#define P_CNT ((GAS int*)(ws + WS_CNT))
#define P_TSTART ((GAS int*)(ws + WS_TSTART))
#define P_RSTD ((GAS float*)(ws + WS_RSTD))
#define P_RSTDOF ((GAS float*)(ws + WS_RSTDOF))
#define P_KPE ((GAS bf16*)(ws + WS_KPE))
#define P_KAUG ((GAS bf16*)(ws + WS_KAUG))
#define P_WIN ((GAS bf16*)(ws + WS_WIN))
#define P_WUQ ((GAS bf16*)(ws + WS_WUQ))
#define P_WUKV ((GAS bf16*)(ws + WS_WUKV))
#define P_WOUT ((GAS bf16*)(ws + WS_WOUT))
#define P_WGU ((GAS bf16*)(ws + WS_WGU))
#define P_WD ((GAS bf16*)(ws + WS_WD))
#define P_XN ((GAS bf16*)(ws + WS_XN))
#define P_FQKV ((GAS bf16*)(ws + WS_FQKV))
#define P_HH ((GAS bf16*)(ws + WS_FQKV))
#define P_LAT ((GAS bf16*)(ws + WS_LAT))
#define P_QM ((GAS bf16*)(ws + WS_QM))
#define P_KVM ((GAS bf16*)(ws + WS_KVM))
#define P_Y ((GAS bf16*)(ws + WS_Y))
#define IN(k) (lo <= (k) && (k) < hi_)
#if MK_ONE_LAUNCH
#define GRID_BAR() xcd_barrier(bar)
#else
#define GRID_BAR() do {} while (0)
#endif
#define SEAM(k) do { if (IN(k) && IN((k) + 1)) GRID_BAR(); } while (0)
template <int l>
__device__ __forceinline__ void layer_body(const int lo, const int hi_, LAS unsigned char* lds0, const int wave0, const int G0, const int bx0, const XcdBarrier& bar) {
        const int P = 10 * l;
        if (IN(P)) for (int rep_ = 0; rep_ < (l == 0 ? NREP(0) : 1); ++rep_) {
            unsigned ldsb_ = (unsigned)(uintptr_t)lds0; asm volatile("" : "+s"(ldsb_)); LAS unsigned char* lds = (LAS unsigned char*)(uintptr_t)ldsb_; volatile LAS unsigned* MISC = (volatile LAS unsigned*)(lds + MISC_OFF); volatile LAS unsigned long long* ARGP = (volatile LAS unsigned long long*)(lds + MISC_OFF + 768); (void)MISC; int wave = wave0, G = G0, bx = bx0; asm volatile("" : "+s"(G), "+s"(bx), "+s"(wave)); const int lane = (int)__builtin_amdgcn_mbcnt_hi(~0u, __builtin_amdgcn_mbcnt_lo(~0u, 0u)); const int tid = wave * 64 + lane; const int vcu = (bx % 8) * (G / 8) + bx / 8; const int gw = vcu * 8 + wave, NGW = G * 8; (void)lane; (void)gw; (void)NGW; (void)vcu;
            GAS unsigned char* ws = (GAS unsigned char*)LDP(22); GAS float* out = (GAS float*)LDP(21); const GAS float* x_in = (const GAS float*)ARGIN(0); const GAS int* positions = (const GAS int*)ARGIN(1);
            if (l < NLAYER) {
                LAS float* scr = (LAS float*)(lds + wave * 16640);
                const GAS float* attn_norm = (const GAS float*)ARGIN(2) + (size_t)l * DM; const GAS float* w_in = (const GAS float*)ARGIN(3) + (size_t)l * DM * INW;
                const GAS float* q_norm = (const GAS float*)ARGIN(5) + (size_t)l * 256; const GAS float* w_uq = (const GAS float*)ARGIN(6) + (size_t)l * 256 * 768;
                const GAS float* kv_norm = (const GAS float*)ARGIN(7) + (size_t)l * 128; const GAS float* w_ukv = (const GAS float*)ARGIN(8) + (size_t)l * 128 * 1024;
                const GAS float* mla_on = (const GAS float*)ARGIN(9) + (size_t)l * 512; const GAS float* fox_on = (const GAS float*)ARGIN(10) + (size_t)l * 512; const GAS float* w_out = (const GAS float*)ARGIN(11) + (size_t)l * DM * DM;
                const GAS float* ffn_norm = (const GAS float*)ARGIN(12) + (size_t)l * DM;
                const GAS float* w_gate = (const GAS float*)ARGIN(17) + (size_t)l * NEXP * DM * DEXP; const GAS float* w_up = (const GAS float*)ARGIN(18) + (size_t)l * NEXP * DM * DEXP; const GAS float* w_down = (const GAS float*)ARGIN(19) + (size_t)l * NEXP * DEXP * DM;
                constexpr int I_IN = 16 * 64, I_UQ = 4 * 24, I_UKV = 4 * 32;
                constexpr int NITEMS = I_IN + I_UQ + I_UKV;
                for (int it = gw; it < NITEMS; it += NGW) {
                    int r = it; const int j = lane & 31;
                    if (r < I_IN) { const int kb = r / 64, nb = r % 64; const int n = nb * 32 + j; int sc;
                        if (n < 384) sc = n; else if (n < 416) sc = 384 + rope_dim(n - 384); else if (n < 424) sc = 1952 + (n - 416); else if (n < 512) sc = -1; else sc = 416 + (n - 512);
                        tr_item(w_in, INW, DM, attn_norm, P_WIN, DM, kb * 64, nb * 32, sc, scr, lane); continue; } r -= I_IN;
                    if (r < I_UQ) { const int kb = r / 24, nb = r % 24; const int n = nb * 32 + j; const int hh = n / 96, d = n % 96; const int sc = d < 64 ? n : hh * 96 + 64 + rope_dim(d - 64);
                        tr_item(w_uq, 768, 256, q_norm, P_WUQ, 256, kb * 64, nb * 32, sc, scr, lane); continue; } r -= I_UQ;
                    { const int kb = r / 32, nb = r % 32; tr_item(w_ukv, 1024, 128, kv_norm, P_WUKV, 256, kb * 64, nb * 32, nb * 32 + j, scr, lane); }
                }
                LAS float* scr64 = (LAS float*)(lds + wave * 16640);
                constexpr int J_OUT = 16 * 16, J_GU = 16 * 16 * NEXP, J_D = 8 * 16 * NEXP;
                for (int it = gw; it < J_OUT + J_GU + J_D; it += NGW) {
                    int r = it;
                    if (r < J_OUT) { const int kb = r / 16, nb = r % 16; const GAS float* gn = kb < 8 ? mla_on : fox_on - 512; tr_item64(w_out, DM, gn, P_WOUT, DM, kb * 64, nb * 64, nb * 64, scr64, lane); continue; } r -= J_OUT;
                    if (r < J_GU) { const int e = r / 256, q = r % 256, kb = q / 16, nb = q % 16; const int n0 = nb * 64; const int ct = n0 >> 8, which = (n0 >> 7) & 1, jj = n0 & 127;
                        const GAS float* src = (which ? w_up : w_gate) + (size_t)e * DM * DEXP;
                        tr_item64(src, DEXP, ffn_norm, P_WGU + (size_t)e * 1024 * 1024, DM, kb * 64, ct * 128 + jj, n0, scr64, lane); continue; } r -= J_GU;
                    { const int e = r / 128, q = r % 128, kb = q / 16, nb = q % 16;
                        tr_item64(w_down + (size_t)e * DEXP * DM, DM, nullptr, P_WD + (size_t)e * 1024 * 512, DEXP, kb * 64, nb * 64, nb * 64, scr64, lane); }
                }
            }
            const GAS float* fin = (const GAS float*)ARGIN(20);
            for (int m = gw; m < NTOK; m += NGW) {
                const GAS float* xr = (l == 0 ? x_in : out) + (size_t)m * DM;
                f32x4 v[4];
#pragma unroll
                for (int j = 0; j < 4; ++j) v[j] = *(const GAS f32x4*)(xr + 4 * lane + 256 * j);
                if (l > 0) {
                    const int s0 = P_SLOT[2 * m], s1 = P_SLOT[2 * m + 1];
#pragma unroll
                    for (int j = 0; j < 4; ++j) { const u32x2 a = *(const GAS u32x2*)(P_Y + (size_t)s0 * 1024 + 4 * lane + 256 * j), c = *(const GAS u32x2*)(P_Y + (size_t)s1 * 1024 + 4 * lane + 256 * j);
                        v[j][0] += __uint_as_float(a.x << 16) + __uint_as_float(c.x << 16); v[j][1] += __uint_as_float(a.x & 0xffff0000u) + __uint_as_float(c.x & 0xffff0000u);
                        v[j][2] += __uint_as_float(a.y << 16) + __uint_as_float(c.y << 16); v[j][3] += __uint_as_float(a.y & 0xffff0000u) + __uint_as_float(c.y & 0xffff0000u); }
                }
                float s = 0.f;
#pragma unroll
                for (int j = 0; j < 4; ++j) s += (v[j][0] * v[j][0] + v[j][1] * v[j][1]) + (v[j][2] * v[j][2] + v[j][3] * v[j][3]);
                const float rstd = rsqrtf(wave_sum(s) * (1.f / DM) + EPS);
                if (l < NLAYER) {
                    if (l > 0) {
#pragma unroll
                        for (int j = 0; j < 4; ++j) *(GAS f32x4*)(out + (size_t)m * DM + 4 * lane + 256 * j) = v[j];
                    }
#pragma unroll
                    for (int j = 0; j < 4; ++j) { u32x2 w; w.x = cvt_pk_bf16(v[j][0] * rstd, v[j][1] * rstd); w.y = cvt_pk_bf16(v[j][2] * rstd, v[j][3] * rstd); *(GAS u32x2*)(P_XN + (size_t)m * DM + 4 * lane + 256 * j) = w; }
                } else {
#pragma unroll
                    for (int j = 0; j < 4; ++j) { const f32x4 g = *(const GAS f32x4*)(fin + 4 * lane + 256 * j); *(GAS f32x4*)(out + (size_t)m * DM + 4 * lane + 256 * j) = v[j] * rstd * g; }
                }
            }
        }
        if constexpr (l == NLAYER) return;
        SEAM(P);
        if (IN(P + 1)) for (int rep_ = 0; rep_ < ((l == 0 || 1 != 5) ? NREP(1) : 1); ++rep_) {
            unsigned ldsb_ = (unsigned)(uintptr_t)lds0; asm volatile("" : "+s"(ldsb_)); LAS unsigned char* lds = (LAS unsigned char*)(uintptr_t)ldsb_; volatile LAS unsigned* MISC = (volatile LAS unsigned*)(lds + MISC_OFF); volatile LAS unsigned long long* ARGP = (volatile LAS unsigned long long*)(lds + MISC_OFF + 768); (void)MISC; int wave = wave0, G = G0, bx = bx0; asm volatile("" : "+s"(G), "+s"(bx), "+s"(wave)); const int lane = (int)__builtin_amdgcn_mbcnt_hi(~0u, __builtin_amdgcn_mbcnt_lo(~0u, 0u)); const int tid = wave * 64 + lane; const int vcu = (bx % 8) * (G / 8) + bx / 8; const int gw = vcu * 8 + wave, NGW = G * 8; (void)lane; (void)gw; (void)NGW; (void)vcu;
            GAS unsigned char* ws = (GAS unsigned char*)LDP(22); GAS float* out = (GAS float*)LDP(21); const GAS float* x_in = (const GAS float*)ARGIN(0); (void)out; (void)x_in; (void)ws;
            DenseOrder S{NTOK / 256, INP / 256, (NTOK / 256) * (INP / 256), G, bx, (const GAS char*)P_XN, (const GAS char*)P_WIN, (size_t)256 * DM * 2, (size_t)256 * DM * 2};
            EpiWin E{P_LAT, P_FQKV, P_KPE, P_FLOG, P_SSQ, P_COS, P_SIN};
            pg8::gemm_phase<EpiWin, DenseOrder, true, false>(tid, lds, DM, DM, DM, S, E, nullptr);
        }
        SEAM(P + 1);
        if (IN(P + 2)) for (int rep_ = 0; rep_ < ((l == 0 || 2 != 5) ? NREP(2) : 1); ++rep_) {
            unsigned ldsb_ = (unsigned)(uintptr_t)lds0; asm volatile("" : "+s"(ldsb_)); LAS unsigned char* lds = (LAS unsigned char*)(uintptr_t)ldsb_; volatile LAS unsigned* MISC = (volatile LAS unsigned*)(lds + MISC_OFF); volatile LAS unsigned long long* ARGP = (volatile LAS unsigned long long*)(lds + MISC_OFF + 768); (void)MISC; int wave = wave0, G = G0, bx = bx0; asm volatile("" : "+s"(G), "+s"(bx), "+s"(wave)); const int lane = (int)__builtin_amdgcn_mbcnt_hi(~0u, __builtin_amdgcn_mbcnt_lo(~0u, 0u)); const int tid = wave * 64 + lane; const int vcu = (bx % 8) * (G / 8) + bx / 8; const int gw = vcu * 8 + wave, NGW = G * 8; (void)lane; (void)gw; (void)NGW; (void)vcu;
            GAS unsigned char* ws = (GAS unsigned char*)LDP(22); GAS float* out = (GAS float*)LDP(21); const GAS float* x_in = (const GAS float*)ARGIN(0); (void)out; (void)x_in; (void)ws;
            if (vcu < 128 && wave == 0) {
                const int b = vcu >> 3, h = vcu & 7; const float bf = ((const GAS float*)ARGIN(4))[l * 8 + h];
                const GAS float* fl = P_FLOG + ((size_t)b * SEQ + 32 * lane) * 8 + h;
                double run = 0.0;
                for (int i = 0; i < 32; ++i) { const float f = fl[i * 8] + bf; const float lf = fminf(f, 0.f) - log1pf(expf(-fabsf(f))); run += (double)lf; }
                double tot = run;
#pragma unroll
                for (int o = 1; o < 64; o <<= 1) { const double t = __shfl_up(tot, o); if (lane >= o) tot += t; }
                double c = tot - run;
                GAS u32x4* ka = (GAS u32x4*)(P_KAUG + (((size_t)b * 8 + h) * SEQ + 32 * lane) * 8);
                for (int i = 0; i < 32; ++i) { const float f = fl[i * 8] + bf; const float lf = fminf(f, 0.f) - log1pf(expf(-fabsf(f))); c += (double)lf; const float x = (float)(-c * 1.4426950408889634);
                    const unsigned h16 = cvt_pk_bf16(x, 0.f) & 0xffffu; const float r1 = x - __uint_as_float(h16 << 16); const unsigned m16 = cvt_pk_bf16(r1, 0.f) & 0xffffu; const float r2 = r1 - __uint_as_float(m16 << 16); const unsigned l16 = cvt_pk_bf16(r2, 0.f) & 0xffffu;
                    ka[i] = (u32x4){h16 | (m16 << 16), l16, 0u, 0u}; }
            }
            UpOrder S{G, vcu, (const GAS char*)P_LAT, (const GAS char*)P_WUQ, (const GAS char*)P_WUKV};
            EpiUp E{P_QM, P_KVM, P_SSQ, P_COS, P_SIN};
            pg8::gemm_phase<EpiUp, UpOrder, true, false>(tid, lds, 256, 512, 256, S, E, nullptr);
        }
        SEAM(P + 2);
        if (IN(P + 3)) for (int rep_ = 0; rep_ < ((l == 0 || 3 != 5) ? NREP(3) : 1); ++rep_) {
            unsigned ldsb_ = (unsigned)(uintptr_t)lds0; asm volatile("" : "+s"(ldsb_)); LAS unsigned char* lds = (LAS unsigned char*)(uintptr_t)ldsb_; volatile LAS unsigned* MISC = (volatile LAS unsigned*)(lds + MISC_OFF); volatile LAS unsigned long long* ARGP = (volatile LAS unsigned long long*)(lds + MISC_OFF + 768); (void)MISC; int wave = wave0, G = G0, bx = bx0; asm volatile("" : "+s"(G), "+s"(bx), "+s"(wave)); const int lane = (int)__builtin_amdgcn_mbcnt_hi(~0u, __builtin_amdgcn_mbcnt_lo(~0u, 0u)); const int tid = wave * 64 + lane; const int vcu = (bx % 8) * (G / 8) + bx / 8; const int gw = vcu * 8 + wave, NGW = G * 8; (void)lane; (void)gw; (void)NGW; (void)vcu;
            GAS unsigned char* ws = (GAS unsigned char*)LDP(22); GAS float* out = (GAS float*)LDP(21); const GAS float* x_in = (const GAS float*)ARGIN(0); (void)out; (void)x_in; (void)ws;
            GAS bf16* O = P_XN;
            const int b = vcu >> 4, hh = (vcu & 15) >> 1, sub = vcu & 1;
            const att::Tens2 TM{P_QM, 768, P_KVM, 1024, P_KPE, P_KVM + 64, 1024, O};
            const att::Tens2 TF{P_FQKV, 512, P_FQKV + (size_t)NTOK * 512, 512, P_KAUG, P_FQKV + (size_t)2 * NTOK * 512, 512, O};
            for (int i = 0; i < 4; ++i) { const int s = 2 * sub + (i >> 1); const int qb = (i & 1) ? 7 - s : s; att::attn_unit2<1>(tid, b, hh, qb, TM, (LAS char*)lds); }
            for (int i = 0; i < 4; ++i) { const int s = 2 * sub + (i >> 1); const int qb = (i & 1) ? 7 - s : s; att::attn_unit2<0>(tid, b, hh, qb, TF, (LAS char*)lds); }
        }
        SEAM(P + 3);
        if (IN(P + 4)) for (int rep_ = 0; rep_ < ((l == 0 || 4 != 5) ? NREP(4) : 1); ++rep_) {
            unsigned ldsb_ = (unsigned)(uintptr_t)lds0; asm volatile("" : "+s"(ldsb_)); LAS unsigned char* lds = (LAS unsigned char*)(uintptr_t)ldsb_; volatile LAS unsigned* MISC = (volatile LAS unsigned*)(lds + MISC_OFF); volatile LAS unsigned long long* ARGP = (volatile LAS unsigned long long*)(lds + MISC_OFF + 768); (void)MISC; int wave = wave0, G = G0, bx = bx0; asm volatile("" : "+s"(G), "+s"(bx), "+s"(wave)); const int lane = (int)__builtin_amdgcn_mbcnt_hi(~0u, __builtin_amdgcn_mbcnt_lo(~0u, 0u)); const int tid = wave * 64 + lane; const int vcu = (bx % 8) * (G / 8) + bx / 8; const int gw = vcu * 8 + wave, NGW = G * 8; (void)lane; (void)gw; (void)NGW; (void)vcu;
            GAS unsigned char* ws = (GAS unsigned char*)LDP(22); GAS float* out = (GAS float*)LDP(21); const GAS float* x_in = (const GAS float*)ARGIN(0); (void)out; (void)x_in; (void)ws;
            GAS bf16* O = P_XN;
            for (int m = gw; m < NTOK; m += NGW) {
                GAS bf16* orow = O + (size_t)m * DM;
                const u32x4 a = *(const GAS u32x4*)(orow + 8 * lane), c = *(const GAS u32x4*)(orow + 512 + 8 * lane);
                float fa[8], fc[8];
#pragma unroll
                for (int j = 0; j < 4; ++j) { fa[2 * j] = __uint_as_float(a[j] << 16); fa[2 * j + 1] = __uint_as_float(a[j] & 0xffff0000u); fc[2 * j] = __uint_as_float(c[j] << 16); fc[2 * j + 1] = __uint_as_float(c[j] & 0xffff0000u); }
                float sa = 0.f, sc = 0.f;
#pragma unroll
                for (int j = 0; j < 8; ++j) { sa += fa[j] * fa[j]; sc += fc[j] * fc[j]; }
                const float ra = rsqrtf(wave_sum(sa) * (1.f / 512.f) + EPS), rc = rsqrtf(wave_sum(sc) * (1.f / 512.f) + EPS);
                u32x4 oa, oc;
#pragma unroll
                for (int j = 0; j < 4; ++j) { oa[j] = cvt_pk_bf16(fa[2 * j] * ra, fa[2 * j + 1] * ra); oc[j] = cvt_pk_bf16(fc[2 * j] * rc, fc[2 * j + 1] * rc); }
                *(GAS u32x4*)(orow + 8 * lane) = oa; *(GAS u32x4*)(orow + 512 + 8 * lane) = oc;
            }
        }
        SEAM(P + 4);
        if (IN(P + 5)) for (int rep_ = 0; rep_ < ((l == 0 || 5 != 5) ? NREP(5) : 1); ++rep_) {
            unsigned ldsb_ = (unsigned)(uintptr_t)lds0; asm volatile("" : "+s"(ldsb_)); LAS unsigned char* lds = (LAS unsigned char*)(uintptr_t)ldsb_; volatile LAS unsigned* MISC = (volatile LAS unsigned*)(lds + MISC_OFF); volatile LAS unsigned long long* ARGP = (volatile LAS unsigned long long*)(lds + MISC_OFF + 768); (void)MISC; int wave = wave0, G = G0, bx = bx0; asm volatile("" : "+s"(G), "+s"(bx), "+s"(wave)); const int lane = (int)__builtin_amdgcn_mbcnt_hi(~0u, __builtin_amdgcn_mbcnt_lo(~0u, 0u)); const int tid = wave * 64 + lane; const int vcu = (bx % 8) * (G / 8) + bx / 8; const int gw = vcu * 8 + wave, NGW = G * 8; (void)lane; (void)gw; (void)NGW; (void)vcu;
            GAS unsigned char* ws = (GAS unsigned char*)LDP(22); GAS float* out = (GAS float*)LDP(21); const GAS float* x_in = (const GAS float*)ARGIN(0); (void)out; (void)x_in; (void)ws;
            DenseOrder S{NTOK / 256, DM / 256, (NTOK / 256) * (DM / 256), G, bx, (const GAS char*)P_XN, (const GAS char*)P_WOUT, (size_t)256 * DM * 2, (size_t)256 * DM * 2};
            EpiOut E{l == 0 ? x_in : out, out};
            pg8::gemm_phase<EpiOut, DenseOrder, true, false>(tid, lds, DM, DM, DM, S, E, nullptr);
        }
        SEAM(P + 5);
        if (IN(P + 6)) for (int rep_ = 0; rep_ < ((l == 0 || 6 != 5) ? NREP(6) : 1); ++rep_) {
            unsigned ldsb_ = (unsigned)(uintptr_t)lds0; asm volatile("" : "+s"(ldsb_)); LAS unsigned char* lds = (LAS unsigned char*)(uintptr_t)ldsb_; volatile LAS unsigned* MISC = (volatile LAS unsigned*)(lds + MISC_OFF); volatile LAS unsigned long long* ARGP = (volatile LAS unsigned long long*)(lds + MISC_OFF + 768); (void)MISC; int wave = wave0, G = G0, bx = bx0; asm volatile("" : "+s"(G), "+s"(bx), "+s"(wave)); const int lane = (int)__builtin_amdgcn_mbcnt_hi(~0u, __builtin_amdgcn_mbcnt_lo(~0u, 0u)); const int tid = wave * 64 + lane; const int vcu = (bx % 8) * (G / 8) + bx / 8; const int gw = vcu * 8 + wave, NGW = G * 8; (void)lane; (void)gw; (void)NGW; (void)vcu;
            GAS unsigned char* ws = (GAS unsigned char*)LDP(22); GAS float* out = (GAS float*)LDP(21); const GAS float* x_in = (const GAS float*)ARGIN(0); (void)out; (void)x_in; (void)ws;
            GAS bf16* H2 = P_XN;
            LAS float* WRh = (LAS float*)lds;
            LAS float* LG = (LAS float*)(lds + 73728) + wave * 576;
            const GAS float* ffn_norm = (const GAS float*)ARGIN(12) + (size_t)l * DM; const GAS float* w_rg = (const GAS float*)ARGIN(13) + (size_t)l * DM * 4; const GAS float* b_rg = (const GAS float*)ARGIN(14) + l * 4;
            const GAS float* w_re = (const GAS float*)ARGIN(15) + (size_t)l * DM * 32; const GAS float* b_re = (const GAS float*)ARGIN(16) + l * 32;
            if (tid < 32) MISC[64 + tid] = 0u;
            const int r16 = lane & 15, g4 = lane >> 4;
            const int m0 = vcu * 128 + wave * 16;
            const GAS float* xrow = out + (size_t)(m0 + r16) * DM + 4 * g4;
            GAS bf16* hrow = H2 + (size_t)(m0 + r16) * DM + 4 * g4;
            f32x4 acc3[3]; acc3[0] = (f32x4){0.f, 0.f, 0.f, 0.f}; acc3[1] = acc3[0]; acc3[2] = acc3[0];
            float ssq = 0.f;
            int colc[3];
#pragma unroll
            for (int ct = 0; ct < 3; ++ct) { const int c = 16 * ct + r16; colc[ct] = c < 36 ? c : 35; }
            for (int half = 0; half < 2; ++half) {
                __syncthreads();
                for (int idx = tid; idx < 512 * 36; idx += 512) { const int k = half * 512 + idx / 36, e = idx % 36; WRh[idx] = ffn_norm[k] * (e < 4 ? w_rg[k * 4 + e] : w_re[k * 32 + (e - 4)]); }
                __syncthreads();
                for (int s8 = 0; s8 < 32; s8 += 8) {
                    f32x4 xv[8];
#pragma unroll
                    for (int u = 0; u < 8; ++u) xv[u] = *(const GAS f32x4*)(xrow + half * 512 + 16 * (s8 + u));
#pragma unroll
                    for (int u = 0; u < 8; ++u) {
                        const f32x4 x4 = xv[u];
                        u32x2 hw; hw.x = cvt_pk_bf16(x4[0], x4[1]); hw.y = cvt_pk_bf16(x4[2], x4[3]); *(GAS u32x2*)(hrow + half * 512 + 16 * (s8 + u)) = hw;
                        ssq += (x4[0] * x4[0] + x4[1] * x4[1]) + (x4[2] * x4[2] + x4[3] * x4[3]);
                        const LAS float* wk = WRh + (16 * (s8 + u) + 4 * g4) * 36;
#pragma unroll
                        for (int j = 0; j < 4; ++j)
#pragma unroll
                            for (int ct = 0; ct < 3; ++ct) acc3[ct] = __builtin_amdgcn_mfma_f32_16x16x4f32(x4[j], wk[j * 36 + colc[ct]], acc3[ct], 0, 0, 0);
                    }
                }
            }
            ssq += __shfl_xor(ssq, 16); ssq += __shfl_xor(ssq, 32);
            const float rstd = rsqrtf(ssq * (1.f / DM) + EPS);
#pragma unroll
            for (int ct = 0; ct < 3; ++ct) { const int c = 16 * ct + r16; if (c < 36) {
#pragma unroll
                for (int rg = 0; rg < 4; ++rg) LG[(4 * g4 + rg) * 36 + c] = acc3[ct][rg]; } }
            LDS_WAIT();
            if (lane < 16) {
                const int m = m0 + lane; const LAS float* lg = LG + lane * 36;
                float gl[4];
#pragma unroll
                for (int g = 0; g < 4; ++g) gl[g] = lg[g] * rstd + b_rg[g];
                int gi = 0; float gm = gl[0];
#pragma unroll
                for (int g = 1; g < 4; ++g) if (gl[g] > gm) { gm = gl[g]; gi = g; }
                float gs = 0.f;
#pragma unroll
                for (int g = 0; g < 4; ++g) gs += __expf(gl[g] - gm);
                const float gval = 1.f / gs;
                float el[8];
#pragma unroll
                for (int j = 0; j < 8; ++j) el[j] = lg[4 + 8 * gi + j] * rstd + b_re[8 * gi + j];
                int i0 = 0; float mx0 = el[0];
#pragma unroll
                for (int j = 1; j < 8; ++j) if (el[j] > mx0) { mx0 = el[j]; i0 = j; }
                int i1 = -1; float mx1 = -INFINITY;
#pragma unroll
                for (int j = 0; j < 8; ++j) if (j != i0 && el[j] > mx1) { mx1 = el[j]; i1 = j; }
                const float e1 = __expf(mx1 - mx0); const float g0 = gval / (1.f + e1), g1 = gval * e1 / (1.f + e1);
                const int ea = gi * 8 + i0, eb = gi * 8 + i1; P_E01[2 * m] = ea; P_E01[2 * m + 1] = eb; P_G01[2 * m] = g0; P_G01[2 * m + 1] = g1; P_RSTD[m] = rstd;
                __hip_atomic_fetch_add((LAS unsigned*)(lds + MISC_OFF) + 64 + ea, 1u, __ATOMIC_RELAXED, __HIP_MEMORY_SCOPE_WORKGROUP); __hip_atomic_fetch_add((LAS unsigned*)(lds + MISC_OFF) + 64 + eb, 1u, __ATOMIC_RELAXED, __HIP_MEMORY_SCOPE_WORKGROUP);
            }
            __syncthreads();
            if (tid < 32) P_CNT[vcu * 32 + tid] = (int)MISC[64 + tid];
        }
        SEAM(P + 6);
        if (IN(P + 7)) for (int rep_ = 0; rep_ < ((l == 0 || 7 != 5) ? NREP(7) : 1); ++rep_) {
            unsigned ldsb_ = (unsigned)(uintptr_t)lds0; asm volatile("" : "+s"(ldsb_)); LAS unsigned char* lds = (LAS unsigned char*)(uintptr_t)ldsb_; volatile LAS unsigned* MISC = (volatile LAS unsigned*)(lds + MISC_OFF); volatile LAS unsigned long long* ARGP = (volatile LAS unsigned long long*)(lds + MISC_OFF + 768); (void)MISC; int wave = wave0, G = G0, bx = bx0; asm volatile("" : "+s"(G), "+s"(bx), "+s"(wave)); const int lane = (int)__builtin_amdgcn_mbcnt_hi(~0u, __builtin_amdgcn_mbcnt_lo(~0u, 0u)); const int tid = wave * 64 + lane; const int vcu = (bx % 8) * (G / 8) + bx / 8; const int gw = vcu * 8 + wave, NGW = G * 8; (void)lane; (void)gw; (void)NGW; (void)vcu;
            GAS unsigned char* ws = (GAS unsigned char*)LDP(22); GAS float* out = (GAS float*)LDP(21); const GAS float* x_in = (const GAS float*)ARGIN(0); (void)out; (void)x_in; (void)ws;
            LAS int* cnt_all = (LAS int*)lds;
            LAS int* pre_e = (LAS int*)(lds + 32768);
            LAS int* tot_e = pre_e + 32;
            LAS int* pst = pre_e + 64;
            LAS int* eL = pre_e + 128;
            for (int i = tid; i < 256 * 32; i += 512) cnt_all[i] = P_CNT[i];
            if (tid < 256) eL[tid] = P_E01[vcu * 256 + tid];
            __syncthreads();
            if (tid < 32) { int pre = 0, tot = 0; for (int w = 0; w < 256; ++w) { const int c = cnt_all[w * 32 + tid]; pre += (w < vcu) ? c : 0; tot += c; } pre_e[tid] = pre; tot_e[tid] = tot; }
            __syncthreads();
            if (tid == 0) { int acc = 0; for (int e = 0; e < 32; ++e) { pst[e] = acc; acc += (tot_e[e] + 255) / 256 * 256; } pst[32] = acc; }
            __syncthreads();
            if (vcu == 0 && tid <= 32) P_TSTART[tid] = pst[tid] / 256;
            if (tid < 256) { const int e = eL[tid]; int r = 0; for (int a = 0; a < tid; ++a) r += (eL[a] == e) ? 1 : 0;
                const int slot = pst[e] + pre_e[e] + r; const int tok = vcu * 128 + (tid >> 1);
                P_SLOT[vcu * 256 + tid] = slot; P_TOKOF[slot] = tok; P_GATEOF[slot] = P_G01[vcu * 256 + tid]; P_RSTDOF[slot] = P_RSTD[tok]; }
            if (vcu < 32) { const int e = vcu; for (int s = pst[e] + tot_e[e] + tid; s < pst[e + 1]; s += 512) { P_TOKOF[s] = 0; P_GATEOF[s] = 0.f; P_RSTDOF[s] = 0.f; } }
            __syncthreads();
        }
        SEAM(P + 7);
        if (IN(P + 8)) for (int rep_ = 0; rep_ < ((l == 0 || 8 != 5) ? NREP(8) : 1); ++rep_) {
            unsigned ldsb_ = (unsigned)(uintptr_t)lds0; asm volatile("" : "+s"(ldsb_)); LAS unsigned char* lds = (LAS unsigned char*)(uintptr_t)ldsb_; volatile LAS unsigned* MISC = (volatile LAS unsigned*)(lds + MISC_OFF); volatile LAS unsigned long long* ARGP = (volatile LAS unsigned long long*)(lds + MISC_OFF + 768); (void)MISC; int wave = wave0, G = G0, bx = bx0; asm volatile("" : "+s"(G), "+s"(bx), "+s"(wave)); const int lane = (int)__builtin_amdgcn_mbcnt_hi(~0u, __builtin_amdgcn_mbcnt_lo(~0u, 0u)); const int tid = wave * 64 + lane; const int vcu = (bx % 8) * (G / 8) + bx / 8; const int gw = vcu * 8 + wave, NGW = G * 8; (void)lane; (void)gw; (void)NGW; (void)vcu;
            GAS unsigned char* ws = (GAS unsigned char*)LDP(22); GAS float* out = (GAS float*)LDP(21); const GAS float* x_in = (const GAS float*)ARGIN(0); (void)out; (void)x_in; (void)ws;
            volatile LAS int* TS = (volatile LAS int*)(MISC + 128);
            if (tid <= 32) TS[tid] = P_TSTART[tid];
            __syncthreads();
            MoeOrder S{G, vcu, TS, (const GAS char*)P_XN, (const GAS char*)P_WGU, 0, (size_t)1024 * 1024 * 2, (size_t)256 * 1024 * 2};
            EpiGU E{P_HH, P_RSTDOF};
            pg8::gemm_phase<EpiGU, MoeOrder, true, true>(tid, lds, DM, DM, DM, S, E, P_TOKOF);
        }
        SEAM(P + 8);
        if (IN(P + 9)) for (int rep_ = 0; rep_ < ((l == 0 || 9 != 5) ? NREP(9) : 1); ++rep_) {
            unsigned ldsb_ = (unsigned)(uintptr_t)lds0; asm volatile("" : "+s"(ldsb_)); LAS unsigned char* lds = (LAS unsigned char*)(uintptr_t)ldsb_; volatile LAS unsigned* MISC = (volatile LAS unsigned*)(lds + MISC_OFF); volatile LAS unsigned long long* ARGP = (volatile LAS unsigned long long*)(lds + MISC_OFF + 768); (void)MISC; int wave = wave0, G = G0, bx = bx0; asm volatile("" : "+s"(G), "+s"(bx), "+s"(wave)); const int lane = (int)__builtin_amdgcn_mbcnt_hi(~0u, __builtin_amdgcn_mbcnt_lo(~0u, 0u)); const int tid = wave * 64 + lane; const int vcu = (bx % 8) * (G / 8) + bx / 8; const int gw = vcu * 8 + wave, NGW = G * 8; (void)lane; (void)gw; (void)NGW; (void)vcu;
            GAS unsigned char* ws = (GAS unsigned char*)LDP(22); GAS float* out = (GAS float*)LDP(21); const GAS float* x_in = (const GAS float*)ARGIN(0); (void)out; (void)x_in; (void)ws;
            volatile LAS int* TS = (volatile LAS int*)(MISC + 128);
            if (tid <= 32) TS[tid] = P_TSTART[tid];
            __syncthreads();
            MoeOrder S{G, vcu, TS, (const GAS char*)P_HH, (const GAS char*)P_WD, (size_t)256 * 512 * 2, (size_t)1024 * 512 * 2, (size_t)256 * 512 * 2};
            EpiDown E{P_Y, P_GATEOF};
            pg8::gemm_phase<EpiDown, MoeOrder, true, false>(tid, lds, DEXP, DEXP, DEXP, S, E, nullptr);
        }
        SEAM(P + 9);
}

__global__ void __launch_bounds__(512, 2) fwd(Args args) {
    extern __shared__ __attribute__((aligned(16))) unsigned char lds_raw[];
    LAS unsigned char* lds0 = (LAS unsigned char*)lds_raw;
    const int tid0 = threadIdx.x; const int wave0 = __builtin_amdgcn_readfirstlane(tid0 >> 6);
    const int G0 = gridDim.x; const int bx0 = blockIdx.x;
    { volatile LAS unsigned* MISC = (volatile LAS unsigned*)(lds0 + MISC_OFF); const int tid = tid0;
    for (int u = tid; u < 256; u += 512) MISC[u] = 0u;
    __syncthreads();
    volatile LAS unsigned long long* ARGP = (volatile LAS unsigned long long*)(lds0 + MISC_OFF + 768);
    if (tid < 21) ARGP[tid] = (unsigned long long)args.in[tid];
    if (tid == 21) ARGP[21] = (unsigned long long)args.out;
    if (tid == 22) ARGP[22] = (unsigned long long)args.ws;
    __syncthreads(); }
#if MK_ONE_LAUNCH
    XcdBarrier bar = xcd_barrier_post((unsigned*)(args.ws + WS_CTL) + CW_BAR, (volatile LAS unsigned*)(lds0 + MISC_OFF) + 8);
#else
    XcdBarrier bar; bar.bar = nullptr; bar.x = 0; bar.st = nullptr;
#endif
    const int lo = args.ph_lo, hi_ = args.ph_hi;
    if (IN(0)) {
        const GAS int* positions = (const GAS int*)args.in[1]; GAS float* COSp = (GAS float*)(args.ws + WS_COS); GAS float* SINp = (GAS float*)(args.ws + WS_SIN);
        for (int i = bx0 * 512 + tid0; i < NTOK * 16; i += G0 * 512) { const int tk = i >> 4, fi = i & 15;
            const double inv = exp2(-(double)fi * (13.287712379549449 / 16.0)); const double ang = (double)positions[tk] * inv;
            COSp[i] = (float)cos(ang); SINp[i] = (float)sin(ang); }
    }
    layer_body<0>(lo, hi_, lds0, wave0, G0, bx0, bar);
    layer_body<1>(lo, hi_, lds0, wave0, G0, bx0, bar);
    layer_body<2>(lo, hi_, lds0, wave0, G0, bx0, bar);
}

extern "C" void kernel_launch(void* const* d_in, const int* in_sizes, int n_in, void* d_out, int out_size, void* d_ws, size_t ws_size, hipStream_t stream) {
    static int grid = 0;
    if (grid == 0) {
        if (n_in != 21 || out_size != NTOK * DM || ws_size < WS_END) { fprintf(stderr, "kernel_launch: unexpected shapes (n_in %d out %d ws %zu)\n", n_in, out_size, ws_size); grid = -1; return; }
        int dev = 0, cus = 0;
        if (hipGetDevice(&dev) != hipSuccess || hipDeviceGetAttribute(&cus, hipDeviceAttributeMultiprocessorCount, dev) != hipSuccess) { grid = -1; return; }
        if (hipFuncSetAttribute((const void*)fwd, hipFuncAttributeMaxDynamicSharedMemorySize, LDS_BYTES) != hipSuccess) { fprintf(stderr, "kernel_launch: hipFuncSetAttribute failed\n"); grid = -1; return; }
        int per_cu = 0;
        if (hipOccupancyMaxActiveBlocksPerMultiprocessor(&per_cu, (const void*)fwd, 512, LDS_BYTES) != hipSuccess || per_cu < 1) fprintf(stderr, "kernel_launch: occupancy query says %d\n", per_cu);
        (void)hipGetLastError();
        grid = cus;
        if (grid != 256) { fprintf(stderr, "kernel_launch: built for 256 CUs, got %d\n", grid); grid = -1; return; }
    }
    if (grid < 0) return;
    if (hipMemsetAsync((char*)d_ws + WS_CTL, 0, CTL_ZERO_BYTES, stream) != hipSuccess) return;
    Args a{};
    for (int i = 0; i < 21; ++i) a.in[i] = d_in[i];
    a.out = (float*)d_out; a.ws = (unsigned char*)d_ws;
#if MK_ONE_LAUNCH
    a.ph_lo = 0; a.ph_hi = 21;
    hipLaunchKernelGGL(fwd, dim3(grid), dim3(512), LDS_BYTES, stream, a);
#else
    for (int p = 0; p <= 20; ++p) { a.ph_lo = p; a.ph_hi = p + 1; hipLaunchKernelGGL(fwd, dim3(grid), dim3(512), LDS_BYTES, stream, a); }
#endif
}
```

```cpp
#include <hip/hip_runtime.h>
#include <cstdio>
#include <cstdint>

#ifndef PROBE_PHASE
#define PROBE_PHASE -1
#endif
#define NREP(k) ((PROBE_PHASE) == (k) ? 2 : 1)
#ifndef MK_ONE_LAUNCH
#define MK_ONE_LAUNCH 1
#endif

#define LAS __attribute__((address_space(3)))
#define GAS __attribute__((address_space(1)))
typedef unsigned short bf16;
typedef short bf16x8 __attribute__((ext_vector_type(8)));
typedef short s16x4 __attribute__((ext_vector_type(4)));
typedef float f32x4 __attribute__((ext_vector_type(4)));
typedef float f32x2 __attribute__((ext_vector_type(2)));
typedef float f32x16 __attribute__((ext_vector_type(16)));
typedef unsigned u32x4 __attribute__((ext_vector_type(4)));
typedef unsigned u32x2 __attribute__((ext_vector_type(2)));

constexpr int NB = 16, SEQ = 2048, DM = 1024, NTOK = NB * SEQ, NLAYER = 2;
constexpr int INW = 1960, INP = 2048;
constexpr int NEXP = 32, DEXP = 512;
constexpr int MAXSLOT = 73728;
constexpr float EPS = 1e-6f;
constexpr float LOG2E = 1.4426950408889634f;
constexpr float C2F = 0.125f * LOG2E;
constexpr float C2M = 0.10206207261596575f * LOG2E;

constexpr size_t MiB = 1u << 20, KiB = 1u << 10;
constexpr size_t WS_CTL = 0, CTL_ZERO_BYTES = 64 * KiB;
constexpr size_t WS_COS = 1 * MiB, WS_SIN = 3 * MiB;
constexpr size_t WS_SSQ = 5 * MiB;
constexpr size_t WS_FLOG = 6 * MiB;
constexpr size_t WS_E01 = 8 * MiB;
constexpr size_t WS_G01 = 8 * MiB + 256 * KiB;
constexpr size_t WS_SLOT = 8 * MiB + 512 * KiB;
constexpr size_t WS_TOKOF = 8 * MiB + 768 * KiB;
constexpr size_t WS_GATEOF = 9 * MiB + 256 * KiB;
constexpr size_t WS_CNT = 9 * MiB + 768 * KiB;
constexpr size_t WS_TSTART = 9 * MiB + 800 * KiB;
constexpr size_t WS_RSTD = 9 * MiB + 832 * KiB;
constexpr size_t WS_RSTDOF = 7 * MiB;
constexpr size_t WS_KPE = 10 * MiB;
constexpr size_t WS_KAUG = 10 * MiB + 2 * MiB;
constexpr size_t WS_WIN = 16 * MiB;
constexpr size_t WS_WUQ = 20 * MiB;
constexpr size_t WS_WUKV = 20 * MiB + 512 * KiB;
constexpr size_t WS_WOUT = 21 * MiB;
constexpr size_t WS_WGU = 24 * MiB;
constexpr size_t WS_WD = 88 * MiB;
constexpr size_t WS_XN = 120 * MiB;
constexpr size_t WS_FQKV = 184 * MiB;
constexpr size_t WS_LAT = 280 * MiB;
constexpr size_t WS_QM = 312 * MiB;
constexpr size_t WS_KVM = 360 * MiB;
constexpr size_t WS_Y = 280 * MiB;
constexpr size_t WS_BIASF = 424 * MiB;
constexpr size_t WS_NRM = 425 * MiB;
constexpr size_t WS_END = 426 * MiB;
static_assert(WS_Y + (size_t)MAXSLOT * 1024 * 2 <= WS_END, "Y fits");
static_assert(WS_FQKV + (size_t)MAXSLOT * 512 * 2 <= WS_LAT, "HH fits");

constexpr int CW_BAR = 1024;

constexpr int RING_BYTES = 147456;
constexpr int MISC_OFF = RING_BYTES;
constexpr int LDS_BYTES = RING_BYTES + 1024;

typedef __bf16 bf16x2_t __attribute__((ext_vector_type(2)));
__device__ __forceinline__ unsigned cvt_pk_bf16(float lo, float hi) { const f32x2 v = {lo, hi}; const bf16x2_t b = __builtin_convertvector(v, bf16x2_t); return __builtin_bit_cast(unsigned, b); }
__device__ __forceinline__ float bf2f(unsigned short b) { return __uint_as_float((unsigned)b << 16); }
__device__ __forceinline__ float wave_sum(float v) {
#pragma unroll
    for (int o = 1; o < 64; o <<= 1) v += __shfl_xor(v, o);
    return v;
}
#define LDS_WAIT() asm volatile("s_waitcnt lgkmcnt(0)" ::: "memory")

#define XB_TMO      128
#define XB_XCNT(j)  (256  + 64 * (j))
#define XB_XSUB(j)  (1280 + 64 * (j))
#define XB_XGEN(j)  (2304 + 64 * (j))
#define XB_TOP      3328
#define XB_TOPGEN   3392
#define XCD_BAR_WORDS 3456
#define XB_SPIN_CAP (1u << 18)
__device__ __forceinline__ unsigned xb_ld(unsigned* p)              { return __hip_atomic_load(p, __ATOMIC_RELAXED, __HIP_MEMORY_SCOPE_AGENT); }
__device__ __forceinline__ unsigned xb_add(unsigned* p, unsigned v) { return __hip_atomic_fetch_add(p, v, __ATOMIC_RELAXED, __HIP_MEMORY_SCOPE_AGENT); }
__device__ __forceinline__ unsigned xb_xcc_id() { return (unsigned)__builtin_amdgcn_s_getreg((3 << 11) | 20) & 0xFu; }
#define XB_SPIN(cond, bar) do { unsigned _sp = 0; while (cond) { __builtin_amdgcn_s_sleep(1); \
    if ((++_sp & 255u) == 0u) { if (xb_ld(&(bar)[XB_TMO])) break; if (_sp > XB_SPIN_CAP) { atomicAdd(&(bar)[XB_TMO], 1u); break; } } } } while (0)
struct XcdBarrier { unsigned* bar; unsigned x; volatile LAS unsigned* st; };
__device__ __forceinline__ XcdBarrier xcd_barrier_post(unsigned* bar, volatile LAS unsigned* st) {
    XcdBarrier b; b.bar = bar; b.x = xb_xcc_id(); b.st = st;
    if (threadIdx.x == 0) (void)xb_add(&bar[XB_XCNT(b.x)], 1u);
    return b;
}
__device__ __forceinline__ void xcd_barrier_complete(unsigned* bar, unsigned x, unsigned& nloc, unsigned& nx) {
    const unsigned G = gridDim.x * gridDim.y * gridDim.z;
    unsigned sum, cnt, mine, sp = 0u;
    for (;;) {
        sum = 0u; cnt = 0u; mine = 0u;
#pragma unroll
        for (unsigned j = 0; j < 16; ++j) { const unsigned c = xb_ld(&bar[XB_XCNT(j)]); sum += c; cnt += (c > 0u) ? 1u : 0u; mine = (j == x) ? c : mine; }
        if (sum == G) break;
        __builtin_amdgcn_s_sleep(1);
        if ((++sp & 255u) == 0u) { if (xb_ld(&bar[XB_TMO])) break; if (sp > XB_SPIN_CAP) { atomicAdd(&bar[XB_TMO], 1u); break; } }
    }
    nloc = mine > 0u ? mine : 1u; nx = cnt > 0u ? cnt : 1u;
}
__device__ __forceinline__ void xcd_barrier(const XcdBarrier& b) {
    asm volatile("s_waitcnt vmcnt(0)" ::: "memory");
    __syncthreads();
    if (threadIdx.x == 0) {
        unsigned* bar = b.bar;
        __builtin_amdgcn_s_waitcnt(0);
        unsigned nloc = b.st[0], nx = b.st[1];
        if (nloc == 0u) { xcd_barrier_complete(bar, b.x, nloc, nx); b.st[0] = nloc; b.st[1] = nx; }
        const unsigned old = xb_add(&bar[XB_XSUB(b.x)], 1u);
        const unsigned gen = old / nloc;
        if (old + 1u == (gen + 1u) * nloc) {
            __builtin_amdgcn_fence(__ATOMIC_RELEASE, "agent");
            asm volatile("s_waitcnt vmcnt(0)" ::: "memory");
            const unsigned og = xb_add(&bar[XB_TOP], 1u);
            const unsigned tg = og / nx;
            if (og + 1u == (tg + 1u) * nx) xb_add(&bar[XB_TOPGEN], 1u);
            else XB_SPIN(xb_ld(&bar[XB_TOPGEN]) == tg, bar);
            __builtin_amdgcn_fence(__ATOMIC_ACQUIRE, "agent");
            xb_add(&bar[XB_XGEN(b.x)], 1u);
            asm volatile("s_waitcnt vmcnt(0)" ::: "memory");
        } else {
            XB_SPIN(xb_ld(&bar[XB_XGEN(b.x)]) == gen, bar);
            __builtin_amdgcn_fence(__ATOMIC_ACQUIRE, "agent");
            asm volatile("s_waitcnt vmcnt(0)" ::: "memory");
        }
    }
    __syncthreads();
}

namespace pg8 {
constexpr int BM = 256, BK = 64, HALF = 128, HTB = HALF * BK * 2, STAGE_BYTES = 8 * HTB;
__host__ __device__ __forceinline__ int lds_byte(int r, int c) { const int st = (r >> 4) * 2 + (c >> 5), rr = r & 15, cc = c & 31, ob = rr * 64 + cc * 2; return st * 1024 + (ob ^ (((ob >> 9) & 1) << 5)); }
__host__ __device__ __forceinline__ void stage_rc(int b, int& R, int& C) { const int st = b / 1024, sb = b % 1024, swz = sb ^ (((sb >> 9) & 1) << 5); R = (st >> 1) * 16 + swz / 64; C = (st & 1) * 32 + (swz % 64) / 2; }
__host__ __device__ __forceinline__ int perm32(int rho) { const int n = rho >> 4, i = rho & 15; return 8 * (i >> 2) + 4 * n + (i & 3); }

struct Unit { const GAS char* a; const GAS char* b; int pm, pn, e; };

template <class Epi, class Sched, bool ALIGN_EPI, bool GATHER>
__device__ __forceinline__ void gemm_phase(const int tid, LAS unsigned char* lds, const int K, const int lda, const int ldb, const Sched& S, const Epi& E, const GAS int* __restrict__ tokof) {
    const int wid = __builtin_amdgcn_readfirstlane(tid >> 6), lane = tid & 63, wr = wid >> 2, wc = wid & 3, fr = lane & 15, fq = lane >> 4;
    const int nt = K / BK;
    unsigned voffA[2], voffB[2]; int RA[2], CA2[2];
#pragma unroll
    for (int i = 0; i < 2; ++i) { int R, C; stage_rc(tid * 16 + i * 8192, R, C); const int Rb = Epi::PERM ? ((R & ~31) + perm32(R & 31)) : R;
        voffA[i] = (unsigned)(R * lda + C) * 2u; voffB[i] = (unsigned)(Rb * ldb + C) * 2u; RA[i] = R; CA2[i] = C * 2; }
    const size_t kstep = (size_t)(BK * 2);
    const size_t hstepA = GATHER ? 0 : (size_t)HALF * lda * 2;
    const size_t hstepB = (size_t)HALF * ldb * 2;
    const unsigned ldsw = (unsigned)wid * 1024u;
    const int aoff = lds_byte(wr * 64 + fr, fq * 8), boff = lds_byte(wc * 32 + fr, fq * 8);
    unsigned gcur[2][2], gnxt[2][2];
#define PG8_SA(b, h) (((b) * 2 + (h)) * HTB)
#define PG8_SB(b, h) ((4 + (b) * 2 + (h)) * HTB)
#define PG8_STAGE(bufoff, gbase, voff) do { _Pragma("unroll") for (int _i = 0; _i < 2; ++_i) \
        __builtin_amdgcn_global_load_lds((const GAS unsigned*)((const GAS char*)(gbase) + (voff)[_i]), (LAS unsigned*)(lds + (bufoff) + ldsw + _i * 8192), 16, 0, 0); } while (0)
#define PG8_STAGE_A(bufoff, base, h, nx) do { if constexpr (GATHER) { unsigned _v[2]; _v[0] = (nx) ? gnxt[h][0] : gcur[h][0]; _v[1] = (nx) ? gnxt[h][1] : gcur[h][1]; PG8_STAGE(bufoff, base, _v); } \
        else { PG8_STAGE(bufoff, (base) + (h) * hstepA, voffA); } } while (0)
#define PG8_LDA(dst, b, h) do { _Pragma("unroll") for (int m = 0; m < 4; ++m) _Pragma("unroll") for (int k = 0; k < 2; ++k) dst[m][k] = *(const LAS bf16x8*)(lds + PG8_SA(b, h) + aoff + m * 2048 + k * 1024); } while (0)
#define PG8_LDB(dst, b, h) do { _Pragma("unroll") for (int n = 0; n < 2; ++n) _Pragma("unroll") for (int k = 0; k < 2; ++k) dst[n][k] = *(const LAS bf16x8*)(lds + PG8_SB(b, h) + boff + n * 2048 + k * 1024); } while (0)
#define PG8_MMA(ai, bj, At, Bt) do { __builtin_amdgcn_s_setprio(1); _Pragma("unroll") for (int m = 0; m < 4; ++m) _Pragma("unroll") for (int n = 0; n < 2; ++n) _Pragma("unroll") for (int k = 0; k < 2; ++k) \
        acc[ai][bj][m][n] = __builtin_amdgcn_mfma_f32_16x16x32_bf16(Bt[n][k], At[m][k], acc[ai][bj][m][n], 0, 0, 0); __builtin_amdgcn_s_setprio(0); } while (0)
#define PG8_WAIT_V(n) asm volatile("s_waitcnt vmcnt(" #n ")" ::: "memory")
#define PG8_WAIT_L(n) asm volatile("s_waitcnt lgkmcnt(" #n ")" ::: "memory")
#define PG8_BAR __builtin_amdgcn_s_barrier()
#define PG8_SCHED __builtin_amdgcn_sched_barrier(0)
#define PG8_GLOAD(dst, u) do { if constexpr (GATHER) { _Pragma("unroll") for (int _h = 0; _h < 2; ++_h) _Pragma("unroll") for (int _i = 0; _i < 2; ++_i) \
        dst[_h][_i] = (unsigned)tokof[(u).pm * BM + _h * HALF + RA[_i]] * (unsigned)(lda * 2) + (unsigned)CA2[_i]; } } while (0)
    Unit cur, nxt; int ui = 0;
    if (!S.next(0, cur)) return;
    PG8_GLOAD(gcur, cur);
    f32x4 acc[2][2][4][2];
#pragma unroll
    for (int a = 0; a < 2; ++a)
#pragma unroll
        for (int b = 0; b < 2; ++b)
#pragma unroll
            for (int m = 0; m < 4; ++m)
#pragma unroll
                for (int n = 0; n < 2; ++n) acc[a][b][m][n] = (f32x4){0.f, 0.f, 0.f, 0.f};
    bf16x8 At[4][2], B0[2][2], B1[2][2];
    const GAS char* cA = cur.a; const GAS char* cB = cur.b;
    PG8_STAGE(PG8_SB(0, 0), cB, voffB); PG8_STAGE(PG8_SB(0, 1), cB + hstepB, voffB); PG8_STAGE_A(PG8_SA(0, 0), cA, 0, false); PG8_STAGE_A(PG8_SA(0, 1), cA, 1, false);
    if (wr == 1) PG8_BAR;
    PG8_WAIT_V(2); PG8_BAR;
    PG8_STAGE(PG8_SB(1, 0), cB + kstep, voffB); PG8_STAGE_A(PG8_SA(1, 0), cA + kstep, 0, false); PG8_STAGE(PG8_SB(1, 1), cB + hstepB + kstep, voffB);
    PG8_WAIT_V(6); PG8_BAR;
    for (;;) {
        const bool has_next = S.next(ui + 1, nxt);
        if constexpr (GATHER) { if (has_next) { PG8_GLOAD(gnxt, nxt); } else { _Pragma("unroll") for (int _h = 0; _h < 2; ++_h) _Pragma("unroll") for (int _i = 0; _i < 2; ++_i) gnxt[_h][_i] = gcur[_h][_i]; } }
        const GAS char* nA = has_next ? nxt.a : cA; const GAS char* nB = has_next ? nxt.b : cB;
        for (int t = 0; t < nt; t += 2) {
            const bool last = (t == nt - 2);
            const GAS char* a1 = cA + (size_t)(t + 1) * kstep;
            const GAS char* a2 = last ? nA : cA + (size_t)(t + 2) * kstep; const GAS char* b2 = last ? nB : cB + (size_t)(t + 2) * kstep;
            const GAS char* a3 = a2 + kstep; const GAS char* b3 = b2 + kstep;
            PG8_LDB(B0, 0, 0); PG8_LDB(B1, 0, 1); PG8_SCHED; PG8_LDA(At, 0, 0); PG8_STAGE_A(PG8_SA(1, 1), a1, 1, false);
            PG8_WAIT_V(8); PG8_WAIT_L(0); PG8_BAR; PG8_MMA(0, 0, At, B0); PG8_MMA(0, 1, At, B1); PG8_BAR; PG8_SCHED;
            PG8_LDA(At, 0, 1); PG8_STAGE(PG8_SB(0, 0), b2, voffB); PG8_STAGE(PG8_SB(0, 1), b2 + hstepB, voffB); PG8_STAGE_A(PG8_SA(0, 0), a2, 0, last);
            PG8_WAIT_V(8); PG8_WAIT_L(0); PG8_BAR; PG8_MMA(1, 0, At, B0); PG8_MMA(1, 1, At, B1); PG8_BAR; PG8_SCHED;
            PG8_LDB(B0, 1, 0); PG8_LDB(B1, 1, 1); PG8_SCHED; PG8_LDA(At, 1, 0); PG8_STAGE_A(PG8_SA(0, 1), a2, 1, last);
            PG8_WAIT_V(8); PG8_WAIT_L(0); PG8_BAR; PG8_MMA(0, 0, At, B0); PG8_MMA(0, 1, At, B1); PG8_BAR; PG8_SCHED;
            PG8_LDA(At, 1, 1); PG8_STAGE(PG8_SB(1, 0), b3, voffB); PG8_STAGE(PG8_SB(1, 1), b3 + hstepB, voffB); PG8_STAGE_A(PG8_SA(1, 0), a3, 0, last);
            PG8_WAIT_V(8); PG8_WAIT_L(0); PG8_BAR; PG8_MMA(1, 0, At, B0); PG8_MMA(1, 1, At, B1); PG8_BAR; PG8_SCHED;
        }
        if constexpr (ALIGN_EPI) { if (wr == 0) PG8_BAR; }
        E(acc, cur, wr, wc, fr, fq);
        if (!has_next) break;
#pragma unroll
        for (int a = 0; a < 2; ++a)
#pragma unroll
            for (int b = 0; b < 2; ++b)
#pragma unroll
                for (int m = 0; m < 4; ++m)
#pragma unroll
                    for (int n = 0; n < 2; ++n) acc[a][b][m][n] = (f32x4){0.f, 0.f, 0.f, 0.f};
        cur = nxt; cA = nA; cB = nB; ++ui;
        if constexpr (GATHER) { _Pragma("unroll") for (int _h = 0; _h < 2; ++_h) _Pragma("unroll") for (int _i = 0; _i < 2; ++_i) gcur[_h][_i] = gnxt[_h][_i]; }
        if constexpr (ALIGN_EPI) { if (wr == 1) PG8_BAR; }
    }
    PG8_WAIT_V(0);
    if constexpr (!ALIGN_EPI) { if (wr == 0) PG8_BAR; }
    PG8_BAR;
#undef PG8_SA
#undef PG8_SB
#undef PG8_STAGE
#undef PG8_STAGE_A
#undef PG8_LDA
#undef PG8_LDB
#undef PG8_MMA
#undef PG8_WAIT_V
#undef PG8_WAIT_L
#undef PG8_BAR
#undef PG8_SCHED
#undef PG8_GLOAD
}
}
using pg8::Unit;

struct DenseOrder {
    int nM, nN, nwg, G, c; const GAS char* A; const GAS char* B; size_t aT, bT;
    __device__ __forceinline__ bool next(int i, Unit& u) const {
        const long L = (long)i * G + c; if (L >= nwg) return false;
        int wgid = (int)L; { const int q = nwg / 8, r = nwg % 8, xcd = wgid % 8, off = wgid / 8; wgid = (xcd < r ? xcd * (q + 1) : r * (q + 1) + (xcd - r) * q) + off; }
        const int nig = 8 * nN, gid = wgid / nig, fm = gid * 8, gsz = (nM - fm) < 8 ? (nM - fm) : 8;
        u.pm = fm + ((wgid % nig) % gsz); u.pn = (wgid % nig) / gsz; u.e = 0;
        u.a = A + (size_t)u.pm * aT; u.b = B + (size_t)u.pn * bT; return true;
    }
};
struct UpOrder {
    int G, c; const GAS char* LATp; const GAS char* Wq; const GAS char* Wkv;
    __device__ __forceinline__ bool next(int i, Unit& u) const {
        const int L = i * G + c; if (L >= 128 * 7) return false;
        u.pm = L / 7; const int j = L % 7; const bool kv = j >= 3; u.pn = kv ? j - 3 : j; u.e = kv ? 1 : 0;
        u.a = LATp + (size_t)u.pm * 256 * 512 * 2 + (kv ? 512 : 0);
        u.b = (kv ? Wkv : Wq) + (size_t)u.pn * 256 * 256 * 2; return true;
    }
};
struct MoeOrder {
    int G, c; const volatile LAS int* TS; const GAS char* A; const GAS char* W; size_t aT  , wE  , wT  ;
    __device__ __forceinline__ bool next(int i, Unit& u) const {
        const int L = i * G + c; const int ntile = TS[32]; if (L >= ntile * 4) return false;
        const int rt = L >> 2, ct = L & 3; int e = 0;
        for (int j = 1; j < 32; ++j) e += (TS[j] <= rt) ? 1 : 0;
        u.pm = rt; u.pn = ct; u.e = e; u.a = A + (size_t)rt * aT; u.b = W + (size_t)e * wE + (size_t)ct * wT; return true;
    }
};

__device__ __forceinline__ u32x4 pack8(f32x4 v0, f32x4 v1) { u32x4 w; w.x = cvt_pk_bf16(v0[0], v0[1]); w.y = cvt_pk_bf16(v0[2], v0[3]); w.z = cvt_pk_bf16(v1[0], v1[1]); w.w = cvt_pk_bf16(v1[2], v1[3]); return w; }

struct EpiWin {
    static constexpr bool PERM = true;
    GAS bf16* LAT_; GAS bf16* FQKV_; GAS bf16* KPE_; GAS float* FLOG_; GAS float* SSQ_; const GAS float* COS_; const GAS float* SIN_;
    __device__ __forceinline__ void operator()(const f32x4 (&acc)[2][2][4][2], const Unit& u, int wr, int wc, int fr, int fq) const {
        GAS bf16* LAT = LAT_; GAS bf16* FQKV = FQKV_; GAS bf16* KPE = KPE_; GAS float* FLOG = FLOG_; GAS float* SSQ = SSQ_; const GAS float* COS = COS_; const GAS float* SIN = SIN_;
        asm volatile("" : "+s"(LAT), "+s"(FQKV), "+s"(KPE), "+s"(FLOG), "+s"(SSQ), "+s"(COS), "+s"(SIN));
        const int row0 = u.pm * 256 + wr * 64 + fr; const int pn = u.pn;
        if (pn >= 2) {
            const int ti = pn >> 1; GAS bf16* dst = FQKV + (size_t)(ti - 1) * NTOK * 512; const int colb = (pn & 1) * 256 + wc * 32 + 8 * fq; const float sc = (ti == 1) ? C2F : 1.f;
#pragma unroll
            for (int ai = 0; ai < 2; ++ai)
#pragma unroll
                for (int m = 0; m < 4; ++m) { GAS bf16* rowp = dst + (size_t)(row0 + ai * 128 + m * 16) * 512 + colb;
#pragma unroll
                    for (int bj = 0; bj < 2; ++bj) *(GAS u32x4*)(rowp + bj * 128) = pack8(acc[ai][bj][m][0] * sc, acc[ai][bj][m][1] * sc); }
        } else {
#pragma unroll
            for (int ai = 0; ai < 2; ++ai)
#pragma unroll
                for (int m = 0; m < 4; ++m) { const int row = row0 + ai * 128 + m * 16; GAS bf16* rowp = LAT + (size_t)row * 512 + pn * 256 + wc * 32 + 8 * fq;
#pragma unroll
                    for (int bj = 0; bj < 2; ++bj) *(GAS u32x4*)(rowp + bj * 128) = pack8(acc[ai][bj][m][0], acc[ai][bj][m][1]);
                    float s = 0.f;
#pragma unroll
                    for (int n = 0; n < 2; ++n) { const f32x4 x = acc[ai][0][m][n]; s += (x[0] * x[0] + x[1] * x[1]) + (x[2] * x[2] + x[3] * x[3]); }
                    if (pn == 0) {
#pragma unroll
                        for (int n = 0; n < 2; ++n) { const f32x4 x = acc[ai][1][m][n]; s += (x[0] * x[0] + x[1] * x[1]) + (x[2] * x[2] + x[3] * x[3]); }
                    }
                    s += __shfl_xor(s, 16); s += __shfl_xor(s, 32);
                    if (fq == 0) SSQ[(size_t)row * 8 + pn * 4 + wc] = s;
                    asm volatile("" ::: "memory"); }
            if (pn == 1 && wc == 0) {
#pragma unroll
                for (int ai = 0; ai < 2; ++ai)
#pragma unroll
                    for (int m = 0; m < 4; ++m) { const int row = row0 + ai * 128 + m * 16;
                        const f32x4 c = *(const GAS f32x4*)(COS + (size_t)row * 16 + 4 * fq), sn = *(const GAS f32x4*)(SIN + (size_t)row * 16 + 4 * fq);
                        const f32x4 x1 = acc[ai][1][m][0], x2 = acc[ai][1][m][1];
                        *(GAS u32x4*)(KPE + (size_t)row * 32 + 8 * fq) = pack8(x1 * c - x2 * sn, x1 * sn + x2 * c);
                        asm volatile("" ::: "memory"); }
            }
            if (pn == 1 && wc == 1 && fq == 0) {
#pragma unroll
                for (int ai = 0; ai < 2; ++ai)
#pragma unroll
                    for (int m = 0; m < 4; ++m) { const int row = row0 + ai * 128 + m * 16; *(GAS f32x4*)(FLOG + (size_t)row * 8) = acc[ai][1][m][0]; *(GAS f32x4*)(FLOG + (size_t)row * 8 + 4) = acc[ai][1][m][1]; }
            }
        }
    }
};
struct EpiUp {
    static constexpr bool PERM = true;
    GAS bf16* QM_; GAS bf16* KVM_; const GAS float* SSQ_; const GAS float* COS_; const GAS float* SIN_;
    __device__ __forceinline__ void operator()(const f32x4 (&acc)[2][2][4][2], const Unit& u, int wr, int wc, int fr, int fq) const {
        GAS bf16* QM = QM_; GAS bf16* KVM = KVM_; const GAS float* SSQ = SSQ_; const GAS float* COS = COS_; const GAS float* SIN = SIN_;
        asm volatile("" : "+s"(QM), "+s"(KVM), "+s"(SSQ), "+s"(COS), "+s"(SIN));
        const int row0 = u.pm * 256 + wr * 64 + fr; const int pn = u.pn; const bool kv = u.e != 0;
#pragma unroll
        for (int ai = 0; ai < 2; ++ai)
#pragma unroll
            for (int m = 0; m < 4; ++m) { const int row = row0 + ai * 128 + m * 16;
                const f32x4 sq = *(const GAS f32x4*)(SSQ + (size_t)row * 8 + (kv ? 4 : 0));
                const float ss = (sq[0] + sq[1]) + (sq[2] + sq[3]);
                if (kv) {
                    const float rs = rsqrtf(ss * (1.f / 128.f) + EPS);
                    GAS bf16* rowp = KVM + (size_t)row * 1024 + pn * 256 + wc * 32 + 8 * fq;
#pragma unroll
                    for (int bj = 0; bj < 2; ++bj) *(GAS u32x4*)(rowp + bj * 128) = pack8(acc[ai][bj][m][0] * rs, acc[ai][bj][m][1] * rs);
                } else {
                    const float rs = rsqrtf(ss * (1.f / 256.f) + EPS) * C2M;
                    GAS bf16* rowp = QM + (size_t)row * 768 + pn * 256 + wc * 32 + 8 * fq;
                    const f32x4 c = *(const GAS f32x4*)(COS + (size_t)row * 16 + 4 * fq), sn = *(const GAS f32x4*)(SIN + (size_t)row * 16 + 4 * fq);
#pragma unroll
                    for (int bj = 0; bj < 2; ++bj) { f32x4 v0 = acc[ai][bj][m][0] * rs, v1 = acc[ai][bj][m][1] * rs;
                        const int G = 8 * pn + 4 * bj + wc;
                        if (G % 3 == 2) { const f32x4 x1 = v0, x2 = v1; v0 = x1 * c - x2 * sn; v1 = x1 * sn + x2 * c; }
                        *(GAS u32x4*)(rowp + bj * 128) = pack8(v0, v1); }
                }
                asm volatile("" ::: "memory");
            }
    }
};
struct EpiOut {
    static constexpr bool PERM = false;
    const GAS float* resid_; GAS float* out_;
    __device__ __forceinline__ void operator()(const f32x4 (&acc)[2][2][4][2], const Unit& u, int wr, int wc, int fr, int fq) const {
        const GAS float* resid = resid_; GAS float* out = out_; asm volatile("" : "+s"(resid), "+s"(out));
        const int row0 = u.pm * 256 + wr * 64 + fr, col0 = u.pn * 256 + wc * 32 + 4 * fq;
#pragma unroll
        for (int ai = 0; ai < 2; ++ai)
#pragma unroll
            for (int m = 0; m < 4; ++m) { const size_t off = (size_t)(row0 + ai * 128 + m * 16) * DM + col0;
#pragma unroll
                for (int bj = 0; bj < 2; ++bj)
#pragma unroll
                    for (int n = 0; n < 2; ++n) { const f32x4 r = *(const GAS f32x4*)(resid + off + bj * 128 + n * 16); *(GAS f32x4*)(out + off + bj * 128 + n * 16) = r + acc[ai][bj][m][n]; } }
    }
};
struct EpiGU {
    static constexpr bool PERM = true;
    GAS bf16* HH_; const GAS float* RS_;
    __device__ __forceinline__ void operator()(const f32x4 (&acc)[2][2][4][2], const Unit& u, int wr, int wc, int fr, int fq) const {
        GAS bf16* HH = HH_; const GAS float* RS = RS_; asm volatile("" : "+s"(HH), "+s"(RS));
        const int row0 = u.pm * 256 + wr * 64 + fr;
#pragma unroll
        for (int ai = 0; ai < 2; ++ai)
#pragma unroll
            for (int m = 0; m < 4; ++m) { GAS bf16* rowp = HH + (size_t)(row0 + ai * 128 + m * 16) * 512 + u.pn * 128 + wc * 32 + 8 * fq; const float rs = RS[row0 + ai * 128 + m * 16];
                f32x4 h[2];
#pragma unroll
                for (int n = 0; n < 2; ++n) { const f32x4 g = acc[ai][0][m][n] * rs, up = acc[ai][1][m][n] * rs;
#pragma unroll
                    for (int j = 0; j < 4; ++j) { const float sg = __builtin_amdgcn_rcpf(1.f + __builtin_amdgcn_exp2f(-g[j] * LOG2E)); h[n][j] = g[j] * sg * up[j]; } }
                *(GAS u32x4*)rowp = pack8(h[0], h[1]); }
    }
};
struct EpiDown {
    static constexpr bool PERM = true;
    GAS bf16* Y_; const GAS float* GATEOF_;
    __device__ __forceinline__ void operator()(const f32x4 (&acc)[2][2][4][2], const Unit& u, int wr, int wc, int fr, int fq) const {
        GAS bf16* Y = Y_; const GAS float* GATEOF = GATEOF_; asm volatile("" : "+s"(Y), "+s"(GATEOF));
        const int row0 = u.pm * 256 + wr * 64 + fr;
#pragma unroll
        for (int ai = 0; ai < 2; ++ai)
#pragma unroll
            for (int m = 0; m < 4; ++m) { const int row = row0 + ai * 128 + m * 16; const float g = GATEOF[row]; GAS bf16* rowp = Y + (size_t)row * 1024 + u.pn * 256 + wc * 32 + 8 * fq;
#pragma unroll
                for (int bj = 0; bj < 2; ++bj) *(GAS u32x4*)(rowp + bj * 128) = pack8(acc[ai][bj][m][0] * g, acc[ai][bj][m][1] * g); }
    }
};

namespace att {
constexpr int KSLOT = 12288, VSLOT = 8192;
constexpr int L_K = 0, L_V = 2 * KSLOT, L_BIAS = L_V + 2 * VSLOT, L_WS = L_BIAS + 8192, L_OST = L_WS + 8 * 64 * 4, L_END = L_OST + 8 * 4096;
__device__ __forceinline__ int crow(int r, int hi) { return (r & 3) + 8 * (r >> 2) + 4 * hi; }
typedef short v4i16_t __attribute__((ext_vector_type(4)));
__device__ __forceinline__ s16x4 vtr(const LAS char* p) { return __builtin_bit_cast(s16x4, __builtin_amdgcn_ds_read_tr16_b64_v4i16((LAS v4i16_t*)p)); }

constexpr int NSL = 5;
constexpr int R_K = 0, R_V = NSL * KSLOT, R_WS = R_V + NSL * VSLOT, R_OST = R_WS + 8 * 64 * 4, R_END = R_OST + 8 * 4096;
static_assert(R_END <= RING_BYTES, "attention LDS");
__device__ __forceinline__ void glds16(const GAS void* gsrc, unsigned lds_dst) { unsigned keep;
    asm volatile("s_mov_b32 %0, m0\n\ts_mov_b32 m0, %2\n\ts_nop 0\n\tglobal_load_lds_dwordx4 %1, off\n\ts_mov_b32 m0, %0" : "=&s"(keep) : "v"(gsrc), "s"(lds_dst) : "memory"); }
struct Tens2 { const GAS bf16* Q; int qp; const GAS bf16* K; int kp; const GAS bf16* KX; const GAS bf16* V; int vp; GAS bf16* O; const GAS float* BIASF; const GAS float* NRM; };
template <int MODE>
__device__ __forceinline__ void attn_unit2(const int tid, int b, int h, int qb, const Tens2& T, LAS char* shm) {
    constexpr int DKS = MODE ? 6 : 5;
    constexpr float THR = 8.f;
    const int lane = tid & 63, r32 = lane & 31, hi = lane >> 5; const int wid = __builtin_amdgcn_readfirstlane(tid >> 6);
    const long rowbase = (long)b * SEQ; const int q0 = qb * 256, qw0 = q0 + wid * 32;
    const int NT = (q0 + 256) / 64, tlast = qw0 / 64;
    int tstart = 0;
    if (MODE == 0) {
        const GAS float* bs = T.BIASF + ((long)b * 8 + h) * SEQ; const GAS float* nr = T.NRM + (b * 8 + h) * 16;
        const float Z = nr[qb] * nr[8] * 1.001f + 0.01f; const float bq0 = bs[q0];
        const float bend = bs[(lane < NT ? lane : NT - 1) * 64 + 63];
        const bool skip = (lane < NT - 4) && (2.f * Z + bend - bq0 < -40.f);
        tstart = __builtin_popcountll(__ballot(skip));
    }
    const int NTE = NT - tstart;
    const GAS bf16* Qw = T.Q + (rowbase + qw0) * T.qp + h * (MODE ? 96 : 64);
    const GAS bf16* Kh = T.K + rowbase * T.kp + h * (MODE ? 128 : 64);
    const GAS bf16* Vh = T.V + rowbase * T.vp + h * (MODE ? 128 : 64);
    LAS float* wsf = (LAS float*)(shm + R_WS) + wid * 64;
    bf16x8 qr[DKS];
    const GAS bf16* ksrc = Kh + (long)lane * T.kp + wid * 8;
    const GAS bf16* xsrc = MODE ? T.KX + (rowbase + lane) * 32 + (wid & 3) * 8 : T.KX + (((long)b * 8 + h) * SEQ + lane) * 8;
    const GAS bf16* vsrc = Vh + (long)(16 * (wid & 3) + (lane >> 2)) * T.vp + (wid >> 2) * 32 + (lane & 3) * 8;
    const int xstep = MODE ? 64 * 32 : 64 * 8;
    LAS char* kdst = shm + R_K + wid * 1024; LAS char* xdst = shm + R_K + (8 + (MODE ? (wid & 3) : 0)) * 1024; LAS char* vdst = shm + R_V + wid * 1024;
    const unsigned kdst_a = (unsigned)(uintptr_t)kdst, xdst_a = (unsigned)(uintptr_t)xdst, vdst_a = (unsigned)(uintptr_t)vdst;
#define A2_DMA(t, slot) do { \
        glds16((const GAS void*)(ksrc + (long)(t) * 64 * T.kp), (unsigned)__builtin_amdgcn_readfirstlane((int)(kdst_a + (slot) * KSLOT))); \
        glds16((const GAS void*)(xsrc + (long)(t) * xstep), (unsigned)__builtin_amdgcn_readfirstlane((int)(xdst_a + (slot) * KSLOT))); \
        glds16((const GAS void*)(vsrc + (long)(t) * 64 * T.vp), (unsigned)__builtin_amdgcn_readfirstlane((int)(vdst_a + (slot) * VSLOT))); } while (0)
    float mhat = 0.f, lrun = 0.f; f32x16 o[2]; o[0] = f32x16{}; o[1] = f32x16{}; f32x16 negm = f32x16{};
    const LAS char* vp0 = shm + R_V + ((lane >> 4) & 1) * 32 + (lane & 3) * 8 + (4 * hi + ((lane & 15) >> 2)) * 64;
    A2_DMA(NT - 1, 0); A2_DMA(NT - 2, 1); A2_DMA(NT - 3, 2);
#pragma unroll
    for (int d0 = 0; d0 < (MODE ? 6 : 4); ++d0) qr[d0] = *(const GAS bf16x8*)(Qw + (long)r32 * T.qp + d0 * 16 + hi * 8);
    if (MODE == 0) { const short one = hi ? (short)0 : (short)0x3F80; qr[DKS - 1] = (bf16x8){one, one, one, 0, 0, 0, 0, 0}; }
#pragma unroll
    for (int d0 = 0; d0 < DKS; ++d0) asm volatile("" : "+v"(qr[d0]));
#define A3_KLOAD(slot) do { const LAS char* kb_ = shm + R_K + (slot) * KSLOT + r32 * 16; _Pragma("unroll") for (int d0 = 0; d0 < DKS; ++d0) { const int off = (MODE == 0 && d0 == 4) ? 8 * 1024 : d0 * 2048 + hi * 1024; \
        kf[2 * d0] = *(const LAS bf16x8*)(kb_ + off); kf[2 * d0 + 1] = *(const LAS bf16x8*)(kb_ + off + 512); } } while (0)
#define A3_VLOAD(slot) do { const LAS char* vp_ = vp0 + (slot) * VSLOT; _Pragma("unroll") for (int q = 0; q < 8; ++q) { vlo[q] = vtr(vp_ + (q >> 2) * 4096 + (q & 3) * 1024); vhh[q] = vtr(vp_ + (q >> 2) * 4096 + (q & 3) * 1024 + 512); } } while (0)
#define A3_QK() do { c0 = negm; c1 = negm; _Pragma("unroll") for (int d0 = 0; d0 < DKS; ++d0) { c0 = __builtin_amdgcn_mfma_f32_32x32x16_bf16(kf[2 * d0], qr[d0], c0, 0, 0, 0); c1 = __builtin_amdgcn_mfma_f32_32x32x16_bf16(kf[2 * d0 + 1], qr[d0], c1, 0, 0, 0); } } while (0)
#define A3_EXP() do { float ls_ = 0.f; _Pragma("unroll") for (int r = 0; r < 16; ++r) { pp0[r] = __builtin_amdgcn_exp2f(pp0[r]); pp1[r] = __builtin_amdgcn_exp2f(pp1[r]); ls_ += pp0[r] + pp1[r]; } lrun += ls_; u32x4 w_; \
        w_.x = cvt_pk_bf16(pp0[0], pp0[1]); w_.y = cvt_pk_bf16(pp0[2], pp0[3]); w_.z = cvt_pk_bf16(pp0[4], pp0[5]); w_.w = cvt_pk_bf16(pp0[6], pp0[7]); pa[0] = __builtin_bit_cast(bf16x8, w_); \
        w_.x = cvt_pk_bf16(pp0[8], pp0[9]); w_.y = cvt_pk_bf16(pp0[10], pp0[11]); w_.z = cvt_pk_bf16(pp0[12], pp0[13]); w_.w = cvt_pk_bf16(pp0[14], pp0[15]); pa[1] = __builtin_bit_cast(bf16x8, w_); \
        w_.x = cvt_pk_bf16(pp1[0], pp1[1]); w_.y = cvt_pk_bf16(pp1[2], pp1[3]); w_.z = cvt_pk_bf16(pp1[4], pp1[5]); w_.w = cvt_pk_bf16(pp1[6], pp1[7]); pa[2] = __builtin_bit_cast(bf16x8, w_); \
        w_.x = cvt_pk_bf16(pp1[8], pp1[9]); w_.y = cvt_pk_bf16(pp1[10], pp1[11]); w_.z = cvt_pk_bf16(pp1[12], pp1[13]); w_.w = cvt_pk_bf16(pp1[14], pp1[15]); pa[3] = __builtin_bit_cast(bf16x8, w_); } while (0)
#define A3_PV() do { _Pragma("unroll") for (int d0 = 0; d0 < 2; ++d0) _Pragma("unroll") for (int k = 0; k < 4; ++k) { const s16x4 lo_ = vlo[4 * d0 + k], hh_ = vhh[4 * d0 + k]; \
        const bf16x8 vf_ = (bf16x8){lo_[0], lo_[1], lo_[2], lo_[3], hh_[0], hh_[1], hh_[2], hh_[3]}; o[d0] = __builtin_amdgcn_mfma_f32_32x32x16_bf16(pa[k], vf_, o[d0], 0, 0, 0); } } while (0)
#define A3_ROWMAX(rm) do { float a_ = fmaxf(fmaxf(c0[0], c0[1]), c1[0]), b_ = fmaxf(fmaxf(c0[2], c0[3]), c1[1]); a_ = fmaxf(fmaxf(a_, c1[2]), c1[3]); \
        _Pragma("unroll") for (int r = 4; r < 16; r += 4) { a_ = fmaxf(fmaxf(a_, c0[r]), c0[r + 1]); b_ = fmaxf(fmaxf(b_, c0[r + 2]), c0[r + 3]); a_ = fmaxf(fmaxf(a_, c1[r]), c1[r + 1]); b_ = fmaxf(fmaxf(b_, c1[r + 2]), c1[r + 3]); } \
        rm = fmaxf(a_, b_); const auto rr_ = __builtin_amdgcn_permlane32_swap(__float_as_uint(rm), __float_as_uint(rm), false, false); rm = fmaxf(__uint_as_float(rr_[0]), __uint_as_float(rr_[1])); } while (0)
    int sl = 0, sl3 = 3;
    f32x16 pp0 = f32x16{}, pp1 = f32x16{}; bool pend = false; int pslot = 0;
    for (int i = 0; i < NTE; ++i) {
        const int t = NT - 1 - i;
        { const int ahead = NTE - 1 - i;
          if (ahead >= 2) asm volatile("s_waitcnt vmcnt(6)" ::: "memory"); else if (ahead == 1) asm volatile("s_waitcnt vmcnt(3)" ::: "memory"); else asm volatile("s_waitcnt vmcnt(0)" ::: "memory"); }
        __builtin_amdgcn_s_barrier(); asm volatile("" ::: "memory");
        if (i + 3 < NTE) A2_DMA(t - 3, sl3);
        if (t <= tlast) {
            bf16x8 kf[2 * DKS]; f32x16 c0, c1; float rm;
            A3_KLOAD(sl);
            if (!pend) {
                A3_QK();
                if (MODE == 0) { const int qrel = qw0 + r32 - 64 * t;
#pragma unroll
                    for (int r = 0; r < 16; ++r) { const int kv = crow(r, hi); if (kv > qrel) c0[r] = -INFINITY; if (kv + 32 > qrel) c1[r] = -INFINITY; } }
                A3_ROWMAX(rm);
                mhat = rm;
#pragma unroll
                for (int r = 0; r < 16; ++r) { c0[r] -= rm; c1[r] -= rm; negm[r] = -mhat; }
                pend = true;
            } else {
                s16x4 vlo[8], vhh[8]; bf16x8 pa[4];
                A3_VLOAD(pslot);
                A3_QK();
                A3_EXP();
#pragma unroll
                for (int g_ = 0; g_ < 2 * DKS; ++g_) { __builtin_amdgcn_sched_group_barrier(0x008, 1, 0); __builtin_amdgcn_sched_group_barrier(0x002, 7, 0); }
                A3_PV();
                A3_ROWMAX(rm);
#pragma unroll
                for (int g_ = 0; g_ < 8; ++g_) { __builtin_amdgcn_sched_group_barrier(0x008, 1, 0); __builtin_amdgcn_sched_group_barrier(0x002, 3, 0); }
                if (__any(rm > THR)) {
                    const float dl = fmaxf(rm, 0.f); mhat += dl;
#pragma unroll
                    for (int r = 0; r < 16; ++r) { c0[r] -= dl; c1[r] -= dl; negm[r] = -mhat; }
                    const float f = __builtin_amdgcn_exp2f(-dl); lrun *= f;
                    if (hi == 0) wsf[r32] = f;
                    LDS_WAIT();
#pragma unroll
                    for (int g = 0; g < 4; ++g) { const f32x4 ff = *(const LAS f32x4*)(wsf + 8 * g + 4 * hi);
#pragma unroll
                        for (int j = 0; j < 4; ++j) { o[0][4 * g + j] *= ff[j]; o[1][4 * g + j] *= ff[j]; } }
                }
            }
            pp0 = c0; pp1 = c1; pslot = sl;
        }
        sl = (sl == NSL - 1) ? 0 : sl + 1; sl3 = (sl3 == NSL - 1) ? 0 : sl3 + 1;
    }
    if (pend) { s16x4 vlo[8], vhh[8]; bf16x8 pa[4]; A3_VLOAD(pslot); A3_EXP(); A3_PV(); }
#undef A3_KLOAD
#undef A3_VLOAD
#undef A3_QK
#undef A3_EXP
#undef A3_PV
#undef A3_ROWMAX
#undef A2_DMA
    lrun += __shfl_xor(lrun, 32);
    LDS_WAIT();
    if (hi == 0) wsf[32 + r32] = lrun;
    LDS_WAIT();
    float rli[16];
#pragma unroll
    for (int g = 0; g < 4; ++g) { const f32x4 ll = *(const LAS f32x4*)(wsf + 32 + 8 * g + 4 * hi);
#pragma unroll
        for (int j = 0; j < 4; ++j) rli[4 * g + j] = __builtin_amdgcn_rcpf(ll[j]); }
    GAS bf16* Ow = T.O + (rowbase + qw0) * 1024 + (MODE ? 0 : 512) + h * 64;
    { LAS bf16* stg = (LAS bf16*)(shm + R_OST) + wid * 2048;
#pragma unroll
      for (int r = 0; r < 16; ++r) { const int orow = crow(r, hi);
#pragma unroll
          for (int d0 = 0; d0 < 2; ++d0) stg[orow * 64 + d0 * 32 + r32] = (bf16)(cvt_pk_bf16(o[d0][r] * rli[r], 0.f) & 0xffffu); }
      LDS_WAIT();
#pragma unroll
      for (int i = 0; i < 4; ++i) { const int row = i * 8 + (lane >> 3), ch = lane & 7; const u32x4 v = *(const LAS u32x4*)(stg + row * 64 + ch * 8); *(GAS u32x4*)(Ow + (long)row * 1024 + ch * 8) = v; } }
    LDS_WAIT(); __builtin_amdgcn_s_barrier(); asm volatile("" ::: "memory");
}
}

struct Args { const void* in[21]; float* out; unsigned char* ws; int ph_lo, ph_hi; };

__device__ __forceinline__ void tr_item(const GAS float* __restrict__ W, int ldw, int Ksrc, const GAS float* __restrict__ gain, GAS bf16* __restrict__ WT, int ldk, int k0, int n0, int srccol, LAS float* scr, int lane) {
#pragma unroll 8
    for (int i = 0; i < 32; ++i) { const int kk = 2 * i + (lane >> 5); const int k = k0 + kk;
        float v = 0.f; if (srccol >= 0 && k < Ksrc) { v = W[(size_t)k * ldw + srccol]; if (gain) v *= gain[k]; }
        scr[kk * 33 + (lane & 31)] = v; }
    LDS_WAIT(); asm volatile("" ::: "memory");
    const int c = lane & 7;
#pragma unroll
    for (int j = 0; j < 4; ++j) { const int n = (lane >> 3) + 8 * j; const LAS float* s = scr + (8 * c) * 33 + n;
        u32x4 o; o.x = cvt_pk_bf16(s[0 * 33], s[1 * 33]); o.y = cvt_pk_bf16(s[2 * 33], s[3 * 33]); o.z = cvt_pk_bf16(s[4 * 33], s[5 * 33]); o.w = cvt_pk_bf16(s[6 * 33], s[7 * 33]);
        *(GAS u32x4*)(WT + (size_t)(n0 + n) * ldk + k0 + 8 * c) = o; }
    LDS_WAIT(); asm volatile("" ::: "memory");
}
__device__ __forceinline__ void tr_item64(const GAS float* __restrict__ W, int ldw, const GAS float* __restrict__ gain, GAS bf16* __restrict__ WT, int ldk, int k0, int n0src, int n0dst, LAS float* scr, int lane) {
    const int rr = lane >> 4, c4 = (lane & 15) * 4;
    f32x4 v[16];
#pragma unroll
    for (int i = 0; i < 16; ++i) v[i] = *(const GAS f32x4*)(W + (size_t)(k0 + 4 * i + rr) * ldw + n0src + c4);
#pragma unroll
    for (int i = 0; i < 16; ++i) { const int k = 4 * i + rr; const float g = gain ? gain[k0 + k] : 1.f; LAS float* d = scr + k * 65 + c4;
        d[0] = v[i][0] * g; d[1] = v[i][1] * g; d[2] = v[i][2] * g; d[3] = v[i][3] * g; }
    LDS_WAIT(); asm volatile("" ::: "memory");
    const int kc = lane & 7;
#pragma unroll
    for (int j = 0; j < 8; ++j) { const int n = (lane >> 3) + 8 * j; const LAS float* sp = scr + (8 * kc) * 65 + n;
        u32x4 o; o.x = cvt_pk_bf16(sp[0 * 65], sp[1 * 65]); o.y = cvt_pk_bf16(sp[2 * 65], sp[3 * 65]); o.z = cvt_pk_bf16(sp[4 * 65], sp[5 * 65]); o.w = cvt_pk_bf16(sp[6 * 65], sp[7 * 65]);
        *(GAS u32x4*)(WT + (size_t)(n0dst + n) * ldk + k0 + 8 * kc) = o; }
    LDS_WAIT(); asm volatile("" ::: "memory");
}
__device__ __forceinline__ int rope_dim(int p) { const int a = p >> 3, j = p & 7; return j < 4 ? 4 * a + j : 16 + 4 * a + (j - 4); }

#define LDP(i) ((void*)((((unsigned long long)(unsigned)__builtin_amdgcn_readfirstlane((int)(ARGP[i] >> 32))) << 32) | (unsigned long long)(unsigned)__builtin_amdgcn_readfirstlane((int)(unsigned)ARGP[i])))
#define ARGIN(i) ((const void*)LDP(i))
#define P_COS ((GAS float*)(ws + WS_COS))
#define P_SIN ((GAS float*)(ws + WS_SIN))
#define P_SSQ ((GAS float*)(ws + WS_SSQ))
#define P_FLOG ((GAS float*)(ws + WS_FLOG))
#define P_E01 ((GAS int*)(ws + WS_E01))
#define P_G01 ((GAS float*)(ws + WS_G01))
#define P_SLOT ((GAS int*)(ws + WS_SLOT))
#define P_TOKOF ((GAS int*)(ws + WS_TOKOF))
#define P_GATEOF ((GAS float*)(ws + WS_GATEOF))
#define P_CNT ((GAS int*)(ws + WS_CNT))
#define P_TSTART ((GAS int*)(ws + WS_TSTART))
#define P_RSTD ((GAS float*)(ws + WS_RSTD))
#define P_RSTDOF ((GAS float*)(ws + WS_RSTDOF))
#define P_KPE ((GAS bf16*)(ws + WS_KPE))
#define P_KAUG ((GAS bf16*)(ws + WS_KAUG))
#define P_BIASF ((GAS float*)(ws + WS_BIASF))
#define P_NRM ((GAS float*)(ws + WS_NRM))
#define P_WIN ((GAS bf16*)(ws + WS_WIN))
#define P_WUQ ((GAS bf16*)(ws + WS_WUQ))
#define P_WUKV ((GAS bf16*)(ws + WS_WUKV))
#define P_WOUT ((GAS bf16*)(ws + WS_WOUT))
#define P_WGU ((GAS bf16*)(ws + WS_WGU))
#define P_WD ((GAS bf16*)(ws + WS_WD))
#define P_XN ((GAS bf16*)(ws + WS_XN))
#define P_FQKV ((GAS bf16*)(ws + WS_FQKV))
#define P_HH ((GAS bf16*)(ws + WS_FQKV))
#define P_LAT ((GAS bf16*)(ws + WS_LAT))
#define P_QM ((GAS bf16*)(ws + WS_QM))
#define P_KVM ((GAS bf16*)(ws + WS_KVM))
#define P_Y ((GAS bf16*)(ws + WS_Y))
#define IN(k) (lo <= (k) && (k) < hi_)
#if MK_ONE_LAUNCH
#define GRID_BAR() xcd_barrier(bar)
#else
#define GRID_BAR() do {} while (0)
#endif
#define SEAM(k) do { if (IN(k) && IN((k) + 1)) GRID_BAR(); } while (0)
template <int l>
__device__ __forceinline__ void layer_body(const int lo, const int hi_, LAS unsigned char* lds0, const int wave0, const int G0, const int bx0, const XcdBarrier& bar) {
        const int P = 10 * l;
        if (IN(P)) for (int rep_ = 0; rep_ < (l == 0 ? NREP(0) : 1); ++rep_) {
            unsigned ldsb_ = (unsigned)(uintptr_t)lds0; asm volatile("" : "+s"(ldsb_)); LAS unsigned char* lds = (LAS unsigned char*)(uintptr_t)ldsb_; volatile LAS unsigned* MISC = (volatile LAS unsigned*)(lds + MISC_OFF); volatile LAS unsigned long long* ARGP = (volatile LAS unsigned long long*)(lds + MISC_OFF + 768); (void)MISC; int wave = wave0, G = G0, bx = bx0; asm volatile("" : "+s"(G), "+s"(bx), "+s"(wave)); const int lane = (int)__builtin_amdgcn_mbcnt_hi(~0u, __builtin_amdgcn_mbcnt_lo(~0u, 0u)); const int tid = wave * 64 + lane; const int vcu = (bx % 8) * (G / 8) + bx / 8; const int gw = vcu * 8 + wave, NGW = G * 8; (void)lane; (void)gw; (void)NGW; (void)vcu;
            GAS unsigned char* ws = (GAS unsigned char*)LDP(22); GAS float* out = (GAS float*)LDP(21); const GAS float* x_in = (const GAS float*)ARGIN(0); const GAS int* positions = (const GAS int*)ARGIN(1);
            if (l < NLAYER) {
                LAS float* scr = (LAS float*)(lds + wave * 16640);
                const GAS float* attn_norm = (const GAS float*)ARGIN(2) + (size_t)l * DM; const GAS float* w_in = (const GAS float*)ARGIN(3) + (size_t)l * DM * INW;
                const GAS float* q_norm = (const GAS float*)ARGIN(5) + (size_t)l * 256; const GAS float* w_uq = (const GAS float*)ARGIN(6) + (size_t)l * 256 * 768;
                const GAS float* kv_norm = (const GAS float*)ARGIN(7) + (size_t)l * 128; const GAS float* w_ukv = (const GAS float*)ARGIN(8) + (size_t)l * 128 * 1024;
                const GAS float* mla_on = (const GAS float*)ARGIN(9) + (size_t)l * 512; const GAS float* fox_on = (const GAS float*)ARGIN(10) + (size_t)l * 512; const GAS float* w_out = (const GAS float*)ARGIN(11) + (size_t)l * DM * DM;
                const GAS float* ffn_norm = (const GAS float*)ARGIN(12) + (size_t)l * DM;
                const GAS float* w_gate = (const GAS float*)ARGIN(17) + (size_t)l * NEXP * DM * DEXP; const GAS float* w_up = (const GAS float*)ARGIN(18) + (size_t)l * NEXP * DM * DEXP; const GAS float* w_down = (const GAS float*)ARGIN(19) + (size_t)l * NEXP * DEXP * DM;
                constexpr int I_IN = 16 * 64, I_UQ = 4 * 24, I_UKV = 4 * 32;
                constexpr int NITEMS = I_IN + I_UQ + I_UKV;
                for (int it = gw; it < NITEMS; it += NGW) {
                    int r = it; const int j = lane & 31;
                    if (r < I_IN) { const int kb = r / 64, nb = r % 64; const int n = nb * 32 + j; int sc;
                        if (n < 384) sc = n; else if (n < 416) sc = 384 + rope_dim(n - 384); else if (n < 424) sc = 1952 + (n - 416); else if (n < 512) sc = -1; else sc = 416 + (n - 512);
                        tr_item(w_in, INW, DM, attn_norm, P_WIN, DM, kb * 64, nb * 32, sc, scr, lane); continue; } r -= I_IN;
                    if (r < I_UQ) { const int kb = r / 24, nb = r % 24; const int n = nb * 32 + j; const int hh = n / 96, d = n % 96; const int sc = d < 64 ? n : hh * 96 + 64 + rope_dim(d - 64);
                        tr_item(w_uq, 768, 256, q_norm, P_WUQ, 256, kb * 64, nb * 32, sc, scr, lane); continue; } r -= I_UQ;
                    { const int kb = r / 32, nb = r % 32; tr_item(w_ukv, 1024, 128, kv_norm, P_WUKV, 256, kb * 64, nb * 32, nb * 32 + j, scr, lane); }
                }
                LAS float* scr64 = (LAS float*)(lds + wave * 16640);
                constexpr int J_OUT = 16 * 16, J_GU = 16 * 16 * NEXP, J_D = 8 * 16 * NEXP;
                for (int it = gw; it < J_OUT + J_GU + J_D; it += NGW) {
                    int r = it;
                    if (r < J_OUT) { const int kb = r / 16, nb = r % 16; const GAS float* gn = kb < 8 ? mla_on : fox_on - 512; tr_item64(w_out, DM, gn, P_WOUT, DM, kb * 64, nb * 64, nb * 64, scr64, lane); continue; } r -= J_OUT;
                    if (r < J_GU) { const int e = r / 256, q = r % 256, kb = q / 16, nb = q % 16; const int n0 = nb * 64; const int ct = n0 >> 8, which = (n0 >> 7) & 1, jj = n0 & 127;
                        const GAS float* src = (which ? w_up : w_gate) + (size_t)e * DM * DEXP;
                        tr_item64(src, DEXP, ffn_norm, P_WGU + (size_t)e * 1024 * 1024, DM, kb * 64, ct * 128 + jj, n0, scr64, lane); continue; } r -= J_GU;
                    { const int e = r / 128, q = r % 128, kb = q / 16, nb = q % 16;
                        tr_item64(w_down + (size_t)e * DEXP * DM, DM, nullptr, P_WD + (size_t)e * 1024 * 512, DEXP, kb * 64, nb * 64, nb * 64, scr64, lane); }
                }
            }
            const GAS float* fin = (const GAS float*)ARGIN(20);
            for (int m = gw; m < NTOK; m += NGW) {
                const GAS float* xr = (l == 0 ? x_in : out) + (size_t)m * DM;
                f32x4 v[4];
#pragma unroll
                for (int j = 0; j < 4; ++j) v[j] = *(const GAS f32x4*)(xr + 4 * lane + 256 * j);
                if (l > 0) {
                    const int s0 = P_SLOT[2 * m], s1 = P_SLOT[2 * m + 1];
#pragma unroll
                    for (int j = 0; j < 4; ++j) { const u32x2 a = *(const GAS u32x2*)(P_Y + (size_t)s0 * 1024 + 4 * lane + 256 * j), c = *(const GAS u32x2*)(P_Y + (size_t)s1 * 1024 + 4 * lane + 256 * j);
                        v[j][0] += __uint_as_float(a.x << 16) + __uint_as_float(c.x << 16); v[j][1] += __uint_as_float(a.x & 0xffff0000u) + __uint_as_float(c.x & 0xffff0000u);
                        v[j][2] += __uint_as_float(a.y << 16) + __uint_as_float(c.y << 16); v[j][3] += __uint_as_float(a.y & 0xffff0000u) + __uint_as_float(c.y & 0xffff0000u); }
                }
                float s = 0.f;
#pragma unroll
                for (int j = 0; j < 4; ++j) s += (v[j][0] * v[j][0] + v[j][1] * v[j][1]) + (v[j][2] * v[j][2] + v[j][3] * v[j][3]);
                const float rstd = rsqrtf(wave_sum(s) * (1.f / DM) + EPS);
                if (l < NLAYER) {
                    if (l > 0) {
#pragma unroll
                        for (int j = 0; j < 4; ++j) *(GAS f32x4*)(out + (size_t)m * DM + 4 * lane + 256 * j) = v[j];
                    }
#pragma unroll
                    for (int j = 0; j < 4; ++j) { u32x2 w; w.x = cvt_pk_bf16(v[j][0] * rstd, v[j][1] * rstd); w.y = cvt_pk_bf16(v[j][2] * rstd, v[j][3] * rstd); *(GAS u32x2*)(P_XN + (size_t)m * DM + 4 * lane + 256 * j) = w; }
                } else {
#pragma unroll
                    for (int j = 0; j < 4; ++j) { const f32x4 g = *(const GAS f32x4*)(fin + 4 * lane + 256 * j); *(GAS f32x4*)(out + (size_t)m * DM + 4 * lane + 256 * j) = v[j] * rstd * g; }
                }
            }
        }
        if constexpr (l == NLAYER) return;
        SEAM(P);
        if (IN(P + 1)) for (int rep_ = 0; rep_ < ((l == 0 || 1 != 5) ? NREP(1) : 1); ++rep_) {
            unsigned ldsb_ = (unsigned)(uintptr_t)lds0; asm volatile("" : "+s"(ldsb_)); LAS unsigned char* lds = (LAS unsigned char*)(uintptr_t)ldsb_; volatile LAS unsigned* MISC = (volatile LAS unsigned*)(lds + MISC_OFF); volatile LAS unsigned long long* ARGP = (volatile LAS unsigned long long*)(lds + MISC_OFF + 768); (void)MISC; int wave = wave0, G = G0, bx = bx0; asm volatile("" : "+s"(G), "+s"(bx), "+s"(wave)); const int lane = (int)__builtin_amdgcn_mbcnt_hi(~0u, __builtin_amdgcn_mbcnt_lo(~0u, 0u)); const int tid = wave * 64 + lane; const int vcu = (bx % 8) * (G / 8) + bx / 8; const int gw = vcu * 8 + wave, NGW = G * 8; (void)lane; (void)gw; (void)NGW; (void)vcu;
            GAS unsigned char* ws = (GAS unsigned char*)LDP(22); GAS float* out = (GAS float*)LDP(21); const GAS float* x_in = (const GAS float*)ARGIN(0); (void)out; (void)x_in; (void)ws;
            DenseOrder S{NTOK / 256, INP / 256, (NTOK / 256) * (INP / 256), G, bx, (const GAS char*)P_XN, (const GAS char*)P_WIN, (size_t)256 * DM * 2, (size_t)256 * DM * 2};
            EpiWin E{P_LAT, P_FQKV, P_KPE, P_FLOG, P_SSQ, P_COS, P_SIN};
            pg8::gemm_phase<EpiWin, DenseOrder, true, false>(tid, lds, DM, DM, DM, S, E, nullptr);
        }
        SEAM(P + 1);
        if (IN(P + 2)) for (int rep_ = 0; rep_ < ((l == 0 || 2 != 5) ? NREP(2) : 1); ++rep_) {
            unsigned ldsb_ = (unsigned)(uintptr_t)lds0; asm volatile("" : "+s"(ldsb_)); LAS unsigned char* lds = (LAS unsigned char*)(uintptr_t)ldsb_; volatile LAS unsigned* MISC = (volatile LAS unsigned*)(lds + MISC_OFF); volatile LAS unsigned long long* ARGP = (volatile LAS unsigned long long*)(lds + MISC_OFF + 768); (void)MISC; int wave = wave0, G = G0, bx = bx0; asm volatile("" : "+s"(G), "+s"(bx), "+s"(wave)); const int lane = (int)__builtin_amdgcn_mbcnt_hi(~0u, __builtin_amdgcn_mbcnt_lo(~0u, 0u)); const int tid = wave * 64 + lane; const int vcu = (bx % 8) * (G / 8) + bx / 8; const int gw = vcu * 8 + wave, NGW = G * 8; (void)lane; (void)gw; (void)NGW; (void)vcu;
            GAS unsigned char* ws = (GAS unsigned char*)LDP(22); GAS float* out = (GAS float*)LDP(21); const GAS float* x_in = (const GAS float*)ARGIN(0); (void)out; (void)x_in; (void)ws;
            if (vcu < 128) {
                const int b = vcu >> 3, h = vcu & 7; const float bf = ((const GAS float*)ARGIN(4))[l * 8 + h];
                const GAS float* fl = P_FLOG + ((size_t)b * SEQ + 4 * tid) * 8 + h;
                float lf[4];
#pragma unroll
                for (int e = 0; e < 4; ++e) { const float f = fl[e * 8] + bf; lf[e] = fminf(f, 0.f) - log1pf(expf(-fabsf(f))); }
                const double s4 = ((double)lf[0] + (double)lf[1]) + ((double)lf[2] + (double)lf[3]);
                double incl = s4;
#pragma unroll
                for (int o = 1; o < 64; o <<= 1) { const double t = __shfl_up(incl, o); if (lane >= o) incl += t; }
                LAS double* wtot = (LAS double*)lds;
                if (lane == 63) wtot[wave] = incl;
                __syncthreads();
                double c = incl - s4;
                for (int w = 0; w < wave; ++w) c += wtot[w];
                GAS u32x4* ka = (GAS u32x4*)(P_KAUG + (((size_t)b * 8 + h) * SEQ + 4 * tid) * 8);
#pragma unroll
                for (int e = 0; e < 4; ++e) { c += (double)lf[e]; const float x = (float)(-c * 1.4426950408889634);
                    const unsigned h16 = cvt_pk_bf16(x, 0.f) & 0xffffu; const float r1 = x - __uint_as_float(h16 << 16); const unsigned m16 = cvt_pk_bf16(r1, 0.f) & 0xffffu; const float r2 = r1 - __uint_as_float(m16 << 16); const unsigned l16 = cvt_pk_bf16(r2, 0.f) & 0xffffu;
                    ka[e] = (u32x4){h16 | (m16 << 16), l16, 0u, 0u}; P_BIASF[((size_t)b * 8 + h) * SEQ + 4 * tid + e] = x; }
                float qn = 0.f, kn = 0.f;
                { const GAS bf16* fqp = P_FQKV + ((size_t)b * SEQ + 4 * tid) * 512 + h * 64; const GAS bf16* fkp = fqp + (size_t)NTOK * 512;
#pragma unroll
                  for (int e = 0; e < 4; ++e) { float sq = 0.f, sk = 0.f;
#pragma unroll
                      for (int c8 = 0; c8 < 8; ++c8) { const u32x4 a = *(const GAS u32x4*)(fqp + e * 512 + c8 * 8), k4 = *(const GAS u32x4*)(fkp + e * 512 + c8 * 8);
#pragma unroll
                          for (int j = 0; j < 4; ++j) { const float a0 = __uint_as_float(a[j] << 16), a1 = __uint_as_float(a[j] & 0xffff0000u), k0 = __uint_as_float(k4[j] << 16), k1 = __uint_as_float(k4[j] & 0xffff0000u);
                              sq += a0 * a0 + a1 * a1; sk += k0 * k0 + k1 * k1; } }
                      qn = fmaxf(qn, sq); kn = fmaxf(kn, sk); } }
#pragma unroll
                for (int o = 1; o < 64; o <<= 1) { qn = fmaxf(qn, __shfl_xor(qn, o)); kn = fmaxf(kn, __shfl_xor(kn, o)); }
                LAS float* knw = (LAS float*)(lds + 256);
                if (lane == 0) { P_NRM[(b * 8 + h) * 16 + wave] = sqrtf(qn); knw[wave] = kn; }
                __syncthreads();
                if (tid == 0) { float m = knw[0]; for (int w = 1; w < 8; ++w) m = fmaxf(m, knw[w]); P_NRM[(b * 8 + h) * 16 + 8] = sqrtf(m); }
                __syncthreads();
            }
            UpOrder S{G, vcu, (const GAS char*)P_LAT, (const GAS char*)P_WUQ, (const GAS char*)P_WUKV};
            EpiUp E{P_QM, P_KVM, P_SSQ, P_COS, P_SIN};
            pg8::gemm_phase<EpiUp, UpOrder, true, false>(tid, lds, 256, 512, 256, S, E, nullptr);
        }
        SEAM(P + 2);
        if (IN(P + 3)) for (int rep_ = 0; rep_ < ((l == 0 || 3 != 5) ? NREP(3) : 1); ++rep_) {
            unsigned ldsb_ = (unsigned)(uintptr_t)lds0; asm volatile("" : "+s"(ldsb_)); LAS unsigned char* lds = (LAS unsigned char*)(uintptr_t)ldsb_; volatile LAS unsigned* MISC = (volatile LAS unsigned*)(lds + MISC_OFF); volatile LAS unsigned long long* ARGP = (volatile LAS unsigned long long*)(lds + MISC_OFF + 768); (void)MISC; int wave = wave0, G = G0, bx = bx0; asm volatile("" : "+s"(G), "+s"(bx), "+s"(wave)); const int lane = (int)__builtin_amdgcn_mbcnt_hi(~0u, __builtin_amdgcn_mbcnt_lo(~0u, 0u)); const int tid = wave * 64 + lane; const int vcu = (bx % 8) * (G / 8) + bx / 8; const int gw = vcu * 8 + wave, NGW = G * 8; (void)lane; (void)gw; (void)NGW; (void)vcu;
            GAS unsigned char* ws = (GAS unsigned char*)LDP(22); GAS float* out = (GAS float*)LDP(21); const GAS float* x_in = (const GAS float*)ARGIN(0); (void)out; (void)x_in; (void)ws;
            GAS bf16* O = P_XN;
            const int b = vcu >> 4, hh = (vcu & 15) >> 1, sub = vcu & 1;
            const att::Tens2 TM{P_QM, 768, P_KVM, 1024, P_KPE, P_KVM + 64, 1024, O, nullptr, nullptr};
            const att::Tens2 TF{P_FQKV, 512, P_FQKV + (size_t)NTOK * 512, 512, P_KAUG, P_FQKV + (size_t)2 * NTOK * 512, 512, O, P_BIASF, P_NRM};
            for (int i = 0; i < 4; ++i) { const int s = 2 * sub + (i >> 1); const int qb = (i & 1) ? 7 - s : s; att::attn_unit2<1>(tid, b, hh, qb, TM, (LAS char*)lds); }
            for (int i = 0; i < 4; ++i) { const int s = 2 * sub + (i >> 1); const int qb = (i & 1) ? 7 - s : s; att::attn_unit2<0>(tid, b, hh, qb, TF, (LAS char*)lds); }
        }
        SEAM(P + 3);
        if (IN(P + 4)) for (int rep_ = 0; rep_ < ((l == 0 || 4 != 5) ? NREP(4) : 1); ++rep_) {
            unsigned ldsb_ = (unsigned)(uintptr_t)lds0; asm volatile("" : "+s"(ldsb_)); LAS unsigned char* lds = (LAS unsigned char*)(uintptr_t)ldsb_; volatile LAS unsigned* MISC = (volatile LAS unsigned*)(lds + MISC_OFF); volatile LAS unsigned long long* ARGP = (volatile LAS unsigned long long*)(lds + MISC_OFF + 768); (void)MISC; int wave = wave0, G = G0, bx = bx0; asm volatile("" : "+s"(G), "+s"(bx), "+s"(wave)); const int lane = (int)__builtin_amdgcn_mbcnt_hi(~0u, __builtin_amdgcn_mbcnt_lo(~0u, 0u)); const int tid = wave * 64 + lane; const int vcu = (bx % 8) * (G / 8) + bx / 8; const int gw = vcu * 8 + wave, NGW = G * 8; (void)lane; (void)gw; (void)NGW; (void)vcu;
            GAS unsigned char* ws = (GAS unsigned char*)LDP(22); GAS float* out = (GAS float*)LDP(21); const GAS float* x_in = (const GAS float*)ARGIN(0); (void)out; (void)x_in; (void)ws;
            GAS bf16* O = P_XN;
            for (int m = gw; m < NTOK; m += NGW) {
                GAS bf16* orow = O + (size_t)m * DM;
                const u32x4 a = *(const GAS u32x4*)(orow + 8 * lane), c = *(const GAS u32x4*)(orow + 512 + 8 * lane);
                float fa[8], fc[8];
#pragma unroll
                for (int j = 0; j < 4; ++j) { fa[2 * j] = __uint_as_float(a[j] << 16); fa[2 * j + 1] = __uint_as_float(a[j] & 0xffff0000u); fc[2 * j] = __uint_as_float(c[j] << 16); fc[2 * j + 1] = __uint_as_float(c[j] & 0xffff0000u); }
                float sa = 0.f, sc = 0.f;
#pragma unroll
                for (int j = 0; j < 8; ++j) { sa += fa[j] * fa[j]; sc += fc[j] * fc[j]; }
                const float ra = rsqrtf(wave_sum(sa) * (1.f / 512.f) + EPS), rc = rsqrtf(wave_sum(sc) * (1.f / 512.f) + EPS);
                u32x4 oa, oc;
#pragma unroll
                for (int j = 0; j < 4; ++j) { oa[j] = cvt_pk_bf16(fa[2 * j] * ra, fa[2 * j + 1] * ra); oc[j] = cvt_pk_bf16(fc[2 * j] * rc, fc[2 * j + 1] * rc); }
                *(GAS u32x4*)(orow + 8 * lane) = oa; *(GAS u32x4*)(orow + 512 + 8 * lane) = oc;
            }
        }
        SEAM(P + 4);
        if (IN(P + 5)) for (int rep_ = 0; rep_ < ((l == 0 || 5 != 5) ? NREP(5) : 1); ++rep_) {
            unsigned ldsb_ = (unsigned)(uintptr_t)lds0; asm volatile("" : "+s"(ldsb_)); LAS unsigned char* lds = (LAS unsigned char*)(uintptr_t)ldsb_; volatile LAS unsigned* MISC = (volatile LAS unsigned*)(lds + MISC_OFF); volatile LAS unsigned long long* ARGP = (volatile LAS unsigned long long*)(lds + MISC_OFF + 768); (void)MISC; int wave = wave0, G = G0, bx = bx0; asm volatile("" : "+s"(G), "+s"(bx), "+s"(wave)); const int lane = (int)__builtin_amdgcn_mbcnt_hi(~0u, __builtin_amdgcn_mbcnt_lo(~0u, 0u)); const int tid = wave * 64 + lane; const int vcu = (bx % 8) * (G / 8) + bx / 8; const int gw = vcu * 8 + wave, NGW = G * 8; (void)lane; (void)gw; (void)NGW; (void)vcu;
            GAS unsigned char* ws = (GAS unsigned char*)LDP(22); GAS float* out = (GAS float*)LDP(21); const GAS float* x_in = (const GAS float*)ARGIN(0); (void)out; (void)x_in; (void)ws;
            DenseOrder S{NTOK / 256, DM / 256, (NTOK / 256) * (DM / 256), G, bx, (const GAS char*)P_XN, (const GAS char*)P_WOUT, (size_t)256 * DM * 2, (size_t)256 * DM * 2};
            EpiOut E{l == 0 ? x_in : out, out};
            pg8::gemm_phase<EpiOut, DenseOrder, true, false>(tid, lds, DM, DM, DM, S, E, nullptr);
        }
        SEAM(P + 5);
        if (IN(P + 6)) for (int rep_ = 0; rep_ < ((l == 0 || 6 != 5) ? NREP(6) : 1); ++rep_) {
            unsigned ldsb_ = (unsigned)(uintptr_t)lds0; asm volatile("" : "+s"(ldsb_)); LAS unsigned char* lds = (LAS unsigned char*)(uintptr_t)ldsb_; volatile LAS unsigned* MISC = (volatile LAS unsigned*)(lds + MISC_OFF); volatile LAS unsigned long long* ARGP = (volatile LAS unsigned long long*)(lds + MISC_OFF + 768); (void)MISC; int wave = wave0, G = G0, bx = bx0; asm volatile("" : "+s"(G), "+s"(bx), "+s"(wave)); const int lane = (int)__builtin_amdgcn_mbcnt_hi(~0u, __builtin_amdgcn_mbcnt_lo(~0u, 0u)); const int tid = wave * 64 + lane; const int vcu = (bx % 8) * (G / 8) + bx / 8; const int gw = vcu * 8 + wave, NGW = G * 8; (void)lane; (void)gw; (void)NGW; (void)vcu;
            GAS unsigned char* ws = (GAS unsigned char*)LDP(22); GAS float* out = (GAS float*)LDP(21); const GAS float* x_in = (const GAS float*)ARGIN(0); (void)out; (void)x_in; (void)ws;
            GAS bf16* H2 = P_XN;
            LAS float* WRh = (LAS float*)lds;
            LAS float* LG = (LAS float*)(lds + 73728) + wave * 576;
            const GAS float* ffn_norm = (const GAS float*)ARGIN(12) + (size_t)l * DM; const GAS float* w_rg = (const GAS float*)ARGIN(13) + (size_t)l * DM * 4; const GAS float* b_rg = (const GAS float*)ARGIN(14) + l * 4;
            const GAS float* w_re = (const GAS float*)ARGIN(15) + (size_t)l * DM * 32; const GAS float* b_re = (const GAS float*)ARGIN(16) + l * 32;
            if (tid < 32) MISC[64 + tid] = 0u;
            const int r16 = lane & 15, g4 = lane >> 4;
            const int m0 = vcu * 128 + wave * 16;
            const GAS float* xrow = out + (size_t)(m0 + r16) * DM + 4 * g4;
            GAS bf16* hrow = H2 + (size_t)(m0 + r16) * DM + 4 * g4;
            f32x4 acc3[3]; acc3[0] = (f32x4){0.f, 0.f, 0.f, 0.f}; acc3[1] = acc3[0]; acc3[2] = acc3[0];
            float ssq = 0.f;
            int colc[3];
#pragma unroll
            for (int ct = 0; ct < 3; ++ct) { const int c = 16 * ct + r16; colc[ct] = c < 36 ? c : 35; }
            for (int half = 0; half < 2; ++half) {
                __syncthreads();
                for (int idx = tid; idx < 512 * 36; idx += 512) { const int k = half * 512 + idx / 36, e = idx % 36; WRh[idx] = ffn_norm[k] * (e < 4 ? w_rg[k * 4 + e] : w_re[k * 32 + (e - 4)]); }
                __syncthreads();
                for (int s8 = 0; s8 < 32; s8 += 8) {
                    f32x4 xv[8];
#pragma unroll
                    for (int u = 0; u < 8; ++u) xv[u] = *(const GAS f32x4*)(xrow + half * 512 + 16 * (s8 + u));
#pragma unroll
                    for (int u = 0; u < 8; ++u) {
                        const f32x4 x4 = xv[u];
                        u32x2 hw; hw.x = cvt_pk_bf16(x4[0], x4[1]); hw.y = cvt_pk_bf16(x4[2], x4[3]); *(GAS u32x2*)(hrow + half * 512 + 16 * (s8 + u)) = hw;
                        ssq += (x4[0] * x4[0] + x4[1] * x4[1]) + (x4[2] * x4[2] + x4[3] * x4[3]);
                        const LAS float* wk = WRh + (16 * (s8 + u) + 4 * g4) * 36;
#pragma unroll
                        for (int j = 0; j < 4; ++j)
#pragma unroll
                            for (int ct = 0; ct < 3; ++ct) acc3[ct] = __builtin_amdgcn_mfma_f32_16x16x4f32(x4[j], wk[j * 36 + colc[ct]], acc3[ct], 0, 0, 0);
                    }
                }
            }
            ssq += __shfl_xor(ssq, 16); ssq += __shfl_xor(ssq, 32);
            const float rstd = rsqrtf(ssq * (1.f / DM) + EPS);
#pragma unroll
            for (int ct = 0; ct < 3; ++ct) { const int c = 16 * ct + r16; if (c < 36) {
#pragma unroll
                for (int rg = 0; rg < 4; ++rg) LG[(4 * g4 + rg) * 36 + c] = acc3[ct][rg]; } }
            LDS_WAIT();
            if (lane < 16) {
                const int m = m0 + lane; const LAS float* lg = LG + lane * 36;
                float gl[4];
#pragma unroll
                for (int g = 0; g < 4; ++g) gl[g] = lg[g] * rstd + b_rg[g];
                int gi = 0; float gm = gl[0];
#pragma unroll
                for (int g = 1; g < 4; ++g) if (gl[g] > gm) { gm = gl[g]; gi = g; }
                float gs = 0.f;
#pragma unroll
                for (int g = 0; g < 4; ++g) gs += __expf(gl[g] - gm);
                const float gval = 1.f / gs;
                float el[8];
#pragma unroll
                for (int j = 0; j < 8; ++j) el[j] = lg[4 + 8 * gi + j] * rstd + b_re[8 * gi + j];
                int i0 = 0; float mx0 = el[0];
#pragma unroll
                for (int j = 1; j < 8; ++j) if (el[j] > mx0) { mx0 = el[j]; i0 = j; }
                int i1 = -1; float mx1 = -INFINITY;
#pragma unroll
                for (int j = 0; j < 8; ++j) if (j != i0 && el[j] > mx1) { mx1 = el[j]; i1 = j; }
                const float e1 = __expf(mx1 - mx0); const float g0 = gval / (1.f + e1), g1 = gval * e1 / (1.f + e1);
                const int ea = gi * 8 + i0, eb = gi * 8 + i1; P_E01[2 * m] = ea; P_E01[2 * m + 1] = eb; P_G01[2 * m] = g0; P_G01[2 * m + 1] = g1; P_RSTD[m] = rstd;
                __hip_atomic_fetch_add((LAS unsigned*)(lds + MISC_OFF) + 64 + ea, 1u, __ATOMIC_RELAXED, __HIP_MEMORY_SCOPE_WORKGROUP); __hip_atomic_fetch_add((LAS unsigned*)(lds + MISC_OFF) + 64 + eb, 1u, __ATOMIC_RELAXED, __HIP_MEMORY_SCOPE_WORKGROUP);
            }
            __syncthreads();
            if (tid < 32) P_CNT[vcu * 32 + tid] = (int)MISC[64 + tid];
        }
        SEAM(P + 6);
        if (IN(P + 7)) for (int rep_ = 0; rep_ < ((l == 0 || 7 != 5) ? NREP(7) : 1); ++rep_) {
            unsigned ldsb_ = (unsigned)(uintptr_t)lds0; asm volatile("" : "+s"(ldsb_)); LAS unsigned char* lds = (LAS unsigned char*)(uintptr_t)ldsb_; volatile LAS unsigned* MISC = (volatile LAS unsigned*)(lds + MISC_OFF); volatile LAS unsigned long long* ARGP = (volatile LAS unsigned long long*)(lds + MISC_OFF + 768); (void)MISC; int wave = wave0, G = G0, bx = bx0; asm volatile("" : "+s"(G), "+s"(bx), "+s"(wave)); const int lane = (int)__builtin_amdgcn_mbcnt_hi(~0u, __builtin_amdgcn_mbcnt_lo(~0u, 0u)); const int tid = wave * 64 + lane; const int vcu = (bx % 8) * (G / 8) + bx / 8; const int gw = vcu * 8 + wave, NGW = G * 8; (void)lane; (void)gw; (void)NGW; (void)vcu;
            GAS unsigned char* ws = (GAS unsigned char*)LDP(22); GAS float* out = (GAS float*)LDP(21); const GAS float* x_in = (const GAS float*)ARGIN(0); (void)out; (void)x_in; (void)ws;
            LAS int* cnt_all = (LAS int*)lds;
            LAS int* pre_e = (LAS int*)(lds + 32768);
            LAS int* tot_e = pre_e + 32;
            LAS int* pst = pre_e + 64;
            LAS int* eL = pre_e + 128;
            for (int i = tid; i < 256 * 32; i += 512) cnt_all[i] = P_CNT[i];
            if (tid < 256) eL[tid] = P_E01[vcu * 256 + tid];
            __syncthreads();
            if (tid < 32) { int pre = 0, tot = 0; for (int w = 0; w < 256; ++w) { const int c = cnt_all[w * 32 + tid]; pre += (w < vcu) ? c : 0; tot += c; } pre_e[tid] = pre; tot_e[tid] = tot; }
            __syncthreads();
            if (tid == 0) { int acc = 0; for (int e = 0; e < 32; ++e) { pst[e] = acc; acc += (tot_e[e] + 255) / 256 * 256; } pst[32] = acc; }
            __syncthreads();
            if (vcu == 0 && tid <= 32) P_TSTART[tid] = pst[tid] / 256;
            if (tid < 256) { const int e = eL[tid]; int r = 0; for (int a = 0; a < tid; ++a) r += (eL[a] == e) ? 1 : 0;
                const int slot = pst[e] + pre_e[e] + r; const int tok = vcu * 128 + (tid >> 1);
                P_SLOT[vcu * 256 + tid] = slot; P_TOKOF[slot] = tok; P_GATEOF[slot] = P_G01[vcu * 256 + tid]; P_RSTDOF[slot] = P_RSTD[tok]; }
            if (vcu < 32) { const int e = vcu; for (int s = pst[e] + tot_e[e] + tid; s < pst[e + 1]; s += 512) { P_TOKOF[s] = 0; P_GATEOF[s] = 0.f; P_RSTDOF[s] = 0.f; } }
            __syncthreads();
        }
        SEAM(P + 7);
        if (IN(P + 8)) for (int rep_ = 0; rep_ < ((l == 0 || 8 != 5) ? NREP(8) : 1); ++rep_) {
            unsigned ldsb_ = (unsigned)(uintptr_t)lds0; asm volatile("" : "+s"(ldsb_)); LAS unsigned char* lds = (LAS unsigned char*)(uintptr_t)ldsb_; volatile LAS unsigned* MISC = (volatile LAS unsigned*)(lds + MISC_OFF); volatile LAS unsigned long long* ARGP = (volatile LAS unsigned long long*)(lds + MISC_OFF + 768); (void)MISC; int wave = wave0, G = G0, bx = bx0; asm volatile("" : "+s"(G), "+s"(bx), "+s"(wave)); const int lane = (int)__builtin_amdgcn_mbcnt_hi(~0u, __builtin_amdgcn_mbcnt_lo(~0u, 0u)); const int tid = wave * 64 + lane; const int vcu = (bx % 8) * (G / 8) + bx / 8; const int gw = vcu * 8 + wave, NGW = G * 8; (void)lane; (void)gw; (void)NGW; (void)vcu;
            GAS unsigned char* ws = (GAS unsigned char*)LDP(22); GAS float* out = (GAS float*)LDP(21); const GAS float* x_in = (const GAS float*)ARGIN(0); (void)out; (void)x_in; (void)ws;
            volatile LAS int* TS = (volatile LAS int*)(MISC + 128);
            if (tid <= 32) TS[tid] = P_TSTART[tid];
            __syncthreads();
            MoeOrder S{G, vcu, TS, (const GAS char*)P_XN, (const GAS char*)P_WGU, 0, (size_t)1024 * 1024 * 2, (size_t)256 * 1024 * 2};
            EpiGU E{P_HH, P_RSTDOF};
            pg8::gemm_phase<EpiGU, MoeOrder, true, true>(tid, lds, DM, DM, DM, S, E, P_TOKOF);
        }
        SEAM(P + 8);
        if (IN(P + 9)) for (int rep_ = 0; rep_ < ((l == 0 || 9 != 5) ? NREP(9) : 1); ++rep_) {
            unsigned ldsb_ = (unsigned)(uintptr_t)lds0; asm volatile("" : "+s"(ldsb_)); LAS unsigned char* lds = (LAS unsigned char*)(uintptr_t)ldsb_; volatile LAS unsigned* MISC = (volatile LAS unsigned*)(lds + MISC_OFF); volatile LAS unsigned long long* ARGP = (volatile LAS unsigned long long*)(lds + MISC_OFF + 768); (void)MISC; int wave = wave0, G = G0, bx = bx0; asm volatile("" : "+s"(G), "+s"(bx), "+s"(wave)); const int lane = (int)__builtin_amdgcn_mbcnt_hi(~0u, __builtin_amdgcn_mbcnt_lo(~0u, 0u)); const int tid = wave * 64 + lane; const int vcu = (bx % 8) * (G / 8) + bx / 8; const int gw = vcu * 8 + wave, NGW = G * 8; (void)lane; (void)gw; (void)NGW; (void)vcu;
            GAS unsigned char* ws = (GAS unsigned char*)LDP(22); GAS float* out = (GAS float*)LDP(21); const GAS float* x_in = (const GAS float*)ARGIN(0); (void)out; (void)x_in; (void)ws;
            volatile LAS int* TS = (volatile LAS int*)(MISC + 128);
            if (tid <= 32) TS[tid] = P_TSTART[tid];
            __syncthreads();
            MoeOrder S{G, vcu, TS, (const GAS char*)P_HH, (const GAS char*)P_WD, (size_t)256 * 512 * 2, (size_t)1024 * 512 * 2, (size_t)256 * 512 * 2};
            EpiDown E{P_Y, P_GATEOF};
            pg8::gemm_phase<EpiDown, MoeOrder, true, false>(tid, lds, DEXP, DEXP, DEXP, S, E, nullptr);
        }
        SEAM(P + 9);
}

__global__ void __launch_bounds__(512, 2) fwd(Args args) {
    extern __shared__ __attribute__((aligned(16))) unsigned char lds_raw[];
    LAS unsigned char* lds0 = (LAS unsigned char*)lds_raw;
    const int tid0 = threadIdx.x; const int wave0 = __builtin_amdgcn_readfirstlane(tid0 >> 6);
    const int G0 = gridDim.x; const int bx0 = blockIdx.x;
    { volatile LAS unsigned* MISC = (volatile LAS unsigned*)(lds0 + MISC_OFF); const int tid = tid0;
    for (int u = tid; u < 256; u += 512) MISC[u] = 0u;
    __syncthreads();
    volatile LAS unsigned long long* ARGP = (volatile LAS unsigned long long*)(lds0 + MISC_OFF + 768);
    if (tid < 21) ARGP[tid] = (unsigned long long)args.in[tid];
    if (tid == 21) ARGP[21] = (unsigned long long)args.out;
    if (tid == 22) ARGP[22] = (unsigned long long)args.ws;
    __syncthreads(); }
#if MK_ONE_LAUNCH
    XcdBarrier bar = xcd_barrier_post((unsigned*)(args.ws + WS_CTL) + CW_BAR, (volatile LAS unsigned*)(lds0 + MISC_OFF) + 8);
#else
    XcdBarrier bar; bar.bar = nullptr; bar.x = 0; bar.st = nullptr;
#endif
    const int lo = args.ph_lo, hi_ = args.ph_hi;
    if (IN(0)) {
        const GAS int* positions = (const GAS int*)args.in[1]; GAS float* COSp = (GAS float*)(args.ws + WS_COS); GAS float* SINp = (GAS float*)(args.ws + WS_SIN);
        for (int i = bx0 * 512 + tid0; i < NTOK * 16; i += G0 * 512) { const int tk = i >> 4, fi = i & 15;
            const double inv = exp2(-(double)fi * (13.287712379549449 / 16.0)); const double ang = (double)positions[tk] * inv;
            COSp[i] = (float)cos(ang); SINp[i] = (float)sin(ang); }
    }
    layer_body<0>(lo, hi_, lds0, wave0, G0, bx0, bar);
    layer_body<1>(lo, hi_, lds0, wave0, G0, bx0, bar);
    layer_body<2>(lo, hi_, lds0, wave0, G0, bx0, bar);
}

extern "C" void kernel_launch(void* const* d_in, const int* in_sizes, int n_in, void* d_out, int out_size, void* d_ws, size_t ws_size, hipStream_t stream) {
    static int grid = 0;
    if (grid == 0) {
        if (n_in != 21 || out_size != NTOK * DM || ws_size < WS_END) { fprintf(stderr, "kernel_launch: unexpected shapes (n_in %d out %d ws %zu)\n", n_in, out_size, ws_size); grid = -1; return; }
        int dev = 0, cus = 0;
        if (hipGetDevice(&dev) != hipSuccess || hipDeviceGetAttribute(&cus, hipDeviceAttributeMultiprocessorCount, dev) != hipSuccess) { grid = -1; return; }
        if (hipFuncSetAttribute((const void*)fwd, hipFuncAttributeMaxDynamicSharedMemorySize, LDS_BYTES) != hipSuccess) { fprintf(stderr, "kernel_launch: hipFuncSetAttribute failed\n"); grid = -1; return; }
        int per_cu = 0;
        if (hipOccupancyMaxActiveBlocksPerMultiprocessor(&per_cu, (const void*)fwd, 512, LDS_BYTES) != hipSuccess || per_cu < 1) fprintf(stderr, "kernel_launch: occupancy query says %d\n", per_cu);
        (void)hipGetLastError();
        grid = cus;
        if (grid != 256) { fprintf(stderr, "kernel_launch: built for 256 CUs, got %d\n", grid); grid = -1; return; }
    }
    if (grid < 0) return;
    if (hipMemsetAsync((char*)d_ws + WS_CTL, 0, CTL_ZERO_BYTES, stream) != hipSuccess) return;
    Args a{};
    for (int i = 0; i < 21; ++i) a.in[i] = d_in[i];
    a.out = (float*)d_out; a.ws = (unsigned char*)d_ws;
#if MK_ONE_LAUNCH
    a.ph_lo = 0; a.ph_hi = 21;
    hipLaunchKernelGGL(fwd, dim3(grid), dim3(512), LDS_BYTES, stream, a);
#else
    for (int p = 0; p <= 20; ++p) { a.ph_lo = p; a.ph_hi = p + 1; hipLaunchKernelGGL(fwd, dim3(grid), dim3(512), LDS_BYTES, stream, a); }
#endif
}
```

```cpp
#include <hip/hip_runtime.h>
#include <cstdio>
#include <cstdint>

#ifndef PROBE_PHASE
#define PROBE_PHASE -1
#endif
#define NREP(k) ((PROBE_PHASE) == (k) ? 2 : 1)
#ifndef MK_ONE_LAUNCH
#define MK_ONE_LAUNCH 1
#endif

#define LAS __attribute__((address_space(3)))
#define GAS __attribute__((address_space(1)))
typedef unsigned short bf16;
typedef short bf16x8 __attribute__((ext_vector_type(8)));
typedef short s16x4 __attribute__((ext_vector_type(4)));
typedef float f32x4 __attribute__((ext_vector_type(4)));
typedef float f32x2 __attribute__((ext_vector_type(2)));
typedef float f32x16 __attribute__((ext_vector_type(16)));
typedef unsigned u32x4 __attribute__((ext_vector_type(4)));
typedef unsigned u32x2 __attribute__((ext_vector_type(2)));

constexpr int NB = 16, SEQ = 2048, DM = 1024, NTOK = NB * SEQ, NLAYER = 2;
constexpr int INW = 1960, INP = 2048;
constexpr int NEXP = 32, DEXP = 512;
constexpr int MAXSLOT = 73728;
constexpr float EPS = 1e-6f;
constexpr float WSCALE = 64.f, WSCALE_INV = 1.f / 64.f;
constexpr float LOG2E = 1.4426950408889634f;
constexpr float C2F = 0.125f * LOG2E;
constexpr float C2M = 0.10206207261596575f * LOG2E;

constexpr size_t MiB = 1u << 20, KiB = 1u << 10;
constexpr size_t WS_CTL = 0, CTL_ZERO_BYTES = 64 * KiB;
constexpr size_t WS_COS = 1 * MiB, WS_SIN = 3 * MiB;
constexpr size_t WS_SSQ = 5 * MiB;
constexpr size_t WS_FLOG = 6 * MiB;
constexpr size_t WS_E01 = 8 * MiB;
constexpr size_t WS_G01 = 8 * MiB + 256 * KiB;
constexpr size_t WS_SLOT = 8 * MiB + 512 * KiB;
constexpr size_t WS_TOKOF = 8 * MiB + 768 * KiB;
constexpr size_t WS_GATEOF = 9 * MiB + 256 * KiB;
constexpr size_t WS_CNT = 9 * MiB + 768 * KiB;
constexpr size_t WS_TSTART = 9 * MiB + 800 * KiB;
constexpr size_t WS_RSTD = 9 * MiB + 832 * KiB;
constexpr size_t WS_RSTDOF = 7 * MiB;
constexpr size_t WS_KPE = 10 * MiB;
constexpr size_t WS_KAUG = 10 * MiB + 2 * MiB;
constexpr size_t WS_WIN = 16 * MiB;
constexpr size_t WS_WUQ = 20 * MiB;
constexpr size_t WS_WUKV = 20 * MiB + 512 * KiB;
constexpr size_t WS_WOUT = 21 * MiB;
constexpr size_t WS_WGU = 24 * MiB;
constexpr size_t WS_WD = 88 * MiB;
constexpr size_t WS_XN = 120 * MiB;
constexpr size_t WS_FQKV = 184 * MiB;
constexpr size_t WS_LAT = 280 * MiB;
constexpr size_t WS_QM = 312 * MiB;
constexpr size_t WS_KVM = 360 * MiB;
constexpr size_t WS_Y = 280 * MiB;
constexpr size_t WS_BIASF = 424 * MiB;
constexpr size_t WS_NRM = 425 * MiB;
constexpr size_t WS_END = 426 * MiB;
static_assert(WS_Y + (size_t)MAXSLOT * 1024 * 2 <= WS_END, "Y fits");
static_assert(WS_FQKV + (size_t)MAXSLOT * 512 * 2 <= WS_LAT, "HH fits");

constexpr int CW_BAR = 1024;

constexpr int RING_BYTES = 147456;
constexpr int MISC_OFF = RING_BYTES;
constexpr int LDS_BYTES = RING_BYTES + 1024;

typedef __bf16 bf16x2_t __attribute__((ext_vector_type(2)));
__device__ __forceinline__ unsigned cvt_pk_bf16(float lo, float hi) { const f32x2 v = {lo, hi}; const bf16x2_t b = __builtin_convertvector(v, bf16x2_t); return __builtin_bit_cast(unsigned, b); }
__device__ __forceinline__ float bf2f(unsigned short b) { return __uint_as_float((unsigned)b << 16); }
__device__ __forceinline__ float wave_sum(float v) {
#pragma unroll
    for (int o = 1; o < 64; o <<= 1) v += __shfl_xor(v, o);
    return v;
}
__device__ __forceinline__ unsigned pk4_fp8(float a, float b, float c, float d) { int w = 0; w = __builtin_amdgcn_cvt_pk_fp8_f32(a, b, w, false); w = __builtin_amdgcn_cvt_pk_fp8_f32(c, d, w, true); return (unsigned)w; }
#define LDS_WAIT() asm volatile("s_waitcnt lgkmcnt(0)" ::: "memory")

#define XB_TMO      128
#define XB_XCNT(j)  (256  + 64 * (j))
#define XB_XSUB(j)  (1280 + 64 * (j))
#define XB_XGEN(j)  (2304 + 64 * (j))
#define XB_TOP      3328
#define XB_TOPGEN   3392
#define XCD_BAR_WORDS 3456
#define XB_SPIN_CAP (1u << 18)
__device__ __forceinline__ unsigned xb_ld(unsigned* p)              { return __hip_atomic_load(p, __ATOMIC_RELAXED, __HIP_MEMORY_SCOPE_AGENT); }
__device__ __forceinline__ unsigned xb_add(unsigned* p, unsigned v) { return __hip_atomic_fetch_add(p, v, __ATOMIC_RELAXED, __HIP_MEMORY_SCOPE_AGENT); }
__device__ __forceinline__ unsigned xb_xcc_id() { return (unsigned)__builtin_amdgcn_s_getreg((3 << 11) | 20) & 0xFu; }
#define XB_SPIN(cond, bar) do { unsigned _sp = 0; while (cond) { __builtin_amdgcn_s_sleep(1); \
    if ((++_sp & 255u) == 0u) { if (xb_ld(&(bar)[XB_TMO])) break; if (_sp > XB_SPIN_CAP) { atomicAdd(&(bar)[XB_TMO], 1u); break; } } } } while (0)
struct XcdBarrier { unsigned* bar; unsigned x; volatile LAS unsigned* st; };
__device__ __forceinline__ XcdBarrier xcd_barrier_post(unsigned* bar, volatile LAS unsigned* st) {
    XcdBarrier b; b.bar = bar; b.x = xb_xcc_id(); b.st = st;
    if (threadIdx.x == 0) (void)xb_add(&bar[XB_XCNT(b.x)], 1u);
    return b;
}
__device__ __forceinline__ void xcd_barrier_complete(unsigned* bar, unsigned x, unsigned& nloc, unsigned& nx) {
    const unsigned G = gridDim.x * gridDim.y * gridDim.z;
    unsigned sum, cnt, mine, sp = 0u;
    for (;;) {
        sum = 0u; cnt = 0u; mine = 0u;
#pragma unroll
        for (unsigned j = 0; j < 16; ++j) { const unsigned c = xb_ld(&bar[XB_XCNT(j)]); sum += c; cnt += (c > 0u) ? 1u : 0u; mine = (j == x) ? c : mine; }
        if (sum == G) break;
        __builtin_amdgcn_s_sleep(1);
        if ((++sp & 255u) == 0u) { if (xb_ld(&bar[XB_TMO])) break; if (sp > XB_SPIN_CAP) { atomicAdd(&bar[XB_TMO], 1u); break; } }
    }
    nloc = mine > 0u ? mine : 1u; nx = cnt > 0u ? cnt : 1u;
}
__device__ __forceinline__ void xcd_barrier(const XcdBarrier& b) {
    asm volatile("s_waitcnt vmcnt(0)" ::: "memory");
    __syncthreads();
    if (threadIdx.x == 0) {
        unsigned* bar = b.bar;
        __builtin_amdgcn_s_waitcnt(0);
        unsigned nloc = b.st[0], nx = b.st[1];
        if (nloc == 0u) { xcd_barrier_complete(bar, b.x, nloc, nx); b.st[0] = nloc; b.st[1] = nx; }
        const unsigned old = xb_add(&bar[XB_XSUB(b.x)], 1u);
        const unsigned gen = old / nloc;
        if (old + 1u == (gen + 1u) * nloc) {
            __builtin_amdgcn_fence(__ATOMIC_RELEASE, "agent");
            asm volatile("s_waitcnt vmcnt(0)" ::: "memory");
            const unsigned og = xb_add(&bar[XB_TOP], 1u);
            const unsigned tg = og / nx;
            if (og + 1u == (tg + 1u) * nx) xb_add(&bar[XB_TOPGEN], 1u);
            else XB_SPIN(xb_ld(&bar[XB_TOPGEN]) == tg, bar);
            __builtin_amdgcn_fence(__ATOMIC_ACQUIRE, "agent");
            xb_add(&bar[XB_XGEN(b.x)], 1u);
            asm volatile("s_waitcnt vmcnt(0)" ::: "memory");
        } else {
            XB_SPIN(xb_ld(&bar[XB_XGEN(b.x)]) == gen, bar);
            __builtin_amdgcn_fence(__ATOMIC_ACQUIRE, "agent");
            asm volatile("s_waitcnt vmcnt(0)" ::: "memory");
        }
    }
    __syncthreads();
}

namespace pg8 {
constexpr int BM = 256, BK = 64, HALF = 128, HTB = HALF * BK * 2, STAGE_BYTES = 8 * HTB;
typedef int v4i32_t __attribute__((ext_vector_type(4)));
typedef int v8i32_t __attribute__((ext_vector_type(8)));
__host__ __device__ __forceinline__ int lds_byte(int r, int c) { const int st = (r >> 4) * 2 + (c >> 5), rr = r & 15, cc = c & 31, ob = rr * 64 + cc * 2; return st * 1024 + (ob ^ (((ob >> 9) & 1) << 5)); }
__host__ __device__ __forceinline__ void stage_rc(int b, int& R, int& C) { const int st = b / 1024, sb = b % 1024, swz = sb ^ (((sb >> 9) & 1) << 5); R = (st >> 1) * 16 + swz / 64; C = (st & 1) * 32 + (swz % 64) / 2; }
__host__ __device__ __forceinline__ int perm32(int rho) { const int n = rho >> 4, i = rho & 15; return 8 * (i >> 2) + 4 * n + (i & 3); }

struct Unit { const GAS char* a; const GAS char* b; int pm, pn, e; };

template <class Epi, class Sched, bool ALIGN_EPI, bool GATHER, bool FP8 = false>
__device__ __forceinline__ void gemm_phase(const int tid, LAS unsigned char* lds, const int Kb, const int ldaB, const int ldbB, const Sched& S, const Epi& E, const GAS int* __restrict__ tokof) {
    const int wid = __builtin_amdgcn_readfirstlane(tid >> 6), lane = tid & 63, wr = wid >> 2, wc = wid & 3, fr = lane & 15, fq = lane >> 4;
    const int nt = Kb / 128;
    unsigned voffA[2], voffB[2]; int RA[2], CA2[2];
#pragma unroll
    for (int i = 0; i < 2; ++i) { int R, C; stage_rc(tid * 16 + i * 8192, R, C); const int Rb = Epi::PERM ? ((R & ~31) + perm32(R & 31)) : R;
        voffA[i] = (unsigned)(R * ldaB + C * 2); voffB[i] = (unsigned)(Rb * ldbB + C * 2); RA[i] = R; CA2[i] = C * 2; }
    const size_t kstep = (size_t)(BK * 2);
    const size_t hstepA = GATHER ? 0 : (size_t)HALF * ldaB;
    const size_t hstepB = (size_t)HALF * ldbB;
    const unsigned ldsw = (unsigned)wid * 1024u;
    const int aoff = lds_byte(wr * 64 + fr, fq * 8), boff = lds_byte(wc * 32 + fr, fq * 8);
    unsigned gcur[2][2], gnxt[2][2];
    const int scl8 = 0x7F7F7F7F;
#define PG8_SA(b, h) (((b) * 2 + (h)) * HTB)
#define PG8_SB(b, h) ((4 + (b) * 2 + (h)) * HTB)
#define PG8_STAGE(bufoff, gbase, voff) do { const unsigned long long gb_ = (unsigned long long)(gbase); const unsigned lbase_ = (unsigned)__builtin_amdgcn_readfirstlane((int)((unsigned)(uintptr_t)lds + (unsigned)(bufoff) + ldsw)); \
        _Pragma("unroll") for (int _i = 0; _i < 2; ++_i) { unsigned keep_; \
            asm volatile("s_mov_b32 %0, m0\n\ts_mov_b32 m0, %3\n\ts_nop 0\n\tglobal_load_lds_dwordx4 %1, %2\n\ts_mov_b32 m0, %0" : "=&s"(keep_) : "v"((voff)[_i]), "s"(gb_), "s"(lbase_ + (unsigned)(_i * 8192)) : "memory"); } } while (0)
#define PG8_STAGE_A(bufoff, base, h, nx) do { if constexpr (GATHER) { unsigned _v[2]; _v[0] = (nx) ? gnxt[h][0] : gcur[h][0]; _v[1] = (nx) ? gnxt[h][1] : gcur[h][1]; PG8_STAGE(bufoff, base, _v); } \
        else { PG8_STAGE(bufoff, (base) + (h) * hstepA, voffA); } } while (0)
#define PG8_LDA(dst, b, h) do { _Pragma("unroll") for (int m = 0; m < 4; ++m) _Pragma("unroll") for (int k = 0; k < 2; ++k) dst[m][k] = *(const LAS bf16x8*)(lds + PG8_SA(b, h) + aoff + m * 2048 + k * 1024); } while (0)
#define PG8_LDB(dst, b, h) do { _Pragma("unroll") for (int n = 0; n < 2; ++n) _Pragma("unroll") for (int k = 0; k < 2; ++k) dst[n][k] = *(const LAS bf16x8*)(lds + PG8_SB(b, h) + boff + n * 2048 + k * 1024); } while (0)
#define PG8_MMA(ai, bj, At, Bt) do { __builtin_amdgcn_s_setprio(1); if constexpr (FP8) { _Pragma("unroll") for (int m = 0; m < 4; ++m) _Pragma("unroll") for (int n = 0; n < 2; ++n) { \
        const v8i32_t b8_ = __builtin_shufflevector(__builtin_bit_cast(v4i32_t, Bt[n][0]), __builtin_bit_cast(v4i32_t, Bt[n][1]), 0, 1, 2, 3, 4, 5, 6, 7), a8_ = __builtin_shufflevector(__builtin_bit_cast(v4i32_t, At[m][0]), __builtin_bit_cast(v4i32_t, At[m][1]), 0, 1, 2, 3, 4, 5, 6, 7); \
        asm volatile("s_nop 1\n\tv_mfma_scale_f32_16x16x128_f8f6f4 %0, %1, %2, %0, %3, %3 op_sel_hi:[0,0,0]" : "+v"(acc[ai][bj][m][n]) : "v"(b8_), "v"(a8_), "v"(scl8)); } } \
      else { _Pragma("unroll") for (int m = 0; m < 4; ++m) _Pragma("unroll") for (int n = 0; n < 2; ++n) _Pragma("unroll") for (int k = 0; k < 2; ++k) \
        acc[ai][bj][m][n] = __builtin_amdgcn_mfma_f32_16x16x32_bf16(Bt[n][k], At[m][k], acc[ai][bj][m][n], 0, 0, 0); } __builtin_amdgcn_s_setprio(0); } while (0)
#define PG8_WAIT_V(n) asm volatile("s_waitcnt vmcnt(" #n ")" ::: "memory")
#define PG8_WAIT_L(n) asm volatile("s_waitcnt lgkmcnt(" #n ")" ::: "memory")
#define PG8_BAR __builtin_amdgcn_s_barrier()
#define PG8_SCHED __builtin_amdgcn_sched_barrier(0)
#define PG8_GLOAD(dst, u) do { if constexpr (GATHER) { _Pragma("unroll") for (int _h = 0; _h < 2; ++_h) _Pragma("unroll") for (int _i = 0; _i < 2; ++_i) \
        dst[_h][_i] = (unsigned)tokof[(u).pm * BM + _h * HALF + RA[_i]] * (unsigned)ldaB + (unsigned)CA2[_i]; } } while (0)
    Unit cur, nxt; int ui = 0;
    if (!S.next(0, cur)) return;
    PG8_GLOAD(gcur, cur);
    f32x4 acc[2][2][4][2];
#pragma unroll
    for (int a = 0; a < 2; ++a)
#pragma unroll
        for (int b = 0; b < 2; ++b)
#pragma unroll
            for (int m = 0; m < 4; ++m)
#pragma unroll
                for (int n = 0; n < 2; ++n) acc[a][b][m][n] = (f32x4){0.f, 0.f, 0.f, 0.f};
    bf16x8 At[4][2], B0[2][2], B1[2][2];
    const GAS char* cA = cur.a; const GAS char* cB = cur.b;
    PG8_STAGE(PG8_SB(0, 0), cB, voffB); PG8_STAGE(PG8_SB(0, 1), cB + hstepB, voffB); PG8_STAGE_A(PG8_SA(0, 0), cA, 0, false); PG8_STAGE_A(PG8_SA(0, 1), cA, 1, false);
    if (wr == 1) PG8_BAR;
    PG8_WAIT_V(2); PG8_BAR;
    PG8_STAGE(PG8_SB(1, 0), cB + kstep, voffB); PG8_STAGE_A(PG8_SA(1, 0), cA + kstep, 0, false); PG8_STAGE(PG8_SB(1, 1), cB + hstepB + kstep, voffB);
    PG8_WAIT_V(6); PG8_BAR;
    for (;;) {
        const bool has_next = S.next(ui + 1, nxt);
        if constexpr (GATHER) { if (has_next) { PG8_GLOAD(gnxt, nxt); } else { _Pragma("unroll") for (int _h = 0; _h < 2; ++_h) _Pragma("unroll") for (int _i = 0; _i < 2; ++_i) gnxt[_h][_i] = gcur[_h][_i]; } }
        const GAS char* nA = has_next ? nxt.a : cA; const GAS char* nB = has_next ? nxt.b : cB;
#pragma nounroll
        for (int t = 0; t < nt; t += 2) {
            const bool last = (t == nt - 2);
            const GAS char* a1 = cA + (size_t)(t + 1) * kstep;
            const GAS char* a2 = last ? nA : cA + (size_t)(t + 2) * kstep; const GAS char* b2 = last ? nB : cB + (size_t)(t + 2) * kstep;
            const GAS char* a3 = a2 + kstep; const GAS char* b3 = b2 + kstep;
            PG8_LDB(B0, 0, 0); PG8_LDB(B1, 0, 1); PG8_SCHED; PG8_LDA(At, 0, 0); PG8_STAGE_A(PG8_SA(1, 1), a1, 1, false);
            PG8_WAIT_V(8); PG8_WAIT_L(0); PG8_BAR; PG8_MMA(0, 0, At, B0); PG8_MMA(0, 1, At, B1); PG8_BAR; PG8_SCHED;
            PG8_LDA(At, 0, 1); PG8_STAGE(PG8_SB(0, 0), b2, voffB); PG8_STAGE(PG8_SB(0, 1), b2 + hstepB, voffB); PG8_STAGE_A(PG8_SA(0, 0), a2, 0, last);
            PG8_WAIT_V(8); PG8_WAIT_L(0); PG8_BAR; PG8_MMA(1, 0, At, B0); PG8_MMA(1, 1, At, B1); PG8_BAR; PG8_SCHED;
            PG8_LDB(B0, 1, 0); PG8_LDB(B1, 1, 1); PG8_SCHED; PG8_LDA(At, 1, 0); PG8_STAGE_A(PG8_SA(0, 1), a2, 1, last);
            PG8_WAIT_V(8); PG8_WAIT_L(0); PG8_BAR; PG8_MMA(0, 0, At, B0); PG8_MMA(0, 1, At, B1); PG8_BAR; PG8_SCHED;
            PG8_LDA(At, 1, 1); PG8_STAGE(PG8_SB(1, 0), b3, voffB); PG8_STAGE(PG8_SB(1, 1), b3 + hstepB, voffB); PG8_STAGE_A(PG8_SA(1, 0), a3, 0, last);
            PG8_WAIT_V(8); PG8_WAIT_L(0); PG8_BAR; PG8_MMA(1, 0, At, B0); PG8_MMA(1, 1, At, B1); PG8_BAR; PG8_SCHED;
        }
        if constexpr (ALIGN_EPI) { if (wr == 0) PG8_BAR; }
        if constexpr (FP8) { asm volatile("s_nop 15\n\ts_nop 15" ::: "memory"); }
        E(acc, cur, wr, wc, fr, fq);
        if (!has_next) break;
#pragma unroll
        for (int a = 0; a < 2; ++a)
#pragma unroll
            for (int b = 0; b < 2; ++b)
#pragma unroll
                for (int m = 0; m < 4; ++m)
#pragma unroll
                    for (int n = 0; n < 2; ++n) acc[a][b][m][n] = (f32x4){0.f, 0.f, 0.f, 0.f};
        cur = nxt; cA = nA; cB = nB; ++ui;
        if constexpr (GATHER) { _Pragma("unroll") for (int _h = 0; _h < 2; ++_h) _Pragma("unroll") for (int _i = 0; _i < 2; ++_i) gcur[_h][_i] = gnxt[_h][_i]; }
        if constexpr (ALIGN_EPI) { if (wr == 1) PG8_BAR; }
    }
    PG8_WAIT_V(0);
    if constexpr (!ALIGN_EPI) { if (wr == 0) PG8_BAR; }
    PG8_BAR;
#undef PG8_SA
#undef PG8_SB
#undef PG8_STAGE
#undef PG8_STAGE_A
#undef PG8_LDA
#undef PG8_LDB
#undef PG8_MMA
#undef PG8_WAIT_V
#undef PG8_WAIT_L
#undef PG8_BAR
#undef PG8_SCHED
#undef PG8_GLOAD
}
}
using pg8::Unit;

struct DenseOrder {
    int nM, nN, nwg, G, c; const GAS char* A; const GAS char* B; size_t aT, bT;
    __device__ __forceinline__ bool next(int i, Unit& u) const {
        const long L = (long)i * G + c; if (L >= nwg) return false;
        int wgid = (int)L; { const int q = nwg / 8, r = nwg % 8, xcd = wgid % 8, off = wgid / 8; wgid = (xcd < r ? xcd * (q + 1) : r * (q + 1) + (xcd - r) * q) + off; }
        const int nig = 8 * nN, gid = wgid / nig, fm = gid * 8, gsz = (nM - fm) < 8 ? (nM - fm) : 8;
        u.pm = fm + ((wgid % nig) % gsz); u.pn = (wgid % nig) / gsz; u.e = 0;
        u.a = A + (size_t)u.pm * aT; u.b = B + (size_t)u.pn * bT; return true;
    }
};
struct UpOrder {
    int G, c; const GAS char* LATp; const GAS char* Wq; const GAS char* Wkv;
    __device__ __forceinline__ bool next(int i, Unit& u) const {
        const int L = i * G + c; if (L >= 128 * 7) return false;
        u.pm = L / 7; const int j = L % 7; const bool kv = j >= 3; u.pn = kv ? j - 3 : j; u.e = kv ? 1 : 0;
        u.a = LATp + (size_t)u.pm * 256 * 512 * 2 + (kv ? 512 : 0);
        u.b = (kv ? Wkv : Wq) + (size_t)u.pn * 256 * 256 * 2; return true;
    }
};
struct MoeOrder {
    int G, c; const volatile LAS int* TS; const GAS char* A; const GAS char* W; size_t aT  , wE  , wT  ;
    __device__ __forceinline__ bool next(int i, Unit& u) const {
        const int L = i * G + c; const int ntile = __builtin_amdgcn_readfirstlane(TS[32]); if (L >= ntile * 4) return false;
        const int rt = L >> 2, ct = L & 3; int e = 0;
        for (int j = 1; j < 32; ++j) e += (TS[j] <= rt) ? 1 : 0;
        e = __builtin_amdgcn_readfirstlane(e);
        u.pm = rt; u.pn = ct; u.e = e; u.a = A + (size_t)rt * aT; u.b = W + (size_t)e * wE + (size_t)ct * wT; return true;
    }
};

__device__ __forceinline__ u32x4 pack8(f32x4 v0, f32x4 v1) { u32x4 w; w.x = cvt_pk_bf16(v0[0], v0[1]); w.y = cvt_pk_bf16(v0[2], v0[3]); w.z = cvt_pk_bf16(v1[0], v1[1]); w.w = cvt_pk_bf16(v1[2], v1[3]); return w; }

struct EpiWin {
    static constexpr bool PERM = true;
    GAS bf16* LAT_; GAS bf16* FQKV_; GAS bf16* KPE_; GAS float* FLOG_; GAS float* SSQ_; const GAS float* COS_; const GAS float* SIN_;
    __device__ __forceinline__ void operator()(const f32x4 (&acc)[2][2][4][2], const Unit& u, int wr, int wc, int fr, int fq) const {
        GAS bf16* LAT = LAT_; GAS bf16* FQKV = FQKV_; GAS bf16* KPE = KPE_; GAS float* FLOG = FLOG_; GAS float* SSQ = SSQ_; const GAS float* COS = COS_; const GAS float* SIN = SIN_;
        asm volatile("" : "+s"(LAT), "+s"(FQKV), "+s"(KPE), "+s"(FLOG), "+s"(SSQ), "+s"(COS), "+s"(SIN));
        const int row0 = u.pm * 256 + wr * 64 + fr; const int pn = u.pn;
        if (pn >= 2) {
            const int ti = pn >> 1; GAS bf16* dst = FQKV + (size_t)(ti - 1) * NTOK * 512; const int colb = (pn & 1) * 256 + wc * 32 + 8 * fq; const float sc = (ti == 1) ? C2F : 1.f;
#pragma unroll
            for (int ai = 0; ai < 2; ++ai)
#pragma unroll
                for (int m = 0; m < 4; ++m) { GAS bf16* rowp = dst + (size_t)(row0 + ai * 128 + m * 16) * 512 + colb;
#pragma unroll
                    for (int bj = 0; bj < 2; ++bj) *(GAS u32x4*)(rowp + bj * 128) = pack8(acc[ai][bj][m][0] * sc, acc[ai][bj][m][1] * sc); }
        } else {
#pragma unroll
            for (int ai = 0; ai < 2; ++ai)
#pragma unroll
                for (int m = 0; m < 4; ++m) { const int row = row0 + ai * 128 + m * 16; GAS bf16* rowp = LAT + (size_t)row * 512 + pn * 256 + wc * 32 + 8 * fq;
#pragma unroll
                    for (int bj = 0; bj < 2; ++bj) *(GAS u32x4*)(rowp + bj * 128) = pack8(acc[ai][bj][m][0], acc[ai][bj][m][1]);
                    float s = 0.f;
#pragma unroll
                    for (int n = 0; n < 2; ++n) { const f32x4 x = acc[ai][0][m][n]; s += (x[0] * x[0] + x[1] * x[1]) + (x[2] * x[2] + x[3] * x[3]); }
                    if (pn == 0) {
#pragma unroll
                        for (int n = 0; n < 2; ++n) { const f32x4 x = acc[ai][1][m][n]; s += (x[0] * x[0] + x[1] * x[1]) + (x[2] * x[2] + x[3] * x[3]); }
                    }
                    s += __shfl_xor(s, 16); s += __shfl_xor(s, 32);
                    if (fq == 0) SSQ[(size_t)row * 8 + pn * 4 + wc] = s;
                    asm volatile("" ::: "memory"); }
            if (pn == 1 && wc == 0) {
#pragma unroll
                for (int ai = 0; ai < 2; ++ai)
#pragma unroll
                    for (int m = 0; m < 4; ++m) { const int row = row0 + ai * 128 + m * 16;
                        const f32x4 c = *(const GAS f32x4*)(COS + (size_t)row * 16 + 4 * fq), sn = *(const GAS f32x4*)(SIN + (size_t)row * 16 + 4 * fq);
                        const f32x4 x1 = acc[ai][1][m][0], x2 = acc[ai][1][m][1];
                        *(GAS u32x4*)(KPE + (size_t)row * 32 + 8 * fq) = pack8(x1 * c - x2 * sn, x1 * sn + x2 * c);
                        asm volatile("" ::: "memory"); }
            }
            if (pn == 1 && wc == 1 && fq == 0) {
#pragma unroll
                for (int ai = 0; ai < 2; ++ai)
#pragma unroll
                    for (int m = 0; m < 4; ++m) { const int row = row0 + ai * 128 + m * 16; *(GAS f32x4*)(FLOG + (size_t)row * 8) = acc[ai][1][m][0]; *(GAS f32x4*)(FLOG + (size_t)row * 8 + 4) = acc[ai][1][m][1]; }
            }
        }
    }
};
struct EpiUp {
    static constexpr bool PERM = true;
    GAS bf16* QM_; GAS bf16* KVM_; const GAS float* SSQ_; const GAS float* COS_; const GAS float* SIN_;
    __device__ __forceinline__ void operator()(const f32x4 (&acc)[2][2][4][2], const Unit& u, int wr, int wc, int fr, int fq) const {
        GAS bf16* QM = QM_; GAS bf16* KVM = KVM_; const GAS float* SSQ = SSQ_; const GAS float* COS = COS_; const GAS float* SIN = SIN_;
        asm volatile("" : "+s"(QM), "+s"(KVM), "+s"(SSQ), "+s"(COS), "+s"(SIN));
        const int row0 = u.pm * 256 + wr * 64 + fr; const int pn = u.pn; const bool kv = u.e != 0;
#pragma unroll
        for (int ai = 0; ai < 2; ++ai)
#pragma unroll
            for (int m = 0; m < 4; ++m) { const int row = row0 + ai * 128 + m * 16;
                const f32x4 sq = *(const GAS f32x4*)(SSQ + (size_t)row * 8 + (kv ? 4 : 0));
                const float ss = (sq[0] + sq[1]) + (sq[2] + sq[3]);
                if (kv) {
                    const float rs = rsqrtf(ss * (1.f / 128.f) + EPS);
                    GAS bf16* rowp = KVM + (size_t)row * 1024 + pn * 256 + wc * 32 + 8 * fq;
#pragma unroll
                    for (int bj = 0; bj < 2; ++bj) *(GAS u32x4*)(rowp + bj * 128) = pack8(acc[ai][bj][m][0] * rs, acc[ai][bj][m][1] * rs);
                } else {
                    const float rs = rsqrtf(ss * (1.f / 256.f) + EPS) * C2M;
                    GAS bf16* rowp = QM + (size_t)row * 768 + pn * 256 + wc * 32 + 8 * fq;
                    const f32x4 c = *(const GAS f32x4*)(COS + (size_t)row * 16 + 4 * fq), sn = *(const GAS f32x4*)(SIN + (size_t)row * 16 + 4 * fq);
#pragma unroll
                    for (int bj = 0; bj < 2; ++bj) { f32x4 v0 = acc[ai][bj][m][0] * rs, v1 = acc[ai][bj][m][1] * rs;
                        const int G = 8 * pn + 4 * bj + wc;
                        if (G % 3 == 2) { const f32x4 x1 = v0, x2 = v1; v0 = x1 * c - x2 * sn; v1 = x1 * sn + x2 * c; }
                        *(GAS u32x4*)(rowp + bj * 128) = pack8(v0, v1); }
                }
                asm volatile("" ::: "memory");
            }
    }
};
struct EpiOut {
    static constexpr bool PERM = false;
    const GAS float* resid_; GAS float* out_;
    __device__ __forceinline__ void operator()(const f32x4 (&acc)[2][2][4][2], const Unit& u, int wr, int wc, int fr, int fq) const {
        const GAS float* resid = resid_; GAS float* out = out_; asm volatile("" : "+s"(resid), "+s"(out));
        const int row0 = u.pm * 256 + wr * 64 + fr, col0 = u.pn * 256 + wc * 32 + 4 * fq;
#pragma unroll
        for (int ai = 0; ai < 2; ++ai)
#pragma unroll
            for (int m = 0; m < 4; ++m) { const size_t off = (size_t)(row0 + ai * 128 + m * 16) * DM + col0;
#pragma unroll
                for (int bj = 0; bj < 2; ++bj)
#pragma unroll
                    for (int n = 0; n < 2; ++n) { const f32x4 r = *(const GAS f32x4*)(resid + off + bj * 128 + n * 16); *(GAS f32x4*)(out + off + bj * 128 + n * 16) = r + acc[ai][bj][m][n]; } }
    }
};
struct EpiGU {
    static constexpr bool PERM = true;
    GAS unsigned char* HH_; const GAS float* RS_;
    __device__ __forceinline__ void operator()(const f32x4 (&acc)[2][2][4][2], const Unit& u, int wr, int wc, int fr, int fq) const {
        GAS unsigned char* HH = HH_; const GAS float* RS = RS_; asm volatile("" : "+s"(HH), "+s"(RS));
        const int row0 = u.pm * 256 + wr * 64 + fr;
#pragma unroll
        for (int ai = 0; ai < 2; ++ai)
#pragma unroll
            for (int m = 0; m < 4; ++m) { GAS unsigned char* rowp = HH + (size_t)(row0 + ai * 128 + m * 16) * 512 + u.pn * 128 + wc * 32 + 8 * fq; const float rs = RS[row0 + ai * 128 + m * 16] * WSCALE_INV;
                f32x4 h[2];
#pragma unroll
                for (int n = 0; n < 2; ++n) { const f32x4 g = acc[ai][0][m][n] * rs, up = acc[ai][1][m][n] * rs;
#pragma unroll
                    for (int j = 0; j < 4; ++j) { const float sg = __builtin_amdgcn_rcpf(1.f + __builtin_amdgcn_exp2f(-g[j] * LOG2E)); h[n][j] = g[j] * sg * up[j]; } }
                u32x2 w; w.x = pk4_fp8(h[0][0], h[0][1], h[0][2], h[0][3]); w.y = pk4_fp8(h[1][0], h[1][1], h[1][2], h[1][3]); *(GAS u32x2*)rowp = w; }
    }
};
struct EpiDown {
    static constexpr bool PERM = true;
    GAS bf16* Y_; const GAS float* GATEOF_;
    __device__ __forceinline__ void operator()(const f32x4 (&acc)[2][2][4][2], const Unit& u, int wr, int wc, int fr, int fq) const {
        GAS bf16* Y = Y_; const GAS float* GATEOF = GATEOF_; asm volatile("" : "+s"(Y), "+s"(GATEOF));
        const int row0 = u.pm * 256 + wr * 64 + fr;
#pragma unroll
        for (int ai = 0; ai < 2; ++ai)
#pragma unroll
            for (int m = 0; m < 4; ++m) { const int row = row0 + ai * 128 + m * 16; const float g = GATEOF[row] * WSCALE_INV; GAS bf16* rowp = Y + (size_t)row * 1024 + u.pn * 256 + wc * 32 + 8 * fq;
#pragma unroll
                for (int bj = 0; bj < 2; ++bj) *(GAS u32x4*)(rowp + bj * 128) = pack8(acc[ai][bj][m][0] * g, acc[ai][bj][m][1] * g); }
    }
};

namespace att {
constexpr int KSLOT = 12288, VSLOT = 8192;
constexpr int L_K = 0, L_V = 2 * KSLOT, L_BIAS = L_V + 2 * VSLOT, L_WS = L_BIAS + 8192, L_OST = L_WS + 8 * 64 * 4, L_END = L_OST + 8 * 4096;
__device__ __forceinline__ int crow(int r, int hi) { return (r & 3) + 8 * (r >> 2) + 4 * hi; }
typedef short v4i16_t __attribute__((ext_vector_type(4)));
__device__ __forceinline__ s16x4 vtr(const LAS char* p) { return __builtin_bit_cast(s16x4, __builtin_amdgcn_ds_read_tr16_b64_v4i16((LAS v4i16_t*)p)); }

constexpr int NSL = 5;
constexpr int R_K = 0, R_V = NSL * KSLOT, R_WS = R_V + NSL * VSLOT, R_OST = R_WS + 8 * 64 * 4, R_END = R_OST + 8 * 4096;
static_assert(R_END <= RING_BYTES, "attention LDS");
__device__ __forceinline__ void glds16(const GAS void* gsrc, unsigned lds_dst) { unsigned keep;
    asm volatile("s_mov_b32 %0, m0\n\ts_mov_b32 m0, %2\n\ts_nop 0\n\tglobal_load_lds_dwordx4 %1, off\n\ts_mov_b32 m0, %0" : "=&s"(keep) : "v"(gsrc), "s"(lds_dst) : "memory"); }
struct Tens2 { const GAS bf16* Q; int qp; const GAS bf16* K; int kp; const GAS bf16* KX; const GAS bf16* V; int vp; GAS bf16* O; const GAS float* BIASF; const GAS float* NRM; };
template <int MODE>
__device__ __forceinline__ void attn_unit2(const int tid, int b, int h, int qb, const Tens2& T, LAS char* shm) {
    constexpr int DKS = MODE ? 6 : 5;
    constexpr float THR = 8.f;
    const int lane = tid & 63, r32 = lane & 31, hi = lane >> 5; const int wid = __builtin_amdgcn_readfirstlane(tid >> 6);
    const long rowbase = (long)b * SEQ; const int q0 = qb * 256, qw0 = q0 + wid * 32;
    const int NT = (q0 + 256) / 64, tlast = qw0 / 64;
    int tstart = 0;
    if (MODE == 0) {
        const GAS float* bs = T.BIASF + ((long)b * 8 + h) * SEQ; const GAS float* nr = T.NRM + (b * 8 + h) * 16;
        const float Z = nr[qb] * nr[8] * 1.001f + 0.01f; const float bq0 = bs[q0];
        const float bend = bs[(lane < NT ? lane : NT - 1) * 64 + 63];
        const bool skip = (lane < NT - 4) && (2.f * Z + bend - bq0 < -40.f);
        tstart = __builtin_popcountll(__ballot(skip));
    }
    const int NTE = NT - tstart;
    const GAS bf16* Qw = T.Q + (rowbase + qw0) * T.qp + h * (MODE ? 96 : 64);
    const GAS bf16* Kh = T.K + rowbase * T.kp + h * (MODE ? 128 : 64);
    const GAS bf16* Vh = T.V + rowbase * T.vp + h * (MODE ? 128 : 64);
    LAS float* wsf = (LAS float*)(shm + R_WS) + wid * 64;
    bf16x8 qr[DKS];
    const GAS bf16* ksrc = Kh + (long)lane * T.kp + wid * 8;
    const GAS bf16* xsrc = MODE ? T.KX + (rowbase + lane) * 32 + (wid & 3) * 8 : T.KX + (((long)b * 8 + h) * SEQ + lane) * 8;
    const GAS bf16* vsrc = Vh + (long)(16 * (wid & 3) + (lane >> 2)) * T.vp + (wid >> 2) * 32 + (lane & 3) * 8;
    const int xstep = MODE ? 64 * 32 : 64 * 8;
    LAS char* kdst = shm + R_K + wid * 1024; LAS char* xdst = shm + R_K + (8 + (MODE ? (wid & 3) : 0)) * 1024; LAS char* vdst = shm + R_V + wid * 1024;
    const unsigned kdst_a = (unsigned)(uintptr_t)kdst, xdst_a = (unsigned)(uintptr_t)xdst, vdst_a = (unsigned)(uintptr_t)vdst;
#define A2_DMA(t, slot) do { \
        glds16((const GAS void*)(ksrc + (long)(t) * 64 * T.kp), (unsigned)__builtin_amdgcn_readfirstlane((int)(kdst_a + (slot) * KSLOT))); \
        glds16((const GAS void*)(xsrc + (long)(t) * xstep), (unsigned)__builtin_amdgcn_readfirstlane((int)(xdst_a + (slot) * KSLOT))); \
        glds16((const GAS void*)(vsrc + (long)(t) * 64 * T.vp), (unsigned)__builtin_amdgcn_readfirstlane((int)(vdst_a + (slot) * VSLOT))); } while (0)
    float mhat = 0.f, lrun = 0.f; f32x16 o[2]; o[0] = f32x16{}; o[1] = f32x16{}; f32x16 negm = f32x16{};
    const LAS char* vp0 = shm + R_V + ((lane >> 4) & 1) * 32 + (lane & 3) * 8 + (4 * hi + ((lane & 15) >> 2)) * 64;
    A2_DMA(NT - 1, 0); A2_DMA(NT - 2, 1); A2_DMA(NT - 3, 2);
#pragma unroll
    for (int d0 = 0; d0 < (MODE ? 6 : 4); ++d0) qr[d0] = *(const GAS bf16x8*)(Qw + (long)r32 * T.qp + d0 * 16 + hi * 8);
    if (MODE == 0) { const short one = hi ? (short)0 : (short)0x3F80; qr[DKS - 1] = (bf16x8){one, one, one, 0, 0, 0, 0, 0}; }
#pragma unroll
    for (int d0 = 0; d0 < DKS; ++d0) asm volatile("" : "+v"(qr[d0]));
#define A3_KLOAD(slot) do { const LAS char* kb_ = shm + R_K + (slot) * KSLOT + r32 * 16; _Pragma("unroll") for (int d0 = 0; d0 < DKS; ++d0) { const int off = (MODE == 0 && d0 == 4) ? 8 * 1024 : d0 * 2048 + hi * 1024; \
        kf[2 * d0] = *(const LAS bf16x8*)(kb_ + off); kf[2 * d0 + 1] = *(const LAS bf16x8*)(kb_ + off + 512); } } while (0)
#define A3_VLOAD(slot) do { const LAS char* vp_ = vp0 + (slot) * VSLOT; _Pragma("unroll") for (int q = 0; q < 8; ++q) { vlo[q] = vtr(vp_ + (q >> 2) * 4096 + (q & 3) * 1024); vhh[q] = vtr(vp_ + (q >> 2) * 4096 + (q & 3) * 1024 + 512); } } while (0)
#define A3_QK() do { c0 = negm; c1 = negm; _Pragma("unroll") for (int d0 = 0; d0 < DKS; ++d0) { c0 = __builtin_amdgcn_mfma_f32_32x32x16_bf16(kf[2 * d0], qr[d0], c0, 0, 0, 0); c1 = __builtin_amdgcn_mfma_f32_32x32x16_bf16(kf[2 * d0 + 1], qr[d0], c1, 0, 0, 0); } } while (0)
#define A3_EXP() do { float ls_ = 0.f; _Pragma("unroll") for (int r = 0; r < 16; ++r) { pp0[r] = __builtin_amdgcn_exp2f(pp0[r]); pp1[r] = __builtin_amdgcn_exp2f(pp1[r]); ls_ += pp0[r] + pp1[r]; } lrun += ls_; u32x4 w_; \
        w_.x = cvt_pk_bf16(pp0[0], pp0[1]); w_.y = cvt_pk_bf16(pp0[2], pp0[3]); w_.z = cvt_pk_bf16(pp0[4], pp0[5]); w_.w = cvt_pk_bf16(pp0[6], pp0[7]); pa[0] = __builtin_bit_cast(bf16x8, w_); \
        w_.x = cvt_pk_bf16(pp0[8], pp0[9]); w_.y = cvt_pk_bf16(pp0[10], pp0[11]); w_.z = cvt_pk_bf16(pp0[12], pp0[13]); w_.w = cvt_pk_bf16(pp0[14], pp0[15]); pa[1] = __builtin_bit_cast(bf16x8, w_); \
        w_.x = cvt_pk_bf16(pp1[0], pp1[1]); w_.y = cvt_pk_bf16(pp1[2], pp1[3]); w_.z = cvt_pk_bf16(pp1[4], pp1[5]); w_.w = cvt_pk_bf16(pp1[6], pp1[7]); pa[2] = __builtin_bit_cast(bf16x8, w_); \
        w_.x = cvt_pk_bf16(pp1[8], pp1[9]); w_.y = cvt_pk_bf16(pp1[10], pp1[11]); w_.z = cvt_pk_bf16(pp1[12], pp1[13]); w_.w = cvt_pk_bf16(pp1[14], pp1[15]); pa[3] = __builtin_bit_cast(bf16x8, w_); } while (0)
#define A3_PV() do { _Pragma("unroll") for (int d0 = 0; d0 < 2; ++d0) _Pragma("unroll") for (int k = 0; k < 4; ++k) { const s16x4 lo_ = vlo[4 * d0 + k], hh_ = vhh[4 * d0 + k]; \
        const bf16x8 vf_ = (bf16x8){lo_[0], lo_[1], lo_[2], lo_[3], hh_[0], hh_[1], hh_[2], hh_[3]}; o[d0] = __builtin_amdgcn_mfma_f32_32x32x16_bf16(pa[k], vf_, o[d0], 0, 0, 0); } } while (0)
#define A3_ROWMAX(rm) do { float a_ = fmaxf(fmaxf(c0[0], c0[1]), c1[0]), b_ = fmaxf(fmaxf(c0[2], c0[3]), c1[1]); a_ = fmaxf(fmaxf(a_, c1[2]), c1[3]); \
        _Pragma("unroll") for (int r = 4; r < 16; r += 4) { a_ = fmaxf(fmaxf(a_, c0[r]), c0[r + 1]); b_ = fmaxf(fmaxf(b_, c0[r + 2]), c0[r + 3]); a_ = fmaxf(fmaxf(a_, c1[r]), c1[r + 1]); b_ = fmaxf(fmaxf(b_, c1[r + 2]), c1[r + 3]); } \
        rm = fmaxf(a_, b_); const auto rr_ = __builtin_amdgcn_permlane32_swap(__float_as_uint(rm), __float_as_uint(rm), false, false); rm = fmaxf(__uint_as_float(rr_[0]), __uint_as_float(rr_[1])); } while (0)
    int sl = 0, sl3 = 3;
    f32x16 pp0 = f32x16{}, pp1 = f32x16{}; bool pend = false; int pslot = 0;
    for (int i = 0; i < NTE; ++i) {
        const int t = NT - 1 - i;
        { const int ahead = NTE - 1 - i;
          if (ahead >= 2) asm volatile("s_waitcnt vmcnt(6)" ::: "memory"); else if (ahead == 1) asm volatile("s_waitcnt vmcnt(3)" ::: "memory"); else asm volatile("s_waitcnt vmcnt(0)" ::: "memory"); }
        __builtin_amdgcn_s_barrier(); asm volatile("" ::: "memory");
        if (i + 3 < NTE) A2_DMA(t - 3, sl3);
        if (t <= tlast) {
            bf16x8 kf[2 * DKS]; f32x16 c0, c1; float rm;
            A3_KLOAD(sl);
            if (!pend) {
                A3_QK();
                if (MODE == 0) { const int qrel = qw0 + r32 - 64 * t;
#pragma unroll
                    for (int r = 0; r < 16; ++r) { const int kv = crow(r, hi); if (kv > qrel) c0[r] = -INFINITY; if (kv + 32 > qrel) c1[r] = -INFINITY; } }
                A3_ROWMAX(rm);
                mhat = rm;
#pragma unroll
                for (int r = 0; r < 16; ++r) { c0[r] -= rm; c1[r] -= rm; negm[r] = -mhat; }
                pend = true;
            } else {
                s16x4 vlo[8], vhh[8]; bf16x8 pa[4];
                A3_VLOAD(pslot);
                A3_QK();
                A3_EXP();
#pragma unroll
                for (int g_ = 0; g_ < 2 * DKS; ++g_) { __builtin_amdgcn_sched_group_barrier(0x008, 1, 0); __builtin_amdgcn_sched_group_barrier(0x002, 7, 0); }
                A3_PV();
                A3_ROWMAX(rm);
#pragma unroll
                for (int g_ = 0; g_ < 8; ++g_) { __builtin_amdgcn_sched_group_barrier(0x008, 1, 0); __builtin_amdgcn_sched_group_barrier(0x002, 3, 0); }
                if (__any(rm > THR)) {
                    const float dl = fmaxf(rm, 0.f); mhat += dl;
#pragma unroll
                    for (int r = 0; r < 16; ++r) { c0[r] -= dl; c1[r] -= dl; negm[r] = -mhat; }
                    const float f = __builtin_amdgcn_exp2f(-dl); lrun *= f;
                    if (hi == 0) wsf[r32] = f;
                    LDS_WAIT();
#pragma unroll
                    for (int g = 0; g < 4; ++g) { const f32x4 ff = *(const LAS f32x4*)(wsf + 8 * g + 4 * hi);
#pragma unroll
                        for (int j = 0; j < 4; ++j) { o[0][4 * g + j] *= ff[j]; o[1][4 * g + j] *= ff[j]; } }
                }
            }
            pp0 = c0; pp1 = c1; pslot = sl;
        }
        sl = (sl == NSL - 1) ? 0 : sl + 1; sl3 = (sl3 == NSL - 1) ? 0 : sl3 + 1;
    }
    if (pend) { s16x4 vlo[8], vhh[8]; bf16x8 pa[4]; A3_VLOAD(pslot); A3_EXP(); A3_PV(); }
#undef A3_KLOAD
#undef A3_VLOAD
#undef A3_QK
#undef A3_EXP
#undef A3_PV
#undef A3_ROWMAX
#undef A2_DMA
    lrun += __shfl_xor(lrun, 32);
    LDS_WAIT();
    if (hi == 0) wsf[32 + r32] = lrun;
    LDS_WAIT();
    float rli[16];
#pragma unroll
    for (int g = 0; g < 4; ++g) { const f32x4 ll = *(const LAS f32x4*)(wsf + 32 + 8 * g + 4 * hi);
#pragma unroll
        for (int j = 0; j < 4; ++j) rli[4 * g + j] = __builtin_amdgcn_rcpf(ll[j]); }
    GAS bf16* Ow = T.O + (rowbase + qw0) * 1024 + (MODE ? 0 : 512) + h * 64;
    { LAS bf16* stg = (LAS bf16*)(shm + R_OST) + wid * 2048;
#pragma unroll
      for (int r = 0; r < 16; ++r) { const int orow = crow(r, hi);
#pragma unroll
          for (int d0 = 0; d0 < 2; ++d0) stg[orow * 64 + d0 * 32 + r32] = (bf16)(cvt_pk_bf16(o[d0][r] * rli[r], 0.f) & 0xffffu); }
      LDS_WAIT();
#pragma unroll
      for (int i = 0; i < 4; ++i) { const int row = i * 8 + (lane >> 3), ch = lane & 7; const u32x4 v = *(const LAS u32x4*)(stg + row * 64 + ch * 8); *(GAS u32x4*)(Ow + (long)row * 1024 + ch * 8) = v; } }
    LDS_WAIT(); __builtin_amdgcn_s_barrier(); asm volatile("" ::: "memory");
}
}

struct Args { const void* in[21]; float* out; unsigned char* ws; int ph_lo, ph_hi; };

__device__ __forceinline__ void tr_item(const GAS float* __restrict__ W, int ldw, int Ksrc, const GAS float* __restrict__ gain, GAS bf16* __restrict__ WT, int ldk, int k0, int n0, int srccol, LAS float* scr, int lane) {
#pragma unroll 8
    for (int i = 0; i < 32; ++i) { const int kk = 2 * i + (lane >> 5); const int k = k0 + kk;
        float v = 0.f; if (srccol >= 0 && k < Ksrc) { v = W[(size_t)k * ldw + srccol]; if (gain) v *= gain[k]; }
        scr[kk * 33 + (lane & 31)] = v; }
    LDS_WAIT(); asm volatile("" ::: "memory");
    const int c = lane & 7;
#pragma unroll
    for (int j = 0; j < 4; ++j) { const int n = (lane >> 3) + 8 * j; const LAS float* s = scr + (8 * c) * 33 + n;
        u32x4 o; o.x = cvt_pk_bf16(s[0 * 33], s[1 * 33]); o.y = cvt_pk_bf16(s[2 * 33], s[3 * 33]); o.z = cvt_pk_bf16(s[4 * 33], s[5 * 33]); o.w = cvt_pk_bf16(s[6 * 33], s[7 * 33]);
        *(GAS u32x4*)(WT + (size_t)(n0 + n) * ldk + k0 + 8 * c) = o; }
    LDS_WAIT(); asm volatile("" ::: "memory");
}
__device__ __forceinline__ void tr_item64(const GAS float* __restrict__ W, int ldw, const GAS float* __restrict__ gain, GAS bf16* __restrict__ WT, int ldk, int k0, int n0src, int n0dst, LAS float* scr, int lane) {
    const int rr = lane >> 4, c4 = (lane & 15) * 4;
    f32x4 v[16];
#pragma unroll
    for (int i = 0; i < 16; ++i) v[i] = *(const GAS f32x4*)(W + (size_t)(k0 + 4 * i + rr) * ldw + n0src + c4);
#pragma unroll
    for (int i = 0; i < 16; ++i) { const int k = 4 * i + rr; const float g = gain ? gain[k0 + k] : 1.f; LAS float* d = scr + k * 65 + c4;
        d[0] = v[i][0] * g; d[1] = v[i][1] * g; d[2] = v[i][2] * g; d[3] = v[i][3] * g; }
    LDS_WAIT(); asm volatile("" ::: "memory");
    const int kc = lane & 7;
#pragma unroll
    for (int j = 0; j < 8; ++j) { const int n = (lane >> 3) + 8 * j; const LAS float* sp = scr + (8 * kc) * 65 + n;
        u32x4 o; o.x = cvt_pk_bf16(sp[0 * 65], sp[1 * 65]); o.y = cvt_pk_bf16(sp[2 * 65], sp[3 * 65]); o.z = cvt_pk_bf16(sp[4 * 65], sp[5 * 65]); o.w = cvt_pk_bf16(sp[6 * 65], sp[7 * 65]);
        *(GAS u32x4*)(WT + (size_t)(n0dst + n) * ldk + k0 + 8 * kc) = o; }
    LDS_WAIT(); asm volatile("" ::: "memory");
}
__device__ __forceinline__ void tr_item64_f8(const GAS float* __restrict__ W, int ldw, const GAS float* __restrict__ gain, float scale, GAS unsigned char* __restrict__ WT8, int ldkB, int k0, int n0src, int n0dst, LAS float* scr, int lane) {
    const int rr = lane >> 4, c4 = (lane & 15) * 4;
    f32x4 v[16];
#pragma unroll
    for (int i = 0; i < 16; ++i) v[i] = *(const GAS f32x4*)(W + (size_t)(k0 + 4 * i + rr) * ldw + n0src + c4);
#pragma unroll
    for (int i = 0; i < 16; ++i) { const int k = 4 * i + rr; const float g = (gain ? gain[k0 + k] : 1.f) * scale; LAS float* d = scr + k * 65 + c4;
        d[0] = v[i][0] * g; d[1] = v[i][1] * g; d[2] = v[i][2] * g; d[3] = v[i][3] * g; }
    LDS_WAIT(); asm volatile("" ::: "memory");
    const int kc = lane & 7;
#pragma unroll
    for (int j = 0; j < 8; ++j) { const int n = (lane >> 3) + 8 * j; const LAS float* sp = scr + (8 * kc) * 65 + n;
        u32x2 o; o.x = pk4_fp8(sp[0 * 65], sp[1 * 65], sp[2 * 65], sp[3 * 65]); o.y = pk4_fp8(sp[4 * 65], sp[5 * 65], sp[6 * 65], sp[7 * 65]);
        *(GAS u32x2*)(WT8 + (size_t)(n0dst + n) * ldkB + k0 + 8 * kc) = o; }
    LDS_WAIT(); asm volatile("" ::: "memory");
}
__device__ __forceinline__ int rope_dim(int p) { const int a = p >> 3, j = p & 7; return j < 4 ? 4 * a + j : 16 + 4 * a + (j - 4); }

#define LDP(i) ((void*)((((unsigned long long)(unsigned)__builtin_amdgcn_readfirstlane((int)(ARGP[i] >> 32))) << 32) | (unsigned long long)(unsigned)__builtin_amdgcn_readfirstlane((int)(unsigned)ARGP[i])))
#define ARGIN(i) ((const void*)LDP(i))
#define P_COS ((GAS float*)(ws + WS_COS))
#define P_SIN ((GAS float*)(ws + WS_SIN))
#define P_SSQ ((GAS float*)(ws + WS_SSQ))
#define P_FLOG ((GAS float*)(ws + WS_FLOG))
#define P_E01 ((GAS int*)(ws + WS_E01))
#define P_G01 ((GAS float*)(ws + WS_G01))
#define P_SLOT ((GAS int*)(ws + WS_SLOT))
#define P_TOKOF ((GAS int*)(ws + WS_TOKOF))
#define P_GATEOF ((GAS float*)(ws + WS_GATEOF))
#define P_CNT ((GAS int*)(ws + WS_CNT))
#define P_TSTART ((GAS int*)(ws + WS_TSTART))
#define P_RSTD ((GAS float*)(ws + WS_RSTD))
#define P_RSTDOF ((GAS float*)(ws + WS_RSTDOF))
#define P_KPE ((GAS bf16*)(ws + WS_KPE))
#define P_KAUG ((GAS bf16*)(ws + WS_KAUG))
#define P_BIASF ((GAS float*)(ws + WS_BIASF))
#define P_NRM ((GAS float*)(ws + WS_NRM))
#define P_WIN ((GAS bf16*)(ws + WS_WIN))
#define P_WUQ ((GAS bf16*)(ws + WS_WUQ))
#define P_WUKV ((GAS bf16*)(ws + WS_WUKV))
#define P_WOUT ((GAS bf16*)(ws + WS_WOUT))
#define P_WGU ((GAS bf16*)(ws + WS_WGU))
#define P_WD ((GAS bf16*)(ws + WS_WD))
#define P_XN ((GAS bf16*)(ws + WS_XN))
#define P_FQKV ((GAS bf16*)(ws + WS_FQKV))
#define P_HH ((GAS bf16*)(ws + WS_FQKV))
#define P_LAT ((GAS bf16*)(ws + WS_LAT))
#define P_QM ((GAS bf16*)(ws + WS_QM))
#define P_KVM ((GAS bf16*)(ws + WS_KVM))
#define P_Y ((GAS bf16*)(ws + WS_Y))
#define IN(k) (lo <= (k) && (k) < hi_)
#if MK_ONE_LAUNCH
#define GRID_BAR() xcd_barrier(bar)
#else
#define GRID_BAR() do {} while (0)
#endif
#define SEAM(k) do { if (IN(k) && IN((k) + 1)) GRID_BAR(); } while (0)
template <int l>
__device__ __forceinline__ void layer_body(const int lo, const int hi_, LAS unsigned char* lds0, const int wave0, const int G0, const int bx0, const XcdBarrier& bar) {
        const int P = 10 * l;
        if (IN(P)) for (int rep_ = 0; rep_ < (l == 0 ? NREP(0) : 1); ++rep_) {
            unsigned ldsb_ = (unsigned)(uintptr_t)lds0; asm volatile("" : "+s"(ldsb_)); LAS unsigned char* lds = (LAS unsigned char*)(uintptr_t)ldsb_; volatile LAS unsigned* MISC = (volatile LAS unsigned*)(lds + MISC_OFF); volatile LAS unsigned long long* ARGP = (volatile LAS unsigned long long*)(lds + MISC_OFF + 768); (void)MISC; int wave = wave0, G = G0, bx = bx0; asm volatile("" : "+s"(G), "+s"(bx), "+s"(wave)); const int lane = (int)__builtin_amdgcn_mbcnt_hi(~0u, __builtin_amdgcn_mbcnt_lo(~0u, 0u)); const int tid = wave * 64 + lane; const int vcu = (bx % 8) * (G / 8) + bx / 8; const int gw = vcu * 8 + wave, NGW = G * 8; (void)lane; (void)gw; (void)NGW; (void)vcu;
            GAS unsigned char* ws = (GAS unsigned char*)LDP(22); GAS float* out = (GAS float*)LDP(21); const GAS float* x_in = (const GAS float*)ARGIN(0); const GAS int* positions = (const GAS int*)ARGIN(1);
            if (l < NLAYER) {
                LAS float* scr = (LAS float*)(lds + wave * 16640);
                const GAS float* attn_norm = (const GAS float*)ARGIN(2) + (size_t)l * DM; const GAS float* w_in = (const GAS float*)ARGIN(3) + (size_t)l * DM * INW;
                const GAS float* q_norm = (const GAS float*)ARGIN(5) + (size_t)l * 256; const GAS float* w_uq = (const GAS float*)ARGIN(6) + (size_t)l * 256 * 768;
                const GAS float* kv_norm = (const GAS float*)ARGIN(7) + (size_t)l * 128; const GAS float* w_ukv = (const GAS float*)ARGIN(8) + (size_t)l * 128 * 1024;
                const GAS float* mla_on = (const GAS float*)ARGIN(9) + (size_t)l * 512; const GAS float* fox_on = (const GAS float*)ARGIN(10) + (size_t)l * 512; const GAS float* w_out = (const GAS float*)ARGIN(11) + (size_t)l * DM * DM;
                const GAS float* ffn_norm = (const GAS float*)ARGIN(12) + (size_t)l * DM;
                const GAS float* w_gate = (const GAS float*)ARGIN(17) + (size_t)l * NEXP * DM * DEXP; const GAS float* w_up = (const GAS float*)ARGIN(18) + (size_t)l * NEXP * DM * DEXP; const GAS float* w_down = (const GAS float*)ARGIN(19) + (size_t)l * NEXP * DEXP * DM;
                constexpr int I_IN = 16 * 64, I_UQ = 4 * 24, I_UKV = 4 * 32;
                constexpr int NITEMS = I_IN + I_UQ + I_UKV;
                for (int it = gw; it < NITEMS; it += NGW) {
                    int r = it; const int j = lane & 31;
                    if (r < I_IN) { const int kb = r / 64, nb = r % 64; const int n = nb * 32 + j; int sc;
                        if (n < 384) sc = n; else if (n < 416) sc = 384 + rope_dim(n - 384); else if (n < 424) sc = 1952 + (n - 416); else if (n < 512) sc = -1; else sc = 416 + (n - 512);
                        tr_item(w_in, INW, DM, attn_norm, P_WIN, DM, kb * 64, nb * 32, sc, scr, lane); continue; } r -= I_IN;
                    if (r < I_UQ) { const int kb = r / 24, nb = r % 24; const int n = nb * 32 + j; const int hh = n / 96, d = n % 96; const int sc = d < 64 ? n : hh * 96 + 64 + rope_dim(d - 64);
                        tr_item(w_uq, 768, 256, q_norm, P_WUQ, 256, kb * 64, nb * 32, sc, scr, lane); continue; } r -= I_UQ;
                    { const int kb = r / 32, nb = r % 32; tr_item(w_ukv, 1024, 128, kv_norm, P_WUKV, 256, kb * 64, nb * 32, nb * 32 + j, scr, lane); }
                }
                LAS float* scr64 = (LAS float*)(lds + wave * 16640);
                constexpr int J_OUT = 16 * 16, J_GU = 16 * 16 * NEXP, J_D = 8 * 16 * NEXP;
                for (int it = gw; it < J_OUT + J_GU + J_D; it += NGW) {
                    int r = it;
                    if (r < J_OUT) { const int kb = r / 16, nb = r % 16; const GAS float* gn = kb < 8 ? mla_on : fox_on - 512; tr_item64(w_out, DM, gn, P_WOUT, DM, kb * 64, nb * 64, nb * 64, scr64, lane); continue; } r -= J_OUT;
                    if (r < J_GU) { const int e = r / 256, q = r % 256, kb = q / 16, nb = q % 16; const int n0 = nb * 64; const int ct = n0 >> 8, which = (n0 >> 7) & 1, jj = n0 & 127;
                        const GAS float* src = (which ? w_up : w_gate) + (size_t)e * DM * DEXP;
                        tr_item64_f8(src, DEXP, ffn_norm, WSCALE, (GAS unsigned char*)P_WGU + (size_t)e * 1024 * 1024, DM, kb * 64, ct * 128 + jj, n0, scr64, lane); continue; } r -= J_GU;
                    { const int e = r / 128, q = r % 128, kb = q / 16, nb = q % 16;
                        tr_item64_f8(w_down + (size_t)e * DEXP * DM, DM, nullptr, WSCALE, (GAS unsigned char*)P_WD + (size_t)e * 1024 * 512, DEXP, kb * 64, nb * 64, nb * 64, scr64, lane); }
                }
            }
            const GAS float* fin = (const GAS float*)ARGIN(20);
            for (int m = gw; m < NTOK; m += NGW) {
                const GAS float* xr = (l == 0 ? x_in : out) + (size_t)m * DM;
                f32x4 v[4];
#pragma unroll
                for (int j = 0; j < 4; ++j) v[j] = *(const GAS f32x4*)(xr + 4 * lane + 256 * j);
                if (l > 0) {
                    const int s0 = P_SLOT[2 * m], s1 = P_SLOT[2 * m + 1];
#pragma unroll
                    for (int j = 0; j < 4; ++j) { const u32x2 a = *(const GAS u32x2*)(P_Y + (size_t)s0 * 1024 + 4 * lane + 256 * j), c = *(const GAS u32x2*)(P_Y + (size_t)s1 * 1024 + 4 * lane + 256 * j);
                        v[j][0] += __uint_as_float(a.x << 16) + __uint_as_float(c.x << 16); v[j][1] += __uint_as_float(a.x & 0xffff0000u) + __uint_as_float(c.x & 0xffff0000u);
                        v[j][2] += __uint_as_float(a.y << 16) + __uint_as_float(c.y << 16); v[j][3] += __uint_as_float(a.y & 0xffff0000u) + __uint_as_float(c.y & 0xffff0000u); }
                }
                float s = 0.f;
#pragma unroll
                for (int j = 0; j < 4; ++j) s += (v[j][0] * v[j][0] + v[j][1] * v[j][1]) + (v[j][2] * v[j][2] + v[j][3] * v[j][3]);
                const float rstd = rsqrtf(wave_sum(s) * (1.f / DM) + EPS);
                if (l < NLAYER) {
                    if (l > 0) {
#pragma unroll
                        for (int j = 0; j < 4; ++j) *(GAS f32x4*)(out + (size_t)m * DM + 4 * lane + 256 * j) = v[j];
                    }
#pragma unroll
                    for (int j = 0; j < 4; ++j) { u32x2 w; w.x = cvt_pk_bf16(v[j][0] * rstd, v[j][1] * rstd); w.y = cvt_pk_bf16(v[j][2] * rstd, v[j][3] * rstd); *(GAS u32x2*)(P_XN + (size_t)m * DM + 4 * lane + 256 * j) = w; }
                } else {
#pragma unroll
                    for (int j = 0; j < 4; ++j) { const f32x4 g = *(const GAS f32x4*)(fin + 4 * lane + 256 * j); *(GAS f32x4*)(out + (size_t)m * DM + 4 * lane + 256 * j) = v[j] * rstd * g; }
                }
            }
        }
        if constexpr (l == NLAYER) return;
        SEAM(P);
        if (IN(P + 1)) for (int rep_ = 0; rep_ < ((l == 0 || 1 != 5) ? NREP(1) : 1); ++rep_) {
            unsigned ldsb_ = (unsigned)(uintptr_t)lds0; asm volatile("" : "+s"(ldsb_)); LAS unsigned char* lds = (LAS unsigned char*)(uintptr_t)ldsb_; volatile LAS unsigned* MISC = (volatile LAS unsigned*)(lds + MISC_OFF); volatile LAS unsigned long long* ARGP = (volatile LAS unsigned long long*)(lds + MISC_OFF + 768); (void)MISC; int wave = wave0, G = G0, bx = bx0; asm volatile("" : "+s"(G), "+s"(bx), "+s"(wave)); const int lane = (int)__builtin_amdgcn_mbcnt_hi(~0u, __builtin_amdgcn_mbcnt_lo(~0u, 0u)); const int tid = wave * 64 + lane; const int vcu = (bx % 8) * (G / 8) + bx / 8; const int gw = vcu * 8 + wave, NGW = G * 8; (void)lane; (void)gw; (void)NGW; (void)vcu;
            GAS unsigned char* ws = (GAS unsigned char*)LDP(22); GAS float* out = (GAS float*)LDP(21); const GAS float* x_in = (const GAS float*)ARGIN(0); (void)out; (void)x_in; (void)ws;
            DenseOrder S{NTOK / 256, INP / 256, (NTOK / 256) * (INP / 256), G, bx, (const GAS char*)P_XN, (const GAS char*)P_WIN, (size_t)256 * DM * 2, (size_t)256 * DM * 2};
            EpiWin E{P_LAT, P_FQKV, P_KPE, P_FLOG, P_SSQ, P_COS, P_SIN};
            pg8::gemm_phase<EpiWin, DenseOrder, true, false>(tid, lds, DM * 2, DM * 2, DM * 2, S, E, nullptr);
        }
        SEAM(P + 1);
        if (IN(P + 2)) for (int rep_ = 0; rep_ < ((l == 0 || 2 != 5) ? NREP(2) : 1); ++rep_) {
            unsigned ldsb_ = (unsigned)(uintptr_t)lds0; asm volatile("" : "+s"(ldsb_)); LAS unsigned char* lds = (LAS unsigned char*)(uintptr_t)ldsb_; volatile LAS unsigned* MISC = (volatile LAS unsigned*)(lds + MISC_OFF); volatile LAS unsigned long long* ARGP = (volatile LAS unsigned long long*)(lds + MISC_OFF + 768); (void)MISC; int wave = wave0, G = G0, bx = bx0; asm volatile("" : "+s"(G), "+s"(bx), "+s"(wave)); const int lane = (int)__builtin_amdgcn_mbcnt_hi(~0u, __builtin_amdgcn_mbcnt_lo(~0u, 0u)); const int tid = wave * 64 + lane; const int vcu = (bx % 8) * (G / 8) + bx / 8; const int gw = vcu * 8 + wave, NGW = G * 8; (void)lane; (void)gw; (void)NGW; (void)vcu;
            GAS unsigned char* ws = (GAS unsigned char*)LDP(22); GAS float* out = (GAS float*)LDP(21); const GAS float* x_in = (const GAS float*)ARGIN(0); (void)out; (void)x_in; (void)ws;
            if (vcu < 128) {
                const int b = vcu >> 3, h = vcu & 7; const float bf = ((const GAS float*)ARGIN(4))[l * 8 + h];
                const GAS float* fl = P_FLOG + ((size_t)b * SEQ + 4 * tid) * 8 + h;
                float lf[4];
#pragma unroll
                for (int e = 0; e < 4; ++e) { const float f = fl[e * 8] + bf; lf[e] = fminf(f, 0.f) - log1pf(expf(-fabsf(f))); }
                const double s4 = ((double)lf[0] + (double)lf[1]) + ((double)lf[2] + (double)lf[3]);
                double incl = s4;
#pragma unroll
                for (int o = 1; o < 64; o <<= 1) { const double t = __shfl_up(incl, o); if (lane >= o) incl += t; }
                LAS double* wtot = (LAS double*)lds;
                if (lane == 63) wtot[wave] = incl;
                __syncthreads();
                double c = incl - s4;
                for (int w = 0; w < wave; ++w) c += wtot[w];
                GAS u32x4* ka = (GAS u32x4*)(P_KAUG + (((size_t)b * 8 + h) * SEQ + 4 * tid) * 8);
#pragma unroll
                for (int e = 0; e < 4; ++e) { c += (double)lf[e]; const float x = (float)(-c * 1.4426950408889634);
                    const unsigned h16 = cvt_pk_bf16(x, 0.f) & 0xffffu; const float r1 = x - __uint_as_float(h16 << 16); const unsigned m16 = cvt_pk_bf16(r1, 0.f) & 0xffffu; const float r2 = r1 - __uint_as_float(m16 << 16); const unsigned l16 = cvt_pk_bf16(r2, 0.f) & 0xffffu;
                    ka[e] = (u32x4){h16 | (m16 << 16), l16, 0u, 0u}; P_BIASF[((size_t)b * 8 + h) * SEQ + 4 * tid + e] = x; }
                float qn = 0.f, kn = 0.f;
                { const GAS bf16* fqp = P_FQKV + ((size_t)b * SEQ + 4 * tid) * 512 + h * 64; const GAS bf16* fkp = fqp + (size_t)NTOK * 512;
#pragma unroll
                  for (int e = 0; e < 4; ++e) { float sq = 0.f, sk = 0.f;
#pragma unroll
                      for (int c8 = 0; c8 < 8; ++c8) { const u32x4 a = *(const GAS u32x4*)(fqp + e * 512 + c8 * 8), k4 = *(const GAS u32x4*)(fkp + e * 512 + c8 * 8);
#pragma unroll
                          for (int j = 0; j < 4; ++j) { const float a0 = __uint_as_float(a[j] << 16), a1 = __uint_as_float(a[j] & 0xffff0000u), k0 = __uint_as_float(k4[j] << 16), k1 = __uint_as_float(k4[j] & 0xffff0000u);
                              sq += a0 * a0 + a1 * a1; sk += k0 * k0 + k1 * k1; } }
                      qn = fmaxf(qn, sq); kn = fmaxf(kn, sk); } }
#pragma unroll
                for (int o = 1; o < 64; o <<= 1) { qn = fmaxf(qn, __shfl_xor(qn, o)); kn = fmaxf(kn, __shfl_xor(kn, o)); }
                LAS float* knw = (LAS float*)(lds + 256);
                if (lane == 0) { P_NRM[(b * 8 + h) * 16 + wave] = sqrtf(qn); knw[wave] = kn; }
                __syncthreads();
                if (tid == 0) { float m = knw[0]; for (int w = 1; w < 8; ++w) m = fmaxf(m, knw[w]); P_NRM[(b * 8 + h) * 16 + 8] = sqrtf(m); }
                __syncthreads();
            }
            UpOrder S{G, vcu, (const GAS char*)P_LAT, (const GAS char*)P_WUQ, (const GAS char*)P_WUKV};
            EpiUp E{P_QM, P_KVM, P_SSQ, P_COS, P_SIN};
            pg8::gemm_phase<EpiUp, UpOrder, true, false>(tid, lds, 256 * 2, 512 * 2, 256 * 2, S, E, nullptr);
        }
        SEAM(P + 2);
        if (IN(P + 3)) for (int rep_ = 0; rep_ < ((l == 0 || 3 != 5) ? NREP(3) : 1); ++rep_) {
            unsigned ldsb_ = (unsigned)(uintptr_t)lds0; asm volatile("" : "+s"(ldsb_)); LAS unsigned char* lds = (LAS unsigned char*)(uintptr_t)ldsb_; volatile LAS unsigned* MISC = (volatile LAS unsigned*)(lds + MISC_OFF); volatile LAS unsigned long long* ARGP = (volatile LAS unsigned long long*)(lds + MISC_OFF + 768); (void)MISC; int wave = wave0, G = G0, bx = bx0; asm volatile("" : "+s"(G), "+s"(bx), "+s"(wave)); const int lane = (int)__builtin_amdgcn_mbcnt_hi(~0u, __builtin_amdgcn_mbcnt_lo(~0u, 0u)); const int tid = wave * 64 + lane; const int vcu = (bx % 8) * (G / 8) + bx / 8; const int gw = vcu * 8 + wave, NGW = G * 8; (void)lane; (void)gw; (void)NGW; (void)vcu;
            GAS unsigned char* ws = (GAS unsigned char*)LDP(22); GAS float* out = (GAS float*)LDP(21); const GAS float* x_in = (const GAS float*)ARGIN(0); (void)out; (void)x_in; (void)ws;
            GAS bf16* O = P_XN;
            const int b = vcu >> 4, hh = (vcu & 15) >> 1, sub = vcu & 1;
            const att::Tens2 TM{P_QM, 768, P_KVM, 1024, P_KPE, P_KVM + 64, 1024, O, nullptr, nullptr};
            const att::Tens2 TF{P_FQKV, 512, P_FQKV + (size_t)NTOK * 512, 512, P_KAUG, P_FQKV + (size_t)2 * NTOK * 512, 512, O, P_BIASF, P_NRM};
            for (int i = 0; i < 4; ++i) { const int s = 2 * sub + (i >> 1); const int qb = (i & 1) ? 7 - s : s; att::attn_unit2<1>(tid, b, hh, qb, TM, (LAS char*)lds); }
            for (int i = 0; i < 4; ++i) { const int s = 2 * sub + (i >> 1); const int qb = (i & 1) ? 7 - s : s; att::attn_unit2<0>(tid, b, hh, qb, TF, (LAS char*)lds); }
        }
        SEAM(P + 3);
        if (IN(P + 4)) for (int rep_ = 0; rep_ < ((l == 0 || 4 != 5) ? NREP(4) : 1); ++rep_) {
            unsigned ldsb_ = (unsigned)(uintptr_t)lds0; asm volatile("" : "+s"(ldsb_)); LAS unsigned char* lds = (LAS unsigned char*)(uintptr_t)ldsb_; volatile LAS unsigned* MISC = (volatile LAS unsigned*)(lds + MISC_OFF); volatile LAS unsigned long long* ARGP = (volatile LAS unsigned long long*)(lds + MISC_OFF + 768); (void)MISC; int wave = wave0, G = G0, bx = bx0; asm volatile("" : "+s"(G), "+s"(bx), "+s"(wave)); const int lane = (int)__builtin_amdgcn_mbcnt_hi(~0u, __builtin_amdgcn_mbcnt_lo(~0u, 0u)); const int tid = wave * 64 + lane; const int vcu = (bx % 8) * (G / 8) + bx / 8; const int gw = vcu * 8 + wave, NGW = G * 8; (void)lane; (void)gw; (void)NGW; (void)vcu;
            GAS unsigned char* ws = (GAS unsigned char*)LDP(22); GAS float* out = (GAS float*)LDP(21); const GAS float* x_in = (const GAS float*)ARGIN(0); (void)out; (void)x_in; (void)ws;
            GAS bf16* O = P_XN;
            for (int m = gw; m < NTOK; m += NGW) {
                GAS bf16* orow = O + (size_t)m * DM;
                const u32x4 a = *(const GAS u32x4*)(orow + 8 * lane), c = *(const GAS u32x4*)(orow + 512 + 8 * lane);
                float fa[8], fc[8];
#pragma unroll
                for (int j = 0; j < 4; ++j) { fa[2 * j] = __uint_as_float(a[j] << 16); fa[2 * j + 1] = __uint_as_float(a[j] & 0xffff0000u); fc[2 * j] = __uint_as_float(c[j] << 16); fc[2 * j + 1] = __uint_as_float(c[j] & 0xffff0000u); }
                float sa = 0.f, sc = 0.f;
#pragma unroll
                for (int j = 0; j < 8; ++j) { sa += fa[j] * fa[j]; sc += fc[j] * fc[j]; }
                const float ra = rsqrtf(wave_sum(sa) * (1.f / 512.f) + EPS), rc = rsqrtf(wave_sum(sc) * (1.f / 512.f) + EPS);
                u32x4 oa, oc;
#pragma unroll
                for (int j = 0; j < 4; ++j) { oa[j] = cvt_pk_bf16(fa[2 * j] * ra, fa[2 * j + 1] * ra); oc[j] = cvt_pk_bf16(fc[2 * j] * rc, fc[2 * j + 1] * rc); }
                *(GAS u32x4*)(orow + 8 * lane) = oa; *(GAS u32x4*)(orow + 512 + 8 * lane) = oc;
            }
        }
        SEAM(P + 4);
        if (IN(P + 5)) for (int rep_ = 0; rep_ < ((l == 0 || 5 != 5) ? NREP(5) : 1); ++rep_) {
            unsigned ldsb_ = (unsigned)(uintptr_t)lds0; asm volatile("" : "+s"(ldsb_)); LAS unsigned char* lds = (LAS unsigned char*)(uintptr_t)ldsb_; volatile LAS unsigned* MISC = (volatile LAS unsigned*)(lds + MISC_OFF); volatile LAS unsigned long long* ARGP = (volatile LAS unsigned long long*)(lds + MISC_OFF + 768); (void)MISC; int wave = wave0, G = G0, bx = bx0; asm volatile("" : "+s"(G), "+s"(bx), "+s"(wave)); const int lane = (int)__builtin_amdgcn_mbcnt_hi(~0u, __builtin_amdgcn_mbcnt_lo(~0u, 0u)); const int tid = wave * 64 + lane; const int vcu = (bx % 8) * (G / 8) + bx / 8; const int gw = vcu * 8 + wave, NGW = G * 8; (void)lane; (void)gw; (void)NGW; (void)vcu;
            GAS unsigned char* ws = (GAS unsigned char*)LDP(22); GAS float* out = (GAS float*)LDP(21); const GAS float* x_in = (const GAS float*)ARGIN(0); (void)out; (void)x_in; (void)ws;
            DenseOrder S{NTOK / 256, DM / 256, (NTOK / 256) * (DM / 256), G, bx, (const GAS char*)P_XN, (const GAS char*)P_WOUT, (size_t)256 * DM * 2, (size_t)256 * DM * 2};
            EpiOut E{l == 0 ? x_in : out, out};
            pg8::gemm_phase<EpiOut, DenseOrder, true, false>(tid, lds, DM * 2, DM * 2, DM * 2, S, E, nullptr);
        }
        SEAM(P + 5);
        if (IN(P + 6)) for (int rep_ = 0; rep_ < ((l == 0 || 6 != 5) ? NREP(6) : 1); ++rep_) {
            unsigned ldsb_ = (unsigned)(uintptr_t)lds0; asm volatile("" : "+s"(ldsb_)); LAS unsigned char* lds = (LAS unsigned char*)(uintptr_t)ldsb_; volatile LAS unsigned* MISC = (volatile LAS unsigned*)(lds + MISC_OFF); volatile LAS unsigned long long* ARGP = (volatile LAS unsigned long long*)(lds + MISC_OFF + 768); (void)MISC; int wave = wave0, G = G0, bx = bx0; asm volatile("" : "+s"(G), "+s"(bx), "+s"(wave)); const int lane = (int)__builtin_amdgcn_mbcnt_hi(~0u, __builtin_amdgcn_mbcnt_lo(~0u, 0u)); const int tid = wave * 64 + lane; const int vcu = (bx % 8) * (G / 8) + bx / 8; const int gw = vcu * 8 + wave, NGW = G * 8; (void)lane; (void)gw; (void)NGW; (void)vcu;
            GAS unsigned char* ws = (GAS unsigned char*)LDP(22); GAS float* out = (GAS float*)LDP(21); const GAS float* x_in = (const GAS float*)ARGIN(0); (void)out; (void)x_in; (void)ws;
            GAS bf16* H2 = P_XN;
            LAS float* WRh = (LAS float*)lds;
            LAS float* LG = (LAS float*)(lds + 73728) + wave * 576;
            const GAS float* ffn_norm = (const GAS float*)ARGIN(12) + (size_t)l * DM; const GAS float* w_rg = (const GAS float*)ARGIN(13) + (size_t)l * DM * 4; const GAS float* b_rg = (const GAS float*)ARGIN(14) + l * 4;
            const GAS float* w_re = (const GAS float*)ARGIN(15) + (size_t)l * DM * 32; const GAS float* b_re = (const GAS float*)ARGIN(16) + l * 32;
            if (tid < 32) MISC[64 + tid] = 0u;
            const int r16 = lane & 15, g4 = lane >> 4;
            const int m0 = vcu * 128 + wave * 16;
            const GAS float* xrow = out + (size_t)(m0 + r16) * DM + 4 * g4;
            GAS unsigned char* hrow = (GAS unsigned char*)H2 + (size_t)(m0 + r16) * DM + 4 * g4;
            f32x4 acc3[3]; acc3[0] = (f32x4){0.f, 0.f, 0.f, 0.f}; acc3[1] = acc3[0]; acc3[2] = acc3[0];
            float ssq = 0.f;
            int colc[3];
#pragma unroll
            for (int ct = 0; ct < 3; ++ct) { const int c = 16 * ct + r16; colc[ct] = c < 36 ? c : 35; }
            for (int half = 0; half < 2; ++half) {
                __syncthreads();
                for (int idx = tid; idx < 512 * 36; idx += 512) { const int k = half * 512 + idx / 36, e = idx % 36; WRh[idx] = ffn_norm[k] * (e < 4 ? w_rg[k * 4 + e] : w_re[k * 32 + (e - 4)]); }
                __syncthreads();
                for (int s8 = 0; s8 < 32; s8 += 8) {
                    f32x4 xv[8];
#pragma unroll
                    for (int u = 0; u < 8; ++u) xv[u] = *(const GAS f32x4*)(xrow + half * 512 + 16 * (s8 + u));
#pragma unroll
                    for (int u = 0; u < 8; ++u) {
                        const f32x4 x4 = xv[u];
                        *(GAS unsigned*)(hrow + half * 512 + 16 * (s8 + u)) = pk4_fp8(x4[0], x4[1], x4[2], x4[3]);
                        ssq += (x4[0] * x4[0] + x4[1] * x4[1]) + (x4[2] * x4[2] + x4[3] * x4[3]);
                        const LAS float* wk = WRh + (16 * (s8 + u) + 4 * g4) * 36;
#pragma unroll
                        for (int j = 0; j < 4; ++j)
#pragma unroll
                            for (int ct = 0; ct < 3; ++ct) acc3[ct] = __builtin_amdgcn_mfma_f32_16x16x4f32(x4[j], wk[j * 36 + colc[ct]], acc3[ct], 0, 0, 0);
                    }
                }
            }
            ssq += __shfl_xor(ssq, 16); ssq += __shfl_xor(ssq, 32);
            const float rstd = rsqrtf(ssq * (1.f / DM) + EPS);
#pragma unroll
            for (int ct = 0; ct < 3; ++ct) { const int c = 16 * ct + r16; if (c < 36) {
#pragma unroll
                for (int rg = 0; rg < 4; ++rg) LG[(4 * g4 + rg) * 36 + c] = acc3[ct][rg]; } }
            LDS_WAIT();
            if (lane < 16) {
                const int m = m0 + lane; const LAS float* lg = LG + lane * 36;
                float gl[4];
#pragma unroll
                for (int g = 0; g < 4; ++g) gl[g] = lg[g] * rstd + b_rg[g];
                int gi = 0; float gm = gl[0];
#pragma unroll
                for (int g = 1; g < 4; ++g) if (gl[g] > gm) { gm = gl[g]; gi = g; }
                float gs = 0.f;
#pragma unroll
                for (int g = 0; g < 4; ++g) gs += __expf(gl[g] - gm);
                const float gval = 1.f / gs;
                float el[8];
#pragma unroll
                for (int j = 0; j < 8; ++j) el[j] = lg[4 + 8 * gi + j] * rstd + b_re[8 * gi + j];
                int i0 = 0; float mx0 = el[0];
#pragma unroll
                for (int j = 1; j < 8; ++j) if (el[j] > mx0) { mx0 = el[j]; i0 = j; }
                int i1 = -1; float mx1 = -INFINITY;
#pragma unroll
                for (int j = 0; j < 8; ++j) if (j != i0 && el[j] > mx1) { mx1 = el[j]; i1 = j; }
                const float e1 = __expf(mx1 - mx0); const float g0 = gval / (1.f + e1), g1 = gval * e1 / (1.f + e1);
                const int ea = gi * 8 + i0, eb = gi * 8 + i1; P_E01[2 * m] = ea; P_E01[2 * m + 1] = eb; P_G01[2 * m] = g0; P_G01[2 * m + 1] = g1; P_RSTD[m] = rstd;
                __hip_atomic_fetch_add((LAS unsigned*)(lds + MISC_OFF) + 64 + ea, 1u, __ATOMIC_RELAXED, __HIP_MEMORY_SCOPE_WORKGROUP); __hip_atomic_fetch_add((LAS unsigned*)(lds + MISC_OFF) + 64 + eb, 1u, __ATOMIC_RELAXED, __HIP_MEMORY_SCOPE_WORKGROUP);
            }
            __syncthreads();
            if (tid < 32) P_CNT[vcu * 32 + tid] = (int)MISC[64 + tid];
        }
        SEAM(P + 6);
        if (IN(P + 7)) for (int rep_ = 0; rep_ < ((l == 0 || 7 != 5) ? NREP(7) : 1); ++rep_) {
            unsigned ldsb_ = (unsigned)(uintptr_t)lds0; asm volatile("" : "+s"(ldsb_)); LAS unsigned char* lds = (LAS unsigned char*)(uintptr_t)ldsb_; volatile LAS unsigned* MISC = (volatile LAS unsigned*)(lds + MISC_OFF); volatile LAS unsigned long long* ARGP = (volatile LAS unsigned long long*)(lds + MISC_OFF + 768); (void)MISC; int wave = wave0, G = G0, bx = bx0; asm volatile("" : "+s"(G), "+s"(bx), "+s"(wave)); const int lane = (int)__builtin_amdgcn_mbcnt_hi(~0u, __builtin_amdgcn_mbcnt_lo(~0u, 0u)); const int tid = wave * 64 + lane; const int vcu = (bx % 8) * (G / 8) + bx / 8; const int gw = vcu * 8 + wave, NGW = G * 8; (void)lane; (void)gw; (void)NGW; (void)vcu;
            GAS unsigned char* ws = (GAS unsigned char*)LDP(22); GAS float* out = (GAS float*)LDP(21); const GAS float* x_in = (const GAS float*)ARGIN(0); (void)out; (void)x_in; (void)ws;
            LAS int* cnt_all = (LAS int*)lds;
            LAS int* pre_e = (LAS int*)(lds + 32768);
            LAS int* tot_e = pre_e + 32;
            LAS int* pst = pre_e + 64;
            LAS int* eL = pre_e + 128;
            for (int i = tid; i < 256 * 32; i += 512) cnt_all[i] = P_CNT[i];
            if (tid < 256) eL[tid] = P_E01[vcu * 256 + tid];
            __syncthreads();
            if (tid < 32) { int pre = 0, tot = 0; for (int w = 0; w < 256; ++w) { const int c = cnt_all[w * 32 + tid]; pre += (w < vcu) ? c : 0; tot += c; } pre_e[tid] = pre; tot_e[tid] = tot; }
            __syncthreads();
            if (tid == 0) { int acc = 0; for (int e = 0; e < 32; ++e) { pst[e] = acc; acc += (tot_e[e] + 255) / 256 * 256; } pst[32] = acc; }
            __syncthreads();
            if (vcu == 0 && tid <= 32) P_TSTART[tid] = pst[tid] / 256;
            if (tid < 256) { const int e = eL[tid]; int r = 0; for (int a = 0; a < tid; ++a) r += (eL[a] == e) ? 1 : 0;
                const int slot = pst[e] + pre_e[e] + r; const int tok = vcu * 128 + (tid >> 1);
                P_SLOT[vcu * 256 + tid] = slot; P_TOKOF[slot] = tok; P_GATEOF[slot] = P_G01[vcu * 256 + tid]; P_RSTDOF[slot] = P_RSTD[tok]; }
            if (vcu < 32) { const int e = vcu; for (int s = pst[e] + tot_e[e] + tid; s < pst[e + 1]; s += 512) { P_TOKOF[s] = 0; P_GATEOF[s] = 0.f; P_RSTDOF[s] = 0.f; } }
            __syncthreads();
        }
        SEAM(P + 7);
        if (IN(P + 8)) for (int rep_ = 0; rep_ < ((l == 0 || 8 != 5) ? NREP(8) : 1); ++rep_) {
            unsigned ldsb_ = (unsigned)(uintptr_t)lds0; asm volatile("" : "+s"(ldsb_)); LAS unsigned char* lds = (LAS unsigned char*)(uintptr_t)ldsb_; volatile LAS unsigned* MISC = (volatile LAS unsigned*)(lds + MISC_OFF); volatile LAS unsigned long long* ARGP = (volatile LAS unsigned long long*)(lds + MISC_OFF + 768); (void)MISC; int wave = wave0, G = G0, bx = bx0; asm volatile("" : "+s"(G), "+s"(bx), "+s"(wave)); const int lane = (int)__builtin_amdgcn_mbcnt_hi(~0u, __builtin_amdgcn_mbcnt_lo(~0u, 0u)); const int tid = wave * 64 + lane; const int vcu = (bx % 8) * (G / 8) + bx / 8; const int gw = vcu * 8 + wave, NGW = G * 8; (void)lane; (void)gw; (void)NGW; (void)vcu;
            GAS unsigned char* ws = (GAS unsigned char*)LDP(22); GAS float* out = (GAS float*)LDP(21); const GAS float* x_in = (const GAS float*)ARGIN(0); (void)out; (void)x_in; (void)ws;
            volatile LAS int* TS = (volatile LAS int*)(MISC + 128);
            if (tid <= 32) TS[tid] = P_TSTART[tid];
            __syncthreads();
            MoeOrder S{G, vcu, TS, (const GAS char*)P_XN, (const GAS char*)P_WGU, 0, (size_t)1024 * 1024, (size_t)256 * 1024};
            EpiGU E{(GAS unsigned char*)P_HH, P_RSTDOF};
            pg8::gemm_phase<EpiGU, MoeOrder, true, true, true>(tid, lds, DM, DM, DM, S, E, P_TOKOF);
        }
        SEAM(P + 8);
        if (IN(P + 9)) for (int rep_ = 0; rep_ < ((l == 0 || 9 != 5) ? NREP(9) : 1); ++rep_) {
            unsigned ldsb_ = (unsigned)(uintptr_t)lds0; asm volatile("" : "+s"(ldsb_)); LAS unsigned char* lds = (LAS unsigned char*)(uintptr_t)ldsb_; volatile LAS unsigned* MISC = (volatile LAS unsigned*)(lds + MISC_OFF); volatile LAS unsigned long long* ARGP = (volatile LAS unsigned long long*)(lds + MISC_OFF + 768); (void)MISC; int wave = wave0, G = G0, bx = bx0; asm volatile("" : "+s"(G), "+s"(bx), "+s"(wave)); const int lane = (int)__builtin_amdgcn_mbcnt_hi(~0u, __builtin_amdgcn_mbcnt_lo(~0u, 0u)); const int tid = wave * 64 + lane; const int vcu = (bx % 8) * (G / 8) + bx / 8; const int gw = vcu * 8 + wave, NGW = G * 8; (void)lane; (void)gw; (void)NGW; (void)vcu;
            GAS unsigned char* ws = (GAS unsigned char*)LDP(22); GAS float* out = (GAS float*)LDP(21); const GAS float* x_in = (const GAS float*)ARGIN(0); (void)out; (void)x_in; (void)ws;
            volatile LAS int* TS = (volatile LAS int*)(MISC + 128);
            if (tid <= 32) TS[tid] = P_TSTART[tid];
            __syncthreads();
            MoeOrder S{G, vcu, TS, (const GAS char*)P_HH, (const GAS char*)P_WD, (size_t)256 * 512, (size_t)1024 * 512, (size_t)256 * 512};
            EpiDown E{P_Y, P_GATEOF};
            pg8::gemm_phase<EpiDown, MoeOrder, true, false, true>(tid, lds, DEXP, DEXP, DEXP, S, E, nullptr);
        }
        SEAM(P + 9);
}

__global__ void __launch_bounds__(512, 2) fwd(Args args) {
    extern __shared__ __attribute__((aligned(16))) unsigned char lds_raw[];
    LAS unsigned char* lds0 = (LAS unsigned char*)lds_raw;
    const int tid0 = threadIdx.x; const int wave0 = __builtin_amdgcn_readfirstlane(tid0 >> 6);
    const int G0 = gridDim.x; const int bx0 = blockIdx.x;
    { volatile LAS unsigned* MISC = (volatile LAS unsigned*)(lds0 + MISC_OFF); const int tid = tid0;
    for (int u = tid; u < 256; u += 512) MISC[u] = 0u;
    __syncthreads();
    volatile LAS unsigned long long* ARGP = (volatile LAS unsigned long long*)(lds0 + MISC_OFF + 768);
    if (tid < 21) ARGP[tid] = (unsigned long long)args.in[tid];
    if (tid == 21) ARGP[21] = (unsigned long long)args.out;
    if (tid == 22) ARGP[22] = (unsigned long long)args.ws;
    __syncthreads(); }
#if MK_ONE_LAUNCH
    XcdBarrier bar = xcd_barrier_post((unsigned*)(args.ws + WS_CTL) + CW_BAR, (volatile LAS unsigned*)(lds0 + MISC_OFF) + 8);
#else
    XcdBarrier bar; bar.bar = nullptr; bar.x = 0; bar.st = nullptr;
#endif
    const int lo = args.ph_lo, hi_ = args.ph_hi;
    if (IN(0)) {
        const GAS int* positions = (const GAS int*)args.in[1]; GAS float* COSp = (GAS float*)(args.ws + WS_COS); GAS float* SINp = (GAS float*)(args.ws + WS_SIN);
        for (int i = bx0 * 512 + tid0; i < NTOK * 16; i += G0 * 512) { const int tk = i >> 4, fi = i & 15;
            const double inv = exp2(-(double)fi * (13.287712379549449 / 16.0)); const double ang = (double)positions[tk] * inv;
            COSp[i] = (float)cos(ang); SINp[i] = (float)sin(ang); }
    }
    layer_body<0>(lo, hi_, lds0, wave0, G0, bx0, bar);
    layer_body<1>(lo, hi_, lds0, wave0, G0, bx0, bar);
    layer_body<2>(lo, hi_, lds0, wave0, G0, bx0, bar);
}

extern "C" void kernel_launch(void* const* d_in, const int* in_sizes, int n_in, void* d_out, int out_size, void* d_ws, size_t ws_size, hipStream_t stream) {
    static int grid = 0;
    if (grid == 0) {
        if (n_in != 21 || out_size != NTOK * DM || ws_size < WS_END) { fprintf(stderr, "kernel_launch: unexpected shapes (n_in %d out %d ws %zu)\n", n_in, out_size, ws_size); grid = -1; return; }
        int dev = 0, cus = 0;
        if (hipGetDevice(&dev) != hipSuccess || hipDeviceGetAttribute(&cus, hipDeviceAttributeMultiprocessorCount, dev) != hipSuccess) { grid = -1; return; }
        if (hipFuncSetAttribute((const void*)fwd, hipFuncAttributeMaxDynamicSharedMemorySize, LDS_BYTES) != hipSuccess) { fprintf(stderr, "kernel_launch: hipFuncSetAttribute failed\n"); grid = -1; return; }
        int per_cu = 0;
        if (hipOccupancyMaxActiveBlocksPerMultiprocessor(&per_cu, (const void*)fwd, 512, LDS_BYTES) != hipSuccess || per_cu < 1) fprintf(stderr, "kernel_launch: occupancy query says %d\n", per_cu);
        (void)hipGetLastError();
        grid = cus;
        if (grid != 256) { fprintf(stderr, "kernel_launch: built for 256 CUs, got %d\n", grid); grid = -1; return; }
    }
    if (grid < 0) return;
    if (hipMemsetAsync((char*)d_ws + WS_CTL, 0, CTL_ZERO_BYTES, stream) != hipSuccess) return;
    Args a{};
    for (int i = 0; i < 21; ++i) a.in[i] = d_in[i];
    a.out = (float*)d_out; a.ws = (unsigned char*)d_ws;
#if MK_ONE_LAUNCH
    a.ph_lo = 0; a.ph_hi = 21;
    hipLaunchKernelGGL(fwd, dim3(grid), dim3(512), LDS_BYTES, stream, a);
#else
    for (int p = 0; p <= 20; ++p) { a.ph_lo = p; a.ph_hi = p + 1; hipLaunchKernelGGL(fwd, dim3(grid), dim3(512), LDS_BYTES, stream, a); }
#endif
}
```

```cpp
#include <hip/hip_runtime.h>
#include <cstdio>
#include <cstdint>

#ifndef PROBE_PHASE
#define PROBE_PHASE -1
#endif
#define NREP(k) ((PROBE_PHASE) == (k) ? 2 : 1)
#ifndef MK_ONE_LAUNCH
#define MK_ONE_LAUNCH 1
#endif

#define LAS __attribute__((address_space(3)))
#define GAS __attribute__((address_space(1)))
typedef unsigned short bf16;
typedef short bf16x8 __attribute__((ext_vector_type(8)));
typedef short s16x4 __attribute__((ext_vector_type(4)));
typedef float f32x4 __attribute__((ext_vector_type(4)));
typedef float f32x2 __attribute__((ext_vector_type(2)));
typedef float f32x16 __attribute__((ext_vector_type(16)));
typedef unsigned u32x4 __attribute__((ext_vector_type(4)));
typedef unsigned u32x2 __attribute__((ext_vector_type(2)));

constexpr int NB = 16, SEQ = 2048, DM = 1024, NTOK = NB * SEQ, NLAYER = 2;
constexpr int INW = 1960, INP = 2048;
constexpr int NEXP = 32, DEXP = 512;
constexpr int MAXSLOT = 73728;
constexpr float EPS = 1e-6f;
constexpr float WSCALE = 64.f, WSCALE_INV = 1.f / 64.f;
constexpr float LOG2E = 1.4426950408889634f;
constexpr float C2F = 0.125f * LOG2E;
constexpr float C2M = 0.10206207261596575f * LOG2E;

constexpr size_t MiB = 1u << 20, KiB = 1u << 10;
constexpr size_t WS_CTL = 0, CTL_ZERO_BYTES = 64 * KiB;
constexpr size_t WS_COS = 1 * MiB, WS_SIN = 3 * MiB;
constexpr size_t WS_SSQ = 5 * MiB;
constexpr size_t WS_FLOG = 6 * MiB;
constexpr size_t WS_E01 = 8 * MiB;
constexpr size_t WS_G01 = 8 * MiB + 256 * KiB;
constexpr size_t WS_SLOT = 8 * MiB + 512 * KiB;
constexpr size_t WS_TOKOF = 8 * MiB + 768 * KiB;
constexpr size_t WS_GATEOF = 9 * MiB + 256 * KiB;
constexpr size_t WS_CNT = 9 * MiB + 768 * KiB;
constexpr size_t WS_TSTART = 9 * MiB + 800 * KiB;
constexpr size_t WS_RSTD = 9 * MiB + 832 * KiB;
constexpr size_t WS_RSTDOF = 7 * MiB;
constexpr size_t WS_KPE = 10 * MiB;
constexpr size_t WS_KAUG = 10 * MiB + 2 * MiB;
constexpr size_t WS_WIN = 16 * MiB;
constexpr size_t WS_WUQ = 20 * MiB;
constexpr size_t WS_WUKV = 20 * MiB + 512 * KiB;
constexpr size_t WS_WOUT = 21 * MiB;
constexpr size_t WS_WGU = 24 * MiB;
constexpr size_t WS_WD = 88 * MiB;
constexpr size_t WS_XN = 120 * MiB;
constexpr size_t WS_FQKV = 184 * MiB;
constexpr size_t WS_LAT = 280 * MiB;
constexpr size_t WS_QM = 312 * MiB;
constexpr size_t WS_KVM = 360 * MiB;
constexpr size_t WS_Y = 280 * MiB;
constexpr size_t WS_BIASF = 424 * MiB;
constexpr size_t WS_NRM = 425 * MiB;
constexpr size_t WS_WR = 426 * MiB;
constexpr size_t WS_END = 427 * MiB;
static_assert(WS_Y + (size_t)MAXSLOT * 1024 * 2 <= WS_END, "Y fits");
static_assert(WS_FQKV + (size_t)MAXSLOT * 512 * 2 <= WS_LAT, "HH fits");

constexpr int CW_BAR = 1024;

constexpr int RING_BYTES = 147456;
constexpr int MISC_OFF = RING_BYTES;
constexpr int LDS_BYTES = RING_BYTES + 1024;

typedef __bf16 bf16x2_t __attribute__((ext_vector_type(2)));
__device__ __forceinline__ unsigned cvt_pk_bf16(float lo, float hi) { const f32x2 v = {lo, hi}; const bf16x2_t b = __builtin_convertvector(v, bf16x2_t); return __builtin_bit_cast(unsigned, b); }
__device__ __forceinline__ float bf2f(unsigned short b) { return __uint_as_float((unsigned)b << 16); }
__device__ __forceinline__ float wave_sum(float v) {
#pragma unroll
    for (int o = 1; o < 64; o <<= 1) v += __shfl_xor(v, o);
    return v;
}
__device__ __forceinline__ unsigned pk4_fp8(float a, float b, float c, float d) { int w = 0; w = __builtin_amdgcn_cvt_pk_fp8_f32(a, b, w, false); w = __builtin_amdgcn_cvt_pk_fp8_f32(c, d, w, true); return (unsigned)w; }
#define LDS_WAIT() asm volatile("s_waitcnt lgkmcnt(0)" ::: "memory")

#define XB_TMO      128
#define XB_XCNT(j)  (256  + 64 * (j))
#define XB_XSUB(j)  (1280 + 64 * (j))
#define XB_XGEN(j)  (2304 + 64 * (j))
#define XB_TOP      3328
#define XB_TOPGEN   3392
#define XCD_BAR_WORDS 3456
#define XB_SPIN_CAP (1u << 18)
__device__ __forceinline__ unsigned xb_ld(unsigned* p)              { return __hip_atomic_load(p, __ATOMIC_RELAXED, __HIP_MEMORY_SCOPE_AGENT); }
__device__ __forceinline__ unsigned xb_add(unsigned* p, unsigned v) { return __hip_atomic_fetch_add(p, v, __ATOMIC_RELAXED, __HIP_MEMORY_SCOPE_AGENT); }
__device__ __forceinline__ unsigned xb_xcc_id() { return (unsigned)__builtin_amdgcn_s_getreg((3 << 11) | 20) & 0xFu; }
#define XB_SPIN(cond, bar) do { unsigned _sp = 0; while (cond) { __builtin_amdgcn_s_sleep(1); \
    if ((++_sp & 255u) == 0u) { if (xb_ld(&(bar)[XB_TMO])) break; if (_sp > XB_SPIN_CAP) { atomicAdd(&(bar)[XB_TMO], 1u); break; } } } } while (0)
struct XcdBarrier { unsigned* bar; unsigned x; volatile LAS unsigned* st; };
__device__ __forceinline__ XcdBarrier xcd_barrier_post(unsigned* bar, volatile LAS unsigned* st) {
    XcdBarrier b; b.bar = bar; b.x = xb_xcc_id(); b.st = st;
    if (threadIdx.x == 0) (void)xb_add(&bar[XB_XCNT(b.x)], 1u);
    return b;
}
__device__ __forceinline__ void xcd_barrier_complete(unsigned* bar, unsigned x, unsigned& nloc, unsigned& nx) {
    const unsigned G = gridDim.x * gridDim.y * gridDim.z;
    unsigned sum, cnt, mine, sp = 0u;
    for (;;) {
        sum = 0u; cnt = 0u; mine = 0u;
#pragma unroll
        for (unsigned j = 0; j < 16; ++j) { const unsigned c = xb_ld(&bar[XB_XCNT(j)]); sum += c; cnt += (c > 0u) ? 1u : 0u; mine = (j == x) ? c : mine; }
        if (sum == G) break;
        __builtin_amdgcn_s_sleep(1);
        if ((++sp & 255u) == 0u) { if (xb_ld(&bar[XB_TMO])) break; if (sp > XB_SPIN_CAP) { atomicAdd(&bar[XB_TMO], 1u); break; } }
    }
    nloc = mine > 0u ? mine : 1u; nx = cnt > 0u ? cnt : 1u;
}
__device__ __forceinline__ void xcd_barrier(const XcdBarrier& b) {
    asm volatile("s_waitcnt vmcnt(0)" ::: "memory");
    __syncthreads();
    if (threadIdx.x == 0) {
        unsigned* bar = b.bar;
        __builtin_amdgcn_s_waitcnt(0);
        unsigned nloc = b.st[0], nx = b.st[1];
        if (nloc == 0u) { xcd_barrier_complete(bar, b.x, nloc, nx); b.st[0] = nloc; b.st[1] = nx; }
        const unsigned old = xb_add(&bar[XB_XSUB(b.x)], 1u);
        const unsigned gen = old / nloc;
        if (old + 1u == (gen + 1u) * nloc) {
            __builtin_amdgcn_fence(__ATOMIC_RELEASE, "agent");
            asm volatile("s_waitcnt vmcnt(0)" ::: "memory");
            const unsigned og = xb_add(&bar[XB_TOP], 1u);
            const unsigned tg = og / nx;
            if (og + 1u == (tg + 1u) * nx) xb_add(&bar[XB_TOPGEN], 1u);
            else XB_SPIN(xb_ld(&bar[XB_TOPGEN]) == tg, bar);
            __builtin_amdgcn_fence(__ATOMIC_ACQUIRE, "agent");
            xb_add(&bar[XB_XGEN(b.x)], 1u);
            asm volatile("s_waitcnt vmcnt(0)" ::: "memory");
        } else {
            XB_SPIN(xb_ld(&bar[XB_XGEN(b.x)]) == gen, bar);
            __builtin_amdgcn_fence(__ATOMIC_ACQUIRE, "agent");
            asm volatile("s_waitcnt vmcnt(0)" ::: "memory");
        }
    }
    __syncthreads();
}

namespace pg8 {
constexpr int BM = 256, BK = 64, HALF = 128, HTB = HALF * BK * 2, STAGE_BYTES = 8 * HTB;
typedef int v4i32_t __attribute__((ext_vector_type(4)));
typedef int v8i32_t __attribute__((ext_vector_type(8)));
__host__ __device__ __forceinline__ int lds_byte(int r, int c) { const int st = (r >> 4) * 2 + (c >> 5), rr = r & 15, cc = c & 31, ob = rr * 64 + cc * 2; return st * 1024 + (ob ^ (((ob >> 9) & 1) << 5)); }
__host__ __device__ __forceinline__ void stage_rc(int b, int& R, int& C) { const int st = b / 1024, sb = b % 1024, swz = sb ^ (((sb >> 9) & 1) << 5); R = (st >> 1) * 16 + swz / 64; C = (st & 1) * 32 + (swz % 64) / 2; }
__host__ __device__ __forceinline__ int perm32(int rho) { const int n = rho >> 4, i = rho & 15; return 8 * (i >> 2) + 4 * n + (i & 3); }

struct Unit { const GAS char* a; const GAS char* b; int pm, pn, e; };

template <class Epi, class Sched, bool ALIGN_EPI, bool GATHER, bool FP8 = false>
__device__ __forceinline__ void gemm_phase(const int tid, LAS unsigned char* lds, const int Kb, const int ldaB, const int ldbB, const Sched& S, const Epi& E, const GAS int* __restrict__ tokof) {
    const int wid = __builtin_amdgcn_readfirstlane(tid >> 6), lane = tid & 63, wr = wid >> 2, wc = wid & 3, fr = lane & 15, fq = lane >> 4;
    const int nt = Kb / 128;
    unsigned voffA[2], voffB[2]; int RA[2], CA2[2];
#pragma unroll
    for (int i = 0; i < 2; ++i) { int R, C; stage_rc(tid * 16 + i * 8192, R, C); const int Rb = Epi::PERM ? ((R & ~31) + perm32(R & 31)) : R;
        voffA[i] = (unsigned)(R * ldaB + C * 2); voffB[i] = (unsigned)(Rb * ldbB + C * 2); RA[i] = R; CA2[i] = C * 2; }
    const size_t kstep = (size_t)(BK * 2);
    const size_t hstepA = GATHER ? 0 : (size_t)HALF * ldaB;
    const size_t hstepB = (size_t)HALF * ldbB;
    const unsigned ldsw = (unsigned)wid * 1024u;
    const int aoff = lds_byte(wr * 64 + fr, fq * 8), boff = lds_byte(wc * 32 + fr, fq * 8);
    unsigned gcur[2][2], gnxt[2][2];
    const int scl8 = 0x7F7F7F7F;
#define PG8_SA(b, h) (((b) * 2 + (h)) * HTB)
#define PG8_SB(b, h) ((4 + (b) * 2 + (h)) * HTB)
#define PG8_STAGE(bufoff, gbase, voff) do { const unsigned long long gb_ = (unsigned long long)(gbase); const unsigned lbase_ = (unsigned)__builtin_amdgcn_readfirstlane((int)((unsigned)(uintptr_t)lds + (unsigned)(bufoff) + ldsw)); \
        _Pragma("unroll") for (int _i = 0; _i < 2; ++_i) { unsigned keep_; \
            asm volatile("s_mov_b32 %0, m0\n\ts_mov_b32 m0, %3\n\ts_nop 0\n\tglobal_load_lds_dwordx4 %1, %2\n\ts_mov_b32 m0, %0" : "=&s"(keep_) : "v"((voff)[_i]), "s"(gb_), "s"(lbase_ + (unsigned)(_i * 8192)) : "memory"); } } while (0)
#define PG8_STAGE_A(bufoff, base, h, nx) do { if constexpr (GATHER) { unsigned _v[2]; _v[0] = (nx) ? gnxt[h][0] : gcur[h][0]; _v[1] = (nx) ? gnxt[h][1] : gcur[h][1]; PG8_STAGE(bufoff, base, _v); } \
        else { PG8_STAGE(bufoff, (base) + (h) * hstepA, voffA); } } while (0)
#define PG8_LDA(dst, b, h) do { _Pragma("unroll") for (int m = 0; m < 4; ++m) _Pragma("unroll") for (int k = 0; k < 2; ++k) dst[m][k] = *(const LAS bf16x8*)(lds + PG8_SA(b, h) + aoff + m * 2048 + k * 1024); } while (0)
#define PG8_LDB(dst, b, h) do { _Pragma("unroll") for (int n = 0; n < 2; ++n) _Pragma("unroll") for (int k = 0; k < 2; ++k) dst[n][k] = *(const LAS bf16x8*)(lds + PG8_SB(b, h) + boff + n * 2048 + k * 1024); } while (0)
#define PG8_MMA(ai, bj, At, Bt) do { __builtin_amdgcn_s_setprio(1); if constexpr (FP8) { _Pragma("unroll") for (int m = 0; m < 4; ++m) _Pragma("unroll") for (int n = 0; n < 2; ++n) { \
        const v8i32_t b8_ = __builtin_shufflevector(__builtin_bit_cast(v4i32_t, Bt[n][0]), __builtin_bit_cast(v4i32_t, Bt[n][1]), 0, 1, 2, 3, 4, 5, 6, 7), a8_ = __builtin_shufflevector(__builtin_bit_cast(v4i32_t, At[m][0]), __builtin_bit_cast(v4i32_t, At[m][1]), 0, 1, 2, 3, 4, 5, 6, 7); \
        asm volatile("s_nop 1\n\tv_mfma_scale_f32_16x16x128_f8f6f4 %0, %1, %2, %0, %3, %3 op_sel_hi:[0,0,0]" : "+v"(acc[ai][bj][m][n]) : "v"(b8_), "v"(a8_), "v"(scl8)); } } \
      else { _Pragma("unroll") for (int m = 0; m < 4; ++m) _Pragma("unroll") for (int n = 0; n < 2; ++n) _Pragma("unroll") for (int k = 0; k < 2; ++k) \
        acc[ai][bj][m][n] = __builtin_amdgcn_mfma_f32_16x16x32_bf16(Bt[n][k], At[m][k], acc[ai][bj][m][n], 0, 0, 0); } __builtin_amdgcn_s_setprio(0); } while (0)
#define PG8_WAIT_V(n) asm volatile("s_waitcnt vmcnt(" #n ")" ::: "memory")
#define PG8_WAIT_L(n) asm volatile("s_waitcnt lgkmcnt(" #n ")" ::: "memory")
#define PG8_BAR __builtin_amdgcn_s_barrier()
#define PG8_SCHED __builtin_amdgcn_sched_barrier(0)
#define PG8_GLOAD(dst, u) do { if constexpr (GATHER) { _Pragma("unroll") for (int _h = 0; _h < 2; ++_h) _Pragma("unroll") for (int _i = 0; _i < 2; ++_i) \
        dst[_h][_i] = (unsigned)tokof[(u).pm * BM + _h * HALF + RA[_i]] * (unsigned)ldaB + (unsigned)CA2[_i]; } } while (0)
    Unit cur, nxt; int ui = 0;
    if (!S.next(0, cur)) return;
    PG8_GLOAD(gcur, cur);
    f32x4 acc[2][2][4][2];
#pragma unroll
    for (int a = 0; a < 2; ++a)
#pragma unroll
        for (int b = 0; b < 2; ++b)
#pragma unroll
            for (int m = 0; m < 4; ++m)
#pragma unroll
                for (int n = 0; n < 2; ++n) acc[a][b][m][n] = (f32x4){0.f, 0.f, 0.f, 0.f};
    bf16x8 At[4][2], B0[2][2], B1[2][2];
    const GAS char* cA = cur.a; const GAS char* cB = cur.b;
    PG8_STAGE(PG8_SB(0, 0), cB, voffB); PG8_STAGE(PG8_SB(0, 1), cB + hstepB, voffB); PG8_STAGE_A(PG8_SA(0, 0), cA, 0, false); PG8_STAGE_A(PG8_SA(0, 1), cA, 1, false);
    if (wr == 1) PG8_BAR;
    PG8_WAIT_V(2); PG8_BAR;
    PG8_STAGE(PG8_SB(1, 0), cB + kstep, voffB); PG8_STAGE_A(PG8_SA(1, 0), cA + kstep, 0, false); PG8_STAGE(PG8_SB(1, 1), cB + hstepB + kstep, voffB);
    PG8_WAIT_V(6); PG8_BAR;
    for (;;) {
        const bool has_next = S.next(ui + 1, nxt);
        if constexpr (GATHER) { if (has_next) { PG8_GLOAD(gnxt, nxt); } else { _Pragma("unroll") for (int _h = 0; _h < 2; ++_h) _Pragma("unroll") for (int _i = 0; _i < 2; ++_i) gnxt[_h][_i] = gcur[_h][_i]; } }
        const GAS char* nA = has_next ? nxt.a : cA; const GAS char* nB = has_next ? nxt.b : cB;
#pragma nounroll
        for (int t = 0; t < nt; t += 2) {
            const bool last = (t == nt - 2);
            const GAS char* a1 = cA + (size_t)(t + 1) * kstep;
            const GAS char* a2 = last ? nA : cA + (size_t)(t + 2) * kstep; const GAS char* b2 = last ? nB : cB + (size_t)(t + 2) * kstep;
            const GAS char* a3 = a2 + kstep; const GAS char* b3 = b2 + kstep;
            PG8_LDB(B0, 0, 0); PG8_LDB(B1, 0, 1); PG8_SCHED; PG8_LDA(At, 0, 0); PG8_STAGE_A(PG8_SA(1, 1), a1, 1, false);
            PG8_WAIT_V(8); PG8_WAIT_L(0); PG8_BAR; PG8_MMA(0, 0, At, B0); PG8_MMA(0, 1, At, B1); PG8_BAR; PG8_SCHED;
            PG8_LDA(At, 0, 1); PG8_STAGE(PG8_SB(0, 0), b2, voffB); PG8_STAGE(PG8_SB(0, 1), b2 + hstepB, voffB); PG8_STAGE_A(PG8_SA(0, 0), a2, 0, last);
            PG8_WAIT_V(8); PG8_WAIT_L(0); PG8_BAR; PG8_MMA(1, 0, At, B0); PG8_MMA(1, 1, At, B1); PG8_BAR; PG8_SCHED;
            PG8_LDB(B0, 1, 0); PG8_LDB(B1, 1, 1); PG8_SCHED; PG8_LDA(At, 1, 0); PG8_STAGE_A(PG8_SA(0, 1), a2, 1, last);
            PG8_WAIT_V(8); PG8_WAIT_L(0); PG8_BAR; PG8_MMA(0, 0, At, B0); PG8_MMA(0, 1, At, B1); PG8_BAR; PG8_SCHED;
            PG8_LDA(At, 1, 1); PG8_STAGE(PG8_SB(1, 0), b3, voffB); PG8_STAGE(PG8_SB(1, 1), b3 + hstepB, voffB); PG8_STAGE_A(PG8_SA(1, 0), a3, 0, last);
            PG8_WAIT_V(8); PG8_WAIT_L(0); PG8_BAR; PG8_MMA(1, 0, At, B0); PG8_MMA(1, 1, At, B1); PG8_BAR; PG8_SCHED;
        }
        if constexpr (ALIGN_EPI) { if (wr == 0) PG8_BAR; }
        if constexpr (FP8) { asm volatile("s_nop 15\n\ts_nop 15" ::: "memory"); }
        E(acc, cur, wr, wc, fr, fq);
        if (!has_next) break;
#pragma unroll
        for (int a = 0; a < 2; ++a)
#pragma unroll
            for (int b = 0; b < 2; ++b)
#pragma unroll
                for (int m = 0; m < 4; ++m)
#pragma unroll
                    for (int n = 0; n < 2; ++n) acc[a][b][m][n] = (f32x4){0.f, 0.f, 0.f, 0.f};
        cur = nxt; cA = nA; cB = nB; ++ui;
        if constexpr (GATHER) { _Pragma("unroll") for (int _h = 0; _h < 2; ++_h) _Pragma("unroll") for (int _i = 0; _i < 2; ++_i) gcur[_h][_i] = gnxt[_h][_i]; }
        if constexpr (ALIGN_EPI) { if (wr == 1) PG8_BAR; }
    }
    PG8_WAIT_V(0);
    if constexpr (!ALIGN_EPI) { if (wr == 0) PG8_BAR; }
    PG8_BAR;
#undef PG8_SA
#undef PG8_SB
#undef PG8_STAGE
#undef PG8_STAGE_A
#undef PG8_LDA
#undef PG8_LDB
#undef PG8_MMA
#undef PG8_WAIT_V
#undef PG8_WAIT_L
#undef PG8_BAR
#undef PG8_SCHED
#undef PG8_GLOAD
}
}
using pg8::Unit;

struct DenseOrder {
    int nM, nN, nwg, G, c; const GAS char* A; const GAS char* B; size_t aT, bT;
    __device__ __forceinline__ bool next(int i, Unit& u) const {
        const long L = (long)i * G + c; if (L >= nwg) return false;
        int wgid = (int)L; { const int q = nwg / 8, r = nwg % 8, xcd = wgid % 8, off = wgid / 8; wgid = (xcd < r ? xcd * (q + 1) : r * (q + 1) + (xcd - r) * q) + off; }
        const int nig = 8 * nN, gid = wgid / nig, fm = gid * 8, gsz = (nM - fm) < 8 ? (nM - fm) : 8;
        u.pm = fm + ((wgid % nig) % gsz); u.pn = (wgid % nig) / gsz; u.e = 0;
        u.a = A + (size_t)u.pm * aT; u.b = B + (size_t)u.pn * bT; return true;
    }
};
struct UpOrder {
    int G, c; const GAS char* LATp; const GAS char* Wq; const GAS char* Wkv;
    __device__ __forceinline__ bool next(int i, Unit& u) const {
        const int L = i * G + c; if (L >= 128 * 7) return false;
        u.pm = L / 7; const int j = L % 7; const bool kv = j >= 3; u.pn = kv ? j - 3 : j; u.e = kv ? 1 : 0;
        u.a = LATp + (size_t)u.pm * 256 * 512 * 2 + (kv ? 512 : 0);
        u.b = (kv ? Wkv : Wq) + (size_t)u.pn * 256 * 256 * 2; return true;
    }
};
struct MoeOrder {
    int G, c; const volatile LAS int* TS; const GAS char* A; const GAS char* W; size_t aT  , wE  , wT  ;
    __device__ __forceinline__ bool next(int i, Unit& u) const {
        const int L = i * G + c; const int ntile = __builtin_amdgcn_readfirstlane(TS[32]); if (L >= ntile * 4) return false;
        const int rt = L >> 2, ct = L & 3; int e = 0;
        for (int j = 1; j < 32; ++j) e += (TS[j] <= rt) ? 1 : 0;
        e = __builtin_amdgcn_readfirstlane(e);
        u.pm = rt; u.pn = ct; u.e = e; u.a = A + (size_t)rt * aT; u.b = W + (size_t)e * wE + (size_t)ct * wT; return true;
    }
};

__device__ __forceinline__ u32x4 pack8(f32x4 v0, f32x4 v1) { u32x4 w; w.x = cvt_pk_bf16(v0[0], v0[1]); w.y = cvt_pk_bf16(v0[2], v0[3]); w.z = cvt_pk_bf16(v1[0], v1[1]); w.w = cvt_pk_bf16(v1[2], v1[3]); return w; }

struct EpiWin {
    static constexpr bool PERM = true;
    GAS bf16* LAT_; GAS bf16* FQKV_; GAS bf16* KPE_; GAS float* FLOG_; GAS float* SSQ_; const GAS float* COS_; const GAS float* SIN_;
    __device__ __forceinline__ void operator()(const f32x4 (&acc)[2][2][4][2], const Unit& u, int wr, int wc, int fr, int fq) const {
        GAS bf16* LAT = LAT_; GAS bf16* FQKV = FQKV_; GAS bf16* KPE = KPE_; GAS float* FLOG = FLOG_; GAS float* SSQ = SSQ_; const GAS float* COS = COS_; const GAS float* SIN = SIN_;
        asm volatile("" : "+s"(LAT), "+s"(FQKV), "+s"(KPE), "+s"(FLOG), "+s"(SSQ), "+s"(COS), "+s"(SIN));
        const int row0 = u.pm * 256 + wr * 64 + fr; const int pn = u.pn;
        if (pn >= 2) {
            const int ti = pn >> 1; GAS bf16* dst = FQKV + (size_t)(ti - 1) * NTOK * 512; const int colb = (pn & 1) * 256 + wc * 32 + 8 * fq; const float sc = (ti == 1) ? C2F : 1.f;
#pragma unroll
            for (int ai = 0; ai < 2; ++ai)
#pragma unroll
                for (int m = 0; m < 4; ++m) { GAS bf16* rowp = dst + (size_t)(row0 + ai * 128 + m * 16) * 512 + colb;
#pragma unroll
                    for (int bj = 0; bj < 2; ++bj) *(GAS u32x4*)(rowp + bj * 128) = pack8(acc[ai][bj][m][0] * sc, acc[ai][bj][m][1] * sc); }
        } else {
#pragma unroll
            for (int ai = 0; ai < 2; ++ai)
#pragma unroll
                for (int m = 0; m < 4; ++m) { const int row = row0 + ai * 128 + m * 16; GAS bf16* rowp = LAT + (size_t)row * 512 + pn * 256 + wc * 32 + 8 * fq;
#pragma unroll
                    for (int bj = 0; bj < 2; ++bj) *(GAS u32x4*)(rowp + bj * 128) = pack8(acc[ai][bj][m][0], acc[ai][bj][m][1]);
                    float s = 0.f;
#pragma unroll
                    for (int n = 0; n < 2; ++n) { const f32x4 x = acc[ai][0][m][n]; s += (x[0] * x[0] + x[1] * x[1]) + (x[2] * x[2] + x[3] * x[3]); }
                    if (pn == 0) {
#pragma unroll
                        for (int n = 0; n < 2; ++n) { const f32x4 x = acc[ai][1][m][n]; s += (x[0] * x[0] + x[1] * x[1]) + (x[2] * x[2] + x[3] * x[3]); }
                    }
                    s += __shfl_xor(s, 16); s += __shfl_xor(s, 32);
                    if (fq == 0) SSQ[(size_t)row * 8 + pn * 4 + wc] = s;
                    asm volatile("" ::: "memory"); }
            if (pn == 1 && wc == 0) {
#pragma unroll
                for (int ai = 0; ai < 2; ++ai)
#pragma unroll
                    for (int m = 0; m < 4; ++m) { const int row = row0 + ai * 128 + m * 16;
                        const f32x4 c = *(const GAS f32x4*)(COS + (size_t)row * 16 + 4 * fq), sn = *(const GAS f32x4*)(SIN + (size_t)row * 16 + 4 * fq);
                        const f32x4 x1 = acc[ai][1][m][0], x2 = acc[ai][1][m][1];
                        *(GAS u32x4*)(KPE + (size_t)row * 32 + 8 * fq) = pack8(x1 * c - x2 * sn, x1 * sn + x2 * c);
                        asm volatile("" ::: "memory"); }
            }
            if (pn == 1 && wc == 1 && fq == 0) {
#pragma unroll
                for (int ai = 0; ai < 2; ++ai)
#pragma unroll
                    for (int m = 0; m < 4; ++m) { const int row = row0 + ai * 128 + m * 16; *(GAS f32x4*)(FLOG + (size_t)row * 8) = acc[ai][1][m][0]; *(GAS f32x4*)(FLOG + (size_t)row * 8 + 4) = acc[ai][1][m][1]; }
            }
        }
    }
};
struct EpiUp {
    static constexpr bool PERM = true;
    GAS bf16* QM_; GAS bf16* KVM_; const GAS float* SSQ_; const GAS float* COS_; const GAS float* SIN_;
    __device__ __forceinline__ void operator()(const f32x4 (&acc)[2][2][4][2], const Unit& u, int wr, int wc, int fr, int fq) const {
        GAS bf16* QM = QM_; GAS bf16* KVM = KVM_; const GAS float* SSQ = SSQ_; const GAS float* COS = COS_; const GAS float* SIN = SIN_;
        asm volatile("" : "+s"(QM), "+s"(KVM), "+s"(SSQ), "+s"(COS), "+s"(SIN));
        const int row0 = u.pm * 256 + wr * 64 + fr; const int pn = u.pn; const bool kv = u.e != 0;
#pragma unroll
        for (int ai = 0; ai < 2; ++ai)
#pragma unroll
            for (int m = 0; m < 4; ++m) { const int row = row0 + ai * 128 + m * 16;
                const f32x4 sq = *(const GAS f32x4*)(SSQ + (size_t)row * 8 + (kv ? 4 : 0));
                const float ss = (sq[0] + sq[1]) + (sq[2] + sq[3]);
                if (kv) {
                    const float rs = rsqrtf(ss * (1.f / 128.f) + EPS);
                    GAS bf16* rowp = KVM + (size_t)row * 1024 + pn * 256 + wc * 32 + 8 * fq;
#pragma unroll
                    for (int bj = 0; bj < 2; ++bj) *(GAS u32x4*)(rowp + bj * 128) = pack8(acc[ai][bj][m][0] * rs, acc[ai][bj][m][1] * rs);
                } else {
                    const float rs = rsqrtf(ss * (1.f / 256.f) + EPS) * C2M;
                    GAS bf16* rowp = QM + (size_t)row * 768 + pn * 256 + wc * 32 + 8 * fq;
                    const f32x4 c = *(const GAS f32x4*)(COS + (size_t)row * 16 + 4 * fq), sn = *(const GAS f32x4*)(SIN + (size_t)row * 16 + 4 * fq);
#pragma unroll
                    for (int bj = 0; bj < 2; ++bj) { f32x4 v0 = acc[ai][bj][m][0] * rs, v1 = acc[ai][bj][m][1] * rs;
                        const int G = 8 * pn + 4 * bj + wc;
                        if (G % 3 == 2) { const f32x4 x1 = v0, x2 = v1; v0 = x1 * c - x2 * sn; v1 = x1 * sn + x2 * c; }
                        *(GAS u32x4*)(rowp + bj * 128) = pack8(v0, v1); }
                }
                asm volatile("" ::: "memory");
            }
    }
};
struct EpiOut {
    static constexpr bool PERM = false;
    const GAS float* resid_; GAS float* out_;
    __device__ __forceinline__ void operator()(const f32x4 (&acc)[2][2][4][2], const Unit& u, int wr, int wc, int fr, int fq) const {
        const GAS float* resid = resid_; GAS float* out = out_; asm volatile("" : "+s"(resid), "+s"(out));
        const int row0 = u.pm * 256 + wr * 64 + fr, col0 = u.pn * 256 + wc * 32 + 4 * fq;
#pragma unroll
        for (int ai = 0; ai < 2; ++ai)
#pragma unroll
            for (int m = 0; m < 4; ++m) { const size_t off = (size_t)(row0 + ai * 128 + m * 16) * DM + col0;
#pragma unroll
                for (int bj = 0; bj < 2; ++bj)
#pragma unroll
                    for (int n = 0; n < 2; ++n) { const f32x4 r = *(const GAS f32x4*)(resid + off + bj * 128 + n * 16); *(GAS f32x4*)(out + off + bj * 128 + n * 16) = r + acc[ai][bj][m][n]; } }
    }
};
struct EpiGU {
    static constexpr bool PERM = true;
    GAS unsigned char* HH_; const GAS float* RS_;
    __device__ __forceinline__ void operator()(const f32x4 (&acc)[2][2][4][2], const Unit& u, int wr, int wc, int fr, int fq) const {
        GAS unsigned char* HH = HH_; const GAS float* RS = RS_; asm volatile("" : "+s"(HH), "+s"(RS));
        const int row0 = u.pm * 256 + wr * 64 + fr;
#pragma unroll
        for (int ai = 0; ai < 2; ++ai)
#pragma unroll
            for (int m = 0; m < 4; ++m) { GAS unsigned char* rowp = HH + (size_t)(row0 + ai * 128 + m * 16) * 512 + u.pn * 128 + wc * 32 + 8 * fq; const float rs = RS[row0 + ai * 128 + m * 16] * WSCALE_INV;
                f32x4 h[2];
#pragma unroll
                for (int n = 0; n < 2; ++n) { const f32x4 g = acc[ai][0][m][n] * rs, up = acc[ai][1][m][n] * rs;
#pragma unroll
                    for (int j = 0; j < 4; ++j) { const float sg = __builtin_amdgcn_rcpf(1.f + __builtin_amdgcn_exp2f(-g[j] * LOG2E)); h[n][j] = g[j] * sg * up[j]; } }
                u32x2 w; w.x = pk4_fp8(h[0][0], h[0][1], h[0][2], h[0][3]); w.y = pk4_fp8(h[1][0], h[1][1], h[1][2], h[1][3]); *(GAS u32x2*)rowp = w; }
    }
};
struct EpiDown {
    static constexpr bool PERM = true;
    GAS bf16* Y_; const GAS float* GATEOF_;
    __device__ __forceinline__ void operator()(const f32x4 (&acc)[2][2][4][2], const Unit& u, int wr, int wc, int fr, int fq) const {
        GAS bf16* Y = Y_; const GAS float* GATEOF = GATEOF_; asm volatile("" : "+s"(Y), "+s"(GATEOF));
        const int row0 = u.pm * 256 + wr * 64 + fr;
#pragma unroll
        for (int ai = 0; ai < 2; ++ai)
#pragma unroll
            for (int m = 0; m < 4; ++m) { const int row = row0 + ai * 128 + m * 16; const float g = GATEOF[row] * WSCALE_INV; GAS bf16* rowp = Y + (size_t)row * 1024 + u.pn * 256 + wc * 32 + 8 * fq;
#pragma unroll
                for (int bj = 0; bj < 2; ++bj) *(GAS u32x4*)(rowp + bj * 128) = pack8(acc[ai][bj][m][0] * g, acc[ai][bj][m][1] * g); }
    }
};

namespace att {
constexpr int KSLOT = 12288, VSLOT = 8192;
constexpr int L_K = 0, L_V = 2 * KSLOT, L_BIAS = L_V + 2 * VSLOT, L_WS = L_BIAS + 8192, L_OST = L_WS + 8 * 64 * 4, L_END = L_OST + 8 * 4096;
__device__ __forceinline__ int crow(int r, int hi) { return (r & 3) + 8 * (r >> 2) + 4 * hi; }
typedef short v4i16_t __attribute__((ext_vector_type(4)));
__device__ __forceinline__ s16x4 vtr(const LAS char* p) { return __builtin_bit_cast(s16x4, __builtin_amdgcn_ds_read_tr16_b64_v4i16((LAS v4i16_t*)p)); }

constexpr int NSL = 5;
constexpr int R_K = 0, R_V = NSL * KSLOT, R_WS = R_V + NSL * VSLOT, R_OST = R_WS + 8 * 64 * 4, R_END = R_OST + 8 * 4096;
static_assert(R_END <= RING_BYTES, "attention LDS");
__device__ __forceinline__ void glds16(const GAS void* gsrc, unsigned lds_dst) { unsigned keep;
    asm volatile("s_mov_b32 %0, m0\n\ts_mov_b32 m0, %2\n\ts_nop 0\n\tglobal_load_lds_dwordx4 %1, off\n\ts_mov_b32 m0, %0" : "=&s"(keep) : "v"(gsrc), "s"(lds_dst) : "memory"); }
__device__ __forceinline__ void glds16s(const GAS void* sbase, unsigned voff, unsigned lds_dst) { unsigned keep;
    asm volatile("s_mov_b32 %0, m0\n\ts_mov_b32 m0, %3\n\ts_nop 0\n\tglobal_load_lds_dwordx4 %1, %2\n\ts_mov_b32 m0, %0" : "=&s"(keep) : "v"(voff), "s"((unsigned long long)sbase), "s"(lds_dst) : "memory"); }
struct Tens2 { const GAS bf16* Q; int qp; const GAS bf16* K; int kp; const GAS bf16* KX; const GAS bf16* V; int vp; GAS bf16* O; const GAS float* BIASF; const GAS float* NRM; };
template <int MODE>
__device__ __forceinline__ int attn_unit2(const int wave_, int b, int h, int qb, const Tens2& T, LAS char* shm, const int slbase, const bool have_pro, const int qb_next) {
    constexpr int DKS = MODE ? 6 : 5, DKH = 3;
    constexpr float THR = 8.f;
    int wid = wave_; asm volatile("" : "+s"(wid));
    int lane = (int)__builtin_amdgcn_mbcnt_hi(~0u, __builtin_amdgcn_mbcnt_lo(~0u, 0u)); asm volatile("" : "+v"(lane)); const int r32 = lane & 31, hi = lane >> 5;
    const long rowbase = (long)b * SEQ; const int q0 = qb * 256, qw0 = q0 + wid * 32;
    const int NT = (q0 + 256) / 64, tlast = qw0 / 64;
    int tstart = 0;
    if (MODE == 0) {
        const GAS float* bs = T.BIASF + ((long)b * 8 + h) * SEQ; const GAS float* nr = T.NRM + (b * 8 + h) * 16;
        const float Z = nr[qb] * nr[8] * 1.001f + 0.01f; const float bq0 = bs[q0];
        const float bend = bs[(lane < NT ? lane : NT - 1) * 64 + 63];
        const bool skip = (lane < NT - 4) && (2.f * Z + bend - bq0 < -40.f);
        tstart = __builtin_popcountll(__ballot(skip));
    }
    const int NTE = NT - tstart;
    const GAS bf16* Qw = T.Q + (rowbase + qw0) * T.qp + h * (MODE ? 96 : 64);
    const GAS bf16* Kh = T.K + rowbase * T.kp + h * (MODE ? 128 : 64);
    const GAS bf16* Vh = T.V + rowbase * T.vp + h * (MODE ? 128 : 64);
    LAS float* wsf = (LAS float*)(shm + R_WS) + wid * 64;
    bf16x8 qr[DKS];
    const unsigned koff = (unsigned)(lane * T.kp + wid * 8) * 2u;
    const unsigned xoff = MODE ? (unsigned)(lane * 32 + (wid & 3) * 8) * 2u : (unsigned)(lane * 8) * 2u;
    const unsigned voff = (unsigned)((16 * (wid & 3) + (lane >> 2)) * T.vp + (wid >> 2) * 32 + (lane & 3) * 8) * 2u;
    const GAS bf16* xbase = MODE ? T.KX + rowbase * 32 : T.KX + ((long)b * 8 + h) * SEQ * 8;
    const int xstep = MODE ? 64 * 32 : 64 * 8;
    const unsigned kdst_a = (unsigned)(uintptr_t)(shm + R_K) + (unsigned)wid * 1024u, xdst_a = (unsigned)(uintptr_t)(shm + R_K) + (unsigned)(8 + (MODE ? (wid & 3) : 0)) * 1024u, vdst_a = (unsigned)(uintptr_t)(shm + R_V) + (unsigned)wid * 1024u;
#define A2_DMA(t, slot) do { \
        glds16s((const GAS void*)(Kh + (long)(t) * 64 * T.kp), koff, (unsigned)__builtin_amdgcn_readfirstlane((int)(kdst_a + (slot) * KSLOT))); \
        glds16s((const GAS void*)(xbase + (long)(t) * xstep), xoff, (unsigned)__builtin_amdgcn_readfirstlane((int)(xdst_a + (slot) * KSLOT))); \
        glds16s((const GAS void*)(Vh + (long)(t) * 64 * T.vp), voff, (unsigned)__builtin_amdgcn_readfirstlane((int)(vdst_a + (slot) * VSLOT))); } while (0)
    float mhat = 0.f, lrun = 0.f; f32x16 o[2]; o[0] = f32x16{}; o[1] = f32x16{}; f32x16 negm = f32x16{};
    const LAS char* vp0 = shm + R_V + ((lane >> 4) & 1) * 32 + (lane & 3) * 8 + (4 * hi + ((lane & 15) >> 2)) * 64;
#define A3_SLOT(k) ((slbase + (k)) % NSL)
    if (!have_pro) { A2_DMA(NT - 1, A3_SLOT(0)); A2_DMA(NT - 2, A3_SLOT(1)); A2_DMA(NT - 3, A3_SLOT(2)); }
#pragma unroll
    for (int d0 = 0; d0 < (MODE ? 6 : 4); ++d0) qr[d0] = *(const GAS bf16x8*)(Qw + (long)r32 * T.qp + d0 * 16 + hi * 8);
    if (MODE == 0) { const short one = hi ? (short)0 : (short)0x3F80; qr[DKS - 1] = (bf16x8){one, one, one, 0, 0, 0, 0, 0}; }
#pragma unroll
    for (int d0 = 0; d0 < DKS; ++d0) asm volatile("" : "+v"(qr[d0]));
#define A3_KLOADH(slot, H) do { const LAS char* kb_ = shm + R_K + (slot) * KSLOT + r32 * 16; _Pragma("unroll") for (int d0 = (H) * DKH; d0 < ((H) ? DKS : DKH); ++d0) { const int off = (MODE == 0 && d0 == 4) ? 8 * 1024 : d0 * 2048 + hi * 1024; \
        kf[2 * (d0 - (H) * DKH)] = *(const LAS bf16x8*)(kb_ + off); kf[2 * (d0 - (H) * DKH) + 1] = *(const LAS bf16x8*)(kb_ + off + 512); } } while (0)
#define A3_VLOAD(slot) do { const LAS char* vp_ = vp0 + (slot) * VSLOT; _Pragma("unroll") for (int q = 0; q < 8; ++q) { vlo[q] = vtr(vp_ + (q >> 2) * 4096 + (q & 3) * 1024); vhh[q] = vtr(vp_ + (q >> 2) * 4096 + (q & 3) * 1024 + 512); } } while (0)
#define A3_QKH(H) do { if ((H) == 0) { c0 = negm; c1 = negm; } _Pragma("unroll") for (int d0 = (H) * DKH; d0 < ((H) ? DKS : DKH); ++d0) { c0 = __builtin_amdgcn_mfma_f32_32x32x16_bf16(kf[2 * (d0 - (H) * DKH)], qr[d0], c0, 0, 0, 0); c1 = __builtin_amdgcn_mfma_f32_32x32x16_bf16(kf[2 * (d0 - (H) * DKH) + 1], qr[d0], c1, 0, 0, 0); } } while (0)
#define A3_EXP() do { float ls_ = 0.f; _Pragma("unroll") for (int r = 0; r < 16; ++r) { pp0[r] = __builtin_amdgcn_exp2f(pp0[r]); pp1[r] = __builtin_amdgcn_exp2f(pp1[r]); ls_ += pp0[r] + pp1[r]; } lrun += ls_; u32x4 w_; \
        w_.x = cvt_pk_bf16(pp0[0], pp0[1]); w_.y = cvt_pk_bf16(pp0[2], pp0[3]); w_.z = cvt_pk_bf16(pp0[4], pp0[5]); w_.w = cvt_pk_bf16(pp0[6], pp0[7]); pa[0] = __builtin_bit_cast(bf16x8, w_); \
        w_.x = cvt_pk_bf16(pp0[8], pp0[9]); w_.y = cvt_pk_bf16(pp0[10], pp0[11]); w_.z = cvt_pk_bf16(pp0[12], pp0[13]); w_.w = cvt_pk_bf16(pp0[14], pp0[15]); pa[1] = __builtin_bit_cast(bf16x8, w_); \
        w_.x = cvt_pk_bf16(pp1[0], pp1[1]); w_.y = cvt_pk_bf16(pp1[2], pp1[3]); w_.z = cvt_pk_bf16(pp1[4], pp1[5]); w_.w = cvt_pk_bf16(pp1[6], pp1[7]); pa[2] = __builtin_bit_cast(bf16x8, w_); \
        w_.x = cvt_pk_bf16(pp1[8], pp1[9]); w_.y = cvt_pk_bf16(pp1[10], pp1[11]); w_.z = cvt_pk_bf16(pp1[12], pp1[13]); w_.w = cvt_pk_bf16(pp1[14], pp1[15]); pa[3] = __builtin_bit_cast(bf16x8, w_); } while (0)
#define A3_PV() do { _Pragma("unroll") for (int d0 = 0; d0 < 2; ++d0) _Pragma("unroll") for (int k = 0; k < 4; ++k) { const s16x4 lo_ = vlo[4 * d0 + k], hh_ = vhh[4 * d0 + k]; \
        const bf16x8 vf_ = (bf16x8){lo_[0], lo_[1], lo_[2], lo_[3], hh_[0], hh_[1], hh_[2], hh_[3]}; o[d0] = __builtin_amdgcn_mfma_f32_32x32x16_bf16(pa[k], vf_, o[d0], 0, 0, 0); } } while (0)
#define A3_ROWMAX(rm) do { float a_ = fmaxf(fmaxf(c0[0], c0[1]), c1[0]), b_ = fmaxf(fmaxf(c0[2], c0[3]), c1[1]); a_ = fmaxf(fmaxf(a_, c1[2]), c1[3]); \
        _Pragma("unroll") for (int r = 4; r < 16; r += 4) { a_ = fmaxf(fmaxf(a_, c0[r]), c0[r + 1]); b_ = fmaxf(fmaxf(b_, c0[r + 2]), c0[r + 3]); a_ = fmaxf(fmaxf(a_, c1[r]), c1[r + 1]); b_ = fmaxf(fmaxf(b_, c1[r + 2]), c1[r + 3]); } \
        rm = fmaxf(a_, b_); const auto rr_ = __builtin_amdgcn_permlane32_swap(__float_as_uint(rm), __float_as_uint(rm), false, false); rm = fmaxf(__uint_as_float(rr_[0]), __uint_as_float(rr_[1])); } while (0)
    int sl = A3_SLOT(0), sl3 = A3_SLOT(3);
    f32x16 pp0 = f32x16{}, pp1 = f32x16{}; bool pend = false; int pslot = 0;
    for (int i = 0; i < NTE; ++i) {
        const int t = NT - 1 - i;
        { const int ahead = NTE - 1 - i;
          if (ahead >= 2) asm volatile("s_waitcnt vmcnt(6)" ::: "memory"); else if (ahead == 1) asm volatile("s_waitcnt vmcnt(3)" ::: "memory"); else asm volatile("s_waitcnt vmcnt(0)" ::: "memory"); }
        __builtin_amdgcn_s_barrier(); asm volatile("" ::: "memory");
        if (i + 3 < NTE) A2_DMA(t - 3, sl3);
        if (i == NTE - 1 && qb_next >= 0) { const int NTn = 4 * qb_next + 4; A2_DMA(NTn - 1, A3_SLOT(NTE)); A2_DMA(NTn - 2, A3_SLOT(NTE + 1)); A2_DMA(NTn - 3, A3_SLOT(NTE + 2)); }
        if (t <= tlast) {
            bf16x8 kf[2 * DKH]; f32x16 c0, c1; float rm;
            A3_KLOADH(sl, 0);
            if (!pend) {
                A3_QKH(0); A3_KLOADH(sl, 1); A3_QKH(1);
                if (MODE == 0) { const int qrel = qw0 + r32 - 64 * t;
#pragma unroll
                    for (int r = 0; r < 16; ++r) { const int kv = crow(r, hi); if (kv > qrel) c0[r] = -INFINITY; if (kv + 32 > qrel) c1[r] = -INFINITY; } }
                A3_ROWMAX(rm);
                mhat = rm;
#pragma unroll
                for (int r = 0; r < 16; ++r) { c0[r] -= rm; c1[r] -= rm; negm[r] = -mhat; }
                pend = true;
            } else {
                s16x4 vlo[8], vhh[8]; bf16x8 pa[4];
                A3_QKH(0); A3_KLOADH(sl, 1);
                A3_VLOAD(pslot);
                A3_QKH(1);
                A3_EXP();
#pragma unroll
                for (int g_ = 0; g_ < 2 * DKS; ++g_) { __builtin_amdgcn_sched_group_barrier(0x008, 1, 0); __builtin_amdgcn_sched_group_barrier(0x002, 7, 0); }
                A3_PV();
                A3_ROWMAX(rm);
#pragma unroll
                for (int g_ = 0; g_ < 8; ++g_) { __builtin_amdgcn_sched_group_barrier(0x008, 1, 0); __builtin_amdgcn_sched_group_barrier(0x002, 3, 0); }
                if (__any(rm > THR)) {
                    const float dl = fmaxf(rm, 0.f); mhat += dl;
#pragma unroll
                    for (int r = 0; r < 16; ++r) { c0[r] -= dl; c1[r] -= dl; negm[r] = -mhat; }
                    const float f = __builtin_amdgcn_exp2f(-dl); lrun *= f;
                    if (hi == 0) wsf[r32] = f;
                    LDS_WAIT();
#pragma unroll
                    for (int g = 0; g < 4; ++g) { const f32x4 ff = *(const LAS f32x4*)(wsf + 8 * g + 4 * hi);
#pragma unroll
                        for (int j = 0; j < 4; ++j) { o[0][4 * g + j] *= ff[j]; o[1][4 * g + j] *= ff[j]; } }
                }
            }
            pp0 = c0; pp1 = c1; pslot = sl;
        }
        sl = (sl == NSL - 1) ? 0 : sl + 1; sl3 = (sl3 == NSL - 1) ? 0 : sl3 + 1;
    }
    if (pend) { s16x4 vlo[8], vhh[8]; bf16x8 pa[4]; A3_VLOAD(pslot); A3_EXP(); A3_PV(); }
#undef A3_KLOADH
#undef A3_VLOAD
#undef A3_QKH
#undef A3_EXP
#undef A3_PV
#undef A3_ROWMAX
#undef A2_DMA
    lrun += __shfl_xor(lrun, 32);
    LDS_WAIT();
    if (hi == 0) wsf[32 + r32] = lrun;
    LDS_WAIT();
    float rli[16];
#pragma unroll
    for (int g = 0; g < 4; ++g) { const f32x4 ll = *(const LAS f32x4*)(wsf + 32 + 8 * g + 4 * hi);
#pragma unroll
        for (int j = 0; j < 4; ++j) rli[4 * g + j] = __builtin_amdgcn_rcpf(ll[j]); }
    GAS bf16* Ow = T.O + (rowbase + qw0) * 1024 + (MODE ? 0 : 512) + h * 64;
    { LAS bf16* stg = (LAS bf16*)(shm + R_OST) + wid * 2048;
#pragma unroll
      for (int r = 0; r < 16; ++r) { const int orow = crow(r, hi);
#pragma unroll
          for (int d0 = 0; d0 < 2; ++d0) stg[orow * 64 + d0 * 32 + r32] = (bf16)(cvt_pk_bf16(o[d0][r] * rli[r], 0.f) & 0xffffu); }
      LDS_WAIT();
#pragma unroll
      for (int i = 0; i < 4; ++i) { const int row = i * 8 + (lane >> 3), ch = lane & 7; const u32x4 v = *(const LAS u32x4*)(stg + row * 64 + ch * 8); *(GAS u32x4*)(Ow + (long)row * 1024 + ch * 8) = v; } }
    if (qb_next < 0) { LDS_WAIT(); __builtin_amdgcn_s_barrier(); asm volatile("" ::: "memory"); }
    return A3_SLOT(NTE);
#undef A3_SLOT
}
}

struct Args { const void* in[21]; float* out; unsigned char* ws; int ph_lo, ph_hi; };

__device__ __forceinline__ void tr_item(const GAS float* __restrict__ W, int ldw, int Ksrc, const GAS float* __restrict__ gain, GAS bf16* __restrict__ WT, int ldk, int k0, int n0, int srccol, LAS float* scr, int lane) {
#pragma unroll 8
    for (int i = 0; i < 32; ++i) { const int kk = 2 * i + (lane >> 5); const int k = k0 + kk;
        float v = 0.f; if (srccol >= 0 && k < Ksrc) { v = W[(size_t)k * ldw + srccol]; if (gain) v *= gain[k]; }
        scr[kk * 33 + (lane & 31)] = v; }
    LDS_WAIT(); asm volatile("" ::: "memory");
    const int c = lane & 7;
#pragma unroll
    for (int j = 0; j < 4; ++j) { const int n = (lane >> 3) + 8 * j; const LAS float* s = scr + (8 * c) * 33 + n;
        u32x4 o; o.x = cvt_pk_bf16(s[0 * 33], s[1 * 33]); o.y = cvt_pk_bf16(s[2 * 33], s[3 * 33]); o.z = cvt_pk_bf16(s[4 * 33], s[5 * 33]); o.w = cvt_pk_bf16(s[6 * 33], s[7 * 33]);
        *(GAS u32x4*)(WT + (size_t)(n0 + n) * ldk + k0 + 8 * c) = o; }
    LDS_WAIT(); asm volatile("" ::: "memory");
}
__device__ __forceinline__ void tr_item64(const GAS float* __restrict__ W, int ldw, const GAS float* __restrict__ gain, GAS bf16* __restrict__ WT, int ldk, int k0, int n0src, int n0dst, LAS float* scr, int lane) {
    const int rr = lane >> 4, c4 = (lane & 15) * 4;
    f32x4 v[16];
#pragma unroll
    for (int i = 0; i < 16; ++i) v[i] = *(const GAS f32x4*)(W + (size_t)(k0 + 4 * i + rr) * ldw + n0src + c4);
#pragma unroll
    for (int i = 0; i < 16; ++i) { const int k = 4 * i + rr; const float g = gain ? gain[k0 + k] : 1.f; LAS float* d = scr + k * 65 + c4;
        d[0] = v[i][0] * g; d[1] = v[i][1] * g; d[2] = v[i][2] * g; d[3] = v[i][3] * g; }
    LDS_WAIT(); asm volatile("" ::: "memory");
    const int kc = lane & 7;
#pragma unroll
    for (int j = 0; j < 8; ++j) { const int n = (lane >> 3) + 8 * j; const LAS float* sp = scr + (8 * kc) * 65 + n;
        u32x4 o; o.x = cvt_pk_bf16(sp[0 * 65], sp[1 * 65]); o.y = cvt_pk_bf16(sp[2 * 65], sp[3 * 65]); o.z = cvt_pk_bf16(sp[4 * 65], sp[5 * 65]); o.w = cvt_pk_bf16(sp[6 * 65], sp[7 * 65]);
        *(GAS u32x4*)(WT + (size_t)(n0dst + n) * ldk + k0 + 8 * kc) = o; }
    LDS_WAIT(); asm volatile("" ::: "memory");
}
__device__ __forceinline__ void tr_item64_f8(const GAS float* __restrict__ W, int ldw, const GAS float* __restrict__ gain, float scale, GAS unsigned char* __restrict__ WT8, int ldkB, int k0, int n0src, int n0dst, LAS float* scr, int lane) {
    const int rr = lane >> 4, c4 = (lane & 15) * 4;
    f32x4 v[16];
#pragma unroll
    for (int i = 0; i < 16; ++i) v[i] = *(const GAS f32x4*)(W + (size_t)(k0 + 4 * i + rr) * ldw + n0src + c4);
#pragma unroll
    for (int i = 0; i < 16; ++i) { const int k = 4 * i + rr; const float g = (gain ? gain[k0 + k] : 1.f) * scale; LAS float* d = scr + k * 65 + c4;
        d[0] = v[i][0] * g; d[1] = v[i][1] * g; d[2] = v[i][2] * g; d[3] = v[i][3] * g; }
    LDS_WAIT(); asm volatile("" ::: "memory");
    const int kc = lane & 7;
#pragma unroll
    for (int j = 0; j < 8; ++j) { const int n = (lane >> 3) + 8 * j; const LAS float* sp = scr + (8 * kc) * 65 + n;
        u32x2 o; o.x = pk4_fp8(sp[0 * 65], sp[1 * 65], sp[2 * 65], sp[3 * 65]); o.y = pk4_fp8(sp[4 * 65], sp[5 * 65], sp[6 * 65], sp[7 * 65]);
        *(GAS u32x2*)(WT8 + (size_t)(n0dst + n) * ldkB + k0 + 8 * kc) = o; }
    LDS_WAIT(); asm volatile("" ::: "memory");
}
__device__ __forceinline__ int rope_dim(int p) { const int a = p >> 3, j = p & 7; return j < 4 ? 4 * a + j : 16 + 4 * a + (j - 4); }

#define LDP(i) ((void*)((((unsigned long long)(unsigned)__builtin_amdgcn_readfirstlane((int)(ARGP[i] >> 32))) << 32) | (unsigned long long)(unsigned)__builtin_amdgcn_readfirstlane((int)(unsigned)ARGP[i])))
#define ARGIN(i) ((const void*)LDP(i))
#define P_COS ((GAS float*)(ws + WS_COS))
#define P_SIN ((GAS float*)(ws + WS_SIN))
#define P_SSQ ((GAS float*)(ws + WS_SSQ))
#define P_FLOG ((GAS float*)(ws + WS_FLOG))
#define P_E01 ((GAS int*)(ws + WS_E01))
#define P_G01 ((GAS float*)(ws + WS_G01))
#define P_SLOT ((GAS int*)(ws + WS_SLOT))
#define P_TOKOF ((GAS int*)(ws + WS_TOKOF))
#define P_GATEOF ((GAS float*)(ws + WS_GATEOF))
#define P_CNT ((GAS int*)(ws + WS_CNT))
#define P_TSTART ((GAS int*)(ws + WS_TSTART))
#define P_RSTD ((GAS float*)(ws + WS_RSTD))
#define P_RSTDOF ((GAS float*)(ws + WS_RSTDOF))
#define P_KPE ((GAS bf16*)(ws + WS_KPE))
#define P_KAUG ((GAS bf16*)(ws + WS_KAUG))
#define P_BIASF ((GAS float*)(ws + WS_BIASF))
#define P_NRM ((GAS float*)(ws + WS_NRM))
#define P_WR ((GAS float*)(ws + WS_WR))
#define P_WIN ((GAS bf16*)(ws + WS_WIN))
#define P_WUQ ((GAS bf16*)(ws + WS_WUQ))
#define P_WUKV ((GAS bf16*)(ws + WS_WUKV))
#define P_WOUT ((GAS bf16*)(ws + WS_WOUT))
#define P_WGU ((GAS bf16*)(ws + WS_WGU))
#define P_WD ((GAS bf16*)(ws + WS_WD))
#define P_XN ((GAS bf16*)(ws + WS_XN))
#define P_FQKV ((GAS bf16*)(ws + WS_FQKV))
#define P_HH ((GAS bf16*)(ws + WS_FQKV))
#define P_LAT ((GAS bf16*)(ws + WS_LAT))
#define P_QM ((GAS bf16*)(ws + WS_QM))
#define P_KVM ((GAS bf16*)(ws + WS_KVM))
#define P_Y ((GAS bf16*)(ws + WS_Y))
#define IN(k) (lo <= (k) && (k) < hi_)
#if MK_ONE_LAUNCH
#define GRID_BAR() xcd_barrier(bar)
#else
#define GRID_BAR() do {} while (0)
#endif
#define SEAM(k) do { if (IN(k) && IN((k) + 1)) GRID_BAR(); } while (0)
template <int l>
__device__ __forceinline__ void layer_body(const int lo, const int hi_, LAS unsigned char* lds0, const int wave0, const int G0, const int bx0, const XcdBarrier& bar) {
        const int P = 10 * l;
        if (IN(P)) for (int rep_ = 0; rep_ < (l == 0 ? NREP(0) : 1); ++rep_) {
            unsigned ldsb_ = (unsigned)(uintptr_t)lds0; asm volatile("" : "+s"(ldsb_)); LAS unsigned char* lds = (LAS unsigned char*)(uintptr_t)ldsb_; volatile LAS unsigned* MISC = (volatile LAS unsigned*)(lds + MISC_OFF); volatile LAS unsigned long long* ARGP = (volatile LAS unsigned long long*)(lds + MISC_OFF + 768); (void)MISC; int wave = wave0, G = G0, bx = bx0; asm volatile("" : "+s"(G), "+s"(bx), "+s"(wave)); const int lane = (int)__builtin_amdgcn_mbcnt_hi(~0u, __builtin_amdgcn_mbcnt_lo(~0u, 0u)); const int tid = wave * 64 + lane; const int vcu = (bx % 8) * (G / 8) + bx / 8; const int gw = vcu * 8 + wave, NGW = G * 8; (void)lane; (void)gw; (void)NGW; (void)vcu;
            GAS unsigned char* ws = (GAS unsigned char*)LDP(22); GAS float* out = (GAS float*)LDP(21); const GAS float* x_in = (const GAS float*)ARGIN(0); const GAS int* positions = (const GAS int*)ARGIN(1);
            if (l < NLAYER) {
                LAS float* scr = (LAS float*)(lds + wave * 16640);
                const GAS float* attn_norm = (const GAS float*)ARGIN(2) + (size_t)l * DM; const GAS float* w_in = (const GAS float*)ARGIN(3) + (size_t)l * DM * INW;
                const GAS float* q_norm = (const GAS float*)ARGIN(5) + (size_t)l * 256; const GAS float* w_uq = (const GAS float*)ARGIN(6) + (size_t)l * 256 * 768;
                const GAS float* kv_norm = (const GAS float*)ARGIN(7) + (size_t)l * 128; const GAS float* w_ukv = (const GAS float*)ARGIN(8) + (size_t)l * 128 * 1024;
                const GAS float* mla_on = (const GAS float*)ARGIN(9) + (size_t)l * 512; const GAS float* fox_on = (const GAS float*)ARGIN(10) + (size_t)l * 512; const GAS float* w_out = (const GAS float*)ARGIN(11) + (size_t)l * DM * DM;
                const GAS float* ffn_norm = (const GAS float*)ARGIN(12) + (size_t)l * DM;
                const GAS float* w_gate = (const GAS float*)ARGIN(17) + (size_t)l * NEXP * DM * DEXP; const GAS float* w_up = (const GAS float*)ARGIN(18) + (size_t)l * NEXP * DM * DEXP; const GAS float* w_down = (const GAS float*)ARGIN(19) + (size_t)l * NEXP * DEXP * DM;
                constexpr int I_IN = 16 * 64, I_UQ = 4 * 24, I_UKV = 4 * 32;
                constexpr int NITEMS = I_IN + I_UQ + I_UKV;
                for (int it = gw; it < NITEMS; it += NGW) {
                    int r = it; const int j = lane & 31;
                    if (r < I_IN) { const int kb = r / 64, nb = r % 64; const int n = nb * 32 + j; int sc;
                        if (n < 384) sc = n; else if (n < 416) sc = 384 + rope_dim(n - 384); else if (n < 424) sc = 1952 + (n - 416); else if (n < 512) sc = -1; else sc = 416 + (n - 512);
                        tr_item(w_in, INW, DM, attn_norm, P_WIN, DM, kb * 64, nb * 32, sc, scr, lane); continue; } r -= I_IN;
                    if (r < I_UQ) { const int kb = r / 24, nb = r % 24; const int n = nb * 32 + j; const int hh = n / 96, d = n % 96; const int sc = d < 64 ? n : hh * 96 + 64 + rope_dim(d - 64);
                        tr_item(w_uq, 768, 256, q_norm, P_WUQ, 256, kb * 64, nb * 32, sc, scr, lane); continue; } r -= I_UQ;
                    { const int kb = r / 32, nb = r % 32; tr_item(w_ukv, 1024, 128, kv_norm, P_WUKV, 256, kb * 64, nb * 32, nb * 32 + j, scr, lane); }
                }
                LAS float* scr64 = (LAS float*)(lds + wave * 16640);
                constexpr int J_OUT = 16 * 16, J_GU = 16 * 16 * NEXP, J_D = 8 * 16 * NEXP;
                for (int it = gw; it < J_OUT + J_GU + J_D; it += NGW) {
                    int r = it;
                    if (r < J_OUT) { const int kb = r / 16, nb = r % 16; const GAS float* gn = kb < 8 ? mla_on : fox_on - 512; tr_item64(w_out, DM, gn, P_WOUT, DM, kb * 64, nb * 64, nb * 64, scr64, lane); continue; } r -= J_OUT;
                    if (r < J_GU) { const int e = r / 256, q = r % 256, kb = q / 16, nb = q % 16; const int n0 = nb * 64; const int ct = n0 >> 8, which = (n0 >> 7) & 1, jj = n0 & 127;
                        const GAS float* src = (which ? w_up : w_gate) + (size_t)e * DM * DEXP;
                        tr_item64_f8(src, DEXP, ffn_norm, WSCALE, (GAS unsigned char*)P_WGU + (size_t)e * 1024 * 1024, DM, kb * 64, ct * 128 + jj, n0, scr64, lane); continue; } r -= J_GU;
                    { const int e = r / 128, q = r % 128, kb = q / 16, nb = q % 16;
                        tr_item64_f8(w_down + (size_t)e * DEXP * DM, DM, nullptr, WSCALE, (GAS unsigned char*)P_WD + (size_t)e * 1024 * 512, DEXP, kb * 64, nb * 64, nb * 64, scr64, lane); }
                }
                { const GAS float* w_rg = (const GAS float*)ARGIN(13) + (size_t)l * DM * 4; const GAS float* w_re = (const GAS float*)ARGIN(15) + (size_t)l * DM * 32;
                  for (int idx = bx * 512 + tid; idx < DM * 36; idx += G * 512) { const int k = idx / 36, e = idx % 36; P_WR[idx] = ffn_norm[k] * (e < 4 ? w_rg[k * 4 + e] : w_re[k * 32 + (e - 4)]); } }
            }
            const GAS float* fin = (const GAS float*)ARGIN(20);
            for (int mb = gw * 4; mb < NTOK; mb += NGW * 4) {
                f32x4 v[4][4]; int s0[4], s1[4];
                if (l > 0) {
#pragma unroll
                    for (int r = 0; r < 4; ++r) { s0[r] = P_SLOT[2 * (mb + r)]; s1[r] = P_SLOT[2 * (mb + r) + 1]; }
                }
#pragma unroll
                for (int r = 0; r < 4; ++r) { const GAS float* xr = (l == 0 ? x_in : out) + (size_t)(mb + r) * DM;
#pragma unroll
                    for (int j = 0; j < 4; ++j) v[r][j] = *(const GAS f32x4*)(xr + 4 * lane + 256 * j); }
                if (l > 0) {
#pragma unroll
                    for (int r = 0; r < 4; ++r)
#pragma unroll
                        for (int j = 0; j < 4; ++j) { const u32x2 a = *(const GAS u32x2*)(P_Y + (size_t)s0[r] * 1024 + 4 * lane + 256 * j), c = *(const GAS u32x2*)(P_Y + (size_t)s1[r] * 1024 + 4 * lane + 256 * j);
                            v[r][j][0] += __uint_as_float(a.x << 16) + __uint_as_float(c.x << 16); v[r][j][1] += __uint_as_float(a.x & 0xffff0000u) + __uint_as_float(c.x & 0xffff0000u);
                            v[r][j][2] += __uint_as_float(a.y << 16) + __uint_as_float(c.y << 16); v[r][j][3] += __uint_as_float(a.y & 0xffff0000u) + __uint_as_float(c.y & 0xffff0000u); }
                }
                float ss[4];
#pragma unroll
                for (int r = 0; r < 4; ++r) { float s = 0.f;
#pragma unroll
                    for (int j = 0; j < 4; ++j) s += (v[r][j][0] * v[r][j][0] + v[r][j][1] * v[r][j][1]) + (v[r][j][2] * v[r][j][2] + v[r][j][3] * v[r][j][3]);
                    ss[r] = s; }
#pragma unroll
                for (int o = 1; o < 64; o <<= 1) {
#pragma unroll
                    for (int r = 0; r < 4; ++r) ss[r] += __shfl_xor(ss[r], o); }
#pragma unroll
                for (int r = 0; r < 4; ++r) { const int m = mb + r; const float rstd = rsqrtf(ss[r] * (1.f / DM) + EPS);
                    if (l < NLAYER) {
                        if (l > 0) {
#pragma unroll
                            for (int j = 0; j < 4; ++j) *(GAS f32x4*)(out + (size_t)m * DM + 4 * lane + 256 * j) = v[r][j];
                        }
#pragma unroll
                        for (int j = 0; j < 4; ++j) { u32x2 w; w.x = cvt_pk_bf16(v[r][j][0] * rstd, v[r][j][1] * rstd); w.y = cvt_pk_bf16(v[r][j][2] * rstd, v[r][j][3] * rstd); *(GAS u32x2*)(P_XN + (size_t)m * DM + 4 * lane + 256 * j) = w; }
                    } else {
#pragma unroll
                        for (int j = 0; j < 4; ++j) { const f32x4 g = *(const GAS f32x4*)(fin + 4 * lane + 256 * j); *(GAS f32x4*)(out + (size_t)m * DM + 4 * lane + 256 * j) = v[r][j] * rstd * g; }
                    }
                }
            }
        }
        if constexpr (l == NLAYER) return;
        SEAM(P);
        if (IN(P + 1)) for (int rep_ = 0; rep_ < ((l == 0 || 1 != 5) ? NREP(1) : 1); ++rep_) {
            unsigned ldsb_ = (unsigned)(uintptr_t)lds0; asm volatile("" : "+s"(ldsb_)); LAS unsigned char* lds = (LAS unsigned char*)(uintptr_t)ldsb_; volatile LAS unsigned* MISC = (volatile LAS unsigned*)(lds + MISC_OFF); volatile LAS unsigned long long* ARGP = (volatile LAS unsigned long long*)(lds + MISC_OFF + 768); (void)MISC; int wave = wave0, G = G0, bx = bx0; asm volatile("" : "+s"(G), "+s"(bx), "+s"(wave)); const int lane = (int)__builtin_amdgcn_mbcnt_hi(~0u, __builtin_amdgcn_mbcnt_lo(~0u, 0u)); const int tid = wave * 64 + lane; const int vcu = (bx % 8) * (G / 8) + bx / 8; const int gw = vcu * 8 + wave, NGW = G * 8; (void)lane; (void)gw; (void)NGW; (void)vcu;
            GAS unsigned char* ws = (GAS unsigned char*)LDP(22); GAS float* out = (GAS float*)LDP(21); const GAS float* x_in = (const GAS float*)ARGIN(0); (void)out; (void)x_in; (void)ws;
            DenseOrder S{NTOK / 256, INP / 256, (NTOK / 256) * (INP / 256), G, bx, (const GAS char*)P_XN, (const GAS char*)P_WIN, (size_t)256 * DM * 2, (size_t)256 * DM * 2};
            EpiWin E{P_LAT, P_FQKV, P_KPE, P_FLOG, P_SSQ, P_COS, P_SIN};
            pg8::gemm_phase<EpiWin, DenseOrder, true, false>(tid, lds, DM * 2, DM * 2, DM * 2, S, E, nullptr);
        }
        SEAM(P + 1);
        if (IN(P + 2)) for (int rep_ = 0; rep_ < ((l == 0 || 2 != 5) ? NREP(2) : 1); ++rep_) {
            unsigned ldsb_ = (unsigned)(uintptr_t)lds0; asm volatile("" : "+s"(ldsb_)); LAS unsigned char* lds = (LAS unsigned char*)(uintptr_t)ldsb_; volatile LAS unsigned* MISC = (volatile LAS unsigned*)(lds + MISC_OFF); volatile LAS unsigned long long* ARGP = (volatile LAS unsigned long long*)(lds + MISC_OFF + 768); (void)MISC; int wave = wave0, G = G0, bx = bx0; asm volatile("" : "+s"(G), "+s"(bx), "+s"(wave)); const int lane = (int)__builtin_amdgcn_mbcnt_hi(~0u, __builtin_amdgcn_mbcnt_lo(~0u, 0u)); const int tid = wave * 64 + lane; const int vcu = (bx % 8) * (G / 8) + bx / 8; const int gw = vcu * 8 + wave, NGW = G * 8; (void)lane; (void)gw; (void)NGW; (void)vcu;
            GAS unsigned char* ws = (GAS unsigned char*)LDP(22); GAS float* out = (GAS float*)LDP(21); const GAS float* x_in = (const GAS float*)ARGIN(0); (void)out; (void)x_in; (void)ws;
            if (vcu < 128) {
                const int b = vcu >> 3, h = vcu & 7; const float bf = ((const GAS float*)ARGIN(4))[l * 8 + h];
                const GAS float* fl = P_FLOG + ((size_t)b * SEQ + 4 * tid) * 8 + h;
                float lf[4];
#pragma unroll
                for (int e = 0; e < 4; ++e) { const float f = fl[e * 8] + bf; lf[e] = fminf(f, 0.f) - log1pf(expf(-fabsf(f))); }
                const double s4 = ((double)lf[0] + (double)lf[1]) + ((double)lf[2] + (double)lf[3]);
                double incl = s4;
#pragma unroll
                for (int o = 1; o < 64; o <<= 1) { const double t = __shfl_up(incl, o); if (lane >= o) incl += t; }
                LAS double* wtot = (LAS double*)lds;
                if (lane == 63) wtot[wave] = incl;
                __syncthreads();
                double c = incl - s4;
                for (int w = 0; w < wave; ++w) c += wtot[w];
                GAS u32x4* ka = (GAS u32x4*)(P_KAUG + (((size_t)b * 8 + h) * SEQ + 4 * tid) * 8);
#pragma unroll
                for (int e = 0; e < 4; ++e) { c += (double)lf[e]; const float x = (float)(-c * 1.4426950408889634);
                    const unsigned h16 = cvt_pk_bf16(x, 0.f) & 0xffffu; const float r1 = x - __uint_as_float(h16 << 16); const unsigned m16 = cvt_pk_bf16(r1, 0.f) & 0xffffu; const float r2 = r1 - __uint_as_float(m16 << 16); const unsigned l16 = cvt_pk_bf16(r2, 0.f) & 0xffffu;
                    ka[e] = (u32x4){h16 | (m16 << 16), l16, 0u, 0u}; P_BIASF[((size_t)b * 8 + h) * SEQ + 4 * tid + e] = x; }
                float qn = 0.f, kn = 0.f;
                { const GAS bf16* fqp = P_FQKV + ((size_t)b * SEQ + 4 * tid) * 512 + h * 64; const GAS bf16* fkp = fqp + (size_t)NTOK * 512;
#pragma unroll
                  for (int e = 0; e < 4; ++e) { float sq = 0.f, sk = 0.f;
#pragma unroll
                      for (int c8 = 0; c8 < 8; ++c8) { const u32x4 a = *(const GAS u32x4*)(fqp + e * 512 + c8 * 8), k4 = *(const GAS u32x4*)(fkp + e * 512 + c8 * 8);
#pragma unroll
                          for (int j = 0; j < 4; ++j) { const float a0 = __uint_as_float(a[j] << 16), a1 = __uint_as_float(a[j] & 0xffff0000u), k0 = __uint_as_float(k4[j] << 16), k1 = __uint_as_float(k4[j] & 0xffff0000u);
                              sq += a0 * a0 + a1 * a1; sk += k0 * k0 + k1 * k1; } }
                      qn = fmaxf(qn, sq); kn = fmaxf(kn, sk); } }
#pragma unroll
                for (int o = 1; o < 64; o <<= 1) { qn = fmaxf(qn, __shfl_xor(qn, o)); kn = fmaxf(kn, __shfl_xor(kn, o)); }
                LAS float* knw = (LAS float*)(lds + 256);
                if (lane == 0) { P_NRM[(b * 8 + h) * 16 + wave] = sqrtf(qn); knw[wave] = kn; }
                __syncthreads();
                if (tid == 0) { float m = knw[0]; for (int w = 1; w < 8; ++w) m = fmaxf(m, knw[w]); P_NRM[(b * 8 + h) * 16 + 8] = sqrtf(m); }
                __syncthreads();
            }
            UpOrder S{G, (vcu + 128) & 255, (const GAS char*)P_LAT, (const GAS char*)P_WUQ, (const GAS char*)P_WUKV};
            EpiUp E{P_QM, P_KVM, P_SSQ, P_COS, P_SIN};
            pg8::gemm_phase<EpiUp, UpOrder, true, false>(tid, lds, 256 * 2, 512 * 2, 256 * 2, S, E, nullptr);
        }
        SEAM(P + 2);
        if (IN(P + 3)) for (int rep_ = 0; rep_ < ((l == 0 || 3 != 5) ? NREP(3) : 1); ++rep_) {
            unsigned ldsb_ = (unsigned)(uintptr_t)lds0; asm volatile("" : "+s"(ldsb_)); LAS unsigned char* lds = (LAS unsigned char*)(uintptr_t)ldsb_; volatile LAS unsigned* MISC = (volatile LAS unsigned*)(lds + MISC_OFF); volatile LAS unsigned long long* ARGP = (volatile LAS unsigned long long*)(lds + MISC_OFF + 768); (void)MISC; int wave = wave0, G = G0, bx = bx0; asm volatile("" : "+s"(G), "+s"(bx), "+s"(wave)); const int lane = (int)__builtin_amdgcn_mbcnt_hi(~0u, __builtin_amdgcn_mbcnt_lo(~0u, 0u)); const int tid = wave * 64 + lane; const int vcu = (bx % 8) * (G / 8) + bx / 8; const int gw = vcu * 8 + wave, NGW = G * 8; (void)lane; (void)gw; (void)NGW; (void)vcu;
            GAS unsigned char* ws = (GAS unsigned char*)LDP(22); GAS float* out = (GAS float*)LDP(21); const GAS float* x_in = (const GAS float*)ARGIN(0); (void)out; (void)x_in; (void)ws;
            GAS bf16* O = P_XN;
            const int b = vcu >> 4, hh = (vcu & 15) >> 1, sub = vcu & 1;
            const att::Tens2 TM{P_QM, 768, P_KVM, 1024, P_KPE, P_KVM + 64, 1024, O, nullptr, nullptr};
            const att::Tens2 TF{P_FQKV, 512, P_FQKV + (size_t)NTOK * 512, 512, P_KAUG, P_FQKV + (size_t)2 * NTOK * 512, 512, O, P_BIASF, P_NRM};
#define QB_OF(i) ((((i) & 1) ? 7 - (2 * sub + ((i) >> 1)) : (2 * sub + ((i) >> 1))))
            { int sb = 0; for (int i = 0; i < 4; ++i) sb = att::attn_unit2<1>(wave, b, hh, QB_OF(i), TM, (LAS char*)lds, sb, i > 0, i < 3 ? QB_OF(i + 1) : -1); }
            { int sb = 0; for (int i = 0; i < 4; ++i) sb = att::attn_unit2<0>(wave, b, hh, QB_OF(i), TF, (LAS char*)lds, sb, i > 0, i < 3 ? QB_OF(i + 1) : -1); }
#undef QB_OF
        }
        SEAM(P + 3);
        if (IN(P + 4)) for (int rep_ = 0; rep_ < ((l == 0 || 4 != 5) ? NREP(4) : 1); ++rep_) {
            unsigned ldsb_ = (unsigned)(uintptr_t)lds0; asm volatile("" : "+s"(ldsb_)); LAS unsigned char* lds = (LAS unsigned char*)(uintptr_t)ldsb_; volatile LAS unsigned* MISC = (volatile LAS unsigned*)(lds + MISC_OFF); volatile LAS unsigned long long* ARGP = (volatile LAS unsigned long long*)(lds + MISC_OFF + 768); (void)MISC; int wave = wave0, G = G0, bx = bx0; asm volatile("" : "+s"(G), "+s"(bx), "+s"(wave)); const int lane = (int)__builtin_amdgcn_mbcnt_hi(~0u, __builtin_amdgcn_mbcnt_lo(~0u, 0u)); const int tid = wave * 64 + lane; const int vcu = (bx % 8) * (G / 8) + bx / 8; const int gw = vcu * 8 + wave, NGW = G * 8; (void)lane; (void)gw; (void)NGW; (void)vcu;
            GAS unsigned char* ws = (GAS unsigned char*)LDP(22); GAS float* out = (GAS float*)LDP(21); const GAS float* x_in = (const GAS float*)ARGIN(0); (void)out; (void)x_in; (void)ws;
            GAS bf16* O = P_XN;
            for (int mb = gw * 4; mb < NTOK; mb += NGW * 4) {
                u32x4 a[4], c[4];
#pragma unroll
                for (int r = 0; r < 4; ++r) { const GAS bf16* orow = O + (size_t)(mb + r) * DM; a[r] = *(const GAS u32x4*)(orow + 8 * lane); c[r] = *(const GAS u32x4*)(orow + 512 + 8 * lane); }
                float sa[4], sc[4];
#pragma unroll
                for (int r = 0; r < 4; ++r) { sa[r] = 0.f; sc[r] = 0.f;
#pragma unroll
                    for (int j = 0; j < 4; ++j) { const float a0 = __uint_as_float(a[r][j] << 16), a1 = __uint_as_float(a[r][j] & 0xffff0000u), c0 = __uint_as_float(c[r][j] << 16), c1 = __uint_as_float(c[r][j] & 0xffff0000u);
                        sa[r] += a0 * a0 + a1 * a1; sc[r] += c0 * c0 + c1 * c1; } }
#pragma unroll
                for (int o = 1; o < 64; o <<= 1) {
#pragma unroll
                    for (int r = 0; r < 4; ++r) { sa[r] += __shfl_xor(sa[r], o); sc[r] += __shfl_xor(sc[r], o); } }
#pragma unroll
                for (int r = 0; r < 4; ++r) { GAS bf16* orow = O + (size_t)(mb + r) * DM;
                    const float ra = rsqrtf(sa[r] * (1.f / 512.f) + EPS), rc = rsqrtf(sc[r] * (1.f / 512.f) + EPS);
                    u32x4 oa, oc;
#pragma unroll
                    for (int j = 0; j < 4; ++j) { oa[j] = cvt_pk_bf16(__uint_as_float(a[r][j] << 16) * ra, __uint_as_float(a[r][j] & 0xffff0000u) * ra); oc[j] = cvt_pk_bf16(__uint_as_float(c[r][j] << 16) * rc, __uint_as_float(c[r][j] & 0xffff0000u) * rc); }
                    *(GAS u32x4*)(orow + 8 * lane) = oa; *(GAS u32x4*)(orow + 512 + 8 * lane) = oc; }
            }
        }
        SEAM(P + 4);
        if (IN(P + 5)) for (int rep_ = 0; rep_ < ((l == 0 || 5 != 5) ? NREP(5) : 1); ++rep_) {
            unsigned ldsb_ = (unsigned)(uintptr_t)lds0; asm volatile("" : "+s"(ldsb_)); LAS unsigned char* lds = (LAS unsigned char*)(uintptr_t)ldsb_; volatile LAS unsigned* MISC = (volatile LAS unsigned*)(lds + MISC_OFF); volatile LAS unsigned long long* ARGP = (volatile LAS unsigned long long*)(lds + MISC_OFF + 768); (void)MISC; int wave = wave0, G = G0, bx = bx0; asm volatile("" : "+s"(G), "+s"(bx), "+s"(wave)); const int lane = (int)__builtin_amdgcn_mbcnt_hi(~0u, __builtin_amdgcn_mbcnt_lo(~0u, 0u)); const int tid = wave * 64 + lane; const int vcu = (bx % 8) * (G / 8) + bx / 8; const int gw = vcu * 8 + wave, NGW = G * 8; (void)lane; (void)gw; (void)NGW; (void)vcu;
            GAS unsigned char* ws = (GAS unsigned char*)LDP(22); GAS float* out = (GAS float*)LDP(21); const GAS float* x_in = (const GAS float*)ARGIN(0); (void)out; (void)x_in; (void)ws;
            DenseOrder S{NTOK / 256, DM / 256, (NTOK / 256) * (DM / 256), G, bx, (const GAS char*)P_XN, (const GAS char*)P_WOUT, (size_t)256 * DM * 2, (size_t)256 * DM * 2};
            EpiOut E{l == 0 ? x_in : out, out};
            pg8::gemm_phase<EpiOut, DenseOrder, true, false>(tid, lds, DM * 2, DM * 2, DM * 2, S, E, nullptr);
        }
        SEAM(P + 5);
        if (IN(P + 6)) for (int rep_ = 0; rep_ < ((l == 0 || 6 != 5) ? NREP(6) : 1); ++rep_) {
            unsigned ldsb_ = (unsigned)(uintptr_t)lds0; asm volatile("" : "+s"(ldsb_)); LAS unsigned char* lds = (LAS unsigned char*)(uintptr_t)ldsb_; volatile LAS unsigned* MISC = (volatile LAS unsigned*)(lds + MISC_OFF); volatile LAS unsigned long long* ARGP = (volatile LAS unsigned long long*)(lds + MISC_OFF + 768); (void)MISC; int wave = wave0, G = G0, bx = bx0; asm volatile("" : "+s"(G), "+s"(bx), "+s"(wave)); const int lane = (int)__builtin_amdgcn_mbcnt_hi(~0u, __builtin_amdgcn_mbcnt_lo(~0u, 0u)); const int tid = wave * 64 + lane; const int vcu = (bx % 8) * (G / 8) + bx / 8; const int gw = vcu * 8 + wave, NGW = G * 8; (void)lane; (void)gw; (void)NGW; (void)vcu;
            GAS unsigned char* ws = (GAS unsigned char*)LDP(22); GAS float* out = (GAS float*)LDP(21); const GAS float* x_in = (const GAS float*)ARGIN(0); (void)out; (void)x_in; (void)ws;
            GAS bf16* H2 = P_XN;
            LAS float* WRh = (LAS float*)lds;
            LAS float* LG = (LAS float*)(lds + 73728) + wave * 576;
            const GAS float* ffn_norm = (const GAS float*)ARGIN(12) + (size_t)l * DM; const GAS float* w_rg = (const GAS float*)ARGIN(13) + (size_t)l * DM * 4; const GAS float* b_rg = (const GAS float*)ARGIN(14) + l * 4;
            const GAS float* w_re = (const GAS float*)ARGIN(15) + (size_t)l * DM * 32; const GAS float* b_re = (const GAS float*)ARGIN(16) + l * 32;
            if (tid < 32) MISC[64 + tid] = 0u;
            const int r16 = lane & 15, g4 = lane >> 4;
            const int m0 = vcu * 128 + wave * 16;
            const GAS float* xrow = out + (size_t)(m0 + r16) * DM + 4 * g4;
            GAS unsigned char* hrow = (GAS unsigned char*)H2 + (size_t)(m0 + r16) * DM + 4 * g4;
            f32x4 acc3[3]; acc3[0] = (f32x4){0.f, 0.f, 0.f, 0.f}; acc3[1] = acc3[0]; acc3[2] = acc3[0];
            float ssq = 0.f;
            int colc[3];
#pragma unroll
            for (int ct = 0; ct < 3; ++ct) { const int c = 16 * ct + r16; colc[ct] = c < 36 ? c : 35; }
            for (int half = 0; half < 2; ++half) {
                __syncthreads();
                for (int idx = tid; idx < 512 * 36 / 4; idx += 512) *(LAS f32x4*)(WRh + 4 * idx) = *(const GAS f32x4*)(P_WR + half * 512 * 36 + 4 * idx);
                __syncthreads();
                for (int s8 = 0; s8 < 32; s8 += 8) {
                    f32x4 xv[8];
#pragma unroll
                    for (int u = 0; u < 8; ++u) xv[u] = *(const GAS f32x4*)(xrow + half * 512 + 16 * (s8 + u));
#pragma unroll
                    for (int u = 0; u < 8; ++u) {
                        const f32x4 x4 = xv[u];
                        *(GAS unsigned*)(hrow + half * 512 + 16 * (s8 + u)) = pk4_fp8(x4[0], x4[1], x4[2], x4[3]);
                        ssq += (x4[0] * x4[0] + x4[1] * x4[1]) + (x4[2] * x4[2] + x4[3] * x4[3]);
                        const LAS float* wk = WRh + (16 * (s8 + u) + 4 * g4) * 36;
#pragma unroll
                        for (int j = 0; j < 4; ++j)
#pragma unroll
                            for (int ct = 0; ct < 3; ++ct) acc3[ct] = __builtin_amdgcn_mfma_f32_16x16x4f32(x4[j], wk[j * 36 + colc[ct]], acc3[ct], 0, 0, 0);
                    }
                }
            }
            ssq += __shfl_xor(ssq, 16); ssq += __shfl_xor(ssq, 32);
            const float rstd = rsqrtf(ssq * (1.f / DM) + EPS);
#pragma unroll
            for (int ct = 0; ct < 3; ++ct) { const int c = 16 * ct + r16; if (c < 36) {
#pragma unroll
                for (int rg = 0; rg < 4; ++rg) LG[(4 * g4 + rg) * 36 + c] = acc3[ct][rg]; } }
            LDS_WAIT();
            if (lane < 16) {
                const int m = m0 + lane; const LAS float* lg = LG + lane * 36;
                float gl[4];
#pragma unroll
                for (int g = 0; g < 4; ++g) gl[g] = lg[g] * rstd + b_rg[g];
                int gi = 0; float gm = gl[0];
#pragma unroll
                for (int g = 1; g < 4; ++g) if (gl[g] > gm) { gm = gl[g]; gi = g; }
                float gs = 0.f;
#pragma unroll
                for (int g = 0; g < 4; ++g) gs += __expf(gl[g] - gm);
                const float gval = 1.f / gs;
                float el[8];
#pragma unroll
                for (int j = 0; j < 8; ++j) el[j] = lg[4 + 8 * gi + j] * rstd + b_re[8 * gi + j];
                int i0 = 0; float mx0 = el[0];
#pragma unroll
                for (int j = 1; j < 8; ++j) if (el[j] > mx0) { mx0 = el[j]; i0 = j; }
                int i1 = -1; float mx1 = -INFINITY;
#pragma unroll
                for (int j = 0; j < 8; ++j) if (j != i0 && el[j] > mx1) { mx1 = el[j]; i1 = j; }
                const float e1 = __expf(mx1 - mx0); const float g0 = gval / (1.f + e1), g1 = gval * e1 / (1.f + e1);
                const int ea = gi * 8 + i0, eb = gi * 8 + i1; P_E01[2 * m] = ea; P_E01[2 * m + 1] = eb; P_G01[2 * m] = g0; P_G01[2 * m + 1] = g1; P_RSTD[m] = rstd;
                __hip_atomic_fetch_add((LAS unsigned*)(lds + MISC_OFF) + 64 + ea, 1u, __ATOMIC_RELAXED, __HIP_MEMORY_SCOPE_WORKGROUP); __hip_atomic_fetch_add((LAS unsigned*)(lds + MISC_OFF) + 64 + eb, 1u, __ATOMIC_RELAXED, __HIP_MEMORY_SCOPE_WORKGROUP);
            }
            __syncthreads();
            if (tid < 32) P_CNT[vcu * 32 + tid] = (int)MISC[64 + tid];
        }
        SEAM(P + 6);
        if (IN(P + 7)) for (int rep_ = 0; rep_ < ((l == 0 || 7 != 5) ? NREP(7) : 1); ++rep_) {
            unsigned ldsb_ = (unsigned)(uintptr_t)lds0; asm volatile("" : "+s"(ldsb_)); LAS unsigned char* lds = (LAS unsigned char*)(uintptr_t)ldsb_; volatile LAS unsigned* MISC = (volatile LAS unsigned*)(lds + MISC_OFF); volatile LAS unsigned long long* ARGP = (volatile LAS unsigned long long*)(lds + MISC_OFF + 768); (void)MISC; int wave = wave0, G = G0, bx = bx0; asm volatile("" : "+s"(G), "+s"(bx), "+s"(wave)); const int lane = (int)__builtin_amdgcn_mbcnt_hi(~0u, __builtin_amdgcn_mbcnt_lo(~0u, 0u)); const int tid = wave * 64 + lane; const int vcu = (bx % 8) * (G / 8) + bx / 8; const int gw = vcu * 8 + wave, NGW = G * 8; (void)lane; (void)gw; (void)NGW; (void)vcu;
            GAS unsigned char* ws = (GAS unsigned char*)LDP(22); GAS float* out = (GAS float*)LDP(21); const GAS float* x_in = (const GAS float*)ARGIN(0); (void)out; (void)x_in; (void)ws;
            LAS int* cnt_all = (LAS int*)lds;
            LAS int* pre_e = (LAS int*)(lds + 32768);
            LAS int* tot_e = pre_e + 32;
            LAS int* pst = pre_e + 64;
            LAS int* eL = pre_e + 128;
            for (int i = tid; i < 256 * 32; i += 512) cnt_all[i] = P_CNT[i];
            if (tid < 256) eL[tid] = P_E01[vcu * 256 + tid];
            __syncthreads();
            { LAS int* part = pre_e + 512;
              const int e = tid & 31, p = tid >> 5; int pre = 0, tot = 0;
#pragma unroll
              for (int j = 0; j < 16; ++j) { const int w = p * 16 + j; const int c = cnt_all[w * 32 + e]; pre += (w < vcu) ? c : 0; tot += c; }
              part[(p * 2) * 32 + e] = pre; part[(p * 2 + 1) * 32 + e] = tot; }
            __syncthreads();
            if (tid < 32) { LAS int* part = pre_e + 512; int pre = 0, tot = 0;
#pragma unroll
                for (int p = 0; p < 16; ++p) { pre += part[(p * 2) * 32 + tid]; tot += part[(p * 2 + 1) * 32 + tid]; } pre_e[tid] = pre; tot_e[tid] = tot; }
            __syncthreads();
            if (tid == 0) { int acc = 0; for (int e = 0; e < 32; ++e) { pst[e] = acc; acc += (tot_e[e] + 255) / 256 * 256; } pst[32] = acc; }
            __syncthreads();
            if (vcu == 0 && tid <= 32) P_TSTART[tid] = pst[tid] / 256;
            { LAS int* hist = pre_e + 2048;
              if (tid < 128) hist[tid] = 0;
              __syncthreads();
              int e = 0, rin = 0;
              if (tid < 256) { e = eL[tid]; unsigned long long mym = 0ull;
                  for (int x = 0; x < 32; ++x) { const unsigned long long bm = __ballot(e == x); if (e == x) mym = bm; }
                  rin = __builtin_popcountll(mym & ((1ull << lane) - 1ull));
                  if (rin == 0) hist[wave * 32 + e] = __builtin_popcountll(mym); }
              __syncthreads();
              if (tid < 256) { int r = rin; for (int w = 0; w < wave; ++w) r += hist[w * 32 + e];
                  const int slot = pst[e] + pre_e[e] + r; const int tok = vcu * 128 + (tid >> 1);
                  P_SLOT[vcu * 256 + tid] = slot; P_TOKOF[slot] = tok; P_GATEOF[slot] = P_G01[vcu * 256 + tid]; P_RSTDOF[slot] = P_RSTD[tok]; } }
            if (vcu < 32) { const int e = vcu; for (int s = pst[e] + tot_e[e] + tid; s < pst[e + 1]; s += 512) { P_TOKOF[s] = 0; P_GATEOF[s] = 0.f; P_RSTDOF[s] = 0.f; } }
            __syncthreads();
        }
        SEAM(P + 7);
        if (IN(P + 8)) for (int rep_ = 0; rep_ < ((l == 0 || 8 != 5) ? NREP(8) : 1); ++rep_) {
            unsigned ldsb_ = (unsigned)(uintptr_t)lds0; asm volatile("" : "+s"(ldsb_)); LAS unsigned char* lds = (LAS unsigned char*)(uintptr_t)ldsb_; volatile LAS unsigned* MISC = (volatile LAS unsigned*)(lds + MISC_OFF); volatile LAS unsigned long long* ARGP = (volatile LAS unsigned long long*)(lds + MISC_OFF + 768); (void)MISC; int wave = wave0, G = G0, bx = bx0; asm volatile("" : "+s"(G), "+s"(bx), "+s"(wave)); const int lane = (int)__builtin_amdgcn_mbcnt_hi(~0u, __builtin_amdgcn_mbcnt_lo(~0u, 0u)); const int tid = wave * 64 + lane; const int vcu = (bx % 8) * (G / 8) + bx / 8; const int gw = vcu * 8 + wave, NGW = G * 8; (void)lane; (void)gw; (void)NGW; (void)vcu;
            GAS unsigned char* ws = (GAS unsigned char*)LDP(22); GAS float* out = (GAS float*)LDP(21); const GAS float* x_in = (const GAS float*)ARGIN(0); (void)out; (void)x_in; (void)ws;
            volatile LAS int* TS = (volatile LAS int*)(MISC + 128);
            if (tid <= 32) TS[tid] = P_TSTART[tid];
            __syncthreads();
            MoeOrder S{G, vcu, TS, (const GAS char*)P_XN, (const GAS char*)P_WGU, 0, (size_t)1024 * 1024, (size_t)256 * 1024};
            EpiGU E{(GAS unsigned char*)P_HH, P_RSTDOF};
            pg8::gemm_phase<EpiGU, MoeOrder, true, true, true>(tid, lds, DM, DM, DM, S, E, P_TOKOF);
        }
        SEAM(P + 8);
        if (IN(P + 9)) for (int rep_ = 0; rep_ < ((l == 0 || 9 != 5) ? NREP(9) : 1); ++rep_) {
            unsigned ldsb_ = (unsigned)(uintptr_t)lds0; asm volatile("" : "+s"(ldsb_)); LAS unsigned char* lds = (LAS unsigned char*)(uintptr_t)ldsb_; volatile LAS unsigned* MISC = (volatile LAS unsigned*)(lds + MISC_OFF); volatile LAS unsigned long long* ARGP = (volatile LAS unsigned long long*)(lds + MISC_OFF + 768); (void)MISC; int wave = wave0, G = G0, bx = bx0; asm volatile("" : "+s"(G), "+s"(bx), "+s"(wave)); const int lane = (int)__builtin_amdgcn_mbcnt_hi(~0u, __builtin_amdgcn_mbcnt_lo(~0u, 0u)); const int tid = wave * 64 + lane; const int vcu = (bx % 8) * (G / 8) + bx / 8; const int gw = vcu * 8 + wave, NGW = G * 8; (void)lane; (void)gw; (void)NGW; (void)vcu;
            GAS unsigned char* ws = (GAS unsigned char*)LDP(22); GAS float* out = (GAS float*)LDP(21); const GAS float* x_in = (const GAS float*)ARGIN(0); (void)out; (void)x_in; (void)ws;
            volatile LAS int* TS = (volatile LAS int*)(MISC + 128);
            if (tid <= 32) TS[tid] = P_TSTART[tid];
            __syncthreads();
            MoeOrder S{G, vcu, TS, (const GAS char*)P_HH, (const GAS char*)P_WD, (size_t)256 * 512, (size_t)1024 * 512, (size_t)256 * 512};
            EpiDown E{P_Y, P_GATEOF};
            pg8::gemm_phase<EpiDown, MoeOrder, true, false, true>(tid, lds, DEXP, DEXP, DEXP, S, E, nullptr);
        }
        SEAM(P + 9);
}

__global__ void __launch_bounds__(512, 2) fwd(Args args) {
    extern __shared__ __attribute__((aligned(16))) unsigned char lds_raw[];
    LAS unsigned char* lds0 = (LAS unsigned char*)lds_raw;
    const int tid0 = threadIdx.x; const int wave0 = __builtin_amdgcn_readfirstlane(tid0 >> 6);
    const int G0 = gridDim.x; const int bx0 = blockIdx.x;
    { volatile LAS unsigned* MISC = (volatile LAS unsigned*)(lds0 + MISC_OFF); const int tid = tid0;
    for (int u = tid; u < 256; u += 512) MISC[u] = 0u;
    __syncthreads();
    volatile LAS unsigned long long* ARGP = (volatile LAS unsigned long long*)(lds0 + MISC_OFF + 768);
    if (tid < 21) ARGP[tid] = (unsigned long long)args.in[tid];
    if (tid == 21) ARGP[21] = (unsigned long long)args.out;
    if (tid == 22) ARGP[22] = (unsigned long long)args.ws;
    __syncthreads(); }
#if MK_ONE_LAUNCH
    XcdBarrier bar = xcd_barrier_post((unsigned*)(args.ws + WS_CTL) + CW_BAR, (volatile LAS unsigned*)(lds0 + MISC_OFF) + 8);
#else
    XcdBarrier bar; bar.bar = nullptr; bar.x = 0; bar.st = nullptr;
#endif
    const int lo = args.ph_lo, hi_ = args.ph_hi;
    if (IN(0)) {
        const GAS int* positions = (const GAS int*)args.in[1]; GAS float* COSp = (GAS float*)(args.ws + WS_COS); GAS float* SINp = (GAS float*)(args.ws + WS_SIN);
        for (int i = bx0 * 512 + tid0; i < NTOK * 16; i += G0 * 512) { const int tk = i >> 4, fi = i & 15;
            const double inv = exp2(-(double)fi * (13.287712379549449 / 16.0)); const double ang = (double)positions[tk] * inv;
            COSp[i] = (float)cos(ang); SINp[i] = (float)sin(ang); }
    }
    layer_body<0>(lo, hi_, lds0, wave0, G0, bx0, bar);
    layer_body<1>(lo, hi_, lds0, wave0, G0, bx0, bar);
    layer_body<2>(lo, hi_, lds0, wave0, G0, bx0, bar);
}

extern "C" void kernel_launch(void* const* d_in, const int* in_sizes, int n_in, void* d_out, int out_size, void* d_ws, size_t ws_size, hipStream_t stream) {
    static int grid = 0;
    if (grid == 0) {
        if (n_in != 21 || out_size != NTOK * DM || ws_size < WS_END) { fprintf(stderr, "kernel_launch: unexpected shapes (n_in %d out %d ws %zu)\n", n_in, out_size, ws_size); grid = -1; return; }
        int dev = 0, cus = 0;
        if (hipGetDevice(&dev) != hipSuccess || hipDeviceGetAttribute(&cus, hipDeviceAttributeMultiprocessorCount, dev) != hipSuccess) { grid = -1; return; }
        if (hipFuncSetAttribute((const void*)fwd, hipFuncAttributeMaxDynamicSharedMemorySize, LDS_BYTES) != hipSuccess) { fprintf(stderr, "kernel_launch: hipFuncSetAttribute failed\n"); grid = -1; return; }
        int per_cu = 0;
        if (hipOccupancyMaxActiveBlocksPerMultiprocessor(&per_cu, (const void*)fwd, 512, LDS_BYTES) != hipSuccess || per_cu < 1) fprintf(stderr, "kernel_launch: occupancy query says %d\n", per_cu);
        (void)hipGetLastError();
        grid = cus;
        if (grid != 256) { fprintf(stderr, "kernel_launch: built for 256 CUs, got %d\n", grid); grid = -1; return; }
    }
    if (grid < 0) return;
    if (hipMemsetAsync((char*)d_ws + WS_CTL, 0, CTL_ZERO_BYTES, stream) != hipSuccess) return;
    Args a{};
    for (int i = 0; i < 21; ++i) a.in[i] = d_in[i];
    a.out = (float*)d_out; a.ws = (unsigned char*)d_ws;
#if MK_ONE_LAUNCH
    a.ph_lo = 0; a.ph_hi = 21;
    hipLaunchKernelGGL(fwd, dim3(grid), dim3(512), LDS_BYTES, stream, a);
#else
    for (int p = 0; p <= 20; ++p) { a.ph_lo = p; a.ph_hi = p + 1; hipLaunchKernelGGL(fwd, dim3(grid), dim3(512), LDS_BYTES, stream, a); }
#endif
}
```

```cpp
#include <hip/hip_runtime.h>
#include <cstdio>
#include <cstdint>

#ifndef PROBE_PHASE
#define PROBE_PHASE -1
#endif
#define NREP(k) ((PROBE_PHASE) == (k) ? 2 : 1)
#ifndef MK_ONE_LAUNCH
#define MK_ONE_LAUNCH 1
#endif

#define LAS __attribute__((address_space(3)))
#define GAS __attribute__((address_space(1)))
typedef unsigned short bf16;
typedef short bf16x8 __attribute__((ext_vector_type(8)));
typedef short s16x4 __attribute__((ext_vector_type(4)));
typedef float f32x4 __attribute__((ext_vector_type(4)));
typedef float f32x2 __attribute__((ext_vector_type(2)));
typedef float f32x16 __attribute__((ext_vector_type(16)));
typedef unsigned u32x4 __attribute__((ext_vector_type(4)));
typedef unsigned u32x2 __attribute__((ext_vector_type(2)));

constexpr int NB = 16, SEQ = 2048, DM = 1024, NTOK = NB * SEQ, NLAYER = 2;
constexpr int INW = 1960, INP = 2048;
constexpr int NEXP = 32, DEXP = 512;
constexpr int MAXSLOT = 73728;
constexpr float EPS = 1e-6f;
constexpr float WSCALE = 64.f, WSCALE_INV = 1.f / 64.f;
constexpr float LOG2E = 1.4426950408889634f;
constexpr float C2F = 0.125f * LOG2E;
constexpr float C2M = 0.10206207261596575f * LOG2E;

constexpr size_t MiB = 1u << 20, KiB = 1u << 10;
constexpr size_t WS_CTL = 0, CTL_ZERO_BYTES = 64 * KiB;
constexpr size_t WS_COS = 1 * MiB, WS_SIN = 3 * MiB;
constexpr size_t WS_SSQ = 5 * MiB;
constexpr size_t WS_FLOG = 6 * MiB;
constexpr size_t WS_E01 = 8 * MiB;
constexpr size_t WS_G01 = 8 * MiB + 256 * KiB;
constexpr size_t WS_SLOT = 8 * MiB + 512 * KiB;
constexpr size_t WS_TOKOF = 8 * MiB + 768 * KiB;
constexpr size_t WS_GATEOF = 9 * MiB + 256 * KiB;
constexpr size_t WS_CNT = 9 * MiB + 768 * KiB;
constexpr size_t WS_TSTART = 9 * MiB + 800 * KiB;
constexpr size_t WS_RSTD = 9 * MiB + 832 * KiB;
constexpr size_t WS_RSTDOF = 7 * MiB;
constexpr size_t WS_KPE = 10 * MiB;
constexpr size_t WS_KAUG = 10 * MiB + 2 * MiB;
constexpr size_t WS_WIN = 16 * MiB;
constexpr size_t WS_WUQ = 20 * MiB;
constexpr size_t WS_WUKV = 20 * MiB + 512 * KiB;
constexpr size_t WS_WOUT = 21 * MiB;
constexpr size_t WS_WGU = 24 * MiB;
constexpr size_t WS_WD = 88 * MiB;
constexpr size_t WS_XN = 120 * MiB;
constexpr size_t WS_FQKV = 184 * MiB;
constexpr size_t WS_LAT = 280 * MiB;
constexpr size_t WS_QM = 312 * MiB;
constexpr size_t WS_KVM = 360 * MiB;
constexpr size_t WS_Y = 280 * MiB;
constexpr size_t WS_BIASF = 424 * MiB;
constexpr size_t WS_NRM = 425 * MiB;
constexpr size_t WS_WR = 426 * MiB;
constexpr size_t WS_XR = 427 * MiB;
constexpr size_t WS_END = 491 * MiB;
static_assert(WS_Y + (size_t)MAXSLOT * 1024 * 2 <= WS_END, "Y fits");
static_assert(WS_FQKV + (size_t)MAXSLOT * 512 * 2 <= WS_LAT, "HH fits");

constexpr int CW_BAR = 1024;

constexpr int RING_BYTES = 147456;
constexpr int MISC_OFF = RING_BYTES;
constexpr int LDS_BYTES = RING_BYTES + 1024;

typedef __bf16 bf16x2_t __attribute__((ext_vector_type(2)));
__device__ __forceinline__ unsigned cvt_pk_bf16(float lo, float hi) { const f32x2 v = {lo, hi}; const bf16x2_t b = __builtin_convertvector(v, bf16x2_t); return __builtin_bit_cast(unsigned, b); }
__device__ __forceinline__ float bf2f(unsigned short b) { return __uint_as_float((unsigned)b << 16); }
__device__ __forceinline__ float wave_sum(float v) {
#pragma unroll
    for (int o = 1; o < 64; o <<= 1) v += __shfl_xor(v, o);
    return v;
}
__device__ __forceinline__ unsigned pk4_fp8(float a, float b, float c, float d) { int w = 0; w = __builtin_amdgcn_cvt_pk_fp8_f32(a, b, w, false); w = __builtin_amdgcn_cvt_pk_fp8_f32(c, d, w, true); return (unsigned)w; }
#define LDS_WAIT() asm volatile("s_waitcnt lgkmcnt(0)" ::: "memory")

#define XB_TMO      128
#define XB_XCNT(j)  (256  + 64 * (j))
#define XB_XSUB(j)  (1280 + 64 * (j))
#define XB_XGEN(j)  (2304 + 64 * (j))
#define XB_TOP      3328
#define XB_TOPGEN   3392
#define XCD_BAR_WORDS 3456
#define XB_SPIN_CAP (1u << 18)
__device__ __forceinline__ unsigned xb_ld(unsigned* p)              { return __hip_atomic_load(p, __ATOMIC_RELAXED, __HIP_MEMORY_SCOPE_AGENT); }
__device__ __forceinline__ unsigned xb_add(unsigned* p, unsigned v) { return __hip_atomic_fetch_add(p, v, __ATOMIC_RELAXED, __HIP_MEMORY_SCOPE_AGENT); }
__device__ __forceinline__ unsigned xb_xcc_id() { return (unsigned)__builtin_amdgcn_s_getreg((3 << 11) | 20) & 0xFu; }
#define XB_SPIN(cond, bar) do { unsigned _sp = 0; while (cond) { __builtin_amdgcn_s_sleep(1); \
    if ((++_sp & 255u) == 0u) { if (xb_ld(&(bar)[XB_TMO])) break; if (_sp > XB_SPIN_CAP) { atomicAdd(&(bar)[XB_TMO], 1u); break; } } } } while (0)
struct XcdBarrier { unsigned* bar; unsigned x; volatile LAS unsigned* st; };
__device__ __forceinline__ XcdBarrier xcd_barrier_post(unsigned* bar, volatile LAS unsigned* st) {
    XcdBarrier b; b.bar = bar; b.x = xb_xcc_id(); b.st = st;
    if (threadIdx.x == 0) (void)xb_add(&bar[XB_XCNT(b.x)], 1u);
    return b;
}
__device__ __forceinline__ void xcd_barrier_complete(unsigned* bar, unsigned x, unsigned& nloc, unsigned& nx) {
    const unsigned G = gridDim.x * gridDim.y * gridDim.z;
    unsigned sum, cnt, mine, sp = 0u;
    for (;;) {
        sum = 0u; cnt = 0u; mine = 0u;
#pragma unroll
        for (unsigned j = 0; j < 16; ++j) { const unsigned c = xb_ld(&bar[XB_XCNT(j)]); sum += c; cnt += (c > 0u) ? 1u : 0u; mine = (j == x) ? c : mine; }
        if (sum == G) break;
        __builtin_amdgcn_s_sleep(1);
        if ((++sp & 255u) == 0u) { if (xb_ld(&bar[XB_TMO])) break; if (sp > XB_SPIN_CAP) { atomicAdd(&bar[XB_TMO], 1u); break; } }
    }
    nloc = mine > 0u ? mine : 1u; nx = cnt > 0u ? cnt : 1u;
}
__device__ __forceinline__ void xcd_barrier(const XcdBarrier& b) {
    asm volatile("s_waitcnt vmcnt(0)" ::: "memory");
    __syncthreads();
    if (threadIdx.x == 0) {
        unsigned* bar = b.bar;
        __builtin_amdgcn_s_waitcnt(0);
        unsigned nloc = b.st[0], nx = b.st[1];
        if (nloc == 0u) { xcd_barrier_complete(bar, b.x, nloc, nx); b.st[0] = nloc; b.st[1] = nx; }
        const unsigned old = xb_add(&bar[XB_XSUB(b.x)], 1u);
        const unsigned gen = old / nloc;
        if (old + 1u == (gen + 1u) * nloc) {
            __builtin_amdgcn_fence(__ATOMIC_RELEASE, "agent");
            asm volatile("s_waitcnt vmcnt(0)" ::: "memory");
            const unsigned og = xb_add(&bar[XB_TOP], 1u);
            const unsigned tg = og / nx;
            if (og + 1u == (tg + 1u) * nx) xb_add(&bar[XB_TOPGEN], 1u);
            else XB_SPIN(xb_ld(&bar[XB_TOPGEN]) == tg, bar);
            __builtin_amdgcn_fence(__ATOMIC_ACQUIRE, "agent");
            xb_add(&bar[XB_XGEN(b.x)], 1u);
            asm volatile("s_waitcnt vmcnt(0)" ::: "memory");
        } else {
            XB_SPIN(xb_ld(&bar[XB_XGEN(b.x)]) == gen, bar);
            __builtin_amdgcn_fence(__ATOMIC_ACQUIRE, "agent");
            asm volatile("s_waitcnt vmcnt(0)" ::: "memory");
        }
    }
    __syncthreads();
}

namespace pg8 {
constexpr int BM = 256, BK = 64, HALF = 128, HTB = HALF * BK * 2, STAGE_BYTES = 8 * HTB;
typedef int v4i32_t __attribute__((ext_vector_type(4)));
typedef int v8i32_t __attribute__((ext_vector_type(8)));
__host__ __device__ __forceinline__ int lds_byte(int r, int c) { const int st = (r >> 4) * 2 + (c >> 5), rr = r & 15, cc = c & 31, ob = rr * 64 + cc * 2; return st * 1024 + (ob ^ (((ob >> 9) & 1) << 5)); }
__host__ __device__ __forceinline__ void stage_rc(int b, int& R, int& C) { const int st = b / 1024, sb = b % 1024, swz = sb ^ (((sb >> 9) & 1) << 5); R = (st >> 1) * 16 + swz / 64; C = (st & 1) * 32 + (swz % 64) / 2; }
__host__ __device__ __forceinline__ int perm32(int rho) { const int n = rho >> 4, i = rho & 15; return 8 * (i >> 2) + 4 * n + (i & 3); }

struct Unit { const GAS char* a; const GAS char* b; int pm, pn, e; };

template <int N> __device__ __forceinline__ void wait_vm() { asm volatile("s_waitcnt vmcnt(%0)" :: "n"(N) : "memory"); }
template <class Epi, class Sched, bool ALIGN_EPI, bool GATHER, bool FP8 = false>
__device__ __forceinline__ void gemm_phase(const int tid, LAS unsigned char* lds, const int Kb, const int ldaB, const int ldbB, const Sched& S, const Epi& E, const GAS int* __restrict__ tokof) {
    const int wid = __builtin_amdgcn_readfirstlane(tid >> 6), lane = tid & 63, wr = wid >> 2, wc = wid & 3, fr = lane & 15, fq = lane >> 4;
    const int nt = Kb / 128;
    unsigned voffA[2], voffB[2]; int RA[2], CA2[2];
#pragma unroll
    for (int i = 0; i < 2; ++i) { int R, C; stage_rc(tid * 16 + i * 8192, R, C); const int Rb = Epi::PERM ? ((R & ~31) + perm32(R & 31)) : R;
        voffA[i] = (unsigned)(R * ldaB + C * 2); voffB[i] = (unsigned)(Rb * ldbB + C * 2); RA[i] = R; CA2[i] = C * 2; }
    const size_t kstep = (size_t)(BK * 2);
    const size_t hstepA = GATHER ? 0 : (size_t)HALF * ldaB;
    const size_t hstepB = (size_t)HALF * ldbB;
    const unsigned ldsw = (unsigned)wid * 1024u;
    const int aoff = lds_byte(wr * 64 + fr, fq * 8), boff = lds_byte(wc * 32 + fr, fq * 8);
    unsigned gcur[2][2], gnxt[2][2];
    const int scl8 = 0x7F7F7F7F;
#define PG8_SA(b, h) (((b) * 2 + (h)) * HTB)
#define PG8_SB(b, h) ((4 + (b) * 2 + (h)) * HTB)
#define PG8_STAGE(bufoff, gbase, voff) do { const unsigned long long gb_ = (unsigned long long)(gbase); const unsigned lbase_ = (unsigned)__builtin_amdgcn_readfirstlane((int)((unsigned)(uintptr_t)lds + (unsigned)(bufoff) + ldsw)); \
        _Pragma("unroll") for (int _i = 0; _i < 2; ++_i) { unsigned keep_; \
            asm volatile("s_mov_b32 %0, m0\n\ts_mov_b32 m0, %3\n\ts_nop 0\n\tglobal_load_lds_dwordx4 %1, %2\n\ts_mov_b32 m0, %0" : "=&s"(keep_) : "v"((voff)[_i]), "s"(gb_), "s"(lbase_ + (unsigned)(_i * 8192)) : "memory"); } } while (0)
#define PG8_STAGE_A(bufoff, base, h, nx) do { if constexpr (GATHER) { unsigned _v[2]; _v[0] = (nx) ? gnxt[h][0] : gcur[h][0]; _v[1] = (nx) ? gnxt[h][1] : gcur[h][1]; PG8_STAGE(bufoff, base, _v); } \
        else { PG8_STAGE(bufoff, (base) + (h) * hstepA, voffA); } } while (0)
#define PG8_LDA(dst, b, h) do { _Pragma("unroll") for (int m = 0; m < 4; ++m) _Pragma("unroll") for (int k = 0; k < 2; ++k) dst[m][k] = *(const LAS bf16x8*)(lds + PG8_SA(b, h) + aoff + m * 2048 + k * 1024); } while (0)
#define PG8_LDB(dst, b, h) do { _Pragma("unroll") for (int n = 0; n < 2; ++n) _Pragma("unroll") for (int k = 0; k < 2; ++k) dst[n][k] = *(const LAS bf16x8*)(lds + PG8_SB(b, h) + boff + n * 2048 + k * 1024); } while (0)
#define PG8_MMA(ai, bj, At, Bt) do { __builtin_amdgcn_s_setprio(1); if constexpr (FP8) { _Pragma("unroll") for (int m = 0; m < 4; ++m) _Pragma("unroll") for (int n = 0; n < 2; ++n) { \
        const v8i32_t b8_ = __builtin_shufflevector(__builtin_bit_cast(v4i32_t, Bt[n][0]), __builtin_bit_cast(v4i32_t, Bt[n][1]), 0, 1, 2, 3, 4, 5, 6, 7), a8_ = __builtin_shufflevector(__builtin_bit_cast(v4i32_t, At[m][0]), __builtin_bit_cast(v4i32_t, At[m][1]), 0, 1, 2, 3, 4, 5, 6, 7); \
        asm volatile("s_nop 1\n\tv_mfma_scale_f32_16x16x128_f8f6f4 %0, %1, %2, %0, %3, %3 op_sel_hi:[0,0,0]" : "+v"(acc[ai][bj][m][n]) : "v"(b8_), "v"(a8_), "v"(scl8)); } } \
      else { _Pragma("unroll") for (int m = 0; m < 4; ++m) _Pragma("unroll") for (int n = 0; n < 2; ++n) _Pragma("unroll") for (int k = 0; k < 2; ++k) \
        acc[ai][bj][m][n] = __builtin_amdgcn_mfma_f32_16x16x32_bf16(Bt[n][k], At[m][k], acc[ai][bj][m][n], 0, 0, 0); } __builtin_amdgcn_s_setprio(0); } while (0)
#define PG8_WAIT_V(n) asm volatile("s_waitcnt vmcnt(" #n ")" ::: "memory")
#define PG8_WAIT_L(n) asm volatile("s_waitcnt lgkmcnt(" #n ")" ::: "memory")
#define PG8_BAR __builtin_amdgcn_s_barrier()
#define PG8_SCHED __builtin_amdgcn_sched_barrier(0)
#define PG8_GLOAD(dst, u) do { if constexpr (GATHER) { _Pragma("unroll") for (int _h = 0; _h < 2; ++_h) _Pragma("unroll") for (int _i = 0; _i < 2; ++_i) \
        dst[_h][_i] = (unsigned)tokof[(u).pm * BM + _h * HALF + RA[_i]] * (unsigned)ldaB + (unsigned)CA2[_i]; } } while (0)
    Unit cur, nxt; int ui = 0;
    if (!S.next(0, cur)) return;
    PG8_GLOAD(gcur, cur);
    f32x4 acc[2][2][4][2];
#pragma unroll
    for (int a = 0; a < 2; ++a)
#pragma unroll
        for (int b = 0; b < 2; ++b)
#pragma unroll
            for (int m = 0; m < 4; ++m)
#pragma unroll
                for (int n = 0; n < 2; ++n) acc[a][b][m][n] = (f32x4){0.f, 0.f, 0.f, 0.f};
    bf16x8 At[4][2], B0[2][2], B1[2][2];
    const GAS char* cA = cur.a; const GAS char* cB = cur.b;
    PG8_STAGE(PG8_SB(0, 0), cB, voffB); PG8_STAGE(PG8_SB(0, 1), cB + hstepB, voffB); PG8_STAGE_A(PG8_SA(0, 0), cA, 0, false); PG8_STAGE_A(PG8_SA(0, 1), cA, 1, false);
    if (wr == 1) PG8_BAR;
    PG8_WAIT_V(2); PG8_BAR;
    PG8_STAGE(PG8_SB(1, 0), cB + kstep, voffB); PG8_STAGE_A(PG8_SA(1, 0), cA + kstep, 0, false); PG8_STAGE(PG8_SB(1, 1), cB + hstepB + kstep, voffB);
    PG8_WAIT_V(6); PG8_BAR;
    bool fresh = false;
    for (;;) {
        const bool has_next = S.next(ui + 1, nxt);
        if constexpr (GATHER) { if (has_next) { PG8_GLOAD(gnxt, nxt); } else { _Pragma("unroll") for (int _h = 0; _h < 2; ++_h) _Pragma("unroll") for (int _i = 0; _i < 2; ++_i) gnxt[_h][_i] = gcur[_h][_i]; } }
        const GAS char* nA = has_next ? nxt.a : cA; const GAS char* nB = has_next ? nxt.b : cB;
#pragma nounroll
        for (int t = 0; t < nt; t += 2) {
            const bool last = (t == nt - 2);
            const GAS char* a1 = cA + (size_t)(t + 1) * kstep;
            const GAS char* a2 = last ? nA : cA + (size_t)(t + 2) * kstep; const GAS char* b2 = last ? nB : cB + (size_t)(t + 2) * kstep;
            const GAS char* a3 = a2 + kstep; const GAS char* b3 = b2 + kstep;
            const bool fe = fresh; fresh = false;
            PG8_LDB(B0, 0, 0); PG8_LDB(B1, 0, 1); PG8_SCHED; PG8_LDA(At, 0, 0); PG8_STAGE_A(PG8_SA(1, 1), a1, 1, false);
            if (fe) wait_vm<8 + Epi::NST>(); else PG8_WAIT_V(8); PG8_WAIT_L(0); PG8_BAR; PG8_MMA(0, 0, At, B0); PG8_MMA(0, 1, At, B1); PG8_BAR; PG8_SCHED;
            PG8_LDA(At, 0, 1); PG8_STAGE(PG8_SB(0, 0), b2, voffB); PG8_STAGE(PG8_SB(0, 1), b2 + hstepB, voffB); PG8_STAGE_A(PG8_SA(0, 0), a2, 0, last);
            if (fe) wait_vm<8 + Epi::NST>(); else PG8_WAIT_V(8); PG8_WAIT_L(0); PG8_BAR; PG8_MMA(1, 0, At, B0); PG8_MMA(1, 1, At, B1); PG8_BAR; PG8_SCHED;
            PG8_LDB(B0, 1, 0); PG8_LDB(B1, 1, 1); PG8_SCHED; PG8_LDA(At, 1, 0); PG8_STAGE_A(PG8_SA(0, 1), a2, 1, last);
            PG8_WAIT_V(8); PG8_WAIT_L(0); PG8_BAR; PG8_MMA(0, 0, At, B0); PG8_MMA(0, 1, At, B1); PG8_BAR; PG8_SCHED;
            PG8_LDA(At, 1, 1); PG8_STAGE(PG8_SB(1, 0), b3, voffB); PG8_STAGE(PG8_SB(1, 1), b3 + hstepB, voffB); PG8_STAGE_A(PG8_SA(1, 0), a3, 0, last);
            PG8_WAIT_V(8); PG8_WAIT_L(0); PG8_BAR; PG8_MMA(1, 0, At, B0); PG8_MMA(1, 1, At, B1); PG8_BAR; PG8_SCHED;
        }
        if constexpr (ALIGN_EPI) { if (wr == 0) PG8_BAR; }
        if constexpr (FP8) { asm volatile("s_nop 15\n\ts_nop 15" ::: "memory"); }
        E(acc, cur, wr, wc, fr, fq);
        if (!has_next) break;
#pragma unroll
        for (int a = 0; a < 2; ++a)
#pragma unroll
            for (int b = 0; b < 2; ++b)
#pragma unroll
                for (int m = 0; m < 4; ++m)
#pragma unroll
                    for (int n = 0; n < 2; ++n) acc[a][b][m][n] = (f32x4){0.f, 0.f, 0.f, 0.f};
        cur = nxt; cA = nA; cB = nB; ++ui; fresh = true;
        if constexpr (GATHER) { _Pragma("unroll") for (int _h = 0; _h < 2; ++_h) _Pragma("unroll") for (int _i = 0; _i < 2; ++_i) gcur[_h][_i] = gnxt[_h][_i]; }
        if constexpr (ALIGN_EPI) { if (wr == 1) PG8_BAR; }
    }
    PG8_WAIT_V(0);
    if constexpr (!ALIGN_EPI) { if (wr == 0) PG8_BAR; }
    PG8_BAR;
#undef PG8_SA
#undef PG8_SB
#undef PG8_STAGE
#undef PG8_STAGE_A
#undef PG8_LDA
#undef PG8_LDB
#undef PG8_MMA
#undef PG8_WAIT_V
#undef PG8_WAIT_L
#undef PG8_BAR
#undef PG8_SCHED
#undef PG8_GLOAD
}
}
using pg8::Unit;

struct DenseOrder {
    int nM, nN, nwg, G, c; const GAS char* A; const GAS char* B; size_t aT, bT;
    __device__ __forceinline__ bool next(int i, Unit& u) const {
        const long L = (long)i * G + c; if (L >= nwg) return false;
        int wgid = (int)L; { const int q = nwg / 8, r = nwg % 8, xcd = wgid % 8, off = wgid / 8; wgid = (xcd < r ? xcd * (q + 1) : r * (q + 1) + (xcd - r) * q) + off; }
        const int nig = 8 * nN, gid = wgid / nig, fm = gid * 8, gsz = (nM - fm) < 8 ? (nM - fm) : 8;
        u.pm = fm + ((wgid % nig) % gsz); u.pn = (wgid % nig) / gsz; u.e = 0;
        u.a = A + (size_t)u.pm * aT; u.b = B + (size_t)u.pn * bT; return true;
    }
};
struct UpOrder {
    int G, c; const GAS char* LATp; const GAS char* Wq; const GAS char* Wkv;
    __device__ __forceinline__ bool next(int i, Unit& u) const {
        const int L = i * G + c; if (L >= 128 * 7) return false;
        u.pm = L / 7; const int j = L % 7; const bool kv = j >= 3; u.pn = kv ? j - 3 : j; u.e = kv ? 1 : 0;
        u.a = LATp + (size_t)u.pm * 256 * 512 * 2 + (kv ? 512 : 0);
        u.b = (kv ? Wkv : Wq) + (size_t)u.pn * 256 * 256 * 2; return true;
    }
};
struct MoeOrder {
    int G, c; const volatile LAS int* TS; const GAS char* A; const GAS char* W; size_t aT  , wE  , wT  ;
    __device__ __forceinline__ bool next(int i, Unit& u) const {
        const int L = i * G + c; const int ntile = __builtin_amdgcn_readfirstlane(TS[32]); if (L >= ntile * 4) return false;
        const int rt = L >> 2, ct = L & 3; int e = 0;
        for (int j = 1; j < 32; ++j) e += (TS[j] <= rt) ? 1 : 0;
        e = __builtin_amdgcn_readfirstlane(e);
        u.pm = rt; u.pn = ct; u.e = e; u.a = A + (size_t)rt * aT; u.b = W + (size_t)e * wE + (size_t)ct * wT; return true;
    }
};

__device__ __forceinline__ u32x4 pack8(f32x4 v0, f32x4 v1) { u32x4 w; w.x = cvt_pk_bf16(v0[0], v0[1]); w.y = cvt_pk_bf16(v0[2], v0[3]); w.z = cvt_pk_bf16(v1[0], v1[1]); w.w = cvt_pk_bf16(v1[2], v1[3]); return w; }

struct EpiWin {
    static constexpr int NST = 16;
    static constexpr bool PERM = true;
    GAS bf16* LAT_; GAS bf16* FQKV_; GAS bf16* KPE_; GAS float* FLOG_; GAS float* SSQ_; const GAS float* COS_; const GAS float* SIN_;
    __device__ __forceinline__ void operator()(const f32x4 (&acc)[2][2][4][2], const Unit& u, int wr, int wc, int fr, int fq) const {
        GAS bf16* LAT = LAT_; GAS bf16* FQKV = FQKV_; GAS bf16* KPE = KPE_; GAS float* FLOG = FLOG_; GAS float* SSQ = SSQ_; const GAS float* COS = COS_; const GAS float* SIN = SIN_;
        asm volatile("" : "+s"(LAT), "+s"(FQKV), "+s"(KPE), "+s"(FLOG), "+s"(SSQ), "+s"(COS), "+s"(SIN));
        const int row0 = u.pm * 256 + wr * 64 + fr; const int pn = u.pn;
        if (pn >= 2) {
            const int ti = pn >> 1; GAS bf16* dst = FQKV + (size_t)(ti - 1) * NTOK * 512; const int colb = (pn & 1) * 256 + wc * 32 + 8 * fq; const float sc = (ti == 1) ? C2F : 1.f;
#pragma unroll
            for (int ai = 0; ai < 2; ++ai)
#pragma unroll
                for (int m = 0; m < 4; ++m) { GAS bf16* rowp = dst + (size_t)(row0 + ai * 128 + m * 16) * 512 + colb;
#pragma unroll
                    for (int bj = 0; bj < 2; ++bj) *(GAS u32x4*)(rowp + bj * 128) = pack8(acc[ai][bj][m][0] * sc, acc[ai][bj][m][1] * sc); }
        } else {
#pragma unroll
            for (int ai = 0; ai < 2; ++ai)
#pragma unroll
                for (int m = 0; m < 4; ++m) { const int row = row0 + ai * 128 + m * 16; GAS bf16* rowp = LAT + (size_t)row * 512 + pn * 256 + wc * 32 + 8 * fq;
#pragma unroll
                    for (int bj = 0; bj < 2; ++bj) *(GAS u32x4*)(rowp + bj * 128) = pack8(acc[ai][bj][m][0], acc[ai][bj][m][1]);
                    float s = 0.f;
#pragma unroll
                    for (int n = 0; n < 2; ++n) { const f32x4 x = acc[ai][0][m][n]; s += (x[0] * x[0] + x[1] * x[1]) + (x[2] * x[2] + x[3] * x[3]); }
                    if (pn == 0) {
#pragma unroll
                        for (int n = 0; n < 2; ++n) { const f32x4 x = acc[ai][1][m][n]; s += (x[0] * x[0] + x[1] * x[1]) + (x[2] * x[2] + x[3] * x[3]); }
                    }
                    s += __shfl_xor(s, 16); s += __shfl_xor(s, 32);
                    if (fq == 0) SSQ[(size_t)row * 8 + pn * 4 + wc] = s;
                    }
            if (pn == 1 && wc == 0) {
#pragma unroll
                for (int ai = 0; ai < 2; ++ai)
#pragma unroll
                    for (int m = 0; m < 4; ++m) { const int row = row0 + ai * 128 + m * 16;
                        const f32x4 c = *(const GAS f32x4*)(COS + (size_t)row * 16 + 4 * fq), sn = *(const GAS f32x4*)(SIN + (size_t)row * 16 + 4 * fq);
                        const f32x4 x1 = acc[ai][1][m][0], x2 = acc[ai][1][m][1];
                        *(GAS u32x4*)(KPE + (size_t)row * 32 + 8 * fq) = pack8(x1 * c - x2 * sn, x1 * sn + x2 * c);
                        }
            }
            if (pn == 1 && wc == 1 && fq == 0) {
#pragma unroll
                for (int ai = 0; ai < 2; ++ai)
#pragma unroll
                    for (int m = 0; m < 4; ++m) { const int row = row0 + ai * 128 + m * 16; *(GAS f32x4*)(FLOG + (size_t)row * 8) = acc[ai][1][m][0]; *(GAS f32x4*)(FLOG + (size_t)row * 8 + 4) = acc[ai][1][m][1]; }
            }
        }
    }
};
struct EpiUp {
    static constexpr int NST = 16;
    static constexpr bool PERM = true;
    GAS bf16* QM_; GAS bf16* KVM_; const GAS float* SSQ_; const GAS float* COS_; const GAS float* SIN_;
    __device__ __forceinline__ void operator()(const f32x4 (&acc)[2][2][4][2], const Unit& u, int wr, int wc, int fr, int fq) const {
        GAS bf16* QM = QM_; GAS bf16* KVM = KVM_; const GAS float* SSQ = SSQ_; const GAS float* COS = COS_; const GAS float* SIN = SIN_;
        asm volatile("" : "+s"(QM), "+s"(KVM), "+s"(SSQ), "+s"(COS), "+s"(SIN));
        const int row0 = u.pm * 256 + wr * 64 + fr; const int pn = u.pn; const bool kv = u.e != 0;
#pragma unroll
        for (int ai = 0; ai < 2; ++ai)
#pragma unroll
            for (int m = 0; m < 4; ++m) { const int row = row0 + ai * 128 + m * 16;
                const f32x4 sq = *(const GAS f32x4*)(SSQ + (size_t)row * 8 + (kv ? 4 : 0));
                const float ss = (sq[0] + sq[1]) + (sq[2] + sq[3]);
                if (kv) {
                    const float rs = rsqrtf(ss * (1.f / 128.f) + EPS);
                    GAS bf16* rowp = KVM + (size_t)row * 1024 + pn * 256 + wc * 32 + 8 * fq;
#pragma unroll
                    for (int bj = 0; bj < 2; ++bj) *(GAS u32x4*)(rowp + bj * 128) = pack8(acc[ai][bj][m][0] * rs, acc[ai][bj][m][1] * rs);
                } else {
                    const float rs = rsqrtf(ss * (1.f / 256.f) + EPS) * C2M;
                    GAS bf16* rowp = QM + (size_t)row * 768 + pn * 256 + wc * 32 + 8 * fq;
                    const f32x4 c = *(const GAS f32x4*)(COS + (size_t)row * 16 + 4 * fq), sn = *(const GAS f32x4*)(SIN + (size_t)row * 16 + 4 * fq);
#pragma unroll
                    for (int bj = 0; bj < 2; ++bj) { f32x4 v0 = acc[ai][bj][m][0] * rs, v1 = acc[ai][bj][m][1] * rs;
                        const int G = 8 * pn + 4 * bj + wc;
                        if (G % 3 == 2) { const f32x4 x1 = v0, x2 = v1; v0 = x1 * c - x2 * sn; v1 = x1 * sn + x2 * c; }
                        *(GAS u32x4*)(rowp + bj * 128) = pack8(v0, v1); }
                }

            }
    }
};
template <bool RES_F32> struct EpiOut {
    static constexpr int NST = 16;
    static constexpr bool PERM = true;
    const GAS float* resf_; GAS bf16* xr_;
    __device__ __forceinline__ void operator()(const f32x4 (&acc)[2][2][4][2], const Unit& u, int wr, int wc, int fr, int fq) const {
        const GAS float* resf = resf_; GAS bf16* xr = xr_; asm volatile("" : "+s"(resf), "+s"(xr));
        const int row0 = u.pm * 256 + wr * 64 + fr, col0 = u.pn * 256 + wc * 32 + 8 * fq;
#pragma unroll
        for (int ai = 0; ai < 2; ++ai)
#pragma unroll
            for (int m = 0; m < 4; ++m) { const size_t off = (size_t)(row0 + ai * 128 + m * 16) * DM + col0;
#pragma unroll
                for (int bj = 0; bj < 2; ++bj) { f32x4 r0, r1;
                    if constexpr (RES_F32) { r0 = *(const GAS f32x4*)(resf + off + bj * 128); r1 = *(const GAS f32x4*)(resf + off + bj * 128 + 4); }
                    else { const u32x4 w = *(const GAS u32x4*)(xr + off + bj * 128);
                        r0 = (f32x4){__uint_as_float(w.x << 16), __uint_as_float(w.x & 0xffff0000u), __uint_as_float(w.y << 16), __uint_as_float(w.y & 0xffff0000u)};
                        r1 = (f32x4){__uint_as_float(w.z << 16), __uint_as_float(w.z & 0xffff0000u), __uint_as_float(w.w << 16), __uint_as_float(w.w & 0xffff0000u)}; }
                    *(GAS u32x4*)(xr + off + bj * 128) = pack8(r0 + acc[ai][bj][m][0], r1 + acc[ai][bj][m][1]); } }
    }
};
struct EpiGU {
    static constexpr int NST = 8;
    static constexpr bool PERM = true;
    GAS unsigned char* HH_; const GAS float* RS_;
    __device__ __forceinline__ void operator()(const f32x4 (&acc)[2][2][4][2], const Unit& u, int wr, int wc, int fr, int fq) const {
        GAS unsigned char* HH = HH_; const GAS float* RS = RS_; asm volatile("" : "+s"(HH), "+s"(RS));
        const int row0 = u.pm * 256 + wr * 64 + fr;
#pragma unroll
        for (int ai = 0; ai < 2; ++ai)
#pragma unroll
            for (int m = 0; m < 4; ++m) { GAS unsigned char* rowp = HH + (size_t)(row0 + ai * 128 + m * 16) * 512 + u.pn * 128 + wc * 32 + 8 * fq; const float rs = RS[row0 + ai * 128 + m * 16] * WSCALE_INV;
                f32x4 h[2];
#pragma unroll
                for (int n = 0; n < 2; ++n) { const f32x4 g = acc[ai][0][m][n] * rs, up = acc[ai][1][m][n] * rs;
#pragma unroll
                    for (int j = 0; j < 4; ++j) { const float sg = __builtin_amdgcn_rcpf(1.f + __builtin_amdgcn_exp2f(-g[j] * LOG2E)); h[n][j] = g[j] * sg * up[j]; } }
                u32x2 w; w.x = pk4_fp8(h[0][0], h[0][1], h[0][2], h[0][3]); w.y = pk4_fp8(h[1][0], h[1][1], h[1][2], h[1][3]); *(GAS u32x2*)rowp = w; }
    }
};
struct EpiDown {
    static constexpr int NST = 16;
    static constexpr bool PERM = true;
    GAS unsigned char* Y_; const GAS float* GATEOF_;
    __device__ __forceinline__ void operator()(const f32x4 (&acc)[2][2][4][2], const Unit& u, int wr, int wc, int fr, int fq) const {
        GAS unsigned char* Y = Y_; const GAS float* GATEOF = GATEOF_; asm volatile("" : "+s"(Y), "+s"(GATEOF));
        const int row0 = u.pm * 256 + wr * 64 + fr;
#pragma unroll
        for (int ai = 0; ai < 2; ++ai)
#pragma unroll
            for (int m = 0; m < 4; ++m) { const int row = row0 + ai * 128 + m * 16; const float g = GATEOF[row]; GAS unsigned char* rowp = Y + (size_t)row * 1024 + u.pn * 256 + wc * 32 + 8 * fq;
#pragma unroll
                for (int bj = 0; bj < 2; ++bj) { const f32x4 v0 = acc[ai][bj][m][0] * g, v1 = acc[ai][bj][m][1] * g; u32x2 w; w.x = pk4_fp8(v0[0], v0[1], v0[2], v0[3]); w.y = pk4_fp8(v1[0], v1[1], v1[2], v1[3]); *(GAS u32x2*)(rowp + bj * 128) = w; } }
    }
};

namespace att {
constexpr int KSLOT = 12288, VSLOT = 8192;
constexpr int L_K = 0, L_V = 2 * KSLOT, L_BIAS = L_V + 2 * VSLOT, L_WS = L_BIAS + 8192, L_OST = L_WS + 8 * 64 * 4, L_END = L_OST + 8 * 4096;
__device__ __forceinline__ int crow(int r, int hi) { return (r & 3) + 8 * (r >> 2) + 4 * hi; }
typedef short v4i16_t __attribute__((ext_vector_type(4)));
__device__ __forceinline__ s16x4 vtr(const LAS char* p) { return __builtin_bit_cast(s16x4, __builtin_amdgcn_ds_read_tr16_b64_v4i16((LAS v4i16_t*)p)); }

constexpr int NSL = 5;
constexpr int R_K = 0, R_V = NSL * KSLOT, R_WS = R_V + NSL * VSLOT, R_OST = R_WS + 8 * 64 * 4, R_END = R_OST + 8 * 4096;
static_assert(R_END <= RING_BYTES, "attention LDS");
__device__ __forceinline__ void glds16(const GAS void* gsrc, unsigned lds_dst) { unsigned keep;
    asm volatile("s_mov_b32 %0, m0\n\ts_mov_b32 m0, %2\n\ts_nop 0\n\tglobal_load_lds_dwordx4 %1, off\n\ts_mov_b32 m0, %0" : "=&s"(keep) : "v"(gsrc), "s"(lds_dst) : "memory"); }
__device__ __forceinline__ void glds16s(const GAS void* sbase, unsigned voff, unsigned lds_dst) { unsigned keep;
    asm volatile("s_mov_b32 %0, m0\n\ts_mov_b32 m0, %3\n\ts_nop 0\n\tglobal_load_lds_dwordx4 %1, %2\n\ts_mov_b32 m0, %0" : "=&s"(keep) : "v"(voff), "s"((unsigned long long)sbase), "s"(lds_dst) : "memory"); }
struct Tens2 { const GAS bf16* Q; int qp; const GAS bf16* K; int kp; const GAS bf16* KX; const GAS bf16* V; int vp; GAS bf16* O; const GAS float* BIASF; const GAS float* NRM; };
template <int MODE>
__device__ __forceinline__ int attn_unit2(const int wave_, int b, int h, int qb, const Tens2& T, LAS char* shm, const int slbase, const bool have_pro, const int qb_next) {
    constexpr int DKS = MODE ? 6 : 5, DKH = 3;
    constexpr float THR = 8.f;
    int wid = wave_; asm volatile("" : "+s"(wid));
    int lane = (int)__builtin_amdgcn_mbcnt_hi(~0u, __builtin_amdgcn_mbcnt_lo(~0u, 0u)); asm volatile("" : "+v"(lane)); const int r32 = lane & 31, hi = lane >> 5;
    const long rowbase = (long)b * SEQ; const int q0 = qb * 256, qw0 = q0 + wid * 32;
    const int NT = (q0 + 256) / 64, tlast = qw0 / 64;
    int tstart = 0;
    if (MODE == 0) {
        const GAS float* bs = T.BIASF + ((long)b * 8 + h) * SEQ; const GAS float* nr = T.NRM + (b * 8 + h) * 16;
        const float Z = nr[qb] * fmaxf(nr[8], nr[9]) * 1.001f + 0.01f; const float bq0 = bs[q0];
        const float bend = bs[(lane < NT ? lane : NT - 1) * 64 + 63];
        const bool skip = (lane < NT - 4) && (2.f * Z + bend - bq0 < -40.f);
        tstart = __builtin_popcountll(__ballot(skip));
    }
    const int NTE = NT - tstart;
    const GAS bf16* Qw = T.Q + (rowbase + qw0) * T.qp + h * (MODE ? 96 : 64);
    const GAS bf16* Kh = T.K + rowbase * T.kp + h * (MODE ? 128 : 64);
    const GAS bf16* Vh = T.V + rowbase * T.vp + h * (MODE ? 128 : 64);
    LAS float* wsf = (LAS float*)(shm + R_WS) + wid * 64;
    bf16x8 qr[DKS];
    const unsigned koff = (unsigned)(lane * T.kp + wid * 8) * 2u;
    const unsigned xoff = MODE ? (unsigned)(lane * 32 + (wid & 3) * 8) * 2u : (unsigned)(lane * 8) * 2u;
    const unsigned voff = (unsigned)((16 * (wid & 3) + (lane >> 2)) * T.vp + (wid >> 2) * 32 + (lane & 3) * 8) * 2u;
    const GAS bf16* xbase = MODE ? T.KX + rowbase * 32 : T.KX + ((long)b * 8 + h) * SEQ * 8;
    const int xstep = MODE ? 64 * 32 : 64 * 8;
    const unsigned kdst_a = (unsigned)(uintptr_t)(shm + R_K) + (unsigned)wid * 1024u, xdst_a = (unsigned)(uintptr_t)(shm + R_K) + (unsigned)(8 + (MODE ? (wid & 3) : 0)) * 1024u, vdst_a = (unsigned)(uintptr_t)(shm + R_V) + (unsigned)wid * 1024u;
#define A2_DMA(t, slot) do { \
        glds16s((const GAS void*)(Kh + (long)(t) * 64 * T.kp), koff, (unsigned)__builtin_amdgcn_readfirstlane((int)(kdst_a + (slot) * KSLOT))); \
        glds16s((const GAS void*)(xbase + (long)(t) * xstep), xoff, (unsigned)__builtin_amdgcn_readfirstlane((int)(xdst_a + (slot) * KSLOT))); \
        glds16s((const GAS void*)(Vh + (long)(t) * 64 * T.vp), voff, (unsigned)__builtin_amdgcn_readfirstlane((int)(vdst_a + (slot) * VSLOT))); } while (0)
    float mhat = 0.f, lrun = 0.f; f32x16 o[2]; o[0] = f32x16{}; o[1] = f32x16{}; f32x16 negm = f32x16{};
    const LAS char* vp0 = shm + R_V + ((lane >> 4) & 1) * 32 + (lane & 3) * 8 + (4 * hi + ((lane & 15) >> 2)) * 64;
#define A3_SLOT(k) ((slbase + (k)) % NSL)
    if (!have_pro) { A2_DMA(NT - 1, A3_SLOT(0)); A2_DMA(NT - 2, A3_SLOT(1)); A2_DMA(NT - 3, A3_SLOT(2)); }
#pragma unroll
    for (int d0 = 0; d0 < (MODE ? 6 : 4); ++d0) qr[d0] = *(const GAS bf16x8*)(Qw + (long)r32 * T.qp + d0 * 16 + hi * 8);
    if (MODE == 0) { const short one = hi ? (short)0 : (short)0x3F80; qr[DKS - 1] = (bf16x8){one, one, one, 0, 0, 0, 0, 0}; }
#pragma unroll
    for (int d0 = 0; d0 < DKS; ++d0) asm volatile("" : "+v"(qr[d0]));
#define A3_KLOADH(slot, H) do { const LAS char* kb_ = shm + R_K + (slot) * KSLOT + r32 * 16; _Pragma("unroll") for (int d0 = (H) * DKH; d0 < ((H) ? DKS : DKH); ++d0) { const int off = (MODE == 0 && d0 == 4) ? 8 * 1024 : d0 * 2048 + hi * 1024; \
        kf[2 * (d0 - (H) * DKH)] = *(const LAS bf16x8*)(kb_ + off); kf[2 * (d0 - (H) * DKH) + 1] = *(const LAS bf16x8*)(kb_ + off + 512); } } while (0)
#define A3_VLOAD(slot) do { const LAS char* vp_ = vp0 + (slot) * VSLOT; _Pragma("unroll") for (int q = 0; q < 8; ++q) { vlo[q] = vtr(vp_ + (q >> 2) * 4096 + (q & 3) * 1024); vhh[q] = vtr(vp_ + (q >> 2) * 4096 + (q & 3) * 1024 + 512); } } while (0)
#define A3_QKH(H) do { if ((H) == 0) { c0 = negm; c1 = negm; } _Pragma("unroll") for (int d0 = (H) * DKH; d0 < ((H) ? DKS : DKH); ++d0) { c0 = __builtin_amdgcn_mfma_f32_32x32x16_bf16(kf[2 * (d0 - (H) * DKH)], qr[d0], c0, 0, 0, 0); c1 = __builtin_amdgcn_mfma_f32_32x32x16_bf16(kf[2 * (d0 - (H) * DKH) + 1], qr[d0], c1, 0, 0, 0); } } while (0)
#define A3_EXP() do { float ls_ = 0.f; _Pragma("unroll") for (int r = 0; r < 16; ++r) { pp0[r] = __builtin_amdgcn_exp2f(pp0[r]); pp1[r] = __builtin_amdgcn_exp2f(pp1[r]); ls_ += pp0[r] + pp1[r]; } lrun += ls_; u32x4 w_; \
        w_.x = cvt_pk_bf16(pp0[0], pp0[1]); w_.y = cvt_pk_bf16(pp0[2], pp0[3]); w_.z = cvt_pk_bf16(pp0[4], pp0[5]); w_.w = cvt_pk_bf16(pp0[6], pp0[7]); pa[0] = __builtin_bit_cast(bf16x8, w_); \
        w_.x = cvt_pk_bf16(pp0[8], pp0[9]); w_.y = cvt_pk_bf16(pp0[10], pp0[11]); w_.z = cvt_pk_bf16(pp0[12], pp0[13]); w_.w = cvt_pk_bf16(pp0[14], pp0[15]); pa[1] = __builtin_bit_cast(bf16x8, w_); \
        w_.x = cvt_pk_bf16(pp1[0], pp1[1]); w_.y = cvt_pk_bf16(pp1[2], pp1[3]); w_.z = cvt_pk_bf16(pp1[4], pp1[5]); w_.w = cvt_pk_bf16(pp1[6], pp1[7]); pa[2] = __builtin_bit_cast(bf16x8, w_); \
        w_.x = cvt_pk_bf16(pp1[8], pp1[9]); w_.y = cvt_pk_bf16(pp1[10], pp1[11]); w_.z = cvt_pk_bf16(pp1[12], pp1[13]); w_.w = cvt_pk_bf16(pp1[14], pp1[15]); pa[3] = __builtin_bit_cast(bf16x8, w_); } while (0)
#define A3_PV() do { _Pragma("unroll") for (int d0 = 0; d0 < 2; ++d0) _Pragma("unroll") for (int k = 0; k < 4; ++k) { const s16x4 lo_ = vlo[4 * d0 + k], hh_ = vhh[4 * d0 + k]; \
        const bf16x8 vf_ = (bf16x8){lo_[0], lo_[1], lo_[2], lo_[3], hh_[0], hh_[1], hh_[2], hh_[3]}; o[d0] = __builtin_amdgcn_mfma_f32_32x32x16_bf16(pa[k], vf_, o[d0], 0, 0, 0); } } while (0)
#define A3_ROWMAX(rm) do { float a_ = fmaxf(fmaxf(c0[0], c0[1]), c1[0]), b_ = fmaxf(fmaxf(c0[2], c0[3]), c1[1]); a_ = fmaxf(fmaxf(a_, c1[2]), c1[3]); \
        _Pragma("unroll") for (int r = 4; r < 16; r += 4) { a_ = fmaxf(fmaxf(a_, c0[r]), c0[r + 1]); b_ = fmaxf(fmaxf(b_, c0[r + 2]), c0[r + 3]); a_ = fmaxf(fmaxf(a_, c1[r]), c1[r + 1]); b_ = fmaxf(fmaxf(b_, c1[r + 2]), c1[r + 3]); } \
        rm = fmaxf(a_, b_); const auto rr_ = __builtin_amdgcn_permlane32_swap(__float_as_uint(rm), __float_as_uint(rm), false, false); rm = fmaxf(__uint_as_float(rr_[0]), __uint_as_float(rr_[1])); } while (0)
    int sl = A3_SLOT(0), sl3 = A3_SLOT(3);
    f32x16 pp0 = f32x16{}, pp1 = f32x16{}; bool pend = false; int pslot = 0;
    for (int i = 0; i < NTE; ++i) {
        const int t = NT - 1 - i;
        { const int ahead = NTE - 1 - i;
          if (ahead >= 2) asm volatile("s_waitcnt vmcnt(6)" ::: "memory"); else if (ahead == 1) asm volatile("s_waitcnt vmcnt(3)" ::: "memory"); else asm volatile("s_waitcnt vmcnt(0)" ::: "memory"); }
        __builtin_amdgcn_s_barrier(); asm volatile("" ::: "memory");
        if (i + 3 < NTE) A2_DMA(t - 3, sl3);
        if (i == NTE - 1 && qb_next >= 0) { const int NTn = 4 * qb_next + 4; A2_DMA(NTn - 1, A3_SLOT(NTE)); A2_DMA(NTn - 2, A3_SLOT(NTE + 1)); A2_DMA(NTn - 3, A3_SLOT(NTE + 2)); }
        if (t <= tlast) {
            bf16x8 kf[2 * DKH]; f32x16 c0, c1; float rm;
            A3_KLOADH(sl, 0);
            if (!pend) {
                A3_QKH(0); A3_KLOADH(sl, 1); A3_QKH(1);
                if (MODE == 0) { const int qrel = qw0 + r32 - 64 * t;
#pragma unroll
                    for (int r = 0; r < 16; ++r) { const int kv = crow(r, hi); if (kv > qrel) c0[r] = -INFINITY; if (kv + 32 > qrel) c1[r] = -INFINITY; } }
                A3_ROWMAX(rm);
                mhat = rm;
#pragma unroll
                for (int r = 0; r < 16; ++r) { c0[r] -= rm; c1[r] -= rm; negm[r] = -mhat; }
                pend = true;
            } else {
                s16x4 vlo[8], vhh[8]; bf16x8 pa[4];
                A3_QKH(0); A3_KLOADH(sl, 1);
                A3_VLOAD(pslot);
                A3_QKH(1);
                A3_EXP();
#pragma unroll
                for (int g_ = 0; g_ < 2 * DKS; ++g_) { __builtin_amdgcn_sched_group_barrier(0x008, 1, 0); __builtin_amdgcn_sched_group_barrier(0x002, 7, 0); }
                A3_PV();
                A3_ROWMAX(rm);
#pragma unroll
                for (int g_ = 0; g_ < 8; ++g_) { __builtin_amdgcn_sched_group_barrier(0x008, 1, 0); __builtin_amdgcn_sched_group_barrier(0x002, 3, 0); }
                if (__any(rm > THR)) {
                    const float dl = fmaxf(rm, 0.f); mhat += dl;
#pragma unroll
                    for (int r = 0; r < 16; ++r) { c0[r] -= dl; c1[r] -= dl; negm[r] = -mhat; }
                    const float f = __builtin_amdgcn_exp2f(-dl); lrun *= f;
                    if (hi == 0) wsf[r32] = f;
                    LDS_WAIT();
#pragma unroll
                    for (int g = 0; g < 4; ++g) { const f32x4 ff = *(const LAS f32x4*)(wsf + 8 * g + 4 * hi);
#pragma unroll
                        for (int j = 0; j < 4; ++j) { o[0][4 * g + j] *= ff[j]; o[1][4 * g + j] *= ff[j]; } }
                }
            }
            pp0 = c0; pp1 = c1; pslot = sl;
        }
        sl = (sl == NSL - 1) ? 0 : sl + 1; sl3 = (sl3 == NSL - 1) ? 0 : sl3 + 1;
    }
    if (pend) { s16x4 vlo[8], vhh[8]; bf16x8 pa[4]; A3_VLOAD(pslot); A3_EXP(); A3_PV(); }
#undef A3_KLOADH
#undef A3_VLOAD
#undef A3_QKH
#undef A3_EXP
#undef A3_PV
#undef A3_ROWMAX
#undef A2_DMA
    lrun += __shfl_xor(lrun, 32);
    LDS_WAIT();
    if (hi == 0) wsf[32 + r32] = lrun;
    LDS_WAIT();
    float rli[16];
#pragma unroll
    for (int g = 0; g < 4; ++g) { const f32x4 ll = *(const LAS f32x4*)(wsf + 32 + 8 * g + 4 * hi);
#pragma unroll
        for (int j = 0; j < 4; ++j) rli[4 * g + j] = __builtin_amdgcn_rcpf(ll[j]); }
    GAS bf16* Ow = T.O + (rowbase + qw0) * 1024 + (MODE ? 0 : 512) + h * 64;
    { LAS bf16* stg = (LAS bf16*)(shm + R_OST) + wid * 2048;
#pragma unroll
      for (int r = 0; r < 16; ++r) { const int orow = crow(r, hi);
#pragma unroll
          for (int d0 = 0; d0 < 2; ++d0) stg[orow * 64 + d0 * 32 + r32] = (bf16)(cvt_pk_bf16(o[d0][r] * rli[r], 0.f) & 0xffffu); }
      LDS_WAIT();
#pragma unroll
      for (int i = 0; i < 4; ++i) { const int row = i * 8 + (lane >> 3), ch = lane & 7; const u32x4 v = *(const LAS u32x4*)(stg + row * 64 + ch * 8); *(GAS u32x4*)(Ow + (long)row * 1024 + ch * 8) = v; } }
    if (qb_next < 0) { LDS_WAIT(); __builtin_amdgcn_s_barrier(); asm volatile("" ::: "memory"); }
    return A3_SLOT(NTE);
#undef A3_SLOT
}
}

struct Args { const void* in[21]; float* out; unsigned char* ws; int ph_lo, ph_hi; };

__device__ __forceinline__ void tr_item(const GAS float* __restrict__ W, int ldw, int Ksrc, const GAS float* __restrict__ gain, GAS bf16* __restrict__ WT, int ldk, int k0, int n0, int srccol, LAS float* scr, int lane) {
#pragma unroll 8
    for (int i = 0; i < 32; ++i) { const int kk = 2 * i + (lane >> 5); const int k = k0 + kk;
        float v = 0.f; if (srccol >= 0 && k < Ksrc) { v = W[(size_t)k * ldw + srccol]; if (gain) v *= gain[k]; }
        scr[kk * 33 + (lane & 31)] = v; }
    LDS_WAIT(); asm volatile("" ::: "memory");
    const int c = lane & 7;
#pragma unroll
    for (int j = 0; j < 4; ++j) { const int n = (lane >> 3) + 8 * j; const LAS float* s = scr + (8 * c) * 33 + n;
        u32x4 o; o.x = cvt_pk_bf16(s[0 * 33], s[1 * 33]); o.y = cvt_pk_bf16(s[2 * 33], s[3 * 33]); o.z = cvt_pk_bf16(s[4 * 33], s[5 * 33]); o.w = cvt_pk_bf16(s[6 * 33], s[7 * 33]);
        *(GAS u32x4*)(WT + (size_t)(n0 + n) * ldk + k0 + 8 * c) = o; }
    LDS_WAIT(); asm volatile("" ::: "memory");
}
__device__ __forceinline__ void tr_item64(const GAS float* __restrict__ W, int ldw, const GAS float* __restrict__ gain, GAS bf16* __restrict__ WT, int ldk, int k0, int n0src, int n0dst, LAS float* scr, int lane) {
    const int rr = lane >> 4, c4 = (lane & 15) * 4;
    f32x4 v[16];
#pragma unroll
    for (int i = 0; i < 16; ++i) v[i] = *(const GAS f32x4*)(W + (size_t)(k0 + 4 * i + rr) * ldw + n0src + c4);
#pragma unroll
    for (int i = 0; i < 16; ++i) { const int k = 4 * i + rr; const float g = gain ? gain[k0 + k] : 1.f; LAS float* d = scr + k * 65 + c4;
        d[0] = v[i][0] * g; d[1] = v[i][1] * g; d[2] = v[i][2] * g; d[3] = v[i][3] * g; }
    LDS_WAIT(); asm volatile("" ::: "memory");
    const int kc = lane & 7;
#pragma unroll
    for (int j = 0; j < 8; ++j) { const int n = (lane >> 3) + 8 * j; const LAS float* sp = scr + (8 * kc) * 65 + n;
        u32x4 o; o.x = cvt_pk_bf16(sp[0 * 65], sp[1 * 65]); o.y = cvt_pk_bf16(sp[2 * 65], sp[3 * 65]); o.z = cvt_pk_bf16(sp[4 * 65], sp[5 * 65]); o.w = cvt_pk_bf16(sp[6 * 65], sp[7 * 65]);
        *(GAS u32x4*)(WT + (size_t)(n0dst + n) * ldk + k0 + 8 * kc) = o; }
    LDS_WAIT(); asm volatile("" ::: "memory");
}
__device__ __forceinline__ void tr_item64_f8(const GAS float* __restrict__ W, int ldw, const GAS float* __restrict__ gain, float scale, GAS unsigned char* __restrict__ WT8, int ldkB, int k0, int n0src, int n0dst, LAS float* scr, int lane) {
    const int rr = lane >> 4, c4 = (lane & 15) * 4;
    f32x4 v[16];
#pragma unroll
    for (int i = 0; i < 16; ++i) v[i] = *(const GAS f32x4*)(W + (size_t)(k0 + 4 * i + rr) * ldw + n0src + c4);
#pragma unroll
    for (int i = 0; i < 16; ++i) { const int k = 4 * i + rr; const float g = (gain ? gain[k0 + k] : 1.f) * scale; LAS float* d = scr + k * 65 + c4;
        d[0] = v[i][0] * g; d[1] = v[i][1] * g; d[2] = v[i][2] * g; d[3] = v[i][3] * g; }
    LDS_WAIT(); asm volatile("" ::: "memory");
    const int kc = lane & 7;
#pragma unroll
    for (int j = 0; j < 8; ++j) { const int n = (lane >> 3) + 8 * j; const LAS float* sp = scr + (8 * kc) * 65 + n;
        u32x2 o; o.x = pk4_fp8(sp[0 * 65], sp[1 * 65], sp[2 * 65], sp[3 * 65]); o.y = pk4_fp8(sp[4 * 65], sp[5 * 65], sp[6 * 65], sp[7 * 65]);
        *(GAS u32x2*)(WT8 + (size_t)(n0dst + n) * ldkB + k0 + 8 * kc) = o; }
    LDS_WAIT(); asm volatile("" ::: "memory");
}
__device__ __forceinline__ int rope_dim(int p) { const int a = p >> 3, j = p & 7; return j < 4 ? 4 * a + j : 16 + 4 * a + (j - 4); }

#define LDP(i) ((void*)((((unsigned long long)(unsigned)__builtin_amdgcn_readfirstlane((int)(ARGP[i] >> 32))) << 32) | (unsigned long long)(unsigned)__builtin_amdgcn_readfirstlane((int)(unsigned)ARGP[i])))
#define ARGIN(i) ((const void*)LDP(i))
#define P_COS ((GAS float*)(ws + WS_COS))
#define P_SIN ((GAS float*)(ws + WS_SIN))
#define P_SSQ ((GAS float*)(ws + WS_SSQ))
#define P_FLOG ((GAS float*)(ws + WS_FLOG))
#define P_E01 ((GAS int*)(ws + WS_E01))
#define P_G01 ((GAS float*)(ws + WS_G01))
#define P_SLOT ((GAS int*)(ws + WS_SLOT))
#define P_TOKOF ((GAS int*)(ws + WS_TOKOF))
#define P_GATEOF ((GAS float*)(ws + WS_GATEOF))
#define P_CNT ((GAS int*)(ws + WS_CNT))
#define P_TSTART ((GAS int*)(ws + WS_TSTART))
#define P_RSTD ((GAS float*)(ws + WS_RSTD))
#define P_RSTDOF ((GAS float*)(ws + WS_RSTDOF))
#define P_KPE ((GAS bf16*)(ws + WS_KPE))
#define P_KAUG ((GAS bf16*)(ws + WS_KAUG))
#define P_BIASF ((GAS float*)(ws + WS_BIASF))
#define P_NRM ((GAS float*)(ws + WS_NRM))
#define P_WR ((GAS bf16*)(ws + WS_WR))
#define P_XR ((GAS bf16*)(ws + WS_XR))
#define P_WIN ((GAS bf16*)(ws + WS_WIN))
#define P_WUQ ((GAS bf16*)(ws + WS_WUQ))
#define P_WUKV ((GAS bf16*)(ws + WS_WUKV))
#define P_WOUT ((GAS bf16*)(ws + WS_WOUT))
#define P_WGU ((GAS bf16*)(ws + WS_WGU))
#define P_WD ((GAS bf16*)(ws + WS_WD))
#define P_XN ((GAS bf16*)(ws + WS_XN))
#define P_FQKV ((GAS bf16*)(ws + WS_FQKV))
#define P_HH ((GAS bf16*)(ws + WS_FQKV))
#define P_LAT ((GAS bf16*)(ws + WS_LAT))
#define P_QM ((GAS bf16*)(ws + WS_QM))
#define P_KVM ((GAS bf16*)(ws + WS_KVM))
#define P_Y ((GAS bf16*)(ws + WS_Y))
#define IN(k) (lo <= (k) && (k) < hi_)
#if MK_ONE_LAUNCH
#define GRID_BAR() xcd_barrier(bar)
#else
#define GRID_BAR() do {} while (0)
#endif
#define SEAM(k) do { if (IN(k) && IN((k) + 1)) GRID_BAR(); } while (0)
template <int l>
__device__ __forceinline__ void layer_body(const int lo, const int hi_, LAS unsigned char* lds0, const int wave0, const int G0, const int bx0, const XcdBarrier& bar) {
        const int P = 10 * l;
        if (IN(P)) for (int rep_ = 0; rep_ < (l == 0 ? NREP(0) : 1); ++rep_) {
            unsigned ldsb_ = (unsigned)(uintptr_t)lds0; asm volatile("" : "+s"(ldsb_)); LAS unsigned char* lds = (LAS unsigned char*)(uintptr_t)ldsb_; volatile LAS unsigned* MISC = (volatile LAS unsigned*)(lds + MISC_OFF); volatile LAS unsigned long long* ARGP = (volatile LAS unsigned long long*)(lds + MISC_OFF + 768); (void)MISC; int wave = wave0, G = G0, bx = bx0; asm volatile("" : "+s"(G), "+s"(bx), "+s"(wave)); const int lane = (int)__builtin_amdgcn_mbcnt_hi(~0u, __builtin_amdgcn_mbcnt_lo(~0u, 0u)); const int tid = wave * 64 + lane; const int vcu = (bx % 8) * (G / 8) + bx / 8; const int gw = vcu * 8 + wave, NGW = G * 8; (void)lane; (void)gw; (void)NGW; (void)vcu;
            GAS unsigned char* ws = (GAS unsigned char*)LDP(22); GAS float* out = (GAS float*)LDP(21); const GAS float* x_in = (const GAS float*)ARGIN(0); const GAS int* positions = (const GAS int*)ARGIN(1);
            if (l < NLAYER) {
                LAS float* scr = (LAS float*)(lds + wave * 16640);
                const GAS float* attn_norm = (const GAS float*)ARGIN(2) + (size_t)l * DM; const GAS float* w_in = (const GAS float*)ARGIN(3) + (size_t)l * DM * INW;
                const GAS float* q_norm = (const GAS float*)ARGIN(5) + (size_t)l * 256; const GAS float* w_uq = (const GAS float*)ARGIN(6) + (size_t)l * 256 * 768;
                const GAS float* kv_norm = (const GAS float*)ARGIN(7) + (size_t)l * 128; const GAS float* w_ukv = (const GAS float*)ARGIN(8) + (size_t)l * 128 * 1024;
                const GAS float* mla_on = (const GAS float*)ARGIN(9) + (size_t)l * 512; const GAS float* fox_on = (const GAS float*)ARGIN(10) + (size_t)l * 512; const GAS float* w_out = (const GAS float*)ARGIN(11) + (size_t)l * DM * DM;
                const GAS float* ffn_norm = (const GAS float*)ARGIN(12) + (size_t)l * DM;
                const GAS float* w_gate = (const GAS float*)ARGIN(17) + (size_t)l * NEXP * DM * DEXP; const GAS float* w_up = (const GAS float*)ARGIN(18) + (size_t)l * NEXP * DM * DEXP; const GAS float* w_down = (const GAS float*)ARGIN(19) + (size_t)l * NEXP * DEXP * DM;
                constexpr int I_IN = 16 * 64, I_UQ = 4 * 24, I_UKV = 4 * 32;
                constexpr int NITEMS = I_IN + I_UQ + I_UKV;
                for (int it = gw; it < NITEMS; it += NGW) {
                    int r = it; const int j = lane & 31;
                    if (r < I_IN) { const int kb = r / 64, nb = r % 64; const int n = nb * 32 + j; int sc;
                        if (n < 384) sc = n; else if (n < 416) sc = 384 + rope_dim(n - 384); else if (n < 424) sc = 1952 + (n - 416); else if (n < 512) sc = -1; else sc = 416 + (n - 512);
                        tr_item(w_in, INW, DM, attn_norm, P_WIN, DM, kb * 64, nb * 32, sc, scr, lane); continue; } r -= I_IN;
                    if (r < I_UQ) { const int kb = r / 24, nb = r % 24; const int n = nb * 32 + j; const int hh = n / 96, d = n % 96; const int sc = d < 64 ? n : hh * 96 + 64 + rope_dim(d - 64);
                        tr_item(w_uq, 768, 256, q_norm, P_WUQ, 256, kb * 64, nb * 32, sc, scr, lane); continue; } r -= I_UQ;
                    { const int kb = r / 32, nb = r % 32; tr_item(w_ukv, 1024, 128, kv_norm, P_WUKV, 256, kb * 64, nb * 32, nb * 32 + j, scr, lane); }
                }
                LAS float* scr64 = (LAS float*)(lds + wave * 16640);
                constexpr int J_OUT = 16 * 16, J_GU = 16 * 16 * NEXP, J_D = 8 * 16 * NEXP;
                for (int it = gw; it < J_OUT + J_GU + J_D; it += NGW) {
                    int r = it;
                    if (r < J_OUT) { const int kb = r / 16, nb = r % 16; const GAS float* gn = kb < 8 ? mla_on : fox_on - 512; tr_item64(w_out, DM, gn, P_WOUT, DM, kb * 64, nb * 64, nb * 64, scr64, lane); continue; } r -= J_OUT;
                    if (r < J_GU) { const int e = r / 256, q = r % 256, kb = q / 16, nb = q % 16; const int n0 = nb * 64; const int ct = n0 >> 8, which = (n0 >> 7) & 1, jj = n0 & 127;
                        const GAS float* src = (which ? w_up : w_gate) + (size_t)e * DM * DEXP;
                        tr_item64_f8(src, DEXP, ffn_norm, WSCALE, (GAS unsigned char*)P_WGU + (size_t)e * 1024 * 1024, DM, kb * 64, ct * 128 + jj, n0, scr64, lane); continue; } r -= J_GU;
                    { const int e = r / 128, q = r % 128, kb = q / 16, nb = q % 16;
                        tr_item64_f8(w_down + (size_t)e * DEXP * DM, DM, nullptr, WSCALE, (GAS unsigned char*)P_WD + (size_t)e * 1024 * 512, DEXP, kb * 64, nb * 64, nb * 64, scr64, lane); }
                }
                { const GAS float* w_rg = (const GAS float*)ARGIN(13) + (size_t)l * DM * 4; const GAS float* w_re = (const GAS float*)ARGIN(15) + (size_t)l * DM * 32;
                  for (int idx = bx * 512 + tid; idx < 2 * 48 * 520; idx += G * 512) { const int half = idx / (48 * 520), r = idx % (48 * 520), c = r / 520, kk = r % 520; const int k = half * 512 + kk;
                      float w = 0.f; if (c < 36 && kk < 512) w = ffn_norm[k] * (c < 4 ? w_rg[k * 4 + c] : w_re[k * 32 + (c - 4)]);
                      const unsigned h16 = cvt_pk_bf16(w, 0.f) & 0xffffu; const unsigned l16 = cvt_pk_bf16(w - __uint_as_float(h16 << 16), 0.f) & 0xffffu;
                      P_WR[(size_t)(half * 2 + 0) * 48 * 520 + r] = (bf16)h16; P_WR[(size_t)(half * 2 + 1) * 48 * 520 + r] = (bf16)l16; } }
            }
            const GAS float* fin = (const GAS float*)ARGIN(20);
            for (int mb = gw * 4; mb < NTOK; mb += NGW * 4) {
                f32x4 v[4][4]; int s0[4], s1[4];
                if (l > 0) {
#pragma unroll
                    for (int r = 0; r < 4; ++r) { s0[r] = P_SLOT[2 * (mb + r)]; s1[r] = P_SLOT[2 * (mb + r) + 1]; }
                }
#pragma unroll
                for (int r = 0; r < 4; ++r) {
                    if (l == 0) { const GAS float* xr = x_in + (size_t)(mb + r) * DM;
#pragma unroll
                        for (int j = 0; j < 4; ++j) v[r][j] = *(const GAS f32x4*)(xr + 4 * lane + 256 * j); }
                    else { const GAS bf16* xr = P_XR + (size_t)(mb + r) * DM;
#pragma unroll
                        for (int j = 0; j < 4; ++j) { const u32x2 w = *(const GAS u32x2*)(xr + 4 * lane + 256 * j); v[r][j] = (f32x4){__uint_as_float(w.x << 16), __uint_as_float(w.x & 0xffff0000u), __uint_as_float(w.y << 16), __uint_as_float(w.y & 0xffff0000u)}; } } }
                if (l > 0) {
#pragma unroll
                    for (int r = 0; r < 4; ++r)
#pragma unroll
                        for (int j = 0; j < 4; ++j) { const int a = *(const GAS int*)((const GAS unsigned char*)P_Y + (size_t)s0[r] * 1024 + 4 * lane + 256 * j), c = *(const GAS int*)((const GAS unsigned char*)P_Y + (size_t)s1[r] * 1024 + 4 * lane + 256 * j);
                            const f32x2 a0 = __builtin_amdgcn_cvt_pk_f32_fp8(a, false), a1 = __builtin_amdgcn_cvt_pk_f32_fp8(a, true), c0 = __builtin_amdgcn_cvt_pk_f32_fp8(c, false), c1 = __builtin_amdgcn_cvt_pk_f32_fp8(c, true);
                            v[r][j][0] += (a0[0] + c0[0]) * WSCALE_INV; v[r][j][1] += (a0[1] + c0[1]) * WSCALE_INV; v[r][j][2] += (a1[0] + c1[0]) * WSCALE_INV; v[r][j][3] += (a1[1] + c1[1]) * WSCALE_INV; }
                }
                float ss[4];
#pragma unroll
                for (int r = 0; r < 4; ++r) { float s = 0.f;
#pragma unroll
                    for (int j = 0; j < 4; ++j) s += (v[r][j][0] * v[r][j][0] + v[r][j][1] * v[r][j][1]) + (v[r][j][2] * v[r][j][2] + v[r][j][3] * v[r][j][3]);
                    ss[r] = s; }
#pragma unroll
                for (int o = 1; o < 64; o <<= 1) {
#pragma unroll
                    for (int r = 0; r < 4; ++r) ss[r] += __shfl_xor(ss[r], o); }
#pragma unroll
                for (int r = 0; r < 4; ++r) { const int m = mb + r; const float rstd = rsqrtf(ss[r] * (1.f / DM) + EPS);
                    if (l < NLAYER) {
                        if (l > 0) {
#pragma unroll
                            for (int j = 0; j < 4; ++j) { u32x2 w; w.x = cvt_pk_bf16(v[r][j][0], v[r][j][1]); w.y = cvt_pk_bf16(v[r][j][2], v[r][j][3]); *(GAS u32x2*)(P_XR + (size_t)m * DM + 4 * lane + 256 * j) = w; }
                        }
#pragma unroll
                        for (int j = 0; j < 4; ++j) { u32x2 w; w.x = cvt_pk_bf16(v[r][j][0] * rstd, v[r][j][1] * rstd); w.y = cvt_pk_bf16(v[r][j][2] * rstd, v[r][j][3] * rstd); *(GAS u32x2*)(P_XN + (size_t)m * DM + 4 * lane + 256 * j) = w; }
                    } else {
#pragma unroll
                        for (int j = 0; j < 4; ++j) { const f32x4 g = *(const GAS f32x4*)(fin + 4 * lane + 256 * j); *(GAS f32x4*)(out + (size_t)m * DM + 4 * lane + 256 * j) = v[r][j] * rstd * g; }
                    }
                }
            }
        }
        if constexpr (l == NLAYER) return;
        SEAM(P);
        if (IN(P + 1)) for (int rep_ = 0; rep_ < ((l == 0 || 1 != 5) ? NREP(1) : 1); ++rep_) {
            unsigned ldsb_ = (unsigned)(uintptr_t)lds0; asm volatile("" : "+s"(ldsb_)); LAS unsigned char* lds = (LAS unsigned char*)(uintptr_t)ldsb_; volatile LAS unsigned* MISC = (volatile LAS unsigned*)(lds + MISC_OFF); volatile LAS unsigned long long* ARGP = (volatile LAS unsigned long long*)(lds + MISC_OFF + 768); (void)MISC; int wave = wave0, G = G0, bx = bx0; asm volatile("" : "+s"(G), "+s"(bx), "+s"(wave)); const int lane = (int)__builtin_amdgcn_mbcnt_hi(~0u, __builtin_amdgcn_mbcnt_lo(~0u, 0u)); const int tid = wave * 64 + lane; const int vcu = (bx % 8) * (G / 8) + bx / 8; const int gw = vcu * 8 + wave, NGW = G * 8; (void)lane; (void)gw; (void)NGW; (void)vcu;
            GAS unsigned char* ws = (GAS unsigned char*)LDP(22); GAS float* out = (GAS float*)LDP(21); const GAS float* x_in = (const GAS float*)ARGIN(0); (void)out; (void)x_in; (void)ws;
            DenseOrder S{NTOK / 256, INP / 256, (NTOK / 256) * (INP / 256), G, bx, (const GAS char*)P_XN, (const GAS char*)P_WIN, (size_t)256 * DM * 2, (size_t)256 * DM * 2};
            EpiWin E{P_LAT, P_FQKV, P_KPE, P_FLOG, P_SSQ, P_COS, P_SIN};
            pg8::gemm_phase<EpiWin, DenseOrder, true, false>(tid, lds, DM * 2, DM * 2, DM * 2, S, E, nullptr);
        }
        SEAM(P + 1);
        if (IN(P + 2)) for (int rep_ = 0; rep_ < ((l == 0 || 2 != 5) ? NREP(2) : 1); ++rep_) {
            unsigned ldsb_ = (unsigned)(uintptr_t)lds0; asm volatile("" : "+s"(ldsb_)); LAS unsigned char* lds = (LAS unsigned char*)(uintptr_t)ldsb_; volatile LAS unsigned* MISC = (volatile LAS unsigned*)(lds + MISC_OFF); volatile LAS unsigned long long* ARGP = (volatile LAS unsigned long long*)(lds + MISC_OFF + 768); (void)MISC; int wave = wave0, G = G0, bx = bx0; asm volatile("" : "+s"(G), "+s"(bx), "+s"(wave)); const int lane = (int)__builtin_amdgcn_mbcnt_hi(~0u, __builtin_amdgcn_mbcnt_lo(~0u, 0u)); const int tid = wave * 64 + lane; const int vcu = (bx % 8) * (G / 8) + bx / 8; const int gw = vcu * 8 + wave, NGW = G * 8; (void)lane; (void)gw; (void)NGW; (void)vcu;
            GAS unsigned char* ws = (GAS unsigned char*)LDP(22); GAS float* out = (GAS float*)LDP(21); const GAS float* x_in = (const GAS float*)ARGIN(0); (void)out; (void)x_in; (void)ws;
            {
                const int sq = vcu >> 1, hf = vcu & 1; const int b = sq >> 3, h = sq & 7; const float bf = ((const GAS float*)ARGIN(4))[l * 8 + h];
                const GAS float* fl = P_FLOG + ((size_t)b * SEQ + hf * 1024 + 2 * tid) * 8 + h;
                float lf[2], lg[2] = {0.f, 0.f};
#pragma unroll
                for (int e = 0; e < 2; ++e) { const float f = fl[e * 8] + bf; lf[e] = fminf(f, 0.f) - log1pf(expf(-fabsf(f))); }
                if (hf) {
#pragma unroll
                    for (int e = 0; e < 2; ++e) { const float f = fl[e * 8 - 1024 * 8] + bf; lg[e] = fminf(f, 0.f) - log1pf(expf(-fabsf(f))); } }
                const double s2 = (double)lf[0] + (double)lf[1];
                double incl = s2, first = (double)lg[0] + (double)lg[1];
#pragma unroll
                for (int o = 1; o < 64; o <<= 1) { const double t = __shfl_up(incl, o); if (lane >= o) incl += t; first += __shfl_xor(first, o); }
                LAS double* wtot = (LAS double*)lds;
                if (lane == 63) wtot[wave] = incl;
                if (lane == 0) wtot[8 + wave] = first;
                __syncthreads();
                double c = incl - s2;
                for (int w = 0; w < wave; ++w) c += wtot[w];
                if (hf) { for (int w = 0; w < 8; ++w) c += wtot[8 + w]; }
                const size_t t0 = ((size_t)b * 8 + h) * SEQ + hf * 1024 + 2 * tid;
                GAS u32x4* ka = (GAS u32x4*)(P_KAUG + t0 * 8);
#pragma unroll
                for (int e = 0; e < 2; ++e) { c += (double)lf[e]; const float x = (float)(-c * 1.4426950408889634);
                    const unsigned h16 = cvt_pk_bf16(x, 0.f) & 0xffffu; const float r1 = x - __uint_as_float(h16 << 16); const unsigned m16 = cvt_pk_bf16(r1, 0.f) & 0xffffu; const float r2 = r1 - __uint_as_float(m16 << 16); const unsigned l16 = cvt_pk_bf16(r2, 0.f) & 0xffffu;
                    ka[e] = (u32x4){h16 | (m16 << 16), l16, 0u, 0u}; P_BIASF[t0 + e] = x; }
                float qn = 0.f, kn = 0.f;
                { const GAS bf16* fqp = P_FQKV + ((size_t)b * SEQ + hf * 1024 + 2 * tid) * 512 + h * 64; const GAS bf16* fkp = fqp + (size_t)NTOK * 512;
#pragma unroll
                  for (int e = 0; e < 2; ++e) { float sq_ = 0.f, sk = 0.f;
#pragma unroll
                      for (int c8 = 0; c8 < 8; ++c8) { const u32x4 a = *(const GAS u32x4*)(fqp + e * 512 + c8 * 8), k4 = *(const GAS u32x4*)(fkp + e * 512 + c8 * 8);
#pragma unroll
                          for (int j = 0; j < 4; ++j) { const float a0 = __uint_as_float(a[j] << 16), a1 = __uint_as_float(a[j] & 0xffff0000u), k0 = __uint_as_float(k4[j] << 16), k1 = __uint_as_float(k4[j] & 0xffff0000u);
                              sq_ += a0 * a0 + a1 * a1; sk += k0 * k0 + k1 * k1; } }
                      qn = fmaxf(qn, sq_); kn = fmaxf(kn, sk); } }
#pragma unroll
                for (int o = 1; o < 64; o <<= 1) { qn = fmaxf(qn, __shfl_xor(qn, o)); kn = fmaxf(kn, __shfl_xor(kn, o)); }
                LAS float* knw = (LAS float*)(lds + 256);
                if (lane == 0) { knw[wave] = kn; knw[8 + wave] = qn; }
                __syncthreads();
                if (tid < 4) P_NRM[sq * 16 + hf * 4 + tid] = sqrtf(fmaxf(knw[8 + 2 * tid], knw[8 + 2 * tid + 1]));
                if (tid == 4) { float m = knw[0]; for (int w = 1; w < 8; ++w) m = fmaxf(m, knw[w]); P_NRM[sq * 16 + 8 + hf] = sqrtf(m); }
                __syncthreads();
            }
            UpOrder S{G, vcu, (const GAS char*)P_LAT, (const GAS char*)P_WUQ, (const GAS char*)P_WUKV};
            EpiUp E{P_QM, P_KVM, P_SSQ, P_COS, P_SIN};
            pg8::gemm_phase<EpiUp, UpOrder, true, false>(tid, lds, 256 * 2, 512 * 2, 256 * 2, S, E, nullptr);
        }
        SEAM(P + 2);
        if (IN(P + 3)) for (int rep_ = 0; rep_ < ((l == 0 || 3 != 5) ? NREP(3) : 1); ++rep_) {
            unsigned ldsb_ = (unsigned)(uintptr_t)lds0; asm volatile("" : "+s"(ldsb_)); LAS unsigned char* lds = (LAS unsigned char*)(uintptr_t)ldsb_; volatile LAS unsigned* MISC = (volatile LAS unsigned*)(lds + MISC_OFF); volatile LAS unsigned long long* ARGP = (volatile LAS unsigned long long*)(lds + MISC_OFF + 768); (void)MISC; int wave = wave0, G = G0, bx = bx0; asm volatile("" : "+s"(G), "+s"(bx), "+s"(wave)); const int lane = (int)__builtin_amdgcn_mbcnt_hi(~0u, __builtin_amdgcn_mbcnt_lo(~0u, 0u)); const int tid = wave * 64 + lane; const int vcu = (bx % 8) * (G / 8) + bx / 8; const int gw = vcu * 8 + wave, NGW = G * 8; (void)lane; (void)gw; (void)NGW; (void)vcu;
            GAS unsigned char* ws = (GAS unsigned char*)LDP(22); GAS float* out = (GAS float*)LDP(21); const GAS float* x_in = (const GAS float*)ARGIN(0); (void)out; (void)x_in; (void)ws;
            GAS bf16* O = P_XN;
            const int b = vcu >> 4, hh = (vcu & 15) >> 1, sub = vcu & 1;
            const att::Tens2 TM{P_QM, 768, P_KVM, 1024, P_KPE, P_KVM + 64, 1024, O, nullptr, nullptr};
            const att::Tens2 TF{P_FQKV, 512, P_FQKV + (size_t)NTOK * 512, 512, P_KAUG, P_FQKV + (size_t)2 * NTOK * 512, 512, O, P_BIASF, P_NRM};
#define QB_OF(i) ((((i) & 1) ? 7 - (2 * sub + ((i) >> 1)) : (2 * sub + ((i) >> 1))))
            { int sb = 0; for (int i = 0; i < 4; ++i) sb = att::attn_unit2<1>(wave, b, hh, QB_OF(i), TM, (LAS char*)lds, sb, i > 0, i < 3 ? QB_OF(i + 1) : -1); }
            { int sb = 0; for (int i = 0; i < 4; ++i) sb = att::attn_unit2<0>(wave, b, hh, QB_OF(i), TF, (LAS char*)lds, sb, i > 0, i < 3 ? QB_OF(i + 1) : -1); }
#undef QB_OF
        }
        SEAM(P + 3);
        if (IN(P + 4)) for (int rep_ = 0; rep_ < ((l == 0 || 4 != 5) ? NREP(4) : 1); ++rep_) {
            unsigned ldsb_ = (unsigned)(uintptr_t)lds0; asm volatile("" : "+s"(ldsb_)); LAS unsigned char* lds = (LAS unsigned char*)(uintptr_t)ldsb_; volatile LAS unsigned* MISC = (volatile LAS unsigned*)(lds + MISC_OFF); volatile LAS unsigned long long* ARGP = (volatile LAS unsigned long long*)(lds + MISC_OFF + 768); (void)MISC; int wave = wave0, G = G0, bx = bx0; asm volatile("" : "+s"(G), "+s"(bx), "+s"(wave)); const int lane = (int)__builtin_amdgcn_mbcnt_hi(~0u, __builtin_amdgcn_mbcnt_lo(~0u, 0u)); const int tid = wave * 64 + lane; const int vcu = (bx % 8) * (G / 8) + bx / 8; const int gw = vcu * 8 + wave, NGW = G * 8; (void)lane; (void)gw; (void)NGW; (void)vcu;
            GAS unsigned char* ws = (GAS unsigned char*)LDP(22); GAS float* out = (GAS float*)LDP(21); const GAS float* x_in = (const GAS float*)ARGIN(0); (void)out; (void)x_in; (void)ws;
            GAS bf16* O = P_XN;
            for (int mb = gw * 4; mb < NTOK; mb += NGW * 4) {
                u32x4 a[4], c[4];
#pragma unroll
                for (int r = 0; r < 4; ++r) { const GAS bf16* orow = O + (size_t)(mb + r) * DM; a[r] = *(const GAS u32x4*)(orow + 8 * lane); c[r] = *(const GAS u32x4*)(orow + 512 + 8 * lane); }
                float sa[4], sc[4];
#pragma unroll
                for (int r = 0; r < 4; ++r) { sa[r] = 0.f; sc[r] = 0.f;
#pragma unroll
                    for (int j = 0; j < 4; ++j) { const float a0 = __uint_as_float(a[r][j] << 16), a1 = __uint_as_float(a[r][j] & 0xffff0000u), c0 = __uint_as_float(c[r][j] << 16), c1 = __uint_as_float(c[r][j] & 0xffff0000u);
                        sa[r] += a0 * a0 + a1 * a1; sc[r] += c0 * c0 + c1 * c1; } }
#pragma unroll
                for (int o = 1; o < 64; o <<= 1) {
#pragma unroll
                    for (int r = 0; r < 4; ++r) { sa[r] += __shfl_xor(sa[r], o); sc[r] += __shfl_xor(sc[r], o); } }
#pragma unroll
                for (int r = 0; r < 4; ++r) { GAS bf16* orow = O + (size_t)(mb + r) * DM;
                    const float ra = rsqrtf(sa[r] * (1.f / 512.f) + EPS), rc = rsqrtf(sc[r] * (1.f / 512.f) + EPS);
                    u32x4 oa, oc;
#pragma unroll
                    for (int j = 0; j < 4; ++j) { oa[j] = cvt_pk_bf16(__uint_as_float(a[r][j] << 16) * ra, __uint_as_float(a[r][j] & 0xffff0000u) * ra); oc[j] = cvt_pk_bf16(__uint_as_float(c[r][j] << 16) * rc, __uint_as_float(c[r][j] & 0xffff0000u) * rc); }
                    *(GAS u32x4*)(orow + 8 * lane) = oa; *(GAS u32x4*)(orow + 512 + 8 * lane) = oc; }
            }
        }
        SEAM(P + 4);
        if (IN(P + 5)) for (int rep_ = 0; rep_ < ((l == 0 || 5 != 5) ? NREP(5) : 1); ++rep_) {
            unsigned ldsb_ = (unsigned)(uintptr_t)lds0; asm volatile("" : "+s"(ldsb_)); LAS unsigned char* lds = (LAS unsigned char*)(uintptr_t)ldsb_; volatile LAS unsigned* MISC = (volatile LAS unsigned*)(lds + MISC_OFF); volatile LAS unsigned long long* ARGP = (volatile LAS unsigned long long*)(lds + MISC_OFF + 768); (void)MISC; int wave = wave0, G = G0, bx = bx0; asm volatile("" : "+s"(G), "+s"(bx), "+s"(wave)); const int lane = (int)__builtin_amdgcn_mbcnt_hi(~0u, __builtin_amdgcn_mbcnt_lo(~0u, 0u)); const int tid = wave * 64 + lane; const int vcu = (bx % 8) * (G / 8) + bx / 8; const int gw = vcu * 8 + wave, NGW = G * 8; (void)lane; (void)gw; (void)NGW; (void)vcu;
            GAS unsigned char* ws = (GAS unsigned char*)LDP(22); GAS float* out = (GAS float*)LDP(21); const GAS float* x_in = (const GAS float*)ARGIN(0); (void)out; (void)x_in; (void)ws;
            DenseOrder S{NTOK / 256, DM / 256, (NTOK / 256) * (DM / 256), G, bx, (const GAS char*)P_XN, (const GAS char*)P_WOUT, (size_t)256 * DM * 2, (size_t)256 * DM * 2};
            EpiOut<l == 0> E{x_in, P_XR};
            pg8::gemm_phase<EpiOut<l == 0>, DenseOrder, true, false>(tid, lds, DM * 2, DM * 2, DM * 2, S, E, nullptr);
        }
        SEAM(P + 5);
        if (IN(P + 6)) for (int rep_ = 0; rep_ < ((l == 0 || 6 != 5) ? NREP(6) : 1); ++rep_) {
            unsigned ldsb_ = (unsigned)(uintptr_t)lds0; asm volatile("" : "+s"(ldsb_)); LAS unsigned char* lds = (LAS unsigned char*)(uintptr_t)ldsb_; volatile LAS unsigned* MISC = (volatile LAS unsigned*)(lds + MISC_OFF); volatile LAS unsigned long long* ARGP = (volatile LAS unsigned long long*)(lds + MISC_OFF + 768); (void)MISC; int wave = wave0, G = G0, bx = bx0; asm volatile("" : "+s"(G), "+s"(bx), "+s"(wave)); const int lane = (int)__builtin_amdgcn_mbcnt_hi(~0u, __builtin_amdgcn_mbcnt_lo(~0u, 0u)); const int tid = wave * 64 + lane; const int vcu = (bx % 8) * (G / 8) + bx / 8; const int gw = vcu * 8 + wave, NGW = G * 8; (void)lane; (void)gw; (void)NGW; (void)vcu;
            GAS unsigned char* ws = (GAS unsigned char*)LDP(22); GAS float* out = (GAS float*)LDP(21); const GAS float* x_in = (const GAS float*)ARGIN(0); (void)out; (void)x_in; (void)ws;
            GAS bf16* H2 = P_XN;
            LAS bf16* WT = (LAS bf16*)lds;
            LAS float* LG = (LAS float*)(lds + 99840) + wave * 576;
            const GAS float* b_rg = (const GAS float*)ARGIN(14) + l * 4; const GAS float* b_re = (const GAS float*)ARGIN(16) + l * 32;
            if (tid < 32) MISC[64 + tid] = 0u;
            const int r16 = lane & 15, g4 = lane >> 4;
            const int m0 = vcu * 128 + wave * 16;
            const GAS bf16* xrow = P_XR + (size_t)(m0 + r16) * DM + 8 * g4;
            GAS unsigned char* hrow = (GAS unsigned char*)H2 + (size_t)(m0 + r16) * DM + 8 * g4;
            f32x4 acc3[3]; acc3[0] = (f32x4){0.f, 0.f, 0.f, 0.f}; acc3[1] = acc3[0]; acc3[2] = acc3[0];
            float ssq = 0.f;
            for (int half = 0; half < 2; ++half) {
                __syncthreads();
                for (int idx = tid; idx < 2 * 48 * 520 / 8; idx += 512) *(LAS u32x4*)(WT + 8 * idx) = *(const GAS u32x4*)(P_WR + (size_t)half * 2 * 48 * 520 + 8 * idx);
                __syncthreads();
                for (int s8 = 0; s8 < 16; s8 += 8) {
                    bf16x8 xv[8];
#pragma unroll
                    for (int u = 0; u < 8; ++u) xv[u] = *(const GAS bf16x8*)(xrow + half * 512 + 32 * (s8 + u));
#pragma unroll
                    for (int u = 0; u < 8; ++u) {
                        const u32x4 xw = __builtin_bit_cast(u32x4, xv[u]); float xf[8];
#pragma unroll
                        for (int j = 0; j < 4; ++j) { xf[2 * j] = __uint_as_float(xw[j] << 16); xf[2 * j + 1] = __uint_as_float(xw[j] & 0xffff0000u); }
                        u32x2 hw; hw.x = pk4_fp8(xf[0], xf[1], xf[2], xf[3]); hw.y = pk4_fp8(xf[4], xf[5], xf[6], xf[7]); *(GAS u32x2*)(hrow + half * 512 + 32 * (s8 + u)) = hw;
#pragma unroll
                        for (int j = 0; j < 8; ++j) ssq += xf[j] * xf[j];
                        const LAS bf16* wk = WT + r16 * 520 + 32 * (s8 + u) + 8 * g4;
#pragma unroll
                        for (int ct = 0; ct < 3; ++ct) { const bf16x8 bh = *(const LAS bf16x8*)(wk + ct * 16 * 520), bl = *(const LAS bf16x8*)(wk + (48 + ct * 16) * 520);
                            acc3[ct] = __builtin_amdgcn_mfma_f32_16x16x32_bf16(xv[u], bh, acc3[ct], 0, 0, 0); acc3[ct] = __builtin_amdgcn_mfma_f32_16x16x32_bf16(xv[u], bl, acc3[ct], 0, 0, 0); }
                    }
                }
            }
            ssq += __shfl_xor(ssq, 16); ssq += __shfl_xor(ssq, 32);
            const float rstd = rsqrtf(ssq * (1.f / DM) + EPS);
#pragma unroll
            for (int ct = 0; ct < 3; ++ct) { const int c = 16 * ct + r16; if (c < 36) {
#pragma unroll
                for (int rg = 0; rg < 4; ++rg) LG[(4 * g4 + rg) * 36 + c] = acc3[ct][rg]; } }
            LDS_WAIT();
            if (lane < 16) {
                const int m = m0 + lane; const LAS float* lg = LG + lane * 36;
                float gl[4];
#pragma unroll
                for (int g = 0; g < 4; ++g) gl[g] = lg[g] * rstd + b_rg[g];
                int gi = 0; float gm = gl[0];
#pragma unroll
                for (int g = 1; g < 4; ++g) if (gl[g] > gm) { gm = gl[g]; gi = g; }
                float gs = 0.f;
#pragma unroll
                for (int g = 0; g < 4; ++g) gs += __expf(gl[g] - gm);
                const float gval = 1.f / gs;
                float el[8];
#pragma unroll
                for (int j = 0; j < 8; ++j) el[j] = lg[4 + 8 * gi + j] * rstd + b_re[8 * gi + j];
                int i0 = 0; float mx0 = el[0];
#pragma unroll
                for (int j = 1; j < 8; ++j) if (el[j] > mx0) { mx0 = el[j]; i0 = j; }
                int i1 = -1; float mx1 = -INFINITY;
#pragma unroll
                for (int j = 0; j < 8; ++j) if (j != i0 && el[j] > mx1) { mx1 = el[j]; i1 = j; }
                const float e1 = __expf(mx1 - mx0); const float g0 = gval / (1.f + e1), g1 = gval * e1 / (1.f + e1);
                const int ea = gi * 8 + i0, eb = gi * 8 + i1; P_E01[2 * m] = ea; P_E01[2 * m + 1] = eb; P_G01[2 * m] = g0; P_G01[2 * m + 1] = g1; P_RSTD[m] = rstd;
                __hip_atomic_fetch_add((LAS unsigned*)(lds + MISC_OFF) + 64 + ea, 1u, __ATOMIC_RELAXED, __HIP_MEMORY_SCOPE_WORKGROUP); __hip_atomic_fetch_add((LAS unsigned*)(lds + MISC_OFF) + 64 + eb, 1u, __ATOMIC_RELAXED, __HIP_MEMORY_SCOPE_WORKGROUP);
            }
            __syncthreads();
            if (tid < 32) P_CNT[vcu * 32 + tid] = (int)MISC[64 + tid];
        }
        SEAM(P + 6);
        if (IN(P + 7)) for (int rep_ = 0; rep_ < ((l == 0 || 7 != 5) ? NREP(7) : 1); ++rep_) {
            unsigned ldsb_ = (unsigned)(uintptr_t)lds0; asm volatile("" : "+s"(ldsb_)); LAS unsigned char* lds = (LAS unsigned char*)(uintptr_t)ldsb_; volatile LAS unsigned* MISC = (volatile LAS unsigned*)(lds + MISC_OFF); volatile LAS unsigned long long* ARGP = (volatile LAS unsigned long long*)(lds + MISC_OFF + 768); (void)MISC; int wave = wave0, G = G0, bx = bx0; asm volatile("" : "+s"(G), "+s"(bx), "+s"(wave)); const int lane = (int)__builtin_amdgcn_mbcnt_hi(~0u, __builtin_amdgcn_mbcnt_lo(~0u, 0u)); const int tid = wave * 64 + lane; const int vcu = (bx % 8) * (G / 8) + bx / 8; const int gw = vcu * 8 + wave, NGW = G * 8; (void)lane; (void)gw; (void)NGW; (void)vcu;
            GAS unsigned char* ws = (GAS unsigned char*)LDP(22); GAS float* out = (GAS float*)LDP(21); const GAS float* x_in = (const GAS float*)ARGIN(0); (void)out; (void)x_in; (void)ws;
            LAS int* cnt_all = (LAS int*)lds;
            LAS int* pre_e = (LAS int*)(lds + 32768);
            LAS int* tot_e = pre_e + 32;
            LAS int* pst = pre_e + 64;
            LAS int* eL = pre_e + 128;
            for (int i = tid; i < 256 * 32; i += 512) cnt_all[i] = P_CNT[i];
            if (tid < 256) eL[tid] = P_E01[vcu * 256 + tid];
            __syncthreads();
            { LAS int* part = pre_e + 512;
              const int e = tid & 31, p = tid >> 5; int pre = 0, tot = 0;
#pragma unroll
              for (int j = 0; j < 16; ++j) { const int w = p * 16 + j; const int c = cnt_all[w * 32 + e]; pre += (w < vcu) ? c : 0; tot += c; }
              part[(p * 2) * 32 + e] = pre; part[(p * 2 + 1) * 32 + e] = tot; }
            __syncthreads();
            if (tid < 32) { LAS int* part = pre_e + 512; int pre = 0, tot = 0;
#pragma unroll
                for (int p = 0; p < 16; ++p) { pre += part[(p * 2) * 32 + tid]; tot += part[(p * 2 + 1) * 32 + tid]; } pre_e[tid] = pre; tot_e[tid] = tot; }
            __syncthreads();
            if (tid == 0) { int acc = 0; for (int e = 0; e < 32; ++e) { pst[e] = acc; acc += (tot_e[e] + 255) / 256 * 256; } pst[32] = acc; }
            __syncthreads();
            if (vcu == 0 && tid <= 32) P_TSTART[tid] = pst[tid] / 256;
            { LAS int* hist = pre_e + 2048;
              if (tid < 128) hist[tid] = 0;
              __syncthreads();
              int e = 0, rin = 0;
              if (tid < 256) { e = eL[tid]; unsigned long long mym = 0ull;
                  for (int x = 0; x < 32; ++x) { const unsigned long long bm = __ballot(e == x); if (e == x) mym = bm; }
                  rin = __builtin_popcountll(mym & ((1ull << lane) - 1ull));
                  if (rin == 0) hist[wave * 32 + e] = __builtin_popcountll(mym); }
              __syncthreads();
              if (tid < 256) { int r = rin; for (int w = 0; w < wave; ++w) r += hist[w * 32 + e];
                  const int slot = pst[e] + pre_e[e] + r; const int tok = vcu * 128 + (tid >> 1);
                  P_SLOT[vcu * 256 + tid] = slot; P_TOKOF[slot] = tok; P_GATEOF[slot] = P_G01[vcu * 256 + tid]; P_RSTDOF[slot] = P_RSTD[tok]; } }
            if (vcu < 32) { const int e = vcu; for (int s = pst[e] + tot_e[e] + tid; s < pst[e + 1]; s += 512) { P_TOKOF[s] = 0; P_GATEOF[s] = 0.f; P_RSTDOF[s] = 0.f; } }
            __syncthreads();
        }
        SEAM(P + 7);
        if (IN(P + 8)) for (int rep_ = 0; rep_ < ((l == 0 || 8 != 5) ? NREP(8) : 1); ++rep_) {
            unsigned ldsb_ = (unsigned)(uintptr_t)lds0; asm volatile("" : "+s"(ldsb_)); LAS unsigned char* lds = (LAS unsigned char*)(uintptr_t)ldsb_; volatile LAS unsigned* MISC = (volatile LAS unsigned*)(lds + MISC_OFF); volatile LAS unsigned long long* ARGP = (volatile LAS unsigned long long*)(lds + MISC_OFF + 768); (void)MISC; int wave = wave0, G = G0, bx = bx0; asm volatile("" : "+s"(G), "+s"(bx), "+s"(wave)); const int lane = (int)__builtin_amdgcn_mbcnt_hi(~0u, __builtin_amdgcn_mbcnt_lo(~0u, 0u)); const int tid = wave * 64 + lane; const int vcu = (bx % 8) * (G / 8) + bx / 8; const int gw = vcu * 8 + wave, NGW = G * 8; (void)lane; (void)gw; (void)NGW; (void)vcu;
            GAS unsigned char* ws = (GAS unsigned char*)LDP(22); GAS float* out = (GAS float*)LDP(21); const GAS float* x_in = (const GAS float*)ARGIN(0); (void)out; (void)x_in; (void)ws;
            volatile LAS int* TS = (volatile LAS int*)(MISC + 128);
            if (tid <= 32) TS[tid] = P_TSTART[tid];
            __syncthreads();
            MoeOrder S{G, vcu, TS, (const GAS char*)P_XN, (const GAS char*)P_WGU, 0, (size_t)1024 * 1024, (size_t)256 * 1024};
            EpiGU E{(GAS unsigned char*)P_HH, P_RSTDOF};
            pg8::gemm_phase<EpiGU, MoeOrder, true, true, true>(tid, lds, DM, DM, DM, S, E, P_TOKOF);
        }
        SEAM(P + 8);
        if (IN(P + 9)) for (int rep_ = 0; rep_ < ((l == 0 || 9 != 5) ? NREP(9) : 1); ++rep_) {
            unsigned ldsb_ = (unsigned)(uintptr_t)lds0; asm volatile("" : "+s"(ldsb_)); LAS unsigned char* lds = (LAS unsigned char*)(uintptr_t)ldsb_; volatile LAS unsigned* MISC = (volatile LAS unsigned*)(lds + MISC_OFF); volatile LAS unsigned long long* ARGP = (volatile LAS unsigned long long*)(lds + MISC_OFF + 768); (void)MISC; int wave = wave0, G = G0, bx = bx0; asm volatile("" : "+s"(G), "+s"(bx), "+s"(wave)); const int lane = (int)__builtin_amdgcn_mbcnt_hi(~0u, __builtin_amdgcn_mbcnt_lo(~0u, 0u)); const int tid = wave * 64 + lane; const int vcu = (bx % 8) * (G / 8) + bx / 8; const int gw = vcu * 8 + wave, NGW = G * 8; (void)lane; (void)gw; (void)NGW; (void)vcu;
            GAS unsigned char* ws = (GAS unsigned char*)LDP(22); GAS float* out = (GAS float*)LDP(21); const GAS float* x_in = (const GAS float*)ARGIN(0); (void)out; (void)x_in; (void)ws;
            volatile LAS int* TS = (volatile LAS int*)(MISC + 128);
            if (tid <= 32) TS[tid] = P_TSTART[tid];
            __syncthreads();
            MoeOrder S{G, vcu, TS, (const GAS char*)P_HH, (const GAS char*)P_WD, (size_t)256 * 512, (size_t)1024 * 512, (size_t)256 * 512};
            EpiDown E{(GAS unsigned char*)P_Y, P_GATEOF};
            pg8::gemm_phase<EpiDown, MoeOrder, true, false, true>(tid, lds, DEXP, DEXP, DEXP, S, E, nullptr);
        }
        SEAM(P + 9);
}

__global__ void __launch_bounds__(512, 2) fwd(Args args) {
    extern __shared__ __attribute__((aligned(16))) unsigned char lds_raw[];
    LAS unsigned char* lds0 = (LAS unsigned char*)lds_raw;
    const int tid0 = threadIdx.x; const int wave0 = __builtin_amdgcn_readfirstlane(tid0 >> 6);
    const int G0 = gridDim.x; const int bx0 = blockIdx.x;
    { volatile LAS unsigned* MISC = (volatile LAS unsigned*)(lds0 + MISC_OFF); const int tid = tid0;
    for (int u = tid; u < 256; u += 512) MISC[u] = 0u;
    __syncthreads();
    volatile LAS unsigned long long* ARGP = (volatile LAS unsigned long long*)(lds0 + MISC_OFF + 768);
    if (tid < 21) ARGP[tid] = (unsigned long long)args.in[tid];
    if (tid == 21) ARGP[21] = (unsigned long long)args.out;
    if (tid == 22) ARGP[22] = (unsigned long long)args.ws;
    __syncthreads(); }
#if MK_ONE_LAUNCH
    XcdBarrier bar = xcd_barrier_post((unsigned*)(args.ws + WS_CTL) + CW_BAR, (volatile LAS unsigned*)(lds0 + MISC_OFF) + 8);
#else
    XcdBarrier bar; bar.bar = nullptr; bar.x = 0; bar.st = nullptr;
#endif
    const int lo = args.ph_lo, hi_ = args.ph_hi;
    if (IN(0)) {
        const GAS int* positions = (const GAS int*)args.in[1]; GAS float* COSp = (GAS float*)(args.ws + WS_COS); GAS float* SINp = (GAS float*)(args.ws + WS_SIN);
        for (int i = bx0 * 512 + tid0; i < NTOK * 16; i += G0 * 512) { const int tk = i >> 4, fi = i & 15;
            const double inv = exp2(-(double)fi * (13.287712379549449 / 16.0)); const double ang = (double)positions[tk] * inv;
            COSp[i] = (float)cos(ang); SINp[i] = (float)sin(ang); }
    }
    layer_body<0>(lo, hi_, lds0, wave0, G0, bx0, bar);
    layer_body<1>(lo, hi_, lds0, wave0, G0, bx0, bar);
    layer_body<2>(lo, hi_, lds0, wave0, G0, bx0, bar);
}

extern "C" void kernel_launch(void* const* d_in, const int* in_sizes, int n_in, void* d_out, int out_size, void* d_ws, size_t ws_size, hipStream_t stream) {
    static int grid = 0;
    if (grid == 0) {
        if (n_in != 21 || out_size != NTOK * DM || ws_size < WS_END) { fprintf(stderr, "kernel_launch: unexpected shapes (n_in %d out %d ws %zu)\n", n_in, out_size, ws_size); grid = -1; return; }
        int dev = 0, cus = 0;
        if (hipGetDevice(&dev) != hipSuccess || hipDeviceGetAttribute(&cus, hipDeviceAttributeMultiprocessorCount, dev) != hipSuccess) { grid = -1; return; }
        if (hipFuncSetAttribute((const void*)fwd, hipFuncAttributeMaxDynamicSharedMemorySize, LDS_BYTES) != hipSuccess) { fprintf(stderr, "kernel_launch: hipFuncSetAttribute failed\n"); grid = -1; return; }
        int per_cu = 0;
        if (hipOccupancyMaxActiveBlocksPerMultiprocessor(&per_cu, (const void*)fwd, 512, LDS_BYTES) != hipSuccess || per_cu < 1) fprintf(stderr, "kernel_launch: occupancy query says %d\n", per_cu);
        (void)hipGetLastError();
        grid = cus;
        if (grid != 256) { fprintf(stderr, "kernel_launch: built for 256 CUs, got %d\n", grid); grid = -1; return; }
    }
    if (grid < 0) return;
    if (hipMemsetAsync((char*)d_ws + WS_CTL, 0, CTL_ZERO_BYTES, stream) != hipSuccess) return;
    Args a{};
    for (int i = 0; i < 21; ++i) a.in[i] = d_in[i];
    a.out = (float*)d_out; a.ws = (unsigned char*)d_ws;
#if MK_ONE_LAUNCH
    a.ph_lo = 0; a.ph_hi = 21;
    hipLaunchKernelGGL(fwd, dim3(grid), dim3(512), LDS_BYTES, stream, a);
#else
    for (int p = 0; p <= 20; ++p) { a.ph_lo = p; a.ph_hi = p + 1; hipLaunchKernelGGL(fwd, dim3(grid), dim3(512), LDS_BYTES, stream, a); }
#endif
}
```

```cpp
#include <hip/hip_runtime.h>
#include <cstdio>
#include <cstdint>

#ifndef PROBE_PHASE
#define PROBE_PHASE -1
#endif
#define NREP(k) ((PROBE_PHASE) == (k) ? 2 : 1)
#ifndef MK_ONE_LAUNCH
#define MK_ONE_LAUNCH 1
#endif

#define LAS __attribute__((address_space(3)))
#define GAS __attribute__((address_space(1)))
typedef unsigned short bf16;
typedef short bf16x8 __attribute__((ext_vector_type(8)));
typedef short s16x4 __attribute__((ext_vector_type(4)));
typedef float f32x4 __attribute__((ext_vector_type(4)));
typedef float f32x2 __attribute__((ext_vector_type(2)));
typedef float f32x16 __attribute__((ext_vector_type(16)));
typedef unsigned u32x4 __attribute__((ext_vector_type(4)));
typedef unsigned u32x2 __attribute__((ext_vector_type(2)));

constexpr int NB = 16, SEQ = 2048, DM = 1024, NTOK = NB * SEQ, NLAYER = 2;
constexpr int INW = 1960, INP = 2048;
constexpr int NEXP = 32, DEXP = 512;
constexpr int MAXSLOT = 73728;
constexpr float EPS = 1e-6f;
constexpr float WSCALE = 64.f, WSCALE_INV = 1.f / 64.f;
constexpr float LOG2E = 1.4426950408889634f;
constexpr float C2F = 0.125f * LOG2E;
constexpr float C2M = 0.10206207261596575f * LOG2E;

constexpr size_t MiB = 1u << 20, KiB = 1u << 10;
constexpr size_t WS_CTL = 0, CTL_ZERO_BYTES = 64 * KiB;
constexpr size_t WS_COS = 1 * MiB, WS_SIN = 3 * MiB;
constexpr size_t WS_SSQ = 5 * MiB;
constexpr size_t WS_FLOG = 6 * MiB;
constexpr size_t WS_E01 = 8 * MiB;
constexpr size_t WS_G01 = 8 * MiB + 256 * KiB;
constexpr size_t WS_SLOT = 8 * MiB + 512 * KiB;
constexpr size_t WS_TOKOF = 8 * MiB + 768 * KiB;
constexpr size_t WS_GATEOF = 9 * MiB + 256 * KiB;
constexpr size_t WS_CNT = 9 * MiB + 768 * KiB;
constexpr size_t WS_TSTART = 9 * MiB + 800 * KiB;
constexpr size_t WS_RSTD = 9 * MiB + 832 * KiB;
constexpr size_t WS_RSTDOF = 7 * MiB;
constexpr size_t WS_KPE = 10 * MiB;
constexpr size_t WS_KAUG = 10 * MiB + 2 * MiB;
constexpr size_t WS_WIN = 16 * MiB;
constexpr size_t WS_WUQ = 20 * MiB;
constexpr size_t WS_WUKV = 20 * MiB + 512 * KiB;
constexpr size_t WS_WOUT = 21 * MiB;
constexpr size_t WS_WGU = 24 * MiB;
constexpr size_t WS_WD = 88 * MiB;
constexpr size_t WS_XN = 120 * MiB;
constexpr size_t WS_FQKV = 184 * MiB;
constexpr size_t WS_LAT = 280 * MiB;
constexpr size_t WS_QM = 312 * MiB;
constexpr size_t WS_KVM = 360 * MiB;
constexpr size_t WS_Y = 280 * MiB;
constexpr size_t WS_BIASF = 424 * MiB;
constexpr size_t WS_NRM = 425 * MiB;
constexpr size_t WS_WR = 426 * MiB;
constexpr size_t WS_XR = 427 * MiB;
constexpr size_t WS_OSS = 491 * MiB;
constexpr size_t WS_RSTDX = 493 * MiB;
constexpr size_t WS_END = 494 * MiB;
static_assert(WS_Y + (size_t)MAXSLOT * 1024 * 2 <= WS_END, "Y fits");
static_assert(WS_FQKV + (size_t)MAXSLOT * 512 * 2 <= WS_LAT, "HH fits");

constexpr int CW_BAR = 1024;

constexpr int RING_BYTES = 147456;
constexpr int MISC_OFF = RING_BYTES;
constexpr int LDS_BYTES = RING_BYTES + 1024;

typedef __bf16 bf16x2_t __attribute__((ext_vector_type(2)));
__device__ __forceinline__ unsigned cvt_pk_bf16(float lo, float hi) { const f32x2 v = {lo, hi}; const bf16x2_t b = __builtin_convertvector(v, bf16x2_t); return __builtin_bit_cast(unsigned, b); }
__device__ __forceinline__ float bf2f(unsigned short b) { return __uint_as_float((unsigned)b << 16); }
__device__ __forceinline__ float wave_sum(float v) {
#pragma unroll
    for (int o = 1; o < 64; o <<= 1) v += __shfl_xor(v, o);
    return v;
}
__device__ __forceinline__ unsigned pk4_fp8(float a, float b, float c, float d) { int w = 0; w = __builtin_amdgcn_cvt_pk_fp8_f32(a, b, w, false); w = __builtin_amdgcn_cvt_pk_fp8_f32(c, d, w, true); return (unsigned)w; }
#define LDS_WAIT() asm volatile("s_waitcnt lgkmcnt(0)" ::: "memory")

#define XB_TMO      128
#define XB_XCNT(j)  (256  + 64 * (j))
#define XB_XSUB(j)  (1280 + 64 * (j))
#define XB_XGEN(j)  (2304 + 64 * (j))
#define XB_TOP      3328
#define XB_TOPGEN   3392
#define XCD_BAR_WORDS 3456
#define XB_SPIN_CAP (1u << 18)
__device__ __forceinline__ unsigned xb_ld(unsigned* p)              { return __hip_atomic_load(p, __ATOMIC_RELAXED, __HIP_MEMORY_SCOPE_AGENT); }
__device__ __forceinline__ unsigned xb_add(unsigned* p, unsigned v) { return __hip_atomic_fetch_add(p, v, __ATOMIC_RELAXED, __HIP_MEMORY_SCOPE_AGENT); }
__device__ __forceinline__ unsigned xb_xcc_id() { return (unsigned)__builtin_amdgcn_s_getreg((3 << 11) | 20) & 0xFu; }
#define XB_SPIN(cond, bar) do { unsigned _sp = 0; while (cond) { __builtin_amdgcn_s_sleep(1); \
    if ((++_sp & 255u) == 0u) { if (xb_ld(&(bar)[XB_TMO])) break; if (_sp > XB_SPIN_CAP) { atomicAdd(&(bar)[XB_TMO], 1u); break; } } } } while (0)
struct XcdBarrier { unsigned* bar; unsigned x; volatile LAS unsigned* st; };
__device__ __forceinline__ XcdBarrier xcd_barrier_post(unsigned* bar, volatile LAS unsigned* st) {
    XcdBarrier b; b.bar = bar; b.x = xb_xcc_id(); b.st = st;
    if (threadIdx.x == 0) (void)xb_add(&bar[XB_XCNT(b.x)], 1u);
    return b;
}
__device__ __forceinline__ void xcd_barrier_complete(unsigned* bar, unsigned x, unsigned& nloc, unsigned& nx) {
    const unsigned G = gridDim.x * gridDim.y * gridDim.z;
    unsigned sum, cnt, mine, sp = 0u;
    for (;;) {
        sum = 0u; cnt = 0u; mine = 0u;
#pragma unroll
        for (unsigned j = 0; j < 16; ++j) { const unsigned c = xb_ld(&bar[XB_XCNT(j)]); sum += c; cnt += (c > 0u) ? 1u : 0u; mine = (j == x) ? c : mine; }
        if (sum == G) break;
        __builtin_amdgcn_s_sleep(1);
        if ((++sp & 255u) == 0u) { if (xb_ld(&bar[XB_TMO])) break; if (sp > XB_SPIN_CAP) { atomicAdd(&bar[XB_TMO], 1u); break; } }
    }
    nloc = mine > 0u ? mine : 1u; nx = cnt > 0u ? cnt : 1u;
}
__device__ __forceinline__ void xcd_barrier(const XcdBarrier& b) {
    asm volatile("s_waitcnt vmcnt(0)" ::: "memory");
    __syncthreads();
    if (threadIdx.x == 0) {
        unsigned* bar = b.bar;
        __builtin_amdgcn_s_waitcnt(0);
        unsigned nloc = b.st[0], nx = b.st[1];
        if (nloc == 0u) { xcd_barrier_complete(bar, b.x, nloc, nx); b.st[0] = nloc; b.st[1] = nx; }
        const unsigned old = xb_add(&bar[XB_XSUB(b.x)], 1u);
        const unsigned gen = old / nloc;
        if (old + 1u == (gen + 1u) * nloc) {
            __builtin_amdgcn_fence(__ATOMIC_RELEASE, "agent");
            asm volatile("s_waitcnt vmcnt(0)" ::: "memory");
            const unsigned og = xb_add(&bar[XB_TOP], 1u);
            const unsigned tg = og / nx;
            if (og + 1u == (tg + 1u) * nx) xb_add(&bar[XB_TOPGEN], 1u);
            else XB_SPIN(xb_ld(&bar[XB_TOPGEN]) == tg, bar);
            __builtin_amdgcn_fence(__ATOMIC_ACQUIRE, "agent");
            xb_add(&bar[XB_XGEN(b.x)], 1u);
            asm volatile("s_waitcnt vmcnt(0)" ::: "memory");
        } else {
            XB_SPIN(xb_ld(&bar[XB_XGEN(b.x)]) == gen, bar);
            __builtin_amdgcn_fence(__ATOMIC_ACQUIRE, "agent");
            asm volatile("s_waitcnt vmcnt(0)" ::: "memory");
        }
    }
    __syncthreads();
}

namespace pg8 {
constexpr int BM = 256, BK = 64, HALF = 128, HTB = HALF * BK * 2, STAGE_BYTES = 8 * HTB;
typedef int v4i32_t __attribute__((ext_vector_type(4)));
typedef int v8i32_t __attribute__((ext_vector_type(8)));
__host__ __device__ __forceinline__ int lds_byte(int r, int c) { const int st = (r >> 4) * 2 + (c >> 5), rr = r & 15, cc = c & 31, ob = rr * 64 + cc * 2; return st * 1024 + (ob ^ (((ob >> 9) & 1) << 5)); }
__host__ __device__ __forceinline__ void stage_rc(int b, int& R, int& C) { const int st = b / 1024, sb = b % 1024, swz = sb ^ (((sb >> 9) & 1) << 5); R = (st >> 1) * 16 + swz / 64; C = (st & 1) * 32 + (swz % 64) / 2; }
__host__ __device__ __forceinline__ int perm32(int rho) { const int n = rho >> 4, i = rho & 15; return 8 * (i >> 2) + 4 * n + (i & 3); }

struct Unit { const GAS char* a; const GAS char* b; int pm, pn, e; };

template <int N> __device__ __forceinline__ void wait_vm() { asm volatile("s_waitcnt vmcnt(%0)" :: "n"(N) : "memory"); }
template <class Epi, class Sched, bool ALIGN_EPI, bool GATHER, bool FP8 = false, bool MIDSCALE = false>
__device__ __forceinline__ void gemm_phase(const int tid, LAS unsigned char* lds, const int Kb, const int ldaB, const int ldbB, const Sched& S, const Epi& E, const GAS int* __restrict__ tokof, const LAS f32x2* scl = nullptr) {
    const int wid = __builtin_amdgcn_readfirstlane(tid >> 6), lane = tid & 63, wr = wid >> 2, wc = wid & 3, fr = lane & 15, fq = lane >> 4;
    const int nt = Kb / 128;
    unsigned voffA[2], voffB[2]; int RA[2], CA2[2];
#pragma unroll
    for (int i = 0; i < 2; ++i) { int R, C; stage_rc(tid * 16 + i * 8192, R, C); const int Rb = Epi::PERM ? ((R & ~31) + perm32(R & 31)) : R;
        voffA[i] = (unsigned)(R * ldaB + C * 2); voffB[i] = (unsigned)(Rb * ldbB + C * 2); RA[i] = R; CA2[i] = C * 2; }
    const size_t kstep = (size_t)(BK * 2);
    const size_t hstepA = GATHER ? 0 : (size_t)HALF * ldaB;
    const size_t hstepB = (size_t)HALF * ldbB;
    const unsigned ldsw = (unsigned)wid * 1024u;
    const int aoff = lds_byte(wr * 64 + fr, fq * 8), boff = lds_byte(wc * 32 + fr, fq * 8);
    unsigned gcur[2][2], gnxt[2][2];
    const int scl8 = 0x7F7F7F7F;
#define PG8_SA(b, h) (((b) * 2 + (h)) * HTB)
#define PG8_SB(b, h) ((4 + (b) * 2 + (h)) * HTB)
#define PG8_STAGE(bufoff, gbase, voff) do { const unsigned long long gb_ = (unsigned long long)(gbase); const unsigned lbase_ = (unsigned)__builtin_amdgcn_readfirstlane((int)((unsigned)(uintptr_t)lds + (unsigned)(bufoff) + ldsw)); \
        _Pragma("unroll") for (int _i = 0; _i < 2; ++_i) { unsigned keep_; \
            asm volatile("s_mov_b32 %0, m0\n\ts_mov_b32 m0, %3\n\ts_nop 0\n\tglobal_load_lds_dwordx4 %1, %2\n\ts_mov_b32 m0, %0" : "=&s"(keep_) : "v"((voff)[_i]), "s"(gb_), "s"(lbase_ + (unsigned)(_i * 8192)) : "memory"); } } while (0)
#define PG8_STAGE_A(bufoff, base, h, nx) do { if constexpr (GATHER) { unsigned _v[2]; _v[0] = (nx) ? gnxt[h][0] : gcur[h][0]; _v[1] = (nx) ? gnxt[h][1] : gcur[h][1]; PG8_STAGE(bufoff, base, _v); } \
        else { PG8_STAGE(bufoff, (base) + (h) * hstepA, voffA); } } while (0)
#define PG8_LDA(dst, b, h) do { _Pragma("unroll") for (int m = 0; m < 4; ++m) _Pragma("unroll") for (int k = 0; k < 2; ++k) dst[m][k] = *(const LAS bf16x8*)(lds + PG8_SA(b, h) + aoff + m * 2048 + k * 1024); } while (0)
#define PG8_LDB(dst, b, h) do { _Pragma("unroll") for (int n = 0; n < 2; ++n) _Pragma("unroll") for (int k = 0; k < 2; ++k) dst[n][k] = *(const LAS bf16x8*)(lds + PG8_SB(b, h) + boff + n * 2048 + k * 1024); } while (0)
#define PG8_MMA(ai, bj, At, Bt) do { __builtin_amdgcn_s_setprio(1); if constexpr (FP8) { _Pragma("unroll") for (int m = 0; m < 4; ++m) _Pragma("unroll") for (int n = 0; n < 2; ++n) { \
        const v8i32_t b8_ = __builtin_shufflevector(__builtin_bit_cast(v4i32_t, Bt[n][0]), __builtin_bit_cast(v4i32_t, Bt[n][1]), 0, 1, 2, 3, 4, 5, 6, 7), a8_ = __builtin_shufflevector(__builtin_bit_cast(v4i32_t, At[m][0]), __builtin_bit_cast(v4i32_t, At[m][1]), 0, 1, 2, 3, 4, 5, 6, 7); \
        asm volatile("s_nop 1\n\tv_mfma_scale_f32_16x16x128_f8f6f4 %0, %1, %2, %0, %3, %3 op_sel_hi:[0,0,0]" : "+v"(acc[ai][bj][m][n]) : "v"(b8_), "v"(a8_), "v"(scl8)); } } \
      else { _Pragma("unroll") for (int m = 0; m < 4; ++m) _Pragma("unroll") for (int n = 0; n < 2; ++n) _Pragma("unroll") for (int k = 0; k < 2; ++k) \
        acc[ai][bj][m][n] = __builtin_amdgcn_mfma_f32_16x16x32_bf16(Bt[n][k], At[m][k], acc[ai][bj][m][n], 0, 0, 0); } __builtin_amdgcn_s_setprio(0); } while (0)
#define PG8_WAIT_V(n) asm volatile("s_waitcnt vmcnt(" #n ")" ::: "memory")
#define PG8_WAIT_L(n) asm volatile("s_waitcnt lgkmcnt(" #n ")" ::: "memory")
#define PG8_BAR __builtin_amdgcn_s_barrier()
#define PG8_SCHED __builtin_amdgcn_sched_barrier(0)
#define PG8_GLOAD(dst, u) do { if constexpr (GATHER) { _Pragma("unroll") for (int _h = 0; _h < 2; ++_h) _Pragma("unroll") for (int _i = 0; _i < 2; ++_i) \
        dst[_h][_i] = (unsigned)tokof[(u).pm * BM + _h * HALF + RA[_i]] * (unsigned)ldaB + (unsigned)CA2[_i]; } } while (0)
    Unit cur, nxt; int ui = 0;
    if (!S.next(0, cur)) return;
    PG8_GLOAD(gcur, cur);
    f32x4 acc[2][2][4][2];
#pragma unroll
    for (int a = 0; a < 2; ++a)
#pragma unroll
        for (int b = 0; b < 2; ++b)
#pragma unroll
            for (int m = 0; m < 4; ++m)
#pragma unroll
                for (int n = 0; n < 2; ++n) acc[a][b][m][n] = (f32x4){0.f, 0.f, 0.f, 0.f};
    bf16x8 At[4][2], B0[2][2], B1[2][2];
    const GAS char* cA = cur.a; const GAS char* cB = cur.b;
    PG8_STAGE(PG8_SB(0, 0), cB, voffB); PG8_STAGE(PG8_SB(0, 1), cB + hstepB, voffB); PG8_STAGE_A(PG8_SA(0, 0), cA, 0, false); PG8_STAGE_A(PG8_SA(0, 1), cA, 1, false);
    if (wr == 1) PG8_BAR;
    PG8_WAIT_V(2); PG8_BAR;
    PG8_STAGE(PG8_SB(1, 0), cB + kstep, voffB); PG8_STAGE_A(PG8_SA(1, 0), cA + kstep, 0, false); PG8_STAGE(PG8_SB(1, 1), cB + hstepB + kstep, voffB);
    PG8_WAIT_V(6); PG8_BAR;
    bool fresh = false;
    for (;;) {
        const bool has_next = S.next(ui + 1, nxt);
        if constexpr (GATHER) { if (has_next) { PG8_GLOAD(gnxt, nxt); } else { _Pragma("unroll") for (int _h = 0; _h < 2; ++_h) _Pragma("unroll") for (int _i = 0; _i < 2; ++_i) gnxt[_h][_i] = gcur[_h][_i]; } }
        const GAS char* nA = has_next ? nxt.a : cA; const GAS char* nB = has_next ? nxt.b : cB;
#pragma nounroll
        for (int t = 0; t < nt; t += 2) {
            const bool last = (t == nt - 2);
            const GAS char* a1 = cA + (size_t)(t + 1) * kstep;
            const GAS char* a2 = last ? nA : cA + (size_t)(t + 2) * kstep; const GAS char* b2 = last ? nB : cB + (size_t)(t + 2) * kstep;
            const GAS char* a3 = a2 + kstep; const GAS char* b3 = b2 + kstep;
            const bool fe = fresh; fresh = false;
            if constexpr (MIDSCALE) { if (t == nt / 2) {
#pragma unroll
                for (int ai = 0; ai < 2; ++ai)
#pragma unroll
                    for (int m = 0; m < 4; ++m) { const float r_ = scl[ui * 256 + ai * 128 + wr * 64 + m * 16 + fr][0];
#pragma unroll
                        for (int bj = 0; bj < 2; ++bj)
#pragma unroll
                            for (int n = 0; n < 2; ++n) acc[ai][bj][m][n] *= r_; } } }
            PG8_LDB(B0, 0, 0); PG8_LDB(B1, 0, 1); PG8_SCHED; PG8_LDA(At, 0, 0); PG8_STAGE_A(PG8_SA(1, 1), a1, 1, false);
            if (fe) wait_vm<8 + Epi::NST>(); else PG8_WAIT_V(8); PG8_WAIT_L(0); PG8_BAR; PG8_MMA(0, 0, At, B0); PG8_MMA(0, 1, At, B1); PG8_BAR; PG8_SCHED;
            PG8_LDA(At, 0, 1); PG8_STAGE(PG8_SB(0, 0), b2, voffB); PG8_STAGE(PG8_SB(0, 1), b2 + hstepB, voffB); PG8_STAGE_A(PG8_SA(0, 0), a2, 0, last);
            if (fe) wait_vm<8 + Epi::NST>(); else PG8_WAIT_V(8); PG8_WAIT_L(0); PG8_BAR; PG8_MMA(1, 0, At, B0); PG8_MMA(1, 1, At, B1); PG8_BAR; PG8_SCHED;
            PG8_LDB(B0, 1, 0); PG8_LDB(B1, 1, 1); PG8_SCHED; PG8_LDA(At, 1, 0); PG8_STAGE_A(PG8_SA(0, 1), a2, 1, last);
            PG8_WAIT_V(8); PG8_WAIT_L(0); PG8_BAR; PG8_MMA(0, 0, At, B0); PG8_MMA(0, 1, At, B1); PG8_BAR; PG8_SCHED;
            PG8_LDA(At, 1, 1); PG8_STAGE(PG8_SB(1, 0), b3, voffB); PG8_STAGE(PG8_SB(1, 1), b3 + hstepB, voffB); PG8_STAGE_A(PG8_SA(1, 0), a3, 0, last);
            PG8_WAIT_V(8); PG8_WAIT_L(0); PG8_BAR; PG8_MMA(1, 0, At, B0); PG8_MMA(1, 1, At, B1); PG8_BAR; PG8_SCHED;
        }
        if constexpr (ALIGN_EPI) { if (wr == 0) PG8_BAR; }
        if constexpr (FP8) { asm volatile("s_nop 15\n\ts_nop 15" ::: "memory"); }
        if constexpr (MIDSCALE) E(acc, cur, wr, wc, fr, fq, scl + ui * 256); else E(acc, cur, wr, wc, fr, fq);
        if (!has_next) break;
#pragma unroll
        for (int a = 0; a < 2; ++a)
#pragma unroll
            for (int b = 0; b < 2; ++b)
#pragma unroll
                for (int m = 0; m < 4; ++m)
#pragma unroll
                    for (int n = 0; n < 2; ++n) acc[a][b][m][n] = (f32x4){0.f, 0.f, 0.f, 0.f};
        cur = nxt; cA = nA; cB = nB; ++ui; fresh = true;
        if constexpr (GATHER) { _Pragma("unroll") for (int _h = 0; _h < 2; ++_h) _Pragma("unroll") for (int _i = 0; _i < 2; ++_i) gcur[_h][_i] = gnxt[_h][_i]; }
        if constexpr (ALIGN_EPI) { if (wr == 1) PG8_BAR; }
    }
    PG8_WAIT_V(0);
    if constexpr (!ALIGN_EPI) { if (wr == 0) PG8_BAR; }
    PG8_BAR;
#undef PG8_SA
#undef PG8_SB
#undef PG8_STAGE
#undef PG8_STAGE_A
#undef PG8_LDA
#undef PG8_LDB
#undef PG8_MMA
#undef PG8_WAIT_V
#undef PG8_WAIT_L
#undef PG8_BAR
#undef PG8_SCHED
#undef PG8_GLOAD
}
}
using pg8::Unit;

struct DenseOrder {
    int nM, nN, nwg, G, c; const GAS char* A; const GAS char* B; size_t aT, bT;
    __device__ __forceinline__ bool next(int i, Unit& u) const {
        const long L = (long)i * G + c; if (L >= nwg) return false;
        int wgid = (int)L; { const int q = nwg / 8, r = nwg % 8, xcd = wgid % 8, off = wgid / 8; wgid = (xcd < r ? xcd * (q + 1) : r * (q + 1) + (xcd - r) * q) + off; }
        const int nig = 8 * nN, gid = wgid / nig, fm = gid * 8, gsz = (nM - fm) < 8 ? (nM - fm) : 8;
        u.pm = fm + ((wgid % nig) % gsz); u.pn = (wgid % nig) / gsz; u.e = 0;
        u.a = A + (size_t)u.pm * aT; u.b = B + (size_t)u.pn * bT; return true;
    }
};
struct UpOrder {
    int G, c; const GAS char* LATp; const GAS char* Wq; const GAS char* Wkv;
    __device__ __forceinline__ bool next(int i, Unit& u) const {
        const int L = i * G + c; if (L >= 128 * 7) return false;
        u.pm = L / 7; const int j = L % 7; const bool kv = j >= 3; u.pn = kv ? j - 3 : j; u.e = kv ? 1 : 0;
        u.a = LATp + (size_t)u.pm * 256 * 512 * 2 + (kv ? 512 : 0);
        u.b = (kv ? Wkv : Wq) + (size_t)u.pn * 256 * 256 * 2; return true;
    }
};
struct MoeOrder {
    int G, c; const volatile LAS int* TS; const GAS char* A; const GAS char* W; size_t aT  , wE  , wT  ;
    __device__ __forceinline__ bool next(int i, Unit& u) const {
        const int L = i * G + c; const int ntile = __builtin_amdgcn_readfirstlane(TS[32]); if (L >= ntile * 4) return false;
        const int rt = L >> 2, ct = L & 3; int e = 0;
        for (int j = 1; j < 32; ++j) e += (TS[j] <= rt) ? 1 : 0;
        e = __builtin_amdgcn_readfirstlane(e);
        u.pm = rt; u.pn = ct; u.e = e; u.a = A + (size_t)rt * aT; u.b = W + (size_t)e * wE + (size_t)ct * wT; return true;
    }
};

__device__ __forceinline__ u32x4 pack8(f32x4 v0, f32x4 v1) { u32x4 w; w.x = cvt_pk_bf16(v0[0], v0[1]); w.y = cvt_pk_bf16(v0[2], v0[3]); w.z = cvt_pk_bf16(v1[0], v1[1]); w.w = cvt_pk_bf16(v1[2], v1[3]); return w; }

struct EpiWin {
    static constexpr int NST = 16;
    static constexpr bool PERM = true;
    GAS bf16* LAT_; GAS bf16* FQKV_; GAS bf16* KPE_; GAS float* FLOG_; GAS float* SSQ_; const GAS float* COS_; const GAS float* SIN_; const GAS float* RSX_;
    __device__ __forceinline__ void operator()(f32x4 (&acc)[2][2][4][2], const Unit& u, int wr, int wc, int fr, int fq) const {
        GAS bf16* LAT = LAT_; GAS bf16* FQKV = FQKV_; GAS bf16* KPE = KPE_; GAS float* FLOG = FLOG_; GAS float* SSQ = SSQ_; const GAS float* COS = COS_; const GAS float* SIN = SIN_; const GAS float* RSX = RSX_;
        asm volatile("" : "+s"(LAT), "+s"(FQKV), "+s"(KPE), "+s"(FLOG), "+s"(SSQ), "+s"(COS), "+s"(SIN), "+s"(RSX));
        {
#pragma unroll
            for (int ai = 0; ai < 2; ++ai)
#pragma unroll
                for (int m = 0; m < 4; ++m) { const float rs_ = RSX[u.pm * 256 + ai * 128 + wr * 64 + m * 16 + fr];
#pragma unroll
                    for (int bj = 0; bj < 2; ++bj)
#pragma unroll
                        for (int n = 0; n < 2; ++n) acc[ai][bj][m][n] *= rs_; } }
        const int row0 = u.pm * 256 + wr * 64 + fr; const int pn = u.pn;
        if (pn >= 2) {
            const int ti = pn >> 1; GAS bf16* dst = FQKV + (size_t)(ti - 1) * NTOK * 512; const int colb = (pn & 1) * 256 + wc * 32 + 8 * fq; const float sc = (ti == 1) ? C2F : 1.f;
#pragma unroll
            for (int ai = 0; ai < 2; ++ai)
#pragma unroll
                for (int m = 0; m < 4; ++m) { GAS bf16* rowp = dst + (size_t)(row0 + ai * 128 + m * 16) * 512 + colb;
#pragma unroll
                    for (int bj = 0; bj < 2; ++bj) *(GAS u32x4*)(rowp + bj * 128) = pack8(acc[ai][bj][m][0] * sc, acc[ai][bj][m][1] * sc); }
        } else {
#pragma unroll
            for (int ai = 0; ai < 2; ++ai)
#pragma unroll
                for (int m = 0; m < 4; ++m) { const int row = row0 + ai * 128 + m * 16; GAS bf16* rowp = LAT + (size_t)row * 512 + pn * 256 + wc * 32 + 8 * fq;
#pragma unroll
                    for (int bj = 0; bj < 2; ++bj) *(GAS u32x4*)(rowp + bj * 128) = pack8(acc[ai][bj][m][0], acc[ai][bj][m][1]);
                    float s = 0.f;
#pragma unroll
                    for (int n = 0; n < 2; ++n) { const f32x4 x = acc[ai][0][m][n]; s += (x[0] * x[0] + x[1] * x[1]) + (x[2] * x[2] + x[3] * x[3]); }
                    if (pn == 0) {
#pragma unroll
                        for (int n = 0; n < 2; ++n) { const f32x4 x = acc[ai][1][m][n]; s += (x[0] * x[0] + x[1] * x[1]) + (x[2] * x[2] + x[3] * x[3]); }
                    }
                    s += __shfl_xor(s, 16); s += __shfl_xor(s, 32);
                    if (fq == 0) SSQ[(size_t)row * 8 + pn * 4 + wc] = s;
                    }
            if (pn == 1 && wc == 0) {
#pragma unroll
                for (int ai = 0; ai < 2; ++ai)
#pragma unroll
                    for (int m = 0; m < 4; ++m) { const int row = row0 + ai * 128 + m * 16;
                        const f32x4 c = *(const GAS f32x4*)(COS + (size_t)row * 16 + 4 * fq), sn = *(const GAS f32x4*)(SIN + (size_t)row * 16 + 4 * fq);
                        const f32x4 x1 = acc[ai][1][m][0], x2 = acc[ai][1][m][1];
                        *(GAS u32x4*)(KPE + (size_t)row * 32 + 8 * fq) = pack8(x1 * c - x2 * sn, x1 * sn + x2 * c);
                        }
            }
            if (pn == 1 && wc == 1 && fq == 0) {
#pragma unroll
                for (int ai = 0; ai < 2; ++ai)
#pragma unroll
                    for (int m = 0; m < 4; ++m) { const int row = row0 + ai * 128 + m * 16; *(GAS f32x4*)(FLOG + (size_t)row * 8) = acc[ai][1][m][0]; *(GAS f32x4*)(FLOG + (size_t)row * 8 + 4) = acc[ai][1][m][1]; }
            }
        }
    }
};
struct EpiUp {
    static constexpr int NST = 16;
    static constexpr bool PERM = true;
    GAS bf16* QM_; GAS bf16* KVM_; const GAS float* SSQ_; const GAS float* COS_; const GAS float* SIN_;
    __device__ __forceinline__ void operator()(const f32x4 (&acc)[2][2][4][2], const Unit& u, int wr, int wc, int fr, int fq) const {
        GAS bf16* QM = QM_; GAS bf16* KVM = KVM_; const GAS float* SSQ = SSQ_; const GAS float* COS = COS_; const GAS float* SIN = SIN_;
        asm volatile("" : "+s"(QM), "+s"(KVM), "+s"(SSQ), "+s"(COS), "+s"(SIN));
        const int row0 = u.pm * 256 + wr * 64 + fr; const int pn = u.pn; const bool kv = u.e != 0;
#pragma unroll
        for (int ai = 0; ai < 2; ++ai)
#pragma unroll
            for (int m = 0; m < 4; ++m) { const int row = row0 + ai * 128 + m * 16;
                const f32x4 sq = *(const GAS f32x4*)(SSQ + (size_t)row * 8 + (kv ? 4 : 0));
                const float ss = (sq[0] + sq[1]) + (sq[2] + sq[3]);
                if (kv) {
                    const float rs = rsqrtf(ss * (1.f / 128.f) + EPS);
                    GAS bf16* rowp = KVM + (size_t)row * 1024 + pn * 256 + wc * 32 + 8 * fq;
#pragma unroll
                    for (int bj = 0; bj < 2; ++bj) *(GAS u32x4*)(rowp + bj * 128) = pack8(acc[ai][bj][m][0] * rs, acc[ai][bj][m][1] * rs);
                } else {
                    const float rs = rsqrtf(ss * (1.f / 256.f) + EPS) * C2M;
                    GAS bf16* rowp = QM + (size_t)row * 768 + pn * 256 + wc * 32 + 8 * fq;
                    const f32x4 c = *(const GAS f32x4*)(COS + (size_t)row * 16 + 4 * fq), sn = *(const GAS f32x4*)(SIN + (size_t)row * 16 + 4 * fq);
#pragma unroll
                    for (int bj = 0; bj < 2; ++bj) { f32x4 v0 = acc[ai][bj][m][0] * rs, v1 = acc[ai][bj][m][1] * rs;
                        const int G = 8 * pn + 4 * bj + wc;
                        if (G % 3 == 2) { const f32x4 x1 = v0, x2 = v1; v0 = x1 * c - x2 * sn; v1 = x1 * sn + x2 * c; }
                        *(GAS u32x4*)(rowp + bj * 128) = pack8(v0, v1); }
                }

            }
    }
};
template <bool RES_F32> struct EpiOut {
    static constexpr int NST = 16;
    static constexpr bool PERM = true;
    const GAS float* resf_; GAS bf16* xr_;
    __device__ __forceinline__ void operator()(const f32x4 (&acc)[2][2][4][2], const Unit& u, int wr, int wc, int fr, int fq, const LAS f32x2* scl) const {
        const GAS float* resf = resf_; GAS bf16* xr = xr_; asm volatile("" : "+s"(resf), "+s"(xr));
        const int row0 = u.pm * 256 + wr * 64 + fr, col0 = u.pn * 256 + wc * 32 + 8 * fq;
#pragma unroll
        for (int ai = 0; ai < 2; ++ai)
#pragma unroll
            for (int m = 0; m < 4; ++m) { const size_t off = (size_t)(row0 + ai * 128 + m * 16) * DM + col0; const float sh = scl[ai * 128 + wr * 64 + m * 16 + fr][1];
#pragma unroll
                for (int bj = 0; bj < 2; ++bj) { f32x4 r0, r1;
                    if constexpr (RES_F32) { r0 = *(const GAS f32x4*)(resf + off + bj * 128); r1 = *(const GAS f32x4*)(resf + off + bj * 128 + 4); }
                    else { const u32x4 w = *(const GAS u32x4*)(xr + off + bj * 128);
                        r0 = (f32x4){__uint_as_float(w.x << 16), __uint_as_float(w.x & 0xffff0000u), __uint_as_float(w.y << 16), __uint_as_float(w.y & 0xffff0000u)};
                        r1 = (f32x4){__uint_as_float(w.z << 16), __uint_as_float(w.z & 0xffff0000u), __uint_as_float(w.w << 16), __uint_as_float(w.w & 0xffff0000u)}; }
                    *(GAS u32x4*)(xr + off + bj * 128) = pack8(r0 + acc[ai][bj][m][0] * sh, r1 + acc[ai][bj][m][1] * sh); } }
    }
};
struct EpiGU {
    static constexpr int NST = 8;
    static constexpr bool PERM = true;
    GAS unsigned char* HH_; const GAS float* RS_;
    __device__ __forceinline__ void operator()(const f32x4 (&acc)[2][2][4][2], const Unit& u, int wr, int wc, int fr, int fq) const {
        GAS unsigned char* HH = HH_; const GAS float* RS = RS_; asm volatile("" : "+s"(HH), "+s"(RS));
        const int row0 = u.pm * 256 + wr * 64 + fr;
#pragma unroll
        for (int ai = 0; ai < 2; ++ai)
#pragma unroll
            for (int m = 0; m < 4; ++m) { GAS unsigned char* rowp = HH + (size_t)(row0 + ai * 128 + m * 16) * 512 + u.pn * 128 + wc * 32 + 8 * fq; const float rs = RS[row0 + ai * 128 + m * 16] * WSCALE_INV;
                f32x4 h[2];
#pragma unroll
                for (int n = 0; n < 2; ++n) { const f32x4 g = acc[ai][0][m][n] * rs, up = acc[ai][1][m][n] * rs;
#pragma unroll
                    for (int j = 0; j < 4; ++j) { const float sg = __builtin_amdgcn_rcpf(1.f + __builtin_amdgcn_exp2f(-g[j] * LOG2E)); h[n][j] = g[j] * sg * up[j]; } }
                u32x2 w; w.x = pk4_fp8(h[0][0], h[0][1], h[0][2], h[0][3]); w.y = pk4_fp8(h[1][0], h[1][1], h[1][2], h[1][3]); *(GAS u32x2*)rowp = w; }
    }
};
struct EpiDown {
    static constexpr int NST = 16;
    static constexpr bool PERM = true;
    GAS unsigned char* Y_; const GAS float* GATEOF_;
    __device__ __forceinline__ void operator()(const f32x4 (&acc)[2][2][4][2], const Unit& u, int wr, int wc, int fr, int fq) const {
        GAS unsigned char* Y = Y_; const GAS float* GATEOF = GATEOF_; asm volatile("" : "+s"(Y), "+s"(GATEOF));
        const int row0 = u.pm * 256 + wr * 64 + fr;
#pragma unroll
        for (int ai = 0; ai < 2; ++ai)
#pragma unroll
            for (int m = 0; m < 4; ++m) { const int row = row0 + ai * 128 + m * 16; const float g = GATEOF[row]; GAS unsigned char* rowp = Y + (size_t)row * 1024 + u.pn * 256 + wc * 32 + 8 * fq;
#pragma unroll
                for (int bj = 0; bj < 2; ++bj) { const f32x4 v0 = acc[ai][bj][m][0] * g, v1 = acc[ai][bj][m][1] * g; u32x2 w; w.x = pk4_fp8(v0[0], v0[1], v0[2], v0[3]); w.y = pk4_fp8(v1[0], v1[1], v1[2], v1[3]); *(GAS u32x2*)(rowp + bj * 128) = w; } }
    }
};

namespace att {
constexpr int KSLOT = 12288, VSLOT = 8192;
constexpr int L_K = 0, L_V = 2 * KSLOT, L_BIAS = L_V + 2 * VSLOT, L_WS = L_BIAS + 8192, L_OST = L_WS + 8 * 64 * 4, L_END = L_OST + 8 * 4096;
__device__ __forceinline__ int crow(int r, int hi) { return (r & 3) + 8 * (r >> 2) + 4 * hi; }
typedef short v4i16_t __attribute__((ext_vector_type(4)));
__device__ __forceinline__ s16x4 vtr(const LAS char* p) { return __builtin_bit_cast(s16x4, __builtin_amdgcn_ds_read_tr16_b64_v4i16((LAS v4i16_t*)p)); }

constexpr int NSL = 5;
constexpr int R_K = 0, R_V = NSL * KSLOT, R_WS = R_V + NSL * VSLOT, R_OST = R_WS + 8 * 64 * 4, R_END = R_OST + 8 * 4096;
static_assert(R_END <= RING_BYTES, "attention LDS");
__device__ __forceinline__ void glds16(const GAS void* gsrc, unsigned lds_dst) { unsigned keep;
    asm volatile("s_mov_b32 %0, m0\n\ts_mov_b32 m0, %2\n\ts_nop 0\n\tglobal_load_lds_dwordx4 %1, off\n\ts_mov_b32 m0, %0" : "=&s"(keep) : "v"(gsrc), "s"(lds_dst) : "memory"); }
__device__ __forceinline__ void glds16s(const GAS void* sbase, unsigned voff, unsigned lds_dst) { unsigned keep;
    asm volatile("s_mov_b32 %0, m0\n\ts_mov_b32 m0, %3\n\ts_nop 0\n\tglobal_load_lds_dwordx4 %1, %2\n\ts_mov_b32 m0, %0" : "=&s"(keep) : "v"(voff), "s"((unsigned long long)sbase), "s"(lds_dst) : "memory"); }
struct Tens2 { const GAS bf16* Q; int qp; const GAS bf16* K; int kp; const GAS bf16* KX; const GAS bf16* V; int vp; GAS bf16* O; const GAS float* BIASF; const GAS float* NRM; GAS float* OSS; };
template <int MODE>
__device__ __forceinline__ int attn_unit2(const int wave_, int b, int h, int qb, const Tens2& T, LAS char* shm, const int slbase, const bool have_pro, const int qb_next) {
    constexpr int DKS = MODE ? 6 : 5, DKH = 3;
    constexpr float THR = 8.f;
    int wid = wave_; asm volatile("" : "+s"(wid));
    int lane = (int)__builtin_amdgcn_mbcnt_hi(~0u, __builtin_amdgcn_mbcnt_lo(~0u, 0u)); asm volatile("" : "+v"(lane)); const int r32 = lane & 31, hi = lane >> 5;
    const long rowbase = (long)b * SEQ; const int q0 = qb * 256, qw0 = q0 + wid * 32;
    const int NT = (q0 + 256) / 64, tlast = qw0 / 64;
    int tstart = 0;
    if (MODE == 0) {
        const GAS float* bs = T.BIASF + ((long)b * 8 + h) * SEQ; const GAS float* nr = T.NRM + (b * 8 + h) * 16;
        const float Z = nr[qb] * fmaxf(nr[8], nr[9]) * 1.001f + 0.01f; const float bq0 = bs[q0];
        const float bend = bs[(lane < NT ? lane : NT - 1) * 64 + 63];
        const bool skip = (lane < NT - 4) && (2.f * Z + bend - bq0 < -40.f);
        tstart = __builtin_popcountll(__ballot(skip));
    }
    const int NTE = NT - tstart;
    const GAS bf16* Qw = T.Q + (rowbase + qw0) * T.qp + h * (MODE ? 96 : 64);
    const GAS bf16* Kh = T.K + rowbase * T.kp + h * (MODE ? 128 : 64);
    const GAS bf16* Vh = T.V + rowbase * T.vp + h * (MODE ? 128 : 64);
    LAS float* wsf = (LAS float*)(shm + R_WS) + wid * 64;
    bf16x8 qr[DKS];
    const unsigned koff = (unsigned)(lane * T.kp + wid * 8) * 2u;
    const unsigned xoff = MODE ? (unsigned)(lane * 32 + (wid & 3) * 8) * 2u : (unsigned)(lane * 8) * 2u;
    const unsigned voff = (unsigned)((16 * (wid & 3) + (lane >> 2)) * T.vp + (wid >> 2) * 32 + (lane & 3) * 8) * 2u;
    const GAS bf16* xbase = MODE ? T.KX + rowbase * 32 : T.KX + ((long)b * 8 + h) * SEQ * 8;
    const int xstep = MODE ? 64 * 32 : 64 * 8;
    const unsigned kdst_a = (unsigned)(uintptr_t)(shm + R_K) + (unsigned)wid * 1024u, xdst_a = (unsigned)(uintptr_t)(shm + R_K) + (unsigned)(8 + (MODE ? (wid & 3) : 0)) * 1024u, vdst_a = (unsigned)(uintptr_t)(shm + R_V) + (unsigned)wid * 1024u;
#define A2_DMA(t, slot) do { \
        glds16s((const GAS void*)(Kh + (long)(t) * 64 * T.kp), koff, (unsigned)__builtin_amdgcn_readfirstlane((int)(kdst_a + (slot) * KSLOT))); \
        glds16s((const GAS void*)(xbase + (long)(t) * xstep), xoff, (unsigned)__builtin_amdgcn_readfirstlane((int)(xdst_a + (slot) * KSLOT))); \
        glds16s((const GAS void*)(Vh + (long)(t) * 64 * T.vp), voff, (unsigned)__builtin_amdgcn_readfirstlane((int)(vdst_a + (slot) * VSLOT))); } while (0)
    float mhat = 0.f, lrun = 0.f; f32x16 o[2]; o[0] = f32x16{}; o[1] = f32x16{}; f32x16 negm = f32x16{};
    const LAS char* vp0 = shm + R_V + ((lane >> 4) & 1) * 32 + (lane & 3) * 8 + (4 * hi + ((lane & 15) >> 2)) * 64;
#define A3_SLOT(k) ((slbase + (k)) % NSL)
    if (!have_pro) { A2_DMA(NT - 1, A3_SLOT(0)); A2_DMA(NT - 2, A3_SLOT(1)); A2_DMA(NT - 3, A3_SLOT(2)); }
#pragma unroll
    for (int d0 = 0; d0 < (MODE ? 6 : 4); ++d0) qr[d0] = *(const GAS bf16x8*)(Qw + (long)r32 * T.qp + d0 * 16 + hi * 8);
    if (MODE == 0) { const short one = hi ? (short)0 : (short)0x3F80; qr[DKS - 1] = (bf16x8){one, one, one, 0, 0, 0, 0, 0}; }
#pragma unroll
    for (int d0 = 0; d0 < DKS; ++d0) asm volatile("" : "+v"(qr[d0]));
#define A3_KLOADH(slot, H) do { const LAS char* kb_ = shm + R_K + (slot) * KSLOT + r32 * 16; _Pragma("unroll") for (int d0 = (H) * DKH; d0 < ((H) ? DKS : DKH); ++d0) { const int off = (MODE == 0 && d0 == 4) ? 8 * 1024 : d0 * 2048 + hi * 1024; \
        kf[2 * (d0 - (H) * DKH)] = *(const LAS bf16x8*)(kb_ + off); kf[2 * (d0 - (H) * DKH) + 1] = *(const LAS bf16x8*)(kb_ + off + 512); } } while (0)
#define A3_VLOAD(slot) do { const LAS char* vp_ = vp0 + (slot) * VSLOT; _Pragma("unroll") for (int q = 0; q < 8; ++q) { vlo[q] = vtr(vp_ + (q >> 2) * 4096 + (q & 3) * 1024); vhh[q] = vtr(vp_ + (q >> 2) * 4096 + (q & 3) * 1024 + 512); } } while (0)
#define A3_QKH(H) do { if ((H) == 0) { c0 = negm; c1 = negm; } _Pragma("unroll") for (int d0 = (H) * DKH; d0 < ((H) ? DKS : DKH); ++d0) { c0 = __builtin_amdgcn_mfma_f32_32x32x16_bf16(kf[2 * (d0 - (H) * DKH)], qr[d0], c0, 0, 0, 0); c1 = __builtin_amdgcn_mfma_f32_32x32x16_bf16(kf[2 * (d0 - (H) * DKH) + 1], qr[d0], c1, 0, 0, 0); } } while (0)
#define A3_EXP() do { float ls_ = 0.f; _Pragma("unroll") for (int r = 0; r < 16; ++r) { pp0[r] = __builtin_amdgcn_exp2f(pp0[r]); pp1[r] = __builtin_amdgcn_exp2f(pp1[r]); ls_ += pp0[r] + pp1[r]; } lrun += ls_; u32x4 w_; \
        w_.x = cvt_pk_bf16(pp0[0], pp0[1]); w_.y = cvt_pk_bf16(pp0[2], pp0[3]); w_.z = cvt_pk_bf16(pp0[4], pp0[5]); w_.w = cvt_pk_bf16(pp0[6], pp0[7]); pa[0] = __builtin_bit_cast(bf16x8, w_); \
        w_.x = cvt_pk_bf16(pp0[8], pp0[9]); w_.y = cvt_pk_bf16(pp0[10], pp0[11]); w_.z = cvt_pk_bf16(pp0[12], pp0[13]); w_.w = cvt_pk_bf16(pp0[14], pp0[15]); pa[1] = __builtin_bit_cast(bf16x8, w_); \
        w_.x = cvt_pk_bf16(pp1[0], pp1[1]); w_.y = cvt_pk_bf16(pp1[2], pp1[3]); w_.z = cvt_pk_bf16(pp1[4], pp1[5]); w_.w = cvt_pk_bf16(pp1[6], pp1[7]); pa[2] = __builtin_bit_cast(bf16x8, w_); \
        w_.x = cvt_pk_bf16(pp1[8], pp1[9]); w_.y = cvt_pk_bf16(pp1[10], pp1[11]); w_.z = cvt_pk_bf16(pp1[12], pp1[13]); w_.w = cvt_pk_bf16(pp1[14], pp1[15]); pa[3] = __builtin_bit_cast(bf16x8, w_); } while (0)
#define A3_PV() do { _Pragma("unroll") for (int d0 = 0; d0 < 2; ++d0) _Pragma("unroll") for (int k = 0; k < 4; ++k) { const s16x4 lo_ = vlo[4 * d0 + k], hh_ = vhh[4 * d0 + k]; \
        const bf16x8 vf_ = (bf16x8){lo_[0], lo_[1], lo_[2], lo_[3], hh_[0], hh_[1], hh_[2], hh_[3]}; o[d0] = __builtin_amdgcn_mfma_f32_32x32x16_bf16(pa[k], vf_, o[d0], 0, 0, 0); } } while (0)
#define A3_ROWMAX(rm) do { float a_ = fmaxf(fmaxf(c0[0], c0[1]), c1[0]), b_ = fmaxf(fmaxf(c0[2], c0[3]), c1[1]); a_ = fmaxf(fmaxf(a_, c1[2]), c1[3]); \
        _Pragma("unroll") for (int r = 4; r < 16; r += 4) { a_ = fmaxf(fmaxf(a_, c0[r]), c0[r + 1]); b_ = fmaxf(fmaxf(b_, c0[r + 2]), c0[r + 3]); a_ = fmaxf(fmaxf(a_, c1[r]), c1[r + 1]); b_ = fmaxf(fmaxf(b_, c1[r + 2]), c1[r + 3]); } \
        rm = fmaxf(a_, b_); const auto rr_ = __builtin_amdgcn_permlane32_swap(__float_as_uint(rm), __float_as_uint(rm), false, false); rm = fmaxf(__uint_as_float(rr_[0]), __uint_as_float(rr_[1])); } while (0)
    int sl = A3_SLOT(0), sl3 = A3_SLOT(3);
    f32x16 pp0 = f32x16{}, pp1 = f32x16{}; bool pend = false; int pslot = 0;
    for (int i = 0; i < NTE; ++i) {
        const int t = NT - 1 - i;
        { const int ahead = NTE - 1 - i;
          if (ahead >= 2) asm volatile("s_waitcnt vmcnt(6)" ::: "memory"); else if (ahead == 1) asm volatile("s_waitcnt vmcnt(3)" ::: "memory"); else asm volatile("s_waitcnt vmcnt(0)" ::: "memory"); }
        __builtin_amdgcn_s_barrier(); asm volatile("" ::: "memory");
        if (i + 3 < NTE) A2_DMA(t - 3, sl3);
        if (i == NTE - 1 && qb_next >= 0) { const int NTn = 4 * qb_next + 4; A2_DMA(NTn - 1, A3_SLOT(NTE)); A2_DMA(NTn - 2, A3_SLOT(NTE + 1)); A2_DMA(NTn - 3, A3_SLOT(NTE + 2)); }
        if (t <= tlast) {
            bf16x8 kf[2 * DKH]; f32x16 c0, c1; float rm;
            A3_KLOADH(sl, 0);
            if (!pend) {
                A3_QKH(0); A3_KLOADH(sl, 1); A3_QKH(1);
                if (MODE == 0) { const int qrel = qw0 + r32 - 64 * t;
#pragma unroll
                    for (int r = 0; r < 16; ++r) { const int kv = crow(r, hi); if (kv > qrel) c0[r] = -INFINITY; if (kv + 32 > qrel) c1[r] = -INFINITY; } }
                A3_ROWMAX(rm);
                mhat = rm;
#pragma unroll
                for (int r = 0; r < 16; ++r) { c0[r] -= rm; c1[r] -= rm; negm[r] = -mhat; }
                pend = true;
            } else {
                s16x4 vlo[8], vhh[8]; bf16x8 pa[4];
                A3_QKH(0); A3_KLOADH(sl, 1);
                A3_VLOAD(pslot);
                A3_QKH(1);
                A3_EXP();
#pragma unroll
                for (int g_ = 0; g_ < 2 * DKS; ++g_) { __builtin_amdgcn_sched_group_barrier(0x008, 1, 0); __builtin_amdgcn_sched_group_barrier(0x002, 7, 0); }
                A3_PV();
                A3_ROWMAX(rm);
#pragma unroll
                for (int g_ = 0; g_ < 8; ++g_) { __builtin_amdgcn_sched_group_barrier(0x008, 1, 0); __builtin_amdgcn_sched_group_barrier(0x002, 3, 0); }
                if (__any(rm > THR)) {
                    const float dl = fmaxf(rm, 0.f); mhat += dl;
#pragma unroll
                    for (int r = 0; r < 16; ++r) { c0[r] -= dl; c1[r] -= dl; negm[r] = -mhat; }
                    const float f = __builtin_amdgcn_exp2f(-dl); lrun *= f;
                    if (hi == 0) wsf[r32] = f;
                    LDS_WAIT();
#pragma unroll
                    for (int g = 0; g < 4; ++g) { const f32x4 ff = *(const LAS f32x4*)(wsf + 8 * g + 4 * hi);
#pragma unroll
                        for (int j = 0; j < 4; ++j) { o[0][4 * g + j] *= ff[j]; o[1][4 * g + j] *= ff[j]; } }
                }
            }
            pp0 = c0; pp1 = c1; pslot = sl;
        }
        sl = (sl == NSL - 1) ? 0 : sl + 1; sl3 = (sl3 == NSL - 1) ? 0 : sl3 + 1;
    }
    if (pend) { s16x4 vlo[8], vhh[8]; bf16x8 pa[4]; A3_VLOAD(pslot); A3_EXP(); A3_PV(); }
#undef A3_KLOADH
#undef A3_VLOAD
#undef A3_QKH
#undef A3_EXP
#undef A3_PV
#undef A3_ROWMAX
#undef A2_DMA
    lrun += __shfl_xor(lrun, 32);
    LDS_WAIT();
    if (hi == 0) wsf[32 + r32] = lrun;
    LDS_WAIT();
    float rli[16];
#pragma unroll
    for (int g = 0; g < 4; ++g) { const f32x4 ll = *(const LAS f32x4*)(wsf + 32 + 8 * g + 4 * hi);
#pragma unroll
        for (int j = 0; j < 4; ++j) rli[4 * g + j] = __builtin_amdgcn_rcpf(ll[j]); }
    GAS bf16* Ow = T.O + (rowbase + qw0) * 1024 + (MODE ? 0 : 512) + h * 64;
    { LAS bf16* stg = (LAS bf16*)(shm + R_OST) + wid * 2048;
#pragma unroll
      for (int r = 0; r < 16; ++r) { const int orow = crow(r, hi);
#pragma unroll
          for (int d0 = 0; d0 < 2; ++d0) stg[orow * 64 + d0 * 32 + r32] = (bf16)(cvt_pk_bf16(o[d0][r] * rli[r], 0.f) & 0xffffu); }
      LDS_WAIT();
#pragma unroll
      for (int i = 0; i < 4; ++i) { const int row = i * 8 + (lane >> 3), ch = lane & 7; const u32x4 v = *(const LAS u32x4*)(stg + row * 64 + ch * 8); *(GAS u32x4*)(Ow + (long)row * 1024 + ch * 8) = v;
          float sq = 0.f;
#pragma unroll
          for (int j = 0; j < 4; ++j) { const float a0 = __uint_as_float(v[j] << 16), a1 = __uint_as_float(v[j] & 0xffff0000u); sq += a0 * a0 + a1 * a1; }
          sq += __shfl_xor(sq, 1); sq += __shfl_xor(sq, 2); sq += __shfl_xor(sq, 4);
          if (ch == 0) T.OSS[(rowbase + qw0 + row) * 16 + (MODE ? 0 : 8) + h] = sq; } }
    if (qb_next < 0) { LDS_WAIT(); __builtin_amdgcn_s_barrier(); asm volatile("" ::: "memory"); }
    return A3_SLOT(NTE);
#undef A3_SLOT
}
}

struct Args { const void* in[21]; float* out; unsigned char* ws; int ph_lo, ph_hi; };

__device__ __forceinline__ void tr_item(const GAS float* __restrict__ W, int ldw, int Ksrc, const GAS float* __restrict__ gain, GAS bf16* __restrict__ WT, int ldk, int k0, int n0, int srccol, LAS float* scr, int lane) {
#pragma unroll 8
    for (int i = 0; i < 32; ++i) { const int kk = 2 * i + (lane >> 5); const int k = k0 + kk;
        float v = 0.f; if (srccol >= 0 && k < Ksrc) { v = W[(size_t)k * ldw + srccol]; if (gain) v *= gain[k]; }
        scr[kk * 33 + (lane & 31)] = v; }
    LDS_WAIT(); asm volatile("" ::: "memory");
    const int c = lane & 7;
#pragma unroll
    for (int j = 0; j < 4; ++j) { const int n = (lane >> 3) + 8 * j; const LAS float* s = scr + (8 * c) * 33 + n;
        u32x4 o; o.x = cvt_pk_bf16(s[0 * 33], s[1 * 33]); o.y = cvt_pk_bf16(s[2 * 33], s[3 * 33]); o.z = cvt_pk_bf16(s[4 * 33], s[5 * 33]); o.w = cvt_pk_bf16(s[6 * 33], s[7 * 33]);
        *(GAS u32x4*)(WT + (size_t)(n0 + n) * ldk + k0 + 8 * c) = o; }
    LDS_WAIT(); asm volatile("" ::: "memory");
}
__device__ __forceinline__ void tr_item64(const GAS float* __restrict__ W, int ldw, const GAS float* __restrict__ gain, GAS bf16* __restrict__ WT, int ldk, int k0, int n0src, int n0dst, LAS float* scr, int lane) {
    const int rr = lane >> 4, c4 = (lane & 15) * 4;
    f32x4 v[16];
#pragma unroll
    for (int i = 0; i < 16; ++i) v[i] = *(const GAS f32x4*)(W + (size_t)(k0 + 4 * i + rr) * ldw + n0src + c4);
#pragma unroll
    for (int i = 0; i < 16; ++i) { const int k = 4 * i + rr; const float g = gain ? gain[k0 + k] : 1.f; LAS float* d = scr + k * 65 + c4;
        d[0] = v[i][0] * g; d[1] = v[i][1] * g; d[2] = v[i][2] * g; d[3] = v[i][3] * g; }
    LDS_WAIT(); asm volatile("" ::: "memory");
    const int kc = lane & 7;
#pragma unroll
    for (int j = 0; j < 8; ++j) { const int n = (lane >> 3) + 8 * j; const LAS float* sp = scr + (8 * kc) * 65 + n;
        u32x4 o; o.x = cvt_pk_bf16(sp[0 * 65], sp[1 * 65]); o.y = cvt_pk_bf16(sp[2 * 65], sp[3 * 65]); o.z = cvt_pk_bf16(sp[4 * 65], sp[5 * 65]); o.w = cvt_pk_bf16(sp[6 * 65], sp[7 * 65]);
        *(GAS u32x4*)(WT + (size_t)(n0dst + n) * ldk + k0 + 8 * kc) = o; }
    LDS_WAIT(); asm volatile("" ::: "memory");
}
__device__ __forceinline__ void tr_item64_f8(const GAS float* __restrict__ W, int ldw, const GAS float* __restrict__ gain, float scale, GAS unsigned char* __restrict__ WT8, int ldkB, int k0, int n0src, int n0dst, LAS float* scr, int lane) {
    const int rr = lane >> 4, c4 = (lane & 15) * 4;
    f32x4 v[16];
#pragma unroll
    for (int i = 0; i < 16; ++i) v[i] = *(const GAS f32x4*)(W + (size_t)(k0 + 4 * i + rr) * ldw + n0src + c4);
#pragma unroll
    for (int i = 0; i < 16; ++i) { const int k = 4 * i + rr; const float g = (gain ? gain[k0 + k] : 1.f) * scale; LAS float* d = scr + k * 65 + c4;
        d[0] = v[i][0] * g; d[1] = v[i][1] * g; d[2] = v[i][2] * g; d[3] = v[i][3] * g; }
    LDS_WAIT(); asm volatile("" ::: "memory");
    const int kc = lane & 7;
#pragma unroll
    for (int j = 0; j < 8; ++j) { const int n = (lane >> 3) + 8 * j; const LAS float* sp = scr + (8 * kc) * 65 + n;
        u32x2 o; o.x = pk4_fp8(sp[0 * 65], sp[1 * 65], sp[2 * 65], sp[3 * 65]); o.y = pk4_fp8(sp[4 * 65], sp[5 * 65], sp[6 * 65], sp[7 * 65]);
        *(GAS u32x2*)(WT8 + (size_t)(n0dst + n) * ldkB + k0 + 8 * kc) = o; }
    LDS_WAIT(); asm volatile("" ::: "memory");
}
__device__ __forceinline__ int rope_dim(int p) { const int a = p >> 3, j = p & 7; return j < 4 ? 4 * a + j : 16 + 4 * a + (j - 4); }

#define LDP(i) ((void*)((((unsigned long long)(unsigned)__builtin_amdgcn_readfirstlane((int)(ARGP[i] >> 32))) << 32) | (unsigned long long)(unsigned)__builtin_amdgcn_readfirstlane((int)(unsigned)ARGP[i])))
#define ARGIN(i) ((const void*)LDP(i))
#define P_COS ((GAS float*)(ws + WS_COS))
#define P_SIN ((GAS float*)(ws + WS_SIN))
#define P_SSQ ((GAS float*)(ws + WS_SSQ))
#define P_FLOG ((GAS float*)(ws + WS_FLOG))
#define P_E01 ((GAS int*)(ws + WS_E01))
#define P_G01 ((GAS float*)(ws + WS_G01))
#define P_SLOT ((GAS int*)(ws + WS_SLOT))
#define P_TOKOF ((GAS int*)(ws + WS_TOKOF))
#define P_GATEOF ((GAS float*)(ws + WS_GATEOF))
#define P_CNT ((GAS int*)(ws + WS_CNT))
#define P_TSTART ((GAS int*)(ws + WS_TSTART))
#define P_RSTD ((GAS float*)(ws + WS_RSTD))
#define P_RSTDOF ((GAS float*)(ws + WS_RSTDOF))
#define P_KPE ((GAS bf16*)(ws + WS_KPE))
#define P_KAUG ((GAS bf16*)(ws + WS_KAUG))
#define P_BIASF ((GAS float*)(ws + WS_BIASF))
#define P_NRM ((GAS float*)(ws + WS_NRM))
#define P_WR ((GAS bf16*)(ws + WS_WR))
#define P_XR ((GAS bf16*)(ws + WS_XR))
#define P_OSS ((GAS float*)(ws + WS_OSS))
#define P_RSTDX ((GAS float*)(ws + WS_RSTDX))
#define P_WIN ((GAS bf16*)(ws + WS_WIN))
#define P_WUQ ((GAS bf16*)(ws + WS_WUQ))
#define P_WUKV ((GAS bf16*)(ws + WS_WUKV))
#define P_WOUT ((GAS bf16*)(ws + WS_WOUT))
#define P_WGU_L(ll) ((GAS unsigned char*)(ws + WS_WGU + (size_t)((ll) & 1) * 32 * MiB))
#define P_WD_L(ll) ((GAS unsigned char*)(ws + WS_WD + (size_t)((ll) & 1) * 16 * MiB))
#define P_XN ((GAS bf16*)(ws + WS_XN))
#define P_FQKV ((GAS bf16*)(ws + WS_FQKV))
#define P_HH ((GAS bf16*)(ws + WS_FQKV))
#define P_LAT ((GAS bf16*)(ws + WS_LAT))
#define P_QM ((GAS bf16*)(ws + WS_QM))
#define P_KVM ((GAS bf16*)(ws + WS_KVM))
#define P_Y ((GAS bf16*)(ws + WS_Y))
#define IN(k) (lo <= (k) && (k) < hi_)
#if MK_ONE_LAUNCH
#define GRID_BAR() xcd_barrier(bar)
#else
#define GRID_BAR() do {} while (0)
#endif
#define SEAM(k) do { if (IN(k) && IN((k) + 1)) GRID_BAR(); } while (0)
__device__ __forceinline__ void conv_gu_item(int r, const GAS float* w_gate, const GAS float* w_up, const GAS float* ffn_norm, GAS unsigned char* WGU, LAS float* scr64, int lane) {
    const int e = r / 256, q = r % 256, kb = q / 16, nb = q % 16; const int n0 = nb * 64; const int ct = n0 >> 8, which = (n0 >> 7) & 1, jj = n0 & 127;
    const GAS float* src = (which ? w_up : w_gate) + (size_t)e * DM * DEXP;
    tr_item64_f8(src, DEXP, ffn_norm, WSCALE, WGU + (size_t)e * 1024 * 1024, DM, kb * 64, ct * 128 + jj, n0, scr64, lane);
}
__device__ __forceinline__ void conv_d_item(int r, const GAS float* w_down, GAS unsigned char* WD, LAS float* scr64, int lane) {
    const int e = r / 128, q = r % 128, kb = q / 16, nb = q % 16;
    tr_item64_f8(w_down + (size_t)e * DEXP * DM, DM, nullptr, WSCALE, WD + (size_t)e * 1024 * 512, DEXP, kb * 64, nb * 64, nb * 64, scr64, lane);
}
template <int l>
__device__ __forceinline__ void layer_body(const int lo, const int hi_, LAS unsigned char* lds0, const int wave0, const int G0, const int bx0, const XcdBarrier& bar) {
        const int P = 10 * l;
        if (IN(P)) for (int rep_ = 0; rep_ < (l == 0 ? NREP(0) : 1); ++rep_) {
            unsigned ldsb_ = (unsigned)(uintptr_t)lds0; asm volatile("" : "+s"(ldsb_)); LAS unsigned char* lds = (LAS unsigned char*)(uintptr_t)ldsb_; volatile LAS unsigned* MISC = (volatile LAS unsigned*)(lds + MISC_OFF); volatile LAS unsigned long long* ARGP = (volatile LAS unsigned long long*)(lds + MISC_OFF + 768); (void)MISC; int wave = wave0, G = G0, bx = bx0; asm volatile("" : "+s"(G), "+s"(bx), "+s"(wave)); const int lane = (int)__builtin_amdgcn_mbcnt_hi(~0u, __builtin_amdgcn_mbcnt_lo(~0u, 0u)); const int tid = wave * 64 + lane; const int vcu = (bx % 8) * (G / 8) + bx / 8; const int gw = vcu * 8 + wave, NGW = G * 8; (void)lane; (void)gw; (void)NGW; (void)vcu;
            GAS unsigned char* ws = (GAS unsigned char*)LDP(22); GAS float* out = (GAS float*)LDP(21); const GAS float* x_in = (const GAS float*)ARGIN(0); const GAS int* positions = (const GAS int*)ARGIN(1);
            if (l < NLAYER) {
                LAS float* scr = (LAS float*)(lds + wave * 16640);
                const GAS float* attn_norm = (const GAS float*)ARGIN(2) + (size_t)l * DM; const GAS float* w_in = (const GAS float*)ARGIN(3) + (size_t)l * DM * INW;
                const GAS float* q_norm = (const GAS float*)ARGIN(5) + (size_t)l * 256; const GAS float* w_uq = (const GAS float*)ARGIN(6) + (size_t)l * 256 * 768;
                const GAS float* kv_norm = (const GAS float*)ARGIN(7) + (size_t)l * 128; const GAS float* w_ukv = (const GAS float*)ARGIN(8) + (size_t)l * 128 * 1024;
                const GAS float* mla_on = (const GAS float*)ARGIN(9) + (size_t)l * 512; const GAS float* fox_on = (const GAS float*)ARGIN(10) + (size_t)l * 512; const GAS float* w_out = (const GAS float*)ARGIN(11) + (size_t)l * DM * DM;
                const GAS float* ffn_norm = (const GAS float*)ARGIN(12) + (size_t)l * DM;
                const GAS float* w_gate = (const GAS float*)ARGIN(17) + (size_t)l * NEXP * DM * DEXP; const GAS float* w_up = (const GAS float*)ARGIN(18) + (size_t)l * NEXP * DM * DEXP; const GAS float* w_down = (const GAS float*)ARGIN(19) + (size_t)l * NEXP * DEXP * DM;
                constexpr int I_IN = 16 * 64, I_UQ = 4 * 24, I_UKV = 4 * 32;
                constexpr int NITEMS = I_IN + I_UQ + I_UKV;
                for (int it = gw; it < NITEMS; it += NGW) {
                    int r = it; const int j = lane & 31;
                    if (r < I_IN) { const int kb = r / 64, nb = r % 64; const int n = nb * 32 + j; int sc;
                        if (n < 384) sc = n; else if (n < 416) sc = 384 + rope_dim(n - 384); else if (n < 424) sc = 1952 + (n - 416); else if (n < 512) sc = -1; else sc = 416 + (n - 512);
                        tr_item(w_in, INW, DM, attn_norm, P_WIN, DM, kb * 64, nb * 32, sc, scr, lane); continue; } r -= I_IN;
                    if (r < I_UQ) { const int kb = r / 24, nb = r % 24; const int n = nb * 32 + j; const int hh = n / 96, d = n % 96; const int sc = d < 64 ? n : hh * 96 + 64 + rope_dim(d - 64);
                        tr_item(w_uq, 768, 256, q_norm, P_WUQ, 256, kb * 64, nb * 32, sc, scr, lane); continue; } r -= I_UQ;
                    { const int kb = r / 32, nb = r % 32; tr_item(w_ukv, 1024, 128, kv_norm, P_WUKV, 256, kb * 64, nb * 32, nb * 32 + j, scr, lane); }
                }
                LAS float* scr64 = (LAS float*)(lds + wave * 16640);
                constexpr int J_OUT = 16 * 16, J_GU = 16 * 16 * NEXP, J_D = 8 * 16 * NEXP;
                for (int it = gw; it < J_OUT + (l == 0 ? J_GU + J_D : 0); it += NGW) {
                    int r = it;
                    if (r < J_OUT) { const int kb = r / 16, nb = r % 16; const GAS float* gn = kb < 8 ? mla_on : fox_on - 512; tr_item64(w_out, DM, gn, P_WOUT, DM, kb * 64, nb * 64, nb * 64, scr64, lane); continue; } r -= J_OUT;
                    if (r < J_GU) { conv_gu_item(r, w_gate, w_up, ffn_norm, P_WGU_L(l), scr64, lane); continue; } r -= J_GU;
                    conv_d_item(r, w_down, P_WD_L(l), scr64, lane);
                }
                { const GAS float* w_rg = (const GAS float*)ARGIN(13) + (size_t)l * DM * 4; const GAS float* w_re = (const GAS float*)ARGIN(15) + (size_t)l * DM * 32;
                  for (int idx = bx * 512 + tid; idx < 2 * 48 * 520; idx += G * 512) { const int half = idx / (48 * 520), r = idx % (48 * 520), c = r / 520, kk = r % 520; const int k = half * 512 + kk;
                      float w = 0.f; if (c < 36 && kk < 512) w = ffn_norm[k] * (c < 4 ? w_rg[k * 4 + c] : w_re[k * 32 + (c - 4)]);
                      const unsigned h16 = cvt_pk_bf16(w, 0.f) & 0xffffu; const unsigned l16 = cvt_pk_bf16(w - __uint_as_float(h16 << 16), 0.f) & 0xffffu;
                      P_WR[(size_t)(half * 2 + 0) * 48 * 520 + r] = (bf16)h16; P_WR[(size_t)(half * 2 + 1) * 48 * 520 + r] = (bf16)l16; } }
            }
            const GAS float* fin = (const GAS float*)ARGIN(20);
            for (int mb = gw * 4; mb < NTOK; mb += NGW * 4) {
                f32x4 v[4][4]; int s0[4], s1[4];
                if (l > 0) {
#pragma unroll
                    for (int r = 0; r < 4; ++r) { s0[r] = P_SLOT[2 * (mb + r)]; s1[r] = P_SLOT[2 * (mb + r) + 1]; }
                }
#pragma unroll
                for (int r = 0; r < 4; ++r) {
                    if (l == 0) { const GAS float* xr = x_in + (size_t)(mb + r) * DM;
#pragma unroll
                        for (int j = 0; j < 4; ++j) v[r][j] = *(const GAS f32x4*)(xr + 4 * lane + 256 * j); }
                    else { const GAS bf16* xr = P_XR + (size_t)(mb + r) * DM;
#pragma unroll
                        for (int j = 0; j < 4; ++j) { const u32x2 w = *(const GAS u32x2*)(xr + 4 * lane + 256 * j); v[r][j] = (f32x4){__uint_as_float(w.x << 16), __uint_as_float(w.x & 0xffff0000u), __uint_as_float(w.y << 16), __uint_as_float(w.y & 0xffff0000u)}; } } }
                if (l > 0) {
#pragma unroll
                    for (int r = 0; r < 4; ++r)
#pragma unroll
                        for (int j = 0; j < 4; ++j) { const int a = *(const GAS int*)((const GAS unsigned char*)P_Y + (size_t)s0[r] * 1024 + 4 * lane + 256 * j), c = *(const GAS int*)((const GAS unsigned char*)P_Y + (size_t)s1[r] * 1024 + 4 * lane + 256 * j);
                            const f32x2 a0 = __builtin_amdgcn_cvt_pk_f32_fp8(a, false), a1 = __builtin_amdgcn_cvt_pk_f32_fp8(a, true), c0 = __builtin_amdgcn_cvt_pk_f32_fp8(c, false), c1 = __builtin_amdgcn_cvt_pk_f32_fp8(c, true);
                            v[r][j][0] += (a0[0] + c0[0]) * WSCALE_INV; v[r][j][1] += (a0[1] + c0[1]) * WSCALE_INV; v[r][j][2] += (a1[0] + c1[0]) * WSCALE_INV; v[r][j][3] += (a1[1] + c1[1]) * WSCALE_INV; }
                }
                float ss[4];
#pragma unroll
                for (int r = 0; r < 4; ++r) { float s = 0.f;
#pragma unroll
                    for (int j = 0; j < 4; ++j) s += (v[r][j][0] * v[r][j][0] + v[r][j][1] * v[r][j][1]) + (v[r][j][2] * v[r][j][2] + v[r][j][3] * v[r][j][3]);
                    ss[r] = s; }
#pragma unroll
                for (int o = 1; o < 64; o <<= 1) {
#pragma unroll
                    for (int r = 0; r < 4; ++r) ss[r] += __shfl_xor(ss[r], o); }
#pragma unroll
                for (int r = 0; r < 4; ++r) { const int m = mb + r; const float rstd = rsqrtf(ss[r] * (1.f / DM) + EPS);
                    if (l < NLAYER) {
#pragma unroll
                        for (int j = 0; j < 4; ++j) { u32x2 w; w.x = cvt_pk_bf16(v[r][j][0], v[r][j][1]); w.y = cvt_pk_bf16(v[r][j][2], v[r][j][3]); *(GAS u32x2*)(P_XR + (size_t)m * DM + 4 * lane + 256 * j) = w; }
                        if (lane == 0) P_RSTDX[m] = rstd;
                    } else {
#pragma unroll
                        for (int j = 0; j < 4; ++j) { const f32x4 g = *(const GAS f32x4*)(fin + 4 * lane + 256 * j); *(GAS f32x4*)(out + (size_t)m * DM + 4 * lane + 256 * j) = v[r][j] * rstd * g; }
                    }
                }
            }
        }
        if constexpr (l == NLAYER) return;
        SEAM(P);
        if (IN(P + 1)) for (int rep_ = 0; rep_ < ((l == 0 || 1 != 5) ? NREP(1) : 1); ++rep_) {
            unsigned ldsb_ = (unsigned)(uintptr_t)lds0; asm volatile("" : "+s"(ldsb_)); LAS unsigned char* lds = (LAS unsigned char*)(uintptr_t)ldsb_; volatile LAS unsigned* MISC = (volatile LAS unsigned*)(lds + MISC_OFF); volatile LAS unsigned long long* ARGP = (volatile LAS unsigned long long*)(lds + MISC_OFF + 768); (void)MISC; int wave = wave0, G = G0, bx = bx0; asm volatile("" : "+s"(G), "+s"(bx), "+s"(wave)); const int lane = (int)__builtin_amdgcn_mbcnt_hi(~0u, __builtin_amdgcn_mbcnt_lo(~0u, 0u)); const int tid = wave * 64 + lane; const int vcu = (bx % 8) * (G / 8) + bx / 8; const int gw = vcu * 8 + wave, NGW = G * 8; (void)lane; (void)gw; (void)NGW; (void)vcu;
            GAS unsigned char* ws = (GAS unsigned char*)LDP(22); GAS float* out = (GAS float*)LDP(21); const GAS float* x_in = (const GAS float*)ARGIN(0); (void)out; (void)x_in; (void)ws;
            DenseOrder S{NTOK / 256, INP / 256, (NTOK / 256) * (INP / 256), G, bx, (const GAS char*)P_XR, (const GAS char*)P_WIN, (size_t)256 * DM * 2, (size_t)256 * DM * 2};
            EpiWin E{P_LAT, P_FQKV, P_KPE, P_FLOG, P_SSQ, P_COS, P_SIN, P_RSTDX};
            pg8::gemm_phase<EpiWin, DenseOrder, true, false>(tid, lds, DM * 2, DM * 2, DM * 2, S, E, nullptr);
        }
        SEAM(P + 1);
        if (IN(P + 2)) for (int rep_ = 0; rep_ < ((l == 0 || 2 != 5) ? NREP(2) : 1); ++rep_) {
            unsigned ldsb_ = (unsigned)(uintptr_t)lds0; asm volatile("" : "+s"(ldsb_)); LAS unsigned char* lds = (LAS unsigned char*)(uintptr_t)ldsb_; volatile LAS unsigned* MISC = (volatile LAS unsigned*)(lds + MISC_OFF); volatile LAS unsigned long long* ARGP = (volatile LAS unsigned long long*)(lds + MISC_OFF + 768); (void)MISC; int wave = wave0, G = G0, bx = bx0; asm volatile("" : "+s"(G), "+s"(bx), "+s"(wave)); const int lane = (int)__builtin_amdgcn_mbcnt_hi(~0u, __builtin_amdgcn_mbcnt_lo(~0u, 0u)); const int tid = wave * 64 + lane; const int vcu = (bx % 8) * (G / 8) + bx / 8; const int gw = vcu * 8 + wave, NGW = G * 8; (void)lane; (void)gw; (void)NGW; (void)vcu;
            GAS unsigned char* ws = (GAS unsigned char*)LDP(22); GAS float* out = (GAS float*)LDP(21); const GAS float* x_in = (const GAS float*)ARGIN(0); (void)out; (void)x_in; (void)ws;
            {
                const int sq = vcu >> 1, hf = vcu & 1; const int b = sq >> 3, h = sq & 7; const float bf = ((const GAS float*)ARGIN(4))[l * 8 + h];
                const GAS float* fl = P_FLOG + ((size_t)b * SEQ + hf * 1024 + 2 * tid) * 8 + h;
                float lf[2], lg[2] = {0.f, 0.f};
#pragma unroll
                for (int e = 0; e < 2; ++e) { const float f = fl[e * 8] + bf; lf[e] = fminf(f, 0.f) - log1pf(expf(-fabsf(f))); }
                if (hf) {
#pragma unroll
                    for (int e = 0; e < 2; ++e) { const float f = fl[e * 8 - 1024 * 8] + bf; lg[e] = fminf(f, 0.f) - log1pf(expf(-fabsf(f))); } }
                const double s2 = (double)lf[0] + (double)lf[1];
                double incl = s2, first = (double)lg[0] + (double)lg[1];
#pragma unroll
                for (int o = 1; o < 64; o <<= 1) { const double t = __shfl_up(incl, o); if (lane >= o) incl += t; first += __shfl_xor(first, o); }
                LAS double* wtot = (LAS double*)lds;
                if (lane == 63) wtot[wave] = incl;
                if (lane == 0) wtot[8 + wave] = first;
                __syncthreads();
                double c = incl - s2;
                for (int w = 0; w < wave; ++w) c += wtot[w];
                if (hf) { for (int w = 0; w < 8; ++w) c += wtot[8 + w]; }
                const size_t t0 = ((size_t)b * 8 + h) * SEQ + hf * 1024 + 2 * tid;
                GAS u32x4* ka = (GAS u32x4*)(P_KAUG + t0 * 8);
#pragma unroll
                for (int e = 0; e < 2; ++e) { c += (double)lf[e]; const float x = (float)(-c * 1.4426950408889634);
                    const unsigned h16 = cvt_pk_bf16(x, 0.f) & 0xffffu; const float r1 = x - __uint_as_float(h16 << 16); const unsigned m16 = cvt_pk_bf16(r1, 0.f) & 0xffffu; const float r2 = r1 - __uint_as_float(m16 << 16); const unsigned l16 = cvt_pk_bf16(r2, 0.f) & 0xffffu;
                    ka[e] = (u32x4){h16 | (m16 << 16), l16, 0u, 0u}; P_BIASF[t0 + e] = x; }
                float qn = 0.f, kn = 0.f;
                { const GAS bf16* fqp = P_FQKV + ((size_t)b * SEQ + hf * 1024 + 2 * tid) * 512 + h * 64; const GAS bf16* fkp = fqp + (size_t)NTOK * 512;
#pragma unroll
                  for (int e = 0; e < 2; ++e) { float sq_ = 0.f, sk = 0.f;
#pragma unroll
                      for (int c8 = 0; c8 < 8; ++c8) { const u32x4 a = *(const GAS u32x4*)(fqp + e * 512 + c8 * 8), k4 = *(const GAS u32x4*)(fkp + e * 512 + c8 * 8);
#pragma unroll
                          for (int j = 0; j < 4; ++j) { const float a0 = __uint_as_float(a[j] << 16), a1 = __uint_as_float(a[j] & 0xffff0000u), k0 = __uint_as_float(k4[j] << 16), k1 = __uint_as_float(k4[j] & 0xffff0000u);
                              sq_ += a0 * a0 + a1 * a1; sk += k0 * k0 + k1 * k1; } }
                      qn = fmaxf(qn, sq_); kn = fmaxf(kn, sk); } }
#pragma unroll
                for (int o = 1; o < 64; o <<= 1) { qn = fmaxf(qn, __shfl_xor(qn, o)); kn = fmaxf(kn, __shfl_xor(kn, o)); }
                LAS float* knw = (LAS float*)(lds + 256);
                if (lane == 0) { knw[wave] = kn; knw[8 + wave] = qn; }
                __syncthreads();
                if (tid < 4) P_NRM[sq * 16 + hf * 4 + tid] = sqrtf(fmaxf(knw[8 + 2 * tid], knw[8 + 2 * tid + 1]));
                if (tid == 4) { float m = knw[0]; for (int w = 1; w < 8; ++w) m = fmaxf(m, knw[w]); P_NRM[sq * 16 + 8 + hf] = sqrtf(m); }
                __syncthreads();
            }
            UpOrder S{G, vcu, (const GAS char*)P_LAT, (const GAS char*)P_WUQ, (const GAS char*)P_WUKV};
            EpiUp E{P_QM, P_KVM, P_SSQ, P_COS, P_SIN};
            pg8::gemm_phase<EpiUp, UpOrder, true, false>(tid, lds, 256 * 2, 512 * 2, 256 * 2, S, E, nullptr);
        }
        SEAM(P + 2);
        if (IN(P + 3)) for (int rep_ = 0; rep_ < ((l == 0 || 3 != 5) ? NREP(3) : 1); ++rep_) {
            unsigned ldsb_ = (unsigned)(uintptr_t)lds0; asm volatile("" : "+s"(ldsb_)); LAS unsigned char* lds = (LAS unsigned char*)(uintptr_t)ldsb_; volatile LAS unsigned* MISC = (volatile LAS unsigned*)(lds + MISC_OFF); volatile LAS unsigned long long* ARGP = (volatile LAS unsigned long long*)(lds + MISC_OFF + 768); (void)MISC; int wave = wave0, G = G0, bx = bx0; asm volatile("" : "+s"(G), "+s"(bx), "+s"(wave)); const int lane = (int)__builtin_amdgcn_mbcnt_hi(~0u, __builtin_amdgcn_mbcnt_lo(~0u, 0u)); const int tid = wave * 64 + lane; const int vcu = (bx % 8) * (G / 8) + bx / 8; const int gw = vcu * 8 + wave, NGW = G * 8; (void)lane; (void)gw; (void)NGW; (void)vcu;
            GAS unsigned char* ws = (GAS unsigned char*)LDP(22); GAS float* out = (GAS float*)LDP(21); const GAS float* x_in = (const GAS float*)ARGIN(0); (void)out; (void)x_in; (void)ws;
            GAS bf16* O = P_XN;
            const int b = vcu >> 4, hh = (vcu & 15) >> 1, sub = vcu & 1;
            const att::Tens2 TM{P_QM, 768, P_KVM, 1024, P_KPE, P_KVM + 64, 1024, O, nullptr, nullptr, P_OSS};
            const att::Tens2 TF{P_FQKV, 512, P_FQKV + (size_t)NTOK * 512, 512, P_KAUG, P_FQKV + (size_t)2 * NTOK * 512, 512, O, P_BIASF, P_NRM, P_OSS};
#define QB_OF(i) ((((i) & 1) ? 7 - (2 * sub + ((i) >> 1)) : (2 * sub + ((i) >> 1))))
            { int sb = 0; for (int i = 0; i < 4; ++i) sb = att::attn_unit2<1>(wave, b, hh, QB_OF(i), TM, (LAS char*)lds, sb, i > 0, i < 3 ? QB_OF(i + 1) : -1); }
            { int sb = 0; for (int i = 0; i < 4; ++i) sb = att::attn_unit2<0>(wave, b, hh, QB_OF(i), TF, (LAS char*)lds, sb, i > 0, i < 3 ? QB_OF(i + 1) : -1); }
#undef QB_OF
        }
        SEAM(P + 3);
        if (IN(P + 5)) for (int rep_ = 0; rep_ < ((l == 0 || 5 != 5) ? NREP(5) : 1); ++rep_) {
            unsigned ldsb_ = (unsigned)(uintptr_t)lds0; asm volatile("" : "+s"(ldsb_)); LAS unsigned char* lds = (LAS unsigned char*)(uintptr_t)ldsb_; volatile LAS unsigned* MISC = (volatile LAS unsigned*)(lds + MISC_OFF); volatile LAS unsigned long long* ARGP = (volatile LAS unsigned long long*)(lds + MISC_OFF + 768); (void)MISC; int wave = wave0, G = G0, bx = bx0; asm volatile("" : "+s"(G), "+s"(bx), "+s"(wave)); const int lane = (int)__builtin_amdgcn_mbcnt_hi(~0u, __builtin_amdgcn_mbcnt_lo(~0u, 0u)); const int tid = wave * 64 + lane; const int vcu = (bx % 8) * (G / 8) + bx / 8; const int gw = vcu * 8 + wave, NGW = G * 8; (void)lane; (void)gw; (void)NGW; (void)vcu;
            GAS unsigned char* ws = (GAS unsigned char*)LDP(22); GAS float* out = (GAS float*)LDP(21); const GAS float* x_in = (const GAS float*)ARGIN(0); (void)out; (void)x_in; (void)ws;
            DenseOrder S{NTOK / 256, DM / 256, (NTOK / 256) * (DM / 256), G, bx, (const GAS char*)P_XN, (const GAS char*)P_WOUT, (size_t)256 * DM * 2, (size_t)256 * DM * 2};
            EpiOut<false> E{x_in, P_XR};
            LAS f32x2* scl = (LAS f32x2*)(lds + pg8::STAGE_BYTES);
            { Unit u_; if (S.next(tid >> 8, u_)) { const GAS float* op = P_OSS + ((size_t)u_.pm * 256 + (tid & 255)) * 16;
                  const f32x4 a0 = *(const GAS f32x4*)op, a1 = *(const GAS f32x4*)(op + 4), c0 = *(const GAS f32x4*)(op + 8), c1 = *(const GAS f32x4*)(op + 12);
                  const float sm = ((a0[0] + a0[1]) + (a0[2] + a0[3])) + ((a1[0] + a1[1]) + (a1[2] + a1[3])), sf = ((c0[0] + c0[1]) + (c0[2] + c0[3])) + ((c1[0] + c1[1]) + (c1[2] + c1[3]));
                  const float rm_ = rsqrtf(sm * (1.f / 512.f) + EPS), rf_ = rsqrtf(sf * (1.f / 512.f) + EPS);
                  scl[tid] = (f32x2){rm_ / rf_, rf_}; } }
            __syncthreads();
            pg8::gemm_phase<EpiOut<false>, DenseOrder, true, false, false, true>(tid, lds, DM * 2, DM * 2, DM * 2, S, E, nullptr, scl);
        }
        SEAM(P + 5);
        if (IN(P + 6)) for (int rep_ = 0; rep_ < ((l == 0 || 6 != 5) ? NREP(6) : 1); ++rep_) {
            unsigned ldsb_ = (unsigned)(uintptr_t)lds0; asm volatile("" : "+s"(ldsb_)); LAS unsigned char* lds = (LAS unsigned char*)(uintptr_t)ldsb_; volatile LAS unsigned* MISC = (volatile LAS unsigned*)(lds + MISC_OFF); volatile LAS unsigned long long* ARGP = (volatile LAS unsigned long long*)(lds + MISC_OFF + 768); (void)MISC; int wave = wave0, G = G0, bx = bx0; asm volatile("" : "+s"(G), "+s"(bx), "+s"(wave)); const int lane = (int)__builtin_amdgcn_mbcnt_hi(~0u, __builtin_amdgcn_mbcnt_lo(~0u, 0u)); const int tid = wave * 64 + lane; const int vcu = (bx % 8) * (G / 8) + bx / 8; const int gw = vcu * 8 + wave, NGW = G * 8; (void)lane; (void)gw; (void)NGW; (void)vcu;
            GAS unsigned char* ws = (GAS unsigned char*)LDP(22); GAS float* out = (GAS float*)LDP(21); const GAS float* x_in = (const GAS float*)ARGIN(0); (void)out; (void)x_in; (void)ws;
            GAS bf16* H2 = P_XN;
            LAS bf16* WT = (LAS bf16*)lds;
            LAS float* LG = (LAS float*)(lds + 99840) + wave * 576;
            const GAS float* b_rg = (const GAS float*)ARGIN(14) + l * 4; const GAS float* b_re = (const GAS float*)ARGIN(16) + l * 32;
            if (tid < 32) MISC[64 + tid] = 0u;
            const int r16 = lane & 15, g4 = lane >> 4;
            const int m0 = vcu * 128 + wave * 16;
            const GAS bf16* xrow = P_XR + (size_t)(m0 + r16) * DM + 8 * g4;
            GAS unsigned char* hrow = (GAS unsigned char*)H2 + (size_t)(m0 + r16) * DM + 8 * g4;
            f32x4 acc3[3]; acc3[0] = (f32x4){0.f, 0.f, 0.f, 0.f}; acc3[1] = acc3[0]; acc3[2] = acc3[0];
            float ssq = 0.f;
            for (int half = 0; half < 2; ++half) {
                __syncthreads();
                for (int idx = tid; idx < 2 * 48 * 520 / 8; idx += 512) *(LAS u32x4*)(WT + 8 * idx) = *(const GAS u32x4*)(P_WR + (size_t)half * 2 * 48 * 520 + 8 * idx);
                __syncthreads();
                for (int s8 = 0; s8 < 16; s8 += 8) {
                    bf16x8 xv[8];
#pragma unroll
                    for (int u = 0; u < 8; ++u) xv[u] = *(const GAS bf16x8*)(xrow + half * 512 + 32 * (s8 + u));
#pragma unroll
                    for (int u = 0; u < 8; ++u) {
                        const u32x4 xw = __builtin_bit_cast(u32x4, xv[u]); float xf[8];
#pragma unroll
                        for (int j = 0; j < 4; ++j) { xf[2 * j] = __uint_as_float(xw[j] << 16); xf[2 * j + 1] = __uint_as_float(xw[j] & 0xffff0000u); }
                        u32x2 hw; hw.x = pk4_fp8(xf[0], xf[1], xf[2], xf[3]); hw.y = pk4_fp8(xf[4], xf[5], xf[6], xf[7]); *(GAS u32x2*)(hrow + half * 512 + 32 * (s8 + u)) = hw;
#pragma unroll
                        for (int j = 0; j < 8; ++j) ssq += xf[j] * xf[j];
                        const LAS bf16* wk = WT + r16 * 520 + 32 * (s8 + u) + 8 * g4;
#pragma unroll
                        for (int ct = 0; ct < 3; ++ct) { const bf16x8 bh = *(const LAS bf16x8*)(wk + ct * 16 * 520), bl = *(const LAS bf16x8*)(wk + (48 + ct * 16) * 520);
                            acc3[ct] = __builtin_amdgcn_mfma_f32_16x16x32_bf16(xv[u], bh, acc3[ct], 0, 0, 0); acc3[ct] = __builtin_amdgcn_mfma_f32_16x16x32_bf16(xv[u], bl, acc3[ct], 0, 0, 0); }
                    }
                }
            }
            ssq += __shfl_xor(ssq, 16); ssq += __shfl_xor(ssq, 32);
            const float rstd = rsqrtf(ssq * (1.f / DM) + EPS);
#pragma unroll
            for (int ct = 0; ct < 3; ++ct) { const int c = 16 * ct + r16; if (c < 36) {
#pragma unroll
                for (int rg = 0; rg < 4; ++rg) LG[(4 * g4 + rg) * 36 + c] = acc3[ct][rg]; } }
            LDS_WAIT();
            if (lane < 16) {
                const int m = m0 + lane; const LAS float* lg = LG + lane * 36;
                float gl[4];
#pragma unroll
                for (int g = 0; g < 4; ++g) gl[g] = lg[g] * rstd + b_rg[g];
                int gi = 0; float gm = gl[0];
#pragma unroll
                for (int g = 1; g < 4; ++g) if (gl[g] > gm) { gm = gl[g]; gi = g; }
                float gs = 0.f;
#pragma unroll
                for (int g = 0; g < 4; ++g) gs += __expf(gl[g] - gm);
                const float gval = 1.f / gs;
                float el[8];
#pragma unroll
                for (int j = 0; j < 8; ++j) el[j] = lg[4 + 8 * gi + j] * rstd + b_re[8 * gi + j];
                int i0 = 0; float mx0 = el[0];
#pragma unroll
                for (int j = 1; j < 8; ++j) if (el[j] > mx0) { mx0 = el[j]; i0 = j; }
                int i1 = -1; float mx1 = -INFINITY;
#pragma unroll
                for (int j = 0; j < 8; ++j) if (j != i0 && el[j] > mx1) { mx1 = el[j]; i1 = j; }
                const float e1 = __expf(mx1 - mx0); const float g0 = gval / (1.f + e1), g1 = gval * e1 / (1.f + e1);
                const int ea = gi * 8 + i0, eb = gi * 8 + i1; P_E01[2 * m] = ea; P_E01[2 * m + 1] = eb; P_G01[2 * m] = g0; P_G01[2 * m + 1] = g1; P_RSTD[m] = rstd;
                __hip_atomic_fetch_add((LAS unsigned*)(lds + MISC_OFF) + 64 + ea, 1u, __ATOMIC_RELAXED, __HIP_MEMORY_SCOPE_WORKGROUP); __hip_atomic_fetch_add((LAS unsigned*)(lds + MISC_OFF) + 64 + eb, 1u, __ATOMIC_RELAXED, __HIP_MEMORY_SCOPE_WORKGROUP);
            }
            __syncthreads();
            if (tid < 32) P_CNT[vcu * 32 + tid] = (int)MISC[64 + tid];
        }
        SEAM(P + 6);
        if (IN(P + 7)) for (int rep_ = 0; rep_ < ((l == 0 || 7 != 5) ? NREP(7) : 1); ++rep_) {
            unsigned ldsb_ = (unsigned)(uintptr_t)lds0; asm volatile("" : "+s"(ldsb_)); LAS unsigned char* lds = (LAS unsigned char*)(uintptr_t)ldsb_; volatile LAS unsigned* MISC = (volatile LAS unsigned*)(lds + MISC_OFF); volatile LAS unsigned long long* ARGP = (volatile LAS unsigned long long*)(lds + MISC_OFF + 768); (void)MISC; int wave = wave0, G = G0, bx = bx0; asm volatile("" : "+s"(G), "+s"(bx), "+s"(wave)); const int lane = (int)__builtin_amdgcn_mbcnt_hi(~0u, __builtin_amdgcn_mbcnt_lo(~0u, 0u)); const int tid = wave * 64 + lane; const int vcu = (bx % 8) * (G / 8) + bx / 8; const int gw = vcu * 8 + wave, NGW = G * 8; (void)lane; (void)gw; (void)NGW; (void)vcu;
            GAS unsigned char* ws = (GAS unsigned char*)LDP(22); GAS float* out = (GAS float*)LDP(21); const GAS float* x_in = (const GAS float*)ARGIN(0); (void)out; (void)x_in; (void)ws;
            LAS int* cnt_all = (LAS int*)lds;
            LAS int* pre_e = (LAS int*)(lds + 32768);
            LAS int* tot_e = pre_e + 32;
            LAS int* pst = pre_e + 64;
            LAS int* eL = pre_e + 128;
            for (int i = tid; i < 256 * 32; i += 512) cnt_all[i] = P_CNT[i];
            if (tid < 256) eL[tid] = P_E01[vcu * 256 + tid];
            __syncthreads();
            { LAS int* part = pre_e + 512;
              const int e = tid & 31, p = tid >> 5; int pre = 0, tot = 0;
#pragma unroll
              for (int j = 0; j < 16; ++j) { const int w = p * 16 + j; const int c = cnt_all[w * 32 + e]; pre += (w < vcu) ? c : 0; tot += c; }
              part[(p * 2) * 32 + e] = pre; part[(p * 2 + 1) * 32 + e] = tot; }
            __syncthreads();
            if (tid < 32) { LAS int* part = pre_e + 512; int pre = 0, tot = 0;
#pragma unroll
                for (int p = 0; p < 16; ++p) { pre += part[(p * 2) * 32 + tid]; tot += part[(p * 2 + 1) * 32 + tid]; } pre_e[tid] = pre; tot_e[tid] = tot; }
            __syncthreads();
            if (tid == 0) { int acc = 0; for (int e = 0; e < 32; ++e) { pst[e] = acc; acc += (tot_e[e] + 255) / 256 * 256; } pst[32] = acc; }
            __syncthreads();
            if (vcu == 0 && tid <= 32) P_TSTART[tid] = pst[tid] / 256;
            { LAS int* hist = pre_e + 2048;
              if (tid < 128) hist[tid] = 0;
              __syncthreads();
              int e = 0, rin = 0;
              if (tid < 256) { e = eL[tid]; unsigned long long mym = 0ull;
                  for (int x = 0; x < 32; ++x) { const unsigned long long bm = __ballot(e == x); if (e == x) mym = bm; }
                  rin = __builtin_popcountll(mym & ((1ull << lane) - 1ull));
                  if (rin == 0) hist[wave * 32 + e] = __builtin_popcountll(mym); }
              __syncthreads();
              if (tid < 256) { int r = rin; for (int w = 0; w < wave; ++w) r += hist[w * 32 + e];
                  const int slot = pst[e] + pre_e[e] + r; const int tok = vcu * 128 + (tid >> 1);
                  P_SLOT[vcu * 256 + tid] = slot; P_TOKOF[slot] = tok; P_GATEOF[slot] = P_G01[vcu * 256 + tid]; P_RSTDOF[slot] = P_RSTD[tok]; } }
            if (vcu < 32) { const int e = vcu; for (int s = pst[e] + tot_e[e] + tid; s < pst[e + 1]; s += 512) { P_TOKOF[s] = 0; P_GATEOF[s] = 0.f; P_RSTDOF[s] = 0.f; } }
            __syncthreads();
        }
        SEAM(P + 7);
        if (IN(P + 8)) for (int rep_ = 0; rep_ < ((l == 0 || 8 != 5) ? NREP(8) : 1); ++rep_) {
            unsigned ldsb_ = (unsigned)(uintptr_t)lds0; asm volatile("" : "+s"(ldsb_)); LAS unsigned char* lds = (LAS unsigned char*)(uintptr_t)ldsb_; volatile LAS unsigned* MISC = (volatile LAS unsigned*)(lds + MISC_OFF); volatile LAS unsigned long long* ARGP = (volatile LAS unsigned long long*)(lds + MISC_OFF + 768); (void)MISC; int wave = wave0, G = G0, bx = bx0; asm volatile("" : "+s"(G), "+s"(bx), "+s"(wave)); const int lane = (int)__builtin_amdgcn_mbcnt_hi(~0u, __builtin_amdgcn_mbcnt_lo(~0u, 0u)); const int tid = wave * 64 + lane; const int vcu = (bx % 8) * (G / 8) + bx / 8; const int gw = vcu * 8 + wave, NGW = G * 8; (void)lane; (void)gw; (void)NGW; (void)vcu;
            GAS unsigned char* ws = (GAS unsigned char*)LDP(22); GAS float* out = (GAS float*)LDP(21); const GAS float* x_in = (const GAS float*)ARGIN(0); (void)out; (void)x_in; (void)ws;
            volatile LAS int* TS = (volatile LAS int*)(MISC + 128);
            if (tid <= 32) TS[tid] = P_TSTART[tid];
            __syncthreads();
            MoeOrder S{G, vcu, TS, (const GAS char*)P_XN, (const GAS char*)P_WGU_L(l), 0, (size_t)1024 * 1024, (size_t)256 * 1024};
            EpiGU E{(GAS unsigned char*)P_HH, P_RSTDOF};
            pg8::gemm_phase<EpiGU, MoeOrder, true, true, true>(tid, lds, DM, DM, DM, S, E, P_TOKOF);
            if constexpr (l + 1 < NLAYER) {
                const int U = (int)TS[32] * 4, rem = U & 255; const int nidle = rem ? 256 - rem : 256, rk = rem ? vcu - rem : vcu;
                if (rk >= 0) { LAS float* scr64 = (LAS float*)(lds + wave * 16640);
                    const GAS float* w_gate = (const GAS float*)ARGIN(17) + (size_t)(l + 1) * NEXP * DM * DEXP; const GAS float* w_up = (const GAS float*)ARGIN(18) + (size_t)(l + 1) * NEXP * DM * DEXP; const GAS float* ffn1 = (const GAS float*)ARGIN(12) + (size_t)(l + 1) * DM;
                    for (int it = rk * 8 + wave; it < 16 * 16 * NEXP; it += nidle * 8) conv_gu_item(it, w_gate, w_up, ffn1, P_WGU_L(l + 1), scr64, lane); }
            }
        }
        SEAM(P + 8);
        if (IN(P + 9)) for (int rep_ = 0; rep_ < ((l == 0 || 9 != 5) ? NREP(9) : 1); ++rep_) {
            unsigned ldsb_ = (unsigned)(uintptr_t)lds0; asm volatile("" : "+s"(ldsb_)); LAS unsigned char* lds = (LAS unsigned char*)(uintptr_t)ldsb_; volatile LAS unsigned* MISC = (volatile LAS unsigned*)(lds + MISC_OFF); volatile LAS unsigned long long* ARGP = (volatile LAS unsigned long long*)(lds + MISC_OFF + 768); (void)MISC; int wave = wave0, G = G0, bx = bx0; asm volatile("" : "+s"(G), "+s"(bx), "+s"(wave)); const int lane = (int)__builtin_amdgcn_mbcnt_hi(~0u, __builtin_amdgcn_mbcnt_lo(~0u, 0u)); const int tid = wave * 64 + lane; const int vcu = (bx % 8) * (G / 8) + bx / 8; const int gw = vcu * 8 + wave, NGW = G * 8; (void)lane; (void)gw; (void)NGW; (void)vcu;
            GAS unsigned char* ws = (GAS unsigned char*)LDP(22); GAS float* out = (GAS float*)LDP(21); const GAS float* x_in = (const GAS float*)ARGIN(0); (void)out; (void)x_in; (void)ws;
            volatile LAS int* TS = (volatile LAS int*)(MISC + 128);
            if (tid <= 32) TS[tid] = P_TSTART[tid];
            __syncthreads();
            MoeOrder S{G, vcu, TS, (const GAS char*)P_HH, (const GAS char*)P_WD_L(l), (size_t)256 * 512, (size_t)1024 * 512, (size_t)256 * 512};
            EpiDown E{(GAS unsigned char*)P_Y, P_GATEOF};
            pg8::gemm_phase<EpiDown, MoeOrder, true, false, true>(tid, lds, DEXP, DEXP, DEXP, S, E, nullptr);
            if constexpr (l + 1 < NLAYER) {
                const int U = (int)TS[32] * 4, rem = U & 255; const int nidle = rem ? 256 - rem : 256, rk = rem ? vcu - rem : vcu;
                if (rk >= 0) { LAS float* scr64 = (LAS float*)(lds + wave * 16640);
                    const GAS float* w_down = (const GAS float*)ARGIN(19) + (size_t)(l + 1) * NEXP * DEXP * DM;
                    for (int it = rk * 8 + wave; it < 8 * 16 * NEXP; it += nidle * 8) conv_d_item(it, w_down, P_WD_L(l + 1), scr64, lane); }
            }
        }
        SEAM(P + 9);
}

__global__ void __launch_bounds__(512, 2) fwd(Args args) {
    extern __shared__ __attribute__((aligned(16))) unsigned char lds_raw[];
    LAS unsigned char* lds0 = (LAS unsigned char*)lds_raw;
    const int tid0 = threadIdx.x; const int wave0 = __builtin_amdgcn_readfirstlane(tid0 >> 6);
    const int G0 = gridDim.x; const int bx0 = blockIdx.x;
    { volatile LAS unsigned* MISC = (volatile LAS unsigned*)(lds0 + MISC_OFF); const int tid = tid0;
    for (int u = tid; u < 256; u += 512) MISC[u] = 0u;
    __syncthreads();
    volatile LAS unsigned long long* ARGP = (volatile LAS unsigned long long*)(lds0 + MISC_OFF + 768);
    if (tid < 21) ARGP[tid] = (unsigned long long)args.in[tid];
    if (tid == 21) ARGP[21] = (unsigned long long)args.out;
    if (tid == 22) ARGP[22] = (unsigned long long)args.ws;
    __syncthreads(); }
#if MK_ONE_LAUNCH
    XcdBarrier bar = xcd_barrier_post((unsigned*)(args.ws + WS_CTL) + CW_BAR, (volatile LAS unsigned*)(lds0 + MISC_OFF) + 8);
#else
    XcdBarrier bar; bar.bar = nullptr; bar.x = 0; bar.st = nullptr;
#endif
    const int lo = args.ph_lo, hi_ = args.ph_hi;
    if (IN(0)) {
        const GAS int* positions = (const GAS int*)args.in[1]; GAS float* COSp = (GAS float*)(args.ws + WS_COS); GAS float* SINp = (GAS float*)(args.ws + WS_SIN);
        for (int i = bx0 * 512 + tid0; i < NTOK * 16; i += G0 * 512) { const int tk = i >> 4, fi = i & 15;
            const double inv = exp2(-(double)fi * (13.287712379549449 / 16.0)); const double ang = (double)positions[tk] * inv;
            COSp[i] = (float)cos(ang); SINp[i] = (float)sin(ang); }
    }
    layer_body<0>(lo, hi_, lds0, wave0, G0, bx0, bar);
    layer_body<1>(lo, hi_, lds0, wave0, G0, bx0, bar);
    layer_body<2>(lo, hi_, lds0, wave0, G0, bx0, bar);
}

extern "C" void kernel_launch(void* const* d_in, const int* in_sizes, int n_in, void* d_out, int out_size, void* d_ws, size_t ws_size, hipStream_t stream) {
    static int grid = 0;
    if (grid == 0) {
        if (n_in != 21 || out_size != NTOK * DM || ws_size < WS_END) { fprintf(stderr, "kernel_launch: unexpected shapes (n_in %d out %d ws %zu)\n", n_in, out_size, ws_size); grid = -1; return; }
        int dev = 0, cus = 0;
        if (hipGetDevice(&dev) != hipSuccess || hipDeviceGetAttribute(&cus, hipDeviceAttributeMultiprocessorCount, dev) != hipSuccess) { grid = -1; return; }
        if (hipFuncSetAttribute((const void*)fwd, hipFuncAttributeMaxDynamicSharedMemorySize, LDS_BYTES) != hipSuccess) { fprintf(stderr, "kernel_launch: hipFuncSetAttribute failed\n"); grid = -1; return; }
        int per_cu = 0;
        if (hipOccupancyMaxActiveBlocksPerMultiprocessor(&per_cu, (const void*)fwd, 512, LDS_BYTES) != hipSuccess || per_cu < 1) fprintf(stderr, "kernel_launch: occupancy query says %d\n", per_cu);
        (void)hipGetLastError();
        grid = cus;
        if (grid != 256) { fprintf(stderr, "kernel_launch: built for 256 CUs, got %d\n", grid); grid = -1; return; }
    }
    if (grid < 0) return;
    if (hipMemsetAsync((char*)d_ws + WS_CTL, 0, CTL_ZERO_BYTES, stream) != hipSuccess) return;
    Args a{};
    for (int i = 0; i < 21; ++i) a.in[i] = d_in[i];
    a.out = (float*)d_out; a.ws = (unsigned char*)d_ws;
#if MK_ONE_LAUNCH
    a.ph_lo = 0; a.ph_hi = 21;
    hipLaunchKernelGGL(fwd, dim3(grid), dim3(512), LDS_BYTES, stream, a);
#else
    for (int p = 0; p <= 20; ++p) { a.ph_lo = p; a.ph_hi = p + 1; hipLaunchKernelGGL(fwd, dim3(grid), dim3(512), LDS_BYTES, stream, a); }
#endif
}
```

```cpp
#include <hip/hip_runtime.h>
#include <cstdio>
#include <cstdint>

#ifndef PROBE_PHASE
#define PROBE_PHASE -1
#endif
#define NREP(k) ((PROBE_PHASE) == (k) ? 2 : 1)
#ifndef MK_ONE_LAUNCH
#define MK_ONE_LAUNCH 1
#endif

#define LAS __attribute__((address_space(3)))
#define GAS __attribute__((address_space(1)))
typedef unsigned short bf16;
typedef short bf16x8 __attribute__((ext_vector_type(8)));
typedef short s16x4 __attribute__((ext_vector_type(4)));
typedef float f32x4 __attribute__((ext_vector_type(4)));
typedef float f32x2 __attribute__((ext_vector_type(2)));
typedef float f32x16 __attribute__((ext_vector_type(16)));
typedef unsigned u32x4 __attribute__((ext_vector_type(4)));
typedef unsigned u32x2 __attribute__((ext_vector_type(2)));

constexpr int NB = 16, SEQ = 2048, DM = 1024, NTOK = NB * SEQ, NLAYER = 2;
constexpr int INW = 1960, INP = 2048;
constexpr int NEXP = 32, DEXP = 512;
constexpr int MAXSLOT = 73728;
constexpr float EPS = 1e-6f;
constexpr float WSCALE = 64.f, WSCALE_INV = 1.f / 64.f;
constexpr float LOG2E = 1.4426950408889634f;
constexpr float C2F = 0.125f * LOG2E;
constexpr float C2M = 0.10206207261596575f * LOG2E;

constexpr size_t MiB = 1u << 20, KiB = 1u << 10;
constexpr size_t WS_CTL = 0, CTL_ZERO_BYTES = 64 * KiB;
constexpr size_t WS_COS = 1 * MiB, WS_SIN = 3 * MiB;
constexpr size_t WS_SSQ = 5 * MiB;
constexpr size_t WS_FLOG = 6 * MiB;
constexpr size_t WS_E01 = 8 * MiB;
constexpr size_t WS_G01 = 8 * MiB + 256 * KiB;
constexpr size_t WS_SLOT = 8 * MiB + 512 * KiB;
constexpr size_t WS_TOKOF = 8 * MiB + 768 * KiB;
constexpr size_t WS_GATEOF = 9 * MiB + 256 * KiB;
constexpr size_t WS_CNT = 9 * MiB + 768 * KiB;
constexpr size_t WS_TSTART = 9 * MiB + 800 * KiB;
constexpr size_t WS_RSTD = 9 * MiB + 832 * KiB;
constexpr size_t WS_RSTDOF = 7 * MiB;
constexpr size_t WS_KPE = 10 * MiB;
constexpr size_t WS_KAUG = 10 * MiB + 2 * MiB;
constexpr size_t WS_WIN = 16 * MiB;
constexpr size_t WS_WUQ = 20 * MiB;
constexpr size_t WS_WUKV = 20 * MiB + 512 * KiB;
constexpr size_t WS_WOUT = 21 * MiB;
constexpr size_t WS_WGU = 24 * MiB;
constexpr size_t WS_WD = 88 * MiB;
constexpr size_t WS_XN = 120 * MiB;
constexpr size_t WS_FQKV = 184 * MiB;
constexpr size_t WS_LAT = 280 * MiB;
constexpr size_t WS_QM = 312 * MiB;
constexpr size_t WS_KVM = 360 * MiB;
constexpr size_t WS_Y = 280 * MiB;
constexpr size_t WS_BIASF = 424 * MiB;
constexpr size_t WS_NRM = 425 * MiB;
constexpr size_t WS_WR = 426 * MiB;
constexpr size_t WS_XR = 427 * MiB;
constexpr size_t WS_OSS = 491 * MiB;
constexpr size_t WS_RSTDX = 493 * MiB;
constexpr size_t WS_END = 494 * MiB;
static_assert(WS_Y + (size_t)MAXSLOT * 1024 * 2 <= WS_END, "Y fits");
static_assert(WS_FQKV + (size_t)MAXSLOT * 512 * 2 <= WS_LAT, "HH fits");

constexpr int CW_BAR = 1024;

constexpr int RING_BYTES = 147456;
constexpr int MISC_OFF = RING_BYTES;
constexpr int LDS_BYTES = RING_BYTES + 1024;

typedef __bf16 bf16x2_t __attribute__((ext_vector_type(2)));
__device__ __forceinline__ unsigned cvt_pk_bf16(float lo, float hi) { const f32x2 v = {lo, hi}; const bf16x2_t b = __builtin_convertvector(v, bf16x2_t); return __builtin_bit_cast(unsigned, b); }
__device__ __forceinline__ float bf2f(unsigned short b) { return __uint_as_float((unsigned)b << 16); }
__device__ __forceinline__ float wave_sum(float v) {
#pragma unroll
    for (int o = 1; o < 64; o <<= 1) v += __shfl_xor(v, o);
    return v;
}
__device__ __forceinline__ unsigned pk4_fp8(float a, float b, float c, float d) { int w = 0; w = __builtin_amdgcn_cvt_pk_fp8_f32(a, b, w, false); w = __builtin_amdgcn_cvt_pk_fp8_f32(c, d, w, true); return (unsigned)w; }
#define LDS_WAIT() asm volatile("s_waitcnt lgkmcnt(0)" ::: "memory")

#define XB_TMO      128
#define XB_XCNT(j)  (256  + 64 * (j))
#define XB_XSUB(j)  (1280 + 64 * (j))
#define XB_XGEN(j)  (2304 + 64 * (j))
#define XB_TOP      3328
#define XB_TOPGEN   3392
#define XCD_BAR_WORDS 3456
#define XB_SPIN_CAP (1u << 18)
__device__ __forceinline__ unsigned xb_ld(unsigned* p)              { return __hip_atomic_load(p, __ATOMIC_RELAXED, __HIP_MEMORY_SCOPE_AGENT); }
__device__ __forceinline__ unsigned xb_add(unsigned* p, unsigned v) { return __hip_atomic_fetch_add(p, v, __ATOMIC_RELAXED, __HIP_MEMORY_SCOPE_AGENT); }
__device__ __forceinline__ unsigned xb_xcc_id() { return (unsigned)__builtin_amdgcn_s_getreg((3 << 11) | 20) & 0xFu; }
#define XB_SPIN(cond, bar) do { unsigned _sp = 0; while (cond) { __builtin_amdgcn_s_sleep(1); \
    if ((++_sp & 255u) == 0u) { if (xb_ld(&(bar)[XB_TMO])) break; if (_sp > XB_SPIN_CAP) { atomicAdd(&(bar)[XB_TMO], 1u); break; } } } } while (0)
struct XcdBarrier { unsigned* bar; unsigned x; volatile LAS unsigned* st; };
__device__ __forceinline__ XcdBarrier xcd_barrier_post(unsigned* bar, volatile LAS unsigned* st) {
    XcdBarrier b; b.bar = bar; b.x = xb_xcc_id(); b.st = st;
    if (threadIdx.x == 0) (void)xb_add(&bar[XB_XCNT(b.x)], 1u);
    return b;
}
__device__ __forceinline__ void xcd_barrier_complete(unsigned* bar, unsigned x, unsigned& nloc, unsigned& nx) {
    const unsigned G = gridDim.x * gridDim.y * gridDim.z;
    unsigned sum, cnt, mine, sp = 0u;
    for (;;) {
        sum = 0u; cnt = 0u; mine = 0u;
#pragma unroll
        for (unsigned j = 0; j < 16; ++j) { const unsigned c = xb_ld(&bar[XB_XCNT(j)]); sum += c; cnt += (c > 0u) ? 1u : 0u; mine = (j == x) ? c : mine; }
        if (sum == G) break;
        __builtin_amdgcn_s_sleep(1);
        if ((++sp & 255u) == 0u) { if (xb_ld(&bar[XB_TMO])) break; if (sp > XB_SPIN_CAP) { atomicAdd(&bar[XB_TMO], 1u); break; } }
    }
    nloc = mine > 0u ? mine : 1u; nx = cnt > 0u ? cnt : 1u;
}
__device__ __forceinline__ void xcd_barrier(const XcdBarrier& b) {
    asm volatile("s_waitcnt vmcnt(0)" ::: "memory");
    __syncthreads();
    if (threadIdx.x == 0) {
        unsigned* bar = b.bar;
        __builtin_amdgcn_s_waitcnt(0);
        unsigned nloc = b.st[0], nx = b.st[1];
        if (nloc == 0u) { xcd_barrier_complete(bar, b.x, nloc, nx); b.st[0] = nloc; b.st[1] = nx; }
        const unsigned old = xb_add(&bar[XB_XSUB(b.x)], 1u);
        const unsigned gen = old / nloc;
        if (old + 1u == (gen + 1u) * nloc) {
            __builtin_amdgcn_fence(__ATOMIC_RELEASE, "agent");
            asm volatile("s_waitcnt vmcnt(0)" ::: "memory");
            const unsigned og = xb_add(&bar[XB_TOP], 1u);
            const unsigned tg = og / nx;
            if (og + 1u == (tg + 1u) * nx) xb_add(&bar[XB_TOPGEN], 1u);
            else XB_SPIN(xb_ld(&bar[XB_TOPGEN]) == tg, bar);
            __builtin_amdgcn_fence(__ATOMIC_ACQUIRE, "agent");
            xb_add(&bar[XB_XGEN(b.x)], 1u);
            asm volatile("s_waitcnt vmcnt(0)" ::: "memory");
        } else {
            XB_SPIN(xb_ld(&bar[XB_XGEN(b.x)]) == gen, bar);
            __builtin_amdgcn_fence(__ATOMIC_ACQUIRE, "agent");
            asm volatile("s_waitcnt vmcnt(0)" ::: "memory");
        }
    }
    __syncthreads();
}

namespace pg8 {
constexpr int BM = 256, BK = 64, HALF = 128, HTB = HALF * BK * 2, STAGE_BYTES = 8 * HTB;
typedef int v4i32_t __attribute__((ext_vector_type(4)));
typedef int v8i32_t __attribute__((ext_vector_type(8)));
__host__ __device__ __forceinline__ int lds_byte(int r, int c) { const int st = (r >> 4) * 2 + (c >> 5), rr = r & 15, cc = c & 31, ob = rr * 64 + cc * 2; return st * 1024 + (ob ^ (((ob >> 9) & 1) << 5)); }
__host__ __device__ __forceinline__ void stage_rc(int b, int& R, int& C) { const int st = b / 1024, sb = b % 1024, swz = sb ^ (((sb >> 9) & 1) << 5); R = (st >> 1) * 16 + swz / 64; C = (st & 1) * 32 + (swz % 64) / 2; }
__host__ __device__ __forceinline__ int perm32(int rho) { const int n = rho >> 4, i = rho & 15; return 8 * (i >> 2) + 4 * n + (i & 3); }

struct Unit { const GAS char* a; const GAS char* b; int pm, pn, e; };

template <int N> __device__ __forceinline__ void wait_vm() { asm volatile("s_waitcnt vmcnt(%0)" :: "n"(N) : "memory"); }
template <class Epi, class Sched, bool ALIGN_EPI, bool GATHER, bool FP8 = false, bool MIDSCALE = false>
__device__ __forceinline__ void gemm_phase(const int tid, LAS unsigned char* lds, const int Kb, const int ldaB, const int ldbB, const Sched& S, const Epi& E, const GAS int* __restrict__ tokof, const LAS f32x2* scl = nullptr) {
    const int wid = __builtin_amdgcn_readfirstlane(tid >> 6), lane = tid & 63, wr = wid >> 2, wc = wid & 3, fr = lane & 15, fq = lane >> 4;
    const int nt = Kb / 128;
    unsigned voffA[2], voffB[2]; int RA[2], CA2[2];
#pragma unroll
    for (int i = 0; i < 2; ++i) { int R, C; stage_rc(tid * 16 + i * 8192, R, C); const int Rb = Epi::PERM ? ((R & ~31) + perm32(R & 31)) : R;
        voffA[i] = (unsigned)(R * ldaB + C * 2); voffB[i] = (unsigned)(Rb * ldbB + C * 2); RA[i] = R; CA2[i] = C * 2; }
    const size_t kstep = (size_t)(BK * 2);
    const size_t hstepA = GATHER ? 0 : (size_t)HALF * ldaB;
    const size_t hstepB = (size_t)HALF * ldbB;
    const unsigned ldsw = (unsigned)wid * 1024u;
    const int aoff = lds_byte(wr * 64 + fr, fq * 8), boff = lds_byte(wc * 32 + fr, fq * 8);
    unsigned gcur[2][2], gnxt[2][2];
    const int scl8 = 0x7F7F7F7F;
#define PG8_SA(b, h) (((b) * 2 + (h)) * HTB)
#define PG8_SB(b, h) ((4 + (b) * 2 + (h)) * HTB)
#define PG8_STAGE(bufoff, gbase, voff) do { const unsigned long long gb_ = (unsigned long long)(gbase); const unsigned lbase_ = (unsigned)__builtin_amdgcn_readfirstlane((int)((unsigned)(uintptr_t)lds + (unsigned)(bufoff) + ldsw)); \
        _Pragma("unroll") for (int _i = 0; _i < 2; ++_i) { unsigned keep_; \
            asm volatile("s_mov_b32 %0, m0\n\ts_mov_b32 m0, %3\n\ts_nop 0\n\tglobal_load_lds_dwordx4 %1, %2\n\ts_mov_b32 m0, %0" : "=&s"(keep_) : "v"((voff)[_i]), "s"(gb_), "s"(lbase_ + (unsigned)(_i * 8192)) : "memory"); } } while (0)
#define PG8_STAGE_A(bufoff, base, h, nx) do { if constexpr (GATHER) { unsigned _v[2]; _v[0] = (nx) ? gnxt[h][0] : gcur[h][0]; _v[1] = (nx) ? gnxt[h][1] : gcur[h][1]; PG8_STAGE(bufoff, base, _v); } \
        else { PG8_STAGE(bufoff, (base) + (h) * hstepA, voffA); } } while (0)
#define PG8_LDA(dst, b, h) do { _Pragma("unroll") for (int m = 0; m < 4; ++m) _Pragma("unroll") for (int k = 0; k < 2; ++k) dst[m][k] = *(const LAS bf16x8*)(lds + PG8_SA(b, h) + aoff + m * 2048 + k * 1024); } while (0)
#define PG8_LDB(dst, b, h) do { _Pragma("unroll") for (int n = 0; n < 2; ++n) _Pragma("unroll") for (int k = 0; k < 2; ++k) dst[n][k] = *(const LAS bf16x8*)(lds + PG8_SB(b, h) + boff + n * 2048 + k * 1024); } while (0)
#define PG8_MMA(ai, bj, At, Bt) do { __builtin_amdgcn_s_setprio(1); if constexpr (FP8) { _Pragma("unroll") for (int m = 0; m < 4; ++m) _Pragma("unroll") for (int n = 0; n < 2; ++n) { \
        const v8i32_t b8_ = __builtin_shufflevector(__builtin_bit_cast(v4i32_t, Bt[n][0]), __builtin_bit_cast(v4i32_t, Bt[n][1]), 0, 1, 2, 3, 4, 5, 6, 7), a8_ = __builtin_shufflevector(__builtin_bit_cast(v4i32_t, At[m][0]), __builtin_bit_cast(v4i32_t, At[m][1]), 0, 1, 2, 3, 4, 5, 6, 7); \
        asm volatile("s_nop 1\n\tv_mfma_scale_f32_16x16x128_f8f6f4 %0, %1, %2, %0, %3, %3 op_sel_hi:[0,0,0]" : "+v"(acc[ai][bj][m][n]) : "v"(b8_), "v"(a8_), "v"(scl8)); } } \
      else { _Pragma("unroll") for (int m = 0; m < 4; ++m) _Pragma("unroll") for (int n = 0; n < 2; ++n) _Pragma("unroll") for (int k = 0; k < 2; ++k) \
        acc[ai][bj][m][n] = __builtin_amdgcn_mfma_f32_16x16x32_bf16(Bt[n][k], At[m][k], acc[ai][bj][m][n], 0, 0, 0); } __builtin_amdgcn_s_setprio(0); } while (0)
#define PG8_WAIT_V(n) asm volatile("s_waitcnt vmcnt(" #n ")" ::: "memory")
#define PG8_WAIT_L(n) asm volatile("s_waitcnt lgkmcnt(" #n ")" ::: "memory")
#define PG8_BAR __builtin_amdgcn_s_barrier()
#define PG8_SCHED __builtin_amdgcn_sched_barrier(0)
#define PG8_GLOAD(dst, u) do { if constexpr (GATHER) { _Pragma("unroll") for (int _h = 0; _h < 2; ++_h) _Pragma("unroll") for (int _i = 0; _i < 2; ++_i) \
        dst[_h][_i] = (unsigned)tokof[(u).pm * BM + _h * HALF + RA[_i]] * (unsigned)ldaB + (unsigned)CA2[_i]; } } while (0)
    Unit cur, nxt; int ui = 0;
    if (!S.next(0, cur)) return;
    PG8_GLOAD(gcur, cur);
    f32x4 acc[2][2][4][2];
#pragma unroll
    for (int a = 0; a < 2; ++a)
#pragma unroll
        for (int b = 0; b < 2; ++b)
#pragma unroll
            for (int m = 0; m < 4; ++m)
#pragma unroll
                for (int n = 0; n < 2; ++n) acc[a][b][m][n] = (f32x4){0.f, 0.f, 0.f, 0.f};
    bf16x8 At[4][2], B0[2][2], B1[2][2];
    const GAS char* cA = cur.a; const GAS char* cB = cur.b;
    PG8_STAGE(PG8_SB(0, 0), cB, voffB); PG8_STAGE(PG8_SB(0, 1), cB + hstepB, voffB); PG8_STAGE_A(PG8_SA(0, 0), cA, 0, false); PG8_STAGE_A(PG8_SA(0, 1), cA, 1, false);
    if (wr == 1) PG8_BAR;
    PG8_WAIT_V(2); PG8_BAR;
    PG8_STAGE(PG8_SB(1, 0), cB + kstep, voffB); PG8_STAGE_A(PG8_SA(1, 0), cA + kstep, 0, false); PG8_STAGE(PG8_SB(1, 1), cB + hstepB + kstep, voffB);
    PG8_WAIT_V(6); PG8_BAR;
    bool fresh = false;
    for (;;) {
        const bool has_next = S.next(ui + 1, nxt);
        if constexpr (GATHER) { if (has_next) { PG8_GLOAD(gnxt, nxt); } else { _Pragma("unroll") for (int _h = 0; _h < 2; ++_h) _Pragma("unroll") for (int _i = 0; _i < 2; ++_i) gnxt[_h][_i] = gcur[_h][_i]; } }
        const GAS char* nA = has_next ? nxt.a : cA; const GAS char* nB = has_next ? nxt.b : cB;
#pragma nounroll
        for (int t = 0; t < nt; t += 2) {
            const bool last = (t == nt - 2);
            const GAS char* a1 = cA + (size_t)(t + 1) * kstep;
            const GAS char* a2 = last ? nA : cA + (size_t)(t + 2) * kstep; const GAS char* b2 = last ? nB : cB + (size_t)(t + 2) * kstep;
            const GAS char* a3 = a2 + kstep; const GAS char* b3 = b2 + kstep;
            const bool fe = fresh; fresh = false;
            if constexpr (MIDSCALE) { if (t == nt / 2) {
#pragma unroll
                for (int ai = 0; ai < 2; ++ai)
#pragma unroll
                    for (int m = 0; m < 4; ++m) { const float r_ = scl[ui * 256 + ai * 128 + wr * 64 + m * 16 + fr][0];
#pragma unroll
                        for (int bj = 0; bj < 2; ++bj)
#pragma unroll
                            for (int n = 0; n < 2; ++n) acc[ai][bj][m][n] *= r_; } } }
            PG8_LDB(B0, 0, 0); PG8_LDB(B1, 0, 1); PG8_SCHED; PG8_LDA(At, 0, 0); PG8_STAGE_A(PG8_SA(1, 1), a1, 1, false);
            if (fe) wait_vm<8 + Epi::NST>(); else PG8_WAIT_V(8); PG8_WAIT_L(0); PG8_BAR; PG8_MMA(0, 0, At, B0); PG8_MMA(0, 1, At, B1); PG8_BAR; PG8_SCHED;
            PG8_LDA(At, 0, 1); PG8_STAGE(PG8_SB(0, 0), b2, voffB); PG8_STAGE(PG8_SB(0, 1), b2 + hstepB, voffB); PG8_STAGE_A(PG8_SA(0, 0), a2, 0, last);
            if (fe) wait_vm<8 + Epi::NST>(); else PG8_WAIT_V(8); PG8_WAIT_L(0); PG8_BAR; PG8_MMA(1, 0, At, B0); PG8_MMA(1, 1, At, B1); PG8_BAR; PG8_SCHED;
            PG8_LDB(B0, 1, 0); PG8_LDB(B1, 1, 1); PG8_SCHED; PG8_LDA(At, 1, 0); PG8_STAGE_A(PG8_SA(0, 1), a2, 1, last);
            PG8_WAIT_V(8); PG8_WAIT_L(0); PG8_BAR; PG8_MMA(0, 0, At, B0); PG8_MMA(0, 1, At, B1); PG8_BAR; PG8_SCHED;
            PG8_LDA(At, 1, 1); PG8_STAGE(PG8_SB(1, 0), b3, voffB); PG8_STAGE(PG8_SB(1, 1), b3 + hstepB, voffB); PG8_STAGE_A(PG8_SA(1, 0), a3, 0, last);
            PG8_WAIT_V(8); PG8_WAIT_L(0); PG8_BAR; PG8_MMA(1, 0, At, B0); PG8_MMA(1, 1, At, B1); PG8_BAR; PG8_SCHED;
        }
        if constexpr (ALIGN_EPI) { if (wr == 0) PG8_BAR; }
        if constexpr (FP8) { asm volatile("s_nop 15\n\ts_nop 15" ::: "memory"); }
        if constexpr (MIDSCALE) E(acc, cur, wr, wc, fr, fq, scl + ui * 256); else E(acc, cur, wr, wc, fr, fq);
        if (!has_next) break;
#pragma unroll
        for (int a = 0; a < 2; ++a)
#pragma unroll
            for (int b = 0; b < 2; ++b)
#pragma unroll
                for (int m = 0; m < 4; ++m)
#pragma unroll
                    for (int n = 0; n < 2; ++n) acc[a][b][m][n] = (f32x4){0.f, 0.f, 0.f, 0.f};
        cur = nxt; cA = nA; cB = nB; ++ui; fresh = true;
        if constexpr (GATHER) { _Pragma("unroll") for (int _h = 0; _h < 2; ++_h) _Pragma("unroll") for (int _i = 0; _i < 2; ++_i) gcur[_h][_i] = gnxt[_h][_i]; }
        if constexpr (ALIGN_EPI) { if (wr == 1) PG8_BAR; }
    }
    PG8_WAIT_V(0);
    if constexpr (!ALIGN_EPI) { if (wr == 0) PG8_BAR; }
    PG8_BAR;
#undef PG8_SA
#undef PG8_SB
#undef PG8_STAGE
#undef PG8_STAGE_A
#undef PG8_LDA
#undef PG8_LDB
#undef PG8_MMA
#undef PG8_WAIT_V
#undef PG8_WAIT_L
#undef PG8_BAR
#undef PG8_SCHED
#undef PG8_GLOAD
}
}
using pg8::Unit;

struct DenseOrder {
    int nM, nN, nwg, G, c; const GAS char* A; const GAS char* B; size_t aT, bT;
    __device__ __forceinline__ bool next(int i, Unit& u) const {
        const long L = (long)i * G + c; if (L >= nwg) return false;
        int wgid = (int)L; { const int q = nwg / 8, r = nwg % 8, xcd = wgid % 8, off = wgid / 8; wgid = (xcd < r ? xcd * (q + 1) : r * (q + 1) + (xcd - r) * q) + off; }
        const int nig = 8 * nN, gid = wgid / nig, fm = gid * 8, gsz = (nM - fm) < 8 ? (nM - fm) : 8;
        u.pm = fm + ((wgid % nig) % gsz); u.pn = (wgid % nig) / gsz; u.e = 0;
        u.a = A + (size_t)u.pm * aT; u.b = B + (size_t)u.pn * bT; return true;
    }
};
struct UpOrder {
    int G, c; const GAS char* LATp; const GAS char* Wq; const GAS char* Wkv;
    __device__ __forceinline__ bool next(int i, Unit& u) const {
        const int L = i * G + c; if (L >= 128 * 7) return false;
        u.pm = L / 7; const int j = L % 7; const bool kv = j >= 3; u.pn = kv ? j - 3 : j; u.e = kv ? 1 : 0;
        u.a = LATp + (size_t)u.pm * 256 * 512 * 2 + (kv ? 512 : 0);
        u.b = (kv ? Wkv : Wq) + (size_t)u.pn * 256 * 256 * 2; return true;
    }
};
struct MoeOrder {
    int G, c; const volatile LAS int* TS; const GAS char* A; const GAS char* W; size_t aT  , wE  , wT  ;
    __device__ __forceinline__ bool next(int i, Unit& u) const {
        const int L = i * G + c; const int ntile = __builtin_amdgcn_readfirstlane(TS[32]); if (L >= ntile * 4) return false;
        const int rt = L >> 2, ct = L & 3; int e = 0;
        for (int j = 1; j < 32; ++j) e += (TS[j] <= rt) ? 1 : 0;
        e = __builtin_amdgcn_readfirstlane(e);
        u.pm = rt; u.pn = ct; u.e = e; u.a = A + (size_t)rt * aT; u.b = W + (size_t)e * wE + (size_t)ct * wT; return true;
    }
};

__device__ __forceinline__ u32x4 pack8(f32x4 v0, f32x4 v1) { u32x4 w; w.x = cvt_pk_bf16(v0[0], v0[1]); w.y = cvt_pk_bf16(v0[2], v0[3]); w.z = cvt_pk_bf16(v1[0], v1[1]); w.w = cvt_pk_bf16(v1[2], v1[3]); return w; }

struct EpiWin {
    static constexpr int NST = 16;
    static constexpr bool PERM = true;
    GAS bf16* LAT_; GAS bf16* FQKV_; GAS bf16* KPE_; GAS float* FLOG_; GAS float* SSQ_; const GAS float* COS_; const GAS float* SIN_; const GAS float* RSX_;
    __device__ __forceinline__ void operator()(f32x4 (&acc)[2][2][4][2], const Unit& u, int wr, int wc, int fr, int fq) const {
        GAS bf16* LAT = LAT_; GAS bf16* FQKV = FQKV_; GAS bf16* KPE = KPE_; GAS float* FLOG = FLOG_; GAS float* SSQ = SSQ_; const GAS float* COS = COS_; const GAS float* SIN = SIN_; const GAS float* RSX = RSX_;
        asm volatile("" : "+s"(LAT), "+s"(FQKV), "+s"(KPE), "+s"(FLOG), "+s"(SSQ), "+s"(COS), "+s"(SIN), "+s"(RSX));
        {
#pragma unroll
            for (int ai = 0; ai < 2; ++ai)
#pragma unroll
                for (int m = 0; m < 4; ++m) { const float rs_ = RSX[u.pm * 256 + ai * 128 + wr * 64 + m * 16 + fr];
#pragma unroll
                    for (int bj = 0; bj < 2; ++bj)
#pragma unroll
                        for (int n = 0; n < 2; ++n) acc[ai][bj][m][n] *= rs_; } }
        const int row0 = u.pm * 256 + wr * 64 + fr; const int pn = u.pn;
        if (pn >= 2) {
            const int ti = pn >> 1; GAS bf16* dst = FQKV + (size_t)(ti - 1) * NTOK * 512; const int colb = (pn & 1) * 256 + wc * 32 + 8 * fq; const float sc = (ti == 1) ? C2F : 1.f;
#pragma unroll
            for (int ai = 0; ai < 2; ++ai)
#pragma unroll
                for (int m = 0; m < 4; ++m) { GAS bf16* rowp = dst + (size_t)(row0 + ai * 128 + m * 16) * 512 + colb;
#pragma unroll
                    for (int bj = 0; bj < 2; ++bj) *(GAS u32x4*)(rowp + bj * 128) = pack8(acc[ai][bj][m][0] * sc, acc[ai][bj][m][1] * sc); }
        } else {
#pragma unroll
            for (int ai = 0; ai < 2; ++ai)
#pragma unroll
                for (int m = 0; m < 4; ++m) { const int row = row0 + ai * 128 + m * 16; GAS bf16* rowp = LAT + (size_t)row * 512 + pn * 256 + wc * 32 + 8 * fq;
#pragma unroll
                    for (int bj = 0; bj < 2; ++bj) *(GAS u32x4*)(rowp + bj * 128) = pack8(acc[ai][bj][m][0], acc[ai][bj][m][1]);
                    float s = 0.f;
#pragma unroll
                    for (int n = 0; n < 2; ++n) { const f32x4 x = acc[ai][0][m][n]; s += (x[0] * x[0] + x[1] * x[1]) + (x[2] * x[2] + x[3] * x[3]); }
                    if (pn == 0) {
#pragma unroll
                        for (int n = 0; n < 2; ++n) { const f32x4 x = acc[ai][1][m][n]; s += (x[0] * x[0] + x[1] * x[1]) + (x[2] * x[2] + x[3] * x[3]); }
                    }
                    s += __shfl_xor(s, 16); s += __shfl_xor(s, 32);
                    if (fq == 0) SSQ[(size_t)row * 8 + pn * 4 + wc] = s;
                    }
            if (pn == 1 && wc == 0) {
#pragma unroll
                for (int ai = 0; ai < 2; ++ai)
#pragma unroll
                    for (int m = 0; m < 4; ++m) { const int row = row0 + ai * 128 + m * 16;
                        const f32x4 c = *(const GAS f32x4*)(COS + (size_t)row * 16 + 4 * fq), sn = *(const GAS f32x4*)(SIN + (size_t)row * 16 + 4 * fq);
                        const f32x4 x1 = acc[ai][1][m][0], x2 = acc[ai][1][m][1];
                        *(GAS u32x4*)(KPE + (size_t)row * 32 + 8 * fq) = pack8(x1 * c - x2 * sn, x1 * sn + x2 * c);
                        }
            }
            if (pn == 1 && wc == 1 && fq == 0) {
#pragma unroll
                for (int ai = 0; ai < 2; ++ai)
#pragma unroll
                    for (int m = 0; m < 4; ++m) { const int row = row0 + ai * 128 + m * 16; *(GAS f32x4*)(FLOG + (size_t)row * 8) = acc[ai][1][m][0]; *(GAS f32x4*)(FLOG + (size_t)row * 8 + 4) = acc[ai][1][m][1]; }
            }
        }
    }
};
struct EpiUp {
    static constexpr int NST = 16;
    static constexpr bool PERM = true;
    GAS bf16* QM_; GAS bf16* KVM_; const GAS float* SSQ_; const GAS float* COS_; const GAS float* SIN_;
    __device__ __forceinline__ void operator()(const f32x4 (&acc)[2][2][4][2], const Unit& u, int wr, int wc, int fr, int fq) const {
        GAS bf16* QM = QM_; GAS bf16* KVM = KVM_; const GAS float* SSQ = SSQ_; const GAS float* COS = COS_; const GAS float* SIN = SIN_;
        asm volatile("" : "+s"(QM), "+s"(KVM), "+s"(SSQ), "+s"(COS), "+s"(SIN));
        const int row0 = u.pm * 256 + wr * 64 + fr; const int pn = u.pn; const bool kv = u.e != 0;
#pragma unroll
        for (int ai = 0; ai < 2; ++ai)
#pragma unroll
            for (int m = 0; m < 4; ++m) { const int row = row0 + ai * 128 + m * 16;
                const f32x4 sq = *(const GAS f32x4*)(SSQ + (size_t)row * 8 + (kv ? 4 : 0));
                const float ss = (sq[0] + sq[1]) + (sq[2] + sq[3]);
                if (kv) {
                    const float rs = rsqrtf(ss * (1.f / 128.f) + EPS);
                    GAS bf16* rowp = KVM + (size_t)row * 1024 + pn * 256 + wc * 32 + 8 * fq;
#pragma unroll
                    for (int bj = 0; bj < 2; ++bj) *(GAS u32x4*)(rowp + bj * 128) = pack8(acc[ai][bj][m][0] * rs, acc[ai][bj][m][1] * rs);
                } else {
                    const float rs = rsqrtf(ss * (1.f / 256.f) + EPS) * C2M;
                    GAS bf16* rowp = QM + (size_t)row * 768 + pn * 256 + wc * 32 + 8 * fq;
                    const f32x4 c = *(const GAS f32x4*)(COS + (size_t)row * 16 + 4 * fq), sn = *(const GAS f32x4*)(SIN + (size_t)row * 16 + 4 * fq);
#pragma unroll
                    for (int bj = 0; bj < 2; ++bj) { f32x4 v0 = acc[ai][bj][m][0] * rs, v1 = acc[ai][bj][m][1] * rs;
                        const int G = 8 * pn + 4 * bj + wc;
                        if (G % 3 == 2) { const f32x4 x1 = v0, x2 = v1; v0 = x1 * c - x2 * sn; v1 = x1 * sn + x2 * c; }
                        *(GAS u32x4*)(rowp + bj * 128) = pack8(v0, v1); }
                }

            }
    }
};
template <bool RES_F32> struct EpiOut {
    static constexpr int NST = 16;
    static constexpr bool PERM = true;
    const GAS float* resf_; GAS bf16* xr_;
    __device__ __forceinline__ void operator()(const f32x4 (&acc)[2][2][4][2], const Unit& u, int wr, int wc, int fr, int fq, const LAS f32x2* scl) const {
        const GAS float* resf = resf_; GAS bf16* xr = xr_; asm volatile("" : "+s"(resf), "+s"(xr));
        const int row0 = u.pm * 256 + wr * 64 + fr, col0 = u.pn * 256 + wc * 32 + 8 * fq;
#pragma unroll
        for (int ai = 0; ai < 2; ++ai)
#pragma unroll
            for (int m = 0; m < 4; ++m) { const size_t off = (size_t)(row0 + ai * 128 + m * 16) * DM + col0; const float sh = scl[ai * 128 + wr * 64 + m * 16 + fr][1];
#pragma unroll
                for (int bj = 0; bj < 2; ++bj) { f32x4 r0, r1;
                    if constexpr (RES_F32) { r0 = *(const GAS f32x4*)(resf + off + bj * 128); r1 = *(const GAS f32x4*)(resf + off + bj * 128 + 4); }
                    else { const u32x4 w = *(const GAS u32x4*)(xr + off + bj * 128);
                        r0 = (f32x4){__uint_as_float(w.x << 16), __uint_as_float(w.x & 0xffff0000u), __uint_as_float(w.y << 16), __uint_as_float(w.y & 0xffff0000u)};
                        r1 = (f32x4){__uint_as_float(w.z << 16), __uint_as_float(w.z & 0xffff0000u), __uint_as_float(w.w << 16), __uint_as_float(w.w & 0xffff0000u)}; }
                    *(GAS u32x4*)(xr + off + bj * 128) = pack8(r0 + acc[ai][bj][m][0] * sh, r1 + acc[ai][bj][m][1] * sh); } }
    }
};
struct EpiGU {
    static constexpr int NST = 8;
    static constexpr bool PERM = true;
    GAS unsigned char* HH_; const GAS float* RS_;
    __device__ __forceinline__ void operator()(const f32x4 (&acc)[2][2][4][2], const Unit& u, int wr, int wc, int fr, int fq) const {
        GAS unsigned char* HH = HH_; const GAS float* RS = RS_; asm volatile("" : "+s"(HH), "+s"(RS));
        const int row0 = u.pm * 256 + wr * 64 + fr;
#pragma unroll
        for (int ai = 0; ai < 2; ++ai)
#pragma unroll
            for (int m = 0; m < 4; ++m) { GAS unsigned char* rowp = HH + (size_t)(row0 + ai * 128 + m * 16) * 512 + u.pn * 128 + wc * 32 + 8 * fq; const float rs = RS[row0 + ai * 128 + m * 16] * WSCALE_INV;
                f32x4 h[2];
#pragma unroll
                for (int n = 0; n < 2; ++n) { const f32x4 g = acc[ai][0][m][n] * rs, up = acc[ai][1][m][n] * rs;
#pragma unroll
                    for (int j = 0; j < 4; ++j) { const float sg = __builtin_amdgcn_rcpf(1.f + __builtin_amdgcn_exp2f(-g[j] * LOG2E)); h[n][j] = g[j] * sg * up[j]; } }
                u32x2 w; w.x = pk4_fp8(h[0][0], h[0][1], h[0][2], h[0][3]); w.y = pk4_fp8(h[1][0], h[1][1], h[1][2], h[1][3]); *(GAS u32x2*)rowp = w; }
    }
};
struct EpiDown {
    static constexpr int NST = 16;
    static constexpr bool PERM = true;
    GAS unsigned char* Y_; const GAS float* GATEOF_;
    __device__ __forceinline__ void operator()(const f32x4 (&acc)[2][2][4][2], const Unit& u, int wr, int wc, int fr, int fq) const {
        GAS unsigned char* Y = Y_; const GAS float* GATEOF = GATEOF_; asm volatile("" : "+s"(Y), "+s"(GATEOF));
        const int row0 = u.pm * 256 + wr * 64 + fr;
#pragma unroll
        for (int ai = 0; ai < 2; ++ai)
#pragma unroll
            for (int m = 0; m < 4; ++m) { const int row = row0 + ai * 128 + m * 16; const float g = GATEOF[row]; GAS unsigned char* rowp = Y + (size_t)row * 1024 + u.pn * 256 + wc * 32 + 8 * fq;
#pragma unroll
                for (int bj = 0; bj < 2; ++bj) { const f32x4 v0 = acc[ai][bj][m][0] * g, v1 = acc[ai][bj][m][1] * g; u32x2 w; w.x = pk4_fp8(v0[0], v0[1], v0[2], v0[3]); w.y = pk4_fp8(v1[0], v1[1], v1[2], v1[3]); *(GAS u32x2*)(rowp + bj * 128) = w; } }
    }
};

namespace att {
constexpr int KSLOT = 12288, VSLOT = 8192;
constexpr int L_K = 0, L_V = 2 * KSLOT, L_BIAS = L_V + 2 * VSLOT, L_WS = L_BIAS + 8192, L_OST = L_WS + 8 * 64 * 4, L_END = L_OST + 8 * 4096;
__device__ __forceinline__ int crow(int r, int hi) { return (r & 3) + 8 * (r >> 2) + 4 * hi; }
typedef short v4i16_t __attribute__((ext_vector_type(4)));
__device__ __forceinline__ s16x4 vtr(const LAS char* p) { return __builtin_bit_cast(s16x4, __builtin_amdgcn_ds_read_tr16_b64_v4i16((LAS v4i16_t*)p)); }

constexpr int NSL = 5;
constexpr int R_K = 0, R_V = NSL * KSLOT, R_WS = R_V + NSL * VSLOT, R_OST = R_WS + 8 * 64 * 4, R_END = R_OST + 8 * 4096;
static_assert(R_END <= RING_BYTES, "attention LDS");
__device__ __forceinline__ void glds16(const GAS void* gsrc, unsigned lds_dst) { unsigned keep;
    asm volatile("s_mov_b32 %0, m0\n\ts_mov_b32 m0, %2\n\ts_nop 0\n\tglobal_load_lds_dwordx4 %1, off\n\ts_mov_b32 m0, %0" : "=&s"(keep) : "v"(gsrc), "s"(lds_dst) : "memory"); }
__device__ __forceinline__ void glds16s(const GAS void* sbase, unsigned voff, unsigned lds_dst) { unsigned keep;
    asm volatile("s_mov_b32 %0, m0\n\ts_mov_b32 m0, %3\n\ts_nop 0\n\tglobal_load_lds_dwordx4 %1, %2\n\ts_mov_b32 m0, %0" : "=&s"(keep) : "v"(voff), "s"((unsigned long long)sbase), "s"(lds_dst) : "memory"); }
struct Tens2 { const GAS bf16* Q; int qp; const GAS bf16* K; int kp; const GAS bf16* KX; const GAS bf16* V; int vp; GAS bf16* O; const GAS float* BIASF; const GAS float* NRM; GAS float* OSS; };
template <int MODE>
__device__ __forceinline__ int attn_unit2(const int wave_, int b, int h, int qb, const Tens2& T, LAS char* shm, const int slbase, const bool have_pro, const int qb_next, bf16x8 (&qr)[6], const int tstart) {
    constexpr int DKS = MODE ? 6 : 5, DKH = 3;
    constexpr float THR = 8.f;
    int wid = wave_; asm volatile("" : "+s"(wid));
    int lane = (int)__builtin_amdgcn_mbcnt_hi(~0u, __builtin_amdgcn_mbcnt_lo(~0u, 0u)); asm volatile("" : "+v"(lane)); const int r32 = lane & 31, hi = lane >> 5;
    const long rowbase = (long)b * SEQ; const int q0 = qb * 256, qw0 = q0 + wid * 32;
    const int NT = (q0 + 256) / 64, tlast = qw0 / 64;
    const int NTE = NT - tstart;
    const GAS bf16* Qw = T.Q + (rowbase + qw0) * T.qp + h * (MODE ? 96 : 64);
    const GAS bf16* Kh = T.K + rowbase * T.kp + h * (MODE ? 128 : 64);
    const GAS bf16* Vh = T.V + rowbase * T.vp + h * (MODE ? 128 : 64);
    LAS float* wsf = (LAS float*)(shm + R_WS) + wid * 64;
    const unsigned koff = (unsigned)(lane * T.kp + wid * 8) * 2u;
    const unsigned xoff = MODE ? (unsigned)(lane * 32 + (wid & 3) * 8) * 2u : (unsigned)(lane * 8) * 2u;
    const unsigned voff = (unsigned)((16 * (wid & 3) + (lane >> 2)) * T.vp + (wid >> 2) * 32 + (lane & 3) * 8) * 2u;
    const GAS bf16* xbase = MODE ? T.KX + rowbase * 32 : T.KX + ((long)b * 8 + h) * SEQ * 8;
    const int xstep = MODE ? 64 * 32 : 64 * 8;
    const unsigned kdst_a = (unsigned)(uintptr_t)(shm + R_K) + (unsigned)wid * 1024u, xdst_a = (unsigned)(uintptr_t)(shm + R_K) + (unsigned)(8 + (MODE ? (wid & 3) : 0)) * 1024u, vdst_a = (unsigned)(uintptr_t)(shm + R_V) + (unsigned)wid * 1024u;
#define A2_DMA(t, slot) do { \
        glds16s((const GAS void*)(Kh + (long)(t) * 64 * T.kp), koff, (unsigned)__builtin_amdgcn_readfirstlane((int)(kdst_a + (slot) * KSLOT))); \
        glds16s((const GAS void*)(xbase + (long)(t) * xstep), xoff, (unsigned)__builtin_amdgcn_readfirstlane((int)(xdst_a + (slot) * KSLOT))); \
        glds16s((const GAS void*)(Vh + (long)(t) * 64 * T.vp), voff, (unsigned)__builtin_amdgcn_readfirstlane((int)(vdst_a + (slot) * VSLOT))); } while (0)
    float mhat = 0.f, lrun = 0.f; f32x16 o[2]; o[0] = f32x16{}; o[1] = f32x16{}; f32x16 negm = f32x16{};
    const LAS char* vp0 = shm + R_V + ((lane >> 4) & 1) * 32 + (lane & 3) * 8 + (4 * hi + ((lane & 15) >> 2)) * 64;
#define A3_SLOT(k) ((slbase + (k)) % NSL)
    if (!have_pro) { A2_DMA(NT - 1, A3_SLOT(0)); A2_DMA(NT - 2, A3_SLOT(1)); A2_DMA(NT - 3, A3_SLOT(2)); }
    if (!have_pro) {
#pragma unroll
        for (int d0 = 0; d0 < (MODE ? 6 : 4); ++d0) qr[d0] = *(const GAS bf16x8*)(Qw + (long)r32 * T.qp + d0 * 16 + hi * 8); }
    if (MODE == 0) { const short one = hi ? (short)0 : (short)0x3F80; qr[DKS - 1] = (bf16x8){one, one, one, 0, 0, 0, 0, 0}; }
#pragma unroll
    for (int d0 = 0; d0 < DKS; ++d0) asm volatile("" : "+v"(qr[d0]));
#define A3_KLOADH(slot, H) do { const LAS char* kb_ = shm + R_K + (slot) * KSLOT + r32 * 16; _Pragma("unroll") for (int d0 = (H) * DKH; d0 < ((H) ? DKS : DKH); ++d0) { const int off = (MODE == 0 && d0 == 4) ? 8 * 1024 : d0 * 2048 + hi * 1024; \
        kf[2 * (d0 - (H) * DKH)] = *(const LAS bf16x8*)(kb_ + off); kf[2 * (d0 - (H) * DKH) + 1] = *(const LAS bf16x8*)(kb_ + off + 512); } } while (0)
#define A3_VLOAD(slot) do { const LAS char* vp_ = vp0 + (slot) * VSLOT; _Pragma("unroll") for (int q = 0; q < 8; ++q) { vlo[q] = vtr(vp_ + (q >> 2) * 4096 + (q & 3) * 1024); vhh[q] = vtr(vp_ + (q >> 2) * 4096 + (q & 3) * 1024 + 512); } } while (0)
#define A3_QKH(H) do { if ((H) == 0) { c0 = negm; c1 = negm; } _Pragma("unroll") for (int d0 = (H) * DKH; d0 < ((H) ? DKS : DKH); ++d0) { c0 = __builtin_amdgcn_mfma_f32_32x32x16_bf16(kf[2 * (d0 - (H) * DKH)], qr[d0], c0, 0, 0, 0); c1 = __builtin_amdgcn_mfma_f32_32x32x16_bf16(kf[2 * (d0 - (H) * DKH) + 1], qr[d0], c1, 0, 0, 0); } } while (0)
#define A3_EXP() do { float ls_ = 0.f; _Pragma("unroll") for (int r = 0; r < 16; ++r) { pp0[r] = __builtin_amdgcn_exp2f(pp0[r]); pp1[r] = __builtin_amdgcn_exp2f(pp1[r]); ls_ += pp0[r] + pp1[r]; } lrun += ls_; u32x4 w_; \
        w_.x = cvt_pk_bf16(pp0[0], pp0[1]); w_.y = cvt_pk_bf16(pp0[2], pp0[3]); w_.z = cvt_pk_bf16(pp0[4], pp0[5]); w_.w = cvt_pk_bf16(pp0[6], pp0[7]); pa[0] = __builtin_bit_cast(bf16x8, w_); \
        w_.x = cvt_pk_bf16(pp0[8], pp0[9]); w_.y = cvt_pk_bf16(pp0[10], pp0[11]); w_.z = cvt_pk_bf16(pp0[12], pp0[13]); w_.w = cvt_pk_bf16(pp0[14], pp0[15]); pa[1] = __builtin_bit_cast(bf16x8, w_); \
        w_.x = cvt_pk_bf16(pp1[0], pp1[1]); w_.y = cvt_pk_bf16(pp1[2], pp1[3]); w_.z = cvt_pk_bf16(pp1[4], pp1[5]); w_.w = cvt_pk_bf16(pp1[6], pp1[7]); pa[2] = __builtin_bit_cast(bf16x8, w_); \
        w_.x = cvt_pk_bf16(pp1[8], pp1[9]); w_.y = cvt_pk_bf16(pp1[10], pp1[11]); w_.z = cvt_pk_bf16(pp1[12], pp1[13]); w_.w = cvt_pk_bf16(pp1[14], pp1[15]); pa[3] = __builtin_bit_cast(bf16x8, w_); } while (0)
#define A3_PV() do { _Pragma("unroll") for (int d0 = 0; d0 < 2; ++d0) _Pragma("unroll") for (int k = 0; k < 4; ++k) { const s16x4 lo_ = vlo[4 * d0 + k], hh_ = vhh[4 * d0 + k]; \
        const bf16x8 vf_ = (bf16x8){lo_[0], lo_[1], lo_[2], lo_[3], hh_[0], hh_[1], hh_[2], hh_[3]}; o[d0] = __builtin_amdgcn_mfma_f32_32x32x16_bf16(pa[k], vf_, o[d0], 0, 0, 0); } } while (0)
#define A3_ROWMAX(rm) do { float a_ = fmaxf(fmaxf(c0[0], c0[1]), c1[0]), b_ = fmaxf(fmaxf(c0[2], c0[3]), c1[1]); a_ = fmaxf(fmaxf(a_, c1[2]), c1[3]); \
        _Pragma("unroll") for (int r = 4; r < 16; r += 4) { a_ = fmaxf(fmaxf(a_, c0[r]), c0[r + 1]); b_ = fmaxf(fmaxf(b_, c0[r + 2]), c0[r + 3]); a_ = fmaxf(fmaxf(a_, c1[r]), c1[r + 1]); b_ = fmaxf(fmaxf(b_, c1[r + 2]), c1[r + 3]); } \
        rm = fmaxf(a_, b_); const auto rr_ = __builtin_amdgcn_permlane32_swap(__float_as_uint(rm), __float_as_uint(rm), false, false); rm = fmaxf(__uint_as_float(rr_[0]), __uint_as_float(rr_[1])); } while (0)
    int sl = A3_SLOT(0), sl3 = A3_SLOT(3);
    f32x16 pp0 = f32x16{}, pp1 = f32x16{}; bool pend = false; int pslot = 0;
    for (int i = 0; i < NTE; ++i) {
        const int t = NT - 1 - i;
        { const int ahead = NTE - 1 - i;
          if (ahead >= 2) asm volatile("s_waitcnt vmcnt(6)" ::: "memory"); else if (ahead == 1) asm volatile("s_waitcnt vmcnt(3)" ::: "memory"); else asm volatile("s_waitcnt vmcnt(0)" ::: "memory"); }
        __builtin_amdgcn_s_barrier(); asm volatile("" ::: "memory");
        if (i + 3 < NTE) A2_DMA(t - 3, sl3);
        if (i == NTE - 1 && qb_next >= 0) { const int NTn = 4 * qb_next + 4; A2_DMA(NTn - 1, A3_SLOT(NTE)); A2_DMA(NTn - 2, A3_SLOT(NTE + 1)); A2_DMA(NTn - 3, A3_SLOT(NTE + 2)); }
        if (t <= tlast) {
            bf16x8 kf[2 * DKH]; f32x16 c0, c1; float rm;
            A3_KLOADH(sl, 0);
            if (!pend) {
                A3_QKH(0); A3_KLOADH(sl, 1); A3_QKH(1);
                if (MODE == 0) { const int qrel = qw0 + r32 - 64 * t;
#pragma unroll
                    for (int r = 0; r < 16; ++r) { const int kv = crow(r, hi); if (kv > qrel) c0[r] = -INFINITY; if (kv + 32 > qrel) c1[r] = -INFINITY; } }
                A3_ROWMAX(rm);
                mhat = rm;
#pragma unroll
                for (int r = 0; r < 16; ++r) { c0[r] -= rm; c1[r] -= rm; negm[r] = -mhat; }
                pend = true;
            } else {
                s16x4 vlo[8], vhh[8]; bf16x8 pa[4];
                A3_QKH(0); A3_KLOADH(sl, 1);
                A3_VLOAD(pslot);
                A3_QKH(1);
                A3_EXP();
#pragma unroll
                for (int g_ = 0; g_ < 2 * DKS; ++g_) { __builtin_amdgcn_sched_group_barrier(0x008, 1, 0); __builtin_amdgcn_sched_group_barrier(0x002, 7, 0); }
                A3_PV();
                A3_ROWMAX(rm);
#pragma unroll
                for (int g_ = 0; g_ < 8; ++g_) { __builtin_amdgcn_sched_group_barrier(0x008, 1, 0); __builtin_amdgcn_sched_group_barrier(0x002, 3, 0); }
                if (__any(rm > THR)) {
                    const float dl = fmaxf(rm, 0.f); mhat += dl;
#pragma unroll
                    for (int r = 0; r < 16; ++r) { c0[r] -= dl; c1[r] -= dl; negm[r] = -mhat; }
                    const float f = __builtin_amdgcn_exp2f(-dl); lrun *= f;
                    if (hi == 0) wsf[r32] = f;
                    LDS_WAIT();
#pragma unroll
                    for (int g = 0; g < 4; ++g) { const f32x4 ff = *(const LAS f32x4*)(wsf + 8 * g + 4 * hi);
#pragma unroll
                        for (int j = 0; j < 4; ++j) { o[0][4 * g + j] *= ff[j]; o[1][4 * g + j] *= ff[j]; } }
                }
            }
            pp0 = c0; pp1 = c1; pslot = sl;
        }
        sl = (sl == NSL - 1) ? 0 : sl + 1; sl3 = (sl3 == NSL - 1) ? 0 : sl3 + 1;
    }
    if (qb_next >= 0) { const GAS bf16* Qn = T.Q + (rowbase + qb_next * 256 + wid * 32) * T.qp + h * (MODE ? 96 : 64);
#pragma unroll
        for (int d0 = 0; d0 < (MODE ? 6 : 4); ++d0) qr[d0] = *(const GAS bf16x8*)(Qn + (long)r32 * T.qp + d0 * 16 + hi * 8); }
    if (pend) { s16x4 vlo[8], vhh[8]; bf16x8 pa[4]; A3_VLOAD(pslot); A3_EXP(); A3_PV(); }
#undef A3_KLOADH
#undef A3_VLOAD
#undef A3_QKH
#undef A3_EXP
#undef A3_PV
#undef A3_ROWMAX
#undef A2_DMA
    lrun += __shfl_xor(lrun, 32);
    LDS_WAIT();
    if (hi == 0) wsf[32 + r32] = lrun;
    LDS_WAIT();
    float rli[16];
#pragma unroll
    for (int g = 0; g < 4; ++g) { const f32x4 ll = *(const LAS f32x4*)(wsf + 32 + 8 * g + 4 * hi);
#pragma unroll
        for (int j = 0; j < 4; ++j) rli[4 * g + j] = __builtin_amdgcn_rcpf(ll[j]); }
    GAS bf16* Ow = T.O + (rowbase + qw0) * 1024 + (MODE ? 0 : 512) + h * 64;
    { LAS bf16* stg = (LAS bf16*)(shm + R_OST) + wid * 2048;
#pragma unroll
      for (int r = 0; r < 16; ++r) { const int orow = crow(r, hi);
#pragma unroll
          for (int d0 = 0; d0 < 2; ++d0) stg[orow * 64 + d0 * 32 + r32] = (bf16)(cvt_pk_bf16(o[d0][r] * rli[r], 0.f) & 0xffffu); }
      LDS_WAIT();
#pragma unroll
      for (int i = 0; i < 4; ++i) { const int row = i * 8 + (lane >> 3), ch = lane & 7; const u32x4 v = *(const LAS u32x4*)(stg + row * 64 + ch * 8); *(GAS u32x4*)(Ow + (long)row * 1024 + ch * 8) = v;
          float sq = 0.f;
#pragma unroll
          for (int j = 0; j < 4; ++j) { const float a0 = __uint_as_float(v[j] << 16), a1 = __uint_as_float(v[j] & 0xffff0000u); sq += a0 * a0 + a1 * a1; }
          sq += __shfl_xor(sq, 1); sq += __shfl_xor(sq, 2); sq += __shfl_xor(sq, 4);
          if (ch == 0) T.OSS[(rowbase + qw0 + row) * 16 + (MODE ? 0 : 8) + h] = sq; } }
    if (qb_next < 0) { LDS_WAIT(); __builtin_amdgcn_s_barrier(); asm volatile("" ::: "memory"); }
    return A3_SLOT(NTE);
#undef A3_SLOT
}
}

struct Args { const void* in[21]; float* out; unsigned char* ws; int ph_lo, ph_hi; };

__device__ __forceinline__ void tr_item(const GAS float* __restrict__ W, int ldw, int Ksrc, const GAS float* __restrict__ gain, GAS bf16* __restrict__ WT, int ldk, int k0, int n0, int srccol, LAS float* scr, int lane) {
#pragma unroll 8
    for (int i = 0; i < 32; ++i) { const int kk = 2 * i + (lane >> 5); const int k = k0 + kk;
        float v = 0.f; if (srccol >= 0 && k < Ksrc) { v = W[(size_t)k * ldw + srccol]; if (gain) v *= gain[k]; }
        scr[kk * 33 + (lane & 31)] = v; }
    LDS_WAIT(); asm volatile("" ::: "memory");
    const int c = lane & 7;
#pragma unroll
    for (int j = 0; j < 4; ++j) { const int n = (lane >> 3) + 8 * j; const LAS float* s = scr + (8 * c) * 33 + n;
        u32x4 o; o.x = cvt_pk_bf16(s[0 * 33], s[1 * 33]); o.y = cvt_pk_bf16(s[2 * 33], s[3 * 33]); o.z = cvt_pk_bf16(s[4 * 33], s[5 * 33]); o.w = cvt_pk_bf16(s[6 * 33], s[7 * 33]);
        *(GAS u32x4*)(WT + (size_t)(n0 + n) * ldk + k0 + 8 * c) = o; }
    LDS_WAIT(); asm volatile("" ::: "memory");
}
__device__ __forceinline__ void tr_item64(const GAS float* __restrict__ W, int ldw, const GAS float* __restrict__ gain, GAS bf16* __restrict__ WT, int ldk, int k0, int n0src, int n0dst, LAS float* scr, int lane) {
    const int rr = lane >> 4, c4 = (lane & 15) * 4;
    f32x4 v[16];
#pragma unroll
    for (int i = 0; i < 16; ++i) v[i] = *(const GAS f32x4*)(W + (size_t)(k0 + 4 * i + rr) * ldw + n0src + c4);
#pragma unroll
    for (int i = 0; i < 16; ++i) { const int k = 4 * i + rr; const float g = gain ? gain[k0 + k] : 1.f; LAS float* d = scr + k * 65 + c4;
        d[0] = v[i][0] * g; d[1] = v[i][1] * g; d[2] = v[i][2] * g; d[3] = v[i][3] * g; }
    LDS_WAIT(); asm volatile("" ::: "memory");
    const int kc = lane & 7;
#pragma unroll
    for (int j = 0; j < 8; ++j) { const int n = (lane >> 3) + 8 * j; const LAS float* sp = scr + (8 * kc) * 65 + n;
        u32x4 o; o.x = cvt_pk_bf16(sp[0 * 65], sp[1 * 65]); o.y = cvt_pk_bf16(sp[2 * 65], sp[3 * 65]); o.z = cvt_pk_bf16(sp[4 * 65], sp[5 * 65]); o.w = cvt_pk_bf16(sp[6 * 65], sp[7 * 65]);
        *(GAS u32x4*)(WT + (size_t)(n0dst + n) * ldk + k0 + 8 * kc) = o; }
    LDS_WAIT(); asm volatile("" ::: "memory");
}
__device__ __forceinline__ void tr_item64_f8(const GAS float* __restrict__ W, int ldw, const GAS float* __restrict__ gain, float scale, GAS unsigned char* __restrict__ WT8, int ldkB, int k0, int n0src, int n0dst, LAS float* scr, int lane) {
    const int rr = lane >> 4, c4 = (lane & 15) * 4;
    f32x4 v[16];
#pragma unroll
    for (int i = 0; i < 16; ++i) v[i] = *(const GAS f32x4*)(W + (size_t)(k0 + 4 * i + rr) * ldw + n0src + c4);
#pragma unroll
    for (int i = 0; i < 16; ++i) { const int k = 4 * i + rr; const float g = (gain ? gain[k0 + k] : 1.f) * scale; LAS float* d = scr + k * 65 + c4;
        d[0] = v[i][0] * g; d[1] = v[i][1] * g; d[2] = v[i][2] * g; d[3] = v[i][3] * g; }
    LDS_WAIT(); asm volatile("" ::: "memory");
    const int kc = lane & 7;
#pragma unroll
    for (int j = 0; j < 8; ++j) { const int n = (lane >> 3) + 8 * j; const LAS float* sp = scr + (8 * kc) * 65 + n;
        u32x2 o; o.x = pk4_fp8(sp[0 * 65], sp[1 * 65], sp[2 * 65], sp[3 * 65]); o.y = pk4_fp8(sp[4 * 65], sp[5 * 65], sp[6 * 65], sp[7 * 65]);
        *(GAS u32x2*)(WT8 + (size_t)(n0dst + n) * ldkB + k0 + 8 * kc) = o; }
    LDS_WAIT(); asm volatile("" ::: "memory");
}
__device__ __forceinline__ int rope_dim(int p) { const int a = p >> 3, j = p & 7; return j < 4 ? 4 * a + j : 16 + 4 * a + (j - 4); }

#define LDP(i) ((void*)((((unsigned long long)(unsigned)__builtin_amdgcn_readfirstlane((int)(ARGP[i] >> 32))) << 32) | (unsigned long long)(unsigned)__builtin_amdgcn_readfirstlane((int)(unsigned)ARGP[i])))
#define ARGIN(i) ((const void*)LDP(i))
#define P_COS ((GAS float*)(ws + WS_COS))
#define P_SIN ((GAS float*)(ws + WS_SIN))
#define P_SSQ ((GAS float*)(ws + WS_SSQ))
#define P_FLOG ((GAS float*)(ws + WS_FLOG))
#define P_E01 ((GAS int*)(ws + WS_E01))
#define P_G01 ((GAS float*)(ws + WS_G01))
#define P_SLOT ((GAS int*)(ws + WS_SLOT))
#define P_TOKOF ((GAS int*)(ws + WS_TOKOF))
#define P_GATEOF ((GAS float*)(ws + WS_GATEOF))
#define P_CNT ((GAS int*)(ws + WS_CNT))
#define P_TSTART ((GAS int*)(ws + WS_TSTART))
#define P_RSTD ((GAS float*)(ws + WS_RSTD))
#define P_RSTDOF ((GAS float*)(ws + WS_RSTDOF))
#define P_KPE ((GAS bf16*)(ws + WS_KPE))
#define P_KAUG ((GAS bf16*)(ws + WS_KAUG))
#define P_BIASF ((GAS float*)(ws + WS_BIASF))
#define P_NRM ((GAS float*)(ws + WS_NRM))
#define P_WR ((GAS bf16*)(ws + WS_WR))
#define P_XR ((GAS bf16*)(ws + WS_XR))
#define P_OSS ((GAS float*)(ws + WS_OSS))
#define P_RSTDX ((GAS float*)(ws + WS_RSTDX))
#define P_WIN ((GAS bf16*)(ws + WS_WIN))
#define P_WUQ ((GAS bf16*)(ws + WS_WUQ))
#define P_WUKV ((GAS bf16*)(ws + WS_WUKV))
#define P_WOUT ((GAS bf16*)(ws + WS_WOUT))
#define P_WGU_L(ll) ((GAS unsigned char*)(ws + WS_WGU + (size_t)((ll) & 1) * 32 * MiB))
#define P_WD_L(ll) ((GAS unsigned char*)(ws + WS_WD + (size_t)((ll) & 1) * 16 * MiB))
#define P_XN ((GAS bf16*)(ws + WS_XN))
#define P_FQKV ((GAS bf16*)(ws + WS_FQKV))
#define P_HH ((GAS bf16*)(ws + WS_FQKV))
#define P_LAT ((GAS bf16*)(ws + WS_LAT))
#define P_QM ((GAS bf16*)(ws + WS_QM))
#define P_KVM ((GAS bf16*)(ws + WS_KVM))
#define P_Y ((GAS bf16*)(ws + WS_Y))
#define IN(k) (lo <= (k) && (k) < hi_)
#if MK_ONE_LAUNCH
#define GRID_BAR() xcd_barrier(bar)
#else
#define GRID_BAR() do {} while (0)
#endif
#define SEAM(k) do { if (IN(k) && IN((k) + 1)) GRID_BAR(); } while (0)
__device__ __forceinline__ void conv_gu_item(int r, const GAS float* w_gate, const GAS float* w_up, const GAS float* ffn_norm, GAS unsigned char* WGU, LAS float* scr64, int lane) {
    const int e = r / 256, q = r % 256, kb = q / 16, nb = q % 16; const int n0 = nb * 64; const int ct = n0 >> 8, which = (n0 >> 7) & 1, jj = n0 & 127;
    const GAS float* src = (which ? w_up : w_gate) + (size_t)e * DM * DEXP;
    tr_item64_f8(src, DEXP, ffn_norm, WSCALE, WGU + (size_t)e * 1024 * 1024, DM, kb * 64, ct * 128 + jj, n0, scr64, lane);
}
__device__ __forceinline__ void conv_d_item(int r, const GAS float* w_down, GAS unsigned char* WD, LAS float* scr64, int lane) {
    const int e = r / 128, q = r % 128, kb = q / 16, nb = q % 16;
    tr_item64_f8(w_down + (size_t)e * DEXP * DM, DM, nullptr, WSCALE, WD + (size_t)e * 1024 * 512, DEXP, kb * 64, nb * 64, nb * 64, scr64, lane);
}
template <int l>
__device__ __forceinline__ void layer_body(const int lo, const int hi_, LAS unsigned char* lds0, const int wave0, const int G0, const int bx0, const XcdBarrier& bar) {
        const int P = 10 * l;
        if (IN(P)) for (int rep_ = 0; rep_ < (l == 0 ? NREP(0) : 1); ++rep_) {
            unsigned ldsb_ = (unsigned)(uintptr_t)lds0; asm volatile("" : "+s"(ldsb_)); LAS unsigned char* lds = (LAS unsigned char*)(uintptr_t)ldsb_; volatile LAS unsigned* MISC = (volatile LAS unsigned*)(lds + MISC_OFF); volatile LAS unsigned long long* ARGP = (volatile LAS unsigned long long*)(lds + MISC_OFF + 768); (void)MISC; int wave = wave0, G = G0, bx = bx0; asm volatile("" : "+s"(G), "+s"(bx), "+s"(wave)); const int lane = (int)__builtin_amdgcn_mbcnt_hi(~0u, __builtin_amdgcn_mbcnt_lo(~0u, 0u)); const int tid = wave * 64 + lane; const int vcu = (bx % 8) * (G / 8) + bx / 8; const int gw = vcu * 8 + wave, NGW = G * 8; (void)lane; (void)gw; (void)NGW; (void)vcu;
            GAS unsigned char* ws = (GAS unsigned char*)LDP(22); GAS float* out = (GAS float*)LDP(21); const GAS float* x_in = (const GAS float*)ARGIN(0); const GAS int* positions = (const GAS int*)ARGIN(1);
            if (l < NLAYER) {
                LAS float* scr = (LAS float*)(lds + wave * 16640);
                const GAS float* attn_norm = (const GAS float*)ARGIN(2) + (size_t)l * DM; const GAS float* w_in = (const GAS float*)ARGIN(3) + (size_t)l * DM * INW;
                const GAS float* q_norm = (const GAS float*)ARGIN(5) + (size_t)l * 256; const GAS float* w_uq = (const GAS float*)ARGIN(6) + (size_t)l * 256 * 768;
                const GAS float* kv_norm = (const GAS float*)ARGIN(7) + (size_t)l * 128; const GAS float* w_ukv = (const GAS float*)ARGIN(8) + (size_t)l * 128 * 1024;
                const GAS float* mla_on = (const GAS float*)ARGIN(9) + (size_t)l * 512; const GAS float* fox_on = (const GAS float*)ARGIN(10) + (size_t)l * 512; const GAS float* w_out = (const GAS float*)ARGIN(11) + (size_t)l * DM * DM;
                const GAS float* ffn_norm = (const GAS float*)ARGIN(12) + (size_t)l * DM;
                const GAS float* w_gate = (const GAS float*)ARGIN(17) + (size_t)l * NEXP * DM * DEXP; const GAS float* w_up = (const GAS float*)ARGIN(18) + (size_t)l * NEXP * DM * DEXP; const GAS float* w_down = (const GAS float*)ARGIN(19) + (size_t)l * NEXP * DEXP * DM;
                constexpr int I_IN = 16 * 64, I_UQ = 4 * 24, I_UKV = 4 * 32;
                constexpr int NITEMS = I_IN + I_UQ + I_UKV;
                for (int it = gw; it < NITEMS; it += NGW) {
                    int r = it; const int j = lane & 31;
                    if (r < I_IN) { const int kb = r / 64, nb = r % 64; const int n = nb * 32 + j; int sc;
                        if (n < 384) sc = n; else if (n < 416) sc = 384 + rope_dim(n - 384); else if (n < 424) sc = 1952 + (n - 416); else if (n < 512) sc = -1; else sc = 416 + (n - 512);
                        tr_item(w_in, INW, DM, attn_norm, P_WIN, DM, kb * 64, nb * 32, sc, scr, lane); continue; } r -= I_IN;
                    if (r < I_UQ) { const int kb = r / 24, nb = r % 24; const int n = nb * 32 + j; const int hh = n / 96, d = n % 96; const int sc = d < 64 ? n : hh * 96 + 64 + rope_dim(d - 64);
                        tr_item(w_uq, 768, 256, q_norm, P_WUQ, 256, kb * 64, nb * 32, sc, scr, lane); continue; } r -= I_UQ;
                    { const int kb = r / 32, nb = r % 32; tr_item(w_ukv, 1024, 128, kv_norm, P_WUKV, 256, kb * 64, nb * 32, nb * 32 + j, scr, lane); }
                }
                LAS float* scr64 = (LAS float*)(lds + wave * 16640);
                constexpr int J_OUT = 16 * 16, J_GU = 16 * 16 * NEXP, J_D = 8 * 16 * NEXP;
                for (int it = gw; it < J_OUT + (l == 0 ? J_GU + J_D : 0); it += NGW) {
                    int r = it;
                    if (r < J_OUT) { const int kb = r / 16, nb = r % 16; const GAS float* gn = kb < 8 ? mla_on : fox_on - 512; tr_item64(w_out, DM, gn, P_WOUT, DM, kb * 64, nb * 64, nb * 64, scr64, lane); continue; } r -= J_OUT;
                    if (r < J_GU) { conv_gu_item(r, w_gate, w_up, ffn_norm, P_WGU_L(l), scr64, lane); continue; } r -= J_GU;
                    conv_d_item(r, w_down, P_WD_L(l), scr64, lane);
                }
                { const GAS float* w_rg = (const GAS float*)ARGIN(13) + (size_t)l * DM * 4; const GAS float* w_re = (const GAS float*)ARGIN(15) + (size_t)l * DM * 32;
                  for (int idx = bx * 512 + tid; idx < 2 * 48 * 520; idx += G * 512) { const int half = idx / (48 * 520), r = idx % (48 * 520), c = r / 520, kk = r % 520; const int k = half * 512 + kk;
                      float w = 0.f; if (c < 36 && kk < 512) w = ffn_norm[k] * (c < 4 ? w_rg[k * 4 + c] : w_re[k * 32 + (c - 4)]);
                      const unsigned h16 = cvt_pk_bf16(w, 0.f) & 0xffffu; const unsigned l16 = cvt_pk_bf16(w - __uint_as_float(h16 << 16), 0.f) & 0xffffu;
                      P_WR[(size_t)(half * 2 + 0) * 48 * 520 + r] = (bf16)h16; P_WR[(size_t)(half * 2 + 1) * 48 * 520 + r] = (bf16)l16; } }
            }
            const GAS float* fin = (const GAS float*)ARGIN(20);
            for (int mb = gw * 4; mb < NTOK; mb += NGW * 4) {
                f32x4 v[4][4]; int s0[4], s1[4];
                if (l > 0) {
#pragma unroll
                    for (int r = 0; r < 4; ++r) { s0[r] = P_SLOT[2 * (mb + r)]; s1[r] = P_SLOT[2 * (mb + r) + 1]; }
                }
#pragma unroll
                for (int r = 0; r < 4; ++r) {
                    if (l == 0) { const GAS float* xr = x_in + (size_t)(mb + r) * DM;
#pragma unroll
                        for (int j = 0; j < 4; ++j) v[r][j] = *(const GAS f32x4*)(xr + 4 * lane + 256 * j); }
                    else { const GAS bf16* xr = P_XR + (size_t)(mb + r) * DM;
#pragma unroll
                        for (int j = 0; j < 4; ++j) { const u32x2 w = *(const GAS u32x2*)(xr + 4 * lane + 256 * j); v[r][j] = (f32x4){__uint_as_float(w.x << 16), __uint_as_float(w.x & 0xffff0000u), __uint_as_float(w.y << 16), __uint_as_float(w.y & 0xffff0000u)}; } } }
                if (l > 0) {
#pragma unroll
                    for (int r = 0; r < 4; ++r)
#pragma unroll
                        for (int j = 0; j < 4; ++j) { const int a = *(const GAS int*)((const GAS unsigned char*)P_Y + (size_t)s0[r] * 1024 + 4 * lane + 256 * j), c = *(const GAS int*)((const GAS unsigned char*)P_Y + (size_t)s1[r] * 1024 + 4 * lane + 256 * j);
                            const f32x2 a0 = __builtin_amdgcn_cvt_pk_f32_fp8(a, false), a1 = __builtin_amdgcn_cvt_pk_f32_fp8(a, true), c0 = __builtin_amdgcn_cvt_pk_f32_fp8(c, false), c1 = __builtin_amdgcn_cvt_pk_f32_fp8(c, true);
                            v[r][j][0] += (a0[0] + c0[0]) * WSCALE_INV; v[r][j][1] += (a0[1] + c0[1]) * WSCALE_INV; v[r][j][2] += (a1[0] + c1[0]) * WSCALE_INV; v[r][j][3] += (a1[1] + c1[1]) * WSCALE_INV; }
                }
                float ss[4];
#pragma unroll
                for (int r = 0; r < 4; ++r) { float s = 0.f;
#pragma unroll
                    for (int j = 0; j < 4; ++j) s += (v[r][j][0] * v[r][j][0] + v[r][j][1] * v[r][j][1]) + (v[r][j][2] * v[r][j][2] + v[r][j][3] * v[r][j][3]);
                    ss[r] = s; }
#pragma unroll
                for (int o = 1; o < 64; o <<= 1) {
#pragma unroll
                    for (int r = 0; r < 4; ++r) ss[r] += __shfl_xor(ss[r], o); }
#pragma unroll
                for (int r = 0; r < 4; ++r) { const int m = mb + r; const float rstd = rsqrtf(ss[r] * (1.f / DM) + EPS);
                    if (l < NLAYER) {
#pragma unroll
                        for (int j = 0; j < 4; ++j) { u32x2 w; w.x = cvt_pk_bf16(v[r][j][0], v[r][j][1]); w.y = cvt_pk_bf16(v[r][j][2], v[r][j][3]); *(GAS u32x2*)(P_XR + (size_t)m * DM + 4 * lane + 256 * j) = w; }
                        if (lane == 0) P_RSTDX[m] = rstd;
                    } else {
#pragma unroll
                        for (int j = 0; j < 4; ++j) { const f32x4 g = *(const GAS f32x4*)(fin + 4 * lane + 256 * j); *(GAS f32x4*)(out + (size_t)m * DM + 4 * lane + 256 * j) = v[r][j] * rstd * g; }
                    }
                }
            }
        }
        if constexpr (l == NLAYER) return;
        SEAM(P);
        if (IN(P + 1)) for (int rep_ = 0; rep_ < ((l == 0 || 1 != 5) ? NREP(1) : 1); ++rep_) {
            unsigned ldsb_ = (unsigned)(uintptr_t)lds0; asm volatile("" : "+s"(ldsb_)); LAS unsigned char* lds = (LAS unsigned char*)(uintptr_t)ldsb_; volatile LAS unsigned* MISC = (volatile LAS unsigned*)(lds + MISC_OFF); volatile LAS unsigned long long* ARGP = (volatile LAS unsigned long long*)(lds + MISC_OFF + 768); (void)MISC; int wave = wave0, G = G0, bx = bx0; asm volatile("" : "+s"(G), "+s"(bx), "+s"(wave)); const int lane = (int)__builtin_amdgcn_mbcnt_hi(~0u, __builtin_amdgcn_mbcnt_lo(~0u, 0u)); const int tid = wave * 64 + lane; const int vcu = (bx % 8) * (G / 8) + bx / 8; const int gw = vcu * 8 + wave, NGW = G * 8; (void)lane; (void)gw; (void)NGW; (void)vcu;
            GAS unsigned char* ws = (GAS unsigned char*)LDP(22); GAS float* out = (GAS float*)LDP(21); const GAS float* x_in = (const GAS float*)ARGIN(0); (void)out; (void)x_in; (void)ws;
            DenseOrder S{NTOK / 256, INP / 256, (NTOK / 256) * (INP / 256), G, bx, (const GAS char*)P_XR, (const GAS char*)P_WIN, (size_t)256 * DM * 2, (size_t)256 * DM * 2};
            EpiWin E{P_LAT, P_FQKV, P_KPE, P_FLOG, P_SSQ, P_COS, P_SIN, P_RSTDX};
            pg8::gemm_phase<EpiWin, DenseOrder, true, false>(tid, lds, DM * 2, DM * 2, DM * 2, S, E, nullptr);
        }
        SEAM(P + 1);
        if (IN(P + 2)) for (int rep_ = 0; rep_ < ((l == 0 || 2 != 5) ? NREP(2) : 1); ++rep_) {
            unsigned ldsb_ = (unsigned)(uintptr_t)lds0; asm volatile("" : "+s"(ldsb_)); LAS unsigned char* lds = (LAS unsigned char*)(uintptr_t)ldsb_; volatile LAS unsigned* MISC = (volatile LAS unsigned*)(lds + MISC_OFF); volatile LAS unsigned long long* ARGP = (volatile LAS unsigned long long*)(lds + MISC_OFF + 768); (void)MISC; int wave = wave0, G = G0, bx = bx0; asm volatile("" : "+s"(G), "+s"(bx), "+s"(wave)); const int lane = (int)__builtin_amdgcn_mbcnt_hi(~0u, __builtin_amdgcn_mbcnt_lo(~0u, 0u)); const int tid = wave * 64 + lane; const int vcu = (bx % 8) * (G / 8) + bx / 8; const int gw = vcu * 8 + wave, NGW = G * 8; (void)lane; (void)gw; (void)NGW; (void)vcu;
            GAS unsigned char* ws = (GAS unsigned char*)LDP(22); GAS float* out = (GAS float*)LDP(21); const GAS float* x_in = (const GAS float*)ARGIN(0); (void)out; (void)x_in; (void)ws;
            {
                const int sq = vcu >> 1, hf = vcu & 1; const int b = sq >> 3, h = sq & 7; const float bf = ((const GAS float*)ARGIN(4))[l * 8 + h];
                const GAS float* fl = P_FLOG + ((size_t)b * SEQ + hf * 1024 + 2 * tid) * 8 + h;
                float lf[2], lg[2] = {0.f, 0.f};
#pragma unroll
                for (int e = 0; e < 2; ++e) { const float f = fl[e * 8] + bf; lf[e] = fminf(f, 0.f) - log1pf(expf(-fabsf(f))); }
                if (hf) {
#pragma unroll
                    for (int e = 0; e < 2; ++e) { const float f = fl[e * 8 - 1024 * 8] + bf; lg[e] = fminf(f, 0.f) - log1pf(expf(-fabsf(f))); } }
                const double s2 = (double)lf[0] + (double)lf[1];
                double incl = s2, first = (double)lg[0] + (double)lg[1];
#pragma unroll
                for (int o = 1; o < 64; o <<= 1) { const double t = __shfl_up(incl, o); if (lane >= o) incl += t; first += __shfl_xor(first, o); }
                LAS double* wtot = (LAS double*)lds;
                if (lane == 63) wtot[wave] = incl;
                if (lane == 0) wtot[8 + wave] = first;
                __syncthreads();
                double c = incl - s2;
                for (int w = 0; w < wave; ++w) c += wtot[w];
                if (hf) { for (int w = 0; w < 8; ++w) c += wtot[8 + w]; }
                const size_t t0 = ((size_t)b * 8 + h) * SEQ + hf * 1024 + 2 * tid;
                GAS u32x4* ka = (GAS u32x4*)(P_KAUG + t0 * 8);
#pragma unroll
                for (int e = 0; e < 2; ++e) { c += (double)lf[e]; const float x = (float)(-c * 1.4426950408889634);
                    const unsigned h16 = cvt_pk_bf16(x, 0.f) & 0xffffu; const float r1 = x - __uint_as_float(h16 << 16); const unsigned m16 = cvt_pk_bf16(r1, 0.f) & 0xffffu; const float r2 = r1 - __uint_as_float(m16 << 16); const unsigned l16 = cvt_pk_bf16(r2, 0.f) & 0xffffu;
                    ka[e] = (u32x4){h16 | (m16 << 16), l16, 0u, 0u}; P_BIASF[t0 + e] = x; }
                float qn = 0.f, kn = 0.f;
                { const GAS bf16* fqp = P_FQKV + ((size_t)b * SEQ + hf * 1024 + 2 * tid) * 512 + h * 64; const GAS bf16* fkp = fqp + (size_t)NTOK * 512;
#pragma unroll
                  for (int e = 0; e < 2; ++e) { float sq_ = 0.f, sk = 0.f;
#pragma unroll
                      for (int c8 = 0; c8 < 8; ++c8) { const u32x4 a = *(const GAS u32x4*)(fqp + e * 512 + c8 * 8), k4 = *(const GAS u32x4*)(fkp + e * 512 + c8 * 8);
#pragma unroll
                          for (int j = 0; j < 4; ++j) { const float a0 = __uint_as_float(a[j] << 16), a1 = __uint_as_float(a[j] & 0xffff0000u), k0 = __uint_as_float(k4[j] << 16), k1 = __uint_as_float(k4[j] & 0xffff0000u);
                              sq_ += a0 * a0 + a1 * a1; sk += k0 * k0 + k1 * k1; } }
                      qn = fmaxf(qn, sq_); kn = fmaxf(kn, sk); } }
#pragma unroll
                for (int o = 1; o < 64; o <<= 1) { qn = fmaxf(qn, __shfl_xor(qn, o)); kn = fmaxf(kn, __shfl_xor(kn, o)); }
                LAS float* knw = (LAS float*)(lds + 256);
                if (lane == 0) { knw[wave] = kn; knw[8 + wave] = qn; }
                __syncthreads();
                if (tid < 4) P_NRM[sq * 16 + hf * 4 + tid] = sqrtf(fmaxf(knw[8 + 2 * tid], knw[8 + 2 * tid + 1]));
                if (tid == 4) { float m = knw[0]; for (int w = 1; w < 8; ++w) m = fmaxf(m, knw[w]); P_NRM[sq * 16 + 8 + hf] = sqrtf(m); }
                __syncthreads();
            }
            UpOrder S{G, vcu, (const GAS char*)P_LAT, (const GAS char*)P_WUQ, (const GAS char*)P_WUKV};
            EpiUp E{P_QM, P_KVM, P_SSQ, P_COS, P_SIN};
            pg8::gemm_phase<EpiUp, UpOrder, true, false>(tid, lds, 256 * 2, 512 * 2, 256 * 2, S, E, nullptr);
        }
        SEAM(P + 2);
        if (IN(P + 3)) for (int rep_ = 0; rep_ < ((l == 0 || 3 != 5) ? NREP(3) : 1); ++rep_) {
            unsigned ldsb_ = (unsigned)(uintptr_t)lds0; asm volatile("" : "+s"(ldsb_)); LAS unsigned char* lds = (LAS unsigned char*)(uintptr_t)ldsb_; volatile LAS unsigned* MISC = (volatile LAS unsigned*)(lds + MISC_OFF); volatile LAS unsigned long long* ARGP = (volatile LAS unsigned long long*)(lds + MISC_OFF + 768); (void)MISC; int wave = wave0, G = G0, bx = bx0; asm volatile("" : "+s"(G), "+s"(bx), "+s"(wave)); const int lane = (int)__builtin_amdgcn_mbcnt_hi(~0u, __builtin_amdgcn_mbcnt_lo(~0u, 0u)); const int tid = wave * 64 + lane; const int vcu = (bx % 8) * (G / 8) + bx / 8; const int gw = vcu * 8 + wave, NGW = G * 8; (void)lane; (void)gw; (void)NGW; (void)vcu;
            GAS unsigned char* ws = (GAS unsigned char*)LDP(22); GAS float* out = (GAS float*)LDP(21); const GAS float* x_in = (const GAS float*)ARGIN(0); (void)out; (void)x_in; (void)ws;
            GAS bf16* O = P_XN;
            const int b = vcu >> 4, hh = (vcu & 15) >> 1, sub = vcu & 1;
            const att::Tens2 TM{P_QM, 768, P_KVM, 1024, P_KPE, P_KVM + 64, 1024, O, nullptr, nullptr, P_OSS};
            const att::Tens2 TF{P_FQKV, 512, P_FQKV + (size_t)NTOK * 512, 512, P_KAUG, P_FQKV + (size_t)2 * NTOK * 512, 512, O, P_BIASF, P_NRM, P_OSS};
#define QB_OF(i) ((((i) & 1) ? 7 - (2 * sub + ((i) >> 1)) : (2 * sub + ((i) >> 1))))
            int ts0, ts1, ts2, ts3;
            { const GAS float* bs = P_BIASF + ((long)b * 8 + hh) * SEQ; const GAS float* nr = P_NRM + (b * 8 + hh) * 16; const float kmx = fmaxf(nr[8], nr[9]);
#define FOX_TS(i, dst) do { const int qb_ = QB_OF(i), NT_ = 4 * qb_ + 4; const float Z_ = nr[qb_] * kmx * 1.001f + 0.01f; const float bend_ = bs[(lane < NT_ ? lane : NT_ - 1) * 64 + 63]; \
                  const bool skip_ = (lane < NT_ - 4) && (2.f * Z_ + bend_ - bs[qb_ * 256] < -40.f); dst = __builtin_popcountll(__ballot(skip_)); } while (0)
              FOX_TS(0, ts0); FOX_TS(1, ts1); FOX_TS(2, ts2); FOX_TS(3, ts3);
#undef FOX_TS
            }
            bf16x8 qreg[6];
            { int sb = 0; for (int i = 0; i < 4; ++i) sb = att::attn_unit2<1>(wave, b, hh, QB_OF(i), TM, (LAS char*)lds, sb, i > 0, i < 3 ? QB_OF(i + 1) : -1, qreg, 0); }
            { int sb = 0; for (int i = 0; i < 4; ++i) { const int ts = i == 0 ? ts0 : i == 1 ? ts1 : i == 2 ? ts2 : ts3; sb = att::attn_unit2<0>(wave, b, hh, QB_OF(i), TF, (LAS char*)lds, sb, i > 0, i < 3 ? QB_OF(i + 1) : -1, qreg, ts); } }
#undef QB_OF
        }
        SEAM(P + 3);
        if (IN(P + 5)) for (int rep_ = 0; rep_ < ((l == 0 || 5 != 5) ? NREP(5) : 1); ++rep_) {
            unsigned ldsb_ = (unsigned)(uintptr_t)lds0; asm volatile("" : "+s"(ldsb_)); LAS unsigned char* lds = (LAS unsigned char*)(uintptr_t)ldsb_; volatile LAS unsigned* MISC = (volatile LAS unsigned*)(lds + MISC_OFF); volatile LAS unsigned long long* ARGP = (volatile LAS unsigned long long*)(lds + MISC_OFF + 768); (void)MISC; int wave = wave0, G = G0, bx = bx0; asm volatile("" : "+s"(G), "+s"(bx), "+s"(wave)); const int lane = (int)__builtin_amdgcn_mbcnt_hi(~0u, __builtin_amdgcn_mbcnt_lo(~0u, 0u)); const int tid = wave * 64 + lane; const int vcu = (bx % 8) * (G / 8) + bx / 8; const int gw = vcu * 8 + wave, NGW = G * 8; (void)lane; (void)gw; (void)NGW; (void)vcu;
            GAS unsigned char* ws = (GAS unsigned char*)LDP(22); GAS float* out = (GAS float*)LDP(21); const GAS float* x_in = (const GAS float*)ARGIN(0); (void)out; (void)x_in; (void)ws;
            DenseOrder S{NTOK / 256, DM / 256, (NTOK / 256) * (DM / 256), G, bx, (const GAS char*)P_XN, (const GAS char*)P_WOUT, (size_t)256 * DM * 2, (size_t)256 * DM * 2};
            EpiOut<false> E{x_in, P_XR};
            LAS f32x2* scl = (LAS f32x2*)(lds + pg8::STAGE_BYTES);
            { Unit u_; if (S.next(tid >> 8, u_)) { const GAS float* op = P_OSS + ((size_t)u_.pm * 256 + (tid & 255)) * 16;
                  const f32x4 a0 = *(const GAS f32x4*)op, a1 = *(const GAS f32x4*)(op + 4), c0 = *(const GAS f32x4*)(op + 8), c1 = *(const GAS f32x4*)(op + 12);
                  const float sm = ((a0[0] + a0[1]) + (a0[2] + a0[3])) + ((a1[0] + a1[1]) + (a1[2] + a1[3])), sf = ((c0[0] + c0[1]) + (c0[2] + c0[3])) + ((c1[0] + c1[1]) + (c1[2] + c1[3]));
                  const float rm_ = rsqrtf(sm * (1.f / 512.f) + EPS), rf_ = rsqrtf(sf * (1.f / 512.f) + EPS);
                  scl[tid] = (f32x2){rm_ / rf_, rf_}; } }
            __syncthreads();
            pg8::gemm_phase<EpiOut<false>, DenseOrder, true, false, false, true>(tid, lds, DM * 2, DM * 2, DM * 2, S, E, nullptr, scl);
        }
        SEAM(P + 5);
        if (IN(P + 6)) for (int rep_ = 0; rep_ < ((l == 0 || 6 != 5) ? NREP(6) : 1); ++rep_) {
            unsigned ldsb_ = (unsigned)(uintptr_t)lds0; asm volatile("" : "+s"(ldsb_)); LAS unsigned char* lds = (LAS unsigned char*)(uintptr_t)ldsb_; volatile LAS unsigned* MISC = (volatile LAS unsigned*)(lds + MISC_OFF); volatile LAS unsigned long long* ARGP = (volatile LAS unsigned long long*)(lds + MISC_OFF + 768); (void)MISC; int wave = wave0, G = G0, bx = bx0; asm volatile("" : "+s"(G), "+s"(bx), "+s"(wave)); const int lane = (int)__builtin_amdgcn_mbcnt_hi(~0u, __builtin_amdgcn_mbcnt_lo(~0u, 0u)); const int tid = wave * 64 + lane; const int vcu = (bx % 8) * (G / 8) + bx / 8; const int gw = vcu * 8 + wave, NGW = G * 8; (void)lane; (void)gw; (void)NGW; (void)vcu;
            GAS unsigned char* ws = (GAS unsigned char*)LDP(22); GAS float* out = (GAS float*)LDP(21); const GAS float* x_in = (const GAS float*)ARGIN(0); (void)out; (void)x_in; (void)ws;
            GAS bf16* H2 = P_XN;
            LAS bf16* WT = (LAS bf16*)lds;
            LAS float* LG = (LAS float*)(lds + 99840) + wave * 576;
            const GAS float* b_rg = (const GAS float*)ARGIN(14) + l * 4; const GAS float* b_re = (const GAS float*)ARGIN(16) + l * 32;
            if (tid < 32) MISC[64 + tid] = 0u;
            const int r16 = lane & 15, g4 = lane >> 4;
            const int m0 = vcu * 128 + wave * 16;
            const GAS bf16* xrow = P_XR + (size_t)(m0 + r16) * DM + 8 * g4;
            GAS unsigned char* hrow = (GAS unsigned char*)H2 + (size_t)(m0 + r16) * DM + 8 * g4;
            f32x4 acc3[3]; acc3[0] = (f32x4){0.f, 0.f, 0.f, 0.f}; acc3[1] = acc3[0]; acc3[2] = acc3[0];
            float ssq = 0.f;
            for (int half = 0; half < 2; ++half) {
                __syncthreads();
                for (int idx = tid; idx < 2 * 48 * 520 / 8; idx += 512) *(LAS u32x4*)(WT + 8 * idx) = *(const GAS u32x4*)(P_WR + (size_t)half * 2 * 48 * 520 + 8 * idx);
                __syncthreads();
                for (int s8 = 0; s8 < 16; s8 += 8) {
                    bf16x8 xv[8];
#pragma unroll
                    for (int u = 0; u < 8; ++u) xv[u] = *(const GAS bf16x8*)(xrow + half * 512 + 32 * (s8 + u));
#pragma unroll
                    for (int u = 0; u < 8; ++u) {
                        const u32x4 xw = __builtin_bit_cast(u32x4, xv[u]); float xf[8];
#pragma unroll
                        for (int j = 0; j < 4; ++j) { xf[2 * j] = __uint_as_float(xw[j] << 16); xf[2 * j + 1] = __uint_as_float(xw[j] & 0xffff0000u); }
                        u32x2 hw; hw.x = pk4_fp8(xf[0], xf[1], xf[2], xf[3]); hw.y = pk4_fp8(xf[4], xf[5], xf[6], xf[7]); *(GAS u32x2*)(hrow + half * 512 + 32 * (s8 + u)) = hw;
#pragma unroll
                        for (int j = 0; j < 8; ++j) ssq += xf[j] * xf[j];
                        const LAS bf16* wk = WT + r16 * 520 + 32 * (s8 + u) + 8 * g4;
#pragma unroll
                        for (int ct = 0; ct < 3; ++ct) { const bf16x8 bh = *(const LAS bf16x8*)(wk + ct * 16 * 520), bl = *(const LAS bf16x8*)(wk + (48 + ct * 16) * 520);
                            acc3[ct] = __builtin_amdgcn_mfma_f32_16x16x32_bf16(xv[u], bh, acc3[ct], 0, 0, 0); acc3[ct] = __builtin_amdgcn_mfma_f32_16x16x32_bf16(xv[u], bl, acc3[ct], 0, 0, 0); }
                    }
                }
            }
            ssq += __shfl_xor(ssq, 16); ssq += __shfl_xor(ssq, 32);
            const float rstd = rsqrtf(ssq * (1.f / DM) + EPS);
#pragma unroll
            for (int ct = 0; ct < 3; ++ct) { const int c = 16 * ct + r16; if (c < 36) {
#pragma unroll
                for (int rg = 0; rg < 4; ++rg) LG[(4 * g4 + rg) * 36 + c] = acc3[ct][rg]; } }
            LDS_WAIT();
            if (lane < 16) {
                const int m = m0 + lane; const LAS float* lg = LG + lane * 36;
                float gl[4];
#pragma unroll
                for (int g = 0; g < 4; ++g) gl[g] = lg[g] * rstd + b_rg[g];
                int gi = 0; float gm = gl[0];
#pragma unroll
                for (int g = 1; g < 4; ++g) if (gl[g] > gm) { gm = gl[g]; gi = g; }
                float gs = 0.f;
#pragma unroll
                for (int g = 0; g < 4; ++g) gs += __expf(gl[g] - gm);
                const float gval = 1.f / gs;
                float el[8];
#pragma unroll
                for (int j = 0; j < 8; ++j) el[j] = lg[4 + 8 * gi + j] * rstd + b_re[8 * gi + j];
                int i0 = 0; float mx0 = el[0];
#pragma unroll
                for (int j = 1; j < 8; ++j) if (el[j] > mx0) { mx0 = el[j]; i0 = j; }
                int i1 = -1; float mx1 = -INFINITY;
#pragma unroll
                for (int j = 0; j < 8; ++j) if (j != i0 && el[j] > mx1) { mx1 = el[j]; i1 = j; }
                const float e1 = __expf(mx1 - mx0); const float g0 = gval / (1.f + e1), g1 = gval * e1 / (1.f + e1);
                const int ea = gi * 8 + i0, eb = gi * 8 + i1; P_E01[2 * m] = ea; P_E01[2 * m + 1] = eb; P_G01[2 * m] = g0; P_G01[2 * m + 1] = g1; P_RSTD[m] = rstd;
                __hip_atomic_fetch_add((LAS unsigned*)(lds + MISC_OFF) + 64 + ea, 1u, __ATOMIC_RELAXED, __HIP_MEMORY_SCOPE_WORKGROUP); __hip_atomic_fetch_add((LAS unsigned*)(lds + MISC_OFF) + 64 + eb, 1u, __ATOMIC_RELAXED, __HIP_MEMORY_SCOPE_WORKGROUP);
            }
            __syncthreads();
            if (tid < 32) P_CNT[vcu * 32 + tid] = (int)MISC[64 + tid];
        }
        SEAM(P + 6);
        if (IN(P + 7)) for (int rep_ = 0; rep_ < ((l == 0 || 7 != 5) ? NREP(7) : 1); ++rep_) {
            unsigned ldsb_ = (unsigned)(uintptr_t)lds0; asm volatile("" : "+s"(ldsb_)); LAS unsigned char* lds = (LAS unsigned char*)(uintptr_t)ldsb_; volatile LAS unsigned* MISC = (volatile LAS unsigned*)(lds + MISC_OFF); volatile LAS unsigned long long* ARGP = (volatile LAS unsigned long long*)(lds + MISC_OFF + 768); (void)MISC; int wave = wave0, G = G0, bx = bx0; asm volatile("" : "+s"(G), "+s"(bx), "+s"(wave)); const int lane = (int)__builtin_amdgcn_mbcnt_hi(~0u, __builtin_amdgcn_mbcnt_lo(~0u, 0u)); const int tid = wave * 64 + lane; const int vcu = (bx % 8) * (G / 8) + bx / 8; const int gw = vcu * 8 + wave, NGW = G * 8; (void)lane; (void)gw; (void)NGW; (void)vcu;
            GAS unsigned char* ws = (GAS unsigned char*)LDP(22); GAS float* out = (GAS float*)LDP(21); const GAS float* x_in = (const GAS float*)ARGIN(0); (void)out; (void)x_in; (void)ws;
            LAS int* cnt_all = (LAS int*)lds;
            LAS int* pre_e = (LAS int*)(lds + 32768);
            LAS int* tot_e = pre_e + 32;
            LAS int* pst = pre_e + 64;
            LAS int* eL = pre_e + 128;
            for (int i = tid; i < 256 * 32; i += 512) cnt_all[i] = P_CNT[i];
            if (tid < 256) eL[tid] = P_E01[vcu * 256 + tid];
            __syncthreads();
            { LAS int* part = pre_e + 512;
              const int e = tid & 31, p = tid >> 5; int pre = 0, tot = 0;
#pragma unroll
              for (int j = 0; j < 16; ++j) { const int w = p * 16 + j; const int c = cnt_all[w * 32 + e]; pre += (w < vcu) ? c : 0; tot += c; }
              part[(p * 2) * 32 + e] = pre; part[(p * 2 + 1) * 32 + e] = tot; }
            __syncthreads();
            if (tid < 32) { LAS int* part = pre_e + 512; int pre = 0, tot = 0;
#pragma unroll
                for (int p = 0; p < 16; ++p) { pre += part[(p * 2) * 32 + tid]; tot += part[(p * 2 + 1) * 32 + tid]; } pre_e[tid] = pre; tot_e[tid] = tot; }
            __syncthreads();
            if (tid == 0) { int acc = 0; for (int e = 0; e < 32; ++e) { pst[e] = acc; acc += (tot_e[e] + 255) / 256 * 256; } pst[32] = acc; }
            __syncthreads();
            if (vcu == 0 && tid <= 32) P_TSTART[tid] = pst[tid] / 256;
            { LAS int* hist = pre_e + 2048;
              if (tid < 128) hist[tid] = 0;
              __syncthreads();
              int e = 0, rin = 0;
              if (tid < 256) { e = eL[tid]; unsigned long long mym = 0ull;
                  for (int x = 0; x < 32; ++x) { const unsigned long long bm = __ballot(e == x); if (e == x) mym = bm; }
                  rin = __builtin_popcountll(mym & ((1ull << lane) - 1ull));
                  if (rin == 0) hist[wave * 32 + e] = __builtin_popcountll(mym); }
              __syncthreads();
              if (tid < 256) { int r = rin; for (int w = 0; w < wave; ++w) r += hist[w * 32 + e];
                  const int slot = pst[e] + pre_e[e] + r; const int tok = vcu * 128 + (tid >> 1);
                  P_SLOT[vcu * 256 + tid] = slot; P_TOKOF[slot] = tok; P_GATEOF[slot] = P_G01[vcu * 256 + tid]; P_RSTDOF[slot] = P_RSTD[tok]; } }
            if (vcu < 32) { const int e = vcu; for (int s = pst[e] + tot_e[e] + tid; s < pst[e + 1]; s += 512) { P_TOKOF[s] = 0; P_GATEOF[s] = 0.f; P_RSTDOF[s] = 0.f; } }
            __syncthreads();
        }
        SEAM(P + 7);
        if (IN(P + 8)) for (int rep_ = 0; rep_ < ((l == 0 || 8 != 5) ? NREP(8) : 1); ++rep_) {
            unsigned ldsb_ = (unsigned)(uintptr_t)lds0; asm volatile("" : "+s"(ldsb_)); LAS unsigned char* lds = (LAS unsigned char*)(uintptr_t)ldsb_; volatile LAS unsigned* MISC = (volatile LAS unsigned*)(lds + MISC_OFF); volatile LAS unsigned long long* ARGP = (volatile LAS unsigned long long*)(lds + MISC_OFF + 768); (void)MISC; int wave = wave0, G = G0, bx = bx0; asm volatile("" : "+s"(G), "+s"(bx), "+s"(wave)); const int lane = (int)__builtin_amdgcn_mbcnt_hi(~0u, __builtin_amdgcn_mbcnt_lo(~0u, 0u)); const int tid = wave * 64 + lane; const int vcu = (bx % 8) * (G / 8) + bx / 8; const int gw = vcu * 8 + wave, NGW = G * 8; (void)lane; (void)gw; (void)NGW; (void)vcu;
            GAS unsigned char* ws = (GAS unsigned char*)LDP(22); GAS float* out = (GAS float*)LDP(21); const GAS float* x_in = (const GAS float*)ARGIN(0); (void)out; (void)x_in; (void)ws;
            volatile LAS int* TS = (volatile LAS int*)(MISC + 128);
            if (tid <= 32) TS[tid] = P_TSTART[tid];
            __syncthreads();
            MoeOrder S{G, vcu, TS, (const GAS char*)P_XN, (const GAS char*)P_WGU_L(l), 0, (size_t)1024 * 1024, (size_t)256 * 1024};
            EpiGU E{(GAS unsigned char*)P_HH, P_RSTDOF};
            pg8::gemm_phase<EpiGU, MoeOrder, true, true, true>(tid, lds, DM, DM, DM, S, E, P_TOKOF);
            if constexpr (l + 1 < NLAYER) {
                const int U = (int)TS[32] * 4, rem = U & 255; const int nidle = rem ? 256 - rem : 256, rk = rem ? vcu - rem : vcu;
                if (rk >= 0) { LAS float* scr64 = (LAS float*)(lds + wave * 16640);
                    const GAS float* w_gate = (const GAS float*)ARGIN(17) + (size_t)(l + 1) * NEXP * DM * DEXP; const GAS float* w_up = (const GAS float*)ARGIN(18) + (size_t)(l + 1) * NEXP * DM * DEXP; const GAS float* ffn1 = (const GAS float*)ARGIN(12) + (size_t)(l + 1) * DM;
                    for (int it = rk * 8 + wave; it < 16 * 16 * NEXP; it += nidle * 8) conv_gu_item(it, w_gate, w_up, ffn1, P_WGU_L(l + 1), scr64, lane); }
            }
        }
        SEAM(P + 8);
        if (IN(P + 9)) for (int rep_ = 0; rep_ < ((l == 0 || 9 != 5) ? NREP(9) : 1); ++rep_) {
            unsigned ldsb_ = (unsigned)(uintptr_t)lds0; asm volatile("" : "+s"(ldsb_)); LAS unsigned char* lds = (LAS unsigned char*)(uintptr_t)ldsb_; volatile LAS unsigned* MISC = (volatile LAS unsigned*)(lds + MISC_OFF); volatile LAS unsigned long long* ARGP = (volatile LAS unsigned long long*)(lds + MISC_OFF + 768); (void)MISC; int wave = wave0, G = G0, bx = bx0; asm volatile("" : "+s"(G), "+s"(bx), "+s"(wave)); const int lane = (int)__builtin_amdgcn_mbcnt_hi(~0u, __builtin_amdgcn_mbcnt_lo(~0u, 0u)); const int tid = wave * 64 + lane; const int vcu = (bx % 8) * (G / 8) + bx / 8; const int gw = vcu * 8 + wave, NGW = G * 8; (void)lane; (void)gw; (void)NGW; (void)vcu;
            GAS unsigned char* ws = (GAS unsigned char*)LDP(22); GAS float* out = (GAS float*)LDP(21); const GAS float* x_in = (const GAS float*)ARGIN(0); (void)out; (void)x_in; (void)ws;
            volatile LAS int* TS = (volatile LAS int*)(MISC + 128);
            if (tid <= 32) TS[tid] = P_TSTART[tid];
            __syncthreads();
            MoeOrder S{G, vcu, TS, (const GAS char*)P_HH, (const GAS char*)P_WD_L(l), (size_t)256 * 512, (size_t)1024 * 512, (size_t)256 * 512};
            EpiDown E{(GAS unsigned char*)P_Y, P_GATEOF};
            pg8::gemm_phase<EpiDown, MoeOrder, true, false, true>(tid, lds, DEXP, DEXP, DEXP, S, E, nullptr);
            if constexpr (l + 1 < NLAYER) {
                const int U = (int)TS[32] * 4, rem = U & 255; const int nidle = rem ? 256 - rem : 256, rk = rem ? vcu - rem : vcu;
                if (rk >= 0) { LAS float* scr64 = (LAS float*)(lds + wave * 16640);
                    const GAS float* w_down = (const GAS float*)ARGIN(19) + (size_t)(l + 1) * NEXP * DEXP * DM;
                    for (int it = rk * 8 + wave; it < 8 * 16 * NEXP; it += nidle * 8) conv_d_item(it, w_down, P_WD_L(l + 1), scr64, lane); }
            }
        }
        SEAM(P + 9);
}

__global__ void __launch_bounds__(512, 2) fwd(Args args) {
    extern __shared__ __attribute__((aligned(16))) unsigned char lds_raw[];
    LAS unsigned char* lds0 = (LAS unsigned char*)lds_raw;
    const int tid0 = threadIdx.x; const int wave0 = __builtin_amdgcn_readfirstlane(tid0 >> 6);
    const int G0 = gridDim.x; const int bx0 = blockIdx.x;
    { volatile LAS unsigned* MISC = (volatile LAS unsigned*)(lds0 + MISC_OFF); const int tid = tid0;
    for (int u = tid; u < 256; u += 512) MISC[u] = 0u;
    __syncthreads();
    volatile LAS unsigned long long* ARGP = (volatile LAS unsigned long long*)(lds0 + MISC_OFF + 768);
    if (tid < 21) ARGP[tid] = (unsigned long long)args.in[tid];
    if (tid == 21) ARGP[21] = (unsigned long long)args.out;
    if (tid == 22) ARGP[22] = (unsigned long long)args.ws;
    __syncthreads(); }
#if MK_ONE_LAUNCH
    XcdBarrier bar = xcd_barrier_post((unsigned*)(args.ws + WS_CTL) + CW_BAR, (volatile LAS unsigned*)(lds0 + MISC_OFF) + 8);
#else
    XcdBarrier bar; bar.bar = nullptr; bar.x = 0; bar.st = nullptr;
#endif
    const int lo = args.ph_lo, hi_ = args.ph_hi;
    if (IN(0)) {
        const GAS int* positions = (const GAS int*)args.in[1]; GAS float* COSp = (GAS float*)(args.ws + WS_COS); GAS float* SINp = (GAS float*)(args.ws + WS_SIN);
        for (int i = bx0 * 512 + tid0; i < NTOK * 16; i += G0 * 512) { const int tk = i >> 4, fi = i & 15;
            const double inv = exp2(-(double)fi * (13.287712379549449 / 16.0)); const double ang = (double)positions[tk] * inv;
            COSp[i] = (float)cos(ang); SINp[i] = (float)sin(ang); }
    }
    layer_body<0>(lo, hi_, lds0, wave0, G0, bx0, bar);
    layer_body<1>(lo, hi_, lds0, wave0, G0, bx0, bar);
    layer_body<2>(lo, hi_, lds0, wave0, G0, bx0, bar);
}

extern "C" void kernel_launch(void* const* d_in, const int* in_sizes, int n_in, void* d_out, int out_size, void* d_ws, size_t ws_size, hipStream_t stream) {
    static int grid = 0;
    if (grid == 0) {
        if (n_in != 21 || out_size != NTOK * DM || ws_size < WS_END) { fprintf(stderr, "kernel_launch: unexpected shapes (n_in %d out %d ws %zu)\n", n_in, out_size, ws_size); grid = -1; return; }
        int dev = 0, cus = 0;
        if (hipGetDevice(&dev) != hipSuccess || hipDeviceGetAttribute(&cus, hipDeviceAttributeMultiprocessorCount, dev) != hipSuccess) { grid = -1; return; }
        if (hipFuncSetAttribute((const void*)fwd, hipFuncAttributeMaxDynamicSharedMemorySize, LDS_BYTES) != hipSuccess) { fprintf(stderr, "kernel_launch: hipFuncSetAttribute failed\n"); grid = -1; return; }
        int per_cu = 0;
        if (hipOccupancyMaxActiveBlocksPerMultiprocessor(&per_cu, (const void*)fwd, 512, LDS_BYTES) != hipSuccess || per_cu < 1) fprintf(stderr, "kernel_launch: occupancy query says %d\n", per_cu);
        (void)hipGetLastError();
        grid = cus;
        if (grid != 256) { fprintf(stderr, "kernel_launch: built for 256 CUs, got %d\n", grid); grid = -1; return; }
    }
    if (grid < 0) return;
    if (hipMemsetAsync((char*)d_ws + WS_CTL, 0, CTL_ZERO_BYTES, stream) != hipSuccess) return;
    Args a{};
    for (int i = 0; i < 21; ++i) a.in[i] = d_in[i];
    a.out = (float*)d_out; a.ws = (unsigned char*)d_ws;
#if MK_ONE_LAUNCH
    a.ph_lo = 0; a.ph_hi = 21;
    hipLaunchKernelGGL(fwd, dim3(grid), dim3(512), LDS_BYTES, stream, a);
#else
    for (int p = 0; p <= 20; ++p) { a.ph_lo = p; a.ph_hi = p + 1; hipLaunchKernelGGL(fwd, dim3(grid), dim3(512), LDS_BYTES, stream, a); }
#endif
}
```

```cpp
#include <hip/hip_runtime.h>
#include <cstdio>
#include <cstdint>

#ifndef PROBE_PHASE
#define PROBE_PHASE -1
#endif
#define NREP(k) ((PROBE_PHASE) == (k) ? 2 : 1)
#ifndef MK_ONE_LAUNCH
#define MK_ONE_LAUNCH 1
#endif

#define LAS __attribute__((address_space(3)))
#define GAS __attribute__((address_space(1)))
typedef unsigned short bf16;
typedef short bf16x8 __attribute__((ext_vector_type(8)));
typedef short s16x4 __attribute__((ext_vector_type(4)));
typedef float f32x4 __attribute__((ext_vector_type(4)));
typedef float f32x2 __attribute__((ext_vector_type(2)));
typedef float f32x16 __attribute__((ext_vector_type(16)));
typedef unsigned u32x4 __attribute__((ext_vector_type(4)));
typedef unsigned u32x2 __attribute__((ext_vector_type(2)));

constexpr int NB = 16, SEQ = 2048, DM = 1024, NTOK = NB * SEQ, NLAYER = 2;
constexpr int INW = 1960, INP = 2048;
constexpr int NEXP = 32, DEXP = 512;
constexpr int MAXSLOT = 73728;
constexpr float EPS = 1e-6f;
constexpr float WSCALE = 64.f, WSCALE_INV = 1.f / 64.f;
constexpr float LOG2E = 1.4426950408889634f;
constexpr float C2F = 0.125f * LOG2E;
constexpr float C2M = 0.10206207261596575f * LOG2E;

constexpr size_t MiB = 1u << 20, KiB = 1u << 10;
constexpr size_t WS_CTL = 0, CTL_ZERO_BYTES = 64 * KiB;
constexpr size_t WS_COS = 1 * MiB, WS_SIN = 3 * MiB;
constexpr size_t WS_SSQ = 5 * MiB;
constexpr size_t WS_FLOG = 6 * MiB;
constexpr size_t WS_E01 = 8 * MiB;
constexpr size_t WS_G01 = 8 * MiB + 256 * KiB;
constexpr size_t WS_SLOT = 8 * MiB + 512 * KiB;
constexpr size_t WS_TOKOF = 8 * MiB + 768 * KiB;
constexpr size_t WS_GATEOF = 9 * MiB + 256 * KiB;
constexpr size_t WS_CNT = 9 * MiB + 768 * KiB;
constexpr size_t WS_TSTART = 9 * MiB + 800 * KiB;
constexpr size_t WS_RSTD = 9 * MiB + 832 * KiB;
constexpr size_t WS_RSTDOF = 7 * MiB;
constexpr size_t WS_KPE = 10 * MiB;
constexpr size_t WS_KAUG = 10 * MiB + 2 * MiB;
constexpr size_t WS_WIN = 16 * MiB;
constexpr size_t WS_WUQ = 20 * MiB;
constexpr size_t WS_WUKV = 20 * MiB + 512 * KiB;
constexpr size_t WS_WOUT = 21 * MiB;
constexpr size_t WS_WGU = 24 * MiB;
constexpr size_t WS_WD = 88 * MiB;
constexpr size_t WS_XN = 120 * MiB;
constexpr size_t WS_FQKV = 184 * MiB;
constexpr size_t WS_LAT = 280 * MiB;
constexpr size_t WS_QM = 312 * MiB;
constexpr size_t WS_KVM = 360 * MiB;
constexpr size_t WS_Y = 280 * MiB;
constexpr size_t WS_BIASF = 424 * MiB;
constexpr size_t WS_NRM = 425 * MiB;
constexpr size_t WS_WR = 426 * MiB;
constexpr size_t WS_XR = 427 * MiB;
constexpr size_t WS_OSS = 491 * MiB;
constexpr size_t WS_RSTDX = 493 * MiB;
constexpr size_t WS_END = 494 * MiB;
static_assert(WS_Y + (size_t)MAXSLOT * 1024 * 2 <= WS_END, "Y fits");
static_assert(WS_FQKV + (size_t)MAXSLOT * 512 * 2 <= WS_LAT, "HH fits");

constexpr int CW_BAR = 1024;

constexpr int RING_BYTES = 147456;
constexpr int MISC_OFF = RING_BYTES;
constexpr int LDS_BYTES = RING_BYTES + 1024;

typedef __bf16 bf16x2_t __attribute__((ext_vector_type(2)));
__device__ __forceinline__ unsigned cvt_pk_bf16(float lo, float hi) { const f32x2 v = {lo, hi}; const bf16x2_t b = __builtin_convertvector(v, bf16x2_t); return __builtin_bit_cast(unsigned, b); }
__device__ __forceinline__ float bf2f(unsigned short b) { return __uint_as_float((unsigned)b << 16); }
__device__ __forceinline__ float wave_sum(float v) {
#pragma unroll
    for (int o = 1; o < 64; o <<= 1) v += __shfl_xor(v, o);
    return v;
}
__device__ __forceinline__ unsigned pk4_fp8(float a, float b, float c, float d) { int w = 0; w = __builtin_amdgcn_cvt_pk_fp8_f32(a, b, w, false); w = __builtin_amdgcn_cvt_pk_fp8_f32(c, d, w, true); return (unsigned)w; }
#define LDS_WAIT() asm volatile("s_waitcnt lgkmcnt(0)" ::: "memory")

#define XB_TMO      128
#define XB_XCNT(j)  (256  + 64 * (j))
#define XB_XSUB(j)  (1280 + 64 * (j))
#define XB_XGEN(j)  (2304 + 64 * (j))
#define XB_TOP      3328
#define XB_TOPGEN   3392
#define XCD_BAR_WORDS 3456
#define XB_SPIN_CAP (1u << 18)
__device__ __forceinline__ unsigned xb_ld(unsigned* p)              { return __hip_atomic_load(p, __ATOMIC_RELAXED, __HIP_MEMORY_SCOPE_AGENT); }
__device__ __forceinline__ unsigned xb_add(unsigned* p, unsigned v) { return __hip_atomic_fetch_add(p, v, __ATOMIC_RELAXED, __HIP_MEMORY_SCOPE_AGENT); }
__device__ __forceinline__ unsigned xb_xcc_id() { return (unsigned)__builtin_amdgcn_s_getreg((3 << 11) | 20) & 0xFu; }
#define XB_SPIN(cond, bar) do { unsigned _sp = 0; while (cond) { __builtin_amdgcn_s_sleep(1); \
    if ((++_sp & 255u) == 0u) { if (xb_ld(&(bar)[XB_TMO])) break; if (_sp > XB_SPIN_CAP) { atomicAdd(&(bar)[XB_TMO], 1u); break; } } } } while (0)
struct XcdBarrier { unsigned* bar; unsigned x; volatile LAS unsigned* st; };
__device__ __forceinline__ XcdBarrier xcd_barrier_post(unsigned* bar, volatile LAS unsigned* st) {
    XcdBarrier b; b.bar = bar; b.x = xb_xcc_id(); b.st = st;
    if (threadIdx.x == 0) (void)xb_add(&bar[XB_XCNT(b.x)], 1u);
    return b;
}
__device__ __forceinline__ void xcd_barrier_complete(unsigned* bar, unsigned x, unsigned& nloc, unsigned& nx) {
    const unsigned G = gridDim.x * gridDim.y * gridDim.z;
    unsigned sum, cnt, mine, sp = 0u;
    for (;;) {
        sum = 0u; cnt = 0u; mine = 0u;
#pragma unroll
        for (unsigned j = 0; j < 16; ++j) { const unsigned c = xb_ld(&bar[XB_XCNT(j)]); sum += c; cnt += (c > 0u) ? 1u : 0u; mine = (j == x) ? c : mine; }
        if (sum == G) break;
        __builtin_amdgcn_s_sleep(1);
        if ((++sp & 255u) == 0u) { if (xb_ld(&bar[XB_TMO])) break; if (sp > XB_SPIN_CAP) { atomicAdd(&bar[XB_TMO], 1u); break; } }
    }
    nloc = mine > 0u ? mine : 1u; nx = cnt > 0u ? cnt : 1u;
}
__device__ __forceinline__ void xcd_barrier(const XcdBarrier& b) {
    asm volatile("s_waitcnt vmcnt(0)" ::: "memory");
    __syncthreads();
    if (threadIdx.x == 0) {
        unsigned* bar = b.bar;
        __builtin_amdgcn_s_waitcnt(0);
        unsigned nloc = b.st[0], nx = b.st[1];
        if (nloc == 0u) { xcd_barrier_complete(bar, b.x, nloc, nx); b.st[0] = nloc; b.st[1] = nx; }
        const unsigned old = xb_add(&bar[XB_XSUB(b.x)], 1u);
        const unsigned gen = old / nloc;
        if (old + 1u == (gen + 1u) * nloc) {
            __builtin_amdgcn_fence(__ATOMIC_RELEASE, "agent");
            asm volatile("s_waitcnt vmcnt(0)" ::: "memory");
            const unsigned og = xb_add(&bar[XB_TOP], 1u);
            const unsigned tg = og / nx;
            if (og + 1u == (tg + 1u) * nx) xb_add(&bar[XB_TOPGEN], 1u);
            else XB_SPIN(xb_ld(&bar[XB_TOPGEN]) == tg, bar);
            __builtin_amdgcn_fence(__ATOMIC_ACQUIRE, "agent");
            xb_add(&bar[XB_XGEN(b.x)], 1u);
            asm volatile("s_waitcnt vmcnt(0)" ::: "memory");
        } else {
            XB_SPIN(xb_ld(&bar[XB_XGEN(b.x)]) == gen, bar);
            __builtin_amdgcn_fence(__ATOMIC_ACQUIRE, "agent");
            asm volatile("s_waitcnt vmcnt(0)" ::: "memory");
        }
    }
    __syncthreads();
}

namespace pg8 {
constexpr int BM = 256, BK = 64, HALF = 128, HTB = HALF * BK * 2, STAGE_BYTES = 8 * HTB;
typedef int v4i32_t __attribute__((ext_vector_type(4)));
typedef int v8i32_t __attribute__((ext_vector_type(8)));
__host__ __device__ __forceinline__ int lds_byte(int r, int c) { const int st = (r >> 4) * 2 + (c >> 5), rr = r & 15, cc = c & 31, ob = rr * 64 + cc * 2; return st * 1024 + (ob ^ (((ob >> 9) & 1) << 5)); }
__host__ __device__ __forceinline__ void stage_rc(int b, int& R, int& C) { const int st = b / 1024, sb = b % 1024, swz = sb ^ (((sb >> 9) & 1) << 5); R = (st >> 1) * 16 + swz / 64; C = (st & 1) * 32 + (swz % 64) / 2; }
__host__ __device__ __forceinline__ int perm32(int rho) { const int n = rho >> 4, i = rho & 15; return 8 * (i >> 2) + 4 * n + (i & 3); }

struct Unit { const GAS char* a; const GAS char* b; int pm, pn, e; };

template <int N> __device__ __forceinline__ void wait_vm() { asm volatile("s_waitcnt vmcnt(%0)" :: "n"(N) : "memory"); }
template <class Epi, class Sched, bool ALIGN_EPI, bool GATHER, bool FP8 = false, bool MIDSCALE = false>
__device__ __forceinline__ void gemm_phase(const int tid, LAS unsigned char* lds, const int Kb, const int ldaB, const int ldbB, const Sched& S, const Epi& E, const GAS int* __restrict__ tokof, const LAS f32x2* scl = nullptr) {
    const int wid = __builtin_amdgcn_readfirstlane(tid >> 6), lane = tid & 63, wr = wid >> 2, wc = wid & 3, fr = lane & 15, fq = lane >> 4;
    const int nt = Kb / 128;
    unsigned voffA[2], voffB[2]; int RA[2], CA2[2];
#pragma unroll
    for (int i = 0; i < 2; ++i) { int R, C; stage_rc(tid * 16 + i * 8192, R, C); const int Rb = Epi::PERM ? ((R & ~31) + perm32(R & 31)) : R;
        voffA[i] = (unsigned)(R * ldaB + C * 2); voffB[i] = (unsigned)(Rb * ldbB + C * 2); RA[i] = R; CA2[i] = C * 2; }
    const size_t kstep = (size_t)(BK * 2);
    const size_t hstepA = GATHER ? 0 : (size_t)HALF * ldaB;
    const size_t hstepB = (size_t)HALF * ldbB;
    const unsigned ldsw = (unsigned)wid * 1024u;
    const int aoff = lds_byte(wr * 64 + fr, fq * 8), boff = lds_byte(wc * 32 + fr, fq * 8);
    unsigned gcur[2][2], gnxt[2][2];
    const int scl8 = 0x7F7F7F7F;
#define PG8_SA(b, h) (((b) * 2 + (h)) * HTB)
#define PG8_SB(b, h) ((4 + (b) * 2 + (h)) * HTB)
#define PG8_STAGE(bufoff, gbase, voff) do { const unsigned long long gb_ = (unsigned long long)(gbase); const unsigned lbase_ = (unsigned)__builtin_amdgcn_readfirstlane((int)((unsigned)(uintptr_t)lds + (unsigned)(bufoff) + ldsw)); \
        _Pragma("unroll") for (int _i = 0; _i < 2; ++_i) { unsigned keep_; \
            asm volatile("s_mov_b32 %0, m0\n\ts_mov_b32 m0, %3\n\ts_nop 0\n\tglobal_load_lds_dwordx4 %1, %2\n\ts_mov_b32 m0, %0" : "=&s"(keep_) : "v"((voff)[_i]), "s"(gb_), "s"(lbase_ + (unsigned)(_i * 8192)) : "memory"); } } while (0)
#define PG8_STAGE_A(bufoff, base, h, nx) do { if constexpr (GATHER) { unsigned _v[2]; _v[0] = (nx) ? gnxt[h][0] : gcur[h][0]; _v[1] = (nx) ? gnxt[h][1] : gcur[h][1]; PG8_STAGE(bufoff, base, _v); } \
        else { PG8_STAGE(bufoff, (base) + (h) * hstepA, voffA); } } while (0)
#define PG8_LDA(dst, b, h) do { _Pragma("unroll") for (int m = 0; m < 4; ++m) _Pragma("unroll") for (int k = 0; k < 2; ++k) dst[m][k] = *(const LAS bf16x8*)(lds + PG8_SA(b, h) + aoff + m * 2048 + k * 1024); } while (0)
#define PG8_LDB(dst, b, h) do { _Pragma("unroll") for (int n = 0; n < 2; ++n) _Pragma("unroll") for (int k = 0; k < 2; ++k) dst[n][k] = *(const LAS bf16x8*)(lds + PG8_SB(b, h) + boff + n * 2048 + k * 1024); } while (0)
#define PG8_MMA(ai, bj, At, Bt) do { __builtin_amdgcn_s_setprio(1); if constexpr (FP8) { _Pragma("unroll") for (int m = 0; m < 4; ++m) _Pragma("unroll") for (int n = 0; n < 2; ++n) { \
        const v8i32_t b8_ = __builtin_shufflevector(__builtin_bit_cast(v4i32_t, Bt[n][0]), __builtin_bit_cast(v4i32_t, Bt[n][1]), 0, 1, 2, 3, 4, 5, 6, 7), a8_ = __builtin_shufflevector(__builtin_bit_cast(v4i32_t, At[m][0]), __builtin_bit_cast(v4i32_t, At[m][1]), 0, 1, 2, 3, 4, 5, 6, 7); \
        asm volatile("s_nop 1\n\tv_mfma_scale_f32_16x16x128_f8f6f4 %0, %1, %2, %0, %3, %3 op_sel_hi:[0,0,0]" : "+v"(acc[ai][bj][m][n]) : "v"(b8_), "v"(a8_), "v"(scl8)); } } \
      else { _Pragma("unroll") for (int m = 0; m < 4; ++m) _Pragma("unroll") for (int n = 0; n < 2; ++n) _Pragma("unroll") for (int k = 0; k < 2; ++k) \
        acc[ai][bj][m][n] = __builtin_amdgcn_mfma_f32_16x16x32_bf16(Bt[n][k], At[m][k], acc[ai][bj][m][n], 0, 0, 0); } __builtin_amdgcn_s_setprio(0); } while (0)
#define PG8_WAIT_V(n) asm volatile("s_waitcnt vmcnt(" #n ")" ::: "memory")
#define PG8_WAIT_L(n) asm volatile("s_waitcnt lgkmcnt(" #n ")" ::: "memory")
#define PG8_BAR __builtin_amdgcn_s_barrier()
#define PG8_SCHED __builtin_amdgcn_sched_barrier(0)
#define PG8_GLOAD(dst, u) do { if constexpr (GATHER) { _Pragma("unroll") for (int _h = 0; _h < 2; ++_h) _Pragma("unroll") for (int _i = 0; _i < 2; ++_i) \
        dst[_h][_i] = (unsigned)tokof[(u).pm * BM + _h * HALF + RA[_i]] * (unsigned)ldaB + (unsigned)CA2[_i]; } } while (0)
    Unit cur, nxt; int ui = 0;
    if (!S.next(0, cur)) return;
    PG8_GLOAD(gcur, cur);
    typename Epi::Pre pre = E.prefetch(cur, wr, fr);
    f32x4 acc[2][2][4][2];
#pragma unroll
    for (int a = 0; a < 2; ++a)
#pragma unroll
        for (int b = 0; b < 2; ++b)
#pragma unroll
            for (int m = 0; m < 4; ++m)
#pragma unroll
                for (int n = 0; n < 2; ++n) acc[a][b][m][n] = (f32x4){0.f, 0.f, 0.f, 0.f};
    bf16x8 At[4][2], B0[2][2], B1[2][2];
    const GAS char* cA = cur.a; const GAS char* cB = cur.b;
    PG8_STAGE(PG8_SB(0, 0), cB, voffB); PG8_STAGE(PG8_SB(0, 1), cB + hstepB, voffB); PG8_STAGE_A(PG8_SA(0, 0), cA, 0, false); PG8_STAGE_A(PG8_SA(0, 1), cA, 1, false);
    if (wr == 1) PG8_BAR;
    PG8_WAIT_V(2); PG8_BAR;
    PG8_STAGE(PG8_SB(1, 0), cB + kstep, voffB); PG8_STAGE_A(PG8_SA(1, 0), cA + kstep, 0, false); PG8_STAGE(PG8_SB(1, 1), cB + hstepB + kstep, voffB);
    PG8_WAIT_V(6); PG8_BAR;
    bool fresh = false;
    for (;;) {
        const bool has_next = S.next(ui + 1, nxt);
        if constexpr (GATHER) { if (has_next) { PG8_GLOAD(gnxt, nxt); } else { _Pragma("unroll") for (int _h = 0; _h < 2; ++_h) _Pragma("unroll") for (int _i = 0; _i < 2; ++_i) gnxt[_h][_i] = gcur[_h][_i]; } }
        const GAS char* nA = has_next ? nxt.a : cA; const GAS char* nB = has_next ? nxt.b : cB;
#pragma nounroll
        for (int t = 0; t < nt; t += 2) {
            const bool last = (t == nt - 2);
            const GAS char* a1 = cA + (size_t)(t + 1) * kstep;
            const GAS char* a2 = last ? nA : cA + (size_t)(t + 2) * kstep; const GAS char* b2 = last ? nB : cB + (size_t)(t + 2) * kstep;
            const GAS char* a3 = a2 + kstep; const GAS char* b3 = b2 + kstep;
            const bool fe = fresh; fresh = false;
            if constexpr (MIDSCALE) { if (t == nt / 2) {
#pragma unroll
                for (int ai = 0; ai < 2; ++ai)
#pragma unroll
                    for (int m = 0; m < 4; ++m) { const float r_ = scl[ui * 256 + ai * 128 + wr * 64 + m * 16 + fr][0];
#pragma unroll
                        for (int bj = 0; bj < 2; ++bj)
#pragma unroll
                            for (int n = 0; n < 2; ++n) acc[ai][bj][m][n] *= r_; } } }
            PG8_LDB(B0, 0, 0); PG8_LDB(B1, 0, 1); PG8_SCHED; PG8_LDA(At, 0, 0); PG8_STAGE_A(PG8_SA(1, 1), a1, 1, false);
            if (fe) wait_vm<8 + Epi::NST>(); else PG8_WAIT_V(8); PG8_WAIT_L(0); PG8_BAR; PG8_MMA(0, 0, At, B0); PG8_MMA(0, 1, At, B1); PG8_BAR; PG8_SCHED;
            PG8_LDA(At, 0, 1); PG8_STAGE(PG8_SB(0, 0), b2, voffB); PG8_STAGE(PG8_SB(0, 1), b2 + hstepB, voffB); PG8_STAGE_A(PG8_SA(0, 0), a2, 0, last);
            if (fe) wait_vm<8 + Epi::NST>(); else PG8_WAIT_V(8); PG8_WAIT_L(0); PG8_BAR; PG8_MMA(1, 0, At, B0); PG8_MMA(1, 1, At, B1); PG8_BAR; PG8_SCHED;
            PG8_LDB(B0, 1, 0); PG8_LDB(B1, 1, 1); PG8_SCHED; PG8_LDA(At, 1, 0); PG8_STAGE_A(PG8_SA(0, 1), a2, 1, last);
            PG8_WAIT_V(8); PG8_WAIT_L(0); PG8_BAR; PG8_MMA(0, 0, At, B0); PG8_MMA(0, 1, At, B1); PG8_BAR; PG8_SCHED;
            PG8_LDA(At, 1, 1); PG8_STAGE(PG8_SB(1, 0), b3, voffB); PG8_STAGE(PG8_SB(1, 1), b3 + hstepB, voffB); PG8_STAGE_A(PG8_SA(1, 0), a3, 0, last);
            PG8_WAIT_V(8); PG8_WAIT_L(0); PG8_BAR; PG8_MMA(1, 0, At, B0); PG8_MMA(1, 1, At, B1); PG8_BAR; PG8_SCHED;
        }
        if constexpr (ALIGN_EPI) { if (wr == 0) PG8_BAR; }
        if constexpr (FP8) { asm volatile("s_nop 15\n\ts_nop 15" ::: "memory"); }
        if constexpr (MIDSCALE) E(acc, cur, wr, wc, fr, fq, scl + ui * 256); else E(acc, cur, wr, wc, fr, fq, pre);
        if (!has_next) break;
        pre = E.prefetch(nxt, wr, fr);
#pragma unroll
        for (int a = 0; a < 2; ++a)
#pragma unroll
            for (int b = 0; b < 2; ++b)
#pragma unroll
                for (int m = 0; m < 4; ++m)
#pragma unroll
                    for (int n = 0; n < 2; ++n) acc[a][b][m][n] = (f32x4){0.f, 0.f, 0.f, 0.f};
        cur = nxt; cA = nA; cB = nB; ++ui; fresh = true;
        if constexpr (GATHER) { _Pragma("unroll") for (int _h = 0; _h < 2; ++_h) _Pragma("unroll") for (int _i = 0; _i < 2; ++_i) gcur[_h][_i] = gnxt[_h][_i]; }
        if constexpr (ALIGN_EPI) { if (wr == 1) PG8_BAR; }
    }
    PG8_WAIT_V(0);
    if constexpr (!ALIGN_EPI) { if (wr == 0) PG8_BAR; }
    PG8_BAR;
#undef PG8_SA
#undef PG8_SB
#undef PG8_STAGE
#undef PG8_STAGE_A
#undef PG8_LDA
#undef PG8_LDB
#undef PG8_MMA
#undef PG8_WAIT_V
#undef PG8_WAIT_L
#undef PG8_BAR
#undef PG8_SCHED
#undef PG8_GLOAD
}
}
using pg8::Unit;

struct DenseOrder {
    int nM, nN, nwg, G, c; const GAS char* A; const GAS char* B; size_t aT, bT;
    __device__ __forceinline__ bool next(int i, Unit& u) const {
        const long L = (long)i * G + c; if (L >= nwg) return false;
        int wgid = (int)L; { const int q = nwg / 8, r = nwg % 8, xcd = wgid % 8, off = wgid / 8; wgid = (xcd < r ? xcd * (q + 1) : r * (q + 1) + (xcd - r) * q) + off; }
        const int nig = 8 * nN, gid = wgid / nig, fm = gid * 8, gsz = (nM - fm) < 8 ? (nM - fm) : 8;
        u.pm = fm + ((wgid % nig) % gsz); u.pn = (wgid % nig) / gsz; u.e = 0;
        u.a = A + (size_t)u.pm * aT; u.b = B + (size_t)u.pn * bT; return true;
    }
};
struct UpOrder {
    int G, c; const GAS char* LATp; const GAS char* Wq; const GAS char* Wkv;
    __device__ __forceinline__ bool next(int i, Unit& u) const {
        const int L = i * G + c; if (L >= 128 * 7) return false;
        u.pm = L / 7; const int j = L % 7; const bool kv = j >= 3; u.pn = kv ? j - 3 : j; u.e = kv ? 1 : 0;
        u.a = LATp + (size_t)u.pm * 256 * 512 * 2 + (kv ? 512 : 0);
        u.b = (kv ? Wkv : Wq) + (size_t)u.pn * 256 * 256 * 2; return true;
    }
};
struct MoeOrder {
    int G, c; const volatile LAS int* TS; const GAS char* A; const GAS char* W; size_t aT  , wE  , wT  ;
    __device__ __forceinline__ bool next(int i, Unit& u) const {
        const int L = i * G + c; const int ntile = __builtin_amdgcn_readfirstlane(TS[32]); if (L >= ntile * 4) return false;
        const int rt = L >> 2, ct = L & 3; int e = 0;
        for (int j = 1; j < 32; ++j) e += (TS[j] <= rt) ? 1 : 0;
        e = __builtin_amdgcn_readfirstlane(e);
        u.pm = rt; u.pn = ct; u.e = e; u.a = A + (size_t)rt * aT; u.b = W + (size_t)e * wE + (size_t)ct * wT; return true;
    }
};

__device__ __forceinline__ u32x4 pack8(f32x4 v0, f32x4 v1) { u32x4 w; w.x = cvt_pk_bf16(v0[0], v0[1]); w.y = cvt_pk_bf16(v0[2], v0[3]); w.z = cvt_pk_bf16(v1[0], v1[1]); w.w = cvt_pk_bf16(v1[2], v1[3]); return w; }

struct EpiWin {
    static constexpr int NST = 16;
    static constexpr bool PERM = true;
    GAS bf16* LAT_; GAS bf16* FQKV_; GAS bf16* KPE_; GAS float* FLOG_; GAS float* SSQ_; const GAS float* COS_; const GAS float* SIN_; const GAS float* RSX_;
    struct Pre { float v[8]; };
    __device__ __forceinline__ Pre prefetch(const Unit& u, int wr, int fr) const { Pre p; const GAS float* RSX = RSX_; asm volatile("" : "+s"(RSX));
#pragma unroll
        for (int g = 0; g < 8; ++g) p.v[g] = RSX[u.pm * 256 + (g >> 2) * 128 + wr * 64 + (g & 3) * 16 + fr]; return p; }
    __device__ __forceinline__ void operator()(f32x4 (&acc)[2][2][4][2], const Unit& u, int wr, int wc, int fr, int fq, const Pre& pre) const {
        GAS bf16* LAT = LAT_; GAS bf16* FQKV = FQKV_; GAS bf16* KPE = KPE_; GAS float* FLOG = FLOG_; GAS float* SSQ = SSQ_; const GAS float* COS = COS_; const GAS float* SIN = SIN_; const GAS float* RSX = RSX_;
        asm volatile("" : "+s"(LAT), "+s"(FQKV), "+s"(KPE), "+s"(FLOG), "+s"(SSQ), "+s"(COS), "+s"(SIN), "+s"(RSX));
        {
#pragma unroll
            for (int ai = 0; ai < 2; ++ai)
#pragma unroll
                for (int m = 0; m < 4; ++m) { const float rs_ = pre.v[ai * 4 + m];
#pragma unroll
                    for (int bj = 0; bj < 2; ++bj)
#pragma unroll
                        for (int n = 0; n < 2; ++n) acc[ai][bj][m][n] *= rs_; } }
        const int row0 = u.pm * 256 + wr * 64 + fr; const int pn = u.pn;
        if (pn >= 2) {
            const int ti = pn >> 1; GAS bf16* dst = FQKV + (size_t)(ti - 1) * NTOK * 512; const int colb = (pn & 1) * 256 + wc * 32 + 8 * fq; const float sc = (ti == 1) ? C2F : 1.f;
#pragma unroll
            for (int ai = 0; ai < 2; ++ai)
#pragma unroll
                for (int m = 0; m < 4; ++m) { GAS bf16* rowp = dst + (size_t)(row0 + ai * 128 + m * 16) * 512 + colb;
#pragma unroll
                    for (int bj = 0; bj < 2; ++bj) *(GAS u32x4*)(rowp + bj * 128) = pack8(acc[ai][bj][m][0] * sc, acc[ai][bj][m][1] * sc); }
        } else {
#pragma unroll
            for (int ai = 0; ai < 2; ++ai)
#pragma unroll
                for (int m = 0; m < 4; ++m) { const int row = row0 + ai * 128 + m * 16; GAS bf16* rowp = LAT + (size_t)row * 512 + pn * 256 + wc * 32 + 8 * fq;
#pragma unroll
                    for (int bj = 0; bj < 2; ++bj) *(GAS u32x4*)(rowp + bj * 128) = pack8(acc[ai][bj][m][0], acc[ai][bj][m][1]);
                    float s = 0.f;
#pragma unroll
                    for (int n = 0; n < 2; ++n) { const f32x4 x = acc[ai][0][m][n]; s += (x[0] * x[0] + x[1] * x[1]) + (x[2] * x[2] + x[3] * x[3]); }
                    if (pn == 0) {
#pragma unroll
                        for (int n = 0; n < 2; ++n) { const f32x4 x = acc[ai][1][m][n]; s += (x[0] * x[0] + x[1] * x[1]) + (x[2] * x[2] + x[3] * x[3]); }
                    }
                    s += __shfl_xor(s, 16); s += __shfl_xor(s, 32);
                    if (fq == 0) SSQ[(size_t)row * 8 + pn * 4 + wc] = s;
                    }
            if (pn == 1 && wc == 0) {
#pragma unroll
                for (int ai = 0; ai < 2; ++ai)
#pragma unroll
                    for (int m = 0; m < 4; ++m) { const int row = row0 + ai * 128 + m * 16;
                        const f32x4 c = *(const GAS f32x4*)(COS + (size_t)row * 16 + 4 * fq), sn = *(const GAS f32x4*)(SIN + (size_t)row * 16 + 4 * fq);
                        const f32x4 x1 = acc[ai][1][m][0], x2 = acc[ai][1][m][1];
                        *(GAS u32x4*)(KPE + (size_t)row * 32 + 8 * fq) = pack8(x1 * c - x2 * sn, x1 * sn + x2 * c);
                        }
            }
            if (pn == 1 && wc == 1 && fq == 0) {
#pragma unroll
                for (int ai = 0; ai < 2; ++ai)
#pragma unroll
                    for (int m = 0; m < 4; ++m) { const int row = row0 + ai * 128 + m * 16; *(GAS f32x4*)(FLOG + (size_t)row * 8) = acc[ai][1][m][0]; *(GAS f32x4*)(FLOG + (size_t)row * 8 + 4) = acc[ai][1][m][1]; }
            }
        }
    }
};
struct EpiUp {
    static constexpr int NST = 16;
    static constexpr bool PERM = true;
    GAS bf16* QM_; GAS bf16* KVM_; const GAS float* SSQ_; const GAS float* COS_; const GAS float* SIN_;
    struct Pre { f32x4 v[8]; };
    __device__ __forceinline__ Pre prefetch(const Unit& u, int wr, int fr) const { Pre p; const GAS float* SSQ = SSQ_; asm volatile("" : "+s"(SSQ)); const int off = u.e ? 4 : 0;
#pragma unroll
        for (int g = 0; g < 8; ++g) p.v[g] = *(const GAS f32x4*)(SSQ + (size_t)(u.pm * 256 + (g >> 2) * 128 + wr * 64 + (g & 3) * 16 + fr) * 8 + off); return p; }
    __device__ __forceinline__ void operator()(const f32x4 (&acc)[2][2][4][2], const Unit& u, int wr, int wc, int fr, int fq, const Pre& pre) const {
        GAS bf16* QM = QM_; GAS bf16* KVM = KVM_; const GAS float* SSQ = SSQ_; const GAS float* COS = COS_; const GAS float* SIN = SIN_;
        asm volatile("" : "+s"(QM), "+s"(KVM), "+s"(SSQ), "+s"(COS), "+s"(SIN));
        const int row0 = u.pm * 256 + wr * 64 + fr; const int pn = u.pn; const bool kv = u.e != 0;
#pragma unroll
        for (int ai = 0; ai < 2; ++ai)
#pragma unroll
            for (int m = 0; m < 4; ++m) { const int row = row0 + ai * 128 + m * 16;
                const f32x4 sq = pre.v[ai * 4 + m];
                const float ss = (sq[0] + sq[1]) + (sq[2] + sq[3]);
                if (kv) {
                    const float rs = rsqrtf(ss * (1.f / 128.f) + EPS);
                    GAS bf16* rowp = KVM + (size_t)row * 1024 + pn * 256 + wc * 32 + 8 * fq;
#pragma unroll
                    for (int bj = 0; bj < 2; ++bj) *(GAS u32x4*)(rowp + bj * 128) = pack8(acc[ai][bj][m][0] * rs, acc[ai][bj][m][1] * rs);
                } else {
                    const float rs = rsqrtf(ss * (1.f / 256.f) + EPS) * C2M;
                    GAS bf16* rowp = QM + (size_t)row * 768 + pn * 256 + wc * 32 + 8 * fq;
                    const f32x4 c = *(const GAS f32x4*)(COS + (size_t)row * 16 + 4 * fq), sn = *(const GAS f32x4*)(SIN + (size_t)row * 16 + 4 * fq);
#pragma unroll
                    for (int bj = 0; bj < 2; ++bj) { f32x4 v0 = acc[ai][bj][m][0] * rs, v1 = acc[ai][bj][m][1] * rs;
                        const int G = 8 * pn + 4 * bj + wc;
                        if (G % 3 == 2) { const f32x4 x1 = v0, x2 = v1; v0 = x1 * c - x2 * sn; v1 = x1 * sn + x2 * c; }
                        *(GAS u32x4*)(rowp + bj * 128) = pack8(v0, v1); }
                }

            }
    }
};
template <bool RES_F32> struct EpiOut {
    static constexpr int NST = 16;
    static constexpr bool PERM = true;
    const GAS float* resf_; GAS bf16* xr_;
    struct Pre {}; __device__ __forceinline__ Pre prefetch(const Unit&, int, int) const { return Pre{}; }
    __device__ __forceinline__ void operator()(const f32x4 (&acc)[2][2][4][2], const Unit& u, int wr, int wc, int fr, int fq, const LAS f32x2* scl) const {
        const GAS float* resf = resf_; GAS bf16* xr = xr_; asm volatile("" : "+s"(resf), "+s"(xr));
        const int row0 = u.pm * 256 + wr * 64 + fr, col0 = u.pn * 256 + wc * 32 + 8 * fq;
#pragma unroll
        for (int ai = 0; ai < 2; ++ai)
#pragma unroll
            for (int m = 0; m < 4; ++m) { const size_t off = (size_t)(row0 + ai * 128 + m * 16) * DM + col0; const float sh = scl[ai * 128 + wr * 64 + m * 16 + fr][1];
#pragma unroll
                for (int bj = 0; bj < 2; ++bj) { f32x4 r0, r1;
                    if constexpr (RES_F32) { r0 = *(const GAS f32x4*)(resf + off + bj * 128); r1 = *(const GAS f32x4*)(resf + off + bj * 128 + 4); }
                    else { const u32x4 w = *(const GAS u32x4*)(xr + off + bj * 128);
                        r0 = (f32x4){__uint_as_float(w.x << 16), __uint_as_float(w.x & 0xffff0000u), __uint_as_float(w.y << 16), __uint_as_float(w.y & 0xffff0000u)};
                        r1 = (f32x4){__uint_as_float(w.z << 16), __uint_as_float(w.z & 0xffff0000u), __uint_as_float(w.w << 16), __uint_as_float(w.w & 0xffff0000u)}; }
                    *(GAS u32x4*)(xr + off + bj * 128) = pack8(r0 + acc[ai][bj][m][0] * sh, r1 + acc[ai][bj][m][1] * sh); } }
    }
};
struct EpiGU {
    static constexpr int NST = 8;
    static constexpr bool PERM = true;
    GAS unsigned char* HH_; const GAS float* RS_;
    struct Pre { float v[8]; };
    __device__ __forceinline__ Pre prefetch(const Unit& u, int wr, int fr) const { Pre p; const GAS float* RS = RS_; asm volatile("" : "+s"(RS));
#pragma unroll
        for (int g = 0; g < 8; ++g) p.v[g] = RS[u.pm * 256 + (g >> 2) * 128 + wr * 64 + (g & 3) * 16 + fr]; return p; }
    __device__ __forceinline__ void operator()(const f32x4 (&acc)[2][2][4][2], const Unit& u, int wr, int wc, int fr, int fq, const Pre& pre) const {
        GAS unsigned char* HH = HH_; const GAS float* RS = RS_; asm volatile("" : "+s"(HH), "+s"(RS));
        const int row0 = u.pm * 256 + wr * 64 + fr;
#pragma unroll
        for (int ai = 0; ai < 2; ++ai)
#pragma unroll
            for (int m = 0; m < 4; ++m) { GAS unsigned char* rowp = HH + (size_t)(row0 + ai * 128 + m * 16) * 512 + u.pn * 128 + wc * 32 + 8 * fq; const float rs = pre.v[ai * 4 + m] * WSCALE_INV;
                f32x4 h[2];
#pragma unroll
                for (int n = 0; n < 2; ++n) { const f32x4 g = acc[ai][0][m][n] * rs, up = acc[ai][1][m][n] * rs;
#pragma unroll
                    for (int j = 0; j < 4; ++j) { const float sg = __builtin_amdgcn_rcpf(1.f + __builtin_amdgcn_exp2f(-g[j] * LOG2E)); h[n][j] = g[j] * sg * up[j]; } }
                u32x2 w; w.x = pk4_fp8(h[0][0], h[0][1], h[0][2], h[0][3]); w.y = pk4_fp8(h[1][0], h[1][1], h[1][2], h[1][3]); *(GAS u32x2*)rowp = w; }
    }
};
struct EpiDown {
    static constexpr int NST = 16;
    static constexpr bool PERM = true;
    GAS unsigned char* Y_; const GAS float* GATEOF_;
    struct Pre { float v[8]; };
    __device__ __forceinline__ Pre prefetch(const Unit& u, int wr, int fr) const { Pre p; const GAS float* GT = GATEOF_; asm volatile("" : "+s"(GT));
#pragma unroll
        for (int g = 0; g < 8; ++g) p.v[g] = GT[u.pm * 256 + (g >> 2) * 128 + wr * 64 + (g & 3) * 16 + fr]; return p; }
    __device__ __forceinline__ void operator()(const f32x4 (&acc)[2][2][4][2], const Unit& u, int wr, int wc, int fr, int fq, const Pre& pre) const {
        GAS unsigned char* Y = Y_; const GAS float* GATEOF = GATEOF_; asm volatile("" : "+s"(Y), "+s"(GATEOF));
        const int row0 = u.pm * 256 + wr * 64 + fr;
#pragma unroll
        for (int ai = 0; ai < 2; ++ai)
#pragma unroll
            for (int m = 0; m < 4; ++m) { const int row = row0 + ai * 128 + m * 16; const float g = pre.v[ai * 4 + m]; GAS unsigned char* rowp = Y + (size_t)row * 1024 + u.pn * 256 + wc * 32 + 8 * fq;
#pragma unroll
                for (int bj = 0; bj < 2; ++bj) { const f32x4 v0 = acc[ai][bj][m][0] * g, v1 = acc[ai][bj][m][1] * g; u32x2 w; w.x = pk4_fp8(v0[0], v0[1], v0[2], v0[3]); w.y = pk4_fp8(v1[0], v1[1], v1[2], v1[3]); *(GAS u32x2*)(rowp + bj * 128) = w; } }
    }
};

namespace att {
constexpr int KSLOT = 12288, VSLOT = 8192;
constexpr int L_K = 0, L_V = 2 * KSLOT, L_BIAS = L_V + 2 * VSLOT, L_WS = L_BIAS + 8192, L_OST = L_WS + 8 * 64 * 4, L_END = L_OST + 8 * 4096;
__device__ __forceinline__ int crow(int r, int hi) { return (r & 3) + 8 * (r >> 2) + 4 * hi; }
typedef short v4i16_t __attribute__((ext_vector_type(4)));
__device__ __forceinline__ s16x4 vtr(const LAS char* p) { return __builtin_bit_cast(s16x4, __builtin_amdgcn_ds_read_tr16_b64_v4i16((LAS v4i16_t*)p)); }

constexpr int NSL = 5;
constexpr int R_K = 0, R_V = NSL * KSLOT, R_WS = R_V + NSL * VSLOT, R_OST = R_WS + 8 * 64 * 4, R_END = R_OST + 8 * 4096;
static_assert(R_END <= RING_BYTES, "attention LDS");
__device__ __forceinline__ void glds16(const GAS void* gsrc, unsigned lds_dst) { unsigned keep;
    asm volatile("s_mov_b32 %0, m0\n\ts_mov_b32 m0, %2\n\ts_nop 0\n\tglobal_load_lds_dwordx4 %1, off\n\ts_mov_b32 m0, %0" : "=&s"(keep) : "v"(gsrc), "s"(lds_dst) : "memory"); }
__device__ __forceinline__ void glds16s(const GAS void* sbase, unsigned voff, unsigned lds_dst) { unsigned keep;
    asm volatile("s_mov_b32 %0, m0\n\ts_mov_b32 m0, %3\n\ts_nop 0\n\tglobal_load_lds_dwordx4 %1, %2\n\ts_mov_b32 m0, %0" : "=&s"(keep) : "v"(voff), "s"((unsigned long long)sbase), "s"(lds_dst) : "memory"); }
struct Tens2 { const GAS bf16* Q; int qp; const GAS bf16* K; int kp; const GAS bf16* KX; const GAS bf16* V; int vp; GAS bf16* O; const GAS float* BIASF; const GAS float* NRM; GAS float* OSS; };
template <int MODE>
__device__ __forceinline__ int attn_unit2(const int wave_, int b, int h, int qb, const Tens2& T, LAS char* shm, const int slbase, const bool have_pro, const int qb_next, bf16x8 (&qr)[6], const int tstart) {
    constexpr int DKS = MODE ? 6 : 5, DKH = 3;
    constexpr float THR = 8.f;
    int wid = wave_; asm volatile("" : "+s"(wid));
    int lane = (int)__builtin_amdgcn_mbcnt_hi(~0u, __builtin_amdgcn_mbcnt_lo(~0u, 0u)); asm volatile("" : "+v"(lane)); const int r32 = lane & 31, hi = lane >> 5;
    const long rowbase = (long)b * SEQ; const int q0 = qb * 256, qw0 = q0 + wid * 32;
    const int NT = (q0 + 256) / 64, tlast = qw0 / 64;
    const int NTE = NT - tstart;
    const GAS bf16* Qw = T.Q + (rowbase + qw0) * T.qp + h * (MODE ? 96 : 64);
    const GAS bf16* Kh = T.K + rowbase * T.kp + h * (MODE ? 128 : 64);
    const GAS bf16* Vh = T.V + rowbase * T.vp + h * (MODE ? 128 : 64);
    LAS float* wsf = (LAS float*)(shm + R_WS) + wid * 64;
    const unsigned koff = (unsigned)(lane * T.kp + wid * 8) * 2u;
    const unsigned xoff = MODE ? (unsigned)(lane * 32 + (wid & 3) * 8) * 2u : (unsigned)(lane * 8) * 2u;
    const unsigned voff = (unsigned)((16 * (wid & 3) + (lane >> 2)) * T.vp + (wid >> 2) * 32 + (lane & 3) * 8) * 2u;
    const GAS bf16* xbase = MODE ? T.KX + rowbase * 32 : T.KX + ((long)b * 8 + h) * SEQ * 8;
    const int xstep = MODE ? 64 * 32 : 64 * 8;
    const unsigned kdst_a = (unsigned)(uintptr_t)(shm + R_K) + (unsigned)wid * 1024u, xdst_a = (unsigned)(uintptr_t)(shm + R_K) + (unsigned)(8 + (MODE ? (wid & 3) : 0)) * 1024u, vdst_a = (unsigned)(uintptr_t)(shm + R_V) + (unsigned)wid * 1024u;
#define A2_DMA(t, slot) do { \
        glds16s((const GAS void*)(Kh + (long)(t) * 64 * T.kp), koff, (unsigned)__builtin_amdgcn_readfirstlane((int)(kdst_a + (slot) * KSLOT))); \
        glds16s((const GAS void*)(xbase + (long)(t) * xstep), xoff, (unsigned)__builtin_amdgcn_readfirstlane((int)(xdst_a + (slot) * KSLOT))); \
        glds16s((const GAS void*)(Vh + (long)(t) * 64 * T.vp), voff, (unsigned)__builtin_amdgcn_readfirstlane((int)(vdst_a + (slot) * VSLOT))); } while (0)
    float mhat = 0.f, lrun = 0.f; f32x16 o[2]; o[0] = f32x16{}; o[1] = f32x16{}; f32x16 negm = f32x16{};
    const LAS char* vp0 = shm + R_V + ((lane >> 4) & 1) * 32 + (lane & 3) * 8 + (4 * hi + ((lane & 15) >> 2)) * 64;
#define A3_SLOT(k) ((slbase + (k)) % NSL)
    if (!have_pro) { A2_DMA(NT - 1, A3_SLOT(0)); A2_DMA(NT - 2, A3_SLOT(1)); A2_DMA(NT - 3, A3_SLOT(2)); }
    if (!have_pro) {
#pragma unroll
        for (int d0 = 0; d0 < (MODE ? 6 : 4); ++d0) qr[d0] = *(const GAS bf16x8*)(Qw + (long)r32 * T.qp + d0 * 16 + hi * 8); }
    if (MODE == 0) { const short one = hi ? (short)0 : (short)0x3F80; qr[DKS - 1] = (bf16x8){one, one, one, 0, 0, 0, 0, 0}; }
#pragma unroll
    for (int d0 = 0; d0 < DKS; ++d0) asm volatile("" : "+v"(qr[d0]));
#define A3_KLOADH(slot, H) do { const LAS char* kb_ = shm + R_K + (slot) * KSLOT + r32 * 16; _Pragma("unroll") for (int d0 = (H) * DKH; d0 < ((H) ? DKS : DKH); ++d0) { const int off = (MODE == 0 && d0 == 4) ? 8 * 1024 : d0 * 2048 + hi * 1024; \
        kf[2 * (d0 - (H) * DKH)] = *(const LAS bf16x8*)(kb_ + off); kf[2 * (d0 - (H) * DKH) + 1] = *(const LAS bf16x8*)(kb_ + off + 512); } } while (0)
#define A3_VLOAD(slot) do { const LAS char* vp_ = vp0 + (slot) * VSLOT; _Pragma("unroll") for (int q = 0; q < 8; ++q) { vlo[q] = vtr(vp_ + (q >> 2) * 4096 + (q & 3) * 1024); vhh[q] = vtr(vp_ + (q >> 2) * 4096 + (q & 3) * 1024 + 512); } } while (0)
#define A3_QKH(H) do { if ((H) == 0) { c0 = negm; c1 = negm; } _Pragma("unroll") for (int d0 = (H) * DKH; d0 < ((H) ? DKS : DKH); ++d0) { c0 = __builtin_amdgcn_mfma_f32_32x32x16_bf16(kf[2 * (d0 - (H) * DKH)], qr[d0], c0, 0, 0, 0); c1 = __builtin_amdgcn_mfma_f32_32x32x16_bf16(kf[2 * (d0 - (H) * DKH) + 1], qr[d0], c1, 0, 0, 0); } } while (0)
#define A3_EXP() do { float ls_ = 0.f; _Pragma("unroll") for (int r = 0; r < 16; ++r) { pp0[r] = __builtin_amdgcn_exp2f(pp0[r]); pp1[r] = __builtin_amdgcn_exp2f(pp1[r]); ls_ += pp0[r] + pp1[r]; } lrun += ls_; u32x4 w_; \
        w_.x = cvt_pk_bf16(pp0[0], pp0[1]); w_.y = cvt_pk_bf16(pp0[2], pp0[3]); w_.z = cvt_pk_bf16(pp0[4], pp0[5]); w_.w = cvt_pk_bf16(pp0[6], pp0[7]); pa[0] = __builtin_bit_cast(bf16x8, w_); \
        w_.x = cvt_pk_bf16(pp0[8], pp0[9]); w_.y = cvt_pk_bf16(pp0[10], pp0[11]); w_.z = cvt_pk_bf16(pp0[12], pp0[13]); w_.w = cvt_pk_bf16(pp0[14], pp0[15]); pa[1] = __builtin_bit_cast(bf16x8, w_); \
        w_.x = cvt_pk_bf16(pp1[0], pp1[1]); w_.y = cvt_pk_bf16(pp1[2], pp1[3]); w_.z = cvt_pk_bf16(pp1[4], pp1[5]); w_.w = cvt_pk_bf16(pp1[6], pp1[7]); pa[2] = __builtin_bit_cast(bf16x8, w_); \
        w_.x = cvt_pk_bf16(pp1[8], pp1[9]); w_.y = cvt_pk_bf16(pp1[10], pp1[11]); w_.z = cvt_pk_bf16(pp1[12], pp1[13]); w_.w = cvt_pk_bf16(pp1[14], pp1[15]); pa[3] = __builtin_bit_cast(bf16x8, w_); } while (0)
#define A3_PV() do { _Pragma("unroll") for (int d0 = 0; d0 < 2; ++d0) _Pragma("unroll") for (int k = 0; k < 4; ++k) { const s16x4 lo_ = vlo[4 * d0 + k], hh_ = vhh[4 * d0 + k]; \
        const bf16x8 vf_ = (bf16x8){lo_[0], lo_[1], lo_[2], lo_[3], hh_[0], hh_[1], hh_[2], hh_[3]}; o[d0] = __builtin_amdgcn_mfma_f32_32x32x16_bf16(pa[k], vf_, o[d0], 0, 0, 0); } } while (0)
#define A3_ROWMAX(rm) do { float a_ = fmaxf(fmaxf(c0[0], c0[1]), c1[0]), b_ = fmaxf(fmaxf(c0[2], c0[3]), c1[1]); a_ = fmaxf(fmaxf(a_, c1[2]), c1[3]); \
        _Pragma("unroll") for (int r = 4; r < 16; r += 4) { a_ = fmaxf(fmaxf(a_, c0[r]), c0[r + 1]); b_ = fmaxf(fmaxf(b_, c0[r + 2]), c0[r + 3]); a_ = fmaxf(fmaxf(a_, c1[r]), c1[r + 1]); b_ = fmaxf(fmaxf(b_, c1[r + 2]), c1[r + 3]); } \
        rm = fmaxf(a_, b_); const auto rr_ = __builtin_amdgcn_permlane32_swap(__float_as_uint(rm), __float_as_uint(rm), false, false); rm = fmaxf(__uint_as_float(rr_[0]), __uint_as_float(rr_[1])); } while (0)
    int sl = A3_SLOT(0), sl3 = A3_SLOT(3);
    f32x16 pp0 = f32x16{}, pp1 = f32x16{}; bool pend = false; int pslot = 0;
    for (int i = 0; i < NTE; ++i) {
        const int t = NT - 1 - i;
        { const int ahead = NTE - 1 - i;
          if (ahead >= 2) asm volatile("s_waitcnt vmcnt(6)" ::: "memory"); else if (ahead == 1) asm volatile("s_waitcnt vmcnt(3)" ::: "memory"); else asm volatile("s_waitcnt vmcnt(0)" ::: "memory"); }
        __builtin_amdgcn_s_barrier(); asm volatile("" ::: "memory");
        if (i + 3 < NTE) A2_DMA(t - 3, sl3);
        if (i == NTE - 1 && qb_next >= 0) { const int NTn = 4 * qb_next + 4; A2_DMA(NTn - 1, A3_SLOT(NTE)); A2_DMA(NTn - 2, A3_SLOT(NTE + 1)); A2_DMA(NTn - 3, A3_SLOT(NTE + 2)); }
        if (t <= tlast) {
            bf16x8 kf[2 * DKH]; f32x16 c0, c1; float rm;
            A3_KLOADH(sl, 0);
            if (!pend) {
                A3_QKH(0); A3_KLOADH(sl, 1); A3_QKH(1);
                if (MODE == 0) { const int qrel = qw0 + r32 - 64 * t;
#pragma unroll
                    for (int r = 0; r < 16; ++r) { const int kv = crow(r, hi); if (kv > qrel) c0[r] = -INFINITY; if (kv + 32 > qrel) c1[r] = -INFINITY; } }
                A3_ROWMAX(rm);
                mhat = rm;
#pragma unroll
                for (int r = 0; r < 16; ++r) { c0[r] -= rm; c1[r] -= rm; negm[r] = -mhat; }
                pend = true;
            } else {
                s16x4 vlo[8], vhh[8]; bf16x8 pa[4];
                A3_QKH(0); A3_KLOADH(sl, 1);
                A3_VLOAD(pslot);
                A3_QKH(1);
                A3_EXP();
#pragma unroll
                for (int g_ = 0; g_ < 2 * DKS; ++g_) { __builtin_amdgcn_sched_group_barrier(0x008, 1, 0); __builtin_amdgcn_sched_group_barrier(0x002, 7, 0); }
                A3_PV();
                A3_ROWMAX(rm);
#pragma unroll
                for (int g_ = 0; g_ < 8; ++g_) { __builtin_amdgcn_sched_group_barrier(0x008, 1, 0); __builtin_amdgcn_sched_group_barrier(0x002, 3, 0); }
                if (__any(rm > THR)) {
                    const float dl = fmaxf(rm, 0.f); mhat += dl;
#pragma unroll
                    for (int r = 0; r < 16; ++r) { c0[r] -= dl; c1[r] -= dl; negm[r] = -mhat; }
                    const float f = __builtin_amdgcn_exp2f(-dl); lrun *= f;
                    if (hi == 0) wsf[r32] = f;
                    LDS_WAIT();
#pragma unroll
                    for (int g = 0; g < 4; ++g) { const f32x4 ff = *(const LAS f32x4*)(wsf + 8 * g + 4 * hi);
#pragma unroll
                        for (int j = 0; j < 4; ++j) { o[0][4 * g + j] *= ff[j]; o[1][4 * g + j] *= ff[j]; } }
                }
            }
            pp0 = c0; pp1 = c1; pslot = sl;
        }
        sl = (sl == NSL - 1) ? 0 : sl + 1; sl3 = (sl3 == NSL - 1) ? 0 : sl3 + 1;
    }
    if (qb_next >= 0) { const GAS bf16* Qn = T.Q + (rowbase + qb_next * 256 + wid * 32) * T.qp + h * (MODE ? 96 : 64);
#pragma unroll
        for (int d0 = 0; d0 < (MODE ? 6 : 4); ++d0) qr[d0] = *(const GAS bf16x8*)(Qn + (long)r32 * T.qp + d0 * 16 + hi * 8); }
    if (pend) { s16x4 vlo[8], vhh[8]; bf16x8 pa[4]; A3_VLOAD(pslot); A3_EXP(); A3_PV(); }
#undef A3_KLOADH
#undef A3_VLOAD
#undef A3_QKH
#undef A3_EXP
#undef A3_PV
#undef A3_ROWMAX
#undef A2_DMA
    lrun += __shfl_xor(lrun, 32);
    LDS_WAIT();
    if (hi == 0) wsf[32 + r32] = lrun;
    LDS_WAIT();
    float rli[16];
#pragma unroll
    for (int g = 0; g < 4; ++g) { const f32x4 ll = *(const LAS f32x4*)(wsf + 32 + 8 * g + 4 * hi);
#pragma unroll
        for (int j = 0; j < 4; ++j) rli[4 * g + j] = __builtin_amdgcn_rcpf(ll[j]); }
    GAS bf16* Ow = T.O + (rowbase + qw0) * 1024 + (MODE ? 0 : 512) + h * 64;
    { LAS bf16* stg = (LAS bf16*)(shm + R_OST) + wid * 2048;
#pragma unroll
      for (int r = 0; r < 16; ++r) { const int orow = crow(r, hi);
#pragma unroll
          for (int d0 = 0; d0 < 2; ++d0) stg[orow * 64 + d0 * 32 + r32] = (bf16)(cvt_pk_bf16(o[d0][r] * rli[r], 0.f) & 0xffffu); }
      LDS_WAIT();
#pragma unroll
      for (int i = 0; i < 4; ++i) { const int row = i * 8 + (lane >> 3), ch = lane & 7; const u32x4 v = *(const LAS u32x4*)(stg + row * 64 + ch * 8); *(GAS u32x4*)(Ow + (long)row * 1024 + ch * 8) = v;
          float sq = 0.f;
#pragma unroll
          for (int j = 0; j < 4; ++j) { const float a0 = __uint_as_float(v[j] << 16), a1 = __uint_as_float(v[j] & 0xffff0000u); sq += a0 * a0 + a1 * a1; }
          sq += __shfl_xor(sq, 1); sq += __shfl_xor(sq, 2); sq += __shfl_xor(sq, 4);
          if (ch == 0) T.OSS[(rowbase + qw0 + row) * 16 + (MODE ? 0 : 8) + h] = sq; } }
    if (qb_next < 0) { LDS_WAIT(); __builtin_amdgcn_s_barrier(); asm volatile("" ::: "memory"); }
    return A3_SLOT(NTE);
#undef A3_SLOT
}
}

struct Args { const void* in[21]; float* out; unsigned char* ws; int ph_lo, ph_hi; };

__device__ __forceinline__ void tr_item(const GAS float* __restrict__ W, int ldw, int Ksrc, const GAS float* __restrict__ gain, GAS bf16* __restrict__ WT, int ldk, int k0, int n0, int srccol, LAS float* scr, int lane) {
#pragma unroll 8
    for (int i = 0; i < 32; ++i) { const int kk = 2 * i + (lane >> 5); const int k = k0 + kk;
        float v = 0.f; if (srccol >= 0 && k < Ksrc) { v = W[(size_t)k * ldw + srccol]; if (gain) v *= gain[k]; }
        scr[kk * 33 + (lane & 31)] = v; }
    LDS_WAIT(); asm volatile("" ::: "memory");
    const int c = lane & 7;
#pragma unroll
    for (int j = 0; j < 4; ++j) { const int n = (lane >> 3) + 8 * j; const LAS float* s = scr + (8 * c) * 33 + n;
        u32x4 o; o.x = cvt_pk_bf16(s[0 * 33], s[1 * 33]); o.y = cvt_pk_bf16(s[2 * 33], s[3 * 33]); o.z = cvt_pk_bf16(s[4 * 33], s[5 * 33]); o.w = cvt_pk_bf16(s[6 * 33], s[7 * 33]);
        *(GAS u32x4*)(WT + (size_t)(n0 + n) * ldk + k0 + 8 * c) = o; }
    LDS_WAIT(); asm volatile("" ::: "memory");
}
__device__ __forceinline__ void tr_item64(const GAS float* __restrict__ W, int ldw, const GAS float* __restrict__ gain, GAS bf16* __restrict__ WT, int ldk, int k0, int n0src, int n0dst, LAS float* scr, int lane) {
    const int rr = lane >> 4, c4 = (lane & 15) * 4;
    f32x4 v[16];
#pragma unroll
    for (int i = 0; i < 16; ++i) v[i] = *(const GAS f32x4*)(W + (size_t)(k0 + 4 * i + rr) * ldw + n0src + c4);
#pragma unroll
    for (int i = 0; i < 16; ++i) { const int k = 4 * i + rr; const float g = gain ? gain[k0 + k] : 1.f; LAS float* d = scr + k * 65 + c4;
        d[0] = v[i][0] * g; d[1] = v[i][1] * g; d[2] = v[i][2] * g; d[3] = v[i][3] * g; }
    LDS_WAIT(); asm volatile("" ::: "memory");
    const int kc = lane & 7;
#pragma unroll
    for (int j = 0; j < 8; ++j) { const int n = (lane >> 3) + 8 * j; const LAS float* sp = scr + (8 * kc) * 65 + n;
        u32x4 o; o.x = cvt_pk_bf16(sp[0 * 65], sp[1 * 65]); o.y = cvt_pk_bf16(sp[2 * 65], sp[3 * 65]); o.z = cvt_pk_bf16(sp[4 * 65], sp[5 * 65]); o.w = cvt_pk_bf16(sp[6 * 65], sp[7 * 65]);
        *(GAS u32x4*)(WT + (size_t)(n0dst + n) * ldk + k0 + 8 * kc) = o; }
    LDS_WAIT(); asm volatile("" ::: "memory");
}
__device__ __forceinline__ void tr_item64_f8(const GAS float* __restrict__ W, int ldw, const GAS float* __restrict__ gain, float scale, GAS unsigned char* __restrict__ WT8, int ldkB, int k0, int n0src, int n0dst, LAS float* scr, int lane) {
    const int rr = lane >> 4, c4 = (lane & 15) * 4;
    f32x4 v[16];
#pragma unroll
    for (int i = 0; i < 16; ++i) v[i] = *(const GAS f32x4*)(W + (size_t)(k0 + 4 * i + rr) * ldw + n0src + c4);
#pragma unroll
    for (int i = 0; i < 16; ++i) { const int k = 4 * i + rr; const float g = (gain ? gain[k0 + k] : 1.f) * scale; LAS float* d = scr + k * 65 + c4;
        d[0] = v[i][0] * g; d[1] = v[i][1] * g; d[2] = v[i][2] * g; d[3] = v[i][3] * g; }
    LDS_WAIT(); asm volatile("" ::: "memory");
    const int kc = lane & 7;
#pragma unroll
    for (int j = 0; j < 8; ++j) { const int n = (lane >> 3) + 8 * j; const LAS float* sp = scr + (8 * kc) * 65 + n;
        u32x2 o; o.x = pk4_fp8(sp[0 * 65], sp[1 * 65], sp[2 * 65], sp[3 * 65]); o.y = pk4_fp8(sp[4 * 65], sp[5 * 65], sp[6 * 65], sp[7 * 65]);
        *(GAS u32x2*)(WT8 + (size_t)(n0dst + n) * ldkB + k0 + 8 * kc) = o; }
    LDS_WAIT(); asm volatile("" ::: "memory");
}
__device__ __forceinline__ int rope_dim(int p) { const int a = p >> 3, j = p & 7; return j < 4 ? 4 * a + j : 16 + 4 * a + (j - 4); }

#define LDP(i) ((void*)((((unsigned long long)(unsigned)__builtin_amdgcn_readfirstlane((int)(ARGP[i] >> 32))) << 32) | (unsigned long long)(unsigned)__builtin_amdgcn_readfirstlane((int)(unsigned)ARGP[i])))
#define ARGIN(i) ((const void*)LDP(i))
#define P_COS ((GAS float*)(ws + WS_COS))
#define P_SIN ((GAS float*)(ws + WS_SIN))
#define P_SSQ ((GAS float*)(ws + WS_SSQ))
#define P_FLOG ((GAS float*)(ws + WS_FLOG))
#define P_E01 ((GAS int*)(ws + WS_E01))
#define P_G01 ((GAS float*)(ws + WS_G01))
#define P_SLOT ((GAS int*)(ws + WS_SLOT))
#define P_TOKOF ((GAS int*)(ws + WS_TOKOF))
#define P_GATEOF ((GAS float*)(ws + WS_GATEOF))
#define P_CNT ((GAS int*)(ws + WS_CNT))
#define P_TSTART ((GAS int*)(ws + WS_TSTART))
#define P_RSTD ((GAS float*)(ws + WS_RSTD))
#define P_RSTDOF ((GAS float*)(ws + WS_RSTDOF))
#define P_KPE ((GAS bf16*)(ws + WS_KPE))
#define P_KAUG ((GAS bf16*)(ws + WS_KAUG))
#define P_BIASF ((GAS float*)(ws + WS_BIASF))
#define P_NRM ((GAS float*)(ws + WS_NRM))
#define P_WR ((GAS bf16*)(ws + WS_WR))
#define P_XR ((GAS bf16*)(ws + WS_XR))
#define P_OSS ((GAS float*)(ws + WS_OSS))
#define P_RSTDX ((GAS float*)(ws + WS_RSTDX))
#define P_WIN ((GAS bf16*)(ws + WS_WIN))
#define P_WUQ ((GAS bf16*)(ws + WS_WUQ))
#define P_WUKV ((GAS bf16*)(ws + WS_WUKV))
#define P_WOUT ((GAS bf16*)(ws + WS_WOUT))
#define P_WGU_L(ll) ((GAS unsigned char*)(ws + WS_WGU + (size_t)((ll) & 1) * 32 * MiB))
#define P_WD_L(ll) ((GAS unsigned char*)(ws + WS_WD + (size_t)((ll) & 1) * 16 * MiB))
#define P_XN ((GAS bf16*)(ws + WS_XN))
#define P_FQKV ((GAS bf16*)(ws + WS_FQKV))
#define P_HH ((GAS bf16*)(ws + WS_FQKV))
#define P_LAT ((GAS bf16*)(ws + WS_LAT))
#define P_QM ((GAS bf16*)(ws + WS_QM))
#define P_KVM ((GAS bf16*)(ws + WS_KVM))
#define P_Y ((GAS bf16*)(ws + WS_Y))
#define IN(k) (lo <= (k) && (k) < hi_)
#if MK_ONE_LAUNCH
#define GRID_BAR() xcd_barrier(bar)
#else
#define GRID_BAR() do {} while (0)
#endif
#define SEAM(k) do { if (IN(k) && IN((k) + 1)) GRID_BAR(); } while (0)
__device__ __forceinline__ void conv_gu_item(int r, const GAS float* w_gate, const GAS float* w_up, const GAS float* ffn_norm, GAS unsigned char* WGU, LAS float* scr64, int lane) {
    const int e = r / 256, q = r % 256, kb = q / 16, nb = q % 16; const int n0 = nb * 64; const int ct = n0 >> 8, which = (n0 >> 7) & 1, jj = n0 & 127;
    const GAS float* src = (which ? w_up : w_gate) + (size_t)e * DM * DEXP;
    tr_item64_f8(src, DEXP, ffn_norm, WSCALE, WGU + (size_t)e * 1024 * 1024, DM, kb * 64, ct * 128 + jj, n0, scr64, lane);
}
__device__ __forceinline__ void conv_d_item(int r, const GAS float* w_down, GAS unsigned char* WD, LAS float* scr64, int lane) {
    const int e = r / 128, q = r % 128, kb = q / 16, nb = q % 16;
    tr_item64_f8(w_down + (size_t)e * DEXP * DM, DM, nullptr, WSCALE, WD + (size_t)e * 1024 * 512, DEXP, kb * 64, nb * 64, nb * 64, scr64, lane);
}
template <int l>
__device__ __forceinline__ void layer_body(const int lo, const int hi_, LAS unsigned char* lds0, const int wave0, const int G0, const int bx0, const XcdBarrier& bar) {
        const int P = 10 * l;
        if (IN(P)) for (int rep_ = 0; rep_ < (l == 0 ? NREP(0) : 1); ++rep_) {
            unsigned ldsb_ = (unsigned)(uintptr_t)lds0; asm volatile("" : "+s"(ldsb_)); LAS unsigned char* lds = (LAS unsigned char*)(uintptr_t)ldsb_; volatile LAS unsigned* MISC = (volatile LAS unsigned*)(lds + MISC_OFF); volatile LAS unsigned long long* ARGP = (volatile LAS unsigned long long*)(lds + MISC_OFF + 768); (void)MISC; int wave = wave0, G = G0, bx = bx0; asm volatile("" : "+s"(G), "+s"(bx), "+s"(wave)); const int lane = (int)__builtin_amdgcn_mbcnt_hi(~0u, __builtin_amdgcn_mbcnt_lo(~0u, 0u)); const int tid = wave * 64 + lane; const int vcu = (bx % 8) * (G / 8) + bx / 8; const int gw = vcu * 8 + wave, NGW = G * 8; (void)lane; (void)gw; (void)NGW; (void)vcu;
            GAS unsigned char* ws = (GAS unsigned char*)LDP(22); GAS float* out = (GAS float*)LDP(21); const GAS float* x_in = (const GAS float*)ARGIN(0); const GAS int* positions = (const GAS int*)ARGIN(1);
            if (l < NLAYER) {
                LAS float* scr = (LAS float*)(lds + wave * 16640);
                const GAS float* attn_norm = (const GAS float*)ARGIN(2) + (size_t)l * DM; const GAS float* w_in = (const GAS float*)ARGIN(3) + (size_t)l * DM * INW;
                const GAS float* q_norm = (const GAS float*)ARGIN(5) + (size_t)l * 256; const GAS float* w_uq = (const GAS float*)ARGIN(6) + (size_t)l * 256 * 768;
                const GAS float* kv_norm = (const GAS float*)ARGIN(7) + (size_t)l * 128; const GAS float* w_ukv = (const GAS float*)ARGIN(8) + (size_t)l * 128 * 1024;
                const GAS float* mla_on = (const GAS float*)ARGIN(9) + (size_t)l * 512; const GAS float* fox_on = (const GAS float*)ARGIN(10) + (size_t)l * 512; const GAS float* w_out = (const GAS float*)ARGIN(11) + (size_t)l * DM * DM;
                const GAS float* ffn_norm = (const GAS float*)ARGIN(12) + (size_t)l * DM;
                const GAS float* w_gate = (const GAS float*)ARGIN(17) + (size_t)l * NEXP * DM * DEXP; const GAS float* w_up = (const GAS float*)ARGIN(18) + (size_t)l * NEXP * DM * DEXP; const GAS float* w_down = (const GAS float*)ARGIN(19) + (size_t)l * NEXP * DEXP * DM;
                constexpr int I_IN = 16 * 64, I_UQ = 4 * 24, I_UKV = 4 * 32;
                constexpr int NITEMS = I_IN + I_UQ + I_UKV;
                for (int it = gw; it < NITEMS; it += NGW) {
                    int r = it; const int j = lane & 31;
                    if (r < I_IN) { const int kb = r / 64, nb = r % 64; const int n = nb * 32 + j; int sc;
                        if (n < 384) sc = n; else if (n < 416) sc = 384 + rope_dim(n - 384); else if (n < 424) sc = 1952 + (n - 416); else if (n < 512) sc = -1; else sc = 416 + (n - 512);
                        tr_item(w_in, INW, DM, attn_norm, P_WIN, DM, kb * 64, nb * 32, sc, scr, lane); continue; } r -= I_IN;
                    if (r < I_UQ) { const int kb = r / 24, nb = r % 24; const int n = nb * 32 + j; const int hh = n / 96, d = n % 96; const int sc = d < 64 ? n : hh * 96 + 64 + rope_dim(d - 64);
                        tr_item(w_uq, 768, 256, q_norm, P_WUQ, 256, kb * 64, nb * 32, sc, scr, lane); continue; } r -= I_UQ;
                    { const int kb = r / 32, nb = r % 32; tr_item(w_ukv, 1024, 128, kv_norm, P_WUKV, 256, kb * 64, nb * 32, nb * 32 + j, scr, lane); }
                }
                LAS float* scr64 = (LAS float*)(lds + wave * 16640);
                constexpr int J_OUT = 16 * 16, J_GU = 16 * 16 * NEXP, J_D = 8 * 16 * NEXP;
                for (int it = gw; it < J_OUT + (l == 0 ? J_GU + J_D : 0); it += NGW) {
                    int r = it;
                    if (r < J_OUT) { const int kb = r / 16, nb = r % 16; const GAS float* gn = kb < 8 ? mla_on : fox_on - 512; tr_item64(w_out, DM, gn, P_WOUT, DM, kb * 64, nb * 64, nb * 64, scr64, lane); continue; } r -= J_OUT;
                    if (r < J_GU) { conv_gu_item(r, w_gate, w_up, ffn_norm, P_WGU_L(l), scr64, lane); continue; } r -= J_GU;
                    conv_d_item(r, w_down, P_WD_L(l), scr64, lane);
                }
                { const GAS float* w_rg = (const GAS float*)ARGIN(13) + (size_t)l * DM * 4; const GAS float* w_re = (const GAS float*)ARGIN(15) + (size_t)l * DM * 32;
                  for (int idx = bx * 512 + tid; idx < 2 * 48 * 520; idx += G * 512) { const int half = idx / (48 * 520), r = idx % (48 * 520), c = r / 520, kk = r % 520; const int k = half * 512 + kk;
                      float w = 0.f; if (c < 36 && kk < 512) w = ffn_norm[k] * (c < 4 ? w_rg[k * 4 + c] : w_re[k * 32 + (c - 4)]);
                      const unsigned h16 = cvt_pk_bf16(w, 0.f) & 0xffffu; const unsigned l16 = cvt_pk_bf16(w - __uint_as_float(h16 << 16), 0.f) & 0xffffu;
                      P_WR[(size_t)(half * 2 + 0) * 48 * 520 + r] = (bf16)h16; P_WR[(size_t)(half * 2 + 1) * 48 * 520 + r] = (bf16)l16; } }
            }
            const GAS float* fin = (const GAS float*)ARGIN(20);
            for (int mb = gw * 4; mb < NTOK; mb += NGW * 4) {
                f32x4 v[4][4]; int s0[4], s1[4];
                if (l > 0) {
#pragma unroll
                    for (int r = 0; r < 4; ++r) { s0[r] = P_SLOT[2 * (mb + r)]; s1[r] = P_SLOT[2 * (mb + r) + 1]; }
                }
#pragma unroll
                for (int r = 0; r < 4; ++r) {
                    if (l == 0) { const GAS float* xr = x_in + (size_t)(mb + r) * DM;
#pragma unroll
                        for (int j = 0; j < 4; ++j) v[r][j] = *(const GAS f32x4*)(xr + 4 * lane + 256 * j); }
                    else { const GAS bf16* xr = P_XR + (size_t)(mb + r) * DM;
#pragma unroll
                        for (int j = 0; j < 4; ++j) { const u32x2 w = *(const GAS u32x2*)(xr + 4 * lane + 256 * j); v[r][j] = (f32x4){__uint_as_float(w.x << 16), __uint_as_float(w.x & 0xffff0000u), __uint_as_float(w.y << 16), __uint_as_float(w.y & 0xffff0000u)}; } } }
                if (l > 0) {
#pragma unroll
                    for (int r = 0; r < 4; ++r)
#pragma unroll
                        for (int j = 0; j < 4; ++j) { const int a = *(const GAS int*)((const GAS unsigned char*)P_Y + (size_t)s0[r] * 1024 + 4 * lane + 256 * j), c = *(const GAS int*)((const GAS unsigned char*)P_Y + (size_t)s1[r] * 1024 + 4 * lane + 256 * j);
                            const f32x2 a0 = __builtin_amdgcn_cvt_pk_f32_fp8(a, false), a1 = __builtin_amdgcn_cvt_pk_f32_fp8(a, true), c0 = __builtin_amdgcn_cvt_pk_f32_fp8(c, false), c1 = __builtin_amdgcn_cvt_pk_f32_fp8(c, true);
                            v[r][j][0] += (a0[0] + c0[0]) * WSCALE_INV; v[r][j][1] += (a0[1] + c0[1]) * WSCALE_INV; v[r][j][2] += (a1[0] + c1[0]) * WSCALE_INV; v[r][j][3] += (a1[1] + c1[1]) * WSCALE_INV; }
                }
                float ss[4];
#pragma unroll
                for (int r = 0; r < 4; ++r) { float s = 0.f;
#pragma unroll
                    for (int j = 0; j < 4; ++j) s += (v[r][j][0] * v[r][j][0] + v[r][j][1] * v[r][j][1]) + (v[r][j][2] * v[r][j][2] + v[r][j][3] * v[r][j][3]);
                    ss[r] = s; }
#pragma unroll
                for (int o = 1; o < 64; o <<= 1) {
#pragma unroll
                    for (int r = 0; r < 4; ++r) ss[r] += __shfl_xor(ss[r], o); }
#pragma unroll
                for (int r = 0; r < 4; ++r) { const int m = mb + r; const float rstd = rsqrtf(ss[r] * (1.f / DM) + EPS);
                    if (l < NLAYER) {
#pragma unroll
                        for (int j = 0; j < 4; ++j) { u32x2 w; w.x = cvt_pk_bf16(v[r][j][0], v[r][j][1]); w.y = cvt_pk_bf16(v[r][j][2], v[r][j][3]); *(GAS u32x2*)(P_XR + (size_t)m * DM + 4 * lane + 256 * j) = w; }
                        if (lane == 0) P_RSTDX[m] = rstd;
                    } else {
#pragma unroll
                        for (int j = 0; j < 4; ++j) { const f32x4 g = *(const GAS f32x4*)(fin + 4 * lane + 256 * j); *(GAS f32x4*)(out + (size_t)m * DM + 4 * lane + 256 * j) = v[r][j] * rstd * g; }
                    }
                }
            }
        }
        if constexpr (l == NLAYER) return;
        SEAM(P);
        if (IN(P + 1)) for (int rep_ = 0; rep_ < ((l == 0 || 1 != 5) ? NREP(1) : 1); ++rep_) {
            unsigned ldsb_ = (unsigned)(uintptr_t)lds0; asm volatile("" : "+s"(ldsb_)); LAS unsigned char* lds = (LAS unsigned char*)(uintptr_t)ldsb_; volatile LAS unsigned* MISC = (volatile LAS unsigned*)(lds + MISC_OFF); volatile LAS unsigned long long* ARGP = (volatile LAS unsigned long long*)(lds + MISC_OFF + 768); (void)MISC; int wave = wave0, G = G0, bx = bx0; asm volatile("" : "+s"(G), "+s"(bx), "+s"(wave)); const int lane = (int)__builtin_amdgcn_mbcnt_hi(~0u, __builtin_amdgcn_mbcnt_lo(~0u, 0u)); const int tid = wave * 64 + lane; const int vcu = (bx % 8) * (G / 8) + bx / 8; const int gw = vcu * 8 + wave, NGW = G * 8; (void)lane; (void)gw; (void)NGW; (void)vcu;
            GAS unsigned char* ws = (GAS unsigned char*)LDP(22); GAS float* out = (GAS float*)LDP(21); const GAS float* x_in = (const GAS float*)ARGIN(0); (void)out; (void)x_in; (void)ws;
            DenseOrder S{NTOK / 256, INP / 256, (NTOK / 256) * (INP / 256), G, bx, (const GAS char*)P_XR, (const GAS char*)P_WIN, (size_t)256 * DM * 2, (size_t)256 * DM * 2};
            EpiWin E{P_LAT, P_FQKV, P_KPE, P_FLOG, P_SSQ, P_COS, P_SIN, P_RSTDX};
            pg8::gemm_phase<EpiWin, DenseOrder, true, false>(tid, lds, DM * 2, DM * 2, DM * 2, S, E, nullptr);
        }
        SEAM(P + 1);
        if (IN(P + 2)) for (int rep_ = 0; rep_ < ((l == 0 || 2 != 5) ? NREP(2) : 1); ++rep_) {
            unsigned ldsb_ = (unsigned)(uintptr_t)lds0; asm volatile("" : "+s"(ldsb_)); LAS unsigned char* lds = (LAS unsigned char*)(uintptr_t)ldsb_; volatile LAS unsigned* MISC = (volatile LAS unsigned*)(lds + MISC_OFF); volatile LAS unsigned long long* ARGP = (volatile LAS unsigned long long*)(lds + MISC_OFF + 768); (void)MISC; int wave = wave0, G = G0, bx = bx0; asm volatile("" : "+s"(G), "+s"(bx), "+s"(wave)); const int lane = (int)__builtin_amdgcn_mbcnt_hi(~0u, __builtin_amdgcn_mbcnt_lo(~0u, 0u)); const int tid = wave * 64 + lane; const int vcu = (bx % 8) * (G / 8) + bx / 8; const int gw = vcu * 8 + wave, NGW = G * 8; (void)lane; (void)gw; (void)NGW; (void)vcu;
            GAS unsigned char* ws = (GAS unsigned char*)LDP(22); GAS float* out = (GAS float*)LDP(21); const GAS float* x_in = (const GAS float*)ARGIN(0); (void)out; (void)x_in; (void)ws;
            {
                const int sq = vcu >> 1, hf = vcu & 1; const int b = sq >> 3, h = sq & 7; const float bf = ((const GAS float*)ARGIN(4))[l * 8 + h];
                const GAS float* fl = P_FLOG + ((size_t)b * SEQ + hf * 1024 + 2 * tid) * 8 + h;
                float lf[2], lg[2] = {0.f, 0.f};
#pragma unroll
                for (int e = 0; e < 2; ++e) { const float f = fl[e * 8] + bf; lf[e] = fminf(f, 0.f) - log1pf(expf(-fabsf(f))); }
                if (hf) {
#pragma unroll
                    for (int e = 0; e < 2; ++e) { const float f = fl[e * 8 - 1024 * 8] + bf; lg[e] = fminf(f, 0.f) - log1pf(expf(-fabsf(f))); } }
                const double s2 = (double)lf[0] + (double)lf[1];
                double incl = s2, first = (double)lg[0] + (double)lg[1];
#pragma unroll
                for (int o = 1; o < 64; o <<= 1) { const double t = __shfl_up(incl, o); if (lane >= o) incl += t; first += __shfl_xor(first, o); }
                LAS double* wtot = (LAS double*)lds;
                if (lane == 63) wtot[wave] = incl;
                if (lane == 0) wtot[8 + wave] = first;
                __syncthreads();
                double c = incl - s2;
                for (int w = 0; w < wave; ++w) c += wtot[w];
                if (hf) { for (int w = 0; w < 8; ++w) c += wtot[8 + w]; }
                const size_t t0 = ((size_t)b * 8 + h) * SEQ + hf * 1024 + 2 * tid;
                GAS u32x4* ka = (GAS u32x4*)(P_KAUG + t0 * 8);
#pragma unroll
                for (int e = 0; e < 2; ++e) { c += (double)lf[e]; const float x = (float)(-c * 1.4426950408889634);
                    const unsigned h16 = cvt_pk_bf16(x, 0.f) & 0xffffu; const float r1 = x - __uint_as_float(h16 << 16); const unsigned m16 = cvt_pk_bf16(r1, 0.f) & 0xffffu; const float r2 = r1 - __uint_as_float(m16 << 16); const unsigned l16 = cvt_pk_bf16(r2, 0.f) & 0xffffu;
                    ka[e] = (u32x4){h16 | (m16 << 16), l16, 0u, 0u}; P_BIASF[t0 + e] = x; }
                float qn = 0.f, kn = 0.f;
                { const GAS bf16* fqp = P_FQKV + ((size_t)b * SEQ + hf * 1024 + 2 * tid) * 512 + h * 64; const GAS bf16* fkp = fqp + (size_t)NTOK * 512;
#pragma unroll
                  for (int e = 0; e < 2; ++e) { float sq_ = 0.f, sk = 0.f;
#pragma unroll
                      for (int c8 = 0; c8 < 8; ++c8) { const u32x4 a = *(const GAS u32x4*)(fqp + e * 512 + c8 * 8), k4 = *(const GAS u32x4*)(fkp + e * 512 + c8 * 8);
#pragma unroll
                          for (int j = 0; j < 4; ++j) { const float a0 = __uint_as_float(a[j] << 16), a1 = __uint_as_float(a[j] & 0xffff0000u), k0 = __uint_as_float(k4[j] << 16), k1 = __uint_as_float(k4[j] & 0xffff0000u);
                              sq_ += a0 * a0 + a1 * a1; sk += k0 * k0 + k1 * k1; } }
                      qn = fmaxf(qn, sq_); kn = fmaxf(kn, sk); } }
#pragma unroll
                for (int o = 1; o < 64; o <<= 1) { qn = fmaxf(qn, __shfl_xor(qn, o)); kn = fmaxf(kn, __shfl_xor(kn, o)); }
                LAS float* knw = (LAS float*)(lds + 256);
                if (lane == 0) { knw[wave] = kn; knw[8 + wave] = qn; }
                __syncthreads();
                if (tid < 4) P_NRM[sq * 16 + hf * 4 + tid] = sqrtf(fmaxf(knw[8 + 2 * tid], knw[8 + 2 * tid + 1]));
                if (tid == 4) { float m = knw[0]; for (int w = 1; w < 8; ++w) m = fmaxf(m, knw[w]); P_NRM[sq * 16 + 8 + hf] = sqrtf(m); }
                __syncthreads();
            }
            UpOrder S{G, vcu, (const GAS char*)P_LAT, (const GAS char*)P_WUQ, (const GAS char*)P_WUKV};
            EpiUp E{P_QM, P_KVM, P_SSQ, P_COS, P_SIN};
            pg8::gemm_phase<EpiUp, UpOrder, true, false>(tid, lds, 256 * 2, 512 * 2, 256 * 2, S, E, nullptr);
        }
        SEAM(P + 2);
        if (IN(P + 3)) for (int rep_ = 0; rep_ < ((l == 0 || 3 != 5) ? NREP(3) : 1); ++rep_) {
            unsigned ldsb_ = (unsigned)(uintptr_t)lds0; asm volatile("" : "+s"(ldsb_)); LAS unsigned char* lds = (LAS unsigned char*)(uintptr_t)ldsb_; volatile LAS unsigned* MISC = (volatile LAS unsigned*)(lds + MISC_OFF); volatile LAS unsigned long long* ARGP = (volatile LAS unsigned long long*)(lds + MISC_OFF + 768); (void)MISC; int wave = wave0, G = G0, bx = bx0; asm volatile("" : "+s"(G), "+s"(bx), "+s"(wave)); const int lane = (int)__builtin_amdgcn_mbcnt_hi(~0u, __builtin_amdgcn_mbcnt_lo(~0u, 0u)); const int tid = wave * 64 + lane; const int vcu = (bx % 8) * (G / 8) + bx / 8; const int gw = vcu * 8 + wave, NGW = G * 8; (void)lane; (void)gw; (void)NGW; (void)vcu;
            GAS unsigned char* ws = (GAS unsigned char*)LDP(22); GAS float* out = (GAS float*)LDP(21); const GAS float* x_in = (const GAS float*)ARGIN(0); (void)out; (void)x_in; (void)ws;
            GAS bf16* O = P_XN;
            const int b = vcu >> 4, hh = (vcu & 15) >> 1, sub = vcu & 1;
            const att::Tens2 TM{P_QM, 768, P_KVM, 1024, P_KPE, P_KVM + 64, 1024, O, nullptr, nullptr, P_OSS};
            const att::Tens2 TF{P_FQKV, 512, P_FQKV + (size_t)NTOK * 512, 512, P_KAUG, P_FQKV + (size_t)2 * NTOK * 512, 512, O, P_BIASF, P_NRM, P_OSS};
#define QB_OF(i) ((((i) & 1) ? 7 - (2 * sub + ((i) >> 1)) : (2 * sub + ((i) >> 1))))
            int ts0, ts1, ts2, ts3;
            { const GAS float* bs = P_BIASF + ((long)b * 8 + hh) * SEQ; const GAS float* nr = P_NRM + (b * 8 + hh) * 16; const float kmx = fmaxf(nr[8], nr[9]);
#define FOX_TS(i, dst) do { const int qb_ = QB_OF(i), NT_ = 4 * qb_ + 4; const float Z_ = nr[qb_] * kmx * 1.001f + 0.01f; const float bend_ = bs[(lane < NT_ ? lane : NT_ - 1) * 64 + 63]; \
                  const bool skip_ = (lane < NT_ - 4) && (2.f * Z_ + bend_ - bs[qb_ * 256] < -40.f); dst = __builtin_popcountll(__ballot(skip_)); } while (0)
              FOX_TS(0, ts0); FOX_TS(1, ts1); FOX_TS(2, ts2); FOX_TS(3, ts3);
#undef FOX_TS
            }
            bf16x8 qreg[6];
            { int sb = 0; for (int i = 0; i < 4; ++i) sb = att::attn_unit2<1>(wave, b, hh, QB_OF(i), TM, (LAS char*)lds, sb, i > 0, i < 3 ? QB_OF(i + 1) : -1, qreg, 0); }
            { int sb = 0; for (int i = 0; i < 4; ++i) { const int ts = i == 0 ? ts0 : i == 1 ? ts1 : i == 2 ? ts2 : ts3; sb = att::attn_unit2<0>(wave, b, hh, QB_OF(i), TF, (LAS char*)lds, sb, i > 0, i < 3 ? QB_OF(i + 1) : -1, qreg, ts); } }
#undef QB_OF
        }
        SEAM(P + 3);
        if (IN(P + 5)) for (int rep_ = 0; rep_ < ((l == 0 || 5 != 5) ? NREP(5) : 1); ++rep_) {
            unsigned ldsb_ = (unsigned)(uintptr_t)lds0; asm volatile("" : "+s"(ldsb_)); LAS unsigned char* lds = (LAS unsigned char*)(uintptr_t)ldsb_; volatile LAS unsigned* MISC = (volatile LAS unsigned*)(lds + MISC_OFF); volatile LAS unsigned long long* ARGP = (volatile LAS unsigned long long*)(lds + MISC_OFF + 768); (void)MISC; int wave = wave0, G = G0, bx = bx0; asm volatile("" : "+s"(G), "+s"(bx), "+s"(wave)); const int lane = (int)__builtin_amdgcn_mbcnt_hi(~0u, __builtin_amdgcn_mbcnt_lo(~0u, 0u)); const int tid = wave * 64 + lane; const int vcu = (bx % 8) * (G / 8) + bx / 8; const int gw = vcu * 8 + wave, NGW = G * 8; (void)lane; (void)gw; (void)NGW; (void)vcu;
            GAS unsigned char* ws = (GAS unsigned char*)LDP(22); GAS float* out = (GAS float*)LDP(21); const GAS float* x_in = (const GAS float*)ARGIN(0); (void)out; (void)x_in; (void)ws;
            DenseOrder S{NTOK / 256, DM / 256, (NTOK / 256) * (DM / 256), G, bx, (const GAS char*)P_XN, (const GAS char*)P_WOUT, (size_t)256 * DM * 2, (size_t)256 * DM * 2};
            EpiOut<false> E{x_in, P_XR};
            LAS f32x2* scl = (LAS f32x2*)(lds + pg8::STAGE_BYTES);
            { Unit u_; if (S.next(tid >> 8, u_)) { const GAS float* op = P_OSS + ((size_t)u_.pm * 256 + (tid & 255)) * 16;
                  const f32x4 a0 = *(const GAS f32x4*)op, a1 = *(const GAS f32x4*)(op + 4), c0 = *(const GAS f32x4*)(op + 8), c1 = *(const GAS f32x4*)(op + 12);
                  const float sm = ((a0[0] + a0[1]) + (a0[2] + a0[3])) + ((a1[0] + a1[1]) + (a1[2] + a1[3])), sf = ((c0[0] + c0[1]) + (c0[2] + c0[3])) + ((c1[0] + c1[1]) + (c1[2] + c1[3]));
                  const float rm_ = rsqrtf(sm * (1.f / 512.f) + EPS), rf_ = rsqrtf(sf * (1.f / 512.f) + EPS);
                  scl[tid] = (f32x2){rm_ / rf_, rf_}; } }
            __syncthreads();
            pg8::gemm_phase<EpiOut<false>, DenseOrder, true, false, false, true>(tid, lds, DM * 2, DM * 2, DM * 2, S, E, nullptr, scl);
        }
        SEAM(P + 5);
        if (IN(P + 6)) for (int rep_ = 0; rep_ < ((l == 0 || 6 != 5) ? NREP(6) : 1); ++rep_) {
            unsigned ldsb_ = (unsigned)(uintptr_t)lds0; asm volatile("" : "+s"(ldsb_)); LAS unsigned char* lds = (LAS unsigned char*)(uintptr_t)ldsb_; volatile LAS unsigned* MISC = (volatile LAS unsigned*)(lds + MISC_OFF); volatile LAS unsigned long long* ARGP = (volatile LAS unsigned long long*)(lds + MISC_OFF + 768); (void)MISC; int wave = wave0, G = G0, bx = bx0; asm volatile("" : "+s"(G), "+s"(bx), "+s"(wave)); const int lane = (int)__builtin_amdgcn_mbcnt_hi(~0u, __builtin_amdgcn_mbcnt_lo(~0u, 0u)); const int tid = wave * 64 + lane; const int vcu = (bx % 8) * (G / 8) + bx / 8; const int gw = vcu * 8 + wave, NGW = G * 8; (void)lane; (void)gw; (void)NGW; (void)vcu;
            GAS unsigned char* ws = (GAS unsigned char*)LDP(22); GAS float* out = (GAS float*)LDP(21); const GAS float* x_in = (const GAS float*)ARGIN(0); (void)out; (void)x_in; (void)ws;
            GAS bf16* H2 = P_XN;
            LAS bf16* WT = (LAS bf16*)lds;
            LAS float* LG = (LAS float*)(lds + 99840) + wave * 576;
            const GAS float* b_rg = (const GAS float*)ARGIN(14) + l * 4; const GAS float* b_re = (const GAS float*)ARGIN(16) + l * 32;
            if (tid < 32) MISC[64 + tid] = 0u;
            const int r16 = lane & 15, g4 = lane >> 4;
            const int m0 = vcu * 128 + wave * 16;
            const GAS bf16* xrow = P_XR + (size_t)(m0 + r16) * DM + 8 * g4;
            GAS unsigned char* hrow = (GAS unsigned char*)H2 + (size_t)(m0 + r16) * DM + 8 * g4;
            f32x4 acc3[3]; acc3[0] = (f32x4){0.f, 0.f, 0.f, 0.f}; acc3[1] = acc3[0]; acc3[2] = acc3[0];
            float ssq = 0.f;
            for (int half = 0; half < 2; ++half) {
                __syncthreads();
                for (int idx = tid; idx < 2 * 48 * 520 / 8; idx += 512) *(LAS u32x4*)(WT + 8 * idx) = *(const GAS u32x4*)(P_WR + (size_t)half * 2 * 48 * 520 + 8 * idx);
                __syncthreads();
                for (int s8 = 0; s8 < 16; s8 += 8) {
                    bf16x8 xv[8];
#pragma unroll
                    for (int u = 0; u < 8; ++u) xv[u] = *(const GAS bf16x8*)(xrow + half * 512 + 32 * (s8 + u));
#pragma unroll
                    for (int u = 0; u < 8; ++u) {
                        const u32x4 xw = __builtin_bit_cast(u32x4, xv[u]); float xf[8];
#pragma unroll
                        for (int j = 0; j < 4; ++j) { xf[2 * j] = __uint_as_float(xw[j] << 16); xf[2 * j + 1] = __uint_as_float(xw[j] & 0xffff0000u); }
                        u32x2 hw; hw.x = pk4_fp8(xf[0], xf[1], xf[2], xf[3]); hw.y = pk4_fp8(xf[4], xf[5], xf[6], xf[7]); *(GAS u32x2*)(hrow + half * 512 + 32 * (s8 + u)) = hw;
#pragma unroll
                        for (int j = 0; j < 8; ++j) ssq += xf[j] * xf[j];
                        const LAS bf16* wk = WT + r16 * 520 + 32 * (s8 + u) + 8 * g4;
#pragma unroll
                        for (int ct = 0; ct < 3; ++ct) { const bf16x8 bh = *(const LAS bf16x8*)(wk + ct * 16 * 520), bl = *(const LAS bf16x8*)(wk + (48 + ct * 16) * 520);
                            acc3[ct] = __builtin_amdgcn_mfma_f32_16x16x32_bf16(xv[u], bh, acc3[ct], 0, 0, 0); acc3[ct] = __builtin_amdgcn_mfma_f32_16x16x32_bf16(xv[u], bl, acc3[ct], 0, 0, 0); }
                    }
                }
            }
            ssq += __shfl_xor(ssq, 16); ssq += __shfl_xor(ssq, 32);
            const float rstd = rsqrtf(ssq * (1.f / DM) + EPS);
#pragma unroll
            for (int ct = 0; ct < 3; ++ct) { const int c = 16 * ct + r16; if (c < 36) {
#pragma unroll
                for (int rg = 0; rg < 4; ++rg) LG[(4 * g4 + rg) * 36 + c] = acc3[ct][rg]; } }
            LDS_WAIT();
            if (lane < 16) {
                const int m = m0 + lane; const LAS float* lg = LG + lane * 36;
                float gl[4];
#pragma unroll
                for (int g = 0; g < 4; ++g) gl[g] = lg[g] * rstd + b_rg[g];
                int gi = 0; float gm = gl[0];
#pragma unroll
                for (int g = 1; g < 4; ++g) if (gl[g] > gm) { gm = gl[g]; gi = g; }
                float gs = 0.f;
#pragma unroll
                for (int g = 0; g < 4; ++g) gs += __expf(gl[g] - gm);
                const float gval = 1.f / gs;
                float el[8];
#pragma unroll
                for (int j = 0; j < 8; ++j) el[j] = lg[4 + 8 * gi + j] * rstd + b_re[8 * gi + j];
                int i0 = 0; float mx0 = el[0];
#pragma unroll
                for (int j = 1; j < 8; ++j) if (el[j] > mx0) { mx0 = el[j]; i0 = j; }
                int i1 = -1; float mx1 = -INFINITY;
#pragma unroll
                for (int j = 0; j < 8; ++j) if (j != i0 && el[j] > mx1) { mx1 = el[j]; i1 = j; }
                const float e1 = __expf(mx1 - mx0); const float g0 = gval / (1.f + e1), g1 = gval * e1 / (1.f + e1);
                const int ea = gi * 8 + i0, eb = gi * 8 + i1; P_E01[2 * m] = ea; P_E01[2 * m + 1] = eb; P_G01[2 * m] = g0; P_G01[2 * m + 1] = g1; P_RSTD[m] = rstd;
                __hip_atomic_fetch_add((LAS unsigned*)(lds + MISC_OFF) + 64 + ea, 1u, __ATOMIC_RELAXED, __HIP_MEMORY_SCOPE_WORKGROUP); __hip_atomic_fetch_add((LAS unsigned*)(lds + MISC_OFF) + 64 + eb, 1u, __ATOMIC_RELAXED, __HIP_MEMORY_SCOPE_WORKGROUP);
            }
            __syncthreads();
            if (tid < 32) P_CNT[vcu * 32 + tid] = (int)MISC[64 + tid];
        }
        SEAM(P + 6);
        if (IN(P + 7)) for (int rep_ = 0; rep_ < ((l == 0 || 7 != 5) ? NREP(7) : 1); ++rep_) {
            unsigned ldsb_ = (unsigned)(uintptr_t)lds0; asm volatile("" : "+s"(ldsb_)); LAS unsigned char* lds = (LAS unsigned char*)(uintptr_t)ldsb_; volatile LAS unsigned* MISC = (volatile LAS unsigned*)(lds + MISC_OFF); volatile LAS unsigned long long* ARGP = (volatile LAS unsigned long long*)(lds + MISC_OFF + 768); (void)MISC; int wave = wave0, G = G0, bx = bx0; asm volatile("" : "+s"(G), "+s"(bx), "+s"(wave)); const int lane = (int)__builtin_amdgcn_mbcnt_hi(~0u, __builtin_amdgcn_mbcnt_lo(~0u, 0u)); const int tid = wave * 64 + lane; const int vcu = (bx % 8) * (G / 8) + bx / 8; const int gw = vcu * 8 + wave, NGW = G * 8; (void)lane; (void)gw; (void)NGW; (void)vcu;
            GAS unsigned char* ws = (GAS unsigned char*)LDP(22); GAS float* out = (GAS float*)LDP(21); const GAS float* x_in = (const GAS float*)ARGIN(0); (void)out; (void)x_in; (void)ws;
            LAS int* cnt_all = (LAS int*)lds;
            LAS int* pre_e = (LAS int*)(lds + 32768);
            LAS int* tot_e = pre_e + 32;
            LAS int* pst = pre_e + 64;
            LAS int* eL = pre_e + 128;
            for (int i = tid; i < 256 * 32; i += 512) cnt_all[i] = P_CNT[i];
            if (tid < 256) eL[tid] = P_E01[vcu * 256 + tid];
            __syncthreads();
            { LAS int* part = pre_e + 512;
              const int e = tid & 31, p = tid >> 5; int pre = 0, tot = 0;
#pragma unroll
              for (int j = 0; j < 16; ++j) { const int w = p * 16 + j; const int c = cnt_all[w * 32 + e]; pre += (w < vcu) ? c : 0; tot += c; }
              part[(p * 2) * 32 + e] = pre; part[(p * 2 + 1) * 32 + e] = tot; }
            __syncthreads();
            if (tid < 32) { LAS int* part = pre_e + 512; int pre = 0, tot = 0;
#pragma unroll
                for (int p = 0; p < 16; ++p) { pre += part[(p * 2) * 32 + tid]; tot += part[(p * 2 + 1) * 32 + tid]; } pre_e[tid] = pre; tot_e[tid] = tot; }
            __syncthreads();
            if (tid == 0) { int acc = 0; for (int e = 0; e < 32; ++e) { pst[e] = acc; acc += (tot_e[e] + 255) / 256 * 256; } pst[32] = acc; }
            __syncthreads();
            if (vcu == 0 && tid <= 32) P_TSTART[tid] = pst[tid] / 256;
            { LAS int* hist = pre_e + 2048;
              if (tid < 128) hist[tid] = 0;
              __syncthreads();
              int e = 0, rin = 0;
              if (tid < 256) { e = eL[tid]; unsigned long long mym = 0ull;
                  for (int x = 0; x < 32; ++x) { const unsigned long long bm = __ballot(e == x); if (e == x) mym = bm; }
                  rin = __builtin_popcountll(mym & ((1ull << lane) - 1ull));
                  if (rin == 0) hist[wave * 32 + e] = __builtin_popcountll(mym); }
              __syncthreads();
              if (tid < 256) { int r = rin; for (int w = 0; w < wave; ++w) r += hist[w * 32 + e];
                  const int slot = pst[e] + pre_e[e] + r; const int tok = vcu * 128 + (tid >> 1);
                  P_SLOT[vcu * 256 + tid] = slot; P_TOKOF[slot] = tok; P_GATEOF[slot] = P_G01[vcu * 256 + tid]; P_RSTDOF[slot] = P_RSTD[tok]; } }
            if (vcu < 32) { const int e = vcu; for (int s = pst[e] + tot_e[e] + tid; s < pst[e + 1]; s += 512) { P_TOKOF[s] = 0; P_GATEOF[s] = 0.f; P_RSTDOF[s] = 0.f; } }
            __syncthreads();
        }
        SEAM(P + 7);
        if (IN(P + 8)) for (int rep_ = 0; rep_ < ((l == 0 || 8 != 5) ? NREP(8) : 1); ++rep_) {
            unsigned ldsb_ = (unsigned)(uintptr_t)lds0; asm volatile("" : "+s"(ldsb_)); LAS unsigned char* lds = (LAS unsigned char*)(uintptr_t)ldsb_; volatile LAS unsigned* MISC = (volatile LAS unsigned*)(lds + MISC_OFF); volatile LAS unsigned long long* ARGP = (volatile LAS unsigned long long*)(lds + MISC_OFF + 768); (void)MISC; int wave = wave0, G = G0, bx = bx0; asm volatile("" : "+s"(G), "+s"(bx), "+s"(wave)); const int lane = (int)__builtin_amdgcn_mbcnt_hi(~0u, __builtin_amdgcn_mbcnt_lo(~0u, 0u)); const int tid = wave * 64 + lane; const int vcu = (bx % 8) * (G / 8) + bx / 8; const int gw = vcu * 8 + wave, NGW = G * 8; (void)lane; (void)gw; (void)NGW; (void)vcu;
            GAS unsigned char* ws = (GAS unsigned char*)LDP(22); GAS float* out = (GAS float*)LDP(21); const GAS float* x_in = (const GAS float*)ARGIN(0); (void)out; (void)x_in; (void)ws;
            volatile LAS int* TS = (volatile LAS int*)(MISC + 128);
            if (tid <= 32) TS[tid] = P_TSTART[tid];
            __syncthreads();
            MoeOrder S{G, vcu, TS, (const GAS char*)P_XN, (const GAS char*)P_WGU_L(l), 0, (size_t)1024 * 1024, (size_t)256 * 1024};
            EpiGU E{(GAS unsigned char*)P_HH, P_RSTDOF};
            pg8::gemm_phase<EpiGU, MoeOrder, true, true, true>(tid, lds, DM, DM, DM, S, E, P_TOKOF);
            if constexpr (l + 1 < NLAYER) {
                const int U = (int)TS[32] * 4, rem = U & 255; const int nidle = rem ? 256 - rem : 256, rk = rem ? vcu - rem : vcu;
                if (rk >= 0) { LAS float* scr64 = (LAS float*)(lds + wave * 16640);
                    const GAS float* w_gate = (const GAS float*)ARGIN(17) + (size_t)(l + 1) * NEXP * DM * DEXP; const GAS float* w_up = (const GAS float*)ARGIN(18) + (size_t)(l + 1) * NEXP * DM * DEXP; const GAS float* ffn1 = (const GAS float*)ARGIN(12) + (size_t)(l + 1) * DM;
                    for (int it = rk * 8 + wave; it < 16 * 16 * NEXP; it += nidle * 8) conv_gu_item(it, w_gate, w_up, ffn1, P_WGU_L(l + 1), scr64, lane); }
            }
        }
        SEAM(P + 8);
        if (IN(P + 9)) for (int rep_ = 0; rep_ < ((l == 0 || 9 != 5) ? NREP(9) : 1); ++rep_) {
            unsigned ldsb_ = (unsigned)(uintptr_t)lds0; asm volatile("" : "+s"(ldsb_)); LAS unsigned char* lds = (LAS unsigned char*)(uintptr_t)ldsb_; volatile LAS unsigned* MISC = (volatile LAS unsigned*)(lds + MISC_OFF); volatile LAS unsigned long long* ARGP = (volatile LAS unsigned long long*)(lds + MISC_OFF + 768); (void)MISC; int wave = wave0, G = G0, bx = bx0; asm volatile("" : "+s"(G), "+s"(bx), "+s"(wave)); const int lane = (int)__builtin_amdgcn_mbcnt_hi(~0u, __builtin_amdgcn_mbcnt_lo(~0u, 0u)); const int tid = wave * 64 + lane; const int vcu = (bx % 8) * (G / 8) + bx / 8; const int gw = vcu * 8 + wave, NGW = G * 8; (void)lane; (void)gw; (void)NGW; (void)vcu;
            GAS unsigned char* ws = (GAS unsigned char*)LDP(22); GAS float* out = (GAS float*)LDP(21); const GAS float* x_in = (const GAS float*)ARGIN(0); (void)out; (void)x_in; (void)ws;
            volatile LAS int* TS = (volatile LAS int*)(MISC + 128);
            if (tid <= 32) TS[tid] = P_TSTART[tid];
            __syncthreads();
            MoeOrder S{G, vcu, TS, (const GAS char*)P_HH, (const GAS char*)P_WD_L(l), (size_t)256 * 512, (size_t)1024 * 512, (size_t)256 * 512};
            EpiDown E{(GAS unsigned char*)P_Y, P_GATEOF};
            pg8::gemm_phase<EpiDown, MoeOrder, true, false, true>(tid, lds, DEXP, DEXP, DEXP, S, E, nullptr);
            if constexpr (l + 1 < NLAYER) {
                const int U = (int)TS[32] * 4, rem = U & 255; const int nidle = rem ? 256 - rem : 256, rk = rem ? vcu - rem : vcu;
                if (rk >= 0) { LAS float* scr64 = (LAS float*)(lds + wave * 16640);
                    const GAS float* w_down = (const GAS float*)ARGIN(19) + (size_t)(l + 1) * NEXP * DEXP * DM;
                    for (int it = rk * 8 + wave; it < 8 * 16 * NEXP; it += nidle * 8) conv_d_item(it, w_down, P_WD_L(l + 1), scr64, lane); }
            }
        }
        SEAM(P + 9);
}

__global__ void __launch_bounds__(512, 2) fwd(Args args) {
    extern __shared__ __attribute__((aligned(16))) unsigned char lds_raw[];
    LAS unsigned char* lds0 = (LAS unsigned char*)lds_raw;
    const int tid0 = threadIdx.x; const int wave0 = __builtin_amdgcn_readfirstlane(tid0 >> 6);
    const int G0 = gridDim.x; const int bx0 = blockIdx.x;
    { volatile LAS unsigned* MISC = (volatile LAS unsigned*)(lds0 + MISC_OFF); const int tid = tid0;
    for (int u = tid; u < 256; u += 512) MISC[u] = 0u;
    __syncthreads();
    volatile LAS unsigned long long* ARGP = (volatile LAS unsigned long long*)(lds0 + MISC_OFF + 768);
    if (tid < 21) ARGP[tid] = (unsigned long long)args.in[tid];
    if (tid == 21) ARGP[21] = (unsigned long long)args.out;
    if (tid == 22) ARGP[22] = (unsigned long long)args.ws;
    __syncthreads(); }
#if MK_ONE_LAUNCH
    XcdBarrier bar = xcd_barrier_post((unsigned*)(args.ws + WS_CTL) + CW_BAR, (volatile LAS unsigned*)(lds0 + MISC_OFF) + 8);
#else
    XcdBarrier bar; bar.bar = nullptr; bar.x = 0; bar.st = nullptr;
#endif
    const int lo = args.ph_lo, hi_ = args.ph_hi;
    if (IN(0)) {
        const GAS int* positions = (const GAS int*)args.in[1]; GAS float* COSp = (GAS float*)(args.ws + WS_COS); GAS float* SINp = (GAS float*)(args.ws + WS_SIN);
        for (int i = bx0 * 512 + tid0; i < NTOK * 16; i += G0 * 512) { const int tk = i >> 4, fi = i & 15;
            const double invrev = exp2(-(double)fi * (13.287712379549449 / 16.0)) * 0.15915494309189535; const double rev = (double)positions[tk] * invrev; const float fr = (float)(rev - rint(rev));
            COSp[i] = __builtin_amdgcn_cosf(fr); SINp[i] = __builtin_amdgcn_sinf(fr); }
    }
    layer_body<0>(lo, hi_, lds0, wave0, G0, bx0, bar);
    layer_body<1>(lo, hi_, lds0, wave0, G0, bx0, bar);
    layer_body<2>(lo, hi_, lds0, wave0, G0, bx0, bar);
}

extern "C" void kernel_launch(void* const* d_in, const int* in_sizes, int n_in, void* d_out, int out_size, void* d_ws, size_t ws_size, hipStream_t stream) {
    static int grid = 0;
    if (grid == 0) {
        if (n_in != 21 || out_size != NTOK * DM || ws_size < WS_END) { fprintf(stderr, "kernel_launch: unexpected shapes (n_in %d out %d ws %zu)\n", n_in, out_size, ws_size); grid = -1; return; }
        int dev = 0, cus = 0;
        if (hipGetDevice(&dev) != hipSuccess || hipDeviceGetAttribute(&cus, hipDeviceAttributeMultiprocessorCount, dev) != hipSuccess) { grid = -1; return; }
        if (hipFuncSetAttribute((const void*)fwd, hipFuncAttributeMaxDynamicSharedMemorySize, LDS_BYTES) != hipSuccess) { fprintf(stderr, "kernel_launch: hipFuncSetAttribute failed\n"); grid = -1; return; }
        int per_cu = 0;
        if (hipOccupancyMaxActiveBlocksPerMultiprocessor(&per_cu, (const void*)fwd, 512, LDS_BYTES) != hipSuccess || per_cu < 1) fprintf(stderr, "kernel_launch: occupancy query says %d\n", per_cu);
        (void)hipGetLastError();
        grid = cus;
        if (grid != 256) { fprintf(stderr, "kernel_launch: built for 256 CUs, got %d\n", grid); grid = -1; return; }
    }
    if (grid < 0) return;
    if (hipMemsetAsync((char*)d_ws + WS_CTL, 0, CTL_ZERO_BYTES, stream) != hipSuccess) return;
    Args a{};
    for (int i = 0; i < 21; ++i) a.in[i] = d_in[i];
    a.out = (float*)d_out; a.ws = (unsigned char*)d_ws;
#if MK_ONE_LAUNCH
    a.ph_lo = 0; a.ph_hi = 21;
    hipLaunchKernelGGL(fwd, dim3(grid), dim3(512), LDS_BYTES, stream, a);
#else
    for (int p = 0; p <= 20; ++p) { a.ph_lo = p; a.ph_hi = p + 1; hipLaunchKernelGGL(fwd, dim3(grid), dim3(512), LDS_BYTES, stream, a); }
#endif
}
```

```cpp
#include <hip/hip_runtime.h>
#include <cstdio>
#include <cstdint>

#ifndef PROBE_PHASE
#define PROBE_PHASE -1
#endif
#define NREP(k) ((PROBE_PHASE) == (k) ? 2 : 1)
#ifndef MK_ONE_LAUNCH
#define MK_ONE_LAUNCH 1
#endif

#define LAS __attribute__((address_space(3)))
#define GAS __attribute__((address_space(1)))
typedef unsigned short bf16;
typedef short bf16x8 __attribute__((ext_vector_type(8)));
typedef short s16x4 __attribute__((ext_vector_type(4)));
typedef float f32x4 __attribute__((ext_vector_type(4)));
typedef float f32x2 __attribute__((ext_vector_type(2)));
typedef float f32x16 __attribute__((ext_vector_type(16)));
typedef unsigned u32x4 __attribute__((ext_vector_type(4)));
typedef unsigned u32x2 __attribute__((ext_vector_type(2)));

constexpr int NB = 16, SEQ = 2048, DM = 1024, NTOK = NB * SEQ, NLAYER = 2;
constexpr int INW = 1960, INP = 2048;
constexpr int NEXP = 32, DEXP = 512;
constexpr int MAXSLOT = 73728;
constexpr float EPS = 1e-6f;
constexpr float WSCALE = 64.f, WSCALE_INV = 1.f / 64.f;
constexpr float LOG2E = 1.4426950408889634f;
constexpr float C2F = 0.125f * LOG2E;
constexpr float C2M = 0.10206207261596575f * LOG2E;

constexpr size_t MiB = 1u << 20, KiB = 1u << 10;
constexpr size_t WS_CTL = 0, CTL_ZERO_BYTES = 64 * KiB;
constexpr size_t WS_COS = 1 * MiB, WS_SIN = 3 * MiB;
constexpr size_t WS_SSQ = 5 * MiB;
constexpr size_t WS_FLOG = 6 * MiB;
constexpr size_t WS_E01 = 8 * MiB;
constexpr size_t WS_G01 = 8 * MiB + 256 * KiB;
constexpr size_t WS_SLOT = 8 * MiB + 512 * KiB;
constexpr size_t WS_TOKOF = 8 * MiB + 768 * KiB;
constexpr size_t WS_GATEOF = 9 * MiB + 256 * KiB;
constexpr size_t WS_CNT = 9 * MiB + 768 * KiB;
constexpr size_t WS_TSTART = 9 * MiB + 800 * KiB;
constexpr size_t WS_RSTD = 9 * MiB + 832 * KiB;
constexpr size_t WS_RSTDOF = 7 * MiB;
constexpr size_t WS_KPE = 10 * MiB;
constexpr size_t WS_KAUG = 10 * MiB + 2 * MiB;
constexpr size_t WS_WIN = 16 * MiB;
constexpr size_t WS_WUQ = 20 * MiB;
constexpr size_t WS_WUKV = 20 * MiB + 512 * KiB;
constexpr size_t WS_WOUT = 21 * MiB;
constexpr size_t WS_WGU = 24 * MiB;
constexpr size_t WS_WD = 88 * MiB;
constexpr size_t WS_XN = 120 * MiB;
constexpr size_t WS_FQKV = 184 * MiB;
constexpr size_t WS_LAT = 280 * MiB;
constexpr size_t WS_QM = 312 * MiB;
constexpr size_t WS_KVM = 360 * MiB;
constexpr size_t WS_Y = 280 * MiB;
constexpr size_t WS_BIASF = 424 * MiB;
constexpr size_t WS_NRM = 425 * MiB;
constexpr size_t WS_WR = 426 * MiB;
constexpr size_t WS_XR = 427 * MiB;
constexpr size_t WS_OSS = 491 * MiB;
constexpr size_t WS_RSTDX = 493 * MiB;
constexpr size_t WS_END = 494 * MiB;
static_assert(WS_Y + (size_t)MAXSLOT * 1024 * 2 <= WS_END, "Y fits");
static_assert(WS_FQKV + (size_t)MAXSLOT * 512 * 2 <= WS_LAT, "HH fits");

constexpr int CW_BAR = 1024;

constexpr int RING_BYTES = 147456;
constexpr int MISC_OFF = RING_BYTES;
constexpr int LDS_BYTES = RING_BYTES + 1024;

typedef __bf16 bf16x2_t __attribute__((ext_vector_type(2)));
__device__ __forceinline__ unsigned cvt_pk_bf16(float lo, float hi) { const f32x2 v = {lo, hi}; const bf16x2_t b = __builtin_convertvector(v, bf16x2_t); return __builtin_bit_cast(unsigned, b); }
__device__ __forceinline__ float bf2f(unsigned short b) { return __uint_as_float((unsigned)b << 16); }
__device__ __forceinline__ float wave_sum(float v) {
#pragma unroll
    for (int o = 1; o < 64; o <<= 1) v += __shfl_xor(v, o);
    return v;
}
__device__ __forceinline__ unsigned pk4_fp8(float a, float b, float c, float d) { int w = 0; w = __builtin_amdgcn_cvt_pk_fp8_f32(a, b, w, false); w = __builtin_amdgcn_cvt_pk_fp8_f32(c, d, w, true); return (unsigned)w; }
#define LDS_WAIT() asm volatile("s_waitcnt lgkmcnt(0)" ::: "memory")

#define XB_TMO      128
#define XB_XCNT(j)  (256  + 64 * (j))
#define XB_XSUB(j)  (1280 + 64 * (j))
#define XB_XGEN(j)  (2304 + 64 * (j))
#define XB_TOP      3328
#define XB_TOPGEN   3392
#define XCD_BAR_WORDS 3456
#define XB_SPIN_CAP (1u << 18)
__device__ __forceinline__ unsigned xb_ld(unsigned* p)              { return __hip_atomic_load(p, __ATOMIC_RELAXED, __HIP_MEMORY_SCOPE_AGENT); }
__device__ __forceinline__ unsigned xb_add(unsigned* p, unsigned v) { return __hip_atomic_fetch_add(p, v, __ATOMIC_RELAXED, __HIP_MEMORY_SCOPE_AGENT); }
__device__ __forceinline__ unsigned xb_xcc_id() { return (unsigned)__builtin_amdgcn_s_getreg((3 << 11) | 20) & 0xFu; }
#define XB_SPIN(cond, bar) do { unsigned _sp = 0; while (cond) { __builtin_amdgcn_s_sleep(1); \
    if ((++_sp & 255u) == 0u) { if (xb_ld(&(bar)[XB_TMO])) break; if (_sp > XB_SPIN_CAP) { atomicAdd(&(bar)[XB_TMO], 1u); break; } } } } while (0)
struct XcdBarrier { unsigned* bar; unsigned x; volatile LAS unsigned* st; };
__device__ __forceinline__ XcdBarrier xcd_barrier_post(unsigned* bar, volatile LAS unsigned* st) {
    XcdBarrier b; b.bar = bar; b.x = xb_xcc_id(); b.st = st;
    if (threadIdx.x == 0) (void)xb_add(&bar[XB_XCNT(b.x)], 1u);
    return b;
}
__device__ __forceinline__ void xcd_barrier_complete(unsigned* bar, unsigned x, unsigned& nloc, unsigned& nx) {
    const unsigned G = gridDim.x * gridDim.y * gridDim.z;
    unsigned sum, cnt, mine, sp = 0u;
    for (;;) {
        sum = 0u; cnt = 0u; mine = 0u;
#pragma unroll
        for (unsigned j = 0; j < 16; ++j) { const unsigned c = xb_ld(&bar[XB_XCNT(j)]); sum += c; cnt += (c > 0u) ? 1u : 0u; mine = (j == x) ? c : mine; }
        if (sum == G) break;
        __builtin_amdgcn_s_sleep(1);
        if ((++sp & 255u) == 0u) { if (xb_ld(&bar[XB_TMO])) break; if (sp > XB_SPIN_CAP) { atomicAdd(&bar[XB_TMO], 1u); break; } }
    }
    nloc = mine > 0u ? mine : 1u; nx = cnt > 0u ? cnt : 1u;
}
__device__ __forceinline__ void xcd_barrier(const XcdBarrier& b) {
    asm volatile("s_waitcnt vmcnt(0)" ::: "memory");
    __syncthreads();
    if (threadIdx.x == 0) {
        unsigned* bar = b.bar;
        __builtin_amdgcn_s_waitcnt(0);
        unsigned nloc = b.st[0], nx = b.st[1];
        if (nloc == 0u) { xcd_barrier_complete(bar, b.x, nloc, nx); b.st[0] = nloc; b.st[1] = nx; }
        const unsigned old = xb_add(&bar[XB_XSUB(b.x)], 1u);
        const unsigned gen = old / nloc;
        if (old + 1u == (gen + 1u) * nloc) {
            __builtin_amdgcn_fence(__ATOMIC_RELEASE, "agent");
            asm volatile("s_waitcnt vmcnt(0)" ::: "memory");
            const unsigned og = xb_add(&bar[XB_TOP], 1u);
            const unsigned tg = og / nx;
            if (og + 1u == (tg + 1u) * nx) xb_add(&bar[XB_TOPGEN], 1u);
            else XB_SPIN(xb_ld(&bar[XB_TOPGEN]) == tg, bar);
            __builtin_amdgcn_fence(__ATOMIC_ACQUIRE, "agent");
            xb_add(&bar[XB_XGEN(b.x)], 1u);
            asm volatile("s_waitcnt vmcnt(0)" ::: "memory");
        } else {
            XB_SPIN(xb_ld(&bar[XB_XGEN(b.x)]) == gen, bar);
            __builtin_amdgcn_fence(__ATOMIC_ACQUIRE, "agent");
            asm volatile("s_waitcnt vmcnt(0)" ::: "memory");
        }
    }
    __syncthreads();
}

namespace pg8 {
constexpr int BM = 256, BK = 64, HALF = 128, HTB = HALF * BK * 2, STAGE_BYTES = 8 * HTB;
typedef int v4i32_t __attribute__((ext_vector_type(4)));
typedef int v8i32_t __attribute__((ext_vector_type(8)));
__host__ __device__ __forceinline__ int lds_byte(int r, int c) { const int st = (r >> 4) * 2 + (c >> 5), rr = r & 15, cc = c & 31, ob = rr * 64 + cc * 2; return st * 1024 + (ob ^ (((ob >> 9) & 1) << 5)); }
__host__ __device__ __forceinline__ void stage_rc(int b, int& R, int& C) { const int st = b / 1024, sb = b % 1024, swz = sb ^ (((sb >> 9) & 1) << 5); R = (st >> 1) * 16 + swz / 64; C = (st & 1) * 32 + (swz % 64) / 2; }
__host__ __device__ __forceinline__ int perm32(int rho) { const int n = rho >> 4, i = rho & 15; return 8 * (i >> 2) + 4 * n + (i & 3); }

struct Unit { const GAS char* a; const GAS char* b; int pm, pn, e; };

template <int N> __device__ __forceinline__ void wait_vm() { asm volatile("s_waitcnt vmcnt(%0)" :: "n"(N) : "memory"); }
template <class Epi, class Sched, bool ALIGN_EPI, bool GATHER, bool FP8 = false, bool MIDSCALE = false>
__device__ __forceinline__ void gemm_phase(const int tid, LAS unsigned char* lds, const int Kb, const int ldaB, const int ldbB, const Sched& S, const Epi& E, const GAS int* __restrict__ tokof, const LAS f32x2* scl = nullptr) {
    const int wid = __builtin_amdgcn_readfirstlane(tid >> 6), lane = tid & 63, wr = wid >> 2, wc = wid & 3, fr = lane & 15, fq = lane >> 4;
    const int nt = Kb / 128;
    unsigned voffA[2], voffB[2]; int RA[2], CA2[2];
#pragma unroll
    for (int i = 0; i < 2; ++i) { int R, C; stage_rc(tid * 16 + i * 8192, R, C); const int Rb = Epi::PERM ? ((R & ~31) + perm32(R & 31)) : R;
        voffA[i] = (unsigned)(R * ldaB + C * 2); voffB[i] = (unsigned)(Rb * ldbB + C * 2); RA[i] = R; CA2[i] = C * 2; }
    const size_t kstep = (size_t)(BK * 2);
    const size_t hstepA = GATHER ? 0 : (size_t)HALF * ldaB;
    const size_t hstepB = (size_t)HALF * ldbB;
    const unsigned ldsw = (unsigned)wid * 1024u;
    const int aoff = lds_byte(wr * 64 + fr, fq * 8), boff = lds_byte(wc * 32 + fr, fq * 8);
    unsigned gcur[2][2], gnxt[2][2];
    const int scl8 = 0x7F7F7F7F;
#define PG8_SA(b, h) (((b) * 2 + (h)) * HTB)
#define PG8_SB(b, h) ((4 + (b) * 2 + (h)) * HTB)
#define PG8_STAGE(bufoff, gbase, voff) do { const unsigned long long gb_ = (unsigned long long)(gbase); const unsigned lbase_ = (unsigned)__builtin_amdgcn_readfirstlane((int)((unsigned)(uintptr_t)lds + (unsigned)(bufoff) + ldsw)); \
        _Pragma("unroll") for (int _i = 0; _i < 2; ++_i) { unsigned keep_; \
            asm volatile("s_mov_b32 %0, m0\n\ts_mov_b32 m0, %3\n\ts_nop 0\n\tglobal_load_lds_dwordx4 %1, %2\n\ts_mov_b32 m0, %0" : "=&s"(keep_) : "v"((voff)[_i]), "s"(gb_), "s"(lbase_ + (unsigned)(_i * 8192)) : "memory"); } } while (0)
#define PG8_STAGE_A(bufoff, base, h, nx) do { if constexpr (GATHER) { unsigned _v[2]; _v[0] = (nx) ? gnxt[h][0] : gcur[h][0]; _v[1] = (nx) ? gnxt[h][1] : gcur[h][1]; PG8_STAGE(bufoff, base, _v); } \
        else { PG8_STAGE(bufoff, (base) + (h) * hstepA, voffA); } } while (0)
#define PG8_LDA(dst, b, h) do { _Pragma("unroll") for (int m = 0; m < 4; ++m) _Pragma("unroll") for (int k = 0; k < 2; ++k) dst[m][k] = *(const LAS bf16x8*)(lds + PG8_SA(b, h) + aoff + m * 2048 + k * 1024); } while (0)
#define PG8_LDB(dst, b, h) do { _Pragma("unroll") for (int n = 0; n < 2; ++n) _Pragma("unroll") for (int k = 0; k < 2; ++k) dst[n][k] = *(const LAS bf16x8*)(lds + PG8_SB(b, h) + boff + n * 2048 + k * 1024); } while (0)
#define PG8_MMA(ai, bj, At, Bt) do { __builtin_amdgcn_s_setprio(1); if constexpr (FP8) { _Pragma("unroll") for (int m = 0; m < 4; ++m) _Pragma("unroll") for (int n = 0; n < 2; ++n) { \
        const v8i32_t b8_ = __builtin_shufflevector(__builtin_bit_cast(v4i32_t, Bt[n][0]), __builtin_bit_cast(v4i32_t, Bt[n][1]), 0, 1, 2, 3, 4, 5, 6, 7), a8_ = __builtin_shufflevector(__builtin_bit_cast(v4i32_t, At[m][0]), __builtin_bit_cast(v4i32_t, At[m][1]), 0, 1, 2, 3, 4, 5, 6, 7); \
        asm volatile("s_nop 1\n\tv_mfma_scale_f32_16x16x128_f8f6f4 %0, %1, %2, %0, %3, %3 op_sel_hi:[0,0,0]" : "+v"(acc[ai][bj][m][n]) : "v"(b8_), "v"(a8_), "v"(scl8)); } } \
      else { _Pragma("unroll") for (int m = 0; m < 4; ++m) _Pragma("unroll") for (int n = 0; n < 2; ++n) _Pragma("unroll") for (int k = 0; k < 2; ++k) \
        acc[ai][bj][m][n] = __builtin_amdgcn_mfma_f32_16x16x32_bf16(Bt[n][k], At[m][k], acc[ai][bj][m][n], 0, 0, 0); } __builtin_amdgcn_s_setprio(0); } while (0)
#define PG8_WAIT_V(n) asm volatile("s_waitcnt vmcnt(" #n ")" ::: "memory")
#define PG8_WAIT_L(n) asm volatile("s_waitcnt lgkmcnt(" #n ")" ::: "memory")
#define PG8_BAR __builtin_amdgcn_s_barrier()
#define PG8_SCHED __builtin_amdgcn_sched_barrier(0)
#define PG8_GLOAD(dst, u) do { if constexpr (GATHER) { _Pragma("unroll") for (int _h = 0; _h < 2; ++_h) _Pragma("unroll") for (int _i = 0; _i < 2; ++_i) \
        dst[_h][_i] = (unsigned)tokof[(u).pm * BM + _h * HALF + RA[_i]] * (unsigned)ldaB + (unsigned)CA2[_i]; } } while (0)
    Unit cur, nxt; int ui = 0;
    if (!S.next(0, cur)) return;
    PG8_GLOAD(gcur, cur);
    typename Epi::Pre pre = E.prefetch(cur, wr, fr);
    f32x4 acc[2][2][4][2];
#pragma unroll
    for (int a = 0; a < 2; ++a)
#pragma unroll
        for (int b = 0; b < 2; ++b)
#pragma unroll
            for (int m = 0; m < 4; ++m)
#pragma unroll
                for (int n = 0; n < 2; ++n) acc[a][b][m][n] = (f32x4){0.f, 0.f, 0.f, 0.f};
    bf16x8 At[4][2], B0[2][2], B1[2][2];
    const GAS char* cA = cur.a; const GAS char* cB = cur.b;
    PG8_STAGE(PG8_SB(0, 0), cB, voffB); PG8_STAGE(PG8_SB(0, 1), cB + hstepB, voffB); PG8_STAGE_A(PG8_SA(0, 0), cA, 0, false); PG8_STAGE_A(PG8_SA(0, 1), cA, 1, false);
    if (wr == 1) PG8_BAR;
    PG8_WAIT_V(2); PG8_BAR;
    PG8_STAGE(PG8_SB(1, 0), cB + kstep, voffB); PG8_STAGE_A(PG8_SA(1, 0), cA + kstep, 0, false); PG8_STAGE(PG8_SB(1, 1), cB + hstepB + kstep, voffB);
    PG8_WAIT_V(6); PG8_BAR;
    bool fresh = false;
    for (;;) {
        const bool has_next = S.next(ui + 1, nxt);
        if constexpr (GATHER) { if (has_next) { PG8_GLOAD(gnxt, nxt); } else { _Pragma("unroll") for (int _h = 0; _h < 2; ++_h) _Pragma("unroll") for (int _i = 0; _i < 2; ++_i) gnxt[_h][_i] = gcur[_h][_i]; } }
        const GAS char* nA = has_next ? nxt.a : cA; const GAS char* nB = has_next ? nxt.b : cB;
#pragma nounroll
        for (int t = 0; t < nt; t += 2) {
            const bool last = (t == nt - 2);
            const GAS char* a1 = cA + (size_t)(t + 1) * kstep;
            const GAS char* a2 = last ? nA : cA + (size_t)(t + 2) * kstep; const GAS char* b2 = last ? nB : cB + (size_t)(t + 2) * kstep;
            const GAS char* a3 = a2 + kstep; const GAS char* b3 = b2 + kstep;
            const bool fe = fresh; fresh = false;
            if constexpr (MIDSCALE) { if (t == nt / 2) {
#pragma unroll
                for (int ai = 0; ai < 2; ++ai)
#pragma unroll
                    for (int m = 0; m < 4; ++m) { const float r_ = scl[ui * 256 + ai * 128 + wr * 64 + m * 16 + fr][0];
#pragma unroll
                        for (int bj = 0; bj < 2; ++bj)
#pragma unroll
                            for (int n = 0; n < 2; ++n) acc[ai][bj][m][n] *= r_; } } }
            PG8_LDB(B0, 0, 0); PG8_LDB(B1, 0, 1); PG8_SCHED; PG8_LDA(At, 0, 0); PG8_STAGE_A(PG8_SA(1, 1), a1, 1, false);
            if (fe) wait_vm<8 + Epi::NST>(); else PG8_WAIT_V(8); PG8_WAIT_L(0); PG8_BAR; PG8_MMA(0, 0, At, B0); PG8_MMA(0, 1, At, B1); PG8_BAR; PG8_SCHED;
            PG8_LDA(At, 0, 1); PG8_STAGE(PG8_SB(0, 0), b2, voffB); PG8_STAGE(PG8_SB(0, 1), b2 + hstepB, voffB); PG8_STAGE_A(PG8_SA(0, 0), a2, 0, last);
            if (fe) wait_vm<8 + Epi::NST>(); else PG8_WAIT_V(8); PG8_WAIT_L(0); PG8_BAR; PG8_MMA(1, 0, At, B0); PG8_MMA(1, 1, At, B1); PG8_BAR; PG8_SCHED;
            PG8_LDB(B0, 1, 0); PG8_LDB(B1, 1, 1); PG8_SCHED; PG8_LDA(At, 1, 0); PG8_STAGE_A(PG8_SA(0, 1), a2, 1, last);
            PG8_WAIT_V(8); PG8_WAIT_L(0); PG8_BAR; PG8_MMA(0, 0, At, B0); PG8_MMA(0, 1, At, B1); PG8_BAR; PG8_SCHED;
            PG8_LDA(At, 1, 1); PG8_STAGE(PG8_SB(1, 0), b3, voffB); PG8_STAGE(PG8_SB(1, 1), b3 + hstepB, voffB); PG8_STAGE_A(PG8_SA(1, 0), a3, 0, last);
            PG8_WAIT_V(8); PG8_WAIT_L(0); PG8_BAR; PG8_MMA(1, 0, At, B0); PG8_MMA(1, 1, At, B1); PG8_BAR; PG8_SCHED;
        }
        if constexpr (ALIGN_EPI) { if (wr == 0) PG8_BAR; }
        if constexpr (FP8) { asm volatile("s_nop 15\n\ts_nop 15" ::: "memory"); }
        if constexpr (MIDSCALE) E(acc, cur, wr, wc, fr, fq, scl + ui * 256); else E(acc, cur, wr, wc, fr, fq, pre);
        if (!has_next) break;
        pre = E.prefetch(nxt, wr, fr);
#pragma unroll
        for (int a = 0; a < 2; ++a)
#pragma unroll
            for (int b = 0; b < 2; ++b)
#pragma unroll
                for (int m = 0; m < 4; ++m)
#pragma unroll
                    for (int n = 0; n < 2; ++n) acc[a][b][m][n] = (f32x4){0.f, 0.f, 0.f, 0.f};
        cur = nxt; cA = nA; cB = nB; ++ui; fresh = true;
        if constexpr (GATHER) { _Pragma("unroll") for (int _h = 0; _h < 2; ++_h) _Pragma("unroll") for (int _i = 0; _i < 2; ++_i) gcur[_h][_i] = gnxt[_h][_i]; }
        if constexpr (ALIGN_EPI) { if (wr == 1) PG8_BAR; }
    }
    PG8_WAIT_V(0);
    if constexpr (!ALIGN_EPI) { if (wr == 0) PG8_BAR; }
    PG8_BAR;
#undef PG8_SA
#undef PG8_SB
#undef PG8_STAGE
#undef PG8_STAGE_A
#undef PG8_LDA
#undef PG8_LDB
#undef PG8_MMA
#undef PG8_WAIT_V
#undef PG8_WAIT_L
#undef PG8_BAR
#undef PG8_SCHED
#undef PG8_GLOAD
}
}
using pg8::Unit;

struct DenseOrder {
    int nM, nN, nwg, G, c; const GAS char* A; const GAS char* B; size_t aT, bT;
    __device__ __forceinline__ bool next(int i, Unit& u) const {
        const long L = (long)i * G + c; if (L >= nwg) return false;
        int wgid = (int)L; { const int q = nwg / 8, r = nwg % 8, xcd = wgid % 8, off = wgid / 8; wgid = (xcd < r ? xcd * (q + 1) : r * (q + 1) + (xcd - r) * q) + off; }
        const int nig = 8 * nN, gid = wgid / nig, fm = gid * 8, gsz = (nM - fm) < 8 ? (nM - fm) : 8;
        u.pm = fm + ((wgid % nig) % gsz); u.pn = (wgid % nig) / gsz; u.e = 0;
        u.a = A + (size_t)u.pm * aT; u.b = B + (size_t)u.pn * bT; return true;
    }
};
struct UpOrder {
    int G, c; const GAS char* LATp; const GAS char* Wq; const GAS char* Wkv;
    __device__ __forceinline__ bool next(int i, Unit& u) const {
        const int L = i * G + c; if (L >= 128 * 7) return false;
        u.pm = L / 7; const int j = L % 7; const bool kv = j >= 3; u.pn = kv ? j - 3 : j; u.e = kv ? 1 : 0;
        u.a = LATp + (size_t)u.pm * 256 * 512 * 2 + (kv ? 512 : 0);
        u.b = (kv ? Wkv : Wq) + (size_t)u.pn * 256 * 256 * 2; return true;
    }
};
struct MoeOrder {
    int G, c; const volatile LAS int* TS; const GAS char* A; const GAS char* W; size_t aT  , wE  , wT  ;
    __device__ __forceinline__ bool next(int i, Unit& u) const {
        const int L = i * G + c; const int ntile = __builtin_amdgcn_readfirstlane(TS[32]); if (L >= ntile * 4) return false;
        const int rt = L >> 2, ct = L & 3; int e = 0;
        for (int j = 1; j < 32; ++j) e += (TS[j] <= rt) ? 1 : 0;
        e = __builtin_amdgcn_readfirstlane(e);
        u.pm = rt; u.pn = ct; u.e = e; u.a = A + (size_t)rt * aT; u.b = W + (size_t)e * wE + (size_t)ct * wT; return true;
    }
};

__device__ __forceinline__ u32x4 pack8(f32x4 v0, f32x4 v1) { u32x4 w; w.x = cvt_pk_bf16(v0[0], v0[1]); w.y = cvt_pk_bf16(v0[2], v0[3]); w.z = cvt_pk_bf16(v1[0], v1[1]); w.w = cvt_pk_bf16(v1[2], v1[3]); return w; }

struct EpiWin {
    static constexpr int NST = 16;
    static constexpr bool PERM = true;
    GAS bf16* LAT_; GAS bf16* FQKV_; GAS bf16* KPE_; GAS float* FLOG_; GAS float* SSQ_; const GAS float* COS_; const GAS float* SIN_; const GAS float* RSX_;
    struct Pre { float v[8]; };
    __device__ __forceinline__ Pre prefetch(const Unit& u, int wr, int fr) const { Pre p; const GAS float* RSX = RSX_; asm volatile("" : "+s"(RSX));
#pragma unroll
        for (int g = 0; g < 8; ++g) p.v[g] = RSX[u.pm * 256 + (g >> 2) * 128 + wr * 64 + (g & 3) * 16 + fr]; return p; }
    __device__ __forceinline__ void operator()(f32x4 (&acc)[2][2][4][2], const Unit& u, int wr, int wc, int fr, int fq, const Pre& pre) const {
        GAS bf16* LAT = LAT_; GAS bf16* FQKV = FQKV_; GAS bf16* KPE = KPE_; GAS float* FLOG = FLOG_; GAS float* SSQ = SSQ_; const GAS float* COS = COS_; const GAS float* SIN = SIN_; const GAS float* RSX = RSX_;
        asm volatile("" : "+s"(LAT), "+s"(FQKV), "+s"(KPE), "+s"(FLOG), "+s"(SSQ), "+s"(COS), "+s"(SIN), "+s"(RSX));
        {
#pragma unroll
            for (int ai = 0; ai < 2; ++ai)
#pragma unroll
                for (int m = 0; m < 4; ++m) { const float rs_ = pre.v[ai * 4 + m];
#pragma unroll
                    for (int bj = 0; bj < 2; ++bj)
#pragma unroll
                        for (int n = 0; n < 2; ++n) acc[ai][bj][m][n] *= rs_; } }
        const int row0 = u.pm * 256 + wr * 64 + fr; const int pn = u.pn;
        if (pn >= 2) {
            const int ti = pn >> 1; GAS bf16* dst = FQKV + (size_t)(ti - 1) * NTOK * 512; const int colb = (pn & 1) * 256 + wc * 32 + 8 * fq; const float sc = (ti == 1) ? C2F : 1.f;
#pragma unroll
            for (int ai = 0; ai < 2; ++ai)
#pragma unroll
                for (int m = 0; m < 4; ++m) { GAS bf16* rowp = dst + (size_t)(row0 + ai * 128 + m * 16) * 512 + colb;
#pragma unroll
                    for (int bj = 0; bj < 2; ++bj) *(GAS u32x4*)(rowp + bj * 128) = pack8(acc[ai][bj][m][0] * sc, acc[ai][bj][m][1] * sc); }
        } else {
#pragma unroll
            for (int ai = 0; ai < 2; ++ai)
#pragma unroll
                for (int m = 0; m < 4; ++m) { const int row = row0 + ai * 128 + m * 16; GAS bf16* rowp = LAT + (size_t)row * 512 + pn * 256 + wc * 32 + 8 * fq;
#pragma unroll
                    for (int bj = 0; bj < 2; ++bj) *(GAS u32x4*)(rowp + bj * 128) = pack8(acc[ai][bj][m][0], acc[ai][bj][m][1]);
                    float s = 0.f;
#pragma unroll
                    for (int n = 0; n < 2; ++n) { const f32x4 x = acc[ai][0][m][n]; s += (x[0] * x[0] + x[1] * x[1]) + (x[2] * x[2] + x[3] * x[3]); }
                    if (pn == 0) {
#pragma unroll
                        for (int n = 0; n < 2; ++n) { const f32x4 x = acc[ai][1][m][n]; s += (x[0] * x[0] + x[1] * x[1]) + (x[2] * x[2] + x[3] * x[3]); }
                    }
                    s += __shfl_xor(s, 16); s += __shfl_xor(s, 32);
                    if (fq == 0) SSQ[(size_t)row * 8 + pn * 4 + wc] = s;
                    }
            if (pn == 1 && wc == 0) {
#pragma unroll
                for (int ai = 0; ai < 2; ++ai)
#pragma unroll
                    for (int m = 0; m < 4; ++m) { const int row = row0 + ai * 128 + m * 16;
                        const f32x4 c = *(const GAS f32x4*)(COS + (size_t)row * 16 + 4 * fq), sn = *(const GAS f32x4*)(SIN + (size_t)row * 16 + 4 * fq);
                        const f32x4 x1 = acc[ai][1][m][0], x2 = acc[ai][1][m][1];
                        *(GAS u32x4*)(KPE + (size_t)row * 32 + 8 * fq) = pack8(x1 * c - x2 * sn, x1 * sn + x2 * c);
                        }
            }
            if (pn == 1 && wc == 1 && fq == 0) {
#pragma unroll
                for (int ai = 0; ai < 2; ++ai)
#pragma unroll
                    for (int m = 0; m < 4; ++m) { const int row = row0 + ai * 128 + m * 16; *(GAS f32x4*)(FLOG + (size_t)row * 8) = acc[ai][1][m][0]; *(GAS f32x4*)(FLOG + (size_t)row * 8 + 4) = acc[ai][1][m][1]; }
            }
        }
    }
};
struct EpiUp {
    static constexpr int NST = 16;
    static constexpr bool PERM = true;
    GAS bf16* QM_; GAS bf16* KVM_; const GAS float* SSQ_; const GAS float* COS_; const GAS float* SIN_;
    struct Pre { f32x4 v[8]; };
    __device__ __forceinline__ Pre prefetch(const Unit& u, int wr, int fr) const { Pre p; const GAS float* SSQ = SSQ_; asm volatile("" : "+s"(SSQ)); const int off = u.e ? 4 : 0;
#pragma unroll
        for (int g = 0; g < 8; ++g) p.v[g] = *(const GAS f32x4*)(SSQ + (size_t)(u.pm * 256 + (g >> 2) * 128 + wr * 64 + (g & 3) * 16 + fr) * 8 + off); return p; }
    __device__ __forceinline__ void operator()(const f32x4 (&acc)[2][2][4][2], const Unit& u, int wr, int wc, int fr, int fq, const Pre& pre) const {
        GAS bf16* QM = QM_; GAS bf16* KVM = KVM_; const GAS float* SSQ = SSQ_; const GAS float* COS = COS_; const GAS float* SIN = SIN_;
        asm volatile("" : "+s"(QM), "+s"(KVM), "+s"(SSQ), "+s"(COS), "+s"(SIN));
        const int row0 = u.pm * 256 + wr * 64 + fr; const int pn = u.pn; const bool kv = u.e != 0;
#pragma unroll
        for (int ai = 0; ai < 2; ++ai)
#pragma unroll
            for (int m = 0; m < 4; ++m) { const int row = row0 + ai * 128 + m * 16;
                const f32x4 sq = pre.v[ai * 4 + m];
                const float ss = (sq[0] + sq[1]) + (sq[2] + sq[3]);
                if (kv) {
                    const float rs = rsqrtf(ss * (1.f / 128.f) + EPS);
                    GAS bf16* rowp = KVM + (size_t)row * 1024 + pn * 256 + wc * 32 + 8 * fq;
#pragma unroll
                    for (int bj = 0; bj < 2; ++bj) *(GAS u32x4*)(rowp + bj * 128) = pack8(acc[ai][bj][m][0] * rs, acc[ai][bj][m][1] * rs);
                } else {
                    const float rs = rsqrtf(ss * (1.f / 256.f) + EPS) * C2M;
                    GAS bf16* rowp = QM + (size_t)row * 768 + pn * 256 + wc * 32 + 8 * fq;
                    const f32x4 c = *(const GAS f32x4*)(COS + (size_t)row * 16 + 4 * fq), sn = *(const GAS f32x4*)(SIN + (size_t)row * 16 + 4 * fq);
#pragma unroll
                    for (int bj = 0; bj < 2; ++bj) { f32x4 v0 = acc[ai][bj][m][0] * rs, v1 = acc[ai][bj][m][1] * rs;
                        const int G = 8 * pn + 4 * bj + wc;
                        if (G % 3 == 2) { const f32x4 x1 = v0, x2 = v1; v0 = x1 * c - x2 * sn; v1 = x1 * sn + x2 * c; }
                        *(GAS u32x4*)(rowp + bj * 128) = pack8(v0, v1); }
                }

            }
    }
};
template <bool RES_F32> struct EpiOut {
    static constexpr int NST = 16;
    static constexpr bool PERM = true;
    const GAS float* resf_; GAS bf16* xr_;
    struct Pre {}; __device__ __forceinline__ Pre prefetch(const Unit&, int, int) const { return Pre{}; }
    __device__ __forceinline__ void operator()(const f32x4 (&acc)[2][2][4][2], const Unit& u, int wr, int wc, int fr, int fq, const LAS f32x2* scl) const {
        const GAS float* resf = resf_; GAS bf16* xr = xr_; asm volatile("" : "+s"(resf), "+s"(xr));
        const int row0 = u.pm * 256 + wr * 64 + fr, col0 = u.pn * 256 + wc * 32 + 8 * fq;
#pragma unroll
        for (int ai = 0; ai < 2; ++ai)
#pragma unroll
            for (int m = 0; m < 4; ++m) { const size_t off = (size_t)(row0 + ai * 128 + m * 16) * DM + col0; const float sh = scl[ai * 128 + wr * 64 + m * 16 + fr][1];
#pragma unroll
                for (int bj = 0; bj < 2; ++bj) { f32x4 r0, r1;
                    if constexpr (RES_F32) { r0 = *(const GAS f32x4*)(resf + off + bj * 128); r1 = *(const GAS f32x4*)(resf + off + bj * 128 + 4); }
                    else { const u32x4 w = *(const GAS u32x4*)(xr + off + bj * 128);
                        r0 = (f32x4){__uint_as_float(w.x << 16), __uint_as_float(w.x & 0xffff0000u), __uint_as_float(w.y << 16), __uint_as_float(w.y & 0xffff0000u)};
                        r1 = (f32x4){__uint_as_float(w.z << 16), __uint_as_float(w.z & 0xffff0000u), __uint_as_float(w.w << 16), __uint_as_float(w.w & 0xffff0000u)}; }
                    *(GAS u32x4*)(xr + off + bj * 128) = pack8(r0 + acc[ai][bj][m][0] * sh, r1 + acc[ai][bj][m][1] * sh); } }
    }
};
struct EpiGU {
    static constexpr int NST = 8;
    static constexpr bool PERM = true;
    GAS unsigned char* HH_; const GAS float* RS_;
    struct Pre { float v[8]; };
    __device__ __forceinline__ Pre prefetch(const Unit& u, int wr, int fr) const { Pre p; const GAS float* RS = RS_; asm volatile("" : "+s"(RS));
#pragma unroll
        for (int g = 0; g < 8; ++g) p.v[g] = RS[u.pm * 256 + (g >> 2) * 128 + wr * 64 + (g & 3) * 16 + fr]; return p; }
    __device__ __forceinline__ void operator()(const f32x4 (&acc)[2][2][4][2], const Unit& u, int wr, int wc, int fr, int fq, const Pre& pre) const {
        GAS unsigned char* HH = HH_; const GAS float* RS = RS_; asm volatile("" : "+s"(HH), "+s"(RS));
        const int row0 = u.pm * 256 + wr * 64 + fr;
#pragma unroll
        for (int ai = 0; ai < 2; ++ai)
#pragma unroll
            for (int m = 0; m < 4; ++m) { GAS unsigned char* rowp = HH + (size_t)(row0 + ai * 128 + m * 16) * 512 + u.pn * 128 + wc * 32 + 8 * fq; const float rs = pre.v[ai * 4 + m] * WSCALE_INV;
                f32x4 h[2];
#pragma unroll
                for (int n = 0; n < 2; ++n) { const f32x4 g = acc[ai][0][m][n] * rs, up = acc[ai][1][m][n] * rs;
#pragma unroll
                    for (int j = 0; j < 4; ++j) { const float sg = __builtin_amdgcn_rcpf(1.f + __builtin_amdgcn_exp2f(-g[j] * LOG2E)); h[n][j] = g[j] * sg * up[j]; } }
                u32x2 w; w.x = pk4_fp8(h[0][0], h[0][1], h[0][2], h[0][3]); w.y = pk4_fp8(h[1][0], h[1][1], h[1][2], h[1][3]); *(GAS u32x2*)rowp = w; }
    }
};
struct EpiDown {
    static constexpr int NST = 16;
    static constexpr bool PERM = true;
    GAS unsigned char* Y_; const GAS float* GATEOF_;
    struct Pre { float v[8]; };
    __device__ __forceinline__ Pre prefetch(const Unit& u, int wr, int fr) const { Pre p; const GAS float* GT = GATEOF_; asm volatile("" : "+s"(GT));
#pragma unroll
        for (int g = 0; g < 8; ++g) p.v[g] = GT[u.pm * 256 + (g >> 2) * 128 + wr * 64 + (g & 3) * 16 + fr]; return p; }
    __device__ __forceinline__ void operator()(const f32x4 (&acc)[2][2][4][2], const Unit& u, int wr, int wc, int fr, int fq, const Pre& pre) const {
        GAS unsigned char* Y = Y_; const GAS float* GATEOF = GATEOF_; asm volatile("" : "+s"(Y), "+s"(GATEOF));
        const int row0 = u.pm * 256 + wr * 64 + fr;
#pragma unroll
        for (int ai = 0; ai < 2; ++ai)
#pragma unroll
            for (int m = 0; m < 4; ++m) { const int row = row0 + ai * 128 + m * 16; const float g = pre.v[ai * 4 + m]; GAS unsigned char* rowp = Y + (size_t)row * 1024 + u.pn * 256 + wc * 32 + 8 * fq;
#pragma unroll
                for (int bj = 0; bj < 2; ++bj) { const f32x4 v0 = acc[ai][bj][m][0] * g, v1 = acc[ai][bj][m][1] * g; u32x2 w; w.x = pk4_fp8(v0[0], v0[1], v0[2], v0[3]); w.y = pk4_fp8(v1[0], v1[1], v1[2], v1[3]); *(GAS u32x2*)(rowp + bj * 128) = w; } }
    }
};

namespace att {
constexpr int KSLOT = 12288, VSLOT = 8192;
constexpr int L_K = 0, L_V = 2 * KSLOT, L_BIAS = L_V + 2 * VSLOT, L_WS = L_BIAS + 8192, L_OST = L_WS + 8 * 64 * 4, L_END = L_OST + 8 * 4096;
__device__ __forceinline__ int crow(int r, int hi) { return (r & 3) + 8 * (r >> 2) + 4 * hi; }
typedef short v4i16_t __attribute__((ext_vector_type(4)));
__device__ __forceinline__ s16x4 vtr(const LAS char* p) { return __builtin_bit_cast(s16x4, __builtin_amdgcn_ds_read_tr16_b64_v4i16((LAS v4i16_t*)p)); }

constexpr int NSL = 5;
constexpr int R_K = 0, R_V = NSL * KSLOT, R_WS = R_V + NSL * VSLOT, R_OST = R_WS + 8 * 64 * 4, R_END = R_OST + 8 * 4096;
static_assert(R_END <= RING_BYTES, "attention LDS");
__device__ __forceinline__ void glds16(const GAS void* gsrc, unsigned lds_dst) { unsigned keep;
    asm volatile("s_mov_b32 %0, m0\n\ts_mov_b32 m0, %2\n\ts_nop 0\n\tglobal_load_lds_dwordx4 %1, off\n\ts_mov_b32 m0, %0" : "=&s"(keep) : "v"(gsrc), "s"(lds_dst) : "memory"); }
__device__ __forceinline__ void glds16s(const GAS void* sbase, unsigned voff, unsigned lds_dst) { unsigned keep;
    asm volatile("s_mov_b32 %0, m0\n\ts_mov_b32 m0, %3\n\ts_nop 0\n\tglobal_load_lds_dwordx4 %1, %2\n\ts_mov_b32 m0, %0" : "=&s"(keep) : "v"(voff), "s"((unsigned long long)sbase), "s"(lds_dst) : "memory"); }
struct Tens2 { const GAS bf16* Q; int qp; const GAS bf16* K; int kp; const GAS bf16* KX; const GAS bf16* V; int vp; GAS bf16* O; const GAS float* BIASF; const GAS float* NRM; GAS float* OSS; };
template <int MODE>
__device__ __forceinline__ int attn_unit2(const int wave_, int b, int h, int qb, const Tens2& T, LAS char* shm, const int slbase, const bool have_pro, const int qb_next, bf16x8 (&qr)[6], const int tstart) {
    constexpr int DKS = MODE ? 6 : 5, DKH = 3;
    constexpr float THR = 8.f;
    int wid = wave_; asm volatile("" : "+s"(wid));
    int lane = (int)__builtin_amdgcn_mbcnt_hi(~0u, __builtin_amdgcn_mbcnt_lo(~0u, 0u)); asm volatile("" : "+v"(lane)); const int r32 = lane & 31, hi = lane >> 5;
    const long rowbase = (long)b * SEQ; const int q0 = qb * 256, qw0 = q0 + wid * 32;
    const int NT = (q0 + 256) / 64, tlast = qw0 / 64;
    const int NTE = NT - tstart;
    const GAS bf16* Qw = T.Q + (rowbase + qw0) * T.qp + h * (MODE ? 96 : 64);
    const GAS bf16* Kh = T.K + rowbase * T.kp + h * (MODE ? 128 : 64);
    const GAS bf16* Vh = T.V + rowbase * T.vp + h * (MODE ? 128 : 64);
    LAS float* wsf = (LAS float*)(shm + R_WS) + wid * 64;
    const unsigned koff = (unsigned)(lane * T.kp + wid * 8) * 2u;
    const unsigned xoff = MODE ? (unsigned)(lane * 32 + (wid & 3) * 8) * 2u : (unsigned)(lane * 8) * 2u;
    const unsigned voff = (unsigned)((16 * (wid & 3) + (lane >> 2)) * T.vp + (wid >> 2) * 32 + (lane & 3) * 8) * 2u;
    const GAS bf16* xbase = MODE ? T.KX + rowbase * 32 : T.KX + ((long)b * 8 + h) * SEQ * 8;
    const int xstep = MODE ? 64 * 32 : 64 * 8;
    const unsigned kdst_a = (unsigned)(uintptr_t)(shm + R_K) + (unsigned)wid * 1024u, xdst_a = (unsigned)(uintptr_t)(shm + R_K) + (unsigned)(8 + (MODE ? (wid & 3) : 0)) * 1024u, vdst_a = (unsigned)(uintptr_t)(shm + R_V) + (unsigned)wid * 1024u;
#define A2_DMA(t, slot) do { \
        glds16s((const GAS void*)(Kh + (long)(t) * 64 * T.kp), koff, (unsigned)__builtin_amdgcn_readfirstlane((int)(kdst_a + (slot) * KSLOT))); \
        glds16s((const GAS void*)(xbase + (long)(t) * xstep), xoff, (unsigned)__builtin_amdgcn_readfirstlane((int)(xdst_a + (slot) * KSLOT))); \
        glds16s((const GAS void*)(Vh + (long)(t) * 64 * T.vp), voff, (unsigned)__builtin_amdgcn_readfirstlane((int)(vdst_a + (slot) * VSLOT))); } while (0)
    float mhat = 0.f, lrun = 0.f; f32x16 o[2]; o[0] = f32x16{}; o[1] = f32x16{}; f32x16 negm = f32x16{};
    const LAS char* vp0 = shm + R_V + ((lane >> 4) & 1) * 32 + (lane & 3) * 8 + (4 * hi + ((lane & 15) >> 2)) * 64;
#define A3_SLOT(k) ((slbase + (k)) % NSL)
    if (!have_pro) { A2_DMA(NT - 1, A3_SLOT(0)); A2_DMA(NT - 2, A3_SLOT(1)); A2_DMA(NT - 3, A3_SLOT(2)); }
    if (!have_pro) {
#pragma unroll
        for (int d0 = 0; d0 < (MODE ? 6 : 4); ++d0) qr[d0] = *(const GAS bf16x8*)(Qw + (long)r32 * T.qp + d0 * 16 + hi * 8); }
    if (MODE == 0) { const short one = hi ? (short)0 : (short)0x3F80; qr[DKS - 1] = (bf16x8){one, one, one, 0, 0, 0, 0, 0}; }
#pragma unroll
    for (int d0 = 0; d0 < DKS; ++d0) asm volatile("" : "+v"(qr[d0]));
#define A3_KLOADH(slot, H) do { const LAS char* kb_ = shm + R_K + (slot) * KSLOT + r32 * 16; _Pragma("unroll") for (int d0 = (H) * DKH; d0 < ((H) ? DKS : DKH); ++d0) { const int off = (MODE == 0 && d0 == 4) ? 8 * 1024 : d0 * 2048 + hi * 1024; \
        kf[2 * (d0 - (H) * DKH)] = *(const LAS bf16x8*)(kb_ + off); kf[2 * (d0 - (H) * DKH) + 1] = *(const LAS bf16x8*)(kb_ + off + 512); } } while (0)
#define A3_VLOAD(slot) do { const LAS char* vp_ = vp0 + (slot) * VSLOT; _Pragma("unroll") for (int q = 0; q < 8; ++q) { vlo[q] = vtr(vp_ + (q >> 2) * 4096 + (q & 3) * 1024); vhh[q] = vtr(vp_ + (q >> 2) * 4096 + (q & 3) * 1024 + 512); } } while (0)
#define A3_QKH(H) do { if ((H) == 0) { c0 = negm; c1 = negm; } _Pragma("unroll") for (int d0 = (H) * DKH; d0 < ((H) ? DKS : DKH); ++d0) { c0 = __builtin_amdgcn_mfma_f32_32x32x16_bf16(kf[2 * (d0 - (H) * DKH)], qr[d0], c0, 0, 0, 0); c1 = __builtin_amdgcn_mfma_f32_32x32x16_bf16(kf[2 * (d0 - (H) * DKH) + 1], qr[d0], c1, 0, 0, 0); } } while (0)
#define A3_EXP() do { float ls_ = 0.f; _Pragma("unroll") for (int r = 0; r < 16; ++r) { pp0[r] = __builtin_amdgcn_exp2f(pp0[r]); pp1[r] = __builtin_amdgcn_exp2f(pp1[r]); ls_ += pp0[r] + pp1[r]; } lrun += ls_; u32x4 w_; \
        w_.x = cvt_pk_bf16(pp0[0], pp0[1]); w_.y = cvt_pk_bf16(pp0[2], pp0[3]); w_.z = cvt_pk_bf16(pp0[4], pp0[5]); w_.w = cvt_pk_bf16(pp0[6], pp0[7]); pa[0] = __builtin_bit_cast(bf16x8, w_); \
        w_.x = cvt_pk_bf16(pp0[8], pp0[9]); w_.y = cvt_pk_bf16(pp0[10], pp0[11]); w_.z = cvt_pk_bf16(pp0[12], pp0[13]); w_.w = cvt_pk_bf16(pp0[14], pp0[15]); pa[1] = __builtin_bit_cast(bf16x8, w_); \
        w_.x = cvt_pk_bf16(pp1[0], pp1[1]); w_.y = cvt_pk_bf16(pp1[2], pp1[3]); w_.z = cvt_pk_bf16(pp1[4], pp1[5]); w_.w = cvt_pk_bf16(pp1[6], pp1[7]); pa[2] = __builtin_bit_cast(bf16x8, w_); \
        w_.x = cvt_pk_bf16(pp1[8], pp1[9]); w_.y = cvt_pk_bf16(pp1[10], pp1[11]); w_.z = cvt_pk_bf16(pp1[12], pp1[13]); w_.w = cvt_pk_bf16(pp1[14], pp1[15]); pa[3] = __builtin_bit_cast(bf16x8, w_); } while (0)
#define A3_PV() do { _Pragma("unroll") for (int d0 = 0; d0 < 2; ++d0) _Pragma("unroll") for (int k = 0; k < 4; ++k) { const s16x4 lo_ = vlo[4 * d0 + k], hh_ = vhh[4 * d0 + k]; \
        const bf16x8 vf_ = (bf16x8){lo_[0], lo_[1], lo_[2], lo_[3], hh_[0], hh_[1], hh_[2], hh_[3]}; o[d0] = __builtin_amdgcn_mfma_f32_32x32x16_bf16(pa[k], vf_, o[d0], 0, 0, 0); } } while (0)
#define A3_ROWMAX(rm) do { float a_ = fmaxf(fmaxf(c0[0], c0[1]), c1[0]), b_ = fmaxf(fmaxf(c0[2], c0[3]), c1[1]); a_ = fmaxf(fmaxf(a_, c1[2]), c1[3]); \
        _Pragma("unroll") for (int r = 4; r < 16; r += 4) { a_ = fmaxf(fmaxf(a_, c0[r]), c0[r + 1]); b_ = fmaxf(fmaxf(b_, c0[r + 2]), c0[r + 3]); a_ = fmaxf(fmaxf(a_, c1[r]), c1[r + 1]); b_ = fmaxf(fmaxf(b_, c1[r + 2]), c1[r + 3]); } \
        rm = fmaxf(a_, b_); const auto rr_ = __builtin_amdgcn_permlane32_swap(__float_as_uint(rm), __float_as_uint(rm), false, false); rm = fmaxf(__uint_as_float(rr_[0]), __uint_as_float(rr_[1])); } while (0)
    int sl = A3_SLOT(0), sl3 = A3_SLOT(3);
    f32x16 pp0 = f32x16{}, pp1 = f32x16{}; bool pend = false; int pslot = 0;
    for (int i = 0; i < NTE; ++i) {
        const int t = NT - 1 - i;
        { const int ahead = NTE - 1 - i;
          if (ahead >= 2) asm volatile("s_waitcnt vmcnt(6)" ::: "memory"); else if (ahead == 1) asm volatile("s_waitcnt vmcnt(3)" ::: "memory"); else asm volatile("s_waitcnt vmcnt(0)" ::: "memory"); }
        __builtin_amdgcn_s_barrier(); asm volatile("" ::: "memory");
        if (i + 3 < NTE) A2_DMA(t - 3, sl3);
        if (i == NTE - 1 && qb_next >= 0) { const int NTn = 4 * qb_next + 4; A2_DMA(NTn - 1, A3_SLOT(NTE)); A2_DMA(NTn - 2, A3_SLOT(NTE + 1)); A2_DMA(NTn - 3, A3_SLOT(NTE + 2)); }
        if (t <= tlast) {
            bf16x8 kf[2 * DKH]; f32x16 c0, c1; float rm;
            A3_KLOADH(sl, 0);
            if (!pend) {
                A3_QKH(0); A3_KLOADH(sl, 1); A3_QKH(1);
                if (MODE == 0) { const int qrel = qw0 + r32 - 64 * t;
#pragma unroll
                    for (int r = 0; r < 16; ++r) { const int kv = crow(r, hi); if (kv > qrel) c0[r] = -INFINITY; if (kv + 32 > qrel) c1[r] = -INFINITY; } }
                A3_ROWMAX(rm);
                mhat = rm;
#pragma unroll
                for (int r = 0; r < 16; ++r) { c0[r] -= rm; c1[r] -= rm; negm[r] = -mhat; }
                pend = true;
            } else {
                s16x4 vlo[8], vhh[8]; bf16x8 pa[4];
                A3_QKH(0); A3_KLOADH(sl, 1);
                A3_VLOAD(pslot);
                A3_QKH(1);
                A3_EXP();
#pragma unroll
                for (int g_ = 0; g_ < 2 * DKS; ++g_) { __builtin_amdgcn_sched_group_barrier(0x008, 1, 0); __builtin_amdgcn_sched_group_barrier(0x002, 7, 0); }
                A3_PV();
                A3_ROWMAX(rm);
#pragma unroll
                for (int g_ = 0; g_ < 8; ++g_) { __builtin_amdgcn_sched_group_barrier(0x008, 1, 0); __builtin_amdgcn_sched_group_barrier(0x002, 3, 0); }
                if (__any(rm > THR)) {
                    const float dl = fmaxf(rm, 0.f); mhat += dl;
#pragma unroll
                    for (int r = 0; r < 16; ++r) { c0[r] -= dl; c1[r] -= dl; negm[r] = -mhat; }
                    const float f = __builtin_amdgcn_exp2f(-dl); lrun *= f;
                    if (hi == 0) wsf[r32] = f;
                    LDS_WAIT();
#pragma unroll
                    for (int g = 0; g < 4; ++g) { const f32x4 ff = *(const LAS f32x4*)(wsf + 8 * g + 4 * hi);
#pragma unroll
                        for (int j = 0; j < 4; ++j) { o[0][4 * g + j] *= ff[j]; o[1][4 * g + j] *= ff[j]; } }
                }
            }
            pp0 = c0; pp1 = c1; pslot = sl;
        }
        sl = (sl == NSL - 1) ? 0 : sl + 1; sl3 = (sl3 == NSL - 1) ? 0 : sl3 + 1;
    }
    if (qb_next >= 0) { const GAS bf16* Qn = T.Q + (rowbase + qb_next * 256 + wid * 32) * T.qp + h * (MODE ? 96 : 64);
#pragma unroll
        for (int d0 = 0; d0 < (MODE ? 6 : 4); ++d0) qr[d0] = *(const GAS bf16x8*)(Qn + (long)r32 * T.qp + d0 * 16 + hi * 8); }
    if (pend) { s16x4 vlo[8], vhh[8]; bf16x8 pa[4]; A3_VLOAD(pslot); A3_EXP(); A3_PV(); }
#undef A3_KLOADH
#undef A3_VLOAD
#undef A3_QKH
#undef A3_EXP
#undef A3_PV
#undef A3_ROWMAX
#undef A2_DMA
    lrun += __shfl_xor(lrun, 32);
    LDS_WAIT();
    if (hi == 0) wsf[32 + r32] = lrun;
    LDS_WAIT();
    float rli[16];
#pragma unroll
    for (int g = 0; g < 4; ++g) { const f32x4 ll = *(const LAS f32x4*)(wsf + 32 + 8 * g + 4 * hi);
#pragma unroll
        for (int j = 0; j < 4; ++j) rli[4 * g + j] = __builtin_amdgcn_rcpf(ll[j]); }
    GAS bf16* Ow = T.O + (rowbase + qw0) * 1024 + (MODE ? 0 : 512) + h * 64;
    { LAS bf16* stg = (LAS bf16*)(shm + R_OST) + wid * 2048;
#pragma unroll
      for (int r = 0; r < 16; ++r) { const int orow = crow(r, hi);
#pragma unroll
          for (int d0 = 0; d0 < 2; ++d0) stg[orow * 64 + d0 * 32 + r32] = (bf16)(cvt_pk_bf16(o[d0][r] * rli[r], 0.f) & 0xffffu); }
      LDS_WAIT();
#pragma unroll
      for (int i = 0; i < 4; ++i) { const int row = i * 8 + (lane >> 3), ch = lane & 7; const u32x4 v = *(const LAS u32x4*)(stg + row * 64 + ch * 8); *(GAS u32x4*)(Ow + (long)row * 1024 + ch * 8) = v;
          float sq = 0.f;
#pragma unroll
          for (int j = 0; j < 4; ++j) { const float a0 = __uint_as_float(v[j] << 16), a1 = __uint_as_float(v[j] & 0xffff0000u); sq += a0 * a0 + a1 * a1; }
          sq += __shfl_xor(sq, 1); sq += __shfl_xor(sq, 2); sq += __shfl_xor(sq, 4);
          if (ch == 0) T.OSS[(rowbase + qw0 + row) * 16 + (MODE ? 0 : 8) + h] = sq; } }
    if (qb_next < 0) { LDS_WAIT(); __builtin_amdgcn_s_barrier(); asm volatile("" ::: "memory"); }
    return A3_SLOT(NTE);
#undef A3_SLOT
}
}

struct Args { const void* in[21]; float* out; unsigned char* ws; int ph_lo, ph_hi; };

__device__ __forceinline__ void tr_item(const GAS float* __restrict__ W, int ldw, int Ksrc, const GAS float* __restrict__ gain, GAS bf16* __restrict__ WT, int ldk, int k0, int n0, int srccol, LAS float* scr, int lane) {
#pragma unroll 8
    for (int i = 0; i < 32; ++i) { const int kk = 2 * i + (lane >> 5); const int k = k0 + kk;
        float v = 0.f; if (srccol >= 0 && k < Ksrc) { v = __builtin_nontemporal_load(W + (size_t)k * ldw + srccol); if (gain) v *= gain[k]; }
        scr[kk * 33 + (lane & 31)] = v; }
    LDS_WAIT(); asm volatile("" ::: "memory");
    const int c = lane & 7;
#pragma unroll
    for (int j = 0; j < 4; ++j) { const int n = (lane >> 3) + 8 * j; const LAS float* s = scr + (8 * c) * 33 + n;
        u32x4 o; o.x = cvt_pk_bf16(s[0 * 33], s[1 * 33]); o.y = cvt_pk_bf16(s[2 * 33], s[3 * 33]); o.z = cvt_pk_bf16(s[4 * 33], s[5 * 33]); o.w = cvt_pk_bf16(s[6 * 33], s[7 * 33]);
        *(GAS u32x4*)(WT + (size_t)(n0 + n) * ldk + k0 + 8 * c) = o; }
    LDS_WAIT(); asm volatile("" ::: "memory");
}
__device__ __forceinline__ void tr_item64(const GAS float* __restrict__ W, int ldw, const GAS float* __restrict__ gain, GAS bf16* __restrict__ WT, int ldk, int k0, int n0src, int n0dst, LAS float* scr, int lane) {
    const int rr = lane >> 4, c4 = (lane & 15) * 4;
    f32x4 v[16];
#pragma unroll
    for (int i = 0; i < 16; ++i) v[i] = __builtin_nontemporal_load((const GAS f32x4*)(W + (size_t)(k0 + 4 * i + rr) * ldw + n0src + c4));
#pragma unroll
    for (int i = 0; i < 16; ++i) { const int k = 4 * i + rr; const float g = gain ? gain[k0 + k] : 1.f; LAS float* d = scr + k * 65 + c4;
        d[0] = v[i][0] * g; d[1] = v[i][1] * g; d[2] = v[i][2] * g; d[3] = v[i][3] * g; }
    LDS_WAIT(); asm volatile("" ::: "memory");
    const int kc = lane & 7;
#pragma unroll
    for (int j = 0; j < 8; ++j) { const int n = (lane >> 3) + 8 * j; const LAS float* sp = scr + (8 * kc) * 65 + n;
        u32x4 o; o.x = cvt_pk_bf16(sp[0 * 65], sp[1 * 65]); o.y = cvt_pk_bf16(sp[2 * 65], sp[3 * 65]); o.z = cvt_pk_bf16(sp[4 * 65], sp[5 * 65]); o.w = cvt_pk_bf16(sp[6 * 65], sp[7 * 65]);
        *(GAS u32x4*)(WT + (size_t)(n0dst + n) * ldk + k0 + 8 * kc) = o; }
    LDS_WAIT(); asm volatile("" ::: "memory");
}
__device__ __forceinline__ void tr_item64_f8(const GAS float* __restrict__ W, int ldw, const GAS float* __restrict__ gain, float scale, GAS unsigned char* __restrict__ WT8, int ldkB, int k0, int n0src, int n0dst, LAS float* scr, int lane) {
    const int rr = lane >> 4, c4 = (lane & 15) * 4;
    f32x4 v[16];
#pragma unroll
    for (int i = 0; i < 16; ++i) v[i] = __builtin_nontemporal_load((const GAS f32x4*)(W + (size_t)(k0 + 4 * i + rr) * ldw + n0src + c4));
#pragma unroll
    for (int i = 0; i < 16; ++i) { const int k = 4 * i + rr; const float g = (gain ? gain[k0 + k] : 1.f) * scale; LAS float* d = scr + k * 65 + c4;
        d[0] = v[i][0] * g; d[1] = v[i][1] * g; d[2] = v[i][2] * g; d[3] = v[i][3] * g; }
    LDS_WAIT(); asm volatile("" ::: "memory");
    const int kc = lane & 7;
#pragma unroll
    for (int j = 0; j < 8; ++j) { const int n = (lane >> 3) + 8 * j; const LAS float* sp = scr + (8 * kc) * 65 + n;
        u32x2 o; o.x = pk4_fp8(sp[0 * 65], sp[1 * 65], sp[2 * 65], sp[3 * 65]); o.y = pk4_fp8(sp[4 * 65], sp[5 * 65], sp[6 * 65], sp[7 * 65]);
        *(GAS u32x2*)(WT8 + (size_t)(n0dst + n) * ldkB + k0 + 8 * kc) = o; }
    LDS_WAIT(); asm volatile("" ::: "memory");
}
__device__ __forceinline__ int rope_dim(int p) { const int a = p >> 3, j = p & 7; return j < 4 ? 4 * a + j : 16 + 4 * a + (j - 4); }

#define LDP(i) ((void*)((((unsigned long long)(unsigned)__builtin_amdgcn_readfirstlane((int)(ARGP[i] >> 32))) << 32) | (unsigned long long)(unsigned)__builtin_amdgcn_readfirstlane((int)(unsigned)ARGP[i])))
#define ARGIN(i) ((const void*)LDP(i))
#define P_COS ((GAS float*)(ws + WS_COS))
#define P_SIN ((GAS float*)(ws + WS_SIN))
#define P_SSQ ((GAS float*)(ws + WS_SSQ))
#define P_FLOG ((GAS float*)(ws + WS_FLOG))
#define P_E01 ((GAS int*)(ws + WS_E01))
#define P_G01 ((GAS float*)(ws + WS_G01))
#define P_SLOT ((GAS int*)(ws + WS_SLOT))
#define P_TOKOF ((GAS int*)(ws + WS_TOKOF))
#define P_GATEOF ((GAS float*)(ws + WS_GATEOF))
#define P_CNT ((GAS int*)(ws + WS_CNT))
#define P_TSTART ((GAS int*)(ws + WS_TSTART))
#define P_RSTD ((GAS float*)(ws + WS_RSTD))
#define P_RSTDOF ((GAS float*)(ws + WS_RSTDOF))
#define P_KPE ((GAS bf16*)(ws + WS_KPE))
#define P_KAUG ((GAS bf16*)(ws + WS_KAUG))
#define P_BIASF ((GAS float*)(ws + WS_BIASF))
#define P_NRM ((GAS float*)(ws + WS_NRM))
#define P_WR ((GAS bf16*)(ws + WS_WR))
#define P_XR ((GAS bf16*)(ws + WS_XR))
#define P_OSS ((GAS float*)(ws + WS_OSS))
#define P_RSTDX ((GAS float*)(ws + WS_RSTDX))
#define P_WIN ((GAS bf16*)(ws + WS_WIN))
#define P_WUQ ((GAS bf16*)(ws + WS_WUQ))
#define P_WUKV ((GAS bf16*)(ws + WS_WUKV))
#define P_WOUT ((GAS bf16*)(ws + WS_WOUT))
#define P_WGU_L(ll) ((GAS unsigned char*)(ws + WS_WGU + (size_t)((ll) & 1) * 32 * MiB))
#define P_WD_L(ll) ((GAS unsigned char*)(ws + WS_WD + (size_t)((ll) & 1) * 16 * MiB))
#define P_XN ((GAS bf16*)(ws + WS_XN))
#define P_FQKV ((GAS bf16*)(ws + WS_FQKV))
#define P_HH ((GAS bf16*)(ws + WS_FQKV))
#define P_LAT ((GAS bf16*)(ws + WS_LAT))
#define P_QM ((GAS bf16*)(ws + WS_QM))
#define P_KVM ((GAS bf16*)(ws + WS_KVM))
#define P_Y ((GAS bf16*)(ws + WS_Y))
#define IN(k) (lo <= (k) && (k) < hi_)
#if MK_ONE_LAUNCH
#define GRID_BAR() xcd_barrier(bar)
#else
#define GRID_BAR() do {} while (0)
#endif
#define SEAM(k) do { if (IN(k) && IN((k) + 1)) GRID_BAR(); } while (0)
__device__ __forceinline__ void conv_gu_item(int r, const GAS float* w_gate, const GAS float* w_up, const GAS float* ffn_norm, GAS unsigned char* WGU, LAS float* scr64, int lane) {
    const int e = r / 256, q = r % 256, kb = q / 16, nb = q % 16; const int n0 = nb * 64; const int ct = n0 >> 8, which = (n0 >> 7) & 1, jj = n0 & 127;
    const GAS float* src = (which ? w_up : w_gate) + (size_t)e * DM * DEXP;
    tr_item64_f8(src, DEXP, ffn_norm, WSCALE, WGU + (size_t)e * 1024 * 1024, DM, kb * 64, ct * 128 + jj, n0, scr64, lane);
}
__device__ __forceinline__ void conv_d_item(int r, const GAS float* w_down, GAS unsigned char* WD, LAS float* scr64, int lane) {
    const int e = r / 128, q = r % 128, kb = q / 16, nb = q % 16;
    tr_item64_f8(w_down + (size_t)e * DEXP * DM, DM, nullptr, WSCALE, WD + (size_t)e * 1024 * 512, DEXP, kb * 64, nb * 64, nb * 64, scr64, lane);
}
template <int l>
__device__ __forceinline__ void layer_body(const int lo, const int hi_, LAS unsigned char* lds0, const int wave0, const int G0, const int bx0, const XcdBarrier& bar) {
        const int P = 10 * l;
        if (IN(P)) for (int rep_ = 0; rep_ < (l == 0 ? NREP(0) : 1); ++rep_) {
            unsigned ldsb_ = (unsigned)(uintptr_t)lds0; asm volatile("" : "+s"(ldsb_)); LAS unsigned char* lds = (LAS unsigned char*)(uintptr_t)ldsb_; volatile LAS unsigned* MISC = (volatile LAS unsigned*)(lds + MISC_OFF); volatile LAS unsigned long long* ARGP = (volatile LAS unsigned long long*)(lds + MISC_OFF + 768); (void)MISC; int wave = wave0, G = G0, bx = bx0; asm volatile("" : "+s"(G), "+s"(bx), "+s"(wave)); const int lane = (int)__builtin_amdgcn_mbcnt_hi(~0u, __builtin_amdgcn_mbcnt_lo(~0u, 0u)); const int tid = wave * 64 + lane; const int vcu = (bx % 8) * (G / 8) + bx / 8; const int gw = vcu * 8 + wave, NGW = G * 8; (void)lane; (void)gw; (void)NGW; (void)vcu;
            GAS unsigned char* ws = (GAS unsigned char*)LDP(22); GAS float* out = (GAS float*)LDP(21); const GAS float* x_in = (const GAS float*)ARGIN(0); const GAS int* positions = (const GAS int*)ARGIN(1);
            if (l < NLAYER) {
                LAS float* scr = (LAS float*)(lds + wave * 16640);
                const GAS float* attn_norm = (const GAS float*)ARGIN(2) + (size_t)l * DM; const GAS float* w_in = (const GAS float*)ARGIN(3) + (size_t)l * DM * INW;
                const GAS float* q_norm = (const GAS float*)ARGIN(5) + (size_t)l * 256; const GAS float* w_uq = (const GAS float*)ARGIN(6) + (size_t)l * 256 * 768;
                const GAS float* kv_norm = (const GAS float*)ARGIN(7) + (size_t)l * 128; const GAS float* w_ukv = (const GAS float*)ARGIN(8) + (size_t)l * 128 * 1024;
                const GAS float* mla_on = (const GAS float*)ARGIN(9) + (size_t)l * 512; const GAS float* fox_on = (const GAS float*)ARGIN(10) + (size_t)l * 512; const GAS float* w_out = (const GAS float*)ARGIN(11) + (size_t)l * DM * DM;
                const GAS float* ffn_norm = (const GAS float*)ARGIN(12) + (size_t)l * DM;
                const GAS float* w_gate = (const GAS float*)ARGIN(17) + (size_t)l * NEXP * DM * DEXP; const GAS float* w_up = (const GAS float*)ARGIN(18) + (size_t)l * NEXP * DM * DEXP; const GAS float* w_down = (const GAS float*)ARGIN(19) + (size_t)l * NEXP * DEXP * DM;
                constexpr int I_IN = 16 * 64, I_UQ = 4 * 24, I_UKV = 4 * 32;
                constexpr int NITEMS = I_IN + I_UQ + I_UKV;
                for (int it = gw; it < NITEMS; it += NGW) {
                    int r = it; const int j = lane & 31;
                    if (r < I_IN) { const int kb = r / 64, nb = r % 64; const int n = nb * 32 + j; int sc;
                        if (n < 384) sc = n; else if (n < 416) sc = 384 + rope_dim(n - 384); else if (n < 424) sc = 1952 + (n - 416); else if (n < 512) sc = -1; else sc = 416 + (n - 512);
                        tr_item(w_in, INW, DM, attn_norm, P_WIN, DM, kb * 64, nb * 32, sc, scr, lane); continue; } r -= I_IN;
                    if (r < I_UQ) { const int kb = r / 24, nb = r % 24; const int n = nb * 32 + j; const int hh = n / 96, d = n % 96; const int sc = d < 64 ? n : hh * 96 + 64 + rope_dim(d - 64);
                        tr_item(w_uq, 768, 256, q_norm, P_WUQ, 256, kb * 64, nb * 32, sc, scr, lane); continue; } r -= I_UQ;
                    { const int kb = r / 32, nb = r % 32; tr_item(w_ukv, 1024, 128, kv_norm, P_WUKV, 256, kb * 64, nb * 32, nb * 32 + j, scr, lane); }
                }
                LAS float* scr64 = (LAS float*)(lds + wave * 16640);
                constexpr int J_OUT = 16 * 16, J_GU = 16 * 16 * NEXP, J_D = 8 * 16 * NEXP;
                for (int it = gw; it < J_OUT + (l == 0 ? J_GU + J_D : 0); it += NGW) {
                    int r = it;
                    if (r < J_OUT) { const int kb = r / 16, nb = r % 16; const GAS float* gn = kb < 8 ? mla_on : fox_on - 512; tr_item64(w_out, DM, gn, P_WOUT, DM, kb * 64, nb * 64, nb * 64, scr64, lane); continue; } r -= J_OUT;
                    if (r < J_GU) { conv_gu_item(r, w_gate, w_up, ffn_norm, P_WGU_L(l), scr64, lane); continue; } r -= J_GU;
                    conv_d_item(r, w_down, P_WD_L(l), scr64, lane);
                }
                { const GAS float* w_rg = (const GAS float*)ARGIN(13) + (size_t)l * DM * 4; const GAS float* w_re = (const GAS float*)ARGIN(15) + (size_t)l * DM * 32;
                  for (int idx = bx * 512 + tid; idx < 2 * 48 * 520; idx += G * 512) { const int half = idx / (48 * 520), r = idx % (48 * 520), c = r / 520, kk = r % 520; const int k = half * 512 + kk;
                      float w = 0.f; if (c < 36 && kk < 512) w = ffn_norm[k] * (c < 4 ? w_rg[k * 4 + c] : w_re[k * 32 + (c - 4)]);
                      const unsigned h16 = cvt_pk_bf16(w, 0.f) & 0xffffu; const unsigned l16 = cvt_pk_bf16(w - __uint_as_float(h16 << 16), 0.f) & 0xffffu;
                      P_WR[(size_t)(half * 2 + 0) * 48 * 520 + r] = (bf16)h16; P_WR[(size_t)(half * 2 + 1) * 48 * 520 + r] = (bf16)l16; } }
            }
            const GAS float* fin = (const GAS float*)ARGIN(20);
            for (int mb = gw * 4; mb < NTOK; mb += NGW * 4) {
                f32x4 v[4][4]; int s0[4], s1[4];
                if (l > 0) {
#pragma unroll
                    for (int r = 0; r < 4; ++r) { s0[r] = P_SLOT[2 * (mb + r)]; s1[r] = P_SLOT[2 * (mb + r) + 1]; }
                }
#pragma unroll
                for (int r = 0; r < 4; ++r) {
                    if (l == 0) { const GAS float* xr = x_in + (size_t)(mb + r) * DM;
#pragma unroll
                        for (int j = 0; j < 4; ++j) v[r][j] = __builtin_nontemporal_load((const GAS f32x4*)(xr + 4 * lane + 256 * j)); }
                    else { const GAS bf16* xr = P_XR + (size_t)(mb + r) * DM;
#pragma unroll
                        for (int j = 0; j < 4; ++j) { const u32x2 w = __builtin_nontemporal_load((const GAS u32x2*)(xr + 4 * lane + 256 * j)); v[r][j] = (f32x4){__uint_as_float(w.x << 16), __uint_as_float(w.x & 0xffff0000u), __uint_as_float(w.y << 16), __uint_as_float(w.y & 0xffff0000u)}; } } }
                if (l > 0) {
#pragma unroll
                    for (int r = 0; r < 4; ++r)
#pragma unroll
                        for (int j = 0; j < 4; ++j) { const int a = __builtin_nontemporal_load((const GAS int*)((const GAS unsigned char*)P_Y + (size_t)s0[r] * 1024 + 4 * lane + 256 * j)), c = __builtin_nontemporal_load((const GAS int*)((const GAS unsigned char*)P_Y + (size_t)s1[r] * 1024 + 4 * lane + 256 * j));
                            const f32x2 a0 = __builtin_amdgcn_cvt_pk_f32_fp8(a, false), a1 = __builtin_amdgcn_cvt_pk_f32_fp8(a, true), c0 = __builtin_amdgcn_cvt_pk_f32_fp8(c, false), c1 = __builtin_amdgcn_cvt_pk_f32_fp8(c, true);
                            v[r][j][0] += (a0[0] + c0[0]) * WSCALE_INV; v[r][j][1] += (a0[1] + c0[1]) * WSCALE_INV; v[r][j][2] += (a1[0] + c1[0]) * WSCALE_INV; v[r][j][3] += (a1[1] + c1[1]) * WSCALE_INV; }
                }
                float ss[4];
#pragma unroll
                for (int r = 0; r < 4; ++r) { float s = 0.f;
#pragma unroll
                    for (int j = 0; j < 4; ++j) s += (v[r][j][0] * v[r][j][0] + v[r][j][1] * v[r][j][1]) + (v[r][j][2] * v[r][j][2] + v[r][j][3] * v[r][j][3]);
                    ss[r] = s; }
#pragma unroll
                for (int o = 1; o < 64; o <<= 1) {
#pragma unroll
                    for (int r = 0; r < 4; ++r) ss[r] += __shfl_xor(ss[r], o); }
#pragma unroll
                for (int r = 0; r < 4; ++r) { const int m = mb + r; const float rstd = rsqrtf(ss[r] * (1.f / DM) + EPS);
                    if (l < NLAYER) {
#pragma unroll
                        for (int j = 0; j < 4; ++j) { u32x2 w; w.x = cvt_pk_bf16(v[r][j][0], v[r][j][1]); w.y = cvt_pk_bf16(v[r][j][2], v[r][j][3]); *(GAS u32x2*)(P_XR + (size_t)m * DM + 4 * lane + 256 * j) = w; }
                        if (lane == 0) P_RSTDX[m] = rstd;
                    } else {
#pragma unroll
                        for (int j = 0; j < 4; ++j) { const f32x4 g = *(const GAS f32x4*)(fin + 4 * lane + 256 * j); __builtin_nontemporal_store(v[r][j] * rstd * g, (GAS f32x4*)(out + (size_t)m * DM + 4 * lane + 256 * j)); }
                    }
                }
            }
        }
        if constexpr (l == NLAYER) return;
        SEAM(P);
        if (IN(P + 1)) for (int rep_ = 0; rep_ < ((l == 0 || 1 != 5) ? NREP(1) : 1); ++rep_) {
            unsigned ldsb_ = (unsigned)(uintptr_t)lds0; asm volatile("" : "+s"(ldsb_)); LAS unsigned char* lds = (LAS unsigned char*)(uintptr_t)ldsb_; volatile LAS unsigned* MISC = (volatile LAS unsigned*)(lds + MISC_OFF); volatile LAS unsigned long long* ARGP = (volatile LAS unsigned long long*)(lds + MISC_OFF + 768); (void)MISC; int wave = wave0, G = G0, bx = bx0; asm volatile("" : "+s"(G), "+s"(bx), "+s"(wave)); const int lane = (int)__builtin_amdgcn_mbcnt_hi(~0u, __builtin_amdgcn_mbcnt_lo(~0u, 0u)); const int tid = wave * 64 + lane; const int vcu = (bx % 8) * (G / 8) + bx / 8; const int gw = vcu * 8 + wave, NGW = G * 8; (void)lane; (void)gw; (void)NGW; (void)vcu;
            GAS unsigned char* ws = (GAS unsigned char*)LDP(22); GAS float* out = (GAS float*)LDP(21); const GAS float* x_in = (const GAS float*)ARGIN(0); (void)out; (void)x_in; (void)ws;
            DenseOrder S{NTOK / 256, INP / 256, (NTOK / 256) * (INP / 256), G, bx, (const GAS char*)P_XR, (const GAS char*)P_WIN, (size_t)256 * DM * 2, (size_t)256 * DM * 2};
            EpiWin E{P_LAT, P_FQKV, P_KPE, P_FLOG, P_SSQ, P_COS, P_SIN, P_RSTDX};
            pg8::gemm_phase<EpiWin, DenseOrder, true, false>(tid, lds, DM * 2, DM * 2, DM * 2, S, E, nullptr);
        }
        SEAM(P + 1);
        if (IN(P + 2)) for (int rep_ = 0; rep_ < ((l == 0 || 2 != 5) ? NREP(2) : 1); ++rep_) {
            unsigned ldsb_ = (unsigned)(uintptr_t)lds0; asm volatile("" : "+s"(ldsb_)); LAS unsigned char* lds = (LAS unsigned char*)(uintptr_t)ldsb_; volatile LAS unsigned* MISC = (volatile LAS unsigned*)(lds + MISC_OFF); volatile LAS unsigned long long* ARGP = (volatile LAS unsigned long long*)(lds + MISC_OFF + 768); (void)MISC; int wave = wave0, G = G0, bx = bx0; asm volatile("" : "+s"(G), "+s"(bx), "+s"(wave)); const int lane = (int)__builtin_amdgcn_mbcnt_hi(~0u, __builtin_amdgcn_mbcnt_lo(~0u, 0u)); const int tid = wave * 64 + lane; const int vcu = (bx % 8) * (G / 8) + bx / 8; const int gw = vcu * 8 + wave, NGW = G * 8; (void)lane; (void)gw; (void)NGW; (void)vcu;
            GAS unsigned char* ws = (GAS unsigned char*)LDP(22); GAS float* out = (GAS float*)LDP(21); const GAS float* x_in = (const GAS float*)ARGIN(0); (void)out; (void)x_in; (void)ws;
            {
                const int sq = vcu >> 1, hf = vcu & 1; const int b = sq >> 3, h = sq & 7; const float bf = ((const GAS float*)ARGIN(4))[l * 8 + h];
                const GAS float* fl = P_FLOG + ((size_t)b * SEQ + hf * 1024 + 2 * tid) * 8 + h;
                float lf[2], lg[2] = {0.f, 0.f};
#pragma unroll
                for (int e = 0; e < 2; ++e) { const float f = fl[e * 8] + bf; lf[e] = fminf(f, 0.f) - log1pf(expf(-fabsf(f))); }
                if (hf) {
#pragma unroll
                    for (int e = 0; e < 2; ++e) { const float f = fl[e * 8 - 1024 * 8] + bf; lg[e] = fminf(f, 0.f) - log1pf(expf(-fabsf(f))); } }
                const double s2 = (double)lf[0] + (double)lf[1];
                double incl = s2, first = (double)lg[0] + (double)lg[1];
#pragma unroll
                for (int o = 1; o < 64; o <<= 1) { const double t = __shfl_up(incl, o); if (lane >= o) incl += t; first += __shfl_xor(first, o); }
                LAS double* wtot = (LAS double*)lds;
                if (lane == 63) wtot[wave] = incl;
                if (lane == 0) wtot[8 + wave] = first;
                __syncthreads();
                double c = incl - s2;
                for (int w = 0; w < wave; ++w) c += wtot[w];
                if (hf) { for (int w = 0; w < 8; ++w) c += wtot[8 + w]; }
                const size_t t0 = ((size_t)b * 8 + h) * SEQ + hf * 1024 + 2 * tid;
                GAS u32x4* ka = (GAS u32x4*)(P_KAUG + t0 * 8);
#pragma unroll
                for (int e = 0; e < 2; ++e) { c += (double)lf[e]; const float x = (float)(-c * 1.4426950408889634);
                    const unsigned h16 = cvt_pk_bf16(x, 0.f) & 0xffffu; const float r1 = x - __uint_as_float(h16 << 16); const unsigned m16 = cvt_pk_bf16(r1, 0.f) & 0xffffu; const float r2 = r1 - __uint_as_float(m16 << 16); const unsigned l16 = cvt_pk_bf16(r2, 0.f) & 0xffffu;
                    ka[e] = (u32x4){h16 | (m16 << 16), l16, 0u, 0u}; P_BIASF[t0 + e] = x; }
                float qn = 0.f, kn = 0.f;
                { const GAS bf16* fqp = P_FQKV + ((size_t)b * SEQ + hf * 1024 + 2 * tid) * 512 + h * 64; const GAS bf16* fkp = fqp + (size_t)NTOK * 512;
#pragma unroll
                  for (int e = 0; e < 2; ++e) { float sq_ = 0.f, sk = 0.f;
#pragma unroll
                      for (int c8 = 0; c8 < 8; ++c8) { const u32x4 a = *(const GAS u32x4*)(fqp + e * 512 + c8 * 8), k4 = *(const GAS u32x4*)(fkp + e * 512 + c8 * 8);
#pragma unroll
                          for (int j = 0; j < 4; ++j) { const float a0 = __uint_as_float(a[j] << 16), a1 = __uint_as_float(a[j] & 0xffff0000u), k0 = __uint_as_float(k4[j] << 16), k1 = __uint_as_float(k4[j] & 0xffff0000u);
                              sq_ += a0 * a0 + a1 * a1; sk += k0 * k0 + k1 * k1; } }
                      qn = fmaxf(qn, sq_); kn = fmaxf(kn, sk); } }
#pragma unroll
                for (int o = 1; o < 64; o <<= 1) { qn = fmaxf(qn, __shfl_xor(qn, o)); kn = fmaxf(kn, __shfl_xor(kn, o)); }
                LAS float* knw = (LAS float*)(lds + 256);
                if (lane == 0) { knw[wave] = kn; knw[8 + wave] = qn; }
                __syncthreads();
                if (tid < 4) P_NRM[sq * 16 + hf * 4 + tid] = sqrtf(fmaxf(knw[8 + 2 * tid], knw[8 + 2 * tid + 1]));
                if (tid == 4) { float m = knw[0]; for (int w = 1; w < 8; ++w) m = fmaxf(m, knw[w]); P_NRM[sq * 16 + 8 + hf] = sqrtf(m); }
                __syncthreads();
            }
            UpOrder S{G, vcu, (const GAS char*)P_LAT, (const GAS char*)P_WUQ, (const GAS char*)P_WUKV};
            EpiUp E{P_QM, P_KVM, P_SSQ, P_COS, P_SIN};
            pg8::gemm_phase<EpiUp, UpOrder, true, false>(tid, lds, 256 * 2, 512 * 2, 256 * 2, S, E, nullptr);
        }
        SEAM(P + 2);
        if (IN(P + 3)) for (int rep_ = 0; rep_ < ((l == 0 || 3 != 5) ? NREP(3) : 1); ++rep_) {
            unsigned ldsb_ = (unsigned)(uintptr_t)lds0; asm volatile("" : "+s"(ldsb_)); LAS unsigned char* lds = (LAS unsigned char*)(uintptr_t)ldsb_; volatile LAS unsigned* MISC = (volatile LAS unsigned*)(lds + MISC_OFF); volatile LAS unsigned long long* ARGP = (volatile LAS unsigned long long*)(lds + MISC_OFF + 768); (void)MISC; int wave = wave0, G = G0, bx = bx0; asm volatile("" : "+s"(G), "+s"(bx), "+s"(wave)); const int lane = (int)__builtin_amdgcn_mbcnt_hi(~0u, __builtin_amdgcn_mbcnt_lo(~0u, 0u)); const int tid = wave * 64 + lane; const int vcu = (bx % 8) * (G / 8) + bx / 8; const int gw = vcu * 8 + wave, NGW = G * 8; (void)lane; (void)gw; (void)NGW; (void)vcu;
            GAS unsigned char* ws = (GAS unsigned char*)LDP(22); GAS float* out = (GAS float*)LDP(21); const GAS float* x_in = (const GAS float*)ARGIN(0); (void)out; (void)x_in; (void)ws;
            GAS bf16* O = P_XN;
            const int b = vcu >> 4, hh = (vcu & 15) >> 1, sub = vcu & 1;
            const att::Tens2 TM{P_QM, 768, P_KVM, 1024, P_KPE, P_KVM + 64, 1024, O, nullptr, nullptr, P_OSS};
            const att::Tens2 TF{P_FQKV, 512, P_FQKV + (size_t)NTOK * 512, 512, P_KAUG, P_FQKV + (size_t)2 * NTOK * 512, 512, O, P_BIASF, P_NRM, P_OSS};
#define QB_OF(i) ((((i) & 1) ? 7 - (2 * sub + ((i) >> 1)) : (2 * sub + ((i) >> 1))))
            int ts0, ts1, ts2, ts3;
            { const GAS float* bs = P_BIASF + ((long)b * 8 + hh) * SEQ; const GAS float* nr = P_NRM + (b * 8 + hh) * 16; const float kmx = fmaxf(nr[8], nr[9]);
#define FOX_TS(i, dst) do { const int qb_ = QB_OF(i), NT_ = 4 * qb_ + 4; const float Z_ = nr[qb_] * kmx * 1.001f + 0.01f; const float bend_ = bs[(lane < NT_ ? lane : NT_ - 1) * 64 + 63]; \
                  const bool skip_ = (lane < NT_ - 4) && (2.f * Z_ + bend_ - bs[qb_ * 256] < -40.f); dst = __builtin_popcountll(__ballot(skip_)); } while (0)
              FOX_TS(0, ts0); FOX_TS(1, ts1); FOX_TS(2, ts2); FOX_TS(3, ts3);
#undef FOX_TS
            }
            bf16x8 qreg[6];
            { int sb = 0; for (int i = 0; i < 4; ++i) sb = att::attn_unit2<1>(wave, b, hh, QB_OF(i), TM, (LAS char*)lds, sb, i > 0, i < 3 ? QB_OF(i + 1) : -1, qreg, 0); }
            { int sb = 0; for (int i = 0; i < 4; ++i) { const int ts = i == 0 ? ts0 : i == 1 ? ts1 : i == 2 ? ts2 : ts3; sb = att::attn_unit2<0>(wave, b, hh, QB_OF(i), TF, (LAS char*)lds, sb, i > 0, i < 3 ? QB_OF(i + 1) : -1, qreg, ts); } }
#undef QB_OF
        }
        SEAM(P + 3);
        if (IN(P + 5)) for (int rep_ = 0; rep_ < ((l == 0 || 5 != 5) ? NREP(5) : 1); ++rep_) {
            unsigned ldsb_ = (unsigned)(uintptr_t)lds0; asm volatile("" : "+s"(ldsb_)); LAS unsigned char* lds = (LAS unsigned char*)(uintptr_t)ldsb_; volatile LAS unsigned* MISC = (volatile LAS unsigned*)(lds + MISC_OFF); volatile LAS unsigned long long* ARGP = (volatile LAS unsigned long long*)(lds + MISC_OFF + 768); (void)MISC; int wave = wave0, G = G0, bx = bx0; asm volatile("" : "+s"(G), "+s"(bx), "+s"(wave)); const int lane = (int)__builtin_amdgcn_mbcnt_hi(~0u, __builtin_amdgcn_mbcnt_lo(~0u, 0u)); const int tid = wave * 64 + lane; const int vcu = (bx % 8) * (G / 8) + bx / 8; const int gw = vcu * 8 + wave, NGW = G * 8; (void)lane; (void)gw; (void)NGW; (void)vcu;
            GAS unsigned char* ws = (GAS unsigned char*)LDP(22); GAS float* out = (GAS float*)LDP(21); const GAS float* x_in = (const GAS float*)ARGIN(0); (void)out; (void)x_in; (void)ws;
            DenseOrder S{NTOK / 256, DM / 256, (NTOK / 256) * (DM / 256), G, bx, (const GAS char*)P_XN, (const GAS char*)P_WOUT, (size_t)256 * DM * 2, (size_t)256 * DM * 2};
            EpiOut<false> E{x_in, P_XR};
            LAS f32x2* scl = (LAS f32x2*)(lds + pg8::STAGE_BYTES);
            { Unit u_; if (S.next(tid >> 8, u_)) { const GAS float* op = P_OSS + ((size_t)u_.pm * 256 + (tid & 255)) * 16;
                  const f32x4 a0 = *(const GAS f32x4*)op, a1 = *(const GAS f32x4*)(op + 4), c0 = *(const GAS f32x4*)(op + 8), c1 = *(const GAS f32x4*)(op + 12);
                  const float sm = ((a0[0] + a0[1]) + (a0[2] + a0[3])) + ((a1[0] + a1[1]) + (a1[2] + a1[3])), sf = ((c0[0] + c0[1]) + (c0[2] + c0[3])) + ((c1[0] + c1[1]) + (c1[2] + c1[3]));
                  const float rm_ = rsqrtf(sm * (1.f / 512.f) + EPS), rf_ = rsqrtf(sf * (1.f / 512.f) + EPS);
                  scl[tid] = (f32x2){rm_ / rf_, rf_}; } }
            __syncthreads();
            pg8::gemm_phase<EpiOut<false>, DenseOrder, true, false, false, true>(tid, lds, DM * 2, DM * 2, DM * 2, S, E, nullptr, scl);
        }
        SEAM(P + 5);
        if (IN(P + 6)) for (int rep_ = 0; rep_ < ((l == 0 || 6 != 5) ? NREP(6) : 1); ++rep_) {
            unsigned ldsb_ = (unsigned)(uintptr_t)lds0; asm volatile("" : "+s"(ldsb_)); LAS unsigned char* lds = (LAS unsigned char*)(uintptr_t)ldsb_; volatile LAS unsigned* MISC = (volatile LAS unsigned*)(lds + MISC_OFF); volatile LAS unsigned long long* ARGP = (volatile LAS unsigned long long*)(lds + MISC_OFF + 768); (void)MISC; int wave = wave0, G = G0, bx = bx0; asm volatile("" : "+s"(G), "+s"(bx), "+s"(wave)); const int lane = (int)__builtin_amdgcn_mbcnt_hi(~0u, __builtin_amdgcn_mbcnt_lo(~0u, 0u)); const int tid = wave * 64 + lane; const int vcu = (bx % 8) * (G / 8) + bx / 8; const int gw = vcu * 8 + wave, NGW = G * 8; (void)lane; (void)gw; (void)NGW; (void)vcu;
            GAS unsigned char* ws = (GAS unsigned char*)LDP(22); GAS float* out = (GAS float*)LDP(21); const GAS float* x_in = (const GAS float*)ARGIN(0); (void)out; (void)x_in; (void)ws;
            GAS bf16* H2 = P_XN;
            LAS bf16* WT = (LAS bf16*)lds;
            LAS float* LG = (LAS float*)(lds + 99840) + wave * 576;
            const GAS float* b_rg = (const GAS float*)ARGIN(14) + l * 4; const GAS float* b_re = (const GAS float*)ARGIN(16) + l * 32;
            if (tid < 32) MISC[64 + tid] = 0u;
            const int r16 = lane & 15, g4 = lane >> 4;
            const int m0 = vcu * 128 + wave * 16;
            const GAS bf16* xrow = P_XR + (size_t)(m0 + r16) * DM + 8 * g4;
            GAS unsigned char* hrow = (GAS unsigned char*)H2 + (size_t)(m0 + r16) * DM + 8 * g4;
            f32x4 acc3[3]; acc3[0] = (f32x4){0.f, 0.f, 0.f, 0.f}; acc3[1] = acc3[0]; acc3[2] = acc3[0];
            float ssq = 0.f;
            for (int half = 0; half < 2; ++half) {
                __syncthreads();
                for (int idx = tid; idx < 2 * 48 * 520 / 8; idx += 512) *(LAS u32x4*)(WT + 8 * idx) = *(const GAS u32x4*)(P_WR + (size_t)half * 2 * 48 * 520 + 8 * idx);
                __syncthreads();
                for (int s8 = 0; s8 < 16; s8 += 8) {
                    bf16x8 xv[8];
#pragma unroll
                    for (int u = 0; u < 8; ++u) xv[u] = *(const GAS bf16x8*)(xrow + half * 512 + 32 * (s8 + u));
#pragma unroll
                    for (int u = 0; u < 8; ++u) {
                        const u32x4 xw = __builtin_bit_cast(u32x4, xv[u]); float xf[8];
#pragma unroll
                        for (int j = 0; j < 4; ++j) { xf[2 * j] = __uint_as_float(xw[j] << 16); xf[2 * j + 1] = __uint_as_float(xw[j] & 0xffff0000u); }
                        u32x2 hw; hw.x = pk4_fp8(xf[0], xf[1], xf[2], xf[3]); hw.y = pk4_fp8(xf[4], xf[5], xf[6], xf[7]); *(GAS u32x2*)(hrow + half * 512 + 32 * (s8 + u)) = hw;
#pragma unroll
                        for (int j = 0; j < 8; ++j) ssq += xf[j] * xf[j];
                        const LAS bf16* wk = WT + r16 * 520 + 32 * (s8 + u) + 8 * g4;
#pragma unroll
                        for (int ct = 0; ct < 3; ++ct) { const bf16x8 bh = *(const LAS bf16x8*)(wk + ct * 16 * 520), bl = *(const LAS bf16x8*)(wk + (48 + ct * 16) * 520);
                            acc3[ct] = __builtin_amdgcn_mfma_f32_16x16x32_bf16(xv[u], bh, acc3[ct], 0, 0, 0); acc3[ct] = __builtin_amdgcn_mfma_f32_16x16x32_bf16(xv[u], bl, acc3[ct], 0, 0, 0); }
                    }
                }
            }
            ssq += __shfl_xor(ssq, 16); ssq += __shfl_xor(ssq, 32);
            const float rstd = rsqrtf(ssq * (1.f / DM) + EPS);
#pragma unroll
            for (int ct = 0; ct < 3; ++ct) { const int c = 16 * ct + r16; if (c < 36) {
#pragma unroll
                for (int rg = 0; rg < 4; ++rg) LG[(4 * g4 + rg) * 36 + c] = acc3[ct][rg]; } }
            LDS_WAIT();
            if (lane < 16) {
                const int m = m0 + lane; const LAS float* lg = LG + lane * 36;
                float gl[4];
#pragma unroll
                for (int g = 0; g < 4; ++g) gl[g] = lg[g] * rstd + b_rg[g];
                int gi = 0; float gm = gl[0];
#pragma unroll
                for (int g = 1; g < 4; ++g) if (gl[g] > gm) { gm = gl[g]; gi = g; }
                float gs = 0.f;
#pragma unroll
                for (int g = 0; g < 4; ++g) gs += __expf(gl[g] - gm);
                const float gval = 1.f / gs;
                float el[8];
#pragma unroll
                for (int j = 0; j < 8; ++j) el[j] = lg[4 + 8 * gi + j] * rstd + b_re[8 * gi + j];
                int i0 = 0; float mx0 = el[0];
#pragma unroll
                for (int j = 1; j < 8; ++j) if (el[j] > mx0) { mx0 = el[j]; i0 = j; }
                int i1 = -1; float mx1 = -INFINITY;
#pragma unroll
                for (int j = 0; j < 8; ++j) if (j != i0 && el[j] > mx1) { mx1 = el[j]; i1 = j; }
                const float e1 = __expf(mx1 - mx0); const float g0 = gval / (1.f + e1), g1 = gval * e1 / (1.f + e1);
                const int ea = gi * 8 + i0, eb = gi * 8 + i1; P_E01[2 * m] = ea; P_E01[2 * m + 1] = eb; P_G01[2 * m] = g0; P_G01[2 * m + 1] = g1; P_RSTD[m] = rstd;
                __hip_atomic_fetch_add((LAS unsigned*)(lds + MISC_OFF) + 64 + ea, 1u, __ATOMIC_RELAXED, __HIP_MEMORY_SCOPE_WORKGROUP); __hip_atomic_fetch_add((LAS unsigned*)(lds + MISC_OFF) + 64 + eb, 1u, __ATOMIC_RELAXED, __HIP_MEMORY_SCOPE_WORKGROUP);
            }
            __syncthreads();
            if (tid < 32) P_CNT[vcu * 32 + tid] = (int)MISC[64 + tid];
        }
        SEAM(P + 6);
        if (IN(P + 7)) for (int rep_ = 0; rep_ < ((l == 0 || 7 != 5) ? NREP(7) : 1); ++rep_) {
            unsigned ldsb_ = (unsigned)(uintptr_t)lds0; asm volatile("" : "+s"(ldsb_)); LAS unsigned char* lds = (LAS unsigned char*)(uintptr_t)ldsb_; volatile LAS unsigned* MISC = (volatile LAS unsigned*)(lds + MISC_OFF); volatile LAS unsigned long long* ARGP = (volatile LAS unsigned long long*)(lds + MISC_OFF + 768); (void)MISC; int wave = wave0, G = G0, bx = bx0; asm volatile("" : "+s"(G), "+s"(bx), "+s"(wave)); const int lane = (int)__builtin_amdgcn_mbcnt_hi(~0u, __builtin_amdgcn_mbcnt_lo(~0u, 0u)); const int tid = wave * 64 + lane; const int vcu = (bx % 8) * (G / 8) + bx / 8; const int gw = vcu * 8 + wave, NGW = G * 8; (void)lane; (void)gw; (void)NGW; (void)vcu;
            GAS unsigned char* ws = (GAS unsigned char*)LDP(22); GAS float* out = (GAS float*)LDP(21); const GAS float* x_in = (const GAS float*)ARGIN(0); (void)out; (void)x_in; (void)ws;
            LAS int* cnt_all = (LAS int*)lds;
            LAS int* pre_e = (LAS int*)(lds + 32768);
            LAS int* tot_e = pre_e + 32;
            LAS int* pst = pre_e + 64;
            LAS int* eL = pre_e + 128;
            for (int i = tid; i < 256 * 32; i += 512) cnt_all[i] = P_CNT[i];
            if (tid < 256) eL[tid] = P_E01[vcu * 256 + tid];
            __syncthreads();
            { LAS int* part = pre_e + 512;
              const int e = tid & 31, p = tid >> 5; int pre = 0, tot = 0;
#pragma unroll
              for (int j = 0; j < 16; ++j) { const int w = p * 16 + j; const int c = cnt_all[w * 32 + e]; pre += (w < vcu) ? c : 0; tot += c; }
              part[(p * 2) * 32 + e] = pre; part[(p * 2 + 1) * 32 + e] = tot; }
            __syncthreads();
            if (tid < 32) { LAS int* part = pre_e + 512; int pre = 0, tot = 0;
#pragma unroll
                for (int p = 0; p < 16; ++p) { pre += part[(p * 2) * 32 + tid]; tot += part[(p * 2 + 1) * 32 + tid]; } pre_e[tid] = pre; tot_e[tid] = tot; }
            __syncthreads();
            if (tid == 0) { int acc = 0; for (int e = 0; e < 32; ++e) { pst[e] = acc; acc += (tot_e[e] + 255) / 256 * 256; } pst[32] = acc; }
            __syncthreads();
            if (vcu == 0 && tid <= 32) P_TSTART[tid] = pst[tid] / 256;
            { LAS int* hist = pre_e + 2048;
              if (tid < 128) hist[tid] = 0;
              __syncthreads();
              int e = 0, rin = 0;
              if (tid < 256) { e = eL[tid]; unsigned long long mym = 0ull;
                  for (int x = 0; x < 32; ++x) { const unsigned long long bm = __ballot(e == x); if (e == x) mym = bm; }
                  rin = __builtin_popcountll(mym & ((1ull << lane) - 1ull));
                  if (rin == 0) hist[wave * 32 + e] = __builtin_popcountll(mym); }
              __syncthreads();
              if (tid < 256) { int r = rin; for (int w = 0; w < wave; ++w) r += hist[w * 32 + e];
                  const int slot = pst[e] + pre_e[e] + r; const int tok = vcu * 128 + (tid >> 1);
                  P_SLOT[vcu * 256 + tid] = slot; P_TOKOF[slot] = tok; P_GATEOF[slot] = P_G01[vcu * 256 + tid]; P_RSTDOF[slot] = P_RSTD[tok]; } }
            if (vcu < 32) { const int e = vcu; for (int s = pst[e] + tot_e[e] + tid; s < pst[e + 1]; s += 512) { P_TOKOF[s] = 0; P_GATEOF[s] = 0.f; P_RSTDOF[s] = 0.f; } }
            __syncthreads();
        }
        SEAM(P + 7);
        if (IN(P + 8)) for (int rep_ = 0; rep_ < ((l == 0 || 8 != 5) ? NREP(8) : 1); ++rep_) {
            unsigned ldsb_ = (unsigned)(uintptr_t)lds0; asm volatile("" : "+s"(ldsb_)); LAS unsigned char* lds = (LAS unsigned char*)(uintptr_t)ldsb_; volatile LAS unsigned* MISC = (volatile LAS unsigned*)(lds + MISC_OFF); volatile LAS unsigned long long* ARGP = (volatile LAS unsigned long long*)(lds + MISC_OFF + 768); (void)MISC; int wave = wave0, G = G0, bx = bx0; asm volatile("" : "+s"(G), "+s"(bx), "+s"(wave)); const int lane = (int)__builtin_amdgcn_mbcnt_hi(~0u, __builtin_amdgcn_mbcnt_lo(~0u, 0u)); const int tid = wave * 64 + lane; const int vcu = (bx % 8) * (G / 8) + bx / 8; const int gw = vcu * 8 + wave, NGW = G * 8; (void)lane; (void)gw; (void)NGW; (void)vcu;
            GAS unsigned char* ws = (GAS unsigned char*)LDP(22); GAS float* out = (GAS float*)LDP(21); const GAS float* x_in = (const GAS float*)ARGIN(0); (void)out; (void)x_in; (void)ws;
            volatile LAS int* TS = (volatile LAS int*)(MISC + 128);
            if (tid <= 32) TS[tid] = P_TSTART[tid];
            __syncthreads();
            MoeOrder S{G, vcu, TS, (const GAS char*)P_XN, (const GAS char*)P_WGU_L(l), 0, (size_t)1024 * 1024, (size_t)256 * 1024};
            EpiGU E{(GAS unsigned char*)P_HH, P_RSTDOF};
            pg8::gemm_phase<EpiGU, MoeOrder, true, true, true>(tid, lds, DM, DM, DM, S, E, P_TOKOF);
            if constexpr (l + 1 < NLAYER) {
                const int U = (int)TS[32] * 4, rem = U & 255; const int nidle = rem ? 256 - rem : 256, rk = rem ? vcu - rem : vcu;
                if (rk >= 0) { LAS float* scr64 = (LAS float*)(lds + wave * 16640);
                    const GAS float* w_gate = (const GAS float*)ARGIN(17) + (size_t)(l + 1) * NEXP * DM * DEXP; const GAS float* w_up = (const GAS float*)ARGIN(18) + (size_t)(l + 1) * NEXP * DM * DEXP; const GAS float* ffn1 = (const GAS float*)ARGIN(12) + (size_t)(l + 1) * DM;
                    for (int it = rk * 8 + wave; it < 16 * 16 * NEXP; it += nidle * 8) conv_gu_item(it, w_gate, w_up, ffn1, P_WGU_L(l + 1), scr64, lane); }
            }
        }
        SEAM(P + 8);
        if (IN(P + 9)) for (int rep_ = 0; rep_ < ((l == 0 || 9 != 5) ? NREP(9) : 1); ++rep_) {
            unsigned ldsb_ = (unsigned)(uintptr_t)lds0; asm volatile("" : "+s"(ldsb_)); LAS unsigned char* lds = (LAS unsigned char*)(uintptr_t)ldsb_; volatile LAS unsigned* MISC = (volatile LAS unsigned*)(lds + MISC_OFF); volatile LAS unsigned long long* ARGP = (volatile LAS unsigned long long*)(lds + MISC_OFF + 768); (void)MISC; int wave = wave0, G = G0, bx = bx0; asm volatile("" : "+s"(G), "+s"(bx), "+s"(wave)); const int lane = (int)__builtin_amdgcn_mbcnt_hi(~0u, __builtin_amdgcn_mbcnt_lo(~0u, 0u)); const int tid = wave * 64 + lane; const int vcu = (bx % 8) * (G / 8) + bx / 8; const int gw = vcu * 8 + wave, NGW = G * 8; (void)lane; (void)gw; (void)NGW; (void)vcu;
            GAS unsigned char* ws = (GAS unsigned char*)LDP(22); GAS float* out = (GAS float*)LDP(21); const GAS float* x_in = (const GAS float*)ARGIN(0); (void)out; (void)x_in; (void)ws;
            volatile LAS int* TS = (volatile LAS int*)(MISC + 128);
            if (tid <= 32) TS[tid] = P_TSTART[tid];
            __syncthreads();
            MoeOrder S{G, vcu, TS, (const GAS char*)P_HH, (const GAS char*)P_WD_L(l), (size_t)256 * 512, (size_t)1024 * 512, (size_t)256 * 512};
            EpiDown E{(GAS unsigned char*)P_Y, P_GATEOF};
            pg8::gemm_phase<EpiDown, MoeOrder, true, false, true>(tid, lds, DEXP, DEXP, DEXP, S, E, nullptr);
            if constexpr (l + 1 < NLAYER) {
                const int U = (int)TS[32] * 4, rem = U & 255; const int nidle = rem ? 256 - rem : 256, rk = rem ? vcu - rem : vcu;
                if (rk >= 0) { LAS float* scr64 = (LAS float*)(lds + wave * 16640);
                    const GAS float* w_down = (const GAS float*)ARGIN(19) + (size_t)(l + 1) * NEXP * DEXP * DM;
                    for (int it = rk * 8 + wave; it < 8 * 16 * NEXP; it += nidle * 8) conv_d_item(it, w_down, P_WD_L(l + 1), scr64, lane); }
            }
        }
        SEAM(P + 9);
}

__global__ void __launch_bounds__(512, 2) fwd(Args args) {
    extern __shared__ __attribute__((aligned(16))) unsigned char lds_raw[];
    LAS unsigned char* lds0 = (LAS unsigned char*)lds_raw;
    const int tid0 = threadIdx.x; const int wave0 = __builtin_amdgcn_readfirstlane(tid0 >> 6);
    const int G0 = gridDim.x; const int bx0 = blockIdx.x;
    { volatile LAS unsigned* MISC = (volatile LAS unsigned*)(lds0 + MISC_OFF); const int tid = tid0;
    for (int u = tid; u < 256; u += 512) MISC[u] = 0u;
    __syncthreads();
    volatile LAS unsigned long long* ARGP = (volatile LAS unsigned long long*)(lds0 + MISC_OFF + 768);
    if (tid < 21) ARGP[tid] = (unsigned long long)args.in[tid];
    if (tid == 21) ARGP[21] = (unsigned long long)args.out;
    if (tid == 22) ARGP[22] = (unsigned long long)args.ws;
    __syncthreads(); }
#if MK_ONE_LAUNCH
    XcdBarrier bar = xcd_barrier_post((unsigned*)(args.ws + WS_CTL) + CW_BAR, (volatile LAS unsigned*)(lds0 + MISC_OFF) + 8);
#else
    XcdBarrier bar; bar.bar = nullptr; bar.x = 0; bar.st = nullptr;
#endif
    const int lo = args.ph_lo, hi_ = args.ph_hi;
    if (IN(0)) {
        const GAS int* positions = (const GAS int*)args.in[1]; GAS float* COSp = (GAS float*)(args.ws + WS_COS); GAS float* SINp = (GAS float*)(args.ws + WS_SIN);
        for (int i = bx0 * 512 + tid0; i < NTOK * 16; i += G0 * 512) { const int tk = i >> 4, fi = i & 15;
            const double invrev = exp2(-(double)fi * (13.287712379549449 / 16.0)) * 0.15915494309189535; const double rev = (double)positions[tk] * invrev; const float fr = (float)(rev - rint(rev));
            COSp[i] = __builtin_amdgcn_cosf(fr); SINp[i] = __builtin_amdgcn_sinf(fr); }
    }
    layer_body<0>(lo, hi_, lds0, wave0, G0, bx0, bar);
    layer_body<1>(lo, hi_, lds0, wave0, G0, bx0, bar);
    layer_body<2>(lo, hi_, lds0, wave0, G0, bx0, bar);
}

extern "C" void kernel_launch(void* const* d_in, const int* in_sizes, int n_in, void* d_out, int out_size, void* d_ws, size_t ws_size, hipStream_t stream) {
    static int grid = 0;
    if (grid == 0) {
        if (n_in != 21 || out_size != NTOK * DM || ws_size < WS_END) { fprintf(stderr, "kernel_launch: unexpected shapes (n_in %d out %d ws %zu)\n", n_in, out_size, ws_size); grid = -1; return; }
        int dev = 0, cus = 0;
        if (hipGetDevice(&dev) != hipSuccess || hipDeviceGetAttribute(&cus, hipDeviceAttributeMultiprocessorCount, dev) != hipSuccess) { grid = -1; return; }
        if (hipFuncSetAttribute((const void*)fwd, hipFuncAttributeMaxDynamicSharedMemorySize, LDS_BYTES) != hipSuccess) { fprintf(stderr, "kernel_launch: hipFuncSetAttribute failed\n"); grid = -1; return; }
        int per_cu = 0;
        if (hipOccupancyMaxActiveBlocksPerMultiprocessor(&per_cu, (const void*)fwd, 512, LDS_BYTES) != hipSuccess || per_cu < 1) fprintf(stderr, "kernel_launch: occupancy query says %d\n", per_cu);
        (void)hipGetLastError();
        grid = cus;
        if (grid != 256) { fprintf(stderr, "kernel_launch: built for 256 CUs, got %d\n", grid); grid = -1; return; }
    }
    if (grid < 0) return;
    if (hipMemsetAsync((char*)d_ws + WS_CTL, 0, CTL_ZERO_BYTES, stream) != hipSuccess) return;
    Args a{};
    for (int i = 0; i < 21; ++i) a.in[i] = d_in[i];
    a.out = (float*)d_out; a.ws = (unsigned char*)d_ws;
#if MK_ONE_LAUNCH
    a.ph_lo = 0; a.ph_hi = 21;
    hipLaunchKernelGGL(fwd, dim3(grid), dim3(512), LDS_BYTES, stream, a);
#else
    for (int p = 0; p <= 20; ++p) { a.ph_lo = p; a.ph_hi = p + 1; hipLaunchKernelGGL(fwd, dim3(grid), dim3(512), LDS_BYTES, stream, a); }
#endif
}
```

```cpp
#include <hip/hip_runtime.h>
#include <cstdio>
#include <cstdint>

#ifndef PROBE_PHASE
#define PROBE_PHASE -1
#endif
#define NREP(k) ((PROBE_PHASE) == (k) ? 2 : 1)
#ifndef MK_ONE_LAUNCH
#define MK_ONE_LAUNCH 1
#endif

#define LAS __attribute__((address_space(3)))
#define GAS __attribute__((address_space(1)))
typedef unsigned short bf16;
typedef short bf16x8 __attribute__((ext_vector_type(8)));
typedef short s16x4 __attribute__((ext_vector_type(4)));
typedef float f32x4 __attribute__((ext_vector_type(4)));
typedef float f32x2 __attribute__((ext_vector_type(2)));
typedef float f32x16 __attribute__((ext_vector_type(16)));
typedef unsigned u32x4 __attribute__((ext_vector_type(4)));
typedef unsigned u32x2 __attribute__((ext_vector_type(2)));

constexpr int NB = 16, SEQ = 2048, DM = 1024, NTOK = NB * SEQ, NLAYER = 2;
constexpr int INW = 1960, INP = 2048;
constexpr int NEXP = 32, DEXP = 512;
constexpr int MAXSLOT = 73728;
constexpr float EPS = 1e-6f;
constexpr float WSCALE = 64.f, WSCALE_INV = 1.f / 64.f;
constexpr float LOG2E = 1.4426950408889634f;
constexpr float C2F = 0.125f * LOG2E;
constexpr float C2M = 0.10206207261596575f * LOG2E;

constexpr size_t MiB = 1u << 20, KiB = 1u << 10;
constexpr size_t WS_CTL = 0, CTL_ZERO_BYTES = 64 * KiB;
constexpr size_t WS_COS = 1 * MiB, WS_SIN = 3 * MiB;
constexpr size_t WS_SSQ = 5 * MiB;
constexpr size_t WS_FLOG = 6 * MiB;
constexpr size_t WS_E01 = 8 * MiB;
constexpr size_t WS_G01 = 8 * MiB + 256 * KiB;
constexpr size_t WS_SLOT = 8 * MiB + 512 * KiB;
constexpr size_t WS_TOKOF = 8 * MiB + 768 * KiB;
constexpr size_t WS_GATEOF = 9 * MiB + 256 * KiB;
constexpr size_t WS_CNT = 9 * MiB + 768 * KiB;
constexpr size_t WS_TSTART = 9 * MiB + 800 * KiB;
constexpr size_t WS_RSTD = 9 * MiB + 832 * KiB;
constexpr size_t WS_RSTDOF = 7 * MiB;
constexpr size_t WS_KPE = 10 * MiB;
constexpr size_t WS_KAUG = 10 * MiB + 2 * MiB;
constexpr size_t WS_WIN = 16 * MiB;
constexpr size_t WS_WUQ = 20 * MiB;
constexpr size_t WS_WUKV = 20 * MiB + 512 * KiB;
constexpr size_t WS_WOUT = 21 * MiB;
constexpr size_t WS_WGU = 24 * MiB;
constexpr size_t WS_WD = 88 * MiB;
constexpr size_t WS_XN = 120 * MiB;
constexpr size_t WS_FQKV = 184 * MiB;
constexpr size_t WS_LAT = 280 * MiB;
constexpr size_t WS_QM = 312 * MiB;
constexpr size_t WS_KVM = 360 * MiB;
constexpr size_t WS_Y = 280 * MiB;
constexpr size_t WS_BIASF = 424 * MiB;
constexpr size_t WS_NRM = 425 * MiB;
constexpr size_t WS_WR = 426 * MiB;
constexpr size_t WS_XR = 427 * MiB;
constexpr size_t WS_OSS = 491 * MiB;
constexpr size_t WS_RSTDX = 493 * MiB;
constexpr size_t WS_END = 494 * MiB;
static_assert(WS_Y + (size_t)MAXSLOT * 1024 * 2 <= WS_END, "Y fits");
static_assert(WS_FQKV + (size_t)MAXSLOT * 512 * 2 <= WS_LAT, "HH fits");

constexpr int CW_BAR = 1024;

constexpr int RING_BYTES = 147456;
constexpr int MISC_OFF = RING_BYTES;
constexpr int LDS_BYTES = RING_BYTES + 1024;

typedef __bf16 bf16x2_t __attribute__((ext_vector_type(2)));
__device__ __forceinline__ unsigned cvt_pk_bf16(float lo, float hi) { const f32x2 v = {lo, hi}; const bf16x2_t b = __builtin_convertvector(v, bf16x2_t); return __builtin_bit_cast(unsigned, b); }
__device__ __forceinline__ float bf2f(unsigned short b) { return __uint_as_float((unsigned)b << 16); }
__device__ __forceinline__ float wave_sum(float v) {
#pragma unroll
    for (int o = 1; o < 64; o <<= 1) v += __shfl_xor(v, o);
    return v;
}
__device__ __forceinline__ unsigned pk4_fp8(float a, float b, float c, float d) { int w = 0; w = __builtin_amdgcn_cvt_pk_fp8_f32(a, b, w, false); w = __builtin_amdgcn_cvt_pk_fp8_f32(c, d, w, true); return (unsigned)w; }
#define LDS_WAIT() asm volatile("s_waitcnt lgkmcnt(0)" ::: "memory")

#define XB_TMO      128
#define XB_XCNT(j)  (256  + 64 * (j))
#define XB_XSUB(j)  (1280 + 64 * (j))
#define XB_XGEN(j)  (2304 + 64 * (j))
#define XB_TOP      3328
#define XB_TOPGEN   3392
#define XCD_BAR_WORDS 3456
#define XB_SPIN_CAP (1u << 18)
__device__ __forceinline__ unsigned xb_ld(unsigned* p)              { return __hip_atomic_load(p, __ATOMIC_RELAXED, __HIP_MEMORY_SCOPE_AGENT); }
__device__ __forceinline__ unsigned xb_add(unsigned* p, unsigned v) { return __hip_atomic_fetch_add(p, v, __ATOMIC_RELAXED, __HIP_MEMORY_SCOPE_AGENT); }
__device__ __forceinline__ unsigned xb_xcc_id() { return (unsigned)__builtin_amdgcn_s_getreg((3 << 11) | 20) & 0xFu; }
#define XB_SPIN(cond, bar) do { unsigned _sp = 0; while (cond) { __builtin_amdgcn_s_sleep(1); \
    if ((++_sp & 255u) == 0u) { if (xb_ld(&(bar)[XB_TMO])) break; if (_sp > XB_SPIN_CAP) { atomicAdd(&(bar)[XB_TMO], 1u); break; } } } } while (0)
struct XcdBarrier { unsigned* bar; unsigned x; volatile LAS unsigned* st; };
__device__ __forceinline__ XcdBarrier xcd_barrier_post(unsigned* bar, volatile LAS unsigned* st) {
    XcdBarrier b; b.bar = bar; b.x = xb_xcc_id(); b.st = st;
    if (threadIdx.x == 0) (void)xb_add(&bar[XB_XCNT(b.x)], 1u);
    return b;
}
__device__ __forceinline__ void xcd_barrier_complete(unsigned* bar, unsigned x, unsigned& nloc, unsigned& nx) {
    const unsigned G = gridDim.x * gridDim.y * gridDim.z;
    unsigned sum, cnt, mine, sp = 0u;
    for (;;) {
        sum = 0u; cnt = 0u; mine = 0u;
#pragma unroll
        for (unsigned j = 0; j < 16; ++j) { const unsigned c = xb_ld(&bar[XB_XCNT(j)]); sum += c; cnt += (c > 0u) ? 1u : 0u; mine = (j == x) ? c : mine; }
        if (sum == G) break;
        __builtin_amdgcn_s_sleep(1);
        if ((++sp & 255u) == 0u) { if (xb_ld(&bar[XB_TMO])) break; if (sp > XB_SPIN_CAP) { atomicAdd(&bar[XB_TMO], 1u); break; } }
    }
    nloc = mine > 0u ? mine : 1u; nx = cnt > 0u ? cnt : 1u;
}
__device__ __forceinline__ void xcd_barrier(const XcdBarrier& b) {
    asm volatile("s_waitcnt vmcnt(0)" ::: "memory");
    __syncthreads();
    if (threadIdx.x == 0) {
        unsigned* bar = b.bar;
        __builtin_amdgcn_s_waitcnt(0);
        unsigned nloc = b.st[0], nx = b.st[1];
        if (nloc == 0u) { xcd_barrier_complete(bar, b.x, nloc, nx); b.st[0] = nloc; b.st[1] = nx; }
        const unsigned old = xb_add(&bar[XB_XSUB(b.x)], 1u);
        const unsigned gen = old / nloc;
        if (old + 1u == (gen + 1u) * nloc) {
            __builtin_amdgcn_fence(__ATOMIC_RELEASE, "agent");
            asm volatile("s_waitcnt vmcnt(0)" ::: "memory");
            const unsigned og = xb_add(&bar[XB_TOP], 1u);
            const unsigned tg = og / nx;
            if (og + 1u == (tg + 1u) * nx) xb_add(&bar[XB_TOPGEN], 1u);
            else XB_SPIN(xb_ld(&bar[XB_TOPGEN]) == tg, bar);
            __builtin_amdgcn_fence(__ATOMIC_ACQUIRE, "agent");
            xb_add(&bar[XB_XGEN(b.x)], 1u);
            asm volatile("s_waitcnt vmcnt(0)" ::: "memory");
        } else {
            XB_SPIN(xb_ld(&bar[XB_XGEN(b.x)]) == gen, bar);
            __builtin_amdgcn_fence(__ATOMIC_ACQUIRE, "agent");
            asm volatile("s_waitcnt vmcnt(0)" ::: "memory");
        }
    }
    __syncthreads();
}

namespace pg8 {
constexpr int BM = 256, BK = 64, HALF = 128, HTB = HALF * BK * 2, STAGE_BYTES = 8 * HTB;
typedef int v4i32_t __attribute__((ext_vector_type(4)));
typedef int v8i32_t __attribute__((ext_vector_type(8)));
__host__ __device__ __forceinline__ int lds_byte(int r, int c) { const int st = (r >> 4) * 2 + (c >> 5), rr = r & 15, cc = c & 31, ob = rr * 64 + cc * 2; return st * 1024 + (ob ^ (((ob >> 9) & 1) << 5)); }
__host__ __device__ __forceinline__ void stage_rc(int b, int& R, int& C) { const int st = b / 1024, sb = b % 1024, swz = sb ^ (((sb >> 9) & 1) << 5); R = (st >> 1) * 16 + swz / 64; C = (st & 1) * 32 + (swz % 64) / 2; }
__host__ __device__ __forceinline__ int perm32(int rho) { const int n = rho >> 4, i = rho & 15; return 8 * (i >> 2) + 4 * n + (i & 3); }

struct Unit { const GAS char* a; const GAS char* b; int pm, pn, e; };

template <int N> __device__ __forceinline__ void wait_vm() { asm volatile("s_waitcnt vmcnt(%0)" :: "n"(N) : "memory"); }
template <class Epi, class Sched, bool ALIGN_EPI, bool GATHER, bool FP8 = false, bool MIDSCALE = false>
__device__ __forceinline__ void gemm_phase(const int tid, LAS unsigned char* lds, const int Kb, const int ldaB, const int ldbB, const Sched& S, const Epi& E, const GAS int* __restrict__ tokof, const LAS f32x2* scl = nullptr) {
    const int wid = __builtin_amdgcn_readfirstlane(tid >> 6), lane = tid & 63, wr = wid >> 2, wc = wid & 3, fr = lane & 15, fq = lane >> 4;
    const int nt = Kb / 128;
    unsigned voffA[2], voffB[2]; int RA[2], CA2[2];
#pragma unroll
    for (int i = 0; i < 2; ++i) { int R, C; stage_rc(tid * 16 + i * 8192, R, C); const int Rb = Epi::PERM ? ((R & ~31) + perm32(R & 31)) : R;
        voffA[i] = (unsigned)(R * ldaB + C * 2); voffB[i] = (unsigned)(Rb * ldbB + C * 2); RA[i] = R; CA2[i] = C * 2; }
    const size_t kstep = (size_t)(BK * 2);
    const size_t hstepA = GATHER ? 0 : (size_t)HALF * ldaB;
    const size_t hstepB = (size_t)HALF * ldbB;
    const unsigned ldsw = (unsigned)wid * 1024u;
    const int aoff = lds_byte(wr * 64 + fr, fq * 8), boff = lds_byte(wc * 32 + fr, fq * 8);
    unsigned gcur[2][2], gnxt[2][2];
    const int scl8 = 0x7F7F7F7F;
#define PG8_SA(b, h) (((b) * 2 + (h)) * HTB)
#define PG8_SB(b, h) ((4 + (b) * 2 + (h)) * HTB)
#define PG8_STAGE(bufoff, gbase, voff) do { const unsigned long long gb_ = (unsigned long long)(gbase); const unsigned lbase_ = (unsigned)__builtin_amdgcn_readfirstlane((int)((unsigned)(uintptr_t)lds + (unsigned)(bufoff) + ldsw)); \
        _Pragma("unroll") for (int _i = 0; _i < 2; ++_i) { unsigned keep_; \
            asm volatile("s_mov_b32 %0, m0\n\ts_mov_b32 m0, %3\n\ts_nop 0\n\tglobal_load_lds_dwordx4 %1, %2\n\ts_mov_b32 m0, %0" : "=&s"(keep_) : "v"((voff)[_i]), "s"(gb_), "s"(lbase_ + (unsigned)(_i * 8192)) : "memory"); } } while (0)
#define PG8_STAGE_A(bufoff, base, h, nx) do { if constexpr (GATHER) { unsigned _v[2]; _v[0] = (nx) ? gnxt[h][0] : gcur[h][0]; _v[1] = (nx) ? gnxt[h][1] : gcur[h][1]; PG8_STAGE(bufoff, base, _v); } \
        else { PG8_STAGE(bufoff, (base) + (h) * hstepA, voffA); } } while (0)
#define PG8_LDA(dst, b, h) do { _Pragma("unroll") for (int m = 0; m < 4; ++m) _Pragma("unroll") for (int k = 0; k < 2; ++k) dst[m][k] = *(const LAS bf16x8*)(lds + PG8_SA(b, h) + aoff + m * 2048 + k * 1024); } while (0)
#define PG8_LDB(dst, b, h) do { _Pragma("unroll") for (int n = 0; n < 2; ++n) _Pragma("unroll") for (int k = 0; k < 2; ++k) dst[n][k] = *(const LAS bf16x8*)(lds + PG8_SB(b, h) + boff + n * 2048 + k * 1024); } while (0)
#define PG8_MMA(ai, bj, At, Bt) do { __builtin_amdgcn_s_setprio(1); if constexpr (FP8) { _Pragma("unroll") for (int m = 0; m < 4; ++m) _Pragma("unroll") for (int n = 0; n < 2; ++n) { \
        const v8i32_t b8_ = __builtin_shufflevector(__builtin_bit_cast(v4i32_t, Bt[n][0]), __builtin_bit_cast(v4i32_t, Bt[n][1]), 0, 1, 2, 3, 4, 5, 6, 7), a8_ = __builtin_shufflevector(__builtin_bit_cast(v4i32_t, At[m][0]), __builtin_bit_cast(v4i32_t, At[m][1]), 0, 1, 2, 3, 4, 5, 6, 7); \
        asm volatile("s_nop 1\n\tv_mfma_scale_f32_16x16x128_f8f6f4 %0, %1, %2, %0, %3, %3 op_sel_hi:[0,0,0]" : "+v"(acc[ai][bj][m][n]) : "v"(b8_), "v"(a8_), "v"(scl8)); } } \
      else { _Pragma("unroll") for (int m = 0; m < 4; ++m) _Pragma("unroll") for (int n = 0; n < 2; ++n) _Pragma("unroll") for (int k = 0; k < 2; ++k) \
        acc[ai][bj][m][n] = __builtin_amdgcn_mfma_f32_16x16x32_bf16(Bt[n][k], At[m][k], acc[ai][bj][m][n], 0, 0, 0); } __builtin_amdgcn_s_setprio(0); } while (0)
#define PG8_WAIT_V(n) asm volatile("s_waitcnt vmcnt(" #n ")" ::: "memory")
#define PG8_WAIT_L(n) asm volatile("s_waitcnt lgkmcnt(" #n ")" ::: "memory")
#define PG8_BAR __builtin_amdgcn_s_barrier()
#define PG8_SCHED __builtin_amdgcn_sched_barrier(0)
#define PG8_GLOAD(dst, u) do { if constexpr (GATHER) { _Pragma("unroll") for (int _h = 0; _h < 2; ++_h) _Pragma("unroll") for (int _i = 0; _i < 2; ++_i) \
        dst[_h][_i] = (unsigned)tokof[(u).pm * BM + _h * HALF + RA[_i]] * (unsigned)ldaB + (unsigned)CA2[_i]; } } while (0)
    Unit cur, nxt; int ui = 0;
    if (!S.next(0, cur)) return;
    PG8_GLOAD(gcur, cur);
    typename Epi::Pre pre = E.prefetch(cur, wr, fr);
    f32x4 acc[2][2][4][2];
#pragma unroll
    for (int a = 0; a < 2; ++a)
#pragma unroll
        for (int b = 0; b < 2; ++b)
#pragma unroll
            for (int m = 0; m < 4; ++m)
#pragma unroll
                for (int n = 0; n < 2; ++n) acc[a][b][m][n] = (f32x4){0.f, 0.f, 0.f, 0.f};
    bf16x8 At[4][2], B0[2][2], B1[2][2];
    const GAS char* cA = cur.a; const GAS char* cB = cur.b;
    PG8_STAGE(PG8_SB(0, 0), cB, voffB); PG8_STAGE(PG8_SB(0, 1), cB + hstepB, voffB); PG8_STAGE_A(PG8_SA(0, 0), cA, 0, false); PG8_STAGE_A(PG8_SA(0, 1), cA, 1, false);
    if (wr == 1) PG8_BAR;
    PG8_WAIT_V(2); PG8_BAR;
    PG8_STAGE(PG8_SB(1, 0), cB + kstep, voffB); PG8_STAGE_A(PG8_SA(1, 0), cA + kstep, 0, false); PG8_STAGE(PG8_SB(1, 1), cB + hstepB + kstep, voffB);
    PG8_WAIT_V(6); PG8_BAR;
    bool fresh = false;
    for (;;) {
        const bool has_next = S.next(ui + 1, nxt);
        if constexpr (GATHER) { if (has_next) { PG8_GLOAD(gnxt, nxt); } else { _Pragma("unroll") for (int _h = 0; _h < 2; ++_h) _Pragma("unroll") for (int _i = 0; _i < 2; ++_i) gnxt[_h][_i] = gcur[_h][_i]; } }
        const GAS char* nA = has_next ? nxt.a : cA; const GAS char* nB = has_next ? nxt.b : cB;
#pragma nounroll
        for (int t = 0; t < nt; t += 2) {
            const bool last = (t == nt - 2);
            const GAS char* a1 = cA + (size_t)(t + 1) * kstep;
            const GAS char* a2 = last ? nA : cA + (size_t)(t + 2) * kstep; const GAS char* b2 = last ? nB : cB + (size_t)(t + 2) * kstep;
            const GAS char* a3 = a2 + kstep; const GAS char* b3 = b2 + kstep;
            const bool fe = fresh; fresh = false;
            if constexpr (MIDSCALE) { if (t == nt / 2) {
#pragma unroll
                for (int ai = 0; ai < 2; ++ai)
#pragma unroll
                    for (int m = 0; m < 4; ++m) { const float r_ = scl[ui * 256 + ai * 128 + wr * 64 + m * 16 + fr][0];
#pragma unroll
                        for (int bj = 0; bj < 2; ++bj)
#pragma unroll
                            for (int n = 0; n < 2; ++n) acc[ai][bj][m][n] *= r_; } } }
            PG8_LDB(B0, 0, 0); PG8_LDB(B1, 0, 1); PG8_SCHED; PG8_LDA(At, 0, 0); PG8_STAGE_A(PG8_SA(1, 1), a1, 1, false);
            if (fe) wait_vm<8 + Epi::NST>(); else PG8_WAIT_V(8); PG8_WAIT_L(0); PG8_BAR; PG8_MMA(0, 0, At, B0); PG8_MMA(0, 1, At, B1); PG8_BAR; PG8_SCHED;
            PG8_LDA(At, 0, 1); PG8_STAGE(PG8_SB(0, 0), b2, voffB); PG8_STAGE(PG8_SB(0, 1), b2 + hstepB, voffB); PG8_STAGE_A(PG8_SA(0, 0), a2, 0, last);
            if (fe) wait_vm<8 + Epi::NST>(); else PG8_WAIT_V(8); PG8_WAIT_L(0); PG8_BAR; PG8_MMA(1, 0, At, B0); PG8_MMA(1, 1, At, B1); PG8_BAR; PG8_SCHED;
            PG8_LDB(B0, 1, 0); PG8_LDB(B1, 1, 1); PG8_SCHED; PG8_LDA(At, 1, 0); PG8_STAGE_A(PG8_SA(0, 1), a2, 1, last);
            PG8_WAIT_V(8); PG8_WAIT_L(0); PG8_BAR; PG8_MMA(0, 0, At, B0); PG8_MMA(0, 1, At, B1); PG8_BAR; PG8_SCHED;
            PG8_LDA(At, 1, 1); PG8_STAGE(PG8_SB(1, 0), b3, voffB); PG8_STAGE(PG8_SB(1, 1), b3 + hstepB, voffB); PG8_STAGE_A(PG8_SA(1, 0), a3, 0, last);
            PG8_WAIT_V(8); PG8_WAIT_L(0); PG8_BAR; PG8_MMA(1, 0, At, B0); PG8_MMA(1, 1, At, B1); PG8_BAR; PG8_SCHED;
        }
        if constexpr (ALIGN_EPI) { if (wr == 0) PG8_BAR; }
        if constexpr (FP8) { asm volatile("s_nop 15\n\ts_nop 15" ::: "memory"); }
        if constexpr (MIDSCALE) E(acc, cur, wr, wc, fr, fq, scl + ui * 256); else E(acc, cur, wr, wc, fr, fq, pre);
        if (!has_next) break;
        pre = E.prefetch(nxt, wr, fr);
#pragma unroll
        for (int a = 0; a < 2; ++a)
#pragma unroll
            for (int b = 0; b < 2; ++b)
#pragma unroll
                for (int m = 0; m < 4; ++m)
#pragma unroll
                    for (int n = 0; n < 2; ++n) acc[a][b][m][n] = (f32x4){0.f, 0.f, 0.f, 0.f};
        cur = nxt; cA = nA; cB = nB; ++ui; fresh = true;
        if constexpr (GATHER) { _Pragma("unroll") for (int _h = 0; _h < 2; ++_h) _Pragma("unroll") for (int _i = 0; _i < 2; ++_i) gcur[_h][_i] = gnxt[_h][_i]; }
        if constexpr (ALIGN_EPI) { if (wr == 1) PG8_BAR; }
    }
    PG8_WAIT_V(0);
    if constexpr (!ALIGN_EPI) { if (wr == 0) PG8_BAR; }
    PG8_BAR;
#undef PG8_SA
#undef PG8_SB
#undef PG8_STAGE
#undef PG8_STAGE_A
#undef PG8_LDA
#undef PG8_LDB
#undef PG8_MMA
#undef PG8_WAIT_V
#undef PG8_WAIT_L
#undef PG8_BAR
#undef PG8_SCHED
#undef PG8_GLOAD
}
}
using pg8::Unit;

struct DenseOrder {
    int nM, nN, nwg, G, c; const GAS char* A; const GAS char* B; size_t aT, bT;
    __device__ __forceinline__ bool next(int i, Unit& u) const {
        const long L = (long)i * G + c; if (L >= nwg) return false;
        int wgid = (int)L; { const int q = nwg / 8, r = nwg % 8, xcd = wgid % 8, off = wgid / 8; wgid = (xcd < r ? xcd * (q + 1) : r * (q + 1) + (xcd - r) * q) + off; }
        const int nig = 8 * nN, gid = wgid / nig, fm = gid * 8, gsz = (nM - fm) < 8 ? (nM - fm) : 8;
        u.pm = fm + ((wgid % nig) % gsz); u.pn = (wgid % nig) / gsz; u.e = 0;
        u.a = A + (size_t)u.pm * aT; u.b = B + (size_t)u.pn * bT; return true;
    }
};
struct UpOrder {
    int G, c; const GAS char* LATp; const GAS char* Wq; const GAS char* Wkv;
    __device__ __forceinline__ bool next(int i, Unit& u) const {
        const int L = i * G + c; if (L >= 128 * 7) return false;
        u.pm = L / 7; const int j = L % 7; const bool kv = j >= 3; u.pn = kv ? j - 3 : j; u.e = kv ? 1 : 0;
        u.a = LATp + (size_t)u.pm * 256 * 512 * 2 + (kv ? 512 : 0);
        u.b = (kv ? Wkv : Wq) + (size_t)u.pn * 256 * 256 * 2; return true;
    }
};
struct MoeOrder {
    int G, c; const volatile LAS int* TS; const GAS char* A; const GAS char* W; size_t aT  , wE  , wT  ;
    __device__ __forceinline__ bool next(int i, Unit& u) const {
        const int L = i * G + c; const int ntile = __builtin_amdgcn_readfirstlane(TS[32]); if (L >= ntile * 4) return false;
        const int rt = L >> 2, ct = L & 3; int e = 0;
        for (int j = 1; j < 32; ++j) e += (TS[j] <= rt) ? 1 : 0;
        e = __builtin_amdgcn_readfirstlane(e);
        u.pm = rt; u.pn = ct; u.e = e; u.a = A + (size_t)rt * aT; u.b = W + (size_t)e * wE + (size_t)ct * wT; return true;
    }
};

__device__ __forceinline__ u32x4 pack8(f32x4 v0, f32x4 v1) { u32x4 w; w.x = cvt_pk_bf16(v0[0], v0[1]); w.y = cvt_pk_bf16(v0[2], v0[3]); w.z = cvt_pk_bf16(v1[0], v1[1]); w.w = cvt_pk_bf16(v1[2], v1[3]); return w; }

struct EpiWin {
    static constexpr int NST = 16;
    static constexpr bool PERM = true;
    GAS bf16* LAT_; GAS bf16* FQKV_; GAS bf16* KPE_; GAS float* FLOG_; GAS float* SSQ_; const GAS float* COS_; const GAS float* SIN_; const GAS float* RSX_;
    struct Pre { float v[8]; };
    __device__ __forceinline__ Pre prefetch(const Unit& u, int wr, int fr) const { Pre p; const GAS float* RSX = RSX_; asm volatile("" : "+s"(RSX));
#pragma unroll
        for (int g = 0; g < 8; ++g) p.v[g] = RSX[u.pm * 256 + (g >> 2) * 128 + wr * 64 + (g & 3) * 16 + fr]; return p; }
    __device__ __forceinline__ void operator()(f32x4 (&acc)[2][2][4][2], const Unit& u, int wr, int wc, int fr, int fq, const Pre& pre) const {
        GAS bf16* LAT = LAT_; GAS bf16* FQKV = FQKV_; GAS bf16* KPE = KPE_; GAS float* FLOG = FLOG_; GAS float* SSQ = SSQ_; const GAS float* COS = COS_; const GAS float* SIN = SIN_; const GAS float* RSX = RSX_;
        asm volatile("" : "+s"(LAT), "+s"(FQKV), "+s"(KPE), "+s"(FLOG), "+s"(SSQ), "+s"(COS), "+s"(SIN), "+s"(RSX));
        {
#pragma unroll
            for (int ai = 0; ai < 2; ++ai)
#pragma unroll
                for (int m = 0; m < 4; ++m) { const float rs_ = pre.v[ai * 4 + m];
#pragma unroll
                    for (int bj = 0; bj < 2; ++bj)
#pragma unroll
                        for (int n = 0; n < 2; ++n) acc[ai][bj][m][n] *= rs_; } }
        const int row0 = u.pm * 256 + wr * 64 + fr; const int pn = u.pn;
        if (pn >= 2) {
            const int ti = pn >> 1; GAS bf16* dst = FQKV + (size_t)(ti - 1) * NTOK * 512; const int colb = (pn & 1) * 256 + wc * 32 + 8 * fq; const float sc = (ti == 1) ? C2F : 1.f;
#pragma unroll
            for (int ai = 0; ai < 2; ++ai)
#pragma unroll
                for (int m = 0; m < 4; ++m) { GAS bf16* rowp = dst + (size_t)(row0 + ai * 128 + m * 16) * 512 + colb;
#pragma unroll
                    for (int bj = 0; bj < 2; ++bj) *(GAS u32x4*)(rowp + bj * 128) = pack8(acc[ai][bj][m][0] * sc, acc[ai][bj][m][1] * sc); }
        } else {
#pragma unroll
            for (int ai = 0; ai < 2; ++ai)
#pragma unroll
                for (int m = 0; m < 4; ++m) { const int row = row0 + ai * 128 + m * 16; GAS bf16* rowp = LAT + (size_t)row * 512 + pn * 256 + wc * 32 + 8 * fq;
#pragma unroll
                    for (int bj = 0; bj < 2; ++bj) *(GAS u32x4*)(rowp + bj * 128) = pack8(acc[ai][bj][m][0], acc[ai][bj][m][1]);
                    float s = 0.f;
#pragma unroll
                    for (int n = 0; n < 2; ++n) { const f32x4 x = acc[ai][0][m][n]; s += (x[0] * x[0] + x[1] * x[1]) + (x[2] * x[2] + x[3] * x[3]); }
                    if (pn == 0) {
#pragma unroll
                        for (int n = 0; n < 2; ++n) { const f32x4 x = acc[ai][1][m][n]; s += (x[0] * x[0] + x[1] * x[1]) + (x[2] * x[2] + x[3] * x[3]); }
                    }
                    s += __shfl_xor(s, 16); s += __shfl_xor(s, 32);
                    if (fq == 0) SSQ[(size_t)row * 8 + pn * 4 + wc] = s;
                    }
            if (pn == 1 && wc == 0) {
#pragma unroll
                for (int ai = 0; ai < 2; ++ai)
#pragma unroll
                    for (int m = 0; m < 4; ++m) { const int row = row0 + ai * 128 + m * 16;
                        const f32x4 c = *(const GAS f32x4*)(COS + (size_t)row * 16 + 4 * fq), sn = *(const GAS f32x4*)(SIN + (size_t)row * 16 + 4 * fq);
                        const f32x4 x1 = acc[ai][1][m][0], x2 = acc[ai][1][m][1];
                        *(GAS u32x4*)(KPE + (size_t)row * 32 + 8 * fq) = pack8(x1 * c - x2 * sn, x1 * sn + x2 * c);
                        }
            }
            if (pn == 1 && wc == 1 && fq == 0) {
#pragma unroll
                for (int ai = 0; ai < 2; ++ai)
#pragma unroll
                    for (int m = 0; m < 4; ++m) { const int row = row0 + ai * 128 + m * 16; *(GAS f32x4*)(FLOG + (size_t)row * 8) = acc[ai][1][m][0]; *(GAS f32x4*)(FLOG + (size_t)row * 8 + 4) = acc[ai][1][m][1]; }
            }
        }
    }
};
struct EpiUp {
    static constexpr int NST = 16;
    static constexpr bool PERM = true;
    GAS bf16* QM_; GAS bf16* KVM_; const GAS float* SSQ_; const GAS float* COS_; const GAS float* SIN_;
    struct Pre { f32x4 v[8]; };
    __device__ __forceinline__ Pre prefetch(const Unit& u, int wr, int fr) const { Pre p; const GAS float* SSQ = SSQ_; asm volatile("" : "+s"(SSQ)); const int off = u.e ? 4 : 0;
#pragma unroll
        for (int g = 0; g < 8; ++g) p.v[g] = *(const GAS f32x4*)(SSQ + (size_t)(u.pm * 256 + (g >> 2) * 128 + wr * 64 + (g & 3) * 16 + fr) * 8 + off); return p; }
    __device__ __forceinline__ void operator()(const f32x4 (&acc)[2][2][4][2], const Unit& u, int wr, int wc, int fr, int fq, const Pre& pre) const {
        GAS bf16* QM = QM_; GAS bf16* KVM = KVM_; const GAS float* SSQ = SSQ_; const GAS float* COS = COS_; const GAS float* SIN = SIN_;
        asm volatile("" : "+s"(QM), "+s"(KVM), "+s"(SSQ), "+s"(COS), "+s"(SIN));
        const int row0 = u.pm * 256 + wr * 64 + fr; const int pn = u.pn; const bool kv = u.e != 0;
#pragma unroll
        for (int ai = 0; ai < 2; ++ai)
#pragma unroll
            for (int m = 0; m < 4; ++m) { const int row = row0 + ai * 128 + m * 16;
                const f32x4 sq = pre.v[ai * 4 + m];
                const float ss = (sq[0] + sq[1]) + (sq[2] + sq[3]);
                if (kv) {
                    const float rs = rsqrtf(ss * (1.f / 128.f) + EPS);
                    GAS bf16* rowp = KVM + (size_t)row * 1024 + pn * 256 + wc * 32 + 8 * fq;
#pragma unroll
                    for (int bj = 0; bj < 2; ++bj) *(GAS u32x4*)(rowp + bj * 128) = pack8(acc[ai][bj][m][0] * rs, acc[ai][bj][m][1] * rs);
                } else {
                    const float rs = rsqrtf(ss * (1.f / 256.f) + EPS) * C2M;
                    GAS bf16* rowp = QM + (size_t)row * 768 + pn * 256 + wc * 32 + 8 * fq;
                    const f32x4 c = *(const GAS f32x4*)(COS + (size_t)row * 16 + 4 * fq), sn = *(const GAS f32x4*)(SIN + (size_t)row * 16 + 4 * fq);
#pragma unroll
                    for (int bj = 0; bj < 2; ++bj) { f32x4 v0 = acc[ai][bj][m][0] * rs, v1 = acc[ai][bj][m][1] * rs;
                        const int G = 8 * pn + 4 * bj + wc;
                        if (G % 3 == 2) { const f32x4 x1 = v0, x2 = v1; v0 = x1 * c - x2 * sn; v1 = x1 * sn + x2 * c; }
                        *(GAS u32x4*)(rowp + bj * 128) = pack8(v0, v1); }
                }

            }
    }
};
template <bool RES_F32> struct EpiOut {
    static constexpr int NST = 16;
    static constexpr bool PERM = true;
    const GAS float* resf_; GAS bf16* xr_;
    struct Pre {}; __device__ __forceinline__ Pre prefetch(const Unit&, int, int) const { return Pre{}; }
    __device__ __forceinline__ void operator()(const f32x4 (&acc)[2][2][4][2], const Unit& u, int wr, int wc, int fr, int fq, const LAS f32x2* scl) const {
        const GAS float* resf = resf_; GAS bf16* xr = xr_; asm volatile("" : "+s"(resf), "+s"(xr));
        const int row0 = u.pm * 256 + wr * 64 + fr, col0 = u.pn * 256 + wc * 32 + 8 * fq;
#pragma unroll
        for (int ai = 0; ai < 2; ++ai)
#pragma unroll
            for (int m = 0; m < 4; ++m) { const size_t off = (size_t)(row0 + ai * 128 + m * 16) * DM + col0; const float sh = scl[ai * 128 + wr * 64 + m * 16 + fr][1];
#pragma unroll
                for (int bj = 0; bj < 2; ++bj) { f32x4 r0, r1;
                    if constexpr (RES_F32) { r0 = *(const GAS f32x4*)(resf + off + bj * 128); r1 = *(const GAS f32x4*)(resf + off + bj * 128 + 4); }
                    else { const u32x4 w = *(const GAS u32x4*)(xr + off + bj * 128);
                        r0 = (f32x4){__uint_as_float(w.x << 16), __uint_as_float(w.x & 0xffff0000u), __uint_as_float(w.y << 16), __uint_as_float(w.y & 0xffff0000u)};
                        r1 = (f32x4){__uint_as_float(w.z << 16), __uint_as_float(w.z & 0xffff0000u), __uint_as_float(w.w << 16), __uint_as_float(w.w & 0xffff0000u)}; }
                    *(GAS u32x4*)(xr + off + bj * 128) = pack8(r0 + acc[ai][bj][m][0] * sh, r1 + acc[ai][bj][m][1] * sh); } }
    }
};
struct EpiGU {
    static constexpr int NST = 8;
    static constexpr bool PERM = true;
    GAS unsigned char* HH_; const GAS float* RS_;
    struct Pre { float v[8]; };
    __device__ __forceinline__ Pre prefetch(const Unit& u, int wr, int fr) const { Pre p; const GAS float* RS = RS_; asm volatile("" : "+s"(RS));
#pragma unroll
        for (int g = 0; g < 8; ++g) p.v[g] = RS[u.pm * 256 + (g >> 2) * 128 + wr * 64 + (g & 3) * 16 + fr]; return p; }
    __device__ __forceinline__ void operator()(const f32x4 (&acc)[2][2][4][2], const Unit& u, int wr, int wc, int fr, int fq, const Pre& pre) const {
        GAS unsigned char* HH = HH_; const GAS float* RS = RS_; asm volatile("" : "+s"(HH), "+s"(RS));
        const int row0 = u.pm * 256 + wr * 64 + fr;
#pragma unroll
        for (int ai = 0; ai < 2; ++ai)
#pragma unroll
            for (int m = 0; m < 4; ++m) { GAS unsigned char* rowp = HH + (size_t)(row0 + ai * 128 + m * 16) * 512 + u.pn * 128 + wc * 32 + 8 * fq; const float rs = pre.v[ai * 4 + m] * WSCALE_INV;
                f32x4 h[2];
#pragma unroll
                for (int n = 0; n < 2; ++n) { const f32x4 g = acc[ai][0][m][n] * rs, up = acc[ai][1][m][n] * rs;
#pragma unroll
                    for (int j = 0; j < 4; ++j) { const float sg = __builtin_amdgcn_rcpf(1.f + __builtin_amdgcn_exp2f(-g[j] * LOG2E)); h[n][j] = g[j] * sg * up[j]; } }
                u32x2 w; w.x = pk4_fp8(h[0][0], h[0][1], h[0][2], h[0][3]); w.y = pk4_fp8(h[1][0], h[1][1], h[1][2], h[1][3]); *(GAS u32x2*)rowp = w; }
    }
};
struct EpiDown {
    static constexpr int NST = 16;
    static constexpr bool PERM = true;
    GAS unsigned char* Y_; const GAS float* GATEOF_;
    struct Pre { float v[8]; };
    __device__ __forceinline__ Pre prefetch(const Unit& u, int wr, int fr) const { Pre p; const GAS float* GT = GATEOF_; asm volatile("" : "+s"(GT));
#pragma unroll
        for (int g = 0; g < 8; ++g) p.v[g] = GT[u.pm * 256 + (g >> 2) * 128 + wr * 64 + (g & 3) * 16 + fr]; return p; }
    __device__ __forceinline__ void operator()(const f32x4 (&acc)[2][2][4][2], const Unit& u, int wr, int wc, int fr, int fq, const Pre& pre) const {
        GAS unsigned char* Y = Y_; const GAS float* GATEOF = GATEOF_; asm volatile("" : "+s"(Y), "+s"(GATEOF));
        const int row0 = u.pm * 256 + wr * 64 + fr;
#pragma unroll
        for (int ai = 0; ai < 2; ++ai)
#pragma unroll
            for (int m = 0; m < 4; ++m) { const int row = row0 + ai * 128 + m * 16; const float g = pre.v[ai * 4 + m]; GAS unsigned char* rowp = Y + (size_t)row * 1024 + u.pn * 256 + wc * 32 + 8 * fq;
#pragma unroll
                for (int bj = 0; bj < 2; ++bj) { const f32x4 v0 = acc[ai][bj][m][0] * g, v1 = acc[ai][bj][m][1] * g; u32x2 w; w.x = pk4_fp8(v0[0], v0[1], v0[2], v0[3]); w.y = pk4_fp8(v1[0], v1[1], v1[2], v1[3]); *(GAS u32x2*)(rowp + bj * 128) = w; } }
    }
};

namespace att {
constexpr int KSLOT = 12288, VSLOT = 8192;
constexpr int L_K = 0, L_V = 2 * KSLOT, L_BIAS = L_V + 2 * VSLOT, L_WS = L_BIAS + 8192, L_OST = L_WS + 8 * 64 * 4, L_END = L_OST + 8 * 4096;
__device__ __forceinline__ int crow(int r, int hi) { return (r & 3) + 8 * (r >> 2) + 4 * hi; }
typedef short v4i16_t __attribute__((ext_vector_type(4)));
__device__ __forceinline__ s16x4 vtr(const LAS char* p) { return __builtin_bit_cast(s16x4, __builtin_amdgcn_ds_read_tr16_b64_v4i16((LAS v4i16_t*)p)); }

constexpr int NSL = 5;
constexpr int R_K = 0, R_V = NSL * KSLOT, R_WS = R_V + NSL * VSLOT, R_OST = R_WS + 8 * 64 * 4, R_END = R_OST + 8 * 4096;
static_assert(R_END <= RING_BYTES, "attention LDS");
__device__ __forceinline__ void glds16(const GAS void* gsrc, unsigned lds_dst) { unsigned keep;
    asm volatile("s_mov_b32 %0, m0\n\ts_mov_b32 m0, %2\n\ts_nop 0\n\tglobal_load_lds_dwordx4 %1, off\n\ts_mov_b32 m0, %0" : "=&s"(keep) : "v"(gsrc), "s"(lds_dst) : "memory"); }
__device__ __forceinline__ void glds16s(const GAS void* sbase, unsigned voff, unsigned lds_dst) { unsigned keep;
    asm volatile("s_mov_b32 %0, m0\n\ts_mov_b32 m0, %3\n\ts_nop 0\n\tglobal_load_lds_dwordx4 %1, %2\n\ts_mov_b32 m0, %0" : "=&s"(keep) : "v"(voff), "s"((unsigned long long)sbase), "s"(lds_dst) : "memory"); }
struct Tens2 { const GAS bf16* Q; int qp; const GAS bf16* K; int kp; const GAS bf16* KX; const GAS bf16* V; int vp; GAS bf16* O; const GAS float* BIASF; const GAS float* NRM; GAS float* OSS; };
template <int MODE>
__device__ __forceinline__ int attn_unit2(const int wave_, int b, int h, int qb, const Tens2& T, LAS char* shm, const int slbase, const bool have_pro, const int qb_next, bf16x8 (&qr)[6], const int tstart) {
    constexpr int DKS = MODE ? 6 : 5, DKH = 3;
    constexpr float THR = 8.f;
    int wid = wave_; asm volatile("" : "+s"(wid));
    int lane = (int)__builtin_amdgcn_mbcnt_hi(~0u, __builtin_amdgcn_mbcnt_lo(~0u, 0u)); asm volatile("" : "+v"(lane)); const int r32 = lane & 31, hi = lane >> 5;
    const long rowbase = (long)b * SEQ; const int q0 = qb * 256, qw0 = q0 + wid * 32;
    const int NT = (q0 + 256) / 64, tlast = qw0 / 64;
    const int NTE = NT - tstart;
    const GAS bf16* Qw = T.Q + (rowbase + qw0) * T.qp + h * (MODE ? 96 : 64);
    const GAS bf16* Kh = T.K + rowbase * T.kp + h * (MODE ? 128 : 64);
    const GAS bf16* Vh = T.V + rowbase * T.vp + h * (MODE ? 128 : 64);
    LAS float* wsf = (LAS float*)(shm + R_WS) + wid * 64;
    const unsigned koff = (unsigned)(lane * T.kp + wid * 8) * 2u;
    const unsigned xoff = MODE ? (unsigned)(lane * 32 + (wid & 3) * 8) * 2u : (unsigned)(lane * 8) * 2u;
    const unsigned voff = (unsigned)((16 * (wid & 3) + (lane >> 2)) * T.vp + (wid >> 2) * 32 + (lane & 3) * 8) * 2u;
    const GAS bf16* xbase = MODE ? T.KX + rowbase * 32 : T.KX + ((long)b * 8 + h) * SEQ * 8;
    const int xstep = MODE ? 64 * 32 : 64 * 8;
    const unsigned kdst_a = (unsigned)(uintptr_t)(shm + R_K) + (unsigned)wid * 1024u, xdst_a = (unsigned)(uintptr_t)(shm + R_K) + (unsigned)(8 + (MODE ? (wid & 3) : 0)) * 1024u, vdst_a = (unsigned)(uintptr_t)(shm + R_V) + (unsigned)wid * 1024u;
#define A2_DMA(t, slot) do { \
        glds16s((const GAS void*)(Kh + (long)(t) * 64 * T.kp), koff, (unsigned)__builtin_amdgcn_readfirstlane((int)(kdst_a + (slot) * KSLOT))); \
        glds16s((const GAS void*)(xbase + (long)(t) * xstep), xoff, (unsigned)__builtin_amdgcn_readfirstlane((int)(xdst_a + (slot) * KSLOT))); \
        glds16s((const GAS void*)(Vh + (long)(t) * 64 * T.vp), voff, (unsigned)__builtin_amdgcn_readfirstlane((int)(vdst_a + (slot) * VSLOT))); } while (0)
    float mhat = 0.f, lrun = 0.f; f32x16 o[2]; o[0] = f32x16{}; o[1] = f32x16{}; f32x16 negm = f32x16{};
    const LAS char* vp0 = shm + R_V + ((lane >> 4) & 1) * 32 + (lane & 3) * 8 + (4 * hi + ((lane & 15) >> 2)) * 64;
#define A3_SLOT(k) ((slbase + (k)) % NSL)
    if (!have_pro) { A2_DMA(NT - 1, A3_SLOT(0)); A2_DMA(NT - 2, A3_SLOT(1)); A2_DMA(NT - 3, A3_SLOT(2)); }
    if (!have_pro) {
#pragma unroll
        for (int d0 = 0; d0 < (MODE ? 6 : 4); ++d0) qr[d0] = *(const GAS bf16x8*)(Qw + (long)r32 * T.qp + d0 * 16 + hi * 8); }
    if (MODE == 0) { const short one = hi ? (short)0 : (short)0x3F80; qr[DKS - 1] = (bf16x8){one, one, one, 0, 0, 0, 0, 0}; }
#pragma unroll
    for (int d0 = 0; d0 < DKS; ++d0) asm volatile("" : "+v"(qr[d0]));
#define A3_KLOADH(slot, H) do { const LAS char* kb_ = shm + R_K + (slot) * KSLOT + r32 * 16; _Pragma("unroll") for (int d0 = (H) * DKH; d0 < ((H) ? DKS : DKH); ++d0) { const int off = (MODE == 0 && d0 == 4) ? 8 * 1024 : d0 * 2048 + hi * 1024; \
        kf[2 * (d0 - (H) * DKH)] = *(const LAS bf16x8*)(kb_ + off); kf[2 * (d0 - (H) * DKH) + 1] = *(const LAS bf16x8*)(kb_ + off + 512); } } while (0)
#define A3_VLOAD(slot) do { const LAS char* vp_ = vp0 + (slot) * VSLOT; _Pragma("unroll") for (int q = 0; q < 8; ++q) { vlo[q] = vtr(vp_ + (q >> 2) * 4096 + (q & 3) * 1024); vhh[q] = vtr(vp_ + (q >> 2) * 4096 + (q & 3) * 1024 + 512); } } while (0)
#define A3_QKH(H) do { if ((H) == 0) { c0 = negm; c1 = negm; } _Pragma("unroll") for (int d0 = (H) * DKH; d0 < ((H) ? DKS : DKH); ++d0) { c0 = __builtin_amdgcn_mfma_f32_32x32x16_bf16(kf[2 * (d0 - (H) * DKH)], qr[d0], c0, 0, 0, 0); c1 = __builtin_amdgcn_mfma_f32_32x32x16_bf16(kf[2 * (d0 - (H) * DKH) + 1], qr[d0], c1, 0, 0, 0); } } while (0)
#define A3_EXP() do { float ls_ = 0.f; _Pragma("unroll") for (int r = 0; r < 16; ++r) { pp0[r] = __builtin_amdgcn_exp2f(pp0[r]); pp1[r] = __builtin_amdgcn_exp2f(pp1[r]); ls_ += pp0[r] + pp1[r]; } lrun += ls_; u32x4 w_; \
        w_.x = cvt_pk_bf16(pp0[0], pp0[1]); w_.y = cvt_pk_bf16(pp0[2], pp0[3]); w_.z = cvt_pk_bf16(pp0[4], pp0[5]); w_.w = cvt_pk_bf16(pp0[6], pp0[7]); pa[0] = __builtin_bit_cast(bf16x8, w_); \
        w_.x = cvt_pk_bf16(pp0[8], pp0[9]); w_.y = cvt_pk_bf16(pp0[10], pp0[11]); w_.z = cvt_pk_bf16(pp0[12], pp0[13]); w_.w = cvt_pk_bf16(pp0[14], pp0[15]); pa[1] = __builtin_bit_cast(bf16x8, w_); \
        w_.x = cvt_pk_bf16(pp1[0], pp1[1]); w_.y = cvt_pk_bf16(pp1[2], pp1[3]); w_.z = cvt_pk_bf16(pp1[4], pp1[5]); w_.w = cvt_pk_bf16(pp1[6], pp1[7]); pa[2] = __builtin_bit_cast(bf16x8, w_); \
        w_.x = cvt_pk_bf16(pp1[8], pp1[9]); w_.y = cvt_pk_bf16(pp1[10], pp1[11]); w_.z = cvt_pk_bf16(pp1[12], pp1[13]); w_.w = cvt_pk_bf16(pp1[14], pp1[15]); pa[3] = __builtin_bit_cast(bf16x8, w_); } while (0)
#define A3_PV() do { _Pragma("unroll") for (int d0 = 0; d0 < 2; ++d0) _Pragma("unroll") for (int k = 0; k < 4; ++k) { const s16x4 lo_ = vlo[4 * d0 + k], hh_ = vhh[4 * d0 + k]; \
        const bf16x8 vf_ = (bf16x8){lo_[0], lo_[1], lo_[2], lo_[3], hh_[0], hh_[1], hh_[2], hh_[3]}; o[d0] = __builtin_amdgcn_mfma_f32_32x32x16_bf16(pa[k], vf_, o[d0], 0, 0, 0); } } while (0)
#define A3_ROWMAX(rm) do { float a_ = fmaxf(fmaxf(c0[0], c0[1]), c1[0]), b_ = fmaxf(fmaxf(c0[2], c0[3]), c1[1]); a_ = fmaxf(fmaxf(a_, c1[2]), c1[3]); \
        _Pragma("unroll") for (int r = 4; r < 16; r += 4) { a_ = fmaxf(fmaxf(a_, c0[r]), c0[r + 1]); b_ = fmaxf(fmaxf(b_, c0[r + 2]), c0[r + 3]); a_ = fmaxf(fmaxf(a_, c1[r]), c1[r + 1]); b_ = fmaxf(fmaxf(b_, c1[r + 2]), c1[r + 3]); } \
        rm = fmaxf(a_, b_); const auto rr_ = __builtin_amdgcn_permlane32_swap(__float_as_uint(rm), __float_as_uint(rm), false, false); rm = fmaxf(__uint_as_float(rr_[0]), __uint_as_float(rr_[1])); } while (0)
    int sl = A3_SLOT(0), sl3 = A3_SLOT(3);
    f32x16 pp0 = f32x16{}, pp1 = f32x16{}; bool pend = false; int pslot = 0;
    for (int i = 0; i < NTE; ++i) {
        const int t = NT - 1 - i;
        { const int ahead = NTE - 1 - i;
          if (ahead >= 2) asm volatile("s_waitcnt vmcnt(6)" ::: "memory"); else if (ahead == 1) asm volatile("s_waitcnt vmcnt(3)" ::: "memory"); else asm volatile("s_waitcnt vmcnt(0)" ::: "memory"); }
        __builtin_amdgcn_s_barrier(); asm volatile("" ::: "memory");
        if (i + 3 < NTE) A2_DMA(t - 3, sl3);
        if (i == NTE - 1 && qb_next >= 0) { const int NTn = 4 * qb_next + 4; A2_DMA(NTn - 1, A3_SLOT(NTE)); A2_DMA(NTn - 2, A3_SLOT(NTE + 1)); A2_DMA(NTn - 3, A3_SLOT(NTE + 2)); }
        if (t <= tlast) {
            bf16x8 kf[2 * DKH]; f32x16 c0, c1; float rm;
            A3_KLOADH(sl, 0);
            if (!pend) {
                A3_QKH(0); A3_KLOADH(sl, 1); A3_QKH(1);
                if (MODE == 0) { const int qrel = qw0 + r32 - 64 * t;
#pragma unroll
                    for (int r = 0; r < 16; ++r) { const int kv = crow(r, hi); if (kv > qrel) c0[r] = -INFINITY; if (kv + 32 > qrel) c1[r] = -INFINITY; } }
                A3_ROWMAX(rm);
                mhat = rm;
#pragma unroll
                for (int r = 0; r < 16; ++r) { c0[r] -= rm; c1[r] -= rm; negm[r] = -mhat; }
                pend = true;
            } else {
                s16x4 vlo[8], vhh[8]; bf16x8 pa[4];
                A3_QKH(0); A3_KLOADH(sl, 1);
                A3_VLOAD(pslot);
                A3_QKH(1);
                A3_EXP();
#pragma unroll
                for (int g_ = 0; g_ < 2 * DKS; ++g_) { __builtin_amdgcn_sched_group_barrier(0x008, 1, 0); __builtin_amdgcn_sched_group_barrier(0x002, 7, 0); }
                A3_PV();
                A3_ROWMAX(rm);
#pragma unroll
                for (int g_ = 0; g_ < 8; ++g_) { __builtin_amdgcn_sched_group_barrier(0x008, 1, 0); __builtin_amdgcn_sched_group_barrier(0x002, 3, 0); }
                if (__any(rm > THR)) {
                    const float dl = fmaxf(rm, 0.f); mhat += dl;
#pragma unroll
                    for (int r = 0; r < 16; ++r) { c0[r] -= dl; c1[r] -= dl; negm[r] = -mhat; }
                    const float f = __builtin_amdgcn_exp2f(-dl); lrun *= f;
                    if (hi == 0) wsf[r32] = f;
                    LDS_WAIT();
#pragma unroll
                    for (int g = 0; g < 4; ++g) { const f32x4 ff = *(const LAS f32x4*)(wsf + 8 * g + 4 * hi);
#pragma unroll
                        for (int j = 0; j < 4; ++j) { o[0][4 * g + j] *= ff[j]; o[1][4 * g + j] *= ff[j]; } }
                }
            }
            pp0 = c0; pp1 = c1; pslot = sl;
        }
        sl = (sl == NSL - 1) ? 0 : sl + 1; sl3 = (sl3 == NSL - 1) ? 0 : sl3 + 1;
    }
    if (qb_next >= 0) { const GAS bf16* Qn = T.Q + (rowbase + qb_next * 256 + wid * 32) * T.qp + h * (MODE ? 96 : 64);
#pragma unroll
        for (int d0 = 0; d0 < (MODE ? 6 : 4); ++d0) qr[d0] = *(const GAS bf16x8*)(Qn + (long)r32 * T.qp + d0 * 16 + hi * 8); }
    if (pend) { s16x4 vlo[8], vhh[8]; bf16x8 pa[4]; A3_VLOAD(pslot); A3_EXP(); A3_PV(); }
#undef A3_KLOADH
#undef A3_VLOAD
#undef A3_QKH
#undef A3_EXP
#undef A3_PV
#undef A3_ROWMAX
#undef A2_DMA
    lrun += __shfl_xor(lrun, 32);
    LDS_WAIT();
    if (hi == 0) wsf[32 + r32] = lrun;
    LDS_WAIT();
    float rli[16];
#pragma unroll
    for (int g = 0; g < 4; ++g) { const f32x4 ll = *(const LAS f32x4*)(wsf + 32 + 8 * g + 4 * hi);
#pragma unroll
        for (int j = 0; j < 4; ++j) rli[4 * g + j] = __builtin_amdgcn_rcpf(ll[j]); }
    GAS bf16* Ow = T.O + (rowbase + qw0) * 1024 + (MODE ? 0 : 512) + h * 64;
    { LAS bf16* stg = (LAS bf16*)(shm + R_OST) + wid * 2048;
#pragma unroll
      for (int r = 0; r < 16; ++r) { const int orow = crow(r, hi);
#pragma unroll
          for (int d0 = 0; d0 < 2; ++d0) stg[orow * 64 + d0 * 32 + r32] = (bf16)(cvt_pk_bf16(o[d0][r] * rli[r], 0.f) & 0xffffu); }
      LDS_WAIT();
#pragma unroll
      for (int i = 0; i < 4; ++i) { const int row = i * 8 + (lane >> 3), ch = lane & 7; const u32x4 v = *(const LAS u32x4*)(stg + row * 64 + ch * 8); *(GAS u32x4*)(Ow + (long)row * 1024 + ch * 8) = v;
          float sq = 0.f;
#pragma unroll
          for (int j = 0; j < 4; ++j) { const float a0 = __uint_as_float(v[j] << 16), a1 = __uint_as_float(v[j] & 0xffff0000u); sq += a0 * a0 + a1 * a1; }
          sq += __shfl_xor(sq, 1); sq += __shfl_xor(sq, 2); sq += __shfl_xor(sq, 4);
          if (ch == 0) T.OSS[(rowbase + qw0 + row) * 16 + (MODE ? 0 : 8) + h] = sq; } }
    if (qb_next < 0) { LDS_WAIT(); __builtin_amdgcn_s_barrier(); asm volatile("" ::: "memory"); }
    return A3_SLOT(NTE);
#undef A3_SLOT
}
}

struct Args { const void* in[21]; float* out; unsigned char* ws; int ph_lo, ph_hi; };

__device__ __forceinline__ void tr_item(const GAS float* __restrict__ W, int ldw, int Ksrc, const GAS float* __restrict__ gain, GAS bf16* __restrict__ WT, int ldk, int k0, int n0, int srccol, LAS float* scr, int lane) {
#pragma unroll 8
    for (int i = 0; i < 32; ++i) { const int kk = 2 * i + (lane >> 5); const int k = k0 + kk;
        float v = 0.f; if (srccol >= 0 && k < Ksrc) { v = __builtin_nontemporal_load(W + (size_t)k * ldw + srccol); if (gain) v *= gain[k]; }
        scr[kk * 33 + (lane & 31)] = v; }
    LDS_WAIT(); asm volatile("" ::: "memory");
    const int c = lane & 7;
#pragma unroll
    for (int j = 0; j < 4; ++j) { const int n = (lane >> 3) + 8 * j; const LAS float* s = scr + (8 * c) * 33 + n;
        u32x4 o; o.x = cvt_pk_bf16(s[0 * 33], s[1 * 33]); o.y = cvt_pk_bf16(s[2 * 33], s[3 * 33]); o.z = cvt_pk_bf16(s[4 * 33], s[5 * 33]); o.w = cvt_pk_bf16(s[6 * 33], s[7 * 33]);
        *(GAS u32x4*)(WT + (size_t)(n0 + n) * ldk + k0 + 8 * c) = o; }
    LDS_WAIT(); asm volatile("" ::: "memory");
}
__device__ __forceinline__ void tr_item64(const GAS float* __restrict__ W, int ldw, const GAS float* __restrict__ gain, GAS bf16* __restrict__ WT, int ldk, int k0, int n0src, int n0dst, LAS float* scr, int lane) {
    const int rr = lane >> 4, c4 = (lane & 15) * 4;
    f32x4 v[16];
#pragma unroll
    for (int i = 0; i < 16; ++i) v[i] = __builtin_nontemporal_load((const GAS f32x4*)(W + (size_t)(k0 + 4 * i + rr) * ldw + n0src + c4));
#pragma unroll
    for (int i = 0; i < 16; ++i) { const int k = 4 * i + rr; const float g = gain ? gain[k0 + k] : 1.f; LAS float* d = scr + k * 65 + c4;
        d[0] = v[i][0] * g; d[1] = v[i][1] * g; d[2] = v[i][2] * g; d[3] = v[i][3] * g; }
    LDS_WAIT(); asm volatile("" ::: "memory");
    const int kc = lane & 7;
#pragma unroll
    for (int j = 0; j < 8; ++j) { const int n = (lane >> 3) + 8 * j; const LAS float* sp = scr + (8 * kc) * 65 + n;
        u32x4 o; o.x = cvt_pk_bf16(sp[0 * 65], sp[1 * 65]); o.y = cvt_pk_bf16(sp[2 * 65], sp[3 * 65]); o.z = cvt_pk_bf16(sp[4 * 65], sp[5 * 65]); o.w = cvt_pk_bf16(sp[6 * 65], sp[7 * 65]);
        *(GAS u32x4*)(WT + (size_t)(n0dst + n) * ldk + k0 + 8 * kc) = o; }
    LDS_WAIT(); asm volatile("" ::: "memory");
}
__device__ __forceinline__ void tr_item64_f8(const GAS float* __restrict__ W, int ldw, const GAS float* __restrict__ gain, float scale, GAS unsigned char* __restrict__ WT8, int ldkB, int k0, int n0src, int n0dst, LAS float* scr, int lane) {
    const int rr = lane >> 4, c4 = (lane & 15) * 4;
    f32x4 v[16];
#pragma unroll
    for (int i = 0; i < 16; ++i) v[i] = __builtin_nontemporal_load((const GAS f32x4*)(W + (size_t)(k0 + 4 * i + rr) * ldw + n0src + c4));
#pragma unroll
    for (int i = 0; i < 16; ++i) { const int k = 4 * i + rr; const float g = (gain ? gain[k0 + k] : 1.f) * scale; LAS float* d = scr + k * 65 + c4;
        d[0] = v[i][0] * g; d[1] = v[i][1] * g; d[2] = v[i][2] * g; d[3] = v[i][3] * g; }
    LDS_WAIT(); asm volatile("" ::: "memory");
    const int kc = lane & 7;
#pragma unroll
    for (int j = 0; j < 8; ++j) { const int n = (lane >> 3) + 8 * j; const LAS float* sp = scr + (8 * kc) * 65 + n;
        u32x2 o; o.x = pk4_fp8(sp[0 * 65], sp[1 * 65], sp[2 * 65], sp[3 * 65]); o.y = pk4_fp8(sp[4 * 65], sp[5 * 65], sp[6 * 65], sp[7 * 65]);
        *(GAS u32x2*)(WT8 + (size_t)(n0dst + n) * ldkB + k0 + 8 * kc) = o; }
    LDS_WAIT(); asm volatile("" ::: "memory");
}
__device__ __forceinline__ int rope_dim(int p) { const int a = p >> 3, j = p & 7; return j < 4 ? 4 * a + j : 16 + 4 * a + (j - 4); }

#define LDP(i) ((void*)((((unsigned long long)(unsigned)__builtin_amdgcn_readfirstlane((int)(ARGP[i] >> 32))) << 32) | (unsigned long long)(unsigned)__builtin_amdgcn_readfirstlane((int)(unsigned)ARGP[i])))
#define ARGIN(i) ((const void*)LDP(i))
#define P_COS ((GAS float*)(ws + WS_COS))
#define P_SIN ((GAS float*)(ws + WS_SIN))
#define P_SSQ ((GAS float*)(ws + WS_SSQ))
#define P_FLOG ((GAS float*)(ws + WS_FLOG))
#define P_E01 ((GAS int*)(ws + WS_E01))
#define P_G01 ((GAS float*)(ws + WS_G01))
#define P_SLOT ((GAS int*)(ws + WS_SLOT))
#define P_TOKOF ((GAS int*)(ws + WS_TOKOF))
#define P_GATEOF ((GAS float*)(ws + WS_GATEOF))
#define P_CNT ((GAS int*)(ws + WS_CNT))
#define P_TSTART ((GAS int*)(ws + WS_TSTART))
#define P_RSTD ((GAS float*)(ws + WS_RSTD))
#define P_RSTDOF ((GAS float*)(ws + WS_RSTDOF))
#define P_KPE ((GAS bf16*)(ws + WS_KPE))
#define P_KAUG ((GAS bf16*)(ws + WS_KAUG))
#define P_BIASF ((GAS float*)(ws + WS_BIASF))
#define P_NRM ((GAS float*)(ws + WS_NRM))
#define P_WR ((GAS bf16*)(ws + WS_WR))
#define P_XR ((GAS bf16*)(ws + WS_XR))
#define P_OSS ((GAS float*)(ws + WS_OSS))
#define P_RSTDX ((GAS float*)(ws + WS_RSTDX))
#define P_WIN ((GAS bf16*)(ws + WS_WIN))
#define P_WUQ ((GAS bf16*)(ws + WS_WUQ))
#define P_WUKV ((GAS bf16*)(ws + WS_WUKV))
#define P_WOUT ((GAS bf16*)(ws + WS_WOUT))
#define P_WGU_L(ll) ((GAS unsigned char*)(ws + WS_WGU + (size_t)((ll) & 1) * 32 * MiB))
#define P_WD_L(ll) ((GAS unsigned char*)(ws + WS_WD + (size_t)((ll) & 1) * 16 * MiB))
#define P_XN ((GAS bf16*)(ws + WS_XN))
#define P_FQKV ((GAS bf16*)(ws + WS_FQKV))
#define P_HH ((GAS bf16*)(ws + WS_FQKV))
#define P_LAT ((GAS bf16*)(ws + WS_LAT))
#define P_QM ((GAS bf16*)(ws + WS_QM))
#define P_KVM ((GAS bf16*)(ws + WS_KVM))
#define P_Y ((GAS bf16*)(ws + WS_Y))
#define IN(k) (lo <= (k) && (k) < hi_)
#if MK_ONE_LAUNCH
#define GRID_BAR() xcd_barrier(bar)
#else
#define GRID_BAR() do {} while (0)
#endif
#define SEAM(k) do { if (IN(k) && IN((k) + 1)) GRID_BAR(); } while (0)
__device__ __forceinline__ void conv_gu_item(int r, const GAS float* w_gate, const GAS float* w_up, const GAS float* ffn_norm, GAS unsigned char* WGU, LAS float* scr64, int lane) {
    const int e = r / 256, q = r % 256, kb = q / 16, nb = q % 16; const int n0 = nb * 64; const int ct = n0 >> 8, which = (n0 >> 7) & 1, jj = n0 & 127;
    const GAS float* src = (which ? w_up : w_gate) + (size_t)e * DM * DEXP;
    tr_item64_f8(src, DEXP, ffn_norm, WSCALE, WGU + (size_t)e * 1024 * 1024, DM, kb * 64, ct * 128 + jj, n0, scr64, lane);
}
__device__ __forceinline__ void conv_d_item(int r, const GAS float* w_down, GAS unsigned char* WD, LAS float* scr64, int lane) {
    const int e = r / 128, q = r % 128, kb = q / 16, nb = q % 16;
    tr_item64_f8(w_down + (size_t)e * DEXP * DM, DM, nullptr, WSCALE, WD + (size_t)e * 1024 * 512, DEXP, kb * 64, nb * 64, nb * 64, scr64, lane);
}
template <int l>
__device__ __forceinline__ void layer_body(const int lo, const int hi_, LAS unsigned char* lds0, const int wave0, const int G0, const int bx0, const XcdBarrier& bar) {
        const int P = 10 * l;
        if (IN(P)) for (int rep_ = 0; rep_ < (l == 0 ? NREP(0) : 1); ++rep_) {
            unsigned ldsb_ = (unsigned)(uintptr_t)lds0; asm volatile("" : "+s"(ldsb_)); LAS unsigned char* lds = (LAS unsigned char*)(uintptr_t)ldsb_; volatile LAS unsigned* MISC = (volatile LAS unsigned*)(lds + MISC_OFF); volatile LAS unsigned long long* ARGP = (volatile LAS unsigned long long*)(lds + MISC_OFF + 768); (void)MISC; int wave = wave0, G = G0, bx = bx0; asm volatile("" : "+s"(G), "+s"(bx), "+s"(wave)); const int lane = (int)__builtin_amdgcn_mbcnt_hi(~0u, __builtin_amdgcn_mbcnt_lo(~0u, 0u)); const int tid = wave * 64 + lane; const int vcu = (bx % 8) * (G / 8) + bx / 8; const int gw = vcu * 8 + wave, NGW = G * 8; (void)lane; (void)gw; (void)NGW; (void)vcu;
            GAS unsigned char* ws = (GAS unsigned char*)LDP(22); GAS float* out = (GAS float*)LDP(21); const GAS float* x_in = (const GAS float*)ARGIN(0); const GAS int* positions = (const GAS int*)ARGIN(1);
            if (l < NLAYER) {
                LAS float* scr = (LAS float*)(lds + wave * 16640);
                const GAS float* attn_norm = (const GAS float*)ARGIN(2) + (size_t)l * DM; const GAS float* w_in = (const GAS float*)ARGIN(3) + (size_t)l * DM * INW;
                const GAS float* q_norm = (const GAS float*)ARGIN(5) + (size_t)l * 256; const GAS float* w_uq = (const GAS float*)ARGIN(6) + (size_t)l * 256 * 768;
                const GAS float* kv_norm = (const GAS float*)ARGIN(7) + (size_t)l * 128; const GAS float* w_ukv = (const GAS float*)ARGIN(8) + (size_t)l * 128 * 1024;
                const GAS float* mla_on = (const GAS float*)ARGIN(9) + (size_t)l * 512; const GAS float* fox_on = (const GAS float*)ARGIN(10) + (size_t)l * 512; const GAS float* w_out = (const GAS float*)ARGIN(11) + (size_t)l * DM * DM;
                const GAS float* ffn_norm = (const GAS float*)ARGIN(12) + (size_t)l * DM;
                const GAS float* w_gate = (const GAS float*)ARGIN(17) + (size_t)l * NEXP * DM * DEXP; const GAS float* w_up = (const GAS float*)ARGIN(18) + (size_t)l * NEXP * DM * DEXP; const GAS float* w_down = (const GAS float*)ARGIN(19) + (size_t)l * NEXP * DEXP * DM;
                constexpr int I_IN = 16 * 64, I_UQ = 4 * 24, I_UKV = 4 * 32;
                constexpr int NITEMS = I_IN + I_UQ + I_UKV;
                for (int it = gw; it < NITEMS; it += NGW) {
                    int r = it; const int j = lane & 31;
                    if (r < I_IN) { const int kb = r / 64, nb = r % 64; const int n = nb * 32 + j; int sc;
                        if (n < 384) sc = n; else if (n < 416) sc = 384 + rope_dim(n - 384); else if (n < 424) sc = 1952 + (n - 416); else if (n < 512) sc = -1; else sc = 416 + (n - 512);
                        tr_item(w_in, INW, DM, attn_norm, P_WIN, DM, kb * 64, nb * 32, sc, scr, lane); continue; } r -= I_IN;
                    if (r < I_UQ) { const int kb = r / 24, nb = r % 24; const int n = nb * 32 + j; const int hh = n / 96, d = n % 96; const int sc = d < 64 ? n : hh * 96 + 64 + rope_dim(d - 64);
                        tr_item(w_uq, 768, 256, q_norm, P_WUQ, 256, kb * 64, nb * 32, sc, scr, lane); continue; } r -= I_UQ;
                    { const int kb = r / 32, nb = r % 32; tr_item(w_ukv, 1024, 128, kv_norm, P_WUKV, 256, kb * 64, nb * 32, nb * 32 + j, scr, lane); }
                }
                LAS float* scr64 = (LAS float*)(lds + wave * 16640);
                constexpr int J_OUT = 16 * 16, J_GU = 16 * 16 * NEXP, J_D = 8 * 16 * NEXP;
                for (int it = gw; it < J_OUT + (l == 0 ? J_GU + J_D : 0); it += NGW) {
                    int r = it;
                    if (r < J_OUT) { const int kb = r / 16, nb = r % 16; const GAS float* gn = kb < 8 ? mla_on : fox_on - 512; tr_item64(w_out, DM, gn, P_WOUT, DM, kb * 64, nb * 64, nb * 64, scr64, lane); continue; } r -= J_OUT;
                    if (r < J_GU) { conv_gu_item(r, w_gate, w_up, ffn_norm, P_WGU_L(l), scr64, lane); continue; } r -= J_GU;
                    conv_d_item(r, w_down, P_WD_L(l), scr64, lane);
                }
                { const GAS float* w_rg = (const GAS float*)ARGIN(13) + (size_t)l * DM * 4; const GAS float* w_re = (const GAS float*)ARGIN(15) + (size_t)l * DM * 32;
                  for (int idx = bx * 512 + tid; idx < 2 * 48 * 520; idx += G * 512) { const int half = idx / (48 * 520), r = idx % (48 * 520), c = r / 520, kk = r % 520; const int k = half * 512 + kk;
                      float w = 0.f; if (c < 36 && kk < 512) w = ffn_norm[k] * (c < 4 ? w_rg[k * 4 + c] : w_re[k * 32 + (c - 4)]);
                      const unsigned h16 = cvt_pk_bf16(w, 0.f) & 0xffffu; const unsigned l16 = cvt_pk_bf16(w - __uint_as_float(h16 << 16), 0.f) & 0xffffu;
                      P_WR[(size_t)(half * 2 + 0) * 48 * 520 + r] = (bf16)h16; P_WR[(size_t)(half * 2 + 1) * 48 * 520 + r] = (bf16)l16; } }
            }
            const GAS float* fin = (const GAS float*)ARGIN(20);
            for (int mb = gw * 4; mb < NTOK; mb += NGW * 4) {
                f32x4 v[4][4]; int s0[4], s1[4];
                if (l > 0) {
#pragma unroll
                    for (int r = 0; r < 4; ++r) { s0[r] = P_SLOT[2 * (mb + r)]; s1[r] = P_SLOT[2 * (mb + r) + 1]; }
                }
#pragma unroll
                for (int r = 0; r < 4; ++r) {
                    if (l == 0) { const GAS float* xr = x_in + (size_t)(mb + r) * DM;
#pragma unroll
                        for (int j = 0; j < 4; ++j) v[r][j] = __builtin_nontemporal_load((const GAS f32x4*)(xr + 4 * lane + 256 * j)); }
                    else { const GAS bf16* xr = P_XR + (size_t)(mb + r) * DM;
#pragma unroll
                        for (int j = 0; j < 4; ++j) { const u32x2 w = __builtin_nontemporal_load((const GAS u32x2*)(xr + 4 * lane + 256 * j)); v[r][j] = (f32x4){__uint_as_float(w.x << 16), __uint_as_float(w.x & 0xffff0000u), __uint_as_float(w.y << 16), __uint_as_float(w.y & 0xffff0000u)}; } } }
                if (l > 0) {
#pragma unroll
                    for (int r = 0; r < 4; ++r)
#pragma unroll
                        for (int j = 0; j < 4; ++j) { const int a = __builtin_nontemporal_load((const GAS int*)((const GAS unsigned char*)P_Y + (size_t)s0[r] * 1024 + 4 * lane + 256 * j)), c = __builtin_nontemporal_load((const GAS int*)((const GAS unsigned char*)P_Y + (size_t)s1[r] * 1024 + 4 * lane + 256 * j));
                            const f32x2 a0 = __builtin_amdgcn_cvt_pk_f32_fp8(a, false), a1 = __builtin_amdgcn_cvt_pk_f32_fp8(a, true), c0 = __builtin_amdgcn_cvt_pk_f32_fp8(c, false), c1 = __builtin_amdgcn_cvt_pk_f32_fp8(c, true);
                            v[r][j][0] += (a0[0] + c0[0]) * WSCALE_INV; v[r][j][1] += (a0[1] + c0[1]) * WSCALE_INV; v[r][j][2] += (a1[0] + c1[0]) * WSCALE_INV; v[r][j][3] += (a1[1] + c1[1]) * WSCALE_INV; }
                }
                float ss[4];
#pragma unroll
                for (int r = 0; r < 4; ++r) { float s = 0.f;
#pragma unroll
                    for (int j = 0; j < 4; ++j) s += (v[r][j][0] * v[r][j][0] + v[r][j][1] * v[r][j][1]) + (v[r][j][2] * v[r][j][2] + v[r][j][3] * v[r][j][3]);
                    ss[r] = s; }
#pragma unroll
                for (int o = 1; o < 64; o <<= 1) {
#pragma unroll
                    for (int r = 0; r < 4; ++r) ss[r] += __shfl_xor(ss[r], o); }
#pragma unroll
                for (int r = 0; r < 4; ++r) { const int m = mb + r; const float rstd = rsqrtf(ss[r] * (1.f / DM) + EPS);
                    if (l < NLAYER) {
#pragma unroll
                        for (int j = 0; j < 4; ++j) { u32x2 w; w.x = cvt_pk_bf16(v[r][j][0], v[r][j][1]); w.y = cvt_pk_bf16(v[r][j][2], v[r][j][3]); *(GAS u32x2*)(P_XR + (size_t)m * DM + 4 * lane + 256 * j) = w; }
                        if (lane == 0) P_RSTDX[m] = rstd;
                    } else {
#pragma unroll
                        for (int j = 0; j < 4; ++j) { const f32x4 g = *(const GAS f32x4*)(fin + 4 * lane + 256 * j); __builtin_nontemporal_store(v[r][j] * rstd * g, (GAS f32x4*)(out + (size_t)m * DM + 4 * lane + 256 * j)); }
                    }
                }
            }
        }
        if constexpr (l == NLAYER) return;
        SEAM(P);
        if (IN(P + 1)) for (int rep_ = 0; rep_ < ((l == 0 || 1 != 5) ? NREP(1) : 1); ++rep_) {
            unsigned ldsb_ = (unsigned)(uintptr_t)lds0; asm volatile("" : "+s"(ldsb_)); LAS unsigned char* lds = (LAS unsigned char*)(uintptr_t)ldsb_; volatile LAS unsigned* MISC = (volatile LAS unsigned*)(lds + MISC_OFF); volatile LAS unsigned long long* ARGP = (volatile LAS unsigned long long*)(lds + MISC_OFF + 768); (void)MISC; int wave = wave0, G = G0, bx = bx0; asm volatile("" : "+s"(G), "+s"(bx), "+s"(wave)); const int lane = (int)__builtin_amdgcn_mbcnt_hi(~0u, __builtin_amdgcn_mbcnt_lo(~0u, 0u)); const int tid = wave * 64 + lane; const int vcu = (bx % 8) * (G / 8) + bx / 8; const int gw = vcu * 8 + wave, NGW = G * 8; (void)lane; (void)gw; (void)NGW; (void)vcu;
            GAS unsigned char* ws = (GAS unsigned char*)LDP(22); GAS float* out = (GAS float*)LDP(21); const GAS float* x_in = (const GAS float*)ARGIN(0); (void)out; (void)x_in; (void)ws;
            DenseOrder S{NTOK / 256, INP / 256, (NTOK / 256) * (INP / 256), G, bx, (const GAS char*)P_XR, (const GAS char*)P_WIN, (size_t)256 * DM * 2, (size_t)256 * DM * 2};
            EpiWin E{P_LAT, P_FQKV, P_KPE, P_FLOG, P_SSQ, P_COS, P_SIN, P_RSTDX};
            pg8::gemm_phase<EpiWin, DenseOrder, true, false>(tid, lds, DM * 2, DM * 2, DM * 2, S, E, nullptr);
        }
        SEAM(P + 1);
        if (IN(P + 2)) for (int rep_ = 0; rep_ < ((l == 0 || 2 != 5) ? NREP(2) : 1); ++rep_) {
            unsigned ldsb_ = (unsigned)(uintptr_t)lds0; asm volatile("" : "+s"(ldsb_)); LAS unsigned char* lds = (LAS unsigned char*)(uintptr_t)ldsb_; volatile LAS unsigned* MISC = (volatile LAS unsigned*)(lds + MISC_OFF); volatile LAS unsigned long long* ARGP = (volatile LAS unsigned long long*)(lds + MISC_OFF + 768); (void)MISC; int wave = wave0, G = G0, bx = bx0; asm volatile("" : "+s"(G), "+s"(bx), "+s"(wave)); const int lane = (int)__builtin_amdgcn_mbcnt_hi(~0u, __builtin_amdgcn_mbcnt_lo(~0u, 0u)); const int tid = wave * 64 + lane; const int vcu = (bx % 8) * (G / 8) + bx / 8; const int gw = vcu * 8 + wave, NGW = G * 8; (void)lane; (void)gw; (void)NGW; (void)vcu;
            GAS unsigned char* ws = (GAS unsigned char*)LDP(22); GAS float* out = (GAS float*)LDP(21); const GAS float* x_in = (const GAS float*)ARGIN(0); (void)out; (void)x_in; (void)ws;
            {
                const int sq = vcu >> 1, hf = vcu & 1; const int b = sq >> 3, h = sq & 7; const float bf = ((const GAS float*)ARGIN(4))[l * 8 + h];
                const GAS float* fl = P_FLOG + ((size_t)b * SEQ + hf * 1024 + 2 * tid) * 8 + h;
                float lf[2], lg[2] = {0.f, 0.f};
#pragma unroll
                for (int e = 0; e < 2; ++e) { const float f = fl[e * 8] + bf; lf[e] = fminf(f, 0.f) - log1pf(expf(-fabsf(f))); }
                if (hf) {
#pragma unroll
                    for (int e = 0; e < 2; ++e) { const float f = fl[e * 8 - 1024 * 8] + bf; lg[e] = fminf(f, 0.f) - log1pf(expf(-fabsf(f))); } }
                const double s2 = (double)lf[0] + (double)lf[1];
                double incl = s2, first = (double)lg[0] + (double)lg[1];
#pragma unroll
                for (int o = 1; o < 64; o <<= 1) { const double t = __shfl_up(incl, o); if (lane >= o) incl += t; first += __shfl_xor(first, o); }
                LAS double* wtot = (LAS double*)lds;
                if (lane == 63) wtot[wave] = incl;
                if (lane == 0) wtot[8 + wave] = first;
                __syncthreads();
                double c = incl - s2;
                for (int w = 0; w < wave; ++w) c += wtot[w];
                if (hf) { for (int w = 0; w < 8; ++w) c += wtot[8 + w]; }
                const size_t t0 = ((size_t)b * 8 + h) * SEQ + hf * 1024 + 2 * tid;
                GAS u32x4* ka = (GAS u32x4*)(P_KAUG + t0 * 8);
#pragma unroll
                for (int e = 0; e < 2; ++e) { c += (double)lf[e]; const float x = (float)(-c * 1.4426950408889634);
                    const unsigned h16 = cvt_pk_bf16(x, 0.f) & 0xffffu; const float r1 = x - __uint_as_float(h16 << 16); const unsigned m16 = cvt_pk_bf16(r1, 0.f) & 0xffffu; const float r2 = r1 - __uint_as_float(m16 << 16); const unsigned l16 = cvt_pk_bf16(r2, 0.f) & 0xffffu;
                    ka[e] = (u32x4){h16 | (m16 << 16), l16, 0u, 0u}; P_BIASF[t0 + e] = x; }
                float qn = 0.f, kn = 0.f;
                { const GAS bf16* fqp = P_FQKV + ((size_t)b * SEQ + hf * 1024 + 2 * tid) * 512 + h * 64; const GAS bf16* fkp = fqp + (size_t)NTOK * 512;
#pragma unroll
                  for (int e = 0; e < 2; ++e) { float sq_ = 0.f, sk = 0.f;
#pragma unroll
                      for (int c8 = 0; c8 < 8; ++c8) { const u32x4 a = *(const GAS u32x4*)(fqp + e * 512 + c8 * 8), k4 = *(const GAS u32x4*)(fkp + e * 512 + c8 * 8);
#pragma unroll
                          for (int j = 0; j < 4; ++j) { const float a0 = __uint_as_float(a[j] << 16), a1 = __uint_as_float(a[j] & 0xffff0000u), k0 = __uint_as_float(k4[j] << 16), k1 = __uint_as_float(k4[j] & 0xffff0000u);
                              sq_ += a0 * a0 + a1 * a1; sk += k0 * k0 + k1 * k1; } }
                      qn = fmaxf(qn, sq_); kn = fmaxf(kn, sk); } }
#pragma unroll
                for (int o = 1; o < 64; o <<= 1) { qn = fmaxf(qn, __shfl_xor(qn, o)); kn = fmaxf(kn, __shfl_xor(kn, o)); }
                LAS float* knw = (LAS float*)(lds + 256);
                if (lane == 0) { knw[wave] = kn; knw[8 + wave] = qn; }
                __syncthreads();
                if (tid < 4) P_NRM[sq * 16 + hf * 4 + tid] = sqrtf(fmaxf(knw[8 + 2 * tid], knw[8 + 2 * tid + 1]));
                if (tid == 4) { float m = knw[0]; for (int w = 1; w < 8; ++w) m = fmaxf(m, knw[w]); P_NRM[sq * 16 + 8 + hf] = sqrtf(m); }
                __syncthreads();
            }
            UpOrder S{G, vcu, (const GAS char*)P_LAT, (const GAS char*)P_WUQ, (const GAS char*)P_WUKV};
            EpiUp E{P_QM, P_KVM, P_SSQ, P_COS, P_SIN};
            pg8::gemm_phase<EpiUp, UpOrder, true, false>(tid, lds, 256 * 2, 512 * 2, 256 * 2, S, E, nullptr);
        }
        SEAM(P + 2);
        if (IN(P + 3)) for (int rep_ = 0; rep_ < ((l == 0 || 3 != 5) ? NREP(3) : 1); ++rep_) {
            unsigned ldsb_ = (unsigned)(uintptr_t)lds0; asm volatile("" : "+s"(ldsb_)); LAS unsigned char* lds = (LAS unsigned char*)(uintptr_t)ldsb_; volatile LAS unsigned* MISC = (volatile LAS unsigned*)(lds + MISC_OFF); volatile LAS unsigned long long* ARGP = (volatile LAS unsigned long long*)(lds + MISC_OFF + 768); (void)MISC; int wave = wave0, G = G0, bx = bx0; asm volatile("" : "+s"(G), "+s"(bx), "+s"(wave)); const int lane = (int)__builtin_amdgcn_mbcnt_hi(~0u, __builtin_amdgcn_mbcnt_lo(~0u, 0u)); const int tid = wave * 64 + lane; const int vcu = (bx % 8) * (G / 8) + bx / 8; const int gw = vcu * 8 + wave, NGW = G * 8; (void)lane; (void)gw; (void)NGW; (void)vcu;
            GAS unsigned char* ws = (GAS unsigned char*)LDP(22); GAS float* out = (GAS float*)LDP(21); const GAS float* x_in = (const GAS float*)ARGIN(0); (void)out; (void)x_in; (void)ws;
            GAS bf16* O = P_XN;
            const int b = vcu >> 4, hh = (vcu & 15) >> 1, sub = vcu & 1;
            const att::Tens2 TM{P_QM, 768, P_KVM, 1024, P_KPE, P_KVM + 64, 1024, O, nullptr, nullptr, P_OSS};
            const att::Tens2 TF{P_FQKV, 512, P_FQKV + (size_t)NTOK * 512, 512, P_KAUG, P_FQKV + (size_t)2 * NTOK * 512, 512, O, P_BIASF, P_NRM, P_OSS};
#define QB_OF(i) ((((i) & 1) ? 7 - (2 * sub + ((i) >> 1)) : (2 * sub + ((i) >> 1))))
            int ts0, ts1, ts2, ts3;
            { const GAS float* bs = P_BIASF + ((long)b * 8 + hh) * SEQ; const GAS float* nr = P_NRM + (b * 8 + hh) * 16; const float kmx = fmaxf(nr[8], nr[9]);
#define FOX_TS(i, dst) do { const int qb_ = QB_OF(i), NT_ = 4 * qb_ + 4; const float Z_ = nr[qb_] * kmx * 1.001f + 0.01f; const float bend_ = bs[(lane < NT_ ? lane : NT_ - 1) * 64 + 63]; \
                  const bool skip_ = (lane < NT_ - 4) && (2.f * Z_ + bend_ - bs[qb_ * 256] < -40.f); dst = __builtin_popcountll(__ballot(skip_)); } while (0)
              FOX_TS(0, ts0); FOX_TS(1, ts1); FOX_TS(2, ts2); FOX_TS(3, ts3);
#undef FOX_TS
            }
            if (wave >= 4) __builtin_amdgcn_s_setprio(1);
            bf16x8 qreg[6];
            { int sb = 0; for (int i = 0; i < 4; ++i) sb = att::attn_unit2<1>(wave, b, hh, QB_OF(i), TM, (LAS char*)lds, sb, i > 0, i < 3 ? QB_OF(i + 1) : -1, qreg, 0); }
            { int sb = 0; for (int i = 0; i < 4; ++i) { const int ts = i == 0 ? ts0 : i == 1 ? ts1 : i == 2 ? ts2 : ts3; sb = att::attn_unit2<0>(wave, b, hh, QB_OF(i), TF, (LAS char*)lds, sb, i > 0, i < 3 ? QB_OF(i + 1) : -1, qreg, ts); } }
#undef QB_OF
            __builtin_amdgcn_s_setprio(0);
        }
        SEAM(P + 3);
        if (IN(P + 5)) for (int rep_ = 0; rep_ < ((l == 0 || 5 != 5) ? NREP(5) : 1); ++rep_) {
            unsigned ldsb_ = (unsigned)(uintptr_t)lds0; asm volatile("" : "+s"(ldsb_)); LAS unsigned char* lds = (LAS unsigned char*)(uintptr_t)ldsb_; volatile LAS unsigned* MISC = (volatile LAS unsigned*)(lds + MISC_OFF); volatile LAS unsigned long long* ARGP = (volatile LAS unsigned long long*)(lds + MISC_OFF + 768); (void)MISC; int wave = wave0, G = G0, bx = bx0; asm volatile("" : "+s"(G), "+s"(bx), "+s"(wave)); const int lane = (int)__builtin_amdgcn_mbcnt_hi(~0u, __builtin_amdgcn_mbcnt_lo(~0u, 0u)); const int tid = wave * 64 + lane; const int vcu = (bx % 8) * (G / 8) + bx / 8; const int gw = vcu * 8 + wave, NGW = G * 8; (void)lane; (void)gw; (void)NGW; (void)vcu;
            GAS unsigned char* ws = (GAS unsigned char*)LDP(22); GAS float* out = (GAS float*)LDP(21); const GAS float* x_in = (const GAS float*)ARGIN(0); (void)out; (void)x_in; (void)ws;
            DenseOrder S{NTOK / 256, DM / 256, (NTOK / 256) * (DM / 256), G, bx, (const GAS char*)P_XN, (const GAS char*)P_WOUT, (size_t)256 * DM * 2, (size_t)256 * DM * 2};
            EpiOut<false> E{x_in, P_XR};
            LAS f32x2* scl = (LAS f32x2*)(lds + pg8::STAGE_BYTES);
            { Unit u_; if (S.next(tid >> 8, u_)) { const GAS float* op = P_OSS + ((size_t)u_.pm * 256 + (tid & 255)) * 16;
                  const f32x4 a0 = *(const GAS f32x4*)op, a1 = *(const GAS f32x4*)(op + 4), c0 = *(const GAS f32x4*)(op + 8), c1 = *(const GAS f32x4*)(op + 12);
                  const float sm = ((a0[0] + a0[1]) + (a0[2] + a0[3])) + ((a1[0] + a1[1]) + (a1[2] + a1[3])), sf = ((c0[0] + c0[1]) + (c0[2] + c0[3])) + ((c1[0] + c1[1]) + (c1[2] + c1[3]));
                  const float rm_ = rsqrtf(sm * (1.f / 512.f) + EPS), rf_ = rsqrtf(sf * (1.f / 512.f) + EPS);
                  scl[tid] = (f32x2){rm_ / rf_, rf_}; } }
            __syncthreads();
            pg8::gemm_phase<EpiOut<false>, DenseOrder, true, false, false, true>(tid, lds, DM * 2, DM * 2, DM * 2, S, E, nullptr, scl);
        }
        SEAM(P + 5);
        if (IN(P + 6)) for (int rep_ = 0; rep_ < ((l == 0 || 6 != 5) ? NREP(6) : 1); ++rep_) {
            unsigned ldsb_ = (unsigned)(uintptr_t)lds0; asm volatile("" : "+s"(ldsb_)); LAS unsigned char* lds = (LAS unsigned char*)(uintptr_t)ldsb_; volatile LAS unsigned* MISC = (volatile LAS unsigned*)(lds + MISC_OFF); volatile LAS unsigned long long* ARGP = (volatile LAS unsigned long long*)(lds + MISC_OFF + 768); (void)MISC; int wave = wave0, G = G0, bx = bx0; asm volatile("" : "+s"(G), "+s"(bx), "+s"(wave)); const int lane = (int)__builtin_amdgcn_mbcnt_hi(~0u, __builtin_amdgcn_mbcnt_lo(~0u, 0u)); const int tid = wave * 64 + lane; const int vcu = (bx % 8) * (G / 8) + bx / 8; const int gw = vcu * 8 + wave, NGW = G * 8; (void)lane; (void)gw; (void)NGW; (void)vcu;
            GAS unsigned char* ws = (GAS unsigned char*)LDP(22); GAS float* out = (GAS float*)LDP(21); const GAS float* x_in = (const GAS float*)ARGIN(0); (void)out; (void)x_in; (void)ws;
            GAS bf16* H2 = P_XN;
            LAS bf16* WT = (LAS bf16*)lds;
            LAS float* LG = (LAS float*)(lds + 99840) + wave * 576;
            const GAS float* b_rg = (const GAS float*)ARGIN(14) + l * 4; const GAS float* b_re = (const GAS float*)ARGIN(16) + l * 32;
            if (tid < 32) MISC[64 + tid] = 0u;
            const int r16 = lane & 15, g4 = lane >> 4;
            const int m0 = vcu * 128 + wave * 16;
            const GAS bf16* xrow = P_XR + (size_t)(m0 + r16) * DM + 8 * g4;
            GAS unsigned char* hrow = (GAS unsigned char*)H2 + (size_t)(m0 + r16) * DM + 8 * g4;
            f32x4 acc3[3]; acc3[0] = (f32x4){0.f, 0.f, 0.f, 0.f}; acc3[1] = acc3[0]; acc3[2] = acc3[0];
            float ssq = 0.f;
            for (int half = 0; half < 2; ++half) {
                __syncthreads();
                for (int idx = tid; idx < 2 * 48 * 520 / 8; idx += 512) *(LAS u32x4*)(WT + 8 * idx) = *(const GAS u32x4*)(P_WR + (size_t)half * 2 * 48 * 520 + 8 * idx);
                __syncthreads();
                for (int s8 = 0; s8 < 16; s8 += 8) {
                    bf16x8 xv[8];
#pragma unroll
                    for (int u = 0; u < 8; ++u) xv[u] = *(const GAS bf16x8*)(xrow + half * 512 + 32 * (s8 + u));
#pragma unroll
                    for (int u = 0; u < 8; ++u) {
                        const u32x4 xw = __builtin_bit_cast(u32x4, xv[u]); float xf[8];
#pragma unroll
                        for (int j = 0; j < 4; ++j) { xf[2 * j] = __uint_as_float(xw[j] << 16); xf[2 * j + 1] = __uint_as_float(xw[j] & 0xffff0000u); }
                        u32x2 hw; hw.x = pk4_fp8(xf[0], xf[1], xf[2], xf[3]); hw.y = pk4_fp8(xf[4], xf[5], xf[6], xf[7]); *(GAS u32x2*)(hrow + half * 512 + 32 * (s8 + u)) = hw;
#pragma unroll
                        for (int j = 0; j < 8; ++j) ssq += xf[j] * xf[j];
                        const LAS bf16* wk = WT + r16 * 520 + 32 * (s8 + u) + 8 * g4;
#pragma unroll
                        for (int ct = 0; ct < 3; ++ct) { const bf16x8 bh = *(const LAS bf16x8*)(wk + ct * 16 * 520), bl = *(const LAS bf16x8*)(wk + (48 + ct * 16) * 520);
                            acc3[ct] = __builtin_amdgcn_mfma_f32_16x16x32_bf16(xv[u], bh, acc3[ct], 0, 0, 0); acc3[ct] = __builtin_amdgcn_mfma_f32_16x16x32_bf16(xv[u], bl, acc3[ct], 0, 0, 0); }
                    }
                }
            }
            ssq += __shfl_xor(ssq, 16); ssq += __shfl_xor(ssq, 32);
            const float rstd = rsqrtf(ssq * (1.f / DM) + EPS);
#pragma unroll
            for (int ct = 0; ct < 3; ++ct) { const int c = 16 * ct + r16; if (c < 36) {
#pragma unroll
                for (int rg = 0; rg < 4; ++rg) LG[(4 * g4 + rg) * 36 + c] = acc3[ct][rg]; } }
            LDS_WAIT();
            if (lane < 16) {
                const int m = m0 + lane; const LAS float* lg = LG + lane * 36;
                float gl[4];
#pragma unroll
                for (int g = 0; g < 4; ++g) gl[g] = lg[g] * rstd + b_rg[g];
                int gi = 0; float gm = gl[0];
#pragma unroll
                for (int g = 1; g < 4; ++g) if (gl[g] > gm) { gm = gl[g]; gi = g; }
                float gs = 0.f;
#pragma unroll
                for (int g = 0; g < 4; ++g) gs += __expf(gl[g] - gm);
                const float gval = 1.f / gs;
                float el[8];
#pragma unroll
                for (int j = 0; j < 8; ++j) el[j] = lg[4 + 8 * gi + j] * rstd + b_re[8 * gi + j];
                int i0 = 0; float mx0 = el[0];
#pragma unroll
                for (int j = 1; j < 8; ++j) if (el[j] > mx0) { mx0 = el[j]; i0 = j; }
                int i1 = -1; float mx1 = -INFINITY;
#pragma unroll
                for (int j = 0; j < 8; ++j) if (j != i0 && el[j] > mx1) { mx1 = el[j]; i1 = j; }
                const float e1 = __expf(mx1 - mx0); const float g0 = gval / (1.f + e1), g1 = gval * e1 / (1.f + e1);
                const int ea = gi * 8 + i0, eb = gi * 8 + i1; P_E01[2 * m] = ea; P_E01[2 * m + 1] = eb; P_G01[2 * m] = g0; P_G01[2 * m + 1] = g1; P_RSTD[m] = rstd;
                __hip_atomic_fetch_add((LAS unsigned*)(lds + MISC_OFF) + 64 + ea, 1u, __ATOMIC_RELAXED, __HIP_MEMORY_SCOPE_WORKGROUP); __hip_atomic_fetch_add((LAS unsigned*)(lds + MISC_OFF) + 64 + eb, 1u, __ATOMIC_RELAXED, __HIP_MEMORY_SCOPE_WORKGROUP);
            }
            __syncthreads();
            if (tid < 32) P_CNT[vcu * 32 + tid] = (int)MISC[64 + tid];
        }
        SEAM(P + 6);
        if (IN(P + 7)) for (int rep_ = 0; rep_ < ((l == 0 || 7 != 5) ? NREP(7) : 1); ++rep_) {
            unsigned ldsb_ = (unsigned)(uintptr_t)lds0; asm volatile("" : "+s"(ldsb_)); LAS unsigned char* lds = (LAS unsigned char*)(uintptr_t)ldsb_; volatile LAS unsigned* MISC = (volatile LAS unsigned*)(lds + MISC_OFF); volatile LAS unsigned long long* ARGP = (volatile LAS unsigned long long*)(lds + MISC_OFF + 768); (void)MISC; int wave = wave0, G = G0, bx = bx0; asm volatile("" : "+s"(G), "+s"(bx), "+s"(wave)); const int lane = (int)__builtin_amdgcn_mbcnt_hi(~0u, __builtin_amdgcn_mbcnt_lo(~0u, 0u)); const int tid = wave * 64 + lane; const int vcu = (bx % 8) * (G / 8) + bx / 8; const int gw = vcu * 8 + wave, NGW = G * 8; (void)lane; (void)gw; (void)NGW; (void)vcu;
            GAS unsigned char* ws = (GAS unsigned char*)LDP(22); GAS float* out = (GAS float*)LDP(21); const GAS float* x_in = (const GAS float*)ARGIN(0); (void)out; (void)x_in; (void)ws;
            LAS int* cnt_all = (LAS int*)lds;
            LAS int* pre_e = (LAS int*)(lds + 32768);
            LAS int* tot_e = pre_e + 32;
            LAS int* pst = pre_e + 64;
            LAS int* eL = pre_e + 128;
            for (int i = tid; i < 256 * 32; i += 512) cnt_all[i] = P_CNT[i];
            if (tid < 256) eL[tid] = P_E01[vcu * 256 + tid];
            __syncthreads();
            { LAS int* part = pre_e + 512;
              const int e = tid & 31, p = tid >> 5; int pre = 0, tot = 0;
#pragma unroll
              for (int j = 0; j < 16; ++j) { const int w = p * 16 + j; const int c = cnt_all[w * 32 + e]; pre += (w < vcu) ? c : 0; tot += c; }
              part[(p * 2) * 32 + e] = pre; part[(p * 2 + 1) * 32 + e] = tot; }
            __syncthreads();
            if (tid < 32) { LAS int* part = pre_e + 512; int pre = 0, tot = 0;
#pragma unroll
                for (int p = 0; p < 16; ++p) { pre += part[(p * 2) * 32 + tid]; tot += part[(p * 2 + 1) * 32 + tid]; } pre_e[tid] = pre; tot_e[tid] = tot; }
            __syncthreads();
            if (tid == 0) { int acc = 0; for (int e = 0; e < 32; ++e) { pst[e] = acc; acc += (tot_e[e] + 255) / 256 * 256; } pst[32] = acc; }
            __syncthreads();
            if (vcu == 0 && tid <= 32) P_TSTART[tid] = pst[tid] / 256;
            { LAS int* hist = pre_e + 2048;
              if (tid < 128) hist[tid] = 0;
              __syncthreads();
              int e = 0, rin = 0;
              if (tid < 256) { e = eL[tid]; unsigned long long mym = 0ull;
                  for (int x = 0; x < 32; ++x) { const unsigned long long bm = __ballot(e == x); if (e == x) mym = bm; }
                  rin = __builtin_popcountll(mym & ((1ull << lane) - 1ull));
                  if (rin == 0) hist[wave * 32 + e] = __builtin_popcountll(mym); }
              __syncthreads();
              if (tid < 256) { int r = rin; for (int w = 0; w < wave; ++w) r += hist[w * 32 + e];
                  const int slot = pst[e] + pre_e[e] + r; const int tok = vcu * 128 + (tid >> 1);
                  P_SLOT[vcu * 256 + tid] = slot; P_TOKOF[slot] = tok; P_GATEOF[slot] = P_G01[vcu * 256 + tid]; P_RSTDOF[slot] = P_RSTD[tok]; } }
            if (vcu < 32) { const int e = vcu; for (int s = pst[e] + tot_e[e] + tid; s < pst[e + 1]; s += 512) { P_TOKOF[s] = 0; P_GATEOF[s] = 0.f; P_RSTDOF[s] = 0.f; } }
            __syncthreads();
        }
        SEAM(P + 7);
        if (IN(P + 8)) for (int rep_ = 0; rep_ < ((l == 0 || 8 != 5) ? NREP(8) : 1); ++rep_) {
            unsigned ldsb_ = (unsigned)(uintptr_t)lds0; asm volatile("" : "+s"(ldsb_)); LAS unsigned char* lds = (LAS unsigned char*)(uintptr_t)ldsb_; volatile LAS unsigned* MISC = (volatile LAS unsigned*)(lds + MISC_OFF); volatile LAS unsigned long long* ARGP = (volatile LAS unsigned long long*)(lds + MISC_OFF + 768); (void)MISC; int wave = wave0, G = G0, bx = bx0; asm volatile("" : "+s"(G), "+s"(bx), "+s"(wave)); const int lane = (int)__builtin_amdgcn_mbcnt_hi(~0u, __builtin_amdgcn_mbcnt_lo(~0u, 0u)); const int tid = wave * 64 + lane; const int vcu = (bx % 8) * (G / 8) + bx / 8; const int gw = vcu * 8 + wave, NGW = G * 8; (void)lane; (void)gw; (void)NGW; (void)vcu;
            GAS unsigned char* ws = (GAS unsigned char*)LDP(22); GAS float* out = (GAS float*)LDP(21); const GAS float* x_in = (const GAS float*)ARGIN(0); (void)out; (void)x_in; (void)ws;
            volatile LAS int* TS = (volatile LAS int*)(MISC + 128);
            if (tid <= 32) TS[tid] = P_TSTART[tid];
            __syncthreads();
            MoeOrder S{G, vcu, TS, (const GAS char*)P_XN, (const GAS char*)P_WGU_L(l), 0, (size_t)1024 * 1024, (size_t)256 * 1024};
            EpiGU E{(GAS unsigned char*)P_HH, P_RSTDOF};
            pg8::gemm_phase<EpiGU, MoeOrder, true, true, true>(tid, lds, DM, DM, DM, S, E, P_TOKOF);
            if constexpr (l + 1 < NLAYER) {
                const int U = (int)TS[32] * 4, rem = U & 255; const int nidle = rem ? 256 - rem : 256, rk = rem ? vcu - rem : vcu;
                if (rk >= 0) { LAS float* scr64 = (LAS float*)(lds + wave * 16640);
                    const GAS float* w_gate = (const GAS float*)ARGIN(17) + (size_t)(l + 1) * NEXP * DM * DEXP; const GAS float* w_up = (const GAS float*)ARGIN(18) + (size_t)(l + 1) * NEXP * DM * DEXP; const GAS float* ffn1 = (const GAS float*)ARGIN(12) + (size_t)(l + 1) * DM;
                    for (int it = rk * 8 + wave; it < 16 * 16 * NEXP; it += nidle * 8) conv_gu_item(it, w_gate, w_up, ffn1, P_WGU_L(l + 1), scr64, lane); }
            }
        }
        SEAM(P + 8);
        if (IN(P + 9)) for (int rep_ = 0; rep_ < ((l == 0 || 9 != 5) ? NREP(9) : 1); ++rep_) {
            unsigned ldsb_ = (unsigned)(uintptr_t)lds0; asm volatile("" : "+s"(ldsb_)); LAS unsigned char* lds = (LAS unsigned char*)(uintptr_t)ldsb_; volatile LAS unsigned* MISC = (volatile LAS unsigned*)(lds + MISC_OFF); volatile LAS unsigned long long* ARGP = (volatile LAS unsigned long long*)(lds + MISC_OFF + 768); (void)MISC; int wave = wave0, G = G0, bx = bx0; asm volatile("" : "+s"(G), "+s"(bx), "+s"(wave)); const int lane = (int)__builtin_amdgcn_mbcnt_hi(~0u, __builtin_amdgcn_mbcnt_lo(~0u, 0u)); const int tid = wave * 64 + lane; const int vcu = (bx % 8) * (G / 8) + bx / 8; const int gw = vcu * 8 + wave, NGW = G * 8; (void)lane; (void)gw; (void)NGW; (void)vcu;
            GAS unsigned char* ws = (GAS unsigned char*)LDP(22); GAS float* out = (GAS float*)LDP(21); const GAS float* x_in = (const GAS float*)ARGIN(0); (void)out; (void)x_in; (void)ws;
            volatile LAS int* TS = (volatile LAS int*)(MISC + 128);
            if (tid <= 32) TS[tid] = P_TSTART[tid];
            __syncthreads();
            MoeOrder S{G, vcu, TS, (const GAS char*)P_HH, (const GAS char*)P_WD_L(l), (size_t)256 * 512, (size_t)1024 * 512, (size_t)256 * 512};
            EpiDown E{(GAS unsigned char*)P_Y, P_GATEOF};
            pg8::gemm_phase<EpiDown, MoeOrder, true, false, true>(tid, lds, DEXP, DEXP, DEXP, S, E, nullptr);
            if constexpr (l + 1 < NLAYER) {
                const int U = (int)TS[32] * 4, rem = U & 255; const int nidle = rem ? 256 - rem : 256, rk = rem ? vcu - rem : vcu;
                if (rk >= 0) { LAS float* scr64 = (LAS float*)(lds + wave * 16640);
                    const GAS float* w_down = (const GAS float*)ARGIN(19) + (size_t)(l + 1) * NEXP * DEXP * DM;
                    for (int it = rk * 8 + wave; it < 8 * 16 * NEXP; it += nidle * 8) conv_d_item(it, w_down, P_WD_L(l + 1), scr64, lane); }
            }
        }
        SEAM(P + 9);
}

__global__ void __launch_bounds__(512, 2) fwd(Args args) {
    extern __shared__ __attribute__((aligned(16))) unsigned char lds_raw[];
    LAS unsigned char* lds0 = (LAS unsigned char*)lds_raw;
    const int tid0 = threadIdx.x; const int wave0 = __builtin_amdgcn_readfirstlane(tid0 >> 6);
    const int G0 = gridDim.x; const int bx0 = blockIdx.x;
    { volatile LAS unsigned* MISC = (volatile LAS unsigned*)(lds0 + MISC_OFF); const int tid = tid0;
    for (int u = tid; u < 256; u += 512) MISC[u] = 0u;
    __syncthreads();
    volatile LAS unsigned long long* ARGP = (volatile LAS unsigned long long*)(lds0 + MISC_OFF + 768);
    if (tid < 21) ARGP[tid] = (unsigned long long)args.in[tid];
    if (tid == 21) ARGP[21] = (unsigned long long)args.out;
    if (tid == 22) ARGP[22] = (unsigned long long)args.ws;
    __syncthreads(); }
#if MK_ONE_LAUNCH
    XcdBarrier bar = xcd_barrier_post((unsigned*)(args.ws + WS_CTL) + CW_BAR, (volatile LAS unsigned*)(lds0 + MISC_OFF) + 8);
#else
    XcdBarrier bar; bar.bar = nullptr; bar.x = 0; bar.st = nullptr;
#endif
    const int lo = args.ph_lo, hi_ = args.ph_hi;
    if (IN(0)) {
        const GAS int* positions = (const GAS int*)args.in[1]; GAS float* COSp = (GAS float*)(args.ws + WS_COS); GAS float* SINp = (GAS float*)(args.ws + WS_SIN);
        for (int i = bx0 * 512 + tid0; i < NTOK * 16; i += G0 * 512) { const int tk = i >> 4, fi = i & 15;
            const double invrev = exp2(-(double)fi * (13.287712379549449 / 16.0)) * 0.15915494309189535; const double rev = (double)positions[tk] * invrev; const float fr = (float)(rev - rint(rev));
            COSp[i] = __builtin_amdgcn_cosf(fr); SINp[i] = __builtin_amdgcn_sinf(fr); }
    }
    layer_body<0>(lo, hi_, lds0, wave0, G0, bx0, bar);
    layer_body<1>(lo, hi_, lds0, wave0, G0, bx0, bar);
    layer_body<2>(lo, hi_, lds0, wave0, G0, bx0, bar);
}

extern "C" void kernel_launch(void* const* d_in, const int* in_sizes, int n_in, void* d_out, int out_size, void* d_ws, size_t ws_size, hipStream_t stream) {
    static int grid = 0;
    if (grid == 0) {
        if (n_in != 21 || out_size != NTOK * DM || ws_size < WS_END) { fprintf(stderr, "kernel_launch: unexpected shapes (n_in %d out %d ws %zu)\n", n_in, out_size, ws_size); grid = -1; return; }
        int dev = 0, cus = 0;
        if (hipGetDevice(&dev) != hipSuccess || hipDeviceGetAttribute(&cus, hipDeviceAttributeMultiprocessorCount, dev) != hipSuccess) { grid = -1; return; }
        if (hipFuncSetAttribute((const void*)fwd, hipFuncAttributeMaxDynamicSharedMemorySize, LDS_BYTES) != hipSuccess) { fprintf(stderr, "kernel_launch: hipFuncSetAttribute failed\n"); grid = -1; return; }
        int per_cu = 0;
        if (hipOccupancyMaxActiveBlocksPerMultiprocessor(&per_cu, (const void*)fwd, 512, LDS_BYTES) != hipSuccess || per_cu < 1) fprintf(stderr, "kernel_launch: occupancy query says %d\n", per_cu);
        (void)hipGetLastError();
        grid = cus;
        if (grid != 256) { fprintf(stderr, "kernel_launch: built for 256 CUs, got %d\n", grid); grid = -1; return; }
    }
    if (grid < 0) return;
    if (hipMemsetAsync((char*)d_ws + WS_CTL, 0, CTL_ZERO_BYTES, stream) != hipSuccess) return;
    Args a{};
    for (int i = 0; i < 21; ++i) a.in[i] = d_in[i];
    a.out = (float*)d_out; a.ws = (unsigned char*)d_ws;
#if MK_ONE_LAUNCH
    a.ph_lo = 0; a.ph_hi = 21;
    hipLaunchKernelGGL(fwd, dim3(grid), dim3(512), LDS_BYTES, stream, a);
#else
    for (int p = 0; p <= 20; ++p) { a.ph_lo = p; a.ph_hi = p + 1; hipLaunchKernelGGL(fwd, dim3(grid), dim3(512), LDS_BYTES, stream, a); }
#endif
}
```

```cpp
#include <hip/hip_runtime.h>
#include <cstdio>
#include <cstdint>

#ifndef PROBE_PHASE
#define PROBE_PHASE -1
#endif
#define NREP(k) ((PROBE_PHASE) == (k) ? 2 : 1)
#ifndef MK_ONE_LAUNCH
#define MK_ONE_LAUNCH 1
#endif

#define LAS __attribute__((address_space(3)))
#define GAS __attribute__((address_space(1)))
typedef unsigned short bf16;
typedef short bf16x8 __attribute__((ext_vector_type(8)));
typedef short s16x4 __attribute__((ext_vector_type(4)));
typedef float f32x4 __attribute__((ext_vector_type(4)));
typedef float f32x2 __attribute__((ext_vector_type(2)));
typedef float f32x16 __attribute__((ext_vector_type(16)));
typedef unsigned u32x4 __attribute__((ext_vector_type(4)));
typedef unsigned u32x2 __attribute__((ext_vector_type(2)));

constexpr int NB = 16, SEQ = 2048, DM = 1024, NTOK = NB * SEQ, NLAYER = 2;
constexpr int INW = 1960, INP = 2048;
constexpr int NEXP = 32, DEXP = 512;
constexpr int MAXSLOT = 73728;
constexpr float EPS = 1e-6f;
constexpr float WSCALE = 64.f, WSCALE_INV = 1.f / 64.f;
constexpr float LOG2E = 1.4426950408889634f;
constexpr float C2F = 0.125f * LOG2E;
constexpr float C2M = 0.10206207261596575f * LOG2E;

constexpr size_t MiB = 1u << 20, KiB = 1u << 10;
constexpr size_t WS_CTL = 0, CTL_ZERO_BYTES = 64 * KiB;
constexpr size_t WS_COS = 1 * MiB, WS_SIN = 3 * MiB;
constexpr size_t WS_SSQ = 5 * MiB;
constexpr size_t WS_FLOG = 6 * MiB;
constexpr size_t WS_E01 = 8 * MiB;
constexpr size_t WS_G01 = 8 * MiB + 256 * KiB;
constexpr size_t WS_SLOT = 8 * MiB + 512 * KiB;
constexpr size_t WS_TOKOF = 8 * MiB + 768 * KiB;
constexpr size_t WS_GATEOF = 9 * MiB + 256 * KiB;
constexpr size_t WS_CNT = 9 * MiB + 768 * KiB;
constexpr size_t WS_TSTART = 9 * MiB + 800 * KiB;
constexpr size_t WS_RSTD = 9 * MiB + 832 * KiB;
constexpr size_t WS_RSTDOF = 7 * MiB;
constexpr size_t WS_KPE = 10 * MiB;
constexpr size_t WS_KAUG = 10 * MiB + 2 * MiB;
constexpr size_t WS_WIN = 16 * MiB;
constexpr size_t WS_WUQ = 20 * MiB;
constexpr size_t WS_WUKV = 20 * MiB + 512 * KiB;
constexpr size_t WS_WOUT = 21 * MiB;
constexpr size_t WS_WGU = 24 * MiB;
constexpr size_t WS_WD = 88 * MiB;
constexpr size_t WS_XN = 120 * MiB;
constexpr size_t WS_FQKV = 184 * MiB;
constexpr size_t WS_LAT = 280 * MiB;
constexpr size_t WS_QM = 312 * MiB;
constexpr size_t WS_KVM = 360 * MiB;
constexpr size_t WS_Y = 280 * MiB;
constexpr size_t WS_BIASF = 424 * MiB;
constexpr size_t WS_NRM = 425 * MiB;
constexpr size_t WS_WR = 426 * MiB;
constexpr size_t WS_XR = 427 * MiB;
constexpr size_t WS_OSS = 491 * MiB;
constexpr size_t WS_RSTDX = 493 * MiB;
constexpr size_t WS_END = 494 * MiB;
static_assert(WS_Y + (size_t)MAXSLOT * 1024 * 2 <= WS_END, "Y fits");
static_assert(WS_FQKV + (size_t)MAXSLOT * 512 * 2 <= WS_LAT, "HH fits");

constexpr int CW_BAR = 1024;

constexpr int RING_BYTES = 147456;
constexpr int MISC_OFF = RING_BYTES;
constexpr int LDS_BYTES = RING_BYTES + 1024;

typedef __bf16 bf16x2_t __attribute__((ext_vector_type(2)));
__device__ __forceinline__ unsigned cvt_pk_bf16(float lo, float hi) { const f32x2 v = {lo, hi}; const bf16x2_t b = __builtin_convertvector(v, bf16x2_t); return __builtin_bit_cast(unsigned, b); }
__device__ __forceinline__ float bf2f(unsigned short b) { return __uint_as_float((unsigned)b << 16); }
__device__ __forceinline__ float wave_sum(float v) {
#pragma unroll
    for (int o = 1; o < 64; o <<= 1) v += __shfl_xor(v, o);
    return v;
}
__device__ __forceinline__ unsigned pk4_fp8(float a, float b, float c, float d) { int w = 0; w = __builtin_amdgcn_cvt_pk_fp8_f32(a, b, w, false); w = __builtin_amdgcn_cvt_pk_fp8_f32(c, d, w, true); return (unsigned)w; }
#define LDS_WAIT() asm volatile("s_waitcnt lgkmcnt(0)" ::: "memory")

#define XB_TMO      128
#define XB_XCNT(j)  (256  + 64 * (j))
#define XB_XSUB(j)  (1280 + 64 * (j))
#define XB_XGEN(j)  (2304 + 64 * (j))
#define XB_TOP      3328
#define XB_TOPGEN   3392
#define XCD_BAR_WORDS 3456
#define XB_SPIN_CAP (1u << 18)
__device__ __forceinline__ unsigned xb_ld(unsigned* p)              { return __hip_atomic_load(p, __ATOMIC_RELAXED, __HIP_MEMORY_SCOPE_AGENT); }
__device__ __forceinline__ unsigned xb_add(unsigned* p, unsigned v) { return __hip_atomic_fetch_add(p, v, __ATOMIC_RELAXED, __HIP_MEMORY_SCOPE_AGENT); }
__device__ __forceinline__ unsigned xb_xcc_id() { return (unsigned)__builtin_amdgcn_s_getreg((3 << 11) | 20) & 0xFu; }
#define XB_SPIN(cond, bar) do { unsigned _sp = 0; while (cond) { __builtin_amdgcn_s_sleep(1); \
    if ((++_sp & 255u) == 0u) { if (xb_ld(&(bar)[XB_TMO])) break; if (_sp > XB_SPIN_CAP) { atomicAdd(&(bar)[XB_TMO], 1u); break; } } } } while (0)
struct XcdBarrier { unsigned* bar; unsigned x; volatile LAS unsigned* st; };
__device__ __forceinline__ XcdBarrier xcd_barrier_post(unsigned* bar, volatile LAS unsigned* st) {
    XcdBarrier b; b.bar = bar; b.x = xb_xcc_id(); b.st = st;
    if (threadIdx.x == 0) (void)xb_add(&bar[XB_XCNT(b.x)], 1u);
    return b;
}
__device__ __forceinline__ void xcd_barrier_complete(unsigned* bar, unsigned x, unsigned& nloc, unsigned& nx) {
    const unsigned G = gridDim.x * gridDim.y * gridDim.z;
    unsigned sum, cnt, mine, sp = 0u;
    for (;;) {
        sum = 0u; cnt = 0u; mine = 0u;
#pragma unroll
        for (unsigned j = 0; j < 16; ++j) { const unsigned c = xb_ld(&bar[XB_XCNT(j)]); sum += c; cnt += (c > 0u) ? 1u : 0u; mine = (j == x) ? c : mine; }
        if (sum == G) break;
        __builtin_amdgcn_s_sleep(1);
        if ((++sp & 255u) == 0u) { if (xb_ld(&bar[XB_TMO])) break; if (sp > XB_SPIN_CAP) { atomicAdd(&bar[XB_TMO], 1u); break; } }
    }
    nloc = mine > 0u ? mine : 1u; nx = cnt > 0u ? cnt : 1u;
}
__device__ __forceinline__ void xcd_barrier(const XcdBarrier& b) {
    asm volatile("s_waitcnt vmcnt(0)" ::: "memory");
    __syncthreads();
    if (threadIdx.x == 0) {
        unsigned* bar = b.bar;
        __builtin_amdgcn_s_waitcnt(0);
        unsigned nloc = b.st[0], nx = b.st[1];
        if (nloc == 0u) { xcd_barrier_complete(bar, b.x, nloc, nx); b.st[0] = nloc; b.st[1] = nx; }
        const unsigned old = xb_add(&bar[XB_XSUB(b.x)], 1u);
        const unsigned gen = old / nloc;
        if (old + 1u == (gen + 1u) * nloc) {
            __builtin_amdgcn_fence(__ATOMIC_RELEASE, "agent");
            asm volatile("s_waitcnt vmcnt(0)" ::: "memory");
            const unsigned og = xb_add(&bar[XB_TOP], 1u);
            const unsigned tg = og / nx;
            if (og + 1u == (tg + 1u) * nx) xb_add(&bar[XB_TOPGEN], 1u);
            else XB_SPIN(xb_ld(&bar[XB_TOPGEN]) == tg, bar);
            __builtin_amdgcn_fence(__ATOMIC_ACQUIRE, "agent");
            xb_add(&bar[XB_XGEN(b.x)], 1u);
            asm volatile("s_waitcnt vmcnt(0)" ::: "memory");
        } else {
            XB_SPIN(xb_ld(&bar[XB_XGEN(b.x)]) == gen, bar);
            __builtin_amdgcn_fence(__ATOMIC_ACQUIRE, "agent");
            asm volatile("s_waitcnt vmcnt(0)" ::: "memory");
        }
    }
    __syncthreads();
}

namespace pg8 {
constexpr int BM = 256, BK = 64, HALF = 128, HTB = HALF * BK * 2, STAGE_BYTES = 8 * HTB;
typedef int v4i32_t __attribute__((ext_vector_type(4)));
typedef int v8i32_t __attribute__((ext_vector_type(8)));
__host__ __device__ __forceinline__ int lds_byte(int r, int c) { const int st = (r >> 4) * 2 + (c >> 5), rr = r & 15, cc = c & 31, ob = rr * 64 + cc * 2; return st * 1024 + (ob ^ (((ob >> 9) & 1) << 5)); }
__host__ __device__ __forceinline__ void stage_rc(int b, int& R, int& C) { const int st = b / 1024, sb = b % 1024, swz = sb ^ (((sb >> 9) & 1) << 5); R = (st >> 1) * 16 + swz / 64; C = (st & 1) * 32 + (swz % 64) / 2; }
__host__ __device__ __forceinline__ int perm32(int rho) { const int n = rho >> 4, i = rho & 15; return 8 * (i >> 2) + 4 * n + (i & 3); }

struct Unit { const GAS char* a; const GAS char* b; int pm, pn, e; };

template <int N> __device__ __forceinline__ void wait_vm() { asm volatile("s_waitcnt vmcnt(%0)" :: "n"(N) : "memory"); }
template <class Epi, class Sched, bool ALIGN_EPI, bool GATHER, bool FP8 = false, bool MIDSCALE = false, bool VARK = false>
__device__ __forceinline__ void gemm_phase(const int tid, LAS unsigned char* lds, const int Kb, const int ldaB, const int ldbB, const Sched& S, const Epi& E, const GAS int* __restrict__ tokof, const LAS f32x2* scl = nullptr) {
    const int wid = __builtin_amdgcn_readfirstlane(tid >> 6), lane = tid & 63, wr = wid >> 2, wc = wid & 3, fr = lane & 15, fq = lane >> 4;
    const int nt = Kb / 128;
    unsigned voffA[2], voffB[2]; int RA[2], CA2[2];
#pragma unroll
    for (int i = 0; i < 2; ++i) { int R, C; stage_rc(tid * 16 + i * 8192, R, C); const int Rb = Epi::PERM ? ((R & ~31) + perm32(R & 31)) : R;
        voffA[i] = (unsigned)(R * ldaB + C * 2); voffB[i] = (unsigned)(Rb * ldbB + C * 2); RA[i] = R; CA2[i] = C * 2; }
    const size_t kstep = (size_t)(BK * 2);
    const size_t hstepA = GATHER ? 0 : (size_t)HALF * ldaB;
    const size_t hstepB = (size_t)HALF * ldbB;
    const unsigned ldsw = (unsigned)wid * 1024u;
    const int aoff = lds_byte(wr * 64 + fr, fq * 8), boff = lds_byte(wc * 32 + fr, fq * 8);
    unsigned gcur[2][2], gnxt[2][2];
    const int scl8 = 0x7F7F7F7F;
#define PG8_SA(b, h) (((b) * 2 + (h)) * HTB)
#define PG8_SB(b, h) ((4 + (b) * 2 + (h)) * HTB)
#define PG8_STAGE(bufoff, gbase, voff) do { const unsigned long long gb_ = (unsigned long long)(gbase); const unsigned lbase_ = (unsigned)__builtin_amdgcn_readfirstlane((int)((unsigned)(uintptr_t)lds + (unsigned)(bufoff) + ldsw)); \
        _Pragma("unroll") for (int _i = 0; _i < 2; ++_i) { unsigned keep_; \
            asm volatile("s_mov_b32 %0, m0\n\ts_mov_b32 m0, %3\n\ts_nop 0\n\tglobal_load_lds_dwordx4 %1, %2\n\ts_mov_b32 m0, %0" : "=&s"(keep_) : "v"((voff)[_i]), "s"(gb_), "s"(lbase_ + (unsigned)(_i * 8192)) : "memory"); } } while (0)
#define PG8_STAGE_A(bufoff, base, h, nx) do { if constexpr (GATHER) { unsigned _v[2]; _v[0] = (nx) ? gnxt[h][0] : gcur[h][0]; _v[1] = (nx) ? gnxt[h][1] : gcur[h][1]; PG8_STAGE(bufoff, base, _v); } \
        else { PG8_STAGE(bufoff, (base) + (h) * hstepA, voffA); } } while (0)
#define PG8_LDA(dst, b, h) do { _Pragma("unroll") for (int m = 0; m < 4; ++m) _Pragma("unroll") for (int k = 0; k < 2; ++k) dst[m][k] = *(const LAS bf16x8*)(lds + PG8_SA(b, h) + aoff + m * 2048 + k * 1024); } while (0)
#define PG8_LDB(dst, b, h) do { _Pragma("unroll") for (int n = 0; n < 2; ++n) _Pragma("unroll") for (int k = 0; k < 2; ++k) dst[n][k] = *(const LAS bf16x8*)(lds + PG8_SB(b, h) + boff + n * 2048 + k * 1024); } while (0)
#define PG8_MMA(ai, bj, At, Bt) do { __builtin_amdgcn_s_setprio(1); if constexpr (FP8) { _Pragma("unroll") for (int m = 0; m < 4; ++m) _Pragma("unroll") for (int n = 0; n < 2; ++n) { \
        const v8i32_t b8_ = __builtin_shufflevector(__builtin_bit_cast(v4i32_t, Bt[n][0]), __builtin_bit_cast(v4i32_t, Bt[n][1]), 0, 1, 2, 3, 4, 5, 6, 7), a8_ = __builtin_shufflevector(__builtin_bit_cast(v4i32_t, At[m][0]), __builtin_bit_cast(v4i32_t, At[m][1]), 0, 1, 2, 3, 4, 5, 6, 7); \
        asm volatile("s_nop 1\n\tv_mfma_scale_f32_16x16x128_f8f6f4 %0, %1, %2, %0, %3, %3 op_sel_hi:[0,0,0]" : "+v"(acc[ai][bj][m][n]) : "v"(b8_), "v"(a8_), "v"(scl8)); } } \
      else { _Pragma("unroll") for (int m = 0; m < 4; ++m) _Pragma("unroll") for (int n = 0; n < 2; ++n) _Pragma("unroll") for (int k = 0; k < 2; ++k) \
        acc[ai][bj][m][n] = __builtin_amdgcn_mfma_f32_16x16x32_bf16(Bt[n][k], At[m][k], acc[ai][bj][m][n], 0, 0, 0); } __builtin_amdgcn_s_setprio(0); } while (0)
#define PG8_WAIT_V(n) asm volatile("s_waitcnt vmcnt(" #n ")" ::: "memory")
#define PG8_WAIT_L(n) asm volatile("s_waitcnt lgkmcnt(" #n ")" ::: "memory")
#define PG8_BAR __builtin_amdgcn_s_barrier()
#define PG8_SCHED __builtin_amdgcn_sched_barrier(0)
#define PG8_GLOAD(dst, u) do { if constexpr (GATHER) { _Pragma("unroll") for (int _h = 0; _h < 2; ++_h) _Pragma("unroll") for (int _i = 0; _i < 2; ++_i) \
        dst[_h][_i] = (unsigned)tokof[(u).pm * BM + _h * HALF + RA[_i]] * (unsigned)ldaB + (unsigned)CA2[_i]; } } while (0)
    Unit cur, nxt; int ui = 0;
    if (!S.next(0, cur)) return;
    PG8_GLOAD(gcur, cur);
    typename Epi::Pre pre = E.prefetch(cur, wr, fr);
    f32x4 acc[2][2][4][2];
#pragma unroll
    for (int a = 0; a < 2; ++a)
#pragma unroll
        for (int b = 0; b < 2; ++b)
#pragma unroll
            for (int m = 0; m < 4; ++m)
#pragma unroll
                for (int n = 0; n < 2; ++n) acc[a][b][m][n] = (f32x4){0.f, 0.f, 0.f, 0.f};
    bf16x8 At[4][2], B0[2][2], B1[2][2];
    const GAS char* cA = cur.a; const GAS char* cB = cur.b;
    PG8_STAGE(PG8_SB(0, 0), cB, voffB); PG8_STAGE(PG8_SB(0, 1), cB + hstepB, voffB); PG8_STAGE_A(PG8_SA(0, 0), cA, 0, false); PG8_STAGE_A(PG8_SA(0, 1), cA, 1, false);
    if (wr == 1) PG8_BAR;
    PG8_WAIT_V(2); PG8_BAR;
    PG8_STAGE(PG8_SB(1, 0), cB + kstep, voffB); PG8_STAGE_A(PG8_SA(1, 0), cA + kstep, 0, false); PG8_STAGE(PG8_SB(1, 1), cB + hstepB + kstep, voffB);
    PG8_WAIT_V(6); PG8_BAR;
    bool fresh = false;
    for (;;) {
        const bool has_next = S.next(ui + 1, nxt);
        if constexpr (GATHER) { if (has_next) { PG8_GLOAD(gnxt, nxt); } else { _Pragma("unroll") for (int _h = 0; _h < 2; ++_h) _Pragma("unroll") for (int _i = 0; _i < 2; ++_i) gnxt[_h][_i] = gcur[_h][_i]; } }
        const GAS char* nA = has_next ? nxt.a : cA; const GAS char* nB = has_next ? nxt.b : cB;
        const int ntu = VARK ? (cur.e ? nt / 2 : nt) : nt;
#pragma nounroll
        for (int t = 0; t < ntu; t += 2) {
            const bool last = (t == ntu - 2);
            const GAS char* a1 = cA + (size_t)(t + 1) * kstep;
            const GAS char* a2 = last ? nA : cA + (size_t)(t + 2) * kstep; const GAS char* b2 = last ? nB : cB + (size_t)(t + 2) * kstep;
            const GAS char* a3 = a2 + kstep; const GAS char* b3 = b2 + kstep;
            const bool fe = fresh; fresh = false;
            if constexpr (MIDSCALE) { if (t == nt / 2) {
#pragma unroll
                for (int ai = 0; ai < 2; ++ai)
#pragma unroll
                    for (int m = 0; m < 4; ++m) { const float r_ = scl[ui * 256 + ai * 128 + wr * 64 + m * 16 + fr][0];
#pragma unroll
                        for (int bj = 0; bj < 2; ++bj)
#pragma unroll
                            for (int n = 0; n < 2; ++n) acc[ai][bj][m][n] *= r_; } } }
            PG8_LDB(B0, 0, 0); PG8_LDB(B1, 0, 1); PG8_SCHED; PG8_LDA(At, 0, 0); PG8_STAGE_A(PG8_SA(1, 1), a1, 1, false);
            if (fe) wait_vm<8 + Epi::NST>(); else PG8_WAIT_V(8); PG8_WAIT_L(0); PG8_BAR; PG8_MMA(0, 0, At, B0); PG8_MMA(0, 1, At, B1); PG8_BAR; PG8_SCHED;
            PG8_LDA(At, 0, 1); PG8_STAGE(PG8_SB(0, 0), b2, voffB); PG8_STAGE(PG8_SB(0, 1), b2 + hstepB, voffB); PG8_STAGE_A(PG8_SA(0, 0), a2, 0, last);
            if (fe) wait_vm<8 + Epi::NST>(); else PG8_WAIT_V(8); PG8_WAIT_L(0); PG8_BAR; PG8_MMA(1, 0, At, B0); PG8_MMA(1, 1, At, B1); PG8_BAR; PG8_SCHED;
            PG8_LDB(B0, 1, 0); PG8_LDB(B1, 1, 1); PG8_SCHED; PG8_LDA(At, 1, 0); PG8_STAGE_A(PG8_SA(0, 1), a2, 1, last);
            PG8_WAIT_V(8); PG8_WAIT_L(0); PG8_BAR; PG8_MMA(0, 0, At, B0); PG8_MMA(0, 1, At, B1); PG8_BAR; PG8_SCHED;
            PG8_LDA(At, 1, 1); PG8_STAGE(PG8_SB(1, 0), b3, voffB); PG8_STAGE(PG8_SB(1, 1), b3 + hstepB, voffB); PG8_STAGE_A(PG8_SA(1, 0), a3, 0, last);
            PG8_WAIT_V(8); PG8_WAIT_L(0); PG8_BAR; PG8_MMA(1, 0, At, B0); PG8_MMA(1, 1, At, B1); PG8_BAR; PG8_SCHED;
        }
        if constexpr (ALIGN_EPI) { if (wr == 0) PG8_BAR; }
        if constexpr (FP8) { asm volatile("s_nop 15\n\ts_nop 15" ::: "memory"); }
        if constexpr (MIDSCALE) E(acc, cur, wr, wc, fr, fq, scl + ui * 256); else E(acc, cur, wr, wc, fr, fq, pre);
        if (!has_next) break;
        pre = E.prefetch(nxt, wr, fr);
#pragma unroll
        for (int a = 0; a < 2; ++a)
#pragma unroll
            for (int b = 0; b < 2; ++b)
#pragma unroll
                for (int m = 0; m < 4; ++m)
#pragma unroll
                    for (int n = 0; n < 2; ++n) acc[a][b][m][n] = (f32x4){0.f, 0.f, 0.f, 0.f};
        cur = nxt; cA = nA; cB = nB; ++ui; fresh = true;
        if constexpr (GATHER) { _Pragma("unroll") for (int _h = 0; _h < 2; ++_h) _Pragma("unroll") for (int _i = 0; _i < 2; ++_i) gcur[_h][_i] = gnxt[_h][_i]; }
        if constexpr (ALIGN_EPI) { if (wr == 1) PG8_BAR; }
    }
    PG8_WAIT_V(0);
    if constexpr (!ALIGN_EPI) { if (wr == 0) PG8_BAR; }
    PG8_BAR;
#undef PG8_SA
#undef PG8_SB
#undef PG8_STAGE
#undef PG8_STAGE_A
#undef PG8_LDA
#undef PG8_LDB
#undef PG8_MMA
#undef PG8_WAIT_V
#undef PG8_WAIT_L
#undef PG8_BAR
#undef PG8_SCHED
#undef PG8_GLOAD
}
}
using pg8::Unit;

struct DenseOrder {
    int nM, nN, nwg, G, c; const GAS char* A; const GAS char* B; size_t aT, bT;
    __device__ __forceinline__ bool next(int i, Unit& u) const {
        const long L = (long)i * G + c; if (L >= nwg) return false;
        int wgid = (int)L; { const int q = nwg / 8, r = nwg % 8, xcd = wgid % 8, off = wgid / 8; wgid = (xcd < r ? xcd * (q + 1) : r * (q + 1) + (xcd - r) * q) + off; }
        const int nig = 8 * nN, gid = wgid / nig, fm = gid * 8, gsz = (nM - fm) < 8 ? (nM - fm) : 8;
        u.pm = fm + ((wgid % nig) % gsz); u.pn = (wgid % nig) / gsz; u.e = 0;
        u.a = A + (size_t)u.pm * aT; u.b = B + (size_t)u.pn * bT; return true;
    }
};
struct UpOrder {
    int G, c; const GAS char* LATp; const GAS char* Wq; const GAS char* Wkv;
    __device__ __forceinline__ bool next(int i, Unit& u) const {
        const int L = i * G + c; if (L >= 128 * 7) return false;
        u.pm = L / 7; const int j = L % 7; const bool kv = j >= 3; u.pn = kv ? j - 3 : j; u.e = kv ? 1 : 0;
        u.a = LATp + (size_t)u.pm * 256 * 512 * 2 + (kv ? 512 : 0);
        u.b = (kv ? Wkv : Wq) + (size_t)u.pn * 256 * 256 * 2; return true;
    }
};
struct MoeOrder {
    int G, c; const volatile LAS int* TS; const GAS char* A; const GAS char* W; size_t aT  , wE  , wT  ;
    __device__ __forceinline__ bool next(int i, Unit& u) const {
        const int L = i * G + c; const int ntile = __builtin_amdgcn_readfirstlane(TS[32]); if (L >= ntile * 4) return false;
        const int rt = L >> 2, ct = L & 3; int e = 0;
        for (int j = 1; j < 32; ++j) e += (TS[j] <= rt) ? 1 : 0;
        e = __builtin_amdgcn_readfirstlane(e);
        u.pm = rt; u.pn = ct; u.e = e; u.a = A + (size_t)rt * aT; u.b = W + (size_t)e * wE + (size_t)ct * wT; return true;
    }
};

__device__ __forceinline__ u32x4 pack8(f32x4 v0, f32x4 v1) { u32x4 w; w.x = cvt_pk_bf16(v0[0], v0[1]); w.y = cvt_pk_bf16(v0[2], v0[3]); w.z = cvt_pk_bf16(v1[0], v1[1]); w.w = cvt_pk_bf16(v1[2], v1[3]); return w; }

struct EpiWin {
    static constexpr int NST = 16;
    static constexpr bool PERM = true;
    GAS bf16* LAT_; GAS bf16* FQKV_; GAS bf16* KPE_; GAS float* FLOG_; GAS float* SSQ_; const GAS float* COS_; const GAS float* SIN_; const GAS float* RSX_;
    struct Pre { float v[8]; };
    __device__ __forceinline__ Pre prefetch(const Unit& u, int wr, int fr) const { Pre p; const GAS float* RSX = RSX_; asm volatile("" : "+s"(RSX));
#pragma unroll
        for (int g = 0; g < 8; ++g) p.v[g] = RSX[u.pm * 256 + (g >> 2) * 128 + wr * 64 + (g & 3) * 16 + fr]; return p; }
    __device__ __forceinline__ void operator()(f32x4 (&acc)[2][2][4][2], const Unit& u, int wr, int wc, int fr, int fq, const Pre& pre) const {
        GAS bf16* LAT = LAT_; GAS bf16* FQKV = FQKV_; GAS bf16* KPE = KPE_; GAS float* FLOG = FLOG_; GAS float* SSQ = SSQ_; const GAS float* COS = COS_; const GAS float* SIN = SIN_; const GAS float* RSX = RSX_;
        asm volatile("" : "+s"(LAT), "+s"(FQKV), "+s"(KPE), "+s"(FLOG), "+s"(SSQ), "+s"(COS), "+s"(SIN), "+s"(RSX));
        {
#pragma unroll
            for (int ai = 0; ai < 2; ++ai)
#pragma unroll
                for (int m = 0; m < 4; ++m) { const float rs_ = pre.v[ai * 4 + m];
#pragma unroll
                    for (int bj = 0; bj < 2; ++bj)
#pragma unroll
                        for (int n = 0; n < 2; ++n) acc[ai][bj][m][n] *= rs_; } }
        const int row0 = u.pm * 256 + wr * 64 + fr; const int pn = u.pn;
        if (pn >= 2) {
            const int ti = pn >> 1; GAS bf16* dst = FQKV + (size_t)(ti - 1) * NTOK * 512; const int colb = (pn & 1) * 256 + wc * 32 + 8 * fq; const float sc = (ti == 1) ? C2F : 1.f;
#pragma unroll
            for (int ai = 0; ai < 2; ++ai)
#pragma unroll
                for (int m = 0; m < 4; ++m) { GAS bf16* rowp = dst + (size_t)(row0 + ai * 128 + m * 16) * 512 + colb;
#pragma unroll
                    for (int bj = 0; bj < 2; ++bj) *(GAS u32x4*)(rowp + bj * 128) = pack8(acc[ai][bj][m][0] * sc, acc[ai][bj][m][1] * sc); }
        } else {
#pragma unroll
            for (int ai = 0; ai < 2; ++ai)
#pragma unroll
                for (int m = 0; m < 4; ++m) { const int row = row0 + ai * 128 + m * 16; GAS bf16* rowp = LAT + (size_t)row * 512 + pn * 256 + wc * 32 + 8 * fq;
#pragma unroll
                    for (int bj = 0; bj < 2; ++bj) *(GAS u32x4*)(rowp + bj * 128) = pack8(acc[ai][bj][m][0], acc[ai][bj][m][1]);
                    float s = 0.f;
#pragma unroll
                    for (int n = 0; n < 2; ++n) { const f32x4 x = acc[ai][0][m][n]; s += (x[0] * x[0] + x[1] * x[1]) + (x[2] * x[2] + x[3] * x[3]); }
                    if (pn == 0) {
#pragma unroll
                        for (int n = 0; n < 2; ++n) { const f32x4 x = acc[ai][1][m][n]; s += (x[0] * x[0] + x[1] * x[1]) + (x[2] * x[2] + x[3] * x[3]); }
                    }
                    s += __shfl_xor(s, 16); s += __shfl_xor(s, 32);
                    if (fq == 0) SSQ[(size_t)row * 8 + pn * 4 + wc] = s;
                    }
            if (pn == 1 && wc == 0) {
#pragma unroll
                for (int ai = 0; ai < 2; ++ai)
#pragma unroll
                    for (int m = 0; m < 4; ++m) { const int row = row0 + ai * 128 + m * 16;
                        const f32x4 c = *(const GAS f32x4*)(COS + (size_t)row * 16 + 4 * fq), sn = *(const GAS f32x4*)(SIN + (size_t)row * 16 + 4 * fq);
                        const f32x4 x1 = acc[ai][1][m][0], x2 = acc[ai][1][m][1];
                        *(GAS u32x4*)(KPE + (size_t)row * 32 + 8 * fq) = pack8(x1 * c - x2 * sn, x1 * sn + x2 * c);
                        }
            }
            if (pn == 1 && wc == 1 && fq == 0) {
#pragma unroll
                for (int ai = 0; ai < 2; ++ai)
#pragma unroll
                    for (int m = 0; m < 4; ++m) { const int row = row0 + ai * 128 + m * 16; *(GAS f32x4*)(FLOG + (size_t)row * 8) = acc[ai][1][m][0]; *(GAS f32x4*)(FLOG + (size_t)row * 8 + 4) = acc[ai][1][m][1]; }
            }
        }
    }
};
struct EpiUp {
    static constexpr int NST = 16;
    static constexpr bool PERM = true;
    GAS bf16* QM_; GAS bf16* KVM_; const GAS float* SSQ_; const GAS float* COS_; const GAS float* SIN_;
    struct Pre { f32x4 v[8]; };
    __device__ __forceinline__ Pre prefetch(const Unit& u, int wr, int fr) const { Pre p; const GAS float* SSQ = SSQ_; asm volatile("" : "+s"(SSQ)); const int off = u.e ? 4 : 0;
#pragma unroll
        for (int g = 0; g < 8; ++g) p.v[g] = *(const GAS f32x4*)(SSQ + (size_t)(u.pm * 256 + (g >> 2) * 128 + wr * 64 + (g & 3) * 16 + fr) * 8 + off); return p; }
    __device__ __forceinline__ void operator()(const f32x4 (&acc)[2][2][4][2], const Unit& u, int wr, int wc, int fr, int fq, const Pre& pre) const {
        GAS bf16* QM = QM_; GAS bf16* KVM = KVM_; const GAS float* SSQ = SSQ_; const GAS float* COS = COS_; const GAS float* SIN = SIN_;
        asm volatile("" : "+s"(QM), "+s"(KVM), "+s"(SSQ), "+s"(COS), "+s"(SIN));
        const int row0 = u.pm * 256 + wr * 64 + fr; const int pn = u.pn; const bool kv = u.e != 0;
#pragma unroll
        for (int ai = 0; ai < 2; ++ai)
#pragma unroll
            for (int m = 0; m < 4; ++m) { const int row = row0 + ai * 128 + m * 16;
                const f32x4 sq = pre.v[ai * 4 + m];
                const float ss = (sq[0] + sq[1]) + (sq[2] + sq[3]);
                if (kv) {
                    const float rs = rsqrtf(ss * (1.f / 128.f) + EPS);
                    GAS bf16* rowp = KVM + (size_t)row * 1024 + pn * 256 + wc * 32 + 8 * fq;
#pragma unroll
                    for (int bj = 0; bj < 2; ++bj) *(GAS u32x4*)(rowp + bj * 128) = pack8(acc[ai][bj][m][0] * rs, acc[ai][bj][m][1] * rs);
                } else {
                    const float rs = rsqrtf(ss * (1.f / 256.f) + EPS) * C2M;
                    GAS bf16* rowp = QM + (size_t)row * 768 + pn * 256 + wc * 32 + 8 * fq;
                    const f32x4 c = *(const GAS f32x4*)(COS + (size_t)row * 16 + 4 * fq), sn = *(const GAS f32x4*)(SIN + (size_t)row * 16 + 4 * fq);
#pragma unroll
                    for (int bj = 0; bj < 2; ++bj) { f32x4 v0 = acc[ai][bj][m][0] * rs, v1 = acc[ai][bj][m][1] * rs;
                        const int G = 8 * pn + 4 * bj + wc;
                        if (G % 3 == 2) { const f32x4 x1 = v0, x2 = v1; v0 = x1 * c - x2 * sn; v1 = x1 * sn + x2 * c; }
                        *(GAS u32x4*)(rowp + bj * 128) = pack8(v0, v1); }
                }

            }
    }
};
template <bool RES_F32> struct EpiOut {
    static constexpr int NST = 16;
    static constexpr bool PERM = true;
    const GAS float* resf_; GAS bf16* xr_;
    struct Pre {}; __device__ __forceinline__ Pre prefetch(const Unit&, int, int) const { return Pre{}; }
    __device__ __forceinline__ void operator()(const f32x4 (&acc)[2][2][4][2], const Unit& u, int wr, int wc, int fr, int fq, const LAS f32x2* scl) const {
        const GAS float* resf = resf_; GAS bf16* xr = xr_; asm volatile("" : "+s"(resf), "+s"(xr));
        const int row0 = u.pm * 256 + wr * 64 + fr, col0 = u.pn * 256 + wc * 32 + 8 * fq;
#pragma unroll
        for (int ai = 0; ai < 2; ++ai)
#pragma unroll
            for (int m = 0; m < 4; ++m) { const size_t off = (size_t)(row0 + ai * 128 + m * 16) * DM + col0; const float sh = scl[ai * 128 + wr * 64 + m * 16 + fr][1];
#pragma unroll
                for (int bj = 0; bj < 2; ++bj) { f32x4 r0, r1;
                    if constexpr (RES_F32) { r0 = *(const GAS f32x4*)(resf + off + bj * 128); r1 = *(const GAS f32x4*)(resf + off + bj * 128 + 4); }
                    else { const u32x4 w = *(const GAS u32x4*)(xr + off + bj * 128);
                        r0 = (f32x4){__uint_as_float(w.x << 16), __uint_as_float(w.x & 0xffff0000u), __uint_as_float(w.y << 16), __uint_as_float(w.y & 0xffff0000u)};
                        r1 = (f32x4){__uint_as_float(w.z << 16), __uint_as_float(w.z & 0xffff0000u), __uint_as_float(w.w << 16), __uint_as_float(w.w & 0xffff0000u)}; }
                    *(GAS u32x4*)(xr + off + bj * 128) = pack8(r0 + acc[ai][bj][m][0] * sh, r1 + acc[ai][bj][m][1] * sh); } }
    }
};
struct EpiGU {
    static constexpr int NST = 8;
    static constexpr bool PERM = true;
    GAS unsigned char* HH_; const GAS float* RS_;
    struct Pre { float v[8]; };
    __device__ __forceinline__ Pre prefetch(const Unit& u, int wr, int fr) const { Pre p; const GAS float* RS = RS_; asm volatile("" : "+s"(RS));
#pragma unroll
        for (int g = 0; g < 8; ++g) p.v[g] = RS[u.pm * 256 + (g >> 2) * 128 + wr * 64 + (g & 3) * 16 + fr]; return p; }
    __device__ __forceinline__ void operator()(const f32x4 (&acc)[2][2][4][2], const Unit& u, int wr, int wc, int fr, int fq, const Pre& pre) const {
        GAS unsigned char* HH = HH_; const GAS float* RS = RS_; asm volatile("" : "+s"(HH), "+s"(RS));
        const int row0 = u.pm * 256 + wr * 64 + fr;
#pragma unroll
        for (int ai = 0; ai < 2; ++ai)
#pragma unroll
            for (int m = 0; m < 4; ++m) { GAS unsigned char* rowp = HH + (size_t)(row0 + ai * 128 + m * 16) * 512 + u.pn * 128 + wc * 32 + 8 * fq; const float rs = pre.v[ai * 4 + m] * WSCALE_INV;
                f32x4 h[2];
#pragma unroll
                for (int n = 0; n < 2; ++n) { const f32x4 g = acc[ai][0][m][n] * rs, up = acc[ai][1][m][n] * rs;
#pragma unroll
                    for (int j = 0; j < 4; ++j) { const float sg = __builtin_amdgcn_rcpf(1.f + __builtin_amdgcn_exp2f(-g[j] * LOG2E)); h[n][j] = g[j] * sg * up[j]; } }
                u32x2 w; w.x = pk4_fp8(h[0][0], h[0][1], h[0][2], h[0][3]); w.y = pk4_fp8(h[1][0], h[1][1], h[1][2], h[1][3]); *(GAS u32x2*)rowp = w; }
    }
};
struct EpiDown {
    static constexpr int NST = 16;
    static constexpr bool PERM = true;
    GAS unsigned char* Y_; const GAS float* GATEOF_;
    struct Pre { float v[8]; };
    __device__ __forceinline__ Pre prefetch(const Unit& u, int wr, int fr) const { Pre p; const GAS float* GT = GATEOF_; asm volatile("" : "+s"(GT));
#pragma unroll
        for (int g = 0; g < 8; ++g) p.v[g] = GT[u.pm * 256 + (g >> 2) * 128 + wr * 64 + (g & 3) * 16 + fr]; return p; }
    __device__ __forceinline__ void operator()(const f32x4 (&acc)[2][2][4][2], const Unit& u, int wr, int wc, int fr, int fq, const Pre& pre) const {
        GAS unsigned char* Y = Y_; const GAS float* GATEOF = GATEOF_; asm volatile("" : "+s"(Y), "+s"(GATEOF));
        const int row0 = u.pm * 256 + wr * 64 + fr;
#pragma unroll
        for (int ai = 0; ai < 2; ++ai)
#pragma unroll
            for (int m = 0; m < 4; ++m) { const int row = row0 + ai * 128 + m * 16; const float g = pre.v[ai * 4 + m]; GAS unsigned char* rowp = Y + (size_t)row * 1024 + u.pn * 256 + wc * 32 + 8 * fq;
#pragma unroll
                for (int bj = 0; bj < 2; ++bj) { const f32x4 v0 = acc[ai][bj][m][0] * g, v1 = acc[ai][bj][m][1] * g; u32x2 w; w.x = pk4_fp8(v0[0], v0[1], v0[2], v0[3]); w.y = pk4_fp8(v1[0], v1[1], v1[2], v1[3]); *(GAS u32x2*)(rowp + bj * 128) = w; } }
    }
};

namespace att {
constexpr int KSLOT = 12288, VSLOT = 8192;
constexpr int L_K = 0, L_V = 2 * KSLOT, L_BIAS = L_V + 2 * VSLOT, L_WS = L_BIAS + 8192, L_OST = L_WS + 8 * 64 * 4, L_END = L_OST + 8 * 4096;
__device__ __forceinline__ int crow(int r, int hi) { return (r & 3) + 8 * (r >> 2) + 4 * hi; }
typedef short v4i16_t __attribute__((ext_vector_type(4)));
__device__ __forceinline__ s16x4 vtr(const LAS char* p) { return __builtin_bit_cast(s16x4, __builtin_amdgcn_ds_read_tr16_b64_v4i16((LAS v4i16_t*)p)); }

constexpr int NSL = 5;
constexpr int R_K = 0, R_V = NSL * KSLOT, R_WS = R_V + NSL * VSLOT, R_OST = R_WS + 8 * 64 * 4, R_END = R_OST + 8 * 4096;
static_assert(R_END <= RING_BYTES, "attention LDS");
__device__ __forceinline__ void glds16(const GAS void* gsrc, unsigned lds_dst) { unsigned keep;
    asm volatile("s_mov_b32 %0, m0\n\ts_mov_b32 m0, %2\n\ts_nop 0\n\tglobal_load_lds_dwordx4 %1, off\n\ts_mov_b32 m0, %0" : "=&s"(keep) : "v"(gsrc), "s"(lds_dst) : "memory"); }
__device__ __forceinline__ void glds16s(const GAS void* sbase, unsigned voff, unsigned lds_dst) { unsigned keep;
    asm volatile("s_mov_b32 %0, m0\n\ts_mov_b32 m0, %3\n\ts_nop 0\n\tglobal_load_lds_dwordx4 %1, %2\n\ts_mov_b32 m0, %0" : "=&s"(keep) : "v"(voff), "s"((unsigned long long)sbase), "s"(lds_dst) : "memory"); }
struct Tens2 { const GAS bf16* Q; int qp; const GAS bf16* K; int kp; const GAS bf16* KX; const GAS bf16* V; int vp; GAS bf16* O; const GAS float* BIASF; const GAS float* NRM; GAS float* OSS; };
template <int MODE>
__device__ __forceinline__ int attn_unit2(const int wave_, int b, int h, int qb, const Tens2& T, LAS char* shm, const int slbase, const bool have_pro, const int qb_next, bf16x8 (&qr)[6], const int tstart) {
    constexpr int DKS = MODE ? 6 : 5, DKH = 3;
    constexpr float THR = 8.f;
    int wid = wave_; asm volatile("" : "+s"(wid));
    int lane = (int)__builtin_amdgcn_mbcnt_hi(~0u, __builtin_amdgcn_mbcnt_lo(~0u, 0u)); asm volatile("" : "+v"(lane)); const int r32 = lane & 31, hi = lane >> 5;
    const long rowbase = (long)b * SEQ; const int q0 = qb * 256, qw0 = q0 + wid * 32;
    const int NT = (q0 + 256) / 64, tlast = qw0 / 64;
    const int NTE = NT - tstart;
    const GAS bf16* Qw = T.Q + (rowbase + qw0) * T.qp + h * (MODE ? 96 : 64);
    const GAS bf16* Kh = T.K + rowbase * T.kp + h * (MODE ? 128 : 64);
    const GAS bf16* Vh = T.V + rowbase * T.vp + h * (MODE ? 128 : 64);
    LAS float* wsf = (LAS float*)(shm + R_WS) + wid * 64;
    const unsigned koff = (unsigned)(lane * T.kp + wid * 8) * 2u;
    const unsigned xoff = MODE ? (unsigned)(lane * 32 + (wid & 3) * 8) * 2u : (unsigned)(lane * 8) * 2u;
    const unsigned voff = (unsigned)((16 * (wid & 3) + (lane >> 2)) * T.vp + (wid >> 2) * 32 + (lane & 3) * 8) * 2u;
    const GAS bf16* xbase = MODE ? T.KX + rowbase * 32 : T.KX + ((long)b * 8 + h) * SEQ * 8;
    const int xstep = MODE ? 64 * 32 : 64 * 8;
    const unsigned kdst_a = (unsigned)(uintptr_t)(shm + R_K) + (unsigned)wid * 1024u, xdst_a = (unsigned)(uintptr_t)(shm + R_K) + (unsigned)(8 + (MODE ? (wid & 3) : 0)) * 1024u, vdst_a = (unsigned)(uintptr_t)(shm + R_V) + (unsigned)wid * 1024u;
#define A2_DMA(t, slot) do { \
        glds16s((const GAS void*)(Kh + (long)(t) * 64 * T.kp), koff, (unsigned)__builtin_amdgcn_readfirstlane((int)(kdst_a + (slot) * KSLOT))); \
        glds16s((const GAS void*)(xbase + (long)(t) * xstep), xoff, (unsigned)__builtin_amdgcn_readfirstlane((int)(xdst_a + (slot) * KSLOT))); \
        glds16s((const GAS void*)(Vh + (long)(t) * 64 * T.vp), voff, (unsigned)__builtin_amdgcn_readfirstlane((int)(vdst_a + (slot) * VSLOT))); } while (0)
    float mhat = 0.f, lrun = 0.f; f32x16 o[2]; o[0] = f32x16{}; o[1] = f32x16{}; f32x16 negm = f32x16{};
    const LAS char* vp0 = shm + R_V + ((lane >> 4) & 1) * 32 + (lane & 3) * 8 + (4 * hi + ((lane & 15) >> 2)) * 64;
#define A3_SLOT(k) ((slbase + (k)) % NSL)
    if (!have_pro) { A2_DMA(NT - 1, A3_SLOT(0)); A2_DMA(NT - 2, A3_SLOT(1)); A2_DMA(NT - 3, A3_SLOT(2)); }
    if (!have_pro) {
#pragma unroll
        for (int d0 = 0; d0 < (MODE ? 6 : 4); ++d0) qr[d0] = *(const GAS bf16x8*)(Qw + (long)r32 * T.qp + d0 * 16 + hi * 8); }
    if (MODE == 0) { const short one = hi ? (short)0 : (short)0x3F80; qr[DKS - 1] = (bf16x8){one, one, one, 0, 0, 0, 0, 0}; }
#pragma unroll
    for (int d0 = 0; d0 < DKS; ++d0) asm volatile("" : "+v"(qr[d0]));
#define A3_KLOADH(slot, H) do { const LAS char* kb_ = shm + R_K + (slot) * KSLOT + r32 * 16; _Pragma("unroll") for (int d0 = (H) * DKH; d0 < ((H) ? DKS : DKH); ++d0) { const int off = (MODE == 0 && d0 == 4) ? 8 * 1024 : d0 * 2048 + hi * 1024; \
        kf[2 * (d0 - (H) * DKH)] = *(const LAS bf16x8*)(kb_ + off); kf[2 * (d0 - (H) * DKH) + 1] = *(const LAS bf16x8*)(kb_ + off + 512); } } while (0)
#define A3_VLOAD(slot) do { const LAS char* vp_ = vp0 + (slot) * VSLOT; _Pragma("unroll") for (int q = 0; q < 8; ++q) { vlo[q] = vtr(vp_ + (q >> 2) * 4096 + (q & 3) * 1024); vhh[q] = vtr(vp_ + (q >> 2) * 4096 + (q & 3) * 1024 + 512); } } while (0)
#define A3_QKH(H) do { if ((H) == 0) { c0 = negm; c1 = negm; } _Pragma("unroll") for (int d0 = (H) * DKH; d0 < ((H) ? DKS : DKH); ++d0) { c0 = __builtin_amdgcn_mfma_f32_32x32x16_bf16(kf[2 * (d0 - (H) * DKH)], qr[d0], c0, 0, 0, 0); c1 = __builtin_amdgcn_mfma_f32_32x32x16_bf16(kf[2 * (d0 - (H) * DKH) + 1], qr[d0], c1, 0, 0, 0); } } while (0)
#define A3_EXP() do { float ls_ = 0.f; _Pragma("unroll") for (int r = 0; r < 16; ++r) { pp0[r] = __builtin_amdgcn_exp2f(pp0[r]); pp1[r] = __builtin_amdgcn_exp2f(pp1[r]); ls_ += pp0[r] + pp1[r]; } lrun += ls_; u32x4 w_; \
        w_.x = cvt_pk_bf16(pp0[0], pp0[1]); w_.y = cvt_pk_bf16(pp0[2], pp0[3]); w_.z = cvt_pk_bf16(pp0[4], pp0[5]); w_.w = cvt_pk_bf16(pp0[6], pp0[7]); pa[0] = __builtin_bit_cast(bf16x8, w_); \
        w_.x = cvt_pk_bf16(pp0[8], pp0[9]); w_.y = cvt_pk_bf16(pp0[10], pp0[11]); w_.z = cvt_pk_bf16(pp0[12], pp0[13]); w_.w = cvt_pk_bf16(pp0[14], pp0[15]); pa[1] = __builtin_bit_cast(bf16x8, w_); \
        w_.x = cvt_pk_bf16(pp1[0], pp1[1]); w_.y = cvt_pk_bf16(pp1[2], pp1[3]); w_.z = cvt_pk_bf16(pp1[4], pp1[5]); w_.w = cvt_pk_bf16(pp1[6], pp1[7]); pa[2] = __builtin_bit_cast(bf16x8, w_); \
        w_.x = cvt_pk_bf16(pp1[8], pp1[9]); w_.y = cvt_pk_bf16(pp1[10], pp1[11]); w_.z = cvt_pk_bf16(pp1[12], pp1[13]); w_.w = cvt_pk_bf16(pp1[14], pp1[15]); pa[3] = __builtin_bit_cast(bf16x8, w_); } while (0)
#define A3_PV() do { _Pragma("unroll") for (int d0 = 0; d0 < 2; ++d0) _Pragma("unroll") for (int k = 0; k < 4; ++k) { const s16x4 lo_ = vlo[4 * d0 + k], hh_ = vhh[4 * d0 + k]; \
        const bf16x8 vf_ = (bf16x8){lo_[0], lo_[1], lo_[2], lo_[3], hh_[0], hh_[1], hh_[2], hh_[3]}; o[d0] = __builtin_amdgcn_mfma_f32_32x32x16_bf16(pa[k], vf_, o[d0], 0, 0, 0); } } while (0)
#define A3_ROWMAX(rm) do { float a_ = fmaxf(fmaxf(c0[0], c0[1]), c1[0]), b_ = fmaxf(fmaxf(c0[2], c0[3]), c1[1]); a_ = fmaxf(fmaxf(a_, c1[2]), c1[3]); \
        _Pragma("unroll") for (int r = 4; r < 16; r += 4) { a_ = fmaxf(fmaxf(a_, c0[r]), c0[r + 1]); b_ = fmaxf(fmaxf(b_, c0[r + 2]), c0[r + 3]); a_ = fmaxf(fmaxf(a_, c1[r]), c1[r + 1]); b_ = fmaxf(fmaxf(b_, c1[r + 2]), c1[r + 3]); } \
        rm = fmaxf(a_, b_); const auto rr_ = __builtin_amdgcn_permlane32_swap(__float_as_uint(rm), __float_as_uint(rm), false, false); rm = fmaxf(__uint_as_float(rr_[0]), __uint_as_float(rr_[1])); } while (0)
    int sl = A3_SLOT(0), sl3 = A3_SLOT(3);
    f32x16 pp0 = f32x16{}, pp1 = f32x16{}; bool pend = false; int pslot = 0;
    for (int i = 0; i < NTE; ++i) {
        const int t = NT - 1 - i;
        { const int ahead = NTE - 1 - i;
          if (ahead >= 2) asm volatile("s_waitcnt vmcnt(6)" ::: "memory"); else if (ahead == 1) asm volatile("s_waitcnt vmcnt(3)" ::: "memory"); else asm volatile("s_waitcnt vmcnt(0)" ::: "memory"); }
        __builtin_amdgcn_s_barrier(); asm volatile("" ::: "memory");
        if (i + 3 < NTE) A2_DMA(t - 3, sl3);
        if (i == NTE - 1 && qb_next >= 0) { const int NTn = 4 * qb_next + 4; A2_DMA(NTn - 1, A3_SLOT(NTE)); A2_DMA(NTn - 2, A3_SLOT(NTE + 1)); A2_DMA(NTn - 3, A3_SLOT(NTE + 2)); }
        if (t <= tlast) {
            bf16x8 kf[2 * DKH]; f32x16 c0, c1; float rm;
            A3_KLOADH(sl, 0);
            if (!pend) {
                A3_QKH(0); A3_KLOADH(sl, 1); A3_QKH(1);
                if (MODE == 0) { const int qrel = qw0 + r32 - 64 * t;
#pragma unroll
                    for (int r = 0; r < 16; ++r) { const int kv = crow(r, hi); if (kv > qrel) c0[r] = -INFINITY; if (kv + 32 > qrel) c1[r] = -INFINITY; } }
                A3_ROWMAX(rm);
                mhat = rm;
#pragma unroll
                for (int r = 0; r < 16; ++r) { c0[r] -= rm; c1[r] -= rm; negm[r] = -mhat; }
                pend = true;
            } else {
                s16x4 vlo[8], vhh[8]; bf16x8 pa[4];
                A3_QKH(0); A3_KLOADH(sl, 1);
                A3_VLOAD(pslot);
                A3_QKH(1);
                A3_EXP();
#pragma unroll
                for (int g_ = 0; g_ < 2 * DKS; ++g_) { __builtin_amdgcn_sched_group_barrier(0x008, 1, 0); __builtin_amdgcn_sched_group_barrier(0x002, 7, 0); }
                A3_PV();
                A3_ROWMAX(rm);
#pragma unroll
                for (int g_ = 0; g_ < 8; ++g_) { __builtin_amdgcn_sched_group_barrier(0x008, 1, 0); __builtin_amdgcn_sched_group_barrier(0x002, 3, 0); }
                if (__any(rm > THR)) {
                    const float dl = fmaxf(rm, 0.f); mhat += dl;
#pragma unroll
                    for (int r = 0; r < 16; ++r) { c0[r] -= dl; c1[r] -= dl; negm[r] = -mhat; }
                    const float f = __builtin_amdgcn_exp2f(-dl); lrun *= f;
                    if (hi == 0) wsf[r32] = f;
                    LDS_WAIT();
#pragma unroll
                    for (int g = 0; g < 4; ++g) { const f32x4 ff = *(const LAS f32x4*)(wsf + 8 * g + 4 * hi);
#pragma unroll
                        for (int j = 0; j < 4; ++j) { o[0][4 * g + j] *= ff[j]; o[1][4 * g + j] *= ff[j]; } }
                }
            }
            pp0 = c0; pp1 = c1; pslot = sl;
        }
        sl = (sl == NSL - 1) ? 0 : sl + 1; sl3 = (sl3 == NSL - 1) ? 0 : sl3 + 1;
    }
    if (qb_next >= 0) { const GAS bf16* Qn = T.Q + (rowbase + qb_next * 256 + wid * 32) * T.qp + h * (MODE ? 96 : 64);
#pragma unroll
        for (int d0 = 0; d0 < (MODE ? 6 : 4); ++d0) qr[d0] = *(const GAS bf16x8*)(Qn + (long)r32 * T.qp + d0 * 16 + hi * 8); }
    if (pend) { s16x4 vlo[8], vhh[8]; bf16x8 pa[4]; A3_VLOAD(pslot); A3_EXP(); A3_PV(); }
#undef A3_KLOADH
#undef A3_VLOAD
#undef A3_QKH
#undef A3_EXP
#undef A3_PV
#undef A3_ROWMAX
#undef A2_DMA
    lrun += __shfl_xor(lrun, 32);
    LDS_WAIT();
    if (hi == 0) wsf[32 + r32] = lrun;
    LDS_WAIT();
    float rli[16];
#pragma unroll
    for (int g = 0; g < 4; ++g) { const f32x4 ll = *(const LAS f32x4*)(wsf + 32 + 8 * g + 4 * hi);
#pragma unroll
        for (int j = 0; j < 4; ++j) rli[4 * g + j] = __builtin_amdgcn_rcpf(ll[j]); }
    GAS bf16* Ow = T.O + (rowbase + qw0) * 1024 + (MODE ? 0 : 512) + h * 64;
    { LAS bf16* stg = (LAS bf16*)(shm + R_OST) + wid * 2048;
#pragma unroll
      for (int r = 0; r < 16; ++r) { const int orow = crow(r, hi);
#pragma unroll
          for (int d0 = 0; d0 < 2; ++d0) stg[orow * 64 + d0 * 32 + r32] = (bf16)(cvt_pk_bf16(o[d0][r] * rli[r], 0.f) & 0xffffu); }
      LDS_WAIT();
#pragma unroll
      for (int i = 0; i < 4; ++i) { const int row = i * 8 + (lane >> 3), ch = lane & 7; const u32x4 v = *(const LAS u32x4*)(stg + row * 64 + ch * 8); *(GAS u32x4*)(Ow + (long)row * 1024 + ch * 8) = v;
          float sq = 0.f;
#pragma unroll
          for (int j = 0; j < 4; ++j) { const float a0 = __uint_as_float(v[j] << 16), a1 = __uint_as_float(v[j] & 0xffff0000u); sq += a0 * a0 + a1 * a1; }
          sq += __shfl_xor(sq, 1); sq += __shfl_xor(sq, 2); sq += __shfl_xor(sq, 4);
          if (ch == 0) T.OSS[(rowbase + qw0 + row) * 16 + (MODE ? 0 : 8) + h] = sq; } }
    if (qb_next < 0) { LDS_WAIT(); __builtin_amdgcn_s_barrier(); asm volatile("" ::: "memory"); }
    return A3_SLOT(NTE);
#undef A3_SLOT
}
}

struct Args { const void* in[21]; float* out; unsigned char* ws; int ph_lo, ph_hi; };

__device__ __forceinline__ void tr_item(const GAS float* __restrict__ W, int ldw, int Ksrc, const GAS float* __restrict__ gain, GAS bf16* __restrict__ WT, int ldk, int k0, int n0, int srccol, LAS float* scr, int lane) {
#pragma unroll 8
    for (int i = 0; i < 32; ++i) { const int kk = 2 * i + (lane >> 5); const int k = k0 + kk;
        float v = 0.f; if (srccol >= 0 && k < Ksrc) { v = __builtin_nontemporal_load(W + (size_t)k * ldw + srccol); if (gain) v *= gain[k]; }
        scr[kk * 33 + (lane & 31)] = v; }
    LDS_WAIT(); asm volatile("" ::: "memory");
    const int c = lane & 7;
#pragma unroll
    for (int j = 0; j < 4; ++j) { const int n = (lane >> 3) + 8 * j; const LAS float* s = scr + (8 * c) * 33 + n;
        u32x4 o; o.x = cvt_pk_bf16(s[0 * 33], s[1 * 33]); o.y = cvt_pk_bf16(s[2 * 33], s[3 * 33]); o.z = cvt_pk_bf16(s[4 * 33], s[5 * 33]); o.w = cvt_pk_bf16(s[6 * 33], s[7 * 33]);
        *(GAS u32x4*)(WT + (size_t)(n0 + n) * ldk + k0 + 8 * c) = o; }
    LDS_WAIT(); asm volatile("" ::: "memory");
}
__device__ __forceinline__ void tr_item64(const GAS float* __restrict__ W, int ldw, const GAS float* __restrict__ gain, GAS bf16* __restrict__ WT, int ldk, int k0, int n0src, int n0dst, LAS float* scr, int lane) {
    const int rr = lane >> 4, c4 = (lane & 15) * 4;
    f32x4 v[16];
#pragma unroll
    for (int i = 0; i < 16; ++i) v[i] = __builtin_nontemporal_load((const GAS f32x4*)(W + (size_t)(k0 + 4 * i + rr) * ldw + n0src + c4));
#pragma unroll
    for (int i = 0; i < 16; ++i) { const int k = 4 * i + rr; const float g = gain ? gain[k0 + k] : 1.f; LAS float* d = scr + k * 65 + c4;
        d[0] = v[i][0] * g; d[1] = v[i][1] * g; d[2] = v[i][2] * g; d[3] = v[i][3] * g; }
    LDS_WAIT(); asm volatile("" ::: "memory");
    const int kc = lane & 7;
#pragma unroll
    for (int j = 0; j < 8; ++j) { const int n = (lane >> 3) + 8 * j; const LAS float* sp = scr + (8 * kc) * 65 + n;
        u32x4 o; o.x = cvt_pk_bf16(sp[0 * 65], sp[1 * 65]); o.y = cvt_pk_bf16(sp[2 * 65], sp[3 * 65]); o.z = cvt_pk_bf16(sp[4 * 65], sp[5 * 65]); o.w = cvt_pk_bf16(sp[6 * 65], sp[7 * 65]);
        *(GAS u32x4*)(WT + (size_t)(n0dst + n) * ldk + k0 + 8 * kc) = o; }
    LDS_WAIT(); asm volatile("" ::: "memory");
}
__device__ __forceinline__ void tr_item64_f8(const GAS float* __restrict__ W, int ldw, const GAS float* __restrict__ gain, float scale, GAS unsigned char* __restrict__ WT8, int ldkB, int k0, int n0src, int n0dst, LAS float* scr, int lane) {
    const int rr = lane >> 4, c4 = (lane & 15) * 4;
    f32x4 v[16];
#pragma unroll
    for (int i = 0; i < 16; ++i) v[i] = __builtin_nontemporal_load((const GAS f32x4*)(W + (size_t)(k0 + 4 * i + rr) * ldw + n0src + c4));
#pragma unroll
    for (int i = 0; i < 16; ++i) { const int k = 4 * i + rr; const float g = (gain ? gain[k0 + k] : 1.f) * scale; LAS float* d = scr + k * 65 + c4;
        d[0] = v[i][0] * g; d[1] = v[i][1] * g; d[2] = v[i][2] * g; d[3] = v[i][3] * g; }
    LDS_WAIT(); asm volatile("" ::: "memory");
    const int kc = lane & 7;
#pragma unroll
    for (int j = 0; j < 8; ++j) { const int n = (lane >> 3) + 8 * j; const LAS float* sp = scr + (8 * kc) * 65 + n;
        u32x2 o; o.x = pk4_fp8(sp[0 * 65], sp[1 * 65], sp[2 * 65], sp[3 * 65]); o.y = pk4_fp8(sp[4 * 65], sp[5 * 65], sp[6 * 65], sp[7 * 65]);
        *(GAS u32x2*)(WT8 + (size_t)(n0dst + n) * ldkB + k0 + 8 * kc) = o; }
    LDS_WAIT(); asm volatile("" ::: "memory");
}
__device__ __forceinline__ int rope_dim(int p) { const int a = p >> 3, j = p & 7; return j < 4 ? 4 * a + j : 16 + 4 * a + (j - 4); }

#define LDP(i) ((void*)((((unsigned long long)(unsigned)__builtin_amdgcn_readfirstlane((int)(ARGP[i] >> 32))) << 32) | (unsigned long long)(unsigned)__builtin_amdgcn_readfirstlane((int)(unsigned)ARGP[i])))
#define ARGIN(i) ((const void*)LDP(i))
#define P_COS ((GAS float*)(ws + WS_COS))
#define P_SIN ((GAS float*)(ws + WS_SIN))
#define P_SSQ ((GAS float*)(ws + WS_SSQ))
#define P_FLOG ((GAS float*)(ws + WS_FLOG))
#define P_E01 ((GAS int*)(ws + WS_E01))
#define P_G01 ((GAS float*)(ws + WS_G01))
#define P_SLOT ((GAS int*)(ws + WS_SLOT))
#define P_TOKOF ((GAS int*)(ws + WS_TOKOF))
#define P_GATEOF ((GAS float*)(ws + WS_GATEOF))
#define P_CNT ((GAS int*)(ws + WS_CNT))
#define P_TSTART ((GAS int*)(ws + WS_TSTART))
#define P_RSTD ((GAS float*)(ws + WS_RSTD))
#define P_RSTDOF ((GAS float*)(ws + WS_RSTDOF))
#define P_KPE ((GAS bf16*)(ws + WS_KPE))
#define P_KAUG ((GAS bf16*)(ws + WS_KAUG))
#define P_BIASF ((GAS float*)(ws + WS_BIASF))
#define P_NRM ((GAS float*)(ws + WS_NRM))
#define P_WR ((GAS bf16*)(ws + WS_WR))
#define P_XR ((GAS bf16*)(ws + WS_XR))
#define P_OSS ((GAS float*)(ws + WS_OSS))
#define P_RSTDX ((GAS float*)(ws + WS_RSTDX))
#define P_WIN ((GAS bf16*)(ws + WS_WIN))
#define P_WUQ ((GAS bf16*)(ws + WS_WUQ))
#define P_WUKV ((GAS bf16*)(ws + WS_WUKV))
#define P_WOUT ((GAS bf16*)(ws + WS_WOUT))
#define P_WGU_L(ll) ((GAS unsigned char*)(ws + WS_WGU + (size_t)((ll) & 1) * 32 * MiB))
#define P_WD_L(ll) ((GAS unsigned char*)(ws + WS_WD + (size_t)((ll) & 1) * 16 * MiB))
#define P_XN ((GAS bf16*)(ws + WS_XN))
#define P_FQKV ((GAS bf16*)(ws + WS_FQKV))
#define P_HH ((GAS bf16*)(ws + WS_FQKV))
#define P_LAT ((GAS bf16*)(ws + WS_LAT))
#define P_QM ((GAS bf16*)(ws + WS_QM))
#define P_KVM ((GAS bf16*)(ws + WS_KVM))
#define P_Y ((GAS bf16*)(ws + WS_Y))
#define IN(k) (lo <= (k) && (k) < hi_)
#if MK_ONE_LAUNCH
#define GRID_BAR() xcd_barrier(bar)
#else
#define GRID_BAR() do {} while (0)
#endif
#define SEAM(k) do { if (IN(k) && IN((k) + 1)) GRID_BAR(); } while (0)
__device__ __forceinline__ void conv_gu_item(int r, const GAS float* w_gate, const GAS float* w_up, const GAS float* ffn_norm, GAS unsigned char* WGU, LAS float* scr64, int lane) {
    const int e = r / 256, q = r % 256, kb = q / 16, nb = q % 16; const int n0 = nb * 64; const int ct = n0 >> 8, which = (n0 >> 7) & 1, jj = n0 & 127;
    const GAS float* src = (which ? w_up : w_gate) + (size_t)e * DM * DEXP;
    tr_item64_f8(src, DEXP, ffn_norm, WSCALE, WGU + (size_t)e * 1024 * 1024, DM, kb * 64, ct * 128 + jj, n0, scr64, lane);
}
__device__ __forceinline__ void conv_d_item(int r, const GAS float* w_down, GAS unsigned char* WD, LAS float* scr64, int lane) {
    const int e = r / 128, q = r % 128, kb = q / 16, nb = q % 16;
    tr_item64_f8(w_down + (size_t)e * DEXP * DM, DM, nullptr, WSCALE, WD + (size_t)e * 1024 * 512, DEXP, kb * 64, nb * 64, nb * 64, scr64, lane);
}
template <int l>
__device__ __forceinline__ void layer_body(const int lo, const int hi_, LAS unsigned char* lds0, const int wave0, const int G0, const int bx0, const XcdBarrier& bar) {
        const int P = 10 * l;
        if (IN(P)) for (int rep_ = 0; rep_ < (l == 0 ? NREP(0) : 1); ++rep_) {
            unsigned ldsb_ = (unsigned)(uintptr_t)lds0; asm volatile("" : "+s"(ldsb_)); LAS unsigned char* lds = (LAS unsigned char*)(uintptr_t)ldsb_; volatile LAS unsigned* MISC = (volatile LAS unsigned*)(lds + MISC_OFF); volatile LAS unsigned long long* ARGP = (volatile LAS unsigned long long*)(lds + MISC_OFF + 768); (void)MISC; int wave = wave0, G = G0, bx = bx0; asm volatile("" : "+s"(G), "+s"(bx), "+s"(wave)); const int lane = (int)__builtin_amdgcn_mbcnt_hi(~0u, __builtin_amdgcn_mbcnt_lo(~0u, 0u)); const int tid = wave * 64 + lane; const int vcu = (bx % 8) * (G / 8) + bx / 8; const int gw = vcu * 8 + wave, NGW = G * 8; (void)lane; (void)gw; (void)NGW; (void)vcu;
            GAS unsigned char* ws = (GAS unsigned char*)LDP(22); GAS float* out = (GAS float*)LDP(21); const GAS float* x_in = (const GAS float*)ARGIN(0); const GAS int* positions = (const GAS int*)ARGIN(1);
            if (l < NLAYER) {
                LAS float* scr = (LAS float*)(lds + wave * 16640);
                const GAS float* attn_norm = (const GAS float*)ARGIN(2) + (size_t)l * DM; const GAS float* w_in = (const GAS float*)ARGIN(3) + (size_t)l * DM * INW;
                const GAS float* q_norm = (const GAS float*)ARGIN(5) + (size_t)l * 256; const GAS float* w_uq = (const GAS float*)ARGIN(6) + (size_t)l * 256 * 768;
                const GAS float* kv_norm = (const GAS float*)ARGIN(7) + (size_t)l * 128; const GAS float* w_ukv = (const GAS float*)ARGIN(8) + (size_t)l * 128 * 1024;
                const GAS float* mla_on = (const GAS float*)ARGIN(9) + (size_t)l * 512; const GAS float* fox_on = (const GAS float*)ARGIN(10) + (size_t)l * 512; const GAS float* w_out = (const GAS float*)ARGIN(11) + (size_t)l * DM * DM;
                const GAS float* ffn_norm = (const GAS float*)ARGIN(12) + (size_t)l * DM;
                const GAS float* w_gate = (const GAS float*)ARGIN(17) + (size_t)l * NEXP * DM * DEXP; const GAS float* w_up = (const GAS float*)ARGIN(18) + (size_t)l * NEXP * DM * DEXP; const GAS float* w_down = (const GAS float*)ARGIN(19) + (size_t)l * NEXP * DEXP * DM;
                constexpr int I_IN = 16 * 64, I_UQ = 4 * 24, I_UKV = 4 * 32;
                constexpr int NITEMS = I_IN + I_UQ + I_UKV;
                for (int it = gw; it < NITEMS; it += NGW) {
                    int r = it; const int j = lane & 31;
                    if (r < I_IN) { const int kb = r / 64, nb = r % 64; const int n = nb * 32 + j; int sc;
                        if (n < 384) sc = n; else if (n < 416) sc = 384 + rope_dim(n - 384); else if (n < 424) sc = 1952 + (n - 416); else if (n < 512) sc = -1; else sc = 416 + (n - 512);
                        tr_item(w_in, INW, DM, attn_norm, P_WIN, DM, kb * 64, nb * 32, sc, scr, lane); continue; } r -= I_IN;
                    if (r < I_UQ) { const int kb = r / 24, nb = r % 24; const int n = nb * 32 + j; const int hh = n / 96, d = n % 96; const int sc = d < 64 ? n : hh * 96 + 64 + rope_dim(d - 64);
                        tr_item(w_uq, 768, 256, q_norm, P_WUQ, 256, kb * 64, nb * 32, sc, scr, lane); continue; } r -= I_UQ;
                    { const int kb = r / 32, nb = r % 32; tr_item(w_ukv, 1024, 128, kv_norm, P_WUKV, 256, kb * 64, nb * 32, nb * 32 + j, scr, lane); }
                }
                LAS float* scr64 = (LAS float*)(lds + wave * 16640);
                constexpr int J_OUT = 16 * 16, J_GU = 16 * 16 * NEXP, J_D = 8 * 16 * NEXP;
                for (int it = gw; it < J_OUT + (l == 0 ? J_GU + J_D : 0); it += NGW) {
                    int r = it;
                    if (r < J_OUT) { const int kb = r / 16, nb = r % 16; const GAS float* gn = kb < 8 ? mla_on : fox_on - 512; tr_item64(w_out, DM, gn, P_WOUT, DM, kb * 64, nb * 64, nb * 64, scr64, lane); continue; } r -= J_OUT;
                    if (r < J_GU) { conv_gu_item(r, w_gate, w_up, ffn_norm, P_WGU_L(l), scr64, lane); continue; } r -= J_GU;
                    conv_d_item(r, w_down, P_WD_L(l), scr64, lane);
                }
                { const GAS float* w_rg = (const GAS float*)ARGIN(13) + (size_t)l * DM * 4; const GAS float* w_re = (const GAS float*)ARGIN(15) + (size_t)l * DM * 32;
                  for (int idx = bx * 512 + tid; idx < 2 * 48 * 520; idx += G * 512) { const int half = idx / (48 * 520), r = idx % (48 * 520), c = r / 520, kk = r % 520; const int k = half * 512 + kk;
                      float w = 0.f; if (c < 36 && kk < 512) w = ffn_norm[k] * (c < 4 ? w_rg[k * 4 + c] : w_re[k * 32 + (c - 4)]);
                      const unsigned h16 = cvt_pk_bf16(w, 0.f) & 0xffffu; const unsigned l16 = cvt_pk_bf16(w - __uint_as_float(h16 << 16), 0.f) & 0xffffu;
                      P_WR[(size_t)(half * 2 + 0) * 48 * 520 + r] = (bf16)h16; P_WR[(size_t)(half * 2 + 1) * 48 * 520 + r] = (bf16)l16; } }
            }
            const GAS float* fin = (const GAS float*)ARGIN(20);
            for (int mb = gw * 4; mb < NTOK; mb += NGW * 4) {
                f32x4 v[4][4]; int s0[4], s1[4];
                if (l > 0) {
#pragma unroll
                    for (int r = 0; r < 4; ++r) { s0[r] = P_SLOT[2 * (mb + r)]; s1[r] = P_SLOT[2 * (mb + r) + 1]; }
                }
#pragma unroll
                for (int r = 0; r < 4; ++r) {
                    if (l == 0) { const GAS float* xr = x_in + (size_t)(mb + r) * DM;
#pragma unroll
                        for (int j = 0; j < 4; ++j) v[r][j] = __builtin_nontemporal_load((const GAS f32x4*)(xr + 4 * lane + 256 * j)); }
                    else { const GAS bf16* xr = P_XR + (size_t)(mb + r) * DM;
#pragma unroll
                        for (int j = 0; j < 4; ++j) { const u32x2 w = __builtin_nontemporal_load((const GAS u32x2*)(xr + 4 * lane + 256 * j)); v[r][j] = (f32x4){__uint_as_float(w.x << 16), __uint_as_float(w.x & 0xffff0000u), __uint_as_float(w.y << 16), __uint_as_float(w.y & 0xffff0000u)}; } } }
                if (l > 0) {
#pragma unroll
                    for (int r = 0; r < 4; ++r)
#pragma unroll
                        for (int j = 0; j < 4; ++j) { const int a = __builtin_nontemporal_load((const GAS int*)((const GAS unsigned char*)P_Y + (size_t)s0[r] * 1024 + 4 * lane + 256 * j)), c = __builtin_nontemporal_load((const GAS int*)((const GAS unsigned char*)P_Y + (size_t)s1[r] * 1024 + 4 * lane + 256 * j));
                            const f32x2 a0 = __builtin_amdgcn_cvt_pk_f32_fp8(a, false), a1 = __builtin_amdgcn_cvt_pk_f32_fp8(a, true), c0 = __builtin_amdgcn_cvt_pk_f32_fp8(c, false), c1 = __builtin_amdgcn_cvt_pk_f32_fp8(c, true);
                            v[r][j][0] += (a0[0] + c0[0]) * WSCALE_INV; v[r][j][1] += (a0[1] + c0[1]) * WSCALE_INV; v[r][j][2] += (a1[0] + c1[0]) * WSCALE_INV; v[r][j][3] += (a1[1] + c1[1]) * WSCALE_INV; }
                }
                float ss[4];
#pragma unroll
                for (int r = 0; r < 4; ++r) { float s = 0.f;
#pragma unroll
                    for (int j = 0; j < 4; ++j) s += (v[r][j][0] * v[r][j][0] + v[r][j][1] * v[r][j][1]) + (v[r][j][2] * v[r][j][2] + v[r][j][3] * v[r][j][3]);
                    ss[r] = s; }
#pragma unroll
                for (int o = 1; o < 64; o <<= 1) {
#pragma unroll
                    for (int r = 0; r < 4; ++r) ss[r] += __shfl_xor(ss[r], o); }
#pragma unroll
                for (int r = 0; r < 4; ++r) { const int m = mb + r; const float rstd = rsqrtf(ss[r] * (1.f / DM) + EPS);
                    if (l < NLAYER) {
#pragma unroll
                        for (int j = 0; j < 4; ++j) { u32x2 w; w.x = cvt_pk_bf16(v[r][j][0], v[r][j][1]); w.y = cvt_pk_bf16(v[r][j][2], v[r][j][3]); *(GAS u32x2*)(P_XR + (size_t)m * DM + 4 * lane + 256 * j) = w; }
                        if (lane == 0) P_RSTDX[m] = rstd;
                    } else {
#pragma unroll
                        for (int j = 0; j < 4; ++j) { const f32x4 g = *(const GAS f32x4*)(fin + 4 * lane + 256 * j); __builtin_nontemporal_store(v[r][j] * rstd * g, (GAS f32x4*)(out + (size_t)m * DM + 4 * lane + 256 * j)); }
                    }
                }
            }
        }
        if constexpr (l == NLAYER) return;
        SEAM(P);
        if (IN(P + 1)) for (int rep_ = 0; rep_ < ((l == 0 || 1 != 5) ? NREP(1) : 1); ++rep_) {
            unsigned ldsb_ = (unsigned)(uintptr_t)lds0; asm volatile("" : "+s"(ldsb_)); LAS unsigned char* lds = (LAS unsigned char*)(uintptr_t)ldsb_; volatile LAS unsigned* MISC = (volatile LAS unsigned*)(lds + MISC_OFF); volatile LAS unsigned long long* ARGP = (volatile LAS unsigned long long*)(lds + MISC_OFF + 768); (void)MISC; int wave = wave0, G = G0, bx = bx0; asm volatile("" : "+s"(G), "+s"(bx), "+s"(wave)); const int lane = (int)__builtin_amdgcn_mbcnt_hi(~0u, __builtin_amdgcn_mbcnt_lo(~0u, 0u)); const int tid = wave * 64 + lane; const int vcu = (bx % 8) * (G / 8) + bx / 8; const int gw = vcu * 8 + wave, NGW = G * 8; (void)lane; (void)gw; (void)NGW; (void)vcu;
            GAS unsigned char* ws = (GAS unsigned char*)LDP(22); GAS float* out = (GAS float*)LDP(21); const GAS float* x_in = (const GAS float*)ARGIN(0); (void)out; (void)x_in; (void)ws;
            DenseOrder S{NTOK / 256, INP / 256, (NTOK / 256) * (INP / 256), G, bx, (const GAS char*)P_XR, (const GAS char*)P_WIN, (size_t)256 * DM * 2, (size_t)256 * DM * 2};
            EpiWin E{P_LAT, P_FQKV, P_KPE, P_FLOG, P_SSQ, P_COS, P_SIN, P_RSTDX};
            pg8::gemm_phase<EpiWin, DenseOrder, true, false>(tid, lds, DM * 2, DM * 2, DM * 2, S, E, nullptr);
        }
        SEAM(P + 1);
        if (IN(P + 2)) for (int rep_ = 0; rep_ < ((l == 0 || 2 != 5) ? NREP(2) : 1); ++rep_) {
            unsigned ldsb_ = (unsigned)(uintptr_t)lds0; asm volatile("" : "+s"(ldsb_)); LAS unsigned char* lds = (LAS unsigned char*)(uintptr_t)ldsb_; volatile LAS unsigned* MISC = (volatile LAS unsigned*)(lds + MISC_OFF); volatile LAS unsigned long long* ARGP = (volatile LAS unsigned long long*)(lds + MISC_OFF + 768); (void)MISC; int wave = wave0, G = G0, bx = bx0; asm volatile("" : "+s"(G), "+s"(bx), "+s"(wave)); const int lane = (int)__builtin_amdgcn_mbcnt_hi(~0u, __builtin_amdgcn_mbcnt_lo(~0u, 0u)); const int tid = wave * 64 + lane; const int vcu = (bx % 8) * (G / 8) + bx / 8; const int gw = vcu * 8 + wave, NGW = G * 8; (void)lane; (void)gw; (void)NGW; (void)vcu;
            GAS unsigned char* ws = (GAS unsigned char*)LDP(22); GAS float* out = (GAS float*)LDP(21); const GAS float* x_in = (const GAS float*)ARGIN(0); (void)out; (void)x_in; (void)ws;
            {
                const int sq = vcu >> 1, hf = vcu & 1; const int b = sq >> 3, h = sq & 7; const float bf = ((const GAS float*)ARGIN(4))[l * 8 + h];
                const GAS float* fl = P_FLOG + ((size_t)b * SEQ + hf * 1024 + 2 * tid) * 8 + h;
                float lf[2], lg[2] = {0.f, 0.f};
#pragma unroll
                for (int e = 0; e < 2; ++e) { const float f = fl[e * 8] + bf; lf[e] = fminf(f, 0.f) - log1pf(expf(-fabsf(f))); }
                if (hf) {
#pragma unroll
                    for (int e = 0; e < 2; ++e) { const float f = fl[e * 8 - 1024 * 8] + bf; lg[e] = fminf(f, 0.f) - log1pf(expf(-fabsf(f))); } }
                const double s2 = (double)lf[0] + (double)lf[1];
                double incl = s2, first = (double)lg[0] + (double)lg[1];
#pragma unroll
                for (int o = 1; o < 64; o <<= 1) { const double t = __shfl_up(incl, o); if (lane >= o) incl += t; first += __shfl_xor(first, o); }
                LAS double* wtot = (LAS double*)lds;
                if (lane == 63) wtot[wave] = incl;
                if (lane == 0) wtot[8 + wave] = first;
                __syncthreads();
                double c = incl - s2;
                for (int w = 0; w < wave; ++w) c += wtot[w];
                if (hf) { for (int w = 0; w < 8; ++w) c += wtot[8 + w]; }
                const size_t t0 = ((size_t)b * 8 + h) * SEQ + hf * 1024 + 2 * tid;
                GAS u32x4* ka = (GAS u32x4*)(P_KAUG + t0 * 8);
#pragma unroll
                for (int e = 0; e < 2; ++e) { c += (double)lf[e]; const float x = (float)(-c * 1.4426950408889634);
                    const unsigned h16 = cvt_pk_bf16(x, 0.f) & 0xffffu; const float r1 = x - __uint_as_float(h16 << 16); const unsigned m16 = cvt_pk_bf16(r1, 0.f) & 0xffffu; const float r2 = r1 - __uint_as_float(m16 << 16); const unsigned l16 = cvt_pk_bf16(r2, 0.f) & 0xffffu;
                    ka[e] = (u32x4){h16 | (m16 << 16), l16, 0u, 0u}; P_BIASF[t0 + e] = x; }
                float qn = 0.f, kn = 0.f;
                { const GAS bf16* fqp = P_FQKV + ((size_t)b * SEQ + hf * 1024 + 2 * tid) * 512 + h * 64; const GAS bf16* fkp = fqp + (size_t)NTOK * 512;
#pragma unroll
                  for (int e = 0; e < 2; ++e) { float sq_ = 0.f, sk = 0.f;
#pragma unroll
                      for (int c8 = 0; c8 < 8; ++c8) { const u32x4 a = *(const GAS u32x4*)(fqp + e * 512 + c8 * 8), k4 = *(const GAS u32x4*)(fkp + e * 512 + c8 * 8);
#pragma unroll
                          for (int j = 0; j < 4; ++j) { const float a0 = __uint_as_float(a[j] << 16), a1 = __uint_as_float(a[j] & 0xffff0000u), k0 = __uint_as_float(k4[j] << 16), k1 = __uint_as_float(k4[j] & 0xffff0000u);
                              sq_ += a0 * a0 + a1 * a1; sk += k0 * k0 + k1 * k1; } }
                      qn = fmaxf(qn, sq_); kn = fmaxf(kn, sk); } }
#pragma unroll
                for (int o = 1; o < 64; o <<= 1) { qn = fmaxf(qn, __shfl_xor(qn, o)); kn = fmaxf(kn, __shfl_xor(kn, o)); }
                LAS float* knw = (LAS float*)(lds + 256);
                if (lane == 0) { knw[wave] = kn; knw[8 + wave] = qn; }
                __syncthreads();
                if (tid < 4) P_NRM[sq * 16 + hf * 4 + tid] = sqrtf(fmaxf(knw[8 + 2 * tid], knw[8 + 2 * tid + 1]));
                if (tid == 4) { float m = knw[0]; for (int w = 1; w < 8; ++w) m = fmaxf(m, knw[w]); P_NRM[sq * 16 + 8 + hf] = sqrtf(m); }
                __syncthreads();
            }
            UpOrder S{G, vcu, (const GAS char*)P_LAT, (const GAS char*)P_WUQ, (const GAS char*)P_WUKV};
            EpiUp E{P_QM, P_KVM, P_SSQ, P_COS, P_SIN};
            pg8::gemm_phase<EpiUp, UpOrder, true, false, false, false, true>(tid, lds, 256 * 2, 512 * 2, 256 * 2, S, E, nullptr);
        }
        SEAM(P + 2);
        if (IN(P + 3)) for (int rep_ = 0; rep_ < ((l == 0 || 3 != 5) ? NREP(3) : 1); ++rep_) {
            unsigned ldsb_ = (unsigned)(uintptr_t)lds0; asm volatile("" : "+s"(ldsb_)); LAS unsigned char* lds = (LAS unsigned char*)(uintptr_t)ldsb_; volatile LAS unsigned* MISC = (volatile LAS unsigned*)(lds + MISC_OFF); volatile LAS unsigned long long* ARGP = (volatile LAS unsigned long long*)(lds + MISC_OFF + 768); (void)MISC; int wave = wave0, G = G0, bx = bx0; asm volatile("" : "+s"(G), "+s"(bx), "+s"(wave)); const int lane = (int)__builtin_amdgcn_mbcnt_hi(~0u, __builtin_amdgcn_mbcnt_lo(~0u, 0u)); const int tid = wave * 64 + lane; const int vcu = (bx % 8) * (G / 8) + bx / 8; const int gw = vcu * 8 + wave, NGW = G * 8; (void)lane; (void)gw; (void)NGW; (void)vcu;
            GAS unsigned char* ws = (GAS unsigned char*)LDP(22); GAS float* out = (GAS float*)LDP(21); const GAS float* x_in = (const GAS float*)ARGIN(0); (void)out; (void)x_in; (void)ws;
            GAS bf16* O = P_XN;
            const int b = vcu >> 4, hh = (vcu & 15) >> 1, sub = vcu & 1;
            const att::Tens2 TM{P_QM, 768, P_KVM, 1024, P_KPE, P_KVM + 64, 1024, O, nullptr, nullptr, P_OSS};
            const att::Tens2 TF{P_FQKV, 512, P_FQKV + (size_t)NTOK * 512, 512, P_KAUG, P_FQKV + (size_t)2 * NTOK * 512, 512, O, P_BIASF, P_NRM, P_OSS};
#define QB_OF(i) ((((i) & 1) ? 7 - (2 * sub + ((i) >> 1)) : (2 * sub + ((i) >> 1))))
            int ts0, ts1, ts2, ts3;
            { const GAS float* bs = P_BIASF + ((long)b * 8 + hh) * SEQ; const GAS float* nr = P_NRM + (b * 8 + hh) * 16; const float kmx = fmaxf(nr[8], nr[9]);
#define FOX_TS(i, dst) do { const int qb_ = QB_OF(i), NT_ = 4 * qb_ + 4; const float Z_ = nr[qb_] * kmx * 1.001f + 0.01f; const float bend_ = bs[(lane < NT_ ? lane : NT_ - 1) * 64 + 63]; \
                  const bool skip_ = (lane < NT_ - 4) && (2.f * Z_ + bend_ - bs[qb_ * 256] < -40.f); dst = __builtin_popcountll(__ballot(skip_)); } while (0)
              FOX_TS(0, ts0); FOX_TS(1, ts1); FOX_TS(2, ts2); FOX_TS(3, ts3);
#undef FOX_TS
            }
            if (wave >= 4) __builtin_amdgcn_s_setprio(1);
            bf16x8 qreg[6];
            { int sb = 0; for (int i = 0; i < 4; ++i) sb = att::attn_unit2<1>(wave, b, hh, QB_OF(i), TM, (LAS char*)lds, sb, i > 0, i < 3 ? QB_OF(i + 1) : -1, qreg, 0); }
            { int sb = 0; for (int i = 0; i < 4; ++i) { const int ts = i == 0 ? ts0 : i == 1 ? ts1 : i == 2 ? ts2 : ts3; sb = att::attn_unit2<0>(wave, b, hh, QB_OF(i), TF, (LAS char*)lds, sb, i > 0, i < 3 ? QB_OF(i + 1) : -1, qreg, ts); } }
#undef QB_OF
            __builtin_amdgcn_s_setprio(0);
        }
        SEAM(P + 3);
        if (IN(P + 5)) for (int rep_ = 0; rep_ < ((l == 0 || 5 != 5) ? NREP(5) : 1); ++rep_) {
            unsigned ldsb_ = (unsigned)(uintptr_t)lds0; asm volatile("" : "+s"(ldsb_)); LAS unsigned char* lds = (LAS unsigned char*)(uintptr_t)ldsb_; volatile LAS unsigned* MISC = (volatile LAS unsigned*)(lds + MISC_OFF); volatile LAS unsigned long long* ARGP = (volatile LAS unsigned long long*)(lds + MISC_OFF + 768); (void)MISC; int wave = wave0, G = G0, bx = bx0; asm volatile("" : "+s"(G), "+s"(bx), "+s"(wave)); const int lane = (int)__builtin_amdgcn_mbcnt_hi(~0u, __builtin_amdgcn_mbcnt_lo(~0u, 0u)); const int tid = wave * 64 + lane; const int vcu = (bx % 8) * (G / 8) + bx / 8; const int gw = vcu * 8 + wave, NGW = G * 8; (void)lane; (void)gw; (void)NGW; (void)vcu;
            GAS unsigned char* ws = (GAS unsigned char*)LDP(22); GAS float* out = (GAS float*)LDP(21); const GAS float* x_in = (const GAS float*)ARGIN(0); (void)out; (void)x_in; (void)ws;
            DenseOrder S{NTOK / 256, DM / 256, (NTOK / 256) * (DM / 256), G, bx, (const GAS char*)P_XN, (const GAS char*)P_WOUT, (size_t)256 * DM * 2, (size_t)256 * DM * 2};
            EpiOut<false> E{x_in, P_XR};
            LAS f32x2* scl = (LAS f32x2*)(lds + pg8::STAGE_BYTES);
            { Unit u_; if (S.next(tid >> 8, u_)) { const GAS float* op = P_OSS + ((size_t)u_.pm * 256 + (tid & 255)) * 16;
                  const f32x4 a0 = *(const GAS f32x4*)op, a1 = *(const GAS f32x4*)(op + 4), c0 = *(const GAS f32x4*)(op + 8), c1 = *(const GAS f32x4*)(op + 12);
                  const float sm = ((a0[0] + a0[1]) + (a0[2] + a0[3])) + ((a1[0] + a1[1]) + (a1[2] + a1[3])), sf = ((c0[0] + c0[1]) + (c0[2] + c0[3])) + ((c1[0] + c1[1]) + (c1[2] + c1[3]));
                  const float rm_ = rsqrtf(sm * (1.f / 512.f) + EPS), rf_ = rsqrtf(sf * (1.f / 512.f) + EPS);
                  scl[tid] = (f32x2){rm_ / rf_, rf_}; } }
            __syncthreads();
            pg8::gemm_phase<EpiOut<false>, DenseOrder, true, false, false, true>(tid, lds, DM * 2, DM * 2, DM * 2, S, E, nullptr, scl);
        }
        SEAM(P + 5);
        if (IN(P + 6)) for (int rep_ = 0; rep_ < ((l == 0 || 6 != 5) ? NREP(6) : 1); ++rep_) {
            unsigned ldsb_ = (unsigned)(uintptr_t)lds0; asm volatile("" : "+s"(ldsb_)); LAS unsigned char* lds = (LAS unsigned char*)(uintptr_t)ldsb_; volatile LAS unsigned* MISC = (volatile LAS unsigned*)(lds + MISC_OFF); volatile LAS unsigned long long* ARGP = (volatile LAS unsigned long long*)(lds + MISC_OFF + 768); (void)MISC; int wave = wave0, G = G0, bx = bx0; asm volatile("" : "+s"(G), "+s"(bx), "+s"(wave)); const int lane = (int)__builtin_amdgcn_mbcnt_hi(~0u, __builtin_amdgcn_mbcnt_lo(~0u, 0u)); const int tid = wave * 64 + lane; const int vcu = (bx % 8) * (G / 8) + bx / 8; const int gw = vcu * 8 + wave, NGW = G * 8; (void)lane; (void)gw; (void)NGW; (void)vcu;
            GAS unsigned char* ws = (GAS unsigned char*)LDP(22); GAS float* out = (GAS float*)LDP(21); const GAS float* x_in = (const GAS float*)ARGIN(0); (void)out; (void)x_in; (void)ws;
            GAS bf16* H2 = P_XN;
            LAS bf16* WT = (LAS bf16*)lds;
            LAS float* LG = (LAS float*)(lds + 99840) + wave * 576;
            const GAS float* b_rg = (const GAS float*)ARGIN(14) + l * 4; const GAS float* b_re = (const GAS float*)ARGIN(16) + l * 32;
            if (tid < 32) MISC[64 + tid] = 0u;
            const int r16 = lane & 15, g4 = lane >> 4;
            const int m0 = vcu * 128 + wave * 16;
            const GAS bf16* xrow = P_XR + (size_t)(m0 + r16) * DM + 8 * g4;
            GAS unsigned char* hrow = (GAS unsigned char*)H2 + (size_t)(m0 + r16) * DM + 8 * g4;
            f32x4 acc3[3]; acc3[0] = (f32x4){0.f, 0.f, 0.f, 0.f}; acc3[1] = acc3[0]; acc3[2] = acc3[0];
            float ssq = 0.f;
            for (int half = 0; half < 2; ++half) {
                __syncthreads();
                for (int idx = tid; idx < 2 * 48 * 520 / 8; idx += 512) *(LAS u32x4*)(WT + 8 * idx) = *(const GAS u32x4*)(P_WR + (size_t)half * 2 * 48 * 520 + 8 * idx);
                __syncthreads();
                for (int s8 = 0; s8 < 16; s8 += 8) {
                    bf16x8 xv[8];
#pragma unroll
                    for (int u = 0; u < 8; ++u) xv[u] = *(const GAS bf16x8*)(xrow + half * 512 + 32 * (s8 + u));
#pragma unroll
                    for (int u = 0; u < 8; ++u) {
                        const u32x4 xw = __builtin_bit_cast(u32x4, xv[u]); float xf[8];
#pragma unroll
                        for (int j = 0; j < 4; ++j) { xf[2 * j] = __uint_as_float(xw[j] << 16); xf[2 * j + 1] = __uint_as_float(xw[j] & 0xffff0000u); }
                        u32x2 hw; hw.x = pk4_fp8(xf[0], xf[1], xf[2], xf[3]); hw.y = pk4_fp8(xf[4], xf[5], xf[6], xf[7]); *(GAS u32x2*)(hrow + half * 512 + 32 * (s8 + u)) = hw;
#pragma unroll
                        for (int j = 0; j < 8; ++j) ssq += xf[j] * xf[j];
                        const LAS bf16* wk = WT + r16 * 520 + 32 * (s8 + u) + 8 * g4;
#pragma unroll
                        for (int ct = 0; ct < 3; ++ct) { const bf16x8 bh = *(const LAS bf16x8*)(wk + ct * 16 * 520), bl = *(const LAS bf16x8*)(wk + (48 + ct * 16) * 520);
                            acc3[ct] = __builtin_amdgcn_mfma_f32_16x16x32_bf16(xv[u], bh, acc3[ct], 0, 0, 0); acc3[ct] = __builtin_amdgcn_mfma_f32_16x16x32_bf16(xv[u], bl, acc3[ct], 0, 0, 0); }
                    }
                }
            }
            ssq += __shfl_xor(ssq, 16); ssq += __shfl_xor(ssq, 32);
            const float rstd = rsqrtf(ssq * (1.f / DM) + EPS);
#pragma unroll
            for (int ct = 0; ct < 3; ++ct) { const int c = 16 * ct + r16; if (c < 36) {
#pragma unroll
                for (int rg = 0; rg < 4; ++rg) LG[(4 * g4 + rg) * 36 + c] = acc3[ct][rg]; } }
            LDS_WAIT();
            if (lane < 16) {
                const int m = m0 + lane; const LAS float* lg = LG + lane * 36;
                float gl[4];
#pragma unroll
                for (int g = 0; g < 4; ++g) gl[g] = lg[g] * rstd + b_rg[g];
                int gi = 0; float gm = gl[0];
#pragma unroll
                for (int g = 1; g < 4; ++g) if (gl[g] > gm) { gm = gl[g]; gi = g; }
                float gs = 0.f;
#pragma unroll
                for (int g = 0; g < 4; ++g) gs += __expf(gl[g] - gm);
                const float gval = 1.f / gs;
                float el[8];
#pragma unroll
                for (int j = 0; j < 8; ++j) el[j] = lg[4 + 8 * gi + j] * rstd + b_re[8 * gi + j];
                int i0 = 0; float mx0 = el[0];
#pragma unroll
                for (int j = 1; j < 8; ++j) if (el[j] > mx0) { mx0 = el[j]; i0 = j; }
                int i1 = -1; float mx1 = -INFINITY;
#pragma unroll
                for (int j = 0; j < 8; ++j) if (j != i0 && el[j] > mx1) { mx1 = el[j]; i1 = j; }
                const float e1 = __expf(mx1 - mx0); const float g0 = gval / (1.f + e1), g1 = gval * e1 / (1.f + e1);
                const int ea = gi * 8 + i0, eb = gi * 8 + i1; P_E01[2 * m] = ea; P_E01[2 * m + 1] = eb; P_G01[2 * m] = g0; P_G01[2 * m + 1] = g1; P_RSTD[m] = rstd;
                __hip_atomic_fetch_add((LAS unsigned*)(lds + MISC_OFF) + 64 + ea, 1u, __ATOMIC_RELAXED, __HIP_MEMORY_SCOPE_WORKGROUP); __hip_atomic_fetch_add((LAS unsigned*)(lds + MISC_OFF) + 64 + eb, 1u, __ATOMIC_RELAXED, __HIP_MEMORY_SCOPE_WORKGROUP);
            }
            __syncthreads();
            if (tid < 32) P_CNT[vcu * 32 + tid] = (int)MISC[64 + tid];
        }
        SEAM(P + 6);
        if (IN(P + 7)) for (int rep_ = 0; rep_ < ((l == 0 || 7 != 5) ? NREP(7) : 1); ++rep_) {
            unsigned ldsb_ = (unsigned)(uintptr_t)lds0; asm volatile("" : "+s"(ldsb_)); LAS unsigned char* lds = (LAS unsigned char*)(uintptr_t)ldsb_; volatile LAS unsigned* MISC = (volatile LAS unsigned*)(lds + MISC_OFF); volatile LAS unsigned long long* ARGP = (volatile LAS unsigned long long*)(lds + MISC_OFF + 768); (void)MISC; int wave = wave0, G = G0, bx = bx0; asm volatile("" : "+s"(G), "+s"(bx), "+s"(wave)); const int lane = (int)__builtin_amdgcn_mbcnt_hi(~0u, __builtin_amdgcn_mbcnt_lo(~0u, 0u)); const int tid = wave * 64 + lane; const int vcu = (bx % 8) * (G / 8) + bx / 8; const int gw = vcu * 8 + wave, NGW = G * 8; (void)lane; (void)gw; (void)NGW; (void)vcu;
            GAS unsigned char* ws = (GAS unsigned char*)LDP(22); GAS float* out = (GAS float*)LDP(21); const GAS float* x_in = (const GAS float*)ARGIN(0); (void)out; (void)x_in; (void)ws;
            LAS int* cnt_all = (LAS int*)lds;
            LAS int* pre_e = (LAS int*)(lds + 32768);
            LAS int* tot_e = pre_e + 32;
            LAS int* pst = pre_e + 64;
            LAS int* eL = pre_e + 128;
            for (int i = tid; i < 256 * 32; i += 512) cnt_all[i] = P_CNT[i];
            if (tid < 256) eL[tid] = P_E01[vcu * 256 + tid];
            __syncthreads();
            { LAS int* part = pre_e + 512;
              const int e = tid & 31, p = tid >> 5; int pre = 0, tot = 0;
#pragma unroll
              for (int j = 0; j < 16; ++j) { const int w = p * 16 + j; const int c = cnt_all[w * 32 + e]; pre += (w < vcu) ? c : 0; tot += c; }
              part[(p * 2) * 32 + e] = pre; part[(p * 2 + 1) * 32 + e] = tot; }
            __syncthreads();
            if (tid < 32) { LAS int* part = pre_e + 512; int pre = 0, tot = 0;
#pragma unroll
                for (int p = 0; p < 16; ++p) { pre += part[(p * 2) * 32 + tid]; tot += part[(p * 2 + 1) * 32 + tid]; } pre_e[tid] = pre; tot_e[tid] = tot; }
            __syncthreads();
            if (tid == 0) { int acc = 0; for (int e = 0; e < 32; ++e) { pst[e] = acc; acc += (tot_e[e] + 255) / 256 * 256; } pst[32] = acc; }
            __syncthreads();
            if (vcu == 0 && tid <= 32) P_TSTART[tid] = pst[tid] / 256;
            { LAS int* hist = pre_e + 2048;
              if (tid < 128) hist[tid] = 0;
              __syncthreads();
              int e = 0, rin = 0;
              if (tid < 256) { e = eL[tid]; unsigned long long mym = 0ull;
                  for (int x = 0; x < 32; ++x) { const unsigned long long bm = __ballot(e == x); if (e == x) mym = bm; }
                  rin = __builtin_popcountll(mym & ((1ull << lane) - 1ull));
                  if (rin == 0) hist[wave * 32 + e] = __builtin_popcountll(mym); }
              __syncthreads();
              if (tid < 256) { int r = rin; for (int w = 0; w < wave; ++w) r += hist[w * 32 + e];
                  const int slot = pst[e] + pre_e[e] + r; const int tok = vcu * 128 + (tid >> 1);
                  P_SLOT[vcu * 256 + tid] = slot; P_TOKOF[slot] = tok; P_GATEOF[slot] = P_G01[vcu * 256 + tid]; P_RSTDOF[slot] = P_RSTD[tok]; } }
            if (vcu < 32) { const int e = vcu; for (int s = pst[e] + tot_e[e] + tid; s < pst[e + 1]; s += 512) { P_TOKOF[s] = 0; P_GATEOF[s] = 0.f; P_RSTDOF[s] = 0.f; } }
            __syncthreads();
        }
        SEAM(P + 7);
        if (IN(P + 8)) for (int rep_ = 0; rep_ < ((l == 0 || 8 != 5) ? NREP(8) : 1); ++rep_) {
            unsigned ldsb_ = (unsigned)(uintptr_t)lds0; asm volatile("" : "+s"(ldsb_)); LAS unsigned char* lds = (LAS unsigned char*)(uintptr_t)ldsb_; volatile LAS unsigned* MISC = (volatile LAS unsigned*)(lds + MISC_OFF); volatile LAS unsigned long long* ARGP = (volatile LAS unsigned long long*)(lds + MISC_OFF + 768); (void)MISC; int wave = wave0, G = G0, bx = bx0; asm volatile("" : "+s"(G), "+s"(bx), "+s"(wave)); const int lane = (int)__builtin_amdgcn_mbcnt_hi(~0u, __builtin_amdgcn_mbcnt_lo(~0u, 0u)); const int tid = wave * 64 + lane; const int vcu = (bx % 8) * (G / 8) + bx / 8; const int gw = vcu * 8 + wave, NGW = G * 8; (void)lane; (void)gw; (void)NGW; (void)vcu;
            GAS unsigned char* ws = (GAS unsigned char*)LDP(22); GAS float* out = (GAS float*)LDP(21); const GAS float* x_in = (const GAS float*)ARGIN(0); (void)out; (void)x_in; (void)ws;
            volatile LAS int* TS = (volatile LAS int*)(MISC + 128);
            if (tid <= 32) TS[tid] = P_TSTART[tid];
            __syncthreads();
            MoeOrder S{G, vcu, TS, (const GAS char*)P_XN, (const GAS char*)P_WGU_L(l), 0, (size_t)1024 * 1024, (size_t)256 * 1024};
            EpiGU E{(GAS unsigned char*)P_HH, P_RSTDOF};
            pg8::gemm_phase<EpiGU, MoeOrder, true, true, true>(tid, lds, DM, DM, DM, S, E, P_TOKOF);
            if constexpr (l + 1 < NLAYER) {
                const int U = (int)TS[32] * 4, rem = U & 255; const int nidle = rem ? 256 - rem : 256, rk = rem ? vcu - rem : vcu;
                if (rk >= 0) { LAS float* scr64 = (LAS float*)(lds + wave * 16640);
                    const GAS float* w_gate = (const GAS float*)ARGIN(17) + (size_t)(l + 1) * NEXP * DM * DEXP; const GAS float* w_up = (const GAS float*)ARGIN(18) + (size_t)(l + 1) * NEXP * DM * DEXP; const GAS float* ffn1 = (const GAS float*)ARGIN(12) + (size_t)(l + 1) * DM;
                    for (int it = rk * 8 + wave; it < 16 * 16 * NEXP; it += nidle * 8) conv_gu_item(it, w_gate, w_up, ffn1, P_WGU_L(l + 1), scr64, lane); }
            }
        }
        SEAM(P + 8);
        if (IN(P + 9)) for (int rep_ = 0; rep_ < ((l == 0 || 9 != 5) ? NREP(9) : 1); ++rep_) {
            unsigned ldsb_ = (unsigned)(uintptr_t)lds0; asm volatile("" : "+s"(ldsb_)); LAS unsigned char* lds = (LAS unsigned char*)(uintptr_t)ldsb_; volatile LAS unsigned* MISC = (volatile LAS unsigned*)(lds + MISC_OFF); volatile LAS unsigned long long* ARGP = (volatile LAS unsigned long long*)(lds + MISC_OFF + 768); (void)MISC; int wave = wave0, G = G0, bx = bx0; asm volatile("" : "+s"(G), "+s"(bx), "+s"(wave)); const int lane = (int)__builtin_amdgcn_mbcnt_hi(~0u, __builtin_amdgcn_mbcnt_lo(~0u, 0u)); const int tid = wave * 64 + lane; const int vcu = (bx % 8) * (G / 8) + bx / 8; const int gw = vcu * 8 + wave, NGW = G * 8; (void)lane; (void)gw; (void)NGW; (void)vcu;
            GAS unsigned char* ws = (GAS unsigned char*)LDP(22); GAS float* out = (GAS float*)LDP(21); const GAS float* x_in = (const GAS float*)ARGIN(0); (void)out; (void)x_in; (void)ws;
            volatile LAS int* TS = (volatile LAS int*)(MISC + 128);
            if (tid <= 32) TS[tid] = P_TSTART[tid];
            __syncthreads();
            MoeOrder S{G, vcu, TS, (const GAS char*)P_HH, (const GAS char*)P_WD_L(l), (size_t)256 * 512, (size_t)1024 * 512, (size_t)256 * 512};
            EpiDown E{(GAS unsigned char*)P_Y, P_GATEOF};
            pg8::gemm_phase<EpiDown, MoeOrder, true, false, true>(tid, lds, DEXP, DEXP, DEXP, S, E, nullptr);
            if constexpr (l + 1 < NLAYER) {
                const int U = (int)TS[32] * 4, rem = U & 255; const int nidle = rem ? 256 - rem : 256, rk = rem ? vcu - rem : vcu;
                if (rk >= 0) { LAS float* scr64 = (LAS float*)(lds + wave * 16640);
                    const GAS float* w_down = (const GAS float*)ARGIN(19) + (size_t)(l + 1) * NEXP * DEXP * DM;
                    for (int it = rk * 8 + wave; it < 8 * 16 * NEXP; it += nidle * 8) conv_d_item(it, w_down, P_WD_L(l + 1), scr64, lane); }
            }
        }
        SEAM(P + 9);
}

__global__ void __launch_bounds__(512, 2) fwd(Args args) {
    extern __shared__ __attribute__((aligned(16))) unsigned char lds_raw[];
    LAS unsigned char* lds0 = (LAS unsigned char*)lds_raw;
    const int tid0 = threadIdx.x; const int wave0 = __builtin_amdgcn_readfirstlane(tid0 >> 6);
    const int G0 = gridDim.x; const int bx0 = blockIdx.x;
    { volatile LAS unsigned* MISC = (volatile LAS unsigned*)(lds0 + MISC_OFF); const int tid = tid0;
    for (int u = tid; u < 256; u += 512) MISC[u] = 0u;
    __syncthreads();
    volatile LAS unsigned long long* ARGP = (volatile LAS unsigned long long*)(lds0 + MISC_OFF + 768);
    if (tid < 21) ARGP[tid] = (unsigned long long)args.in[tid];
    if (tid == 21) ARGP[21] = (unsigned long long)args.out;
    if (tid == 22) ARGP[22] = (unsigned long long)args.ws;
    __syncthreads(); }
#if MK_ONE_LAUNCH
    XcdBarrier bar = xcd_barrier_post((unsigned*)(args.ws + WS_CTL) + CW_BAR, (volatile LAS unsigned*)(lds0 + MISC_OFF) + 8);
#else
    XcdBarrier bar; bar.bar = nullptr; bar.x = 0; bar.st = nullptr;
#endif
    const int lo = args.ph_lo, hi_ = args.ph_hi;
    if (IN(0)) {
        const GAS int* positions = (const GAS int*)args.in[1]; GAS float* COSp = (GAS float*)(args.ws + WS_COS); GAS float* SINp = (GAS float*)(args.ws + WS_SIN);
        for (int i = bx0 * 512 + tid0; i < NTOK * 16; i += G0 * 512) { const int tk = i >> 4, fi = i & 15;
            const double invrev = exp2(-(double)fi * (13.287712379549449 / 16.0)) * 0.15915494309189535; const double rev = (double)positions[tk] * invrev; const float fr = (float)(rev - rint(rev));
            COSp[i] = __builtin_amdgcn_cosf(fr); SINp[i] = __builtin_amdgcn_sinf(fr); }
    }
    layer_body<0>(lo, hi_, lds0, wave0, G0, bx0, bar);
    layer_body<1>(lo, hi_, lds0, wave0, G0, bx0, bar);
    layer_body<2>(lo, hi_, lds0, wave0, G0, bx0, bar);
}

extern "C" void kernel_launch(void* const* d_in, const int* in_sizes, int n_in, void* d_out, int out_size, void* d_ws, size_t ws_size, hipStream_t stream) {
    static int grid = 0;
    if (grid == 0) {
        if (n_in != 21 || out_size != NTOK * DM || ws_size < WS_END) { fprintf(stderr, "kernel_launch: unexpected shapes (n_in %d out %d ws %zu)\n", n_in, out_size, ws_size); grid = -1; return; }
        int dev = 0, cus = 0;
        if (hipGetDevice(&dev) != hipSuccess || hipDeviceGetAttribute(&cus, hipDeviceAttributeMultiprocessorCount, dev) != hipSuccess) { grid = -1; return; }
        if (hipFuncSetAttribute((const void*)fwd, hipFuncAttributeMaxDynamicSharedMemorySize, LDS_BYTES) != hipSuccess) { fprintf(stderr, "kernel_launch: hipFuncSetAttribute failed\n"); grid = -1; return; }
        int per_cu = 0;
        if (hipOccupancyMaxActiveBlocksPerMultiprocessor(&per_cu, (const void*)fwd, 512, LDS_BYTES) != hipSuccess || per_cu < 1) fprintf(stderr, "kernel_launch: occupancy query says %d\n", per_cu);
        (void)hipGetLastError();
        grid = cus;
        if (grid != 256) { fprintf(stderr, "kernel_launch: built for 256 CUs, got %d\n", grid); grid = -1; return; }
    }
    if (grid < 0) return;
    if (hipMemsetAsync((char*)d_ws + WS_CTL, 0, CTL_ZERO_BYTES, stream) != hipSuccess) return;
    Args a{};
    for (int i = 0; i < 21; ++i) a.in[i] = d_in[i];
    a.out = (float*)d_out; a.ws = (unsigned char*)d_ws;
#if MK_ONE_LAUNCH
    a.ph_lo = 0; a.ph_hi = 21;
    hipLaunchKernelGGL(fwd, dim3(grid), dim3(512), LDS_BYTES, stream, a);
#else
    for (int p = 0; p <= 20; ++p) { a.ph_lo = p; a.ph_hi = p + 1; hipLaunchKernelGGL(fwd, dim3(grid), dim3(512), LDS_BYTES, stream, a); }
#endif
}
```

```cpp
#include <hip/hip_runtime.h>
#include <cstdio>
#include <cstdint>

#ifndef PROBE_PHASE
#define PROBE_PHASE -1
#endif
#define NREP(k) ((PROBE_PHASE) == (k) ? 2 : 1)
#ifndef MK_ONE_LAUNCH
#define MK_ONE_LAUNCH 1
#endif

#define LAS __attribute__((address_space(3)))
#define GAS __attribute__((address_space(1)))
typedef unsigned short bf16;
typedef short bf16x8 __attribute__((ext_vector_type(8)));
typedef short s16x4 __attribute__((ext_vector_type(4)));
typedef float f32x4 __attribute__((ext_vector_type(4)));
typedef float f32x2 __attribute__((ext_vector_type(2)));
typedef float f32x16 __attribute__((ext_vector_type(16)));
typedef unsigned u32x4 __attribute__((ext_vector_type(4)));
typedef unsigned u32x2 __attribute__((ext_vector_type(2)));

constexpr int NB = 16, SEQ = 2048, DM = 1024, NTOK = NB * SEQ, NLAYER = 2;
constexpr int INW = 1960, INP = 2048;
constexpr int NEXP = 32, DEXP = 512;
constexpr int MAXSLOT = 73728;
constexpr float EPS = 1e-6f;
constexpr float WSCALE = 64.f, WSCALE_INV = 1.f / 64.f;
constexpr float LOG2E = 1.4426950408889634f;
constexpr float C2F = 0.125f * LOG2E;
constexpr float C2M = 0.10206207261596575f * LOG2E;

constexpr size_t MiB = 1u << 20, KiB = 1u << 10;
constexpr size_t WS_CTL = 0, CTL_ZERO_BYTES = 64 * KiB;
constexpr size_t WS_COS = 1 * MiB, WS_SIN = 3 * MiB;
constexpr size_t WS_SSQ = 5 * MiB;
constexpr size_t WS_FLOG = 6 * MiB;
constexpr size_t WS_E01 = 8 * MiB;
constexpr size_t WS_G01 = 8 * MiB + 256 * KiB;
constexpr size_t WS_SLOT = 8 * MiB + 512 * KiB;
constexpr size_t WS_TOKOF = 8 * MiB + 768 * KiB;
constexpr size_t WS_GATEOF = 9 * MiB + 256 * KiB;
constexpr size_t WS_CNT = 9 * MiB + 768 * KiB;
constexpr size_t WS_TSTART = 9 * MiB + 800 * KiB;
constexpr size_t WS_RSTD = 9 * MiB + 832 * KiB;
constexpr size_t WS_RSTDOF = 7 * MiB;
constexpr size_t WS_KPE = 10 * MiB;
constexpr size_t WS_KAUG = 10 * MiB + 2 * MiB;
constexpr size_t WS_WIN = 16 * MiB;
constexpr size_t WS_WUQ = 20 * MiB;
constexpr size_t WS_WUKV = 20 * MiB + 512 * KiB;
constexpr size_t WS_WOUT = 21 * MiB;
constexpr size_t WS_WGU = 24 * MiB;
constexpr size_t WS_WD = 88 * MiB;
constexpr size_t WS_XN = 120 * MiB;
constexpr size_t WS_FQKV = 184 * MiB;
constexpr size_t WS_LAT = 280 * MiB;
constexpr size_t WS_QM = 312 * MiB;
constexpr size_t WS_KVM = 360 * MiB;
constexpr size_t WS_Y = 280 * MiB;
constexpr size_t WS_BIASF = 424 * MiB;
constexpr size_t WS_NRM = 425 * MiB;
constexpr size_t WS_WR = 426 * MiB;
constexpr size_t WS_XR = 427 * MiB;
constexpr size_t WS_OSS = 491 * MiB;
constexpr size_t WS_RSTDX = 493 * MiB;
constexpr size_t WS_END = 494 * MiB;
static_assert(WS_Y + (size_t)MAXSLOT * 1024 * 2 <= WS_END, "Y fits");
static_assert(WS_FQKV + (size_t)MAXSLOT * 512 * 2 <= WS_LAT, "HH fits");

constexpr int CW_BAR = 1024;

constexpr int RING_BYTES = 147456;
constexpr int MISC_OFF = RING_BYTES;
constexpr int LDS_BYTES = RING_BYTES + 1024;

typedef __bf16 bf16x2_t __attribute__((ext_vector_type(2)));
__device__ __forceinline__ unsigned cvt_pk_bf16(float lo, float hi) { const f32x2 v = {lo, hi}; const bf16x2_t b = __builtin_convertvector(v, bf16x2_t); return __builtin_bit_cast(unsigned, b); }
__device__ __forceinline__ float bf2f(unsigned short b) { return __uint_as_float((unsigned)b << 16); }
__device__ __forceinline__ float wave_sum(float v) {
#pragma unroll
    for (int o = 1; o < 64; o <<= 1) v += __shfl_xor(v, o);
    return v;
}
__device__ __forceinline__ unsigned pk4_fp8(float a, float b, float c, float d) { int w = 0; w = __builtin_amdgcn_cvt_pk_fp8_f32(a, b, w, false); w = __builtin_amdgcn_cvt_pk_fp8_f32(c, d, w, true); return (unsigned)w; }
#define LDS_WAIT() asm volatile("s_waitcnt lgkmcnt(0)" ::: "memory")

#define XB_TMO      128
#define XB_XCNT(j)  (256  + 64 * (j))
#define XB_XSUB(j)  (1280 + 64 * (j))
#define XB_XGEN(j)  (2304 + 64 * (j))
#define XB_TOP      3328
#define XB_TOPGEN   3392
#define XCD_BAR_WORDS 3456
#define XB_SPIN_CAP (1u << 18)
__device__ __forceinline__ unsigned xb_ld(unsigned* p)              { return __hip_atomic_load(p, __ATOMIC_RELAXED, __HIP_MEMORY_SCOPE_AGENT); }
__device__ __forceinline__ unsigned xb_add(unsigned* p, unsigned v) { return __hip_atomic_fetch_add(p, v, __ATOMIC_RELAXED, __HIP_MEMORY_SCOPE_AGENT); }
__device__ __forceinline__ unsigned xb_xcc_id() { return (unsigned)__builtin_amdgcn_s_getreg((3 << 11) | 20) & 0xFu; }
#define XB_SPIN(cond, bar) do { unsigned _sp = 0; while (cond) { __builtin_amdgcn_s_sleep(1); \
    if ((++_sp & 255u) == 0u) { if (xb_ld(&(bar)[XB_TMO])) break; if (_sp > XB_SPIN_CAP) { atomicAdd(&(bar)[XB_TMO], 1u); break; } } } } while (0)
struct XcdBarrier { unsigned* bar; unsigned x; volatile LAS unsigned* st; };
__device__ __forceinline__ XcdBarrier xcd_barrier_post(unsigned* bar, volatile LAS unsigned* st) {
    XcdBarrier b; b.bar = bar; b.x = xb_xcc_id(); b.st = st;
    if (threadIdx.x == 0) (void)xb_add(&bar[XB_XCNT(b.x)], 1u);
    return b;
}
__device__ __forceinline__ void xcd_barrier_complete(unsigned* bar, unsigned x, unsigned& nloc, unsigned& nx) {
    const unsigned G = gridDim.x * gridDim.y * gridDim.z;
    unsigned sum, cnt, mine, sp = 0u;
    for (;;) {
        sum = 0u; cnt = 0u; mine = 0u;
#pragma unroll
        for (unsigned j = 0; j < 16; ++j) { const unsigned c = xb_ld(&bar[XB_XCNT(j)]); sum += c; cnt += (c > 0u) ? 1u : 0u; mine = (j == x) ? c : mine; }
        if (sum == G) break;
        __builtin_amdgcn_s_sleep(1);
        if ((++sp & 255u) == 0u) { if (xb_ld(&bar[XB_TMO])) break; if (sp > XB_SPIN_CAP) { atomicAdd(&bar[XB_TMO], 1u); break; } }
    }
    nloc = mine > 0u ? mine : 1u; nx = cnt > 0u ? cnt : 1u;
}
__device__ __forceinline__ void xcd_barrier(const XcdBarrier& b) {
    asm volatile("s_waitcnt vmcnt(0)" ::: "memory");
    __syncthreads();
    if (threadIdx.x == 0) {
        unsigned* bar = b.bar;
        __builtin_amdgcn_s_waitcnt(0);
        unsigned nloc = b.st[0], nx = b.st[1];
        if (nloc == 0u) { xcd_barrier_complete(bar, b.x, nloc, nx); b.st[0] = nloc; b.st[1] = nx; }
        const unsigned old = xb_add(&bar[XB_XSUB(b.x)], 1u);
        const unsigned gen = old / nloc;
        if (old + 1u == (gen + 1u) * nloc) {
            __builtin_amdgcn_fence(__ATOMIC_RELEASE, "agent");
            asm volatile("s_waitcnt vmcnt(0)" ::: "memory");
            const unsigned og = xb_add(&bar[XB_TOP], 1u);
            const unsigned tg = og / nx;
            if (og + 1u == (tg + 1u) * nx) xb_add(&bar[XB_TOPGEN], 1u);
            else XB_SPIN(xb_ld(&bar[XB_TOPGEN]) == tg, bar);
            __builtin_amdgcn_fence(__ATOMIC_ACQUIRE, "agent");
            xb_add(&bar[XB_XGEN(b.x)], 1u);
            asm volatile("s_waitcnt vmcnt(0)" ::: "memory");
        } else {
            XB_SPIN(xb_ld(&bar[XB_XGEN(b.x)]) == gen, bar);
            __builtin_amdgcn_fence(__ATOMIC_ACQUIRE, "agent");
            asm volatile("s_waitcnt vmcnt(0)" ::: "memory");
        }
    }
    __syncthreads();
}

namespace pg8 {
constexpr int BM = 256, BK = 64, HALF = 128, HTB = HALF * BK * 2, STAGE_BYTES = 8 * HTB;
typedef int v4i32_t __attribute__((ext_vector_type(4)));
typedef int v8i32_t __attribute__((ext_vector_type(8)));
__host__ __device__ __forceinline__ int lds_byte(int r, int c) { const int st = (r >> 4) * 2 + (c >> 5), rr = r & 15, cc = c & 31, ob = rr * 64 + cc * 2; return st * 1024 + (ob ^ (((ob >> 9) & 1) << 5)); }
__host__ __device__ __forceinline__ void stage_rc(int b, int& R, int& C) { const int st = b / 1024, sb = b % 1024, swz = sb ^ (((sb >> 9) & 1) << 5); R = (st >> 1) * 16 + swz / 64; C = (st & 1) * 32 + (swz % 64) / 2; }
__host__ __device__ __forceinline__ int perm32(int rho) { const int n = rho >> 4, i = rho & 15; return 8 * (i >> 2) + 4 * n + (i & 3); }

struct Unit { const GAS char* a; const GAS char* b; int pm, pn, e; };

template <int N> __device__ __forceinline__ void wait_vm() { asm volatile("s_waitcnt vmcnt(%0)" :: "n"(N) : "memory"); }
template <class Epi, class Sched, bool ALIGN_EPI, bool GATHER, bool FP8 = false, bool MIDSCALE = false, bool VARK = false>
__device__ __forceinline__ void gemm_phase(const int tid, LAS unsigned char* lds, const int Kb, const int ldaB, const int ldbB, const Sched& S, const Epi& E, const GAS int* __restrict__ tokof, const LAS f32x2* scl = nullptr) {
    const int wid = __builtin_amdgcn_readfirstlane(tid >> 6), lane = tid & 63, wr = wid >> 2, wc = wid & 3, fr = lane & 15, fq = lane >> 4;
    const int nt = Kb / 128;
    unsigned voffA[2], voffB[2]; int RA[2], CA2[2];
#pragma unroll
    for (int i = 0; i < 2; ++i) { int R, C; stage_rc(tid * 16 + i * 8192, R, C); const int Rb = Epi::PERM ? ((R & ~31) + perm32(R & 31)) : R;
        voffA[i] = (unsigned)(R * ldaB + C * 2); voffB[i] = (unsigned)(Rb * ldbB + C * 2); RA[i] = R; CA2[i] = C * 2; }
    const size_t kstep = (size_t)(BK * 2);
    const size_t hstepA = GATHER ? 0 : (size_t)HALF * ldaB;
    const size_t hstepB = (size_t)HALF * ldbB;
    const unsigned ldsw = (unsigned)wid * 1024u;
    const int aoff = lds_byte(wr * 64 + fr, fq * 8), boff = lds_byte(wc * 32 + fr, fq * 8);
    unsigned gcur[2][2], gnxt[2][2];
    const int scl8 = 0x7F7F7F7F;
#define PG8_SA(b, h) (((b) * 2 + (h)) * HTB)
#define PG8_SB(b, h) ((4 + (b) * 2 + (h)) * HTB)
#define PG8_STAGE(bufoff, gbase, voff) do { const unsigned long long gb_ = (unsigned long long)(gbase); const unsigned lbase_ = (unsigned)__builtin_amdgcn_readfirstlane((int)((unsigned)(uintptr_t)lds + (unsigned)(bufoff) + ldsw)); \
        _Pragma("unroll") for (int _i = 0; _i < 2; ++_i) { unsigned keep_; \
            asm volatile("s_mov_b32 %0, m0\n\ts_mov_b32 m0, %3\n\ts_nop 0\n\tglobal_load_lds_dwordx4 %1, %2\n\ts_mov_b32 m0, %0" : "=&s"(keep_) : "v"((voff)[_i]), "s"(gb_), "s"(lbase_ + (unsigned)(_i * 8192)) : "memory"); } } while (0)
#define PG8_STAGE_A(bufoff, base, h, nx) do { if constexpr (GATHER) { unsigned _v[2]; _v[0] = (nx) ? gnxt[h][0] : gcur[h][0]; _v[1] = (nx) ? gnxt[h][1] : gcur[h][1]; PG8_STAGE(bufoff, base, _v); } \
        else { PG8_STAGE(bufoff, (base) + (h) * hstepA, voffA); } } while (0)
#define PG8_LDA(dst, b, h) do { _Pragma("unroll") for (int m = 0; m < 4; ++m) _Pragma("unroll") for (int k = 0; k < 2; ++k) dst[m][k] = *(const LAS bf16x8*)(lds + PG8_SA(b, h) + aoff + m * 2048 + k * 1024); } while (0)
#define PG8_LDB(dst, b, h) do { _Pragma("unroll") for (int n = 0; n < 2; ++n) _Pragma("unroll") for (int k = 0; k < 2; ++k) dst[n][k] = *(const LAS bf16x8*)(lds + PG8_SB(b, h) + boff + n * 2048 + k * 1024); } while (0)
#define PG8_MMA(ai, bj, At, Bt) do { __builtin_amdgcn_s_setprio(1); if constexpr (FP8) { _Pragma("unroll") for (int m = 0; m < 4; ++m) _Pragma("unroll") for (int n = 0; n < 2; ++n) { \
        const v8i32_t b8_ = __builtin_shufflevector(__builtin_bit_cast(v4i32_t, Bt[n][0]), __builtin_bit_cast(v4i32_t, Bt[n][1]), 0, 1, 2, 3, 4, 5, 6, 7), a8_ = __builtin_shufflevector(__builtin_bit_cast(v4i32_t, At[m][0]), __builtin_bit_cast(v4i32_t, At[m][1]), 0, 1, 2, 3, 4, 5, 6, 7); \
        asm volatile("s_nop 1\n\tv_mfma_scale_f32_16x16x128_f8f6f4 %0, %1, %2, %0, %3, %3 op_sel_hi:[0,0,0]" : "+v"(acc[ai][bj][m][n]) : "v"(b8_), "v"(a8_), "v"(scl8)); } } \
      else { _Pragma("unroll") for (int m = 0; m < 4; ++m) _Pragma("unroll") for (int n = 0; n < 2; ++n) _Pragma("unroll") for (int k = 0; k < 2; ++k) \
        acc[ai][bj][m][n] = __builtin_amdgcn_mfma_f32_16x16x32_bf16(Bt[n][k], At[m][k], acc[ai][bj][m][n], 0, 0, 0); } __builtin_amdgcn_s_setprio(0); } while (0)
#define PG8_WAIT_V(n) asm volatile("s_waitcnt vmcnt(" #n ")" ::: "memory")
#define PG8_WAIT_L(n) asm volatile("s_waitcnt lgkmcnt(" #n ")" ::: "memory")
#define PG8_BAR __builtin_amdgcn_s_barrier()
#define PG8_SCHED __builtin_amdgcn_sched_barrier(0)
#define PG8_GLOAD(dst, u) do { if constexpr (GATHER) { _Pragma("unroll") for (int _h = 0; _h < 2; ++_h) _Pragma("unroll") for (int _i = 0; _i < 2; ++_i) \
        dst[_h][_i] = (unsigned)tokof[(u).pm * BM + _h * HALF + RA[_i]] * (unsigned)ldaB + (unsigned)CA2[_i]; } } while (0)
    Unit cur, nxt; int ui = 0;
    if (!S.next(0, cur)) return;
    PG8_GLOAD(gcur, cur);
    typename Epi::Pre pre = E.prefetch(cur, wr, fr);
    f32x4 acc[2][2][4][2];
#pragma unroll
    for (int a = 0; a < 2; ++a)
#pragma unroll
        for (int b = 0; b < 2; ++b)
#pragma unroll
            for (int m = 0; m < 4; ++m)
#pragma unroll
                for (int n = 0; n < 2; ++n) acc[a][b][m][n] = (f32x4){0.f, 0.f, 0.f, 0.f};
    bf16x8 At[4][2], B0[2][2], B1[2][2];
    const GAS char* cA = cur.a; const GAS char* cB = cur.b;
    PG8_STAGE(PG8_SB(0, 0), cB, voffB); PG8_STAGE(PG8_SB(0, 1), cB + hstepB, voffB); PG8_STAGE_A(PG8_SA(0, 0), cA, 0, false); PG8_STAGE_A(PG8_SA(0, 1), cA, 1, false);
    if (wr == 1) PG8_BAR;
    PG8_WAIT_V(2); PG8_BAR;
    PG8_STAGE(PG8_SB(1, 0), cB + kstep, voffB); PG8_STAGE_A(PG8_SA(1, 0), cA + kstep, 0, false); PG8_STAGE(PG8_SB(1, 1), cB + hstepB + kstep, voffB);
    PG8_WAIT_V(6); PG8_BAR;
    bool fresh = false;
    for (;;) {
        const bool has_next = S.next(ui + 1, nxt);
        if constexpr (GATHER) { if (has_next) { PG8_GLOAD(gnxt, nxt); } else { _Pragma("unroll") for (int _h = 0; _h < 2; ++_h) _Pragma("unroll") for (int _i = 0; _i < 2; ++_i) gnxt[_h][_i] = gcur[_h][_i]; } }
        const GAS char* nA = has_next ? nxt.a : cA; const GAS char* nB = has_next ? nxt.b : cB;
        const int ntu = VARK ? (cur.e ? nt / 2 : nt) : nt;
#pragma nounroll
        for (int t = 0; t < ntu; t += 2) {
            const bool last = (t == ntu - 2);
            const GAS char* a1 = cA + (size_t)(t + 1) * kstep;
            const GAS char* a2 = last ? nA : cA + (size_t)(t + 2) * kstep; const GAS char* b2 = last ? nB : cB + (size_t)(t + 2) * kstep;
            const GAS char* a3 = a2 + kstep; const GAS char* b3 = b2 + kstep;
            const bool fe = fresh; fresh = false;
            if constexpr (MIDSCALE) { if (t == nt / 2) {
#pragma unroll
                for (int ai = 0; ai < 2; ++ai)
#pragma unroll
                    for (int m = 0; m < 4; ++m) { const float r_ = scl[ui * 256 + ai * 128 + wr * 64 + m * 16 + fr][0];
#pragma unroll
                        for (int bj = 0; bj < 2; ++bj)
#pragma unroll
                            for (int n = 0; n < 2; ++n) acc[ai][bj][m][n] *= r_; } } }
            PG8_LDB(B0, 0, 0); PG8_LDB(B1, 0, 1); PG8_SCHED; PG8_LDA(At, 0, 0); PG8_STAGE_A(PG8_SA(1, 1), a1, 1, false);
            if (fe) wait_vm<8 + Epi::NST>(); else PG8_WAIT_V(8); PG8_WAIT_L(0); PG8_BAR; PG8_MMA(0, 0, At, B0); PG8_MMA(0, 1, At, B1); PG8_BAR; PG8_SCHED;
            PG8_LDA(At, 0, 1); PG8_STAGE(PG8_SB(0, 0), b2, voffB); PG8_STAGE(PG8_SB(0, 1), b2 + hstepB, voffB); PG8_STAGE_A(PG8_SA(0, 0), a2, 0, last);
            if (fe) wait_vm<8 + Epi::NST>(); else PG8_WAIT_V(8); PG8_WAIT_L(0); PG8_BAR; PG8_MMA(1, 0, At, B0); PG8_MMA(1, 1, At, B1); PG8_BAR; PG8_SCHED;
            PG8_LDB(B0, 1, 0); PG8_LDB(B1, 1, 1); PG8_SCHED; PG8_LDA(At, 1, 0); PG8_STAGE_A(PG8_SA(0, 1), a2, 1, last);
            PG8_WAIT_V(8); PG8_WAIT_L(0); PG8_BAR; PG8_MMA(0, 0, At, B0); PG8_MMA(0, 1, At, B1); PG8_BAR; PG8_SCHED;
            PG8_LDA(At, 1, 1); PG8_STAGE(PG8_SB(1, 0), b3, voffB); PG8_STAGE(PG8_SB(1, 1), b3 + hstepB, voffB); PG8_STAGE_A(PG8_SA(1, 0), a3, 0, last);
            PG8_WAIT_V(8); PG8_WAIT_L(0); PG8_BAR; PG8_MMA(1, 0, At, B0); PG8_MMA(1, 1, At, B1); PG8_BAR; PG8_SCHED;
        }
        if constexpr (ALIGN_EPI) { if (wr == 0) PG8_BAR; }
        if constexpr (FP8) { asm volatile("s_nop 15\n\ts_nop 15" ::: "memory"); }
        if constexpr (MIDSCALE) E(acc, cur, wr, wc, fr, fq, scl + ui * 256); else E(acc, cur, wr, wc, fr, fq, pre);
        if (!has_next) break;
        pre = E.prefetch(nxt, wr, fr);
#pragma unroll
        for (int a = 0; a < 2; ++a)
#pragma unroll
            for (int b = 0; b < 2; ++b)
#pragma unroll
                for (int m = 0; m < 4; ++m)
#pragma unroll
                    for (int n = 0; n < 2; ++n) acc[a][b][m][n] = (f32x4){0.f, 0.f, 0.f, 0.f};
        cur = nxt; cA = nA; cB = nB; ++ui; fresh = true;
        if constexpr (GATHER) { _Pragma("unroll") for (int _h = 0; _h < 2; ++_h) _Pragma("unroll") for (int _i = 0; _i < 2; ++_i) gcur[_h][_i] = gnxt[_h][_i]; }
        if constexpr (ALIGN_EPI) { if (wr == 1) PG8_BAR; }
    }
    PG8_WAIT_V(0);
    if constexpr (!ALIGN_EPI) { if (wr == 0) PG8_BAR; }
    PG8_BAR;
#undef PG8_SA
#undef PG8_SB
#undef PG8_STAGE
#undef PG8_STAGE_A
#undef PG8_LDA
#undef PG8_LDB
#undef PG8_MMA
#undef PG8_WAIT_V
#undef PG8_WAIT_L
#undef PG8_BAR
#undef PG8_SCHED
#undef PG8_GLOAD
}
}
using pg8::Unit;

struct DenseOrder {
    int nM, nN, nwg, G, c; const GAS char* A; const GAS char* B; size_t aT, bT;
    __device__ __forceinline__ bool next(int i, Unit& u) const {
        const long L = (long)i * G + c; if (L >= nwg) return false;
        int wgid = (int)L; { const int q = nwg / 8, r = nwg % 8, xcd = wgid % 8, off = wgid / 8; wgid = (xcd < r ? xcd * (q + 1) : r * (q + 1) + (xcd - r) * q) + off; }
        const int nig = 8 * nN, gid = wgid / nig, fm = gid * 8, gsz = (nM - fm) < 8 ? (nM - fm) : 8;
        u.pm = fm + ((wgid % nig) % gsz); u.pn = (wgid % nig) / gsz; u.e = 0;
        u.a = A + (size_t)u.pm * aT; u.b = B + (size_t)u.pn * bT; return true;
    }
};
struct UpOrder {
    int G, c; const GAS char* LATp; const GAS char* Wq; const GAS char* Wkv;
    __device__ __forceinline__ bool next(int i, Unit& u) const {
        const int L = i * G + c; if (L >= 128 * 7) return false;
        u.pm = L / 7; const int j = L % 7; const bool kv = j >= 3; u.pn = kv ? j - 3 : j; u.e = kv ? 1 : 0;
        u.a = LATp + (size_t)u.pm * 256 * 512 * 2 + (kv ? 512 : 0);
        u.b = (kv ? Wkv : Wq) + (size_t)u.pn * 256 * 256 * 2; return true;
    }
};
struct MoeOrder {
    int G, c; const volatile LAS int* TS; const GAS char* A; const GAS char* W; size_t aT  , wE  , wT  ;
    __device__ __forceinline__ bool next(int i, Unit& u) const {
        const int L = i * G + c; const int ntile = __builtin_amdgcn_readfirstlane(TS[32]); if (L >= ntile * 4) return false;
        const int rt = L >> 2, ct = L & 3; int e = 0;
        for (int j = 1; j < 32; ++j) e += (TS[j] <= rt) ? 1 : 0;
        e = __builtin_amdgcn_readfirstlane(e);
        u.pm = rt; u.pn = ct; u.e = e; u.a = A + (size_t)rt * aT; u.b = W + (size_t)e * wE + (size_t)ct * wT; return true;
    }
};

__device__ __forceinline__ u32x4 pack8(f32x4 v0, f32x4 v1) { u32x4 w; w.x = cvt_pk_bf16(v0[0], v0[1]); w.y = cvt_pk_bf16(v0[2], v0[3]); w.z = cvt_pk_bf16(v1[0], v1[1]); w.w = cvt_pk_bf16(v1[2], v1[3]); return w; }

struct EpiWin {
    static constexpr int NST = 16;
    static constexpr bool PERM = true;
    GAS bf16* LAT_; GAS bf16* FQKV_; GAS bf16* KPE_; GAS float* FLOG_; GAS float* SSQ_; const GAS float* COS_; const GAS float* SIN_; const GAS float* RSX_;
    struct Pre { float v[8]; };
    __device__ __forceinline__ Pre prefetch(const Unit& u, int wr, int fr) const { Pre p; const GAS float* RSX = RSX_; asm volatile("" : "+s"(RSX));
#pragma unroll
        for (int g = 0; g < 8; ++g) p.v[g] = RSX[u.pm * 256 + (g >> 2) * 128 + wr * 64 + (g & 3) * 16 + fr]; return p; }
    __device__ __forceinline__ void operator()(f32x4 (&acc)[2][2][4][2], const Unit& u, int wr, int wc, int fr, int fq, const Pre& pre) const {
        GAS bf16* LAT = LAT_; GAS bf16* FQKV = FQKV_; GAS bf16* KPE = KPE_; GAS float* FLOG = FLOG_; GAS float* SSQ = SSQ_; const GAS float* COS = COS_; const GAS float* SIN = SIN_; const GAS float* RSX = RSX_;
        asm volatile("" : "+s"(LAT), "+s"(FQKV), "+s"(KPE), "+s"(FLOG), "+s"(SSQ), "+s"(COS), "+s"(SIN), "+s"(RSX));
        {
#pragma unroll
            for (int ai = 0; ai < 2; ++ai)
#pragma unroll
                for (int m = 0; m < 4; ++m) { const float rs_ = pre.v[ai * 4 + m];
#pragma unroll
                    for (int bj = 0; bj < 2; ++bj)
#pragma unroll
                        for (int n = 0; n < 2; ++n) acc[ai][bj][m][n] *= rs_; } }
        const int row0 = u.pm * 256 + wr * 64 + fr; const int pn = u.pn;
        if (pn >= 2) {
            const int ti = pn >> 1; GAS bf16* dst = FQKV + (size_t)(ti - 1) * NTOK * 512; const int colb = (pn & 1) * 256 + wc * 32 + 8 * fq; const float sc = (ti == 1) ? C2F : 1.f;
#pragma unroll
            for (int ai = 0; ai < 2; ++ai)
#pragma unroll
                for (int m = 0; m < 4; ++m) { GAS bf16* rowp = dst + (size_t)(row0 + ai * 128 + m * 16) * 512 + colb;
#pragma unroll
                    for (int bj = 0; bj < 2; ++bj) *(GAS u32x4*)(rowp + bj * 128) = pack8(acc[ai][bj][m][0] * sc, acc[ai][bj][m][1] * sc); }
        } else {
#pragma unroll
            for (int ai = 0; ai < 2; ++ai)
#pragma unroll
                for (int m = 0; m < 4; ++m) { const int row = row0 + ai * 128 + m * 16; GAS bf16* rowp = LAT + (size_t)row * 512 + pn * 256 + wc * 32 + 8 * fq;
#pragma unroll
                    for (int bj = 0; bj < 2; ++bj) *(GAS u32x4*)(rowp + bj * 128) = pack8(acc[ai][bj][m][0], acc[ai][bj][m][1]);
                    float s = 0.f;
#pragma unroll
                    for (int n = 0; n < 2; ++n) { const f32x4 x = acc[ai][0][m][n]; s += (x[0] * x[0] + x[1] * x[1]) + (x[2] * x[2] + x[3] * x[3]); }
                    if (pn == 0) {
#pragma unroll
                        for (int n = 0; n < 2; ++n) { const f32x4 x = acc[ai][1][m][n]; s += (x[0] * x[0] + x[1] * x[1]) + (x[2] * x[2] + x[3] * x[3]); }
                    }
                    s += __shfl_xor(s, 16); s += __shfl_xor(s, 32);
                    if (fq == 0) SSQ[(size_t)row * 8 + pn * 4 + wc] = s;
                    }
            if (pn == 1 && wc == 0) {
#pragma unroll
                for (int ai = 0; ai < 2; ++ai)
#pragma unroll
                    for (int m = 0; m < 4; ++m) { const int row = row0 + ai * 128 + m * 16;
                        const f32x4 c = *(const GAS f32x4*)(COS + (size_t)row * 16 + 4 * fq), sn = *(const GAS f32x4*)(SIN + (size_t)row * 16 + 4 * fq);
                        const f32x4 x1 = acc[ai][1][m][0], x2 = acc[ai][1][m][1];
                        *(GAS u32x4*)(KPE + (size_t)row * 32 + 8 * fq) = pack8(x1 * c - x2 * sn, x1 * sn + x2 * c);
                        }
            }
            if (pn == 1 && wc == 1 && fq == 0) {
#pragma unroll
                for (int ai = 0; ai < 2; ++ai)
#pragma unroll
                    for (int m = 0; m < 4; ++m) { const int row = row0 + ai * 128 + m * 16; *(GAS f32x4*)(FLOG + (size_t)row * 8) = acc[ai][1][m][0]; *(GAS f32x4*)(FLOG + (size_t)row * 8 + 4) = acc[ai][1][m][1]; }
            }
        }
    }
};
struct EpiUp {
    static constexpr int NST = 16;
    static constexpr bool PERM = true;
    GAS bf16* QM_; GAS bf16* KVM_; const GAS float* SSQ_; const GAS float* COS_; const GAS float* SIN_;
    struct Pre { f32x4 v[8]; };
    __device__ __forceinline__ Pre prefetch(const Unit& u, int wr, int fr) const { Pre p; const GAS float* SSQ = SSQ_; asm volatile("" : "+s"(SSQ)); const int off = u.e ? 4 : 0;
#pragma unroll
        for (int g = 0; g < 8; ++g) p.v[g] = *(const GAS f32x4*)(SSQ + (size_t)(u.pm * 256 + (g >> 2) * 128 + wr * 64 + (g & 3) * 16 + fr) * 8 + off); return p; }
    __device__ __forceinline__ void operator()(const f32x4 (&acc)[2][2][4][2], const Unit& u, int wr, int wc, int fr, int fq, const Pre& pre) const {
        GAS bf16* QM = QM_; GAS bf16* KVM = KVM_; const GAS float* SSQ = SSQ_; const GAS float* COS = COS_; const GAS float* SIN = SIN_;
        asm volatile("" : "+s"(QM), "+s"(KVM), "+s"(SSQ), "+s"(COS), "+s"(SIN));
        const int row0 = u.pm * 256 + wr * 64 + fr; const int pn = u.pn; const bool kv = u.e != 0;
#pragma unroll
        for (int ai = 0; ai < 2; ++ai)
#pragma unroll
            for (int m = 0; m < 4; ++m) { const int row = row0 + ai * 128 + m * 16;
                const f32x4 sq = pre.v[ai * 4 + m];
                const float ss = (sq[0] + sq[1]) + (sq[2] + sq[3]);
                if (kv) {
                    const float rs = rsqrtf(ss * (1.f / 128.f) + EPS);
                    GAS bf16* rowp = KVM + (size_t)row * 1024 + pn * 256 + wc * 32 + 8 * fq;
#pragma unroll
                    for (int bj = 0; bj < 2; ++bj) *(GAS u32x4*)(rowp + bj * 128) = pack8(acc[ai][bj][m][0] * rs, acc[ai][bj][m][1] * rs);
                } else {
                    const float rs = rsqrtf(ss * (1.f / 256.f) + EPS) * C2M;
                    GAS bf16* rowp = QM + (size_t)row * 768 + pn * 256 + wc * 32 + 8 * fq;
                    const f32x4 c = *(const GAS f32x4*)(COS + (size_t)row * 16 + 4 * fq), sn = *(const GAS f32x4*)(SIN + (size_t)row * 16 + 4 * fq);
#pragma unroll
                    for (int bj = 0; bj < 2; ++bj) { f32x4 v0 = acc[ai][bj][m][0] * rs, v1 = acc[ai][bj][m][1] * rs;
                        const int G = 8 * pn + 4 * bj + wc;
                        if (G % 3 == 2) { const f32x4 x1 = v0, x2 = v1; v0 = x1 * c - x2 * sn; v1 = x1 * sn + x2 * c; }
                        *(GAS u32x4*)(rowp + bj * 128) = pack8(v0, v1); }
                }

            }
    }
};
template <bool RES_F32> struct EpiOut {
    static constexpr int NST = 16;
    static constexpr bool PERM = true;
    const GAS float* resf_; GAS bf16* xr_;
    struct Pre {}; __device__ __forceinline__ Pre prefetch(const Unit&, int, int) const { return Pre{}; }
    __device__ __forceinline__ void operator()(const f32x4 (&acc)[2][2][4][2], const Unit& u, int wr, int wc, int fr, int fq, const LAS f32x2* scl) const {
        const GAS float* resf = resf_; GAS bf16* xr = xr_; asm volatile("" : "+s"(resf), "+s"(xr));
        const int row0 = u.pm * 256 + wr * 64 + fr, col0 = u.pn * 256 + wc * 32 + 8 * fq;
#pragma unroll
        for (int ai = 0; ai < 2; ++ai)
#pragma unroll
            for (int m = 0; m < 4; ++m) { const size_t off = (size_t)(row0 + ai * 128 + m * 16) * DM + col0; const float sh = scl[ai * 128 + wr * 64 + m * 16 + fr][1];
#pragma unroll
                for (int bj = 0; bj < 2; ++bj) { f32x4 r0, r1;
                    if constexpr (RES_F32) { r0 = *(const GAS f32x4*)(resf + off + bj * 128); r1 = *(const GAS f32x4*)(resf + off + bj * 128 + 4); }
                    else { const u32x4 w = *(const GAS u32x4*)(xr + off + bj * 128);
                        r0 = (f32x4){__uint_as_float(w.x << 16), __uint_as_float(w.x & 0xffff0000u), __uint_as_float(w.y << 16), __uint_as_float(w.y & 0xffff0000u)};
                        r1 = (f32x4){__uint_as_float(w.z << 16), __uint_as_float(w.z & 0xffff0000u), __uint_as_float(w.w << 16), __uint_as_float(w.w & 0xffff0000u)}; }
                    *(GAS u32x4*)(xr + off + bj * 128) = pack8(r0 + acc[ai][bj][m][0] * sh, r1 + acc[ai][bj][m][1] * sh); } }
    }
};
struct EpiGU {
    static constexpr int NST = 8;
    static constexpr bool PERM = true;
    GAS unsigned char* HH_; const GAS float* RS_;
    struct Pre { float v[8]; };
    __device__ __forceinline__ Pre prefetch(const Unit& u, int wr, int fr) const { Pre p; const GAS float* RS = RS_; asm volatile("" : "+s"(RS));
#pragma unroll
        for (int g = 0; g < 8; ++g) p.v[g] = RS[u.pm * 256 + (g >> 2) * 128 + wr * 64 + (g & 3) * 16 + fr]; return p; }
    __device__ __forceinline__ void operator()(const f32x4 (&acc)[2][2][4][2], const Unit& u, int wr, int wc, int fr, int fq, const Pre& pre) const {
        GAS unsigned char* HH = HH_; const GAS float* RS = RS_; asm volatile("" : "+s"(HH), "+s"(RS));
        const int row0 = u.pm * 256 + wr * 64 + fr;
#pragma unroll
        for (int ai = 0; ai < 2; ++ai)
#pragma unroll
            for (int m = 0; m < 4; ++m) { GAS unsigned char* rowp = HH + (size_t)(row0 + ai * 128 + m * 16) * 512 + u.pn * 128 + wc * 32 + 8 * fq; const float rs = pre.v[ai * 4 + m] * WSCALE_INV;
                f32x4 h[2];
#pragma unroll
                for (int n = 0; n < 2; ++n) { const f32x4 g = acc[ai][0][m][n] * rs, up = acc[ai][1][m][n] * rs;
#pragma unroll
                    for (int j = 0; j < 4; ++j) { const float sg = __builtin_amdgcn_rcpf(1.f + __builtin_amdgcn_exp2f(-g[j] * LOG2E)); h[n][j] = g[j] * sg * up[j]; } }
                u32x2 w; w.x = pk4_fp8(h[0][0], h[0][1], h[0][2], h[0][3]); w.y = pk4_fp8(h[1][0], h[1][1], h[1][2], h[1][3]); *(GAS u32x2*)rowp = w; }
    }
};
struct EpiDown {
    static constexpr int NST = 16;
    static constexpr bool PERM = true;
    GAS unsigned char* Y_; const GAS float* GATEOF_;
    struct Pre { float v[8]; };
    __device__ __forceinline__ Pre prefetch(const Unit& u, int wr, int fr) const { Pre p; const GAS float* GT = GATEOF_; asm volatile("" : "+s"(GT));
#pragma unroll
        for (int g = 0; g < 8; ++g) p.v[g] = GT[u.pm * 256 + (g >> 2) * 128 + wr * 64 + (g & 3) * 16 + fr]; return p; }
    __device__ __forceinline__ void operator()(const f32x4 (&acc)[2][2][4][2], const Unit& u, int wr, int wc, int fr, int fq, const Pre& pre) const {
        GAS unsigned char* Y = Y_; const GAS float* GATEOF = GATEOF_; asm volatile("" : "+s"(Y), "+s"(GATEOF));
        const int row0 = u.pm * 256 + wr * 64 + fr;
#pragma unroll
        for (int ai = 0; ai < 2; ++ai)
#pragma unroll
            for (int m = 0; m < 4; ++m) { const int row = row0 + ai * 128 + m * 16; const float g = pre.v[ai * 4 + m]; GAS unsigned char* rowp = Y + (size_t)row * 1024 + u.pn * 256 + wc * 32 + 8 * fq;
#pragma unroll
                for (int bj = 0; bj < 2; ++bj) { const f32x4 v0 = acc[ai][bj][m][0] * g, v1 = acc[ai][bj][m][1] * g; u32x2 w; w.x = pk4_fp8(v0[0], v0[1], v0[2], v0[3]); w.y = pk4_fp8(v1[0], v1[1], v1[2], v1[3]); *(GAS u32x2*)(rowp + bj * 128) = w; } }
    }
};

namespace att {
constexpr int KSLOT = 12288, VSLOT = 8192;
constexpr int L_K = 0, L_V = 2 * KSLOT, L_BIAS = L_V + 2 * VSLOT, L_WS = L_BIAS + 8192, L_OST = L_WS + 8 * 64 * 4, L_END = L_OST + 8 * 4096;
__device__ __forceinline__ int crow(int r, int hi) { return (r & 3) + 8 * (r >> 2) + 4 * hi; }
typedef short v4i16_t __attribute__((ext_vector_type(4)));
__device__ __forceinline__ s16x4 vtr(const LAS char* p) { return __builtin_bit_cast(s16x4, __builtin_amdgcn_ds_read_tr16_b64_v4i16((LAS v4i16_t*)p)); }

constexpr int NSL = 5;
constexpr int R_K = 0, R_V = NSL * KSLOT, R_WS = R_V + NSL * VSLOT, R_OST = R_WS + 8 * 64 * 4, R_END = R_OST + 8 * 4096;
static_assert(R_END <= RING_BYTES, "attention LDS");
__device__ __forceinline__ void glds16(const GAS void* gsrc, unsigned lds_dst) { unsigned keep;
    asm volatile("s_mov_b32 %0, m0\n\ts_mov_b32 m0, %2\n\ts_nop 0\n\tglobal_load_lds_dwordx4 %1, off\n\ts_mov_b32 m0, %0" : "=&s"(keep) : "v"(gsrc), "s"(lds_dst) : "memory"); }
__device__ __forceinline__ void glds16s(const GAS void* sbase, unsigned voff, unsigned lds_dst) { unsigned keep;
    asm volatile("s_mov_b32 %0, m0\n\ts_mov_b32 m0, %3\n\ts_nop 0\n\tglobal_load_lds_dwordx4 %1, %2\n\ts_mov_b32 m0, %0" : "=&s"(keep) : "v"(voff), "s"((unsigned long long)sbase), "s"(lds_dst) : "memory"); }
struct Tens2 { const GAS bf16* Q; int qp; const GAS bf16* K; int kp; const GAS bf16* KX; const GAS bf16* V; int vp; GAS bf16* O; const GAS float* BIASF; const GAS float* NRM; GAS float* OSS; };
template <int MODE>
__device__ __forceinline__ int attn_unit2(const int wave_, int b, int h, int qb, const Tens2& T, LAS char* shm, const int slbase, const bool have_pro, const int qb_next, bf16x8 (&qr)[6], const int tstart) {
    constexpr int DKS = MODE ? 6 : 5, DKH = 3;
    constexpr float THR = 8.f;
    int wid = wave_; asm volatile("" : "+s"(wid));
    int lane = (int)__builtin_amdgcn_mbcnt_hi(~0u, __builtin_amdgcn_mbcnt_lo(~0u, 0u)); asm volatile("" : "+v"(lane)); const int r32 = lane & 31, hi = lane >> 5;
    const long rowbase = (long)b * SEQ; const int q0 = qb * 256, qw0 = q0 + wid * 32;
    const int NT = (q0 + 256) / 64, tlast = qw0 / 64;
    const int NTE = NT - tstart;
    const GAS bf16* Qw = T.Q + (rowbase + qw0) * T.qp + h * (MODE ? 96 : 64);
    const GAS bf16* Kh = T.K + rowbase * T.kp + h * (MODE ? 128 : 64);
    const GAS bf16* Vh = T.V + rowbase * T.vp + h * (MODE ? 128 : 64);
    LAS float* wsf = (LAS float*)(shm + R_WS) + wid * 64;
    const unsigned koff = (unsigned)(lane * T.kp + wid * 8) * 2u;
    const unsigned xoff = MODE ? (unsigned)(lane * 32 + (wid & 3) * 8) * 2u : (unsigned)(lane * 8) * 2u;
    const unsigned voff = (unsigned)((16 * (wid & 3) + (lane >> 2)) * T.vp + (wid >> 2) * 32 + (lane & 3) * 8) * 2u;
    const GAS bf16* xbase = MODE ? T.KX + rowbase * 32 : T.KX + ((long)b * 8 + h) * SEQ * 8;
    const int xstep = MODE ? 64 * 32 : 64 * 8;
    const unsigned kdst_a = (unsigned)(uintptr_t)(shm + R_K) + (unsigned)wid * 1024u, xdst_a = (unsigned)(uintptr_t)(shm + R_K) + (unsigned)(8 + (MODE ? (wid & 3) : 0)) * 1024u, vdst_a = (unsigned)(uintptr_t)(shm + R_V) + (unsigned)wid * 1024u;
#define A2_DMA(t, slot) do { \
        glds16s((const GAS void*)(Kh + (long)(t) * 64 * T.kp), koff, (unsigned)__builtin_amdgcn_readfirstlane((int)(kdst_a + (slot) * KSLOT))); \
        glds16s((const GAS void*)(xbase + (long)(t) * xstep), xoff, (unsigned)__builtin_amdgcn_readfirstlane((int)(xdst_a + (slot) * KSLOT))); \
        glds16s((const GAS void*)(Vh + (long)(t) * 64 * T.vp), voff, (unsigned)__builtin_amdgcn_readfirstlane((int)(vdst_a + (slot) * VSLOT))); } while (0)
    float mhat = 0.f, lrun = 0.f; f32x16 o[2]; o[0] = f32x16{}; o[1] = f32x16{}; f32x16 negm = f32x16{};
    const LAS char* vp0 = shm + R_V + ((lane >> 4) & 1) * 32 + (lane & 3) * 8 + (4 * hi + ((lane & 15) >> 2)) * 64;
#define A3_SLOT(k) ((slbase + (k)) % NSL)
    if (!have_pro) { A2_DMA(NT - 1, A3_SLOT(0)); A2_DMA(NT - 2, A3_SLOT(1)); A2_DMA(NT - 3, A3_SLOT(2)); }
    if (!have_pro) {
#pragma unroll
        for (int d0 = 0; d0 < (MODE ? 6 : 4); ++d0) qr[d0] = *(const GAS bf16x8*)(Qw + (long)r32 * T.qp + d0 * 16 + hi * 8); }
    if (MODE == 0) { const short one = hi ? (short)0 : (short)0x3F80; qr[DKS - 1] = (bf16x8){one, one, one, 0, 0, 0, 0, 0}; }
#pragma unroll
    for (int d0 = 0; d0 < DKS; ++d0) asm volatile("" : "+v"(qr[d0]));
#define A3_KLOADH(slot, H) do { const LAS char* kb_ = shm + R_K + (slot) * KSLOT + r32 * 16; _Pragma("unroll") for (int d0 = (H) * DKH; d0 < ((H) ? DKS : DKH); ++d0) { const int off = (MODE == 0 && d0 == 4) ? 8 * 1024 : d0 * 2048 + hi * 1024; \
        kf[2 * (d0 - (H) * DKH)] = *(const LAS bf16x8*)(kb_ + off); kf[2 * (d0 - (H) * DKH) + 1] = *(const LAS bf16x8*)(kb_ + off + 512); } } while (0)
#define A3_VLOAD(slot) do { const LAS char* vp_ = vp0 + (slot) * VSLOT; _Pragma("unroll") for (int q = 0; q < 8; ++q) { vlo[q] = vtr(vp_ + (q >> 2) * 4096 + (q & 3) * 1024); vhh[q] = vtr(vp_ + (q >> 2) * 4096 + (q & 3) * 1024 + 512); } } while (0)
#define A3_QKH(H) do { if ((H) == 0) { c0 = negm; c1 = negm; } _Pragma("unroll") for (int d0 = (H) * DKH; d0 < ((H) ? DKS : DKH); ++d0) { c0 = __builtin_amdgcn_mfma_f32_32x32x16_bf16(kf[2 * (d0 - (H) * DKH)], qr[d0], c0, 0, 0, 0); c1 = __builtin_amdgcn_mfma_f32_32x32x16_bf16(kf[2 * (d0 - (H) * DKH) + 1], qr[d0], c1, 0, 0, 0); } } while (0)
#define A3_EXP() do { float ls_ = 0.f; _Pragma("unroll") for (int r = 0; r < 16; ++r) { pp0[r] = __builtin_amdgcn_exp2f(pp0[r]); pp1[r] = __builtin_amdgcn_exp2f(pp1[r]); ls_ += pp0[r] + pp1[r]; } lrun += ls_; u32x4 w_; \
        w_.x = cvt_pk_bf16(pp0[0], pp0[1]); w_.y = cvt_pk_bf16(pp0[2], pp0[3]); w_.z = cvt_pk_bf16(pp0[4], pp0[5]); w_.w = cvt_pk_bf16(pp0[6], pp0[7]); pa[0] = __builtin_bit_cast(bf16x8, w_); \
        w_.x = cvt_pk_bf16(pp0[8], pp0[9]); w_.y = cvt_pk_bf16(pp0[10], pp0[11]); w_.z = cvt_pk_bf16(pp0[12], pp0[13]); w_.w = cvt_pk_bf16(pp0[14], pp0[15]); pa[1] = __builtin_bit_cast(bf16x8, w_); \
        w_.x = cvt_pk_bf16(pp1[0], pp1[1]); w_.y = cvt_pk_bf16(pp1[2], pp1[3]); w_.z = cvt_pk_bf16(pp1[4], pp1[5]); w_.w = cvt_pk_bf16(pp1[6], pp1[7]); pa[2] = __builtin_bit_cast(bf16x8, w_); \
        w_.x = cvt_pk_bf16(pp1[8], pp1[9]); w_.y = cvt_pk_bf16(pp1[10], pp1[11]); w_.z = cvt_pk_bf16(pp1[12], pp1[13]); w_.w = cvt_pk_bf16(pp1[14], pp1[15]); pa[3] = __builtin_bit_cast(bf16x8, w_); } while (0)
#define A3_PV() do { _Pragma("unroll") for (int d0 = 0; d0 < 2; ++d0) _Pragma("unroll") for (int k = 0; k < 4; ++k) { const s16x4 lo_ = vlo[4 * d0 + k], hh_ = vhh[4 * d0 + k]; \
        const bf16x8 vf_ = (bf16x8){lo_[0], lo_[1], lo_[2], lo_[3], hh_[0], hh_[1], hh_[2], hh_[3]}; o[d0] = __builtin_amdgcn_mfma_f32_32x32x16_bf16(pa[k], vf_, o[d0], 0, 0, 0); } } while (0)
#define A3_ROWMAX(rm) do { float a_ = fmaxf(fmaxf(c0[0], c0[1]), c1[0]), b_ = fmaxf(fmaxf(c0[2], c0[3]), c1[1]); a_ = fmaxf(fmaxf(a_, c1[2]), c1[3]); \
        _Pragma("unroll") for (int r = 4; r < 16; r += 4) { a_ = fmaxf(fmaxf(a_, c0[r]), c0[r + 1]); b_ = fmaxf(fmaxf(b_, c0[r + 2]), c0[r + 3]); a_ = fmaxf(fmaxf(a_, c1[r]), c1[r + 1]); b_ = fmaxf(fmaxf(b_, c1[r + 2]), c1[r + 3]); } \
        rm = fmaxf(a_, b_); const auto rr_ = __builtin_amdgcn_permlane32_swap(__float_as_uint(rm), __float_as_uint(rm), false, false); rm = fmaxf(__uint_as_float(rr_[0]), __uint_as_float(rr_[1])); } while (0)
    int sl = A3_SLOT(0), sl3 = A3_SLOT(3);
    f32x16 pp0 = f32x16{}, pp1 = f32x16{}; bool pend = false; int pslot = 0;
    for (int i = 0; i < NTE; ++i) {
        const int t = NT - 1 - i;
        { const int ahead = NTE - 1 - i;
          if (ahead >= 2) asm volatile("s_waitcnt vmcnt(6)" ::: "memory"); else if (ahead == 1) asm volatile("s_waitcnt vmcnt(3)" ::: "memory"); else asm volatile("s_waitcnt vmcnt(0)" ::: "memory"); }
        __builtin_amdgcn_s_barrier(); asm volatile("" ::: "memory");
        if (i + 3 < NTE) A2_DMA(t - 3, sl3);
        if (i == NTE - 1 && qb_next >= 0) { const int NTn = 4 * qb_next + 4; A2_DMA(NTn - 1, A3_SLOT(NTE)); A2_DMA(NTn - 2, A3_SLOT(NTE + 1)); A2_DMA(NTn - 3, A3_SLOT(NTE + 2)); }
        if (t <= tlast) {
            bf16x8 kf[2 * DKH]; f32x16 c0, c1; float rm;
            A3_KLOADH(sl, 0);
            if (!pend) {
                A3_QKH(0); A3_KLOADH(sl, 1); A3_QKH(1);
                if (MODE == 0) { const int qrel = qw0 + r32 - 64 * t;
#pragma unroll
                    for (int r = 0; r < 16; ++r) { const int kv = crow(r, hi); if (kv > qrel) c0[r] = -INFINITY; if (kv + 32 > qrel) c1[r] = -INFINITY; } }
                A3_ROWMAX(rm);
                mhat = rm;
#pragma unroll
                for (int r = 0; r < 16; ++r) { c0[r] -= rm; c1[r] -= rm; negm[r] = -mhat; }
                pend = true;
            } else {
                s16x4 vlo[8], vhh[8]; bf16x8 pa[4];
                A3_QKH(0); A3_KLOADH(sl, 1);
                A3_VLOAD(pslot);
                A3_QKH(1);
                A3_EXP();
#pragma unroll
                for (int g_ = 0; g_ < 2 * DKS; ++g_) { __builtin_amdgcn_sched_group_barrier(0x008, 1, 0); __builtin_amdgcn_sched_group_barrier(0x002, 7, 0); }
                A3_PV();
                A3_ROWMAX(rm);
#pragma unroll
                for (int g_ = 0; g_ < 8; ++g_) { __builtin_amdgcn_sched_group_barrier(0x008, 1, 0); __builtin_amdgcn_sched_group_barrier(0x002, 3, 0); }
                if (__any(rm > THR)) {
                    const float dl = fmaxf(rm, 0.f); mhat += dl;
#pragma unroll
                    for (int r = 0; r < 16; ++r) { c0[r] -= dl; c1[r] -= dl; negm[r] = -mhat; }
                    const float f = __builtin_amdgcn_exp2f(-dl); lrun *= f;
                    if (hi == 0) wsf[r32] = f;
                    LDS_WAIT();
#pragma unroll
                    for (int g = 0; g < 4; ++g) { const f32x4 ff = *(const LAS f32x4*)(wsf + 8 * g + 4 * hi);
#pragma unroll
                        for (int j = 0; j < 4; ++j) { o[0][4 * g + j] *= ff[j]; o[1][4 * g + j] *= ff[j]; } }
                }
            }
            pp0 = c0; pp1 = c1; pslot = sl;
        }
        sl = (sl == NSL - 1) ? 0 : sl + 1; sl3 = (sl3 == NSL - 1) ? 0 : sl3 + 1;
    }
    if (qb_next >= 0) { const GAS bf16* Qn = T.Q + (rowbase + qb_next * 256 + wid * 32) * T.qp + h * (MODE ? 96 : 64);
#pragma unroll
        for (int d0 = 0; d0 < (MODE ? 6 : 4); ++d0) qr[d0] = *(const GAS bf16x8*)(Qn + (long)r32 * T.qp + d0 * 16 + hi * 8); }
    if (pend) { s16x4 vlo[8], vhh[8]; bf16x8 pa[4]; A3_VLOAD(pslot); A3_EXP(); A3_PV(); }
#undef A3_KLOADH
#undef A3_VLOAD
#undef A3_QKH
#undef A3_EXP
#undef A3_PV
#undef A3_ROWMAX
#undef A2_DMA
    lrun += __shfl_xor(lrun, 32);
    LDS_WAIT();
    if (hi == 0) wsf[32 + r32] = lrun;
    LDS_WAIT();
    float rli[16];
#pragma unroll
    for (int g = 0; g < 4; ++g) { const f32x4 ll = *(const LAS f32x4*)(wsf + 32 + 8 * g + 4 * hi);
#pragma unroll
        for (int j = 0; j < 4; ++j) rli[4 * g + j] = __builtin_amdgcn_rcpf(ll[j]); }
    GAS bf16* Ow = T.O + (rowbase + qw0) * 1024 + (MODE ? 0 : 512) + h * 64;
    { LAS bf16* stg = (LAS bf16*)(shm + R_OST) + wid * 2048;
#pragma unroll
      for (int r = 0; r < 16; ++r) { const int orow = crow(r, hi);
#pragma unroll
          for (int d0 = 0; d0 < 2; ++d0) stg[orow * 64 + d0 * 32 + r32] = (bf16)(cvt_pk_bf16(o[d0][r] * rli[r], 0.f) & 0xffffu); }
      LDS_WAIT();
#pragma unroll
      for (int i = 0; i < 4; ++i) { const int row = i * 8 + (lane >> 3), ch = lane & 7; const u32x4 v = *(const LAS u32x4*)(stg + row * 64 + ch * 8); *(GAS u32x4*)(Ow + (long)row * 1024 + ch * 8) = v;
          float sq = 0.f;
#pragma unroll
          for (int j = 0; j < 4; ++j) { const float a0 = __uint_as_float(v[j] << 16), a1 = __uint_as_float(v[j] & 0xffff0000u); sq += a0 * a0 + a1 * a1; }
          sq += __shfl_xor(sq, 1); sq += __shfl_xor(sq, 2); sq += __shfl_xor(sq, 4);
          if (ch == 0) T.OSS[(rowbase + qw0 + row) * 16 + (MODE ? 0 : 8) + h] = sq; } }
    if (qb_next < 0) { LDS_WAIT(); __builtin_amdgcn_s_barrier(); asm volatile("" ::: "memory"); }
    return A3_SLOT(NTE);
#undef A3_SLOT
}
}

struct Args { const void* in[21]; float* out; unsigned char* ws; int ph_lo, ph_hi; };

__device__ __forceinline__ void tr_item(const GAS float* __restrict__ W, int ldw, int Ksrc, const GAS float* __restrict__ gain, GAS bf16* __restrict__ WT, int ldk, int k0, int n0, int srccol, LAS float* scr, int lane) {
#pragma unroll 8
    for (int i = 0; i < 32; ++i) { const int kk = 2 * i + (lane >> 5); const int k = k0 + kk;
        float v = 0.f; if (srccol >= 0 && k < Ksrc) { v = __builtin_nontemporal_load(W + (size_t)k * ldw + srccol); if (gain) v *= gain[k]; }
        scr[kk * 33 + (lane & 31)] = v; }
    LDS_WAIT(); asm volatile("" ::: "memory");
    const int c = lane & 7;
#pragma unroll
    for (int j = 0; j < 4; ++j) { const int n = (lane >> 3) + 8 * j; const LAS float* s = scr + (8 * c) * 33 + n;
        u32x4 o; o.x = cvt_pk_bf16(s[0 * 33], s[1 * 33]); o.y = cvt_pk_bf16(s[2 * 33], s[3 * 33]); o.z = cvt_pk_bf16(s[4 * 33], s[5 * 33]); o.w = cvt_pk_bf16(s[6 * 33], s[7 * 33]);
        *(GAS u32x4*)(WT + (size_t)(n0 + n) * ldk + k0 + 8 * c) = o; }
    LDS_WAIT(); asm volatile("" ::: "memory");
}
__device__ __forceinline__ void tr_item64(const GAS float* __restrict__ W, int ldw, const GAS float* __restrict__ gain, GAS bf16* __restrict__ WT, int ldk, int k0, int n0src, int n0dst, LAS float* scr, int lane) {
    const int rr = lane >> 4, c4 = (lane & 15) * 4;
    f32x4 v[16];
#pragma unroll
    for (int i = 0; i < 16; ++i) v[i] = __builtin_nontemporal_load((const GAS f32x4*)(W + (size_t)(k0 + 4 * i + rr) * ldw + n0src + c4));
#pragma unroll
    for (int i = 0; i < 16; ++i) { const int k = 4 * i + rr; const float g = gain ? gain[k0 + k] : 1.f; LAS float* d = scr + k * 65 + c4;
        d[0] = v[i][0] * g; d[1] = v[i][1] * g; d[2] = v[i][2] * g; d[3] = v[i][3] * g; }
    LDS_WAIT(); asm volatile("" ::: "memory");
    const int kc = lane & 7;
#pragma unroll
    for (int j = 0; j < 8; ++j) { const int n = (lane >> 3) + 8 * j; const LAS float* sp = scr + (8 * kc) * 65 + n;
        u32x4 o; o.x = cvt_pk_bf16(sp[0 * 65], sp[1 * 65]); o.y = cvt_pk_bf16(sp[2 * 65], sp[3 * 65]); o.z = cvt_pk_bf16(sp[4 * 65], sp[5 * 65]); o.w = cvt_pk_bf16(sp[6 * 65], sp[7 * 65]);
        *(GAS u32x4*)(WT + (size_t)(n0dst + n) * ldk + k0 + 8 * kc) = o; }
    LDS_WAIT(); asm volatile("" ::: "memory");
}
__device__ __forceinline__ void tr_item64_f8(const GAS float* __restrict__ W, int ldw, const GAS float* __restrict__ gain, float scale, GAS unsigned char* __restrict__ WT8, int ldkB, int k0, int n0src, int n0dst, LAS float* scr, int lane) {
    const int rr = lane >> 4, c4 = (lane & 15) * 4;
    f32x4 v[16];
#pragma unroll
    for (int i = 0; i < 16; ++i) v[i] = __builtin_nontemporal_load((const GAS f32x4*)(W + (size_t)(k0 + 4 * i + rr) * ldw + n0src + c4));
#pragma unroll
    for (int i = 0; i < 16; ++i) { const int k = 4 * i + rr; const float g = (gain ? gain[k0 + k] : 1.f) * scale; LAS float* d = scr + k * 65 + c4;
        d[0] = v[i][0] * g; d[1] = v[i][1] * g; d[2] = v[i][2] * g; d[3] = v[i][3] * g; }
    LDS_WAIT(); asm volatile("" ::: "memory");
    const int kc = lane & 7;
#pragma unroll
    for (int j = 0; j < 8; ++j) { const int n = (lane >> 3) + 8 * j; const LAS float* sp = scr + (8 * kc) * 65 + n;
        u32x2 o; o.x = pk4_fp8(sp[0 * 65], sp[1 * 65], sp[2 * 65], sp[3 * 65]); o.y = pk4_fp8(sp[4 * 65], sp[5 * 65], sp[6 * 65], sp[7 * 65]);
        *(GAS u32x2*)(WT8 + (size_t)(n0dst + n) * ldkB + k0 + 8 * kc) = o; }
    LDS_WAIT(); asm volatile("" ::: "memory");
}
__device__ __forceinline__ int rope_dim(int p) { const int a = p >> 3, j = p & 7; return j < 4 ? 4 * a + j : 16 + 4 * a + (j - 4); }

#define LDP(i) ((void*)((((unsigned long long)(unsigned)__builtin_amdgcn_readfirstlane((int)(ARGP[i] >> 32))) << 32) | (unsigned long long)(unsigned)__builtin_amdgcn_readfirstlane((int)(unsigned)ARGP[i])))
#define ARGIN(i) ((const void*)LDP(i))
#define P_COS ((GAS float*)(ws + WS_COS))
#define P_SIN ((GAS float*)(ws + WS_SIN))
#define P_SSQ ((GAS float*)(ws + WS_SSQ))
#define P_FLOG ((GAS float*)(ws + WS_FLOG))
#define P_E01 ((GAS int*)(ws + WS_E01))
#define P_G01 ((GAS float*)(ws + WS_G01))
#define P_SLOT ((GAS int*)(ws + WS_SLOT))
#define P_TOKOF ((GAS int*)(ws + WS_TOKOF))
#define P_GATEOF ((GAS float*)(ws + WS_GATEOF))
#define P_CNT ((GAS int*)(ws + WS_CNT))
#define P_TSTART ((GAS int*)(ws + WS_TSTART))
#define P_RSTD ((GAS float*)(ws + WS_RSTD))
#define P_RSTDOF ((GAS float*)(ws + WS_RSTDOF))
#define P_KPE ((GAS bf16*)(ws + WS_KPE))
#define P_KAUG ((GAS bf16*)(ws + WS_KAUG))
#define P_BIASF ((GAS float*)(ws + WS_BIASF))
#define P_NRM ((GAS float*)(ws + WS_NRM))
#define P_WR ((GAS bf16*)(ws + WS_WR))
#define P_XR ((GAS bf16*)(ws + WS_XR))
#define P_OSS ((GAS float*)(ws + WS_OSS))
#define P_RSTDX ((GAS float*)(ws + WS_RSTDX))
#define P_WIN ((GAS bf16*)(ws + WS_WIN))
#define P_WUQ ((GAS bf16*)(ws + WS_WUQ))
#define P_WUKV ((GAS bf16*)(ws + WS_WUKV))
#define P_WOUT ((GAS bf16*)(ws + WS_WOUT))
#define P_WGU_L(ll) ((GAS unsigned char*)(ws + WS_WGU + (size_t)((ll) & 1) * 32 * MiB))
#define P_WD_L(ll) ((GAS unsigned char*)(ws + WS_WD + (size_t)((ll) & 1) * 16 * MiB))
#define P_XN ((GAS bf16*)(ws + WS_XN))
#define P_FQKV ((GAS bf16*)(ws + WS_FQKV))
#define P_HH ((GAS bf16*)(ws + WS_FQKV))
#define P_LAT ((GAS bf16*)(ws + WS_LAT))
#define P_QM ((GAS bf16*)(ws + WS_QM))
#define P_KVM ((GAS bf16*)(ws + WS_KVM))
#define P_Y ((GAS bf16*)(ws + WS_Y))
#define IN(k) (lo <= (k) && (k) < hi_)
#if MK_ONE_LAUNCH
#define GRID_BAR() xcd_barrier(bar)
#else
#define GRID_BAR() do {} while (0)
#endif
#define SEAM(k) do { if (IN(k) && IN((k) + 1)) GRID_BAR(); } while (0)
__device__ __forceinline__ void conv_gu_item(int r, const GAS float* w_gate, const GAS float* w_up, const GAS float* ffn_norm, GAS unsigned char* WGU, LAS float* scr64, int lane) {
    const int e = r / 256, q = r % 256, kb = q / 16, nb = q % 16; const int n0 = nb * 64; const int ct = n0 >> 8, which = (n0 >> 7) & 1, jj = n0 & 127;
    const GAS float* src = (which ? w_up : w_gate) + (size_t)e * DM * DEXP;
    tr_item64_f8(src, DEXP, ffn_norm, WSCALE, WGU + (size_t)e * 1024 * 1024, DM, kb * 64, ct * 128 + jj, n0, scr64, lane);
}
__device__ __forceinline__ void conv_d_item(int r, const GAS float* w_down, GAS unsigned char* WD, LAS float* scr64, int lane) {
    const int e = r / 128, q = r % 128, kb = q / 16, nb = q % 16;
    tr_item64_f8(w_down + (size_t)e * DEXP * DM, DM, nullptr, WSCALE, WD + (size_t)e * 1024 * 512, DEXP, kb * 64, nb * 64, nb * 64, scr64, lane);
}
template <int l>
__device__ __forceinline__ void layer_body(const int lo, const int hi_, LAS unsigned char* lds0, const int wave0, const int G0, const int bx0, const XcdBarrier& bar) {
        const int P = 10 * l;
        if (IN(P)) for (int rep_ = 0; rep_ < (l == 0 ? NREP(0) : 1); ++rep_) {
            unsigned ldsb_ = (unsigned)(uintptr_t)lds0; asm volatile("" : "+s"(ldsb_)); LAS unsigned char* lds = (LAS unsigned char*)(uintptr_t)ldsb_; volatile LAS unsigned* MISC = (volatile LAS unsigned*)(lds + MISC_OFF); volatile LAS unsigned long long* ARGP = (volatile LAS unsigned long long*)(lds + MISC_OFF + 768); (void)MISC; int wave = wave0, G = G0, bx = bx0; asm volatile("" : "+s"(G), "+s"(bx), "+s"(wave)); const int lane = (int)__builtin_amdgcn_mbcnt_hi(~0u, __builtin_amdgcn_mbcnt_lo(~0u, 0u)); const int tid = wave * 64 + lane; const int vcu = (bx % 8) * (G / 8) + bx / 8; const int gw = vcu * 8 + wave, NGW = G * 8; (void)lane; (void)gw; (void)NGW; (void)vcu;
            GAS unsigned char* ws = (GAS unsigned char*)LDP(22); GAS float* out = (GAS float*)LDP(21); const GAS float* x_in = (const GAS float*)ARGIN(0); const GAS int* positions = (const GAS int*)ARGIN(1);
            if (l < NLAYER) {
                LAS float* scr = (LAS float*)(lds + wave * 16640);
                const GAS float* attn_norm = (const GAS float*)ARGIN(2) + (size_t)l * DM; const GAS float* w_in = (const GAS float*)ARGIN(3) + (size_t)l * DM * INW;
                const GAS float* q_norm = (const GAS float*)ARGIN(5) + (size_t)l * 256; const GAS float* w_uq = (const GAS float*)ARGIN(6) + (size_t)l * 256 * 768;
                const GAS float* kv_norm = (const GAS float*)ARGIN(7) + (size_t)l * 128; const GAS float* w_ukv = (const GAS float*)ARGIN(8) + (size_t)l * 128 * 1024;
                const GAS float* mla_on = (const GAS float*)ARGIN(9) + (size_t)l * 512; const GAS float* fox_on = (const GAS float*)ARGIN(10) + (size_t)l * 512; const GAS float* w_out = (const GAS float*)ARGIN(11) + (size_t)l * DM * DM;
                const GAS float* ffn_norm = (const GAS float*)ARGIN(12) + (size_t)l * DM;
                const GAS float* w_gate = (const GAS float*)ARGIN(17) + (size_t)l * NEXP * DM * DEXP; const GAS float* w_up = (const GAS float*)ARGIN(18) + (size_t)l * NEXP * DM * DEXP; const GAS float* w_down = (const GAS float*)ARGIN(19) + (size_t)l * NEXP * DEXP * DM;
                constexpr int I_IN = 16 * 64, I_UQ = 4 * 24, I_UKV = 4 * 32;
                constexpr int NITEMS = I_IN + I_UQ + I_UKV;
                for (int it = vcu + G * wave; it < NITEMS; it += NGW) {
                    int r = it; const int j = lane & 31;
                    if (r < I_IN) { const int kb = r / 64, nb = r % 64; const int n = nb * 32 + j; int sc;
                        if (n < 384) sc = n; else if (n < 416) sc = 384 + rope_dim(n - 384); else if (n < 424) sc = 1952 + (n - 416); else if (n < 512) sc = -1; else sc = 416 + (n - 512);
                        tr_item(w_in, INW, DM, attn_norm, P_WIN, DM, kb * 64, nb * 32, sc, scr, lane); continue; } r -= I_IN;
                    if (r < I_UQ) { const int kb = r / 24, nb = r % 24; const int n = nb * 32 + j; const int hh = n / 96, d = n % 96; const int sc = d < 64 ? n : hh * 96 + 64 + rope_dim(d - 64);
                        tr_item(w_uq, 768, 256, q_norm, P_WUQ, 256, kb * 64, nb * 32, sc, scr, lane); continue; } r -= I_UQ;
                    { const int kb = r / 32, nb = r % 32; tr_item(w_ukv, 1024, 128, kv_norm, P_WUKV, 256, kb * 64, nb * 32, nb * 32 + j, scr, lane); }
                }
                LAS float* scr64 = (LAS float*)(lds + wave * 16640);
                constexpr int J_OUT = 16 * 16, J_GU = 16 * 16 * NEXP, J_D = 8 * 16 * NEXP;
                for (int it = vcu + G * ((wave + 1) & 7); it < J_OUT + (l == 0 ? J_GU + J_D : 0); it += NGW) {
                    int r = it;
                    if (r < J_OUT) { const int kb = r / 16, nb = r % 16; const GAS float* gn = kb < 8 ? mla_on : fox_on - 512; tr_item64(w_out, DM, gn, P_WOUT, DM, kb * 64, nb * 64, nb * 64, scr64, lane); continue; } r -= J_OUT;
                    if (r < J_GU) { conv_gu_item(r, w_gate, w_up, ffn_norm, P_WGU_L(l), scr64, lane); continue; } r -= J_GU;
                    conv_d_item(r, w_down, P_WD_L(l), scr64, lane);
                }
                { const GAS float* w_rg = (const GAS float*)ARGIN(13) + (size_t)l * DM * 4; const GAS float* w_re = (const GAS float*)ARGIN(15) + (size_t)l * DM * 32;
                  for (int idx = bx * 512 + tid; idx < 2 * 48 * 520; idx += G * 512) { const int half = idx / (48 * 520), r = idx % (48 * 520), c = r / 520, kk = r % 520; const int k = half * 512 + kk;
                      float w = 0.f; if (c < 36 && kk < 512) w = ffn_norm[k] * (c < 4 ? w_rg[k * 4 + c] : w_re[k * 32 + (c - 4)]);
                      const unsigned h16 = cvt_pk_bf16(w, 0.f) & 0xffffu; const unsigned l16 = cvt_pk_bf16(w - __uint_as_float(h16 << 16), 0.f) & 0xffffu;
                      P_WR[(size_t)(half * 2 + 0) * 48 * 520 + r] = (bf16)h16; P_WR[(size_t)(half * 2 + 1) * 48 * 520 + r] = (bf16)l16; } }
            }
            const GAS float* fin = (const GAS float*)ARGIN(20);
            for (int mb = gw * 4; mb < NTOK; mb += NGW * 4) {
                f32x4 v[4][4]; int s0[4], s1[4];
                if (l > 0) {
#pragma unroll
                    for (int r = 0; r < 4; ++r) { s0[r] = P_SLOT[2 * (mb + r)]; s1[r] = P_SLOT[2 * (mb + r) + 1]; }
                }
#pragma unroll
                for (int r = 0; r < 4; ++r) {
                    if (l == 0) { const GAS float* xr = x_in + (size_t)(mb + r) * DM;
#pragma unroll
                        for (int j = 0; j < 4; ++j) v[r][j] = __builtin_nontemporal_load((const GAS f32x4*)(xr + 4 * lane + 256 * j)); }
                    else { const GAS bf16* xr = P_XR + (size_t)(mb + r) * DM;
#pragma unroll
                        for (int j = 0; j < 4; ++j) { const u32x2 w = __builtin_nontemporal_load((const GAS u32x2*)(xr + 4 * lane + 256 * j)); v[r][j] = (f32x4){__uint_as_float(w.x << 16), __uint_as_float(w.x & 0xffff0000u), __uint_as_float(w.y << 16), __uint_as_float(w.y & 0xffff0000u)}; } } }
                if (l > 0) {
#pragma unroll
                    for (int r = 0; r < 4; ++r)
#pragma unroll
                        for (int j = 0; j < 4; ++j) { const int a = __builtin_nontemporal_load((const GAS int*)((const GAS unsigned char*)P_Y + (size_t)s0[r] * 1024 + 4 * lane + 256 * j)), c = __builtin_nontemporal_load((const GAS int*)((const GAS unsigned char*)P_Y + (size_t)s1[r] * 1024 + 4 * lane + 256 * j));
                            const f32x2 a0 = __builtin_amdgcn_cvt_pk_f32_fp8(a, false), a1 = __builtin_amdgcn_cvt_pk_f32_fp8(a, true), c0 = __builtin_amdgcn_cvt_pk_f32_fp8(c, false), c1 = __builtin_amdgcn_cvt_pk_f32_fp8(c, true);
                            v[r][j][0] += (a0[0] + c0[0]) * WSCALE_INV; v[r][j][1] += (a0[1] + c0[1]) * WSCALE_INV; v[r][j][2] += (a1[0] + c1[0]) * WSCALE_INV; v[r][j][3] += (a1[1] + c1[1]) * WSCALE_INV; }
                }
                float ss[4];
#pragma unroll
                for (int r = 0; r < 4; ++r) { float s = 0.f;
#pragma unroll
                    for (int j = 0; j < 4; ++j) s += (v[r][j][0] * v[r][j][0] + v[r][j][1] * v[r][j][1]) + (v[r][j][2] * v[r][j][2] + v[r][j][3] * v[r][j][3]);
                    ss[r] = s; }
#pragma unroll
                for (int o = 1; o < 64; o <<= 1) {
#pragma unroll
                    for (int r = 0; r < 4; ++r) ss[r] += __shfl_xor(ss[r], o); }
#pragma unroll
                for (int r = 0; r < 4; ++r) { const int m = mb + r; const float rstd = rsqrtf(ss[r] * (1.f / DM) + EPS);
                    if (l < NLAYER) {
#pragma unroll
                        for (int j = 0; j < 4; ++j) { u32x2 w; w.x = cvt_pk_bf16(v[r][j][0], v[r][j][1]); w.y = cvt_pk_bf16(v[r][j][2], v[r][j][3]); *(GAS u32x2*)(P_XR + (size_t)m * DM + 4 * lane + 256 * j) = w; }
                        if (lane == 0) P_RSTDX[m] = rstd;
                    } else {
#pragma unroll
                        for (int j = 0; j < 4; ++j) { const f32x4 g = *(const GAS f32x4*)(fin + 4 * lane + 256 * j); __builtin_nontemporal_store(v[r][j] * rstd * g, (GAS f32x4*)(out + (size_t)m * DM + 4 * lane + 256 * j)); }
                    }
                }
            }
        }
        if constexpr (l == NLAYER) return;
        SEAM(P);
        if (IN(P + 1)) for (int rep_ = 0; rep_ < ((l == 0 || 1 != 5) ? NREP(1) : 1); ++rep_) {
            unsigned ldsb_ = (unsigned)(uintptr_t)lds0; asm volatile("" : "+s"(ldsb_)); LAS unsigned char* lds = (LAS unsigned char*)(uintptr_t)ldsb_; volatile LAS unsigned* MISC = (volatile LAS unsigned*)(lds + MISC_OFF); volatile LAS unsigned long long* ARGP = (volatile LAS unsigned long long*)(lds + MISC_OFF + 768); (void)MISC; int wave = wave0, G = G0, bx = bx0; asm volatile("" : "+s"(G), "+s"(bx), "+s"(wave)); const int lane = (int)__builtin_amdgcn_mbcnt_hi(~0u, __builtin_amdgcn_mbcnt_lo(~0u, 0u)); const int tid = wave * 64 + lane; const int vcu = (bx % 8) * (G / 8) + bx / 8; const int gw = vcu * 8 + wave, NGW = G * 8; (void)lane; (void)gw; (void)NGW; (void)vcu;
            GAS unsigned char* ws = (GAS unsigned char*)LDP(22); GAS float* out = (GAS float*)LDP(21); const GAS float* x_in = (const GAS float*)ARGIN(0); (void)out; (void)x_in; (void)ws;
            DenseOrder S{NTOK / 256, INP / 256, (NTOK / 256) * (INP / 256), G, bx, (const GAS char*)P_XR, (const GAS char*)P_WIN, (size_t)256 * DM * 2, (size_t)256 * DM * 2};
            EpiWin E{P_LAT, P_FQKV, P_KPE, P_FLOG, P_SSQ, P_COS, P_SIN, P_RSTDX};
            pg8::gemm_phase<EpiWin, DenseOrder, true, false>(tid, lds, DM * 2, DM * 2, DM * 2, S, E, nullptr);
        }
        SEAM(P + 1);
        if (IN(P + 2)) for (int rep_ = 0; rep_ < ((l == 0 || 2 != 5) ? NREP(2) : 1); ++rep_) {
            unsigned ldsb_ = (unsigned)(uintptr_t)lds0; asm volatile("" : "+s"(ldsb_)); LAS unsigned char* lds = (LAS unsigned char*)(uintptr_t)ldsb_; volatile LAS unsigned* MISC = (volatile LAS unsigned*)(lds + MISC_OFF); volatile LAS unsigned long long* ARGP = (volatile LAS unsigned long long*)(lds + MISC_OFF + 768); (void)MISC; int wave = wave0, G = G0, bx = bx0; asm volatile("" : "+s"(G), "+s"(bx), "+s"(wave)); const int lane = (int)__builtin_amdgcn_mbcnt_hi(~0u, __builtin_amdgcn_mbcnt_lo(~0u, 0u)); const int tid = wave * 64 + lane; const int vcu = (bx % 8) * (G / 8) + bx / 8; const int gw = vcu * 8 + wave, NGW = G * 8; (void)lane; (void)gw; (void)NGW; (void)vcu;
            GAS unsigned char* ws = (GAS unsigned char*)LDP(22); GAS float* out = (GAS float*)LDP(21); const GAS float* x_in = (const GAS float*)ARGIN(0); (void)out; (void)x_in; (void)ws;
            {
                const int sq = vcu >> 1, hf = vcu & 1; const int b = sq >> 3, h = sq & 7; const float bf = ((const GAS float*)ARGIN(4))[l * 8 + h];
                const GAS float* fl = P_FLOG + ((size_t)b * SEQ + hf * 1024 + 2 * tid) * 8 + h;
                float lf[2], lg[2] = {0.f, 0.f};
#pragma unroll
                for (int e = 0; e < 2; ++e) { const float f = fl[e * 8] + bf; lf[e] = fminf(f, 0.f) - log1pf(expf(-fabsf(f))); }
                if (hf) {
#pragma unroll
                    for (int e = 0; e < 2; ++e) { const float f = fl[e * 8 - 1024 * 8] + bf; lg[e] = fminf(f, 0.f) - log1pf(expf(-fabsf(f))); } }
                const double s2 = (double)lf[0] + (double)lf[1];
                double incl = s2, first = (double)lg[0] + (double)lg[1];
#pragma unroll
                for (int o = 1; o < 64; o <<= 1) { const double t = __shfl_up(incl, o); if (lane >= o) incl += t; first += __shfl_xor(first, o); }
                LAS double* wtot = (LAS double*)lds;
                if (lane == 63) wtot[wave] = incl;
                if (lane == 0) wtot[8 + wave] = first;
                __syncthreads();
                double c = incl - s2;
                for (int w = 0; w < wave; ++w) c += wtot[w];
                if (hf) { for (int w = 0; w < 8; ++w) c += wtot[8 + w]; }
                const size_t t0 = ((size_t)b * 8 + h) * SEQ + hf * 1024 + 2 * tid;
                GAS u32x4* ka = (GAS u32x4*)(P_KAUG + t0 * 8);
                float xs[2];
#pragma unroll
                for (int e = 0; e < 2; ++e) { c += (double)lf[e]; const float x = (float)(-c * 1.4426950408889634); xs[e] = x;
                    const unsigned h16 = cvt_pk_bf16(x, 0.f) & 0xffffu; const float r1 = x - __uint_as_float(h16 << 16); const unsigned m16 = cvt_pk_bf16(r1, 0.f) & 0xffffu; const float r2 = r1 - __uint_as_float(m16 << 16); const unsigned l16 = cvt_pk_bf16(r2, 0.f) & 0xffffu;
                    ka[e] = (u32x4){h16 | (m16 << 16), l16, 0u, 0u}; P_BIASF[t0 + e] = x; }
                float qn = 0.f, kn = 0.f, xdm = INFINITY;
                { const GAS bf16* fqp = P_FQKV + ((size_t)b * SEQ + hf * 1024 + 2 * tid) * 512 + h * 64; const GAS bf16* fkp = fqp + (size_t)NTOK * 512;
#pragma unroll
                  for (int e = 0; e < 2; ++e) { float sq_ = 0.f, sk = 0.f, dd = 0.f;
#pragma unroll
                      for (int c8 = 0; c8 < 8; ++c8) { const u32x4 a = *(const GAS u32x4*)(fqp + e * 512 + c8 * 8), k4 = *(const GAS u32x4*)(fkp + e * 512 + c8 * 8);
#pragma unroll
                          for (int j = 0; j < 4; ++j) { const float a0 = __uint_as_float(a[j] << 16), a1 = __uint_as_float(a[j] & 0xffff0000u), k0 = __uint_as_float(k4[j] << 16), k1 = __uint_as_float(k4[j] & 0xffff0000u);
                              sq_ += a0 * a0 + a1 * a1; sk += k0 * k0 + k1 * k1; dd += a0 * k0 + a1 * k1; } }
                      qn = fmaxf(qn, sq_); kn = fmaxf(kn, sk); xdm = fminf(xdm, xs[e] + dd); } }
#pragma unroll
                for (int o = 1; o < 64; o <<= 1) { qn = fmaxf(qn, __shfl_xor(qn, o)); kn = fmaxf(kn, __shfl_xor(kn, o)); xdm = fminf(xdm, __shfl_xor(xdm, o)); }
                LAS float* knw = (LAS float*)(lds + 256);
                if (lane == 0) { knw[wave] = kn; knw[8 + wave] = qn; knw[16 + wave] = xdm; }
                __syncthreads();
                if (tid < 4) { P_NRM[sq * 32 + hf * 4 + tid] = sqrtf(fmaxf(knw[8 + 2 * tid], knw[8 + 2 * tid + 1])); P_NRM[sq * 32 + 16 + hf * 4 + tid] = fminf(knw[16 + 2 * tid], knw[16 + 2 * tid + 1]); }
                if (tid == 4) { float m = knw[0]; for (int w = 1; w < 8; ++w) m = fmaxf(m, knw[w]); P_NRM[sq * 32 + 8 + hf] = sqrtf(m); }
                __syncthreads();
            }
            UpOrder S{G, vcu, (const GAS char*)P_LAT, (const GAS char*)P_WUQ, (const GAS char*)P_WUKV};
            EpiUp E{P_QM, P_KVM, P_SSQ, P_COS, P_SIN};
            pg8::gemm_phase<EpiUp, UpOrder, true, false, false, false, true>(tid, lds, 256 * 2, 512 * 2, 256 * 2, S, E, nullptr);
        }
        SEAM(P + 2);
        if (IN(P + 3)) for (int rep_ = 0; rep_ < ((l == 0 || 3 != 5) ? NREP(3) : 1); ++rep_) {
            unsigned ldsb_ = (unsigned)(uintptr_t)lds0; asm volatile("" : "+s"(ldsb_)); LAS unsigned char* lds = (LAS unsigned char*)(uintptr_t)ldsb_; volatile LAS unsigned* MISC = (volatile LAS unsigned*)(lds + MISC_OFF); volatile LAS unsigned long long* ARGP = (volatile LAS unsigned long long*)(lds + MISC_OFF + 768); (void)MISC; int wave = wave0, G = G0, bx = bx0; asm volatile("" : "+s"(G), "+s"(bx), "+s"(wave)); const int lane = (int)__builtin_amdgcn_mbcnt_hi(~0u, __builtin_amdgcn_mbcnt_lo(~0u, 0u)); const int tid = wave * 64 + lane; const int vcu = (bx % 8) * (G / 8) + bx / 8; const int gw = vcu * 8 + wave, NGW = G * 8; (void)lane; (void)gw; (void)NGW; (void)vcu;
            GAS unsigned char* ws = (GAS unsigned char*)LDP(22); GAS float* out = (GAS float*)LDP(21); const GAS float* x_in = (const GAS float*)ARGIN(0); (void)out; (void)x_in; (void)ws;
            GAS bf16* O = P_XN;
            const int b = vcu >> 4, hh = (vcu & 15) >> 1, sub = vcu & 1;
            const att::Tens2 TM{P_QM, 768, P_KVM, 1024, P_KPE, P_KVM + 64, 1024, O, nullptr, nullptr, P_OSS};
            const att::Tens2 TF{P_FQKV, 512, P_FQKV + (size_t)NTOK * 512, 512, P_KAUG, P_FQKV + (size_t)2 * NTOK * 512, 512, O, P_BIASF, P_NRM, P_OSS};
#define QB_OF(i) ((((i) & 1) ? 7 - (2 * sub + ((i) >> 1)) : (2 * sub + ((i) >> 1))))
            int ts0, ts1, ts2, ts3;
            { const GAS float* bs = P_BIASF + ((long)b * 8 + hh) * SEQ; const GAS float* nr = P_NRM + (b * 8 + hh) * 32; const float kmx = fmaxf(nr[8], nr[9]);
#define FOX_TS(i, dst) do { const int qb_ = QB_OF(i), NT_ = 4 * qb_ + 4; const float Z_ = nr[qb_] * kmx * 1.001f + 0.01f; const float bend_ = bs[(lane < NT_ ? lane : NT_ - 1) * 64 + 63]; \
                  const bool skip_ = (lane < NT_ - 4) && (Z_ + bend_ - nr[16 + qb_] < -32.f); dst = __builtin_popcountll(__ballot(skip_)); } while (0)
              FOX_TS(0, ts0); FOX_TS(1, ts1); FOX_TS(2, ts2); FOX_TS(3, ts3);
#undef FOX_TS
            }
            if (wave >= 4) __builtin_amdgcn_s_setprio(1);
            bf16x8 qreg[6];
            { int sb = 0; for (int i = 0; i < 4; ++i) sb = att::attn_unit2<1>(wave, b, hh, QB_OF(i), TM, (LAS char*)lds, sb, i > 0, i < 3 ? QB_OF(i + 1) : -1, qreg, 0); }
            { int sb = 0; for (int i = 0; i < 4; ++i) { const int ts = i == 0 ? ts0 : i == 1 ? ts1 : i == 2 ? ts2 : ts3; sb = att::attn_unit2<0>(wave, b, hh, QB_OF(i), TF, (LAS char*)lds, sb, i > 0, i < 3 ? QB_OF(i + 1) : -1, qreg, ts); } }
#undef QB_OF
            __builtin_amdgcn_s_setprio(0);
        }
        SEAM(P + 3);
        if (IN(P + 5)) for (int rep_ = 0; rep_ < ((l == 0 || 5 != 5) ? NREP(5) : 1); ++rep_) {
            unsigned ldsb_ = (unsigned)(uintptr_t)lds0; asm volatile("" : "+s"(ldsb_)); LAS unsigned char* lds = (LAS unsigned char*)(uintptr_t)ldsb_; volatile LAS unsigned* MISC = (volatile LAS unsigned*)(lds + MISC_OFF); volatile LAS unsigned long long* ARGP = (volatile LAS unsigned long long*)(lds + MISC_OFF + 768); (void)MISC; int wave = wave0, G = G0, bx = bx0; asm volatile("" : "+s"(G), "+s"(bx), "+s"(wave)); const int lane = (int)__builtin_amdgcn_mbcnt_hi(~0u, __builtin_amdgcn_mbcnt_lo(~0u, 0u)); const int tid = wave * 64 + lane; const int vcu = (bx % 8) * (G / 8) + bx / 8; const int gw = vcu * 8 + wave, NGW = G * 8; (void)lane; (void)gw; (void)NGW; (void)vcu;
            GAS unsigned char* ws = (GAS unsigned char*)LDP(22); GAS float* out = (GAS float*)LDP(21); const GAS float* x_in = (const GAS float*)ARGIN(0); (void)out; (void)x_in; (void)ws;
            DenseOrder S{NTOK / 256, DM / 256, (NTOK / 256) * (DM / 256), G, bx, (const GAS char*)P_XN, (const GAS char*)P_WOUT, (size_t)256 * DM * 2, (size_t)256 * DM * 2};
            EpiOut<false> E{x_in, P_XR};
            LAS f32x2* scl = (LAS f32x2*)(lds + pg8::STAGE_BYTES);
            { Unit u_; if (S.next(tid >> 8, u_)) { const GAS float* op = P_OSS + ((size_t)u_.pm * 256 + (tid & 255)) * 16;
                  const f32x4 a0 = *(const GAS f32x4*)op, a1 = *(const GAS f32x4*)(op + 4), c0 = *(const GAS f32x4*)(op + 8), c1 = *(const GAS f32x4*)(op + 12);
                  const float sm = ((a0[0] + a0[1]) + (a0[2] + a0[3])) + ((a1[0] + a1[1]) + (a1[2] + a1[3])), sf = ((c0[0] + c0[1]) + (c0[2] + c0[3])) + ((c1[0] + c1[1]) + (c1[2] + c1[3]));
                  const float rm_ = rsqrtf(sm * (1.f / 512.f) + EPS), rf_ = rsqrtf(sf * (1.f / 512.f) + EPS);
                  scl[tid] = (f32x2){rm_ / rf_, rf_}; } }
            __syncthreads();
            pg8::gemm_phase<EpiOut<false>, DenseOrder, true, false, false, true>(tid, lds, DM * 2, DM * 2, DM * 2, S, E, nullptr, scl);
        }
        SEAM(P + 5);
        if (IN(P + 6)) for (int rep_ = 0; rep_ < ((l == 0 || 6 != 5) ? NREP(6) : 1); ++rep_) {
            unsigned ldsb_ = (unsigned)(uintptr_t)lds0; asm volatile("" : "+s"(ldsb_)); LAS unsigned char* lds = (LAS unsigned char*)(uintptr_t)ldsb_; volatile LAS unsigned* MISC = (volatile LAS unsigned*)(lds + MISC_OFF); volatile LAS unsigned long long* ARGP = (volatile LAS unsigned long long*)(lds + MISC_OFF + 768); (void)MISC; int wave = wave0, G = G0, bx = bx0; asm volatile("" : "+s"(G), "+s"(bx), "+s"(wave)); const int lane = (int)__builtin_amdgcn_mbcnt_hi(~0u, __builtin_amdgcn_mbcnt_lo(~0u, 0u)); const int tid = wave * 64 + lane; const int vcu = (bx % 8) * (G / 8) + bx / 8; const int gw = vcu * 8 + wave, NGW = G * 8; (void)lane; (void)gw; (void)NGW; (void)vcu;
            GAS unsigned char* ws = (GAS unsigned char*)LDP(22); GAS float* out = (GAS float*)LDP(21); const GAS float* x_in = (const GAS float*)ARGIN(0); (void)out; (void)x_in; (void)ws;
            GAS bf16* H2 = P_XN;
            LAS bf16* WT = (LAS bf16*)lds;
            LAS float* LG = (LAS float*)(lds + 99840) + wave * 576;
            const GAS float* b_rg = (const GAS float*)ARGIN(14) + l * 4; const GAS float* b_re = (const GAS float*)ARGIN(16) + l * 32;
            if (tid < 32) MISC[64 + tid] = 0u;
            const int r16 = lane & 15, g4 = lane >> 4;
            const int m0 = vcu * 128 + wave * 16;
            const GAS bf16* xrow = P_XR + (size_t)(m0 + r16) * DM + 8 * g4;
            GAS unsigned char* hrow = (GAS unsigned char*)H2 + (size_t)(m0 + r16) * DM + 8 * g4;
            f32x4 acc3[3]; acc3[0] = (f32x4){0.f, 0.f, 0.f, 0.f}; acc3[1] = acc3[0]; acc3[2] = acc3[0];
            float ssq = 0.f;
            for (int half = 0; half < 2; ++half) {
                __syncthreads();
                for (int idx = tid; idx < 2 * 48 * 520 / 8; idx += 512) *(LAS u32x4*)(WT + 8 * idx) = *(const GAS u32x4*)(P_WR + (size_t)half * 2 * 48 * 520 + 8 * idx);
                __syncthreads();
                for (int s8 = 0; s8 < 16; s8 += 8) {
                    bf16x8 xv[8];
#pragma unroll
                    for (int u = 0; u < 8; ++u) xv[u] = *(const GAS bf16x8*)(xrow + half * 512 + 32 * (s8 + u));
#pragma unroll
                    for (int u = 0; u < 8; ++u) {
                        const u32x4 xw = __builtin_bit_cast(u32x4, xv[u]); float xf[8];
#pragma unroll
                        for (int j = 0; j < 4; ++j) { xf[2 * j] = __uint_as_float(xw[j] << 16); xf[2 * j + 1] = __uint_as_float(xw[j] & 0xffff0000u); }
                        u32x2 hw; hw.x = pk4_fp8(xf[0], xf[1], xf[2], xf[3]); hw.y = pk4_fp8(xf[4], xf[5], xf[6], xf[7]); *(GAS u32x2*)(hrow + half * 512 + 32 * (s8 + u)) = hw;
#pragma unroll
                        for (int j = 0; j < 8; ++j) ssq += xf[j] * xf[j];
                        const LAS bf16* wk = WT + r16 * 520 + 32 * (s8 + u) + 8 * g4;
#pragma unroll
                        for (int ct = 0; ct < 3; ++ct) { const bf16x8 bh = *(const LAS bf16x8*)(wk + ct * 16 * 520), bl = *(const LAS bf16x8*)(wk + (48 + ct * 16) * 520);
                            acc3[ct] = __builtin_amdgcn_mfma_f32_16x16x32_bf16(xv[u], bh, acc3[ct], 0, 0, 0); acc3[ct] = __builtin_amdgcn_mfma_f32_16x16x32_bf16(xv[u], bl, acc3[ct], 0, 0, 0); }
                    }
                }
            }
            ssq += __shfl_xor(ssq, 16); ssq += __shfl_xor(ssq, 32);
            const float rstd = rsqrtf(ssq * (1.f / DM) + EPS);
#pragma unroll
            for (int ct = 0; ct < 3; ++ct) { const int c = 16 * ct + r16; if (c < 36) {
#pragma unroll
                for (int rg = 0; rg < 4; ++rg) LG[(4 * g4 + rg) * 36 + c] = acc3[ct][rg]; } }
            LDS_WAIT();
            if (lane < 16) {
                const int m = m0 + lane; const LAS float* lg = LG + lane * 36;
                float gl[4];
#pragma unroll
                for (int g = 0; g < 4; ++g) gl[g] = lg[g] * rstd + b_rg[g];
                int gi = 0; float gm = gl[0];
#pragma unroll
                for (int g = 1; g < 4; ++g) if (gl[g] > gm) { gm = gl[g]; gi = g; }
                float gs = 0.f;
#pragma unroll
                for (int g = 0; g < 4; ++g) gs += __expf(gl[g] - gm);
                const float gval = 1.f / gs;
                float el[8];
#pragma unroll
                for (int j = 0; j < 8; ++j) el[j] = lg[4 + 8 * gi + j] * rstd + b_re[8 * gi + j];
                int i0 = 0; float mx0 = el[0];
#pragma unroll
                for (int j = 1; j < 8; ++j) if (el[j] > mx0) { mx0 = el[j]; i0 = j; }
                int i1 = -1; float mx1 = -INFINITY;
#pragma unroll
                for (int j = 0; j < 8; ++j) if (j != i0 && el[j] > mx1) { mx1 = el[j]; i1 = j; }
                const float e1 = __expf(mx1 - mx0); const float g0 = gval / (1.f + e1), g1 = gval * e1 / (1.f + e1);
                const int ea = gi * 8 + i0, eb = gi * 8 + i1; P_E01[2 * m] = ea; P_E01[2 * m + 1] = eb; P_G01[2 * m] = g0; P_G01[2 * m + 1] = g1; P_RSTD[m] = rstd;
                __hip_atomic_fetch_add((LAS unsigned*)(lds + MISC_OFF) + 64 + ea, 1u, __ATOMIC_RELAXED, __HIP_MEMORY_SCOPE_WORKGROUP); __hip_atomic_fetch_add((LAS unsigned*)(lds + MISC_OFF) + 64 + eb, 1u, __ATOMIC_RELAXED, __HIP_MEMORY_SCOPE_WORKGROUP);
            }
            __syncthreads();
            if (tid < 32) P_CNT[vcu * 32 + tid] = (int)MISC[64 + tid];
        }
        SEAM(P + 6);
        if (IN(P + 7)) for (int rep_ = 0; rep_ < ((l == 0 || 7 != 5) ? NREP(7) : 1); ++rep_) {
            unsigned ldsb_ = (unsigned)(uintptr_t)lds0; asm volatile("" : "+s"(ldsb_)); LAS unsigned char* lds = (LAS unsigned char*)(uintptr_t)ldsb_; volatile LAS unsigned* MISC = (volatile LAS unsigned*)(lds + MISC_OFF); volatile LAS unsigned long long* ARGP = (volatile LAS unsigned long long*)(lds + MISC_OFF + 768); (void)MISC; int wave = wave0, G = G0, bx = bx0; asm volatile("" : "+s"(G), "+s"(bx), "+s"(wave)); const int lane = (int)__builtin_amdgcn_mbcnt_hi(~0u, __builtin_amdgcn_mbcnt_lo(~0u, 0u)); const int tid = wave * 64 + lane; const int vcu = (bx % 8) * (G / 8) + bx / 8; const int gw = vcu * 8 + wave, NGW = G * 8; (void)lane; (void)gw; (void)NGW; (void)vcu;
            GAS unsigned char* ws = (GAS unsigned char*)LDP(22); GAS float* out = (GAS float*)LDP(21); const GAS float* x_in = (const GAS float*)ARGIN(0); (void)out; (void)x_in; (void)ws;
            LAS int* cnt_all = (LAS int*)lds;
            LAS int* pre_e = (LAS int*)(lds + 32768);
            LAS int* tot_e = pre_e + 32;
            LAS int* pst = pre_e + 64;
            LAS int* eL = pre_e + 128;
            for (int i = tid; i < 256 * 32; i += 512) cnt_all[i] = P_CNT[i];
            if (tid < 256) eL[tid] = P_E01[vcu * 256 + tid];
            __syncthreads();
            { LAS int* part = pre_e + 512;
              const int e = tid & 31, p = tid >> 5; int pre = 0, tot = 0;
#pragma unroll
              for (int j = 0; j < 16; ++j) { const int w = p * 16 + j; const int c = cnt_all[w * 32 + e]; pre += (w < vcu) ? c : 0; tot += c; }
              part[(p * 2) * 32 + e] = pre; part[(p * 2 + 1) * 32 + e] = tot; }
            __syncthreads();
            if (tid < 32) { LAS int* part = pre_e + 512; int pre = 0, tot = 0;
#pragma unroll
                for (int p = 0; p < 16; ++p) { pre += part[(p * 2) * 32 + tid]; tot += part[(p * 2 + 1) * 32 + tid]; } pre_e[tid] = pre; tot_e[tid] = tot; }
            __syncthreads();
            if (tid == 0) { int acc = 0; for (int e = 0; e < 32; ++e) { pst[e] = acc; acc += (tot_e[e] + 255) / 256 * 256; } pst[32] = acc; }
            __syncthreads();
            if (vcu == 0 && tid <= 32) P_TSTART[tid] = pst[tid] / 256;
            { LAS int* hist = pre_e + 2048;
              if (tid < 128) hist[tid] = 0;
              __syncthreads();
              int e = 0, rin = 0;
              if (tid < 256) { e = eL[tid]; unsigned long long mym = 0ull;
                  for (int x = 0; x < 32; ++x) { const unsigned long long bm = __ballot(e == x); if (e == x) mym = bm; }
                  rin = __builtin_popcountll(mym & ((1ull << lane) - 1ull));
                  if (rin == 0) hist[wave * 32 + e] = __builtin_popcountll(mym); }
              __syncthreads();
              if (tid < 256) { int r = rin; for (int w = 0; w < wave; ++w) r += hist[w * 32 + e];
                  const int slot = pst[e] + pre_e[e] + r; const int tok = vcu * 128 + (tid >> 1);
                  P_SLOT[vcu * 256 + tid] = slot; P_TOKOF[slot] = tok; P_GATEOF[slot] = P_G01[vcu * 256 + tid]; P_RSTDOF[slot] = P_RSTD[tok]; } }
            if (vcu < 32) { const int e = vcu; for (int s = pst[e] + tot_e[e] + tid; s < pst[e + 1]; s += 512) { P_TOKOF[s] = 0; P_GATEOF[s] = 0.f; P_RSTDOF[s] = 0.f; } }
            __syncthreads();
        }
        SEAM(P + 7);
        if (IN(P + 8)) for (int rep_ = 0; rep_ < ((l == 0 || 8 != 5) ? NREP(8) : 1); ++rep_) {
            unsigned ldsb_ = (unsigned)(uintptr_t)lds0; asm volatile("" : "+s"(ldsb_)); LAS unsigned char* lds = (LAS unsigned char*)(uintptr_t)ldsb_; volatile LAS unsigned* MISC = (volatile LAS unsigned*)(lds + MISC_OFF); volatile LAS unsigned long long* ARGP = (volatile LAS unsigned long long*)(lds + MISC_OFF + 768); (void)MISC; int wave = wave0, G = G0, bx = bx0; asm volatile("" : "+s"(G), "+s"(bx), "+s"(wave)); const int lane = (int)__builtin_amdgcn_mbcnt_hi(~0u, __builtin_amdgcn_mbcnt_lo(~0u, 0u)); const int tid = wave * 64 + lane; const int vcu = (bx % 8) * (G / 8) + bx / 8; const int gw = vcu * 8 + wave, NGW = G * 8; (void)lane; (void)gw; (void)NGW; (void)vcu;
            GAS unsigned char* ws = (GAS unsigned char*)LDP(22); GAS float* out = (GAS float*)LDP(21); const GAS float* x_in = (const GAS float*)ARGIN(0); (void)out; (void)x_in; (void)ws;
            volatile LAS int* TS = (volatile LAS int*)(MISC + 128);
            if (tid <= 32) TS[tid] = P_TSTART[tid];
            __syncthreads();
            MoeOrder S{G, vcu, TS, (const GAS char*)P_XN, (const GAS char*)P_WGU_L(l), 0, (size_t)1024 * 1024, (size_t)256 * 1024};
            EpiGU E{(GAS unsigned char*)P_HH, P_RSTDOF};
            pg8::gemm_phase<EpiGU, MoeOrder, true, true, true>(tid, lds, DM, DM, DM, S, E, P_TOKOF);
            if constexpr (l + 1 < NLAYER) {
                const int U = (int)TS[32] * 4, rem = U & 255; const int nidle = rem ? 256 - rem : 256, rk = rem ? vcu - rem : vcu;
                if (rk >= 0) { LAS float* scr64 = (LAS float*)(lds + wave * 16640);
                    const GAS float* w_gate = (const GAS float*)ARGIN(17) + (size_t)(l + 1) * NEXP * DM * DEXP; const GAS float* w_up = (const GAS float*)ARGIN(18) + (size_t)(l + 1) * NEXP * DM * DEXP; const GAS float* ffn1 = (const GAS float*)ARGIN(12) + (size_t)(l + 1) * DM;
                    for (int it = rk * 8 + wave; it < 16 * 16 * NEXP; it += nidle * 8) conv_gu_item(it, w_gate, w_up, ffn1, P_WGU_L(l + 1), scr64, lane); }
            }
        }
        SEAM(P + 8);
        if (IN(P + 9)) for (int rep_ = 0; rep_ < ((l == 0 || 9 != 5) ? NREP(9) : 1); ++rep_) {
            unsigned ldsb_ = (unsigned)(uintptr_t)lds0; asm volatile("" : "+s"(ldsb_)); LAS unsigned char* lds = (LAS unsigned char*)(uintptr_t)ldsb_; volatile LAS unsigned* MISC = (volatile LAS unsigned*)(lds + MISC_OFF); volatile LAS unsigned long long* ARGP = (volatile LAS unsigned long long*)(lds + MISC_OFF + 768); (void)MISC; int wave = wave0, G = G0, bx = bx0; asm volatile("" : "+s"(G), "+s"(bx), "+s"(wave)); const int lane = (int)__builtin_amdgcn_mbcnt_hi(~0u, __builtin_amdgcn_mbcnt_lo(~0u, 0u)); const int tid = wave * 64 + lane; const int vcu = (bx % 8) * (G / 8) + bx / 8; const int gw = vcu * 8 + wave, NGW = G * 8; (void)lane; (void)gw; (void)NGW; (void)vcu;
            GAS unsigned char* ws = (GAS unsigned char*)LDP(22); GAS float* out = (GAS float*)LDP(21); const GAS float* x_in = (const GAS float*)ARGIN(0); (void)out; (void)x_in; (void)ws;
            volatile LAS int* TS = (volatile LAS int*)(MISC + 128);
            if (tid <= 32) TS[tid] = P_TSTART[tid];
            __syncthreads();
            MoeOrder S{G, vcu, TS, (const GAS char*)P_HH, (const GAS char*)P_WD_L(l), (size_t)256 * 512, (size_t)1024 * 512, (size_t)256 * 512};
            EpiDown E{(GAS unsigned char*)P_Y, P_GATEOF};
            pg8::gemm_phase<EpiDown, MoeOrder, true, false, true>(tid, lds, DEXP, DEXP, DEXP, S, E, nullptr);
            if constexpr (l + 1 < NLAYER) {
                const int U = (int)TS[32] * 4, rem = U & 255; const int nidle = rem ? 256 - rem : 256, rk = rem ? vcu - rem : vcu;
                if (rk >= 0) { LAS float* scr64 = (LAS float*)(lds + wave * 16640);
                    const GAS float* w_down = (const GAS float*)ARGIN(19) + (size_t)(l + 1) * NEXP * DEXP * DM;
                    for (int it = rk * 8 + wave; it < 8 * 16 * NEXP; it += nidle * 8) conv_d_item(it, w_down, P_WD_L(l + 1), scr64, lane); }
            }
        }
        SEAM(P + 9);
}

__global__ void __launch_bounds__(512, 2) fwd(Args args) {
    extern __shared__ __attribute__((aligned(16))) unsigned char lds_raw[];
    LAS unsigned char* lds0 = (LAS unsigned char*)lds_raw;
    const int tid0 = threadIdx.x; const int wave0 = __builtin_amdgcn_readfirstlane(tid0 >> 6);
    const int G0 = gridDim.x; const int bx0 = blockIdx.x;
    { volatile LAS unsigned* MISC = (volatile LAS unsigned*)(lds0 + MISC_OFF); const int tid = tid0;
    for (int u = tid; u < 256; u += 512) MISC[u] = 0u;
    __syncthreads();
    volatile LAS unsigned long long* ARGP = (volatile LAS unsigned long long*)(lds0 + MISC_OFF + 768);
    if (tid < 21) ARGP[tid] = (unsigned long long)args.in[tid];
    if (tid == 21) ARGP[21] = (unsigned long long)args.out;
    if (tid == 22) ARGP[22] = (unsigned long long)args.ws;
    __syncthreads(); }
#if MK_ONE_LAUNCH
    XcdBarrier bar = xcd_barrier_post((unsigned*)(args.ws + WS_CTL) + CW_BAR, (volatile LAS unsigned*)(lds0 + MISC_OFF) + 8);
#else
    XcdBarrier bar; bar.bar = nullptr; bar.x = 0; bar.st = nullptr;
#endif
    const int lo = args.ph_lo, hi_ = args.ph_hi;
    if (IN(0)) {
        const GAS int* positions = (const GAS int*)args.in[1]; GAS float* COSp = (GAS float*)(args.ws + WS_COS); GAS float* SINp = (GAS float*)(args.ws + WS_SIN);
        for (int i = bx0 * 512 + tid0; i < NTOK * 16; i += G0 * 512) { const int tk = i >> 4, fi = i & 15;
            const double invrev = exp2(-(double)fi * (13.287712379549449 / 16.0)) * 0.15915494309189535; const double rev = (double)positions[tk] * invrev; const float fr = (float)(rev - rint(rev));
            COSp[i] = __builtin_amdgcn_cosf(fr); SINp[i] = __builtin_amdgcn_sinf(fr); }
    }
    layer_body<0>(lo, hi_, lds0, wave0, G0, bx0, bar);
    layer_body<1>(lo, hi_, lds0, wave0, G0, bx0, bar);
    layer_body<2>(lo, hi_, lds0, wave0, G0, bx0, bar);
}

extern "C" void kernel_launch(void* const* d_in, const int* in_sizes, int n_in, void* d_out, int out_size, void* d_ws, size_t ws_size, hipStream_t stream) {
    static int grid = 0;
    if (grid == 0) {
        if (n_in != 21 || out_size != NTOK * DM || ws_size < WS_END) { fprintf(stderr, "kernel_launch: unexpected shapes (n_in %d out %d ws %zu)\n", n_in, out_size, ws_size); grid = -1; return; }
        int dev = 0, cus = 0;
        if (hipGetDevice(&dev) != hipSuccess || hipDeviceGetAttribute(&cus, hipDeviceAttributeMultiprocessorCount, dev) != hipSuccess) { grid = -1; return; }
        if (hipFuncSetAttribute((const void*)fwd, hipFuncAttributeMaxDynamicSharedMemorySize, LDS_BYTES) != hipSuccess) { fprintf(stderr, "kernel_launch: hipFuncSetAttribute failed\n"); grid = -1; return; }
        int per_cu = 0;
        if (hipOccupancyMaxActiveBlocksPerMultiprocessor(&per_cu, (const void*)fwd, 512, LDS_BYTES) != hipSuccess || per_cu < 1) fprintf(stderr, "kernel_launch: occupancy query says %d\n", per_cu);
        (void)hipGetLastError();
        grid = cus;
        if (grid != 256) { fprintf(stderr, "kernel_launch: built for 256 CUs, got %d\n", grid); grid = -1; return; }
    }
    if (grid < 0) return;
    if (hipMemsetAsync((char*)d_ws + WS_CTL, 0, CTL_ZERO_BYTES, stream) != hipSuccess) return;
    Args a{};
    for (int i = 0; i < 21; ++i) a.in[i] = d_in[i];
    a.out = (float*)d_out; a.ws = (unsigned char*)d_ws;
#if MK_ONE_LAUNCH
    a.ph_lo = 0; a.ph_hi = 21;
    hipLaunchKernelGGL(fwd, dim3(grid), dim3(512), LDS_BYTES, stream, a);
#else
    for (int p = 0; p <= 20; ++p) { a.ph_lo = p; a.ph_hi = p + 1; hipLaunchKernelGGL(fwd, dim3(grid), dim3(512), LDS_BYTES, stream, a); }
#endif
}
```

```cpp
#include <hip/hip_runtime.h>
#include <cstdio>
#include <cstdint>

#ifndef PROBE_PHASE
#define PROBE_PHASE -1
#endif
#ifndef PROBE_LAYER
#define PROBE_LAYER -1
#endif
#define NREP(k) (((PROBE_PHASE) == (k) && ((PROBE_LAYER) < 0 || (PROBE_LAYER) == l)) ? 2 : 1)
#ifndef MK_ONE_LAUNCH
#define MK_ONE_LAUNCH 1
#endif

#define LAS __attribute__((address_space(3)))
#define GAS __attribute__((address_space(1)))
typedef unsigned short bf16;
typedef short bf16x8 __attribute__((ext_vector_type(8)));
typedef short s16x4 __attribute__((ext_vector_type(4)));
typedef float f32x4 __attribute__((ext_vector_type(4)));
typedef float f32x2 __attribute__((ext_vector_type(2)));
typedef float f32x16 __attribute__((ext_vector_type(16)));
typedef unsigned u32x4 __attribute__((ext_vector_type(4)));
typedef unsigned u32x2 __attribute__((ext_vector_type(2)));

constexpr int NB = 16, SEQ = 2048, DM = 1024, NTOK = NB * SEQ, NLAYER = 2;
constexpr int INW = 1960, INP = 2048;
constexpr int NEXP = 32, DEXP = 512;
constexpr int MAXSLOT = 73728;
constexpr float EPS = 1e-6f;
constexpr float WSCALE = 64.f, WSCALE_INV = 1.f / 64.f;
constexpr float LOG2E = 1.4426950408889634f;
constexpr float C2F = 0.125f * LOG2E;
constexpr float C2M = 0.10206207261596575f * LOG2E;

constexpr size_t MiB = 1u << 20, KiB = 1u << 10;
constexpr size_t WS_CTL = 0, CTL_ZERO_BYTES = 64 * KiB;
constexpr size_t WS_COS = 1 * MiB, WS_SIN = 3 * MiB;
constexpr size_t WS_SSQ = 5 * MiB;
constexpr size_t WS_FLOG = 6 * MiB;
constexpr size_t WS_E01 = 8 * MiB;
constexpr size_t WS_G01 = 8 * MiB + 256 * KiB;
constexpr size_t WS_SLOT = 8 * MiB + 512 * KiB;
constexpr size_t WS_TOKOF = 8 * MiB + 768 * KiB;
constexpr size_t WS_GATEOF = 9 * MiB + 256 * KiB;
constexpr size_t WS_CNT = 9 * MiB + 768 * KiB;
constexpr size_t WS_TSTART = 9 * MiB + 800 * KiB;
constexpr size_t WS_RSTD = 9 * MiB + 832 * KiB;
constexpr size_t WS_RSTDOF = 7 * MiB;
constexpr size_t WS_KPE = 10 * MiB;
constexpr size_t WS_KAUG = 10 * MiB + 2 * MiB;
constexpr size_t WS_WIN = 16 * MiB;
constexpr size_t WS_WUQ = 20 * MiB;
constexpr size_t WS_WUKV = 20 * MiB + 512 * KiB;
constexpr size_t WS_WOUT = 21 * MiB;
constexpr size_t WS_WGU = 24 * MiB;
constexpr size_t WS_WD = 88 * MiB;
constexpr size_t WS_XN = 120 * MiB;
constexpr size_t WS_FQKV = 184 * MiB;
constexpr size_t WS_LAT = 280 * MiB;
constexpr size_t WS_QM = 312 * MiB;
constexpr size_t WS_KVM = 360 * MiB;
constexpr size_t WS_Y = 280 * MiB;
constexpr size_t WS_BIASF = 424 * MiB;
constexpr size_t WS_NRM = 425 * MiB;
constexpr size_t WS_WR = 426 * MiB;
constexpr size_t WS_XR = 427 * MiB;
constexpr size_t WS_OSS = 491 * MiB;
constexpr size_t WS_RSTDX = 493 * MiB;
constexpr size_t WS_END = 494 * MiB;
static_assert(WS_Y + (size_t)MAXSLOT * 1024 * 2 <= WS_END, "Y fits");
static_assert(WS_FQKV + (size_t)MAXSLOT * 512 * 2 <= WS_LAT, "HH fits");

constexpr int CW_BAR = 1024;

constexpr int RING_BYTES = 147456;
constexpr int MISC_OFF = RING_BYTES;
constexpr int LDS_BYTES = RING_BYTES + 1024;

typedef __bf16 bf16x2_t __attribute__((ext_vector_type(2)));
__device__ __forceinline__ unsigned cvt_pk_bf16(float lo, float hi) { const f32x2 v = {lo, hi}; const bf16x2_t b = __builtin_convertvector(v, bf16x2_t); return __builtin_bit_cast(unsigned, b); }
__device__ __forceinline__ float bf2f(unsigned short b) { return __uint_as_float((unsigned)b << 16); }
__device__ __forceinline__ float wave_sum(float v) {
#pragma unroll
    for (int o = 1; o < 64; o <<= 1) v += __shfl_xor(v, o);
    return v;
}
__device__ __forceinline__ unsigned pk4_fp8(float a, float b, float c, float d) { int w = 0; w = __builtin_amdgcn_cvt_pk_fp8_f32(a, b, w, false); w = __builtin_amdgcn_cvt_pk_fp8_f32(c, d, w, true); return (unsigned)w; }
#define LDS_WAIT() asm volatile("s_waitcnt lgkmcnt(0)" ::: "memory")

#define XB_TMO      128
#define XB_XCNT(j)  (256  + 64 * (j))
#define XB_XSUB(j)  (1280 + 64 * (j))
#define XB_XGEN(j)  (2304 + 64 * (j))
#define XB_TOP      3328
#define XB_TOPGEN   3392
#define XCD_BAR_WORDS 3456
#define XB_SPIN_CAP (1u << 18)
__device__ __forceinline__ unsigned xb_ld(unsigned* p)              { return __hip_atomic_load(p, __ATOMIC_RELAXED, __HIP_MEMORY_SCOPE_AGENT); }
__device__ __forceinline__ unsigned xb_add(unsigned* p, unsigned v) { return __hip_atomic_fetch_add(p, v, __ATOMIC_RELAXED, __HIP_MEMORY_SCOPE_AGENT); }
__device__ __forceinline__ unsigned xb_xcc_id() { return (unsigned)__builtin_amdgcn_s_getreg((3 << 11) | 20) & 0xFu; }
#define XB_SPIN(cond, bar) do { unsigned _sp = 0; while (cond) { __builtin_amdgcn_s_sleep(1); \
    if ((++_sp & 255u) == 0u) { if (xb_ld(&(bar)[XB_TMO])) break; if (_sp > XB_SPIN_CAP) { atomicAdd(&(bar)[XB_TMO], 1u); break; } } } } while (0)
struct XcdBarrier { unsigned* bar; unsigned x; volatile LAS unsigned* st; };
__device__ __forceinline__ XcdBarrier xcd_barrier_post(unsigned* bar, volatile LAS unsigned* st) {
    XcdBarrier b; b.bar = bar; b.x = xb_xcc_id(); b.st = st;
    if (threadIdx.x == 0) (void)xb_add(&bar[XB_XCNT(b.x)], 1u);
    return b;
}
__device__ __forceinline__ void xcd_barrier_complete(unsigned* bar, unsigned x, unsigned& nloc, unsigned& nx) {
    const unsigned G = gridDim.x * gridDim.y * gridDim.z;
    unsigned sum, cnt, mine, sp = 0u;
    for (;;) {
        sum = 0u; cnt = 0u; mine = 0u;
#pragma unroll
        for (unsigned j = 0; j < 16; ++j) { const unsigned c = xb_ld(&bar[XB_XCNT(j)]); sum += c; cnt += (c > 0u) ? 1u : 0u; mine = (j == x) ? c : mine; }
        if (sum == G) break;
        __builtin_amdgcn_s_sleep(1);
        if ((++sp & 255u) == 0u) { if (xb_ld(&bar[XB_TMO])) break; if (sp > XB_SPIN_CAP) { atomicAdd(&bar[XB_TMO], 1u); break; } }
    }
    nloc = mine > 0u ? mine : 1u; nx = cnt > 0u ? cnt : 1u;
}
__device__ __forceinline__ void xcd_barrier(const XcdBarrier& b) {
    asm volatile("s_waitcnt vmcnt(0)" ::: "memory");
    __syncthreads();
    if (threadIdx.x == 0) {
        unsigned* bar = b.bar;
        __builtin_amdgcn_s_waitcnt(0);
        unsigned nloc = b.st[0], nx = b.st[1];
        if (nloc == 0u) { xcd_barrier_complete(bar, b.x, nloc, nx); b.st[0] = nloc; b.st[1] = nx; }
        const unsigned old = xb_add(&bar[XB_XSUB(b.x)], 1u);
        const unsigned gen = old / nloc;
        if (old + 1u == (gen + 1u) * nloc) {
            __builtin_amdgcn_fence(__ATOMIC_RELEASE, "agent");
            asm volatile("s_waitcnt vmcnt(0)" ::: "memory");
            const unsigned og = xb_add(&bar[XB_TOP], 1u);
            const unsigned tg = og / nx;
            if (og + 1u == (tg + 1u) * nx) xb_add(&bar[XB_TOPGEN], 1u);
            else XB_SPIN(xb_ld(&bar[XB_TOPGEN]) == tg, bar);
            __builtin_amdgcn_fence(__ATOMIC_ACQUIRE, "agent");
            xb_add(&bar[XB_XGEN(b.x)], 1u);
            asm volatile("s_waitcnt vmcnt(0)" ::: "memory");
        } else {
            XB_SPIN(xb_ld(&bar[XB_XGEN(b.x)]) == gen, bar);
            __builtin_amdgcn_fence(__ATOMIC_ACQUIRE, "agent");
            asm volatile("s_waitcnt vmcnt(0)" ::: "memory");
        }
    }
    __syncthreads();
}

namespace pg8 {
constexpr int BM = 256, BK = 64, HALF = 128, HTB = HALF * BK * 2, STAGE_BYTES = 8 * HTB;
typedef int v4i32_t __attribute__((ext_vector_type(4)));
typedef int v8i32_t __attribute__((ext_vector_type(8)));
__host__ __device__ __forceinline__ int lds_byte(int r, int c) { const int st = (r >> 4) * 2 + (c >> 5), rr = r & 15, cc = c & 31, ob = rr * 64 + cc * 2; return st * 1024 + (ob ^ (((ob >> 9) & 1) << 5)); }
__host__ __device__ __forceinline__ void stage_rc(int b, int& R, int& C) { const int st = b / 1024, sb = b % 1024, swz = sb ^ (((sb >> 9) & 1) << 5); R = (st >> 1) * 16 + swz / 64; C = (st & 1) * 32 + (swz % 64) / 2; }
__host__ __device__ __forceinline__ int perm32(int rho) { const int n = rho >> 4, i = rho & 15; return 8 * (i >> 2) + 4 * n + (i & 3); }

struct Unit { const GAS char* a; const GAS char* b; int pm, pn, e; };

template <int N> __device__ __forceinline__ void wait_vm() { asm volatile("s_waitcnt vmcnt(%0)" :: "n"(N) : "memory"); }
template <class Epi, class Sched, bool ALIGN_EPI, bool GATHER, bool FP8 = false, bool MIDSCALE = false, bool VARK = false>
__device__ __forceinline__ void gemm_phase(const int tid, LAS unsigned char* lds, const int Kb, const int ldaB, const int ldbB, const Sched& S, const Epi& E, const GAS int* __restrict__ tokof, const LAS f32x2* scl = nullptr) {
    const int wid = __builtin_amdgcn_readfirstlane(tid >> 6), lane = tid & 63, wr = wid >> 2, wc = wid & 3, fr = lane & 15, fq = lane >> 4;
    const int nt = Kb / 128;
    unsigned voffA[2], voffB[2]; int RA[2], CA2[2];
#pragma unroll
    for (int i = 0; i < 2; ++i) { int R, C; stage_rc(tid * 16 + i * 8192, R, C); const int Rb = Epi::PERM ? ((R & ~31) + perm32(R & 31)) : R;
        voffA[i] = (unsigned)(R * ldaB + C * 2); voffB[i] = (unsigned)(Rb * ldbB + C * 2); RA[i] = R; CA2[i] = C * 2; }
    const size_t kstep = (size_t)(BK * 2);
    const size_t hstepA = GATHER ? 0 : (size_t)HALF * ldaB;
    const size_t hstepB = (size_t)HALF * ldbB;
    const unsigned ldsw = (unsigned)wid * 1024u;
    const int aoff = lds_byte(wr * 64 + fr, fq * 8), boff = lds_byte(wc * 32 + fr, fq * 8);
    unsigned gcur[2][2], gnxt[2][2];
    const int scl8 = 0x7F7F7F7F;
#define PG8_SA(b, h) (((b) * 2 + (h)) * HTB)
#define PG8_SB(b, h) ((4 + (b) * 2 + (h)) * HTB)
#define PG8_STAGE(bufoff, gbase, voff) do { const unsigned long long gb_ = (unsigned long long)(gbase); const unsigned lbase_ = (unsigned)__builtin_amdgcn_readfirstlane((int)((unsigned)(uintptr_t)lds + (unsigned)(bufoff) + ldsw)); \
        _Pragma("unroll") for (int _i = 0; _i < 2; ++_i) { unsigned keep_; \
            asm volatile("s_mov_b32 %0, m0\n\ts_mov_b32 m0, %3\n\ts_nop 0\n\tglobal_load_lds_dwordx4 %1, %2\n\ts_mov_b32 m0, %0" : "=&s"(keep_) : "v"((voff)[_i]), "s"(gb_), "s"(lbase_ + (unsigned)(_i * 8192)) : "memory"); } } while (0)
#define PG8_STAGE_A(bufoff, base, h, nx) do { if constexpr (GATHER) { unsigned _v[2]; _v[0] = (nx) ? gnxt[h][0] : gcur[h][0]; _v[1] = (nx) ? gnxt[h][1] : gcur[h][1]; PG8_STAGE(bufoff, base, _v); } \
        else { PG8_STAGE(bufoff, (base) + (h) * hstepA, voffA); } } while (0)
#define PG8_LDA(dst, b, h) do { _Pragma("unroll") for (int m = 0; m < 4; ++m) _Pragma("unroll") for (int k = 0; k < 2; ++k) dst[m][k] = *(const LAS bf16x8*)(lds + PG8_SA(b, h) + aoff + m * 2048 + k * 1024); } while (0)
#define PG8_LDB(dst, b, h) do { _Pragma("unroll") for (int n = 0; n < 2; ++n) _Pragma("unroll") for (int k = 0; k < 2; ++k) dst[n][k] = *(const LAS bf16x8*)(lds + PG8_SB(b, h) + boff + n * 2048 + k * 1024); } while (0)
#define PG8_MMA(ai, bj, At, Bt) do { __builtin_amdgcn_s_setprio(1); if constexpr (FP8) { _Pragma("unroll") for (int m = 0; m < 4; ++m) _Pragma("unroll") for (int n = 0; n < 2; ++n) { \
        const v8i32_t b8_ = __builtin_shufflevector(__builtin_bit_cast(v4i32_t, Bt[n][0]), __builtin_bit_cast(v4i32_t, Bt[n][1]), 0, 1, 2, 3, 4, 5, 6, 7), a8_ = __builtin_shufflevector(__builtin_bit_cast(v4i32_t, At[m][0]), __builtin_bit_cast(v4i32_t, At[m][1]), 0, 1, 2, 3, 4, 5, 6, 7); \
        asm volatile("s_nop 1\n\tv_mfma_scale_f32_16x16x128_f8f6f4 %0, %1, %2, %0, %3, %3 op_sel_hi:[0,0,0]" : "+v"(acc[ai][bj][m][n]) : "v"(b8_), "v"(a8_), "v"(scl8)); } } \
      else { _Pragma("unroll") for (int m = 0; m < 4; ++m) _Pragma("unroll") for (int n = 0; n < 2; ++n) _Pragma("unroll") for (int k = 0; k < 2; ++k) \
        acc[ai][bj][m][n] = __builtin_amdgcn_mfma_f32_16x16x32_bf16(Bt[n][k], At[m][k], acc[ai][bj][m][n], 0, 0, 0); } __builtin_amdgcn_s_setprio(0); } while (0)
#define PG8_MMA_Z(ai, bj, At, Bt) do { __builtin_amdgcn_s_setprio(1); if constexpr (FP8) { _Pragma("unroll") for (int m = 0; m < 4; ++m) _Pragma("unroll") for (int n = 0; n < 2; ++n) { \
        const v8i32_t b8_ = __builtin_shufflevector(__builtin_bit_cast(v4i32_t, Bt[n][0]), __builtin_bit_cast(v4i32_t, Bt[n][1]), 0, 1, 2, 3, 4, 5, 6, 7), a8_ = __builtin_shufflevector(__builtin_bit_cast(v4i32_t, At[m][0]), __builtin_bit_cast(v4i32_t, At[m][1]), 0, 1, 2, 3, 4, 5, 6, 7); \
        asm volatile("s_nop 1\n\tv_mfma_scale_f32_16x16x128_f8f6f4 %0, %1, %2, 0, %3, %3 op_sel_hi:[0,0,0]" : "=&v"(acc[ai][bj][m][n]) : "v"(b8_), "v"(a8_), "v"(scl8)); } } \
      __builtin_amdgcn_s_setprio(0); } while (0)
#define PG8_WAIT_V(n) asm volatile("s_waitcnt vmcnt(" #n ")" ::: "memory")
#define PG8_WAIT_L(n) asm volatile("s_waitcnt lgkmcnt(" #n ")" ::: "memory")
#define PG8_BAR __builtin_amdgcn_s_barrier()
#define PG8_SCHED __builtin_amdgcn_sched_barrier(0)
#define PG8_GLOAD(dst, u) do { if constexpr (GATHER) { _Pragma("unroll") for (int _h = 0; _h < 2; ++_h) _Pragma("unroll") for (int _i = 0; _i < 2; ++_i) \
        dst[_h][_i] = (unsigned)tokof[(u).pm * BM + _h * HALF + RA[_i]] * (unsigned)ldaB + (unsigned)CA2[_i]; } } while (0)
    Unit cur, nxt; int ui = 0;
    if (!S.next(0, cur)) return;
    PG8_GLOAD(gcur, cur);
    typename Epi::Pre pre = E.prefetch(cur, wr, fr);
    f32x4 acc[2][2][4][2];
#pragma unroll
    for (int a = 0; a < 2; ++a)
#pragma unroll
        for (int b = 0; b < 2; ++b)
#pragma unroll
            for (int m = 0; m < 4; ++m)
#pragma unroll
                for (int n = 0; n < 2; ++n) acc[a][b][m][n] = (f32x4){0.f, 0.f, 0.f, 0.f};
    bf16x8 At[4][2], B0[2][2], B1[2][2];
    const GAS char* cA = cur.a; const GAS char* cB = cur.b;
    PG8_STAGE(PG8_SB(0, 0), cB, voffB); PG8_STAGE(PG8_SB(0, 1), cB + hstepB, voffB); PG8_STAGE_A(PG8_SA(0, 0), cA, 0, false); PG8_STAGE_A(PG8_SA(0, 1), cA, 1, false);
    if (wr == 1) PG8_BAR;
    PG8_WAIT_V(2); PG8_BAR;
    PG8_STAGE(PG8_SB(1, 0), cB + kstep, voffB); PG8_STAGE_A(PG8_SA(1, 0), cA + kstep, 0, false); PG8_STAGE(PG8_SB(1, 1), cB + hstepB + kstep, voffB);
    PG8_WAIT_V(6); PG8_BAR;
    bool fresh = false;
    for (;;) {
        const bool has_next = S.next(ui + 1, nxt);
        if constexpr (GATHER) { if (has_next) { PG8_GLOAD(gnxt, nxt); } else { _Pragma("unroll") for (int _h = 0; _h < 2; ++_h) _Pragma("unroll") for (int _i = 0; _i < 2; ++_i) gnxt[_h][_i] = gcur[_h][_i]; } }
        const GAS char* nA = has_next ? nxt.a : cA; const GAS char* nB = has_next ? nxt.b : cB;
        const int ntu = VARK ? (cur.e ? nt / 2 : nt) : nt;
#pragma nounroll
        for (int t = 0; t < ntu; t += 2) {
            const bool last = (t == ntu - 2);
            const GAS char* a1 = cA + (size_t)(t + 1) * kstep;
            const GAS char* a2 = last ? nA : cA + (size_t)(t + 2) * kstep; const GAS char* b2 = last ? nB : cB + (size_t)(t + 2) * kstep;
            const GAS char* a3 = a2 + kstep; const GAS char* b3 = b2 + kstep;
            const bool fe = fresh; fresh = false;
            if constexpr (MIDSCALE) { if (t == nt / 2) {
#pragma unroll
                for (int ai = 0; ai < 2; ++ai)
#pragma unroll
                    for (int m = 0; m < 4; ++m) { const float r_ = scl[ui * 256 + ai * 128 + wr * 64 + m * 16 + fr][0];
#pragma unroll
                        for (int bj = 0; bj < 2; ++bj)
#pragma unroll
                            for (int n = 0; n < 2; ++n) acc[ai][bj][m][n] *= r_; } } }
            PG8_LDB(B0, 0, 0); PG8_LDB(B1, 0, 1); PG8_SCHED; PG8_LDA(At, 0, 0); PG8_STAGE_A(PG8_SA(1, 1), a1, 1, false);
            if (fe) wait_vm<8 + Epi::NST>(); else PG8_WAIT_V(8); PG8_WAIT_L(0); PG8_BAR; if (FP8 && t == 0) { PG8_MMA_Z(0, 0, At, B0); PG8_MMA_Z(0, 1, At, B1); } else { PG8_MMA(0, 0, At, B0); PG8_MMA(0, 1, At, B1); } PG8_BAR; PG8_SCHED;
            PG8_LDA(At, 0, 1); PG8_STAGE(PG8_SB(0, 0), b2, voffB); PG8_STAGE(PG8_SB(0, 1), b2 + hstepB, voffB); PG8_STAGE_A(PG8_SA(0, 0), a2, 0, last);
            if (fe) wait_vm<8 + Epi::NST>(); else PG8_WAIT_V(8); PG8_WAIT_L(0); PG8_BAR; if (FP8 && t == 0) { PG8_MMA_Z(1, 0, At, B0); PG8_MMA_Z(1, 1, At, B1); } else { PG8_MMA(1, 0, At, B0); PG8_MMA(1, 1, At, B1); } PG8_BAR; PG8_SCHED;
            PG8_LDB(B0, 1, 0); PG8_LDB(B1, 1, 1); PG8_SCHED; PG8_LDA(At, 1, 0); PG8_STAGE_A(PG8_SA(0, 1), a2, 1, last);
            PG8_WAIT_V(8); PG8_WAIT_L(0); PG8_BAR; PG8_MMA(0, 0, At, B0); PG8_MMA(0, 1, At, B1); PG8_BAR; PG8_SCHED;
            PG8_LDA(At, 1, 1); PG8_STAGE(PG8_SB(1, 0), b3, voffB); PG8_STAGE(PG8_SB(1, 1), b3 + hstepB, voffB); PG8_STAGE_A(PG8_SA(1, 0), a3, 0, last);
            PG8_WAIT_V(8); PG8_WAIT_L(0); PG8_BAR; PG8_MMA(1, 0, At, B0); PG8_MMA(1, 1, At, B1); PG8_BAR; PG8_SCHED;
        }
        if constexpr (ALIGN_EPI) { if (wr == 0) PG8_BAR; }
        if constexpr (FP8) {
            asm volatile("s_nop 15\n\ts_nop 15" ::: "memory");
#pragma unroll
            for (int a = 0; a < 2; ++a)
#pragma unroll
                for (int b = 0; b < 2; ++b)
                    asm volatile("" : "+v"(acc[a][b][0][0]), "+v"(acc[a][b][0][1]), "+v"(acc[a][b][1][0]), "+v"(acc[a][b][1][1]), "+v"(acc[a][b][2][0]), "+v"(acc[a][b][2][1]), "+v"(acc[a][b][3][0]), "+v"(acc[a][b][3][1])); }
        if constexpr (MIDSCALE) E(acc, cur, wr, wc, fr, fq, scl + ui * 256); else E(acc, cur, wr, wc, fr, fq, pre);
        if (!has_next) break;
        pre = E.prefetch(nxt, wr, fr);
        if constexpr (FP8) {
#pragma unroll
            for (int a = 0; a < 2; ++a)
#pragma unroll
                for (int b = 0; b < 2; ++b)
                    asm volatile("" : "=v"(acc[a][b][0][0]), "=v"(acc[a][b][0][1]), "=v"(acc[a][b][1][0]), "=v"(acc[a][b][1][1]), "=v"(acc[a][b][2][0]), "=v"(acc[a][b][2][1]), "=v"(acc[a][b][3][0]), "=v"(acc[a][b][3][1]));
        } else {
#pragma unroll
            for (int a = 0; a < 2; ++a)
#pragma unroll
                for (int b = 0; b < 2; ++b)
#pragma unroll
                    for (int m = 0; m < 4; ++m)
#pragma unroll
                        for (int n = 0; n < 2; ++n) acc[a][b][m][n] = (f32x4){0.f, 0.f, 0.f, 0.f};
        }
        cur = nxt; cA = nA; cB = nB; ++ui; fresh = true;
        if constexpr (GATHER) { _Pragma("unroll") for (int _h = 0; _h < 2; ++_h) _Pragma("unroll") for (int _i = 0; _i < 2; ++_i) gcur[_h][_i] = gnxt[_h][_i]; }
        if constexpr (ALIGN_EPI) { if (wr == 1) PG8_BAR; }
    }
    PG8_WAIT_V(0);
    if constexpr (!ALIGN_EPI) { if (wr == 0) PG8_BAR; }
    PG8_BAR;
#undef PG8_SA
#undef PG8_SB
#undef PG8_STAGE
#undef PG8_STAGE_A
#undef PG8_LDA
#undef PG8_LDB
#undef PG8_MMA
#undef PG8_MMA_Z
#undef PG8_WAIT_V
#undef PG8_WAIT_L
#undef PG8_BAR
#undef PG8_SCHED
#undef PG8_GLOAD
}
}
using pg8::Unit;

struct DenseOrder {
    int nM, nN, nwg, G, c; const GAS char* A; const GAS char* B; size_t aT, bT;
    __device__ __forceinline__ bool next(int i, Unit& u) const {
        const long L = (long)i * G + c; if (L >= nwg) return false;
        int wgid = (int)L; { const int q = nwg / 8, r = nwg % 8, xcd = wgid % 8, off = wgid / 8; wgid = (xcd < r ? xcd * (q + 1) : r * (q + 1) + (xcd - r) * q) + off; }
        const int nig = 8 * nN, gid = wgid / nig, fm = gid * 8, gsz = (nM - fm) < 8 ? (nM - fm) : 8;
        u.pm = fm + ((wgid % nig) % gsz); u.pn = (wgid % nig) / gsz; u.e = 0;
        u.a = A + (size_t)u.pm * aT; u.b = B + (size_t)u.pn * bT; return true;
    }
};
struct UpOrder {
    int G, c; const GAS char* LATp; const GAS char* Wq; const GAS char* Wkv;
    __device__ __forceinline__ bool next(int i, Unit& u) const {
        const int L = i * G + c; if (L >= 128 * 7) return false;
        u.pm = L / 7; const int j = L % 7; const bool kv = j >= 3; u.pn = kv ? j - 3 : j; u.e = kv ? 1 : 0;
        u.a = LATp + (size_t)u.pm * 256 * 512 * 2 + (kv ? 512 : 0);
        u.b = (kv ? Wkv : Wq) + (size_t)u.pn * 256 * 256 * 2; return true;
    }
};
struct MoeOrder {
    int G, c; const volatile LAS int* TS; const GAS char* A; const GAS char* W; size_t aT  , wE  , wT  ;
    __device__ __forceinline__ bool next(int i, Unit& u) const {
        const int L = i * G + c; const int ntile = __builtin_amdgcn_readfirstlane(TS[32]); if (L >= ntile * 4) return false;
        const int rt = L >> 2, ct = L & 3;
        const int ln_ = (int)__builtin_amdgcn_mbcnt_hi(~0u, __builtin_amdgcn_mbcnt_lo(~0u, 0u)); const int tsv_ = TS[ln_ & 31];
        const int e = __builtin_popcountll(__ballot(ln_ >= 1 && ln_ < 32 && tsv_ <= rt));
        u.pm = rt; u.pn = ct; u.e = e; u.a = A + (size_t)rt * aT; u.b = W + (size_t)e * wE + (size_t)ct * wT; return true;
    }
};

__device__ __forceinline__ u32x4 pack8(f32x4 v0, f32x4 v1) { u32x4 w; w.x = cvt_pk_bf16(v0[0], v0[1]); w.y = cvt_pk_bf16(v0[2], v0[3]); w.z = cvt_pk_bf16(v1[0], v1[1]); w.w = cvt_pk_bf16(v1[2], v1[3]); return w; }

struct EpiWin {
    static constexpr int NST = 16;
    static constexpr bool PERM = true;
    GAS bf16* LAT_; GAS bf16* FQKV_; GAS bf16* KPE_; GAS float* FLOG_; GAS float* SSQ_; const GAS float* COS_; const GAS float* SIN_; const GAS float* RSX_;
    struct Pre { float v[8]; };
    __device__ __forceinline__ Pre prefetch(const Unit& u, int wr, int fr) const { Pre p; const GAS float* RSX = RSX_; asm volatile("" : "+s"(RSX));
#pragma unroll
        for (int g = 0; g < 8; ++g) p.v[g] = RSX[u.pm * 256 + (g >> 2) * 128 + wr * 64 + (g & 3) * 16 + fr]; return p; }
    __device__ __forceinline__ void operator()(f32x4 (&acc)[2][2][4][2], const Unit& u, int wr, int wc, int fr, int fq, const Pre& pre) const {
        GAS bf16* LAT = LAT_; GAS bf16* FQKV = FQKV_; GAS bf16* KPE = KPE_; GAS float* FLOG = FLOG_; GAS float* SSQ = SSQ_; const GAS float* COS = COS_; const GAS float* SIN = SIN_; const GAS float* RSX = RSX_;
        asm volatile("" : "+s"(LAT), "+s"(FQKV), "+s"(KPE), "+s"(FLOG), "+s"(SSQ), "+s"(COS), "+s"(SIN), "+s"(RSX));
        {
#pragma unroll
            for (int ai = 0; ai < 2; ++ai)
#pragma unroll
                for (int m = 0; m < 4; ++m) { const float rs_ = pre.v[ai * 4 + m];
#pragma unroll
                    for (int bj = 0; bj < 2; ++bj)
#pragma unroll
                        for (int n = 0; n < 2; ++n) acc[ai][bj][m][n] *= rs_; } }
        const int row0 = u.pm * 256 + wr * 64 + fr; const int pn = u.pn;
        if (pn >= 2) {
            const int ti = pn >> 1; GAS bf16* dst = FQKV + (size_t)(ti - 1) * NTOK * 512; const int colb = (pn & 1) * 256 + wc * 32 + 8 * fq; const float sc = (ti == 1) ? C2F : 1.f;
#pragma unroll
            for (int ai = 0; ai < 2; ++ai)
#pragma unroll
                for (int m = 0; m < 4; ++m) { GAS bf16* rowp = dst + (size_t)(row0 + ai * 128 + m * 16) * 512 + colb;
#pragma unroll
                    for (int bj = 0; bj < 2; ++bj) *(GAS u32x4*)(rowp + bj * 128) = pack8(acc[ai][bj][m][0] * sc, acc[ai][bj][m][1] * sc); }
        } else {
#pragma unroll
            for (int ai = 0; ai < 2; ++ai)
#pragma unroll
                for (int m = 0; m < 4; ++m) { const int row = row0 + ai * 128 + m * 16; GAS bf16* rowp = LAT + (size_t)row * 512 + pn * 256 + wc * 32 + 8 * fq;
#pragma unroll
                    for (int bj = 0; bj < 2; ++bj) *(GAS u32x4*)(rowp + bj * 128) = pack8(acc[ai][bj][m][0], acc[ai][bj][m][1]);
                    float s = 0.f;
#pragma unroll
                    for (int n = 0; n < 2; ++n) { const f32x4 x = acc[ai][0][m][n]; s += (x[0] * x[0] + x[1] * x[1]) + (x[2] * x[2] + x[3] * x[3]); }
                    if (pn == 0) {
#pragma unroll
                        for (int n = 0; n < 2; ++n) { const f32x4 x = acc[ai][1][m][n]; s += (x[0] * x[0] + x[1] * x[1]) + (x[2] * x[2] + x[3] * x[3]); }
                    }
                    s += __shfl_xor(s, 16); s += __shfl_xor(s, 32);
                    if (fq == 0) SSQ[(size_t)row * 8 + pn * 4 + wc] = s;
                    }
            if (pn == 1 && wc == 0) {
#pragma unroll
                for (int ai = 0; ai < 2; ++ai)
#pragma unroll
                    for (int m = 0; m < 4; ++m) { const int row = row0 + ai * 128 + m * 16;
                        const f32x4 c = *(const GAS f32x4*)(COS + (size_t)row * 16 + 4 * fq), sn = *(const GAS f32x4*)(SIN + (size_t)row * 16 + 4 * fq);
                        const f32x4 x1 = acc[ai][1][m][0], x2 = acc[ai][1][m][1];
                        *(GAS u32x4*)(KPE + (size_t)row * 32 + 8 * fq) = pack8(x1 * c - x2 * sn, x1 * sn + x2 * c);
                        }
            }
            if (pn == 1 && wc == 1 && fq == 0) {
#pragma unroll
                for (int ai = 0; ai < 2; ++ai)
#pragma unroll
                    for (int m = 0; m < 4; ++m) { const int row = row0 + ai * 128 + m * 16; *(GAS f32x4*)(FLOG + (size_t)row * 8) = acc[ai][1][m][0]; *(GAS f32x4*)(FLOG + (size_t)row * 8 + 4) = acc[ai][1][m][1]; }
            }
        }
    }
};
struct EpiUp {
    static constexpr int NST = 16;
    static constexpr bool PERM = true;
    GAS bf16* QM_; GAS bf16* KVM_; const GAS float* SSQ_; const GAS float* COS_; const GAS float* SIN_;
    struct Pre { f32x4 v[8]; };
    __device__ __forceinline__ Pre prefetch(const Unit& u, int wr, int fr) const { Pre p; const GAS float* SSQ = SSQ_; asm volatile("" : "+s"(SSQ)); const int off = u.e ? 4 : 0;
#pragma unroll
        for (int g = 0; g < 8; ++g) p.v[g] = *(const GAS f32x4*)(SSQ + (size_t)(u.pm * 256 + (g >> 2) * 128 + wr * 64 + (g & 3) * 16 + fr) * 8 + off); return p; }
    __device__ __forceinline__ void operator()(const f32x4 (&acc)[2][2][4][2], const Unit& u, int wr, int wc, int fr, int fq, const Pre& pre) const {
        GAS bf16* QM = QM_; GAS bf16* KVM = KVM_; const GAS float* SSQ = SSQ_; const GAS float* COS = COS_; const GAS float* SIN = SIN_;
        asm volatile("" : "+s"(QM), "+s"(KVM), "+s"(SSQ), "+s"(COS), "+s"(SIN));
        const int row0 = u.pm * 256 + wr * 64 + fr; const int pn = u.pn; const bool kv = u.e != 0;
#pragma unroll
        for (int ai = 0; ai < 2; ++ai)
#pragma unroll
            for (int m = 0; m < 4; ++m) { const int row = row0 + ai * 128 + m * 16;
                const f32x4 sq = pre.v[ai * 4 + m];
                const float ss = (sq[0] + sq[1]) + (sq[2] + sq[3]);
                if (kv) {
                    const float rs = rsqrtf(ss * (1.f / 128.f) + EPS);
                    GAS bf16* rowp = KVM + (size_t)row * 1024 + pn * 256 + wc * 32 + 8 * fq;
#pragma unroll
                    for (int bj = 0; bj < 2; ++bj) *(GAS u32x4*)(rowp + bj * 128) = pack8(acc[ai][bj][m][0] * rs, acc[ai][bj][m][1] * rs);
                } else {
                    const float rs = rsqrtf(ss * (1.f / 256.f) + EPS) * C2M;
                    GAS bf16* rowp = QM + (size_t)row * 768 + pn * 256 + wc * 32 + 8 * fq;
                    const f32x4 c = *(const GAS f32x4*)(COS + (size_t)row * 16 + 4 * fq), sn = *(const GAS f32x4*)(SIN + (size_t)row * 16 + 4 * fq);
#pragma unroll
                    for (int bj = 0; bj < 2; ++bj) { f32x4 v0 = acc[ai][bj][m][0] * rs, v1 = acc[ai][bj][m][1] * rs;
                        const int G = 8 * pn + 4 * bj + wc;
                        if (G % 3 == 2) { const f32x4 x1 = v0, x2 = v1; v0 = x1 * c - x2 * sn; v1 = x1 * sn + x2 * c; }
                        *(GAS u32x4*)(rowp + bj * 128) = pack8(v0, v1); }
                }

            }
    }
};
template <bool RES_F32> struct EpiOut {
    static constexpr int NST = 16;
    static constexpr bool PERM = true;
    const GAS float* resf_; GAS bf16* xr_;
    struct Pre {}; __device__ __forceinline__ Pre prefetch(const Unit&, int, int) const { return Pre{}; }
    __device__ __forceinline__ void operator()(const f32x4 (&acc)[2][2][4][2], const Unit& u, int wr, int wc, int fr, int fq, const LAS f32x2* scl) const {
        const GAS float* resf = resf_; GAS bf16* xr = xr_; asm volatile("" : "+s"(resf), "+s"(xr));
        const int row0 = u.pm * 256 + wr * 64 + fr, col0 = u.pn * 256 + wc * 32 + 8 * fq;
#pragma unroll
        for (int ai = 0; ai < 2; ++ai)
#pragma unroll
            for (int m = 0; m < 4; ++m) { const size_t off = (size_t)(row0 + ai * 128 + m * 16) * DM + col0; const float sh = scl[ai * 128 + wr * 64 + m * 16 + fr][1];
#pragma unroll
                for (int bj = 0; bj < 2; ++bj) { f32x4 r0, r1;
                    if constexpr (RES_F32) { r0 = *(const GAS f32x4*)(resf + off + bj * 128); r1 = *(const GAS f32x4*)(resf + off + bj * 128 + 4); }
                    else { const u32x4 w = *(const GAS u32x4*)(xr + off + bj * 128);
                        r0 = (f32x4){__uint_as_float(w.x << 16), __uint_as_float(w.x & 0xffff0000u), __uint_as_float(w.y << 16), __uint_as_float(w.y & 0xffff0000u)};
                        r1 = (f32x4){__uint_as_float(w.z << 16), __uint_as_float(w.z & 0xffff0000u), __uint_as_float(w.w << 16), __uint_as_float(w.w & 0xffff0000u)}; }
                    *(GAS u32x4*)(xr + off + bj * 128) = pack8(r0 + acc[ai][bj][m][0] * sh, r1 + acc[ai][bj][m][1] * sh); } }
    }
};
struct EpiGU {
    static constexpr int NST = 8;
    static constexpr bool PERM = true;
    GAS unsigned char* HH_; const GAS float* RS_;
    struct Pre { float v[8]; };
    __device__ __forceinline__ Pre prefetch(const Unit& u, int wr, int fr) const { Pre p; const GAS float* RS = RS_; asm volatile("" : "+s"(RS));
#pragma unroll
        for (int g = 0; g < 8; ++g) p.v[g] = RS[u.pm * 256 + (g >> 2) * 128 + wr * 64 + (g & 3) * 16 + fr]; return p; }
    __device__ __forceinline__ void operator()(const f32x4 (&acc)[2][2][4][2], const Unit& u, int wr, int wc, int fr, int fq, const Pre& pre) const {
        GAS unsigned char* HH = HH_; const GAS float* RS = RS_; asm volatile("" : "+s"(HH), "+s"(RS));
        const int row0 = u.pm * 256 + wr * 64 + fr;
#pragma unroll
        for (int ai = 0; ai < 2; ++ai)
#pragma unroll
            for (int m = 0; m < 4; ++m) { GAS unsigned char* rowp = HH + (size_t)(row0 + ai * 128 + m * 16) * 512 + u.pn * 128 + wc * 32 + 8 * fq; const float rs = pre.v[ai * 4 + m] * WSCALE_INV;
                f32x4 h[2];
#pragma unroll
                for (int n = 0; n < 2; ++n) { const f32x4 g = acc[ai][0][m][n] * rs, up = acc[ai][1][m][n] * rs;
#pragma unroll
                    for (int j = 0; j < 4; ++j) { const float sg = __builtin_amdgcn_rcpf(1.f + __builtin_amdgcn_exp2f(-g[j] * LOG2E)); h[n][j] = g[j] * sg * up[j]; } }
                u32x2 w; w.x = pk4_fp8(h[0][0], h[0][1], h[0][2], h[0][3]); w.y = pk4_fp8(h[1][0], h[1][1], h[1][2], h[1][3]); *(GAS u32x2*)rowp = w; }
    }
};
struct EpiDown {
    static constexpr int NST = 16;
    static constexpr bool PERM = true;
    GAS unsigned char* Y_; const GAS float* GATEOF_;
    struct Pre { float v[8]; };
    __device__ __forceinline__ Pre prefetch(const Unit& u, int wr, int fr) const { Pre p; const GAS float* GT = GATEOF_; asm volatile("" : "+s"(GT));
#pragma unroll
        for (int g = 0; g < 8; ++g) p.v[g] = GT[u.pm * 256 + (g >> 2) * 128 + wr * 64 + (g & 3) * 16 + fr]; return p; }
    __device__ __forceinline__ void operator()(const f32x4 (&acc)[2][2][4][2], const Unit& u, int wr, int wc, int fr, int fq, const Pre& pre) const {
        GAS unsigned char* Y = Y_; const GAS float* GATEOF = GATEOF_; asm volatile("" : "+s"(Y), "+s"(GATEOF));
        const int row0 = u.pm * 256 + wr * 64 + fr;
#pragma unroll
        for (int ai = 0; ai < 2; ++ai)
#pragma unroll
            for (int m = 0; m < 4; ++m) { const int row = row0 + ai * 128 + m * 16; const float g = pre.v[ai * 4 + m]; GAS unsigned char* rowp = Y + (size_t)row * 1024 + u.pn * 256 + wc * 32 + 8 * fq;
#pragma unroll
                for (int bj = 0; bj < 2; ++bj) { const f32x4 v0 = acc[ai][bj][m][0] * g, v1 = acc[ai][bj][m][1] * g; u32x2 w; w.x = pk4_fp8(v0[0], v0[1], v0[2], v0[3]); w.y = pk4_fp8(v1[0], v1[1], v1[2], v1[3]); *(GAS u32x2*)(rowp + bj * 128) = w; } }
    }
};

namespace att {
constexpr int KSLOT = 12288, VSLOT = 8192;
constexpr int L_K = 0, L_V = 2 * KSLOT, L_BIAS = L_V + 2 * VSLOT, L_WS = L_BIAS + 8192, L_OST = L_WS + 8 * 64 * 4, L_END = L_OST + 8 * 4096;
__device__ __forceinline__ int crow(int r, int hi) { return (r & 3) + 8 * (r >> 2) + 4 * hi; }
typedef short v4i16_t __attribute__((ext_vector_type(4)));
__device__ __forceinline__ s16x4 vtr(const LAS char* p) { return __builtin_bit_cast(s16x4, __builtin_amdgcn_ds_read_tr16_b64_v4i16((LAS v4i16_t*)p)); }

constexpr int NSL = 5;
constexpr int R_K = 0, R_V = NSL * KSLOT, R_WS = R_V + NSL * VSLOT, R_OST = R_WS + 8 * 64 * 4, R_END = R_OST + 8 * 4096;
static_assert(R_END <= RING_BYTES, "attention LDS");
__device__ __forceinline__ void glds16(const GAS void* gsrc, unsigned lds_dst) { unsigned keep;
    asm volatile("s_mov_b32 %0, m0\n\ts_mov_b32 m0, %2\n\ts_nop 0\n\tglobal_load_lds_dwordx4 %1, off\n\ts_mov_b32 m0, %0" : "=&s"(keep) : "v"(gsrc), "s"(lds_dst) : "memory"); }
__device__ __forceinline__ void glds16s(const GAS void* sbase, unsigned voff, unsigned lds_dst) { unsigned keep;
    asm volatile("s_mov_b32 %0, m0\n\ts_mov_b32 m0, %3\n\ts_nop 0\n\tglobal_load_lds_dwordx4 %1, %2\n\ts_mov_b32 m0, %0" : "=&s"(keep) : "v"(voff), "s"((unsigned long long)sbase), "s"(lds_dst) : "memory"); }
struct Tens2 { const GAS bf16* Q; int qp; const GAS bf16* K; int kp; const GAS bf16* KX; const GAS bf16* V; int vp; GAS bf16* O; const GAS float* BIASF; const GAS float* NRM; GAS float* OSS; };
template <int MODE>
__device__ __forceinline__ int attn_unit2(const int wave_, int b, int h, int qb, const Tens2& T, LAS char* shm, const int slbase, const bool have_pro, const int qb_next, bf16x8 (&qr)[6], const int tstart) {
    constexpr int DKS = MODE ? 6 : 5, DKH = 3;
    constexpr float THR = 8.f;
    int wid = wave_; asm volatile("" : "+s"(wid));
    int lane = (int)__builtin_amdgcn_mbcnt_hi(~0u, __builtin_amdgcn_mbcnt_lo(~0u, 0u)); asm volatile("" : "+v"(lane)); const int r32 = lane & 31, hi = lane >> 5;
    const long rowbase = (long)b * SEQ; const int q0 = qb * 256, qw0 = q0 + wid * 32;
    const int NT = (q0 + 256) / 64, tlast = qw0 / 64;
    const int NTE = NT - tstart;
    const GAS bf16* Qw = T.Q + (rowbase + qw0) * T.qp + h * (MODE ? 96 : 64);
    const GAS bf16* Kh = T.K + rowbase * T.kp + h * (MODE ? 128 : 64);
    const GAS bf16* Vh = T.V + rowbase * T.vp + h * (MODE ? 128 : 64);
    LAS float* wsf = (LAS float*)(shm + R_WS) + wid * 64;
    const unsigned koff = (unsigned)(lane * T.kp + wid * 8) * 2u;
    const unsigned xoff = MODE ? (unsigned)(lane * 32 + (wid & 3) * 8) * 2u : (unsigned)(lane * 8) * 2u;
    const unsigned voff = (unsigned)((16 * (wid & 3) + (lane >> 2)) * T.vp + (wid >> 2) * 32 + (lane & 3) * 8) * 2u;
    const GAS bf16* xbase = MODE ? T.KX + rowbase * 32 : T.KX + ((long)b * 8 + h) * SEQ * 8;
    const int xstep = MODE ? 64 * 32 : 64 * 8;
    const unsigned kdst_a = (unsigned)(uintptr_t)(shm + R_K) + (unsigned)wid * 1024u, xdst_a = (unsigned)(uintptr_t)(shm + R_K) + (unsigned)(8 + (MODE ? (wid & 3) : 0)) * 1024u, vdst_a = (unsigned)(uintptr_t)(shm + R_V) + (unsigned)wid * 1024u;
#define A2_DMA(t, slot) do { \
        glds16s((const GAS void*)(Kh + (long)(t) * 64 * T.kp), koff, (unsigned)__builtin_amdgcn_readfirstlane((int)(kdst_a + (slot) * KSLOT))); \
        glds16s((const GAS void*)(xbase + (long)(t) * xstep), xoff, (unsigned)__builtin_amdgcn_readfirstlane((int)(xdst_a + (slot) * KSLOT))); \
        glds16s((const GAS void*)(Vh + (long)(t) * 64 * T.vp), voff, (unsigned)__builtin_amdgcn_readfirstlane((int)(vdst_a + (slot) * VSLOT))); } while (0)
    float mhat = 0.f, lrun = 0.f; f32x16 o[2]; o[0] = f32x16{}; o[1] = f32x16{}; f32x16 negm = f32x16{};
    const LAS char* vp0 = shm + R_V + ((lane >> 4) & 1) * 32 + (lane & 3) * 8 + (4 * hi + ((lane & 15) >> 2)) * 64;
#define A3_SLOT(k) ((slbase + (k)) % NSL)
    if (!have_pro) { A2_DMA(NT - 1, A3_SLOT(0)); A2_DMA(NT - 2, A3_SLOT(1)); A2_DMA(NT - 3, A3_SLOT(2)); }
    if (!have_pro) {
#pragma unroll
        for (int d0 = 0; d0 < (MODE ? 6 : 4); ++d0) qr[d0] = *(const GAS bf16x8*)(Qw + (long)r32 * T.qp + d0 * 16 + hi * 8); }
    if (MODE == 0) { const short one = hi ? (short)0 : (short)0x3F80; qr[DKS - 1] = (bf16x8){one, one, one, 0, 0, 0, 0, 0}; }
#pragma unroll
    for (int d0 = 0; d0 < DKS; ++d0) asm volatile("" : "+v"(qr[d0]));
#define A3_KLOADH(slot, H) do { const LAS char* kb_ = shm + R_K + (slot) * KSLOT + r32 * 16; _Pragma("unroll") for (int d0 = (H) * DKH; d0 < ((H) ? DKS : DKH); ++d0) { const int off = (MODE == 0 && d0 == 4) ? 8 * 1024 : d0 * 2048 + hi * 1024; \
        kf[2 * (d0 - (H) * DKH)] = *(const LAS bf16x8*)(kb_ + off); kf[2 * (d0 - (H) * DKH) + 1] = *(const LAS bf16x8*)(kb_ + off + 512); } } while (0)
#define A3_VLOAD(slot) do { const LAS char* vp_ = vp0 + (slot) * VSLOT; _Pragma("unroll") for (int q = 0; q < 8; ++q) { vlo[q] = vtr(vp_ + (q >> 2) * 4096 + (q & 3) * 1024); vhh[q] = vtr(vp_ + (q >> 2) * 4096 + (q & 3) * 1024 + 512); } } while (0)
#define A3_QKH(H) do { if ((H) == 0) { c0 = negm; c1 = negm; } _Pragma("unroll") for (int d0 = (H) * DKH; d0 < ((H) ? DKS : DKH); ++d0) { c0 = __builtin_amdgcn_mfma_f32_32x32x16_bf16(kf[2 * (d0 - (H) * DKH)], qr[d0], c0, 0, 0, 0); c1 = __builtin_amdgcn_mfma_f32_32x32x16_bf16(kf[2 * (d0 - (H) * DKH) + 1], qr[d0], c1, 0, 0, 0); } } while (0)
#define A3_EXP() do { float ls_ = 0.f; _Pragma("unroll") for (int r = 0; r < 16; ++r) { pp0[r] = __builtin_amdgcn_exp2f(pp0[r]); pp1[r] = __builtin_amdgcn_exp2f(pp1[r]); ls_ += pp0[r] + pp1[r]; } lrun += ls_; u32x4 w_; \
        w_.x = cvt_pk_bf16(pp0[0], pp0[1]); w_.y = cvt_pk_bf16(pp0[2], pp0[3]); w_.z = cvt_pk_bf16(pp0[4], pp0[5]); w_.w = cvt_pk_bf16(pp0[6], pp0[7]); pa[0] = __builtin_bit_cast(bf16x8, w_); \
        w_.x = cvt_pk_bf16(pp0[8], pp0[9]); w_.y = cvt_pk_bf16(pp0[10], pp0[11]); w_.z = cvt_pk_bf16(pp0[12], pp0[13]); w_.w = cvt_pk_bf16(pp0[14], pp0[15]); pa[1] = __builtin_bit_cast(bf16x8, w_); \
        w_.x = cvt_pk_bf16(pp1[0], pp1[1]); w_.y = cvt_pk_bf16(pp1[2], pp1[3]); w_.z = cvt_pk_bf16(pp1[4], pp1[5]); w_.w = cvt_pk_bf16(pp1[6], pp1[7]); pa[2] = __builtin_bit_cast(bf16x8, w_); \
        w_.x = cvt_pk_bf16(pp1[8], pp1[9]); w_.y = cvt_pk_bf16(pp1[10], pp1[11]); w_.z = cvt_pk_bf16(pp1[12], pp1[13]); w_.w = cvt_pk_bf16(pp1[14], pp1[15]); pa[3] = __builtin_bit_cast(bf16x8, w_); } while (0)
#define A3_PV() do { _Pragma("unroll") for (int d0 = 0; d0 < 2; ++d0) _Pragma("unroll") for (int k = 0; k < 4; ++k) { const s16x4 lo_ = vlo[4 * d0 + k], hh_ = vhh[4 * d0 + k]; \
        const bf16x8 vf_ = (bf16x8){lo_[0], lo_[1], lo_[2], lo_[3], hh_[0], hh_[1], hh_[2], hh_[3]}; o[d0] = __builtin_amdgcn_mfma_f32_32x32x16_bf16(pa[k], vf_, o[d0], 0, 0, 0); } } while (0)
#define A3_ROWMAX(rm) do { float a_ = fmaxf(fmaxf(c0[0], c0[1]), c1[0]), b_ = fmaxf(fmaxf(c0[2], c0[3]), c1[1]); a_ = fmaxf(fmaxf(a_, c1[2]), c1[3]); \
        _Pragma("unroll") for (int r = 4; r < 16; r += 4) { a_ = fmaxf(fmaxf(a_, c0[r]), c0[r + 1]); b_ = fmaxf(fmaxf(b_, c0[r + 2]), c0[r + 3]); a_ = fmaxf(fmaxf(a_, c1[r]), c1[r + 1]); b_ = fmaxf(fmaxf(b_, c1[r + 2]), c1[r + 3]); } \
        rm = fmaxf(a_, b_); const auto rr_ = __builtin_amdgcn_permlane32_swap(__float_as_uint(rm), __float_as_uint(rm), false, false); rm = fmaxf(__uint_as_float(rr_[0]), __uint_as_float(rr_[1])); } while (0)
    int sl = A3_SLOT(0), sl3 = A3_SLOT(3);
    f32x16 pp0 = f32x16{}, pp1 = f32x16{}; bool pend = false; int pslot = 0;
    for (int i = 0; i < NTE; ++i) {
        const int t = NT - 1 - i;
        { const int ahead = NTE - 1 - i;
          if (ahead >= 2) asm volatile("s_waitcnt vmcnt(6)" ::: "memory"); else if (ahead == 1) asm volatile("s_waitcnt vmcnt(3)" ::: "memory"); else asm volatile("s_waitcnt vmcnt(0)" ::: "memory"); }
        __builtin_amdgcn_s_barrier(); asm volatile("" ::: "memory");
        if (i + 3 < NTE) A2_DMA(t - 3, sl3);
        if (i == NTE - 1 && qb_next >= 0) { const int NTn = 4 * qb_next + 4; A2_DMA(NTn - 1, A3_SLOT(NTE)); A2_DMA(NTn - 2, A3_SLOT(NTE + 1)); A2_DMA(NTn - 3, A3_SLOT(NTE + 2)); }
        if (t <= tlast) {
            bf16x8 kf[2 * DKH]; f32x16 c0, c1; float rm;
            A3_KLOADH(sl, 0);
            if (!pend) {
                A3_QKH(0); A3_KLOADH(sl, 1); A3_QKH(1);
                if (MODE == 0) { const int qrel = qw0 + r32 - 64 * t;
#pragma unroll
                    for (int r = 0; r < 16; ++r) { const int kv = crow(r, hi); if (kv > qrel) c0[r] = -INFINITY; if (kv + 32 > qrel) c1[r] = -INFINITY; } }
                A3_ROWMAX(rm);
                mhat = rm;
#pragma unroll
                for (int r = 0; r < 16; ++r) { c0[r] -= rm; c1[r] -= rm; negm[r] = -mhat; }
                pend = true;
            } else {
                s16x4 vlo[8], vhh[8]; bf16x8 pa[4];
                A3_QKH(0); A3_KLOADH(sl, 1);
                A3_VLOAD(pslot);
                A3_QKH(1);
                A3_EXP();
#pragma unroll
                for (int g_ = 0; g_ < 2 * DKS; ++g_) { __builtin_amdgcn_sched_group_barrier(0x008, 1, 0); __builtin_amdgcn_sched_group_barrier(0x002, 7, 0); }
                A3_PV();
                A3_ROWMAX(rm);
#pragma unroll
                for (int g_ = 0; g_ < 8; ++g_) { __builtin_amdgcn_sched_group_barrier(0x008, 1, 0); __builtin_amdgcn_sched_group_barrier(0x002, 3, 0); }
                if (__any(rm > THR)) {
                    const float dl = fmaxf(rm, 0.f); mhat += dl;
#pragma unroll
                    for (int r = 0; r < 16; ++r) { c0[r] -= dl; c1[r] -= dl; negm[r] = -mhat; }
                    const float f = __builtin_amdgcn_exp2f(-dl); lrun *= f;
                    if (hi == 0) wsf[r32] = f;
                    LDS_WAIT();
#pragma unroll
                    for (int g = 0; g < 4; ++g) { const f32x4 ff = *(const LAS f32x4*)(wsf + 8 * g + 4 * hi);
#pragma unroll
                        for (int j = 0; j < 4; ++j) { o[0][4 * g + j] *= ff[j]; o[1][4 * g + j] *= ff[j]; } }
                }
            }
            pp0 = c0; pp1 = c1; pslot = sl;
        }
        sl = (sl == NSL - 1) ? 0 : sl + 1; sl3 = (sl3 == NSL - 1) ? 0 : sl3 + 1;
    }
    if (qb_next >= 0) { const GAS bf16* Qn = T.Q + (rowbase + qb_next * 256 + wid * 32) * T.qp + h * (MODE ? 96 : 64);
#pragma unroll
        for (int d0 = 0; d0 < (MODE ? 6 : 4); ++d0) qr[d0] = *(const GAS bf16x8*)(Qn + (long)r32 * T.qp + d0 * 16 + hi * 8); }
    if (pend) { s16x4 vlo[8], vhh[8]; bf16x8 pa[4]; A3_VLOAD(pslot); A3_EXP(); A3_PV(); }
#undef A3_KLOADH
#undef A3_VLOAD
#undef A3_QKH
#undef A3_EXP
#undef A3_PV
#undef A3_ROWMAX
#undef A2_DMA
    lrun += __shfl_xor(lrun, 32);
    LDS_WAIT();
    if (hi == 0) wsf[32 + r32] = lrun;
    LDS_WAIT();
    float rli[16];
#pragma unroll
    for (int g = 0; g < 4; ++g) { const f32x4 ll = *(const LAS f32x4*)(wsf + 32 + 8 * g + 4 * hi);
#pragma unroll
        for (int j = 0; j < 4; ++j) rli[4 * g + j] = __builtin_amdgcn_rcpf(ll[j]); }
    GAS bf16* Ow = T.O + (rowbase + qw0) * 1024 + (MODE ? 0 : 512) + h * 64;
    { LAS bf16* stg = (LAS bf16*)(shm + R_OST) + wid * 2048;
#pragma unroll
      for (int r = 0; r < 16; ++r) { const int orow = crow(r, hi);
#pragma unroll
          for (int d0 = 0; d0 < 2; ++d0) stg[orow * 64 + d0 * 32 + r32] = (bf16)(cvt_pk_bf16(o[d0][r] * rli[r], 0.f) & 0xffffu); }
      LDS_WAIT();
#pragma unroll
      for (int i = 0; i < 4; ++i) { const int row = i * 8 + (lane >> 3), ch = lane & 7; const u32x4 v = *(const LAS u32x4*)(stg + row * 64 + ch * 8); *(GAS u32x4*)(Ow + (long)row * 1024 + ch * 8) = v;
          float sq = 0.f;
#pragma unroll
          for (int j = 0; j < 4; ++j) { const float a0 = __uint_as_float(v[j] << 16), a1 = __uint_as_float(v[j] & 0xffff0000u); sq += a0 * a0 + a1 * a1; }
          sq += __shfl_xor(sq, 1); sq += __shfl_xor(sq, 2); sq += __shfl_xor(sq, 4);
          if (ch == 0) T.OSS[(rowbase + qw0 + row) * 16 + (MODE ? 0 : 8) + h] = sq; } }
    if (qb_next < 0) { LDS_WAIT(); __builtin_amdgcn_s_barrier(); asm volatile("" ::: "memory"); }
    return A3_SLOT(NTE);
#undef A3_SLOT
}
}

struct Args { const void* in[21]; float* out; unsigned char* ws; int ph_lo, ph_hi; };

__device__ __forceinline__ void tr_item(const GAS float* __restrict__ W, int ldw, int Ksrc, const GAS float* __restrict__ gain, GAS bf16* __restrict__ WT, int ldk, int k0, int n0, int srccol, LAS float* scr, int lane) {
#pragma unroll 8
    for (int i = 0; i < 32; ++i) { const int kk = 2 * i + (lane >> 5); const int k = k0 + kk;
        float v = 0.f; if (srccol >= 0 && k < Ksrc) { v = __builtin_nontemporal_load(W + (size_t)k * ldw + srccol); if (gain) v *= gain[k]; }
        scr[kk * 33 + (lane & 31)] = v; }
    LDS_WAIT(); asm volatile("" ::: "memory");
    const int c = lane & 7;
#pragma unroll
    for (int j = 0; j < 4; ++j) { const int n = (lane >> 3) + 8 * j; const LAS float* s = scr + (8 * c) * 33 + n;
        u32x4 o; o.x = cvt_pk_bf16(s[0 * 33], s[1 * 33]); o.y = cvt_pk_bf16(s[2 * 33], s[3 * 33]); o.z = cvt_pk_bf16(s[4 * 33], s[5 * 33]); o.w = cvt_pk_bf16(s[6 * 33], s[7 * 33]);
        *(GAS u32x4*)(WT + (size_t)(n0 + n) * ldk + k0 + 8 * c) = o; }
    LDS_WAIT(); asm volatile("" ::: "memory");
}
__device__ __forceinline__ void tr_item64(const GAS float* __restrict__ W, int ldw, const GAS float* __restrict__ gain, GAS bf16* __restrict__ WT, int ldk, int k0, int n0src, int n0dst, LAS float* scr, int lane) {
    const int rr = lane >> 4, c4 = (lane & 15) * 4;
    f32x4 v[16];
#pragma unroll
    for (int i = 0; i < 16; ++i) v[i] = __builtin_nontemporal_load((const GAS f32x4*)(W + (size_t)(k0 + 4 * i + rr) * ldw + n0src + c4));
#pragma unroll
    for (int i = 0; i < 16; ++i) { const int k = 4 * i + rr; const float g = gain ? gain[k0 + k] : 1.f; LAS float* d = scr + k * 65 + c4;
        d[0] = v[i][0] * g; d[1] = v[i][1] * g; d[2] = v[i][2] * g; d[3] = v[i][3] * g; }
    LDS_WAIT(); asm volatile("" ::: "memory");
    const int kc = lane & 7;
#pragma unroll
    for (int j = 0; j < 8; ++j) { const int n = (lane >> 3) + 8 * j; const LAS float* sp = scr + (8 * kc) * 65 + n;
        u32x4 o; o.x = cvt_pk_bf16(sp[0 * 65], sp[1 * 65]); o.y = cvt_pk_bf16(sp[2 * 65], sp[3 * 65]); o.z = cvt_pk_bf16(sp[4 * 65], sp[5 * 65]); o.w = cvt_pk_bf16(sp[6 * 65], sp[7 * 65]);
        *(GAS u32x4*)(WT + (size_t)(n0dst + n) * ldk + k0 + 8 * kc) = o; }
    LDS_WAIT(); asm volatile("" ::: "memory");
}
__device__ __forceinline__ void tr_item64_f8(const GAS float* __restrict__ W, int ldw, const GAS float* __restrict__ gain, float scale, GAS unsigned char* __restrict__ WT8, int ldkB, int k0, int n0src, int n0dst, LAS float* scr, int lane) {
    const int rr = lane >> 4, c4 = (lane & 15) * 4;
    f32x4 v[16];
#pragma unroll
    for (int i = 0; i < 16; ++i) v[i] = __builtin_nontemporal_load((const GAS f32x4*)(W + (size_t)(k0 + 4 * i + rr) * ldw + n0src + c4));
#pragma unroll
    for (int i = 0; i < 16; ++i) { const int k = 4 * i + rr; const float g = (gain ? gain[k0 + k] : 1.f) * scale; LAS float* d = scr + k * 65 + c4;
        d[0] = v[i][0] * g; d[1] = v[i][1] * g; d[2] = v[i][2] * g; d[3] = v[i][3] * g; }
    LDS_WAIT(); asm volatile("" ::: "memory");
    const int kc = lane & 7;
#pragma unroll
    for (int j = 0; j < 8; ++j) { const int n = (lane >> 3) + 8 * j; const LAS float* sp = scr + (8 * kc) * 65 + n;
        u32x2 o; o.x = pk4_fp8(sp[0 * 65], sp[1 * 65], sp[2 * 65], sp[3 * 65]); o.y = pk4_fp8(sp[4 * 65], sp[5 * 65], sp[6 * 65], sp[7 * 65]);
        *(GAS u32x2*)(WT8 + (size_t)(n0dst + n) * ldkB + k0 + 8 * kc) = o; }
    LDS_WAIT(); asm volatile("" ::: "memory");
}
__device__ __forceinline__ int rope_dim(int p) { const int a = p >> 3, j = p & 7; return j < 4 ? 4 * a + j : 16 + 4 * a + (j - 4); }

#define LDP(i) ((void*)((((unsigned long long)(unsigned)__builtin_amdgcn_readfirstlane((int)(ARGP[i] >> 32))) << 32) | (unsigned long long)(unsigned)__builtin_amdgcn_readfirstlane((int)(unsigned)ARGP[i])))
#define ARGIN(i) ((const void*)LDP(i))
#define P_COS ((GAS float*)(ws + WS_COS))
#define P_SIN ((GAS float*)(ws + WS_SIN))
#define P_SSQ ((GAS float*)(ws + WS_SSQ))
#define P_FLOG ((GAS float*)(ws + WS_FLOG))
#define P_E01 ((GAS int*)(ws + WS_E01))
#define P_G01 ((GAS float*)(ws + WS_G01))
#define P_SLOT ((GAS int*)(ws + WS_SLOT))
#define P_TOKOF ((GAS int*)(ws + WS_TOKOF))
#define P_GATEOF ((GAS float*)(ws + WS_GATEOF))
#define P_CNT ((GAS int*)(ws + WS_CNT))
#define P_TSTART ((GAS int*)(ws + WS_TSTART))
#define P_RSTD ((GAS float*)(ws + WS_RSTD))
#define P_RSTDOF ((GAS float*)(ws + WS_RSTDOF))
#define P_KPE ((GAS bf16*)(ws + WS_KPE))
#define P_KAUG ((GAS bf16*)(ws + WS_KAUG))
#define P_BIASF ((GAS float*)(ws + WS_BIASF))
#define P_NRM ((GAS float*)(ws + WS_NRM))
#define P_WR ((GAS bf16*)(ws + WS_WR))
#define P_XR ((GAS bf16*)(ws + WS_XR))
#define P_OSS ((GAS float*)(ws + WS_OSS))
#define P_RSTDX ((GAS float*)(ws + WS_RSTDX))
#define P_WIN ((GAS bf16*)(ws + WS_WIN))
#define P_WUQ ((GAS bf16*)(ws + WS_WUQ))
#define P_WUKV ((GAS bf16*)(ws + WS_WUKV))
#define P_WOUT ((GAS bf16*)(ws + WS_WOUT))
#define P_WGU_L(ll) ((GAS unsigned char*)(ws + WS_WGU + (size_t)((ll) & 1) * 32 * MiB))
#define P_WD_L(ll) ((GAS unsigned char*)(ws + WS_WD + (size_t)((ll) & 1) * 16 * MiB))
#define P_XN ((GAS bf16*)(ws + WS_XN))
#define P_FQKV ((GAS bf16*)(ws + WS_FQKV))
#define P_HH ((GAS bf16*)(ws + WS_FQKV))
#define P_LAT ((GAS bf16*)(ws + WS_LAT))
#define P_QM ((GAS bf16*)(ws + WS_QM))
#define P_KVM ((GAS bf16*)(ws + WS_KVM))
#define P_Y ((GAS bf16*)(ws + WS_Y))
#define IN(k) (lo <= (k) && (k) < hi_)
#if MK_ONE_LAUNCH
#define GRID_BAR() xcd_barrier(bar)
#else
#define GRID_BAR() do {} while (0)
#endif
#define SEAM(k) do { if (IN(k) && IN((k) + 1)) GRID_BAR(); } while (0)
__device__ __forceinline__ void conv_gu_item(int r, const GAS float* w_gate, const GAS float* w_up, const GAS float* ffn_norm, GAS unsigned char* WGU, LAS float* scr64, int lane) {
    const int e = r / 256, q = r % 256, kb = q / 16, nb = q % 16; const int n0 = nb * 64; const int ct = n0 >> 8, which = (n0 >> 7) & 1, jj = n0 & 127;
    const GAS float* src = (which ? w_up : w_gate) + (size_t)e * DM * DEXP;
    tr_item64_f8(src, DEXP, ffn_norm, WSCALE, WGU + (size_t)e * 1024 * 1024, DM, kb * 64, ct * 128 + jj, n0, scr64, lane);
}
__device__ __forceinline__ void conv_d_item(int r, const GAS float* w_down, GAS unsigned char* WD, LAS float* scr64, int lane) {
    const int e = r / 128, q = r % 128, kb = q / 16, nb = q % 16;
    tr_item64_f8(w_down + (size_t)e * DEXP * DM, DM, nullptr, WSCALE, WD + (size_t)e * 1024 * 512, DEXP, kb * 64, nb * 64, nb * 64, scr64, lane);
}
template <int l>
__device__ __forceinline__ void layer_body(const int lo, const int hi_, LAS unsigned char* lds0, const int wave0, const int G0, const int bx0, const XcdBarrier& bar) {
        const int P = 10 * l;
        if (IN(P)) for (int rep_ = 0; rep_ < (l == 0 ? NREP(0) : 1); ++rep_) {
            unsigned ldsb_ = (unsigned)(uintptr_t)lds0; asm volatile("" : "+s"(ldsb_)); LAS unsigned char* lds = (LAS unsigned char*)(uintptr_t)ldsb_; volatile LAS unsigned* MISC = (volatile LAS unsigned*)(lds + MISC_OFF); volatile LAS unsigned long long* ARGP = (volatile LAS unsigned long long*)(lds + MISC_OFF + 768); (void)MISC; int wave = wave0, G = G0, bx = bx0; asm volatile("" : "+s"(G), "+s"(bx), "+s"(wave)); const int lane = (int)__builtin_amdgcn_mbcnt_hi(~0u, __builtin_amdgcn_mbcnt_lo(~0u, 0u)); const int tid = wave * 64 + lane; const int vcu = (bx % 8) * (G / 8) + bx / 8; const int gw = vcu * 8 + wave, NGW = G * 8; (void)lane; (void)gw; (void)NGW; (void)vcu;
            GAS unsigned char* ws = (GAS unsigned char*)LDP(22); GAS float* out = (GAS float*)LDP(21); const GAS float* x_in = (const GAS float*)ARGIN(0); const GAS int* positions = (const GAS int*)ARGIN(1);
            if (l < NLAYER) {
                LAS float* scr = (LAS float*)(lds + wave * 16640);
                const GAS float* attn_norm = (const GAS float*)ARGIN(2) + (size_t)l * DM; const GAS float* w_in = (const GAS float*)ARGIN(3) + (size_t)l * DM * INW;
                const GAS float* q_norm = (const GAS float*)ARGIN(5) + (size_t)l * 256; const GAS float* w_uq = (const GAS float*)ARGIN(6) + (size_t)l * 256 * 768;
                const GAS float* kv_norm = (const GAS float*)ARGIN(7) + (size_t)l * 128; const GAS float* w_ukv = (const GAS float*)ARGIN(8) + (size_t)l * 128 * 1024;
                const GAS float* mla_on = (const GAS float*)ARGIN(9) + (size_t)l * 512; const GAS float* fox_on = (const GAS float*)ARGIN(10) + (size_t)l * 512; const GAS float* w_out = (const GAS float*)ARGIN(11) + (size_t)l * DM * DM;
                const GAS float* ffn_norm = (const GAS float*)ARGIN(12) + (size_t)l * DM;
                const GAS float* w_gate = (const GAS float*)ARGIN(17) + (size_t)l * NEXP * DM * DEXP; const GAS float* w_up = (const GAS float*)ARGIN(18) + (size_t)l * NEXP * DM * DEXP; const GAS float* w_down = (const GAS float*)ARGIN(19) + (size_t)l * NEXP * DEXP * DM;
                constexpr int I_IN = 16 * 64, I_UQ = 4 * 24, I_UKV = 4 * 32;
                constexpr int NITEMS = I_IN + I_UQ + I_UKV;
                for (int it = vcu + G * wave; it < NITEMS; it += NGW) {
                    int r = it; const int j = lane & 31;
                    if (r < I_IN) { const int kb = r / 64, nb = r % 64; const int n = nb * 32 + j; int sc;
                        if (n < 384) sc = n; else if (n < 416) sc = 384 + rope_dim(n - 384); else if (n < 424) sc = 1952 + (n - 416); else if (n < 512) sc = -1; else sc = 416 + (n - 512);
                        tr_item(w_in, INW, DM, attn_norm, P_WIN, DM, kb * 64, nb * 32, sc, scr, lane); continue; } r -= I_IN;
                    if (r < I_UQ) { const int kb = r / 24, nb = r % 24; const int n = nb * 32 + j; const int hh = n / 96, d = n % 96; const int sc = d < 64 ? n : hh * 96 + 64 + rope_dim(d - 64);
                        tr_item(w_uq, 768, 256, q_norm, P_WUQ, 256, kb * 64, nb * 32, sc, scr, lane); continue; } r -= I_UQ;
                    { const int kb = r / 32, nb = r % 32; tr_item(w_ukv, 1024, 128, kv_norm, P_WUKV, 256, kb * 64, nb * 32, nb * 32 + j, scr, lane); }
                }
                LAS float* scr64 = (LAS float*)(lds + wave * 16640);
                constexpr int J_OUT = 16 * 16, J_GU = 16 * 16 * NEXP, J_D = 8 * 16 * NEXP;
                for (int it = vcu + G * ((wave + 1) & 7); it < J_OUT + (l == 0 ? J_GU + J_D : 0); it += NGW) {
                    int r = it;
                    if (r < J_OUT) { const int kb = r / 16, nb = r % 16; const GAS float* gn = kb < 8 ? mla_on : fox_on - 512; tr_item64(w_out, DM, gn, P_WOUT, DM, kb * 64, nb * 64, nb * 64, scr64, lane); continue; } r -= J_OUT;
                    if (r < J_GU) { conv_gu_item(r, w_gate, w_up, ffn_norm, P_WGU_L(l), scr64, lane); continue; } r -= J_GU;
                    conv_d_item(r, w_down, P_WD_L(l), scr64, lane);
                }
                { const GAS float* w_rg = (const GAS float*)ARGIN(13) + (size_t)l * DM * 4; const GAS float* w_re = (const GAS float*)ARGIN(15) + (size_t)l * DM * 32;
                  for (int idx = bx * 512 + tid; idx < 2 * 48 * 520; idx += G * 512) { const int half = idx / (48 * 520), r = idx % (48 * 520), c = r / 520, kk = r % 520; const int k = half * 512 + kk;
                      float w = 0.f; if (c < 36 && kk < 512) w = ffn_norm[k] * (c < 4 ? w_rg[k * 4 + c] : w_re[k * 32 + (c - 4)]);
                      const unsigned h16 = cvt_pk_bf16(w, 0.f) & 0xffffu; const unsigned l16 = cvt_pk_bf16(w - __uint_as_float(h16 << 16), 0.f) & 0xffffu;
                      P_WR[(size_t)(half * 2 + 0) * 48 * 520 + r] = (bf16)h16; P_WR[(size_t)(half * 2 + 1) * 48 * 520 + r] = (bf16)l16; } }
            }
            const GAS float* fin = (const GAS float*)ARGIN(20);
            for (int mb = gw * 4; mb < NTOK; mb += NGW * 4) {
                f32x4 v[4][4]; int s0[4], s1[4];
                if (l > 0) {
#pragma unroll
                    for (int r = 0; r < 4; ++r) { s0[r] = P_SLOT[2 * (mb + r)]; s1[r] = P_SLOT[2 * (mb + r) + 1]; }
                }
#pragma unroll
                for (int r = 0; r < 4; ++r) {
                    if (l == 0) { const GAS float* xr = x_in + (size_t)(mb + r) * DM;
#pragma unroll
                        for (int j = 0; j < 4; ++j) v[r][j] = __builtin_nontemporal_load((const GAS f32x4*)(xr + 4 * lane + 256 * j)); }
                    else { const GAS bf16* xr = P_XR + (size_t)(mb + r) * DM;
#pragma unroll
                        for (int j = 0; j < 4; ++j) { const u32x2 w = __builtin_nontemporal_load((const GAS u32x2*)(xr + 4 * lane + 256 * j)); v[r][j] = (f32x4){__uint_as_float(w.x << 16), __uint_as_float(w.x & 0xffff0000u), __uint_as_float(w.y << 16), __uint_as_float(w.y & 0xffff0000u)}; } } }
                if (l > 0) {
#pragma unroll
                    for (int r = 0; r < 4; ++r)
#pragma unroll
                        for (int j = 0; j < 4; ++j) { const int a = __builtin_nontemporal_load((const GAS int*)((const GAS unsigned char*)P_Y + (size_t)s0[r] * 1024 + 4 * lane + 256 * j)), c = __builtin_nontemporal_load((const GAS int*)((const GAS unsigned char*)P_Y + (size_t)s1[r] * 1024 + 4 * lane + 256 * j));
                            const f32x2 a0 = __builtin_amdgcn_cvt_pk_f32_fp8(a, false), a1 = __builtin_amdgcn_cvt_pk_f32_fp8(a, true), c0 = __builtin_amdgcn_cvt_pk_f32_fp8(c, false), c1 = __builtin_amdgcn_cvt_pk_f32_fp8(c, true);
                            v[r][j][0] += (a0[0] + c0[0]) * WSCALE_INV; v[r][j][1] += (a0[1] + c0[1]) * WSCALE_INV; v[r][j][2] += (a1[0] + c1[0]) * WSCALE_INV; v[r][j][3] += (a1[1] + c1[1]) * WSCALE_INV; }
                }
                float ss[4];
#pragma unroll
                for (int r = 0; r < 4; ++r) { float s = 0.f;
#pragma unroll
                    for (int j = 0; j < 4; ++j) s += (v[r][j][0] * v[r][j][0] + v[r][j][1] * v[r][j][1]) + (v[r][j][2] * v[r][j][2] + v[r][j][3] * v[r][j][3]);
                    ss[r] = s; }
#pragma unroll
                for (int o = 1; o < 64; o <<= 1) {
#pragma unroll
                    for (int r = 0; r < 4; ++r) ss[r] += __shfl_xor(ss[r], o); }
#pragma unroll
                for (int r = 0; r < 4; ++r) { const int m = mb + r; const float rstd = rsqrtf(ss[r] * (1.f / DM) + EPS);
                    if (l < NLAYER) {
#pragma unroll
                        for (int j = 0; j < 4; ++j) { u32x2 w; w.x = cvt_pk_bf16(v[r][j][0], v[r][j][1]); w.y = cvt_pk_bf16(v[r][j][2], v[r][j][3]); *(GAS u32x2*)(P_XR + (size_t)m * DM + 4 * lane + 256 * j) = w; }
                        if (lane == 0) P_RSTDX[m] = rstd;
                    } else {
#pragma unroll
                        for (int j = 0; j < 4; ++j) { const f32x4 g = *(const GAS f32x4*)(fin + 4 * lane + 256 * j); __builtin_nontemporal_store(v[r][j] * rstd * g, (GAS f32x4*)(out + (size_t)m * DM + 4 * lane + 256 * j)); }
                    }
                }
            }
        }
        if constexpr (l == NLAYER) return;
        SEAM(P);
        if (IN(P + 1)) for (int rep_ = 0; rep_ < ((l == 0 || 1 != 5) ? NREP(1) : 1); ++rep_) {
            unsigned ldsb_ = (unsigned)(uintptr_t)lds0; asm volatile("" : "+s"(ldsb_)); LAS unsigned char* lds = (LAS unsigned char*)(uintptr_t)ldsb_; volatile LAS unsigned* MISC = (volatile LAS unsigned*)(lds + MISC_OFF); volatile LAS unsigned long long* ARGP = (volatile LAS unsigned long long*)(lds + MISC_OFF + 768); (void)MISC; int wave = wave0, G = G0, bx = bx0; asm volatile("" : "+s"(G), "+s"(bx), "+s"(wave)); const int lane = (int)__builtin_amdgcn_mbcnt_hi(~0u, __builtin_amdgcn_mbcnt_lo(~0u, 0u)); const int tid = wave * 64 + lane; const int vcu = (bx % 8) * (G / 8) + bx / 8; const int gw = vcu * 8 + wave, NGW = G * 8; (void)lane; (void)gw; (void)NGW; (void)vcu;
            GAS unsigned char* ws = (GAS unsigned char*)LDP(22); GAS float* out = (GAS float*)LDP(21); const GAS float* x_in = (const GAS float*)ARGIN(0); (void)out; (void)x_in; (void)ws;
            DenseOrder S{NTOK / 256, INP / 256, (NTOK / 256) * (INP / 256), G, bx, (const GAS char*)P_XR, (const GAS char*)P_WIN, (size_t)256 * DM * 2, (size_t)256 * DM * 2};
            EpiWin E{P_LAT, P_FQKV, P_KPE, P_FLOG, P_SSQ, P_COS, P_SIN, P_RSTDX};
            pg8::gemm_phase<EpiWin, DenseOrder, true, false>(tid, lds, DM * 2, DM * 2, DM * 2, S, E, nullptr);
        }
        SEAM(P + 1);
        if (IN(P + 2)) for (int rep_ = 0; rep_ < ((l == 0 || 2 != 5) ? NREP(2) : 1); ++rep_) {
            unsigned ldsb_ = (unsigned)(uintptr_t)lds0; asm volatile("" : "+s"(ldsb_)); LAS unsigned char* lds = (LAS unsigned char*)(uintptr_t)ldsb_; volatile LAS unsigned* MISC = (volatile LAS unsigned*)(lds + MISC_OFF); volatile LAS unsigned long long* ARGP = (volatile LAS unsigned long long*)(lds + MISC_OFF + 768); (void)MISC; int wave = wave0, G = G0, bx = bx0; asm volatile("" : "+s"(G), "+s"(bx), "+s"(wave)); const int lane = (int)__builtin_amdgcn_mbcnt_hi(~0u, __builtin_amdgcn_mbcnt_lo(~0u, 0u)); const int tid = wave * 64 + lane; const int vcu = (bx % 8) * (G / 8) + bx / 8; const int gw = vcu * 8 + wave, NGW = G * 8; (void)lane; (void)gw; (void)NGW; (void)vcu;
            GAS unsigned char* ws = (GAS unsigned char*)LDP(22); GAS float* out = (GAS float*)LDP(21); const GAS float* x_in = (const GAS float*)ARGIN(0); (void)out; (void)x_in; (void)ws;
            {
                const int sq = vcu >> 1, hf = vcu & 1; const int b = sq >> 3, h = sq & 7; const float bf = ((const GAS float*)ARGIN(4))[l * 8 + h];
                const GAS float* fl = P_FLOG + ((size_t)b * SEQ + hf * 1024 + 2 * tid) * 8 + h;
                float lf[2], lg[2] = {0.f, 0.f};
#pragma unroll
                for (int e = 0; e < 2; ++e) { const float f = fl[e * 8] + bf; lf[e] = fminf(f, 0.f) - log1pf(expf(-fabsf(f))); }
                if (hf) {
#pragma unroll
                    for (int e = 0; e < 2; ++e) { const float f = fl[e * 8 - 1024 * 8] + bf; lg[e] = fminf(f, 0.f) - log1pf(expf(-fabsf(f))); } }
                const double s2 = (double)lf[0] + (double)lf[1];
                double incl = s2, first = (double)lg[0] + (double)lg[1];
#pragma unroll
                for (int o = 1; o < 64; o <<= 1) { const double t = __shfl_up(incl, o); if (lane >= o) incl += t; first += __shfl_xor(first, o); }
                LAS double* wtot = (LAS double*)lds;
                if (lane == 63) wtot[wave] = incl;
                if (lane == 0) wtot[8 + wave] = first;
                __syncthreads();
                double c = incl - s2;
                for (int w = 0; w < wave; ++w) c += wtot[w];
                if (hf) { for (int w = 0; w < 8; ++w) c += wtot[8 + w]; }
                const size_t t0 = ((size_t)b * 8 + h) * SEQ + hf * 1024 + 2 * tid;
                GAS u32x4* ka = (GAS u32x4*)(P_KAUG + t0 * 8);
                float xs[2];
#pragma unroll
                for (int e = 0; e < 2; ++e) { c += (double)lf[e]; const float x = (float)(-c * 1.4426950408889634); xs[e] = x;
                    const unsigned h16 = cvt_pk_bf16(x, 0.f) & 0xffffu; const float r1 = x - __uint_as_float(h16 << 16); const unsigned m16 = cvt_pk_bf16(r1, 0.f) & 0xffffu; const float r2 = r1 - __uint_as_float(m16 << 16); const unsigned l16 = cvt_pk_bf16(r2, 0.f) & 0xffffu;
                    ka[e] = (u32x4){h16 | (m16 << 16), l16, 0u, 0u}; P_BIASF[t0 + e] = x; }
                float qn = 0.f, kn = 0.f, xdm = INFINITY;
                { const GAS bf16* fqp = P_FQKV + ((size_t)b * SEQ + hf * 1024 + 2 * tid) * 512 + h * 64; const GAS bf16* fkp = fqp + (size_t)NTOK * 512;
#pragma unroll
                  for (int e = 0; e < 2; ++e) { float sq_ = 0.f, sk = 0.f, dd = 0.f;
#pragma unroll
                      for (int c8 = 0; c8 < 8; ++c8) { const u32x4 a = *(const GAS u32x4*)(fqp + e * 512 + c8 * 8), k4 = *(const GAS u32x4*)(fkp + e * 512 + c8 * 8);
#pragma unroll
                          for (int j = 0; j < 4; ++j) { const float a0 = __uint_as_float(a[j] << 16), a1 = __uint_as_float(a[j] & 0xffff0000u), k0 = __uint_as_float(k4[j] << 16), k1 = __uint_as_float(k4[j] & 0xffff0000u);
                              sq_ += a0 * a0 + a1 * a1; sk += k0 * k0 + k1 * k1; dd += a0 * k0 + a1 * k1; } }
                      qn = fmaxf(qn, sq_); kn = fmaxf(kn, sk); xdm = fminf(xdm, xs[e] + dd); } }
#pragma unroll
                for (int o = 1; o < 64; o <<= 1) { qn = fmaxf(qn, __shfl_xor(qn, o)); kn = fmaxf(kn, __shfl_xor(kn, o)); xdm = fminf(xdm, __shfl_xor(xdm, o)); }
                LAS float* knw = (LAS float*)(lds + 256);
                if (lane == 0) { knw[wave] = kn; knw[8 + wave] = qn; knw[16 + wave] = xdm; }
                __syncthreads();
                if (tid < 4) { P_NRM[sq * 32 + hf * 4 + tid] = sqrtf(fmaxf(knw[8 + 2 * tid], knw[8 + 2 * tid + 1])); P_NRM[sq * 32 + 16 + hf * 4 + tid] = fminf(knw[16 + 2 * tid], knw[16 + 2 * tid + 1]); }
                if (tid == 4) { float m = knw[0]; for (int w = 1; w < 8; ++w) m = fmaxf(m, knw[w]); P_NRM[sq * 32 + 8 + hf] = sqrtf(m); }
                __syncthreads();
            }
            UpOrder S{G, vcu, (const GAS char*)P_LAT, (const GAS char*)P_WUQ, (const GAS char*)P_WUKV};
            EpiUp E{P_QM, P_KVM, P_SSQ, P_COS, P_SIN};
            pg8::gemm_phase<EpiUp, UpOrder, true, false, false, false, true>(tid, lds, 256 * 2, 512 * 2, 256 * 2, S, E, nullptr);
        }
        SEAM(P + 2);
        if (IN(P + 3)) for (int rep_ = 0; rep_ < ((l == 0 || 3 != 5) ? NREP(3) : 1); ++rep_) {
            unsigned ldsb_ = (unsigned)(uintptr_t)lds0; asm volatile("" : "+s"(ldsb_)); LAS unsigned char* lds = (LAS unsigned char*)(uintptr_t)ldsb_; volatile LAS unsigned* MISC = (volatile LAS unsigned*)(lds + MISC_OFF); volatile LAS unsigned long long* ARGP = (volatile LAS unsigned long long*)(lds + MISC_OFF + 768); (void)MISC; int wave = wave0, G = G0, bx = bx0; asm volatile("" : "+s"(G), "+s"(bx), "+s"(wave)); const int lane = (int)__builtin_amdgcn_mbcnt_hi(~0u, __builtin_amdgcn_mbcnt_lo(~0u, 0u)); const int tid = wave * 64 + lane; const int vcu = (bx % 8) * (G / 8) + bx / 8; const int gw = vcu * 8 + wave, NGW = G * 8; (void)lane; (void)gw; (void)NGW; (void)vcu;
            GAS unsigned char* ws = (GAS unsigned char*)LDP(22); GAS float* out = (GAS float*)LDP(21); const GAS float* x_in = (const GAS float*)ARGIN(0); (void)out; (void)x_in; (void)ws;
            GAS bf16* O = P_XN;
            const int b = vcu >> 4, hh = (vcu & 15) >> 1, sub = vcu & 1;
            const att::Tens2 TM{P_QM, 768, P_KVM, 1024, P_KPE, P_KVM + 64, 1024, O, nullptr, nullptr, P_OSS};
            const att::Tens2 TF{P_FQKV, 512, P_FQKV + (size_t)NTOK * 512, 512, P_KAUG, P_FQKV + (size_t)2 * NTOK * 512, 512, O, P_BIASF, P_NRM, P_OSS};
#define QB_OF(i) ((((i) & 1) ? 7 - (2 * sub + ((i) >> 1)) : (2 * sub + ((i) >> 1))))
            int ts0, ts1, ts2, ts3;
            { const GAS float* bs = P_BIASF + ((long)b * 8 + hh) * SEQ; const GAS float* nr = P_NRM + (b * 8 + hh) * 32; const float kmx = fmaxf(nr[8], nr[9]);
#define FOX_TS(i, dst) do { const int qb_ = QB_OF(i), NT_ = 4 * qb_ + 4; const float Z_ = nr[qb_] * kmx * 1.001f + 0.01f; const float bend_ = bs[(lane < NT_ ? lane : NT_ - 1) * 64 + 63]; \
                  const bool skip_ = (lane < NT_ - 4) && (Z_ + bend_ - nr[16 + qb_] < -32.f); dst = __builtin_popcountll(__ballot(skip_)); } while (0)
              FOX_TS(0, ts0); FOX_TS(1, ts1); FOX_TS(2, ts2); FOX_TS(3, ts3);
#undef FOX_TS
            }
            if (wave >= 4) __builtin_amdgcn_s_setprio(1);
            bf16x8 qreg[6];
            { int sb = 0; for (int i = 0; i < 4; ++i) sb = att::attn_unit2<1>(wave, b, hh, QB_OF(i), TM, (LAS char*)lds, sb, i > 0, i < 3 ? QB_OF(i + 1) : -1, qreg, 0); }
            { int sb = 0; for (int i = 0; i < 4; ++i) { const int ts = i == 0 ? ts0 : i == 1 ? ts1 : i == 2 ? ts2 : ts3; sb = att::attn_unit2<0>(wave, b, hh, QB_OF(i), TF, (LAS char*)lds, sb, i > 0, i < 3 ? QB_OF(i + 1) : -1, qreg, ts); } }
#undef QB_OF
            __builtin_amdgcn_s_setprio(0);
        }
        SEAM(P + 3);
        if (IN(P + 5)) for (int rep_ = 0; rep_ < ((l == 0 || 5 != 5) ? NREP(5) : 1); ++rep_) {
            unsigned ldsb_ = (unsigned)(uintptr_t)lds0; asm volatile("" : "+s"(ldsb_)); LAS unsigned char* lds = (LAS unsigned char*)(uintptr_t)ldsb_; volatile LAS unsigned* MISC = (volatile LAS unsigned*)(lds + MISC_OFF); volatile LAS unsigned long long* ARGP = (volatile LAS unsigned long long*)(lds + MISC_OFF + 768); (void)MISC; int wave = wave0, G = G0, bx = bx0; asm volatile("" : "+s"(G), "+s"(bx), "+s"(wave)); const int lane = (int)__builtin_amdgcn_mbcnt_hi(~0u, __builtin_amdgcn_mbcnt_lo(~0u, 0u)); const int tid = wave * 64 + lane; const int vcu = (bx % 8) * (G / 8) + bx / 8; const int gw = vcu * 8 + wave, NGW = G * 8; (void)lane; (void)gw; (void)NGW; (void)vcu;
            GAS unsigned char* ws = (GAS unsigned char*)LDP(22); GAS float* out = (GAS float*)LDP(21); const GAS float* x_in = (const GAS float*)ARGIN(0); (void)out; (void)x_in; (void)ws;
            DenseOrder S{NTOK / 256, DM / 256, (NTOK / 256) * (DM / 256), G, bx, (const GAS char*)P_XN, (const GAS char*)P_WOUT, (size_t)256 * DM * 2, (size_t)256 * DM * 2};
            EpiOut<false> E{x_in, P_XR};
            LAS f32x2* scl = (LAS f32x2*)(lds + pg8::STAGE_BYTES);
            { Unit u_; if (S.next(tid >> 8, u_)) { const GAS float* op = P_OSS + ((size_t)u_.pm * 256 + (tid & 255)) * 16;
                  const f32x4 a0 = *(const GAS f32x4*)op, a1 = *(const GAS f32x4*)(op + 4), c0 = *(const GAS f32x4*)(op + 8), c1 = *(const GAS f32x4*)(op + 12);
                  const float sm = ((a0[0] + a0[1]) + (a0[2] + a0[3])) + ((a1[0] + a1[1]) + (a1[2] + a1[3])), sf = ((c0[0] + c0[1]) + (c0[2] + c0[3])) + ((c1[0] + c1[1]) + (c1[2] + c1[3]));
                  const float rm_ = rsqrtf(sm * (1.f / 512.f) + EPS), rf_ = rsqrtf(sf * (1.f / 512.f) + EPS);
                  scl[tid] = (f32x2){rm_ / rf_, rf_}; } }
            __syncthreads();
            pg8::gemm_phase<EpiOut<false>, DenseOrder, true, false, false, true>(tid, lds, DM * 2, DM * 2, DM * 2, S, E, nullptr, scl);
        }
        SEAM(P + 5);
        if (IN(P + 6)) for (int rep_ = 0; rep_ < ((l == 0 || 6 != 5) ? NREP(6) : 1); ++rep_) {
            unsigned ldsb_ = (unsigned)(uintptr_t)lds0; asm volatile("" : "+s"(ldsb_)); LAS unsigned char* lds = (LAS unsigned char*)(uintptr_t)ldsb_; volatile LAS unsigned* MISC = (volatile LAS unsigned*)(lds + MISC_OFF); volatile LAS unsigned long long* ARGP = (volatile LAS unsigned long long*)(lds + MISC_OFF + 768); (void)MISC; int wave = wave0, G = G0, bx = bx0; asm volatile("" : "+s"(G), "+s"(bx), "+s"(wave)); const int lane = (int)__builtin_amdgcn_mbcnt_hi(~0u, __builtin_amdgcn_mbcnt_lo(~0u, 0u)); const int tid = wave * 64 + lane; const int vcu = (bx % 8) * (G / 8) + bx / 8; const int gw = vcu * 8 + wave, NGW = G * 8; (void)lane; (void)gw; (void)NGW; (void)vcu;
            GAS unsigned char* ws = (GAS unsigned char*)LDP(22); GAS float* out = (GAS float*)LDP(21); const GAS float* x_in = (const GAS float*)ARGIN(0); (void)out; (void)x_in; (void)ws;
            GAS bf16* H2 = P_XN;
            LAS bf16* WT = (LAS bf16*)lds;
            LAS float* LG = (LAS float*)(lds + 99840) + wave * 576;
            const GAS float* b_rg = (const GAS float*)ARGIN(14) + l * 4; const GAS float* b_re = (const GAS float*)ARGIN(16) + l * 32;
            if (tid < 32) MISC[64 + tid] = 0u;
            const int r16 = lane & 15, g4 = lane >> 4;
            const int m0 = vcu * 128 + wave * 16;
            const GAS bf16* xrow = P_XR + (size_t)(m0 + r16) * DM + 8 * g4;
            GAS unsigned char* hrow = (GAS unsigned char*)H2 + (size_t)(m0 + r16) * DM + 8 * g4;
            f32x4 acc3[3]; acc3[0] = (f32x4){0.f, 0.f, 0.f, 0.f}; acc3[1] = acc3[0]; acc3[2] = acc3[0];
            float ssq = 0.f;
            for (int half = 0; half < 2; ++half) {
                __syncthreads();
                for (int idx = tid; idx < 2 * 48 * 520 / 8; idx += 512) *(LAS u32x4*)(WT + 8 * idx) = *(const GAS u32x4*)(P_WR + (size_t)half * 2 * 48 * 520 + 8 * idx);
                __syncthreads();
                for (int s8 = 0; s8 < 16; s8 += 8) {
                    bf16x8 xv[8];
#pragma unroll
                    for (int u = 0; u < 8; ++u) xv[u] = *(const GAS bf16x8*)(xrow + half * 512 + 32 * (s8 + u));
#pragma unroll
                    for (int u = 0; u < 8; ++u) {
                        const u32x4 xw = __builtin_bit_cast(u32x4, xv[u]); float xf[8];
#pragma unroll
                        for (int j = 0; j < 4; ++j) { xf[2 * j] = __uint_as_float(xw[j] << 16); xf[2 * j + 1] = __uint_as_float(xw[j] & 0xffff0000u); }
                        u32x2 hw; hw.x = pk4_fp8(xf[0], xf[1], xf[2], xf[3]); hw.y = pk4_fp8(xf[4], xf[5], xf[6], xf[7]); *(GAS u32x2*)(hrow + half * 512 + 32 * (s8 + u)) = hw;
#pragma unroll
                        for (int j = 0; j < 8; ++j) ssq += xf[j] * xf[j];
                        const LAS bf16* wk = WT + r16 * 520 + 32 * (s8 + u) + 8 * g4;
#pragma unroll
                        for (int ct = 0; ct < 3; ++ct) { const bf16x8 bh = *(const LAS bf16x8*)(wk + ct * 16 * 520), bl = *(const LAS bf16x8*)(wk + (48 + ct * 16) * 520);
                            acc3[ct] = __builtin_amdgcn_mfma_f32_16x16x32_bf16(xv[u], bh, acc3[ct], 0, 0, 0); acc3[ct] = __builtin_amdgcn_mfma_f32_16x16x32_bf16(xv[u], bl, acc3[ct], 0, 0, 0); }
                    }
                }
            }
            ssq += __shfl_xor(ssq, 16); ssq += __shfl_xor(ssq, 32);
            const float rstd = rsqrtf(ssq * (1.f / DM) + EPS);
#pragma unroll
            for (int ct = 0; ct < 3; ++ct) { const int c = 16 * ct + r16; if (c < 36) {
#pragma unroll
                for (int rg = 0; rg < 4; ++rg) LG[(4 * g4 + rg) * 36 + c] = acc3[ct][rg]; } }
            LDS_WAIT();
            if (lane < 16) {
                const int m = m0 + lane; const LAS float* lg = LG + lane * 36;
                float gl[4];
#pragma unroll
                for (int g = 0; g < 4; ++g) gl[g] = lg[g] * rstd + b_rg[g];
                int gi = 0; float gm = gl[0];
#pragma unroll
                for (int g = 1; g < 4; ++g) if (gl[g] > gm) { gm = gl[g]; gi = g; }
                float gs = 0.f;
#pragma unroll
                for (int g = 0; g < 4; ++g) gs += __expf(gl[g] - gm);
                const float gval = 1.f / gs;
                float el[8];
#pragma unroll
                for (int j = 0; j < 8; ++j) el[j] = lg[4 + 8 * gi + j] * rstd + b_re[8 * gi + j];
                int i0 = 0; float mx0 = el[0];
#pragma unroll
                for (int j = 1; j < 8; ++j) if (el[j] > mx0) { mx0 = el[j]; i0 = j; }
                int i1 = -1; float mx1 = -INFINITY;
#pragma unroll
                for (int j = 0; j < 8; ++j) if (j != i0 && el[j] > mx1) { mx1 = el[j]; i1 = j; }
                const float e1 = __expf(mx1 - mx0); const float g0 = gval / (1.f + e1), g1 = gval * e1 / (1.f + e1);
                const int ea = gi * 8 + i0, eb = gi * 8 + i1; P_E01[2 * m] = ea; P_E01[2 * m + 1] = eb; P_G01[2 * m] = g0; P_G01[2 * m + 1] = g1; P_RSTD[m] = rstd;
                __hip_atomic_fetch_add((LAS unsigned*)(lds + MISC_OFF) + 64 + ea, 1u, __ATOMIC_RELAXED, __HIP_MEMORY_SCOPE_WORKGROUP); __hip_atomic_fetch_add((LAS unsigned*)(lds + MISC_OFF) + 64 + eb, 1u, __ATOMIC_RELAXED, __HIP_MEMORY_SCOPE_WORKGROUP);
            }
            __syncthreads();
            if (tid < 32) P_CNT[vcu * 32 + tid] = (int)MISC[64 + tid];
        }
        SEAM(P + 6);
        if (IN(P + 7)) for (int rep_ = 0; rep_ < ((l == 0 || 7 != 5) ? NREP(7) : 1); ++rep_) {
            unsigned ldsb_ = (unsigned)(uintptr_t)lds0; asm volatile("" : "+s"(ldsb_)); LAS unsigned char* lds = (LAS unsigned char*)(uintptr_t)ldsb_; volatile LAS unsigned* MISC = (volatile LAS unsigned*)(lds + MISC_OFF); volatile LAS unsigned long long* ARGP = (volatile LAS unsigned long long*)(lds + MISC_OFF + 768); (void)MISC; int wave = wave0, G = G0, bx = bx0; asm volatile("" : "+s"(G), "+s"(bx), "+s"(wave)); const int lane = (int)__builtin_amdgcn_mbcnt_hi(~0u, __builtin_amdgcn_mbcnt_lo(~0u, 0u)); const int tid = wave * 64 + lane; const int vcu = (bx % 8) * (G / 8) + bx / 8; const int gw = vcu * 8 + wave, NGW = G * 8; (void)lane; (void)gw; (void)NGW; (void)vcu;
            GAS unsigned char* ws = (GAS unsigned char*)LDP(22); GAS float* out = (GAS float*)LDP(21); const GAS float* x_in = (const GAS float*)ARGIN(0); (void)out; (void)x_in; (void)ws;
            LAS int* cnt_all = (LAS int*)lds;
            LAS int* pre_e = (LAS int*)(lds + 32768);
            LAS int* tot_e = pre_e + 32;
            LAS int* pst = pre_e + 64;
            LAS int* eL = pre_e + 128;
            for (int i = tid; i < 256 * 32; i += 512) cnt_all[i] = P_CNT[i];
            if (tid < 256) eL[tid] = P_E01[vcu * 256 + tid];
            __syncthreads();
            { LAS int* part = pre_e + 512;
              const int e = tid & 31, p = tid >> 5; int pre = 0, tot = 0;
#pragma unroll
              for (int j = 0; j < 16; ++j) { const int w = p * 16 + j; const int c = cnt_all[w * 32 + e]; pre += (w < vcu) ? c : 0; tot += c; }
              part[(p * 2) * 32 + e] = pre; part[(p * 2 + 1) * 32 + e] = tot; }
            __syncthreads();
            if (tid < 32) { LAS int* part = pre_e + 512; int pre = 0, tot = 0;
#pragma unroll
                for (int p = 0; p < 16; ++p) { pre += part[(p * 2) * 32 + tid]; tot += part[(p * 2 + 1) * 32 + tid]; } pre_e[tid] = pre; tot_e[tid] = tot; }
            __syncthreads();
            if (tid == 0) { int acc = 0; for (int e = 0; e < 32; ++e) { pst[e] = acc; acc += (tot_e[e] + 255) / 256 * 256; } pst[32] = acc; }
            __syncthreads();
            if (vcu == 0 && tid <= 32) P_TSTART[tid] = pst[tid] / 256;
            { LAS int* hist = pre_e + 2048;
              if (tid < 128) hist[tid] = 0;
              __syncthreads();
              int e = 0, rin = 0;
              if (tid < 256) { e = eL[tid]; unsigned long long mym = 0ull;
                  for (int x = 0; x < 32; ++x) { const unsigned long long bm = __ballot(e == x); if (e == x) mym = bm; }
                  rin = __builtin_popcountll(mym & ((1ull << lane) - 1ull));
                  if (rin == 0) hist[wave * 32 + e] = __builtin_popcountll(mym); }
              __syncthreads();
              if (tid < 256) { int r = rin; for (int w = 0; w < wave; ++w) r += hist[w * 32 + e];
                  const int slot = pst[e] + pre_e[e] + r; const int tok = vcu * 128 + (tid >> 1);
                  P_SLOT[vcu * 256 + tid] = slot; P_TOKOF[slot] = tok; P_GATEOF[slot] = P_G01[vcu * 256 + tid]; P_RSTDOF[slot] = P_RSTD[tok]; } }
            if (vcu < 32) { const int e = vcu; for (int s = pst[e] + tot_e[e] + tid; s < pst[e + 1]; s += 512) { P_TOKOF[s] = 0; P_GATEOF[s] = 0.f; P_RSTDOF[s] = 0.f; } }
            __syncthreads();
        }
        SEAM(P + 7);
        if (IN(P + 8)) for (int rep_ = 0; rep_ < ((l == 0 || 8 != 5) ? NREP(8) : 1); ++rep_) {
            unsigned ldsb_ = (unsigned)(uintptr_t)lds0; asm volatile("" : "+s"(ldsb_)); LAS unsigned char* lds = (LAS unsigned char*)(uintptr_t)ldsb_; volatile LAS unsigned* MISC = (volatile LAS unsigned*)(lds + MISC_OFF); volatile LAS unsigned long long* ARGP = (volatile LAS unsigned long long*)(lds + MISC_OFF + 768); (void)MISC; int wave = wave0, G = G0, bx = bx0; asm volatile("" : "+s"(G), "+s"(bx), "+s"(wave)); const int lane = (int)__builtin_amdgcn_mbcnt_hi(~0u, __builtin_amdgcn_mbcnt_lo(~0u, 0u)); const int tid = wave * 64 + lane; const int vcu = (bx % 8) * (G / 8) + bx / 8; const int gw = vcu * 8 + wave, NGW = G * 8; (void)lane; (void)gw; (void)NGW; (void)vcu;
            GAS unsigned char* ws = (GAS unsigned char*)LDP(22); GAS float* out = (GAS float*)LDP(21); const GAS float* x_in = (const GAS float*)ARGIN(0); (void)out; (void)x_in; (void)ws;
            volatile LAS int* TS = (volatile LAS int*)(MISC + 128);
            if (tid <= 32) TS[tid] = P_TSTART[tid];
            __syncthreads();
            MoeOrder S{G, vcu, TS, (const GAS char*)P_XN, (const GAS char*)P_WGU_L(l), 0, (size_t)1024 * 1024, (size_t)256 * 1024};
            EpiGU E{(GAS unsigned char*)P_HH, P_RSTDOF};
            pg8::gemm_phase<EpiGU, MoeOrder, true, true, true>(tid, lds, DM, DM, DM, S, E, P_TOKOF);
            if constexpr (l + 1 < NLAYER) {
                const int U = (int)TS[32] * 4, rem = U & 255; const int nidle = rem ? 256 - rem : 256, rk = rem ? vcu - rem : vcu;
                if (rk >= 0) { LAS float* scr64 = (LAS float*)(lds + wave * 16640);
                    const GAS float* w_gate = (const GAS float*)ARGIN(17) + (size_t)(l + 1) * NEXP * DM * DEXP; const GAS float* w_up = (const GAS float*)ARGIN(18) + (size_t)(l + 1) * NEXP * DM * DEXP; const GAS float* ffn1 = (const GAS float*)ARGIN(12) + (size_t)(l + 1) * DM;
                    for (int it = rk * 8 + wave; it < 16 * 16 * NEXP; it += nidle * 8) conv_gu_item(it, w_gate, w_up, ffn1, P_WGU_L(l + 1), scr64, lane); }
            }
        }
        SEAM(P + 8);
        if (IN(P + 9)) for (int rep_ = 0; rep_ < ((l == 0 || 9 != 5) ? NREP(9) : 1); ++rep_) {
            unsigned ldsb_ = (unsigned)(uintptr_t)lds0; asm volatile("" : "+s"(ldsb_)); LAS unsigned char* lds = (LAS unsigned char*)(uintptr_t)ldsb_; volatile LAS unsigned* MISC = (volatile LAS unsigned*)(lds + MISC_OFF); volatile LAS unsigned long long* ARGP = (volatile LAS unsigned long long*)(lds + MISC_OFF + 768); (void)MISC; int wave = wave0, G = G0, bx = bx0; asm volatile("" : "+s"(G), "+s"(bx), "+s"(wave)); const int lane = (int)__builtin_amdgcn_mbcnt_hi(~0u, __builtin_amdgcn_mbcnt_lo(~0u, 0u)); const int tid = wave * 64 + lane; const int vcu = (bx % 8) * (G / 8) + bx / 8; const int gw = vcu * 8 + wave, NGW = G * 8; (void)lane; (void)gw; (void)NGW; (void)vcu;
            GAS unsigned char* ws = (GAS unsigned char*)LDP(22); GAS float* out = (GAS float*)LDP(21); const GAS float* x_in = (const GAS float*)ARGIN(0); (void)out; (void)x_in; (void)ws;
            volatile LAS int* TS = (volatile LAS int*)(MISC + 128);
            if (tid <= 32) TS[tid] = P_TSTART[tid];
            __syncthreads();
            MoeOrder S{G, vcu, TS, (const GAS char*)P_HH, (const GAS char*)P_WD_L(l), (size_t)256 * 512, (size_t)1024 * 512, (size_t)256 * 512};
            EpiDown E{(GAS unsigned char*)P_Y, P_GATEOF};
            pg8::gemm_phase<EpiDown, MoeOrder, true, false, true>(tid, lds, DEXP, DEXP, DEXP, S, E, nullptr);
            if constexpr (l + 1 < NLAYER) {
                const int U = (int)TS[32] * 4, rem = U & 255; const int nidle = rem ? 256 - rem : 256, rk = rem ? vcu - rem : vcu;
                if (rk >= 0) { LAS float* scr64 = (LAS float*)(lds + wave * 16640);
                    const GAS float* w_down = (const GAS float*)ARGIN(19) + (size_t)(l + 1) * NEXP * DEXP * DM;
                    for (int it = rk * 8 + wave; it < 8 * 16 * NEXP; it += nidle * 8) conv_d_item(it, w_down, P_WD_L(l + 1), scr64, lane); }
            }
        }
        SEAM(P + 9);
}

__global__ void __launch_bounds__(512, 2) fwd(Args args) {
    extern __shared__ __attribute__((aligned(16))) unsigned char lds_raw[];
    LAS unsigned char* lds0 = (LAS unsigned char*)lds_raw;
    const int tid0 = threadIdx.x; const int wave0 = __builtin_amdgcn_readfirstlane(tid0 >> 6);
    const int G0 = gridDim.x; const int bx0 = blockIdx.x;
    { volatile LAS unsigned* MISC = (volatile LAS unsigned*)(lds0 + MISC_OFF); const int tid = tid0;
    for (int u = tid; u < 256; u += 512) MISC[u] = 0u;
    __syncthreads();
    volatile LAS unsigned long long* ARGP = (volatile LAS unsigned long long*)(lds0 + MISC_OFF + 768);
    if (tid < 21) ARGP[tid] = (unsigned long long)args.in[tid];
    if (tid == 21) ARGP[21] = (unsigned long long)args.out;
    if (tid == 22) ARGP[22] = (unsigned long long)args.ws;
    __syncthreads(); }
#if MK_ONE_LAUNCH
    XcdBarrier bar = xcd_barrier_post((unsigned*)(args.ws + WS_CTL) + CW_BAR, (volatile LAS unsigned*)(lds0 + MISC_OFF) + 8);
#else
    XcdBarrier bar; bar.bar = nullptr; bar.x = 0; bar.st = nullptr;
#endif
    const int lo = args.ph_lo, hi_ = args.ph_hi;
    if (IN(0)) {
        const GAS int* positions = (const GAS int*)args.in[1]; GAS float* COSp = (GAS float*)(args.ws + WS_COS); GAS float* SINp = (GAS float*)(args.ws + WS_SIN);
        for (int i = bx0 * 512 + tid0; i < NTOK * 16; i += G0 * 512) { const int tk = i >> 4, fi = i & 15;
            const double invrev = exp2(-(double)fi * (13.287712379549449 / 16.0)) * 0.15915494309189535; const double rev = (double)positions[tk] * invrev; const float fr = (float)(rev - rint(rev));
            COSp[i] = __builtin_amdgcn_cosf(fr); SINp[i] = __builtin_amdgcn_sinf(fr); }
    }
    layer_body<0>(lo, hi_, lds0, wave0, G0, bx0, bar);
    layer_body<1>(lo, hi_, lds0, wave0, G0, bx0, bar);
    layer_body<2>(lo, hi_, lds0, wave0, G0, bx0, bar);
}

extern "C" void kernel_launch(void* const* d_in, const int* in_sizes, int n_in, void* d_out, int out_size, void* d_ws, size_t ws_size, hipStream_t stream) {
    static int grid = 0;
    if (grid == 0) {
        if (n_in != 21 || out_size != NTOK * DM || ws_size < WS_END) { fprintf(stderr, "kernel_launch: unexpected shapes (n_in %d out %d ws %zu)\n", n_in, out_size, ws_size); grid = -1; return; }
        int dev = 0, cus = 0;
        if (hipGetDevice(&dev) != hipSuccess || hipDeviceGetAttribute(&cus, hipDeviceAttributeMultiprocessorCount, dev) != hipSuccess) { grid = -1; return; }
        if (hipFuncSetAttribute((const void*)fwd, hipFuncAttributeMaxDynamicSharedMemorySize, LDS_BYTES) != hipSuccess) { fprintf(stderr, "kernel_launch: hipFuncSetAttribute failed\n"); grid = -1; return; }
        int per_cu = 0;
        if (hipOccupancyMaxActiveBlocksPerMultiprocessor(&per_cu, (const void*)fwd, 512, LDS_BYTES) != hipSuccess || per_cu < 1) fprintf(stderr, "kernel_launch: occupancy query says %d\n", per_cu);
        (void)hipGetLastError();
        grid = cus;
        if (grid != 256) { fprintf(stderr, "kernel_launch: built for 256 CUs, got %d\n", grid); grid = -1; return; }
    }
    if (grid < 0) return;
    if (hipMemsetAsync((char*)d_ws + WS_CTL, 0, CTL_ZERO_BYTES, stream) != hipSuccess) return;
    Args a{};
    for (int i = 0; i < 21; ++i) a.in[i] = d_in[i];
    a.out = (float*)d_out; a.ws = (unsigned char*)d_ws;
#if MK_ONE_LAUNCH
    a.ph_lo = 0; a.ph_hi = 21;
    hipLaunchKernelGGL(fwd, dim3(grid), dim3(512), LDS_BYTES, stream, a);
#else
    for (int p = 0; p <= 20; ++p) { a.ph_lo = p; a.ph_hi = p + 1; hipLaunchKernelGGL(fwd, dim3(grid), dim3(512), LDS_BYTES, stream, a); }
#endif
}
```

```cpp
#include <hip/hip_runtime.h>
#include <cstdio>
#include <cstdint>

#ifndef PROBE_PHASE
#define PROBE_PHASE -1
#endif
#ifndef PROBE_LAYER
#define PROBE_LAYER -1
#endif
#define NREP(k) (((PROBE_PHASE) == (k) && ((PROBE_LAYER) < 0 || (PROBE_LAYER) == l)) ? 2 : 1)
#ifndef MK_ONE_LAUNCH
#define MK_ONE_LAUNCH 1
#endif

#define LAS __attribute__((address_space(3)))
#define GAS __attribute__((address_space(1)))
typedef unsigned short bf16;
typedef short bf16x8 __attribute__((ext_vector_type(8)));
typedef short s16x4 __attribute__((ext_vector_type(4)));
typedef float f32x4 __attribute__((ext_vector_type(4)));
typedef float f32x2 __attribute__((ext_vector_type(2)));
typedef float f32x16 __attribute__((ext_vector_type(16)));
typedef unsigned u32x4 __attribute__((ext_vector_type(4)));
typedef unsigned u32x2 __attribute__((ext_vector_type(2)));

constexpr int NB = 16, SEQ = 2048, DM = 1024, NTOK = NB * SEQ, NLAYER = 2;
constexpr int INW = 1960, INP = 2048;
constexpr int NEXP = 32, DEXP = 512;
constexpr int MAXSLOT = 73728;
constexpr float EPS = 1e-6f;
constexpr float WSCALE = 64.f, WSCALE_INV = 1.f / 64.f;
constexpr float LOG2E = 1.4426950408889634f;
constexpr float C2F = 0.125f * LOG2E;
constexpr float C2M = 0.10206207261596575f * LOG2E;

constexpr size_t MiB = 1u << 20, KiB = 1u << 10;
constexpr size_t WS_CTL = 0, CTL_ZERO_BYTES = 64 * KiB;
constexpr size_t WS_COS = 1 * MiB, WS_SIN = 3 * MiB;
constexpr size_t WS_SSQ = 5 * MiB;
constexpr size_t WS_FLOG = 6 * MiB;
constexpr size_t WS_E01 = 8 * MiB;
constexpr size_t WS_G01 = 8 * MiB + 256 * KiB;
constexpr size_t WS_SLOT = 8 * MiB + 512 * KiB;
constexpr size_t WS_TOKOF = 8 * MiB + 768 * KiB;
constexpr size_t WS_GATEOF = 9 * MiB + 256 * KiB;
constexpr size_t WS_CNT = 9 * MiB + 768 * KiB;
constexpr size_t WS_TSTART = 9 * MiB + 800 * KiB;
constexpr size_t WS_RSTD = 9 * MiB + 832 * KiB;
constexpr size_t WS_RSTDOF = 7 * MiB;
constexpr size_t WS_KPE = 10 * MiB;
constexpr size_t WS_KAUG = 10 * MiB + 2 * MiB;
constexpr size_t WS_WIN = 16 * MiB;
constexpr size_t WS_WUQ = 20 * MiB;
constexpr size_t WS_WUKV = 20 * MiB + 512 * KiB;
constexpr size_t WS_WOUT = 21 * MiB;
constexpr size_t WS_WGU = 24 * MiB;
constexpr size_t WS_WD = 88 * MiB;
constexpr size_t WS_XN = 120 * MiB;
constexpr size_t WS_FQKV = 184 * MiB;
constexpr size_t WS_LAT = 280 * MiB;
constexpr size_t WS_QM = 312 * MiB;
constexpr size_t WS_KVM = 360 * MiB;
constexpr size_t WS_Y = 280 * MiB;
constexpr size_t WS_BIASF = 424 * MiB;
constexpr size_t WS_NRM = 425 * MiB;
constexpr size_t WS_WR = 426 * MiB;
constexpr size_t WS_XR = 427 * MiB;
constexpr size_t WS_OSS = 491 * MiB;
constexpr size_t WS_RSTDX = 493 * MiB;
constexpr size_t WS_END = 494 * MiB;
static_assert(WS_Y + (size_t)MAXSLOT * 1024 * 2 <= WS_END, "Y fits");
static_assert(WS_FQKV + (size_t)MAXSLOT * 512 * 2 <= WS_LAT, "HH fits");

constexpr int CW_BAR = 1024;

constexpr int RING_BYTES = 147456;
constexpr int MISC_OFF = RING_BYTES;
constexpr int LDS_BYTES = RING_BYTES + 1024;

typedef __bf16 bf16x2_t __attribute__((ext_vector_type(2)));
__device__ __forceinline__ unsigned cvt_pk_bf16(float lo, float hi) { const f32x2 v = {lo, hi}; const bf16x2_t b = __builtin_convertvector(v, bf16x2_t); return __builtin_bit_cast(unsigned, b); }
__device__ __forceinline__ float bf2f(unsigned short b) { return __uint_as_float((unsigned)b << 16); }
__device__ __forceinline__ float wave_sum(float v) {
#pragma unroll
    for (int o = 1; o < 64; o <<= 1) v += __shfl_xor(v, o);
    return v;
}
__device__ __forceinline__ unsigned pk4_fp8(float a, float b, float c, float d) { int w = 0; w = __builtin_amdgcn_cvt_pk_fp8_f32(a, b, w, false); w = __builtin_amdgcn_cvt_pk_fp8_f32(c, d, w, true); return (unsigned)w; }
#define LDS_WAIT() asm volatile("s_waitcnt lgkmcnt(0)" ::: "memory")

#define XB_TMO      128
#define XB_XCNT(j)  (256  + 64 * (j))
#define XB_XSUB(j)  (1280 + 64 * (j))
#define XB_XGEN(j)  (2304 + 64 * (j))
#define XB_TOP      3328
#define XB_TOPGEN   3392
#define XCD_BAR_WORDS 3456
#define XB_SPIN_CAP (1u << 18)
__device__ __forceinline__ unsigned xb_ld(unsigned* p)              { return __hip_atomic_load(p, __ATOMIC_RELAXED, __HIP_MEMORY_SCOPE_AGENT); }
__device__ __forceinline__ unsigned xb_add(unsigned* p, unsigned v) { return __hip_atomic_fetch_add(p, v, __ATOMIC_RELAXED, __HIP_MEMORY_SCOPE_AGENT); }
__device__ __forceinline__ unsigned xb_xcc_id() { return (unsigned)__builtin_amdgcn_s_getreg((3 << 11) | 20) & 0xFu; }
#define XB_SPIN(cond, bar) do { unsigned _sp = 0; while (cond) { __builtin_amdgcn_s_sleep(1); \
    if ((++_sp & 255u) == 0u) { if (xb_ld(&(bar)[XB_TMO])) break; if (_sp > XB_SPIN_CAP) { atomicAdd(&(bar)[XB_TMO], 1u); break; } } } } while (0)
struct XcdBarrier { unsigned* bar; unsigned x; volatile LAS unsigned* st; };
__device__ __forceinline__ XcdBarrier xcd_barrier_post(unsigned* bar, volatile LAS unsigned* st) {
    XcdBarrier b; b.bar = bar; b.x = xb_xcc_id(); b.st = st;
    if (threadIdx.x == 0) (void)xb_add(&bar[XB_XCNT(b.x)], 1u);
    return b;
}
__device__ __forceinline__ void xcd_barrier_complete(unsigned* bar, unsigned x, unsigned& nloc, unsigned& nx) {
    const unsigned G = gridDim.x * gridDim.y * gridDim.z;
    unsigned sum, cnt, mine, sp = 0u;
    for (;;) {
        sum = 0u; cnt = 0u; mine = 0u;
#pragma unroll
        for (unsigned j = 0; j < 16; ++j) { const unsigned c = xb_ld(&bar[XB_XCNT(j)]); sum += c; cnt += (c > 0u) ? 1u : 0u; mine = (j == x) ? c : mine; }
        if (sum == G) break;
        __builtin_amdgcn_s_sleep(1);
        if ((++sp & 255u) == 0u) { if (xb_ld(&bar[XB_TMO])) break; if (sp > XB_SPIN_CAP) { atomicAdd(&bar[XB_TMO], 1u); break; } }
    }
    nloc = mine > 0u ? mine : 1u; nx = cnt > 0u ? cnt : 1u;
}
__device__ __forceinline__ void xcd_barrier(const XcdBarrier& b) {
    asm volatile("s_waitcnt vmcnt(0)" ::: "memory");
    __syncthreads();
    if (threadIdx.x == 0) {
        unsigned* bar = b.bar;
        __builtin_amdgcn_s_waitcnt(0);
        unsigned nloc = b.st[0], nx = b.st[1];
        if (nloc == 0u) { xcd_barrier_complete(bar, b.x, nloc, nx); b.st[0] = nloc; b.st[1] = nx; }
        const unsigned old = xb_add(&bar[XB_XSUB(b.x)], 1u);
        const unsigned gen = old / nloc;
        if (old + 1u == (gen + 1u) * nloc) {
            __builtin_amdgcn_fence(__ATOMIC_RELEASE, "agent");
            asm volatile("s_waitcnt vmcnt(0)" ::: "memory");
            const unsigned og = xb_add(&bar[XB_TOP], 1u);
            const unsigned tg = og / nx;
            if (og + 1u == (tg + 1u) * nx) xb_add(&bar[XB_TOPGEN], 1u);
            else XB_SPIN(xb_ld(&bar[XB_TOPGEN]) == tg, bar);
            __builtin_amdgcn_fence(__ATOMIC_ACQUIRE, "agent");
            xb_add(&bar[XB_XGEN(b.x)], 1u);
            asm volatile("s_waitcnt vmcnt(0)" ::: "memory");
        } else {
            XB_SPIN(xb_ld(&bar[XB_XGEN(b.x)]) == gen, bar);
            __builtin_amdgcn_fence(__ATOMIC_ACQUIRE, "agent");
            asm volatile("s_waitcnt vmcnt(0)" ::: "memory");
        }
    }
    __syncthreads();
}

namespace pg8 {
constexpr int BM = 256, BK = 64, HALF = 128, HTB = HALF * BK * 2, STAGE_BYTES = 8 * HTB;
typedef int v4i32_t __attribute__((ext_vector_type(4)));
typedef int v8i32_t __attribute__((ext_vector_type(8)));
__host__ __device__ __forceinline__ int lds_byte(int r, int c) { const int st = (r >> 4) * 2 + (c >> 5), rr = r & 15, cc = c & 31, ob = rr * 64 + cc * 2; return st * 1024 + (ob ^ (((ob >> 9) & 1) << 5)); }
__host__ __device__ __forceinline__ void stage_rc(int b, int& R, int& C) { const int st = b / 1024, sb = b % 1024, swz = sb ^ (((sb >> 9) & 1) << 5); R = (st >> 1) * 16 + swz / 64; C = (st & 1) * 32 + (swz % 64) / 2; }
__host__ __device__ __forceinline__ int perm32(int rho) { const int n = rho >> 4, i = rho & 15; return 8 * (i >> 2) + 4 * n + (i & 3); }

struct Unit { const GAS char* a; const GAS char* b; int pm, pn, e; };

template <int N> __device__ __forceinline__ void wait_vm() { asm volatile("s_waitcnt vmcnt(%0)" :: "n"(N) : "memory"); }
template <class Epi, class Sched, bool ALIGN_EPI, bool GATHER, bool FP8 = false, bool MIDSCALE = false, bool VARK = false>
__device__ __forceinline__ void gemm_phase(const int tid, LAS unsigned char* lds, const int Kb, const int ldaB, const int ldbB, const Sched& S, const Epi& E, const GAS int* __restrict__ tokof, const LAS f32x2* scl = nullptr) {
    const int wid = __builtin_amdgcn_readfirstlane(tid >> 6), lane = tid & 63, wr = wid >> 2, wc = wid & 3, fr = lane & 15, fq = lane >> 4;
    const int nt = Kb / 128;
    unsigned voffA[2], voffB[2]; int RA[2], CA2[2];
#pragma unroll
    for (int i = 0; i < 2; ++i) { int R, C; stage_rc(tid * 16 + i * 8192, R, C); const int Rb = Epi::WIDE ? (64 * (R >> 5) + perm32(R & 31)) : Epi::PERM ? ((R & ~31) + perm32(R & 31)) : R;
        voffA[i] = (unsigned)(R * ldaB + C * 2); voffB[i] = (unsigned)(Rb * ldbB + C * 2); RA[i] = R; CA2[i] = C * 2; }
    const size_t kstep = (size_t)(BK * 2);
    const size_t hstepA = GATHER ? 0 : (size_t)HALF * ldaB;
    const size_t hstepB = (size_t)(Epi::WIDE ? 32 : HALF) * ldbB;
    const unsigned ldsw = (unsigned)wid * 1024u;
    const int aoff = lds_byte(wr * 64 + fr, fq * 8), boff = lds_byte(wc * 32 + fr, fq * 8);
    unsigned gcur[2][2], gnxt[2][2];
    const int scl8 = 0x7F7F7F7F;
#define PG8_SA(b, h) (((b) * 2 + (h)) * HTB)
#define PG8_SB(b, h) ((4 + (b) * 2 + (h)) * HTB)
#define PG8_STAGE(bufoff, gbase, voff) do { const unsigned long long gb_ = (unsigned long long)(gbase); const unsigned lbase_ = (unsigned)__builtin_amdgcn_readfirstlane((int)((unsigned)(uintptr_t)lds + (unsigned)(bufoff) + ldsw)); \
        _Pragma("unroll") for (int _i = 0; _i < 2; ++_i) { unsigned keep_; \
            asm volatile("s_mov_b32 %0, m0\n\ts_mov_b32 m0, %3\n\ts_nop 0\n\tglobal_load_lds_dwordx4 %1, %2\n\ts_mov_b32 m0, %0" : "=&s"(keep_) : "v"((voff)[_i]), "s"(gb_), "s"(lbase_ + (unsigned)(_i * 8192)) : "memory"); } } while (0)
#define PG8_STAGE_A(bufoff, base, h, nx) do { if constexpr (GATHER) { unsigned _v[2]; _v[0] = (nx) ? gnxt[h][0] : gcur[h][0]; _v[1] = (nx) ? gnxt[h][1] : gcur[h][1]; PG8_STAGE(bufoff, base, _v); } \
        else { PG8_STAGE(bufoff, (base) + (h) * hstepA, voffA); } } while (0)
#define PG8_LDA(dst, b, h) do { _Pragma("unroll") for (int m = 0; m < 4; ++m) _Pragma("unroll") for (int k = 0; k < 2; ++k) dst[m][k] = *(const LAS bf16x8*)(lds + PG8_SA(b, h) + aoff + m * 2048 + k * 1024); } while (0)
#define PG8_LDB(dst, b, h) do { _Pragma("unroll") for (int n = 0; n < 2; ++n) _Pragma("unroll") for (int k = 0; k < 2; ++k) dst[n][k] = *(const LAS bf16x8*)(lds + PG8_SB(b, h) + boff + n * 2048 + k * 1024); } while (0)
#define PG8_MMA(ai, bj, At, Bt) do { __builtin_amdgcn_s_setprio(1); if constexpr (FP8) { _Pragma("unroll") for (int m = 0; m < 4; ++m) _Pragma("unroll") for (int n = 0; n < 2; ++n) { \
        const v8i32_t b8_ = __builtin_shufflevector(__builtin_bit_cast(v4i32_t, Bt[n][0]), __builtin_bit_cast(v4i32_t, Bt[n][1]), 0, 1, 2, 3, 4, 5, 6, 7), a8_ = __builtin_shufflevector(__builtin_bit_cast(v4i32_t, At[m][0]), __builtin_bit_cast(v4i32_t, At[m][1]), 0, 1, 2, 3, 4, 5, 6, 7); \
        asm volatile("s_nop 1\n\tv_mfma_scale_f32_16x16x128_f8f6f4 %0, %1, %2, %0, %3, %3 op_sel_hi:[0,0,0]" : "+v"(acc[ai][bj][m][n]) : "v"(b8_), "v"(a8_), "v"(scl8)); } } \
      else { _Pragma("unroll") for (int m = 0; m < 4; ++m) _Pragma("unroll") for (int n = 0; n < 2; ++n) _Pragma("unroll") for (int k = 0; k < 2; ++k) \
        acc[ai][bj][m][n] = __builtin_amdgcn_mfma_f32_16x16x32_bf16(Bt[n][k], At[m][k], acc[ai][bj][m][n], 0, 0, 0); } __builtin_amdgcn_s_setprio(0); } while (0)
#define PG8_MMA_Z(ai, bj, At, Bt) do { __builtin_amdgcn_s_setprio(1); if constexpr (FP8) { _Pragma("unroll") for (int m = 0; m < 4; ++m) _Pragma("unroll") for (int n = 0; n < 2; ++n) { \
        const v8i32_t b8_ = __builtin_shufflevector(__builtin_bit_cast(v4i32_t, Bt[n][0]), __builtin_bit_cast(v4i32_t, Bt[n][1]), 0, 1, 2, 3, 4, 5, 6, 7), a8_ = __builtin_shufflevector(__builtin_bit_cast(v4i32_t, At[m][0]), __builtin_bit_cast(v4i32_t, At[m][1]), 0, 1, 2, 3, 4, 5, 6, 7); \
        asm volatile("s_nop 1\n\tv_mfma_scale_f32_16x16x128_f8f6f4 %0, %1, %2, 0, %3, %3 op_sel_hi:[0,0,0]" : "=&v"(acc[ai][bj][m][n]) : "v"(b8_), "v"(a8_), "v"(scl8)); } } \
      __builtin_amdgcn_s_setprio(0); } while (0)
#define PG8_WAIT_V(n) asm volatile("s_waitcnt vmcnt(" #n ")" ::: "memory")
#define PG8_WAIT_L(n) asm volatile("s_waitcnt lgkmcnt(" #n ")" ::: "memory")
#define PG8_BAR __builtin_amdgcn_s_barrier()
#define PG8_SCHED __builtin_amdgcn_sched_barrier(0)
#define PG8_GLOAD(dst, u) do { if constexpr (GATHER) { _Pragma("unroll") for (int _h = 0; _h < 2; ++_h) _Pragma("unroll") for (int _i = 0; _i < 2; ++_i) \
        dst[_h][_i] = (unsigned)tokof[(u).pm * BM + _h * HALF + RA[_i]] * (unsigned)ldaB + (unsigned)CA2[_i]; } } while (0)
    Unit cur, nxt; int ui = 0;
    if (!S.next(0, cur)) return;
    PG8_GLOAD(gcur, cur);
    typename Epi::Pre pre = E.prefetch(cur, wr, fr);
    f32x4 acc[2][2][4][2];
#pragma unroll
    for (int a = 0; a < 2; ++a)
#pragma unroll
        for (int b = 0; b < 2; ++b)
#pragma unroll
            for (int m = 0; m < 4; ++m)
#pragma unroll
                for (int n = 0; n < 2; ++n) acc[a][b][m][n] = (f32x4){0.f, 0.f, 0.f, 0.f};
    bf16x8 At[4][2], B0[2][2], B1[2][2];
    const GAS char* cA = cur.a; const GAS char* cB = cur.b;
    PG8_STAGE(PG8_SB(0, 0), cB, voffB); PG8_STAGE(PG8_SB(0, 1), cB + hstepB, voffB); PG8_STAGE_A(PG8_SA(0, 0), cA, 0, false); PG8_STAGE_A(PG8_SA(0, 1), cA, 1, false);
    if (wr == 1) PG8_BAR;
    PG8_WAIT_V(2); PG8_BAR;
    PG8_STAGE(PG8_SB(1, 0), cB + kstep, voffB); PG8_STAGE_A(PG8_SA(1, 0), cA + kstep, 0, false); PG8_STAGE(PG8_SB(1, 1), cB + hstepB + kstep, voffB);
    PG8_WAIT_V(6); PG8_BAR;
    bool fresh = false;
    for (;;) {
        const bool has_next = S.next(ui + 1, nxt);
        if constexpr (GATHER) { if (has_next) { PG8_GLOAD(gnxt, nxt); } else { _Pragma("unroll") for (int _h = 0; _h < 2; ++_h) _Pragma("unroll") for (int _i = 0; _i < 2; ++_i) gnxt[_h][_i] = gcur[_h][_i]; } }
        const GAS char* nA = has_next ? nxt.a : cA; const GAS char* nB = has_next ? nxt.b : cB;
        const int ntu = VARK ? (cur.e ? nt / 2 : nt) : nt;
#pragma nounroll
        for (int t = 0; t < ntu; t += 2) {
            const bool last = (t == ntu - 2);
            const GAS char* a1 = cA + (size_t)(t + 1) * kstep;
            const GAS char* a2 = last ? nA : cA + (size_t)(t + 2) * kstep; const GAS char* b2 = last ? nB : cB + (size_t)(t + 2) * kstep;
            const GAS char* a3 = a2 + kstep; const GAS char* b3 = b2 + kstep;
            const bool fe = fresh; fresh = false;
            if constexpr (MIDSCALE) { if (t == nt / 2) {
#pragma unroll
                for (int ai = 0; ai < 2; ++ai)
#pragma unroll
                    for (int m = 0; m < 4; ++m) { const float r_ = scl[ui * 256 + ai * 128 + wr * 64 + m * 16 + fr][0];
#pragma unroll
                        for (int bj = 0; bj < 2; ++bj)
#pragma unroll
                            for (int n = 0; n < 2; ++n) acc[ai][bj][m][n] *= r_; } } }
            PG8_LDB(B0, 0, 0); PG8_LDB(B1, 0, 1); PG8_SCHED; PG8_LDA(At, 0, 0); PG8_STAGE_A(PG8_SA(1, 1), a1, 1, false);
            if (fe) wait_vm<8 + Epi::NST>(); else PG8_WAIT_V(8); PG8_WAIT_L(0); PG8_BAR; if (FP8 && t == 0) { PG8_MMA_Z(0, 0, At, B0); PG8_MMA_Z(0, 1, At, B1); } else { PG8_MMA(0, 0, At, B0); PG8_MMA(0, 1, At, B1); } PG8_BAR; PG8_SCHED;
            PG8_LDA(At, 0, 1); PG8_STAGE(PG8_SB(0, 0), b2, voffB); PG8_STAGE(PG8_SB(0, 1), b2 + hstepB, voffB); PG8_STAGE_A(PG8_SA(0, 0), a2, 0, last);
            if (fe) wait_vm<8 + Epi::NST>(); else PG8_WAIT_V(8); PG8_WAIT_L(0); PG8_BAR; if (FP8 && t == 0) { PG8_MMA_Z(1, 0, At, B0); PG8_MMA_Z(1, 1, At, B1); } else { PG8_MMA(1, 0, At, B0); PG8_MMA(1, 1, At, B1); } PG8_BAR; PG8_SCHED;
            PG8_LDB(B0, 1, 0); PG8_LDB(B1, 1, 1); PG8_SCHED; PG8_LDA(At, 1, 0); PG8_STAGE_A(PG8_SA(0, 1), a2, 1, last);
            PG8_WAIT_V(8); PG8_WAIT_L(0); PG8_BAR; PG8_MMA(0, 0, At, B0); PG8_MMA(0, 1, At, B1); PG8_BAR; PG8_SCHED;
            PG8_LDA(At, 1, 1); PG8_STAGE(PG8_SB(1, 0), b3, voffB); PG8_STAGE(PG8_SB(1, 1), b3 + hstepB, voffB); PG8_STAGE_A(PG8_SA(1, 0), a3, 0, last);
            PG8_WAIT_V(8); PG8_WAIT_L(0); PG8_BAR; PG8_MMA(1, 0, At, B0); PG8_MMA(1, 1, At, B1); PG8_BAR; PG8_SCHED;
        }
        if constexpr (ALIGN_EPI) { if (wr == 0) PG8_BAR; }
        if constexpr (FP8) {
            asm volatile("s_nop 15\n\ts_nop 15" ::: "memory");
#pragma unroll
            for (int a = 0; a < 2; ++a)
#pragma unroll
                for (int b = 0; b < 2; ++b)
                    asm volatile("" : "+v"(acc[a][b][0][0]), "+v"(acc[a][b][0][1]), "+v"(acc[a][b][1][0]), "+v"(acc[a][b][1][1]), "+v"(acc[a][b][2][0]), "+v"(acc[a][b][2][1]), "+v"(acc[a][b][3][0]), "+v"(acc[a][b][3][1])); }
        if constexpr (MIDSCALE) E(acc, cur, wr, wc, fr, fq, scl + ui * 256); else E(acc, cur, wr, wc, fr, fq, pre);
        if (!has_next) break;
        pre = E.prefetch(nxt, wr, fr);
        if constexpr (FP8) {
#pragma unroll
            for (int a = 0; a < 2; ++a)
#pragma unroll
                for (int b = 0; b < 2; ++b)
                    asm volatile("" : "=v"(acc[a][b][0][0]), "=v"(acc[a][b][0][1]), "=v"(acc[a][b][1][0]), "=v"(acc[a][b][1][1]), "=v"(acc[a][b][2][0]), "=v"(acc[a][b][2][1]), "=v"(acc[a][b][3][0]), "=v"(acc[a][b][3][1]));
        } else {
#pragma unroll
            for (int a = 0; a < 2; ++a)
#pragma unroll
                for (int b = 0; b < 2; ++b)
#pragma unroll
                    for (int m = 0; m < 4; ++m)
#pragma unroll
                        for (int n = 0; n < 2; ++n) acc[a][b][m][n] = (f32x4){0.f, 0.f, 0.f, 0.f};
        }
        cur = nxt; cA = nA; cB = nB; ++ui; fresh = true;
        if constexpr (GATHER) { _Pragma("unroll") for (int _h = 0; _h < 2; ++_h) _Pragma("unroll") for (int _i = 0; _i < 2; ++_i) gcur[_h][_i] = gnxt[_h][_i]; }
        if constexpr (ALIGN_EPI) { if (wr == 1) PG8_BAR; }
    }
    PG8_WAIT_V(0);
    if constexpr (!ALIGN_EPI) { if (wr == 0) PG8_BAR; }
    PG8_BAR;
#undef PG8_SA
#undef PG8_SB
#undef PG8_STAGE
#undef PG8_STAGE_A
#undef PG8_LDA
#undef PG8_LDB
#undef PG8_MMA
#undef PG8_MMA_Z
#undef PG8_WAIT_V
#undef PG8_WAIT_L
#undef PG8_BAR
#undef PG8_SCHED
#undef PG8_GLOAD
}
}
using pg8::Unit;

struct DenseOrder {
    int nM, nN, nwg, G, c; const GAS char* A; const GAS char* B; size_t aT, bT;
    __device__ __forceinline__ bool next(int i, Unit& u) const {
        const long L = (long)i * G + c; if (L >= nwg) return false;
        int wgid = (int)L; { const int q = nwg / 8, r = nwg % 8, xcd = wgid % 8, off = wgid / 8; wgid = (xcd < r ? xcd * (q + 1) : r * (q + 1) + (xcd - r) * q) + off; }
        const int nig = 8 * nN, gid = wgid / nig, fm = gid * 8, gsz = (nM - fm) < 8 ? (nM - fm) : 8;
        u.pm = fm + ((wgid % nig) % gsz); u.pn = (wgid % nig) / gsz; u.e = 0;
        u.a = A + (size_t)u.pm * aT; u.b = B + (size_t)u.pn * bT; return true;
    }
};
struct UpOrder {
    int G, c; const GAS char* LATp; const GAS char* Wq; const GAS char* Wkv;
    __device__ __forceinline__ bool next(int i, Unit& u) const {
        const int L = i * G + c; if (L >= 128 * 7) return false;
        u.pm = L / 7; const int j = L % 7; const bool kv = j >= 3; u.pn = kv ? j - 3 : j; u.e = kv ? 1 : 0;
        u.a = LATp + (size_t)u.pm * 256 * 512 * 2 + (kv ? 512 : 0);
        u.b = (kv ? Wkv : Wq) + (size_t)u.pn * 256 * 256 * 2; return true;
    }
};
struct MoeOrder {
    int G, c; const volatile LAS int* TS; const GAS char* A; const GAS char* W; size_t aT  , wE  , wT  ;
    __device__ __forceinline__ bool next(int i, Unit& u) const {
        const int L = i * G + c; const int ntile = __builtin_amdgcn_readfirstlane(TS[32]); if (L >= ntile * 4) return false;
        const int rt = L >> 2, ct = L & 3;
        const int ln_ = (int)__builtin_amdgcn_mbcnt_hi(~0u, __builtin_amdgcn_mbcnt_lo(~0u, 0u)); const int tsv_ = TS[ln_ & 31];
        const int e = __builtin_popcountll(__ballot(ln_ >= 1 && ln_ < 32 && tsv_ <= rt));
        u.pm = rt; u.pn = ct; u.e = e; u.a = A + (size_t)rt * aT; u.b = W + (size_t)e * wE + (size_t)ct * wT; return true;
    }
};

__device__ __forceinline__ u32x4 pack8(f32x4 v0, f32x4 v1) { u32x4 w; w.x = cvt_pk_bf16(v0[0], v0[1]); w.y = cvt_pk_bf16(v0[2], v0[3]); w.z = cvt_pk_bf16(v1[0], v1[1]); w.w = cvt_pk_bf16(v1[2], v1[3]); return w; }

__device__ __forceinline__ void wide_store(GAS bf16* p, long dB, bool lo, u32x4 X, u32x4 Y) {
    u32x4 Yr;
#pragma unroll
    for (int j = 0; j < 4; ++j) Yr[j] = (unsigned)__builtin_amdgcn_update_dpp(0, (int)Y[j], 0x128, 0xf, 0xf, false);
    u32x4 A, B;
#pragma unroll
    for (int j = 0; j < 4; ++j) { A[j] = lo ? X[j] : Yr[j]; B[j] = lo ? Yr[j] : X[j]; }
    *(GAS u32x4*)p = A; *(GAS u32x4*)(p + dB) = B;
}

struct EpiWin {
    static constexpr int NST = 16;
    static constexpr bool PERM = true, WIDE = true;
    GAS bf16* LAT_; GAS bf16* FQKV_; GAS bf16* KPE_; GAS float* FLOG_; GAS float* SSQ_; const GAS float* COS_; const GAS float* SIN_; const GAS float* RSX_;
    struct Pre { float v[8]; };
    __device__ __forceinline__ Pre prefetch(const Unit& u, int wr, int fr) const { Pre p; const GAS float* RSX = RSX_; asm volatile("" : "+s"(RSX));
#pragma unroll
        for (int g = 0; g < 8; ++g) p.v[g] = RSX[u.pm * 256 + (g >> 2) * 128 + wr * 64 + (g & 3) * 16 + fr]; return p; }
    __device__ __forceinline__ void operator()(f32x4 (&acc)[2][2][4][2], const Unit& u, int wr, int wc, int fr, int fq, const Pre& pre) const {
        GAS bf16* LAT = LAT_; GAS bf16* FQKV = FQKV_; GAS bf16* KPE = KPE_; GAS float* FLOG = FLOG_; GAS float* SSQ = SSQ_; const GAS float* COS = COS_; const GAS float* SIN = SIN_; const GAS float* RSX = RSX_;
        asm volatile("" : "+s"(LAT), "+s"(FQKV), "+s"(KPE), "+s"(FLOG), "+s"(SSQ), "+s"(COS), "+s"(SIN), "+s"(RSX));
        {
#pragma unroll
            for (int ai = 0; ai < 2; ++ai)
#pragma unroll
                for (int m = 0; m < 4; ++m) { const float rs_ = pre.v[ai * 4 + m];
#pragma unroll
                    for (int bj = 0; bj < 2; ++bj)
#pragma unroll
                        for (int n = 0; n < 2; ++n) acc[ai][bj][m][n] *= rs_; } }
        const int row0 = u.pm * 256 + wr * 64 + fr; const int pn = u.pn;
        const bool lo = fr < 8; const int roww = u.pm * 256 + wr * 64 + (fr & 7), colw = wc * 64 + (fr >> 3) * 32 + 8 * fq; const long dB = 8 * 512 + (lo ? 32 : -32);
        if (pn >= 2) {
            const int ti = pn >> 1; GAS bf16* dst = FQKV + (size_t)(ti - 1) * NTOK * 512 + (pn & 1) * 256 + colw; const float sc = (ti == 1) ? C2F : 1.f;
#pragma unroll
            for (int ai = 0; ai < 2; ++ai)
#pragma unroll
                for (int m = 0; m < 4; ++m) wide_store(dst + (size_t)(roww + ai * 128 + m * 16) * 512, dB, lo, pack8(acc[ai][0][m][0] * sc, acc[ai][0][m][1] * sc), pack8(acc[ai][1][m][0] * sc, acc[ai][1][m][1] * sc));
        } else {
#pragma unroll
            for (int ai = 0; ai < 2; ++ai)
#pragma unroll
                for (int m = 0; m < 4; ++m) { const int row = row0 + ai * 128 + m * 16;
                    wide_store(LAT + (size_t)(roww + ai * 128 + m * 16) * 512 + pn * 256 + colw, dB, lo, pack8(acc[ai][0][m][0], acc[ai][0][m][1]), pack8(acc[ai][1][m][0], acc[ai][1][m][1]));
                    float s = 0.f;
                    if (pn == 0 || wc < 2) {
#pragma unroll
                        for (int bj = 0; bj < 2; ++bj)
#pragma unroll
                            for (int n = 0; n < 2; ++n) { const f32x4 x = acc[ai][bj][m][n]; s += (x[0] * x[0] + x[1] * x[1]) + (x[2] * x[2] + x[3] * x[3]); }
                    }
                    s += __shfl_xor(s, 16); s += __shfl_xor(s, 32);
                    if (fq == 0) SSQ[(size_t)row * 8 + pn * 4 + wc] = s;
                    }
            if (pn == 1 && wc == 2) {
#pragma unroll
                for (int ai = 0; ai < 2; ++ai)
#pragma unroll
                    for (int m = 0; m < 4; ++m) { const int row = row0 + ai * 128 + m * 16;
                        const f32x4 c = *(const GAS f32x4*)(COS + (size_t)row * 16 + 4 * fq), sn = *(const GAS f32x4*)(SIN + (size_t)row * 16 + 4 * fq);
                        const f32x4 x1 = acc[ai][0][m][0], x2 = acc[ai][0][m][1];
                        *(GAS u32x4*)(KPE + (size_t)row * 32 + 8 * fq) = pack8(x1 * c - x2 * sn, x1 * sn + x2 * c);
                        }
            }
            if (pn == 1 && wc == 2 && fq == 0) {
#pragma unroll
                for (int ai = 0; ai < 2; ++ai)
#pragma unroll
                    for (int m = 0; m < 4; ++m) { const int row = row0 + ai * 128 + m * 16; *(GAS f32x4*)(FLOG + (size_t)row * 8) = acc[ai][1][m][0]; *(GAS f32x4*)(FLOG + (size_t)row * 8 + 4) = acc[ai][1][m][1]; }
            }
        }
    }
};
struct EpiUp {
    static constexpr int NST = 16;
    static constexpr bool PERM = true, WIDE = true;
    GAS bf16* QM_; GAS bf16* KVM_; const GAS float* SSQ_; const GAS float* COS_; const GAS float* SIN_;
    struct Pre { f32x4 v[8]; };
    __device__ __forceinline__ Pre prefetch(const Unit& u, int wr, int fr) const { Pre p; const GAS float* SSQ = SSQ_; asm volatile("" : "+s"(SSQ)); const int off = u.e ? 4 : 0;
#pragma unroll
        for (int g = 0; g < 8; ++g) p.v[g] = *(const GAS f32x4*)(SSQ + (size_t)(u.pm * 256 + (g >> 2) * 128 + wr * 64 + (g & 3) * 16 + fr) * 8 + off); return p; }
    __device__ __forceinline__ void operator()(const f32x4 (&acc)[2][2][4][2], const Unit& u, int wr, int wc, int fr, int fq, const Pre& pre) const {
        GAS bf16* QM = QM_; GAS bf16* KVM = KVM_; const GAS float* SSQ = SSQ_; const GAS float* COS = COS_; const GAS float* SIN = SIN_;
        asm volatile("" : "+s"(QM), "+s"(KVM), "+s"(SSQ), "+s"(COS), "+s"(SIN));
        const int row0 = u.pm * 256 + wr * 64 + fr; const int pn = u.pn; const bool kv = u.e != 0;
        const bool lo = fr < 8; const int roww = u.pm * 256 + wr * 64 + (fr & 7), colw = pn * 256 + wc * 64 + (fr >> 3) * 32 + 8 * fq;
#pragma unroll
        for (int ai = 0; ai < 2; ++ai)
#pragma unroll
            for (int m = 0; m < 4; ++m) { const int row = row0 + ai * 128 + m * 16;
                const f32x4 sq = pre.v[ai * 4 + m];
                const float ss = (sq[0] + sq[1]) + (sq[2] + sq[3]);
                if (kv) {
                    const float rs = rsqrtf(ss * (1.f / 128.f) + EPS);
                    wide_store(KVM + (size_t)(roww + ai * 128 + m * 16) * 1024 + colw, 8 * 1024 + (lo ? 32 : -32), lo, pack8(acc[ai][0][m][0] * rs, acc[ai][0][m][1] * rs), pack8(acc[ai][1][m][0] * rs, acc[ai][1][m][1] * rs));
                } else {
                    const float rs = rsqrtf(ss * (1.f / 256.f) + EPS) * C2M;
                    const f32x4 c = *(const GAS f32x4*)(COS + (size_t)row * 16 + 4 * fq), sn = *(const GAS f32x4*)(SIN + (size_t)row * 16 + 4 * fq);
                    u32x4 XY[2];
#pragma unroll
                    for (int bj = 0; bj < 2; ++bj) { f32x4 v0 = acc[ai][bj][m][0] * rs, v1 = acc[ai][bj][m][1] * rs;
                        const int G = 8 * pn + 2 * wc + bj;
                        if (G % 3 == 2) { const f32x4 x1 = v0, x2 = v1; v0 = x1 * c - x2 * sn; v1 = x1 * sn + x2 * c; }
                        XY[bj] = pack8(v0, v1); }
                    wide_store(QM + (size_t)(roww + ai * 128 + m * 16) * 768 + colw, 8 * 768 + (lo ? 32 : -32), lo, XY[0], XY[1]);
                }

            }
    }
};
template <bool RES_F32> struct EpiOut {
    static constexpr int NST = 16;
    static constexpr bool PERM = true, WIDE = true;
    const GAS float* resf_; GAS bf16* xr_;
    struct Pre {}; __device__ __forceinline__ Pre prefetch(const Unit&, int, int) const { return Pre{}; }
    __device__ __forceinline__ void operator()(const f32x4 (&acc)[2][2][4][2], const Unit& u, int wr, int wc, int fr, int fq, const LAS f32x2* scl) const {
        const GAS float* resf = resf_; GAS bf16* xr = xr_; asm volatile("" : "+s"(resf), "+s"(xr));
        const int row0 = u.pm * 256 + wr * 64 + fr, col0 = u.pn * 256 + wc * 64 + 8 * fq;
        const bool lo = fr < 8; const int roww = u.pm * 256 + wr * 64 + (fr & 7), colw = u.pn * 256 + wc * 64 + (fr >> 3) * 32 + 8 * fq;
#pragma unroll
        for (int ai = 0; ai < 2; ++ai)
#pragma unroll
            for (int m = 0; m < 4; ++m) { const size_t off = (size_t)(row0 + ai * 128 + m * 16) * DM + col0; const float sh = scl[ai * 128 + wr * 64 + m * 16 + fr][1];
                u32x4 XY[2];
#pragma unroll
                for (int bj = 0; bj < 2; ++bj) { f32x4 r0, r1;
                    if constexpr (RES_F32) { r0 = *(const GAS f32x4*)(resf + off + bj * 32); r1 = *(const GAS f32x4*)(resf + off + bj * 32 + 4); }
                    else { const u32x4 w = *(const GAS u32x4*)(xr + off + bj * 32);
                        r0 = (f32x4){__uint_as_float(w.x << 16), __uint_as_float(w.x & 0xffff0000u), __uint_as_float(w.y << 16), __uint_as_float(w.y & 0xffff0000u)};
                        r1 = (f32x4){__uint_as_float(w.z << 16), __uint_as_float(w.z & 0xffff0000u), __uint_as_float(w.w << 16), __uint_as_float(w.w & 0xffff0000u)}; }
                    XY[bj] = pack8(r0 + acc[ai][bj][m][0] * sh, r1 + acc[ai][bj][m][1] * sh); }
                wide_store(xr + (size_t)(roww + ai * 128 + m * 16) * DM + colw, 8 * DM + (lo ? 32 : -32), lo, XY[0], XY[1]); }
    }
};
struct EpiGU {
    static constexpr int NST = 8;
    static constexpr bool PERM = true, WIDE = false;
    GAS unsigned char* HH_; const GAS float* RS_;
    struct Pre { float v[8]; };
    __device__ __forceinline__ Pre prefetch(const Unit& u, int wr, int fr) const { Pre p; const GAS float* RS = RS_; asm volatile("" : "+s"(RS));
#pragma unroll
        for (int g = 0; g < 8; ++g) p.v[g] = RS[u.pm * 256 + (g >> 2) * 128 + wr * 64 + (g & 3) * 16 + fr]; return p; }
    __device__ __forceinline__ void operator()(const f32x4 (&acc)[2][2][4][2], const Unit& u, int wr, int wc, int fr, int fq, const Pre& pre) const {
        GAS unsigned char* HH = HH_; const GAS float* RS = RS_; asm volatile("" : "+s"(HH), "+s"(RS));
        const int row0 = u.pm * 256 + wr * 64 + fr;
#pragma unroll
        for (int ai = 0; ai < 2; ++ai)
#pragma unroll
            for (int m = 0; m < 4; ++m) { GAS unsigned char* rowp = HH + (size_t)(row0 + ai * 128 + m * 16) * 512 + u.pn * 128 + wc * 32 + 8 * fq; const float rs = pre.v[ai * 4 + m] * WSCALE_INV;
                f32x4 h[2];
#pragma unroll
                for (int n = 0; n < 2; ++n) { const f32x4 g = acc[ai][0][m][n] * rs, up = acc[ai][1][m][n] * rs;
#pragma unroll
                    for (int j = 0; j < 4; ++j) { const float sg = __builtin_amdgcn_rcpf(1.f + __builtin_amdgcn_exp2f(-g[j] * LOG2E)); h[n][j] = g[j] * sg * up[j]; } }
                u32x2 w; w.x = pk4_fp8(h[0][0], h[0][1], h[0][2], h[0][3]); w.y = pk4_fp8(h[1][0], h[1][1], h[1][2], h[1][3]); *(GAS u32x2*)rowp = w; }
    }
};
struct EpiDown {
    static constexpr int NST = 16;
    static constexpr bool PERM = true, WIDE = false;
    GAS unsigned char* Y_; const GAS float* GATEOF_;
    struct Pre { float v[8]; };
    __device__ __forceinline__ Pre prefetch(const Unit& u, int wr, int fr) const { Pre p; const GAS float* GT = GATEOF_; asm volatile("" : "+s"(GT));
#pragma unroll
        for (int g = 0; g < 8; ++g) p.v[g] = GT[u.pm * 256 + (g >> 2) * 128 + wr * 64 + (g & 3) * 16 + fr]; return p; }
    __device__ __forceinline__ void operator()(const f32x4 (&acc)[2][2][4][2], const Unit& u, int wr, int wc, int fr, int fq, const Pre& pre) const {
        GAS unsigned char* Y = Y_; const GAS float* GATEOF = GATEOF_; asm volatile("" : "+s"(Y), "+s"(GATEOF));
        const int row0 = u.pm * 256 + wr * 64 + fr;
#pragma unroll
        for (int ai = 0; ai < 2; ++ai)
#pragma unroll
            for (int m = 0; m < 4; ++m) { const int row = row0 + ai * 128 + m * 16; const float g = pre.v[ai * 4 + m]; GAS unsigned char* rowp = Y + (size_t)row * 1024 + u.pn * 256 + wc * 32 + 8 * fq;
#pragma unroll
                for (int bj = 0; bj < 2; ++bj) { const f32x4 v0 = acc[ai][bj][m][0] * g, v1 = acc[ai][bj][m][1] * g; u32x2 w; w.x = pk4_fp8(v0[0], v0[1], v0[2], v0[3]); w.y = pk4_fp8(v1[0], v1[1], v1[2], v1[3]); *(GAS u32x2*)(rowp + bj * 128) = w; } }
    }
};

namespace att {
constexpr int KSLOT = 12288, VSLOT = 8192;
constexpr int L_K = 0, L_V = 2 * KSLOT, L_BIAS = L_V + 2 * VSLOT, L_WS = L_BIAS + 8192, L_OST = L_WS + 8 * 64 * 4, L_END = L_OST + 8 * 4096;
__device__ __forceinline__ int crow(int r, int hi) { return (r & 3) + 8 * (r >> 2) + 4 * hi; }
typedef short v4i16_t __attribute__((ext_vector_type(4)));
__device__ __forceinline__ s16x4 vtr(const LAS char* p) { return __builtin_bit_cast(s16x4, __builtin_amdgcn_ds_read_tr16_b64_v4i16((LAS v4i16_t*)p)); }

constexpr int NSL = 5;
constexpr int R_K = 0, R_V = NSL * KSLOT, R_WS = R_V + NSL * VSLOT, R_OST = R_WS + 8 * 64 * 4, R_END = R_OST + 8 * 4096;
static_assert(R_END <= RING_BYTES, "attention LDS");
__device__ __forceinline__ void glds16(const GAS void* gsrc, unsigned lds_dst) { unsigned keep;
    asm volatile("s_mov_b32 %0, m0\n\ts_mov_b32 m0, %2\n\ts_nop 0\n\tglobal_load_lds_dwordx4 %1, off\n\ts_mov_b32 m0, %0" : "=&s"(keep) : "v"(gsrc), "s"(lds_dst) : "memory"); }
__device__ __forceinline__ void glds16s(const GAS void* sbase, unsigned voff, unsigned lds_dst) { unsigned keep;
    asm volatile("s_mov_b32 %0, m0\n\ts_mov_b32 m0, %3\n\ts_nop 0\n\tglobal_load_lds_dwordx4 %1, %2\n\ts_mov_b32 m0, %0" : "=&s"(keep) : "v"(voff), "s"((unsigned long long)sbase), "s"(lds_dst) : "memory"); }
struct Tens2 { const GAS bf16* Q; int qp; const GAS bf16* K; int kp; const GAS bf16* KX; const GAS bf16* V; int vp; GAS bf16* O; const GAS float* BIASF; const GAS float* NRM; GAS float* OSS; };
template <int MODE>
__device__ __forceinline__ int attn_unit2(const int wave_, int b, int h, int qb, const Tens2& T, LAS char* shm, const int slbase, const bool have_pro, const int qb_next, bf16x8 (&qr)[6], const int tstart) {
    constexpr int DKS = MODE ? 6 : 5, DKH = 3;
    constexpr float THR = 8.f;
    int wid = wave_; asm volatile("" : "+s"(wid));
    int lane = (int)__builtin_amdgcn_mbcnt_hi(~0u, __builtin_amdgcn_mbcnt_lo(~0u, 0u)); asm volatile("" : "+v"(lane)); const int r32 = lane & 31, hi = lane >> 5;
    const long rowbase = (long)b * SEQ; const int q0 = qb * 256, qw0 = q0 + wid * 32;
    const int NT = (q0 + 256) / 64, tlast = qw0 / 64;
    const int NTE = NT - tstart;
    const GAS bf16* Qw = T.Q + (rowbase + qw0) * T.qp + h * (MODE ? 96 : 64);
    const GAS bf16* Kh = T.K + rowbase * T.kp + h * (MODE ? 128 : 64);
    const GAS bf16* Vh = T.V + rowbase * T.vp + h * (MODE ? 128 : 64);
    LAS float* wsf = (LAS float*)(shm + R_WS) + wid * 64;
    const unsigned koff = (unsigned)(lane * T.kp + wid * 8) * 2u;
    const unsigned xoff = MODE ? (unsigned)(lane * 32 + (wid & 3) * 8) * 2u : (unsigned)(lane * 8) * 2u;
    const unsigned voff = (unsigned)((16 * (wid & 3) + (lane >> 2)) * T.vp + (wid >> 2) * 32 + (lane & 3) * 8) * 2u;
    const GAS bf16* xbase = MODE ? T.KX + rowbase * 32 : T.KX + ((long)b * 8 + h) * SEQ * 8;
    const int xstep = MODE ? 64 * 32 : 64 * 8;
    const unsigned kdst_a = (unsigned)(uintptr_t)(shm + R_K) + (unsigned)wid * 1024u, xdst_a = (unsigned)(uintptr_t)(shm + R_K) + (unsigned)(8 + (MODE ? (wid & 3) : 0)) * 1024u, vdst_a = (unsigned)(uintptr_t)(shm + R_V) + (unsigned)wid * 1024u;
#define A2_DMA(t, slot) do { \
        glds16s((const GAS void*)(Kh + (long)(t) * 64 * T.kp), koff, (unsigned)__builtin_amdgcn_readfirstlane((int)(kdst_a + (slot) * KSLOT))); \
        glds16s((const GAS void*)(xbase + (long)(t) * xstep), xoff, (unsigned)__builtin_amdgcn_readfirstlane((int)(xdst_a + (slot) * KSLOT))); \
        glds16s((const GAS void*)(Vh + (long)(t) * 64 * T.vp), voff, (unsigned)__builtin_amdgcn_readfirstlane((int)(vdst_a + (slot) * VSLOT))); } while (0)
    float mhat = 0.f, lrun = 0.f; f32x16 o[2]; o[0] = f32x16{}; o[1] = f32x16{}; f32x16 negm = f32x16{};
    const LAS char* vp0 = shm + R_V + ((lane >> 4) & 1) * 32 + (lane & 3) * 8 + (4 * hi + ((lane & 15) >> 2)) * 64;
#define A3_SLOT(k) ((slbase + (k)) % NSL)
    if (!have_pro) { A2_DMA(NT - 1, A3_SLOT(0)); A2_DMA(NT - 2, A3_SLOT(1)); A2_DMA(NT - 3, A3_SLOT(2)); }
    if (!have_pro) {
#pragma unroll
        for (int d0 = 0; d0 < (MODE ? 6 : 4); ++d0) qr[d0] = *(const GAS bf16x8*)(Qw + (long)r32 * T.qp + d0 * 16 + hi * 8); }
    if (MODE == 0) { const short one = hi ? (short)0 : (short)0x3F80; qr[DKS - 1] = (bf16x8){one, one, one, 0, 0, 0, 0, 0}; }
#pragma unroll
    for (int d0 = 0; d0 < DKS; ++d0) asm volatile("" : "+v"(qr[d0]));
#define A3_KLOADH(slot, H) do { const LAS char* kb_ = shm + R_K + (slot) * KSLOT + r32 * 16; _Pragma("unroll") for (int d0 = (H) * DKH; d0 < ((H) ? DKS : DKH); ++d0) { const int off = (MODE == 0 && d0 == 4) ? 8 * 1024 : d0 * 2048 + hi * 1024; \
        kf[2 * (d0 - (H) * DKH)] = *(const LAS bf16x8*)(kb_ + off); kf[2 * (d0 - (H) * DKH) + 1] = *(const LAS bf16x8*)(kb_ + off + 512); } } while (0)
#define A3_VLOAD(slot) do { const LAS char* vp_ = vp0 + (slot) * VSLOT; _Pragma("unroll") for (int q = 0; q < 8; ++q) { vlo[q] = vtr(vp_ + (q >> 2) * 4096 + (q & 3) * 1024); vhh[q] = vtr(vp_ + (q >> 2) * 4096 + (q & 3) * 1024 + 512); } } while (0)
#define A3_QKH(H) do { if ((H) == 0) { c0 = negm; c1 = negm; } _Pragma("unroll") for (int d0 = (H) * DKH; d0 < ((H) ? DKS : DKH); ++d0) { c0 = __builtin_amdgcn_mfma_f32_32x32x16_bf16(kf[2 * (d0 - (H) * DKH)], qr[d0], c0, 0, 0, 0); c1 = __builtin_amdgcn_mfma_f32_32x32x16_bf16(kf[2 * (d0 - (H) * DKH) + 1], qr[d0], c1, 0, 0, 0); } } while (0)
#define A3_EXP() do { float ls_ = 0.f; _Pragma("unroll") for (int r = 0; r < 16; ++r) { pp0[r] = __builtin_amdgcn_exp2f(pp0[r]); pp1[r] = __builtin_amdgcn_exp2f(pp1[r]); ls_ += pp0[r] + pp1[r]; } lrun += ls_; u32x4 w_; \
        w_.x = cvt_pk_bf16(pp0[0], pp0[1]); w_.y = cvt_pk_bf16(pp0[2], pp0[3]); w_.z = cvt_pk_bf16(pp0[4], pp0[5]); w_.w = cvt_pk_bf16(pp0[6], pp0[7]); pa[0] = __builtin_bit_cast(bf16x8, w_); \
        w_.x = cvt_pk_bf16(pp0[8], pp0[9]); w_.y = cvt_pk_bf16(pp0[10], pp0[11]); w_.z = cvt_pk_bf16(pp0[12], pp0[13]); w_.w = cvt_pk_bf16(pp0[14], pp0[15]); pa[1] = __builtin_bit_cast(bf16x8, w_); \
        w_.x = cvt_pk_bf16(pp1[0], pp1[1]); w_.y = cvt_pk_bf16(pp1[2], pp1[3]); w_.z = cvt_pk_bf16(pp1[4], pp1[5]); w_.w = cvt_pk_bf16(pp1[6], pp1[7]); pa[2] = __builtin_bit_cast(bf16x8, w_); \
        w_.x = cvt_pk_bf16(pp1[8], pp1[9]); w_.y = cvt_pk_bf16(pp1[10], pp1[11]); w_.z = cvt_pk_bf16(pp1[12], pp1[13]); w_.w = cvt_pk_bf16(pp1[14], pp1[15]); pa[3] = __builtin_bit_cast(bf16x8, w_); } while (0)
#define A3_PV() do { _Pragma("unroll") for (int d0 = 0; d0 < 2; ++d0) _Pragma("unroll") for (int k = 0; k < 4; ++k) { const s16x4 lo_ = vlo[4 * d0 + k], hh_ = vhh[4 * d0 + k]; \
        const bf16x8 vf_ = (bf16x8){lo_[0], lo_[1], lo_[2], lo_[3], hh_[0], hh_[1], hh_[2], hh_[3]}; o[d0] = __builtin_amdgcn_mfma_f32_32x32x16_bf16(pa[k], vf_, o[d0], 0, 0, 0); } } while (0)
#define A3_ROWMAX(rm) do { float a_ = fmaxf(fmaxf(c0[0], c0[1]), c1[0]), b_ = fmaxf(fmaxf(c0[2], c0[3]), c1[1]); a_ = fmaxf(fmaxf(a_, c1[2]), c1[3]); \
        _Pragma("unroll") for (int r = 4; r < 16; r += 4) { a_ = fmaxf(fmaxf(a_, c0[r]), c0[r + 1]); b_ = fmaxf(fmaxf(b_, c0[r + 2]), c0[r + 3]); a_ = fmaxf(fmaxf(a_, c1[r]), c1[r + 1]); b_ = fmaxf(fmaxf(b_, c1[r + 2]), c1[r + 3]); } \
        rm = fmaxf(a_, b_); const auto rr_ = __builtin_amdgcn_permlane32_swap(__float_as_uint(rm), __float_as_uint(rm), false, false); rm = fmaxf(__uint_as_float(rr_[0]), __uint_as_float(rr_[1])); } while (0)
    int sl = A3_SLOT(0), sl3 = A3_SLOT(3);
    f32x16 pp0 = f32x16{}, pp1 = f32x16{}; bool pend = false; int pslot = 0;
    for (int i = 0; i < NTE; ++i) {
        const int t = NT - 1 - i;
        { const int ahead = NTE - 1 - i;
          if (ahead >= 2) asm volatile("s_waitcnt vmcnt(6)" ::: "memory"); else if (ahead == 1) asm volatile("s_waitcnt vmcnt(3)" ::: "memory"); else asm volatile("s_waitcnt vmcnt(0)" ::: "memory"); }
        __builtin_amdgcn_s_barrier(); asm volatile("" ::: "memory");
        if (i + 3 < NTE) A2_DMA(t - 3, sl3);
        if (i == NTE - 1 && qb_next >= 0) { const int NTn = 4 * qb_next + 4; A2_DMA(NTn - 1, A3_SLOT(NTE)); A2_DMA(NTn - 2, A3_SLOT(NTE + 1)); A2_DMA(NTn - 3, A3_SLOT(NTE + 2)); }
        if (t <= tlast) {
            bf16x8 kf[2 * DKH]; f32x16 c0, c1; float rm;
            A3_KLOADH(sl, 0);
            if (!pend) {
                A3_QKH(0); A3_KLOADH(sl, 1); A3_QKH(1);
                if (MODE == 0) { const int qrel = qw0 + r32 - 64 * t;
#pragma unroll
                    for (int r = 0; r < 16; ++r) { const int kv = crow(r, hi); if (kv > qrel) c0[r] = -INFINITY; if (kv + 32 > qrel) c1[r] = -INFINITY; } }
                A3_ROWMAX(rm);
                mhat = rm;
#pragma unroll
                for (int r = 0; r < 16; ++r) { c0[r] -= rm; c1[r] -= rm; negm[r] = -mhat; }
                pend = true;
            } else {
                s16x4 vlo[8], vhh[8]; bf16x8 pa[4];
                A3_QKH(0); A3_KLOADH(sl, 1);
                A3_VLOAD(pslot);
                A3_QKH(1);
                A3_EXP();
#pragma unroll
                for (int g_ = 0; g_ < 2 * DKS; ++g_) { __builtin_amdgcn_sched_group_barrier(0x008, 1, 0); __builtin_amdgcn_sched_group_barrier(0x002, 7, 0); }
                A3_PV();
                A3_ROWMAX(rm);
#pragma unroll
                for (int g_ = 0; g_ < 8; ++g_) { __builtin_amdgcn_sched_group_barrier(0x008, 1, 0); __builtin_amdgcn_sched_group_barrier(0x002, 3, 0); }
                if (__any(rm > THR)) {
                    const float dl = fmaxf(rm, 0.f); mhat += dl;
#pragma unroll
                    for (int r = 0; r < 16; ++r) { c0[r] -= dl; c1[r] -= dl; negm[r] = -mhat; }
                    const float f = __builtin_amdgcn_exp2f(-dl); lrun *= f;
                    if (hi == 0) wsf[r32] = f;
                    LDS_WAIT();
#pragma unroll
                    for (int g = 0; g < 4; ++g) { const f32x4 ff = *(const LAS f32x4*)(wsf + 8 * g + 4 * hi);
#pragma unroll
                        for (int j = 0; j < 4; ++j) { o[0][4 * g + j] *= ff[j]; o[1][4 * g + j] *= ff[j]; } }
                }
            }
            pp0 = c0; pp1 = c1; pslot = sl;
        }
        sl = (sl == NSL - 1) ? 0 : sl + 1; sl3 = (sl3 == NSL - 1) ? 0 : sl3 + 1;
    }
    if (qb_next >= 0) { const GAS bf16* Qn = T.Q + (rowbase + qb_next * 256 + wid * 32) * T.qp + h * (MODE ? 96 : 64);
#pragma unroll
        for (int d0 = 0; d0 < (MODE ? 6 : 4); ++d0) qr[d0] = *(const GAS bf16x8*)(Qn + (long)r32 * T.qp + d0 * 16 + hi * 8); }
    if (pend) { s16x4 vlo[8], vhh[8]; bf16x8 pa[4]; A3_VLOAD(pslot); A3_EXP(); A3_PV(); }
#undef A3_KLOADH
#undef A3_VLOAD
#undef A3_QKH
#undef A3_EXP
#undef A3_PV
#undef A3_ROWMAX
#undef A2_DMA
    lrun += __shfl_xor(lrun, 32);
    LDS_WAIT();
    if (hi == 0) wsf[32 + r32] = lrun;
    LDS_WAIT();
    float rli[16];
#pragma unroll
    for (int g = 0; g < 4; ++g) { const f32x4 ll = *(const LAS f32x4*)(wsf + 32 + 8 * g + 4 * hi);
#pragma unroll
        for (int j = 0; j < 4; ++j) rli[4 * g + j] = __builtin_amdgcn_rcpf(ll[j]); }
    GAS bf16* Ow = T.O + (rowbase + qw0) * 1024 + (MODE ? 0 : 512) + h * 64;
    { LAS bf16* stg = (LAS bf16*)(shm + R_OST) + wid * 2048;
#pragma unroll
      for (int r = 0; r < 16; ++r) { const int orow = crow(r, hi);
#pragma unroll
          for (int d0 = 0; d0 < 2; ++d0) stg[orow * 64 + d0 * 32 + r32] = (bf16)(cvt_pk_bf16(o[d0][r] * rli[r], 0.f) & 0xffffu); }
      LDS_WAIT();
#pragma unroll
      for (int i = 0; i < 4; ++i) { const int row = i * 8 + (lane >> 3), ch = lane & 7; const u32x4 v = *(const LAS u32x4*)(stg + row * 64 + ch * 8); *(GAS u32x4*)(Ow + (long)row * 1024 + ch * 8) = v;
          float sq = 0.f;
#pragma unroll
          for (int j = 0; j < 4; ++j) { const float a0 = __uint_as_float(v[j] << 16), a1 = __uint_as_float(v[j] & 0xffff0000u); sq += a0 * a0 + a1 * a1; }
          sq += __shfl_xor(sq, 1); sq += __shfl_xor(sq, 2); sq += __shfl_xor(sq, 4);
          if (ch == 0) T.OSS[(rowbase + qw0 + row) * 16 + (MODE ? 0 : 8) + h] = sq; } }
    if (qb_next < 0) { LDS_WAIT(); __builtin_amdgcn_s_barrier(); asm volatile("" ::: "memory"); }
    return A3_SLOT(NTE);
#undef A3_SLOT
}
}

struct Args { const void* in[21]; float* out; unsigned char* ws; int ph_lo, ph_hi; };

__device__ __forceinline__ void tr_item(const GAS float* __restrict__ W, int ldw, int Ksrc, const GAS float* __restrict__ gain, GAS bf16* __restrict__ WT, int ldk, int k0, int n0, int srccol, LAS float* scr, int lane) {
#pragma unroll 8
    for (int i = 0; i < 32; ++i) { const int kk = 2 * i + (lane >> 5); const int k = k0 + kk;
        float v = 0.f; if (srccol >= 0 && k < Ksrc) { v = __builtin_nontemporal_load(W + (size_t)k * ldw + srccol); if (gain) v *= gain[k]; }
        scr[kk * 33 + (lane & 31)] = v; }
    LDS_WAIT(); asm volatile("" ::: "memory");
    const int c = lane & 7;
#pragma unroll
    for (int j = 0; j < 4; ++j) { const int n = (lane >> 3) + 8 * j; const LAS float* s = scr + (8 * c) * 33 + n;
        u32x4 o; o.x = cvt_pk_bf16(s[0 * 33], s[1 * 33]); o.y = cvt_pk_bf16(s[2 * 33], s[3 * 33]); o.z = cvt_pk_bf16(s[4 * 33], s[5 * 33]); o.w = cvt_pk_bf16(s[6 * 33], s[7 * 33]);
        *(GAS u32x4*)(WT + (size_t)(n0 + n) * ldk + k0 + 8 * c) = o; }
    LDS_WAIT(); asm volatile("" ::: "memory");
}
__device__ __forceinline__ void tr_item64(const GAS float* __restrict__ W, int ldw, const GAS float* __restrict__ gain, GAS bf16* __restrict__ WT, int ldk, int k0, int n0src, int n0dst, LAS float* scr, int lane) {
    const int rr = lane >> 4, c4 = (lane & 15) * 4;
    f32x4 v[16];
#pragma unroll
    for (int i = 0; i < 16; ++i) v[i] = __builtin_nontemporal_load((const GAS f32x4*)(W + (size_t)(k0 + 4 * i + rr) * ldw + n0src + c4));
#pragma unroll
    for (int i = 0; i < 16; ++i) { const int k = 4 * i + rr; const float g = gain ? gain[k0 + k] : 1.f; LAS float* d = scr + k * 65 + c4;
        d[0] = v[i][0] * g; d[1] = v[i][1] * g; d[2] = v[i][2] * g; d[3] = v[i][3] * g; }
    LDS_WAIT(); asm volatile("" ::: "memory");
    const int kc = lane & 7;
#pragma unroll
    for (int j = 0; j < 8; ++j) { const int n = (lane >> 3) + 8 * j; const LAS float* sp = scr + (8 * kc) * 65 + n;
        u32x4 o; o.x = cvt_pk_bf16(sp[0 * 65], sp[1 * 65]); o.y = cvt_pk_bf16(sp[2 * 65], sp[3 * 65]); o.z = cvt_pk_bf16(sp[4 * 65], sp[5 * 65]); o.w = cvt_pk_bf16(sp[6 * 65], sp[7 * 65]);
        *(GAS u32x4*)(WT + (size_t)(n0dst + n) * ldk + k0 + 8 * kc) = o; }
    LDS_WAIT(); asm volatile("" ::: "memory");
}
__device__ __forceinline__ void tr_item64_f8(const GAS float* __restrict__ W, int ldw, const GAS float* __restrict__ gain, float scale, GAS unsigned char* __restrict__ WT8, int ldkB, int k0, int n0src, int n0dst, LAS float* scr, int lane) {
    const int rr = lane >> 4, c4 = (lane & 15) * 4;
    f32x4 v[16];
#pragma unroll
    for (int i = 0; i < 16; ++i) v[i] = __builtin_nontemporal_load((const GAS f32x4*)(W + (size_t)(k0 + 4 * i + rr) * ldw + n0src + c4));
#pragma unroll
    for (int i = 0; i < 16; ++i) { const int k = 4 * i + rr; const float g = (gain ? gain[k0 + k] : 1.f) * scale; LAS float* d = scr + k * 65 + c4;
        d[0] = v[i][0] * g; d[1] = v[i][1] * g; d[2] = v[i][2] * g; d[3] = v[i][3] * g; }
    LDS_WAIT(); asm volatile("" ::: "memory");
    const int kc = lane & 7;
#pragma unroll
    for (int j = 0; j < 8; ++j) { const int n = (lane >> 3) + 8 * j; const LAS float* sp = scr + (8 * kc) * 65 + n;
        u32x2 o; o.x = pk4_fp8(sp[0 * 65], sp[1 * 65], sp[2 * 65], sp[3 * 65]); o.y = pk4_fp8(sp[4 * 65], sp[5 * 65], sp[6 * 65], sp[7 * 65]);
        *(GAS u32x2*)(WT8 + (size_t)(n0dst + n) * ldkB + k0 + 8 * kc) = o; }
    LDS_WAIT(); asm volatile("" ::: "memory");
}
__device__ __forceinline__ int rope_dim(int p) { const int a = p >> 3, j = p & 7; return j < 4 ? 4 * a + j : 16 + 4 * a + (j - 4); }

#define LDP(i) ((void*)((((unsigned long long)(unsigned)__builtin_amdgcn_readfirstlane((int)(ARGP[i] >> 32))) << 32) | (unsigned long long)(unsigned)__builtin_amdgcn_readfirstlane((int)(unsigned)ARGP[i])))
#define ARGIN(i) ((const void*)LDP(i))
#define P_COS ((GAS float*)(ws + WS_COS))
#define P_SIN ((GAS float*)(ws + WS_SIN))
#define P_SSQ ((GAS float*)(ws + WS_SSQ))
#define P_FLOG ((GAS float*)(ws + WS_FLOG))
#define P_E01 ((GAS int*)(ws + WS_E01))
#define P_G01 ((GAS float*)(ws + WS_G01))
#define P_SLOT ((GAS int*)(ws + WS_SLOT))
#define P_TOKOF ((GAS int*)(ws + WS_TOKOF))
#define P_GATEOF ((GAS float*)(ws + WS_GATEOF))
#define P_CNT ((GAS int*)(ws + WS_CNT))
#define P_TSTART ((GAS int*)(ws + WS_TSTART))
#define P_RSTD ((GAS float*)(ws + WS_RSTD))
#define P_RSTDOF ((GAS float*)(ws + WS_RSTDOF))
#define P_KPE ((GAS bf16*)(ws + WS_KPE))
#define P_KAUG ((GAS bf16*)(ws + WS_KAUG))
#define P_BIASF ((GAS float*)(ws + WS_BIASF))
#define P_NRM ((GAS float*)(ws + WS_NRM))
#define P_WR ((GAS bf16*)(ws + WS_WR))
#define P_XR ((GAS bf16*)(ws + WS_XR))
#define P_OSS ((GAS float*)(ws + WS_OSS))
#define P_RSTDX ((GAS float*)(ws + WS_RSTDX))
#define P_WIN ((GAS bf16*)(ws + WS_WIN))
#define P_WUQ ((GAS bf16*)(ws + WS_WUQ))
#define P_WUKV ((GAS bf16*)(ws + WS_WUKV))
#define P_WOUT ((GAS bf16*)(ws + WS_WOUT))
#define P_WGU_L(ll) ((GAS unsigned char*)(ws + WS_WGU + (size_t)((ll) & 1) * 32 * MiB))
#define P_WD_L(ll) ((GAS unsigned char*)(ws + WS_WD + (size_t)((ll) & 1) * 16 * MiB))
#define P_XN ((GAS bf16*)(ws + WS_XN))
#define P_FQKV ((GAS bf16*)(ws + WS_FQKV))
#define P_HH ((GAS bf16*)(ws + WS_FQKV))
#define P_LAT ((GAS bf16*)(ws + WS_LAT))
#define P_QM ((GAS bf16*)(ws + WS_QM))
#define P_KVM ((GAS bf16*)(ws + WS_KVM))
#define P_Y ((GAS bf16*)(ws + WS_Y))
#define IN(k) (lo <= (k) && (k) < hi_)
#if MK_ONE_LAUNCH
#define GRID_BAR() xcd_barrier(bar)
#else
#define GRID_BAR() do {} while (0)
#endif
#define SEAM(k) do { if (IN(k) && IN((k) + 1)) GRID_BAR(); } while (0)
__device__ __forceinline__ void conv_gu_item(int r, const GAS float* w_gate, const GAS float* w_up, const GAS float* ffn_norm, GAS unsigned char* WGU, LAS float* scr64, int lane) {
    const int e = r / 256, q = r % 256, kb = q / 16, nb = q % 16; const int n0 = nb * 64; const int ct = n0 >> 8, which = (n0 >> 7) & 1, jj = n0 & 127;
    const GAS float* src = (which ? w_up : w_gate) + (size_t)e * DM * DEXP;
    tr_item64_f8(src, DEXP, ffn_norm, WSCALE, WGU + (size_t)e * 1024 * 1024, DM, kb * 64, ct * 128 + jj, n0, scr64, lane);
}
__device__ __forceinline__ void conv_d_item(int r, const GAS float* w_down, GAS unsigned char* WD, LAS float* scr64, int lane) {
    const int e = r / 128, q = r % 128, kb = q / 16, nb = q % 16;
    tr_item64_f8(w_down + (size_t)e * DEXP * DM, DM, nullptr, WSCALE, WD + (size_t)e * 1024 * 512, DEXP, kb * 64, nb * 64, nb * 64, scr64, lane);
}
template <int l>
__device__ __forceinline__ void layer_body(const int lo, const int hi_, LAS unsigned char* lds0, const int wave0, const int G0, const int bx0, const XcdBarrier& bar) {
        const int P = 10 * l;
        if (IN(P)) for (int rep_ = 0; rep_ < (l == 0 ? NREP(0) : 1); ++rep_) {
            unsigned ldsb_ = (unsigned)(uintptr_t)lds0; asm volatile("" : "+s"(ldsb_)); LAS unsigned char* lds = (LAS unsigned char*)(uintptr_t)ldsb_; volatile LAS unsigned* MISC = (volatile LAS unsigned*)(lds + MISC_OFF); volatile LAS unsigned long long* ARGP = (volatile LAS unsigned long long*)(lds + MISC_OFF + 768); (void)MISC; int wave = wave0, G = G0, bx = bx0; asm volatile("" : "+s"(G), "+s"(bx), "+s"(wave)); const int lane = (int)__builtin_amdgcn_mbcnt_hi(~0u, __builtin_amdgcn_mbcnt_lo(~0u, 0u)); const int tid = wave * 64 + lane; const int vcu = (bx % 8) * (G / 8) + bx / 8; const int gw = vcu * 8 + wave, NGW = G * 8; (void)lane; (void)gw; (void)NGW; (void)vcu;
            GAS unsigned char* ws = (GAS unsigned char*)LDP(22); GAS float* out = (GAS float*)LDP(21); const GAS float* x_in = (const GAS float*)ARGIN(0); const GAS int* positions = (const GAS int*)ARGIN(1);
            if (l < NLAYER) {
                LAS float* scr = (LAS float*)(lds + wave * 16640);
                const GAS float* attn_norm = (const GAS float*)ARGIN(2) + (size_t)l * DM; const GAS float* w_in = (const GAS float*)ARGIN(3) + (size_t)l * DM * INW;
                const GAS float* q_norm = (const GAS float*)ARGIN(5) + (size_t)l * 256; const GAS float* w_uq = (const GAS float*)ARGIN(6) + (size_t)l * 256 * 768;
                const GAS float* kv_norm = (const GAS float*)ARGIN(7) + (size_t)l * 128; const GAS float* w_ukv = (const GAS float*)ARGIN(8) + (size_t)l * 128 * 1024;
                const GAS float* mla_on = (const GAS float*)ARGIN(9) + (size_t)l * 512; const GAS float* fox_on = (const GAS float*)ARGIN(10) + (size_t)l * 512; const GAS float* w_out = (const GAS float*)ARGIN(11) + (size_t)l * DM * DM;
                const GAS float* ffn_norm = (const GAS float*)ARGIN(12) + (size_t)l * DM;
                const GAS float* w_gate = (const GAS float*)ARGIN(17) + (size_t)l * NEXP * DM * DEXP; const GAS float* w_up = (const GAS float*)ARGIN(18) + (size_t)l * NEXP * DM * DEXP; const GAS float* w_down = (const GAS float*)ARGIN(19) + (size_t)l * NEXP * DEXP * DM;
                constexpr int I_IN = 16 * 64, I_UQ = 4 * 24, I_UKV = 4 * 32;
                constexpr int NITEMS = I_IN + I_UQ + I_UKV;
                for (int it = vcu + G * wave; it < NITEMS; it += NGW) {
                    int r = it; const int j = lane & 31;
                    if (r < I_IN) { const int kb = r / 64, nb = r % 64; const int n = nb * 32 + j; int sc;
                        if (n < 384) sc = n; else if (n < 416) sc = 384 + rope_dim(n - 384); else if (n < 424) sc = 1952 + (n - 416); else if (n < 512) sc = -1; else sc = 416 + (n - 512);
                        tr_item(w_in, INW, DM, attn_norm, P_WIN, DM, kb * 64, nb * 32, sc, scr, lane); continue; } r -= I_IN;
                    if (r < I_UQ) { const int kb = r / 24, nb = r % 24; const int n = nb * 32 + j; const int hh = n / 96, d = n % 96; const int sc = d < 64 ? n : hh * 96 + 64 + rope_dim(d - 64);
                        tr_item(w_uq, 768, 256, q_norm, P_WUQ, 256, kb * 64, nb * 32, sc, scr, lane); continue; } r -= I_UQ;
                    { const int kb = r / 32, nb = r % 32; tr_item(w_ukv, 1024, 128, kv_norm, P_WUKV, 256, kb * 64, nb * 32, nb * 32 + j, scr, lane); }
                }
                LAS float* scr64 = (LAS float*)(lds + wave * 16640);
                constexpr int J_OUT = 16 * 16, J_GU = 16 * 16 * NEXP, J_D = 8 * 16 * NEXP;
                for (int it = vcu + G * ((wave + 1) & 7); it < J_OUT + (l == 0 ? J_GU + J_D : 0); it += NGW) {
                    int r = it;
                    if (r < J_OUT) { const int kb = r / 16, nb = r % 16; const GAS float* gn = kb < 8 ? mla_on : fox_on - 512; tr_item64(w_out, DM, gn, P_WOUT, DM, kb * 64, nb * 64, nb * 64, scr64, lane); continue; } r -= J_OUT;
                    if (r < J_GU) { conv_gu_item(r, w_gate, w_up, ffn_norm, P_WGU_L(l), scr64, lane); continue; } r -= J_GU;
                    conv_d_item(r, w_down, P_WD_L(l), scr64, lane);
                }
                { const GAS float* w_rg = (const GAS float*)ARGIN(13) + (size_t)l * DM * 4; const GAS float* w_re = (const GAS float*)ARGIN(15) + (size_t)l * DM * 32;
                  for (int idx = bx * 512 + tid; idx < 2 * 48 * 520; idx += G * 512) { const int half = idx / (48 * 520), r = idx % (48 * 520), c = r / 520, kk = r % 520; const int k = half * 512 + kk;
                      float w = 0.f; if (c < 36 && kk < 512) w = ffn_norm[k] * (c < 4 ? w_rg[k * 4 + c] : w_re[k * 32 + (c - 4)]);
                      const unsigned h16 = cvt_pk_bf16(w, 0.f) & 0xffffu; const unsigned l16 = cvt_pk_bf16(w - __uint_as_float(h16 << 16), 0.f) & 0xffffu;
                      P_WR[(size_t)(half * 2 + 0) * 48 * 520 + r] = (bf16)h16; P_WR[(size_t)(half * 2 + 1) * 48 * 520 + r] = (bf16)l16; } }
            }
            const GAS float* fin = (const GAS float*)ARGIN(20);
            for (int mb = gw * 4; mb < NTOK; mb += NGW * 4) {
                f32x4 v[4][4]; int s0[4], s1[4];
                if (l > 0) {
#pragma unroll
                    for (int r = 0; r < 4; ++r) { s0[r] = P_SLOT[2 * (mb + r)]; s1[r] = P_SLOT[2 * (mb + r) + 1]; }
                }
#pragma unroll
                for (int r = 0; r < 4; ++r) {
                    if (l == 0) { const GAS float* xr = x_in + (size_t)(mb + r) * DM;
#pragma unroll
                        for (int j = 0; j < 4; ++j) v[r][j] = __builtin_nontemporal_load((const GAS f32x4*)(xr + 4 * lane + 256 * j)); }
                    else { const GAS bf16* xr = P_XR + (size_t)(mb + r) * DM;
#pragma unroll
                        for (int j = 0; j < 4; ++j) { const u32x2 w = __builtin_nontemporal_load((const GAS u32x2*)(xr + 4 * lane + 256 * j)); v[r][j] = (f32x4){__uint_as_float(w.x << 16), __uint_as_float(w.x & 0xffff0000u), __uint_as_float(w.y << 16), __uint_as_float(w.y & 0xffff0000u)}; } } }
                if (l > 0) {
#pragma unroll
                    for (int r = 0; r < 4; ++r)
#pragma unroll
                        for (int j = 0; j < 4; ++j) { const int a = __builtin_nontemporal_load((const GAS int*)((const GAS unsigned char*)P_Y + (size_t)s0[r] * 1024 + 4 * lane + 256 * j)), c = __builtin_nontemporal_load((const GAS int*)((const GAS unsigned char*)P_Y + (size_t)s1[r] * 1024 + 4 * lane + 256 * j));
                            const f32x2 a0 = __builtin_amdgcn_cvt_pk_f32_fp8(a, false), a1 = __builtin_amdgcn_cvt_pk_f32_fp8(a, true), c0 = __builtin_amdgcn_cvt_pk_f32_fp8(c, false), c1 = __builtin_amdgcn_cvt_pk_f32_fp8(c, true);
                            v[r][j][0] += (a0[0] + c0[0]) * WSCALE_INV; v[r][j][1] += (a0[1] + c0[1]) * WSCALE_INV; v[r][j][2] += (a1[0] + c1[0]) * WSCALE_INV; v[r][j][3] += (a1[1] + c1[1]) * WSCALE_INV; }
                }
                float ss[4];
#pragma unroll
                for (int r = 0; r < 4; ++r) { float s = 0.f;
#pragma unroll
                    for (int j = 0; j < 4; ++j) s += (v[r][j][0] * v[r][j][0] + v[r][j][1] * v[r][j][1]) + (v[r][j][2] * v[r][j][2] + v[r][j][3] * v[r][j][3]);
                    ss[r] = s; }
#pragma unroll
                for (int o = 1; o < 64; o <<= 1) {
#pragma unroll
                    for (int r = 0; r < 4; ++r) ss[r] += __shfl_xor(ss[r], o); }
#pragma unroll
                for (int r = 0; r < 4; ++r) { const int m = mb + r; const float rstd = rsqrtf(ss[r] * (1.f / DM) + EPS);
                    if (l < NLAYER) {
#pragma unroll
                        for (int j = 0; j < 4; ++j) { u32x2 w; w.x = cvt_pk_bf16(v[r][j][0], v[r][j][1]); w.y = cvt_pk_bf16(v[r][j][2], v[r][j][3]); *(GAS u32x2*)(P_XR + (size_t)m * DM + 4 * lane + 256 * j) = w; }
                        if (lane == 0) P_RSTDX[m] = rstd;
                    } else {
#pragma unroll
                        for (int j = 0; j < 4; ++j) { const f32x4 g = *(const GAS f32x4*)(fin + 4 * lane + 256 * j); __builtin_nontemporal_store(v[r][j] * rstd * g, (GAS f32x4*)(out + (size_t)m * DM + 4 * lane + 256 * j)); }
                    }
                }
            }
        }
        if constexpr (l == NLAYER) return;
        SEAM(P);
        if (IN(P + 1)) for (int rep_ = 0; rep_ < ((l == 0 || 1 != 5) ? NREP(1) : 1); ++rep_) {
            unsigned ldsb_ = (unsigned)(uintptr_t)lds0; asm volatile("" : "+s"(ldsb_)); LAS unsigned char* lds = (LAS unsigned char*)(uintptr_t)ldsb_; volatile LAS unsigned* MISC = (volatile LAS unsigned*)(lds + MISC_OFF); volatile LAS unsigned long long* ARGP = (volatile LAS unsigned long long*)(lds + MISC_OFF + 768); (void)MISC; int wave = wave0, G = G0, bx = bx0; asm volatile("" : "+s"(G), "+s"(bx), "+s"(wave)); const int lane = (int)__builtin_amdgcn_mbcnt_hi(~0u, __builtin_amdgcn_mbcnt_lo(~0u, 0u)); const int tid = wave * 64 + lane; const int vcu = (bx % 8) * (G / 8) + bx / 8; const int gw = vcu * 8 + wave, NGW = G * 8; (void)lane; (void)gw; (void)NGW; (void)vcu;
            GAS unsigned char* ws = (GAS unsigned char*)LDP(22); GAS float* out = (GAS float*)LDP(21); const GAS float* x_in = (const GAS float*)ARGIN(0); (void)out; (void)x_in; (void)ws;
            DenseOrder S{NTOK / 256, INP / 256, (NTOK / 256) * (INP / 256), G, bx, (const GAS char*)P_XR, (const GAS char*)P_WIN, (size_t)256 * DM * 2, (size_t)256 * DM * 2};
            EpiWin E{P_LAT, P_FQKV, P_KPE, P_FLOG, P_SSQ, P_COS, P_SIN, P_RSTDX};
            pg8::gemm_phase<EpiWin, DenseOrder, true, false>(tid, lds, DM * 2, DM * 2, DM * 2, S, E, nullptr);
        }
        SEAM(P + 1);
        if (IN(P + 2)) for (int rep_ = 0; rep_ < ((l == 0 || 2 != 5) ? NREP(2) : 1); ++rep_) {
            unsigned ldsb_ = (unsigned)(uintptr_t)lds0; asm volatile("" : "+s"(ldsb_)); LAS unsigned char* lds = (LAS unsigned char*)(uintptr_t)ldsb_; volatile LAS unsigned* MISC = (volatile LAS unsigned*)(lds + MISC_OFF); volatile LAS unsigned long long* ARGP = (volatile LAS unsigned long long*)(lds + MISC_OFF + 768); (void)MISC; int wave = wave0, G = G0, bx = bx0; asm volatile("" : "+s"(G), "+s"(bx), "+s"(wave)); const int lane = (int)__builtin_amdgcn_mbcnt_hi(~0u, __builtin_amdgcn_mbcnt_lo(~0u, 0u)); const int tid = wave * 64 + lane; const int vcu = (bx % 8) * (G / 8) + bx / 8; const int gw = vcu * 8 + wave, NGW = G * 8; (void)lane; (void)gw; (void)NGW; (void)vcu;
            GAS unsigned char* ws = (GAS unsigned char*)LDP(22); GAS float* out = (GAS float*)LDP(21); const GAS float* x_in = (const GAS float*)ARGIN(0); (void)out; (void)x_in; (void)ws;
            {
                const int sq = vcu >> 1, hf = vcu & 1; const int b = sq >> 3, h = sq & 7; const float bf = ((const GAS float*)ARGIN(4))[l * 8 + h];
                const GAS float* fl = P_FLOG + ((size_t)b * SEQ + hf * 1024 + 2 * tid) * 8 + h;
                float lf[2], lg[2] = {0.f, 0.f};
#pragma unroll
                for (int e = 0; e < 2; ++e) { const float f = fl[e * 8] + bf; lf[e] = fminf(f, 0.f) - log1pf(expf(-fabsf(f))); }
                if (hf) {
#pragma unroll
                    for (int e = 0; e < 2; ++e) { const float f = fl[e * 8 - 1024 * 8] + bf; lg[e] = fminf(f, 0.f) - log1pf(expf(-fabsf(f))); } }
                const double s2 = (double)lf[0] + (double)lf[1];
                double incl = s2, first = (double)lg[0] + (double)lg[1];
#pragma unroll
                for (int o = 1; o < 64; o <<= 1) { const double t = __shfl_up(incl, o); if (lane >= o) incl += t; first += __shfl_xor(first, o); }
                LAS double* wtot = (LAS double*)lds;
                if (lane == 63) wtot[wave] = incl;
                if (lane == 0) wtot[8 + wave] = first;
                __syncthreads();
                double c = incl - s2;
                for (int w = 0; w < wave; ++w) c += wtot[w];
                if (hf) { for (int w = 0; w < 8; ++w) c += wtot[8 + w]; }
                const size_t t0 = ((size_t)b * 8 + h) * SEQ + hf * 1024 + 2 * tid;
                GAS u32x4* ka = (GAS u32x4*)(P_KAUG + t0 * 8);
                float xs[2];
#pragma unroll
                for (int e = 0; e < 2; ++e) { c += (double)lf[e]; const float x = (float)(-c * 1.4426950408889634); xs[e] = x;
                    const unsigned h16 = cvt_pk_bf16(x, 0.f) & 0xffffu; const float r1 = x - __uint_as_float(h16 << 16); const unsigned m16 = cvt_pk_bf16(r1, 0.f) & 0xffffu; const float r2 = r1 - __uint_as_float(m16 << 16); const unsigned l16 = cvt_pk_bf16(r2, 0.f) & 0xffffu;
                    ka[e] = (u32x4){h16 | (m16 << 16), l16, 0u, 0u}; P_BIASF[t0 + e] = x; }
                float qn = 0.f, kn = 0.f, xdm = INFINITY;
                { const GAS bf16* fqp = P_FQKV + ((size_t)b * SEQ + hf * 1024 + 2 * tid) * 512 + h * 64; const GAS bf16* fkp = fqp + (size_t)NTOK * 512;
#pragma unroll
                  for (int e = 0; e < 2; ++e) { float sq_ = 0.f, sk = 0.f, dd = 0.f;
#pragma unroll
                      for (int c8 = 0; c8 < 8; ++c8) { const u32x4 a = *(const GAS u32x4*)(fqp + e * 512 + c8 * 8), k4 = *(const GAS u32x4*)(fkp + e * 512 + c8 * 8);
#pragma unroll
                          for (int j = 0; j < 4; ++j) { const float a0 = __uint_as_float(a[j] << 16), a1 = __uint_as_float(a[j] & 0xffff0000u), k0 = __uint_as_float(k4[j] << 16), k1 = __uint_as_float(k4[j] & 0xffff0000u);
                              sq_ += a0 * a0 + a1 * a1; sk += k0 * k0 + k1 * k1; dd += a0 * k0 + a1 * k1; } }
                      qn = fmaxf(qn, sq_); kn = fmaxf(kn, sk); xdm = fminf(xdm, xs[e] + dd); } }
#pragma unroll
                for (int o = 1; o < 64; o <<= 1) { qn = fmaxf(qn, __shfl_xor(qn, o)); kn = fmaxf(kn, __shfl_xor(kn, o)); xdm = fminf(xdm, __shfl_xor(xdm, o)); }
                LAS float* knw = (LAS float*)(lds + 256);
                if (lane == 0) { knw[wave] = kn; knw[8 + wave] = qn; knw[16 + wave] = xdm; }
                __syncthreads();
                if (tid < 4) { P_NRM[sq * 32 + hf * 4 + tid] = sqrtf(fmaxf(knw[8 + 2 * tid], knw[8 + 2 * tid + 1])); P_NRM[sq * 32 + 16 + hf * 4 + tid] = fminf(knw[16 + 2 * tid], knw[16 + 2 * tid + 1]); }
                if (tid == 4) { float m = knw[0]; for (int w = 1; w < 8; ++w) m = fmaxf(m, knw[w]); P_NRM[sq * 32 + 8 + hf] = sqrtf(m); }
                __syncthreads();
            }
            UpOrder S{G, vcu, (const GAS char*)P_LAT, (const GAS char*)P_WUQ, (const GAS char*)P_WUKV};
            EpiUp E{P_QM, P_KVM, P_SSQ, P_COS, P_SIN};
            pg8::gemm_phase<EpiUp, UpOrder, true, false, false, false, true>(tid, lds, 256 * 2, 512 * 2, 256 * 2, S, E, nullptr);
        }
        SEAM(P + 2);
        if (IN(P + 3)) for (int rep_ = 0; rep_ < ((l == 0 || 3 != 5) ? NREP(3) : 1); ++rep_) {
            unsigned ldsb_ = (unsigned)(uintptr_t)lds0; asm volatile("" : "+s"(ldsb_)); LAS unsigned char* lds = (LAS unsigned char*)(uintptr_t)ldsb_; volatile LAS unsigned* MISC = (volatile LAS unsigned*)(lds + MISC_OFF); volatile LAS unsigned long long* ARGP = (volatile LAS unsigned long long*)(lds + MISC_OFF + 768); (void)MISC; int wave = wave0, G = G0, bx = bx0; asm volatile("" : "+s"(G), "+s"(bx), "+s"(wave)); const int lane = (int)__builtin_amdgcn_mbcnt_hi(~0u, __builtin_amdgcn_mbcnt_lo(~0u, 0u)); const int tid = wave * 64 + lane; const int vcu = (bx % 8) * (G / 8) + bx / 8; const int gw = vcu * 8 + wave, NGW = G * 8; (void)lane; (void)gw; (void)NGW; (void)vcu;
            GAS unsigned char* ws = (GAS unsigned char*)LDP(22); GAS float* out = (GAS float*)LDP(21); const GAS float* x_in = (const GAS float*)ARGIN(0); (void)out; (void)x_in; (void)ws;
            GAS bf16* O = P_XN;
            const int b = vcu >> 4, hh = (vcu & 15) >> 1, sub = vcu & 1;
            const att::Tens2 TM{P_QM, 768, P_KVM, 1024, P_KPE, P_KVM + 64, 1024, O, nullptr, nullptr, P_OSS};
            const att::Tens2 TF{P_FQKV, 512, P_FQKV + (size_t)NTOK * 512, 512, P_KAUG, P_FQKV + (size_t)2 * NTOK * 512, 512, O, P_BIASF, P_NRM, P_OSS};
#define QB_OF(i) ((((i) & 1) ? 7 - (2 * sub + ((i) >> 1)) : (2 * sub + ((i) >> 1))))
            int ts0, ts1, ts2, ts3;
            { const GAS float* bs = P_BIASF + ((long)b * 8 + hh) * SEQ; const GAS float* nr = P_NRM + (b * 8 + hh) * 32; const float kmx = fmaxf(nr[8], nr[9]);
#define FOX_TS(i, dst) do { const int qb_ = QB_OF(i), NT_ = 4 * qb_ + 4; const float Z_ = nr[qb_] * kmx * 1.001f + 0.01f; const float bend_ = bs[(lane < NT_ ? lane : NT_ - 1) * 64 + 63]; \
                  const bool skip_ = (lane < NT_ - 4) && (Z_ + bend_ - nr[16 + qb_] < -32.f); dst = __builtin_popcountll(__ballot(skip_)); } while (0)
              FOX_TS(0, ts0); FOX_TS(1, ts1); FOX_TS(2, ts2); FOX_TS(3, ts3);
#undef FOX_TS
            }
            if (wave >= 4) __builtin_amdgcn_s_setprio(1);
            bf16x8 qreg[6];
            { int sb = 0; for (int i = 0; i < 4; ++i) sb = att::attn_unit2<1>(wave, b, hh, QB_OF(i), TM, (LAS char*)lds, sb, i > 0, i < 3 ? QB_OF(i + 1) : -1, qreg, 0); }
            { int sb = 0; for (int i = 0; i < 4; ++i) { const int ts = i == 0 ? ts0 : i == 1 ? ts1 : i == 2 ? ts2 : ts3; sb = att::attn_unit2<0>(wave, b, hh, QB_OF(i), TF, (LAS char*)lds, sb, i > 0, i < 3 ? QB_OF(i + 1) : -1, qreg, ts); } }
#undef QB_OF
            __builtin_amdgcn_s_setprio(0);
        }
        SEAM(P + 3);
        if (IN(P + 5)) for (int rep_ = 0; rep_ < ((l == 0 || 5 != 5) ? NREP(5) : 1); ++rep_) {
            unsigned ldsb_ = (unsigned)(uintptr_t)lds0; asm volatile("" : "+s"(ldsb_)); LAS unsigned char* lds = (LAS unsigned char*)(uintptr_t)ldsb_; volatile LAS unsigned* MISC = (volatile LAS unsigned*)(lds + MISC_OFF); volatile LAS unsigned long long* ARGP = (volatile LAS unsigned long long*)(lds + MISC_OFF + 768); (void)MISC; int wave = wave0, G = G0, bx = bx0; asm volatile("" : "+s"(G), "+s"(bx), "+s"(wave)); const int lane = (int)__builtin_amdgcn_mbcnt_hi(~0u, __builtin_amdgcn_mbcnt_lo(~0u, 0u)); const int tid = wave * 64 + lane; const int vcu = (bx % 8) * (G / 8) + bx / 8; const int gw = vcu * 8 + wave, NGW = G * 8; (void)lane; (void)gw; (void)NGW; (void)vcu;
            GAS unsigned char* ws = (GAS unsigned char*)LDP(22); GAS float* out = (GAS float*)LDP(21); const GAS float* x_in = (const GAS float*)ARGIN(0); (void)out; (void)x_in; (void)ws;
            DenseOrder S{NTOK / 256, DM / 256, (NTOK / 256) * (DM / 256), G, bx, (const GAS char*)P_XN, (const GAS char*)P_WOUT, (size_t)256 * DM * 2, (size_t)256 * DM * 2};
            EpiOut<false> E{x_in, P_XR};
            LAS f32x2* scl = (LAS f32x2*)(lds + pg8::STAGE_BYTES);
            { Unit u_; if (S.next(tid >> 8, u_)) { const GAS float* op = P_OSS + ((size_t)u_.pm * 256 + (tid & 255)) * 16;
                  const f32x4 a0 = *(const GAS f32x4*)op, a1 = *(const GAS f32x4*)(op + 4), c0 = *(const GAS f32x4*)(op + 8), c1 = *(const GAS f32x4*)(op + 12);
                  const float sm = ((a0[0] + a0[1]) + (a0[2] + a0[3])) + ((a1[0] + a1[1]) + (a1[2] + a1[3])), sf = ((c0[0] + c0[1]) + (c0[2] + c0[3])) + ((c1[0] + c1[1]) + (c1[2] + c1[3]));
                  const float rm_ = rsqrtf(sm * (1.f / 512.f) + EPS), rf_ = rsqrtf(sf * (1.f / 512.f) + EPS);
                  scl[tid] = (f32x2){rm_ / rf_, rf_}; } }
            __syncthreads();
            pg8::gemm_phase<EpiOut<false>, DenseOrder, true, false, false, true>(tid, lds, DM * 2, DM * 2, DM * 2, S, E, nullptr, scl);
        }
        SEAM(P + 5);
        if (IN(P + 6)) for (int rep_ = 0; rep_ < ((l == 0 || 6 != 5) ? NREP(6) : 1); ++rep_) {
            unsigned ldsb_ = (unsigned)(uintptr_t)lds0; asm volatile("" : "+s"(ldsb_)); LAS unsigned char* lds = (LAS unsigned char*)(uintptr_t)ldsb_; volatile LAS unsigned* MISC = (volatile LAS unsigned*)(lds + MISC_OFF); volatile LAS unsigned long long* ARGP = (volatile LAS unsigned long long*)(lds + MISC_OFF + 768); (void)MISC; int wave = wave0, G = G0, bx = bx0; asm volatile("" : "+s"(G), "+s"(bx), "+s"(wave)); const int lane = (int)__builtin_amdgcn_mbcnt_hi(~0u, __builtin_amdgcn_mbcnt_lo(~0u, 0u)); const int tid = wave * 64 + lane; const int vcu = (bx % 8) * (G / 8) + bx / 8; const int gw = vcu * 8 + wave, NGW = G * 8; (void)lane; (void)gw; (void)NGW; (void)vcu;
            GAS unsigned char* ws = (GAS unsigned char*)LDP(22); GAS float* out = (GAS float*)LDP(21); const GAS float* x_in = (const GAS float*)ARGIN(0); (void)out; (void)x_in; (void)ws;
            GAS bf16* H2 = P_XN;
            LAS bf16* WT = (LAS bf16*)lds;
            LAS float* LG = (LAS float*)(lds + 99840) + wave * 576;
            const GAS float* b_rg = (const GAS float*)ARGIN(14) + l * 4; const GAS float* b_re = (const GAS float*)ARGIN(16) + l * 32;
            if (tid < 32) MISC[64 + tid] = 0u;
            const int r16 = lane & 15, g4 = lane >> 4;
            const int m0 = vcu * 128 + wave * 16;
            const GAS bf16* xrow = P_XR + (size_t)(m0 + r16) * DM + 8 * g4;
            GAS unsigned char* hrow = (GAS unsigned char*)H2 + (size_t)(m0 + r16) * DM + 8 * g4;
            f32x4 acc3[3]; acc3[0] = (f32x4){0.f, 0.f, 0.f, 0.f}; acc3[1] = acc3[0]; acc3[2] = acc3[0];
            float ssq = 0.f;
            for (int half = 0; half < 2; ++half) {
                __syncthreads();
                for (int idx = tid; idx < 2 * 48 * 520 / 8; idx += 512) *(LAS u32x4*)(WT + 8 * idx) = *(const GAS u32x4*)(P_WR + (size_t)half * 2 * 48 * 520 + 8 * idx);
                __syncthreads();
                for (int s8 = 0; s8 < 16; s8 += 8) {
                    bf16x8 xv[8];
#pragma unroll
                    for (int u = 0; u < 8; ++u) xv[u] = *(const GAS bf16x8*)(xrow + half * 512 + 32 * (s8 + u));
#pragma unroll
                    for (int u = 0; u < 8; ++u) {
                        const u32x4 xw = __builtin_bit_cast(u32x4, xv[u]); float xf[8];
#pragma unroll
                        for (int j = 0; j < 4; ++j) { xf[2 * j] = __uint_as_float(xw[j] << 16); xf[2 * j + 1] = __uint_as_float(xw[j] & 0xffff0000u); }
                        u32x2 hw; hw.x = pk4_fp8(xf[0], xf[1], xf[2], xf[3]); hw.y = pk4_fp8(xf[4], xf[5], xf[6], xf[7]); *(GAS u32x2*)(hrow + half * 512 + 32 * (s8 + u)) = hw;
#pragma unroll
                        for (int j = 0; j < 8; ++j) ssq += xf[j] * xf[j];
                        const LAS bf16* wk = WT + r16 * 520 + 32 * (s8 + u) + 8 * g4;
#pragma unroll
                        for (int ct = 0; ct < 3; ++ct) { const bf16x8 bh = *(const LAS bf16x8*)(wk + ct * 16 * 520), bl = *(const LAS bf16x8*)(wk + (48 + ct * 16) * 520);
                            acc3[ct] = __builtin_amdgcn_mfma_f32_16x16x32_bf16(xv[u], bh, acc3[ct], 0, 0, 0); acc3[ct] = __builtin_amdgcn_mfma_f32_16x16x32_bf16(xv[u], bl, acc3[ct], 0, 0, 0); }
                    }
                }
            }
            ssq += __shfl_xor(ssq, 16); ssq += __shfl_xor(ssq, 32);
            const float rstd = rsqrtf(ssq * (1.f / DM) + EPS);
#pragma unroll
            for (int ct = 0; ct < 3; ++ct) { const int c = 16 * ct + r16; if (c < 36) {
#pragma unroll
                for (int rg = 0; rg < 4; ++rg) LG[(4 * g4 + rg) * 36 + c] = acc3[ct][rg]; } }
            LDS_WAIT();
            if (lane < 16) {
                const int m = m0 + lane; const LAS float* lg = LG + lane * 36;
                float gl[4];
#pragma unroll
                for (int g = 0; g < 4; ++g) gl[g] = lg[g] * rstd + b_rg[g];
                int gi = 0; float gm = gl[0];
#pragma unroll
                for (int g = 1; g < 4; ++g) if (gl[g] > gm) { gm = gl[g]; gi = g; }
                float gs = 0.f;
#pragma unroll
                for (int g = 0; g < 4; ++g) gs += __expf(gl[g] - gm);
                const float gval = 1.f / gs;
                float el[8];
#pragma unroll
                for (int j = 0; j < 8; ++j) el[j] = lg[4 + 8 * gi + j] * rstd + b_re[8 * gi + j];
                int i0 = 0; float mx0 = el[0];
#pragma unroll
                for (int j = 1; j < 8; ++j) if (el[j] > mx0) { mx0 = el[j]; i0 = j; }
                int i1 = -1; float mx1 = -INFINITY;
#pragma unroll
                for (int j = 0; j < 8; ++j) if (j != i0 && el[j] > mx1) { mx1 = el[j]; i1 = j; }
                const float e1 = __expf(mx1 - mx0); const float g0 = gval / (1.f + e1), g1 = gval * e1 / (1.f + e1);
                const int ea = gi * 8 + i0, eb = gi * 8 + i1; P_E01[2 * m] = ea; P_E01[2 * m + 1] = eb; P_G01[2 * m] = g0; P_G01[2 * m + 1] = g1; P_RSTD[m] = rstd;
                __hip_atomic_fetch_add((LAS unsigned*)(lds + MISC_OFF) + 64 + ea, 1u, __ATOMIC_RELAXED, __HIP_MEMORY_SCOPE_WORKGROUP); __hip_atomic_fetch_add((LAS unsigned*)(lds + MISC_OFF) + 64 + eb, 1u, __ATOMIC_RELAXED, __HIP_MEMORY_SCOPE_WORKGROUP);
            }
            __syncthreads();
            if (tid < 32) P_CNT[vcu * 32 + tid] = (int)MISC[64 + tid];
        }
        SEAM(P + 6);
        if (IN(P + 7)) for (int rep_ = 0; rep_ < ((l == 0 || 7 != 5) ? NREP(7) : 1); ++rep_) {
            unsigned ldsb_ = (unsigned)(uintptr_t)lds0; asm volatile("" : "+s"(ldsb_)); LAS unsigned char* lds = (LAS unsigned char*)(uintptr_t)ldsb_; volatile LAS unsigned* MISC = (volatile LAS unsigned*)(lds + MISC_OFF); volatile LAS unsigned long long* ARGP = (volatile LAS unsigned long long*)(lds + MISC_OFF + 768); (void)MISC; int wave = wave0, G = G0, bx = bx0; asm volatile("" : "+s"(G), "+s"(bx), "+s"(wave)); const int lane = (int)__builtin_amdgcn_mbcnt_hi(~0u, __builtin_amdgcn_mbcnt_lo(~0u, 0u)); const int tid = wave * 64 + lane; const int vcu = (bx % 8) * (G / 8) + bx / 8; const int gw = vcu * 8 + wave, NGW = G * 8; (void)lane; (void)gw; (void)NGW; (void)vcu;
            GAS unsigned char* ws = (GAS unsigned char*)LDP(22); GAS float* out = (GAS float*)LDP(21); const GAS float* x_in = (const GAS float*)ARGIN(0); (void)out; (void)x_in; (void)ws;
            LAS int* cnt_all = (LAS int*)lds;
            LAS int* pre_e = (LAS int*)(lds + 32768);
            LAS int* tot_e = pre_e + 32;
            LAS int* pst = pre_e + 64;
            LAS int* eL = pre_e + 128;
            for (int i = tid; i < 256 * 32; i += 512) cnt_all[i] = P_CNT[i];
            if (tid < 256) eL[tid] = P_E01[vcu * 256 + tid];
            __syncthreads();
            { LAS int* part = pre_e + 512;
              const int e = tid & 31, p = tid >> 5; int pre = 0, tot = 0;
#pragma unroll
              for (int j = 0; j < 16; ++j) { const int w = p * 16 + j; const int c = cnt_all[w * 32 + e]; pre += (w < vcu) ? c : 0; tot += c; }
              part[(p * 2) * 32 + e] = pre; part[(p * 2 + 1) * 32 + e] = tot; }
            __syncthreads();
            if (tid < 32) { LAS int* part = pre_e + 512; int pre = 0, tot = 0;
#pragma unroll
                for (int p = 0; p < 16; ++p) { pre += part[(p * 2) * 32 + tid]; tot += part[(p * 2 + 1) * 32 + tid]; } pre_e[tid] = pre; tot_e[tid] = tot; }
            __syncthreads();
            if (tid == 0) { int acc = 0; for (int e = 0; e < 32; ++e) { pst[e] = acc; acc += (tot_e[e] + 255) / 256 * 256; } pst[32] = acc; }
            __syncthreads();
            if (vcu == 0 && tid <= 32) P_TSTART[tid] = pst[tid] / 256;
            { LAS int* hist = pre_e + 2048;
              if (tid < 128) hist[tid] = 0;
              __syncthreads();
              int e = 0, rin = 0;
              if (tid < 256) { e = eL[tid]; unsigned long long mym = 0ull;
                  for (int x = 0; x < 32; ++x) { const unsigned long long bm = __ballot(e == x); if (e == x) mym = bm; }
                  rin = __builtin_popcountll(mym & ((1ull << lane) - 1ull));
                  if (rin == 0) hist[wave * 32 + e] = __builtin_popcountll(mym); }
              __syncthreads();
              if (tid < 256) { int r = rin; for (int w = 0; w < wave; ++w) r += hist[w * 32 + e];
                  const int slot = pst[e] + pre_e[e] + r; const int tok = vcu * 128 + (tid >> 1);
                  P_SLOT[vcu * 256 + tid] = slot; P_TOKOF[slot] = tok; P_GATEOF[slot] = P_G01[vcu * 256 + tid]; P_RSTDOF[slot] = P_RSTD[tok]; } }
            if (vcu < 32) { const int e = vcu; for (int s = pst[e] + tot_e[e] + tid; s < pst[e + 1]; s += 512) { P_TOKOF[s] = 0; P_GATEOF[s] = 0.f; P_RSTDOF[s] = 0.f; } }
            __syncthreads();
        }
        SEAM(P + 7);
        if (IN(P + 8)) for (int rep_ = 0; rep_ < ((l == 0 || 8 != 5) ? NREP(8) : 1); ++rep_) {
            unsigned ldsb_ = (unsigned)(uintptr_t)lds0; asm volatile("" : "+s"(ldsb_)); LAS unsigned char* lds = (LAS unsigned char*)(uintptr_t)ldsb_; volatile LAS unsigned* MISC = (volatile LAS unsigned*)(lds + MISC_OFF); volatile LAS unsigned long long* ARGP = (volatile LAS unsigned long long*)(lds + MISC_OFF + 768); (void)MISC; int wave = wave0, G = G0, bx = bx0; asm volatile("" : "+s"(G), "+s"(bx), "+s"(wave)); const int lane = (int)__builtin_amdgcn_mbcnt_hi(~0u, __builtin_amdgcn_mbcnt_lo(~0u, 0u)); const int tid = wave * 64 + lane; const int vcu = (bx % 8) * (G / 8) + bx / 8; const int gw = vcu * 8 + wave, NGW = G * 8; (void)lane; (void)gw; (void)NGW; (void)vcu;
            GAS unsigned char* ws = (GAS unsigned char*)LDP(22); GAS float* out = (GAS float*)LDP(21); const GAS float* x_in = (const GAS float*)ARGIN(0); (void)out; (void)x_in; (void)ws;
            volatile LAS int* TS = (volatile LAS int*)(MISC + 128);
            if (tid <= 32) TS[tid] = P_TSTART[tid];
            __syncthreads();
            MoeOrder S{G, vcu, TS, (const GAS char*)P_XN, (const GAS char*)P_WGU_L(l), 0, (size_t)1024 * 1024, (size_t)256 * 1024};
            EpiGU E{(GAS unsigned char*)P_HH, P_RSTDOF};
            pg8::gemm_phase<EpiGU, MoeOrder, true, true, true>(tid, lds, DM, DM, DM, S, E, P_TOKOF);
            if constexpr (l + 1 < NLAYER) {
                const int U = (int)TS[32] * 4, rem = U & 255; const int nidle = rem ? 256 - rem : 256, rk = rem ? vcu - rem : vcu;
                if (rk >= 0) { LAS float* scr64 = (LAS float*)(lds + wave * 16640);
                    const GAS float* w_gate = (const GAS float*)ARGIN(17) + (size_t)(l + 1) * NEXP * DM * DEXP; const GAS float* w_up = (const GAS float*)ARGIN(18) + (size_t)(l + 1) * NEXP * DM * DEXP; const GAS float* ffn1 = (const GAS float*)ARGIN(12) + (size_t)(l + 1) * DM;
                    for (int it = rk * 8 + wave; it < 16 * 16 * NEXP; it += nidle * 8) conv_gu_item(it, w_gate, w_up, ffn1, P_WGU_L(l + 1), scr64, lane); }
            }
        }
        SEAM(P + 8);
        if (IN(P + 9)) for (int rep_ = 0; rep_ < ((l == 0 || 9 != 5) ? NREP(9) : 1); ++rep_) {
            unsigned ldsb_ = (unsigned)(uintptr_t)lds0; asm volatile("" : "+s"(ldsb_)); LAS unsigned char* lds = (LAS unsigned char*)(uintptr_t)ldsb_; volatile LAS unsigned* MISC = (volatile LAS unsigned*)(lds + MISC_OFF); volatile LAS unsigned long long* ARGP = (volatile LAS unsigned long long*)(lds + MISC_OFF + 768); (void)MISC; int wave = wave0, G = G0, bx = bx0; asm volatile("" : "+s"(G), "+s"(bx), "+s"(wave)); const int lane = (int)__builtin_amdgcn_mbcnt_hi(~0u, __builtin_amdgcn_mbcnt_lo(~0u, 0u)); const int tid = wave * 64 + lane; const int vcu = (bx % 8) * (G / 8) + bx / 8; const int gw = vcu * 8 + wave, NGW = G * 8; (void)lane; (void)gw; (void)NGW; (void)vcu;
            GAS unsigned char* ws = (GAS unsigned char*)LDP(22); GAS float* out = (GAS float*)LDP(21); const GAS float* x_in = (const GAS float*)ARGIN(0); (void)out; (void)x_in; (void)ws;
            volatile LAS int* TS = (volatile LAS int*)(MISC + 128);
            if (tid <= 32) TS[tid] = P_TSTART[tid];
            __syncthreads();
            MoeOrder S{G, vcu, TS, (const GAS char*)P_HH, (const GAS char*)P_WD_L(l), (size_t)256 * 512, (size_t)1024 * 512, (size_t)256 * 512};
            EpiDown E{(GAS unsigned char*)P_Y, P_GATEOF};
            pg8::gemm_phase<EpiDown, MoeOrder, true, false, true>(tid, lds, DEXP, DEXP, DEXP, S, E, nullptr);
            if constexpr (l + 1 < NLAYER) {
                const int U = (int)TS[32] * 4, rem = U & 255; const int nidle = rem ? 256 - rem : 256, rk = rem ? vcu - rem : vcu;
                if (rk >= 0) { LAS float* scr64 = (LAS float*)(lds + wave * 16640);
                    const GAS float* w_down = (const GAS float*)ARGIN(19) + (size_t)(l + 1) * NEXP * DEXP * DM;
                    for (int it = rk * 8 + wave; it < 8 * 16 * NEXP; it += nidle * 8) conv_d_item(it, w_down, P_WD_L(l + 1), scr64, lane); }
            }
        }
        SEAM(P + 9);
}

__global__ void __launch_bounds__(512, 2) fwd(Args args) {
    extern __shared__ __attribute__((aligned(16))) unsigned char lds_raw[];
    LAS unsigned char* lds0 = (LAS unsigned char*)lds_raw;
    const int tid0 = threadIdx.x; const int wave0 = __builtin_amdgcn_readfirstlane(tid0 >> 6);
    const int G0 = gridDim.x; const int bx0 = blockIdx.x;
    { volatile LAS unsigned* MISC = (volatile LAS unsigned*)(lds0 + MISC_OFF); const int tid = tid0;
    for (int u = tid; u < 256; u += 512) MISC[u] = 0u;
    __syncthreads();
    volatile LAS unsigned long long* ARGP = (volatile LAS unsigned long long*)(lds0 + MISC_OFF + 768);
    if (tid < 21) ARGP[tid] = (unsigned long long)args.in[tid];
    if (tid == 21) ARGP[21] = (unsigned long long)args.out;
    if (tid == 22) ARGP[22] = (unsigned long long)args.ws;
    __syncthreads(); }
#if MK_ONE_LAUNCH
    XcdBarrier bar = xcd_barrier_post((unsigned*)(args.ws + WS_CTL) + CW_BAR, (volatile LAS unsigned*)(lds0 + MISC_OFF) + 8);
#else
    XcdBarrier bar; bar.bar = nullptr; bar.x = 0; bar.st = nullptr;
#endif
    const int lo = args.ph_lo, hi_ = args.ph_hi;
    if (IN(0)) {
        const GAS int* positions = (const GAS int*)args.in[1]; GAS float* COSp = (GAS float*)(args.ws + WS_COS); GAS float* SINp = (GAS float*)(args.ws + WS_SIN);
        for (int i = bx0 * 512 + tid0; i < NTOK * 16; i += G0 * 512) { const int tk = i >> 4, fi = i & 15;
            const double invrev = exp2(-(double)fi * (13.287712379549449 / 16.0)) * 0.15915494309189535; const double rev = (double)positions[tk] * invrev; const float fr = (float)(rev - rint(rev));
            COSp[i] = __builtin_amdgcn_cosf(fr); SINp[i] = __builtin_amdgcn_sinf(fr); }
    }
    layer_body<0>(lo, hi_, lds0, wave0, G0, bx0, bar);
    layer_body<1>(lo, hi_, lds0, wave0, G0, bx0, bar);
    layer_body<2>(lo, hi_, lds0, wave0, G0, bx0, bar);
}

extern "C" void kernel_launch(void* const* d_in, const int* in_sizes, int n_in, void* d_out, int out_size, void* d_ws, size_t ws_size, hipStream_t stream) {
    static int grid = 0;
    if (grid == 0) {
        if (n_in != 21 || out_size != NTOK * DM || ws_size < WS_END) { fprintf(stderr, "kernel_launch: unexpected shapes (n_in %d out %d ws %zu)\n", n_in, out_size, ws_size); grid = -1; return; }
        int dev = 0, cus = 0;
        if (hipGetDevice(&dev) != hipSuccess || hipDeviceGetAttribute(&cus, hipDeviceAttributeMultiprocessorCount, dev) != hipSuccess) { grid = -1; return; }
        if (hipFuncSetAttribute((const void*)fwd, hipFuncAttributeMaxDynamicSharedMemorySize, LDS_BYTES) != hipSuccess) { fprintf(stderr, "kernel_launch: hipFuncSetAttribute failed\n"); grid = -1; return; }
        int per_cu = 0;
        if (hipOccupancyMaxActiveBlocksPerMultiprocessor(&per_cu, (const void*)fwd, 512, LDS_BYTES) != hipSuccess || per_cu < 1) fprintf(stderr, "kernel_launch: occupancy query says %d\n", per_cu);
        (void)hipGetLastError();
        grid = cus;
        if (grid != 256) { fprintf(stderr, "kernel_launch: built for 256 CUs, got %d\n", grid); grid = -1; return; }
    }
    if (grid < 0) return;
    if (hipMemsetAsync((char*)d_ws + WS_CTL, 0, CTL_ZERO_BYTES, stream) != hipSuccess) return;
    Args a{};
    for (int i = 0; i < 21; ++i) a.in[i] = d_in[i];
    a.out = (float*)d_out; a.ws = (unsigned char*)d_ws;
#if MK_ONE_LAUNCH
    a.ph_lo = 0; a.ph_hi = 21;
    hipLaunchKernelGGL(fwd, dim3(grid), dim3(512), LDS_BYTES, stream, a);
#else
    for (int p = 0; p <= 20; ++p) { a.ph_lo = p; a.ph_hi = p + 1; hipLaunchKernelGGL(fwd, dim3(grid), dim3(512), LDS_BYTES, stream, a); }
#endif
}
```

```cpp
#include <hip/hip_runtime.h>
#include <cstdio>
#include <cstdint>

#ifndef PROBE_PHASE
#define PROBE_PHASE -1
#endif
#ifndef PROBE_LAYER
#define PROBE_LAYER -1
#endif
#define NREP(k) (((PROBE_PHASE) == (k) && ((PROBE_LAYER) < 0 || (PROBE_LAYER) == l)) ? 2 : 1)
#ifndef MK_ONE_LAUNCH
#define MK_ONE_LAUNCH 1
#endif

#define LAS __attribute__((address_space(3)))
#define GAS __attribute__((address_space(1)))
typedef unsigned short bf16;
typedef short bf16x8 __attribute__((ext_vector_type(8)));
typedef short s16x4 __attribute__((ext_vector_type(4)));
typedef float f32x4 __attribute__((ext_vector_type(4)));
typedef float f32x2 __attribute__((ext_vector_type(2)));
typedef float f32x16 __attribute__((ext_vector_type(16)));
typedef unsigned u32x4 __attribute__((ext_vector_type(4)));
typedef unsigned u32x2 __attribute__((ext_vector_type(2)));

constexpr int NB = 16, SEQ = 2048, DM = 1024, NTOK = NB * SEQ, NLAYER = 2;
constexpr int INW = 1960, INP = 2048;
constexpr int NEXP = 32, DEXP = 512;
constexpr int MAXSLOT = 73728;
constexpr float EPS = 1e-6f;
constexpr float WSCALE = 64.f, WSCALE_INV = 1.f / 64.f;
constexpr float LOG2E = 1.4426950408889634f;
constexpr float C2F = 0.125f * LOG2E;
constexpr float C2M = 0.10206207261596575f * LOG2E;

constexpr size_t MiB = 1u << 20, KiB = 1u << 10;
constexpr size_t WS_CTL = 0, CTL_ZERO_BYTES = 256 * KiB;
constexpr size_t WS_COS = 1 * MiB, WS_SIN = 3 * MiB;
constexpr size_t WS_SSQ = 5 * MiB;
constexpr size_t WS_FLOG = 6 * MiB;
constexpr size_t WS_E01 = 8 * MiB;
constexpr size_t WS_G01 = 8 * MiB + 256 * KiB;
constexpr size_t WS_SLOT = 8 * MiB + 512 * KiB;
constexpr size_t WS_TOKOF = 8 * MiB + 768 * KiB;
constexpr size_t WS_GATEOF = 9 * MiB + 256 * KiB;
constexpr size_t WS_CNT = 9 * MiB + 768 * KiB;
constexpr size_t WS_TSTART = 9 * MiB + 800 * KiB;
constexpr size_t WS_RSTD = 9 * MiB + 832 * KiB;
constexpr size_t WS_RSTDOF = 7 * MiB;
constexpr size_t WS_KPE = 10 * MiB;
constexpr size_t WS_KAUG = 10 * MiB + 2 * MiB;
constexpr size_t WS_WIN = 16 * MiB;
constexpr size_t WS_WUQ = 20 * MiB;
constexpr size_t WS_WUKV = 20 * MiB + 512 * KiB;
constexpr size_t WS_WOUT = 21 * MiB;
constexpr size_t WS_WGU = 24 * MiB;
constexpr size_t WS_WD = 88 * MiB;
constexpr size_t WS_XN = 120 * MiB;
constexpr size_t WS_FQKV = 184 * MiB;
constexpr size_t WS_LAT = 280 * MiB;
constexpr size_t WS_QM = 312 * MiB;
constexpr size_t WS_KVM = 360 * MiB;
constexpr size_t WS_Y = 280 * MiB;
constexpr size_t WS_BIASF = 424 * MiB;
constexpr size_t WS_NRM = 425 * MiB;
constexpr size_t WS_WR = 426 * MiB;
constexpr size_t WS_XR = 427 * MiB;
constexpr size_t WS_OSS = 491 * MiB;
constexpr size_t WS_RSTDX = 493 * MiB;
constexpr size_t WS_W1 = 494 * MiB;
constexpr size_t WS_END = 502 * MiB;
static_assert(WS_Y + (size_t)MAXSLOT * 1024 * 2 <= WS_END, "Y fits");
static_assert(WS_FQKV + (size_t)MAXSLOT * 512 * 2 <= WS_LAT, "HH fits");

constexpr int CW_BAR = 1024;
static_assert((size_t)(CW_BAR + 17 * 3456) * 4 <= CTL_ZERO_BYTES, "barrier words inside the zeroed control block");

constexpr int RING_BYTES = 147456;
constexpr int MISC_OFF = RING_BYTES;
constexpr int LDS_BYTES = RING_BYTES + 1024;

typedef __bf16 bf16x2_t __attribute__((ext_vector_type(2)));
__device__ __forceinline__ unsigned cvt_pk_bf16(float lo, float hi) { const f32x2 v = {lo, hi}; const bf16x2_t b = __builtin_convertvector(v, bf16x2_t); return __builtin_bit_cast(unsigned, b); }
__device__ __forceinline__ float bf2f(unsigned short b) { return __uint_as_float((unsigned)b << 16); }
__device__ __forceinline__ float wave_sum(float v) {
#pragma unroll
    for (int o = 1; o < 64; o <<= 1) v += __shfl_xor(v, o);
    return v;
}
__device__ __forceinline__ unsigned pk4_fp8(float a, float b, float c, float d) { int w = 0; w = __builtin_amdgcn_cvt_pk_fp8_f32(a, b, w, false); w = __builtin_amdgcn_cvt_pk_fp8_f32(c, d, w, true); return (unsigned)w; }
#define LDS_WAIT() asm volatile("s_waitcnt lgkmcnt(0)" ::: "memory")

#define XB_TMO      128
#define XB_XCNT(j)  (256  + 64 * (j))
#define XB_XSUB(j)  (1280 + 64 * (j))
#define XB_XGEN(j)  (2304 + 64 * (j))
#define XB_TOP      3328
#define XB_TOPGEN   3392
#define XCD_BAR_WORDS 3456
#define XB_SPIN_CAP (1u << 18)
__device__ __forceinline__ unsigned xb_ld(unsigned* p)              { return __hip_atomic_load(p, __ATOMIC_RELAXED, __HIP_MEMORY_SCOPE_AGENT); }
__device__ __forceinline__ unsigned xb_add(unsigned* p, unsigned v) { return __hip_atomic_fetch_add(p, v, __ATOMIC_RELAXED, __HIP_MEMORY_SCOPE_AGENT); }
__device__ __forceinline__ unsigned xb_xcc_id() { return (unsigned)__builtin_amdgcn_s_getreg((3 << 11) | 20) & 0xFu; }
#define XB_SPIN(cond, bar) do { unsigned _sp = 0; while (cond) { __builtin_amdgcn_s_sleep(1); \
    if ((++_sp & 255u) == 0u) { if (xb_ld(&(bar)[XB_TMO])) break; if (_sp > XB_SPIN_CAP) { atomicAdd(&(bar)[XB_TMO], 1u); break; } } } } while (0)
struct XcdBarrier { unsigned* bar; unsigned x; volatile LAS unsigned* st; unsigned n; };
__device__ __forceinline__ XcdBarrier xcd_barrier_post(unsigned* bar, volatile LAS unsigned* st, unsigned n) {
    XcdBarrier b; b.bar = bar; b.x = xb_xcc_id(); b.st = st; b.n = n;
    if (threadIdx.x == 0) (void)xb_add(&bar[XB_XCNT(b.x)], 1u);
    return b;
}
__device__ __forceinline__ void xcd_barrier_complete(unsigned* bar, unsigned x, unsigned G, unsigned& nloc, unsigned& nx) {
    unsigned sum, cnt, mine, sp = 0u;
    for (;;) {
        sum = 0u; cnt = 0u; mine = 0u;
#pragma unroll
        for (unsigned j = 0; j < 16; ++j) { const unsigned c = xb_ld(&bar[XB_XCNT(j)]); sum += c; cnt += (c > 0u) ? 1u : 0u; mine = (j == x) ? c : mine; }
        if (sum == G) break;
        __builtin_amdgcn_s_sleep(1);
        if ((++sp & 255u) == 0u) { if (xb_ld(&bar[XB_TMO])) break; if (sp > XB_SPIN_CAP) { atomicAdd(&bar[XB_TMO], 1u); break; } }
    }
    nloc = mine > 0u ? mine : 1u; nx = cnt > 0u ? cnt : 1u;
}
__device__ __forceinline__ void xcd_barrier(const XcdBarrier& b) {
    asm volatile("s_waitcnt vmcnt(0)" ::: "memory");
    __syncthreads();
    if (threadIdx.x == 0) {
        unsigned* bar = b.bar;
        __builtin_amdgcn_s_waitcnt(0);
        unsigned nloc = b.st[0], nx = b.st[1];
        if (nloc == 0u) { xcd_barrier_complete(bar, b.x, b.n, nloc, nx); b.st[0] = nloc; b.st[1] = nx; }
        const unsigned old = xb_add(&bar[XB_XSUB(b.x)], 1u);
        const unsigned gen = old / nloc;
        if (old + 1u == (gen + 1u) * nloc) {
            __builtin_amdgcn_fence(__ATOMIC_RELEASE, "agent");
            asm volatile("s_waitcnt vmcnt(0)" ::: "memory");
            const unsigned og = xb_add(&bar[XB_TOP], 1u);
            const unsigned tg = og / nx;
            if (og + 1u == (tg + 1u) * nx) xb_add(&bar[XB_TOPGEN], 1u);
            else XB_SPIN(xb_ld(&bar[XB_TOPGEN]) == tg, bar);
            __builtin_amdgcn_fence(__ATOMIC_ACQUIRE, "agent");
            xb_add(&bar[XB_XGEN(b.x)], 1u);
            asm volatile("s_waitcnt vmcnt(0)" ::: "memory");
        } else {
            XB_SPIN(xb_ld(&bar[XB_XGEN(b.x)]) == gen, bar);
            __builtin_amdgcn_fence(__ATOMIC_ACQUIRE, "agent");
            asm volatile("s_waitcnt vmcnt(0)" ::: "memory");
        }
    }
    __syncthreads();
}

namespace pg8 {
constexpr int BM = 256, BK = 64, HALF = 128, HTB = HALF * BK * 2, STAGE_BYTES = 8 * HTB;
typedef int v4i32_t __attribute__((ext_vector_type(4)));
typedef int v8i32_t __attribute__((ext_vector_type(8)));
__host__ __device__ __forceinline__ int lds_byte(int r, int c) { const int st = (r >> 4) * 2 + (c >> 5), rr = r & 15, cc = c & 31, ob = rr * 64 + cc * 2; return st * 1024 + (ob ^ (((ob >> 9) & 1) << 5)); }
__host__ __device__ __forceinline__ void stage_rc(int b, int& R, int& C) { const int st = b / 1024, sb = b % 1024, swz = sb ^ (((sb >> 9) & 1) << 5); R = (st >> 1) * 16 + swz / 64; C = (st & 1) * 32 + (swz % 64) / 2; }
__host__ __device__ __forceinline__ int perm32(int rho) { const int n = rho >> 4, i = rho & 15; return 8 * (i >> 2) + 4 * n + (i & 3); }

struct Unit { const GAS char* a; const GAS char* b; int pm, pn, e; };

template <int N> __device__ __forceinline__ void wait_vm() { asm volatile("s_waitcnt vmcnt(%0)" :: "n"(N) : "memory"); }
template <class Epi, class Sched, bool ALIGN_EPI, bool GATHER, bool FP8 = false, bool MIDSCALE = false, bool VARK = false>
__device__ __forceinline__ void gemm_phase(const int tid, LAS unsigned char* lds, const int Kb, const int ldaB, const int ldbB, const Sched& S, const Epi& E, const GAS int* __restrict__ tokof, const LAS f32x2* scl = nullptr) {
    const int wid = __builtin_amdgcn_readfirstlane(tid >> 6), lane = tid & 63, wr = wid >> 2, wc = wid & 3, fr = lane & 15, fq = lane >> 4;
    const int nt = Kb / 128;
    unsigned voffA[2], voffB[2]; int RA[2], CA2[2];
#pragma unroll
    for (int i = 0; i < 2; ++i) { int R, C; stage_rc(tid * 16 + i * 8192, R, C); const int Rb = Epi::WIDE ? (64 * (R >> 5) + perm32(R & 31)) : Epi::PERM ? ((R & ~31) + perm32(R & 31)) : R;
        voffA[i] = (unsigned)(R * ldaB + C * 2); voffB[i] = (unsigned)(Rb * ldbB + C * 2); RA[i] = R; CA2[i] = C * 2; }
    const size_t kstep = (size_t)(BK * 2);
    const size_t hstepA = GATHER ? 0 : (size_t)HALF * ldaB;
    const size_t hstepB = (size_t)(Epi::WIDE ? 32 : HALF) * ldbB;
    const unsigned ldsw = (unsigned)wid * 1024u;
    const int aoff = lds_byte(wr * 64 + fr, fq * 8), boff = lds_byte(wc * 32 + fr, fq * 8);
    unsigned gcur[2][2], gnxt[2][2];
    const int scl8 = 0x7F7F7F7F;
#define PG8_SA(b, h) (((b) * 2 + (h)) * HTB)
#define PG8_SB(b, h) ((4 + (b) * 2 + (h)) * HTB)
#define PG8_STAGE(bufoff, gbase, voff) do { const unsigned long long gb_ = (unsigned long long)(gbase); const unsigned lbase_ = (unsigned)__builtin_amdgcn_readfirstlane((int)((unsigned)(uintptr_t)lds + (unsigned)(bufoff) + ldsw)); \
        _Pragma("unroll") for (int _i = 0; _i < 2; ++_i) { unsigned keep_; \
            asm volatile("s_mov_b32 %0, m0\n\ts_mov_b32 m0, %3\n\ts_nop 0\n\tglobal_load_lds_dwordx4 %1, %2\n\ts_mov_b32 m0, %0" : "=&s"(keep_) : "v"((voff)[_i]), "s"(gb_), "s"(lbase_ + (unsigned)(_i * 8192)) : "memory"); } } while (0)
#define PG8_STAGE_A(bufoff, base, h, nx) do { if constexpr (GATHER) { unsigned _v[2]; _v[0] = (nx) ? gnxt[h][0] : gcur[h][0]; _v[1] = (nx) ? gnxt[h][1] : gcur[h][1]; PG8_STAGE(bufoff, base, _v); } \
        else { PG8_STAGE(bufoff, (base) + (h) * hstepA, voffA); } } while (0)
#define PG8_LDA(dst, b, h) do { _Pragma("unroll") for (int m = 0; m < 4; ++m) _Pragma("unroll") for (int k = 0; k < 2; ++k) dst[m][k] = *(const LAS bf16x8*)(lds + PG8_SA(b, h) + aoff + m * 2048 + k * 1024); } while (0)
#define PG8_LDB(dst, b, h) do { _Pragma("unroll") for (int n = 0; n < 2; ++n) _Pragma("unroll") for (int k = 0; k < 2; ++k) dst[n][k] = *(const LAS bf16x8*)(lds + PG8_SB(b, h) + boff + n * 2048 + k * 1024); } while (0)
#define PG8_MMA(ai, bj, At, Bt) do { __builtin_amdgcn_s_setprio(1); if constexpr (FP8) { _Pragma("unroll") for (int m = 0; m < 4; ++m) _Pragma("unroll") for (int n = 0; n < 2; ++n) { \
        const v8i32_t b8_ = __builtin_shufflevector(__builtin_bit_cast(v4i32_t, Bt[n][0]), __builtin_bit_cast(v4i32_t, Bt[n][1]), 0, 1, 2, 3, 4, 5, 6, 7), a8_ = __builtin_shufflevector(__builtin_bit_cast(v4i32_t, At[m][0]), __builtin_bit_cast(v4i32_t, At[m][1]), 0, 1, 2, 3, 4, 5, 6, 7); \
        asm volatile("s_nop 1\n\tv_mfma_scale_f32_16x16x128_f8f6f4 %0, %1, %2, %0, %3, %3 op_sel_hi:[0,0,0]" : "+v"(acc[ai][bj][m][n]) : "v"(b8_), "v"(a8_), "v"(scl8)); } } \
      else { _Pragma("unroll") for (int m = 0; m < 4; ++m) _Pragma("unroll") for (int n = 0; n < 2; ++n) _Pragma("unroll") for (int k = 0; k < 2; ++k) \
        acc[ai][bj][m][n] = __builtin_amdgcn_mfma_f32_16x16x32_bf16(Bt[n][k], At[m][k], acc[ai][bj][m][n], 0, 0, 0); } __builtin_amdgcn_s_setprio(0); } while (0)
#define PG8_MMA_Z(ai, bj, At, Bt) do { __builtin_amdgcn_s_setprio(1); if constexpr (FP8) { _Pragma("unroll") for (int m = 0; m < 4; ++m) _Pragma("unroll") for (int n = 0; n < 2; ++n) { \
        const v8i32_t b8_ = __builtin_shufflevector(__builtin_bit_cast(v4i32_t, Bt[n][0]), __builtin_bit_cast(v4i32_t, Bt[n][1]), 0, 1, 2, 3, 4, 5, 6, 7), a8_ = __builtin_shufflevector(__builtin_bit_cast(v4i32_t, At[m][0]), __builtin_bit_cast(v4i32_t, At[m][1]), 0, 1, 2, 3, 4, 5, 6, 7); \
        asm volatile("s_nop 1\n\tv_mfma_scale_f32_16x16x128_f8f6f4 %0, %1, %2, 0, %3, %3 op_sel_hi:[0,0,0]" : "=&v"(acc[ai][bj][m][n]) : "v"(b8_), "v"(a8_), "v"(scl8)); } } \
      __builtin_amdgcn_s_setprio(0); } while (0)
#define PG8_WAIT_V(n) asm volatile("s_waitcnt vmcnt(" #n ")" ::: "memory")
#define PG8_WAIT_L(n) asm volatile("s_waitcnt lgkmcnt(" #n ")" ::: "memory")
#define PG8_BAR __builtin_amdgcn_s_barrier()
#define PG8_SCHED __builtin_amdgcn_sched_barrier(0)
#define PG8_GLOAD(dst, u) do { if constexpr (GATHER) { _Pragma("unroll") for (int _h = 0; _h < 2; ++_h) _Pragma("unroll") for (int _i = 0; _i < 2; ++_i) \
        dst[_h][_i] = (unsigned)tokof[(u).pm * BM + _h * HALF + RA[_i]] * (unsigned)ldaB + (unsigned)CA2[_i]; } } while (0)
    Unit cur, nxt; int ui = 0;
    if (!S.next(0, cur)) return;
    PG8_GLOAD(gcur, cur);
    typename Epi::Pre pre = E.prefetch(cur, wr, fr);
    f32x4 acc[2][2][4][2];
#pragma unroll
    for (int a = 0; a < 2; ++a)
#pragma unroll
        for (int b = 0; b < 2; ++b)
#pragma unroll
            for (int m = 0; m < 4; ++m)
#pragma unroll
                for (int n = 0; n < 2; ++n) acc[a][b][m][n] = (f32x4){0.f, 0.f, 0.f, 0.f};
    bf16x8 At[4][2], B0[2][2], B1[2][2];
    const GAS char* cA = cur.a; const GAS char* cB = cur.b;
    PG8_STAGE(PG8_SB(0, 0), cB, voffB); PG8_STAGE(PG8_SB(0, 1), cB + hstepB, voffB); PG8_STAGE_A(PG8_SA(0, 0), cA, 0, false); PG8_STAGE_A(PG8_SA(0, 1), cA, 1, false);
    if (wr == 1) PG8_BAR;
    PG8_WAIT_V(2); PG8_BAR;
    PG8_STAGE(PG8_SB(1, 0), cB + kstep, voffB); PG8_STAGE_A(PG8_SA(1, 0), cA + kstep, 0, false); PG8_STAGE(PG8_SB(1, 1), cB + hstepB + kstep, voffB);
    PG8_WAIT_V(6); PG8_BAR;
    bool fresh = false;
    for (;;) {
        const bool has_next = S.next(ui + 1, nxt);
        if constexpr (GATHER) { if (has_next) { PG8_GLOAD(gnxt, nxt); } else { _Pragma("unroll") for (int _h = 0; _h < 2; ++_h) _Pragma("unroll") for (int _i = 0; _i < 2; ++_i) gnxt[_h][_i] = gcur[_h][_i]; } }
        const GAS char* nA = has_next ? nxt.a : cA; const GAS char* nB = has_next ? nxt.b : cB;
        const int ntu = VARK ? (cur.e ? nt / 2 : nt) : nt;
#pragma nounroll
        for (int t = 0; t < ntu; t += 2) {
            const bool last = (t == ntu - 2);
            const GAS char* a1 = cA + (size_t)(t + 1) * kstep;
            const GAS char* a2 = last ? nA : cA + (size_t)(t + 2) * kstep; const GAS char* b2 = last ? nB : cB + (size_t)(t + 2) * kstep;
            const GAS char* a3 = a2 + kstep; const GAS char* b3 = b2 + kstep;
            const bool fe = fresh; fresh = false;
            if constexpr (MIDSCALE) { if (t == nt / 2) {
#pragma unroll
                for (int ai = 0; ai < 2; ++ai)
#pragma unroll
                    for (int m = 0; m < 4; ++m) { const float r_ = scl[ui * 256 + ai * 128 + wr * 64 + m * 16 + fr][0];
#pragma unroll
                        for (int bj = 0; bj < 2; ++bj)
#pragma unroll
                            for (int n = 0; n < 2; ++n) acc[ai][bj][m][n] *= r_; } } }
            PG8_LDB(B0, 0, 0); PG8_LDB(B1, 0, 1); PG8_SCHED; PG8_LDA(At, 0, 0); PG8_STAGE_A(PG8_SA(1, 1), a1, 1, false);
            if (fe) wait_vm<8 + Epi::NST>(); else PG8_WAIT_V(8); PG8_WAIT_L(0); PG8_BAR; if (FP8 && t == 0) { PG8_MMA_Z(0, 0, At, B0); PG8_MMA_Z(0, 1, At, B1); } else { PG8_MMA(0, 0, At, B0); PG8_MMA(0, 1, At, B1); } PG8_BAR; PG8_SCHED;
            PG8_LDA(At, 0, 1); PG8_STAGE(PG8_SB(0, 0), b2, voffB); PG8_STAGE(PG8_SB(0, 1), b2 + hstepB, voffB); PG8_STAGE_A(PG8_SA(0, 0), a2, 0, last);
            if (fe) wait_vm<8 + Epi::NST>(); else PG8_WAIT_V(8); PG8_WAIT_L(0); PG8_BAR; if (FP8 && t == 0) { PG8_MMA_Z(1, 0, At, B0); PG8_MMA_Z(1, 1, At, B1); } else { PG8_MMA(1, 0, At, B0); PG8_MMA(1, 1, At, B1); } PG8_BAR; PG8_SCHED;
            PG8_LDB(B0, 1, 0); PG8_LDB(B1, 1, 1); PG8_SCHED; PG8_LDA(At, 1, 0); PG8_STAGE_A(PG8_SA(0, 1), a2, 1, last);
            PG8_WAIT_V(8); PG8_WAIT_L(0); PG8_BAR; PG8_MMA(0, 0, At, B0); PG8_MMA(0, 1, At, B1); PG8_BAR; PG8_SCHED;
            PG8_LDA(At, 1, 1); PG8_STAGE(PG8_SB(1, 0), b3, voffB); PG8_STAGE(PG8_SB(1, 1), b3 + hstepB, voffB); PG8_STAGE_A(PG8_SA(1, 0), a3, 0, last);
            PG8_WAIT_V(8); PG8_WAIT_L(0); PG8_BAR; PG8_MMA(1, 0, At, B0); PG8_MMA(1, 1, At, B1); PG8_BAR; PG8_SCHED;
        }
        if constexpr (ALIGN_EPI) { if (wr == 0) PG8_BAR; }
        if constexpr (FP8) {
            asm volatile("s_nop 15\n\ts_nop 15" ::: "memory");
#pragma unroll
            for (int a = 0; a < 2; ++a)
#pragma unroll
                for (int b = 0; b < 2; ++b)
                    asm volatile("" : "+v"(acc[a][b][0][0]), "+v"(acc[a][b][0][1]), "+v"(acc[a][b][1][0]), "+v"(acc[a][b][1][1]), "+v"(acc[a][b][2][0]), "+v"(acc[a][b][2][1]), "+v"(acc[a][b][3][0]), "+v"(acc[a][b][3][1])); }
        if constexpr (MIDSCALE) E(acc, cur, wr, wc, fr, fq, scl + ui * 256); else E(acc, cur, wr, wc, fr, fq, pre);
        if (!has_next) break;
        pre = E.prefetch(nxt, wr, fr);
        if constexpr (FP8) {
#pragma unroll
            for (int a = 0; a < 2; ++a)
#pragma unroll
                for (int b = 0; b < 2; ++b)
                    asm volatile("" : "=v"(acc[a][b][0][0]), "=v"(acc[a][b][0][1]), "=v"(acc[a][b][1][0]), "=v"(acc[a][b][1][1]), "=v"(acc[a][b][2][0]), "=v"(acc[a][b][2][1]), "=v"(acc[a][b][3][0]), "=v"(acc[a][b][3][1]));
        } else {
#pragma unroll
            for (int a = 0; a < 2; ++a)
#pragma unroll
                for (int b = 0; b < 2; ++b)
#pragma unroll
                    for (int m = 0; m < 4; ++m)
#pragma unroll
                        for (int n = 0; n < 2; ++n) acc[a][b][m][n] = (f32x4){0.f, 0.f, 0.f, 0.f};
        }
        cur = nxt; cA = nA; cB = nB; ++ui; fresh = true;
        if constexpr (GATHER) { _Pragma("unroll") for (int _h = 0; _h < 2; ++_h) _Pragma("unroll") for (int _i = 0; _i < 2; ++_i) gcur[_h][_i] = gnxt[_h][_i]; }
        if constexpr (ALIGN_EPI) { if (wr == 1) PG8_BAR; }
    }
    PG8_WAIT_V(0);
    if constexpr (!ALIGN_EPI) { if (wr == 0) PG8_BAR; }
    PG8_BAR;
#undef PG8_SA
#undef PG8_SB
#undef PG8_STAGE
#undef PG8_STAGE_A
#undef PG8_LDA
#undef PG8_LDB
#undef PG8_MMA
#undef PG8_MMA_Z
#undef PG8_WAIT_V
#undef PG8_WAIT_L
#undef PG8_BAR
#undef PG8_SCHED
#undef PG8_GLOAD
}
}
using pg8::Unit;

struct BatchOrder {
    int nN, v; const GAS char* A; const GAS char* B; size_t aT, bT;
    __device__ __forceinline__ bool next(int i, Unit& u) const {
        const int uu = i * 16 + (v & 15); if (uu >= 8 * nN) return false;
        u.pm = __builtin_amdgcn_readfirstlane((v >> 4) * 8 + uu / nN); u.pn = __builtin_amdgcn_readfirstlane(uu % nN); u.e = 0;
        u.a = A + (size_t)u.pm * aT; u.b = B + (size_t)u.pn * bT; return true;
    }
};
struct UpOrder {
    int v; const GAS char* LATp; const GAS char* Wq; const GAS char* Wkv;
    __device__ __forceinline__ bool next(int i, Unit& u) const {
        const int j = v & 15; const bool hi = j >= 8; if (i >= (hi ? 4 : 3)) return false;
        const bool kv = hi ? (i < 3) : (i == 2); u.pn = __builtin_amdgcn_readfirstlane(hi ? (kv ? 1 + i : 2) : (kv ? 0 : i)); u.e = __builtin_amdgcn_readfirstlane(kv ? 1 : 0); u.pm = __builtin_amdgcn_readfirstlane((v >> 4) * 8 + (j & 7));
        u.a = LATp + (size_t)u.pm * 256 * 512 * 2 + (u.e ? 512 : 0);
        u.b = (u.e ? Wkv : Wq) + (size_t)u.pn * 256 * 256 * 2; return true;
    }
};
struct MoeOrder {
    int G, c; const volatile LAS int* TS; const GAS char* A; const GAS char* W; size_t aT  , wE  , wT  ;
    __device__ __forceinline__ bool next(int i, Unit& u) const {
        const int L = i * G + c; const int ntile = __builtin_amdgcn_readfirstlane(TS[32]); if (L >= ntile * 4) return false;
        const int rt = L >> 2, ct = L & 3;
        const int ln_ = (int)__builtin_amdgcn_mbcnt_hi(~0u, __builtin_amdgcn_mbcnt_lo(~0u, 0u)); const int tsv_ = TS[ln_ & 31];
        const int e = __builtin_popcountll(__ballot(ln_ >= 1 && ln_ < 32 && tsv_ <= rt));
        u.pm = rt; u.pn = ct; u.e = e; u.a = A + (size_t)rt * aT; u.b = W + (size_t)e * wE + (size_t)ct * wT; return true;
    }
};

__device__ __forceinline__ u32x4 pack8(f32x4 v0, f32x4 v1) { u32x4 w; w.x = cvt_pk_bf16(v0[0], v0[1]); w.y = cvt_pk_bf16(v0[2], v0[3]); w.z = cvt_pk_bf16(v1[0], v1[1]); w.w = cvt_pk_bf16(v1[2], v1[3]); return w; }

__device__ __forceinline__ void wide_store(GAS bf16* p, long dB, bool lo, u32x4 X, u32x4 Y) {
    u32x4 Yr;
#pragma unroll
    for (int j = 0; j < 4; ++j) Yr[j] = (unsigned)__builtin_amdgcn_update_dpp(0, (int)Y[j], 0x128, 0xf, 0xf, false);
    u32x4 A, B;
#pragma unroll
    for (int j = 0; j < 4; ++j) { A[j] = lo ? X[j] : Yr[j]; B[j] = lo ? Yr[j] : X[j]; }
    *(GAS u32x4*)p = A; *(GAS u32x4*)(p + dB) = B;
}

struct EpiWin {
    static constexpr int NST = 16;
    static constexpr bool PERM = true, WIDE = true;
    GAS bf16* LAT_; GAS bf16* FQKV_; GAS bf16* KPE_; GAS float* FLOG_; GAS float* SSQ_; const GAS float* COS_; const GAS float* SIN_; const GAS float* RSX_;
    struct Pre { float v[8]; };
    __device__ __forceinline__ Pre prefetch(const Unit& u, int wr, int fr) const { Pre p; const GAS float* RSX = RSX_; asm volatile("" : "+s"(RSX));
#pragma unroll
        for (int g = 0; g < 8; ++g) p.v[g] = RSX[u.pm * 256 + (g >> 2) * 128 + wr * 64 + (g & 3) * 16 + fr]; return p; }
    __device__ __forceinline__ void operator()(f32x4 (&acc)[2][2][4][2], const Unit& u, int wr, int wc, int fr, int fq, const Pre& pre) const {
        GAS bf16* LAT = LAT_; GAS bf16* FQKV = FQKV_; GAS bf16* KPE = KPE_; GAS float* FLOG = FLOG_; GAS float* SSQ = SSQ_; const GAS float* COS = COS_; const GAS float* SIN = SIN_; const GAS float* RSX = RSX_;
        asm volatile("" : "+s"(LAT), "+s"(FQKV), "+s"(KPE), "+s"(FLOG), "+s"(SSQ), "+s"(COS), "+s"(SIN), "+s"(RSX));
        {
#pragma unroll
            for (int ai = 0; ai < 2; ++ai)
#pragma unroll
                for (int m = 0; m < 4; ++m) { const float rs_ = pre.v[ai * 4 + m];
#pragma unroll
                    for (int bj = 0; bj < 2; ++bj)
#pragma unroll
                        for (int n = 0; n < 2; ++n) acc[ai][bj][m][n] *= rs_; } }
        const int row0 = u.pm * 256 + wr * 64 + fr; const int pn = u.pn;
        const bool lo = fr < 8; const int roww = u.pm * 256 + wr * 64 + (fr & 7), colw = wc * 64 + (fr >> 3) * 32 + 8 * fq; const long dB = 8 * 512 + (lo ? 32 : -32);
        if (pn >= 2) {
            const int ti = pn >> 1; GAS bf16* dst = FQKV + (size_t)(ti - 1) * NTOK * 512 + (pn & 1) * 256 + colw; const float sc = (ti == 1) ? C2F : 1.f;
#pragma unroll
            for (int ai = 0; ai < 2; ++ai)
#pragma unroll
                for (int m = 0; m < 4; ++m) wide_store(dst + (size_t)(roww + ai * 128 + m * 16) * 512, dB, lo, pack8(acc[ai][0][m][0] * sc, acc[ai][0][m][1] * sc), pack8(acc[ai][1][m][0] * sc, acc[ai][1][m][1] * sc));
        } else {
#pragma unroll
            for (int ai = 0; ai < 2; ++ai)
#pragma unroll
                for (int m = 0; m < 4; ++m) { const int row = row0 + ai * 128 + m * 16;
                    wide_store(LAT + (size_t)(roww + ai * 128 + m * 16) * 512 + pn * 256 + colw, dB, lo, pack8(acc[ai][0][m][0], acc[ai][0][m][1]), pack8(acc[ai][1][m][0], acc[ai][1][m][1]));
                    float s = 0.f;
                    if (pn == 0 || wc < 2) {
#pragma unroll
                        for (int bj = 0; bj < 2; ++bj)
#pragma unroll
                            for (int n = 0; n < 2; ++n) { const f32x4 x = acc[ai][bj][m][n]; s += (x[0] * x[0] + x[1] * x[1]) + (x[2] * x[2] + x[3] * x[3]); }
                    }
                    s += __shfl_xor(s, 16); s += __shfl_xor(s, 32);
                    if (fq == 0) SSQ[(size_t)row * 8 + pn * 4 + wc] = s;
                    }
            if (pn == 1 && wc == 2) {
#pragma unroll
                for (int ai = 0; ai < 2; ++ai)
#pragma unroll
                    for (int m = 0; m < 4; ++m) { const int row = row0 + ai * 128 + m * 16;
                        const f32x4 c = *(const GAS f32x4*)(COS + (size_t)row * 16 + 4 * fq), sn = *(const GAS f32x4*)(SIN + (size_t)row * 16 + 4 * fq);
                        const f32x4 x1 = acc[ai][0][m][0], x2 = acc[ai][0][m][1];
                        *(GAS u32x4*)(KPE + (size_t)row * 32 + 8 * fq) = pack8(x1 * c - x2 * sn, x1 * sn + x2 * c);
                        }
            }
            if (pn == 1 && wc == 2 && fq == 0) {
#pragma unroll
                for (int ai = 0; ai < 2; ++ai)
#pragma unroll
                    for (int m = 0; m < 4; ++m) { const int row = row0 + ai * 128 + m * 16; *(GAS f32x4*)(FLOG + (size_t)row * 8) = acc[ai][1][m][0]; *(GAS f32x4*)(FLOG + (size_t)row * 8 + 4) = acc[ai][1][m][1]; }
            }
        }
    }
};
struct EpiUp {
    static constexpr int NST = 16;
    static constexpr bool PERM = true, WIDE = true;
    GAS bf16* QM_; GAS bf16* KVM_; const GAS float* SSQ_; const GAS float* COS_; const GAS float* SIN_;
    struct Pre { f32x4 v[8]; };
    __device__ __forceinline__ Pre prefetch(const Unit& u, int wr, int fr) const { Pre p; const GAS float* SSQ = SSQ_; asm volatile("" : "+s"(SSQ)); const int off = u.e ? 4 : 0;
#pragma unroll
        for (int g = 0; g < 8; ++g) p.v[g] = *(const GAS f32x4*)(SSQ + (size_t)(u.pm * 256 + (g >> 2) * 128 + wr * 64 + (g & 3) * 16 + fr) * 8 + off); return p; }
    __device__ __forceinline__ void operator()(const f32x4 (&acc)[2][2][4][2], const Unit& u, int wr, int wc, int fr, int fq, const Pre& pre) const {
        GAS bf16* QM = QM_; GAS bf16* KVM = KVM_; const GAS float* SSQ = SSQ_; const GAS float* COS = COS_; const GAS float* SIN = SIN_;
        asm volatile("" : "+s"(QM), "+s"(KVM), "+s"(SSQ), "+s"(COS), "+s"(SIN));
        const int row0 = u.pm * 256 + wr * 64 + fr; const int pn = u.pn; const bool kv = u.e != 0;
        const bool lo = fr < 8; const int roww = u.pm * 256 + wr * 64 + (fr & 7), colw = pn * 256 + wc * 64 + (fr >> 3) * 32 + 8 * fq;
#pragma unroll
        for (int ai = 0; ai < 2; ++ai)
#pragma unroll
            for (int m = 0; m < 4; ++m) { const int row = row0 + ai * 128 + m * 16;
                const f32x4 sq = pre.v[ai * 4 + m];
                const float ss = (sq[0] + sq[1]) + (sq[2] + sq[3]);
                if (kv) {
                    const float rs = rsqrtf(ss * (1.f / 128.f) + EPS);
                    wide_store(KVM + (size_t)(roww + ai * 128 + m * 16) * 1024 + colw, 8 * 1024 + (lo ? 32 : -32), lo, pack8(acc[ai][0][m][0] * rs, acc[ai][0][m][1] * rs), pack8(acc[ai][1][m][0] * rs, acc[ai][1][m][1] * rs));
                } else {
                    const float rs = rsqrtf(ss * (1.f / 256.f) + EPS) * C2M;
                    const f32x4 c = *(const GAS f32x4*)(COS + (size_t)row * 16 + 4 * fq), sn = *(const GAS f32x4*)(SIN + (size_t)row * 16 + 4 * fq);
                    u32x4 XY[2];
#pragma unroll
                    for (int bj = 0; bj < 2; ++bj) { f32x4 v0 = acc[ai][bj][m][0] * rs, v1 = acc[ai][bj][m][1] * rs;
                        const int G = 8 * pn + 2 * wc + bj;
                        if (G % 3 == 2) { const f32x4 x1 = v0, x2 = v1; v0 = x1 * c - x2 * sn; v1 = x1 * sn + x2 * c; }
                        XY[bj] = pack8(v0, v1); }
                    wide_store(QM + (size_t)(roww + ai * 128 + m * 16) * 768 + colw, 8 * 768 + (lo ? 32 : -32), lo, XY[0], XY[1]);
                }

            }
    }
};
template <bool RES_F32> struct EpiOut {
    static constexpr int NST = 16;
    static constexpr bool PERM = true, WIDE = true;
    const GAS float* resf_; GAS bf16* xr_;
    struct Pre {}; __device__ __forceinline__ Pre prefetch(const Unit&, int, int) const { return Pre{}; }
    __device__ __forceinline__ void operator()(const f32x4 (&acc)[2][2][4][2], const Unit& u, int wr, int wc, int fr, int fq, const LAS f32x2* scl) const {
        const GAS float* resf = resf_; GAS bf16* xr = xr_; asm volatile("" : "+s"(resf), "+s"(xr));
        const int row0 = u.pm * 256 + wr * 64 + fr, col0 = u.pn * 256 + wc * 64 + 8 * fq;
        const bool lo = fr < 8; const int roww = u.pm * 256 + wr * 64 + (fr & 7), colw = u.pn * 256 + wc * 64 + (fr >> 3) * 32 + 8 * fq;
#pragma unroll
        for (int ai = 0; ai < 2; ++ai)
#pragma unroll
            for (int m = 0; m < 4; ++m) { const size_t off = (size_t)(row0 + ai * 128 + m * 16) * DM + col0; const float sh = scl[ai * 128 + wr * 64 + m * 16 + fr][1];
                u32x4 XY[2];
#pragma unroll
                for (int bj = 0; bj < 2; ++bj) { f32x4 r0, r1;
                    if constexpr (RES_F32) { r0 = *(const GAS f32x4*)(resf + off + bj * 32); r1 = *(const GAS f32x4*)(resf + off + bj * 32 + 4); }
                    else { const u32x4 w = *(const GAS u32x4*)(xr + off + bj * 32);
                        r0 = (f32x4){__uint_as_float(w.x << 16), __uint_as_float(w.x & 0xffff0000u), __uint_as_float(w.y << 16), __uint_as_float(w.y & 0xffff0000u)};
                        r1 = (f32x4){__uint_as_float(w.z << 16), __uint_as_float(w.z & 0xffff0000u), __uint_as_float(w.w << 16), __uint_as_float(w.w & 0xffff0000u)}; }
                    XY[bj] = pack8(r0 + acc[ai][bj][m][0] * sh, r1 + acc[ai][bj][m][1] * sh); }
                wide_store(xr + (size_t)(roww + ai * 128 + m * 16) * DM + colw, 8 * DM + (lo ? 32 : -32), lo, XY[0], XY[1]); }
    }
};
struct EpiGU {
    static constexpr int NST = 8;
    static constexpr bool PERM = true, WIDE = false;
    GAS unsigned char* HH_; const GAS float* RS_;
    struct Pre { float v[8]; };
    __device__ __forceinline__ Pre prefetch(const Unit& u, int wr, int fr) const { Pre p; const GAS float* RS = RS_; asm volatile("" : "+s"(RS));
#pragma unroll
        for (int g = 0; g < 8; ++g) p.v[g] = RS[u.pm * 256 + (g >> 2) * 128 + wr * 64 + (g & 3) * 16 + fr]; return p; }
    __device__ __forceinline__ void operator()(const f32x4 (&acc)[2][2][4][2], const Unit& u, int wr, int wc, int fr, int fq, const Pre& pre) const {
        GAS unsigned char* HH = HH_; const GAS float* RS = RS_; asm volatile("" : "+s"(HH), "+s"(RS));
        const int row0 = u.pm * 256 + wr * 64 + fr;
#pragma unroll
        for (int ai = 0; ai < 2; ++ai)
#pragma unroll
            for (int m = 0; m < 4; ++m) { GAS unsigned char* rowp = HH + (size_t)(row0 + ai * 128 + m * 16) * 512 + u.pn * 128 + wc * 32 + 8 * fq; const float rs = pre.v[ai * 4 + m] * WSCALE_INV;
                f32x4 h[2];
#pragma unroll
                for (int n = 0; n < 2; ++n) { const f32x4 g = acc[ai][0][m][n] * rs, up = acc[ai][1][m][n] * rs;
#pragma unroll
                    for (int j = 0; j < 4; ++j) { const float sg = __builtin_amdgcn_rcpf(1.f + __builtin_amdgcn_exp2f(-g[j] * LOG2E)); h[n][j] = g[j] * sg * up[j]; } }
                u32x2 w; w.x = pk4_fp8(h[0][0], h[0][1], h[0][2], h[0][3]); w.y = pk4_fp8(h[1][0], h[1][1], h[1][2], h[1][3]); *(GAS u32x2*)rowp = w; }
    }
};
struct EpiDown {
    static constexpr int NST = 16;
    static constexpr bool PERM = true, WIDE = false;
    GAS unsigned char* Y_; const GAS float* GATEOF_;
    struct Pre { float v[8]; };
    __device__ __forceinline__ Pre prefetch(const Unit& u, int wr, int fr) const { Pre p; const GAS float* GT = GATEOF_; asm volatile("" : "+s"(GT));
#pragma unroll
        for (int g = 0; g < 8; ++g) p.v[g] = GT[u.pm * 256 + (g >> 2) * 128 + wr * 64 + (g & 3) * 16 + fr]; return p; }
    __device__ __forceinline__ void operator()(const f32x4 (&acc)[2][2][4][2], const Unit& u, int wr, int wc, int fr, int fq, const Pre& pre) const {
        GAS unsigned char* Y = Y_; const GAS float* GATEOF = GATEOF_; asm volatile("" : "+s"(Y), "+s"(GATEOF));
        const int row0 = u.pm * 256 + wr * 64 + fr;
#pragma unroll
        for (int ai = 0; ai < 2; ++ai)
#pragma unroll
            for (int m = 0; m < 4; ++m) { const int row = row0 + ai * 128 + m * 16; const float g = pre.v[ai * 4 + m]; GAS unsigned char* rowp = Y + (size_t)row * 1024 + u.pn * 256 + wc * 32 + 8 * fq;
#pragma unroll
                for (int bj = 0; bj < 2; ++bj) { const f32x4 v0 = acc[ai][bj][m][0] * g, v1 = acc[ai][bj][m][1] * g; u32x2 w; w.x = pk4_fp8(v0[0], v0[1], v0[2], v0[3]); w.y = pk4_fp8(v1[0], v1[1], v1[2], v1[3]); *(GAS u32x2*)(rowp + bj * 128) = w; } }
    }
};

namespace att {
constexpr int KSLOT = 12288, VSLOT = 8192;
constexpr int L_K = 0, L_V = 2 * KSLOT, L_BIAS = L_V + 2 * VSLOT, L_WS = L_BIAS + 8192, L_OST = L_WS + 8 * 64 * 4, L_END = L_OST + 8 * 4096;
__device__ __forceinline__ int crow(int r, int hi) { return (r & 3) + 8 * (r >> 2) + 4 * hi; }
typedef short v4i16_t __attribute__((ext_vector_type(4)));
__device__ __forceinline__ s16x4 vtr(const LAS char* p) { return __builtin_bit_cast(s16x4, __builtin_amdgcn_ds_read_tr16_b64_v4i16((LAS v4i16_t*)p)); }

constexpr int NSL = 5;
constexpr int R_K = 0, R_V = NSL * KSLOT, R_WS = R_V + NSL * VSLOT, R_OST = R_WS + 8 * 64 * 4, R_END = R_OST + 8 * 4096;
static_assert(R_END <= RING_BYTES, "attention LDS");
__device__ __forceinline__ void glds16(const GAS void* gsrc, unsigned lds_dst) { unsigned keep;
    asm volatile("s_mov_b32 %0, m0\n\ts_mov_b32 m0, %2\n\ts_nop 0\n\tglobal_load_lds_dwordx4 %1, off\n\ts_mov_b32 m0, %0" : "=&s"(keep) : "v"(gsrc), "s"(lds_dst) : "memory"); }
__device__ __forceinline__ void glds16s(const GAS void* sbase, unsigned voff, unsigned lds_dst) { unsigned keep;
    asm volatile("s_mov_b32 %0, m0\n\ts_mov_b32 m0, %3\n\ts_nop 0\n\tglobal_load_lds_dwordx4 %1, %2\n\ts_mov_b32 m0, %0" : "=&s"(keep) : "v"(voff), "s"((unsigned long long)sbase), "s"(lds_dst) : "memory"); }
struct Tens2 { const GAS bf16* Q; int qp; const GAS bf16* K; int kp; const GAS bf16* KX; const GAS bf16* V; int vp; GAS bf16* O; const GAS float* BIASF; const GAS float* NRM; GAS float* OSS; };
template <int MODE>
__device__ __forceinline__ int attn_unit2(const int wave_, int b, int h, int qb, const Tens2& T, LAS char* shm, const int slbase, const bool have_pro, const int qb_next, bf16x8 (&qr)[6], const int tstart) {
    constexpr int DKS = MODE ? 6 : 5, DKH = 3;
    constexpr float THR = 8.f;
    int wid = wave_; asm volatile("" : "+s"(wid));
    int lane = (int)__builtin_amdgcn_mbcnt_hi(~0u, __builtin_amdgcn_mbcnt_lo(~0u, 0u)); asm volatile("" : "+v"(lane)); const int r32 = lane & 31, hi = lane >> 5;
    const long rowbase = (long)b * SEQ; const int q0 = qb * 256, qw0 = q0 + wid * 32;
    const int NT = (q0 + 256) / 64, tlast = qw0 / 64;
    const int NTE = NT - tstart;
    const GAS bf16* Qw = T.Q + (rowbase + qw0) * T.qp + h * (MODE ? 96 : 64);
    const GAS bf16* Kh = T.K + rowbase * T.kp + h * (MODE ? 128 : 64);
    const GAS bf16* Vh = T.V + rowbase * T.vp + h * (MODE ? 128 : 64);
    LAS float* wsf = (LAS float*)(shm + R_WS) + wid * 64;
    const unsigned koff = (unsigned)(lane * T.kp + wid * 8) * 2u;
    const unsigned xoff = MODE ? (unsigned)(lane * 32 + (wid & 3) * 8) * 2u : (unsigned)(lane * 8) * 2u;
    const unsigned voff = (unsigned)((16 * (wid & 3) + (lane >> 2)) * T.vp + (wid >> 2) * 32 + (lane & 3) * 8) * 2u;
    const GAS bf16* xbase = MODE ? T.KX + rowbase * 32 : T.KX + ((long)b * 8 + h) * SEQ * 8;
    const int xstep = MODE ? 64 * 32 : 64 * 8;
    const unsigned kdst_a = (unsigned)(uintptr_t)(shm + R_K) + (unsigned)wid * 1024u, xdst_a = (unsigned)(uintptr_t)(shm + R_K) + (unsigned)(8 + (MODE ? (wid & 3) : 0)) * 1024u, vdst_a = (unsigned)(uintptr_t)(shm + R_V) + (unsigned)wid * 1024u;
#define A2_DMA(t, slot) do { \
        glds16s((const GAS void*)(Kh + (long)(t) * 64 * T.kp), koff, (unsigned)__builtin_amdgcn_readfirstlane((int)(kdst_a + (slot) * KSLOT))); \
        glds16s((const GAS void*)(xbase + (long)(t) * xstep), xoff, (unsigned)__builtin_amdgcn_readfirstlane((int)(xdst_a + (slot) * KSLOT))); \
        glds16s((const GAS void*)(Vh + (long)(t) * 64 * T.vp), voff, (unsigned)__builtin_amdgcn_readfirstlane((int)(vdst_a + (slot) * VSLOT))); } while (0)
    float mhat = 0.f, lrun = 0.f; f32x16 o[2]; o[0] = f32x16{}; o[1] = f32x16{}; f32x16 negm = f32x16{};
    const LAS char* vp0 = shm + R_V + ((lane >> 4) & 1) * 32 + (lane & 3) * 8 + (4 * hi + ((lane & 15) >> 2)) * 64;
#define A3_SLOT(k) ((slbase + (k)) % NSL)
    if (!have_pro) { A2_DMA(NT - 1, A3_SLOT(0)); A2_DMA(NT - 2, A3_SLOT(1)); A2_DMA(NT - 3, A3_SLOT(2)); }
    if (!have_pro) {
#pragma unroll
        for (int d0 = 0; d0 < (MODE ? 6 : 4); ++d0) qr[d0] = *(const GAS bf16x8*)(Qw + (long)r32 * T.qp + d0 * 16 + hi * 8); }
    if (MODE == 0) { const short one = hi ? (short)0 : (short)0x3F80; qr[DKS - 1] = (bf16x8){one, one, one, 0, 0, 0, 0, 0}; }
#pragma unroll
    for (int d0 = 0; d0 < DKS; ++d0) asm volatile("" : "+v"(qr[d0]));
#define A3_KLOADH(slot, H) do { const LAS char* kb_ = shm + R_K + (slot) * KSLOT + r32 * 16; _Pragma("unroll") for (int d0 = (H) * DKH; d0 < ((H) ? DKS : DKH); ++d0) { const int off = (MODE == 0 && d0 == 4) ? 8 * 1024 : d0 * 2048 + hi * 1024; \
        kf[2 * (d0 - (H) * DKH)] = *(const LAS bf16x8*)(kb_ + off); kf[2 * (d0 - (H) * DKH) + 1] = *(const LAS bf16x8*)(kb_ + off + 512); } } while (0)
#define A3_VLOAD(slot) do { const LAS char* vp_ = vp0 + (slot) * VSLOT; _Pragma("unroll") for (int q = 0; q < 8; ++q) { vlo[q] = vtr(vp_ + (q >> 2) * 4096 + (q & 3) * 1024); vhh[q] = vtr(vp_ + (q >> 2) * 4096 + (q & 3) * 1024 + 512); } } while (0)
#define A3_QKH(H) do { if ((H) == 0) { c0 = negm; c1 = negm; } _Pragma("unroll") for (int d0 = (H) * DKH; d0 < ((H) ? DKS : DKH); ++d0) { c0 = __builtin_amdgcn_mfma_f32_32x32x16_bf16(kf[2 * (d0 - (H) * DKH)], qr[d0], c0, 0, 0, 0); c1 = __builtin_amdgcn_mfma_f32_32x32x16_bf16(kf[2 * (d0 - (H) * DKH) + 1], qr[d0], c1, 0, 0, 0); } } while (0)
#define A3_EXP() do { float ls_ = 0.f; _Pragma("unroll") for (int r = 0; r < 16; ++r) { pp0[r] = __builtin_amdgcn_exp2f(pp0[r]); pp1[r] = __builtin_amdgcn_exp2f(pp1[r]); ls_ += pp0[r] + pp1[r]; } lrun += ls_; u32x4 w_; \
        w_.x = cvt_pk_bf16(pp0[0], pp0[1]); w_.y = cvt_pk_bf16(pp0[2], pp0[3]); w_.z = cvt_pk_bf16(pp0[4], pp0[5]); w_.w = cvt_pk_bf16(pp0[6], pp0[7]); pa[0] = __builtin_bit_cast(bf16x8, w_); \
        w_.x = cvt_pk_bf16(pp0[8], pp0[9]); w_.y = cvt_pk_bf16(pp0[10], pp0[11]); w_.z = cvt_pk_bf16(pp0[12], pp0[13]); w_.w = cvt_pk_bf16(pp0[14], pp0[15]); pa[1] = __builtin_bit_cast(bf16x8, w_); \
        w_.x = cvt_pk_bf16(pp1[0], pp1[1]); w_.y = cvt_pk_bf16(pp1[2], pp1[3]); w_.z = cvt_pk_bf16(pp1[4], pp1[5]); w_.w = cvt_pk_bf16(pp1[6], pp1[7]); pa[2] = __builtin_bit_cast(bf16x8, w_); \
        w_.x = cvt_pk_bf16(pp1[8], pp1[9]); w_.y = cvt_pk_bf16(pp1[10], pp1[11]); w_.z = cvt_pk_bf16(pp1[12], pp1[13]); w_.w = cvt_pk_bf16(pp1[14], pp1[15]); pa[3] = __builtin_bit_cast(bf16x8, w_); } while (0)
#define A3_PV() do { _Pragma("unroll") for (int d0 = 0; d0 < 2; ++d0) _Pragma("unroll") for (int k = 0; k < 4; ++k) { const s16x4 lo_ = vlo[4 * d0 + k], hh_ = vhh[4 * d0 + k]; \
        const bf16x8 vf_ = (bf16x8){lo_[0], lo_[1], lo_[2], lo_[3], hh_[0], hh_[1], hh_[2], hh_[3]}; o[d0] = __builtin_amdgcn_mfma_f32_32x32x16_bf16(pa[k], vf_, o[d0], 0, 0, 0); } } while (0)
#define A3_ROWMAX(rm) do { float a_ = fmaxf(fmaxf(c0[0], c0[1]), c1[0]), b_ = fmaxf(fmaxf(c0[2], c0[3]), c1[1]); a_ = fmaxf(fmaxf(a_, c1[2]), c1[3]); \
        _Pragma("unroll") for (int r = 4; r < 16; r += 4) { a_ = fmaxf(fmaxf(a_, c0[r]), c0[r + 1]); b_ = fmaxf(fmaxf(b_, c0[r + 2]), c0[r + 3]); a_ = fmaxf(fmaxf(a_, c1[r]), c1[r + 1]); b_ = fmaxf(fmaxf(b_, c1[r + 2]), c1[r + 3]); } \
        rm = fmaxf(a_, b_); const auto rr_ = __builtin_amdgcn_permlane32_swap(__float_as_uint(rm), __float_as_uint(rm), false, false); rm = fmaxf(__uint_as_float(rr_[0]), __uint_as_float(rr_[1])); } while (0)
    int sl = A3_SLOT(0), sl3 = A3_SLOT(3);
    f32x16 pp0 = f32x16{}, pp1 = f32x16{}; bool pend = false; int pslot = 0;
    for (int i = 0; i < NTE; ++i) {
        const int t = NT - 1 - i;
        { const int ahead = NTE - 1 - i;
          if (ahead >= 2) asm volatile("s_waitcnt vmcnt(6)" ::: "memory"); else if (ahead == 1) asm volatile("s_waitcnt vmcnt(3)" ::: "memory"); else asm volatile("s_waitcnt vmcnt(0)" ::: "memory"); }
        __builtin_amdgcn_s_barrier(); asm volatile("" ::: "memory");
        if (i + 3 < NTE) A2_DMA(t - 3, sl3);
        if (i == NTE - 1 && qb_next >= 0) { const int NTn = 4 * qb_next + 4; A2_DMA(NTn - 1, A3_SLOT(NTE)); A2_DMA(NTn - 2, A3_SLOT(NTE + 1)); A2_DMA(NTn - 3, A3_SLOT(NTE + 2)); }
        if (t <= tlast) {
            bf16x8 kf[2 * DKH]; f32x16 c0, c1; float rm;
            A3_KLOADH(sl, 0);
            if (!pend) {
                A3_QKH(0); A3_KLOADH(sl, 1); A3_QKH(1);
                if (MODE == 0) { const int qrel = qw0 + r32 - 64 * t;
#pragma unroll
                    for (int r = 0; r < 16; ++r) { const int kv = crow(r, hi); if (kv > qrel) c0[r] = -INFINITY; if (kv + 32 > qrel) c1[r] = -INFINITY; } }
                A3_ROWMAX(rm);
                mhat = rm;
#pragma unroll
                for (int r = 0; r < 16; ++r) { c0[r] -= rm; c1[r] -= rm; negm[r] = -mhat; }
                pend = true;
            } else {
                s16x4 vlo[8], vhh[8]; bf16x8 pa[4];
                A3_QKH(0); A3_KLOADH(sl, 1);
                A3_VLOAD(pslot);
                A3_QKH(1);
                A3_EXP();
#pragma unroll
                for (int g_ = 0; g_ < 2 * DKS; ++g_) { __builtin_amdgcn_sched_group_barrier(0x008, 1, 0); __builtin_amdgcn_sched_group_barrier(0x002, 7, 0); }
                A3_PV();
                A3_ROWMAX(rm);
#pragma unroll
                for (int g_ = 0; g_ < 8; ++g_) { __builtin_amdgcn_sched_group_barrier(0x008, 1, 0); __builtin_amdgcn_sched_group_barrier(0x002, 3, 0); }
                if (__any(rm > THR)) {
                    const float dl = fmaxf(rm, 0.f); mhat += dl;
#pragma unroll
                    for (int r = 0; r < 16; ++r) { c0[r] -= dl; c1[r] -= dl; negm[r] = -mhat; }
                    const float f = __builtin_amdgcn_exp2f(-dl); lrun *= f;
                    if (hi == 0) wsf[r32] = f;
                    LDS_WAIT();
#pragma unroll
                    for (int g = 0; g < 4; ++g) { const f32x4 ff = *(const LAS f32x4*)(wsf + 8 * g + 4 * hi);
#pragma unroll
                        for (int j = 0; j < 4; ++j) { o[0][4 * g + j] *= ff[j]; o[1][4 * g + j] *= ff[j]; } }
                }
            }
            pp0 = c0; pp1 = c1; pslot = sl;
        }
        sl = (sl == NSL - 1) ? 0 : sl + 1; sl3 = (sl3 == NSL - 1) ? 0 : sl3 + 1;
    }
    if (qb_next >= 0) { const GAS bf16* Qn = T.Q + (rowbase + qb_next * 256 + wid * 32) * T.qp + h * (MODE ? 96 : 64);
#pragma unroll
        for (int d0 = 0; d0 < (MODE ? 6 : 4); ++d0) qr[d0] = *(const GAS bf16x8*)(Qn + (long)r32 * T.qp + d0 * 16 + hi * 8); }
    if (pend) { s16x4 vlo[8], vhh[8]; bf16x8 pa[4]; A3_VLOAD(pslot); A3_EXP(); A3_PV(); }
#undef A3_KLOADH
#undef A3_VLOAD
#undef A3_QKH
#undef A3_EXP
#undef A3_PV
#undef A3_ROWMAX
#undef A2_DMA
    lrun += __shfl_xor(lrun, 32);
    LDS_WAIT();
    if (hi == 0) wsf[32 + r32] = lrun;
    LDS_WAIT();
    float rli[16];
#pragma unroll
    for (int g = 0; g < 4; ++g) { const f32x4 ll = *(const LAS f32x4*)(wsf + 32 + 8 * g + 4 * hi);
#pragma unroll
        for (int j = 0; j < 4; ++j) rli[4 * g + j] = __builtin_amdgcn_rcpf(ll[j]); }
    GAS bf16* Ow = T.O + (rowbase + qw0) * 1024 + (MODE ? 0 : 512) + h * 64;
    { LAS bf16* stg = (LAS bf16*)(shm + R_OST) + wid * 2048;
#pragma unroll
      for (int r = 0; r < 16; ++r) { const int orow = crow(r, hi);
#pragma unroll
          for (int d0 = 0; d0 < 2; ++d0) stg[orow * 64 + d0 * 32 + r32] = (bf16)(cvt_pk_bf16(o[d0][r] * rli[r], 0.f) & 0xffffu); }
      LDS_WAIT();
#pragma unroll
      for (int i = 0; i < 4; ++i) { const int row = i * 8 + (lane >> 3), ch = lane & 7; const u32x4 v = *(const LAS u32x4*)(stg + row * 64 + ch * 8); *(GAS u32x4*)(Ow + (long)row * 1024 + ch * 8) = v;
          float sq = 0.f;
#pragma unroll
          for (int j = 0; j < 4; ++j) { const float a0 = __uint_as_float(v[j] << 16), a1 = __uint_as_float(v[j] & 0xffff0000u); sq += a0 * a0 + a1 * a1; }
          sq += __shfl_xor(sq, 1); sq += __shfl_xor(sq, 2); sq += __shfl_xor(sq, 4);
          if (ch == 0) T.OSS[(rowbase + qw0 + row) * 16 + (MODE ? 0 : 8) + h] = sq; } }
    if (qb_next < 0) { LDS_WAIT(); __builtin_amdgcn_s_barrier(); asm volatile("" ::: "memory"); }
    return A3_SLOT(NTE);
#undef A3_SLOT
}
}

struct Args { const void* in[21]; float* out; unsigned char* ws; int ph_lo, ph_hi; };

__device__ __forceinline__ void tr_item(const GAS float* __restrict__ W, int ldw, int Ksrc, const GAS float* __restrict__ gain, GAS bf16* __restrict__ WT, int ldk, int k0, int n0, int srccol, LAS float* scr, int lane) {
#pragma unroll 8
    for (int i = 0; i < 32; ++i) { const int kk = 2 * i + (lane >> 5); const int k = k0 + kk;
        float v = 0.f; if (srccol >= 0 && k < Ksrc) { v = __builtin_nontemporal_load(W + (size_t)k * ldw + srccol); if (gain) v *= gain[k]; }
        scr[kk * 33 + (lane & 31)] = v; }
    LDS_WAIT(); asm volatile("" ::: "memory");
    const int c = lane & 7;
#pragma unroll
    for (int j = 0; j < 4; ++j) { const int n = (lane >> 3) + 8 * j; const LAS float* s = scr + (8 * c) * 33 + n;
        u32x4 o; o.x = cvt_pk_bf16(s[0 * 33], s[1 * 33]); o.y = cvt_pk_bf16(s[2 * 33], s[3 * 33]); o.z = cvt_pk_bf16(s[4 * 33], s[5 * 33]); o.w = cvt_pk_bf16(s[6 * 33], s[7 * 33]);
        *(GAS u32x4*)(WT + (size_t)(n0 + n) * ldk + k0 + 8 * c) = o; }
    LDS_WAIT(); asm volatile("" ::: "memory");
}
__device__ __forceinline__ void tr_item64(const GAS float* __restrict__ W, int ldw, const GAS float* __restrict__ gain, GAS bf16* __restrict__ WT, int ldk, int k0, int n0src, int n0dst, LAS float* scr, int lane) {
    const int rr = lane >> 4, c4 = (lane & 15) * 4;
    f32x4 v[16];
#pragma unroll
    for (int i = 0; i < 16; ++i) v[i] = __builtin_nontemporal_load((const GAS f32x4*)(W + (size_t)(k0 + 4 * i + rr) * ldw + n0src + c4));
#pragma unroll
    for (int i = 0; i < 16; ++i) { const int k = 4 * i + rr; const float g = gain ? gain[k0 + k] : 1.f; LAS float* d = scr + k * 65 + c4;
        d[0] = v[i][0] * g; d[1] = v[i][1] * g; d[2] = v[i][2] * g; d[3] = v[i][3] * g; }
    LDS_WAIT(); asm volatile("" ::: "memory");
    const int kc = lane & 7;
#pragma unroll
    for (int j = 0; j < 8; ++j) { const int n = (lane >> 3) + 8 * j; const LAS float* sp = scr + (8 * kc) * 65 + n;
        u32x4 o; o.x = cvt_pk_bf16(sp[0 * 65], sp[1 * 65]); o.y = cvt_pk_bf16(sp[2 * 65], sp[3 * 65]); o.z = cvt_pk_bf16(sp[4 * 65], sp[5 * 65]); o.w = cvt_pk_bf16(sp[6 * 65], sp[7 * 65]);
        *(GAS u32x4*)(WT + (size_t)(n0dst + n) * ldk + k0 + 8 * kc) = o; }
    LDS_WAIT(); asm volatile("" ::: "memory");
}
__device__ __forceinline__ void tr_item64_f8(const GAS float* __restrict__ W, int ldw, const GAS float* __restrict__ gain, float scale, GAS unsigned char* __restrict__ WT8, int ldkB, int k0, int n0src, int n0dst, LAS float* scr, int lane) {
    const int rr = lane >> 4, c4 = (lane & 15) * 4;
    f32x4 v[16];
#pragma unroll
    for (int i = 0; i < 16; ++i) v[i] = __builtin_nontemporal_load((const GAS f32x4*)(W + (size_t)(k0 + 4 * i + rr) * ldw + n0src + c4));
#pragma unroll
    for (int i = 0; i < 16; ++i) { const int k = 4 * i + rr; const float g = (gain ? gain[k0 + k] : 1.f) * scale; LAS float* d = scr + k * 65 + c4;
        d[0] = v[i][0] * g; d[1] = v[i][1] * g; d[2] = v[i][2] * g; d[3] = v[i][3] * g; }
    LDS_WAIT(); asm volatile("" ::: "memory");
    const int kc = lane & 7;
#pragma unroll
    for (int j = 0; j < 8; ++j) { const int n = (lane >> 3) + 8 * j; const LAS float* sp = scr + (8 * kc) * 65 + n;
        u32x2 o; o.x = pk4_fp8(sp[0 * 65], sp[1 * 65], sp[2 * 65], sp[3 * 65]); o.y = pk4_fp8(sp[4 * 65], sp[5 * 65], sp[6 * 65], sp[7 * 65]);
        *(GAS u32x2*)(WT8 + (size_t)(n0dst + n) * ldkB + k0 + 8 * kc) = o; }
    LDS_WAIT(); asm volatile("" ::: "memory");
}
__device__ __forceinline__ int rope_dim(int p) { const int a = p >> 3, j = p & 7; return j < 4 ? 4 * a + j : 16 + 4 * a + (j - 4); }

#define LDP(i) ((void*)((((unsigned long long)(unsigned)__builtin_amdgcn_readfirstlane((int)(ARGP[i] >> 32))) << 32) | (unsigned long long)(unsigned)__builtin_amdgcn_readfirstlane((int)(unsigned)ARGP[i])))
#define ARGIN(i) ((const void*)LDP(i))
#define P_COS ((GAS float*)(ws + WS_COS))
#define P_SIN ((GAS float*)(ws + WS_SIN))
#define P_SSQ ((GAS float*)(ws + WS_SSQ))
#define P_FLOG ((GAS float*)(ws + WS_FLOG))
#define P_E01 ((GAS int*)(ws + WS_E01))
#define P_G01 ((GAS float*)(ws + WS_G01))
#define P_SLOT ((GAS int*)(ws + WS_SLOT))
#define P_TOKOF ((GAS int*)(ws + WS_TOKOF))
#define P_GATEOF ((GAS float*)(ws + WS_GATEOF))
#define P_CNT ((GAS int*)(ws + WS_CNT))
#define P_TSTART ((GAS int*)(ws + WS_TSTART))
#define P_RSTD ((GAS float*)(ws + WS_RSTD))
#define P_RSTDOF ((GAS float*)(ws + WS_RSTDOF))
#define P_KPE ((GAS bf16*)(ws + WS_KPE))
#define P_KAUG ((GAS bf16*)(ws + WS_KAUG))
#define P_BIASF ((GAS float*)(ws + WS_BIASF))
#define P_NRM ((GAS float*)(ws + WS_NRM))
#define P_WR_L(l) ((GAS bf16*)(ws + ((l) ? WS_W1 + 7 * MiB : WS_WR)))
#define P_XR ((GAS bf16*)(ws + WS_XR))
#define P_OSS ((GAS float*)(ws + WS_OSS))
#define P_RSTDX ((GAS float*)(ws + WS_RSTDX))
#define P_WIN_L(l) ((GAS bf16*)(ws + ((l) ? WS_W1 : WS_WIN)))
#define P_WUQ_L(l) ((GAS bf16*)(ws + ((l) ? WS_W1 + 4 * MiB : WS_WUQ)))
#define P_WUKV_L(l) ((GAS bf16*)(ws + ((l) ? WS_W1 + 4 * MiB + 512 * KiB : WS_WUKV)))
#define P_WOUT_L(l) ((GAS bf16*)(ws + ((l) ? WS_W1 + 5 * MiB : WS_WOUT)))
#define P_WGU_L(ll) ((GAS unsigned char*)(ws + WS_WGU + (size_t)((ll) & 1) * 32 * MiB))
#define P_WD_L(ll) ((GAS unsigned char*)(ws + WS_WD + (size_t)((ll) & 1) * 16 * MiB))
#define P_XN ((GAS bf16*)(ws + WS_XN))
#define P_FQKV ((GAS bf16*)(ws + WS_FQKV))
#define P_HH ((GAS bf16*)(ws + WS_FQKV))
#define P_LAT ((GAS bf16*)(ws + WS_LAT))
#define P_QM ((GAS bf16*)(ws + WS_QM))
#define P_KVM ((GAS bf16*)(ws + WS_KVM))
#define P_Y ((GAS bf16*)(ws + WS_Y))
#define IN(k) (lo <= (k) && (k) < hi_)
#if MK_ONE_LAUNCH
#define GRID_BAR() xcd_barrier(bar)
#else
#define GRID_BAR() do {} while (0)
#endif
#define SEAM(k) do { if (IN(k) && IN((k) + 1)) GRID_BAR(); } while (0)
#if MK_ONE_LAUNCH
#define GROUP_BAR() xcd_barrier(gbar)
#else
#define GROUP_BAR() do {} while (0)
#endif
#define SEAMG(k) do { if (IN(k) && IN((k) + 1)) GROUP_BAR(); } while (0)
__device__ __forceinline__ void conv_gu_item(int r, const GAS float* w_gate, const GAS float* w_up, const GAS float* ffn_norm, GAS unsigned char* WGU, LAS float* scr64, int lane) {
    const int e = r / 256, q = r % 256, kb = q / 16, nb = q % 16; const int n0 = nb * 64; const int ct = n0 >> 8, which = (n0 >> 7) & 1, jj = n0 & 127;
    const GAS float* src = (which ? w_up : w_gate) + (size_t)e * DM * DEXP;
    tr_item64_f8(src, DEXP, ffn_norm, WSCALE, WGU + (size_t)e * 1024 * 1024, DM, kb * 64, ct * 128 + jj, n0, scr64, lane);
}
__device__ __forceinline__ void conv_d_item(int r, const GAS float* w_down, GAS unsigned char* WD, LAS float* scr64, int lane) {
    const int e = r / 128, q = r % 128, kb = q / 16, nb = q % 16;
    tr_item64_f8(w_down + (size_t)e * DEXP * DM, DM, nullptr, WSCALE, WD + (size_t)e * 1024 * 512, DEXP, kb * 64, nb * 64, nb * 64, scr64, lane);
}
template <int l>
__device__ __forceinline__ void layer_body(const int lo, const int hi_, LAS unsigned char* lds0, const int wave0, const int G0, const int bx0, const XcdBarrier& bar, const XcdBarrier& gbar) {
        const int P = 10 * l;
        if (IN(P)) for (int rep_ = 0; rep_ < (l == 0 ? NREP(0) : 1); ++rep_) {
            unsigned ldsb_ = (unsigned)(uintptr_t)lds0; asm volatile("" : "+s"(ldsb_)); LAS unsigned char* lds = (LAS unsigned char*)(uintptr_t)ldsb_; volatile LAS unsigned* MISC = (volatile LAS unsigned*)(lds + MISC_OFF); volatile LAS unsigned long long* ARGP = (volatile LAS unsigned long long*)(lds + MISC_OFF + 768); (void)MISC; int wave = wave0, G = G0, bx = bx0; asm volatile("" : "+s"(G), "+s"(bx), "+s"(wave)); const int lane = (int)__builtin_amdgcn_mbcnt_hi(~0u, __builtin_amdgcn_mbcnt_lo(~0u, 0u)); const int tid = wave * 64 + lane; const int vcu = (bx % 8) * (G / 8) + bx / 8; const int gw = vcu * 8 + wave, NGW = G * 8; (void)lane; (void)gw; (void)NGW; (void)vcu;
            GAS unsigned char* ws = (GAS unsigned char*)LDP(22); GAS float* out = (GAS float*)LDP(21); const GAS float* x_in = (const GAS float*)ARGIN(0); const GAS int* positions = (const GAS int*)ARGIN(1);
            if constexpr (l == 0) {
                LAS float* scr = (LAS float*)(lds + wave * 16640);
                constexpr int I_IN = 16 * 64, I_UQ = 4 * 24, I_UKV = 4 * 32, J_OUT = 16 * 16;
                constexpr int NITEMS = I_IN + I_UQ + I_UKV + J_OUT;
                for (int it = vcu + G * wave; it < NLAYER * NITEMS; it += NGW) {
                    const int lw = it / NITEMS; int r = it % NITEMS; const int j = lane & 31;
                    if (r < I_IN) { const GAS float* attn_norm = (const GAS float*)ARGIN(2) + (size_t)lw * DM; const GAS float* w_in = (const GAS float*)ARGIN(3) + (size_t)lw * DM * INW;
                        const int kb = r / 64, nb = r % 64; const int n = nb * 32 + j; int sc;
                        if (n < 384) sc = n; else if (n < 416) sc = 384 + rope_dim(n - 384); else if (n < 424) sc = 1952 + (n - 416); else if (n < 512) sc = -1; else sc = 416 + (n - 512);
                        tr_item(w_in, INW, DM, attn_norm, P_WIN_L(lw), DM, kb * 64, nb * 32, sc, scr, lane); continue; } r -= I_IN;
                    if (r < I_UQ) { const GAS float* q_norm = (const GAS float*)ARGIN(5) + (size_t)lw * 256; const GAS float* w_uq = (const GAS float*)ARGIN(6) + (size_t)lw * 256 * 768;
                        const int kb = r / 24, nb = r % 24; const int n = nb * 32 + j; const int hh = n / 96, d = n % 96; const int sc = d < 64 ? n : hh * 96 + 64 + rope_dim(d - 64);
                        tr_item(w_uq, 768, 256, q_norm, P_WUQ_L(lw), 256, kb * 64, nb * 32, sc, scr, lane); continue; } r -= I_UQ;
                    if (r < I_UKV) { const GAS float* kv_norm = (const GAS float*)ARGIN(7) + (size_t)lw * 128; const GAS float* w_ukv = (const GAS float*)ARGIN(8) + (size_t)lw * 128 * 1024;
                        const int kb = r / 32, nb = r % 32; tr_item(w_ukv, 1024, 128, kv_norm, P_WUKV_L(lw), 256, kb * 64, nb * 32, nb * 32 + j, scr, lane); continue; } r -= I_UKV;
                    { const GAS float* mla_on = (const GAS float*)ARGIN(9) + (size_t)lw * 512; const GAS float* fox_on = (const GAS float*)ARGIN(10) + (size_t)lw * 512; const GAS float* w_out = (const GAS float*)ARGIN(11) + (size_t)lw * DM * DM;
                        const int kb = r / 16, nb = r % 16; const GAS float* gn = kb < 8 ? mla_on : fox_on - 512; tr_item64(w_out, DM, gn, P_WOUT_L(lw), DM, kb * 64, nb * 64, nb * 64, scr, lane); }
                }
                { LAS float* scr64 = (LAS float*)(lds + wave * 16640);
                  const GAS float* ffn_norm = (const GAS float*)ARGIN(12);
                  const GAS float* w_gate = (const GAS float*)ARGIN(17); const GAS float* w_up = (const GAS float*)ARGIN(18); const GAS float* w_down = (const GAS float*)ARGIN(19);
                  constexpr int J_GU = 16 * 16 * NEXP, J_D = 8 * 16 * NEXP;
                  for (int it = vcu + G * ((wave + 5) & 7); it < J_GU + J_D; it += NGW) {
                      int r = it;
                      if (r < J_GU) { conv_gu_item(r, w_gate, w_up, ffn_norm, P_WGU_L(0), scr64, lane); continue; } r -= J_GU;
                      conv_d_item(r, w_down, P_WD_L(0), scr64, lane);
                  } }
                for (int lw = 0; lw < NLAYER; ++lw) { const GAS float* ffn_norm = (const GAS float*)ARGIN(12) + (size_t)lw * DM; const GAS float* w_rg = (const GAS float*)ARGIN(13) + (size_t)lw * DM * 4; const GAS float* w_re = (const GAS float*)ARGIN(15) + (size_t)lw * DM * 32;
                  for (int idx = bx * 512 + tid; idx < 2 * 48 * 520; idx += G * 512) { const int half = idx / (48 * 520), r = idx % (48 * 520), c = r / 520, kk = r % 520; const int k = half * 512 + kk;
                      float w = 0.f; if (c < 36 && kk < 512) w = ffn_norm[k] * (c < 4 ? w_rg[k * 4 + c] : w_re[k * 32 + (c - 4)]);
                      const unsigned h16 = cvt_pk_bf16(w, 0.f) & 0xffffu; const unsigned l16 = cvt_pk_bf16(w - __uint_as_float(h16 << 16), 0.f) & 0xffffu;
                      P_WR_L(lw)[(size_t)(half * 2 + 0) * 48 * 520 + r] = (bf16)h16; P_WR_L(lw)[(size_t)(half * 2 + 1) * 48 * 520 + r] = (bf16)l16; } }
            }
            const GAS float* fin = (const GAS float*)ARGIN(20);
            for (int mb = vcu * 128 + wave * 16; mb < vcu * 128 + wave * 16 + 16; mb += 4) {
                f32x4 v[4][4]; int s0[4], s1[4];
                if (l > 0) {
#pragma unroll
                    for (int r = 0; r < 4; ++r) { s0[r] = P_SLOT[2 * (mb + r)]; s1[r] = P_SLOT[2 * (mb + r) + 1]; }
                }
#pragma unroll
                for (int r = 0; r < 4; ++r) {
                    if (l == 0) { const GAS float* xr = x_in + (size_t)(mb + r) * DM;
#pragma unroll
                        for (int j = 0; j < 4; ++j) v[r][j] = __builtin_nontemporal_load((const GAS f32x4*)(xr + 4 * lane + 256 * j)); }
                    else { const GAS bf16* xr = P_XR + (size_t)(mb + r) * DM;
#pragma unroll
                        for (int j = 0; j < 4; ++j) { const u32x2 w = __builtin_nontemporal_load((const GAS u32x2*)(xr + 4 * lane + 256 * j)); v[r][j] = (f32x4){__uint_as_float(w.x << 16), __uint_as_float(w.x & 0xffff0000u), __uint_as_float(w.y << 16), __uint_as_float(w.y & 0xffff0000u)}; } } }
                if (l > 0) {
#pragma unroll
                    for (int r = 0; r < 4; ++r)
#pragma unroll
                        for (int j = 0; j < 4; ++j) { const int a = __builtin_nontemporal_load((const GAS int*)((const GAS unsigned char*)P_Y + (size_t)s0[r] * 1024 + 4 * lane + 256 * j)), c = __builtin_nontemporal_load((const GAS int*)((const GAS unsigned char*)P_Y + (size_t)s1[r] * 1024 + 4 * lane + 256 * j));
                            const f32x2 a0 = __builtin_amdgcn_cvt_pk_f32_fp8(a, false), a1 = __builtin_amdgcn_cvt_pk_f32_fp8(a, true), c0 = __builtin_amdgcn_cvt_pk_f32_fp8(c, false), c1 = __builtin_amdgcn_cvt_pk_f32_fp8(c, true);
                            v[r][j][0] += (a0[0] + c0[0]) * WSCALE_INV; v[r][j][1] += (a0[1] + c0[1]) * WSCALE_INV; v[r][j][2] += (a1[0] + c1[0]) * WSCALE_INV; v[r][j][3] += (a1[1] + c1[1]) * WSCALE_INV; }
                }
                float ss[4];
#pragma unroll
                for (int r = 0; r < 4; ++r) { float s = 0.f;
#pragma unroll
                    for (int j = 0; j < 4; ++j) s += (v[r][j][0] * v[r][j][0] + v[r][j][1] * v[r][j][1]) + (v[r][j][2] * v[r][j][2] + v[r][j][3] * v[r][j][3]);
                    ss[r] = s; }
#pragma unroll
                for (int o = 1; o < 64; o <<= 1) {
#pragma unroll
                    for (int r = 0; r < 4; ++r) ss[r] += __shfl_xor(ss[r], o); }
#pragma unroll
                for (int r = 0; r < 4; ++r) { const int m = mb + r; const float rstd = rsqrtf(ss[r] * (1.f / DM) + EPS);
                    if (l < NLAYER) {
#pragma unroll
                        for (int j = 0; j < 4; ++j) { u32x2 w; w.x = cvt_pk_bf16(v[r][j][0], v[r][j][1]); w.y = cvt_pk_bf16(v[r][j][2], v[r][j][3]); *(GAS u32x2*)(P_XR + (size_t)m * DM + 4 * lane + 256 * j) = w; }
                        if (lane == 0) P_RSTDX[m] = rstd;
                    } else {
#pragma unroll
                        for (int j = 0; j < 4; ++j) { const f32x4 g = *(const GAS f32x4*)(fin + 4 * lane + 256 * j); __builtin_nontemporal_store(v[r][j] * rstd * g, (GAS f32x4*)(out + (size_t)m * DM + 4 * lane + 256 * j)); }
                    }
                }
            }
        }
        if constexpr (l == NLAYER) return;
        SEAM(P);
        if (IN(P + 1)) for (int rep_ = 0; rep_ < ((l == 0 || 1 != 5) ? NREP(1) : 1); ++rep_) {
            unsigned ldsb_ = (unsigned)(uintptr_t)lds0; asm volatile("" : "+s"(ldsb_)); LAS unsigned char* lds = (LAS unsigned char*)(uintptr_t)ldsb_; volatile LAS unsigned* MISC = (volatile LAS unsigned*)(lds + MISC_OFF); volatile LAS unsigned long long* ARGP = (volatile LAS unsigned long long*)(lds + MISC_OFF + 768); (void)MISC; int wave = wave0, G = G0, bx = bx0; asm volatile("" : "+s"(G), "+s"(bx), "+s"(wave)); const int lane = (int)__builtin_amdgcn_mbcnt_hi(~0u, __builtin_amdgcn_mbcnt_lo(~0u, 0u)); const int tid = wave * 64 + lane; const int vcu = (bx % 8) * (G / 8) + bx / 8; const int gw = vcu * 8 + wave, NGW = G * 8; (void)lane; (void)gw; (void)NGW; (void)vcu;
            GAS unsigned char* ws = (GAS unsigned char*)LDP(22); GAS float* out = (GAS float*)LDP(21); const GAS float* x_in = (const GAS float*)ARGIN(0); (void)out; (void)x_in; (void)ws;
            BatchOrder S{INP / 256, vcu, (const GAS char*)P_XR, (const GAS char*)P_WIN_L(l), (size_t)256 * DM * 2, (size_t)256 * DM * 2};
            EpiWin E{P_LAT, P_FQKV, P_KPE, P_FLOG, P_SSQ, P_COS, P_SIN, P_RSTDX};
            pg8::gemm_phase<EpiWin, BatchOrder, true, false>(tid, lds, DM * 2, DM * 2, DM * 2, S, E, nullptr);
        }
        SEAMG(P + 1);
        if (IN(P + 2)) for (int rep_ = 0; rep_ < ((l == 0 || 2 != 5) ? NREP(2) : 1); ++rep_) {
            unsigned ldsb_ = (unsigned)(uintptr_t)lds0; asm volatile("" : "+s"(ldsb_)); LAS unsigned char* lds = (LAS unsigned char*)(uintptr_t)ldsb_; volatile LAS unsigned* MISC = (volatile LAS unsigned*)(lds + MISC_OFF); volatile LAS unsigned long long* ARGP = (volatile LAS unsigned long long*)(lds + MISC_OFF + 768); (void)MISC; int wave = wave0, G = G0, bx = bx0; asm volatile("" : "+s"(G), "+s"(bx), "+s"(wave)); const int lane = (int)__builtin_amdgcn_mbcnt_hi(~0u, __builtin_amdgcn_mbcnt_lo(~0u, 0u)); const int tid = wave * 64 + lane; const int vcu = (bx % 8) * (G / 8) + bx / 8; const int gw = vcu * 8 + wave, NGW = G * 8; (void)lane; (void)gw; (void)NGW; (void)vcu;
            GAS unsigned char* ws = (GAS unsigned char*)LDP(22); GAS float* out = (GAS float*)LDP(21); const GAS float* x_in = (const GAS float*)ARGIN(0); (void)out; (void)x_in; (void)ws;
            {
                const int sq = vcu >> 1, hf = vcu & 1; const int b = sq >> 3, h = sq & 7; const float bf = ((const GAS float*)ARGIN(4))[l * 8 + h];
                const GAS float* fl = P_FLOG + ((size_t)b * SEQ + hf * 1024 + 2 * tid) * 8 + h;
                float lf[2], lg[2] = {0.f, 0.f};
#pragma unroll
                for (int e = 0; e < 2; ++e) { const float f = fl[e * 8] + bf; lf[e] = fminf(f, 0.f) - log1pf(expf(-fabsf(f))); }
                if (hf) {
#pragma unroll
                    for (int e = 0; e < 2; ++e) { const float f = fl[e * 8 - 1024 * 8] + bf; lg[e] = fminf(f, 0.f) - log1pf(expf(-fabsf(f))); } }
                const double s2 = (double)lf[0] + (double)lf[1];
                double incl = s2, first = (double)lg[0] + (double)lg[1];
#pragma unroll
                for (int o = 1; o < 64; o <<= 1) { const double t = __shfl_up(incl, o); if (lane >= o) incl += t; first += __shfl_xor(first, o); }
                LAS double* wtot = (LAS double*)lds;
                if (lane == 63) wtot[wave] = incl;
                if (lane == 0) wtot[8 + wave] = first;
                __syncthreads();
                double c = incl - s2;
                for (int w = 0; w < wave; ++w) c += wtot[w];
                if (hf) { for (int w = 0; w < 8; ++w) c += wtot[8 + w]; }
                const size_t t0 = ((size_t)b * 8 + h) * SEQ + hf * 1024 + 2 * tid;
                GAS u32x4* ka = (GAS u32x4*)(P_KAUG + t0 * 8);
                float xs[2];
#pragma unroll
                for (int e = 0; e < 2; ++e) { c += (double)lf[e]; const float x = (float)(-c * 1.4426950408889634); xs[e] = x;
                    const unsigned h16 = cvt_pk_bf16(x, 0.f) & 0xffffu; const float r1 = x - __uint_as_float(h16 << 16); const unsigned m16 = cvt_pk_bf16(r1, 0.f) & 0xffffu; const float r2 = r1 - __uint_as_float(m16 << 16); const unsigned l16 = cvt_pk_bf16(r2, 0.f) & 0xffffu;
                    ka[e] = (u32x4){h16 | (m16 << 16), l16, 0u, 0u}; P_BIASF[t0 + e] = x; }
                float qn = 0.f, kn = 0.f, xdm = INFINITY;
                { const GAS bf16* fqp = P_FQKV + ((size_t)b * SEQ + hf * 1024 + 2 * tid) * 512 + h * 64; const GAS bf16* fkp = fqp + (size_t)NTOK * 512;
#pragma unroll
                  for (int e = 0; e < 2; ++e) { float sq_ = 0.f, sk = 0.f, dd = 0.f;
#pragma unroll
                      for (int c8 = 0; c8 < 8; ++c8) { const u32x4 a = *(const GAS u32x4*)(fqp + e * 512 + c8 * 8), k4 = *(const GAS u32x4*)(fkp + e * 512 + c8 * 8);
#pragma unroll
                          for (int j = 0; j < 4; ++j) { const float a0 = __uint_as_float(a[j] << 16), a1 = __uint_as_float(a[j] & 0xffff0000u), k0 = __uint_as_float(k4[j] << 16), k1 = __uint_as_float(k4[j] & 0xffff0000u);
                              sq_ += a0 * a0 + a1 * a1; sk += k0 * k0 + k1 * k1; dd += a0 * k0 + a1 * k1; } }
                      qn = fmaxf(qn, sq_); kn = fmaxf(kn, sk); xdm = fminf(xdm, xs[e] + dd); } }
#pragma unroll
                for (int o = 1; o < 64; o <<= 1) { qn = fmaxf(qn, __shfl_xor(qn, o)); kn = fmaxf(kn, __shfl_xor(kn, o)); xdm = fminf(xdm, __shfl_xor(xdm, o)); }
                LAS float* knw = (LAS float*)(lds + 256);
                if (lane == 0) { knw[wave] = kn; knw[8 + wave] = qn; knw[16 + wave] = xdm; }
                __syncthreads();
                if (tid < 4) { P_NRM[sq * 32 + hf * 4 + tid] = sqrtf(fmaxf(knw[8 + 2 * tid], knw[8 + 2 * tid + 1])); P_NRM[sq * 32 + 16 + hf * 4 + tid] = fminf(knw[16 + 2 * tid], knw[16 + 2 * tid + 1]); }
                if (tid == 4) { float m = knw[0]; for (int w = 1; w < 8; ++w) m = fmaxf(m, knw[w]); P_NRM[sq * 32 + 8 + hf] = sqrtf(m); }
                __syncthreads();
            }
            UpOrder S{vcu, (const GAS char*)P_LAT, (const GAS char*)P_WUQ_L(l), (const GAS char*)P_WUKV_L(l)};
            EpiUp E{P_QM, P_KVM, P_SSQ, P_COS, P_SIN};
            pg8::gemm_phase<EpiUp, UpOrder, true, false, false, false, true>(tid, lds, 256 * 2, 512 * 2, 256 * 2, S, E, nullptr);
        }
        SEAMG(P + 2);
        if (IN(P + 3)) for (int rep_ = 0; rep_ < ((l == 0 || 3 != 5) ? NREP(3) : 1); ++rep_) {
            unsigned ldsb_ = (unsigned)(uintptr_t)lds0; asm volatile("" : "+s"(ldsb_)); LAS unsigned char* lds = (LAS unsigned char*)(uintptr_t)ldsb_; volatile LAS unsigned* MISC = (volatile LAS unsigned*)(lds + MISC_OFF); volatile LAS unsigned long long* ARGP = (volatile LAS unsigned long long*)(lds + MISC_OFF + 768); (void)MISC; int wave = wave0, G = G0, bx = bx0; asm volatile("" : "+s"(G), "+s"(bx), "+s"(wave)); const int lane = (int)__builtin_amdgcn_mbcnt_hi(~0u, __builtin_amdgcn_mbcnt_lo(~0u, 0u)); const int tid = wave * 64 + lane; const int vcu = (bx % 8) * (G / 8) + bx / 8; const int gw = vcu * 8 + wave, NGW = G * 8; (void)lane; (void)gw; (void)NGW; (void)vcu;
            GAS unsigned char* ws = (GAS unsigned char*)LDP(22); GAS float* out = (GAS float*)LDP(21); const GAS float* x_in = (const GAS float*)ARGIN(0); (void)out; (void)x_in; (void)ws;
            GAS bf16* O = P_XN;
            const int b = vcu >> 4, hh = (vcu & 15) >> 1, sub = vcu & 1;
            const att::Tens2 TM{P_QM, 768, P_KVM, 1024, P_KPE, P_KVM + 64, 1024, O, nullptr, nullptr, P_OSS};
            const att::Tens2 TF{P_FQKV, 512, P_FQKV + (size_t)NTOK * 512, 512, P_KAUG, P_FQKV + (size_t)2 * NTOK * 512, 512, O, P_BIASF, P_NRM, P_OSS};
#define QB_OF(i) ((((i) & 1) ? 7 - (2 * sub + ((i) >> 1)) : (2 * sub + ((i) >> 1))))
            int ts0, ts1, ts2, ts3;
            { const GAS float* bs = P_BIASF + ((long)b * 8 + hh) * SEQ; const GAS float* nr = P_NRM + (b * 8 + hh) * 32; const float kmx = fmaxf(nr[8], nr[9]);
#define FOX_TS(i, dst) do { const int qb_ = QB_OF(i), NT_ = 4 * qb_ + 4; const float Z_ = nr[qb_] * kmx * 1.001f + 0.01f; const float bend_ = bs[(lane < NT_ ? lane : NT_ - 1) * 64 + 63]; \
                  const bool skip_ = (lane < NT_ - 4) && (Z_ + bend_ - nr[16 + qb_] < -32.f); dst = __builtin_popcountll(__ballot(skip_)); } while (0)
              FOX_TS(0, ts0); FOX_TS(1, ts1); FOX_TS(2, ts2); FOX_TS(3, ts3);
#undef FOX_TS
            }
            if (wave >= 4) __builtin_amdgcn_s_setprio(1);
            bf16x8 qreg[6];
            { int sb = 0; for (int i = 0; i < 4; ++i) sb = att::attn_unit2<1>(wave, b, hh, QB_OF(i), TM, (LAS char*)lds, sb, i > 0, i < 3 ? QB_OF(i + 1) : -1, qreg, 0); }
            { int sb = 0; for (int i = 0; i < 4; ++i) { const int ts = i == 0 ? ts0 : i == 1 ? ts1 : i == 2 ? ts2 : ts3; sb = att::attn_unit2<0>(wave, b, hh, QB_OF(i), TF, (LAS char*)lds, sb, i > 0, i < 3 ? QB_OF(i + 1) : -1, qreg, ts); } }
#undef QB_OF
            __builtin_amdgcn_s_setprio(0);
        }
        SEAMG(P + 3);
        if (IN(P + 5)) for (int rep_ = 0; rep_ < ((l == 0 || 5 != 5) ? NREP(5) : 1); ++rep_) {
            unsigned ldsb_ = (unsigned)(uintptr_t)lds0; asm volatile("" : "+s"(ldsb_)); LAS unsigned char* lds = (LAS unsigned char*)(uintptr_t)ldsb_; volatile LAS unsigned* MISC = (volatile LAS unsigned*)(lds + MISC_OFF); volatile LAS unsigned long long* ARGP = (volatile LAS unsigned long long*)(lds + MISC_OFF + 768); (void)MISC; int wave = wave0, G = G0, bx = bx0; asm volatile("" : "+s"(G), "+s"(bx), "+s"(wave)); const int lane = (int)__builtin_amdgcn_mbcnt_hi(~0u, __builtin_amdgcn_mbcnt_lo(~0u, 0u)); const int tid = wave * 64 + lane; const int vcu = (bx % 8) * (G / 8) + bx / 8; const int gw = vcu * 8 + wave, NGW = G * 8; (void)lane; (void)gw; (void)NGW; (void)vcu;
            GAS unsigned char* ws = (GAS unsigned char*)LDP(22); GAS float* out = (GAS float*)LDP(21); const GAS float* x_in = (const GAS float*)ARGIN(0); (void)out; (void)x_in; (void)ws;
            BatchOrder S{DM / 256, vcu, (const GAS char*)P_XN, (const GAS char*)P_WOUT_L(l), (size_t)256 * DM * 2, (size_t)256 * DM * 2};
            EpiOut<false> E{x_in, P_XR};
            LAS f32x2* scl = (LAS f32x2*)(lds + pg8::STAGE_BYTES);
            { Unit u_; if (S.next(tid >> 8, u_)) { const GAS float* op = P_OSS + ((size_t)u_.pm * 256 + (tid & 255)) * 16;
                  const f32x4 a0 = *(const GAS f32x4*)op, a1 = *(const GAS f32x4*)(op + 4), c0 = *(const GAS f32x4*)(op + 8), c1 = *(const GAS f32x4*)(op + 12);
                  const float sm = ((a0[0] + a0[1]) + (a0[2] + a0[3])) + ((a1[0] + a1[1]) + (a1[2] + a1[3])), sf = ((c0[0] + c0[1]) + (c0[2] + c0[3])) + ((c1[0] + c1[1]) + (c1[2] + c1[3]));
                  const float rm_ = rsqrtf(sm * (1.f / 512.f) + EPS), rf_ = rsqrtf(sf * (1.f / 512.f) + EPS);
                  scl[tid] = (f32x2){rm_ / rf_, rf_}; } }
            __syncthreads();
            pg8::gemm_phase<EpiOut<false>, BatchOrder, true, false, false, true>(tid, lds, DM * 2, DM * 2, DM * 2, S, E, nullptr, scl);
        }
        SEAMG(P + 5);
        if (IN(P + 6)) for (int rep_ = 0; rep_ < ((l == 0 || 6 != 5) ? NREP(6) : 1); ++rep_) {
            unsigned ldsb_ = (unsigned)(uintptr_t)lds0; asm volatile("" : "+s"(ldsb_)); LAS unsigned char* lds = (LAS unsigned char*)(uintptr_t)ldsb_; volatile LAS unsigned* MISC = (volatile LAS unsigned*)(lds + MISC_OFF); volatile LAS unsigned long long* ARGP = (volatile LAS unsigned long long*)(lds + MISC_OFF + 768); (void)MISC; int wave = wave0, G = G0, bx = bx0; asm volatile("" : "+s"(G), "+s"(bx), "+s"(wave)); const int lane = (int)__builtin_amdgcn_mbcnt_hi(~0u, __builtin_amdgcn_mbcnt_lo(~0u, 0u)); const int tid = wave * 64 + lane; const int vcu = (bx % 8) * (G / 8) + bx / 8; const int gw = vcu * 8 + wave, NGW = G * 8; (void)lane; (void)gw; (void)NGW; (void)vcu;
            GAS unsigned char* ws = (GAS unsigned char*)LDP(22); GAS float* out = (GAS float*)LDP(21); const GAS float* x_in = (const GAS float*)ARGIN(0); (void)out; (void)x_in; (void)ws;
            GAS bf16* H2 = P_XN;
            LAS bf16* WT = (LAS bf16*)lds;
            LAS float* LG = (LAS float*)(lds + 99840) + wave * 576;
            const GAS float* b_rg = (const GAS float*)ARGIN(14) + l * 4; const GAS float* b_re = (const GAS float*)ARGIN(16) + l * 32;
            if (tid < 32) MISC[64 + tid] = 0u;
            const int r16 = lane & 15, g4 = lane >> 4;
            const int m0 = vcu * 128 + wave * 16;
            const GAS bf16* xrow = P_XR + (size_t)(m0 + r16) * DM + 8 * g4;
            GAS unsigned char* hrow = (GAS unsigned char*)H2 + (size_t)(m0 + r16) * DM + 8 * g4;
            f32x4 acc3[3]; acc3[0] = (f32x4){0.f, 0.f, 0.f, 0.f}; acc3[1] = acc3[0]; acc3[2] = acc3[0];
            float ssq = 0.f;
            for (int half = 0; half < 2; ++half) {
                __syncthreads();
                for (int idx = tid; idx < 2 * 48 * 520 / 8; idx += 512) *(LAS u32x4*)(WT + 8 * idx) = *(const GAS u32x4*)(P_WR_L(l) + (size_t)half * 2 * 48 * 520 + 8 * idx);
                __syncthreads();
                for (int s8 = 0; s8 < 16; s8 += 8) {
                    bf16x8 xv[8];
#pragma unroll
                    for (int u = 0; u < 8; ++u) xv[u] = *(const GAS bf16x8*)(xrow + half * 512 + 32 * (s8 + u));
#pragma unroll
                    for (int u = 0; u < 8; ++u) {
                        const u32x4 xw = __builtin_bit_cast(u32x4, xv[u]); float xf[8];
#pragma unroll
                        for (int j = 0; j < 4; ++j) { xf[2 * j] = __uint_as_float(xw[j] << 16); xf[2 * j + 1] = __uint_as_float(xw[j] & 0xffff0000u); }
                        u32x2 hw; hw.x = pk4_fp8(xf[0], xf[1], xf[2], xf[3]); hw.y = pk4_fp8(xf[4], xf[5], xf[6], xf[7]); *(GAS u32x2*)(hrow + half * 512 + 32 * (s8 + u)) = hw;
#pragma unroll
                        for (int j = 0; j < 8; ++j) ssq += xf[j] * xf[j];
                        const LAS bf16* wk = WT + r16 * 520 + 32 * (s8 + u) + 8 * g4;
#pragma unroll
                        for (int ct = 0; ct < 3; ++ct) { const bf16x8 bh = *(const LAS bf16x8*)(wk + ct * 16 * 520), bl = *(const LAS bf16x8*)(wk + (48 + ct * 16) * 520);
                            acc3[ct] = __builtin_amdgcn_mfma_f32_16x16x32_bf16(xv[u], bh, acc3[ct], 0, 0, 0); acc3[ct] = __builtin_amdgcn_mfma_f32_16x16x32_bf16(xv[u], bl, acc3[ct], 0, 0, 0); }
                    }
                }
            }
            ssq += __shfl_xor(ssq, 16); ssq += __shfl_xor(ssq, 32);
            const float rstd = rsqrtf(ssq * (1.f / DM) + EPS);
#pragma unroll
            for (int ct = 0; ct < 3; ++ct) { const int c = 16 * ct + r16; if (c < 36) {
#pragma unroll
                for (int rg = 0; rg < 4; ++rg) LG[(4 * g4 + rg) * 36 + c] = acc3[ct][rg]; } }
            LDS_WAIT();
            if (lane < 16) {
                const int m = m0 + lane; const LAS float* lg = LG + lane * 36;
                float gl[4];
#pragma unroll
                for (int g = 0; g < 4; ++g) gl[g] = lg[g] * rstd + b_rg[g];
                int gi = 0; float gm = gl[0];
#pragma unroll
                for (int g = 1; g < 4; ++g) if (gl[g] > gm) { gm = gl[g]; gi = g; }
                float gs = 0.f;
#pragma unroll
                for (int g = 0; g < 4; ++g) gs += __expf(gl[g] - gm);
                const float gval = 1.f / gs;
                float el[8];
#pragma unroll
                for (int j = 0; j < 8; ++j) el[j] = lg[4 + 8 * gi + j] * rstd + b_re[8 * gi + j];
                int i0 = 0; float mx0 = el[0];
#pragma unroll
                for (int j = 1; j < 8; ++j) if (el[j] > mx0) { mx0 = el[j]; i0 = j; }
                int i1 = -1; float mx1 = -INFINITY;
#pragma unroll
                for (int j = 0; j < 8; ++j) if (j != i0 && el[j] > mx1) { mx1 = el[j]; i1 = j; }
                const float e1 = __expf(mx1 - mx0); const float g0 = gval / (1.f + e1), g1 = gval * e1 / (1.f + e1);
                const int ea = gi * 8 + i0, eb = gi * 8 + i1; P_E01[2 * m] = ea; P_E01[2 * m + 1] = eb; P_G01[2 * m] = g0; P_G01[2 * m + 1] = g1; P_RSTD[m] = rstd;
                __hip_atomic_fetch_add((LAS unsigned*)(lds + MISC_OFF) + 64 + ea, 1u, __ATOMIC_RELAXED, __HIP_MEMORY_SCOPE_WORKGROUP); __hip_atomic_fetch_add((LAS unsigned*)(lds + MISC_OFF) + 64 + eb, 1u, __ATOMIC_RELAXED, __HIP_MEMORY_SCOPE_WORKGROUP);
            }
            __syncthreads();
            if (tid < 32) P_CNT[vcu * 32 + tid] = (int)MISC[64 + tid];
        }
        SEAM(P + 6);
        if (IN(P + 7)) for (int rep_ = 0; rep_ < ((l == 0 || 7 != 5) ? NREP(7) : 1); ++rep_) {
            unsigned ldsb_ = (unsigned)(uintptr_t)lds0; asm volatile("" : "+s"(ldsb_)); LAS unsigned char* lds = (LAS unsigned char*)(uintptr_t)ldsb_; volatile LAS unsigned* MISC = (volatile LAS unsigned*)(lds + MISC_OFF); volatile LAS unsigned long long* ARGP = (volatile LAS unsigned long long*)(lds + MISC_OFF + 768); (void)MISC; int wave = wave0, G = G0, bx = bx0; asm volatile("" : "+s"(G), "+s"(bx), "+s"(wave)); const int lane = (int)__builtin_amdgcn_mbcnt_hi(~0u, __builtin_amdgcn_mbcnt_lo(~0u, 0u)); const int tid = wave * 64 + lane; const int vcu = (bx % 8) * (G / 8) + bx / 8; const int gw = vcu * 8 + wave, NGW = G * 8; (void)lane; (void)gw; (void)NGW; (void)vcu;
            GAS unsigned char* ws = (GAS unsigned char*)LDP(22); GAS float* out = (GAS float*)LDP(21); const GAS float* x_in = (const GAS float*)ARGIN(0); (void)out; (void)x_in; (void)ws;
            LAS int* cnt_all = (LAS int*)lds;
            LAS int* pre_e = (LAS int*)(lds + 32768);
            LAS int* tot_e = pre_e + 32;
            LAS int* pst = pre_e + 64;
            LAS int* eL = pre_e + 128;
            for (int i = tid; i < 256 * 32; i += 512) cnt_all[i] = P_CNT[i];
            if (tid < 256) eL[tid] = P_E01[vcu * 256 + tid];
            __syncthreads();
            { LAS int* part = pre_e + 512;
              const int e = tid & 31, p = tid >> 5; int pre = 0, tot = 0;
#pragma unroll
              for (int j = 0; j < 16; ++j) { const int w = p * 16 + j; const int c = cnt_all[w * 32 + e]; pre += (w < vcu) ? c : 0; tot += c; }
              part[(p * 2) * 32 + e] = pre; part[(p * 2 + 1) * 32 + e] = tot; }
            __syncthreads();
            if (tid < 32) { LAS int* part = pre_e + 512; int pre = 0, tot = 0;
#pragma unroll
                for (int p = 0; p < 16; ++p) { pre += part[(p * 2) * 32 + tid]; tot += part[(p * 2 + 1) * 32 + tid]; } pre_e[tid] = pre; tot_e[tid] = tot; }
            __syncthreads();
            if (tid == 0) { int acc = 0; for (int e = 0; e < 32; ++e) { pst[e] = acc; acc += (tot_e[e] + 255) / 256 * 256; } pst[32] = acc; }
            __syncthreads();
            if (vcu == 0 && tid <= 32) P_TSTART[tid] = pst[tid] / 256;
            { LAS int* hist = pre_e + 2048;
              if (tid < 128) hist[tid] = 0;
              __syncthreads();
              int e = 0, rin = 0;
              if (tid < 256) { e = eL[tid]; unsigned long long mym = 0ull;
                  for (int x = 0; x < 32; ++x) { const unsigned long long bm = __ballot(e == x); if (e == x) mym = bm; }
                  rin = __builtin_popcountll(mym & ((1ull << lane) - 1ull));
                  if (rin == 0) hist[wave * 32 + e] = __builtin_popcountll(mym); }
              __syncthreads();
              if (tid < 256) { int r = rin; for (int w = 0; w < wave; ++w) r += hist[w * 32 + e];
                  const int slot = pst[e] + pre_e[e] + r; const int tok = vcu * 128 + (tid >> 1);
                  P_SLOT[vcu * 256 + tid] = slot; P_TOKOF[slot] = tok; P_GATEOF[slot] = P_G01[vcu * 256 + tid]; P_RSTDOF[slot] = P_RSTD[tok]; } }
            if (vcu < 32) { const int e = vcu; for (int s = pst[e] + tot_e[e] + tid; s < pst[e + 1]; s += 512) { P_TOKOF[s] = 0; P_GATEOF[s] = 0.f; P_RSTDOF[s] = 0.f; } }
            __syncthreads();
        }
        SEAM(P + 7);
        if (IN(P + 8)) for (int rep_ = 0; rep_ < ((l == 0 || 8 != 5) ? NREP(8) : 1); ++rep_) {
            unsigned ldsb_ = (unsigned)(uintptr_t)lds0; asm volatile("" : "+s"(ldsb_)); LAS unsigned char* lds = (LAS unsigned char*)(uintptr_t)ldsb_; volatile LAS unsigned* MISC = (volatile LAS unsigned*)(lds + MISC_OFF); volatile LAS unsigned long long* ARGP = (volatile LAS unsigned long long*)(lds + MISC_OFF + 768); (void)MISC; int wave = wave0, G = G0, bx = bx0; asm volatile("" : "+s"(G), "+s"(bx), "+s"(wave)); const int lane = (int)__builtin_amdgcn_mbcnt_hi(~0u, __builtin_amdgcn_mbcnt_lo(~0u, 0u)); const int tid = wave * 64 + lane; const int vcu = (bx % 8) * (G / 8) + bx / 8; const int gw = vcu * 8 + wave, NGW = G * 8; (void)lane; (void)gw; (void)NGW; (void)vcu;
            GAS unsigned char* ws = (GAS unsigned char*)LDP(22); GAS float* out = (GAS float*)LDP(21); const GAS float* x_in = (const GAS float*)ARGIN(0); (void)out; (void)x_in; (void)ws;
            volatile LAS int* TS = (volatile LAS int*)(MISC + 128);
            if (tid <= 32) TS[tid] = P_TSTART[tid];
            __syncthreads();
            MoeOrder S{G, vcu, TS, (const GAS char*)P_XN, (const GAS char*)P_WGU_L(l), 0, (size_t)1024 * 1024, (size_t)256 * 1024};
            EpiGU E{(GAS unsigned char*)P_HH, P_RSTDOF};
            pg8::gemm_phase<EpiGU, MoeOrder, true, true, true>(tid, lds, DM, DM, DM, S, E, P_TOKOF);
            if constexpr (l + 1 < NLAYER) {
                const int U = (int)TS[32] * 4, rem = U & 255; const int nidle = rem ? 256 - rem : 256, rk = rem ? vcu - rem : vcu;
                if (rk >= 0) { LAS float* scr64 = (LAS float*)(lds + wave * 16640);
                    const GAS float* w_gate = (const GAS float*)ARGIN(17) + (size_t)(l + 1) * NEXP * DM * DEXP; const GAS float* w_up = (const GAS float*)ARGIN(18) + (size_t)(l + 1) * NEXP * DM * DEXP; const GAS float* ffn1 = (const GAS float*)ARGIN(12) + (size_t)(l + 1) * DM;
                    for (int it = rk * 8 + wave; it < 16 * 16 * NEXP; it += nidle * 8) conv_gu_item(it, w_gate, w_up, ffn1, P_WGU_L(l + 1), scr64, lane); }
            }
        }
        SEAM(P + 8);
        if (IN(P + 9)) for (int rep_ = 0; rep_ < ((l == 0 || 9 != 5) ? NREP(9) : 1); ++rep_) {
            unsigned ldsb_ = (unsigned)(uintptr_t)lds0; asm volatile("" : "+s"(ldsb_)); LAS unsigned char* lds = (LAS unsigned char*)(uintptr_t)ldsb_; volatile LAS unsigned* MISC = (volatile LAS unsigned*)(lds + MISC_OFF); volatile LAS unsigned long long* ARGP = (volatile LAS unsigned long long*)(lds + MISC_OFF + 768); (void)MISC; int wave = wave0, G = G0, bx = bx0; asm volatile("" : "+s"(G), "+s"(bx), "+s"(wave)); const int lane = (int)__builtin_amdgcn_mbcnt_hi(~0u, __builtin_amdgcn_mbcnt_lo(~0u, 0u)); const int tid = wave * 64 + lane; const int vcu = (bx % 8) * (G / 8) + bx / 8; const int gw = vcu * 8 + wave, NGW = G * 8; (void)lane; (void)gw; (void)NGW; (void)vcu;
            GAS unsigned char* ws = (GAS unsigned char*)LDP(22); GAS float* out = (GAS float*)LDP(21); const GAS float* x_in = (const GAS float*)ARGIN(0); (void)out; (void)x_in; (void)ws;
            volatile LAS int* TS = (volatile LAS int*)(MISC + 128);
            if (tid <= 32) TS[tid] = P_TSTART[tid];
            __syncthreads();
            MoeOrder S{G, vcu, TS, (const GAS char*)P_HH, (const GAS char*)P_WD_L(l), (size_t)256 * 512, (size_t)1024 * 512, (size_t)256 * 512};
            EpiDown E{(GAS unsigned char*)P_Y, P_GATEOF};
            pg8::gemm_phase<EpiDown, MoeOrder, true, false, true>(tid, lds, DEXP, DEXP, DEXP, S, E, nullptr);
            if constexpr (l + 1 < NLAYER) {
                const int U = (int)TS[32] * 4, rem = U & 255; const int nidle = rem ? 256 - rem : 256, rk = rem ? vcu - rem : vcu;
                if (rk >= 0) { LAS float* scr64 = (LAS float*)(lds + wave * 16640);
                    const GAS float* w_down = (const GAS float*)ARGIN(19) + (size_t)(l + 1) * NEXP * DEXP * DM;
                    for (int it = rk * 8 + wave; it < 8 * 16 * NEXP; it += nidle * 8) conv_d_item(it, w_down, P_WD_L(l + 1), scr64, lane); }
            }
        }
        SEAM(P + 9);
}

__global__ void __launch_bounds__(512, 2) fwd(Args args) {
    extern __shared__ __attribute__((aligned(16))) unsigned char lds_raw[];
    LAS unsigned char* lds0 = (LAS unsigned char*)lds_raw;
    const int tid0 = threadIdx.x; const int wave0 = __builtin_amdgcn_readfirstlane(tid0 >> 6);
    const int G0 = gridDim.x; const int bx0 = blockIdx.x;
    { volatile LAS unsigned* MISC = (volatile LAS unsigned*)(lds0 + MISC_OFF); const int tid = tid0;
    for (int u = tid; u < 256; u += 512) MISC[u] = 0u;
    __syncthreads();
    volatile LAS unsigned long long* ARGP = (volatile LAS unsigned long long*)(lds0 + MISC_OFF + 768);
    if (tid < 21) ARGP[tid] = (unsigned long long)args.in[tid];
    if (tid == 21) ARGP[21] = (unsigned long long)args.out;
    if (tid == 22) ARGP[22] = (unsigned long long)args.ws;
    __syncthreads(); }
#if MK_ONE_LAUNCH
    XcdBarrier bar = xcd_barrier_post((unsigned*)(args.ws + WS_CTL) + CW_BAR, (volatile LAS unsigned*)(lds0 + MISC_OFF) + 8, gridDim.x);
    const int vcu0 = (bx0 % 8) * (G0 / 8) + bx0 / 8;
    XcdBarrier gbar = xcd_barrier_post((unsigned*)(args.ws + WS_CTL) + CW_BAR + (1 + (vcu0 >> 4)) * XCD_BAR_WORDS, (volatile LAS unsigned*)(lds0 + MISC_OFF) + 12, 16u);
#else
    XcdBarrier bar; bar.bar = nullptr; bar.x = 0; bar.st = nullptr; bar.n = 0;
    XcdBarrier gbar = bar;
#endif
    const int lo = args.ph_lo, hi_ = args.ph_hi;
    if (IN(0)) {
        const GAS int* positions = (const GAS int*)args.in[1]; GAS float* COSp = (GAS float*)(args.ws + WS_COS); GAS float* SINp = (GAS float*)(args.ws + WS_SIN);
        for (int i = bx0 * 512 + tid0; i < NTOK * 16; i += G0 * 512) { const int tk = i >> 4, fi = i & 15;
            const double invrev = exp2(-(double)fi * (13.287712379549449 / 16.0)) * 0.15915494309189535; const double rev = (double)positions[tk] * invrev; const float fr = (float)(rev - rint(rev));
            COSp[i] = __builtin_amdgcn_cosf(fr); SINp[i] = __builtin_amdgcn_sinf(fr); }
    }
    layer_body<0>(lo, hi_, lds0, wave0, G0, bx0, bar, gbar);
    layer_body<1>(lo, hi_, lds0, wave0, G0, bx0, bar, gbar);
    layer_body<2>(lo, hi_, lds0, wave0, G0, bx0, bar, gbar);
}

extern "C" void kernel_launch(void* const* d_in, const int* in_sizes, int n_in, void* d_out, int out_size, void* d_ws, size_t ws_size, hipStream_t stream) {
    static int grid = 0;
    if (grid == 0) {
        if (n_in != 21 || out_size != NTOK * DM || ws_size < WS_END) { fprintf(stderr, "kernel_launch: unexpected shapes (n_in %d out %d ws %zu)\n", n_in, out_size, ws_size); grid = -1; return; }
        int dev = 0, cus = 0;
        if (hipGetDevice(&dev) != hipSuccess || hipDeviceGetAttribute(&cus, hipDeviceAttributeMultiprocessorCount, dev) != hipSuccess) { grid = -1; return; }
        if (hipFuncSetAttribute((const void*)fwd, hipFuncAttributeMaxDynamicSharedMemorySize, LDS_BYTES) != hipSuccess) { fprintf(stderr, "kernel_launch: hipFuncSetAttribute failed\n"); grid = -1; return; }
        int per_cu = 0;
        if (hipOccupancyMaxActiveBlocksPerMultiprocessor(&per_cu, (const void*)fwd, 512, LDS_BYTES) != hipSuccess || per_cu < 1) fprintf(stderr, "kernel_launch: occupancy query says %d\n", per_cu);
        (void)hipGetLastError();
        grid = cus;
        if (grid != 256) { fprintf(stderr, "kernel_launch: built for 256 CUs, got %d\n", grid); grid = -1; return; }
    }
    if (grid < 0) return;
    if (hipMemsetAsync((char*)d_ws + WS_CTL, 0, CTL_ZERO_BYTES, stream) != hipSuccess) return;
    Args a{};
    for (int i = 0; i < 21; ++i) a.in[i] = d_in[i];
    a.out = (float*)d_out; a.ws = (unsigned char*)d_ws;
#if MK_ONE_LAUNCH
    a.ph_lo = 0; a.ph_hi = 21;
    hipLaunchKernelGGL(fwd, dim3(grid), dim3(512), LDS_BYTES, stream, a);
#else
    for (int p = 0; p <= 20; ++p) { a.ph_lo = p; a.ph_hi = p + 1; hipLaunchKernelGGL(fwd, dim3(grid), dim3(512), LDS_BYTES, stream, a); }
#endif
}
```

```cpp
#include <hip/hip_runtime.h>
#include <cstdio>
#include <cstdint>

#ifndef PROBE_PHASE
#define PROBE_PHASE -1
#endif
#ifndef PROBE_LAYER
#define PROBE_LAYER -1
#endif
#define NREP(k) (((PROBE_PHASE) == (k) && ((PROBE_LAYER) < 0 || (PROBE_LAYER) == l)) ? 2 : 1)
#ifndef MK_ONE_LAUNCH
#define MK_ONE_LAUNCH 1
#endif

#define LAS __attribute__((address_space(3)))
#define GAS __attribute__((address_space(1)))
typedef unsigned short bf16;
typedef short bf16x8 __attribute__((ext_vector_type(8)));
typedef short s16x4 __attribute__((ext_vector_type(4)));
typedef float f32x4 __attribute__((ext_vector_type(4)));
typedef float f32x2 __attribute__((ext_vector_type(2)));
typedef float f32x16 __attribute__((ext_vector_type(16)));
typedef unsigned u32x4 __attribute__((ext_vector_type(4)));
typedef unsigned u32x2 __attribute__((ext_vector_type(2)));

constexpr int NB = 16, SEQ = 2048, DM = 1024, NTOK = NB * SEQ, NLAYER = 2;
constexpr int INW = 1960, INP = 2048;
constexpr int NEXP = 32, DEXP = 512;
constexpr int MAXSLOT = 73728;
constexpr float EPS = 1e-6f;
constexpr float WSCALE = 64.f, WSCALE_INV = 1.f / 64.f;
constexpr float LOG2E = 1.4426950408889634f;
constexpr float C2F = 0.125f * LOG2E;
constexpr float C2M = 0.10206207261596575f * LOG2E;

constexpr size_t MiB = 1u << 20, KiB = 1u << 10;
constexpr size_t WS_CTL = 0, CTL_ZERO_BYTES = 256 * KiB;
constexpr size_t WS_COS = 1 * MiB, WS_SIN = 3 * MiB;
constexpr size_t WS_SSQ = 5 * MiB;
constexpr size_t WS_FLOG = 6 * MiB;
constexpr size_t WS_E01 = 8 * MiB;
constexpr size_t WS_G01 = 8 * MiB + 256 * KiB;
constexpr size_t WS_SLOT = 8 * MiB + 512 * KiB;
constexpr size_t WS_TOKOF = 8 * MiB + 768 * KiB;
constexpr size_t WS_GATEOF = 9 * MiB + 256 * KiB;
constexpr size_t WS_CNT = 9 * MiB + 768 * KiB;
constexpr size_t WS_TSTART = 9 * MiB + 800 * KiB;
constexpr size_t WS_RSTD = 9 * MiB + 832 * KiB;
constexpr size_t WS_RSTDOF = 7 * MiB;
constexpr size_t WS_KPE = 10 * MiB;
constexpr size_t WS_KAUG = 10 * MiB + 2 * MiB;
constexpr size_t WS_WIN = 16 * MiB;
constexpr size_t WS_WUQ = 20 * MiB;
constexpr size_t WS_WUKV = 20 * MiB + 512 * KiB;
constexpr size_t WS_WOUT = 21 * MiB;
constexpr size_t WS_WGU = 24 * MiB;
constexpr size_t WS_WD = 88 * MiB;
constexpr size_t WS_XN = 120 * MiB;
constexpr size_t WS_FQKV = 184 * MiB;
constexpr size_t WS_LAT = 280 * MiB;
constexpr size_t WS_QM = 312 * MiB;
constexpr size_t WS_KVM = 360 * MiB;
constexpr size_t WS_Y = 280 * MiB;
constexpr size_t WS_BIASF = 424 * MiB;
constexpr size_t WS_NRM = 425 * MiB;
constexpr size_t WS_WR = 426 * MiB;
constexpr size_t WS_XR = 427 * MiB;
constexpr size_t WS_OSS = 491 * MiB;
constexpr size_t WS_RSTDX = 493 * MiB;
constexpr size_t WS_W1 = 494 * MiB;
constexpr size_t WS_END = 502 * MiB;
static_assert(WS_Y + (size_t)MAXSLOT * 1024 * 2 <= WS_END, "Y fits");
static_assert(WS_FQKV + (size_t)MAXSLOT * 512 * 2 <= WS_LAT, "HH fits");

constexpr int CW_BAR = 1024;
static_assert((size_t)(CW_BAR + 17 * 3456) * 4 <= CTL_ZERO_BYTES, "barrier words inside the zeroed control block");

constexpr int RING_BYTES = 147456;
constexpr int MISC_OFF = RING_BYTES;
constexpr int LDS_BYTES = RING_BYTES + 1024;

typedef __bf16 bf16x2_t __attribute__((ext_vector_type(2)));
__device__ __forceinline__ unsigned cvt_pk_bf16(float lo, float hi) { const f32x2 v = {lo, hi}; const bf16x2_t b = __builtin_convertvector(v, bf16x2_t); return __builtin_bit_cast(unsigned, b); }
__device__ __forceinline__ float bf2f(unsigned short b) { return __uint_as_float((unsigned)b << 16); }
__device__ __forceinline__ float wave_sum(float v) {
#pragma unroll
    for (int o = 1; o < 64; o <<= 1) v += __shfl_xor(v, o);
    return v;
}
__device__ __forceinline__ unsigned pk4_fp8(float a, float b, float c, float d) { int w = 0; w = __builtin_amdgcn_cvt_pk_fp8_f32(a, b, w, false); w = __builtin_amdgcn_cvt_pk_fp8_f32(c, d, w, true); return (unsigned)w; }
#define LDS_WAIT() asm volatile("s_waitcnt lgkmcnt(0)" ::: "memory")

#define XB_TMO      128
#define XB_XCNT(j)  (256  + 64 * (j))
#define XB_XSUB(j)  (1280 + 64 * (j))
#define XB_XGEN(j)  (2304 + 64 * (j))
#define XB_TOP      3328
#define XB_TOPGEN   3392
#define XCD_BAR_WORDS 3456
#define XB_SPIN_CAP (1u << 18)
__device__ __forceinline__ unsigned xb_ld(unsigned* p)              { return __hip_atomic_load(p, __ATOMIC_RELAXED, __HIP_MEMORY_SCOPE_AGENT); }
__device__ __forceinline__ unsigned xb_add(unsigned* p, unsigned v) { return __hip_atomic_fetch_add(p, v, __ATOMIC_RELAXED, __HIP_MEMORY_SCOPE_AGENT); }
__device__ __forceinline__ unsigned xb_xcc_id() { return (unsigned)__builtin_amdgcn_s_getreg((3 << 11) | 20) & 0xFu; }
#define XB_SPIN(cond, bar) do { unsigned _sp = 0; while (cond) { __builtin_amdgcn_s_sleep(1); \
    if ((++_sp & 255u) == 0u) { if (xb_ld(&(bar)[XB_TMO])) break; if (_sp > XB_SPIN_CAP) { atomicAdd(&(bar)[XB_TMO], 1u); break; } } } } while (0)
struct XcdBarrier { unsigned* bar; unsigned x; volatile LAS unsigned* st; unsigned n; };
__device__ __forceinline__ XcdBarrier xcd_barrier_post(unsigned* bar, volatile LAS unsigned* st, unsigned n) {
    XcdBarrier b; b.bar = bar; b.x = xb_xcc_id(); b.st = st; b.n = n;
    if (threadIdx.x == 0) (void)xb_add(&bar[XB_XCNT(b.x)], 1u);
    return b;
}
__device__ __forceinline__ void xcd_barrier_complete(unsigned* bar, unsigned x, unsigned G, unsigned& nloc, unsigned& nx) {
    unsigned sum, cnt, mine, sp = 0u;
    for (;;) {
        sum = 0u; cnt = 0u; mine = 0u;
#pragma unroll
        for (unsigned j = 0; j < 16; ++j) { const unsigned c = xb_ld(&bar[XB_XCNT(j)]); sum += c; cnt += (c > 0u) ? 1u : 0u; mine = (j == x) ? c : mine; }
        if (sum == G) break;
        __builtin_amdgcn_s_sleep(1);
        if ((++sp & 255u) == 0u) { if (xb_ld(&bar[XB_TMO])) break; if (sp > XB_SPIN_CAP) { atomicAdd(&bar[XB_TMO], 1u); break; } }
    }
    nloc = mine > 0u ? mine : 1u; nx = cnt > 0u ? cnt : 1u;
}
__device__ __forceinline__ void xcd_barrier(const XcdBarrier& b) {
    asm volatile("s_waitcnt vmcnt(0)" ::: "memory");
    __syncthreads();
    if (threadIdx.x == 0) {
        unsigned* bar = b.bar;
        __builtin_amdgcn_s_waitcnt(0);
        unsigned nloc = b.st[0], nx = b.st[1];
        if (nloc == 0u) { xcd_barrier_complete(bar, b.x, b.n, nloc, nx); b.st[0] = nloc; b.st[1] = nx; }
        const unsigned old = xb_add(&bar[XB_XSUB(b.x)], 1u);
        const unsigned gen = old / nloc;
        if (old + 1u == (gen + 1u) * nloc) {
            __builtin_amdgcn_fence(__ATOMIC_RELEASE, "agent");
            asm volatile("s_waitcnt vmcnt(0)" ::: "memory");
            const unsigned og = xb_add(&bar[XB_TOP], 1u);
            const unsigned tg = og / nx;
            if (og + 1u == (tg + 1u) * nx) xb_add(&bar[XB_TOPGEN], 1u);
            else XB_SPIN(xb_ld(&bar[XB_TOPGEN]) == tg, bar);
            __builtin_amdgcn_fence(__ATOMIC_ACQUIRE, "agent");
            xb_add(&bar[XB_XGEN(b.x)], 1u);
            asm volatile("s_waitcnt vmcnt(0)" ::: "memory");
        } else {
            XB_SPIN(xb_ld(&bar[XB_XGEN(b.x)]) == gen, bar);
            __builtin_amdgcn_fence(__ATOMIC_ACQUIRE, "agent");
            asm volatile("s_waitcnt vmcnt(0)" ::: "memory");
        }
    }
    __syncthreads();
}

namespace pg8 {
constexpr int BM = 256, BK = 64, HALF = 128, HTB = HALF * BK * 2, STAGE_BYTES = 8 * HTB;
typedef int v4i32_t __attribute__((ext_vector_type(4)));
typedef int v8i32_t __attribute__((ext_vector_type(8)));
__host__ __device__ __forceinline__ int lds_byte(int r, int c) { const int st = (r >> 4) * 2 + (c >> 5), rr = r & 15, cc = c & 31, ob = rr * 64 + cc * 2; return st * 1024 + (ob ^ (((ob >> 9) & 1) << 5)); }
__host__ __device__ __forceinline__ void stage_rc(int b, int& R, int& C) { const int st = b / 1024, sb = b % 1024, swz = sb ^ (((sb >> 9) & 1) << 5); R = (st >> 1) * 16 + swz / 64; C = (st & 1) * 32 + (swz % 64) / 2; }
__host__ __device__ __forceinline__ int perm32(int rho) { const int n = rho >> 4, i = rho & 15; return 8 * (i >> 2) + 4 * n + (i & 3); }

struct Unit { const GAS char* a; const GAS char* b; int pm, pn, e; };

template <int N> __device__ __forceinline__ void wait_vm() { asm volatile("s_waitcnt vmcnt(%0)" :: "n"(N) : "memory"); }
template <class Epi, class Sched, bool ALIGN_EPI, bool GATHER, bool FP8 = false, bool MIDSCALE = false, bool VARK = false>
__device__ __forceinline__ void gemm_phase(const int tid, LAS unsigned char* lds, const int Kb, const int ldaB, const int ldbB, const Sched& S, const Epi& E, const GAS int* __restrict__ tokof, const LAS f32x2* scl = nullptr) {
    const int wid = __builtin_amdgcn_readfirstlane(tid >> 6), lane = tid & 63, wr = wid >> 2, wc = wid & 3, fr = lane & 15, fq = lane >> 4;
    const int nt = Kb / 128;
    unsigned voffA[2], voffB[2]; int RA[2], CA2[2];
#pragma unroll
    for (int i = 0; i < 2; ++i) { int R, C; stage_rc(tid * 16 + i * 8192, R, C); const int Rb = Epi::WIDE ? (64 * (R >> 5) + perm32(R & 31)) : Epi::PERM ? ((R & ~31) + perm32(R & 31)) : R;
        voffA[i] = (unsigned)(R * ldaB + C * 2); voffB[i] = (unsigned)(Rb * ldbB + C * 2); RA[i] = R; CA2[i] = C * 2; }
    const size_t kstep = (size_t)(BK * 2);
    const size_t hstepA = GATHER ? 0 : (size_t)HALF * ldaB;
    const size_t hstepB = (size_t)(Epi::WIDE ? 32 : HALF) * ldbB;
    const unsigned ldsw = (unsigned)wid * 1024u;
    const int aoff = lds_byte(wr * 64 + fr, fq * 8), boff = lds_byte(wc * 32 + fr, fq * 8);
    unsigned gcur[2][2], gnxt[2][2];
    const int scl8 = 0x7F7F7F7F;
#define PG8_SA(b, h) (((b) * 2 + (h)) * HTB)
#define PG8_SB(b, h) ((4 + (b) * 2 + (h)) * HTB)
#define PG8_STAGE(bufoff, gbase, voff) do { const unsigned long long gb_ = (unsigned long long)(gbase); const unsigned lbase_ = (unsigned)__builtin_amdgcn_readfirstlane((int)((unsigned)(uintptr_t)lds + (unsigned)(bufoff) + ldsw)); \
        _Pragma("unroll") for (int _i = 0; _i < 2; ++_i) { unsigned keep_; \
            asm volatile("s_mov_b32 %0, m0\n\ts_mov_b32 m0, %3\n\ts_nop 0\n\tglobal_load_lds_dwordx4 %1, %2\n\ts_mov_b32 m0, %0" : "=&s"(keep_) : "v"((voff)[_i]), "s"(gb_), "s"(lbase_ + (unsigned)(_i * 8192)) : "memory"); } } while (0)
#define PG8_STAGE_A(bufoff, base, h, nx) do { if constexpr (GATHER) { unsigned _v[2]; _v[0] = (nx) ? gnxt[h][0] : gcur[h][0]; _v[1] = (nx) ? gnxt[h][1] : gcur[h][1]; PG8_STAGE(bufoff, base, _v); } \
        else { PG8_STAGE(bufoff, (base) + (h) * hstepA, voffA); } } while (0)
#define PG8_LDA(dst, b, h) do { _Pragma("unroll") for (int m = 0; m < 4; ++m) _Pragma("unroll") for (int k = 0; k < 2; ++k) dst[m][k] = *(const LAS bf16x8*)(lds + PG8_SA(b, h) + aoff + m * 2048 + k * 1024); } while (0)
#define PG8_LDB(dst, b, h) do { _Pragma("unroll") for (int n = 0; n < 2; ++n) _Pragma("unroll") for (int k = 0; k < 2; ++k) dst[n][k] = *(const LAS bf16x8*)(lds + PG8_SB(b, h) + boff + n * 2048 + k * 1024); } while (0)
#define PG8_MMA(ai, bj, At, Bt) do { __builtin_amdgcn_s_setprio(1); if constexpr (FP8) { _Pragma("unroll") for (int m = 0; m < 4; ++m) _Pragma("unroll") for (int n = 0; n < 2; ++n) { \
        const v8i32_t b8_ = __builtin_shufflevector(__builtin_bit_cast(v4i32_t, Bt[n][0]), __builtin_bit_cast(v4i32_t, Bt[n][1]), 0, 1, 2, 3, 4, 5, 6, 7), a8_ = __builtin_shufflevector(__builtin_bit_cast(v4i32_t, At[m][0]), __builtin_bit_cast(v4i32_t, At[m][1]), 0, 1, 2, 3, 4, 5, 6, 7); \
        asm volatile("s_nop 1\n\tv_mfma_scale_f32_16x16x128_f8f6f4 %0, %1, %2, %0, %3, %3 op_sel_hi:[0,0,0]" : "+v"(acc[ai][bj][m][n]) : "v"(b8_), "v"(a8_), "v"(scl8)); } } \
      else { _Pragma("unroll") for (int m = 0; m < 4; ++m) _Pragma("unroll") for (int n = 0; n < 2; ++n) _Pragma("unroll") for (int k = 0; k < 2; ++k) \
        acc[ai][bj][m][n] = __builtin_amdgcn_mfma_f32_16x16x32_bf16(Bt[n][k], At[m][k], acc[ai][bj][m][n], 0, 0, 0); } __builtin_amdgcn_s_setprio(0); } while (0)
#define PG8_MMA_Z(ai, bj, At, Bt) do { __builtin_amdgcn_s_setprio(1); if constexpr (FP8) { _Pragma("unroll") for (int m = 0; m < 4; ++m) _Pragma("unroll") for (int n = 0; n < 2; ++n) { \
        const v8i32_t b8_ = __builtin_shufflevector(__builtin_bit_cast(v4i32_t, Bt[n][0]), __builtin_bit_cast(v4i32_t, Bt[n][1]), 0, 1, 2, 3, 4, 5, 6, 7), a8_ = __builtin_shufflevector(__builtin_bit_cast(v4i32_t, At[m][0]), __builtin_bit_cast(v4i32_t, At[m][1]), 0, 1, 2, 3, 4, 5, 6, 7); \
        asm volatile("s_nop 1\n\tv_mfma_scale_f32_16x16x128_f8f6f4 %0, %1, %2, 0, %3, %3 op_sel_hi:[0,0,0]" : "=&v"(acc[ai][bj][m][n]) : "v"(b8_), "v"(a8_), "v"(scl8)); } } \
      __builtin_amdgcn_s_setprio(0); } while (0)
#define PG8_WAIT_V(n) asm volatile("s_waitcnt vmcnt(" #n ")" ::: "memory")
#define PG8_WAIT_L(n) asm volatile("s_waitcnt lgkmcnt(" #n ")" ::: "memory")
#define PG8_BAR __builtin_amdgcn_s_barrier()
#define PG8_SCHED __builtin_amdgcn_sched_barrier(0)
#define PG8_GLOAD(dst, u) do { if constexpr (GATHER) { _Pragma("unroll") for (int _h = 0; _h < 2; ++_h) _Pragma("unroll") for (int _i = 0; _i < 2; ++_i) \
        dst[_h][_i] = (unsigned)tokof[(u).pm * BM + _h * HALF + RA[_i]] * (unsigned)ldaB + (unsigned)CA2[_i]; } } while (0)
    Unit cur, nxt; int ui = 0;
    if (!S.next(0, cur)) return;
    PG8_GLOAD(gcur, cur);
    typename Epi::Pre pre = E.prefetch(cur, wr, fr);
    f32x4 acc[2][2][4][2];
#pragma unroll
    for (int a = 0; a < 2; ++a)
#pragma unroll
        for (int b = 0; b < 2; ++b)
#pragma unroll
            for (int m = 0; m < 4; ++m)
#pragma unroll
                for (int n = 0; n < 2; ++n) acc[a][b][m][n] = (f32x4){0.f, 0.f, 0.f, 0.f};
    bf16x8 At[4][2], B0[2][2], B1[2][2];
    const GAS char* cA = cur.a; const GAS char* cB = cur.b;
    PG8_STAGE(PG8_SB(0, 0), cB, voffB); PG8_STAGE(PG8_SB(0, 1), cB + hstepB, voffB); PG8_STAGE_A(PG8_SA(0, 0), cA, 0, false); PG8_STAGE_A(PG8_SA(0, 1), cA, 1, false);
    if (wr == 1) PG8_BAR;
    PG8_WAIT_V(2); PG8_BAR;
    PG8_STAGE(PG8_SB(1, 0), cB + kstep, voffB); PG8_STAGE_A(PG8_SA(1, 0), cA + kstep, 0, false); PG8_STAGE(PG8_SB(1, 1), cB + hstepB + kstep, voffB);
    PG8_WAIT_V(6); PG8_BAR;
    bool fresh = false;
    for (;;) {
        const bool has_next = S.next(ui + 1, nxt);
        if constexpr (GATHER) { if (has_next) { PG8_GLOAD(gnxt, nxt); } else { _Pragma("unroll") for (int _h = 0; _h < 2; ++_h) _Pragma("unroll") for (int _i = 0; _i < 2; ++_i) gnxt[_h][_i] = gcur[_h][_i]; } }
        const GAS char* nA = has_next ? nxt.a : cA; const GAS char* nB = has_next ? nxt.b : cB;
        const int ntu = VARK ? (cur.e ? nt / 2 : nt) : nt;
#pragma nounroll
        for (int t = 0; t < ntu; t += 2) {
            const bool last = (t == ntu - 2);
            const GAS char* a1 = cA + (size_t)(t + 1) * kstep;
            const GAS char* a2 = last ? nA : cA + (size_t)(t + 2) * kstep; const GAS char* b2 = last ? nB : cB + (size_t)(t + 2) * kstep;
            const GAS char* a3 = a2 + kstep; const GAS char* b3 = b2 + kstep;
            const bool fe = fresh; fresh = false;
            if constexpr (MIDSCALE) { if (t == nt / 2) {
#pragma unroll
                for (int ai = 0; ai < 2; ++ai)
#pragma unroll
                    for (int m = 0; m < 4; ++m) { const float r_ = scl[ui * 256 + ai * 128 + wr * 64 + m * 16 + fr][0];
#pragma unroll
                        for (int bj = 0; bj < 2; ++bj)
#pragma unroll
                            for (int n = 0; n < 2; ++n) acc[ai][bj][m][n] *= r_; } } }
            PG8_LDB(B0, 0, 0); PG8_LDB(B1, 0, 1); PG8_SCHED; PG8_LDA(At, 0, 0); PG8_STAGE_A(PG8_SA(1, 1), a1, 1, false);
            if (fe) wait_vm<8 + Epi::NST>(); else PG8_WAIT_V(8); PG8_WAIT_L(0); PG8_BAR; if (FP8 && t == 0) { PG8_MMA_Z(0, 0, At, B0); PG8_MMA_Z(0, 1, At, B1); } else { PG8_MMA(0, 0, At, B0); PG8_MMA(0, 1, At, B1); } PG8_BAR; PG8_SCHED;
            PG8_LDA(At, 0, 1); PG8_STAGE(PG8_SB(0, 0), b2, voffB); PG8_STAGE(PG8_SB(0, 1), b2 + hstepB, voffB); PG8_STAGE_A(PG8_SA(0, 0), a2, 0, last);
            if (fe) wait_vm<8 + Epi::NST>(); else PG8_WAIT_V(8); PG8_WAIT_L(0); PG8_BAR; if (FP8 && t == 0) { PG8_MMA_Z(1, 0, At, B0); PG8_MMA_Z(1, 1, At, B1); } else { PG8_MMA(1, 0, At, B0); PG8_MMA(1, 1, At, B1); } PG8_BAR; PG8_SCHED;
            PG8_LDB(B0, 1, 0); PG8_LDB(B1, 1, 1); PG8_SCHED; PG8_LDA(At, 1, 0); PG8_STAGE_A(PG8_SA(0, 1), a2, 1, last);
            PG8_WAIT_V(8); PG8_WAIT_L(0); PG8_BAR; PG8_MMA(0, 0, At, B0); PG8_MMA(0, 1, At, B1); PG8_BAR; PG8_SCHED;
            PG8_LDA(At, 1, 1); PG8_STAGE(PG8_SB(1, 0), b3, voffB); PG8_STAGE(PG8_SB(1, 1), b3 + hstepB, voffB); PG8_STAGE_A(PG8_SA(1, 0), a3, 0, last);
            PG8_WAIT_V(8); PG8_WAIT_L(0); PG8_BAR; PG8_MMA(1, 0, At, B0); PG8_MMA(1, 1, At, B1); PG8_BAR; PG8_SCHED;
        }
        if constexpr (ALIGN_EPI) { if (wr == 0) PG8_BAR; }
        if constexpr (FP8) {
            asm volatile("s_nop 15\n\ts_nop 15" ::: "memory");
#pragma unroll
            for (int a = 0; a < 2; ++a)
#pragma unroll
                for (int b = 0; b < 2; ++b)
                    asm volatile("" : "+v"(acc[a][b][0][0]), "+v"(acc[a][b][0][1]), "+v"(acc[a][b][1][0]), "+v"(acc[a][b][1][1]), "+v"(acc[a][b][2][0]), "+v"(acc[a][b][2][1]), "+v"(acc[a][b][3][0]), "+v"(acc[a][b][3][1])); }
        if constexpr (MIDSCALE) E(acc, cur, wr, wc, fr, fq, scl + ui * 256); else E(acc, cur, wr, wc, fr, fq, pre);
        if (!has_next) break;
        pre = E.prefetch(nxt, wr, fr);
        if constexpr (FP8) {
#pragma unroll
            for (int a = 0; a < 2; ++a)
#pragma unroll
                for (int b = 0; b < 2; ++b)
                    asm volatile("" : "=v"(acc[a][b][0][0]), "=v"(acc[a][b][0][1]), "=v"(acc[a][b][1][0]), "=v"(acc[a][b][1][1]), "=v"(acc[a][b][2][0]), "=v"(acc[a][b][2][1]), "=v"(acc[a][b][3][0]), "=v"(acc[a][b][3][1]));
        } else {
#pragma unroll
            for (int a = 0; a < 2; ++a)
#pragma unroll
                for (int b = 0; b < 2; ++b)
#pragma unroll
                    for (int m = 0; m < 4; ++m)
#pragma unroll
                        for (int n = 0; n < 2; ++n) acc[a][b][m][n] = (f32x4){0.f, 0.f, 0.f, 0.f};
        }
        cur = nxt; cA = nA; cB = nB; ++ui; fresh = true;
        if constexpr (GATHER) { _Pragma("unroll") for (int _h = 0; _h < 2; ++_h) _Pragma("unroll") for (int _i = 0; _i < 2; ++_i) gcur[_h][_i] = gnxt[_h][_i]; }
        if constexpr (ALIGN_EPI) { if (wr == 1) PG8_BAR; }
    }
    PG8_WAIT_V(0);
    if constexpr (!ALIGN_EPI) { if (wr == 0) PG8_BAR; }
    PG8_BAR;
#undef PG8_SA
#undef PG8_SB
#undef PG8_STAGE
#undef PG8_STAGE_A
#undef PG8_LDA
#undef PG8_LDB
#undef PG8_MMA
#undef PG8_MMA_Z
#undef PG8_WAIT_V
#undef PG8_WAIT_L
#undef PG8_BAR
#undef PG8_SCHED
#undef PG8_GLOAD
}
}
using pg8::Unit;

struct BatchOrder {
    int nN, v; const GAS char* A; const GAS char* B; size_t aT, bT;
    __device__ __forceinline__ bool next(int i, Unit& u) const {
        const int uu = i * 16 + (v & 15); if (uu >= 8 * nN) return false;
        u.pm = __builtin_amdgcn_readfirstlane((v >> 4) * 8 + uu / nN); u.pn = __builtin_amdgcn_readfirstlane(uu % nN); u.e = 0;
        u.a = A + (size_t)u.pm * aT; u.b = B + (size_t)u.pn * bT; return true;
    }
};
struct UpOrder {
    int v; const GAS char* LATp; const GAS char* Wq; const GAS char* Wkv;
    __device__ __forceinline__ bool next(int i, Unit& u) const {
        const int j = v & 15; const bool hi = j >= 8; if (i >= (hi ? 4 : 3)) return false;
        const bool kv = hi ? (i < 3) : (i == 2); u.pn = __builtin_amdgcn_readfirstlane(hi ? (kv ? 1 + i : 2) : (kv ? 0 : i)); u.e = __builtin_amdgcn_readfirstlane(kv ? 1 : 0); u.pm = __builtin_amdgcn_readfirstlane((v >> 4) * 8 + (j & 7));
        u.a = LATp + (size_t)u.pm * 256 * 512 * 2 + (u.e ? 512 : 0);
        u.b = (u.e ? Wkv : Wq) + (size_t)u.pn * 256 * 256 * 2; return true;
    }
};
struct MoeOrder {
    int G, c; const volatile LAS int* TS; const GAS char* A; const GAS char* W; size_t aT  , wE  , wT  ;
    __device__ __forceinline__ bool next(int i, Unit& u) const {
        const int L = i * G + c; const int ntile = __builtin_amdgcn_readfirstlane(TS[32]); if (L >= ntile * 4) return false;
        const int rt = L >> 2, ct = L & 3;
        const int ln_ = (int)__builtin_amdgcn_mbcnt_hi(~0u, __builtin_amdgcn_mbcnt_lo(~0u, 0u)); const int tsv_ = TS[ln_ & 31];
        const int e = __builtin_popcountll(__ballot(ln_ >= 1 && ln_ < 32 && tsv_ <= rt));
        u.pm = rt; u.pn = ct; u.e = e; u.a = A + (size_t)rt * aT; u.b = W + (size_t)e * wE + (size_t)ct * wT; return true;
    }
};

__device__ __forceinline__ u32x4 pack8(f32x4 v0, f32x4 v1) { u32x4 w; w.x = cvt_pk_bf16(v0[0], v0[1]); w.y = cvt_pk_bf16(v0[2], v0[3]); w.z = cvt_pk_bf16(v1[0], v1[1]); w.w = cvt_pk_bf16(v1[2], v1[3]); return w; }

__device__ __forceinline__ void wide_store(GAS bf16* p, long dB, bool lo, u32x4 X, u32x4 Y) {
    u32x4 Yr;
#pragma unroll
    for (int j = 0; j < 4; ++j) Yr[j] = (unsigned)__builtin_amdgcn_update_dpp(0, (int)Y[j], 0x128, 0xf, 0xf, false);
    u32x4 A, B;
#pragma unroll
    for (int j = 0; j < 4; ++j) { A[j] = lo ? X[j] : Yr[j]; B[j] = lo ? Yr[j] : X[j]; }
    *(GAS u32x4*)p = A; *(GAS u32x4*)(p + dB) = B;
}

struct EpiWin {
    static constexpr int NST = 16;
    static constexpr bool PERM = true, WIDE = true;
    GAS bf16* LAT_; GAS bf16* FQKV_; GAS bf16* KPE_; GAS float* FLOG_; GAS float* SSQ_; const GAS float* COS_; const GAS float* SIN_; const GAS float* RSX_;
    struct Pre { float v[8]; };
    __device__ __forceinline__ Pre prefetch(const Unit& u, int wr, int fr) const { Pre p; const GAS float* RSX = RSX_; asm volatile("" : "+s"(RSX));
#pragma unroll
        for (int g = 0; g < 8; ++g) p.v[g] = RSX[u.pm * 256 + (g >> 2) * 128 + wr * 64 + (g & 3) * 16 + fr]; return p; }
    __device__ __forceinline__ void operator()(f32x4 (&acc)[2][2][4][2], const Unit& u, int wr, int wc, int fr, int fq, const Pre& pre) const {
        GAS bf16* LAT = LAT_; GAS bf16* FQKV = FQKV_; GAS bf16* KPE = KPE_; GAS float* FLOG = FLOG_; GAS float* SSQ = SSQ_; const GAS float* COS = COS_; const GAS float* SIN = SIN_; const GAS float* RSX = RSX_;
        asm volatile("" : "+s"(LAT), "+s"(FQKV), "+s"(KPE), "+s"(FLOG), "+s"(SSQ), "+s"(COS), "+s"(SIN), "+s"(RSX));
        {
#pragma unroll
            for (int ai = 0; ai < 2; ++ai)
#pragma unroll
                for (int m = 0; m < 4; ++m) { const float rs_ = pre.v[ai * 4 + m];
#pragma unroll
                    for (int bj = 0; bj < 2; ++bj)
#pragma unroll
                        for (int n = 0; n < 2; ++n) acc[ai][bj][m][n] *= rs_; } }
        const int row0 = u.pm * 256 + wr * 64 + fr; const int pn = u.pn;
        const bool lo = fr < 8; const int roww = u.pm * 256 + wr * 64 + (fr & 7), colw = wc * 64 + (fr >> 3) * 32 + 8 * fq; const long dB = 8 * 512 + (lo ? 32 : -32);
        if (pn >= 2) {
            const int ti = pn >> 1; GAS bf16* dst = FQKV + (size_t)(ti - 1) * NTOK * 512 + (pn & 1) * 256 + colw; const float sc = (ti == 1) ? C2F : 1.f;
#pragma unroll
            for (int ai = 0; ai < 2; ++ai)
#pragma unroll
                for (int m = 0; m < 4; ++m) wide_store(dst + (size_t)(roww + ai * 128 + m * 16) * 512, dB, lo, pack8(acc[ai][0][m][0] * sc, acc[ai][0][m][1] * sc), pack8(acc[ai][1][m][0] * sc, acc[ai][1][m][1] * sc));
        } else {
#pragma unroll
            for (int ai = 0; ai < 2; ++ai)
#pragma unroll
                for (int m = 0; m < 4; ++m) { const int row = row0 + ai * 128 + m * 16;
                    wide_store(LAT + (size_t)(roww + ai * 128 + m * 16) * 512 + pn * 256 + colw, dB, lo, pack8(acc[ai][0][m][0], acc[ai][0][m][1]), pack8(acc[ai][1][m][0], acc[ai][1][m][1]));
                    float s = 0.f;
                    if (pn == 0 || wc < 2) {
#pragma unroll
                        for (int bj = 0; bj < 2; ++bj)
#pragma unroll
                            for (int n = 0; n < 2; ++n) { const f32x4 x = acc[ai][bj][m][n]; s += (x[0] * x[0] + x[1] * x[1]) + (x[2] * x[2] + x[3] * x[3]); }
                    }
                    s += __shfl_xor(s, 16); s += __shfl_xor(s, 32);
                    if (fq == 0) SSQ[(size_t)row * 8 + pn * 4 + wc] = s;
                    }
            if (pn == 1 && wc == 2) {
#pragma unroll
                for (int ai = 0; ai < 2; ++ai)
#pragma unroll
                    for (int m = 0; m < 4; ++m) { const int row = row0 + ai * 128 + m * 16;
                        const f32x4 c = *(const GAS f32x4*)(COS + (size_t)row * 16 + 4 * fq), sn = *(const GAS f32x4*)(SIN + (size_t)row * 16 + 4 * fq);
                        const f32x4 x1 = acc[ai][0][m][0], x2 = acc[ai][0][m][1];
                        *(GAS u32x4*)(KPE + (size_t)row * 32 + 8 * fq) = pack8(x1 * c - x2 * sn, x1 * sn + x2 * c);
                        }
            }
            if (pn == 1 && wc == 2 && fq == 0) {
#pragma unroll
                for (int ai = 0; ai < 2; ++ai)
#pragma unroll
                    for (int m = 0; m < 4; ++m) { const int row = row0 + ai * 128 + m * 16; *(GAS f32x4*)(FLOG + (size_t)row * 8) = acc[ai][1][m][0]; *(GAS f32x4*)(FLOG + (size_t)row * 8 + 4) = acc[ai][1][m][1]; }
            }
        }
    }
};
struct EpiUp {
    static constexpr int NST = 16;
    static constexpr bool PERM = true, WIDE = true;
    GAS bf16* QM_; GAS bf16* KVM_; const GAS float* SSQ_; const GAS float* COS_; const GAS float* SIN_;
    struct Pre { f32x4 v[8]; };
    __device__ __forceinline__ Pre prefetch(const Unit& u, int wr, int fr) const { Pre p; const GAS float* SSQ = SSQ_; asm volatile("" : "+s"(SSQ)); const int off = u.e ? 4 : 0;
#pragma unroll
        for (int g = 0; g < 8; ++g) p.v[g] = *(const GAS f32x4*)(SSQ + (size_t)(u.pm * 256 + (g >> 2) * 128 + wr * 64 + (g & 3) * 16 + fr) * 8 + off); return p; }
    __device__ __forceinline__ void operator()(const f32x4 (&acc)[2][2][4][2], const Unit& u, int wr, int wc, int fr, int fq, const Pre& pre) const {
        GAS bf16* QM = QM_; GAS bf16* KVM = KVM_; const GAS float* SSQ = SSQ_; const GAS float* COS = COS_; const GAS float* SIN = SIN_;
        asm volatile("" : "+s"(QM), "+s"(KVM), "+s"(SSQ), "+s"(COS), "+s"(SIN));
        const int row0 = u.pm * 256 + wr * 64 + fr; const int pn = u.pn; const bool kv = u.e != 0;
        const bool lo = fr < 8; const int roww = u.pm * 256 + wr * 64 + (fr & 7), colw = pn * 256 + wc * 64 + (fr >> 3) * 32 + 8 * fq;
#pragma unroll
        for (int ai = 0; ai < 2; ++ai)
#pragma unroll
            for (int m = 0; m < 4; ++m) { const int row = row0 + ai * 128 + m * 16;
                const f32x4 sq = pre.v[ai * 4 + m];
                const float ss = (sq[0] + sq[1]) + (sq[2] + sq[3]);
                if (kv) {
                    const float rs = rsqrtf(ss * (1.f / 128.f) + EPS);
                    wide_store(KVM + (size_t)(roww + ai * 128 + m * 16) * 1024 + colw, 8 * 1024 + (lo ? 32 : -32), lo, pack8(acc[ai][0][m][0] * rs, acc[ai][0][m][1] * rs), pack8(acc[ai][1][m][0] * rs, acc[ai][1][m][1] * rs));
                } else {
                    const float rs = rsqrtf(ss * (1.f / 256.f) + EPS) * C2M;
                    const f32x4 c = *(const GAS f32x4*)(COS + (size_t)row * 16 + 4 * fq), sn = *(const GAS f32x4*)(SIN + (size_t)row * 16 + 4 * fq);
                    u32x4 XY[2];
#pragma unroll
                    for (int bj = 0; bj < 2; ++bj) { f32x4 v0 = acc[ai][bj][m][0] * rs, v1 = acc[ai][bj][m][1] * rs;
                        const int G = 8 * pn + 2 * wc + bj;
                        if (G % 3 == 2) { const f32x4 x1 = v0, x2 = v1; v0 = x1 * c - x2 * sn; v1 = x1 * sn + x2 * c; }
                        XY[bj] = pack8(v0, v1); }
                    wide_store(QM + (size_t)(roww + ai * 128 + m * 16) * 768 + colw, 8 * 768 + (lo ? 32 : -32), lo, XY[0], XY[1]);
                }

            }
    }
};
template <bool RES_F32> struct EpiOut {
    static constexpr int NST = 16;
    static constexpr bool PERM = true, WIDE = true;
    const GAS float* resf_; GAS bf16* xr_;
    struct Pre {}; __device__ __forceinline__ Pre prefetch(const Unit&, int, int) const { return Pre{}; }
    __device__ __forceinline__ void operator()(const f32x4 (&acc)[2][2][4][2], const Unit& u, int wr, int wc, int fr, int fq, const LAS f32x2* scl) const {
        const GAS float* resf = resf_; GAS bf16* xr = xr_; asm volatile("" : "+s"(resf), "+s"(xr));
        const int row0 = u.pm * 256 + wr * 64 + fr, col0 = u.pn * 256 + wc * 64 + 8 * fq;
        const bool lo = fr < 8; const int roww = u.pm * 256 + wr * 64 + (fr & 7), colw = u.pn * 256 + wc * 64 + (fr >> 3) * 32 + 8 * fq;
#pragma unroll
        for (int ai = 0; ai < 2; ++ai)
#pragma unroll
            for (int m = 0; m < 4; ++m) { const size_t off = (size_t)(row0 + ai * 128 + m * 16) * DM + col0; const float sh = scl[ai * 128 + wr * 64 + m * 16 + fr][1];
                u32x4 XY[2];
#pragma unroll
                for (int bj = 0; bj < 2; ++bj) { f32x4 r0, r1;
                    if constexpr (RES_F32) { r0 = *(const GAS f32x4*)(resf + off + bj * 32); r1 = *(const GAS f32x4*)(resf + off + bj * 32 + 4); }
                    else { const u32x4 w = *(const GAS u32x4*)(xr + off + bj * 32);
                        r0 = (f32x4){__uint_as_float(w.x << 16), __uint_as_float(w.x & 0xffff0000u), __uint_as_float(w.y << 16), __uint_as_float(w.y & 0xffff0000u)};
                        r1 = (f32x4){__uint_as_float(w.z << 16), __uint_as_float(w.z & 0xffff0000u), __uint_as_float(w.w << 16), __uint_as_float(w.w & 0xffff0000u)}; }
                    XY[bj] = pack8(r0 + acc[ai][bj][m][0] * sh, r1 + acc[ai][bj][m][1] * sh); }
                wide_store(xr + (size_t)(roww + ai * 128 + m * 16) * DM + colw, 8 * DM + (lo ? 32 : -32), lo, XY[0], XY[1]); }
    }
};
struct EpiGU {
    static constexpr int NST = 8;
    static constexpr bool PERM = true, WIDE = false;
    GAS unsigned char* HH_; const GAS float* RS_;
    struct Pre { float v[8]; };
    __device__ __forceinline__ Pre prefetch(const Unit& u, int wr, int fr) const { Pre p; const GAS float* RS = RS_; asm volatile("" : "+s"(RS));
#pragma unroll
        for (int g = 0; g < 8; ++g) p.v[g] = RS[u.pm * 256 + (g >> 2) * 128 + wr * 64 + (g & 3) * 16 + fr]; return p; }
    __device__ __forceinline__ void operator()(const f32x4 (&acc)[2][2][4][2], const Unit& u, int wr, int wc, int fr, int fq, const Pre& pre) const {
        GAS unsigned char* HH = HH_; const GAS float* RS = RS_; asm volatile("" : "+s"(HH), "+s"(RS));
        const int row0 = u.pm * 256 + wr * 64 + fr;
#pragma unroll
        for (int ai = 0; ai < 2; ++ai)
#pragma unroll
            for (int m = 0; m < 4; ++m) { GAS unsigned char* rowp = HH + (size_t)(row0 + ai * 128 + m * 16) * 512 + u.pn * 128 + wc * 32 + 8 * fq; const float rs = pre.v[ai * 4 + m] * WSCALE_INV;
                f32x4 h[2];
#pragma unroll
                for (int n = 0; n < 2; ++n) { const f32x4 g = acc[ai][0][m][n] * rs, up = acc[ai][1][m][n] * rs;
#pragma unroll
                    for (int j = 0; j < 4; ++j) { const float sg = __builtin_amdgcn_rcpf(1.f + __builtin_amdgcn_exp2f(-g[j] * LOG2E)); h[n][j] = g[j] * sg * up[j]; } }
                u32x2 w; w.x = pk4_fp8(h[0][0], h[0][1], h[0][2], h[0][3]); w.y = pk4_fp8(h[1][0], h[1][1], h[1][2], h[1][3]); *(GAS u32x2*)rowp = w; }
    }
};
struct EpiDown {
    static constexpr int NST = 16;
    static constexpr bool PERM = true, WIDE = false;
    GAS unsigned char* Y_; const GAS float* GATEOF_;
    struct Pre { float v[8]; };
    __device__ __forceinline__ Pre prefetch(const Unit& u, int wr, int fr) const { Pre p; const GAS float* GT = GATEOF_; asm volatile("" : "+s"(GT));
#pragma unroll
        for (int g = 0; g < 8; ++g) p.v[g] = GT[u.pm * 256 + (g >> 2) * 128 + wr * 64 + (g & 3) * 16 + fr]; return p; }
    __device__ __forceinline__ void operator()(const f32x4 (&acc)[2][2][4][2], const Unit& u, int wr, int wc, int fr, int fq, const Pre& pre) const {
        GAS unsigned char* Y = Y_; const GAS float* GATEOF = GATEOF_; asm volatile("" : "+s"(Y), "+s"(GATEOF));
        const int row0 = u.pm * 256 + wr * 64 + fr;
#pragma unroll
        for (int ai = 0; ai < 2; ++ai)
#pragma unroll
            for (int m = 0; m < 4; ++m) { const int row = row0 + ai * 128 + m * 16; const float g = pre.v[ai * 4 + m]; GAS unsigned char* rowp = Y + (size_t)row * 1024 + u.pn * 256 + wc * 32 + 8 * fq;
#pragma unroll
                for (int bj = 0; bj < 2; ++bj) { const f32x4 v0 = acc[ai][bj][m][0] * g, v1 = acc[ai][bj][m][1] * g; u32x2 w; w.x = pk4_fp8(v0[0], v0[1], v0[2], v0[3]); w.y = pk4_fp8(v1[0], v1[1], v1[2], v1[3]); *(GAS u32x2*)(rowp + bj * 128) = w; } }
    }
};

namespace att {
constexpr int KSLOT = 12288, VSLOT = 8192;
constexpr int L_K = 0, L_V = 2 * KSLOT, L_BIAS = L_V + 2 * VSLOT, L_WS = L_BIAS + 8192, L_OST = L_WS + 8 * 64 * 4, L_END = L_OST + 8 * 4096;
__device__ __forceinline__ int crow(int r, int hi) { return (r & 3) + 8 * (r >> 2) + 4 * hi; }
typedef short v4i16_t __attribute__((ext_vector_type(4)));
__device__ __forceinline__ s16x4 vtr(const LAS char* p) { return __builtin_bit_cast(s16x4, __builtin_amdgcn_ds_read_tr16_b64_v4i16((LAS v4i16_t*)p)); }

constexpr int NSL = 5;
constexpr int R_K = 0, R_V = NSL * KSLOT, R_WS = R_V + NSL * VSLOT, R_OST = R_WS + 8 * 64 * 4, R_END = R_OST + 8 * 4096;
static_assert(R_END <= RING_BYTES, "attention LDS");
__device__ __forceinline__ void glds16(const GAS void* gsrc, unsigned lds_dst) { unsigned keep;
    asm volatile("s_mov_b32 %0, m0\n\ts_mov_b32 m0, %2\n\ts_nop 0\n\tglobal_load_lds_dwordx4 %1, off\n\ts_mov_b32 m0, %0" : "=&s"(keep) : "v"(gsrc), "s"(lds_dst) : "memory"); }
__device__ __forceinline__ void glds16s(const GAS void* sbase, unsigned voff, unsigned lds_dst) { unsigned keep;
    asm volatile("s_mov_b32 %0, m0\n\ts_mov_b32 m0, %3\n\ts_nop 0\n\tglobal_load_lds_dwordx4 %1, %2\n\ts_mov_b32 m0, %0" : "=&s"(keep) : "v"(voff), "s"((unsigned long long)sbase), "s"(lds_dst) : "memory"); }
struct Tens2 { const GAS bf16* Q; int qp; const GAS bf16* K; int kp; const GAS bf16* KX; const GAS bf16* V; int vp; GAS bf16* O; const GAS float* BIASF; const GAS float* NRM; GAS float* OSS; };
template <int MODE>
__device__ __forceinline__ int attn_unit2(const int wave_, int b, int h, int qb, const Tens2& T, LAS char* shm, const int slbase, const bool have_pro, const int qb_next, bf16x8 (&qr)[6], const int tstart) {
    constexpr int DKS = MODE ? 6 : 5, DKH = 3;
    constexpr float THR = 8.f;
    int wid = wave_; asm volatile("" : "+s"(wid));
    int lane = (int)__builtin_amdgcn_mbcnt_hi(~0u, __builtin_amdgcn_mbcnt_lo(~0u, 0u)); asm volatile("" : "+v"(lane)); const int r32 = lane & 31, hi = lane >> 5;
    const long rowbase = (long)b * SEQ; const int q0 = qb * 256, qw0 = q0 + wid * 32;
    const int NT = (q0 + 256) / 64, tlast = qw0 / 64;
    const int NTE = NT - tstart;
    const GAS bf16* Qw = T.Q + (rowbase + qw0) * T.qp + h * (MODE ? 96 : 64);
    const GAS bf16* Kh = T.K + rowbase * T.kp + h * (MODE ? 128 : 64);
    const GAS bf16* Vh = T.V + rowbase * T.vp + h * (MODE ? 128 : 64);
    LAS float* wsf = (LAS float*)(shm + R_WS) + wid * 64;
    const unsigned koff = (unsigned)(lane * T.kp + wid * 8) * 2u;
    const unsigned xoff = MODE ? (unsigned)(lane * 32 + (wid & 3) * 8) * 2u : (unsigned)(lane * 8) * 2u;
    const unsigned voff = (unsigned)((16 * (wid & 3) + (lane >> 2)) * T.vp + (wid >> 2) * 32 + (lane & 3) * 8) * 2u;
    const GAS bf16* xbase = MODE ? T.KX + rowbase * 32 : T.KX + ((long)b * 8 + h) * SEQ * 8;
    const int xstep = MODE ? 64 * 32 : 64 * 8;
    const unsigned kdst_a = (unsigned)(uintptr_t)(shm + R_K) + (unsigned)wid * 1024u, xdst_a = (unsigned)(uintptr_t)(shm + R_K) + (unsigned)(8 + (MODE ? (wid & 3) : 0)) * 1024u, vdst_a = (unsigned)(uintptr_t)(shm + R_V) + (unsigned)wid * 1024u;
#define A2_DMA(t, slot) do { \
        glds16s((const GAS void*)(Kh + (long)(t) * 64 * T.kp), koff, (unsigned)__builtin_amdgcn_readfirstlane((int)(kdst_a + (slot) * KSLOT))); \
        glds16s((const GAS void*)(xbase + (long)(t) * xstep), xoff, (unsigned)__builtin_amdgcn_readfirstlane((int)(xdst_a + (slot) * KSLOT))); \
        glds16s((const GAS void*)(Vh + (long)(t) * 64 * T.vp), voff, (unsigned)__builtin_amdgcn_readfirstlane((int)(vdst_a + (slot) * VSLOT))); } while (0)
    float mhat = 0.f, lrun = 0.f; f32x16 o[2]; o[0] = f32x16{}; o[1] = f32x16{}; f32x16 negm = f32x16{};
    const LAS char* vp0 = shm + R_V + ((lane >> 4) & 1) * 32 + (lane & 3) * 8 + (4 * hi + ((lane & 15) >> 2)) * 64;
#define A3_SLOT(k) ((slbase + (k)) % NSL)
    if (!have_pro) { A2_DMA(NT - 1, A3_SLOT(0)); A2_DMA(NT - 2, A3_SLOT(1)); A2_DMA(NT - 3, A3_SLOT(2)); }
    if (!have_pro) {
#pragma unroll
        for (int d0 = 0; d0 < (MODE ? 6 : 4); ++d0) qr[d0] = *(const GAS bf16x8*)(Qw + (long)r32 * T.qp + d0 * 16 + hi * 8); }
    if (MODE == 0) { const short one = hi ? (short)0 : (short)0x3F80; qr[DKS - 1] = (bf16x8){one, one, one, 0, 0, 0, 0, 0}; }
#pragma unroll
    for (int d0 = 0; d0 < DKS; ++d0) asm volatile("" : "+v"(qr[d0]));
#define A3_KLOADH(slot, H) do { const LAS char* kb_ = shm + R_K + (slot) * KSLOT + r32 * 16; _Pragma("unroll") for (int d0 = (H) * DKH; d0 < ((H) ? DKS : DKH); ++d0) { const int off = (MODE == 0 && d0 == 4) ? 8 * 1024 : d0 * 2048 + hi * 1024; \
        kf[2 * (d0 - (H) * DKH)] = *(const LAS bf16x8*)(kb_ + off); kf[2 * (d0 - (H) * DKH) + 1] = *(const LAS bf16x8*)(kb_ + off + 512); } } while (0)
#define A3_VLOAD(slot) do { const LAS char* vp_ = vp0 + (slot) * VSLOT; _Pragma("unroll") for (int q = 0; q < 8; ++q) { vlo[q] = vtr(vp_ + (q >> 2) * 4096 + (q & 3) * 1024); vhh[q] = vtr(vp_ + (q >> 2) * 4096 + (q & 3) * 1024 + 512); } } while (0)
#define A3_QKH(H) do { if ((H) == 0) { c0 = negm; c1 = negm; } _Pragma("unroll") for (int d0 = (H) * DKH; d0 < ((H) ? DKS : DKH); ++d0) { c0 = __builtin_amdgcn_mfma_f32_32x32x16_bf16(kf[2 * (d0 - (H) * DKH)], qr[d0], c0, 0, 0, 0); c1 = __builtin_amdgcn_mfma_f32_32x32x16_bf16(kf[2 * (d0 - (H) * DKH) + 1], qr[d0], c1, 0, 0, 0); } } while (0)
#define A3_EXP() do { float ls_ = 0.f; _Pragma("unroll") for (int r = 0; r < 16; ++r) { pp0[r] = __builtin_amdgcn_exp2f(pp0[r]); pp1[r] = __builtin_amdgcn_exp2f(pp1[r]); ls_ += pp0[r] + pp1[r]; } lrun += ls_; u32x4 w_; \
        w_.x = cvt_pk_bf16(pp0[0], pp0[1]); w_.y = cvt_pk_bf16(pp0[2], pp0[3]); w_.z = cvt_pk_bf16(pp0[4], pp0[5]); w_.w = cvt_pk_bf16(pp0[6], pp0[7]); pa[0] = __builtin_bit_cast(bf16x8, w_); \
        w_.x = cvt_pk_bf16(pp0[8], pp0[9]); w_.y = cvt_pk_bf16(pp0[10], pp0[11]); w_.z = cvt_pk_bf16(pp0[12], pp0[13]); w_.w = cvt_pk_bf16(pp0[14], pp0[15]); pa[1] = __builtin_bit_cast(bf16x8, w_); \
        w_.x = cvt_pk_bf16(pp1[0], pp1[1]); w_.y = cvt_pk_bf16(pp1[2], pp1[3]); w_.z = cvt_pk_bf16(pp1[4], pp1[5]); w_.w = cvt_pk_bf16(pp1[6], pp1[7]); pa[2] = __builtin_bit_cast(bf16x8, w_); \
        w_.x = cvt_pk_bf16(pp1[8], pp1[9]); w_.y = cvt_pk_bf16(pp1[10], pp1[11]); w_.z = cvt_pk_bf16(pp1[12], pp1[13]); w_.w = cvt_pk_bf16(pp1[14], pp1[15]); pa[3] = __builtin_bit_cast(bf16x8, w_); } while (0)
#define A3_PV() do { _Pragma("unroll") for (int d0 = 0; d0 < 2; ++d0) _Pragma("unroll") for (int k = 0; k < 4; ++k) { const s16x4 lo_ = vlo[4 * d0 + k], hh_ = vhh[4 * d0 + k]; \
        const bf16x8 vf_ = (bf16x8){lo_[0], lo_[1], lo_[2], lo_[3], hh_[0], hh_[1], hh_[2], hh_[3]}; o[d0] = __builtin_amdgcn_mfma_f32_32x32x16_bf16(pa[k], vf_, o[d0], 0, 0, 0); } } while (0)
#define A3_ROWMAX(rm) do { float a_ = fmaxf(fmaxf(c0[0], c0[1]), c1[0]), b_ = fmaxf(fmaxf(c0[2], c0[3]), c1[1]); a_ = fmaxf(fmaxf(a_, c1[2]), c1[3]); \
        _Pragma("unroll") for (int r = 4; r < 16; r += 4) { a_ = fmaxf(fmaxf(a_, c0[r]), c0[r + 1]); b_ = fmaxf(fmaxf(b_, c0[r + 2]), c0[r + 3]); a_ = fmaxf(fmaxf(a_, c1[r]), c1[r + 1]); b_ = fmaxf(fmaxf(b_, c1[r + 2]), c1[r + 3]); } \
        rm = fmaxf(a_, b_); const auto rr_ = __builtin_amdgcn_permlane32_swap(__float_as_uint(rm), __float_as_uint(rm), false, false); rm = fmaxf(__uint_as_float(rr_[0]), __uint_as_float(rr_[1])); } while (0)
    int sl = A3_SLOT(0), sl3 = A3_SLOT(3);
    f32x16 pp0 = f32x16{}, pp1 = f32x16{}; bool pend = false; int pslot = 0;
    for (int i = 0; i < NTE; ++i) {
        const int t = NT - 1 - i;
        { const int ahead = NTE - 1 - i;
          if (ahead >= 2) asm volatile("s_waitcnt vmcnt(6)" ::: "memory"); else if (ahead == 1) asm volatile("s_waitcnt vmcnt(3)" ::: "memory"); else asm volatile("s_waitcnt vmcnt(0)" ::: "memory"); }
        __builtin_amdgcn_s_barrier(); asm volatile("" ::: "memory");
        if (i + 3 < NTE) A2_DMA(t - 3, sl3);
        if (i == NTE - 1 && qb_next >= 0) { const int NTn = 4 * qb_next + 4; A2_DMA(NTn - 1, A3_SLOT(NTE)); A2_DMA(NTn - 2, A3_SLOT(NTE + 1)); A2_DMA(NTn - 3, A3_SLOT(NTE + 2)); }
        if (t <= tlast) {
            bf16x8 kf[2 * DKH]; f32x16 c0, c1; float rm;
            A3_KLOADH(sl, 0);
            if (!pend) {
                A3_QKH(0); A3_KLOADH(sl, 1); A3_QKH(1);
                if (MODE == 0) { const int qrel = qw0 + r32 - 64 * t;
#pragma unroll
                    for (int r = 0; r < 16; ++r) { const int kv = crow(r, hi); if (kv > qrel) c0[r] = -INFINITY; if (kv + 32 > qrel) c1[r] = -INFINITY; } }
                A3_ROWMAX(rm);
                mhat = rm;
#pragma unroll
                for (int r = 0; r < 16; ++r) { c0[r] -= rm; c1[r] -= rm; negm[r] = -mhat; }
                pend = true;
            } else {
                s16x4 vlo[8], vhh[8]; bf16x8 pa[4];
                A3_QKH(0); A3_KLOADH(sl, 1);
                A3_VLOAD(pslot);
                A3_QKH(1);
                A3_EXP();
#pragma unroll
                for (int g_ = 0; g_ < 2 * DKS; ++g_) { __builtin_amdgcn_sched_group_barrier(0x008, 1, 0); __builtin_amdgcn_sched_group_barrier(0x002, 7, 0); }
                A3_PV();
                A3_ROWMAX(rm);
#pragma unroll
                for (int g_ = 0; g_ < 8; ++g_) { __builtin_amdgcn_sched_group_barrier(0x008, 1, 0); __builtin_amdgcn_sched_group_barrier(0x002, 3, 0); }
                if (__any(rm > THR)) {
                    const float dl = fmaxf(rm, 0.f); mhat += dl;
#pragma unroll
                    for (int r = 0; r < 16; ++r) { c0[r] -= dl; c1[r] -= dl; negm[r] = -mhat; }
                    const float f = __builtin_amdgcn_exp2f(-dl); lrun *= f;
                    if (hi == 0) wsf[r32] = f;
                    LDS_WAIT();
#pragma unroll
                    for (int g = 0; g < 4; ++g) { const f32x4 ff = *(const LAS f32x4*)(wsf + 8 * g + 4 * hi);
#pragma unroll
                        for (int j = 0; j < 4; ++j) { o[0][4 * g + j] *= ff[j]; o[1][4 * g + j] *= ff[j]; } }
                }
            }
            pp0 = c0; pp1 = c1; pslot = sl;
        }
        sl = (sl == NSL - 1) ? 0 : sl + 1; sl3 = (sl3 == NSL - 1) ? 0 : sl3 + 1;
    }
    if (qb_next >= 0) { const GAS bf16* Qn = T.Q + (rowbase + qb_next * 256 + wid * 32) * T.qp + h * (MODE ? 96 : 64);
#pragma unroll
        for (int d0 = 0; d0 < (MODE ? 6 : 4); ++d0) qr[d0] = *(const GAS bf16x8*)(Qn + (long)r32 * T.qp + d0 * 16 + hi * 8); }
    if (pend) { s16x4 vlo[8], vhh[8]; bf16x8 pa[4]; A3_VLOAD(pslot); A3_EXP(); A3_PV(); }
#undef A3_KLOADH
#undef A3_VLOAD
#undef A3_QKH
#undef A3_EXP
#undef A3_PV
#undef A3_ROWMAX
#undef A2_DMA
    lrun += __shfl_xor(lrun, 32);
    LDS_WAIT();
    if (hi == 0) wsf[32 + r32] = lrun;
    LDS_WAIT();
    float rli[16];
#pragma unroll
    for (int g = 0; g < 4; ++g) { const f32x4 ll = *(const LAS f32x4*)(wsf + 32 + 8 * g + 4 * hi);
#pragma unroll
        for (int j = 0; j < 4; ++j) rli[4 * g + j] = __builtin_amdgcn_rcpf(ll[j]); }
    GAS bf16* Ow = T.O + (rowbase + qw0) * 1024 + (MODE ? 0 : 512) + h * 64;
    { LAS bf16* stg = (LAS bf16*)(shm + R_OST) + wid * 2048;
#pragma unroll
      for (int r = 0; r < 16; ++r) { const int orow = crow(r, hi);
#pragma unroll
          for (int d0 = 0; d0 < 2; ++d0) stg[orow * 64 + d0 * 32 + r32] = (bf16)(cvt_pk_bf16(o[d0][r] * rli[r], 0.f) & 0xffffu); }
      LDS_WAIT();
#pragma unroll
      for (int i = 0; i < 4; ++i) { const int row = i * 8 + (lane >> 3), ch = lane & 7; const u32x4 v = *(const LAS u32x4*)(stg + row * 64 + ch * 8); *(GAS u32x4*)(Ow + (long)row * 1024 + ch * 8) = v;
          float sq = 0.f;
#pragma unroll
          for (int j = 0; j < 4; ++j) { const float a0 = __uint_as_float(v[j] << 16), a1 = __uint_as_float(v[j] & 0xffff0000u); sq += a0 * a0 + a1 * a1; }
          sq += __shfl_xor(sq, 1); sq += __shfl_xor(sq, 2); sq += __shfl_xor(sq, 4);
          if (ch == 0) T.OSS[(rowbase + qw0 + row) * 16 + (MODE ? 0 : 8) + h] = sq; } }
    if (qb_next < 0) { LDS_WAIT(); __builtin_amdgcn_s_barrier(); asm volatile("" ::: "memory"); }
    return A3_SLOT(NTE);
#undef A3_SLOT
}
}

struct Args { const void* in[21]; float* out; unsigned char* ws; int ph_lo, ph_hi; };

__device__ __forceinline__ void tr_item(const GAS float* __restrict__ W, int ldw, int Ksrc, const GAS float* __restrict__ gain, GAS bf16* __restrict__ WT, int ldk, int k0, int n0, int srccol, LAS float* scr, int lane) {
#pragma unroll 8
    for (int i = 0; i < 32; ++i) { const int kk = 2 * i + (lane >> 5); const int k = k0 + kk;
        float v = 0.f; if (srccol >= 0 && k < Ksrc) { v = __builtin_nontemporal_load(W + (size_t)k * ldw + srccol); if (gain) v *= gain[k]; }
        scr[kk * 33 + (lane & 31)] = v; }
    LDS_WAIT(); asm volatile("" ::: "memory");
    const int c = lane & 7;
#pragma unroll
    for (int j = 0; j < 4; ++j) { const int n = (lane >> 3) + 8 * j; const LAS float* s = scr + (8 * c) * 33 + n;
        u32x4 o; o.x = cvt_pk_bf16(s[0 * 33], s[1 * 33]); o.y = cvt_pk_bf16(s[2 * 33], s[3 * 33]); o.z = cvt_pk_bf16(s[4 * 33], s[5 * 33]); o.w = cvt_pk_bf16(s[6 * 33], s[7 * 33]);
        *(GAS u32x4*)(WT + (size_t)(n0 + n) * ldk + k0 + 8 * c) = o; }
    LDS_WAIT(); asm volatile("" ::: "memory");
}
__device__ __forceinline__ void tr_item64(const GAS float* __restrict__ W, int ldw, const GAS float* __restrict__ gain, GAS bf16* __restrict__ WT, int ldk, int k0, int n0src, int n0dst, LAS float* scr, int lane) {
    const int rr = lane >> 4, c4 = (lane & 15) * 4;
    f32x4 v[16];
#pragma unroll
    for (int i = 0; i < 16; ++i) v[i] = __builtin_nontemporal_load((const GAS f32x4*)(W + (size_t)(k0 + 4 * i + rr) * ldw + n0src + c4));
#pragma unroll
    for (int i = 0; i < 16; ++i) { const int k = 4 * i + rr; const float g = gain ? gain[k0 + k] : 1.f; LAS float* d = scr + k * 65 + c4;
        d[0] = v[i][0] * g; d[1] = v[i][1] * g; d[2] = v[i][2] * g; d[3] = v[i][3] * g; }
    LDS_WAIT(); asm volatile("" ::: "memory");
    const int kc = lane & 7;
#pragma unroll
    for (int j = 0; j < 8; ++j) { const int n = (lane >> 3) + 8 * j; const LAS float* sp = scr + (8 * kc) * 65 + n;
        u32x4 o; o.x = cvt_pk_bf16(sp[0 * 65], sp[1 * 65]); o.y = cvt_pk_bf16(sp[2 * 65], sp[3 * 65]); o.z = cvt_pk_bf16(sp[4 * 65], sp[5 * 65]); o.w = cvt_pk_bf16(sp[6 * 65], sp[7 * 65]);
        *(GAS u32x4*)(WT + (size_t)(n0dst + n) * ldk + k0 + 8 * kc) = o; }
    LDS_WAIT(); asm volatile("" ::: "memory");
}
__device__ __forceinline__ void tr_item64_f8(const GAS float* __restrict__ W, int ldw, const GAS float* __restrict__ gain, float scale, GAS unsigned char* __restrict__ WT8, int ldkB, int k0, int n0src, int n0dst, LAS float* scr, int lane) {
    const int rr = lane >> 4, c4 = (lane & 15) * 4;
    f32x4 v[16];
#pragma unroll
    for (int i = 0; i < 16; ++i) v[i] = __builtin_nontemporal_load((const GAS f32x4*)(W + (size_t)(k0 + 4 * i + rr) * ldw + n0src + c4));
#pragma unroll
    for (int i = 0; i < 16; ++i) { const int k = 4 * i + rr; const float g = (gain ? gain[k0 + k] : 1.f) * scale; LAS float* d = scr + k * 65 + c4;
        d[0] = v[i][0] * g; d[1] = v[i][1] * g; d[2] = v[i][2] * g; d[3] = v[i][3] * g; }
    LDS_WAIT(); asm volatile("" ::: "memory");
    const int kc = lane & 7;
#pragma unroll
    for (int j = 0; j < 8; ++j) { const int n = (lane >> 3) + 8 * j; const LAS float* sp = scr + (8 * kc) * 65 + n;
        u32x2 o; o.x = pk4_fp8(sp[0 * 65], sp[1 * 65], sp[2 * 65], sp[3 * 65]); o.y = pk4_fp8(sp[4 * 65], sp[5 * 65], sp[6 * 65], sp[7 * 65]);
        *(GAS u32x2*)(WT8 + (size_t)(n0dst + n) * ldkB + k0 + 8 * kc) = o; }
    LDS_WAIT(); asm volatile("" ::: "memory");
}
struct F8Item { const GAS float* W; int ldw; const GAS float* gain; GAS unsigned char* WT8; int ldkB, k0, n0src, n0dst; };
__device__ __forceinline__ void tr_load64(f32x4 (&v)[16], float (&gn)[16], const F8Item& I, int lane) {
    const int rr = lane >> 4, c4 = (lane & 15) * 4;
#pragma unroll
    for (int i = 0; i < 16; ++i) gn[i] = I.gain ? I.gain[I.k0 + 4 * i + rr] : 1.f;
#pragma unroll
    for (int i = 0; i < 16; ++i) v[i] = __builtin_nontemporal_load((const GAS f32x4*)(I.W + (size_t)(I.k0 + 4 * i + rr) * I.ldw + I.n0src + c4));
}
__device__ __forceinline__ void tr_finish64_f8(const f32x4 (&v)[16], const float (&gn)[16], const F8Item& I, float scale, LAS float* scr, int lane) {
    const int rr = lane >> 4, c4 = (lane & 15) * 4;
#pragma unroll
    for (int i = 0; i < 16; ++i) { const int k = 4 * i + rr; const float g = gn[i] * scale; LAS float* d = scr + k * 65 + c4;
        d[0] = v[i][0] * g; d[1] = v[i][1] * g; d[2] = v[i][2] * g; d[3] = v[i][3] * g; }
    LDS_WAIT(); asm volatile("" ::: "memory");
    const int kc = lane & 7;
#pragma unroll
    for (int j = 0; j < 8; ++j) { const int n = (lane >> 3) + 8 * j; const LAS float* sp = scr + (8 * kc) * 65 + n;
        u32x2 o; o.x = pk4_fp8(sp[0 * 65], sp[1 * 65], sp[2 * 65], sp[3 * 65]); o.y = pk4_fp8(sp[4 * 65], sp[5 * 65], sp[6 * 65], sp[7 * 65]);
        *(GAS u32x2*)(I.WT8 + (size_t)(I.n0dst + n) * I.ldkB + I.k0 + 8 * kc) = o; }
    LDS_WAIT(); asm volatile("" ::: "memory");
}
__device__ __forceinline__ int rope_dim(int p) { const int a = p >> 3, j = p & 7; return j < 4 ? 4 * a + j : 16 + 4 * a + (j - 4); }

#define LDP(i) ((void*)((((unsigned long long)(unsigned)__builtin_amdgcn_readfirstlane((int)(ARGP[i] >> 32))) << 32) | (unsigned long long)(unsigned)__builtin_amdgcn_readfirstlane((int)(unsigned)ARGP[i])))
#define ARGIN(i) ((const void*)LDP(i))
#define P_COS ((GAS float*)(ws + WS_COS))
#define P_SIN ((GAS float*)(ws + WS_SIN))
#define P_SSQ ((GAS float*)(ws + WS_SSQ))
#define P_FLOG ((GAS float*)(ws + WS_FLOG))
#define P_E01 ((GAS int*)(ws + WS_E01))
#define P_G01 ((GAS float*)(ws + WS_G01))
#define P_SLOT ((GAS int*)(ws + WS_SLOT))
#define P_TOKOF ((GAS int*)(ws + WS_TOKOF))
#define P_GATEOF ((GAS float*)(ws + WS_GATEOF))
#define P_CNT ((GAS int*)(ws + WS_CNT))
#define P_TSTART ((GAS int*)(ws + WS_TSTART))
#define P_RSTD ((GAS float*)(ws + WS_RSTD))
#define P_RSTDOF ((GAS float*)(ws + WS_RSTDOF))
#define P_KPE ((GAS bf16*)(ws + WS_KPE))
#define P_KAUG ((GAS bf16*)(ws + WS_KAUG))
#define P_BIASF ((GAS float*)(ws + WS_BIASF))
#define P_NRM ((GAS float*)(ws + WS_NRM))
#define P_WR_L(l) ((GAS bf16*)(ws + ((l) ? WS_W1 + 7 * MiB : WS_WR)))
#define P_XR ((GAS bf16*)(ws + WS_XR))
#define P_OSS ((GAS float*)(ws + WS_OSS))
#define P_RSTDX ((GAS float*)(ws + WS_RSTDX))
#define P_WIN_L(l) ((GAS bf16*)(ws + ((l) ? WS_W1 : WS_WIN)))
#define P_WUQ_L(l) ((GAS bf16*)(ws + ((l) ? WS_W1 + 4 * MiB : WS_WUQ)))
#define P_WUKV_L(l) ((GAS bf16*)(ws + ((l) ? WS_W1 + 4 * MiB + 512 * KiB : WS_WUKV)))
#define P_WOUT_L(l) ((GAS bf16*)(ws + ((l) ? WS_W1 + 5 * MiB : WS_WOUT)))
#define P_WGU_L(ll) ((GAS unsigned char*)(ws + WS_WGU + (size_t)((ll) & 1) * 32 * MiB))
#define P_WD_L(ll) ((GAS unsigned char*)(ws + WS_WD + (size_t)((ll) & 1) * 16 * MiB))
#define P_XN ((GAS bf16*)(ws + WS_XN))
#define P_FQKV ((GAS bf16*)(ws + WS_FQKV))
#define P_HH ((GAS bf16*)(ws + WS_FQKV))
#define P_LAT ((GAS bf16*)(ws + WS_LAT))
#define P_QM ((GAS bf16*)(ws + WS_QM))
#define P_KVM ((GAS bf16*)(ws + WS_KVM))
#define P_Y ((GAS bf16*)(ws + WS_Y))
#define IN(k) (lo <= (k) && (k) < hi_)
#if MK_ONE_LAUNCH
#define GRID_BAR() xcd_barrier(bar)
#else
#define GRID_BAR() do {} while (0)
#endif
#define SEAM(k) do { if (IN(k) && IN((k) + 1)) GRID_BAR(); } while (0)
#if MK_ONE_LAUNCH
#define GROUP_BAR() xcd_barrier(gbar)
#else
#define GROUP_BAR() do {} while (0)
#endif
#define SEAMG(k) do { if (IN(k) && IN((k) + 1)) GROUP_BAR(); } while (0)
__device__ __forceinline__ void conv_gu_item(int r, const GAS float* w_gate, const GAS float* w_up, const GAS float* ffn_norm, GAS unsigned char* WGU, LAS float* scr64, int lane) {
    const int e = r / 256, q = r % 256, kb = q / 16, nb = q % 16; const int n0 = nb * 64; const int ct = n0 >> 8, which = (n0 >> 7) & 1, jj = n0 & 127;
    const GAS float* src = (which ? w_up : w_gate) + (size_t)e * DM * DEXP;
    tr_item64_f8(src, DEXP, ffn_norm, WSCALE, WGU + (size_t)e * 1024 * 1024, DM, kb * 64, ct * 128 + jj, n0, scr64, lane);
}
__device__ __forceinline__ F8Item gu_item(int r, const GAS float* w_gate, const GAS float* w_up, const GAS float* ffn_norm, GAS unsigned char* WGU) {
    const int e = r / 256, q = r % 256, kb = q / 16, nb = q % 16; const int n0 = nb * 64; const int ct = n0 >> 8, which = (n0 >> 7) & 1, jj = n0 & 127;
    return F8Item{(which ? w_up : w_gate) + (size_t)e * DM * DEXP, DEXP, ffn_norm, WGU + (size_t)e * 1024 * 1024, DM, kb * 64, ct * 128 + jj, n0};
}
__device__ __forceinline__ F8Item d_item(int r, const GAS float* w_down, GAS unsigned char* WD) {
    const int e = r / 128, q = r % 128, kb = q / 16, nb = q % 16;
    return F8Item{w_down + (size_t)e * DEXP * DM, DM, nullptr, WD + (size_t)e * 1024 * 512, DEXP, kb * 64, nb * 64, nb * 64};
}
__device__ __forceinline__ void conv_d_item(int r, const GAS float* w_down, GAS unsigned char* WD, LAS float* scr64, int lane) {
    const int e = r / 128, q = r % 128, kb = q / 16, nb = q % 16;
    tr_item64_f8(w_down + (size_t)e * DEXP * DM, DM, nullptr, WSCALE, WD + (size_t)e * 1024 * 512, DEXP, kb * 64, nb * 64, nb * 64, scr64, lane);
}
__device__ __forceinline__ void conv_experts_l0(LAS unsigned char* lds0, const int wave0, const int G0, const int bx0) {
    unsigned ldsb_ = (unsigned)(uintptr_t)lds0; asm volatile("" : "+s"(ldsb_)); LAS unsigned char* lds = (LAS unsigned char*)(uintptr_t)ldsb_; volatile LAS unsigned long long* ARGP = (volatile LAS unsigned long long*)(lds + MISC_OFF + 768);
    int wave = wave0, G = G0, bx = bx0; asm volatile("" : "+s"(G), "+s"(bx), "+s"(wave)); const int lane = (int)__builtin_amdgcn_mbcnt_hi(~0u, __builtin_amdgcn_mbcnt_lo(~0u, 0u)); const int vcu = (bx % 8) * (G / 8) + bx / 8;
    GAS unsigned char* ws = (GAS unsigned char*)LDP(22);
    LAS float* scr64 = (LAS float*)(lds + wave * 16640);
    const GAS float* ffn_norm = (const GAS float*)ARGIN(12);
    const GAS float* w_gate = (const GAS float*)ARGIN(17); const GAS float* w_up = (const GAS float*)ARGIN(18); const GAS float* w_down = (const GAS float*)ARGIN(19);
    constexpr int J_GU = 16 * 16 * NEXP, J_D = 8 * 16 * NEXP;
    asm volatile("s_waitcnt vmcnt(0)" ::: "memory"); __syncthreads();
    static_assert(J_GU == 256 * 8 * 4 && J_D == 256 * 8 * 2, "six items per wave");
    const int it0 = vcu + G * wave;
    f32x4 va[16], vb[16]; float ga[16], gb[16];
    const F8Item I0 = gu_item(it0, w_gate, w_up, ffn_norm, P_WGU_L(0)); tr_load64(va, ga, I0, lane);
    const F8Item I1 = gu_item(it0 + G * 8, w_gate, w_up, ffn_norm, P_WGU_L(0)); tr_load64(vb, gb, I1, lane); tr_finish64_f8(va, ga, I0, WSCALE, scr64, lane);
    const F8Item I2 = gu_item(it0 + G * 16, w_gate, w_up, ffn_norm, P_WGU_L(0)); tr_load64(va, ga, I2, lane); tr_finish64_f8(vb, gb, I1, WSCALE, scr64, lane);
    const F8Item I3 = gu_item(it0 + G * 24, w_gate, w_up, ffn_norm, P_WGU_L(0)); tr_load64(vb, gb, I3, lane); tr_finish64_f8(va, ga, I2, WSCALE, scr64, lane);
    const F8Item I4 = d_item(it0 + G * 32 - J_GU, w_down, P_WD_L(0)); tr_load64(va, ga, I4, lane); tr_finish64_f8(vb, gb, I3, WSCALE, scr64, lane);
    const F8Item I5 = d_item(it0 + G * 40 - J_GU, w_down, P_WD_L(0)); tr_load64(vb, gb, I5, lane); tr_finish64_f8(va, ga, I4, WSCALE, scr64, lane);
    tr_finish64_f8(vb, gb, I5, WSCALE, scr64, lane);
    __syncthreads();
}
#define CONV_SLOT(k, sl) do { if constexpr (l == 0) { if (IN(P + (k)) && ((((bx0 % 8) * (G0 / 8) + bx0 / 8) >> 4) & 1) == (sl)) conv_experts_l0(lds0, wave0, G0, bx0); } } while (0)
template <int l>
__device__ __forceinline__ void layer_body(const int lo, const int hi_, LAS unsigned char* lds0, const int wave0, const int G0, const int bx0, const XcdBarrier& bar, const XcdBarrier& gbar) {
        const int P = 10 * l;
        if (IN(P)) for (int rep_ = 0; rep_ < (l == 0 ? NREP(0) : 1); ++rep_) {
            unsigned ldsb_ = (unsigned)(uintptr_t)lds0; asm volatile("" : "+s"(ldsb_)); LAS unsigned char* lds = (LAS unsigned char*)(uintptr_t)ldsb_; volatile LAS unsigned* MISC = (volatile LAS unsigned*)(lds + MISC_OFF); volatile LAS unsigned long long* ARGP = (volatile LAS unsigned long long*)(lds + MISC_OFF + 768); (void)MISC; int wave = wave0, G = G0, bx = bx0; asm volatile("" : "+s"(G), "+s"(bx), "+s"(wave)); const int lane = (int)__builtin_amdgcn_mbcnt_hi(~0u, __builtin_amdgcn_mbcnt_lo(~0u, 0u)); const int tid = wave * 64 + lane; const int vcu = (bx % 8) * (G / 8) + bx / 8; const int gw = vcu * 8 + wave, NGW = G * 8; (void)lane; (void)gw; (void)NGW; (void)vcu;
            GAS unsigned char* ws = (GAS unsigned char*)LDP(22); GAS float* out = (GAS float*)LDP(21); const GAS float* x_in = (const GAS float*)ARGIN(0); const GAS int* positions = (const GAS int*)ARGIN(1);
            if constexpr (l == 0) {
                LAS float* scr = (LAS float*)(lds + wave * 16640);
                constexpr int I_IN = 16 * 64, I_UQ = 4 * 24, I_UKV = 4 * 32, J_OUT = 16 * 16;
                constexpr int NITEMS = I_IN + I_UQ + I_UKV + J_OUT;
                for (int it = vcu + G * wave; it < NLAYER * NITEMS; it += NGW) {
                    const int lw = it / NITEMS; int r = it % NITEMS; const int j = lane & 31;
                    if (r < I_IN) { const GAS float* attn_norm = (const GAS float*)ARGIN(2) + (size_t)lw * DM; const GAS float* w_in = (const GAS float*)ARGIN(3) + (size_t)lw * DM * INW;
                        const int kb = r / 64, nb = r % 64; const int n = nb * 32 + j; int sc;
                        if (n < 384) sc = n; else if (n < 416) sc = 384 + rope_dim(n - 384); else if (n < 424) sc = 1952 + (n - 416); else if (n < 512) sc = -1; else sc = 416 + (n - 512);
                        tr_item(w_in, INW, DM, attn_norm, P_WIN_L(lw), DM, kb * 64, nb * 32, sc, scr, lane); continue; } r -= I_IN;
                    if (r < I_UQ) { const GAS float* q_norm = (const GAS float*)ARGIN(5) + (size_t)lw * 256; const GAS float* w_uq = (const GAS float*)ARGIN(6) + (size_t)lw * 256 * 768;
                        const int kb = r / 24, nb = r % 24; const int n = nb * 32 + j; const int hh = n / 96, d = n % 96; const int sc = d < 64 ? n : hh * 96 + 64 + rope_dim(d - 64);
                        tr_item(w_uq, 768, 256, q_norm, P_WUQ_L(lw), 256, kb * 64, nb * 32, sc, scr, lane); continue; } r -= I_UQ;
                    if (r < I_UKV) { const GAS float* kv_norm = (const GAS float*)ARGIN(7) + (size_t)lw * 128; const GAS float* w_ukv = (const GAS float*)ARGIN(8) + (size_t)lw * 128 * 1024;
                        const int kb = r / 32, nb = r % 32; tr_item(w_ukv, 1024, 128, kv_norm, P_WUKV_L(lw), 256, kb * 64, nb * 32, nb * 32 + j, scr, lane); continue; } r -= I_UKV;
                    { const GAS float* mla_on = (const GAS float*)ARGIN(9) + (size_t)lw * 512; const GAS float* fox_on = (const GAS float*)ARGIN(10) + (size_t)lw * 512; const GAS float* w_out = (const GAS float*)ARGIN(11) + (size_t)lw * DM * DM;
                        const int kb = r / 16, nb = r % 16; const GAS float* gn = kb < 8 ? mla_on : fox_on - 512; tr_item64(w_out, DM, gn, P_WOUT_L(lw), DM, kb * 64, nb * 64, nb * 64, scr, lane); }
                }
                for (int lw = 0; lw < NLAYER; ++lw) { const GAS float* ffn_norm = (const GAS float*)ARGIN(12) + (size_t)lw * DM; const GAS float* w_rg = (const GAS float*)ARGIN(13) + (size_t)lw * DM * 4; const GAS float* w_re = (const GAS float*)ARGIN(15) + (size_t)lw * DM * 32;
                  for (int idx = bx * 512 + tid; idx < 2 * 48 * 520; idx += G * 512) { const int half = idx / (48 * 520), r = idx % (48 * 520), c = r / 520, kk = r % 520; const int k = half * 512 + kk;
                      float w = 0.f; if (c < 36 && kk < 512) w = ffn_norm[k] * (c < 4 ? w_rg[k * 4 + c] : w_re[k * 32 + (c - 4)]);
                      const unsigned h16 = cvt_pk_bf16(w, 0.f) & 0xffffu; const unsigned l16 = cvt_pk_bf16(w - __uint_as_float(h16 << 16), 0.f) & 0xffffu;
                      P_WR_L(lw)[(size_t)(half * 2 + 0) * 48 * 520 + r] = (bf16)h16; P_WR_L(lw)[(size_t)(half * 2 + 1) * 48 * 520 + r] = (bf16)l16; } }
            }
            const GAS float* fin = (const GAS float*)ARGIN(20);
            for (int mb = vcu * 128 + wave * 16; mb < vcu * 128 + wave * 16 + 16; mb += 4) {
                f32x4 v[4][4]; int s0[4], s1[4];
                if (l > 0) {
#pragma unroll
                    for (int r = 0; r < 4; ++r) { s0[r] = P_SLOT[2 * (mb + r)]; s1[r] = P_SLOT[2 * (mb + r) + 1]; }
                }
#pragma unroll
                for (int r = 0; r < 4; ++r) {
                    if (l == 0) { const GAS float* xr = x_in + (size_t)(mb + r) * DM;
#pragma unroll
                        for (int j = 0; j < 4; ++j) v[r][j] = __builtin_nontemporal_load((const GAS f32x4*)(xr + 4 * lane + 256 * j)); }
                    else { const GAS bf16* xr = P_XR + (size_t)(mb + r) * DM;
#pragma unroll
                        for (int j = 0; j < 4; ++j) { const u32x2 w = __builtin_nontemporal_load((const GAS u32x2*)(xr + 4 * lane + 256 * j)); v[r][j] = (f32x4){__uint_as_float(w.x << 16), __uint_as_float(w.x & 0xffff0000u), __uint_as_float(w.y << 16), __uint_as_float(w.y & 0xffff0000u)}; } } }
                if (l > 0) {
#pragma unroll
                    for (int r = 0; r < 4; ++r)
#pragma unroll
                        for (int j = 0; j < 4; ++j) { const int a = __builtin_nontemporal_load((const GAS int*)((const GAS unsigned char*)P_Y + (size_t)s0[r] * 1024 + 4 * lane + 256 * j)), c = __builtin_nontemporal_load((const GAS int*)((const GAS unsigned char*)P_Y + (size_t)s1[r] * 1024 + 4 * lane + 256 * j));
                            const f32x2 a0 = __builtin_amdgcn_cvt_pk_f32_fp8(a, false), a1 = __builtin_amdgcn_cvt_pk_f32_fp8(a, true), c0 = __builtin_amdgcn_cvt_pk_f32_fp8(c, false), c1 = __builtin_amdgcn_cvt_pk_f32_fp8(c, true);
                            v[r][j][0] += (a0[0] + c0[0]) * WSCALE_INV; v[r][j][1] += (a0[1] + c0[1]) * WSCALE_INV; v[r][j][2] += (a1[0] + c1[0]) * WSCALE_INV; v[r][j][3] += (a1[1] + c1[1]) * WSCALE_INV; }
                }
                float ss[4];
#pragma unroll
                for (int r = 0; r < 4; ++r) { float s = 0.f;
#pragma unroll
                    for (int j = 0; j < 4; ++j) s += (v[r][j][0] * v[r][j][0] + v[r][j][1] * v[r][j][1]) + (v[r][j][2] * v[r][j][2] + v[r][j][3] * v[r][j][3]);
                    ss[r] = s; }
#pragma unroll
                for (int o = 1; o < 64; o <<= 1) {
#pragma unroll
                    for (int r = 0; r < 4; ++r) ss[r] += __shfl_xor(ss[r], o); }
#pragma unroll
                for (int r = 0; r < 4; ++r) { const int m = mb + r; const float rstd = rsqrtf(ss[r] * (1.f / DM) + EPS);
                    if (l < NLAYER) {
#pragma unroll
                        for (int j = 0; j < 4; ++j) { u32x2 w; w.x = cvt_pk_bf16(v[r][j][0], v[r][j][1]); w.y = cvt_pk_bf16(v[r][j][2], v[r][j][3]); *(GAS u32x2*)(P_XR + (size_t)m * DM + 4 * lane + 256 * j) = w; }
                        if (lane == 0) P_RSTDX[m] = rstd;
                    } else {
#pragma unroll
                        for (int j = 0; j < 4; ++j) { const f32x4 g = *(const GAS f32x4*)(fin + 4 * lane + 256 * j); __builtin_nontemporal_store(v[r][j] * rstd * g, (GAS f32x4*)(out + (size_t)m * DM + 4 * lane + 256 * j)); }
                    }
                }
            }
        }
        if constexpr (l == NLAYER) return;
        SEAM(P);
        if (IN(P + 1)) for (int rep_ = 0; rep_ < ((l == 0 || 1 != 5) ? NREP(1) : 1); ++rep_) {
            unsigned ldsb_ = (unsigned)(uintptr_t)lds0; asm volatile("" : "+s"(ldsb_)); LAS unsigned char* lds = (LAS unsigned char*)(uintptr_t)ldsb_; volatile LAS unsigned* MISC = (volatile LAS unsigned*)(lds + MISC_OFF); volatile LAS unsigned long long* ARGP = (volatile LAS unsigned long long*)(lds + MISC_OFF + 768); (void)MISC; int wave = wave0, G = G0, bx = bx0; asm volatile("" : "+s"(G), "+s"(bx), "+s"(wave)); const int lane = (int)__builtin_amdgcn_mbcnt_hi(~0u, __builtin_amdgcn_mbcnt_lo(~0u, 0u)); const int tid = wave * 64 + lane; const int vcu = (bx % 8) * (G / 8) + bx / 8; const int gw = vcu * 8 + wave, NGW = G * 8; (void)lane; (void)gw; (void)NGW; (void)vcu;
            GAS unsigned char* ws = (GAS unsigned char*)LDP(22); GAS float* out = (GAS float*)LDP(21); const GAS float* x_in = (const GAS float*)ARGIN(0); (void)out; (void)x_in; (void)ws;
            BatchOrder S{INP / 256, vcu, (const GAS char*)P_XR, (const GAS char*)P_WIN_L(l), (size_t)256 * DM * 2, (size_t)256 * DM * 2};
            EpiWin E{P_LAT, P_FQKV, P_KPE, P_FLOG, P_SSQ, P_COS, P_SIN, P_RSTDX};
            pg8::gemm_phase<EpiWin, BatchOrder, true, false>(tid, lds, DM * 2, DM * 2, DM * 2, S, E, nullptr);
        }
        SEAMG(P + 1);
        if (IN(P + 2)) for (int rep_ = 0; rep_ < ((l == 0 || 2 != 5) ? NREP(2) : 1); ++rep_) {
            unsigned ldsb_ = (unsigned)(uintptr_t)lds0; asm volatile("" : "+s"(ldsb_)); LAS unsigned char* lds = (LAS unsigned char*)(uintptr_t)ldsb_; volatile LAS unsigned* MISC = (volatile LAS unsigned*)(lds + MISC_OFF); volatile LAS unsigned long long* ARGP = (volatile LAS unsigned long long*)(lds + MISC_OFF + 768); (void)MISC; int wave = wave0, G = G0, bx = bx0; asm volatile("" : "+s"(G), "+s"(bx), "+s"(wave)); const int lane = (int)__builtin_amdgcn_mbcnt_hi(~0u, __builtin_amdgcn_mbcnt_lo(~0u, 0u)); const int tid = wave * 64 + lane; const int vcu = (bx % 8) * (G / 8) + bx / 8; const int gw = vcu * 8 + wave, NGW = G * 8; (void)lane; (void)gw; (void)NGW; (void)vcu;
            GAS unsigned char* ws = (GAS unsigned char*)LDP(22); GAS float* out = (GAS float*)LDP(21); const GAS float* x_in = (const GAS float*)ARGIN(0); (void)out; (void)x_in; (void)ws;
            {
                const int sq = vcu >> 1, hf = vcu & 1; const int b = sq >> 3, h = sq & 7; const float bf = ((const GAS float*)ARGIN(4))[l * 8 + h];
                const GAS float* fl = P_FLOG + ((size_t)b * SEQ + hf * 1024 + 2 * tid) * 8 + h;
                float lf[2], lg[2] = {0.f, 0.f};
#pragma unroll
                for (int e = 0; e < 2; ++e) { const float f = fl[e * 8] + bf; lf[e] = fminf(f, 0.f) - log1pf(expf(-fabsf(f))); }
                if (hf) {
#pragma unroll
                    for (int e = 0; e < 2; ++e) { const float f = fl[e * 8 - 1024 * 8] + bf; lg[e] = fminf(f, 0.f) - log1pf(expf(-fabsf(f))); } }
                const double s2 = (double)lf[0] + (double)lf[1];
                double incl = s2, first = (double)lg[0] + (double)lg[1];
#pragma unroll
                for (int o = 1; o < 64; o <<= 1) { const double t = __shfl_up(incl, o); if (lane >= o) incl += t; first += __shfl_xor(first, o); }
                LAS double* wtot = (LAS double*)lds;
                if (lane == 63) wtot[wave] = incl;
                if (lane == 0) wtot[8 + wave] = first;
                __syncthreads();
                double c = incl - s2;
                for (int w = 0; w < wave; ++w) c += wtot[w];
                if (hf) { for (int w = 0; w < 8; ++w) c += wtot[8 + w]; }
                const size_t t0 = ((size_t)b * 8 + h) * SEQ + hf * 1024 + 2 * tid;
                GAS u32x4* ka = (GAS u32x4*)(P_KAUG + t0 * 8);
                float xs[2];
#pragma unroll
                for (int e = 0; e < 2; ++e) { c += (double)lf[e]; const float x = (float)(-c * 1.4426950408889634); xs[e] = x;
                    const unsigned h16 = cvt_pk_bf16(x, 0.f) & 0xffffu; const float r1 = x - __uint_as_float(h16 << 16); const unsigned m16 = cvt_pk_bf16(r1, 0.f) & 0xffffu; const float r2 = r1 - __uint_as_float(m16 << 16); const unsigned l16 = cvt_pk_bf16(r2, 0.f) & 0xffffu;
                    ka[e] = (u32x4){h16 | (m16 << 16), l16, 0u, 0u}; P_BIASF[t0 + e] = x; }
                float qn = 0.f, kn = 0.f, xdm = INFINITY;
                { const GAS bf16* fqp = P_FQKV + ((size_t)b * SEQ + hf * 1024 + 2 * tid) * 512 + h * 64; const GAS bf16* fkp = fqp + (size_t)NTOK * 512;
#pragma unroll
                  for (int e = 0; e < 2; ++e) { float sq_ = 0.f, sk = 0.f, dd = 0.f;
#pragma unroll
                      for (int c8 = 0; c8 < 8; ++c8) { const u32x4 a = *(const GAS u32x4*)(fqp + e * 512 + c8 * 8), k4 = *(const GAS u32x4*)(fkp + e * 512 + c8 * 8);
#pragma unroll
                          for (int j = 0; j < 4; ++j) { const float a0 = __uint_as_float(a[j] << 16), a1 = __uint_as_float(a[j] & 0xffff0000u), k0 = __uint_as_float(k4[j] << 16), k1 = __uint_as_float(k4[j] & 0xffff0000u);
                              sq_ += a0 * a0 + a1 * a1; sk += k0 * k0 + k1 * k1; dd += a0 * k0 + a1 * k1; } }
                      qn = fmaxf(qn, sq_); kn = fmaxf(kn, sk); xdm = fminf(xdm, xs[e] + dd); } }
#pragma unroll
                for (int o = 1; o < 64; o <<= 1) { qn = fmaxf(qn, __shfl_xor(qn, o)); kn = fmaxf(kn, __shfl_xor(kn, o)); xdm = fminf(xdm, __shfl_xor(xdm, o)); }
                LAS float* knw = (LAS float*)(lds + 256);
                if (lane == 0) { knw[wave] = kn; knw[8 + wave] = qn; knw[16 + wave] = xdm; }
                __syncthreads();
                if (tid < 4) { P_NRM[sq * 32 + hf * 4 + tid] = sqrtf(fmaxf(knw[8 + 2 * tid], knw[8 + 2 * tid + 1])); P_NRM[sq * 32 + 16 + hf * 4 + tid] = fminf(knw[16 + 2 * tid], knw[16 + 2 * tid + 1]); }
                if (tid == 4) { float m = knw[0]; for (int w = 1; w < 8; ++w) m = fmaxf(m, knw[w]); P_NRM[sq * 32 + 8 + hf] = sqrtf(m); }
                __syncthreads();
            }
            UpOrder S{vcu, (const GAS char*)P_LAT, (const GAS char*)P_WUQ_L(l), (const GAS char*)P_WUKV_L(l)};
            EpiUp E{P_QM, P_KVM, P_SSQ, P_COS, P_SIN};
            pg8::gemm_phase<EpiUp, UpOrder, true, false, false, false, true>(tid, lds, 256 * 2, 512 * 2, 256 * 2, S, E, nullptr);
        }
        SEAMG(P + 2);
        CONV_SLOT(3, 0);
        if (IN(P + 3)) for (int rep_ = 0; rep_ < ((l == 0 || 3 != 5) ? NREP(3) : 1); ++rep_) {
            unsigned ldsb_ = (unsigned)(uintptr_t)lds0; asm volatile("" : "+s"(ldsb_)); LAS unsigned char* lds = (LAS unsigned char*)(uintptr_t)ldsb_; volatile LAS unsigned* MISC = (volatile LAS unsigned*)(lds + MISC_OFF); volatile LAS unsigned long long* ARGP = (volatile LAS unsigned long long*)(lds + MISC_OFF + 768); (void)MISC; int wave = wave0, G = G0, bx = bx0; asm volatile("" : "+s"(G), "+s"(bx), "+s"(wave)); const int lane = (int)__builtin_amdgcn_mbcnt_hi(~0u, __builtin_amdgcn_mbcnt_lo(~0u, 0u)); const int tid = wave * 64 + lane; const int vcu = (bx % 8) * (G / 8) + bx / 8; const int gw = vcu * 8 + wave, NGW = G * 8; (void)lane; (void)gw; (void)NGW; (void)vcu;
            GAS unsigned char* ws = (GAS unsigned char*)LDP(22); GAS float* out = (GAS float*)LDP(21); const GAS float* x_in = (const GAS float*)ARGIN(0); (void)out; (void)x_in; (void)ws;
            GAS bf16* O = P_XN;
            const int b = vcu >> 4, hh = (vcu & 15) >> 1, sub = vcu & 1;
            const att::Tens2 TM{P_QM, 768, P_KVM, 1024, P_KPE, P_KVM + 64, 1024, O, nullptr, nullptr, P_OSS};
            const att::Tens2 TF{P_FQKV, 512, P_FQKV + (size_t)NTOK * 512, 512, P_KAUG, P_FQKV + (size_t)2 * NTOK * 512, 512, O, P_BIASF, P_NRM, P_OSS};
#define QB_OF(i) ((((i) & 1) ? 7 - (2 * sub + ((i) >> 1)) : (2 * sub + ((i) >> 1))))
            int ts0, ts1, ts2, ts3;
            { const GAS float* bs = P_BIASF + ((long)b * 8 + hh) * SEQ; const GAS float* nr = P_NRM + (b * 8 + hh) * 32; const float kmx = fmaxf(nr[8], nr[9]);
#define FOX_TS(i, dst) do { const int qb_ = QB_OF(i), NT_ = 4 * qb_ + 4; const float Z_ = nr[qb_] * kmx * 1.001f + 0.01f; const float bend_ = bs[(lane < NT_ ? lane : NT_ - 1) * 64 + 63]; \
                  const bool skip_ = (lane < NT_ - 4) && (Z_ + bend_ - nr[16 + qb_] < -32.f); dst = __builtin_popcountll(__ballot(skip_)); } while (0)
              FOX_TS(0, ts0); FOX_TS(1, ts1); FOX_TS(2, ts2); FOX_TS(3, ts3);
#undef FOX_TS
            }
            if (wave >= 4) __builtin_amdgcn_s_setprio(1);
            bf16x8 qreg[6];
            { int sb = 0; for (int i = 0; i < 4; ++i) sb = att::attn_unit2<1>(wave, b, hh, QB_OF(i), TM, (LAS char*)lds, sb, i > 0, i < 3 ? QB_OF(i + 1) : -1, qreg, 0); }
            if constexpr (l == 0) { if ((b & 1) == 1) { __builtin_amdgcn_s_setprio(0); conv_experts_l0(lds0, wave0, G0, bx0); if (wave >= 4) __builtin_amdgcn_s_setprio(1); } }
            { int sb = 0; for (int i = 0; i < 4; ++i) { const int ts = i == 0 ? ts0 : i == 1 ? ts1 : i == 2 ? ts2 : ts3; sb = att::attn_unit2<0>(wave, b, hh, QB_OF(i), TF, (LAS char*)lds, sb, i > 0, i < 3 ? QB_OF(i + 1) : -1, qreg, ts); } }
#undef QB_OF
            __builtin_amdgcn_s_setprio(0);
        }
        SEAMG(P + 3);
        if (IN(P + 5)) for (int rep_ = 0; rep_ < ((l == 0 || 5 != 5) ? NREP(5) : 1); ++rep_) {
            unsigned ldsb_ = (unsigned)(uintptr_t)lds0; asm volatile("" : "+s"(ldsb_)); LAS unsigned char* lds = (LAS unsigned char*)(uintptr_t)ldsb_; volatile LAS unsigned* MISC = (volatile LAS unsigned*)(lds + MISC_OFF); volatile LAS unsigned long long* ARGP = (volatile LAS unsigned long long*)(lds + MISC_OFF + 768); (void)MISC; int wave = wave0, G = G0, bx = bx0; asm volatile("" : "+s"(G), "+s"(bx), "+s"(wave)); const int lane = (int)__builtin_amdgcn_mbcnt_hi(~0u, __builtin_amdgcn_mbcnt_lo(~0u, 0u)); const int tid = wave * 64 + lane; const int vcu = (bx % 8) * (G / 8) + bx / 8; const int gw = vcu * 8 + wave, NGW = G * 8; (void)lane; (void)gw; (void)NGW; (void)vcu;
            GAS unsigned char* ws = (GAS unsigned char*)LDP(22); GAS float* out = (GAS float*)LDP(21); const GAS float* x_in = (const GAS float*)ARGIN(0); (void)out; (void)x_in; (void)ws;
            BatchOrder S{DM / 256, vcu, (const GAS char*)P_XN, (const GAS char*)P_WOUT_L(l), (size_t)256 * DM * 2, (size_t)256 * DM * 2};
            EpiOut<false> E{x_in, P_XR};
            LAS f32x2* scl = (LAS f32x2*)(lds + pg8::STAGE_BYTES);
            { Unit u_; if (S.next(tid >> 8, u_)) { const GAS float* op = P_OSS + ((size_t)u_.pm * 256 + (tid & 255)) * 16;
                  const f32x4 a0 = *(const GAS f32x4*)op, a1 = *(const GAS f32x4*)(op + 4), c0 = *(const GAS f32x4*)(op + 8), c1 = *(const GAS f32x4*)(op + 12);
                  const float sm = ((a0[0] + a0[1]) + (a0[2] + a0[3])) + ((a1[0] + a1[1]) + (a1[2] + a1[3])), sf = ((c0[0] + c0[1]) + (c0[2] + c0[3])) + ((c1[0] + c1[1]) + (c1[2] + c1[3]));
                  const float rm_ = rsqrtf(sm * (1.f / 512.f) + EPS), rf_ = rsqrtf(sf * (1.f / 512.f) + EPS);
                  scl[tid] = (f32x2){rm_ / rf_, rf_}; } }
            __syncthreads();
            pg8::gemm_phase<EpiOut<false>, BatchOrder, true, false, false, true>(tid, lds, DM * 2, DM * 2, DM * 2, S, E, nullptr, scl);
        }
        SEAMG(P + 5);
        if (IN(P + 6)) for (int rep_ = 0; rep_ < ((l == 0 || 6 != 5) ? NREP(6) : 1); ++rep_) {
            unsigned ldsb_ = (unsigned)(uintptr_t)lds0; asm volatile("" : "+s"(ldsb_)); LAS unsigned char* lds = (LAS unsigned char*)(uintptr_t)ldsb_; volatile LAS unsigned* MISC = (volatile LAS unsigned*)(lds + MISC_OFF); volatile LAS unsigned long long* ARGP = (volatile LAS unsigned long long*)(lds + MISC_OFF + 768); (void)MISC; int wave = wave0, G = G0, bx = bx0; asm volatile("" : "+s"(G), "+s"(bx), "+s"(wave)); const int lane = (int)__builtin_amdgcn_mbcnt_hi(~0u, __builtin_amdgcn_mbcnt_lo(~0u, 0u)); const int tid = wave * 64 + lane; const int vcu = (bx % 8) * (G / 8) + bx / 8; const int gw = vcu * 8 + wave, NGW = G * 8; (void)lane; (void)gw; (void)NGW; (void)vcu;
            GAS unsigned char* ws = (GAS unsigned char*)LDP(22); GAS float* out = (GAS float*)LDP(21); const GAS float* x_in = (const GAS float*)ARGIN(0); (void)out; (void)x_in; (void)ws;
            GAS bf16* H2 = P_XN;
            LAS bf16* WT = (LAS bf16*)lds;
            LAS float* LG = (LAS float*)(lds + 99840) + wave * 576;
            const GAS float* b_rg = (const GAS float*)ARGIN(14) + l * 4; const GAS float* b_re = (const GAS float*)ARGIN(16) + l * 32;
            if (tid < 32) MISC[64 + tid] = 0u;
            const int r16 = lane & 15, g4 = lane >> 4;
            const int m0 = vcu * 128 + wave * 16;
            const GAS bf16* xrow = P_XR + (size_t)(m0 + r16) * DM + 8 * g4;
            GAS unsigned char* hrow = (GAS unsigned char*)H2 + (size_t)(m0 + r16) * DM + 8 * g4;
            f32x4 acc3[3]; acc3[0] = (f32x4){0.f, 0.f, 0.f, 0.f}; acc3[1] = acc3[0]; acc3[2] = acc3[0];
            float ssq = 0.f;
            for (int half = 0; half < 2; ++half) {
                __syncthreads();
                for (int idx = tid; idx < 2 * 48 * 520 / 8; idx += 512) *(LAS u32x4*)(WT + 8 * idx) = *(const GAS u32x4*)(P_WR_L(l) + (size_t)half * 2 * 48 * 520 + 8 * idx);
                __syncthreads();
                for (int s8 = 0; s8 < 16; s8 += 8) {
                    bf16x8 xv[8];
#pragma unroll
                    for (int u = 0; u < 8; ++u) xv[u] = *(const GAS bf16x8*)(xrow + half * 512 + 32 * (s8 + u));
#pragma unroll
                    for (int u = 0; u < 8; ++u) {
                        const u32x4 xw = __builtin_bit_cast(u32x4, xv[u]); float xf[8];
#pragma unroll
                        for (int j = 0; j < 4; ++j) { xf[2 * j] = __uint_as_float(xw[j] << 16); xf[2 * j + 1] = __uint_as_float(xw[j] & 0xffff0000u); }
                        u32x2 hw; hw.x = pk4_fp8(xf[0], xf[1], xf[2], xf[3]); hw.y = pk4_fp8(xf[4], xf[5], xf[6], xf[7]); *(GAS u32x2*)(hrow + half * 512 + 32 * (s8 + u)) = hw;
#pragma unroll
                        for (int j = 0; j < 8; ++j) ssq += xf[j] * xf[j];
                        const LAS bf16* wk = WT + r16 * 520 + 32 * (s8 + u) + 8 * g4;
#pragma unroll
                        for (int ct = 0; ct < 3; ++ct) { const bf16x8 bh = *(const LAS bf16x8*)(wk + ct * 16 * 520), bl = *(const LAS bf16x8*)(wk + (48 + ct * 16) * 520);
                            acc3[ct] = __builtin_amdgcn_mfma_f32_16x16x32_bf16(xv[u], bh, acc3[ct], 0, 0, 0); acc3[ct] = __builtin_amdgcn_mfma_f32_16x16x32_bf16(xv[u], bl, acc3[ct], 0, 0, 0); }
                    }
                }
            }
            ssq += __shfl_xor(ssq, 16); ssq += __shfl_xor(ssq, 32);
            const float rstd = rsqrtf(ssq * (1.f / DM) + EPS);
#pragma unroll
            for (int ct = 0; ct < 3; ++ct) { const int c = 16 * ct + r16; if (c < 36) {
#pragma unroll
                for (int rg = 0; rg < 4; ++rg) LG[(4 * g4 + rg) * 36 + c] = acc3[ct][rg]; } }
            LDS_WAIT();
            if (lane < 16) {
                const int m = m0 + lane; const LAS float* lg = LG + lane * 36;
                float gl[4];
#pragma unroll
                for (int g = 0; g < 4; ++g) gl[g] = lg[g] * rstd + b_rg[g];
                int gi = 0; float gm = gl[0];
#pragma unroll
                for (int g = 1; g < 4; ++g) if (gl[g] > gm) { gm = gl[g]; gi = g; }
                float gs = 0.f;
#pragma unroll
                for (int g = 0; g < 4; ++g) gs += __expf(gl[g] - gm);
                const float gval = 1.f / gs;
                float el[8];
#pragma unroll
                for (int j = 0; j < 8; ++j) el[j] = lg[4 + 8 * gi + j] * rstd + b_re[8 * gi + j];
                int i0 = 0; float mx0 = el[0];
#pragma unroll
                for (int j = 1; j < 8; ++j) if (el[j] > mx0) { mx0 = el[j]; i0 = j; }
                int i1 = -1; float mx1 = -INFINITY;
#pragma unroll
                for (int j = 0; j < 8; ++j) if (j != i0 && el[j] > mx1) { mx1 = el[j]; i1 = j; }
                const float e1 = __expf(mx1 - mx0); const float g0 = gval / (1.f + e1), g1 = gval * e1 / (1.f + e1);
                const int ea = gi * 8 + i0, eb = gi * 8 + i1; P_E01[2 * m] = ea; P_E01[2 * m + 1] = eb; P_G01[2 * m] = g0; P_G01[2 * m + 1] = g1; P_RSTD[m] = rstd;
                __hip_atomic_fetch_add((LAS unsigned*)(lds + MISC_OFF) + 64 + ea, 1u, __ATOMIC_RELAXED, __HIP_MEMORY_SCOPE_WORKGROUP); __hip_atomic_fetch_add((LAS unsigned*)(lds + MISC_OFF) + 64 + eb, 1u, __ATOMIC_RELAXED, __HIP_MEMORY_SCOPE_WORKGROUP);
            }
            __syncthreads();
            if (tid < 32) P_CNT[vcu * 32 + tid] = (int)MISC[64 + tid];
        }
        SEAM(P + 6);
        if (IN(P + 7)) for (int rep_ = 0; rep_ < ((l == 0 || 7 != 5) ? NREP(7) : 1); ++rep_) {
            unsigned ldsb_ = (unsigned)(uintptr_t)lds0; asm volatile("" : "+s"(ldsb_)); LAS unsigned char* lds = (LAS unsigned char*)(uintptr_t)ldsb_; volatile LAS unsigned* MISC = (volatile LAS unsigned*)(lds + MISC_OFF); volatile LAS unsigned long long* ARGP = (volatile LAS unsigned long long*)(lds + MISC_OFF + 768); (void)MISC; int wave = wave0, G = G0, bx = bx0; asm volatile("" : "+s"(G), "+s"(bx), "+s"(wave)); const int lane = (int)__builtin_amdgcn_mbcnt_hi(~0u, __builtin_amdgcn_mbcnt_lo(~0u, 0u)); const int tid = wave * 64 + lane; const int vcu = (bx % 8) * (G / 8) + bx / 8; const int gw = vcu * 8 + wave, NGW = G * 8; (void)lane; (void)gw; (void)NGW; (void)vcu;
            GAS unsigned char* ws = (GAS unsigned char*)LDP(22); GAS float* out = (GAS float*)LDP(21); const GAS float* x_in = (const GAS float*)ARGIN(0); (void)out; (void)x_in; (void)ws;
            LAS int* cnt_all = (LAS int*)lds;
            LAS int* pre_e = (LAS int*)(lds + 32768);
            LAS int* tot_e = pre_e + 32;
            LAS int* pst = pre_e + 64;
            LAS int* eL = pre_e + 128;
            for (int i = tid; i < 256 * 32; i += 512) cnt_all[i] = P_CNT[i];
            if (tid < 256) eL[tid] = P_E01[vcu * 256 + tid];
            __syncthreads();
            { LAS int* part = pre_e + 512;
              const int e = tid & 31, p = tid >> 5; int pre = 0, tot = 0;
#pragma unroll
              for (int j = 0; j < 16; ++j) { const int w = p * 16 + j; const int c = cnt_all[w * 32 + e]; pre += (w < vcu) ? c : 0; tot += c; }
              part[(p * 2) * 32 + e] = pre; part[(p * 2 + 1) * 32 + e] = tot; }
            __syncthreads();
            if (tid < 32) { LAS int* part = pre_e + 512; int pre = 0, tot = 0;
#pragma unroll
                for (int p = 0; p < 16; ++p) { pre += part[(p * 2) * 32 + tid]; tot += part[(p * 2 + 1) * 32 + tid]; } pre_e[tid] = pre; tot_e[tid] = tot; }
            __syncthreads();
            if (tid == 0) { int acc = 0; for (int e = 0; e < 32; ++e) { pst[e] = acc; acc += (tot_e[e] + 255) / 256 * 256; } pst[32] = acc; }
            __syncthreads();
            if (vcu == 0 && tid <= 32) P_TSTART[tid] = pst[tid] / 256;
            { LAS int* hist = pre_e + 2048;
              if (tid < 128) hist[tid] = 0;
              __syncthreads();
              int e = 0, rin = 0;
              if (tid < 256) { e = eL[tid]; unsigned long long mym = 0ull;
                  for (int x = 0; x < 32; ++x) { const unsigned long long bm = __ballot(e == x); if (e == x) mym = bm; }
                  rin = __builtin_popcountll(mym & ((1ull << lane) - 1ull));
                  if (rin == 0) hist[wave * 32 + e] = __builtin_popcountll(mym); }
              __syncthreads();
              if (tid < 256) { int r = rin; for (int w = 0; w < wave; ++w) r += hist[w * 32 + e];
                  const int slot = pst[e] + pre_e[e] + r; const int tok = vcu * 128 + (tid >> 1);
                  P_SLOT[vcu * 256 + tid] = slot; P_TOKOF[slot] = tok; P_GATEOF[slot] = P_G01[vcu * 256 + tid]; P_RSTDOF[slot] = P_RSTD[tok]; } }
            if (vcu < 32) { const int e = vcu; for (int s = pst[e] + tot_e[e] + tid; s < pst[e + 1]; s += 512) { P_TOKOF[s] = 0; P_GATEOF[s] = 0.f; P_RSTDOF[s] = 0.f; } }
            __syncthreads();
        }
        SEAM(P + 7);
        if (IN(P + 8)) for (int rep_ = 0; rep_ < ((l == 0 || 8 != 5) ? NREP(8) : 1); ++rep_) {
            unsigned ldsb_ = (unsigned)(uintptr_t)lds0; asm volatile("" : "+s"(ldsb_)); LAS unsigned char* lds = (LAS unsigned char*)(uintptr_t)ldsb_; volatile LAS unsigned* MISC = (volatile LAS unsigned*)(lds + MISC_OFF); volatile LAS unsigned long long* ARGP = (volatile LAS unsigned long long*)(lds + MISC_OFF + 768); (void)MISC; int wave = wave0, G = G0, bx = bx0; asm volatile("" : "+s"(G), "+s"(bx), "+s"(wave)); const int lane = (int)__builtin_amdgcn_mbcnt_hi(~0u, __builtin_amdgcn_mbcnt_lo(~0u, 0u)); const int tid = wave * 64 + lane; const int vcu = (bx % 8) * (G / 8) + bx / 8; const int gw = vcu * 8 + wave, NGW = G * 8; (void)lane; (void)gw; (void)NGW; (void)vcu;
            GAS unsigned char* ws = (GAS unsigned char*)LDP(22); GAS float* out = (GAS float*)LDP(21); const GAS float* x_in = (const GAS float*)ARGIN(0); (void)out; (void)x_in; (void)ws;
            volatile LAS int* TS = (volatile LAS int*)(MISC + 128);
            if (tid <= 32) TS[tid] = P_TSTART[tid];
            __syncthreads();
            MoeOrder S{G, vcu, TS, (const GAS char*)P_XN, (const GAS char*)P_WGU_L(l), 0, (size_t)1024 * 1024, (size_t)256 * 1024};
            EpiGU E{(GAS unsigned char*)P_HH, P_RSTDOF};
            pg8::gemm_phase<EpiGU, MoeOrder, true, true, true>(tid, lds, DM, DM, DM, S, E, P_TOKOF);
            if constexpr (l + 1 < NLAYER) {
                const int U = (int)TS[32] * 4, rem = U & 255; const int nidle = rem ? 256 - rem : 256, rk = rem ? vcu - rem : vcu;
                if (rk >= 0) { LAS float* scr64 = (LAS float*)(lds + wave * 16640);
                    const GAS float* w_gate = (const GAS float*)ARGIN(17) + (size_t)(l + 1) * NEXP * DM * DEXP; const GAS float* w_up = (const GAS float*)ARGIN(18) + (size_t)(l + 1) * NEXP * DM * DEXP; const GAS float* ffn1 = (const GAS float*)ARGIN(12) + (size_t)(l + 1) * DM;
                    for (int it = rk * 8 + wave; it < 16 * 16 * NEXP; it += nidle * 8) conv_gu_item(it, w_gate, w_up, ffn1, P_WGU_L(l + 1), scr64, lane); }
            }
        }
        SEAM(P + 8);
        if (IN(P + 9)) for (int rep_ = 0; rep_ < ((l == 0 || 9 != 5) ? NREP(9) : 1); ++rep_) {
            unsigned ldsb_ = (unsigned)(uintptr_t)lds0; asm volatile("" : "+s"(ldsb_)); LAS unsigned char* lds = (LAS unsigned char*)(uintptr_t)ldsb_; volatile LAS unsigned* MISC = (volatile LAS unsigned*)(lds + MISC_OFF); volatile LAS unsigned long long* ARGP = (volatile LAS unsigned long long*)(lds + MISC_OFF + 768); (void)MISC; int wave = wave0, G = G0, bx = bx0; asm volatile("" : "+s"(G), "+s"(bx), "+s"(wave)); const int lane = (int)__builtin_amdgcn_mbcnt_hi(~0u, __builtin_amdgcn_mbcnt_lo(~0u, 0u)); const int tid = wave * 64 + lane; const int vcu = (bx % 8) * (G / 8) + bx / 8; const int gw = vcu * 8 + wave, NGW = G * 8; (void)lane; (void)gw; (void)NGW; (void)vcu;
            GAS unsigned char* ws = (GAS unsigned char*)LDP(22); GAS float* out = (GAS float*)LDP(21); const GAS float* x_in = (const GAS float*)ARGIN(0); (void)out; (void)x_in; (void)ws;
            volatile LAS int* TS = (volatile LAS int*)(MISC + 128);
            if (tid <= 32) TS[tid] = P_TSTART[tid];
            __syncthreads();
            MoeOrder S{G, vcu, TS, (const GAS char*)P_HH, (const GAS char*)P_WD_L(l), (size_t)256 * 512, (size_t)1024 * 512, (size_t)256 * 512};
            EpiDown E{(GAS unsigned char*)P_Y, P_GATEOF};
            pg8::gemm_phase<EpiDown, MoeOrder, true, false, true>(tid, lds, DEXP, DEXP, DEXP, S, E, nullptr);
            if constexpr (l + 1 < NLAYER) {
                const int U = (int)TS[32] * 4, rem = U & 255; const int nidle = rem ? 256 - rem : 256, rk = rem ? vcu - rem : vcu;
                if (rk >= 0) { LAS float* scr64 = (LAS float*)(lds + wave * 16640);
                    const GAS float* w_down = (const GAS float*)ARGIN(19) + (size_t)(l + 1) * NEXP * DEXP * DM;
                    for (int it = rk * 8 + wave; it < 8 * 16 * NEXP; it += nidle * 8) conv_d_item(it, w_down, P_WD_L(l + 1), scr64, lane); }
            }
        }
        SEAM(P + 9);
}

__global__ void __launch_bounds__(512, 2) fwd(Args args) {
    extern __shared__ __attribute__((aligned(16))) unsigned char lds_raw[];
    LAS unsigned char* lds0 = (LAS unsigned char*)lds_raw;
    const int tid0 = threadIdx.x; const int wave0 = __builtin_amdgcn_readfirstlane(tid0 >> 6);
    const int G0 = gridDim.x; const int bx0 = blockIdx.x;
    { volatile LAS unsigned* MISC = (volatile LAS unsigned*)(lds0 + MISC_OFF); const int tid = tid0;
    for (int u = tid; u < 256; u += 512) MISC[u] = 0u;
    __syncthreads();
    volatile LAS unsigned long long* ARGP = (volatile LAS unsigned long long*)(lds0 + MISC_OFF + 768);
    if (tid < 21) ARGP[tid] = (unsigned long long)args.in[tid];
    if (tid == 21) ARGP[21] = (unsigned long long)args.out;
    if (tid == 22) ARGP[22] = (unsigned long long)args.ws;
    __syncthreads(); }
#if MK_ONE_LAUNCH
    XcdBarrier bar = xcd_barrier_post((unsigned*)(args.ws + WS_CTL) + CW_BAR, (volatile LAS unsigned*)(lds0 + MISC_OFF) + 8, gridDim.x);
    const int vcu0 = (bx0 % 8) * (G0 / 8) + bx0 / 8;
    XcdBarrier gbar = xcd_barrier_post((unsigned*)(args.ws + WS_CTL) + CW_BAR + (1 + (vcu0 >> 4)) * XCD_BAR_WORDS, (volatile LAS unsigned*)(lds0 + MISC_OFF) + 12, 16u);
#else
    XcdBarrier bar; bar.bar = nullptr; bar.x = 0; bar.st = nullptr; bar.n = 0;
    XcdBarrier gbar = bar;
#endif
    const int lo = args.ph_lo, hi_ = args.ph_hi;
    if (IN(0)) {
        const GAS int* positions = (const GAS int*)args.in[1]; GAS float* COSp = (GAS float*)(args.ws + WS_COS); GAS float* SINp = (GAS float*)(args.ws + WS_SIN);
        for (int i = bx0 * 512 + tid0; i < NTOK * 16; i += G0 * 512) { const int tk = i >> 4, fi = i & 15;
            const double invrev = exp2(-(double)fi * (13.287712379549449 / 16.0)) * 0.15915494309189535; const double rev = (double)positions[tk] * invrev; const float fr = (float)(rev - rint(rev));
            COSp[i] = __builtin_amdgcn_cosf(fr); SINp[i] = __builtin_amdgcn_sinf(fr); }
    }
    layer_body<0>(lo, hi_, lds0, wave0, G0, bx0, bar, gbar);
    layer_body<1>(lo, hi_, lds0, wave0, G0, bx0, bar, gbar);
    layer_body<2>(lo, hi_, lds0, wave0, G0, bx0, bar, gbar);
}

extern "C" void kernel_launch(void* const* d_in, const int* in_sizes, int n_in, void* d_out, int out_size, void* d_ws, size_t ws_size, hipStream_t stream) {
    static int grid = 0;
    if (grid == 0) {
        if (n_in != 21 || out_size != NTOK * DM || ws_size < WS_END) { fprintf(stderr, "kernel_launch: unexpected shapes (n_in %d out %d ws %zu)\n", n_in, out_size, ws_size); grid = -1; return; }
        int dev = 0, cus = 0;
        if (hipGetDevice(&dev) != hipSuccess || hipDeviceGetAttribute(&cus, hipDeviceAttributeMultiprocessorCount, dev) != hipSuccess) { grid = -1; return; }
        if (hipFuncSetAttribute((const void*)fwd, hipFuncAttributeMaxDynamicSharedMemorySize, LDS_BYTES) != hipSuccess) { fprintf(stderr, "kernel_launch: hipFuncSetAttribute failed\n"); grid = -1; return; }
        int per_cu = 0;
        if (hipOccupancyMaxActiveBlocksPerMultiprocessor(&per_cu, (const void*)fwd, 512, LDS_BYTES) != hipSuccess || per_cu < 1) fprintf(stderr, "kernel_launch: occupancy query says %d\n", per_cu);
        (void)hipGetLastError();
        grid = cus;
        if (grid != 256) { fprintf(stderr, "kernel_launch: built for 256 CUs, got %d\n", grid); grid = -1; return; }
    }
    if (grid < 0) return;
    if (hipMemsetAsync((char*)d_ws + WS_CTL, 0, CTL_ZERO_BYTES, stream) != hipSuccess) return;
    Args a{};
    for (int i = 0; i < 21; ++i) a.in[i] = d_in[i];
    a.out = (float*)d_out; a.ws = (unsigned char*)d_ws;
#if MK_ONE_LAUNCH
    a.ph_lo = 0; a.ph_hi = 21;
    hipLaunchKernelGGL(fwd, dim3(grid), dim3(512), LDS_BYTES, stream, a);
#else
    for (int p = 0; p <= 20; ++p) { a.ph_lo = p; a.ph_hi = p + 1; hipLaunchKernelGGL(fwd, dim3(grid), dim3(512), LDS_BYTES, stream, a); }
#endif
}
```

```cpp
#include <hip/hip_runtime.h>
#include <cstdio>
#include <cstdint>

#ifndef PROBE_PHASE
#define PROBE_PHASE -1
#endif
#ifndef PROBE_LAYER
#define PROBE_LAYER -1
#endif
#define NREP(k) (((PROBE_PHASE) == (k) && ((PROBE_LAYER) < 0 || (PROBE_LAYER) == l)) ? 2 : 1)
#ifndef MK_ONE_LAUNCH
#define MK_ONE_LAUNCH 1
#endif

#define LAS __attribute__((address_space(3)))
#define GAS __attribute__((address_space(1)))
typedef unsigned short bf16;
typedef short bf16x8 __attribute__((ext_vector_type(8)));
typedef short s16x4 __attribute__((ext_vector_type(4)));
typedef float f32x4 __attribute__((ext_vector_type(4)));
typedef float f32x2 __attribute__((ext_vector_type(2)));
typedef float f32x16 __attribute__((ext_vector_type(16)));
typedef unsigned u32x4 __attribute__((ext_vector_type(4)));
typedef unsigned u32x2 __attribute__((ext_vector_type(2)));

constexpr int NB = 16, SEQ = 2048, DM = 1024, NTOK = NB * SEQ, NLAYER = 2;
constexpr int INW = 1960, INP = 2048;
constexpr int NEXP = 32, DEXP = 512;
constexpr int MAXSLOT = 73728;
constexpr float EPS = 1e-6f;
constexpr float WSCALE = 64.f, WSCALE_INV = 1.f / 64.f;
constexpr float LOG2E = 1.4426950408889634f;
constexpr float C2F = 0.125f * LOG2E;
constexpr float C2M = 0.10206207261596575f * LOG2E;

constexpr size_t MiB = 1u << 20, KiB = 1u << 10;
constexpr size_t WS_CTL = 0, CTL_ZERO_BYTES = 256 * KiB;
constexpr size_t WS_COS = 1 * MiB, WS_SIN = 3 * MiB;
constexpr size_t WS_SSQ = 5 * MiB;
constexpr size_t WS_FLOG = 6 * MiB;
constexpr size_t WS_E01 = 8 * MiB;
constexpr size_t WS_G01 = 8 * MiB + 256 * KiB;
constexpr size_t WS_SLOT = 8 * MiB + 512 * KiB;
constexpr size_t WS_TOKOF = 8 * MiB + 768 * KiB;
constexpr size_t WS_GATEOF = 9 * MiB + 256 * KiB;
constexpr size_t WS_CNT = 9 * MiB + 768 * KiB;
constexpr size_t WS_TSTART = 9 * MiB + 800 * KiB;
constexpr size_t WS_RSTD = 9 * MiB + 832 * KiB;
constexpr size_t WS_RSTDOF = 7 * MiB;
constexpr size_t WS_KPE = 10 * MiB;
constexpr size_t WS_KAUG = 10 * MiB + 2 * MiB;
constexpr size_t WS_WIN = 16 * MiB;
constexpr size_t WS_WUQ = 20 * MiB;
constexpr size_t WS_WUKV = 20 * MiB + 512 * KiB;
constexpr size_t WS_WOUT = 21 * MiB;
constexpr size_t WS_WGU = 24 * MiB;
constexpr size_t WS_WD = 88 * MiB;
constexpr size_t WS_XN = 120 * MiB;
constexpr size_t WS_FQKV = 184 * MiB;
constexpr size_t WS_LAT = 280 * MiB;
constexpr size_t WS_QM = 312 * MiB;
constexpr size_t WS_KVM = 360 * MiB;
constexpr size_t WS_Y = 280 * MiB;
constexpr size_t WS_BIASF = 424 * MiB;
constexpr size_t WS_NRM = 425 * MiB;
constexpr size_t WS_WR = 426 * MiB;
constexpr size_t WS_XR = 427 * MiB;
constexpr size_t WS_OSS = 491 * MiB;
constexpr size_t WS_RSTDX = 493 * MiB;
constexpr size_t WS_W1 = 494 * MiB;
constexpr size_t WS_END = 502 * MiB;
static_assert(WS_Y + (size_t)MAXSLOT * 1024 * 2 <= WS_END, "Y fits");
static_assert(WS_FQKV + (size_t)MAXSLOT * 512 * 2 <= WS_LAT, "HH fits");

constexpr int CW_BAR = 1024;
static_assert((size_t)(CW_BAR + 17 * 3456) * 4 <= CTL_ZERO_BYTES, "barrier words inside the zeroed control block");

constexpr int RING_BYTES = 147456;
constexpr int MISC_OFF = RING_BYTES;
constexpr int LDS_BYTES = RING_BYTES + 1024;

typedef __bf16 bf16x2_t __attribute__((ext_vector_type(2)));
__device__ __forceinline__ unsigned cvt_pk_bf16(float lo, float hi) { const f32x2 v = {lo, hi}; const bf16x2_t b = __builtin_convertvector(v, bf16x2_t); return __builtin_bit_cast(unsigned, b); }
__device__ __forceinline__ float bf2f(unsigned short b) { return __uint_as_float((unsigned)b << 16); }
__device__ __forceinline__ float wave_sum(float v) {
#pragma unroll
    for (int o = 1; o < 64; o <<= 1) v += __shfl_xor(v, o);
    return v;
}
__device__ __forceinline__ unsigned pk4_fp8(float a, float b, float c, float d) { int w = 0; w = __builtin_amdgcn_cvt_pk_fp8_f32(a, b, w, false); w = __builtin_amdgcn_cvt_pk_fp8_f32(c, d, w, true); return (unsigned)w; }
#define LDS_WAIT() asm volatile("s_waitcnt lgkmcnt(0)" ::: "memory")

#define XB_TMO      128
#define XB_XCNT(j)  (256  + 64 * (j))
#define XB_XSUB(j)  (1280 + 64 * (j))
#define XB_XGEN(j)  (2304 + 64 * (j))
#define XB_TOP      3328
#define XB_TOPGEN   3392
#define XCD_BAR_WORDS 3456
#define XB_SPIN_CAP (1u << 18)
__device__ __forceinline__ unsigned xb_ld(unsigned* p)              { return __hip_atomic_load(p, __ATOMIC_RELAXED, __HIP_MEMORY_SCOPE_AGENT); }
__device__ __forceinline__ unsigned xb_add(unsigned* p, unsigned v) { return __hip_atomic_fetch_add(p, v, __ATOMIC_RELAXED, __HIP_MEMORY_SCOPE_AGENT); }
__device__ __forceinline__ unsigned xb_xcc_id() { return (unsigned)__builtin_amdgcn_s_getreg((3 << 11) | 20) & 0xFu; }
#define XB_SPIN(cond, bar) do { unsigned _sp = 0; while (cond) { __builtin_amdgcn_s_sleep(1); \
    if ((++_sp & 255u) == 0u) { if (xb_ld(&(bar)[XB_TMO])) break; if (_sp > XB_SPIN_CAP) { atomicAdd(&(bar)[XB_TMO], 1u); break; } } } } while (0)
struct XcdBarrier { unsigned* bar; unsigned x; volatile LAS unsigned* st; unsigned n; };
__device__ __forceinline__ XcdBarrier xcd_barrier_post(unsigned* bar, volatile LAS unsigned* st, unsigned n) {
    XcdBarrier b; b.bar = bar; b.x = xb_xcc_id(); b.st = st; b.n = n;
    if (threadIdx.x == 0) (void)xb_add(&bar[XB_XCNT(b.x)], 1u);
    return b;
}
__device__ __forceinline__ void xcd_barrier_complete(unsigned* bar, unsigned x, unsigned G, unsigned& nloc, unsigned& nx) {
    unsigned sum, cnt, mine, sp = 0u;
    for (;;) {
        sum = 0u; cnt = 0u; mine = 0u;
#pragma unroll
        for (unsigned j = 0; j < 16; ++j) { const unsigned c = xb_ld(&bar[XB_XCNT(j)]); sum += c; cnt += (c > 0u) ? 1u : 0u; mine = (j == x) ? c : mine; }
        if (sum == G) break;
        __builtin_amdgcn_s_sleep(1);
        if ((++sp & 255u) == 0u) { if (xb_ld(&bar[XB_TMO])) break; if (sp > XB_SPIN_CAP) { atomicAdd(&bar[XB_TMO], 1u); break; } }
    }
    nloc = mine > 0u ? mine : 1u; nx = cnt > 0u ? cnt : 1u;
}
__device__ __forceinline__ void xcd_barrier(const XcdBarrier& b) {
    asm volatile("s_waitcnt vmcnt(0)" ::: "memory");
    __syncthreads();
    if (threadIdx.x == 0) {
        unsigned* bar = b.bar;
        __builtin_amdgcn_s_waitcnt(0);
        unsigned nloc = b.st[0], nx = b.st[1];
        if (nloc == 0u) { xcd_barrier_complete(bar, b.x, b.n, nloc, nx); b.st[0] = nloc; b.st[1] = nx; }
        const unsigned old = xb_add(&bar[XB_XSUB(b.x)], 1u);
        const unsigned gen = old / nloc;
        if (old + 1u == (gen + 1u) * nloc) {
            __builtin_amdgcn_fence(__ATOMIC_RELEASE, "agent");
            asm volatile("s_waitcnt vmcnt(0)" ::: "memory");
            const unsigned og = xb_add(&bar[XB_TOP], 1u);
            const unsigned tg = og / nx;
            if (og + 1u == (tg + 1u) * nx) xb_add(&bar[XB_TOPGEN], 1u);
            else XB_SPIN(xb_ld(&bar[XB_TOPGEN]) == tg, bar);
            __builtin_amdgcn_fence(__ATOMIC_ACQUIRE, "agent");
            xb_add(&bar[XB_XGEN(b.x)], 1u);
            asm volatile("s_waitcnt vmcnt(0)" ::: "memory");
        } else {
            XB_SPIN(xb_ld(&bar[XB_XGEN(b.x)]) == gen, bar);
            __builtin_amdgcn_fence(__ATOMIC_ACQUIRE, "agent");
            asm volatile("s_waitcnt vmcnt(0)" ::: "memory");
        }
    }
    __syncthreads();
}

namespace pg8 {
constexpr int BM = 256, BK = 64, HALF = 128, HTB = HALF * BK * 2, STAGE_BYTES = 8 * HTB;
typedef int v4i32_t __attribute__((ext_vector_type(4)));
typedef int v8i32_t __attribute__((ext_vector_type(8)));
__host__ __device__ __forceinline__ int lds_byte(int r, int c) { const int st = (r >> 4) * 2 + (c >> 5), rr = r & 15, cc = c & 31, ob = rr * 64 + cc * 2; return st * 1024 + (ob ^ (((ob >> 9) & 1) << 5)); }
__host__ __device__ __forceinline__ void stage_rc(int b, int& R, int& C) { const int st = b / 1024, sb = b % 1024, swz = sb ^ (((sb >> 9) & 1) << 5); R = (st >> 1) * 16 + swz / 64; C = (st & 1) * 32 + (swz % 64) / 2; }
__host__ __device__ __forceinline__ int perm32(int rho) { const int n = rho >> 4, i = rho & 15; return 8 * (i >> 2) + 4 * n + (i & 3); }

struct Unit { const GAS char* a; const GAS char* b; int pm, pn, e; };

template <int N> __device__ __forceinline__ void wait_vm() { asm volatile("s_waitcnt vmcnt(%0)" :: "n"(N) : "memory"); }
template <class Epi, class Sched, bool ALIGN_EPI, bool GATHER, bool FP8 = false, bool MIDSCALE = false, bool VARK = false>
__device__ __forceinline__ void gemm_phase(const int tid, LAS unsigned char* lds, const int Kb, const int ldaB, const int ldbB, const Sched& S, const Epi& E, const GAS int* __restrict__ tokof, const LAS f32x2* scl = nullptr) {
    const int wid = __builtin_amdgcn_readfirstlane(tid >> 6), lane = tid & 63, wr = wid >> 2, wc = wid & 3, fr = lane & 15, fq = lane >> 4;
    const int nt = Kb / 128;
    unsigned voffA[2], voffB[2]; int RA[2], CA2[2];
#pragma unroll
    for (int i = 0; i < 2; ++i) { int R, C; stage_rc(tid * 16 + i * 8192, R, C); const int Rb = Epi::WIDE ? (64 * (R >> 5) + perm32(R & 31)) : Epi::PERM ? ((R & ~31) + perm32(R & 31)) : R;
        voffA[i] = (unsigned)(R * ldaB + C * 2); voffB[i] = (unsigned)(Rb * ldbB + C * 2); RA[i] = R; CA2[i] = C * 2; }
    const size_t kstep = (size_t)(BK * 2);
    const size_t hstepA = GATHER ? 0 : (size_t)HALF * ldaB;
    const size_t hstepB = (size_t)(Epi::WIDE ? 32 : HALF) * ldbB;
    const unsigned ldsw = (unsigned)wid * 1024u;
    const int aoff = lds_byte(wr * 64 + fr, fq * 8), boff = lds_byte(wc * 32 + fr, fq * 8);
    unsigned gcur[2][2], gnxt[2][2];
    const int scl8 = 0x7F7F7F7F;
#define PG8_SA(b, h) (((b) * 2 + (h)) * HTB)
#define PG8_SB(b, h) ((4 + (b) * 2 + (h)) * HTB)
#define PG8_STAGE(bufoff, gbase, voff) do { const unsigned long long gb_ = (unsigned long long)(gbase); const unsigned lbase_ = (unsigned)__builtin_amdgcn_readfirstlane((int)((unsigned)(uintptr_t)lds + (unsigned)(bufoff) + ldsw)); \
        _Pragma("unroll") for (int _i = 0; _i < 2; ++_i) { unsigned keep_; \
            asm volatile("s_mov_b32 %0, m0\n\ts_mov_b32 m0, %3\n\ts_nop 0\n\tglobal_load_lds_dwordx4 %1, %2\n\ts_mov_b32 m0, %0" : "=&s"(keep_) : "v"((voff)[_i]), "s"(gb_), "s"(lbase_ + (unsigned)(_i * 8192)) : "memory"); } } while (0)
#define PG8_STAGE_A(bufoff, base, h, nx) do { if constexpr (GATHER) { unsigned _v[2]; _v[0] = (nx) ? gnxt[h][0] : gcur[h][0]; _v[1] = (nx) ? gnxt[h][1] : gcur[h][1]; PG8_STAGE(bufoff, base, _v); } \
        else { PG8_STAGE(bufoff, (base) + (h) * hstepA, voffA); } } while (0)
#define PG8_LDA(dst, b, h) do { _Pragma("unroll") for (int m = 0; m < 4; ++m) _Pragma("unroll") for (int k = 0; k < 2; ++k) dst[m][k] = *(const LAS bf16x8*)(lds + PG8_SA(b, h) + aoff + m * 2048 + k * 1024); } while (0)
#define PG8_LDB(dst, b, h) do { _Pragma("unroll") for (int n = 0; n < 2; ++n) _Pragma("unroll") for (int k = 0; k < 2; ++k) dst[n][k] = *(const LAS bf16x8*)(lds + PG8_SB(b, h) + boff + n * 2048 + k * 1024); } while (0)
#define PG8_MMA(ai, bj, At, Bt) do { __builtin_amdgcn_s_setprio(1); if constexpr (FP8) { _Pragma("unroll") for (int m = 0; m < 4; ++m) _Pragma("unroll") for (int n = 0; n < 2; ++n) { \
        const v8i32_t b8_ = __builtin_shufflevector(__builtin_bit_cast(v4i32_t, Bt[n][0]), __builtin_bit_cast(v4i32_t, Bt[n][1]), 0, 1, 2, 3, 4, 5, 6, 7), a8_ = __builtin_shufflevector(__builtin_bit_cast(v4i32_t, At[m][0]), __builtin_bit_cast(v4i32_t, At[m][1]), 0, 1, 2, 3, 4, 5, 6, 7); \
        asm volatile("s_nop 1\n\tv_mfma_scale_f32_16x16x128_f8f6f4 %0, %1, %2, %0, %3, %3 op_sel_hi:[0,0,0]" : "+v"(acc[ai][bj][m][n]) : "v"(b8_), "v"(a8_), "v"(scl8)); } } \
      else { _Pragma("unroll") for (int m = 0; m < 4; ++m) _Pragma("unroll") for (int n = 0; n < 2; ++n) _Pragma("unroll") for (int k = 0; k < 2; ++k) \
        acc[ai][bj][m][n] = __builtin_amdgcn_mfma_f32_16x16x32_bf16(Bt[n][k], At[m][k], acc[ai][bj][m][n], 0, 0, 0); } __builtin_amdgcn_s_setprio(0); } while (0)
#define PG8_MMA_Z(ai, bj, At, Bt) do { __builtin_amdgcn_s_setprio(1); if constexpr (FP8) { _Pragma("unroll") for (int m = 0; m < 4; ++m) _Pragma("unroll") for (int n = 0; n < 2; ++n) { \
        const v8i32_t b8_ = __builtin_shufflevector(__builtin_bit_cast(v4i32_t, Bt[n][0]), __builtin_bit_cast(v4i32_t, Bt[n][1]), 0, 1, 2, 3, 4, 5, 6, 7), a8_ = __builtin_shufflevector(__builtin_bit_cast(v4i32_t, At[m][0]), __builtin_bit_cast(v4i32_t, At[m][1]), 0, 1, 2, 3, 4, 5, 6, 7); \
        asm volatile("s_nop 1\n\tv_mfma_scale_f32_16x16x128_f8f6f4 %0, %1, %2, 0, %3, %3 op_sel_hi:[0,0,0]" : "=&v"(acc[ai][bj][m][n]) : "v"(b8_), "v"(a8_), "v"(scl8)); } } \
      __builtin_amdgcn_s_setprio(0); } while (0)
#define PG8_WAIT_V(n) asm volatile("s_waitcnt vmcnt(" #n ")" ::: "memory")
#define PG8_WAIT_L(n) asm volatile("s_waitcnt lgkmcnt(" #n ")" ::: "memory")
#define PG8_BAR __builtin_amdgcn_s_barrier()
#define PG8_SCHED __builtin_amdgcn_sched_barrier(0)
#define PG8_GLOAD(dst, u) do { if constexpr (GATHER) { _Pragma("unroll") for (int _h = 0; _h < 2; ++_h) _Pragma("unroll") for (int _i = 0; _i < 2; ++_i) \
        dst[_h][_i] = (unsigned)tokof[(u).pm * BM + _h * HALF + RA[_i]] * (unsigned)ldaB + (unsigned)CA2[_i]; } } while (0)
    Unit cur, nxt; int ui = 0;
    if (!S.next(0, cur)) return;
    PG8_GLOAD(gcur, cur);
    typename Epi::Pre pre = E.prefetch(cur, wr, fr);
    f32x4 acc[2][2][4][2];
#pragma unroll
    for (int a = 0; a < 2; ++a)
#pragma unroll
        for (int b = 0; b < 2; ++b)
#pragma unroll
            for (int m = 0; m < 4; ++m)
#pragma unroll
                for (int n = 0; n < 2; ++n) acc[a][b][m][n] = (f32x4){0.f, 0.f, 0.f, 0.f};
    bf16x8 At[4][2], B0[2][2], B1[2][2];
    const GAS char* cA = cur.a; const GAS char* cB = cur.b;
    PG8_STAGE(PG8_SB(0, 0), cB, voffB); PG8_STAGE(PG8_SB(0, 1), cB + hstepB, voffB); PG8_STAGE_A(PG8_SA(0, 0), cA, 0, false); PG8_STAGE_A(PG8_SA(0, 1), cA, 1, false);
    if (wr == 1) PG8_BAR;
    PG8_WAIT_V(2); PG8_BAR;
    PG8_STAGE(PG8_SB(1, 0), cB + kstep, voffB); PG8_STAGE_A(PG8_SA(1, 0), cA + kstep, 0, false); PG8_STAGE(PG8_SB(1, 1), cB + hstepB + kstep, voffB);
    PG8_WAIT_V(6); PG8_BAR;
    bool fresh = false;
    for (;;) {
        const bool has_next = S.next(ui + 1, nxt);
        if constexpr (GATHER) { if (has_next) { PG8_GLOAD(gnxt, nxt); } else { _Pragma("unroll") for (int _h = 0; _h < 2; ++_h) _Pragma("unroll") for (int _i = 0; _i < 2; ++_i) gnxt[_h][_i] = gcur[_h][_i]; } }
        const GAS char* nA = has_next ? nxt.a : cA; const GAS char* nB = has_next ? nxt.b : cB;
        const int ntu = VARK ? (cur.e ? nt / 2 : nt) : nt;
#pragma nounroll
        for (int t = 0; t < ntu; t += 2) {
            const bool last = (t == ntu - 2);
            const GAS char* a1 = cA + (size_t)(t + 1) * kstep;
            const GAS char* a2 = last ? nA : cA + (size_t)(t + 2) * kstep; const GAS char* b2 = last ? nB : cB + (size_t)(t + 2) * kstep;
            const GAS char* a3 = a2 + kstep; const GAS char* b3 = b2 + kstep;
            const bool fe = fresh; fresh = false;
            if constexpr (MIDSCALE) { if (t == nt / 2) {
#pragma unroll
                for (int ai = 0; ai < 2; ++ai)
#pragma unroll
                    for (int m = 0; m < 4; ++m) { const float r_ = scl[ui * 256 + ai * 128 + wr * 64 + m * 16 + fr][0];
#pragma unroll
                        for (int bj = 0; bj < 2; ++bj)
#pragma unroll
                            for (int n = 0; n < 2; ++n) acc[ai][bj][m][n] *= r_; } } }
            PG8_LDB(B0, 0, 0); PG8_LDB(B1, 0, 1); PG8_SCHED; PG8_LDA(At, 0, 0); PG8_STAGE_A(PG8_SA(1, 1), a1, 1, false);
            if (fe) wait_vm<8 + Epi::NST>(); else PG8_WAIT_V(8); PG8_WAIT_L(0); PG8_BAR; if (FP8 && t == 0) { PG8_MMA_Z(0, 0, At, B0); PG8_MMA_Z(0, 1, At, B1); } else { PG8_MMA(0, 0, At, B0); PG8_MMA(0, 1, At, B1); } PG8_BAR; PG8_SCHED;
            PG8_LDA(At, 0, 1); PG8_STAGE(PG8_SB(0, 0), b2, voffB); PG8_STAGE(PG8_SB(0, 1), b2 + hstepB, voffB); PG8_STAGE_A(PG8_SA(0, 0), a2, 0, last);
            if (fe) wait_vm<8 + Epi::NST>(); else PG8_WAIT_V(8); PG8_WAIT_L(0); PG8_BAR; if (FP8 && t == 0) { PG8_MMA_Z(1, 0, At, B0); PG8_MMA_Z(1, 1, At, B1); } else { PG8_MMA(1, 0, At, B0); PG8_MMA(1, 1, At, B1); } PG8_BAR; PG8_SCHED;
            PG8_LDB(B0, 1, 0); PG8_LDB(B1, 1, 1); PG8_SCHED; PG8_LDA(At, 1, 0); PG8_STAGE_A(PG8_SA(0, 1), a2, 1, last);
            PG8_WAIT_V(8); PG8_WAIT_L(0); PG8_BAR; PG8_MMA(0, 0, At, B0); PG8_MMA(0, 1, At, B1); PG8_BAR; PG8_SCHED;
            PG8_LDA(At, 1, 1); PG8_STAGE(PG8_SB(1, 0), b3, voffB); PG8_STAGE(PG8_SB(1, 1), b3 + hstepB, voffB); PG8_STAGE_A(PG8_SA(1, 0), a3, 0, last);
            PG8_WAIT_V(8); PG8_WAIT_L(0); PG8_BAR; PG8_MMA(1, 0, At, B0); PG8_MMA(1, 1, At, B1); PG8_BAR; PG8_SCHED;
        }
        if constexpr (ALIGN_EPI) { if (wr == 0) PG8_BAR; }
        if constexpr (FP8) {
            asm volatile("s_nop 15\n\ts_nop 15" ::: "memory");
#pragma unroll
            for (int a = 0; a < 2; ++a)
#pragma unroll
                for (int b = 0; b < 2; ++b)
                    asm volatile("" : "+v"(acc[a][b][0][0]), "+v"(acc[a][b][0][1]), "+v"(acc[a][b][1][0]), "+v"(acc[a][b][1][1]), "+v"(acc[a][b][2][0]), "+v"(acc[a][b][2][1]), "+v"(acc[a][b][3][0]), "+v"(acc[a][b][3][1])); }
        if constexpr (MIDSCALE) E(acc, cur, wr, wc, fr, fq, scl + ui * 256); else E(acc, cur, wr, wc, fr, fq, pre);
        if (!has_next) break;
        pre = E.prefetch(nxt, wr, fr);
        if constexpr (FP8) {
#pragma unroll
            for (int a = 0; a < 2; ++a)
#pragma unroll
                for (int b = 0; b < 2; ++b)
                    asm volatile("" : "=v"(acc[a][b][0][0]), "=v"(acc[a][b][0][1]), "=v"(acc[a][b][1][0]), "=v"(acc[a][b][1][1]), "=v"(acc[a][b][2][0]), "=v"(acc[a][b][2][1]), "=v"(acc[a][b][3][0]), "=v"(acc[a][b][3][1]));
        } else {
#pragma unroll
            for (int a = 0; a < 2; ++a)
#pragma unroll
                for (int b = 0; b < 2; ++b)
#pragma unroll
                    for (int m = 0; m < 4; ++m)
#pragma unroll
                        for (int n = 0; n < 2; ++n) acc[a][b][m][n] = (f32x4){0.f, 0.f, 0.f, 0.f};
        }
        cur = nxt; cA = nA; cB = nB; ++ui; fresh = true;
        if constexpr (GATHER) { _Pragma("unroll") for (int _h = 0; _h < 2; ++_h) _Pragma("unroll") for (int _i = 0; _i < 2; ++_i) gcur[_h][_i] = gnxt[_h][_i]; }
        if constexpr (ALIGN_EPI) { if (wr == 1) PG8_BAR; }
    }
    PG8_WAIT_V(0);
    if constexpr (!ALIGN_EPI) { if (wr == 0) PG8_BAR; }
    PG8_BAR;
#undef PG8_SA
#undef PG8_SB
#undef PG8_STAGE
#undef PG8_STAGE_A
#undef PG8_LDA
#undef PG8_LDB
#undef PG8_MMA
#undef PG8_MMA_Z
#undef PG8_WAIT_V
#undef PG8_WAIT_L
#undef PG8_BAR
#undef PG8_SCHED
#undef PG8_GLOAD
}
}
using pg8::Unit;

struct BatchOrder {
    int nN, v; const GAS char* A; const GAS char* B; size_t aT, bT;
    __device__ __forceinline__ bool next(int i, Unit& u) const {
        const int uu = i * 16 + (v & 15); if (uu >= 8 * nN) return false;
        u.pm = __builtin_amdgcn_readfirstlane((v >> 4) * 8 + uu / nN); u.pn = __builtin_amdgcn_readfirstlane(uu % nN); u.e = 0;
        u.a = A + (size_t)u.pm * aT; u.b = B + (size_t)u.pn * bT; return true;
    }
};
struct UpOrder {
    int v; const GAS char* LATp; const GAS char* Wq; const GAS char* Wkv;
    __device__ __forceinline__ bool next(int i, Unit& u) const {
        const int j = v & 15; const bool hi = j >= 8; if (i >= (hi ? 4 : 3)) return false;
        const bool kv = hi ? (i < 3) : (i == 2); u.pn = __builtin_amdgcn_readfirstlane(hi ? (kv ? 1 + i : 2) : (kv ? 0 : i)); u.e = __builtin_amdgcn_readfirstlane(kv ? 1 : 0); u.pm = __builtin_amdgcn_readfirstlane((v >> 4) * 8 + (j & 7));
        u.a = LATp + (size_t)u.pm * 256 * 512 * 2 + (u.e ? 512 : 0);
        u.b = (u.e ? Wkv : Wq) + (size_t)u.pn * 256 * 256 * 2; return true;
    }
};
struct MoeOrder {
    int G, c; const volatile LAS int* TS; const GAS char* A; const GAS char* W; size_t aT  , wE  , wT  ;
    __device__ __forceinline__ bool next(int i, Unit& u) const {
        const int L = i * G + c; const int ntile = __builtin_amdgcn_readfirstlane(TS[32]); if (L >= ntile * 4) return false;
        const int rt = L >> 2, ct = L & 3;
        const int ln_ = (int)__builtin_amdgcn_mbcnt_hi(~0u, __builtin_amdgcn_mbcnt_lo(~0u, 0u)); const int tsv_ = TS[ln_ & 31];
        const int e = __builtin_popcountll(__ballot(ln_ >= 1 && ln_ < 32 && tsv_ <= rt));
        u.pm = rt; u.pn = ct; u.e = e; u.a = A + (size_t)rt * aT; u.b = W + (size_t)e * wE + (size_t)ct * wT; return true;
    }
};

__device__ __forceinline__ u32x4 pack8(f32x4 v0, f32x4 v1) { u32x4 w; w.x = cvt_pk_bf16(v0[0], v0[1]); w.y = cvt_pk_bf16(v0[2], v0[3]); w.z = cvt_pk_bf16(v1[0], v1[1]); w.w = cvt_pk_bf16(v1[2], v1[3]); return w; }

__device__ __forceinline__ void wide_store(GAS bf16* p, long dB, bool lo, u32x4 X, u32x4 Y) {
    u32x4 Yr;
#pragma unroll
    for (int j = 0; j < 4; ++j) Yr[j] = (unsigned)__builtin_amdgcn_update_dpp(0, (int)Y[j], 0x128, 0xf, 0xf, false);
    u32x4 A, B;
#pragma unroll
    for (int j = 0; j < 4; ++j) { A[j] = lo ? X[j] : Yr[j]; B[j] = lo ? Yr[j] : X[j]; }
    *(GAS u32x4*)p = A; *(GAS u32x4*)(p + dB) = B;
}

struct EpiWin {
    static constexpr int NST = 16;
    static constexpr bool PERM = true, WIDE = true;
    GAS bf16* LAT_; GAS bf16* FQKV_; GAS bf16* KPE_; GAS float* FLOG_; GAS float* SSQ_; const GAS float* COS_; const GAS float* SIN_; const GAS float* RSX_;
    struct Pre { float v[8]; };
    __device__ __forceinline__ Pre prefetch(const Unit& u, int wr, int fr) const { Pre p; const GAS float* RSX = RSX_; asm volatile("" : "+s"(RSX));
#pragma unroll
        for (int g = 0; g < 8; ++g) p.v[g] = RSX[u.pm * 256 + (g >> 2) * 128 + wr * 64 + (g & 3) * 16 + fr]; return p; }
    __device__ __forceinline__ void operator()(f32x4 (&acc)[2][2][4][2], const Unit& u, int wr, int wc, int fr, int fq, const Pre& pre) const {
        GAS bf16* LAT = LAT_; GAS bf16* FQKV = FQKV_; GAS bf16* KPE = KPE_; GAS float* FLOG = FLOG_; GAS float* SSQ = SSQ_; const GAS float* COS = COS_; const GAS float* SIN = SIN_; const GAS float* RSX = RSX_;
        asm volatile("" : "+s"(LAT), "+s"(FQKV), "+s"(KPE), "+s"(FLOG), "+s"(SSQ), "+s"(COS), "+s"(SIN), "+s"(RSX));
        {
#pragma unroll
            for (int ai = 0; ai < 2; ++ai)
#pragma unroll
                for (int m = 0; m < 4; ++m) { const float rs_ = pre.v[ai * 4 + m];
#pragma unroll
                    for (int bj = 0; bj < 2; ++bj)
#pragma unroll
                        for (int n = 0; n < 2; ++n) acc[ai][bj][m][n] *= rs_; } }
        const int row0 = u.pm * 256 + wr * 64 + fr; const int pn = u.pn;
        const bool lo = fr < 8; const int roww = u.pm * 256 + wr * 64 + (fr & 7), colw = wc * 64 + (fr >> 3) * 32 + 8 * fq; const long dB = 8 * 512 + (lo ? 32 : -32);
        if (pn >= 2) {
            const int ti = pn >> 1; GAS bf16* dst = FQKV + (size_t)(ti - 1) * NTOK * 512 + (pn & 1) * 256 + colw; const float sc = (ti == 1) ? C2F : 1.f;
#pragma unroll
            for (int ai = 0; ai < 2; ++ai)
#pragma unroll
                for (int m = 0; m < 4; ++m) wide_store(dst + (size_t)(roww + ai * 128 + m * 16) * 512, dB, lo, pack8(acc[ai][0][m][0] * sc, acc[ai][0][m][1] * sc), pack8(acc[ai][1][m][0] * sc, acc[ai][1][m][1] * sc));
        } else {
#pragma unroll
            for (int ai = 0; ai < 2; ++ai)
#pragma unroll
                for (int m = 0; m < 4; ++m) { const int row = row0 + ai * 128 + m * 16;
                    if (pn == 0 || wc != 2) wide_store(LAT + (size_t)(roww + ai * 128 + m * 16) * 512 + pn * 256 + colw, dB, lo, pack8(acc[ai][0][m][0], acc[ai][0][m][1]), pack8(acc[ai][1][m][0], acc[ai][1][m][1]));
                    float s = 0.f;
                    if (pn == 0 || wc < 2) {
#pragma unroll
                        for (int bj = 0; bj < 2; ++bj)
#pragma unroll
                            for (int n = 0; n < 2; ++n) { const f32x4 x = acc[ai][bj][m][n]; s += (x[0] * x[0] + x[1] * x[1]) + (x[2] * x[2] + x[3] * x[3]); }
                    }
                    s += __shfl_xor(s, 16); s += __shfl_xor(s, 32);
                    if (fq == 0) SSQ[(size_t)row * 8 + pn * 4 + wc] = s;
                    }
            if (pn == 1 && wc == 2) {
#pragma unroll
                for (int ai = 0; ai < 2; ++ai)
#pragma unroll
                    for (int m = 0; m < 4; ++m) { const int row = row0 + ai * 128 + m * 16;
                        const f32x4 c = *(const GAS f32x4*)(COS + (size_t)row * 16 + 4 * fq), sn = *(const GAS f32x4*)(SIN + (size_t)row * 16 + 4 * fq);
                        const f32x4 x1 = acc[ai][0][m][0], x2 = acc[ai][0][m][1];
                        *(GAS u32x4*)(KPE + (size_t)row * 32 + 8 * fq) = pack8(x1 * c - x2 * sn, x1 * sn + x2 * c);
                        }
            }
            if (pn == 1 && wc == 2 && fq == 0) {
#pragma unroll
                for (int ai = 0; ai < 2; ++ai)
#pragma unroll
                    for (int m = 0; m < 4; ++m) { const int row = row0 + ai * 128 + m * 16; *(GAS f32x4*)(FLOG + (size_t)row * 8) = acc[ai][1][m][0]; *(GAS f32x4*)(FLOG + (size_t)row * 8 + 4) = acc[ai][1][m][1]; }
            }
        }
    }
};
struct EpiUp {
    static constexpr int NST = 16;
    static constexpr bool PERM = true, WIDE = true;
    GAS bf16* QM_; GAS bf16* KVM_; const GAS float* SSQ_; const GAS float* COS_; const GAS float* SIN_;
    struct Pre { f32x4 v[8]; };
    __device__ __forceinline__ Pre prefetch(const Unit& u, int wr, int fr) const { Pre p; const GAS float* SSQ = SSQ_; asm volatile("" : "+s"(SSQ)); const int off = u.e ? 4 : 0;
#pragma unroll
        for (int g = 0; g < 8; ++g) p.v[g] = *(const GAS f32x4*)(SSQ + (size_t)(u.pm * 256 + (g >> 2) * 128 + wr * 64 + (g & 3) * 16 + fr) * 8 + off); return p; }
    __device__ __forceinline__ void operator()(const f32x4 (&acc)[2][2][4][2], const Unit& u, int wr, int wc, int fr, int fq, const Pre& pre) const {
        GAS bf16* QM = QM_; GAS bf16* KVM = KVM_; const GAS float* SSQ = SSQ_; const GAS float* COS = COS_; const GAS float* SIN = SIN_;
        asm volatile("" : "+s"(QM), "+s"(KVM), "+s"(SSQ), "+s"(COS), "+s"(SIN));
        const int row0 = u.pm * 256 + wr * 64 + fr; const int pn = u.pn; const bool kv = u.e != 0;
        const bool lo = fr < 8; const int roww = u.pm * 256 + wr * 64 + (fr & 7), colw = pn * 256 + wc * 64 + (fr >> 3) * 32 + 8 * fq;
#pragma unroll
        for (int ai = 0; ai < 2; ++ai)
#pragma unroll
            for (int m = 0; m < 4; ++m) { const int row = row0 + ai * 128 + m * 16;
                const f32x4 sq = pre.v[ai * 4 + m];
                const float ss = (sq[0] + sq[1]) + (sq[2] + sq[3]);
                if (kv) {
                    const float rs = rsqrtf(ss * (1.f / 128.f) + EPS);
                    wide_store(KVM + (size_t)(roww + ai * 128 + m * 16) * 1024 + colw, 8 * 1024 + (lo ? 32 : -32), lo, pack8(acc[ai][0][m][0] * rs, acc[ai][0][m][1] * rs), pack8(acc[ai][1][m][0] * rs, acc[ai][1][m][1] * rs));
                } else {
                    const float rs = rsqrtf(ss * (1.f / 256.f) + EPS) * C2M;
                    const f32x4 c = *(const GAS f32x4*)(COS + (size_t)row * 16 + 4 * fq), sn = *(const GAS f32x4*)(SIN + (size_t)row * 16 + 4 * fq);
                    u32x4 XY[2];
#pragma unroll
                    for (int bj = 0; bj < 2; ++bj) { f32x4 v0 = acc[ai][bj][m][0] * rs, v1 = acc[ai][bj][m][1] * rs;
                        const int G = 8 * pn + 2 * wc + bj;
                        if (G % 3 == 2) { const f32x4 x1 = v0, x2 = v1; v0 = x1 * c - x2 * sn; v1 = x1 * sn + x2 * c; }
                        XY[bj] = pack8(v0, v1); }
                    wide_store(QM + (size_t)(roww + ai * 128 + m * 16) * 768 + colw, 8 * 768 + (lo ? 32 : -32), lo, XY[0], XY[1]);
                }

            }
    }
};
template <bool RES_F32> struct EpiOut {
    static constexpr int NST = 16;
    static constexpr bool PERM = true, WIDE = true;
    const GAS float* resf_; GAS bf16* xr_;
    struct Pre {}; __device__ __forceinline__ Pre prefetch(const Unit&, int, int) const { return Pre{}; }
    __device__ __forceinline__ void operator()(const f32x4 (&acc)[2][2][4][2], const Unit& u, int wr, int wc, int fr, int fq, const LAS f32x2* scl) const {
        const GAS float* resf = resf_; GAS bf16* xr = xr_; asm volatile("" : "+s"(resf), "+s"(xr));
        const int row0 = u.pm * 256 + wr * 64 + fr, col0 = u.pn * 256 + wc * 64 + 8 * fq;
        const bool lo = fr < 8; const int roww = u.pm * 256 + wr * 64 + (fr & 7), colw = u.pn * 256 + wc * 64 + (fr >> 3) * 32 + 8 * fq;
#pragma unroll
        for (int ai = 0; ai < 2; ++ai)
#pragma unroll
            for (int m = 0; m < 4; ++m) { const size_t off = (size_t)(row0 + ai * 128 + m * 16) * DM + col0; const float sh = scl[ai * 128 + wr * 64 + m * 16 + fr][1];
                u32x4 XY[2];
#pragma unroll
                for (int bj = 0; bj < 2; ++bj) { f32x4 r0, r1;
                    if constexpr (RES_F32) { r0 = *(const GAS f32x4*)(resf + off + bj * 32); r1 = *(const GAS f32x4*)(resf + off + bj * 32 + 4); }
                    else { const u32x4 w = *(const GAS u32x4*)(xr + off + bj * 32);
                        r0 = (f32x4){__uint_as_float(w.x << 16), __uint_as_float(w.x & 0xffff0000u), __uint_as_float(w.y << 16), __uint_as_float(w.y & 0xffff0000u)};
                        r1 = (f32x4){__uint_as_float(w.z << 16), __uint_as_float(w.z & 0xffff0000u), __uint_as_float(w.w << 16), __uint_as_float(w.w & 0xffff0000u)}; }
                    XY[bj] = pack8(r0 + acc[ai][bj][m][0] * sh, r1 + acc[ai][bj][m][1] * sh); }
                wide_store(xr + (size_t)(roww + ai * 128 + m * 16) * DM + colw, 8 * DM + (lo ? 32 : -32), lo, XY[0], XY[1]); }
    }
};
struct EpiGU {
    static constexpr int NST = 8;
    static constexpr bool PERM = true, WIDE = false;
    GAS unsigned char* HH_; const GAS float* RS_;
    struct Pre { float v[8]; };
    __device__ __forceinline__ Pre prefetch(const Unit& u, int wr, int fr) const { Pre p; const GAS float* RS = RS_; asm volatile("" : "+s"(RS));
#pragma unroll
        for (int g = 0; g < 8; ++g) p.v[g] = RS[u.pm * 256 + (g >> 2) * 128 + wr * 64 + (g & 3) * 16 + fr]; return p; }
    __device__ __forceinline__ void operator()(const f32x4 (&acc)[2][2][4][2], const Unit& u, int wr, int wc, int fr, int fq, const Pre& pre) const {
        GAS unsigned char* HH = HH_; const GAS float* RS = RS_; asm volatile("" : "+s"(HH), "+s"(RS));
        const int row0 = u.pm * 256 + wr * 64 + fr;
#pragma unroll
        for (int ai = 0; ai < 2; ++ai)
#pragma unroll
            for (int m = 0; m < 4; ++m) { GAS unsigned char* rowp = HH + (size_t)(row0 + ai * 128 + m * 16) * 512 + u.pn * 128 + wc * 32 + 8 * fq; const float rs = pre.v[ai * 4 + m] * WSCALE_INV;
                f32x4 h[2];
#pragma unroll
                for (int n = 0; n < 2; ++n) { const f32x4 g = acc[ai][0][m][n] * rs, up = acc[ai][1][m][n] * rs;
#pragma unroll
                    for (int j = 0; j < 4; ++j) { const float sg = __builtin_amdgcn_rcpf(1.f + __builtin_amdgcn_exp2f(-g[j] * LOG2E)); h[n][j] = g[j] * sg * up[j]; } }
                u32x2 w; w.x = pk4_fp8(h[0][0], h[0][1], h[0][2], h[0][3]); w.y = pk4_fp8(h[1][0], h[1][1], h[1][2], h[1][3]); *(GAS u32x2*)rowp = w; }
    }
};
struct EpiDown {
    static constexpr int NST = 8;
    static constexpr bool PERM = true, WIDE = true;
    GAS unsigned char* Y_; const GAS float* GATEOF_;
    struct Pre { float v[8]; };
    __device__ __forceinline__ Pre prefetch(const Unit& u, int wr, int fr) const { Pre p; const GAS float* GT = GATEOF_; asm volatile("" : "+s"(GT));
#pragma unroll
        for (int g = 0; g < 8; ++g) p.v[g] = GT[u.pm * 256 + (g >> 2) * 128 + wr * 64 + (g & 3) * 16 + fr]; return p; }
    __device__ __forceinline__ void operator()(const f32x4 (&acc)[2][2][4][2], const Unit& u, int wr, int wc, int fr, int fq, const Pre& pre) const {
        GAS unsigned char* Y = Y_; const GAS float* GATEOF = GATEOF_; asm volatile("" : "+s"(Y), "+s"(GATEOF));
        const int row0 = u.pm * 256 + wr * 64 + fr;
#pragma unroll
        for (int ai = 0; ai < 2; ++ai)
#pragma unroll
            for (int m = 0; m < 4; ++m) { const int row = row0 + ai * 128 + m * 16; const float g = pre.v[ai * 4 + m];
                u32x2 w[2];
#pragma unroll
                for (int bj = 0; bj < 2; ++bj) { const f32x4 v0 = acc[ai][bj][m][0] * g, v1 = acc[ai][bj][m][1] * g; w[bj].x = pk4_fp8(v0[0], v0[1], v0[2], v0[3]); w[bj].y = pk4_fp8(v1[0], v1[1], v1[2], v1[3]); }
                const auto s0 = __builtin_amdgcn_permlane16_swap(w[0].x, w[1].x, false, false), s1 = __builtin_amdgcn_permlane16_swap(w[0].y, w[1].y, false, false);
                *(GAS u32x4*)(Y + (size_t)row * 1024 + u.pn * 256 + wc * 64 + (fq & 1) * 32 + (fq >> 1) * 16) = (u32x4){s0[0], s1[0], s0[1], s1[1]}; }
    }
};

namespace att {
constexpr int KSLOT = 12288, VSLOT = 8192;
constexpr int L_K = 0, L_V = 2 * KSLOT, L_BIAS = L_V + 2 * VSLOT, L_WS = L_BIAS + 8192, L_OST = L_WS + 8 * 64 * 4, L_END = L_OST + 8 * 4096;
__device__ __forceinline__ int crow(int r, int hi) { return (r & 3) + 8 * (r >> 2) + 4 * hi; }
typedef short v4i16_t __attribute__((ext_vector_type(4)));
__device__ __forceinline__ s16x4 vtr(const LAS char* p) { return __builtin_bit_cast(s16x4, __builtin_amdgcn_ds_read_tr16_b64_v4i16((LAS v4i16_t*)p)); }

constexpr int NSL = 5;
constexpr int R_K = 0, R_V = NSL * KSLOT, R_WS = R_V + NSL * VSLOT, R_OST = R_WS + 8 * 64 * 4, R_END = R_OST + 8 * 4096;
static_assert(R_END <= RING_BYTES, "attention LDS");
__device__ __forceinline__ void glds16(const GAS void* gsrc, unsigned lds_dst) { unsigned keep;
    asm volatile("s_mov_b32 %0, m0\n\ts_mov_b32 m0, %2\n\ts_nop 0\n\tglobal_load_lds_dwordx4 %1, off\n\ts_mov_b32 m0, %0" : "=&s"(keep) : "v"(gsrc), "s"(lds_dst) : "memory"); }
__device__ __forceinline__ void glds16s(const GAS void* sbase, unsigned voff, unsigned lds_dst) { unsigned keep;
    asm volatile("s_mov_b32 %0, m0\n\ts_mov_b32 m0, %3\n\ts_nop 0\n\tglobal_load_lds_dwordx4 %1, %2\n\ts_mov_b32 m0, %0" : "=&s"(keep) : "v"(voff), "s"((unsigned long long)sbase), "s"(lds_dst) : "memory"); }
struct Tens2 { const GAS bf16* Q; int qp; const GAS bf16* K; int kp; const GAS bf16* KX; const GAS bf16* V; int vp; GAS bf16* O; const GAS float* BIASF; const GAS float* NRM; GAS float* OSS; };
template <int MODE>
__device__ __forceinline__ int attn_unit2(const int wave_, int b, int h, int qb, const Tens2& T, LAS char* shm, const int slbase, const bool have_pro, const int qb_next, bf16x8 (&qr)[6], const int tstart) {
    constexpr int DKS = MODE ? 6 : 5, DKH = 3;
    constexpr float THR = 8.f;
    int wid = wave_; asm volatile("" : "+s"(wid));
    int lane = (int)__builtin_amdgcn_mbcnt_hi(~0u, __builtin_amdgcn_mbcnt_lo(~0u, 0u)); asm volatile("" : "+v"(lane)); const int r32 = lane & 31, hi = lane >> 5;
    const long rowbase = (long)b * SEQ; const int q0 = qb * 256, qw0 = q0 + wid * 32;
    const int NT = (q0 + 256) / 64, tlast = qw0 / 64;
    const int NTE = NT - tstart;
    const GAS bf16* Qw = T.Q + (rowbase + qw0) * T.qp + h * (MODE ? 96 : 64);
    const GAS bf16* Kh = T.K + rowbase * T.kp + h * (MODE ? 128 : 64);
    const GAS bf16* Vh = T.V + rowbase * T.vp + h * (MODE ? 128 : 64);
    LAS float* wsf = (LAS float*)(shm + R_WS) + wid * 64;
    const unsigned koff = (unsigned)(lane * T.kp + wid * 8) * 2u;
    const unsigned xoff = MODE ? (unsigned)(lane * 32 + (wid & 3) * 8) * 2u : (unsigned)(lane * 8) * 2u;
    const unsigned voff = (unsigned)((16 * (wid & 3) + (lane >> 2)) * T.vp + (wid >> 2) * 32 + (lane & 3) * 8) * 2u;
    const GAS bf16* xbase = MODE ? T.KX + rowbase * 32 : T.KX + ((long)b * 8 + h) * SEQ * 8;
    const int xstep = MODE ? 64 * 32 : 64 * 8;
    const unsigned kdst_a = (unsigned)(uintptr_t)(shm + R_K) + (unsigned)wid * 1024u, xdst_a = (unsigned)(uintptr_t)(shm + R_K) + (unsigned)(8 + (MODE ? (wid & 3) : 0)) * 1024u, vdst_a = (unsigned)(uintptr_t)(shm + R_V) + (unsigned)wid * 1024u;
#define A2_DMA(t, slot) do { \
        glds16s((const GAS void*)(Kh + (long)(t) * 64 * T.kp), koff, (unsigned)__builtin_amdgcn_readfirstlane((int)(kdst_a + (slot) * KSLOT))); \
        glds16s((const GAS void*)(xbase + (long)(t) * xstep), xoff, (unsigned)__builtin_amdgcn_readfirstlane((int)(xdst_a + (slot) * KSLOT))); \
        glds16s((const GAS void*)(Vh + (long)(t) * 64 * T.vp), voff, (unsigned)__builtin_amdgcn_readfirstlane((int)(vdst_a + (slot) * VSLOT))); } while (0)
    float mhat = 0.f, lrun = 0.f; f32x16 o[2]; o[0] = f32x16{}; o[1] = f32x16{}; f32x16 negm = f32x16{};
    const LAS char* vp0 = shm + R_V + ((lane >> 4) & 1) * 32 + (lane & 3) * 8 + (4 * hi + ((lane & 15) >> 2)) * 64;
#define A3_SLOT(k) ((slbase + (k)) % NSL)
    if (!have_pro) { A2_DMA(NT - 1, A3_SLOT(0)); A2_DMA(NT - 2, A3_SLOT(1)); A2_DMA(NT - 3, A3_SLOT(2)); }
    if (!have_pro) {
#pragma unroll
        for (int d0 = 0; d0 < (MODE ? 6 : 4); ++d0) qr[d0] = *(const GAS bf16x8*)(Qw + (long)r32 * T.qp + d0 * 16 + hi * 8); }
    if (MODE == 0) { const short one = hi ? (short)0 : (short)0x3F80; qr[DKS - 1] = (bf16x8){one, one, one, 0, 0, 0, 0, 0}; }
#pragma unroll
    for (int d0 = 0; d0 < DKS; ++d0) asm volatile("" : "+v"(qr[d0]));
#define A3_KLOADH(slot, H) do { const LAS char* kb_ = shm + R_K + (slot) * KSLOT + r32 * 16; _Pragma("unroll") for (int d0 = (H) * DKH; d0 < ((H) ? DKS : DKH); ++d0) { const int off = (MODE == 0 && d0 == 4) ? 8 * 1024 : d0 * 2048 + hi * 1024; \
        kf[2 * (d0 - (H) * DKH)] = *(const LAS bf16x8*)(kb_ + off); kf[2 * (d0 - (H) * DKH) + 1] = *(const LAS bf16x8*)(kb_ + off + 512); } } while (0)
#define A3_VLOAD(slot) do { const LAS char* vp_ = vp0 + (slot) * VSLOT; _Pragma("unroll") for (int q = 0; q < 8; ++q) { vlo[q] = vtr(vp_ + (q >> 2) * 4096 + (q & 3) * 1024); vhh[q] = vtr(vp_ + (q >> 2) * 4096 + (q & 3) * 1024 + 512); } } while (0)
#define A3_QKH(H) do { if ((H) == 0) { c0 = negm; c1 = negm; } _Pragma("unroll") for (int d0 = (H) * DKH; d0 < ((H) ? DKS : DKH); ++d0) { c0 = __builtin_amdgcn_mfma_f32_32x32x16_bf16(kf[2 * (d0 - (H) * DKH)], qr[d0], c0, 0, 0, 0); c1 = __builtin_amdgcn_mfma_f32_32x32x16_bf16(kf[2 * (d0 - (H) * DKH) + 1], qr[d0], c1, 0, 0, 0); } } while (0)
#define A3_EXP() do { float ls_ = 0.f; _Pragma("unroll") for (int r = 0; r < 16; ++r) { pp0[r] = __builtin_amdgcn_exp2f(pp0[r]); pp1[r] = __builtin_amdgcn_exp2f(pp1[r]); ls_ += pp0[r] + pp1[r]; } lrun += ls_; u32x4 w_; \
        w_.x = cvt_pk_bf16(pp0[0], pp0[1]); w_.y = cvt_pk_bf16(pp0[2], pp0[3]); w_.z = cvt_pk_bf16(pp0[4], pp0[5]); w_.w = cvt_pk_bf16(pp0[6], pp0[7]); pa[0] = __builtin_bit_cast(bf16x8, w_); \
        w_.x = cvt_pk_bf16(pp0[8], pp0[9]); w_.y = cvt_pk_bf16(pp0[10], pp0[11]); w_.z = cvt_pk_bf16(pp0[12], pp0[13]); w_.w = cvt_pk_bf16(pp0[14], pp0[15]); pa[1] = __builtin_bit_cast(bf16x8, w_); \
        w_.x = cvt_pk_bf16(pp1[0], pp1[1]); w_.y = cvt_pk_bf16(pp1[2], pp1[3]); w_.z = cvt_pk_bf16(pp1[4], pp1[5]); w_.w = cvt_pk_bf16(pp1[6], pp1[7]); pa[2] = __builtin_bit_cast(bf16x8, w_); \
        w_.x = cvt_pk_bf16(pp1[8], pp1[9]); w_.y = cvt_pk_bf16(pp1[10], pp1[11]); w_.z = cvt_pk_bf16(pp1[12], pp1[13]); w_.w = cvt_pk_bf16(pp1[14], pp1[15]); pa[3] = __builtin_bit_cast(bf16x8, w_); } while (0)
#define A3_PV() do { _Pragma("unroll") for (int d0 = 0; d0 < 2; ++d0) _Pragma("unroll") for (int k = 0; k < 4; ++k) { const s16x4 lo_ = vlo[4 * d0 + k], hh_ = vhh[4 * d0 + k]; \
        const bf16x8 vf_ = (bf16x8){lo_[0], lo_[1], lo_[2], lo_[3], hh_[0], hh_[1], hh_[2], hh_[3]}; o[d0] = __builtin_amdgcn_mfma_f32_32x32x16_bf16(pa[k], vf_, o[d0], 0, 0, 0); } } while (0)
#define A3_ROWMAX(rm) do { float a_ = fmaxf(fmaxf(c0[0], c0[1]), c1[0]), b_ = fmaxf(fmaxf(c0[2], c0[3]), c1[1]); a_ = fmaxf(fmaxf(a_, c1[2]), c1[3]); \
        _Pragma("unroll") for (int r = 4; r < 16; r += 4) { a_ = fmaxf(fmaxf(a_, c0[r]), c0[r + 1]); b_ = fmaxf(fmaxf(b_, c0[r + 2]), c0[r + 3]); a_ = fmaxf(fmaxf(a_, c1[r]), c1[r + 1]); b_ = fmaxf(fmaxf(b_, c1[r + 2]), c1[r + 3]); } \
        rm = fmaxf(a_, b_); const auto rr_ = __builtin_amdgcn_permlane32_swap(__float_as_uint(rm), __float_as_uint(rm), false, false); rm = fmaxf(__uint_as_float(rr_[0]), __uint_as_float(rr_[1])); } while (0)
    int sl = A3_SLOT(0), sl3 = A3_SLOT(3);
    f32x16 pp0 = f32x16{}, pp1 = f32x16{}; bool pend = false; int pslot = 0;
    for (int i = 0; i < NTE; ++i) {
        const int t = NT - 1 - i;
        { const int ahead = NTE - 1 - i;
          if (ahead >= 2) asm volatile("s_waitcnt vmcnt(6)" ::: "memory"); else if (ahead == 1) asm volatile("s_waitcnt vmcnt(3)" ::: "memory"); else asm volatile("s_waitcnt vmcnt(0)" ::: "memory"); }
        __builtin_amdgcn_s_barrier(); asm volatile("" ::: "memory");
        if (i + 3 < NTE) A2_DMA(t - 3, sl3);
        if (i == NTE - 1 && qb_next >= 0) { const int NTn = 4 * qb_next + 4; A2_DMA(NTn - 1, A3_SLOT(NTE)); A2_DMA(NTn - 2, A3_SLOT(NTE + 1)); A2_DMA(NTn - 3, A3_SLOT(NTE + 2)); }
        if (t <= tlast) {
            bf16x8 kf[2 * DKH]; f32x16 c0, c1; float rm;
            A3_KLOADH(sl, 0);
            if (!pend) {
                A3_QKH(0); A3_KLOADH(sl, 1); A3_QKH(1);
                if (MODE == 0) { const int qrel = qw0 + r32 - 64 * t;
#pragma unroll
                    for (int r = 0; r < 16; ++r) { const int kv = crow(r, hi); if (kv > qrel) c0[r] = -INFINITY; if (kv + 32 > qrel) c1[r] = -INFINITY; } }
                A3_ROWMAX(rm);
                mhat = rm;
#pragma unroll
                for (int r = 0; r < 16; ++r) { c0[r] -= rm; c1[r] -= rm; negm[r] = -mhat; }
                pend = true;
            } else {
                s16x4 vlo[8], vhh[8]; bf16x8 pa[4];
                A3_QKH(0); A3_KLOADH(sl, 1);
                A3_VLOAD(pslot);
                A3_QKH(1);
                A3_EXP();
#pragma unroll
                for (int g_ = 0; g_ < 2 * DKS; ++g_) { __builtin_amdgcn_sched_group_barrier(0x008, 1, 0); __builtin_amdgcn_sched_group_barrier(0x002, 7, 0); }
                A3_PV();
                A3_ROWMAX(rm);
#pragma unroll
                for (int g_ = 0; g_ < 8; ++g_) { __builtin_amdgcn_sched_group_barrier(0x008, 1, 0); __builtin_amdgcn_sched_group_barrier(0x002, 3, 0); }
                if (__any(rm > THR)) {
                    const float dl = fmaxf(rm, 0.f); mhat += dl;
#pragma unroll
                    for (int r = 0; r < 16; ++r) { c0[r] -= dl; c1[r] -= dl; negm[r] = -mhat; }
                    const float f = __builtin_amdgcn_exp2f(-dl); lrun *= f;
                    if (hi == 0) wsf[r32] = f;
                    LDS_WAIT();
#pragma unroll
                    for (int g = 0; g < 4; ++g) { const f32x4 ff = *(const LAS f32x4*)(wsf + 8 * g + 4 * hi);
#pragma unroll
                        for (int j = 0; j < 4; ++j) { o[0][4 * g + j] *= ff[j]; o[1][4 * g + j] *= ff[j]; } }
                }
            }
            pp0 = c0; pp1 = c1; pslot = sl;
        }
        sl = (sl == NSL - 1) ? 0 : sl + 1; sl3 = (sl3 == NSL - 1) ? 0 : sl3 + 1;
    }
    if (qb_next >= 0) { const GAS bf16* Qn = T.Q + (rowbase + qb_next * 256 + wid * 32) * T.qp + h * (MODE ? 96 : 64);
#pragma unroll
        for (int d0 = 0; d0 < (MODE ? 6 : 4); ++d0) qr[d0] = *(const GAS bf16x8*)(Qn + (long)r32 * T.qp + d0 * 16 + hi * 8); }
    if (pend) { s16x4 vlo[8], vhh[8]; bf16x8 pa[4]; A3_VLOAD(pslot); A3_EXP(); A3_PV(); }
#undef A3_KLOADH
#undef A3_VLOAD
#undef A3_QKH
#undef A3_EXP
#undef A3_PV
#undef A3_ROWMAX
#undef A2_DMA
    lrun += __shfl_xor(lrun, 32);
    LDS_WAIT();
    if (hi == 0) wsf[32 + r32] = lrun;
    LDS_WAIT();
    float rli[16];
#pragma unroll
    for (int g = 0; g < 4; ++g) { const f32x4 ll = *(const LAS f32x4*)(wsf + 32 + 8 * g + 4 * hi);
#pragma unroll
        for (int j = 0; j < 4; ++j) rli[4 * g + j] = __builtin_amdgcn_rcpf(ll[j]); }
    GAS bf16* Ow = T.O + (rowbase + qw0) * 1024 + (MODE ? 0 : 512) + h * 64;
    { LAS bf16* stg = (LAS bf16*)(shm + R_OST) + wid * 2048;
#pragma unroll
      for (int r = 0; r < 16; ++r) { const int orow = crow(r, hi);
#pragma unroll
          for (int d0 = 0; d0 < 2; ++d0) stg[orow * 64 + d0 * 32 + r32] = (bf16)(cvt_pk_bf16(o[d0][r] * rli[r], 0.f) & 0xffffu); }
      LDS_WAIT();
#pragma unroll
      for (int i = 0; i < 4; ++i) { const int row = i * 8 + (lane >> 3), ch = lane & 7; const u32x4 v = *(const LAS u32x4*)(stg + row * 64 + ch * 8); *(GAS u32x4*)(Ow + (long)row * 1024 + ch * 8) = v;
          float sq = 0.f;
#pragma unroll
          for (int j = 0; j < 4; ++j) { const float a0 = __uint_as_float(v[j] << 16), a1 = __uint_as_float(v[j] & 0xffff0000u); sq += a0 * a0 + a1 * a1; }
          sq += __shfl_xor(sq, 1); sq += __shfl_xor(sq, 2); sq += __shfl_xor(sq, 4);
          if (ch == 0) T.OSS[(rowbase + qw0 + row) * 16 + (MODE ? 0 : 8) + h] = sq; } }
    if (qb_next < 0) { LDS_WAIT(); __builtin_amdgcn_s_barrier(); asm volatile("" ::: "memory"); }
    return A3_SLOT(NTE);
#undef A3_SLOT
}
}

struct Args { const void* in[21]; float* out; unsigned char* ws; int ph_lo, ph_hi; };

__device__ __forceinline__ void tr_item(const GAS float* __restrict__ W, int ldw, int Ksrc, const GAS float* __restrict__ gain, GAS bf16* __restrict__ WT, int ldk, int k0, int n0, int srccol, LAS float* scr, int lane) {
#pragma unroll 8
    for (int i = 0; i < 32; ++i) { const int kk = 2 * i + (lane >> 5); const int k = k0 + kk;
        float v = 0.f; if (srccol >= 0 && k < Ksrc) { v = __builtin_nontemporal_load(W + (size_t)k * ldw + srccol); if (gain) v *= gain[k]; }
        scr[kk * 33 + (lane & 31)] = v; }
    LDS_WAIT(); asm volatile("" ::: "memory");
    const int c = lane & 7;
#pragma unroll
    for (int j = 0; j < 4; ++j) { const int n = (lane >> 3) + 8 * j; const LAS float* s = scr + (8 * c) * 33 + n;
        u32x4 o; o.x = cvt_pk_bf16(s[0 * 33], s[1 * 33]); o.y = cvt_pk_bf16(s[2 * 33], s[3 * 33]); o.z = cvt_pk_bf16(s[4 * 33], s[5 * 33]); o.w = cvt_pk_bf16(s[6 * 33], s[7 * 33]);
        *(GAS u32x4*)(WT + (size_t)(n0 + n) * ldk + k0 + 8 * c) = o; }
    LDS_WAIT(); asm volatile("" ::: "memory");
}
__device__ __forceinline__ void tr_item64(const GAS float* __restrict__ W, int ldw, const GAS float* __restrict__ gain, GAS bf16* __restrict__ WT, int ldk, int k0, int n0src, int n0dst, LAS float* scr, int lane) {
    const int rr = lane >> 4, c4 = (lane & 15) * 4;
    f32x4 v[16];
#pragma unroll
    for (int i = 0; i < 16; ++i) v[i] = __builtin_nontemporal_load((const GAS f32x4*)(W + (size_t)(k0 + 4 * i + rr) * ldw + n0src + c4));
#pragma unroll
    for (int i = 0; i < 16; ++i) { const int k = 4 * i + rr; const float g = gain ? gain[k0 + k] : 1.f; LAS float* d = scr + k * 65 + c4;
        d[0] = v[i][0] * g; d[1] = v[i][1] * g; d[2] = v[i][2] * g; d[3] = v[i][3] * g; }
    LDS_WAIT(); asm volatile("" ::: "memory");
    const int kc = lane & 7;
#pragma unroll
    for (int j = 0; j < 8; ++j) { const int n = (lane >> 3) + 8 * j; const LAS float* sp = scr + (8 * kc) * 65 + n;
        u32x4 o; o.x = cvt_pk_bf16(sp[0 * 65], sp[1 * 65]); o.y = cvt_pk_bf16(sp[2 * 65], sp[3 * 65]); o.z = cvt_pk_bf16(sp[4 * 65], sp[5 * 65]); o.w = cvt_pk_bf16(sp[6 * 65], sp[7 * 65]);
        *(GAS u32x4*)(WT + (size_t)(n0dst + n) * ldk + k0 + 8 * kc) = o; }
    LDS_WAIT(); asm volatile("" ::: "memory");
}
__device__ __forceinline__ void tr_item64_f8(const GAS float* __restrict__ W, int ldw, const GAS float* __restrict__ gain, float scale, GAS unsigned char* __restrict__ WT8, int ldkB, int k0, int n0src, int n0dst, LAS float* scr, int lane) {
    const int rr = lane >> 4, c4 = (lane & 15) * 4;
    f32x4 v[16];
#pragma unroll
    for (int i = 0; i < 16; ++i) v[i] = __builtin_nontemporal_load((const GAS f32x4*)(W + (size_t)(k0 + 4 * i + rr) * ldw + n0src + c4));
#pragma unroll
    for (int i = 0; i < 16; ++i) { const int k = 4 * i + rr; const float g = (gain ? gain[k0 + k] : 1.f) * scale; LAS float* d = scr + k * 65 + c4;
        d[0] = v[i][0] * g; d[1] = v[i][1] * g; d[2] = v[i][2] * g; d[3] = v[i][3] * g; }
    LDS_WAIT(); asm volatile("" ::: "memory");
    const int kc = lane & 7;
#pragma unroll
    for (int j = 0; j < 8; ++j) { const int n = (lane >> 3) + 8 * j; const LAS float* sp = scr + (8 * kc) * 65 + n;
        u32x2 o; o.x = pk4_fp8(sp[0 * 65], sp[1 * 65], sp[2 * 65], sp[3 * 65]); o.y = pk4_fp8(sp[4 * 65], sp[5 * 65], sp[6 * 65], sp[7 * 65]);
        *(GAS u32x2*)(WT8 + (size_t)(n0dst + n) * ldkB + k0 + 8 * kc) = o; }
    LDS_WAIT(); asm volatile("" ::: "memory");
}
struct F8Item { const GAS float* W; int ldw; const GAS float* gain; GAS unsigned char* WT8; int ldkB, k0, n0src, n0dst; };
__device__ __forceinline__ void tr_load64(f32x4 (&v)[16], float (&gn)[16], const F8Item& I, int lane) {
    const int rr = lane >> 4, c4 = (lane & 15) * 4;
#pragma unroll
    for (int i = 0; i < 16; ++i) gn[i] = I.gain ? I.gain[I.k0 + 4 * i + rr] : 1.f;
#pragma unroll
    for (int i = 0; i < 16; ++i) v[i] = __builtin_nontemporal_load((const GAS f32x4*)(I.W + (size_t)(I.k0 + 4 * i + rr) * I.ldw + I.n0src + c4));
}
__device__ __forceinline__ void tr_finish64_f8(const f32x4 (&v)[16], const float (&gn)[16], const F8Item& I, float scale, LAS float* scr, int lane) {
    const int rr = lane >> 4, c4 = (lane & 15) * 4;
#pragma unroll
    for (int i = 0; i < 16; ++i) { const int k = 4 * i + rr; const float g = gn[i] * scale; LAS float* d = scr + k * 65 + c4;
        d[0] = v[i][0] * g; d[1] = v[i][1] * g; d[2] = v[i][2] * g; d[3] = v[i][3] * g; }
    LDS_WAIT(); asm volatile("" ::: "memory");
    const int kc = lane & 7;
#pragma unroll
    for (int j = 0; j < 8; ++j) { const int n = (lane >> 3) + 8 * j; const LAS float* sp = scr + (8 * kc) * 65 + n;
        u32x2 o; o.x = pk4_fp8(sp[0 * 65], sp[1 * 65], sp[2 * 65], sp[3 * 65]); o.y = pk4_fp8(sp[4 * 65], sp[5 * 65], sp[6 * 65], sp[7 * 65]);
        *(GAS u32x2*)(I.WT8 + (size_t)(I.n0dst + n) * I.ldkB + I.k0 + 8 * kc) = o; }
    LDS_WAIT(); asm volatile("" ::: "memory");
}
__device__ __forceinline__ int rope_dim(int p) { const int a = p >> 3, j = p & 7; return j < 4 ? 4 * a + j : 16 + 4 * a + (j - 4); }

#define LDP(i) ((void*)((((unsigned long long)(unsigned)__builtin_amdgcn_readfirstlane((int)(ARGP[i] >> 32))) << 32) | (unsigned long long)(unsigned)__builtin_amdgcn_readfirstlane((int)(unsigned)ARGP[i])))
#define ARGIN(i) ((const void*)LDP(i))
#define P_COS ((GAS float*)(ws + WS_COS))
#define P_SIN ((GAS float*)(ws + WS_SIN))
#define P_SSQ ((GAS float*)(ws + WS_SSQ))
#define P_FLOG ((GAS float*)(ws + WS_FLOG))
#define P_E01 ((GAS int*)(ws + WS_E01))
#define P_G01 ((GAS float*)(ws + WS_G01))
#define P_SLOT ((GAS int*)(ws + WS_SLOT))
#define P_TOKOF ((GAS int*)(ws + WS_TOKOF))
#define P_GATEOF ((GAS float*)(ws + WS_GATEOF))
#define P_CNT ((GAS int*)(ws + WS_CNT))
#define P_TSTART ((GAS int*)(ws + WS_TSTART))
#define P_RSTD ((GAS float*)(ws + WS_RSTD))
#define P_RSTDOF ((GAS float*)(ws + WS_RSTDOF))
#define P_KPE ((GAS bf16*)(ws + WS_KPE))
#define P_KAUG ((GAS bf16*)(ws + WS_KAUG))
#define P_BIASF ((GAS float*)(ws + WS_BIASF))
#define P_NRM ((GAS float*)(ws + WS_NRM))
#define P_WR_L(l) ((GAS bf16*)(ws + ((l) ? WS_W1 + 7 * MiB : WS_WR)))
#define P_XR ((GAS bf16*)(ws + WS_XR))
#define P_OSS ((GAS float*)(ws + WS_OSS))
#define P_RSTDX ((GAS float*)(ws + WS_RSTDX))
#define P_WIN_L(l) ((GAS bf16*)(ws + ((l) ? WS_W1 : WS_WIN)))
#define P_WUQ_L(l) ((GAS bf16*)(ws + ((l) ? WS_W1 + 4 * MiB : WS_WUQ)))
#define P_WUKV_L(l) ((GAS bf16*)(ws + ((l) ? WS_W1 + 4 * MiB + 512 * KiB : WS_WUKV)))
#define P_WOUT_L(l) ((GAS bf16*)(ws + ((l) ? WS_W1 + 5 * MiB : WS_WOUT)))
#define P_WGU_L(ll) ((GAS unsigned char*)(ws + WS_WGU + (size_t)((ll) & 1) * 32 * MiB))
#define P_WD_L(ll) ((GAS unsigned char*)(ws + WS_WD + (size_t)((ll) & 1) * 16 * MiB))
#define P_XN ((GAS bf16*)(ws + WS_XN))
#define P_FQKV ((GAS bf16*)(ws + WS_FQKV))
#define P_HH ((GAS bf16*)(ws + WS_FQKV))
#define P_LAT ((GAS bf16*)(ws + WS_LAT))
#define P_QM ((GAS bf16*)(ws + WS_QM))
#define P_KVM ((GAS bf16*)(ws + WS_KVM))
#define P_Y ((GAS bf16*)(ws + WS_Y))
#define IN(k) (lo <= (k) && (k) < hi_)
#if MK_ONE_LAUNCH
#define GRID_BAR() xcd_barrier(bar)
#else
#define GRID_BAR() do {} while (0)
#endif
#define SEAM(k) do { if (IN(k) && IN((k) + 1)) GRID_BAR(); } while (0)
#if MK_ONE_LAUNCH
#define GROUP_BAR() xcd_barrier(gbar)
#else
#define GROUP_BAR() do {} while (0)
#endif
#define SEAMG(k) do { if (IN(k) && IN((k) + 1)) GROUP_BAR(); } while (0)
__device__ __forceinline__ void conv_gu_item(int r, const GAS float* w_gate, const GAS float* w_up, const GAS float* ffn_norm, GAS unsigned char* WGU, LAS float* scr64, int lane) {
    const int e = r / 256, q = r % 256, kb = q / 16, nb = q % 16; const int n0 = nb * 64; const int ct = n0 >> 8, which = (n0 >> 7) & 1, jj = n0 & 127;
    const GAS float* src = (which ? w_up : w_gate) + (size_t)e * DM * DEXP;
    tr_item64_f8(src, DEXP, ffn_norm, WSCALE, WGU + (size_t)e * 1024 * 1024, DM, kb * 64, ct * 128 + jj, n0, scr64, lane);
}
__device__ __forceinline__ F8Item gu_item(int r, const GAS float* w_gate, const GAS float* w_up, const GAS float* ffn_norm, GAS unsigned char* WGU) {
    const int e = r / 256, q = r % 256, kb = q / 16, nb = q % 16; const int n0 = nb * 64; const int ct = n0 >> 8, which = (n0 >> 7) & 1, jj = n0 & 127;
    return F8Item{(which ? w_up : w_gate) + (size_t)e * DM * DEXP, DEXP, ffn_norm, WGU + (size_t)e * 1024 * 1024, DM, kb * 64, ct * 128 + jj, n0};
}
__device__ __forceinline__ F8Item d_item(int r, const GAS float* w_down, GAS unsigned char* WD) {
    const int e = r / 128, q = r % 128, kb = q / 16, nb = q % 16;
    return F8Item{w_down + (size_t)e * DEXP * DM, DM, nullptr, WD + (size_t)e * 1024 * 512, DEXP, kb * 64, nb * 64, nb * 64};
}
__device__ __forceinline__ void conv_d_item(int r, const GAS float* w_down, GAS unsigned char* WD, LAS float* scr64, int lane) {
    const int e = r / 128, q = r % 128, kb = q / 16, nb = q % 16;
    tr_item64_f8(w_down + (size_t)e * DEXP * DM, DM, nullptr, WSCALE, WD + (size_t)e * 1024 * 512, DEXP, kb * 64, nb * 64, nb * 64, scr64, lane);
}
__device__ __forceinline__ void conv_experts_l0(LAS unsigned char* lds0, const int wave0, const int G0, const int bx0) {
    unsigned ldsb_ = (unsigned)(uintptr_t)lds0; asm volatile("" : "+s"(ldsb_)); LAS unsigned char* lds = (LAS unsigned char*)(uintptr_t)ldsb_; volatile LAS unsigned long long* ARGP = (volatile LAS unsigned long long*)(lds + MISC_OFF + 768);
    int wave = wave0, G = G0, bx = bx0; asm volatile("" : "+s"(G), "+s"(bx), "+s"(wave)); const int lane = (int)__builtin_amdgcn_mbcnt_hi(~0u, __builtin_amdgcn_mbcnt_lo(~0u, 0u)); const int vcu = (bx % 8) * (G / 8) + bx / 8;
    GAS unsigned char* ws = (GAS unsigned char*)LDP(22);
    LAS float* scr64 = (LAS float*)(lds + wave * 16640);
    const GAS float* ffn_norm = (const GAS float*)ARGIN(12);
    const GAS float* w_gate = (const GAS float*)ARGIN(17); const GAS float* w_up = (const GAS float*)ARGIN(18); const GAS float* w_down = (const GAS float*)ARGIN(19);
    constexpr int J_GU = 16 * 16 * NEXP, J_D = 8 * 16 * NEXP;
    asm volatile("s_waitcnt vmcnt(0)" ::: "memory"); __syncthreads();
    static_assert(J_GU == 256 * 8 * 4 && J_D == 256 * 8 * 2, "six items per wave");
    const int it0 = vcu + G * wave;
    f32x4 va[16], vb[16]; float ga[16], gb[16];
    const F8Item I0 = gu_item(it0, w_gate, w_up, ffn_norm, P_WGU_L(0)); tr_load64(va, ga, I0, lane);
    const F8Item I1 = gu_item(it0 + G * 8, w_gate, w_up, ffn_norm, P_WGU_L(0)); tr_load64(vb, gb, I1, lane); tr_finish64_f8(va, ga, I0, WSCALE, scr64, lane);
    const F8Item I2 = gu_item(it0 + G * 16, w_gate, w_up, ffn_norm, P_WGU_L(0)); tr_load64(va, ga, I2, lane); tr_finish64_f8(vb, gb, I1, WSCALE, scr64, lane);
    const F8Item I3 = gu_item(it0 + G * 24, w_gate, w_up, ffn_norm, P_WGU_L(0)); tr_load64(vb, gb, I3, lane); tr_finish64_f8(va, ga, I2, WSCALE, scr64, lane);
    const F8Item I4 = d_item(it0 + G * 32 - J_GU, w_down, P_WD_L(0)); tr_load64(va, ga, I4, lane); tr_finish64_f8(vb, gb, I3, WSCALE, scr64, lane);
    const F8Item I5 = d_item(it0 + G * 40 - J_GU, w_down, P_WD_L(0)); tr_load64(vb, gb, I5, lane); tr_finish64_f8(va, ga, I4, WSCALE, scr64, lane);
    tr_finish64_f8(vb, gb, I5, WSCALE, scr64, lane);
    __syncthreads();
}
#define CONV_SLOT(k, sl) do { if constexpr (l == 0) { if (IN(P + (k)) && ((((bx0 % 8) * (G0 / 8) + bx0 / 8) >> 4) & 1) == (sl)) conv_experts_l0(lds0, wave0, G0, bx0); } } while (0)
template <int l>
__device__ __forceinline__ void layer_body(const int lo, const int hi_, LAS unsigned char* lds0, const int wave0, const int G0, const int bx0, const XcdBarrier& bar, const XcdBarrier& gbar) {
        const int P = 10 * l;
        if (IN(P)) for (int rep_ = 0; rep_ < (l == 0 ? NREP(0) : 1); ++rep_) {
            unsigned ldsb_ = (unsigned)(uintptr_t)lds0; asm volatile("" : "+s"(ldsb_)); LAS unsigned char* lds = (LAS unsigned char*)(uintptr_t)ldsb_; volatile LAS unsigned* MISC = (volatile LAS unsigned*)(lds + MISC_OFF); volatile LAS unsigned long long* ARGP = (volatile LAS unsigned long long*)(lds + MISC_OFF + 768); (void)MISC; int wave = wave0, G = G0, bx = bx0; asm volatile("" : "+s"(G), "+s"(bx), "+s"(wave)); const int lane = (int)__builtin_amdgcn_mbcnt_hi(~0u, __builtin_amdgcn_mbcnt_lo(~0u, 0u)); const int tid = wave * 64 + lane; const int vcu = (bx % 8) * (G / 8) + bx / 8; const int gw = vcu * 8 + wave, NGW = G * 8; (void)lane; (void)gw; (void)NGW; (void)vcu;
            GAS unsigned char* ws = (GAS unsigned char*)LDP(22); GAS float* out = (GAS float*)LDP(21); const GAS float* x_in = (const GAS float*)ARGIN(0); const GAS int* positions = (const GAS int*)ARGIN(1);
            if constexpr (l == 0) {
                LAS float* scr = (LAS float*)(lds + wave * 16640);
                constexpr int I_IN = 16 * 64, I_UQ = 4 * 24, I_UKV = 4 * 32, J_OUT = 16 * 16;
                constexpr int NITEMS = I_IN + I_UQ + I_UKV + J_OUT;
                for (int it = vcu + G * wave; it < NLAYER * NITEMS; it += NGW) {
                    const int lw = it / NITEMS; int r = it % NITEMS; const int j = lane & 31;
                    if (r < I_IN) { const GAS float* attn_norm = (const GAS float*)ARGIN(2) + (size_t)lw * DM; const GAS float* w_in = (const GAS float*)ARGIN(3) + (size_t)lw * DM * INW;
                        const int kb = r / 64, nb = r % 64; const int n = nb * 32 + j; int sc;
                        if (n < 384) sc = n; else if (n < 416) sc = 384 + rope_dim(n - 384); else if (n < 424) sc = 1952 + (n - 416); else if (n < 512) sc = -1; else sc = 416 + (n - 512);
                        tr_item(w_in, INW, DM, attn_norm, P_WIN_L(lw), DM, kb * 64, nb * 32, sc, scr, lane); continue; } r -= I_IN;
                    if (r < I_UQ) { const GAS float* q_norm = (const GAS float*)ARGIN(5) + (size_t)lw * 256; const GAS float* w_uq = (const GAS float*)ARGIN(6) + (size_t)lw * 256 * 768;
                        const int kb = r / 24, nb = r % 24; const int n = nb * 32 + j; const int hh = n / 96, d = n % 96; const int sc = d < 64 ? n : hh * 96 + 64 + rope_dim(d - 64);
                        tr_item(w_uq, 768, 256, q_norm, P_WUQ_L(lw), 256, kb * 64, nb * 32, sc, scr, lane); continue; } r -= I_UQ;
                    if (r < I_UKV) { const GAS float* kv_norm = (const GAS float*)ARGIN(7) + (size_t)lw * 128; const GAS float* w_ukv = (const GAS float*)ARGIN(8) + (size_t)lw * 128 * 1024;
                        const int kb = r / 32, nb = r % 32; tr_item(w_ukv, 1024, 128, kv_norm, P_WUKV_L(lw), 256, kb * 64, nb * 32, nb * 32 + j, scr, lane); continue; } r -= I_UKV;
                    { const GAS float* mla_on = (const GAS float*)ARGIN(9) + (size_t)lw * 512; const GAS float* fox_on = (const GAS float*)ARGIN(10) + (size_t)lw * 512; const GAS float* w_out = (const GAS float*)ARGIN(11) + (size_t)lw * DM * DM;
                        const int kb = r / 16, nb = r % 16; const GAS float* gn = kb < 8 ? mla_on : fox_on - 512; tr_item64(w_out, DM, gn, P_WOUT_L(lw), DM, kb * 64, nb * 64, nb * 64, scr, lane); }
                }
                for (int lw = 0; lw < NLAYER; ++lw) { const GAS float* ffn_norm = (const GAS float*)ARGIN(12) + (size_t)lw * DM; const GAS float* w_rg = (const GAS float*)ARGIN(13) + (size_t)lw * DM * 4; const GAS float* w_re = (const GAS float*)ARGIN(15) + (size_t)lw * DM * 32;
                  for (int idx = bx * 512 + tid; idx < 2 * 48 * 520; idx += G * 512) { const int half = idx / (48 * 520), r = idx % (48 * 520), c = r / 520, kk = r % 520; const int k = half * 512 + kk;
                      float w = 0.f; if (c < 36 && kk < 512) w = ffn_norm[k] * (c < 4 ? w_rg[k * 4 + c] : w_re[k * 32 + (c - 4)]);
                      const unsigned h16 = cvt_pk_bf16(w, 0.f) & 0xffffu; const unsigned l16 = cvt_pk_bf16(w - __uint_as_float(h16 << 16), 0.f) & 0xffffu;
                      P_WR_L(lw)[(size_t)(half * 2 + 0) * 48 * 520 + r] = (bf16)h16; P_WR_L(lw)[(size_t)(half * 2 + 1) * 48 * 520 + r] = (bf16)l16; } }
            }
            const GAS float* fin = (const GAS float*)ARGIN(20);
            for (int mb = vcu * 128 + wave * 16; mb < vcu * 128 + wave * 16 + 16; mb += 4) {
                f32x4 v[4][4]; int s0[4], s1[4];
                if (l > 0) {
#pragma unroll
                    for (int r = 0; r < 4; ++r) { s0[r] = P_SLOT[2 * (mb + r)]; s1[r] = P_SLOT[2 * (mb + r) + 1]; }
                }
#pragma unroll
                for (int r = 0; r < 4; ++r) {
                    if (l == 0) { const GAS float* xr = x_in + (size_t)(mb + r) * DM;
#pragma unroll
                        for (int j = 0; j < 4; ++j) v[r][j] = __builtin_nontemporal_load((const GAS f32x4*)(xr + 4 * lane + 256 * j)); }
                    else { const GAS bf16* xr = P_XR + (size_t)(mb + r) * DM;
#pragma unroll
                        for (int j = 0; j < 4; ++j) { const u32x2 w = __builtin_nontemporal_load((const GAS u32x2*)(xr + 4 * lane + 256 * j)); v[r][j] = (f32x4){__uint_as_float(w.x << 16), __uint_as_float(w.x & 0xffff0000u), __uint_as_float(w.y << 16), __uint_as_float(w.y & 0xffff0000u)}; } } }
                if (l > 0) {
#pragma unroll
                    for (int r = 0; r < 4; ++r)
#pragma unroll
                        for (int j = 0; j < 4; ++j) { const int a = __builtin_nontemporal_load((const GAS int*)((const GAS unsigned char*)P_Y + (size_t)s0[r] * 1024 + 4 * lane + 256 * j)), c = __builtin_nontemporal_load((const GAS int*)((const GAS unsigned char*)P_Y + (size_t)s1[r] * 1024 + 4 * lane + 256 * j));
                            const f32x2 a0 = __builtin_amdgcn_cvt_pk_f32_fp8(a, false), a1 = __builtin_amdgcn_cvt_pk_f32_fp8(a, true), c0 = __builtin_amdgcn_cvt_pk_f32_fp8(c, false), c1 = __builtin_amdgcn_cvt_pk_f32_fp8(c, true);
                            v[r][j][0] += (a0[0] + c0[0]) * WSCALE_INV; v[r][j][1] += (a0[1] + c0[1]) * WSCALE_INV; v[r][j][2] += (a1[0] + c1[0]) * WSCALE_INV; v[r][j][3] += (a1[1] + c1[1]) * WSCALE_INV; }
                }
                float ss[4];
#pragma unroll
                for (int r = 0; r < 4; ++r) { float s = 0.f;
#pragma unroll
                    for (int j = 0; j < 4; ++j) s += (v[r][j][0] * v[r][j][0] + v[r][j][1] * v[r][j][1]) + (v[r][j][2] * v[r][j][2] + v[r][j][3] * v[r][j][3]);
                    ss[r] = s; }
#pragma unroll
                for (int o = 1; o < 64; o <<= 1) {
#pragma unroll
                    for (int r = 0; r < 4; ++r) ss[r] += __shfl_xor(ss[r], o); }
#pragma unroll
                for (int r = 0; r < 4; ++r) { const int m = mb + r; const float rstd = rsqrtf(ss[r] * (1.f / DM) + EPS);
                    if (l < NLAYER) {
#pragma unroll
                        for (int j = 0; j < 4; ++j) { u32x2 w; w.x = cvt_pk_bf16(v[r][j][0], v[r][j][1]); w.y = cvt_pk_bf16(v[r][j][2], v[r][j][3]); *(GAS u32x2*)(P_XR + (size_t)m * DM + 4 * lane + 256 * j) = w; }
                        if (lane == 0) P_RSTDX[m] = rstd;
                    } else {
#pragma unroll
                        for (int j = 0; j < 4; ++j) { const f32x4 g = *(const GAS f32x4*)(fin + 4 * lane + 256 * j); __builtin_nontemporal_store(v[r][j] * rstd * g, (GAS f32x4*)(out + (size_t)m * DM + 4 * lane + 256 * j)); }
                    }
                }
            }
        }
        if constexpr (l == NLAYER) return;
        SEAM(P);
        if (IN(P + 1)) for (int rep_ = 0; rep_ < ((l == 0 || 1 != 5) ? NREP(1) : 1); ++rep_) {
            unsigned ldsb_ = (unsigned)(uintptr_t)lds0; asm volatile("" : "+s"(ldsb_)); LAS unsigned char* lds = (LAS unsigned char*)(uintptr_t)ldsb_; volatile LAS unsigned* MISC = (volatile LAS unsigned*)(lds + MISC_OFF); volatile LAS unsigned long long* ARGP = (volatile LAS unsigned long long*)(lds + MISC_OFF + 768); (void)MISC; int wave = wave0, G = G0, bx = bx0; asm volatile("" : "+s"(G), "+s"(bx), "+s"(wave)); const int lane = (int)__builtin_amdgcn_mbcnt_hi(~0u, __builtin_amdgcn_mbcnt_lo(~0u, 0u)); const int tid = wave * 64 + lane; const int vcu = (bx % 8) * (G / 8) + bx / 8; const int gw = vcu * 8 + wave, NGW = G * 8; (void)lane; (void)gw; (void)NGW; (void)vcu;
            GAS unsigned char* ws = (GAS unsigned char*)LDP(22); GAS float* out = (GAS float*)LDP(21); const GAS float* x_in = (const GAS float*)ARGIN(0); (void)out; (void)x_in; (void)ws;
            BatchOrder S{INP / 256, vcu, (const GAS char*)P_XR, (const GAS char*)P_WIN_L(l), (size_t)256 * DM * 2, (size_t)256 * DM * 2};
            EpiWin E{P_LAT, P_FQKV, P_KPE, P_FLOG, P_SSQ, P_COS, P_SIN, P_RSTDX};
            pg8::gemm_phase<EpiWin, BatchOrder, true, false>(tid, lds, DM * 2, DM * 2, DM * 2, S, E, nullptr);
        }
        SEAMG(P + 1);
        if (IN(P + 2)) for (int rep_ = 0; rep_ < ((l == 0 || 2 != 5) ? NREP(2) : 1); ++rep_) {
            unsigned ldsb_ = (unsigned)(uintptr_t)lds0; asm volatile("" : "+s"(ldsb_)); LAS unsigned char* lds = (LAS unsigned char*)(uintptr_t)ldsb_; volatile LAS unsigned* MISC = (volatile LAS unsigned*)(lds + MISC_OFF); volatile LAS unsigned long long* ARGP = (volatile LAS unsigned long long*)(lds + MISC_OFF + 768); (void)MISC; int wave = wave0, G = G0, bx = bx0; asm volatile("" : "+s"(G), "+s"(bx), "+s"(wave)); const int lane = (int)__builtin_amdgcn_mbcnt_hi(~0u, __builtin_amdgcn_mbcnt_lo(~0u, 0u)); const int tid = wave * 64 + lane; const int vcu = (bx % 8) * (G / 8) + bx / 8; const int gw = vcu * 8 + wave, NGW = G * 8; (void)lane; (void)gw; (void)NGW; (void)vcu;
            GAS unsigned char* ws = (GAS unsigned char*)LDP(22); GAS float* out = (GAS float*)LDP(21); const GAS float* x_in = (const GAS float*)ARGIN(0); (void)out; (void)x_in; (void)ws;
            {
                const int sq = vcu >> 1, hf = vcu & 1; const int b = sq >> 3, h = sq & 7; const float bf = ((const GAS float*)ARGIN(4))[l * 8 + h];
                const GAS float* fl = P_FLOG + ((size_t)b * SEQ + hf * 1024 + 2 * tid) * 8 + h;
                float lf[2], lg[2] = {0.f, 0.f};
#pragma unroll
                for (int e = 0; e < 2; ++e) { const float f = fl[e * 8] + bf; lf[e] = fminf(f, 0.f) - log1pf(expf(-fabsf(f))); }
                if (hf) {
#pragma unroll
                    for (int e = 0; e < 2; ++e) { const float f = fl[e * 8 - 1024 * 8] + bf; lg[e] = fminf(f, 0.f) - log1pf(expf(-fabsf(f))); } }
                const double s2 = (double)lf[0] + (double)lf[1];
                double incl = s2, first = (double)lg[0] + (double)lg[1];
#pragma unroll
                for (int o = 1; o < 64; o <<= 1) { const double t = __shfl_up(incl, o); if (lane >= o) incl += t; first += __shfl_xor(first, o); }
                LAS double* wtot = (LAS double*)lds;
                if (lane == 63) wtot[wave] = incl;
                if (lane == 0) wtot[8 + wave] = first;
                __syncthreads();
                double c = incl - s2;
                for (int w = 0; w < wave; ++w) c += wtot[w];
                if (hf) { for (int w = 0; w < 8; ++w) c += wtot[8 + w]; }
                const size_t t0 = ((size_t)b * 8 + h) * SEQ + hf * 1024 + 2 * tid;
                GAS u32x4* ka = (GAS u32x4*)(P_KAUG + t0 * 8);
                float xs[2];
#pragma unroll
                for (int e = 0; e < 2; ++e) { c += (double)lf[e]; const float x = (float)(-c * 1.4426950408889634); xs[e] = x;
                    const unsigned h16 = cvt_pk_bf16(x, 0.f) & 0xffffu; const float r1 = x - __uint_as_float(h16 << 16); const unsigned m16 = cvt_pk_bf16(r1, 0.f) & 0xffffu; const float r2 = r1 - __uint_as_float(m16 << 16); const unsigned l16 = cvt_pk_bf16(r2, 0.f) & 0xffffu;
                    ka[e] = (u32x4){h16 | (m16 << 16), l16, 0u, 0u}; P_BIASF[t0 + e] = x; }
                float qn = 0.f, kn = 0.f, xdm = INFINITY;
                { const GAS bf16* fqp = P_FQKV + ((size_t)b * SEQ + hf * 1024 + 2 * tid) * 512 + h * 64; const GAS bf16* fkp = fqp + (size_t)NTOK * 512;
#pragma unroll
                  for (int e = 0; e < 2; ++e) { float sq_ = 0.f, sk = 0.f, dd = 0.f;
#pragma unroll
                      for (int c8 = 0; c8 < 8; ++c8) { const u32x4 a = *(const GAS u32x4*)(fqp + e * 512 + c8 * 8), k4 = *(const GAS u32x4*)(fkp + e * 512 + c8 * 8);
#pragma unroll
                          for (int j = 0; j < 4; ++j) { const float a0 = __uint_as_float(a[j] << 16), a1 = __uint_as_float(a[j] & 0xffff0000u), k0 = __uint_as_float(k4[j] << 16), k1 = __uint_as_float(k4[j] & 0xffff0000u);
                              sq_ += a0 * a0 + a1 * a1; sk += k0 * k0 + k1 * k1; dd += a0 * k0 + a1 * k1; } }
                      qn = fmaxf(qn, sq_); kn = fmaxf(kn, sk); xdm = fminf(xdm, xs[e] + dd); } }
#pragma unroll
                for (int o = 1; o < 64; o <<= 1) { qn = fmaxf(qn, __shfl_xor(qn, o)); kn = fmaxf(kn, __shfl_xor(kn, o)); xdm = fminf(xdm, __shfl_xor(xdm, o)); }
                LAS float* knw = (LAS float*)(lds + 256);
                if (lane == 0) { knw[wave] = kn; knw[8 + wave] = qn; knw[16 + wave] = xdm; }
                __syncthreads();
                if (tid < 4) { P_NRM[sq * 32 + hf * 4 + tid] = sqrtf(fmaxf(knw[8 + 2 * tid], knw[8 + 2 * tid + 1])); P_NRM[sq * 32 + 16 + hf * 4 + tid] = fminf(knw[16 + 2 * tid], knw[16 + 2 * tid + 1]); }
                if (tid == 4) { float m = knw[0]; for (int w = 1; w < 8; ++w) m = fmaxf(m, knw[w]); P_NRM[sq * 32 + 8 + hf] = sqrtf(m); }
                __syncthreads();
            }
            UpOrder S{vcu, (const GAS char*)P_LAT, (const GAS char*)P_WUQ_L(l), (const GAS char*)P_WUKV_L(l)};
            EpiUp E{P_QM, P_KVM, P_SSQ, P_COS, P_SIN};
            pg8::gemm_phase<EpiUp, UpOrder, true, false, false, false, true>(tid, lds, 256 * 2, 512 * 2, 256 * 2, S, E, nullptr);
        }
        SEAMG(P + 2);
        CONV_SLOT(3, 0);
        if (IN(P + 3)) for (int rep_ = 0; rep_ < ((l == 0 || 3 != 5) ? NREP(3) : 1); ++rep_) {
            unsigned ldsb_ = (unsigned)(uintptr_t)lds0; asm volatile("" : "+s"(ldsb_)); LAS unsigned char* lds = (LAS unsigned char*)(uintptr_t)ldsb_; volatile LAS unsigned* MISC = (volatile LAS unsigned*)(lds + MISC_OFF); volatile LAS unsigned long long* ARGP = (volatile LAS unsigned long long*)(lds + MISC_OFF + 768); (void)MISC; int wave = wave0, G = G0, bx = bx0; asm volatile("" : "+s"(G), "+s"(bx), "+s"(wave)); const int lane = (int)__builtin_amdgcn_mbcnt_hi(~0u, __builtin_amdgcn_mbcnt_lo(~0u, 0u)); const int tid = wave * 64 + lane; const int vcu = (bx % 8) * (G / 8) + bx / 8; const int gw = vcu * 8 + wave, NGW = G * 8; (void)lane; (void)gw; (void)NGW; (void)vcu;
            GAS unsigned char* ws = (GAS unsigned char*)LDP(22); GAS float* out = (GAS float*)LDP(21); const GAS float* x_in = (const GAS float*)ARGIN(0); (void)out; (void)x_in; (void)ws;
            GAS bf16* O = P_XN;
            const int b = vcu >> 4, hh = (vcu & 15) >> 1, sub = vcu & 1;
            const att::Tens2 TM{P_QM, 768, P_KVM, 1024, P_KPE, P_KVM + 64, 1024, O, nullptr, nullptr, P_OSS};
            const att::Tens2 TF{P_FQKV, 512, P_FQKV + (size_t)NTOK * 512, 512, P_KAUG, P_FQKV + (size_t)2 * NTOK * 512, 512, O, P_BIASF, P_NRM, P_OSS};
#define QB_OF(i) ((((i) & 1) ? 7 - (2 * sub + ((i) >> 1)) : (2 * sub + ((i) >> 1))))
            int ts0, ts1, ts2, ts3;
            { const GAS float* bs = P_BIASF + ((long)b * 8 + hh) * SEQ; const GAS float* nr = P_NRM + (b * 8 + hh) * 32; const float kmx = fmaxf(nr[8], nr[9]);
#define FOX_TS(i, dst) do { const int qb_ = QB_OF(i), NT_ = 4 * qb_ + 4; const float Z_ = nr[qb_] * kmx * 1.001f + 0.01f; const float bend_ = bs[(lane < NT_ ? lane : NT_ - 1) * 64 + 63]; \
                  const bool skip_ = (lane < NT_ - 4) && (Z_ + bend_ - nr[16 + qb_] < -32.f); dst = __builtin_popcountll(__ballot(skip_)); } while (0)
              FOX_TS(0, ts0); FOX_TS(1, ts1); FOX_TS(2, ts2); FOX_TS(3, ts3);
#undef FOX_TS
            }
            if (wave >= 4) __builtin_amdgcn_s_setprio(1);
            bf16x8 qreg[6];
            { int sb = 0; for (int i = 0; i < 4; ++i) sb = att::attn_unit2<1>(wave, b, hh, QB_OF(i), TM, (LAS char*)lds, sb, i > 0, i < 3 ? QB_OF(i + 1) : -1, qreg, 0); }
            if constexpr (l == 0) { if ((b & 1) == 1) { __builtin_amdgcn_s_setprio(0); conv_experts_l0(lds0, wave0, G0, bx0); if (wave >= 4) __builtin_amdgcn_s_setprio(1); } }
            { int sb = 0; for (int i = 0; i < 4; ++i) { const int ts = i == 0 ? ts0 : i == 1 ? ts1 : i == 2 ? ts2 : ts3; sb = att::attn_unit2<0>(wave, b, hh, QB_OF(i), TF, (LAS char*)lds, sb, i > 0, i < 3 ? QB_OF(i + 1) : -1, qreg, ts); } }
#undef QB_OF
            __builtin_amdgcn_s_setprio(0);
        }
        SEAMG(P + 3);
        if (IN(P + 5)) for (int rep_ = 0; rep_ < ((l == 0 || 5 != 5) ? NREP(5) : 1); ++rep_) {
            unsigned ldsb_ = (unsigned)(uintptr_t)lds0; asm volatile("" : "+s"(ldsb_)); LAS unsigned char* lds = (LAS unsigned char*)(uintptr_t)ldsb_; volatile LAS unsigned* MISC = (volatile LAS unsigned*)(lds + MISC_OFF); volatile LAS unsigned long long* ARGP = (volatile LAS unsigned long long*)(lds + MISC_OFF + 768); (void)MISC; int wave = wave0, G = G0, bx = bx0; asm volatile("" : "+s"(G), "+s"(bx), "+s"(wave)); const int lane = (int)__builtin_amdgcn_mbcnt_hi(~0u, __builtin_amdgcn_mbcnt_lo(~0u, 0u)); const int tid = wave * 64 + lane; const int vcu = (bx % 8) * (G / 8) + bx / 8; const int gw = vcu * 8 + wave, NGW = G * 8; (void)lane; (void)gw; (void)NGW; (void)vcu;
            GAS unsigned char* ws = (GAS unsigned char*)LDP(22); GAS float* out = (GAS float*)LDP(21); const GAS float* x_in = (const GAS float*)ARGIN(0); (void)out; (void)x_in; (void)ws;
            BatchOrder S{DM / 256, vcu, (const GAS char*)P_XN, (const GAS char*)P_WOUT_L(l), (size_t)256 * DM * 2, (size_t)256 * DM * 2};
            EpiOut<false> E{x_in, P_XR};
            LAS f32x2* scl = (LAS f32x2*)(lds + pg8::STAGE_BYTES);
            { Unit u_; if (S.next(tid >> 8, u_)) { const GAS float* op = P_OSS + ((size_t)u_.pm * 256 + (tid & 255)) * 16;
                  const f32x4 a0 = *(const GAS f32x4*)op, a1 = *(const GAS f32x4*)(op + 4), c0 = *(const GAS f32x4*)(op + 8), c1 = *(const GAS f32x4*)(op + 12);
                  const float sm = ((a0[0] + a0[1]) + (a0[2] + a0[3])) + ((a1[0] + a1[1]) + (a1[2] + a1[3])), sf = ((c0[0] + c0[1]) + (c0[2] + c0[3])) + ((c1[0] + c1[1]) + (c1[2] + c1[3]));
                  const float rm_ = rsqrtf(sm * (1.f / 512.f) + EPS), rf_ = rsqrtf(sf * (1.f / 512.f) + EPS);
                  scl[tid] = (f32x2){rm_ / rf_, rf_}; } }
            __syncthreads();
            pg8::gemm_phase<EpiOut<false>, BatchOrder, true, false, false, true>(tid, lds, DM * 2, DM * 2, DM * 2, S, E, nullptr, scl);
        }
        SEAMG(P + 5);
        if (IN(P + 6)) for (int rep_ = 0; rep_ < ((l == 0 || 6 != 5) ? NREP(6) : 1); ++rep_) {
            unsigned ldsb_ = (unsigned)(uintptr_t)lds0; asm volatile("" : "+s"(ldsb_)); LAS unsigned char* lds = (LAS unsigned char*)(uintptr_t)ldsb_; volatile LAS unsigned* MISC = (volatile LAS unsigned*)(lds + MISC_OFF); volatile LAS unsigned long long* ARGP = (volatile LAS unsigned long long*)(lds + MISC_OFF + 768); (void)MISC; int wave = wave0, G = G0, bx = bx0; asm volatile("" : "+s"(G), "+s"(bx), "+s"(wave)); const int lane = (int)__builtin_amdgcn_mbcnt_hi(~0u, __builtin_amdgcn_mbcnt_lo(~0u, 0u)); const int tid = wave * 64 + lane; const int vcu = (bx % 8) * (G / 8) + bx / 8; const int gw = vcu * 8 + wave, NGW = G * 8; (void)lane; (void)gw; (void)NGW; (void)vcu;
            GAS unsigned char* ws = (GAS unsigned char*)LDP(22); GAS float* out = (GAS float*)LDP(21); const GAS float* x_in = (const GAS float*)ARGIN(0); (void)out; (void)x_in; (void)ws;
            GAS bf16* H2 = P_XN;
            LAS bf16* WT = (LAS bf16*)lds;
            LAS float* LG = (LAS float*)(lds + 99840) + wave * 576;
            const GAS float* b_rg = (const GAS float*)ARGIN(14) + l * 4; const GAS float* b_re = (const GAS float*)ARGIN(16) + l * 32;
            if (tid < 32) MISC[64 + tid] = 0u;
            const int r16 = lane & 15, g4 = lane >> 4;
            const int m0 = vcu * 128 + wave * 16;
            const GAS bf16* xrow = P_XR + (size_t)(m0 + r16) * DM + 8 * g4;
            GAS unsigned char* hrow = (GAS unsigned char*)H2 + (size_t)(m0 + r16) * DM + 8 * g4;
            f32x4 acc3[3]; acc3[0] = (f32x4){0.f, 0.f, 0.f, 0.f}; acc3[1] = acc3[0]; acc3[2] = acc3[0];
            float ssq = 0.f;
            for (int half = 0; half < 2; ++half) {
                __syncthreads();
                for (int idx = tid; idx < 2 * 48 * 520 / 8; idx += 512) *(LAS u32x4*)(WT + 8 * idx) = *(const GAS u32x4*)(P_WR_L(l) + (size_t)half * 2 * 48 * 520 + 8 * idx);
                __syncthreads();
                for (int s8 = 0; s8 < 16; s8 += 8) {
                    bf16x8 xv[8];
#pragma unroll
                    for (int u = 0; u < 8; ++u) xv[u] = *(const GAS bf16x8*)(xrow + half * 512 + 32 * (s8 + u));
#pragma unroll
                    for (int u = 0; u < 8; ++u) {
                        const u32x4 xw = __builtin_bit_cast(u32x4, xv[u]); float xf[8];
#pragma unroll
                        for (int j = 0; j < 4; ++j) { xf[2 * j] = __uint_as_float(xw[j] << 16); xf[2 * j + 1] = __uint_as_float(xw[j] & 0xffff0000u); }
                        u32x2 hw; hw.x = pk4_fp8(xf[0], xf[1], xf[2], xf[3]); hw.y = pk4_fp8(xf[4], xf[5], xf[6], xf[7]); *(GAS u32x2*)(hrow + half * 512 + 32 * (s8 + u)) = hw;
#pragma unroll
                        for (int j = 0; j < 8; ++j) ssq += xf[j] * xf[j];
                        const LAS bf16* wk = WT + r16 * 520 + 32 * (s8 + u) + 8 * g4;
#pragma unroll
                        for (int ct = 0; ct < 3; ++ct) { const bf16x8 bh = *(const LAS bf16x8*)(wk + ct * 16 * 520), bl = *(const LAS bf16x8*)(wk + (48 + ct * 16) * 520);
                            acc3[ct] = __builtin_amdgcn_mfma_f32_16x16x32_bf16(xv[u], bh, acc3[ct], 0, 0, 0); acc3[ct] = __builtin_amdgcn_mfma_f32_16x16x32_bf16(xv[u], bl, acc3[ct], 0, 0, 0); }
                    }
                }
            }
            ssq += __shfl_xor(ssq, 16); ssq += __shfl_xor(ssq, 32);
            const float rstd = rsqrtf(ssq * (1.f / DM) + EPS);
#pragma unroll
            for (int ct = 0; ct < 3; ++ct) { const int c = 16 * ct + r16; if (c < 36) {
#pragma unroll
                for (int rg = 0; rg < 4; ++rg) LG[(4 * g4 + rg) * 36 + c] = acc3[ct][rg]; } }
            LDS_WAIT();
            if (lane < 16) {
                const int m = m0 + lane; const LAS float* lg = LG + lane * 36;
                float gl[4];
#pragma unroll
                for (int g = 0; g < 4; ++g) gl[g] = lg[g] * rstd + b_rg[g];
                int gi = 0; float gm = gl[0];
#pragma unroll
                for (int g = 1; g < 4; ++g) if (gl[g] > gm) { gm = gl[g]; gi = g; }
                float gs = 0.f;
#pragma unroll
                for (int g = 0; g < 4; ++g) gs += __expf(gl[g] - gm);
                const float gval = 1.f / gs;
                float el[8];
#pragma unroll
                for (int j = 0; j < 8; ++j) el[j] = lg[4 + 8 * gi + j] * rstd + b_re[8 * gi + j];
                int i0 = 0; float mx0 = el[0];
#pragma unroll
                for (int j = 1; j < 8; ++j) if (el[j] > mx0) { mx0 = el[j]; i0 = j; }
                int i1 = -1; float mx1 = -INFINITY;
#pragma unroll
                for (int j = 0; j < 8; ++j) if (j != i0 && el[j] > mx1) { mx1 = el[j]; i1 = j; }
                const float e1 = __expf(mx1 - mx0); const float g0 = gval / (1.f + e1), g1 = gval * e1 / (1.f + e1);
                const int ea = gi * 8 + i0, eb = gi * 8 + i1; P_E01[2 * m] = ea; P_E01[2 * m + 1] = eb; P_G01[2 * m] = g0; P_G01[2 * m + 1] = g1; P_RSTD[m] = rstd;
                __hip_atomic_fetch_add((LAS unsigned*)(lds + MISC_OFF) + 64 + ea, 1u, __ATOMIC_RELAXED, __HIP_MEMORY_SCOPE_WORKGROUP); __hip_atomic_fetch_add((LAS unsigned*)(lds + MISC_OFF) + 64 + eb, 1u, __ATOMIC_RELAXED, __HIP_MEMORY_SCOPE_WORKGROUP);
            }
            __syncthreads();
            if (tid < 32) P_CNT[vcu * 32 + tid] = (int)MISC[64 + tid];
        }
        SEAM(P + 6);
        if (IN(P + 7)) for (int rep_ = 0; rep_ < ((l == 0 || 7 != 5) ? NREP(7) : 1); ++rep_) {
            unsigned ldsb_ = (unsigned)(uintptr_t)lds0; asm volatile("" : "+s"(ldsb_)); LAS unsigned char* lds = (LAS unsigned char*)(uintptr_t)ldsb_; volatile LAS unsigned* MISC = (volatile LAS unsigned*)(lds + MISC_OFF); volatile LAS unsigned long long* ARGP = (volatile LAS unsigned long long*)(lds + MISC_OFF + 768); (void)MISC; int wave = wave0, G = G0, bx = bx0; asm volatile("" : "+s"(G), "+s"(bx), "+s"(wave)); const int lane = (int)__builtin_amdgcn_mbcnt_hi(~0u, __builtin_amdgcn_mbcnt_lo(~0u, 0u)); const int tid = wave * 64 + lane; const int vcu = (bx % 8) * (G / 8) + bx / 8; const int gw = vcu * 8 + wave, NGW = G * 8; (void)lane; (void)gw; (void)NGW; (void)vcu;
            GAS unsigned char* ws = (GAS unsigned char*)LDP(22); GAS float* out = (GAS float*)LDP(21); const GAS float* x_in = (const GAS float*)ARGIN(0); (void)out; (void)x_in; (void)ws;
            LAS int* cnt_all = (LAS int*)lds;
            LAS int* pre_e = (LAS int*)(lds + 32768);
            LAS int* tot_e = pre_e + 32;
            LAS int* pst = pre_e + 64;
            LAS int* eL = pre_e + 128;
            for (int i = tid; i < 256 * 32; i += 512) cnt_all[i] = P_CNT[i];
            if (tid < 256) eL[tid] = P_E01[vcu * 256 + tid];
            __syncthreads();
            { LAS int* part = pre_e + 512;
              const int e = tid & 31, p = tid >> 5; int pre = 0, tot = 0;
#pragma unroll
              for (int j = 0; j < 16; ++j) { const int w = p * 16 + j; const int c = cnt_all[w * 32 + e]; pre += (w < vcu) ? c : 0; tot += c; }
              part[(p * 2) * 32 + e] = pre; part[(p * 2 + 1) * 32 + e] = tot; }
            __syncthreads();
            if (tid < 32) { LAS int* part = pre_e + 512; int pre = 0, tot = 0;
#pragma unroll
                for (int p = 0; p < 16; ++p) { pre += part[(p * 2) * 32 + tid]; tot += part[(p * 2 + 1) * 32 + tid]; } pre_e[tid] = pre; tot_e[tid] = tot; }
            __syncthreads();
            if (tid == 0) { int acc = 0; for (int e = 0; e < 32; ++e) { pst[e] = acc; acc += (tot_e[e] + 255) / 256 * 256; } pst[32] = acc; }
            __syncthreads();
            if (vcu == 0 && tid <= 32) P_TSTART[tid] = pst[tid] / 256;
            { LAS int* hist = pre_e + 2048;
              if (tid < 128) hist[tid] = 0;
              __syncthreads();
              int e = 0, rin = 0;
              if (tid < 256) { e = eL[tid]; unsigned long long mym = 0ull;
                  for (int x = 0; x < 32; ++x) { const unsigned long long bm = __ballot(e == x); if (e == x) mym = bm; }
                  rin = __builtin_popcountll(mym & ((1ull << lane) - 1ull));
                  if (rin == 0) hist[wave * 32 + e] = __builtin_popcountll(mym); }
              __syncthreads();
              if (tid < 256) { int r = rin; for (int w = 0; w < wave; ++w) r += hist[w * 32 + e];
                  const int slot = pst[e] + pre_e[e] + r; const int tok = vcu * 128 + (tid >> 1);
                  P_SLOT[vcu * 256 + tid] = slot; P_TOKOF[slot] = tok; P_GATEOF[slot] = P_G01[vcu * 256 + tid]; P_RSTDOF[slot] = P_RSTD[tok]; } }
            if (vcu < 32) { const int e = vcu; for (int s = pst[e] + tot_e[e] + tid; s < pst[e + 1]; s += 512) { P_TOKOF[s] = 0; P_GATEOF[s] = 0.f; P_RSTDOF[s] = 0.f; } }
            __syncthreads();
        }
        SEAM(P + 7);
        if (IN(P + 8)) for (int rep_ = 0; rep_ < ((l == 0 || 8 != 5) ? NREP(8) : 1); ++rep_) {
            unsigned ldsb_ = (unsigned)(uintptr_t)lds0; asm volatile("" : "+s"(ldsb_)); LAS unsigned char* lds = (LAS unsigned char*)(uintptr_t)ldsb_; volatile LAS unsigned* MISC = (volatile LAS unsigned*)(lds + MISC_OFF); volatile LAS unsigned long long* ARGP = (volatile LAS unsigned long long*)(lds + MISC_OFF + 768); (void)MISC; int wave = wave0, G = G0, bx = bx0; asm volatile("" : "+s"(G), "+s"(bx), "+s"(wave)); const int lane = (int)__builtin_amdgcn_mbcnt_hi(~0u, __builtin_amdgcn_mbcnt_lo(~0u, 0u)); const int tid = wave * 64 + lane; const int vcu = (bx % 8) * (G / 8) + bx / 8; const int gw = vcu * 8 + wave, NGW = G * 8; (void)lane; (void)gw; (void)NGW; (void)vcu;
            GAS unsigned char* ws = (GAS unsigned char*)LDP(22); GAS float* out = (GAS float*)LDP(21); const GAS float* x_in = (const GAS float*)ARGIN(0); (void)out; (void)x_in; (void)ws;
            volatile LAS int* TS = (volatile LAS int*)(MISC + 128);
            if (tid <= 32) TS[tid] = P_TSTART[tid];
            __syncthreads();
            MoeOrder S{G, vcu, TS, (const GAS char*)P_XN, (const GAS char*)P_WGU_L(l), 0, (size_t)1024 * 1024, (size_t)256 * 1024};
            EpiGU E{(GAS unsigned char*)P_HH, P_RSTDOF};
            pg8::gemm_phase<EpiGU, MoeOrder, true, true, true>(tid, lds, DM, DM, DM, S, E, P_TOKOF);
            if constexpr (l + 1 < NLAYER) {
                const int U = (int)TS[32] * 4, rem = U & 255; const int nidle = rem ? 256 - rem : 256, rk = rem ? vcu - rem : vcu;
                if (rk >= 0) { LAS float* scr64 = (LAS float*)(lds + wave * 16640);
                    const GAS float* w_gate = (const GAS float*)ARGIN(17) + (size_t)(l + 1) * NEXP * DM * DEXP; const GAS float* w_up = (const GAS float*)ARGIN(18) + (size_t)(l + 1) * NEXP * DM * DEXP; const GAS float* ffn1 = (const GAS float*)ARGIN(12) + (size_t)(l + 1) * DM;
                    for (int it = rk * 8 + wave; it < 16 * 16 * NEXP; it += nidle * 8) conv_gu_item(it, w_gate, w_up, ffn1, P_WGU_L(l + 1), scr64, lane); }
            }
        }
        SEAM(P + 8);
        if (IN(P + 9)) for (int rep_ = 0; rep_ < ((l == 0 || 9 != 5) ? NREP(9) : 1); ++rep_) {
            unsigned ldsb_ = (unsigned)(uintptr_t)lds0; asm volatile("" : "+s"(ldsb_)); LAS unsigned char* lds = (LAS unsigned char*)(uintptr_t)ldsb_; volatile LAS unsigned* MISC = (volatile LAS unsigned*)(lds + MISC_OFF); volatile LAS unsigned long long* ARGP = (volatile LAS unsigned long long*)(lds + MISC_OFF + 768); (void)MISC; int wave = wave0, G = G0, bx = bx0; asm volatile("" : "+s"(G), "+s"(bx), "+s"(wave)); const int lane = (int)__builtin_amdgcn_mbcnt_hi(~0u, __builtin_amdgcn_mbcnt_lo(~0u, 0u)); const int tid = wave * 64 + lane; const int vcu = (bx % 8) * (G / 8) + bx / 8; const int gw = vcu * 8 + wave, NGW = G * 8; (void)lane; (void)gw; (void)NGW; (void)vcu;
            GAS unsigned char* ws = (GAS unsigned char*)LDP(22); GAS float* out = (GAS float*)LDP(21); const GAS float* x_in = (const GAS float*)ARGIN(0); (void)out; (void)x_in; (void)ws;
            volatile LAS int* TS = (volatile LAS int*)(MISC + 128);
            if (tid <= 32) TS[tid] = P_TSTART[tid];
            __syncthreads();
            MoeOrder S{G, vcu, TS, (const GAS char*)P_HH, (const GAS char*)P_WD_L(l), (size_t)256 * 512, (size_t)1024 * 512, (size_t)256 * 512};
            EpiDown E{(GAS unsigned char*)P_Y, P_GATEOF};
            pg8::gemm_phase<EpiDown, MoeOrder, true, false, true>(tid, lds, DEXP, DEXP, DEXP, S, E, nullptr);
            if constexpr (l + 1 < NLAYER) {
                const int U = (int)TS[32] * 4, rem = U & 255; const int nidle = rem ? 256 - rem : 256, rk = rem ? vcu - rem : vcu;
                if (rk >= 0) { LAS float* scr64 = (LAS float*)(lds + wave * 16640);
                    const GAS float* w_down = (const GAS float*)ARGIN(19) + (size_t)(l + 1) * NEXP * DEXP * DM;
                    for (int it = rk * 8 + wave; it < 8 * 16 * NEXP; it += nidle * 8) conv_d_item(it, w_down, P_WD_L(l + 1), scr64, lane); }
            }
        }
        SEAM(P + 9);
}

__global__ void __launch_bounds__(512, 2) fwd(Args args) {
    extern __shared__ __attribute__((aligned(16))) unsigned char lds_raw[];
    LAS unsigned char* lds0 = (LAS unsigned char*)lds_raw;
    const int tid0 = threadIdx.x; const int wave0 = __builtin_amdgcn_readfirstlane(tid0 >> 6);
    const int G0 = gridDim.x; const int bx0 = blockIdx.x;
    { volatile LAS unsigned* MISC = (volatile LAS unsigned*)(lds0 + MISC_OFF); const int tid = tid0;
    for (int u = tid; u < 256; u += 512) MISC[u] = 0u;
    __syncthreads();
    volatile LAS unsigned long long* ARGP = (volatile LAS unsigned long long*)(lds0 + MISC_OFF + 768);
    if (tid < 21) ARGP[tid] = (unsigned long long)args.in[tid];
    if (tid == 21) ARGP[21] = (unsigned long long)args.out;
    if (tid == 22) ARGP[22] = (unsigned long long)args.ws;
    __syncthreads(); }
#if MK_ONE_LAUNCH
    XcdBarrier bar = xcd_barrier_post((unsigned*)(args.ws + WS_CTL) + CW_BAR, (volatile LAS unsigned*)(lds0 + MISC_OFF) + 8, gridDim.x);
    const int vcu0 = (bx0 % 8) * (G0 / 8) + bx0 / 8;
    XcdBarrier gbar = xcd_barrier_post((unsigned*)(args.ws + WS_CTL) + CW_BAR + (1 + (vcu0 >> 4)) * XCD_BAR_WORDS, (volatile LAS unsigned*)(lds0 + MISC_OFF) + 12, 16u);
#else
    XcdBarrier bar; bar.bar = nullptr; bar.x = 0; bar.st = nullptr; bar.n = 0;
    XcdBarrier gbar = bar;
#endif
    const int lo = args.ph_lo, hi_ = args.ph_hi;
    if (IN(0)) {
        const GAS int* positions = (const GAS int*)args.in[1]; GAS float* COSp = (GAS float*)(args.ws + WS_COS); GAS float* SINp = (GAS float*)(args.ws + WS_SIN);
        for (int i = bx0 * 512 + tid0; i < NTOK * 16; i += G0 * 512) { const int tk = i >> 4, fi = i & 15;
            const double invrev = exp2(-(double)fi * (13.287712379549449 / 16.0)) * 0.15915494309189535; const double rev = (double)positions[tk] * invrev; const float fr = (float)(rev - rint(rev));
            COSp[i] = __builtin_amdgcn_cosf(fr); SINp[i] = __builtin_amdgcn_sinf(fr); }
    }
    layer_body<0>(lo, hi_, lds0, wave0, G0, bx0, bar, gbar);
    layer_body<1>(lo, hi_, lds0, wave0, G0, bx0, bar, gbar);
    layer_body<2>(lo, hi_, lds0, wave0, G0, bx0, bar, gbar);
}

extern "C" void kernel_launch(void* const* d_in, const int* in_sizes, int n_in, void* d_out, int out_size, void* d_ws, size_t ws_size, hipStream_t stream) {
    static int grid = 0;
    if (grid == 0) {
        if (n_in != 21 || out_size != NTOK * DM || ws_size < WS_END) { fprintf(stderr, "kernel_launch: unexpected shapes (n_in %d out %d ws %zu)\n", n_in, out_size, ws_size); grid = -1; return; }
        int dev = 0, cus = 0;
        if (hipGetDevice(&dev) != hipSuccess || hipDeviceGetAttribute(&cus, hipDeviceAttributeMultiprocessorCount, dev) != hipSuccess) { grid = -1; return; }
        if (hipFuncSetAttribute((const void*)fwd, hipFuncAttributeMaxDynamicSharedMemorySize, LDS_BYTES) != hipSuccess) { fprintf(stderr, "kernel_launch: hipFuncSetAttribute failed\n"); grid = -1; return; }
        int per_cu = 0;
        if (hipOccupancyMaxActiveBlocksPerMultiprocessor(&per_cu, (const void*)fwd, 512, LDS_BYTES) != hipSuccess || per_cu < 1) fprintf(stderr, "kernel_launch: occupancy query says %d\n", per_cu);
        (void)hipGetLastError();
        grid = cus;
        if (grid != 256) { fprintf(stderr, "kernel_launch: built for 256 CUs, got %d\n", grid); grid = -1; return; }
    }
    if (grid < 0) return;
    if (hipMemsetAsync((char*)d_ws + WS_CTL, 0, CTL_ZERO_BYTES, stream) != hipSuccess) return;
    Args a{};
    for (int i = 0; i < 21; ++i) a.in[i] = d_in[i];
    a.out = (float*)d_out; a.ws = (unsigned char*)d_ws;
#if MK_ONE_LAUNCH
    a.ph_lo = 0; a.ph_hi = 21;
    hipLaunchKernelGGL(fwd, dim3(grid), dim3(512), LDS_BYTES, stream, a);
#else
    for (int p = 0; p <= 20; ++p) { a.ph_lo = p; a.ph_hi = p + 1; hipLaunchKernelGGL(fwd, dim3(grid), dim3(512), LDS_BYTES, stream, a); }
#endif
}
```

```cpp
#include <hip/hip_runtime.h>
#include <cstdio>
#include <cstdint>

#ifndef PROBE_PHASE
#define PROBE_PHASE -1
#endif
#ifndef PROBE_LAYER
#define PROBE_LAYER -1
#endif
#define NREP(k) (((PROBE_PHASE) == (k) && ((PROBE_LAYER) < 0 || (PROBE_LAYER) == l)) ? 2 : 1)
#ifndef MK_ONE_LAUNCH
#define MK_ONE_LAUNCH 1
#endif

#define LAS __attribute__((address_space(3)))
#define GAS __attribute__((address_space(1)))
typedef unsigned short bf16;
typedef short bf16x8 __attribute__((ext_vector_type(8)));
typedef short s16x4 __attribute__((ext_vector_type(4)));
typedef float f32x4 __attribute__((ext_vector_type(4)));
typedef float f32x2 __attribute__((ext_vector_type(2)));
typedef float f32x16 __attribute__((ext_vector_type(16)));
typedef unsigned u32x4 __attribute__((ext_vector_type(4)));
typedef unsigned u32x2 __attribute__((ext_vector_type(2)));

constexpr int NB = 16, SEQ = 2048, DM = 1024, NTOK = NB * SEQ, NLAYER = 2;
constexpr int INW = 1960, INP = 2048;
constexpr int NEXP = 32, DEXP = 512;
constexpr int MAXSLOT = 73728;
constexpr float EPS = 1e-6f;
constexpr float WSCALE = 64.f, WSCALE_INV = 1.f / 64.f;
constexpr float LOG2E = 1.4426950408889634f;
constexpr float C2F = 0.125f * LOG2E;
constexpr float C2M = 0.10206207261596575f * LOG2E;

constexpr size_t MiB = 1u << 20, KiB = 1u << 10;
constexpr size_t WS_CTL = 0, CTL_ZERO_BYTES = 256 * KiB;
constexpr size_t WS_COS = 1 * MiB, WS_SIN = 3 * MiB;
constexpr size_t WS_SSQ = 5 * MiB;
constexpr size_t WS_FLOG = 6 * MiB;
constexpr size_t WS_E01 = 8 * MiB;
constexpr size_t WS_G01 = 8 * MiB + 256 * KiB;
constexpr size_t WS_SLOT = 8 * MiB + 512 * KiB;
constexpr size_t WS_TOKOF = 8 * MiB + 768 * KiB;
constexpr size_t WS_GATEOF = 9 * MiB + 256 * KiB;
constexpr size_t WS_CNT = 9 * MiB + 768 * KiB;
constexpr size_t WS_TSTART = 9 * MiB + 800 * KiB;
constexpr size_t WS_RSTD = 9 * MiB + 832 * KiB;
constexpr size_t WS_RSTDOF = 7 * MiB;
constexpr size_t WS_KPE = 10 * MiB;
constexpr size_t WS_KAUG = 10 * MiB + 2 * MiB;
constexpr size_t WS_WIN = 16 * MiB;
constexpr size_t WS_WUQ = 20 * MiB;
constexpr size_t WS_WUKV = 20 * MiB + 512 * KiB;
constexpr size_t WS_WOUT = 21 * MiB;
constexpr size_t WS_WGU = 24 * MiB;
constexpr size_t WS_WD = 88 * MiB;
constexpr size_t WS_XN = 120 * MiB;
constexpr size_t WS_FQKV = 184 * MiB;
constexpr size_t WS_LAT = 280 * MiB;
constexpr size_t WS_QM = 312 * MiB;
constexpr size_t WS_KVM = 360 * MiB;
constexpr size_t WS_Y = 280 * MiB;
constexpr size_t WS_BIASF = 424 * MiB;
constexpr size_t WS_NRM = 425 * MiB;
constexpr size_t WS_WR = 426 * MiB;
constexpr size_t WS_XR = 427 * MiB;
constexpr size_t WS_OSS = 491 * MiB;
constexpr size_t WS_RSTDX = 493 * MiB;
constexpr size_t WS_W1 = 494 * MiB;
constexpr size_t WS_END = 502 * MiB;
static_assert(WS_Y + (size_t)MAXSLOT * 1024 * 2 <= WS_END, "Y fits");
static_assert(WS_FQKV + (size_t)MAXSLOT * 512 * 2 <= WS_LAT, "HH fits");

constexpr int CW_BAR = 1024;
static_assert((size_t)(CW_BAR + 17 * 3456) * 4 <= CTL_ZERO_BYTES, "barrier words inside the zeroed control block");

constexpr int RING_BYTES = 147456;
constexpr int MISC_OFF = RING_BYTES;
constexpr int LDS_BYTES = RING_BYTES + 1024;

typedef __bf16 bf16x2_t __attribute__((ext_vector_type(2)));
__device__ __forceinline__ unsigned cvt_pk_bf16(float lo, float hi) { const f32x2 v = {lo, hi}; const bf16x2_t b = __builtin_convertvector(v, bf16x2_t); return __builtin_bit_cast(unsigned, b); }
__device__ __forceinline__ float bf2f(unsigned short b) { return __uint_as_float((unsigned)b << 16); }
__device__ __forceinline__ float wave_sum(float v) {
#pragma unroll
    for (int o = 1; o < 64; o <<= 1) v += __shfl_xor(v, o);
    return v;
}
__device__ __forceinline__ unsigned pk4_fp8(float a, float b, float c, float d) { int w = 0; w = __builtin_amdgcn_cvt_pk_fp8_f32(a, b, w, false); w = __builtin_amdgcn_cvt_pk_fp8_f32(c, d, w, true); return (unsigned)w; }
#define LDS_WAIT() asm volatile("s_waitcnt lgkmcnt(0)" ::: "memory")

#define XB_TMO      128
#define XB_XCNT(j)  (256  + 64 * (j))
#define XB_XSUB(j)  (1280 + 64 * (j))
#define XB_XGEN(j)  (2304 + 64 * (j))
#define XB_TOP      3328
#define XB_TOPGEN   3392
#define XCD_BAR_WORDS 3456
#define XB_SPIN_CAP (1u << 18)
__device__ __forceinline__ unsigned xb_ld(unsigned* p)              { return __hip_atomic_load(p, __ATOMIC_RELAXED, __HIP_MEMORY_SCOPE_AGENT); }
__device__ __forceinline__ unsigned xb_add(unsigned* p, unsigned v) { return __hip_atomic_fetch_add(p, v, __ATOMIC_RELAXED, __HIP_MEMORY_SCOPE_AGENT); }
__device__ __forceinline__ unsigned xb_xcc_id() { return (unsigned)__builtin_amdgcn_s_getreg((3 << 11) | 20) & 0xFu; }
#define XB_SPIN(cond, bar) do { unsigned _sp = 0; while (cond) { __builtin_amdgcn_s_sleep(1); \
    if ((++_sp & 255u) == 0u) { if (xb_ld(&(bar)[XB_TMO])) break; if (_sp > XB_SPIN_CAP) { atomicAdd(&(bar)[XB_TMO], 1u); break; } } } } while (0)
struct XcdBarrier { unsigned* bar; unsigned x; volatile LAS unsigned* st; unsigned n; };
__device__ __forceinline__ XcdBarrier xcd_barrier_post(unsigned* bar, volatile LAS unsigned* st, unsigned n) {
    XcdBarrier b; b.bar = bar; b.x = xb_xcc_id(); b.st = st; b.n = n;
    if (threadIdx.x == 0) (void)xb_add(&bar[XB_XCNT(b.x)], 1u);
    return b;
}
__device__ __forceinline__ void xcd_barrier_complete(unsigned* bar, unsigned x, unsigned G, unsigned& nloc, unsigned& nx) {
    unsigned sum, cnt, mine, sp = 0u;
    for (;;) {
        sum = 0u; cnt = 0u; mine = 0u;
#pragma unroll
        for (unsigned j = 0; j < 16; ++j) { const unsigned c = xb_ld(&bar[XB_XCNT(j)]); sum += c; cnt += (c > 0u) ? 1u : 0u; mine = (j == x) ? c : mine; }
        if (sum == G) break;
        __builtin_amdgcn_s_sleep(1);
        if ((++sp & 255u) == 0u) { if (xb_ld(&bar[XB_TMO])) break; if (sp > XB_SPIN_CAP) { atomicAdd(&bar[XB_TMO], 1u); break; } }
    }
    nloc = mine > 0u ? mine : 1u; nx = cnt > 0u ? cnt : 1u;
}
__device__ __forceinline__ void xcd_barrier(const XcdBarrier& b) {
    asm volatile("s_waitcnt vmcnt(0)" ::: "memory");
    __syncthreads();
    if (threadIdx.x == 0) {
        unsigned* bar = b.bar;
        __builtin_amdgcn_s_waitcnt(0);
        unsigned nloc = b.st[0], nx = b.st[1];
        if (nloc == 0u) { xcd_barrier_complete(bar, b.x, b.n, nloc, nx); b.st[0] = nloc; b.st[1] = nx; }
        const unsigned old = xb_add(&bar[XB_XSUB(b.x)], 1u);
        const unsigned gen = old / nloc;
        if (old + 1u == (gen + 1u) * nloc) {
            __builtin_amdgcn_fence(__ATOMIC_RELEASE, "agent");
            asm volatile("s_waitcnt vmcnt(0)" ::: "memory");
            const unsigned og = xb_add(&bar[XB_TOP], 1u);
            const unsigned tg = og / nx;
            if (og + 1u == (tg + 1u) * nx) xb_add(&bar[XB_TOPGEN], 1u);
            else XB_SPIN(xb_ld(&bar[XB_TOPGEN]) == tg, bar);
            __builtin_amdgcn_fence(__ATOMIC_ACQUIRE, "agent");
            xb_add(&bar[XB_XGEN(b.x)], 1u);
            asm volatile("s_waitcnt vmcnt(0)" ::: "memory");
        } else {
            XB_SPIN(xb_ld(&bar[XB_XGEN(b.x)]) == gen, bar);
            __builtin_amdgcn_fence(__ATOMIC_ACQUIRE, "agent");
            asm volatile("s_waitcnt vmcnt(0)" ::: "memory");
        }
    }
    __syncthreads();
}

namespace pg8 {
constexpr int BM = 256, BK = 64, HALF = 128, HTB = HALF * BK * 2, STAGE_BYTES = 8 * HTB;
typedef int v4i32_t __attribute__((ext_vector_type(4)));
typedef int v8i32_t __attribute__((ext_vector_type(8)));
__host__ __device__ __forceinline__ int lds_byte(int r, int c) { const int st = (r >> 4) * 2 + (c >> 5), rr = r & 15, cc = c & 31, ob = rr * 64 + cc * 2; return st * 1024 + (ob ^ (((ob >> 9) & 1) << 5)); }
__host__ __device__ __forceinline__ void stage_rc(int b, int& R, int& C) { const int st = b / 1024, sb = b % 1024, swz = sb ^ (((sb >> 9) & 1) << 5); R = (st >> 1) * 16 + swz / 64; C = (st & 1) * 32 + (swz % 64) / 2; }
__host__ __device__ __forceinline__ int perm32(int rho) { const int n = rho >> 4, i = rho & 15; return 8 * (i >> 2) + 4 * n + (i & 3); }

struct Unit { const GAS char* a; const GAS char* b; int pm, pn, e; };

template <int N> __device__ __forceinline__ void wait_vm() { asm volatile("s_waitcnt vmcnt(%0)" :: "n"(N) : "memory"); }
template <class Epi, class Sched, bool ALIGN_EPI, bool GATHER, bool FP8 = false, bool MIDSCALE = false, bool VARK = false>
__device__ __forceinline__ void gemm_phase(const int tid, LAS unsigned char* lds, const int Kb, const int ldaB, const int ldbB, const Sched& S, const Epi& E, const GAS int* __restrict__ tokof, const LAS f32x2* scl = nullptr) {
    const int wid = __builtin_amdgcn_readfirstlane(tid >> 6), lane = tid & 63, wr = wid >> 2, wc = wid & 3, fr = lane & 15, fq = lane >> 4;
    const int nt = Kb / 128;
    unsigned voffA[2], voffB[2]; int RA[2], CA2[2];
#pragma unroll
    for (int i = 0; i < 2; ++i) { int R, C; stage_rc(tid * 16 + i * 8192, R, C); const int Rb = Epi::WIDE ? (64 * (R >> 5) + perm32(R & 31)) : Epi::PERM ? ((R & ~31) + perm32(R & 31)) : R;
        voffA[i] = (unsigned)(R * ldaB + C * 2); voffB[i] = (unsigned)(Rb * ldbB + C * 2); RA[i] = R; CA2[i] = C * 2; }
    const size_t kstep = (size_t)(BK * 2);
    const size_t hstepA = GATHER ? 0 : (size_t)HALF * ldaB;
    const size_t hstepB = (size_t)(Epi::WIDE ? 32 : HALF) * ldbB;
    const unsigned ldsw = (unsigned)wid * 1024u;
    const int aoff = lds_byte(wr * 64 + fr, fq * 8), boff = lds_byte(wc * 32 + fr, fq * 8);
    unsigned gcur[2][2], gnxt[2][2];
    const int scl8 = 0x7F7F7F7F;
#define PG8_SA(b, h) (((b) * 2 + (h)) * HTB)
#define PG8_SB(b, h) ((4 + (b) * 2 + (h)) * HTB)
#define PG8_STAGE(bufoff, gbase, voff) do { const unsigned long long gb_ = (unsigned long long)(gbase); const unsigned lbase_ = (unsigned)__builtin_amdgcn_readfirstlane((int)((unsigned)(uintptr_t)lds + (unsigned)(bufoff) + ldsw)); \
        _Pragma("unroll") for (int _i = 0; _i < 2; ++_i) { unsigned keep_; \
            asm volatile("s_mov_b32 %0, m0\n\ts_mov_b32 m0, %3\n\ts_nop 0\n\tglobal_load_lds_dwordx4 %1, %2\n\ts_mov_b32 m0, %0" : "=&s"(keep_) : "v"((voff)[_i]), "s"(gb_), "s"(lbase_ + (unsigned)(_i * 8192)) : "memory"); } } while (0)
#define PG8_STAGE_A(bufoff, base, h, nx) do { if constexpr (GATHER) { unsigned _v[2]; _v[0] = (nx) ? gnxt[h][0] : gcur[h][0]; _v[1] = (nx) ? gnxt[h][1] : gcur[h][1]; PG8_STAGE(bufoff, base, _v); } \
        else { PG8_STAGE(bufoff, (base) + (h) * hstepA, voffA); } } while (0)
#define PG8_LDA(dst, b, h) do { _Pragma("unroll") for (int m = 0; m < 4; ++m) _Pragma("unroll") for (int k = 0; k < 2; ++k) dst[m][k] = *(const LAS bf16x8*)(lds + PG8_SA(b, h) + aoff + m * 2048 + k * 1024); } while (0)
#define PG8_LDB(dst, b, h) do { _Pragma("unroll") for (int n = 0; n < 2; ++n) _Pragma("unroll") for (int k = 0; k < 2; ++k) dst[n][k] = *(const LAS bf16x8*)(lds + PG8_SB(b, h) + boff + n * 2048 + k * 1024); } while (0)
#define PG8_MMA(ai, bj, At, Bt) do { __builtin_amdgcn_s_setprio(1); if constexpr (FP8) { _Pragma("unroll") for (int m = 0; m < 4; ++m) _Pragma("unroll") for (int n = 0; n < 2; ++n) { \
        const v8i32_t b8_ = __builtin_shufflevector(__builtin_bit_cast(v4i32_t, Bt[n][0]), __builtin_bit_cast(v4i32_t, Bt[n][1]), 0, 1, 2, 3, 4, 5, 6, 7), a8_ = __builtin_shufflevector(__builtin_bit_cast(v4i32_t, At[m][0]), __builtin_bit_cast(v4i32_t, At[m][1]), 0, 1, 2, 3, 4, 5, 6, 7); \
        asm volatile("s_nop 1\n\tv_mfma_scale_f32_16x16x128_f8f6f4 %0, %1, %2, %0, %3, %3 op_sel_hi:[0,0,0]" : "+v"(acc[ai][bj][m][n]) : "v"(b8_), "v"(a8_), "v"(scl8)); } } \
      else { _Pragma("unroll") for (int m = 0; m < 4; ++m) _Pragma("unroll") for (int n = 0; n < 2; ++n) _Pragma("unroll") for (int k = 0; k < 2; ++k) \
        acc[ai][bj][m][n] = __builtin_amdgcn_mfma_f32_16x16x32_bf16(Bt[n][k], At[m][k], acc[ai][bj][m][n], 0, 0, 0); } __builtin_amdgcn_s_setprio(0); } while (0)
#define PG8_MMA_Z(ai, bj, At, Bt) do { __builtin_amdgcn_s_setprio(1); if constexpr (FP8) { _Pragma("unroll") for (int m = 0; m < 4; ++m) _Pragma("unroll") for (int n = 0; n < 2; ++n) { \
        const v8i32_t b8_ = __builtin_shufflevector(__builtin_bit_cast(v4i32_t, Bt[n][0]), __builtin_bit_cast(v4i32_t, Bt[n][1]), 0, 1, 2, 3, 4, 5, 6, 7), a8_ = __builtin_shufflevector(__builtin_bit_cast(v4i32_t, At[m][0]), __builtin_bit_cast(v4i32_t, At[m][1]), 0, 1, 2, 3, 4, 5, 6, 7); \
        asm volatile("s_nop 1\n\tv_mfma_scale_f32_16x16x128_f8f6f4 %0, %1, %2, 0, %3, %3 op_sel_hi:[0,0,0]" : "=&v"(acc[ai][bj][m][n]) : "v"(b8_), "v"(a8_), "v"(scl8)); } } \
      __builtin_amdgcn_s_setprio(0); } while (0)
#define PG8_WAIT_V(n) asm volatile("s_waitcnt vmcnt(" #n ")" ::: "memory")
#define PG8_WAIT_L(n) asm volatile("s_waitcnt lgkmcnt(" #n ")" ::: "memory")
#define PG8_BAR __builtin_amdgcn_s_barrier()
#define PG8_SCHED __builtin_amdgcn_sched_barrier(0)
#define PG8_GLOAD(dst, u) do { if constexpr (GATHER) { _Pragma("unroll") for (int _h = 0; _h < 2; ++_h) _Pragma("unroll") for (int _i = 0; _i < 2; ++_i) \
        dst[_h][_i] = (unsigned)tokof[(u).pm * BM + _h * HALF + RA[_i]] * (unsigned)ldaB + (unsigned)CA2[_i]; } } while (0)
    Unit cur, nxt; int ui = 0;
    if (!S.next(0, cur)) return;
    PG8_GLOAD(gcur, cur);
    typename Epi::Pre pre = E.prefetch(cur, wr, fr);
    f32x4 acc[2][2][4][2];
#pragma unroll
    for (int a = 0; a < 2; ++a)
#pragma unroll
        for (int b = 0; b < 2; ++b)
#pragma unroll
            for (int m = 0; m < 4; ++m)
#pragma unroll
                for (int n = 0; n < 2; ++n) acc[a][b][m][n] = (f32x4){0.f, 0.f, 0.f, 0.f};
    bf16x8 At[4][2], B0[2][2], B1[2][2];
    const GAS char* cA = cur.a; const GAS char* cB = cur.b;
    PG8_STAGE(PG8_SB(0, 0), cB, voffB); PG8_STAGE(PG8_SB(0, 1), cB + hstepB, voffB); PG8_STAGE_A(PG8_SA(0, 0), cA, 0, false); PG8_STAGE_A(PG8_SA(0, 1), cA, 1, false);
    if (wr == 1) PG8_BAR;
    PG8_WAIT_V(2); PG8_BAR;
    PG8_STAGE(PG8_SB(1, 0), cB + kstep, voffB); PG8_STAGE_A(PG8_SA(1, 0), cA + kstep, 0, false); PG8_STAGE(PG8_SB(1, 1), cB + hstepB + kstep, voffB);
    PG8_WAIT_V(6); PG8_BAR;
    bool fresh = false;
    for (;;) {
        const bool has_next = S.next(ui + 1, nxt);
        if constexpr (GATHER) { if (has_next) { PG8_GLOAD(gnxt, nxt); } else { _Pragma("unroll") for (int _h = 0; _h < 2; ++_h) _Pragma("unroll") for (int _i = 0; _i < 2; ++_i) gnxt[_h][_i] = gcur[_h][_i]; } }
        const GAS char* nA = has_next ? nxt.a : cA; const GAS char* nB = has_next ? nxt.b : cB;
        const int ntu = VARK ? (cur.e ? nt / 2 : nt) : nt;
#pragma nounroll
        for (int t = 0; t < ntu; t += 2) {
            const bool last = (t == ntu - 2);
            const GAS char* a1 = cA + (size_t)(t + 1) * kstep;
            const GAS char* a2 = last ? nA : cA + (size_t)(t + 2) * kstep; const GAS char* b2 = last ? nB : cB + (size_t)(t + 2) * kstep;
            const GAS char* a3 = a2 + kstep; const GAS char* b3 = b2 + kstep;
            const bool fe = fresh; fresh = false;
            if constexpr (MIDSCALE) { if (t == nt / 2) {
#pragma unroll
                for (int ai = 0; ai < 2; ++ai)
#pragma unroll
                    for (int m = 0; m < 4; ++m) { const float r_ = scl[ui * 256 + ai * 128 + wr * 64 + m * 16 + fr][0];
#pragma unroll
                        for (int bj = 0; bj < 2; ++bj)
#pragma unroll
                            for (int n = 0; n < 2; ++n) acc[ai][bj][m][n] *= r_; } } }
            PG8_LDB(B0, 0, 0); PG8_LDB(B1, 0, 1); PG8_SCHED; PG8_LDA(At, 0, 0); PG8_STAGE_A(PG8_SA(1, 1), a1, 1, false);
            if (fe) wait_vm<8 + Epi::NST>(); else PG8_WAIT_V(8); PG8_WAIT_L(0); PG8_BAR; if (FP8 && t == 0) { PG8_MMA_Z(0, 0, At, B0); PG8_MMA_Z(0, 1, At, B1); } else { PG8_MMA(0, 0, At, B0); PG8_MMA(0, 1, At, B1); } PG8_BAR; PG8_SCHED;
            PG8_LDA(At, 0, 1); PG8_STAGE(PG8_SB(0, 0), b2, voffB); PG8_STAGE(PG8_SB(0, 1), b2 + hstepB, voffB); PG8_STAGE_A(PG8_SA(0, 0), a2, 0, last);
            if (fe) wait_vm<8 + Epi::NST>(); else PG8_WAIT_V(8); PG8_WAIT_L(0); PG8_BAR; if (FP8 && t == 0) { PG8_MMA_Z(1, 0, At, B0); PG8_MMA_Z(1, 1, At, B1); } else { PG8_MMA(1, 0, At, B0); PG8_MMA(1, 1, At, B1); } PG8_BAR; PG8_SCHED;
            PG8_LDB(B0, 1, 0); PG8_LDB(B1, 1, 1); PG8_SCHED; PG8_LDA(At, 1, 0); PG8_STAGE_A(PG8_SA(0, 1), a2, 1, last);
            PG8_WAIT_V(8); PG8_WAIT_L(0); PG8_BAR; PG8_MMA(0, 0, At, B0); PG8_MMA(0, 1, At, B1); PG8_BAR; PG8_SCHED;
            PG8_LDA(At, 1, 1); PG8_STAGE(PG8_SB(1, 0), b3, voffB); PG8_STAGE(PG8_SB(1, 1), b3 + hstepB, voffB); PG8_STAGE_A(PG8_SA(1, 0), a3, 0, last);
            PG8_WAIT_V(8); PG8_WAIT_L(0); PG8_BAR; PG8_MMA(1, 0, At, B0); PG8_MMA(1, 1, At, B1); PG8_BAR; PG8_SCHED;
        }
        if constexpr (ALIGN_EPI) { if (wr == 0) PG8_BAR; }
        if constexpr (FP8) {
            asm volatile("s_nop 15\n\ts_nop 15" ::: "memory");
#pragma unroll
            for (int a = 0; a < 2; ++a)
#pragma unroll
                for (int b = 0; b < 2; ++b)
                    asm volatile("" : "+v"(acc[a][b][0][0]), "+v"(acc[a][b][0][1]), "+v"(acc[a][b][1][0]), "+v"(acc[a][b][1][1]), "+v"(acc[a][b][2][0]), "+v"(acc[a][b][2][1]), "+v"(acc[a][b][3][0]), "+v"(acc[a][b][3][1])); }
        if constexpr (MIDSCALE) E(acc, cur, wr, wc, fr, fq, scl + ui * 256); else E(acc, cur, wr, wc, fr, fq, pre);
        if (!has_next) break;
        pre = E.prefetch(nxt, wr, fr);
        if constexpr (FP8) {
#pragma unroll
            for (int a = 0; a < 2; ++a)
#pragma unroll
                for (int b = 0; b < 2; ++b)
                    asm volatile("" : "=v"(acc[a][b][0][0]), "=v"(acc[a][b][0][1]), "=v"(acc[a][b][1][0]), "=v"(acc[a][b][1][1]), "=v"(acc[a][b][2][0]), "=v"(acc[a][b][2][1]), "=v"(acc[a][b][3][0]), "=v"(acc[a][b][3][1]));
        } else {
#pragma unroll
            for (int a = 0; a < 2; ++a)
#pragma unroll
                for (int b = 0; b < 2; ++b)
#pragma unroll
                    for (int m = 0; m < 4; ++m)
#pragma unroll
                        for (int n = 0; n < 2; ++n) acc[a][b][m][n] = (f32x4){0.f, 0.f, 0.f, 0.f};
        }
        cur = nxt; cA = nA; cB = nB; ++ui; fresh = true;
        if constexpr (GATHER) { _Pragma("unroll") for (int _h = 0; _h < 2; ++_h) _Pragma("unroll") for (int _i = 0; _i < 2; ++_i) gcur[_h][_i] = gnxt[_h][_i]; }
        if constexpr (ALIGN_EPI) { if (wr == 1) PG8_BAR; }
    }
    PG8_WAIT_V(0);
    if constexpr (!ALIGN_EPI) { if (wr == 0) PG8_BAR; }
    PG8_BAR;
#undef PG8_SA
#undef PG8_SB
#undef PG8_STAGE
#undef PG8_STAGE_A
#undef PG8_LDA
#undef PG8_LDB
#undef PG8_MMA
#undef PG8_MMA_Z
#undef PG8_WAIT_V
#undef PG8_WAIT_L
#undef PG8_BAR
#undef PG8_SCHED
#undef PG8_GLOAD
}
}
using pg8::Unit;

struct BatchOrder {
    int nN, v; const GAS char* A; const GAS char* B; size_t aT, bT;
    __device__ __forceinline__ bool next(int i, Unit& u) const {
        const int uu = i * 16 + (v & 15); if (uu >= 8 * nN) return false;
        u.pm = __builtin_amdgcn_readfirstlane((v >> 4) * 8 + uu / nN); u.pn = __builtin_amdgcn_readfirstlane(uu % nN); u.e = 0;
        u.a = A + (size_t)u.pm * aT; u.b = B + (size_t)u.pn * bT; return true;
    }
};
struct UpOrder {
    int v; const GAS char* LATp; const GAS char* Wq; const GAS char* Wkv;
    __device__ __forceinline__ bool next(int i, Unit& u) const {
        const int j = v & 15; const bool hi = j >= 8; if (i >= (hi ? 4 : 3)) return false;
        const bool kv = hi ? (i < 3) : (i == 2); u.pn = __builtin_amdgcn_readfirstlane(hi ? (kv ? 1 + i : 2) : (kv ? 0 : i)); u.e = __builtin_amdgcn_readfirstlane(kv ? 1 : 0); u.pm = __builtin_amdgcn_readfirstlane((v >> 4) * 8 + (j & 7));
        u.a = LATp + (size_t)u.pm * 256 * 512 * 2 + (u.e ? 512 : 0);
        u.b = (u.e ? Wkv : Wq) + (size_t)u.pn * 256 * 256 * 2; return true;
    }
};
struct MoeOrder {
    int G, c; const volatile LAS int* TS; const GAS char* A; const GAS char* W; size_t aT  , wE  , wT  ;
    __device__ __forceinline__ bool next(int i, Unit& u) const {
        const int L = i * G + c; const int ntile = __builtin_amdgcn_readfirstlane(TS[32]); if (L >= ntile * 4) return false;
        const int rt = L >> 2, ct = L & 3;
        const int ln_ = (int)__builtin_amdgcn_mbcnt_hi(~0u, __builtin_amdgcn_mbcnt_lo(~0u, 0u)); const int tsv_ = TS[ln_ & 31];
        const int e = __builtin_popcountll(__ballot(ln_ >= 1 && ln_ < 32 && tsv_ <= rt));
        u.pm = rt; u.pn = ct; u.e = e; u.a = A + (size_t)rt * aT; u.b = W + (size_t)e * wE + (size_t)ct * wT; return true;
    }
};

__device__ __forceinline__ u32x4 pack8(f32x4 v0, f32x4 v1) { u32x4 w; w.x = cvt_pk_bf16(v0[0], v0[1]); w.y = cvt_pk_bf16(v0[2], v0[3]); w.z = cvt_pk_bf16(v1[0], v1[1]); w.w = cvt_pk_bf16(v1[2], v1[3]); return w; }

__device__ __forceinline__ void wide_store(GAS bf16* p, long dB, bool lo, u32x4 X, u32x4 Y) {
    u32x4 Yr;
#pragma unroll
    for (int j = 0; j < 4; ++j) Yr[j] = (unsigned)__builtin_amdgcn_update_dpp(0, (int)Y[j], 0x128, 0xf, 0xf, false);
    u32x4 A, B;
#pragma unroll
    for (int j = 0; j < 4; ++j) { A[j] = lo ? X[j] : Yr[j]; B[j] = lo ? Yr[j] : X[j]; }
    *(GAS u32x4*)p = A; *(GAS u32x4*)(p + dB) = B;
}

struct EpiWin {
    static constexpr int NST = 16;
    static constexpr bool PERM = true, WIDE = true;
    GAS bf16* LAT_; GAS bf16* FQKV_; GAS bf16* KPE_; GAS float* FLOG_; GAS float* SSQ_; const GAS float* COS_; const GAS float* SIN_; const GAS float* RSX_;
    struct Pre { float v[8]; };
    __device__ __forceinline__ Pre prefetch(const Unit& u, int wr, int fr) const { Pre p; const GAS float* RSX = RSX_; asm volatile("" : "+s"(RSX));
#pragma unroll
        for (int g = 0; g < 8; ++g) p.v[g] = RSX[u.pm * 256 + (g >> 2) * 128 + wr * 64 + (g & 3) * 16 + fr]; return p; }
    __device__ __forceinline__ void operator()(f32x4 (&acc)[2][2][4][2], const Unit& u, int wr, int wc, int fr, int fq, const Pre& pre) const {
        GAS bf16* LAT = LAT_; GAS bf16* FQKV = FQKV_; GAS bf16* KPE = KPE_; GAS float* FLOG = FLOG_; GAS float* SSQ = SSQ_; const GAS float* COS = COS_; const GAS float* SIN = SIN_; const GAS float* RSX = RSX_;
        asm volatile("" : "+s"(LAT), "+s"(FQKV), "+s"(KPE), "+s"(FLOG), "+s"(SSQ), "+s"(COS), "+s"(SIN), "+s"(RSX));
        {
#pragma unroll
            for (int ai = 0; ai < 2; ++ai)
#pragma unroll
                for (int m = 0; m < 4; ++m) { const float rs_ = pre.v[ai * 4 + m];
#pragma unroll
                    for (int bj = 0; bj < 2; ++bj)
#pragma unroll
                        for (int n = 0; n < 2; ++n) acc[ai][bj][m][n] *= rs_; } }
        const int row0 = u.pm * 256 + wr * 64 + fr; const int pn = u.pn;
        const bool lo = fr < 8; const int roww = u.pm * 256 + wr * 64 + (fr & 7), colw = wc * 64 + (fr >> 3) * 32 + 8 * fq; const long dB = 8 * 512 + (lo ? 32 : -32);
        if (pn >= 2) {
            const int ti = pn >> 1; GAS bf16* dst = FQKV + (size_t)(ti - 1) * NTOK * 512 + (pn & 1) * 256 + colw; const float sc = (ti == 1) ? C2F : 1.f;
#pragma unroll
            for (int ai = 0; ai < 2; ++ai)
#pragma unroll
                for (int m = 0; m < 4; ++m) wide_store(dst + (size_t)(roww + ai * 128 + m * 16) * 512, dB, lo, pack8(acc[ai][0][m][0] * sc, acc[ai][0][m][1] * sc), pack8(acc[ai][1][m][0] * sc, acc[ai][1][m][1] * sc));
        } else {
#pragma unroll
            for (int ai = 0; ai < 2; ++ai)
#pragma unroll
                for (int m = 0; m < 4; ++m) { const int row = row0 + ai * 128 + m * 16;
                    if (pn == 0 || wc != 2) wide_store(LAT + (size_t)(roww + ai * 128 + m * 16) * 512 + pn * 256 + colw, dB, lo, pack8(acc[ai][0][m][0], acc[ai][0][m][1]), pack8(acc[ai][1][m][0], acc[ai][1][m][1]));
                    float s = 0.f;
                    if (pn == 0 || wc < 2) {
#pragma unroll
                        for (int bj = 0; bj < 2; ++bj)
#pragma unroll
                            for (int n = 0; n < 2; ++n) { const f32x4 x = acc[ai][bj][m][n]; s += (x[0] * x[0] + x[1] * x[1]) + (x[2] * x[2] + x[3] * x[3]); }
                    }
                    s += __shfl_xor(s, 16); s += __shfl_xor(s, 32);
                    if (fq == 0) SSQ[(size_t)row * 8 + pn * 4 + wc] = s;
                    }
            if (pn == 1 && wc == 2) {
#pragma unroll
                for (int ai = 0; ai < 2; ++ai)
#pragma unroll
                    for (int m = 0; m < 4; ++m) { const int row = row0 + ai * 128 + m * 16;
                        const f32x4 c = *(const GAS f32x4*)(COS + (size_t)row * 16 + 4 * fq), sn = *(const GAS f32x4*)(SIN + (size_t)row * 16 + 4 * fq);
                        const f32x4 x1 = acc[ai][0][m][0], x2 = acc[ai][0][m][1];
                        *(GAS u32x4*)(KPE + (size_t)row * 32 + 8 * fq) = pack8(x1 * c - x2 * sn, x1 * sn + x2 * c);
                        }
            }
            if (pn == 1 && wc == 2 && fq == 0) {
#pragma unroll
                for (int ai = 0; ai < 2; ++ai)
#pragma unroll
                    for (int m = 0; m < 4; ++m) { const int row = row0 + ai * 128 + m * 16; *(GAS f32x4*)(FLOG + (size_t)row * 8) = acc[ai][1][m][0]; *(GAS f32x4*)(FLOG + (size_t)row * 8 + 4) = acc[ai][1][m][1]; }
            }
        }
    }
};
struct EpiUp {
    static constexpr int NST = 16;
    static constexpr bool PERM = true, WIDE = true;
    GAS bf16* QM_; GAS bf16* KVM_; const GAS float* SSQ_; const GAS float* COS_; const GAS float* SIN_;
    struct Pre { f32x4 v[8]; };
    __device__ __forceinline__ Pre prefetch(const Unit& u, int wr, int fr) const { Pre p; const GAS float* SSQ = SSQ_; asm volatile("" : "+s"(SSQ)); const int off = u.e ? 4 : 0;
#pragma unroll
        for (int g = 0; g < 8; ++g) p.v[g] = *(const GAS f32x4*)(SSQ + (size_t)(u.pm * 256 + (g >> 2) * 128 + wr * 64 + (g & 3) * 16 + fr) * 8 + off); return p; }
    __device__ __forceinline__ void operator()(const f32x4 (&acc)[2][2][4][2], const Unit& u, int wr, int wc, int fr, int fq, const Pre& pre) const {
        GAS bf16* QM = QM_; GAS bf16* KVM = KVM_; const GAS float* SSQ = SSQ_; const GAS float* COS = COS_; const GAS float* SIN = SIN_;
        asm volatile("" : "+s"(QM), "+s"(KVM), "+s"(SSQ), "+s"(COS), "+s"(SIN));
        const int row0 = u.pm * 256 + wr * 64 + fr; const int pn = u.pn; const bool kv = u.e != 0;
        const bool lo = fr < 8; const int roww = u.pm * 256 + wr * 64 + (fr & 7), colw = pn * 256 + wc * 64 + (fr >> 3) * 32 + 8 * fq;
#pragma unroll
        for (int ai = 0; ai < 2; ++ai)
#pragma unroll
            for (int m = 0; m < 4; ++m) { const int row = row0 + ai * 128 + m * 16;
                const f32x4 sq = pre.v[ai * 4 + m];
                const float ss = (sq[0] + sq[1]) + (sq[2] + sq[3]);
                if (kv) {
                    const float rs = rsqrtf(ss * (1.f / 128.f) + EPS);
                    wide_store(KVM + (size_t)(roww + ai * 128 + m * 16) * 1024 + colw, 8 * 1024 + (lo ? 32 : -32), lo, pack8(acc[ai][0][m][0] * rs, acc[ai][0][m][1] * rs), pack8(acc[ai][1][m][0] * rs, acc[ai][1][m][1] * rs));
                } else {
                    const float rs = rsqrtf(ss * (1.f / 256.f) + EPS) * C2M;
                    const f32x4 c = *(const GAS f32x4*)(COS + (size_t)row * 16 + 4 * fq), sn = *(const GAS f32x4*)(SIN + (size_t)row * 16 + 4 * fq);
                    u32x4 XY[2];
#pragma unroll
                    for (int bj = 0; bj < 2; ++bj) { f32x4 v0 = acc[ai][bj][m][0] * rs, v1 = acc[ai][bj][m][1] * rs;
                        const int G = 8 * pn + 2 * wc + bj;
                        if (G % 3 == 2) { const f32x4 x1 = v0, x2 = v1; v0 = x1 * c - x2 * sn; v1 = x1 * sn + x2 * c; }
                        XY[bj] = pack8(v0, v1); }
                    wide_store(QM + (size_t)(roww + ai * 128 + m * 16) * 768 + colw, 8 * 768 + (lo ? 32 : -32), lo, XY[0], XY[1]);
                }

            }
    }
};
template <bool RES_F32> struct EpiOut {
    static constexpr int NST = 16;
    static constexpr bool PERM = true, WIDE = true;
    const GAS float* resf_; GAS bf16* xr_;
    struct Pre {}; __device__ __forceinline__ Pre prefetch(const Unit&, int, int) const { return Pre{}; }
    __device__ __forceinline__ void operator()(const f32x4 (&acc)[2][2][4][2], const Unit& u, int wr, int wc, int fr, int fq, const LAS f32x2* scl) const {
        const GAS float* resf = resf_; GAS bf16* xr = xr_; asm volatile("" : "+s"(resf), "+s"(xr));
        const int row0 = u.pm * 256 + wr * 64 + fr, col0 = u.pn * 256 + wc * 64 + 8 * fq;
        const bool lo = fr < 8; const int roww = u.pm * 256 + wr * 64 + (fr & 7), colw = u.pn * 256 + wc * 64 + (fr >> 3) * 32 + 8 * fq;
#pragma unroll
        for (int ai = 0; ai < 2; ++ai)
#pragma unroll
            for (int m = 0; m < 4; ++m) { const size_t off = (size_t)(row0 + ai * 128 + m * 16) * DM + col0; const float sh = scl[ai * 128 + wr * 64 + m * 16 + fr][1];
                u32x4 XY[2];
#pragma unroll
                for (int bj = 0; bj < 2; ++bj) { f32x4 r0, r1;
                    if constexpr (RES_F32) { r0 = *(const GAS f32x4*)(resf + off + bj * 32); r1 = *(const GAS f32x4*)(resf + off + bj * 32 + 4); }
                    else { const u32x4 w = *(const GAS u32x4*)(xr + off + bj * 32);
                        r0 = (f32x4){__uint_as_float(w.x << 16), __uint_as_float(w.x & 0xffff0000u), __uint_as_float(w.y << 16), __uint_as_float(w.y & 0xffff0000u)};
                        r1 = (f32x4){__uint_as_float(w.z << 16), __uint_as_float(w.z & 0xffff0000u), __uint_as_float(w.w << 16), __uint_as_float(w.w & 0xffff0000u)}; }
                    XY[bj] = pack8(r0 + acc[ai][bj][m][0] * sh, r1 + acc[ai][bj][m][1] * sh); }
                wide_store(xr + (size_t)(roww + ai * 128 + m * 16) * DM + colw, 8 * DM + (lo ? 32 : -32), lo, XY[0], XY[1]); }
    }
};
struct EpiGU {
    static constexpr int NST = 4;
    static constexpr bool PERM = true, WIDE = false;
    GAS unsigned char* HH_; const GAS float* RS_;
    struct Pre { float v[8]; };
    __device__ __forceinline__ Pre prefetch(const Unit& u, int wr, int fr) const { Pre p; const GAS float* RS = RS_; asm volatile("" : "+s"(RS));
#pragma unroll
        for (int g = 0; g < 8; ++g) p.v[g] = RS[u.pm * 256 + (g >> 2) * 128 + wr * 64 + (g & 3) * 16 + fr]; return p; }
    __device__ __forceinline__ void operator()(const f32x4 (&acc)[2][2][4][2], const Unit& u, int wr, int wc, int fr, int fq, const Pre& pre) const {
        GAS unsigned char* HH = HH_; const GAS float* RS = RS_; asm volatile("" : "+s"(HH), "+s"(RS));
        const int row0 = u.pm * 256 + wr * 64 + fr;
#pragma unroll
        for (int ai = 0; ai < 2; ++ai)
#pragma unroll
            for (int mp = 0; mp < 2; ++mp) {
                u32x2 w[2];
#pragma unroll
                for (int q = 0; q < 2; ++q) { const int m = 2 * mp + q; const float rs = pre.v[ai * 4 + m] * WSCALE_INV;
                    f32x4 h[2];
#pragma unroll
                    for (int n = 0; n < 2; ++n) { const f32x4 g = acc[ai][0][m][n] * rs, up = acc[ai][1][m][n] * rs;
#pragma unroll
                        for (int j = 0; j < 4; ++j) { const float sg = __builtin_amdgcn_rcpf(1.f + __builtin_amdgcn_exp2f(-g[j] * LOG2E)); h[n][j] = g[j] * sg * up[j]; } }
                    w[q].x = pk4_fp8(h[0][0], h[0][1], h[0][2], h[0][3]); w[q].y = pk4_fp8(h[1][0], h[1][1], h[1][2], h[1][3]); }
                const auto s0 = __builtin_amdgcn_permlane16_swap(w[0].x, w[1].x, false, false), s1 = __builtin_amdgcn_permlane16_swap(w[0].y, w[1].y, false, false);
                *(GAS u32x4*)(HH + (size_t)(row0 + ai * 128 + (2 * mp + (fq & 1)) * 16) * 512 + u.pn * 128 + wc * 32 + (fq >> 1) * 16) = (u32x4){s0[0], s1[0], s0[1], s1[1]}; }
    }
};
struct EpiDown {
    static constexpr int NST = 8;
    static constexpr bool PERM = true, WIDE = true;
    GAS unsigned char* Y_; const GAS float* GATEOF_;
    struct Pre { float v[8]; };
    __device__ __forceinline__ Pre prefetch(const Unit& u, int wr, int fr) const { Pre p; const GAS float* GT = GATEOF_; asm volatile("" : "+s"(GT));
#pragma unroll
        for (int g = 0; g < 8; ++g) p.v[g] = GT[u.pm * 256 + (g >> 2) * 128 + wr * 64 + (g & 3) * 16 + fr]; return p; }
    __device__ __forceinline__ void operator()(const f32x4 (&acc)[2][2][4][2], const Unit& u, int wr, int wc, int fr, int fq, const Pre& pre) const {
        GAS unsigned char* Y = Y_; const GAS float* GATEOF = GATEOF_; asm volatile("" : "+s"(Y), "+s"(GATEOF));
        const int row0 = u.pm * 256 + wr * 64 + fr;
#pragma unroll
        for (int ai = 0; ai < 2; ++ai)
#pragma unroll
            for (int m = 0; m < 4; ++m) { const int row = row0 + ai * 128 + m * 16; const float g = pre.v[ai * 4 + m];
                u32x2 w[2];
#pragma unroll
                for (int bj = 0; bj < 2; ++bj) { const f32x4 v0 = acc[ai][bj][m][0] * g, v1 = acc[ai][bj][m][1] * g; w[bj].x = pk4_fp8(v0[0], v0[1], v0[2], v0[3]); w[bj].y = pk4_fp8(v1[0], v1[1], v1[2], v1[3]); }
                const auto s0 = __builtin_amdgcn_permlane16_swap(w[0].x, w[1].x, false, false), s1 = __builtin_amdgcn_permlane16_swap(w[0].y, w[1].y, false, false);
                *(GAS u32x4*)(Y + (size_t)row * 1024 + u.pn * 256 + wc * 64 + (fq & 1) * 32 + (fq >> 1) * 16) = (u32x4){s0[0], s1[0], s0[1], s1[1]}; }
    }
};

namespace att {
constexpr int KSLOT = 12288, VSLOT = 8192;
constexpr int L_K = 0, L_V = 2 * KSLOT, L_BIAS = L_V + 2 * VSLOT, L_WS = L_BIAS + 8192, L_OST = L_WS + 8 * 64 * 4, L_END = L_OST + 8 * 4096;
__device__ __forceinline__ int crow(int r, int hi) { return (r & 3) + 8 * (r >> 2) + 4 * hi; }
typedef short v4i16_t __attribute__((ext_vector_type(4)));
__device__ __forceinline__ s16x4 vtr(const LAS char* p) { return __builtin_bit_cast(s16x4, __builtin_amdgcn_ds_read_tr16_b64_v4i16((LAS v4i16_t*)p)); }

constexpr int NSL = 5;
constexpr int R_K = 0, R_V = NSL * KSLOT, R_WS = R_V + NSL * VSLOT, R_OST = R_WS + 8 * 64 * 4, R_END = R_OST + 8 * 4096;
static_assert(R_END <= RING_BYTES, "attention LDS");
__device__ __forceinline__ void glds16(const GAS void* gsrc, unsigned lds_dst) { unsigned keep;
    asm volatile("s_mov_b32 %0, m0\n\ts_mov_b32 m0, %2\n\ts_nop 0\n\tglobal_load_lds_dwordx4 %1, off\n\ts_mov_b32 m0, %0" : "=&s"(keep) : "v"(gsrc), "s"(lds_dst) : "memory"); }
__device__ __forceinline__ void glds16s(const GAS void* sbase, unsigned voff, unsigned lds_dst) { unsigned keep;
    asm volatile("s_mov_b32 %0, m0\n\ts_mov_b32 m0, %3\n\ts_nop 0\n\tglobal_load_lds_dwordx4 %1, %2\n\ts_mov_b32 m0, %0" : "=&s"(keep) : "v"(voff), "s"((unsigned long long)sbase), "s"(lds_dst) : "memory"); }
struct Tens2 { const GAS bf16* Q; int qp; const GAS bf16* K; int kp; const GAS bf16* KX; const GAS bf16* V; int vp; GAS bf16* O; const GAS float* BIASF; const GAS float* NRM; GAS float* OSS; };
template <int MODE>
__device__ __forceinline__ int attn_unit2(const int wave_, int b, int h, int qb, const Tens2& T, LAS char* shm, const int slbase, const bool have_pro, const int qb_next, bf16x8 (&qr)[6], const int tstart) {
    constexpr int DKS = MODE ? 6 : 5, DKH = 3;
    constexpr float THR = 8.f;
    int wid = wave_; asm volatile("" : "+s"(wid));
    int lane = (int)__builtin_amdgcn_mbcnt_hi(~0u, __builtin_amdgcn_mbcnt_lo(~0u, 0u)); asm volatile("" : "+v"(lane)); const int r32 = lane & 31, hi = lane >> 5;
    const long rowbase = (long)b * SEQ; const int q0 = qb * 256, qw0 = q0 + wid * 32;
    const int NT = (q0 + 256) / 64, tlast = qw0 / 64;
    const int NTE = NT - tstart;
    const GAS bf16* Qw = T.Q + (rowbase + qw0) * T.qp + h * (MODE ? 96 : 64);
    const GAS bf16* Kh = T.K + rowbase * T.kp + h * (MODE ? 128 : 64);
    const GAS bf16* Vh = T.V + rowbase * T.vp + h * (MODE ? 128 : 64);
    LAS float* wsf = (LAS float*)(shm + R_WS) + wid * 64;
    const unsigned koff = (unsigned)(lane * T.kp + wid * 8) * 2u;
    const unsigned xoff = MODE ? (unsigned)(lane * 32 + (wid & 3) * 8) * 2u : (unsigned)(lane * 8) * 2u;
    const unsigned voff = (unsigned)((16 * (wid & 3) + (lane >> 2)) * T.vp + (wid >> 2) * 32 + (lane & 3) * 8) * 2u;
    const GAS bf16* xbase = MODE ? T.KX + rowbase * 32 : T.KX + ((long)b * 8 + h) * SEQ * 8;
    const int xstep = MODE ? 64 * 32 : 64 * 8;
    const unsigned kdst_a = (unsigned)(uintptr_t)(shm + R_K) + (unsigned)wid * 1024u, xdst_a = (unsigned)(uintptr_t)(shm + R_K) + (unsigned)(8 + (MODE ? (wid & 3) : 0)) * 1024u, vdst_a = (unsigned)(uintptr_t)(shm + R_V) + (unsigned)wid * 1024u;
#define A2_DMA(t, slot) do { \
        glds16s((const GAS void*)(Kh + (long)(t) * 64 * T.kp), koff, (unsigned)__builtin_amdgcn_readfirstlane((int)(kdst_a + (slot) * KSLOT))); \
        glds16s((const GAS void*)(xbase + (long)(t) * xstep), xoff, (unsigned)__builtin_amdgcn_readfirstlane((int)(xdst_a + (slot) * KSLOT))); \
        glds16s((const GAS void*)(Vh + (long)(t) * 64 * T.vp), voff, (unsigned)__builtin_amdgcn_readfirstlane((int)(vdst_a + (slot) * VSLOT))); } while (0)
    float mhat = 0.f, lrun = 0.f; f32x16 o[2]; o[0] = f32x16{}; o[1] = f32x16{}; f32x16 negm = f32x16{};
    const LAS char* vp0 = shm + R_V + ((lane >> 4) & 1) * 32 + (lane & 3) * 8 + (4 * hi + ((lane & 15) >> 2)) * 64;
#define A3_SLOT(k) ((slbase + (k)) % NSL)
    if (!have_pro) { A2_DMA(NT - 1, A3_SLOT(0)); A2_DMA(NT - 2, A3_SLOT(1)); A2_DMA(NT - 3, A3_SLOT(2)); }
    if (!have_pro) {
#pragma unroll
        for (int d0 = 0; d0 < (MODE ? 6 : 4); ++d0) qr[d0] = *(const GAS bf16x8*)(Qw + (long)r32 * T.qp + d0 * 16 + hi * 8); }
    if (MODE == 0) { const short one = hi ? (short)0 : (short)0x3F80; qr[DKS - 1] = (bf16x8){one, one, one, 0, 0, 0, 0, 0}; }
#pragma unroll
    for (int d0 = 0; d0 < DKS; ++d0) asm volatile("" : "+v"(qr[d0]));
#define A3_KLOADH(slot, H) do { const LAS char* kb_ = shm + R_K + (slot) * KSLOT + r32 * 16; _Pragma("unroll") for (int d0 = (H) * DKH; d0 < ((H) ? DKS : DKH); ++d0) { const int off = (MODE == 0 && d0 == 4) ? 8 * 1024 : d0 * 2048 + hi * 1024; \
        kf[2 * (d0 - (H) * DKH)] = *(const LAS bf16x8*)(kb_ + off); kf[2 * (d0 - (H) * DKH) + 1] = *(const LAS bf16x8*)(kb_ + off + 512); } } while (0)
#define A3_VLOAD(slot) do { const LAS char* vp_ = vp0 + (slot) * VSLOT; _Pragma("unroll") for (int q = 0; q < 8; ++q) { vlo[q] = vtr(vp_ + (q >> 2) * 4096 + (q & 3) * 1024); vhh[q] = vtr(vp_ + (q >> 2) * 4096 + (q & 3) * 1024 + 512); } } while (0)
#define A3_QKH(H) do { if ((H) == 0) { c0 = negm; c1 = negm; } _Pragma("unroll") for (int d0 = (H) * DKH; d0 < ((H) ? DKS : DKH); ++d0) { c0 = __builtin_amdgcn_mfma_f32_32x32x16_bf16(kf[2 * (d0 - (H) * DKH)], qr[d0], c0, 0, 0, 0); c1 = __builtin_amdgcn_mfma_f32_32x32x16_bf16(kf[2 * (d0 - (H) * DKH) + 1], qr[d0], c1, 0, 0, 0); } } while (0)
#define A3_EXP() do { float ls_ = 0.f; _Pragma("unroll") for (int r = 0; r < 16; ++r) { pp0[r] = __builtin_amdgcn_exp2f(pp0[r]); pp1[r] = __builtin_amdgcn_exp2f(pp1[r]); ls_ += pp0[r] + pp1[r]; } lrun += ls_; u32x4 w_; \
        w_.x = cvt_pk_bf16(pp0[0], pp0[1]); w_.y = cvt_pk_bf16(pp0[2], pp0[3]); w_.z = cvt_pk_bf16(pp0[4], pp0[5]); w_.w = cvt_pk_bf16(pp0[6], pp0[7]); pa[0] = __builtin_bit_cast(bf16x8, w_); \
        w_.x = cvt_pk_bf16(pp0[8], pp0[9]); w_.y = cvt_pk_bf16(pp0[10], pp0[11]); w_.z = cvt_pk_bf16(pp0[12], pp0[13]); w_.w = cvt_pk_bf16(pp0[14], pp0[15]); pa[1] = __builtin_bit_cast(bf16x8, w_); \
        w_.x = cvt_pk_bf16(pp1[0], pp1[1]); w_.y = cvt_pk_bf16(pp1[2], pp1[3]); w_.z = cvt_pk_bf16(pp1[4], pp1[5]); w_.w = cvt_pk_bf16(pp1[6], pp1[7]); pa[2] = __builtin_bit_cast(bf16x8, w_); \
        w_.x = cvt_pk_bf16(pp1[8], pp1[9]); w_.y = cvt_pk_bf16(pp1[10], pp1[11]); w_.z = cvt_pk_bf16(pp1[12], pp1[13]); w_.w = cvt_pk_bf16(pp1[14], pp1[15]); pa[3] = __builtin_bit_cast(bf16x8, w_); } while (0)
#define A3_PV() do { _Pragma("unroll") for (int d0 = 0; d0 < 2; ++d0) _Pragma("unroll") for (int k = 0; k < 4; ++k) { const s16x4 lo_ = vlo[4 * d0 + k], hh_ = vhh[4 * d0 + k]; \
        const bf16x8 vf_ = (bf16x8){lo_[0], lo_[1], lo_[2], lo_[3], hh_[0], hh_[1], hh_[2], hh_[3]}; o[d0] = __builtin_amdgcn_mfma_f32_32x32x16_bf16(pa[k], vf_, o[d0], 0, 0, 0); } } while (0)
#define A3_ROWMAX(rm) do { float a_ = fmaxf(fmaxf(c0[0], c0[1]), c1[0]), b_ = fmaxf(fmaxf(c0[2], c0[3]), c1[1]); a_ = fmaxf(fmaxf(a_, c1[2]), c1[3]); \
        _Pragma("unroll") for (int r = 4; r < 16; r += 4) { a_ = fmaxf(fmaxf(a_, c0[r]), c0[r + 1]); b_ = fmaxf(fmaxf(b_, c0[r + 2]), c0[r + 3]); a_ = fmaxf(fmaxf(a_, c1[r]), c1[r + 1]); b_ = fmaxf(fmaxf(b_, c1[r + 2]), c1[r + 3]); } \
        rm = fmaxf(a_, b_); const auto rr_ = __builtin_amdgcn_permlane32_swap(__float_as_uint(rm), __float_as_uint(rm), false, false); rm = fmaxf(__uint_as_float(rr_[0]), __uint_as_float(rr_[1])); } while (0)
    int sl = A3_SLOT(0), sl3 = A3_SLOT(3);
    f32x16 pp0 = f32x16{}, pp1 = f32x16{}; bool pend = false; int pslot = 0;
    for (int i = 0; i < NTE; ++i) {
        const int t = NT - 1 - i;
        { const int ahead = NTE - 1 - i;
          if (ahead >= 2) asm volatile("s_waitcnt vmcnt(6)" ::: "memory"); else if (ahead == 1) asm volatile("s_waitcnt vmcnt(3)" ::: "memory"); else asm volatile("s_waitcnt vmcnt(0)" ::: "memory"); }
        __builtin_amdgcn_s_barrier(); asm volatile("" ::: "memory");
        if (i + 3 < NTE) A2_DMA(t - 3, sl3);
        if (i == NTE - 1 && qb_next >= 0) { const int NTn = 4 * qb_next + 4; A2_DMA(NTn - 1, A3_SLOT(NTE)); A2_DMA(NTn - 2, A3_SLOT(NTE + 1)); A2_DMA(NTn - 3, A3_SLOT(NTE + 2)); }
        if (t <= tlast) {
            bf16x8 kf[2 * DKH]; f32x16 c0, c1; float rm;
            A3_KLOADH(sl, 0);
            if (!pend) {
                A3_QKH(0); A3_KLOADH(sl, 1); A3_QKH(1);
                if (MODE == 0) { const int qrel = qw0 + r32 - 64 * t;
#pragma unroll
                    for (int r = 0; r < 16; ++r) { const int kv = crow(r, hi); if (kv > qrel) c0[r] = -INFINITY; if (kv + 32 > qrel) c1[r] = -INFINITY; } }
                A3_ROWMAX(rm);
                mhat = rm;
#pragma unroll
                for (int r = 0; r < 16; ++r) { c0[r] -= rm; c1[r] -= rm; negm[r] = -mhat; }
                pend = true;
            } else {
                s16x4 vlo[8], vhh[8]; bf16x8 pa[4];
                A3_QKH(0); A3_KLOADH(sl, 1);
                A3_VLOAD(pslot);
                A3_QKH(1);
                A3_EXP();
#pragma unroll
                for (int g_ = 0; g_ < 2 * DKS; ++g_) { __builtin_amdgcn_sched_group_barrier(0x008, 1, 0); __builtin_amdgcn_sched_group_barrier(0x002, 7, 0); }
                A3_PV();
                A3_ROWMAX(rm);
#pragma unroll
                for (int g_ = 0; g_ < 8; ++g_) { __builtin_amdgcn_sched_group_barrier(0x008, 1, 0); __builtin_amdgcn_sched_group_barrier(0x002, 3, 0); }
                if (__any(rm > THR)) {
                    const float dl = fmaxf(rm, 0.f); mhat += dl;
#pragma unroll
                    for (int r = 0; r < 16; ++r) { c0[r] -= dl; c1[r] -= dl; negm[r] = -mhat; }
                    const float f = __builtin_amdgcn_exp2f(-dl); lrun *= f;
                    if (hi == 0) wsf[r32] = f;
                    LDS_WAIT();
#pragma unroll
                    for (int g = 0; g < 4; ++g) { const f32x4 ff = *(const LAS f32x4*)(wsf + 8 * g + 4 * hi);
#pragma unroll
                        for (int j = 0; j < 4; ++j) { o[0][4 * g + j] *= ff[j]; o[1][4 * g + j] *= ff[j]; } }
                }
            }
            pp0 = c0; pp1 = c1; pslot = sl;
        }
        sl = (sl == NSL - 1) ? 0 : sl + 1; sl3 = (sl3 == NSL - 1) ? 0 : sl3 + 1;
    }
    if (qb_next >= 0) { const GAS bf16* Qn = T.Q + (rowbase + qb_next * 256 + wid * 32) * T.qp + h * (MODE ? 96 : 64);
#pragma unroll
        for (int d0 = 0; d0 < (MODE ? 6 : 4); ++d0) qr[d0] = *(const GAS bf16x8*)(Qn + (long)r32 * T.qp + d0 * 16 + hi * 8); }
    if (pend) { s16x4 vlo[8], vhh[8]; bf16x8 pa[4]; A3_VLOAD(pslot); A3_EXP(); A3_PV(); }
#undef A3_KLOADH
#undef A3_VLOAD
#undef A3_QKH
#undef A3_EXP
#undef A3_PV
#undef A3_ROWMAX
#undef A2_DMA
    lrun += __shfl_xor(lrun, 32);
    LDS_WAIT();
    if (hi == 0) wsf[32 + r32] = lrun;
    LDS_WAIT();
    float rli[16];
#pragma unroll
    for (int g = 0; g < 4; ++g) { const f32x4 ll = *(const LAS f32x4*)(wsf + 32 + 8 * g + 4 * hi);
#pragma unroll
        for (int j = 0; j < 4; ++j) rli[4 * g + j] = __builtin_amdgcn_rcpf(ll[j]); }
    GAS bf16* Ow = T.O + (rowbase + qw0) * 1024 + (MODE ? 0 : 512) + h * 64;
    { LAS bf16* stg = (LAS bf16*)(shm + R_OST) + wid * 2048;
#pragma unroll
      for (int r = 0; r < 16; ++r) { const int orow = crow(r, hi);
#pragma unroll
          for (int d0 = 0; d0 < 2; ++d0) stg[orow * 64 + d0 * 32 + r32] = (bf16)(cvt_pk_bf16(o[d0][r] * rli[r], 0.f) & 0xffffu); }
      LDS_WAIT();
#pragma unroll
      for (int i = 0; i < 4; ++i) { const int row = i * 8 + (lane >> 3), ch = lane & 7; const u32x4 v = *(const LAS u32x4*)(stg + row * 64 + ch * 8); *(GAS u32x4*)(Ow + (long)row * 1024 + ch * 8) = v;
          float sq = 0.f;
#pragma unroll
          for (int j = 0; j < 4; ++j) { const float a0 = __uint_as_float(v[j] << 16), a1 = __uint_as_float(v[j] & 0xffff0000u); sq += a0 * a0 + a1 * a1; }
          sq += __shfl_xor(sq, 1); sq += __shfl_xor(sq, 2); sq += __shfl_xor(sq, 4);
          if (ch == 0) T.OSS[(rowbase + qw0 + row) * 16 + (MODE ? 0 : 8) + h] = sq; } }
    if (qb_next < 0) { LDS_WAIT(); __builtin_amdgcn_s_barrier(); asm volatile("" ::: "memory"); }
    return A3_SLOT(NTE);
#undef A3_SLOT
}
}

struct Args { const void* in[21]; float* out; unsigned char* ws; int ph_lo, ph_hi; };

__device__ __forceinline__ void tr_item(const GAS float* __restrict__ W, int ldw, int Ksrc, const GAS float* __restrict__ gain, GAS bf16* __restrict__ WT, int ldk, int k0, int n0, int srccol, LAS float* scr, int lane) {
#pragma unroll 8
    for (int i = 0; i < 32; ++i) { const int kk = 2 * i + (lane >> 5); const int k = k0 + kk;
        float v = 0.f; if (srccol >= 0 && k < Ksrc) { v = __builtin_nontemporal_load(W + (size_t)k * ldw + srccol); if (gain) v *= gain[k]; }
        scr[kk * 33 + (lane & 31)] = v; }
    LDS_WAIT(); asm volatile("" ::: "memory");
    const int c = lane & 7;
#pragma unroll
    for (int j = 0; j < 4; ++j) { const int n = (lane >> 3) + 8 * j; const LAS float* s = scr + (8 * c) * 33 + n;
        u32x4 o; o.x = cvt_pk_bf16(s[0 * 33], s[1 * 33]); o.y = cvt_pk_bf16(s[2 * 33], s[3 * 33]); o.z = cvt_pk_bf16(s[4 * 33], s[5 * 33]); o.w = cvt_pk_bf16(s[6 * 33], s[7 * 33]);
        *(GAS u32x4*)(WT + (size_t)(n0 + n) * ldk + k0 + 8 * c) = o; }
    LDS_WAIT(); asm volatile("" ::: "memory");
}
__device__ __forceinline__ void tr_item64(const GAS float* __restrict__ W, int ldw, const GAS float* __restrict__ gain, GAS bf16* __restrict__ WT, int ldk, int k0, int n0src, int n0dst, LAS float* scr, int lane) {
    const int rr = lane >> 4, c4 = (lane & 15) * 4;
    f32x4 v[16];
#pragma unroll
    for (int i = 0; i < 16; ++i) v[i] = __builtin_nontemporal_load((const GAS f32x4*)(W + (size_t)(k0 + 4 * i + rr) * ldw + n0src + c4));
#pragma unroll
    for (int i = 0; i < 16; ++i) { const int k = 4 * i + rr; const float g = gain ? gain[k0 + k] : 1.f; LAS float* d = scr + k * 65 + c4;
        d[0] = v[i][0] * g; d[1] = v[i][1] * g; d[2] = v[i][2] * g; d[3] = v[i][3] * g; }
    LDS_WAIT(); asm volatile("" ::: "memory");
    const int kc = lane & 7;
#pragma unroll
    for (int j = 0; j < 8; ++j) { const int n = (lane >> 3) + 8 * j; const LAS float* sp = scr + (8 * kc) * 65 + n;
        u32x4 o; o.x = cvt_pk_bf16(sp[0 * 65], sp[1 * 65]); o.y = cvt_pk_bf16(sp[2 * 65], sp[3 * 65]); o.z = cvt_pk_bf16(sp[4 * 65], sp[5 * 65]); o.w = cvt_pk_bf16(sp[6 * 65], sp[7 * 65]);
        *(GAS u32x4*)(WT + (size_t)(n0dst + n) * ldk + k0 + 8 * kc) = o; }
    LDS_WAIT(); asm volatile("" ::: "memory");
}
__device__ __forceinline__ void tr_item64_f8(const GAS float* __restrict__ W, int ldw, const GAS float* __restrict__ gain, float scale, GAS unsigned char* __restrict__ WT8, int ldkB, int k0, int n0src, int n0dst, LAS float* scr, int lane) {
    const int rr = lane >> 4, c4 = (lane & 15) * 4;
    f32x4 v[16];
#pragma unroll
    for (int i = 0; i < 16; ++i) v[i] = __builtin_nontemporal_load((const GAS f32x4*)(W + (size_t)(k0 + 4 * i + rr) * ldw + n0src + c4));
#pragma unroll
    for (int i = 0; i < 16; ++i) { const int k = 4 * i + rr; const float g = (gain ? gain[k0 + k] : 1.f) * scale; LAS float* d = scr + k * 65 + c4;
        d[0] = v[i][0] * g; d[1] = v[i][1] * g; d[2] = v[i][2] * g; d[3] = v[i][3] * g; }
    LDS_WAIT(); asm volatile("" ::: "memory");
    const int kc = lane & 3;
#pragma unroll
    for (int j = 0; j < 4; ++j) { const int n = (lane >> 2) + 16 * j; const LAS float* sp = scr + (16 * kc) * 65 + n;
        u32x4 o; o.x = pk4_fp8(sp[0 * 65], sp[1 * 65], sp[2 * 65], sp[3 * 65]); o.y = pk4_fp8(sp[4 * 65], sp[5 * 65], sp[6 * 65], sp[7 * 65]); o.z = pk4_fp8(sp[8 * 65], sp[9 * 65], sp[10 * 65], sp[11 * 65]); o.w = pk4_fp8(sp[12 * 65], sp[13 * 65], sp[14 * 65], sp[15 * 65]);
        *(GAS u32x4*)(WT8 + (size_t)(n0dst + n) * ldkB + k0 + 16 * kc) = o; }
    LDS_WAIT(); asm volatile("" ::: "memory");
}
struct F8Item { const GAS float* W; int ldw; const GAS float* gain; GAS unsigned char* WT8; int ldkB, k0, n0src, n0dst; };
__device__ __forceinline__ void tr_load64(f32x4 (&v)[16], float (&gn)[16], const F8Item& I, int lane) {
    const int rr = lane >> 4, c4 = (lane & 15) * 4;
#pragma unroll
    for (int i = 0; i < 16; ++i) gn[i] = I.gain ? I.gain[I.k0 + 4 * i + rr] : 1.f;
#pragma unroll
    for (int i = 0; i < 16; ++i) v[i] = __builtin_nontemporal_load((const GAS f32x4*)(I.W + (size_t)(I.k0 + 4 * i + rr) * I.ldw + I.n0src + c4));
}
__device__ __forceinline__ void tr_finish64_f8(const f32x4 (&v)[16], const float (&gn)[16], const F8Item& I, float scale, LAS float* scr, int lane) {
    const int rr = lane >> 4, c4 = (lane & 15) * 4;
#pragma unroll
    for (int i = 0; i < 16; ++i) { const int k = 4 * i + rr; const float g = gn[i] * scale; LAS float* d = scr + k * 65 + c4;
        d[0] = v[i][0] * g; d[1] = v[i][1] * g; d[2] = v[i][2] * g; d[3] = v[i][3] * g; }
    LDS_WAIT(); asm volatile("" ::: "memory");
    const int kc = lane & 3;
#pragma unroll
    for (int j = 0; j < 4; ++j) { const int n = (lane >> 2) + 16 * j; const LAS float* sp = scr + (16 * kc) * 65 + n;
        u32x4 o; o.x = pk4_fp8(sp[0 * 65], sp[1 * 65], sp[2 * 65], sp[3 * 65]); o.y = pk4_fp8(sp[4 * 65], sp[5 * 65], sp[6 * 65], sp[7 * 65]); o.z = pk4_fp8(sp[8 * 65], sp[9 * 65], sp[10 * 65], sp[11 * 65]); o.w = pk4_fp8(sp[12 * 65], sp[13 * 65], sp[14 * 65], sp[15 * 65]);
        *(GAS u32x4*)(I.WT8 + (size_t)(I.n0dst + n) * I.ldkB + I.k0 + 16 * kc) = o; }
    LDS_WAIT(); asm volatile("" ::: "memory");
}
__device__ __forceinline__ int rope_dim(int p) { const int a = p >> 3, j = p & 7; return j < 4 ? 4 * a + j : 16 + 4 * a + (j - 4); }

#define LDP(i) ((void*)((((unsigned long long)(unsigned)__builtin_amdgcn_readfirstlane((int)(ARGP[i] >> 32))) << 32) | (unsigned long long)(unsigned)__builtin_amdgcn_readfirstlane((int)(unsigned)ARGP[i])))
#define ARGIN(i) ((const void*)LDP(i))
#define P_COS ((GAS float*)(ws + WS_COS))
#define P_SIN ((GAS float*)(ws + WS_SIN))
#define P_SSQ ((GAS float*)(ws + WS_SSQ))
#define P_FLOG ((GAS float*)(ws + WS_FLOG))
#define P_E01 ((GAS int*)(ws + WS_E01))
#define P_G01 ((GAS float*)(ws + WS_G01))
#define P_SLOT ((GAS int*)(ws + WS_SLOT))
#define P_TOKOF ((GAS int*)(ws + WS_TOKOF))
#define P_GATEOF ((GAS float*)(ws + WS_GATEOF))
#define P_CNT ((GAS int*)(ws + WS_CNT))
#define P_TSTART ((GAS int*)(ws + WS_TSTART))
#define P_RSTD ((GAS float*)(ws + WS_RSTD))
#define P_RSTDOF ((GAS float*)(ws + WS_RSTDOF))
#define P_KPE ((GAS bf16*)(ws + WS_KPE))
#define P_KAUG ((GAS bf16*)(ws + WS_KAUG))
#define P_BIASF ((GAS float*)(ws + WS_BIASF))
#define P_NRM ((GAS float*)(ws + WS_NRM))
#define P_WR_L(l) ((GAS bf16*)(ws + ((l) ? WS_W1 + 7 * MiB : WS_WR)))
#define P_XR ((GAS bf16*)(ws + WS_XR))
#define P_OSS ((GAS float*)(ws + WS_OSS))
#define P_RSTDX ((GAS float*)(ws + WS_RSTDX))
#define P_WIN_L(l) ((GAS bf16*)(ws + ((l) ? WS_W1 : WS_WIN)))
#define P_WUQ_L(l) ((GAS bf16*)(ws + ((l) ? WS_W1 + 4 * MiB : WS_WUQ)))
#define P_WUKV_L(l) ((GAS bf16*)(ws + ((l) ? WS_W1 + 4 * MiB + 512 * KiB : WS_WUKV)))
#define P_WOUT_L(l) ((GAS bf16*)(ws + ((l) ? WS_W1 + 5 * MiB : WS_WOUT)))
#define P_WGU_L(ll) ((GAS unsigned char*)(ws + WS_WGU + (size_t)((ll) & 1) * 32 * MiB))
#define P_WD_L(ll) ((GAS unsigned char*)(ws + WS_WD + (size_t)((ll) & 1) * 16 * MiB))
#define P_XN ((GAS bf16*)(ws + WS_XN))
#define P_FQKV ((GAS bf16*)(ws + WS_FQKV))
#define P_HH ((GAS bf16*)(ws + WS_FQKV))
#define P_LAT ((GAS bf16*)(ws + WS_LAT))
#define P_QM ((GAS bf16*)(ws + WS_QM))
#define P_KVM ((GAS bf16*)(ws + WS_KVM))
#define P_Y ((GAS bf16*)(ws + WS_Y))
#define IN(k) (lo <= (k) && (k) < hi_)
#if MK_ONE_LAUNCH
#define GRID_BAR() xcd_barrier(bar)
#else
#define GRID_BAR() do {} while (0)
#endif
#define SEAM(k) do { if (IN(k) && IN((k) + 1)) GRID_BAR(); } while (0)
#if MK_ONE_LAUNCH
#define GROUP_BAR() xcd_barrier(gbar)
#else
#define GROUP_BAR() do {} while (0)
#endif
#define SEAMG(k) do { if (IN(k) && IN((k) + 1)) GROUP_BAR(); } while (0)
__device__ __forceinline__ void conv_gu_item(int r, const GAS float* w_gate, const GAS float* w_up, const GAS float* ffn_norm, GAS unsigned char* WGU, LAS float* scr64, int lane) {
    const int e = r / 256, q = r % 256, kb = q / 16, nb = q % 16; const int n0 = nb * 64; const int ct = n0 >> 8, which = (n0 >> 7) & 1, jj = n0 & 127;
    const GAS float* src = (which ? w_up : w_gate) + (size_t)e * DM * DEXP;
    tr_item64_f8(src, DEXP, ffn_norm, WSCALE, WGU + (size_t)e * 1024 * 1024, DM, kb * 64, ct * 128 + jj, n0, scr64, lane);
}
__device__ __forceinline__ F8Item gu_item(int r, const GAS float* w_gate, const GAS float* w_up, const GAS float* ffn_norm, GAS unsigned char* WGU) {
    const int e = r / 256, q = r % 256, kb = q / 16, nb = q % 16; const int n0 = nb * 64; const int ct = n0 >> 8, which = (n0 >> 7) & 1, jj = n0 & 127;
    return F8Item{(which ? w_up : w_gate) + (size_t)e * DM * DEXP, DEXP, ffn_norm, WGU + (size_t)e * 1024 * 1024, DM, kb * 64, ct * 128 + jj, n0};
}
__device__ __forceinline__ F8Item d_item(int r, const GAS float* w_down, GAS unsigned char* WD) {
    const int e = r / 128, q = r % 128, kb = q / 16, nb = q % 16;
    return F8Item{w_down + (size_t)e * DEXP * DM, DM, nullptr, WD + (size_t)e * 1024 * 512, DEXP, kb * 64, nb * 64, nb * 64};
}
__device__ __forceinline__ void conv_d_item(int r, const GAS float* w_down, GAS unsigned char* WD, LAS float* scr64, int lane) {
    const int e = r / 128, q = r % 128, kb = q / 16, nb = q % 16;
    tr_item64_f8(w_down + (size_t)e * DEXP * DM, DM, nullptr, WSCALE, WD + (size_t)e * 1024 * 512, DEXP, kb * 64, nb * 64, nb * 64, scr64, lane);
}
__device__ __forceinline__ void conv_experts_l0(LAS unsigned char* lds0, const int wave0, const int G0, const int bx0) {
    unsigned ldsb_ = (unsigned)(uintptr_t)lds0; asm volatile("" : "+s"(ldsb_)); LAS unsigned char* lds = (LAS unsigned char*)(uintptr_t)ldsb_; volatile LAS unsigned long long* ARGP = (volatile LAS unsigned long long*)(lds + MISC_OFF + 768);
    int wave = wave0, G = G0, bx = bx0; asm volatile("" : "+s"(G), "+s"(bx), "+s"(wave)); const int lane = (int)__builtin_amdgcn_mbcnt_hi(~0u, __builtin_amdgcn_mbcnt_lo(~0u, 0u)); const int vcu = (bx % 8) * (G / 8) + bx / 8;
    GAS unsigned char* ws = (GAS unsigned char*)LDP(22);
    LAS float* scr64 = (LAS float*)(lds + wave * 16640);
    const GAS float* ffn_norm = (const GAS float*)ARGIN(12);
    const GAS float* w_gate = (const GAS float*)ARGIN(17); const GAS float* w_up = (const GAS float*)ARGIN(18); const GAS float* w_down = (const GAS float*)ARGIN(19);
    constexpr int J_GU = 16 * 16 * NEXP, J_D = 8 * 16 * NEXP;
    asm volatile("s_waitcnt vmcnt(0)" ::: "memory"); __syncthreads();
    static_assert(J_GU == 256 * 8 * 4 && J_D == 256 * 8 * 2, "six items per wave");
    const int it0 = vcu + G * wave;
    f32x4 va[16], vb[16]; float ga[16], gb[16];
    const F8Item I0 = gu_item(it0, w_gate, w_up, ffn_norm, P_WGU_L(0)); tr_load64(va, ga, I0, lane);
    const F8Item I1 = gu_item(it0 + G * 8, w_gate, w_up, ffn_norm, P_WGU_L(0)); tr_load64(vb, gb, I1, lane); tr_finish64_f8(va, ga, I0, WSCALE, scr64, lane);
    const F8Item I2 = gu_item(it0 + G * 16, w_gate, w_up, ffn_norm, P_WGU_L(0)); tr_load64(va, ga, I2, lane); tr_finish64_f8(vb, gb, I1, WSCALE, scr64, lane);
    const F8Item I3 = gu_item(it0 + G * 24, w_gate, w_up, ffn_norm, P_WGU_L(0)); tr_load64(vb, gb, I3, lane); tr_finish64_f8(va, ga, I2, WSCALE, scr64, lane);
    const F8Item I4 = d_item(it0 + G * 32 - J_GU, w_down, P_WD_L(0)); tr_load64(va, ga, I4, lane); tr_finish64_f8(vb, gb, I3, WSCALE, scr64, lane);
    const F8Item I5 = d_item(it0 + G * 40 - J_GU, w_down, P_WD_L(0)); tr_load64(vb, gb, I5, lane); tr_finish64_f8(va, ga, I4, WSCALE, scr64, lane);
    tr_finish64_f8(vb, gb, I5, WSCALE, scr64, lane);
    __syncthreads();
}
#define CONV_SLOT(k, sl) do { if constexpr (l == 0) { if (IN(P + (k)) && ((((bx0 % 8) * (G0 / 8) + bx0 / 8) >> 4) & 1) == (sl)) conv_experts_l0(lds0, wave0, G0, bx0); } } while (0)
template <int l>
__device__ __forceinline__ void layer_body(const int lo, const int hi_, LAS unsigned char* lds0, const int wave0, const int G0, const int bx0, const XcdBarrier& bar, const XcdBarrier& gbar) {
        const int P = 10 * l;
        if (IN(P)) for (int rep_ = 0; rep_ < (l == 0 ? NREP(0) : 1); ++rep_) {
            unsigned ldsb_ = (unsigned)(uintptr_t)lds0; asm volatile("" : "+s"(ldsb_)); LAS unsigned char* lds = (LAS unsigned char*)(uintptr_t)ldsb_; volatile LAS unsigned* MISC = (volatile LAS unsigned*)(lds + MISC_OFF); volatile LAS unsigned long long* ARGP = (volatile LAS unsigned long long*)(lds + MISC_OFF + 768); (void)MISC; int wave = wave0, G = G0, bx = bx0; asm volatile("" : "+s"(G), "+s"(bx), "+s"(wave)); const int lane = (int)__builtin_amdgcn_mbcnt_hi(~0u, __builtin_amdgcn_mbcnt_lo(~0u, 0u)); const int tid = wave * 64 + lane; const int vcu = (bx % 8) * (G / 8) + bx / 8; const int gw = vcu * 8 + wave, NGW = G * 8; (void)lane; (void)gw; (void)NGW; (void)vcu;
            GAS unsigned char* ws = (GAS unsigned char*)LDP(22); GAS float* out = (GAS float*)LDP(21); const GAS float* x_in = (const GAS float*)ARGIN(0); const GAS int* positions = (const GAS int*)ARGIN(1);
            if constexpr (l == 0) {
                LAS float* scr = (LAS float*)(lds + wave * 16640);
                constexpr int I_IN = 16 * 64, I_UQ = 4 * 24, I_UKV = 4 * 32, J_OUT = 16 * 16;
                constexpr int NITEMS = I_IN + I_UQ + I_UKV + J_OUT;
                for (int it = vcu + G * wave; it < NLAYER * NITEMS; it += NGW) {
                    const int lw = it / NITEMS; int r = it % NITEMS; const int j = lane & 31;
                    if (r < I_IN) { const GAS float* attn_norm = (const GAS float*)ARGIN(2) + (size_t)lw * DM; const GAS float* w_in = (const GAS float*)ARGIN(3) + (size_t)lw * DM * INW;
                        const int kb = r / 64, nb = r % 64; const int n = nb * 32 + j; int sc;
                        if (n < 384) sc = n; else if (n < 416) sc = 384 + rope_dim(n - 384); else if (n < 424) sc = 1952 + (n - 416); else if (n < 512) sc = -1; else sc = 416 + (n - 512);
                        tr_item(w_in, INW, DM, attn_norm, P_WIN_L(lw), DM, kb * 64, nb * 32, sc, scr, lane); continue; } r -= I_IN;
                    if (r < I_UQ) { const GAS float* q_norm = (const GAS float*)ARGIN(5) + (size_t)lw * 256; const GAS float* w_uq = (const GAS float*)ARGIN(6) + (size_t)lw * 256 * 768;
                        const int kb = r / 24, nb = r % 24; const int n = nb * 32 + j; const int hh = n / 96, d = n % 96; const int sc = d < 64 ? n : hh * 96 + 64 + rope_dim(d - 64);
                        tr_item(w_uq, 768, 256, q_norm, P_WUQ_L(lw), 256, kb * 64, nb * 32, sc, scr, lane); continue; } r -= I_UQ;
                    if (r < I_UKV) { const GAS float* kv_norm = (const GAS float*)ARGIN(7) + (size_t)lw * 128; const GAS float* w_ukv = (const GAS float*)ARGIN(8) + (size_t)lw * 128 * 1024;
                        const int kb = r / 32, nb = r % 32; tr_item(w_ukv, 1024, 128, kv_norm, P_WUKV_L(lw), 256, kb * 64, nb * 32, nb * 32 + j, scr, lane); continue; } r -= I_UKV;
                    { const GAS float* mla_on = (const GAS float*)ARGIN(9) + (size_t)lw * 512; const GAS float* fox_on = (const GAS float*)ARGIN(10) + (size_t)lw * 512; const GAS float* w_out = (const GAS float*)ARGIN(11) + (size_t)lw * DM * DM;
                        const int kb = r / 16, nb = r % 16; const GAS float* gn = kb < 8 ? mla_on : fox_on - 512; tr_item64(w_out, DM, gn, P_WOUT_L(lw), DM, kb * 64, nb * 64, nb * 64, scr, lane); }
                }
                for (int lw = 0; lw < NLAYER; ++lw) { const GAS float* ffn_norm = (const GAS float*)ARGIN(12) + (size_t)lw * DM; const GAS float* w_rg = (const GAS float*)ARGIN(13) + (size_t)lw * DM * 4; const GAS float* w_re = (const GAS float*)ARGIN(15) + (size_t)lw * DM * 32;
                  for (int idx = bx * 512 + tid; idx < 2 * 48 * 520; idx += G * 512) { const int half = idx / (48 * 520), r = idx % (48 * 520), c = r / 520, kk = r % 520; const int k = half * 512 + kk;
                      float w = 0.f; if (c < 36 && kk < 512) w = ffn_norm[k] * (c < 4 ? w_rg[k * 4 + c] : w_re[k * 32 + (c - 4)]);
                      const unsigned h16 = cvt_pk_bf16(w, 0.f) & 0xffffu; const unsigned l16 = cvt_pk_bf16(w - __uint_as_float(h16 << 16), 0.f) & 0xffffu;
                      P_WR_L(lw)[(size_t)(half * 2 + 0) * 48 * 520 + r] = (bf16)h16; P_WR_L(lw)[(size_t)(half * 2 + 1) * 48 * 520 + r] = (bf16)l16; } }
            }
            const GAS float* fin = (const GAS float*)ARGIN(20);
            for (int mb = vcu * 128 + wave * 16; mb < vcu * 128 + wave * 16 + 16; mb += 4) {
                f32x4 v[4][4]; int s0[4], s1[4];
                if (l > 0) {
#pragma unroll
                    for (int r = 0; r < 4; ++r) { s0[r] = P_SLOT[2 * (mb + r)]; s1[r] = P_SLOT[2 * (mb + r) + 1]; }
                }
#pragma unroll
                for (int r = 0; r < 4; ++r) {
                    if (l == 0) { const GAS float* xr = x_in + (size_t)(mb + r) * DM;
#pragma unroll
                        for (int j = 0; j < 4; ++j) v[r][j] = __builtin_nontemporal_load((const GAS f32x4*)(xr + 4 * lane + 256 * j)); }
                    else { const GAS bf16* xr = P_XR + (size_t)(mb + r) * DM;
#pragma unroll
                        for (int j = 0; j < 4; ++j) { const u32x2 w = __builtin_nontemporal_load((const GAS u32x2*)(xr + 4 * lane + 256 * j)); v[r][j] = (f32x4){__uint_as_float(w.x << 16), __uint_as_float(w.x & 0xffff0000u), __uint_as_float(w.y << 16), __uint_as_float(w.y & 0xffff0000u)}; } } }
                if (l > 0) {
#pragma unroll
                    for (int r = 0; r < 4; ++r)
#pragma unroll
                        for (int j = 0; j < 4; ++j) { const int a = __builtin_nontemporal_load((const GAS int*)((const GAS unsigned char*)P_Y + (size_t)s0[r] * 1024 + 4 * lane + 256 * j)), c = __builtin_nontemporal_load((const GAS int*)((const GAS unsigned char*)P_Y + (size_t)s1[r] * 1024 + 4 * lane + 256 * j));
                            const f32x2 a0 = __builtin_amdgcn_cvt_pk_f32_fp8(a, false), a1 = __builtin_amdgcn_cvt_pk_f32_fp8(a, true), c0 = __builtin_amdgcn_cvt_pk_f32_fp8(c, false), c1 = __builtin_amdgcn_cvt_pk_f32_fp8(c, true);
                            v[r][j][0] += (a0[0] + c0[0]) * WSCALE_INV; v[r][j][1] += (a0[1] + c0[1]) * WSCALE_INV; v[r][j][2] += (a1[0] + c1[0]) * WSCALE_INV; v[r][j][3] += (a1[1] + c1[1]) * WSCALE_INV; }
                }
                float ss[4];
#pragma unroll
                for (int r = 0; r < 4; ++r) { float s = 0.f;
#pragma unroll
                    for (int j = 0; j < 4; ++j) s += (v[r][j][0] * v[r][j][0] + v[r][j][1] * v[r][j][1]) + (v[r][j][2] * v[r][j][2] + v[r][j][3] * v[r][j][3]);
                    ss[r] = s; }
#pragma unroll
                for (int o = 1; o < 64; o <<= 1) {
#pragma unroll
                    for (int r = 0; r < 4; ++r) ss[r] += __shfl_xor(ss[r], o); }
#pragma unroll
                for (int r = 0; r < 4; ++r) { const int m = mb + r; const float rstd = rsqrtf(ss[r] * (1.f / DM) + EPS);
                    if (l < NLAYER) {
#pragma unroll
                        for (int jp = 0; jp < 2; ++jp) {
                            u32x2 w0, w1; w0.x = cvt_pk_bf16(v[r][2 * jp][0], v[r][2 * jp][1]); w0.y = cvt_pk_bf16(v[r][2 * jp][2], v[r][2 * jp][3]); w1.x = cvt_pk_bf16(v[r][2 * jp + 1][0], v[r][2 * jp + 1][1]); w1.y = cvt_pk_bf16(v[r][2 * jp + 1][2], v[r][2 * jp + 1][3]);
                            const bool od = lane & 1; const u32x2 give = od ? w0 : w1;
                            u32x2 got; got.x = (unsigned)__builtin_amdgcn_update_dpp(0, (int)give.x, 0xB1, 0xf, 0xf, false); got.y = (unsigned)__builtin_amdgcn_update_dpp(0, (int)give.y, 0xB1, 0xf, 0xf, false);
                            const u32x4 o = od ? (u32x4){got.x, got.y, w1.x, w1.y} : (u32x4){w0.x, w0.y, got.x, got.y};
                            *(GAS u32x4*)(P_XR + (size_t)m * DM + 8 * (lane >> 1) + 256 * (2 * jp + (lane & 1))) = o; }
                        if (lane == 0) P_RSTDX[m] = rstd;
                    } else {
#pragma unroll
                        for (int j = 0; j < 4; ++j) { const f32x4 g = *(const GAS f32x4*)(fin + 4 * lane + 256 * j); __builtin_nontemporal_store(v[r][j] * rstd * g, (GAS f32x4*)(out + (size_t)m * DM + 4 * lane + 256 * j)); }
                    }
                }
            }
        }
        if constexpr (l == NLAYER) return;
        SEAM(P);
        if (IN(P + 1)) for (int rep_ = 0; rep_ < ((l == 0 || 1 != 5) ? NREP(1) : 1); ++rep_) {
            unsigned ldsb_ = (unsigned)(uintptr_t)lds0; asm volatile("" : "+s"(ldsb_)); LAS unsigned char* lds = (LAS unsigned char*)(uintptr_t)ldsb_; volatile LAS unsigned* MISC = (volatile LAS unsigned*)(lds + MISC_OFF); volatile LAS unsigned long long* ARGP = (volatile LAS unsigned long long*)(lds + MISC_OFF + 768); (void)MISC; int wave = wave0, G = G0, bx = bx0; asm volatile("" : "+s"(G), "+s"(bx), "+s"(wave)); const int lane = (int)__builtin_amdgcn_mbcnt_hi(~0u, __builtin_amdgcn_mbcnt_lo(~0u, 0u)); const int tid = wave * 64 + lane; const int vcu = (bx % 8) * (G / 8) + bx / 8; const int gw = vcu * 8 + wave, NGW = G * 8; (void)lane; (void)gw; (void)NGW; (void)vcu;
            GAS unsigned char* ws = (GAS unsigned char*)LDP(22); GAS float* out = (GAS float*)LDP(21); const GAS float* x_in = (const GAS float*)ARGIN(0); (void)out; (void)x_in; (void)ws;
            BatchOrder S{INP / 256, vcu, (const GAS char*)P_XR, (const GAS char*)P_WIN_L(l), (size_t)256 * DM * 2, (size_t)256 * DM * 2};
            EpiWin E{P_LAT, P_FQKV, P_KPE, P_FLOG, P_SSQ, P_COS, P_SIN, P_RSTDX};
            pg8::gemm_phase<EpiWin, BatchOrder, true, false>(tid, lds, DM * 2, DM * 2, DM * 2, S, E, nullptr);
        }
        SEAMG(P + 1);
        if (IN(P + 2)) for (int rep_ = 0; rep_ < ((l == 0 || 2 != 5) ? NREP(2) : 1); ++rep_) {
            unsigned ldsb_ = (unsigned)(uintptr_t)lds0; asm volatile("" : "+s"(ldsb_)); LAS unsigned char* lds = (LAS unsigned char*)(uintptr_t)ldsb_; volatile LAS unsigned* MISC = (volatile LAS unsigned*)(lds + MISC_OFF); volatile LAS unsigned long long* ARGP = (volatile LAS unsigned long long*)(lds + MISC_OFF + 768); (void)MISC; int wave = wave0, G = G0, bx = bx0; asm volatile("" : "+s"(G), "+s"(bx), "+s"(wave)); const int lane = (int)__builtin_amdgcn_mbcnt_hi(~0u, __builtin_amdgcn_mbcnt_lo(~0u, 0u)); const int tid = wave * 64 + lane; const int vcu = (bx % 8) * (G / 8) + bx / 8; const int gw = vcu * 8 + wave, NGW = G * 8; (void)lane; (void)gw; (void)NGW; (void)vcu;
            GAS unsigned char* ws = (GAS unsigned char*)LDP(22); GAS float* out = (GAS float*)LDP(21); const GAS float* x_in = (const GAS float*)ARGIN(0); (void)out; (void)x_in; (void)ws;
            {
                const int sq = vcu >> 1, hf = vcu & 1; const int b = sq >> 3, h = sq & 7; const float bf = ((const GAS float*)ARGIN(4))[l * 8 + h];
                const GAS float* fl = P_FLOG + ((size_t)b * SEQ + hf * 1024 + 2 * tid) * 8 + h;
                float lf[2], lg[2] = {0.f, 0.f};
#pragma unroll
                for (int e = 0; e < 2; ++e) { const float f = fl[e * 8] + bf; lf[e] = fminf(f, 0.f) - log1pf(expf(-fabsf(f))); }
                if (hf) {
#pragma unroll
                    for (int e = 0; e < 2; ++e) { const float f = fl[e * 8 - 1024 * 8] + bf; lg[e] = fminf(f, 0.f) - log1pf(expf(-fabsf(f))); } }
                const double s2 = (double)lf[0] + (double)lf[1];
                double incl = s2, first = (double)lg[0] + (double)lg[1];
#pragma unroll
                for (int o = 1; o < 64; o <<= 1) { const double t = __shfl_up(incl, o); if (lane >= o) incl += t; first += __shfl_xor(first, o); }
                LAS double* wtot = (LAS double*)lds;
                if (lane == 63) wtot[wave] = incl;
                if (lane == 0) wtot[8 + wave] = first;
                __syncthreads();
                double c = incl - s2;
                for (int w = 0; w < wave; ++w) c += wtot[w];
                if (hf) { for (int w = 0; w < 8; ++w) c += wtot[8 + w]; }
                const size_t t0 = ((size_t)b * 8 + h) * SEQ + hf * 1024 + 2 * tid;
                GAS u32x4* ka = (GAS u32x4*)(P_KAUG + t0 * 8);
                float xs[2];
#pragma unroll
                for (int e = 0; e < 2; ++e) { c += (double)lf[e]; const float x = (float)(-c * 1.4426950408889634); xs[e] = x;
                    const unsigned h16 = cvt_pk_bf16(x, 0.f) & 0xffffu; const float r1 = x - __uint_as_float(h16 << 16); const unsigned m16 = cvt_pk_bf16(r1, 0.f) & 0xffffu; const float r2 = r1 - __uint_as_float(m16 << 16); const unsigned l16 = cvt_pk_bf16(r2, 0.f) & 0xffffu;
                    ka[e] = (u32x4){h16 | (m16 << 16), l16, 0u, 0u}; P_BIASF[t0 + e] = x; }
                float qn = 0.f, kn = 0.f, xdm = INFINITY;
                { const GAS bf16* fqp = P_FQKV + ((size_t)b * SEQ + hf * 1024 + 2 * tid) * 512 + h * 64; const GAS bf16* fkp = fqp + (size_t)NTOK * 512;
#pragma unroll
                  for (int e = 0; e < 2; ++e) { float sq_ = 0.f, sk = 0.f, dd = 0.f;
#pragma unroll
                      for (int c8 = 0; c8 < 8; ++c8) { const u32x4 a = *(const GAS u32x4*)(fqp + e * 512 + c8 * 8), k4 = *(const GAS u32x4*)(fkp + e * 512 + c8 * 8);
#pragma unroll
                          for (int j = 0; j < 4; ++j) { const float a0 = __uint_as_float(a[j] << 16), a1 = __uint_as_float(a[j] & 0xffff0000u), k0 = __uint_as_float(k4[j] << 16), k1 = __uint_as_float(k4[j] & 0xffff0000u);
                              sq_ += a0 * a0 + a1 * a1; sk += k0 * k0 + k1 * k1; dd += a0 * k0 + a1 * k1; } }
                      qn = fmaxf(qn, sq_); kn = fmaxf(kn, sk); xdm = fminf(xdm, xs[e] + dd); } }
#pragma unroll
                for (int o = 1; o < 64; o <<= 1) { qn = fmaxf(qn, __shfl_xor(qn, o)); kn = fmaxf(kn, __shfl_xor(kn, o)); xdm = fminf(xdm, __shfl_xor(xdm, o)); }
                LAS float* knw = (LAS float*)(lds + 256);
                if (lane == 0) { knw[wave] = kn; knw[8 + wave] = qn; knw[16 + wave] = xdm; }
                __syncthreads();
                if (tid < 4) { P_NRM[sq * 32 + hf * 4 + tid] = sqrtf(fmaxf(knw[8 + 2 * tid], knw[8 + 2 * tid + 1])); P_NRM[sq * 32 + 16 + hf * 4 + tid] = fminf(knw[16 + 2 * tid], knw[16 + 2 * tid + 1]); }
                if (tid == 4) { float m = knw[0]; for (int w = 1; w < 8; ++w) m = fmaxf(m, knw[w]); P_NRM[sq * 32 + 8 + hf] = sqrtf(m); }
                __syncthreads();
            }
            UpOrder S{vcu, (const GAS char*)P_LAT, (const GAS char*)P_WUQ_L(l), (const GAS char*)P_WUKV_L(l)};
            EpiUp E{P_QM, P_KVM, P_SSQ, P_COS, P_SIN};
            pg8::gemm_phase<EpiUp, UpOrder, true, false, false, false, true>(tid, lds, 256 * 2, 512 * 2, 256 * 2, S, E, nullptr);
        }
        SEAMG(P + 2);
        CONV_SLOT(3, 0);
        if (IN(P + 3)) for (int rep_ = 0; rep_ < ((l == 0 || 3 != 5) ? NREP(3) : 1); ++rep_) {
            unsigned ldsb_ = (unsigned)(uintptr_t)lds0; asm volatile("" : "+s"(ldsb_)); LAS unsigned char* lds = (LAS unsigned char*)(uintptr_t)ldsb_; volatile LAS unsigned* MISC = (volatile LAS unsigned*)(lds + MISC_OFF); volatile LAS unsigned long long* ARGP = (volatile LAS unsigned long long*)(lds + MISC_OFF + 768); (void)MISC; int wave = wave0, G = G0, bx = bx0; asm volatile("" : "+s"(G), "+s"(bx), "+s"(wave)); const int lane = (int)__builtin_amdgcn_mbcnt_hi(~0u, __builtin_amdgcn_mbcnt_lo(~0u, 0u)); const int tid = wave * 64 + lane; const int vcu = (bx % 8) * (G / 8) + bx / 8; const int gw = vcu * 8 + wave, NGW = G * 8; (void)lane; (void)gw; (void)NGW; (void)vcu;
            GAS unsigned char* ws = (GAS unsigned char*)LDP(22); GAS float* out = (GAS float*)LDP(21); const GAS float* x_in = (const GAS float*)ARGIN(0); (void)out; (void)x_in; (void)ws;
            GAS bf16* O = P_XN;
            const int b = vcu >> 4, hh = (vcu & 15) >> 1, sub = vcu & 1;
            const att::Tens2 TM{P_QM, 768, P_KVM, 1024, P_KPE, P_KVM + 64, 1024, O, nullptr, nullptr, P_OSS};
            const att::Tens2 TF{P_FQKV, 512, P_FQKV + (size_t)NTOK * 512, 512, P_KAUG, P_FQKV + (size_t)2 * NTOK * 512, 512, O, P_BIASF, P_NRM, P_OSS};
#define QB_OF(i) ((((i) & 1) ? 7 - (2 * sub + ((i) >> 1)) : (2 * sub + ((i) >> 1))))
            int ts0, ts1, ts2, ts3;
            { const GAS float* bs = P_BIASF + ((long)b * 8 + hh) * SEQ; const GAS float* nr = P_NRM + (b * 8 + hh) * 32; const float kmx = fmaxf(nr[8], nr[9]);
#define FOX_TS(i, dst) do { const int qb_ = QB_OF(i), NT_ = 4 * qb_ + 4; const float Z_ = nr[qb_] * kmx * 1.001f + 0.01f; const float bend_ = bs[(lane < NT_ ? lane : NT_ - 1) * 64 + 63]; \
                  const bool skip_ = (lane < NT_ - 4) && (Z_ + bend_ - nr[16 + qb_] < -32.f); dst = __builtin_popcountll(__ballot(skip_)); } while (0)
              FOX_TS(0, ts0); FOX_TS(1, ts1); FOX_TS(2, ts2); FOX_TS(3, ts3);
#undef FOX_TS
            }
            if (wave >= 4) __builtin_amdgcn_s_setprio(1);
            bf16x8 qreg[6];
            { int sb = 0; for (int i = 0; i < 4; ++i) sb = att::attn_unit2<1>(wave, b, hh, QB_OF(i), TM, (LAS char*)lds, sb, i > 0, i < 3 ? QB_OF(i + 1) : -1, qreg, 0); }
            if constexpr (l == 0) { if ((b & 1) == 1) { __builtin_amdgcn_s_setprio(0); conv_experts_l0(lds0, wave0, G0, bx0); if (wave >= 4) __builtin_amdgcn_s_setprio(1); } }
            { int sb = 0; for (int i = 0; i < 4; ++i) { const int ts = i == 0 ? ts0 : i == 1 ? ts1 : i == 2 ? ts2 : ts3; sb = att::attn_unit2<0>(wave, b, hh, QB_OF(i), TF, (LAS char*)lds, sb, i > 0, i < 3 ? QB_OF(i + 1) : -1, qreg, ts); } }
#undef QB_OF
            __builtin_amdgcn_s_setprio(0);
        }
        SEAMG(P + 3);
        if (IN(P + 5)) for (int rep_ = 0; rep_ < ((l == 0 || 5 != 5) ? NREP(5) : 1); ++rep_) {
            unsigned ldsb_ = (unsigned)(uintptr_t)lds0; asm volatile("" : "+s"(ldsb_)); LAS unsigned char* lds = (LAS unsigned char*)(uintptr_t)ldsb_; volatile LAS unsigned* MISC = (volatile LAS unsigned*)(lds + MISC_OFF); volatile LAS unsigned long long* ARGP = (volatile LAS unsigned long long*)(lds + MISC_OFF + 768); (void)MISC; int wave = wave0, G = G0, bx = bx0; asm volatile("" : "+s"(G), "+s"(bx), "+s"(wave)); const int lane = (int)__builtin_amdgcn_mbcnt_hi(~0u, __builtin_amdgcn_mbcnt_lo(~0u, 0u)); const int tid = wave * 64 + lane; const int vcu = (bx % 8) * (G / 8) + bx / 8; const int gw = vcu * 8 + wave, NGW = G * 8; (void)lane; (void)gw; (void)NGW; (void)vcu;
            GAS unsigned char* ws = (GAS unsigned char*)LDP(22); GAS float* out = (GAS float*)LDP(21); const GAS float* x_in = (const GAS float*)ARGIN(0); (void)out; (void)x_in; (void)ws;
            BatchOrder S{DM / 256, vcu, (const GAS char*)P_XN, (const GAS char*)P_WOUT_L(l), (size_t)256 * DM * 2, (size_t)256 * DM * 2};
            EpiOut<false> E{x_in, P_XR};
            LAS f32x2* scl = (LAS f32x2*)(lds + pg8::STAGE_BYTES);
            { Unit u_; if (S.next(tid >> 8, u_)) { const GAS float* op = P_OSS + ((size_t)u_.pm * 256 + (tid & 255)) * 16;
                  const f32x4 a0 = *(const GAS f32x4*)op, a1 = *(const GAS f32x4*)(op + 4), c0 = *(const GAS f32x4*)(op + 8), c1 = *(const GAS f32x4*)(op + 12);
                  const float sm = ((a0[0] + a0[1]) + (a0[2] + a0[3])) + ((a1[0] + a1[1]) + (a1[2] + a1[3])), sf = ((c0[0] + c0[1]) + (c0[2] + c0[3])) + ((c1[0] + c1[1]) + (c1[2] + c1[3]));
                  const float rm_ = rsqrtf(sm * (1.f / 512.f) + EPS), rf_ = rsqrtf(sf * (1.f / 512.f) + EPS);
                  scl[tid] = (f32x2){rm_ / rf_, rf_}; } }
            __syncthreads();
            pg8::gemm_phase<EpiOut<false>, BatchOrder, true, false, false, true>(tid, lds, DM * 2, DM * 2, DM * 2, S, E, nullptr, scl);
        }
        SEAMG(P + 5);
        if (IN(P + 6)) for (int rep_ = 0; rep_ < ((l == 0 || 6 != 5) ? NREP(6) : 1); ++rep_) {
            unsigned ldsb_ = (unsigned)(uintptr_t)lds0; asm volatile("" : "+s"(ldsb_)); LAS unsigned char* lds = (LAS unsigned char*)(uintptr_t)ldsb_; volatile LAS unsigned* MISC = (volatile LAS unsigned*)(lds + MISC_OFF); volatile LAS unsigned long long* ARGP = (volatile LAS unsigned long long*)(lds + MISC_OFF + 768); (void)MISC; int wave = wave0, G = G0, bx = bx0; asm volatile("" : "+s"(G), "+s"(bx), "+s"(wave)); const int lane = (int)__builtin_amdgcn_mbcnt_hi(~0u, __builtin_amdgcn_mbcnt_lo(~0u, 0u)); const int tid = wave * 64 + lane; const int vcu = (bx % 8) * (G / 8) + bx / 8; const int gw = vcu * 8 + wave, NGW = G * 8; (void)lane; (void)gw; (void)NGW; (void)vcu;
            GAS unsigned char* ws = (GAS unsigned char*)LDP(22); GAS float* out = (GAS float*)LDP(21); const GAS float* x_in = (const GAS float*)ARGIN(0); (void)out; (void)x_in; (void)ws;
            GAS bf16* H2 = P_XN;
            LAS bf16* WT = (LAS bf16*)lds;
            LAS float* LG = (LAS float*)(lds + 99840) + wave * 576;
            const GAS float* b_rg = (const GAS float*)ARGIN(14) + l * 4; const GAS float* b_re = (const GAS float*)ARGIN(16) + l * 32;
            if (tid < 32) MISC[64 + tid] = 0u;
            const int r16 = lane & 15, g4 = lane >> 4;
            const int m0 = vcu * 128 + wave * 16;
            const GAS bf16* xrow = P_XR + (size_t)(m0 + r16) * DM + 8 * g4;
            f32x4 acc3[3]; acc3[0] = (f32x4){0.f, 0.f, 0.f, 0.f}; acc3[1] = acc3[0]; acc3[2] = acc3[0];
            float ssq = 0.f;
            for (int half = 0; half < 2; ++half) {
                __syncthreads();
                for (int idx = tid; idx < 2 * 48 * 520 / 8; idx += 512) *(LAS u32x4*)(WT + 8 * idx) = *(const GAS u32x4*)(P_WR_L(l) + (size_t)half * 2 * 48 * 520 + 8 * idx);
                __syncthreads();
                for (int s8 = 0; s8 < 16; s8 += 8) {
                    bf16x8 xv[8];
#pragma unroll
                    for (int u = 0; u < 8; ++u) xv[u] = *(const GAS bf16x8*)(xrow + half * 512 + 32 * (s8 + u));
                    u32x2 hwp = {0u, 0u};
#pragma unroll
                    for (int u = 0; u < 8; ++u) {
                        const u32x4 xw = __builtin_bit_cast(u32x4, xv[u]); float xf[8];
#pragma unroll
                        for (int j = 0; j < 4; ++j) { xf[2 * j] = __uint_as_float(xw[j] << 16); xf[2 * j + 1] = __uint_as_float(xw[j] & 0xffff0000u); }
                        u32x2 hw; hw.x = pk4_fp8(xf[0], xf[1], xf[2], xf[3]); hw.y = pk4_fp8(xf[4], xf[5], xf[6], xf[7]);
                        if (u & 1) {
                            const auto s0 = __builtin_amdgcn_permlane16_swap(hwp.x, hw.x, false, false), s1 = __builtin_amdgcn_permlane16_swap(hwp.y, hw.y, false, false);
                            *(GAS u32x4*)((GAS unsigned char*)H2 + (size_t)(m0 + r16) * DM + half * 512 + 32 * (s8 + u - 1 + (g4 & 1)) + 16 * (g4 >> 1)) = (u32x4){s0[0], s1[0], s0[1], s1[1]};
                        } else hwp = hw;
#pragma unroll
                        for (int j = 0; j < 8; ++j) ssq += xf[j] * xf[j];
                        const LAS bf16* wk = WT + r16 * 520 + 32 * (s8 + u) + 8 * g4;
#pragma unroll
                        for (int ct = 0; ct < 3; ++ct) { const bf16x8 bh = *(const LAS bf16x8*)(wk + ct * 16 * 520), bl = *(const LAS bf16x8*)(wk + (48 + ct * 16) * 520);
                            acc3[ct] = __builtin_amdgcn_mfma_f32_16x16x32_bf16(xv[u], bh, acc3[ct], 0, 0, 0); acc3[ct] = __builtin_amdgcn_mfma_f32_16x16x32_bf16(xv[u], bl, acc3[ct], 0, 0, 0); }
                    }
                }
            }
            ssq += __shfl_xor(ssq, 16); ssq += __shfl_xor(ssq, 32);
            const float rstd = rsqrtf(ssq * (1.f / DM) + EPS);
#pragma unroll
            for (int ct = 0; ct < 3; ++ct) { const int c = 16 * ct + r16; if (c < 36) {
#pragma unroll
                for (int rg = 0; rg < 4; ++rg) LG[(4 * g4 + rg) * 36 + c] = acc3[ct][rg]; } }
            LDS_WAIT();
            if (lane < 16) {
                const int m = m0 + lane; const LAS float* lg = LG + lane * 36;
                float gl[4];
#pragma unroll
                for (int g = 0; g < 4; ++g) gl[g] = lg[g] * rstd + b_rg[g];
                int gi = 0; float gm = gl[0];
#pragma unroll
                for (int g = 1; g < 4; ++g) if (gl[g] > gm) { gm = gl[g]; gi = g; }
                float gs = 0.f;
#pragma unroll
                for (int g = 0; g < 4; ++g) gs += __expf(gl[g] - gm);
                const float gval = 1.f / gs;
                float el[8];
#pragma unroll
                for (int j = 0; j < 8; ++j) el[j] = lg[4 + 8 * gi + j] * rstd + b_re[8 * gi + j];
                int i0 = 0; float mx0 = el[0];
#pragma unroll
                for (int j = 1; j < 8; ++j) if (el[j] > mx0) { mx0 = el[j]; i0 = j; }
                int i1 = -1; float mx1 = -INFINITY;
#pragma unroll
                for (int j = 0; j < 8; ++j) if (j != i0 && el[j] > mx1) { mx1 = el[j]; i1 = j; }
                const float e1 = __expf(mx1 - mx0); const float g0 = gval / (1.f + e1), g1 = gval * e1 / (1.f + e1);
                const int ea = gi * 8 + i0, eb = gi * 8 + i1; P_E01[2 * m] = ea; P_E01[2 * m + 1] = eb; P_G01[2 * m] = g0; P_G01[2 * m + 1] = g1; P_RSTD[m] = rstd;
                __hip_atomic_fetch_add((LAS unsigned*)(lds + MISC_OFF) + 64 + ea, 1u, __ATOMIC_RELAXED, __HIP_MEMORY_SCOPE_WORKGROUP); __hip_atomic_fetch_add((LAS unsigned*)(lds + MISC_OFF) + 64 + eb, 1u, __ATOMIC_RELAXED, __HIP_MEMORY_SCOPE_WORKGROUP);
            }
            __syncthreads();
            if (tid < 32) P_CNT[vcu * 32 + tid] = (int)MISC[64 + tid];
        }
        SEAM(P + 6);
        if (IN(P + 7)) for (int rep_ = 0; rep_ < ((l == 0 || 7 != 5) ? NREP(7) : 1); ++rep_) {
            unsigned ldsb_ = (unsigned)(uintptr_t)lds0; asm volatile("" : "+s"(ldsb_)); LAS unsigned char* lds = (LAS unsigned char*)(uintptr_t)ldsb_; volatile LAS unsigned* MISC = (volatile LAS unsigned*)(lds + MISC_OFF); volatile LAS unsigned long long* ARGP = (volatile LAS unsigned long long*)(lds + MISC_OFF + 768); (void)MISC; int wave = wave0, G = G0, bx = bx0; asm volatile("" : "+s"(G), "+s"(bx), "+s"(wave)); const int lane = (int)__builtin_amdgcn_mbcnt_hi(~0u, __builtin_amdgcn_mbcnt_lo(~0u, 0u)); const int tid = wave * 64 + lane; const int vcu = (bx % 8) * (G / 8) + bx / 8; const int gw = vcu * 8 + wave, NGW = G * 8; (void)lane; (void)gw; (void)NGW; (void)vcu;
            GAS unsigned char* ws = (GAS unsigned char*)LDP(22); GAS float* out = (GAS float*)LDP(21); const GAS float* x_in = (const GAS float*)ARGIN(0); (void)out; (void)x_in; (void)ws;
            LAS int* cnt_all = (LAS int*)lds;
            LAS int* pre_e = (LAS int*)(lds + 32768);
            LAS int* tot_e = pre_e + 32;
            LAS int* pst = pre_e + 64;
            LAS int* eL = pre_e + 128;
            for (int i = tid; i < 256 * 32; i += 512) cnt_all[i] = P_CNT[i];
            if (tid < 256) eL[tid] = P_E01[vcu * 256 + tid];
            __syncthreads();
            { LAS int* part = pre_e + 512;
              const int e = tid & 31, p = tid >> 5; int pre = 0, tot = 0;
#pragma unroll
              for (int j = 0; j < 16; ++j) { const int w = p * 16 + j; const int c = cnt_all[w * 32 + e]; pre += (w < vcu) ? c : 0; tot += c; }
              part[(p * 2) * 32 + e] = pre; part[(p * 2 + 1) * 32 + e] = tot; }
            __syncthreads();
            if (tid < 32) { LAS int* part = pre_e + 512; int pre = 0, tot = 0;
#pragma unroll
                for (int p = 0; p < 16; ++p) { pre += part[(p * 2) * 32 + tid]; tot += part[(p * 2 + 1) * 32 + tid]; } pre_e[tid] = pre; tot_e[tid] = tot; }
            __syncthreads();
            if (tid == 0) { int acc = 0; for (int e = 0; e < 32; ++e) { pst[e] = acc; acc += (tot_e[e] + 255) / 256 * 256; } pst[32] = acc; }
            __syncthreads();
            if (vcu == 0 && tid <= 32) P_TSTART[tid] = pst[tid] / 256;
            { LAS int* hist = pre_e + 2048;
              if (tid < 128) hist[tid] = 0;
              __syncthreads();
              int e = 0, rin = 0;
              if (tid < 256) { e = eL[tid]; unsigned long long mym = 0ull;
                  for (int x = 0; x < 32; ++x) { const unsigned long long bm = __ballot(e == x); if (e == x) mym = bm; }
                  rin = __builtin_popcountll(mym & ((1ull << lane) - 1ull));
                  if (rin == 0) hist[wave * 32 + e] = __builtin_popcountll(mym); }
              __syncthreads();
              if (tid < 256) { int r = rin; for (int w = 0; w < wave; ++w) r += hist[w * 32 + e];
                  const int slot = pst[e] + pre_e[e] + r; const int tok = vcu * 128 + (tid >> 1);
                  P_SLOT[vcu * 256 + tid] = slot; P_TOKOF[slot] = tok; P_GATEOF[slot] = P_G01[vcu * 256 + tid]; P_RSTDOF[slot] = P_RSTD[tok]; } }
            if (vcu < 32) { const int e = vcu; for (int s = pst[e] + tot_e[e] + tid; s < pst[e + 1]; s += 512) { P_TOKOF[s] = 0; P_GATEOF[s] = 0.f; P_RSTDOF[s] = 0.f; } }
            __syncthreads();
        }
        SEAM(P + 7);
        if (IN(P + 8)) for (int rep_ = 0; rep_ < ((l == 0 || 8 != 5) ? NREP(8) : 1); ++rep_) {
            unsigned ldsb_ = (unsigned)(uintptr_t)lds0; asm volatile("" : "+s"(ldsb_)); LAS unsigned char* lds = (LAS unsigned char*)(uintptr_t)ldsb_; volatile LAS unsigned* MISC = (volatile LAS unsigned*)(lds + MISC_OFF); volatile LAS unsigned long long* ARGP = (volatile LAS unsigned long long*)(lds + MISC_OFF + 768); (void)MISC; int wave = wave0, G = G0, bx = bx0; asm volatile("" : "+s"(G), "+s"(bx), "+s"(wave)); const int lane = (int)__builtin_amdgcn_mbcnt_hi(~0u, __builtin_amdgcn_mbcnt_lo(~0u, 0u)); const int tid = wave * 64 + lane; const int vcu = (bx % 8) * (G / 8) + bx / 8; const int gw = vcu * 8 + wave, NGW = G * 8; (void)lane; (void)gw; (void)NGW; (void)vcu;
            GAS unsigned char* ws = (GAS unsigned char*)LDP(22); GAS float* out = (GAS float*)LDP(21); const GAS float* x_in = (const GAS float*)ARGIN(0); (void)out; (void)x_in; (void)ws;
            volatile LAS int* TS = (volatile LAS int*)(MISC + 128);
            if (tid <= 32) TS[tid] = P_TSTART[tid];
            __syncthreads();
            MoeOrder S{G, vcu, TS, (const GAS char*)P_XN, (const GAS char*)P_WGU_L(l), 0, (size_t)1024 * 1024, (size_t)256 * 1024};
            EpiGU E{(GAS unsigned char*)P_HH, P_RSTDOF};
            pg8::gemm_phase<EpiGU, MoeOrder, true, true, true>(tid, lds, DM, DM, DM, S, E, P_TOKOF);
            if constexpr (l + 1 < NLAYER) {
                const int U = (int)TS[32] * 4, rem = U & 255; const int nidle = rem ? 256 - rem : 256, rk = rem ? vcu - rem : vcu;
                if (rk >= 0) { LAS float* scr64 = (LAS float*)(lds + wave * 16640);
                    const GAS float* w_gate = (const GAS float*)ARGIN(17) + (size_t)(l + 1) * NEXP * DM * DEXP; const GAS float* w_up = (const GAS float*)ARGIN(18) + (size_t)(l + 1) * NEXP * DM * DEXP; const GAS float* ffn1 = (const GAS float*)ARGIN(12) + (size_t)(l + 1) * DM;
                    for (int it = rk * 8 + wave; it < 16 * 16 * NEXP; it += nidle * 8) conv_gu_item(it, w_gate, w_up, ffn1, P_WGU_L(l + 1), scr64, lane); }
            }
        }
        SEAM(P + 8);
        if (IN(P + 9)) for (int rep_ = 0; rep_ < ((l == 0 || 9 != 5) ? NREP(9) : 1); ++rep_) {
            unsigned ldsb_ = (unsigned)(uintptr_t)lds0; asm volatile("" : "+s"(ldsb_)); LAS unsigned char* lds = (LAS unsigned char*)(uintptr_t)ldsb_; volatile LAS unsigned* MISC = (volatile LAS unsigned*)(lds + MISC_OFF); volatile LAS unsigned long long* ARGP = (volatile LAS unsigned long long*)(lds + MISC_OFF + 768); (void)MISC; int wave = wave0, G = G0, bx = bx0; asm volatile("" : "+s"(G), "+s"(bx), "+s"(wave)); const int lane = (int)__builtin_amdgcn_mbcnt_hi(~0u, __builtin_amdgcn_mbcnt_lo(~0u, 0u)); const int tid = wave * 64 + lane; const int vcu = (bx % 8) * (G / 8) + bx / 8; const int gw = vcu * 8 + wave, NGW = G * 8; (void)lane; (void)gw; (void)NGW; (void)vcu;
            GAS unsigned char* ws = (GAS unsigned char*)LDP(22); GAS float* out = (GAS float*)LDP(21); const GAS float* x_in = (const GAS float*)ARGIN(0); (void)out; (void)x_in; (void)ws;
            volatile LAS int* TS = (volatile LAS int*)(MISC + 128);
            if (tid <= 32) TS[tid] = P_TSTART[tid];
            __syncthreads();
            MoeOrder S{G, vcu, TS, (const GAS char*)P_HH, (const GAS char*)P_WD_L(l), (size_t)256 * 512, (size_t)1024 * 512, (size_t)256 * 512};
            EpiDown E{(GAS unsigned char*)P_Y, P_GATEOF};
            pg8::gemm_phase<EpiDown, MoeOrder, true, false, true>(tid, lds, DEXP, DEXP, DEXP, S, E, nullptr);
            if constexpr (l + 1 < NLAYER) {
                const int U = (int)TS[32] * 4, rem = U & 255; const int nidle = rem ? 256 - rem : 256, rk = rem ? vcu - rem : vcu;
                if (rk >= 0) { LAS float* scr64 = (LAS float*)(lds + wave * 16640);
                    const GAS float* w_down = (const GAS float*)ARGIN(19) + (size_t)(l + 1) * NEXP * DEXP * DM;
                    for (int it = rk * 8 + wave; it < 8 * 16 * NEXP; it += nidle * 8) conv_d_item(it, w_down, P_WD_L(l + 1), scr64, lane); }
            }
        }
        SEAM(P + 9);
}

__global__ void __launch_bounds__(512, 2) fwd(Args args) {
    extern __shared__ __attribute__((aligned(16))) unsigned char lds_raw[];
    LAS unsigned char* lds0 = (LAS unsigned char*)lds_raw;
    const int tid0 = threadIdx.x; const int wave0 = __builtin_amdgcn_readfirstlane(tid0 >> 6);
    const int G0 = gridDim.x; const int bx0 = blockIdx.x;
    { volatile LAS unsigned* MISC = (volatile LAS unsigned*)(lds0 + MISC_OFF); const int tid = tid0;
    for (int u = tid; u < 256; u += 512) MISC[u] = 0u;
    __syncthreads();
    volatile LAS unsigned long long* ARGP = (volatile LAS unsigned long long*)(lds0 + MISC_OFF + 768);
    if (tid < 21) ARGP[tid] = (unsigned long long)args.in[tid];
    if (tid == 21) ARGP[21] = (unsigned long long)args.out;
    if (tid == 22) ARGP[22] = (unsigned long long)args.ws;
    __syncthreads(); }
#if MK_ONE_LAUNCH
    XcdBarrier bar = xcd_barrier_post((unsigned*)(args.ws + WS_CTL) + CW_BAR, (volatile LAS unsigned*)(lds0 + MISC_OFF) + 8, gridDim.x);
    const int vcu0 = (bx0 % 8) * (G0 / 8) + bx0 / 8;
    XcdBarrier gbar = xcd_barrier_post((unsigned*)(args.ws + WS_CTL) + CW_BAR + (1 + (vcu0 >> 4)) * XCD_BAR_WORDS, (volatile LAS unsigned*)(lds0 + MISC_OFF) + 12, 16u);
#else
    XcdBarrier bar; bar.bar = nullptr; bar.x = 0; bar.st = nullptr; bar.n = 0;
    XcdBarrier gbar = bar;
#endif
    const int lo = args.ph_lo, hi_ = args.ph_hi;
    if (IN(0)) {
        const GAS int* positions = (const GAS int*)args.in[1]; GAS float* COSp = (GAS float*)(args.ws + WS_COS); GAS float* SINp = (GAS float*)(args.ws + WS_SIN);
        for (int i = bx0 * 512 + tid0; i < NTOK * 16; i += G0 * 512) { const int tk = i >> 4, fi = i & 15;
            const double invrev = exp2(-(double)fi * (13.287712379549449 / 16.0)) * 0.15915494309189535; const double rev = (double)positions[tk] * invrev; const float fr = (float)(rev - rint(rev));
            COSp[i] = __builtin_amdgcn_cosf(fr); SINp[i] = __builtin_amdgcn_sinf(fr); }
    }
    layer_body<0>(lo, hi_, lds0, wave0, G0, bx0, bar, gbar);
    layer_body<1>(lo, hi_, lds0, wave0, G0, bx0, bar, gbar);
    layer_body<2>(lo, hi_, lds0, wave0, G0, bx0, bar, gbar);
}

extern "C" void kernel_launch(void* const* d_in, const int* in_sizes, int n_in, void* d_out, int out_size, void* d_ws, size_t ws_size, hipStream_t stream) {
    static int grid = 0;
    if (grid == 0) {
        if (n_in != 21 || out_size != NTOK * DM || ws_size < WS_END) { fprintf(stderr, "kernel_launch: unexpected shapes (n_in %d out %d ws %zu)\n", n_in, out_size, ws_size); grid = -1; return; }
        int dev = 0, cus = 0;
        if (hipGetDevice(&dev) != hipSuccess || hipDeviceGetAttribute(&cus, hipDeviceAttributeMultiprocessorCount, dev) != hipSuccess) { grid = -1; return; }
        if (hipFuncSetAttribute((const void*)fwd, hipFuncAttributeMaxDynamicSharedMemorySize, LDS_BYTES) != hipSuccess) { fprintf(stderr, "kernel_launch: hipFuncSetAttribute failed\n"); grid = -1; return; }
        int per_cu = 0;
        if (hipOccupancyMaxActiveBlocksPerMultiprocessor(&per_cu, (const void*)fwd, 512, LDS_BYTES) != hipSuccess || per_cu < 1) fprintf(stderr, "kernel_launch: occupancy query says %d\n", per_cu);
        (void)hipGetLastError();
        grid = cus;
        if (grid != 256) { fprintf(stderr, "kernel_launch: built for 256 CUs, got %d\n", grid); grid = -1; return; }
    }
    if (grid < 0) return;
    if (hipMemsetAsync((char*)d_ws + WS_CTL, 0, CTL_ZERO_BYTES, stream) != hipSuccess) return;
    Args a{};
    for (int i = 0; i < 21; ++i) a.in[i] = d_in[i];
    a.out = (float*)d_out; a.ws = (unsigned char*)d_ws;
#if MK_ONE_LAUNCH
    a.ph_lo = 0; a.ph_hi = 21;
    hipLaunchKernelGGL(fwd, dim3(grid), dim3(512), LDS_BYTES, stream, a);
#else
    for (int p = 0; p <= 20; ++p) { a.ph_lo = p; a.ph_hi = p + 1; hipLaunchKernelGGL(fwd, dim3(grid), dim3(512), LDS_BYTES, stream, a); }
#endif
}
```

```cpp
#include <hip/hip_runtime.h>
#include <cstdio>
#include <cstdint>

#ifndef PROBE_PHASE
#define PROBE_PHASE -1
#endif
#ifndef PROBE_LAYER
#define PROBE_LAYER -1
#endif
#define NREP(k) (((PROBE_PHASE) == (k) && ((PROBE_LAYER) < 0 || (PROBE_LAYER) == l)) ? 2 : 1)
#ifndef MK_ONE_LAUNCH
#define MK_ONE_LAUNCH 1
#endif

#define LAS __attribute__((address_space(3)))
#define GAS __attribute__((address_space(1)))
typedef unsigned short bf16;
typedef short bf16x8 __attribute__((ext_vector_type(8)));
typedef short s16x4 __attribute__((ext_vector_type(4)));
typedef float f32x4 __attribute__((ext_vector_type(4)));
typedef float f32x2 __attribute__((ext_vector_type(2)));
typedef float f32x16 __attribute__((ext_vector_type(16)));
typedef unsigned u32x4 __attribute__((ext_vector_type(4)));
typedef unsigned u32x2 __attribute__((ext_vector_type(2)));

constexpr int NB = 16, SEQ = 2048, DM = 1024, NTOK = NB * SEQ, NLAYER = 2;
constexpr int INW = 1960, INP = 2048;
constexpr int NEXP = 32, DEXP = 512;
constexpr int MAXSLOT = 73728;
constexpr float EPS = 1e-6f;
constexpr float WSCALE = 64.f, WSCALE_INV = 1.f / 64.f;
constexpr float LOG2E = 1.4426950408889634f;
constexpr float C2F = 0.125f * LOG2E;
constexpr float C2M = 0.10206207261596575f * LOG2E;

constexpr size_t MiB = 1u << 20, KiB = 1u << 10;
constexpr size_t WS_CTL = 0, CTL_ZERO_BYTES = 256 * KiB;
constexpr size_t WS_COS = 1 * MiB, WS_SIN = 3 * MiB;
constexpr size_t WS_SSQ = 5 * MiB;
constexpr size_t WS_FLOG = 6 * MiB;
constexpr size_t WS_E01 = 8 * MiB;
constexpr size_t WS_G01 = 8 * MiB + 256 * KiB;
constexpr size_t WS_SLOT = 8 * MiB + 512 * KiB;
constexpr size_t WS_TOKOF = 8 * MiB + 768 * KiB;
constexpr size_t WS_GATEOF = 9 * MiB + 256 * KiB;
constexpr size_t WS_CNT = 9 * MiB + 768 * KiB;
constexpr size_t WS_TSTART = 9 * MiB + 800 * KiB;
constexpr size_t WS_RSTD = 9 * MiB + 832 * KiB;
constexpr size_t WS_RSTDOF = 7 * MiB;
constexpr size_t WS_KPE = 10 * MiB;
constexpr size_t WS_KAUG = 10 * MiB + 2 * MiB;
constexpr size_t WS_WIN = 16 * MiB;
constexpr size_t WS_WUQ = 20 * MiB;
constexpr size_t WS_WUKV = 20 * MiB + 512 * KiB;
constexpr size_t WS_WOUT = 21 * MiB;
constexpr size_t WS_WGU = 24 * MiB;
constexpr size_t WS_WD = 88 * MiB;
constexpr size_t WS_XN = 120 * MiB;
constexpr size_t WS_FQKV = 184 * MiB;
constexpr size_t WS_LAT = 280 * MiB;
constexpr size_t WS_QM = 312 * MiB;
constexpr size_t WS_KVM = 360 * MiB;
constexpr size_t WS_Y = 280 * MiB;
constexpr size_t WS_BIASF = 424 * MiB;
constexpr size_t WS_NRM = 425 * MiB;
constexpr size_t WS_WR = 426 * MiB;
constexpr size_t WS_XR = 427 * MiB;
constexpr size_t WS_OSS = 491 * MiB;
constexpr size_t WS_RSTDX = 493 * MiB;
constexpr size_t WS_W1 = 494 * MiB;
constexpr size_t WS_END = 502 * MiB;
static_assert(WS_Y + (size_t)MAXSLOT * 1024 * 2 <= WS_END, "Y fits");
static_assert(WS_FQKV + (size_t)MAXSLOT * 512 * 2 <= WS_LAT, "HH fits");

constexpr int CW_BAR = 1024;
static_assert((size_t)(CW_BAR + 17 * 3456) * 4 <= CTL_ZERO_BYTES, "barrier words inside the zeroed control block");

constexpr int RING_BYTES = 147456;
constexpr int MISC_OFF = RING_BYTES;
constexpr int LDS_BYTES = RING_BYTES + 1024;

typedef __bf16 bf16x2_t __attribute__((ext_vector_type(2)));
__device__ __forceinline__ unsigned cvt_pk_bf16(float lo, float hi) { const f32x2 v = {lo, hi}; const bf16x2_t b = __builtin_convertvector(v, bf16x2_t); return __builtin_bit_cast(unsigned, b); }
__device__ __forceinline__ float bf2f(unsigned short b) { return __uint_as_float((unsigned)b << 16); }
__device__ __forceinline__ float wave_sum(float v) {
#pragma unroll
    for (int o = 1; o < 64; o <<= 1) v += __shfl_xor(v, o);
    return v;
}
__device__ __forceinline__ unsigned pk4_fp8(float a, float b, float c, float d) { int w = 0; w = __builtin_amdgcn_cvt_pk_fp8_f32(a, b, w, false); w = __builtin_amdgcn_cvt_pk_fp8_f32(c, d, w, true); return (unsigned)w; }
#define LDS_WAIT() asm volatile("s_waitcnt lgkmcnt(0)" ::: "memory")

#define XB_TMO      128
#define XB_XCNT(j)  (256  + 64 * (j))
#define XB_XSUB(j)  (1280 + 64 * (j))
#define XB_XGEN(j)  (2304 + 64 * (j))
#define XB_TOP      3328
#define XB_TOPGEN   3392
#define XCD_BAR_WORDS 3456
#define XB_SPIN_CAP (1u << 18)
__device__ __forceinline__ unsigned xb_ld(unsigned* p)              { return __hip_atomic_load(p, __ATOMIC_RELAXED, __HIP_MEMORY_SCOPE_AGENT); }
__device__ __forceinline__ unsigned xb_add(unsigned* p, unsigned v) { return __hip_atomic_fetch_add(p, v, __ATOMIC_RELAXED, __HIP_MEMORY_SCOPE_AGENT); }
__device__ __forceinline__ unsigned xb_xcc_id() { return (unsigned)__builtin_amdgcn_s_getreg((3 << 11) | 20) & 0xFu; }
#define XB_SPIN(cond, bar) do { unsigned _sp = 0; while (cond) { __builtin_amdgcn_s_sleep(1); \
    if ((++_sp & 255u) == 0u) { if (xb_ld(&(bar)[XB_TMO])) break; if (_sp > XB_SPIN_CAP) { atomicAdd(&(bar)[XB_TMO], 1u); break; } } } } while (0)
struct XcdBarrier { unsigned* bar; unsigned x; volatile LAS unsigned* st; unsigned n; };
__device__ __forceinline__ XcdBarrier xcd_barrier_post(unsigned* bar, volatile LAS unsigned* st, unsigned n) {
    XcdBarrier b; b.bar = bar; b.x = xb_xcc_id(); b.st = st; b.n = n;
    if (threadIdx.x == 0) (void)xb_add(&bar[XB_XCNT(b.x)], 1u);
    return b;
}
__device__ __forceinline__ void xcd_barrier_complete(unsigned* bar, unsigned x, unsigned G, unsigned& nloc, unsigned& nx) {
    unsigned sum, cnt, mine, sp = 0u;
    for (;;) {
        sum = 0u; cnt = 0u; mine = 0u;
#pragma unroll
        for (unsigned j = 0; j < 16; ++j) { const unsigned c = xb_ld(&bar[XB_XCNT(j)]); sum += c; cnt += (c > 0u) ? 1u : 0u; mine = (j == x) ? c : mine; }
        if (sum == G) break;
        __builtin_amdgcn_s_sleep(1);
        if ((++sp & 255u) == 0u) { if (xb_ld(&bar[XB_TMO])) break; if (sp > XB_SPIN_CAP) { atomicAdd(&bar[XB_TMO], 1u); break; } }
    }
    nloc = mine > 0u ? mine : 1u; nx = cnt > 0u ? cnt : 1u;
}
__device__ __forceinline__ void xcd_barrier(const XcdBarrier& b) {
    asm volatile("s_waitcnt vmcnt(0)" ::: "memory");
    __syncthreads();
    if (threadIdx.x == 0) {
        unsigned* bar = b.bar;
        __builtin_amdgcn_s_waitcnt(0);
        unsigned nloc = b.st[0], nx = b.st[1];
        if (nloc == 0u) { xcd_barrier_complete(bar, b.x, b.n, nloc, nx); b.st[0] = nloc; b.st[1] = nx; }
        const unsigned old = xb_add(&bar[XB_XSUB(b.x)], 1u);
        const unsigned gen = old / nloc;
        if (old + 1u == (gen + 1u) * nloc) {
            __builtin_amdgcn_fence(__ATOMIC_RELEASE, "agent");
            asm volatile("s_waitcnt vmcnt(0)" ::: "memory");
            const unsigned og = xb_add(&bar[XB_TOP], 1u);
            const unsigned tg = og / nx;
            if (og + 1u == (tg + 1u) * nx) xb_add(&bar[XB_TOPGEN], 1u);
            else XB_SPIN(xb_ld(&bar[XB_TOPGEN]) == tg, bar);
            __builtin_amdgcn_fence(__ATOMIC_ACQUIRE, "agent");
            xb_add(&bar[XB_XGEN(b.x)], 1u);
            asm volatile("s_waitcnt vmcnt(0)" ::: "memory");
        } else {
            XB_SPIN(xb_ld(&bar[XB_XGEN(b.x)]) == gen, bar);
            __builtin_amdgcn_fence(__ATOMIC_ACQUIRE, "agent");
            asm volatile("s_waitcnt vmcnt(0)" ::: "memory");
        }
    }
    __syncthreads();
}

namespace pg8 {
constexpr int BM = 256, BK = 64, HALF = 128, HTB = HALF * BK * 2, STAGE_BYTES = 8 * HTB;
typedef int v4i32_t __attribute__((ext_vector_type(4)));
typedef int v8i32_t __attribute__((ext_vector_type(8)));
__host__ __device__ __forceinline__ int lds_byte(int r, int c) { const int st = (r >> 4) * 2 + (c >> 5), rr = r & 15, cc = c & 31, ob = rr * 64 + cc * 2; return st * 1024 + (ob ^ (((ob >> 9) & 1) << 5)); }
__host__ __device__ __forceinline__ void stage_rc(int b, int& R, int& C) { const int st = b / 1024, sb = b % 1024, swz = sb ^ (((sb >> 9) & 1) << 5); R = (st >> 1) * 16 + swz / 64; C = (st & 1) * 32 + (swz % 64) / 2; }
__host__ __device__ __forceinline__ int perm32(int rho) { const int n = rho >> 4, i = rho & 15; return 8 * (i >> 2) + 4 * n + (i & 3); }

struct Unit { const GAS char* a; const GAS char* b; int pm, pn, e; };

template <int N> __device__ __forceinline__ void wait_vm() { asm volatile("s_waitcnt vmcnt(%0)" :: "n"(N) : "memory"); }
template <class Epi, class Sched, bool ALIGN_EPI, bool GATHER, bool FP8 = false, bool MIDSCALE = false, bool VARK = false>
__device__ __forceinline__ void gemm_phase(const int tid, LAS unsigned char* lds, const int Kb, const int ldaB, const int ldbB, const Sched& S, const Epi& E, const GAS int* __restrict__ tokof, const LAS f32x2* scl = nullptr) {
    const int wid = __builtin_amdgcn_readfirstlane(tid >> 6), lane = tid & 63, wr = wid >> 2, wc = wid & 3, fr = lane & 15, fq = lane >> 4;
    const int nt = Kb / 128;
    unsigned voffA[2], voffB[2]; int RA[2], CA2[2];
#pragma unroll
    for (int i = 0; i < 2; ++i) { int R, C; stage_rc(tid * 16 + i * 8192, R, C); const int Rb = Epi::WIDE ? (64 * (R >> 5) + perm32(R & 31)) : Epi::PERM ? ((R & ~31) + perm32(R & 31)) : R;
        voffA[i] = (unsigned)(R * ldaB + C * 2); voffB[i] = (unsigned)(Rb * ldbB + C * 2); RA[i] = R; CA2[i] = C * 2; }
    const size_t kstep = (size_t)(BK * 2);
    const size_t hstepA = GATHER ? 0 : (size_t)HALF * ldaB;
    const size_t hstepB = (size_t)(Epi::WIDE ? 32 : HALF) * ldbB;
    const unsigned ldsw = (unsigned)wid * 1024u;
    const int aoff = lds_byte(wr * 64 + fr, fq * 8), boff = lds_byte(wc * 32 + fr, fq * 8);
    unsigned gcur[2][2], gnxt[2][2];
    const int scl8 = 0x7F7F7F7F;
#define PG8_SA(b, h) (((b) * 2 + (h)) * HTB)
#define PG8_SB(b, h) ((4 + (b) * 2 + (h)) * HTB)
#define PG8_STAGE(bufoff, gbase, voff) do { const unsigned long long gb_ = (unsigned long long)(gbase); const unsigned lbase_ = (unsigned)__builtin_amdgcn_readfirstlane((int)((unsigned)(uintptr_t)lds + (unsigned)(bufoff) + ldsw)); \
        _Pragma("unroll") for (int _i = 0; _i < 2; ++_i) { unsigned keep_; \
            asm volatile("s_mov_b32 %0, m0\n\ts_mov_b32 m0, %3\n\ts_nop 0\n\tglobal_load_lds_dwordx4 %1, %2\n\ts_mov_b32 m0, %0" : "=&s"(keep_) : "v"((voff)[_i]), "s"(gb_), "s"(lbase_ + (unsigned)(_i * 8192)) : "memory"); } } while (0)
#define PG8_STAGE_A(bufoff, base, h, nx) do { if constexpr (GATHER) { unsigned _v[2]; _v[0] = (nx) ? gnxt[h][0] : gcur[h][0]; _v[1] = (nx) ? gnxt[h][1] : gcur[h][1]; PG8_STAGE(bufoff, base, _v); } \
        else { PG8_STAGE(bufoff, (base) + (h) * hstepA, voffA); } } while (0)
#define PG8_LDA(dst, b, h) do { _Pragma("unroll") for (int m = 0; m < 4; ++m) _Pragma("unroll") for (int k = 0; k < 2; ++k) dst[m][k] = *(const LAS bf16x8*)(lds + PG8_SA(b, h) + aoff + m * 2048 + k * 1024); } while (0)
#define PG8_LDB(dst, b, h) do { _Pragma("unroll") for (int n = 0; n < 2; ++n) _Pragma("unroll") for (int k = 0; k < 2; ++k) dst[n][k] = *(const LAS bf16x8*)(lds + PG8_SB(b, h) + boff + n * 2048 + k * 1024); } while (0)
#define PG8_MMA(ai, bj, At, Bt) do { __builtin_amdgcn_s_setprio(1); if constexpr (FP8) { _Pragma("unroll") for (int m = 0; m < 4; ++m) _Pragma("unroll") for (int n = 0; n < 2; ++n) { \
        const v8i32_t b8_ = __builtin_shufflevector(__builtin_bit_cast(v4i32_t, Bt[n][0]), __builtin_bit_cast(v4i32_t, Bt[n][1]), 0, 1, 2, 3, 4, 5, 6, 7), a8_ = __builtin_shufflevector(__builtin_bit_cast(v4i32_t, At[m][0]), __builtin_bit_cast(v4i32_t, At[m][1]), 0, 1, 2, 3, 4, 5, 6, 7); \
        asm volatile("s_nop 1\n\tv_mfma_scale_f32_16x16x128_f8f6f4 %0, %1, %2, %0, %3, %3 op_sel_hi:[0,0,0]" : "+v"(acc[ai][bj][m][n]) : "v"(b8_), "v"(a8_), "v"(scl8)); } } \
      else { _Pragma("unroll") for (int m = 0; m < 4; ++m) _Pragma("unroll") for (int n = 0; n < 2; ++n) _Pragma("unroll") for (int k = 0; k < 2; ++k) \
        acc[ai][bj][m][n] = __builtin_amdgcn_mfma_f32_16x16x32_bf16(Bt[n][k], At[m][k], acc[ai][bj][m][n], 0, 0, 0); } __builtin_amdgcn_s_setprio(0); } while (0)
#define PG8_MMA_Z(ai, bj, At, Bt) do { __builtin_amdgcn_s_setprio(1); if constexpr (FP8) { _Pragma("unroll") for (int m = 0; m < 4; ++m) _Pragma("unroll") for (int n = 0; n < 2; ++n) { \
        const v8i32_t b8_ = __builtin_shufflevector(__builtin_bit_cast(v4i32_t, Bt[n][0]), __builtin_bit_cast(v4i32_t, Bt[n][1]), 0, 1, 2, 3, 4, 5, 6, 7), a8_ = __builtin_shufflevector(__builtin_bit_cast(v4i32_t, At[m][0]), __builtin_bit_cast(v4i32_t, At[m][1]), 0, 1, 2, 3, 4, 5, 6, 7); \
        asm volatile("s_nop 1\n\tv_mfma_scale_f32_16x16x128_f8f6f4 %0, %1, %2, 0, %3, %3 op_sel_hi:[0,0,0]" : "=&v"(acc[ai][bj][m][n]) : "v"(b8_), "v"(a8_), "v"(scl8)); } } \
      __builtin_amdgcn_s_setprio(0); } while (0)
#define PG8_WAIT_V(n) asm volatile("s_waitcnt vmcnt(" #n ")" ::: "memory")
#define PG8_WAIT_L(n) asm volatile("s_waitcnt lgkmcnt(" #n ")" ::: "memory")
#define PG8_BAR __builtin_amdgcn_s_barrier()
#define PG8_SCHED __builtin_amdgcn_sched_barrier(0)
#define PG8_GLOAD(dst, u) do { if constexpr (GATHER) { _Pragma("unroll") for (int _h = 0; _h < 2; ++_h) _Pragma("unroll") for (int _i = 0; _i < 2; ++_i) \
        dst[_h][_i] = (unsigned)tokof[(u).pm * BM + _h * HALF + RA[_i]] * (unsigned)ldaB + (unsigned)CA2[_i]; } } while (0)
    Unit cur, nxt; int ui = 0;
    if (!S.next(0, cur)) return;
    PG8_GLOAD(gcur, cur);
    typename Epi::Pre pre = E.prefetch(cur, wr, fr);
    f32x4 acc[2][2][4][2];
#pragma unroll
    for (int a = 0; a < 2; ++a)
#pragma unroll
        for (int b = 0; b < 2; ++b)
#pragma unroll
            for (int m = 0; m < 4; ++m)
#pragma unroll
                for (int n = 0; n < 2; ++n) acc[a][b][m][n] = (f32x4){0.f, 0.f, 0.f, 0.f};
    bf16x8 At[4][2], B0[2][2], B1[2][2];
    const GAS char* cA = cur.a; const GAS char* cB = cur.b;
    PG8_STAGE(PG8_SB(0, 0), cB, voffB); PG8_STAGE(PG8_SB(0, 1), cB + hstepB, voffB); PG8_STAGE_A(PG8_SA(0, 0), cA, 0, false); PG8_STAGE_A(PG8_SA(0, 1), cA, 1, false);
    if (wr == 1) PG8_BAR;
    PG8_WAIT_V(2); PG8_BAR;
    PG8_STAGE(PG8_SB(1, 0), cB + kstep, voffB); PG8_STAGE_A(PG8_SA(1, 0), cA + kstep, 0, false); PG8_STAGE(PG8_SB(1, 1), cB + hstepB + kstep, voffB);
    PG8_WAIT_V(6); PG8_BAR;
    bool fresh = false;
    for (;;) {
        const bool has_next = S.next(ui + 1, nxt);
        if constexpr (GATHER) { if (has_next) { PG8_GLOAD(gnxt, nxt); } else { _Pragma("unroll") for (int _h = 0; _h < 2; ++_h) _Pragma("unroll") for (int _i = 0; _i < 2; ++_i) gnxt[_h][_i] = gcur[_h][_i]; } }
        const GAS char* nA = has_next ? nxt.a : cA; const GAS char* nB = has_next ? nxt.b : cB;
        const int ntu = VARK ? (cur.e ? nt / 2 : nt) : nt;
#pragma nounroll
        for (int t = 0; t < ntu; t += 2) {
            const bool last = (t == ntu - 2);
            const GAS char* a1 = cA + (size_t)(t + 1) * kstep;
            const GAS char* a2 = last ? nA : cA + (size_t)(t + 2) * kstep; const GAS char* b2 = last ? nB : cB + (size_t)(t + 2) * kstep;
            const GAS char* a3 = a2 + kstep; const GAS char* b3 = b2 + kstep;
            const bool fe = fresh; fresh = false;
            if constexpr (MIDSCALE) { if (t == nt / 2) {
#pragma unroll
                for (int ai = 0; ai < 2; ++ai)
#pragma unroll
                    for (int m = 0; m < 4; ++m) { const float r_ = scl[ui * 256 + ai * 128 + wr * 64 + m * 16 + fr][0];
#pragma unroll
                        for (int bj = 0; bj < 2; ++bj)
#pragma unroll
                            for (int n = 0; n < 2; ++n) acc[ai][bj][m][n] *= r_; } } }
            PG8_LDB(B0, 0, 0); PG8_LDB(B1, 0, 1); PG8_SCHED; PG8_LDA(At, 0, 0); PG8_STAGE_A(PG8_SA(1, 1), a1, 1, false);
            if (fe) wait_vm<8 + Epi::NST>(); else PG8_WAIT_V(8); PG8_WAIT_L(0); PG8_BAR; if (FP8 && t == 0) { PG8_MMA_Z(0, 0, At, B0); PG8_MMA_Z(0, 1, At, B1); } else { PG8_MMA(0, 0, At, B0); PG8_MMA(0, 1, At, B1); } PG8_BAR; PG8_SCHED;
            PG8_LDA(At, 0, 1); PG8_STAGE(PG8_SB(0, 0), b2, voffB); PG8_STAGE(PG8_SB(0, 1), b2 + hstepB, voffB); PG8_STAGE_A(PG8_SA(0, 0), a2, 0, last);
            if (fe) wait_vm<8 + Epi::NST>(); else PG8_WAIT_V(8); PG8_WAIT_L(0); PG8_BAR; if (FP8 && t == 0) { PG8_MMA_Z(1, 0, At, B0); PG8_MMA_Z(1, 1, At, B1); } else { PG8_MMA(1, 0, At, B0); PG8_MMA(1, 1, At, B1); } PG8_BAR; PG8_SCHED;
            PG8_LDB(B0, 1, 0); PG8_LDB(B1, 1, 1); PG8_SCHED; PG8_LDA(At, 1, 0); PG8_STAGE_A(PG8_SA(0, 1), a2, 1, last);
            PG8_WAIT_V(8); PG8_WAIT_L(0); PG8_BAR; PG8_MMA(0, 0, At, B0); PG8_MMA(0, 1, At, B1); PG8_BAR; PG8_SCHED;
            PG8_LDA(At, 1, 1); PG8_STAGE(PG8_SB(1, 0), b3, voffB); PG8_STAGE(PG8_SB(1, 1), b3 + hstepB, voffB); PG8_STAGE_A(PG8_SA(1, 0), a3, 0, last);
            PG8_WAIT_V(8); PG8_WAIT_L(0); PG8_BAR; PG8_MMA(1, 0, At, B0); PG8_MMA(1, 1, At, B1); PG8_BAR; PG8_SCHED;
        }
        if constexpr (ALIGN_EPI) { if (wr == 0) PG8_BAR; }
        if constexpr (FP8) {
            asm volatile("s_nop 15\n\ts_nop 15" ::: "memory");
#pragma unroll
            for (int a = 0; a < 2; ++a)
#pragma unroll
                for (int b = 0; b < 2; ++b)
                    asm volatile("" : "+v"(acc[a][b][0][0]), "+v"(acc[a][b][0][1]), "+v"(acc[a][b][1][0]), "+v"(acc[a][b][1][1]), "+v"(acc[a][b][2][0]), "+v"(acc[a][b][2][1]), "+v"(acc[a][b][3][0]), "+v"(acc[a][b][3][1])); }
        if constexpr (MIDSCALE) E(acc, cur, wr, wc, fr, fq, scl + ui * 256); else E(acc, cur, wr, wc, fr, fq, pre);
        if (!has_next) break;
        pre = E.prefetch(nxt, wr, fr);
        if constexpr (FP8) {
#pragma unroll
            for (int a = 0; a < 2; ++a)
#pragma unroll
                for (int b = 0; b < 2; ++b)
                    asm volatile("" : "=v"(acc[a][b][0][0]), "=v"(acc[a][b][0][1]), "=v"(acc[a][b][1][0]), "=v"(acc[a][b][1][1]), "=v"(acc[a][b][2][0]), "=v"(acc[a][b][2][1]), "=v"(acc[a][b][3][0]), "=v"(acc[a][b][3][1]));
        } else {
#pragma unroll
            for (int a = 0; a < 2; ++a)
#pragma unroll
                for (int b = 0; b < 2; ++b)
#pragma unroll
                    for (int m = 0; m < 4; ++m)
#pragma unroll
                        for (int n = 0; n < 2; ++n) acc[a][b][m][n] = (f32x4){0.f, 0.f, 0.f, 0.f};
        }
        cur = nxt; cA = nA; cB = nB; ++ui; fresh = true;
        if constexpr (GATHER) { _Pragma("unroll") for (int _h = 0; _h < 2; ++_h) _Pragma("unroll") for (int _i = 0; _i < 2; ++_i) gcur[_h][_i] = gnxt[_h][_i]; }
        if constexpr (ALIGN_EPI) { if (wr == 1) PG8_BAR; }
    }
    PG8_WAIT_V(0);
    if constexpr (!ALIGN_EPI) { if (wr == 0) PG8_BAR; }
    PG8_BAR;
#undef PG8_SA
#undef PG8_SB
#undef PG8_STAGE
#undef PG8_STAGE_A
#undef PG8_LDA
#undef PG8_LDB
#undef PG8_MMA
#undef PG8_MMA_Z
#undef PG8_WAIT_V
#undef PG8_WAIT_L
#undef PG8_BAR
#undef PG8_SCHED
#undef PG8_GLOAD
}
}
using pg8::Unit;

struct BatchOrder {
    int nN, v; const GAS char* A; const GAS char* B; size_t aT, bT;
    __device__ __forceinline__ bool next(int i, Unit& u) const {
        const int uu = i * 16 + (v & 15); if (uu >= 8 * nN) return false;
        u.pm = __builtin_amdgcn_readfirstlane((v >> 4) * 8 + uu / nN); u.pn = __builtin_amdgcn_readfirstlane(uu % nN); u.e = 0;
        u.a = A + (size_t)u.pm * aT; u.b = B + (size_t)u.pn * bT; return true;
    }
};
struct UpOrder {
    int v; const GAS char* LATp; const GAS char* Wq; const GAS char* Wkv;
    __device__ __forceinline__ bool next(int i, Unit& u) const {
        const int j = v & 15; const bool hi = j >= 8; if (i >= (hi ? 4 : 3)) return false;
        const bool kv = hi ? (i < 3) : (i == 2); u.pn = __builtin_amdgcn_readfirstlane(hi ? (kv ? 1 + i : 2) : (kv ? 0 : i)); u.e = __builtin_amdgcn_readfirstlane(kv ? 1 : 0); u.pm = __builtin_amdgcn_readfirstlane((v >> 4) * 8 + (j & 7));
        u.a = LATp + (size_t)u.pm * 256 * 512 * 2 + (u.e ? 512 : 0);
        u.b = (u.e ? Wkv : Wq) + (size_t)u.pn * 256 * 256 * 2; return true;
    }
};
struct MoeOrder {
    int G, c; const volatile LAS int* TS; const GAS char* A; const GAS char* W; size_t aT  , wE  , wT  ;
    __device__ __forceinline__ bool next(int i, Unit& u) const {
        const int L = i * G + c; const int ntile = __builtin_amdgcn_readfirstlane(TS[32]); if (L >= ntile * 4) return false;
        const int rt = L >> 2, ct = L & 3;
        const int ln_ = (int)__builtin_amdgcn_mbcnt_hi(~0u, __builtin_amdgcn_mbcnt_lo(~0u, 0u)); const int tsv_ = TS[ln_ & 31];
        const int e = __builtin_popcountll(__ballot(ln_ >= 1 && ln_ < 32 && tsv_ <= rt));
        u.pm = rt; u.pn = ct; u.e = e; u.a = A + (size_t)rt * aT; u.b = W + (size_t)e * wE + (size_t)ct * wT; return true;
    }
};

__device__ __forceinline__ u32x4 pack8(f32x4 v0, f32x4 v1) { u32x4 w; w.x = cvt_pk_bf16(v0[0], v0[1]); w.y = cvt_pk_bf16(v0[2], v0[3]); w.z = cvt_pk_bf16(v1[0], v1[1]); w.w = cvt_pk_bf16(v1[2], v1[3]); return w; }

__device__ __forceinline__ void wide_store(GAS bf16* p, long dB, bool lo, u32x4 X, u32x4 Y) {
    u32x4 Yr;
#pragma unroll
    for (int j = 0; j < 4; ++j) Yr[j] = (unsigned)__builtin_amdgcn_update_dpp(0, (int)Y[j], 0x128, 0xf, 0xf, false);
    u32x4 A, B;
#pragma unroll
    for (int j = 0; j < 4; ++j) { A[j] = lo ? X[j] : Yr[j]; B[j] = lo ? Yr[j] : X[j]; }
    *(GAS u32x4*)p = A; *(GAS u32x4*)(p + dB) = B;
}

struct EpiWin {
    static constexpr int NST = 16;
    static constexpr bool PERM = true, WIDE = true;
    GAS bf16* LAT_; GAS bf16* FQKV_; GAS bf16* KPE_; GAS float* FLOG_; GAS float* SSQ_; const GAS float* COS_; const GAS float* SIN_; const GAS float* RSX_;
    struct Pre { float v[8]; };
    __device__ __forceinline__ Pre prefetch(const Unit& u, int wr, int fr) const { Pre p; const GAS float* RSX = RSX_; asm volatile("" : "+s"(RSX));
#pragma unroll
        for (int g = 0; g < 8; ++g) p.v[g] = RSX[u.pm * 256 + (g >> 2) * 128 + wr * 64 + (g & 3) * 16 + fr]; return p; }
    __device__ __forceinline__ void operator()(f32x4 (&acc)[2][2][4][2], const Unit& u, int wr, int wc, int fr, int fq, const Pre& pre) const {
        GAS bf16* LAT = LAT_; GAS bf16* FQKV = FQKV_; GAS bf16* KPE = KPE_; GAS float* FLOG = FLOG_; GAS float* SSQ = SSQ_; const GAS float* COS = COS_; const GAS float* SIN = SIN_; const GAS float* RSX = RSX_;
        asm volatile("" : "+s"(LAT), "+s"(FQKV), "+s"(KPE), "+s"(FLOG), "+s"(SSQ), "+s"(COS), "+s"(SIN), "+s"(RSX));
        {
#pragma unroll
            for (int ai = 0; ai < 2; ++ai)
#pragma unroll
                for (int m = 0; m < 4; ++m) { const float rs_ = pre.v[ai * 4 + m];
#pragma unroll
                    for (int bj = 0; bj < 2; ++bj)
#pragma unroll
                        for (int n = 0; n < 2; ++n) acc[ai][bj][m][n] *= rs_; } }
        const int row0 = u.pm * 256 + wr * 64 + fr; const int pn = u.pn;
        const bool lo = fr < 8; const int roww = u.pm * 256 + wr * 64 + (fr & 7), colw = wc * 64 + (fr >> 3) * 32 + 8 * fq; const long dB = 8 * 512 + (lo ? 32 : -32);
        if (pn >= 2) {
            const int ti = pn >> 1; GAS bf16* dst = FQKV + (size_t)(ti - 1) * NTOK * 512 + (pn & 1) * 256 + colw; const float sc = (ti == 1) ? C2F : 1.f;
#pragma unroll
            for (int ai = 0; ai < 2; ++ai)
#pragma unroll
                for (int m = 0; m < 4; ++m) wide_store(dst + (size_t)(roww + ai * 128 + m * 16) * 512, dB, lo, pack8(acc[ai][0][m][0] * sc, acc[ai][0][m][1] * sc), pack8(acc[ai][1][m][0] * sc, acc[ai][1][m][1] * sc));
        } else {
#pragma unroll
            for (int ai = 0; ai < 2; ++ai)
#pragma unroll
                for (int m = 0; m < 4; ++m) { const int row = row0 + ai * 128 + m * 16;
                    if (pn == 0 || wc != 2) wide_store(LAT + (size_t)(roww + ai * 128 + m * 16) * 512 + pn * 256 + colw, dB, lo, pack8(acc[ai][0][m][0], acc[ai][0][m][1]), pack8(acc[ai][1][m][0], acc[ai][1][m][1]));
                    float s = 0.f;
                    if (pn == 0 || wc < 2) {
#pragma unroll
                        for (int bj = 0; bj < 2; ++bj)
#pragma unroll
                            for (int n = 0; n < 2; ++n) { const f32x4 x = acc[ai][bj][m][n]; s += (x[0] * x[0] + x[1] * x[1]) + (x[2] * x[2] + x[3] * x[3]); }
                    }
                    s += __shfl_xor(s, 16); s += __shfl_xor(s, 32);
                    if (fq == 0) SSQ[(size_t)row * 8 + pn * 4 + wc] = s;
                    }
            if (pn == 1 && wc == 2) {
#pragma unroll
                for (int ai = 0; ai < 2; ++ai)
#pragma unroll
                    for (int m = 0; m < 4; ++m) { const int row = row0 + ai * 128 + m * 16;
                        const f32x4 c = *(const GAS f32x4*)(COS + (size_t)row * 16 + 4 * fq), sn = *(const GAS f32x4*)(SIN + (size_t)row * 16 + 4 * fq);
                        const f32x4 x1 = acc[ai][0][m][0], x2 = acc[ai][0][m][1];
                        *(GAS u32x4*)(KPE + (size_t)row * 32 + 8 * fq) = pack8(x1 * c - x2 * sn, x1 * sn + x2 * c);
                        }
            }
            if (pn == 1 && wc == 2 && fq == 0) {
#pragma unroll
                for (int ai = 0; ai < 2; ++ai)
#pragma unroll
                    for (int m = 0; m < 4; ++m) { const int row = row0 + ai * 128 + m * 16; *(GAS f32x4*)(FLOG + (size_t)row * 8) = acc[ai][1][m][0]; *(GAS f32x4*)(FLOG + (size_t)row * 8 + 4) = acc[ai][1][m][1]; }
            }
        }
    }
};
struct EpiUp {
    static constexpr int NST = 16;
    static constexpr bool PERM = true, WIDE = true;
    GAS bf16* QM_; GAS bf16* KVM_; const GAS float* SSQ_; const GAS float* COS_; const GAS float* SIN_;
    struct Pre { f32x4 v[8]; };
    __device__ __forceinline__ Pre prefetch(const Unit& u, int wr, int fr) const { Pre p; const GAS float* SSQ = SSQ_; asm volatile("" : "+s"(SSQ)); const int off = u.e ? 4 : 0;
#pragma unroll
        for (int g = 0; g < 8; ++g) p.v[g] = *(const GAS f32x4*)(SSQ + (size_t)(u.pm * 256 + (g >> 2) * 128 + wr * 64 + (g & 3) * 16 + fr) * 8 + off); return p; }
    __device__ __forceinline__ void operator()(const f32x4 (&acc)[2][2][4][2], const Unit& u, int wr, int wc, int fr, int fq, const Pre& pre) const {
        GAS bf16* QM = QM_; GAS bf16* KVM = KVM_; const GAS float* SSQ = SSQ_; const GAS float* COS = COS_; const GAS float* SIN = SIN_;
        asm volatile("" : "+s"(QM), "+s"(KVM), "+s"(SSQ), "+s"(COS), "+s"(SIN));
        const int row0 = u.pm * 256 + wr * 64 + fr; const int pn = u.pn; const bool kv = u.e != 0;
        const bool lo = fr < 8; const int roww = u.pm * 256 + wr * 64 + (fr & 7), colw = pn * 256 + wc * 64 + (fr >> 3) * 32 + 8 * fq;
#pragma unroll
        for (int ai = 0; ai < 2; ++ai)
#pragma unroll
            for (int m = 0; m < 4; ++m) { const int row = row0 + ai * 128 + m * 16;
                const f32x4 sq = pre.v[ai * 4 + m];
                const float ss = (sq[0] + sq[1]) + (sq[2] + sq[3]);
                if (kv) {
                    const float rs = rsqrtf(ss * (1.f / 128.f) + EPS);
                    wide_store(KVM + (size_t)(roww + ai * 128 + m * 16) * 1024 + colw, 8 * 1024 + (lo ? 32 : -32), lo, pack8(acc[ai][0][m][0] * rs, acc[ai][0][m][1] * rs), pack8(acc[ai][1][m][0] * rs, acc[ai][1][m][1] * rs));
                } else {
                    const float rs = rsqrtf(ss * (1.f / 256.f) + EPS) * C2M;
                    const f32x4 c = *(const GAS f32x4*)(COS + (size_t)row * 16 + 4 * fq), sn = *(const GAS f32x4*)(SIN + (size_t)row * 16 + 4 * fq);
                    u32x4 XY[2];
#pragma unroll
                    for (int bj = 0; bj < 2; ++bj) { f32x4 v0 = acc[ai][bj][m][0] * rs, v1 = acc[ai][bj][m][1] * rs;
                        const int G = 8 * pn + 2 * wc + bj;
                        if (G % 3 == 2) { const f32x4 x1 = v0, x2 = v1; v0 = x1 * c - x2 * sn; v1 = x1 * sn + x2 * c; }
                        XY[bj] = pack8(v0, v1); }
                    wide_store(QM + (size_t)(roww + ai * 128 + m * 16) * 768 + colw, 8 * 768 + (lo ? 32 : -32), lo, XY[0], XY[1]);
                }

            }
    }
};
template <bool RES_F32> struct EpiOut {
    static constexpr int NST = 16;
    static constexpr bool PERM = true, WIDE = true;
    const GAS float* resf_; GAS bf16* xr_;
    struct Pre {}; __device__ __forceinline__ Pre prefetch(const Unit&, int, int) const { return Pre{}; }
    __device__ __forceinline__ void operator()(const f32x4 (&acc)[2][2][4][2], const Unit& u, int wr, int wc, int fr, int fq, const LAS f32x2* scl) const {
        const GAS float* resf = resf_; GAS bf16* xr = xr_; asm volatile("" : "+s"(resf), "+s"(xr));
        const int row0 = u.pm * 256 + wr * 64 + fr, col0 = u.pn * 256 + wc * 64 + 8 * fq;
        const bool lo = fr < 8; const int roww = u.pm * 256 + wr * 64 + (fr & 7), colw = u.pn * 256 + wc * 64 + (fr >> 3) * 32 + 8 * fq;
#pragma unroll
        for (int ai = 0; ai < 2; ++ai)
#pragma unroll
            for (int m = 0; m < 4; ++m) { const size_t off = (size_t)(row0 + ai * 128 + m * 16) * DM + col0; const float sh = scl[ai * 128 + wr * 64 + m * 16 + fr][1];
                u32x4 XY[2];
#pragma unroll
                for (int bj = 0; bj < 2; ++bj) { f32x4 r0, r1;
                    if constexpr (RES_F32) { r0 = *(const GAS f32x4*)(resf + off + bj * 32); r1 = *(const GAS f32x4*)(resf + off + bj * 32 + 4); }
                    else { const u32x4 w = *(const GAS u32x4*)(xr + off + bj * 32);
                        r0 = (f32x4){__uint_as_float(w.x << 16), __uint_as_float(w.x & 0xffff0000u), __uint_as_float(w.y << 16), __uint_as_float(w.y & 0xffff0000u)};
                        r1 = (f32x4){__uint_as_float(w.z << 16), __uint_as_float(w.z & 0xffff0000u), __uint_as_float(w.w << 16), __uint_as_float(w.w & 0xffff0000u)}; }
                    XY[bj] = pack8(r0 + acc[ai][bj][m][0] * sh, r1 + acc[ai][bj][m][1] * sh); }
                wide_store(xr + (size_t)(roww + ai * 128 + m * 16) * DM + colw, 8 * DM + (lo ? 32 : -32), lo, XY[0], XY[1]); }
    }
};
struct EpiGU {
    static constexpr int NST = 4;
    static constexpr bool PERM = true, WIDE = false;
    GAS unsigned char* HH_; const GAS float* RS_;
    struct Pre { float v[8]; };
    __device__ __forceinline__ Pre prefetch(const Unit& u, int wr, int fr) const { Pre p; const GAS float* RS = RS_; asm volatile("" : "+s"(RS));
#pragma unroll
        for (int g = 0; g < 8; ++g) p.v[g] = RS[u.pm * 256 + (g >> 2) * 128 + wr * 64 + (g & 3) * 16 + fr]; return p; }
    __device__ __forceinline__ void operator()(const f32x4 (&acc)[2][2][4][2], const Unit& u, int wr, int wc, int fr, int fq, const Pre& pre) const {
        GAS unsigned char* HH = HH_; const GAS float* RS = RS_; asm volatile("" : "+s"(HH), "+s"(RS));
        const int row0 = u.pm * 256 + wr * 64 + fr;
#pragma unroll
        for (int ai = 0; ai < 2; ++ai)
#pragma unroll
            for (int mp = 0; mp < 2; ++mp) {
                u32x2 w[2];
#pragma unroll
                for (int q = 0; q < 2; ++q) { const int m = 2 * mp + q; const float rs = pre.v[ai * 4 + m] * WSCALE_INV;
                    f32x4 h[2];
#pragma unroll
                    for (int n = 0; n < 2; ++n) { const f32x4 g = acc[ai][0][m][n] * rs, up = acc[ai][1][m][n] * rs;
#pragma unroll
                        for (int j = 0; j < 4; ++j) { const float sg = __builtin_amdgcn_rcpf(1.f + __builtin_amdgcn_exp2f(-g[j] * LOG2E)); h[n][j] = g[j] * sg * up[j]; } }
                    w[q].x = pk4_fp8(h[0][0], h[0][1], h[0][2], h[0][3]); w[q].y = pk4_fp8(h[1][0], h[1][1], h[1][2], h[1][3]); }
                const auto s0 = __builtin_amdgcn_permlane16_swap(w[0].x, w[1].x, false, false), s1 = __builtin_amdgcn_permlane16_swap(w[0].y, w[1].y, false, false);
                *(GAS u32x4*)(HH + (size_t)(row0 + ai * 128 + (2 * mp + (fq & 1)) * 16) * 512 + u.pn * 128 + wc * 32 + (fq >> 1) * 16) = (u32x4){s0[0], s1[0], s0[1], s1[1]}; }
    }
};
struct EpiDown {
    static constexpr int NST = 8;
    static constexpr bool PERM = true, WIDE = true;
    GAS unsigned char* Y_; const GAS float* GATEOF_;
    struct Pre { float v[8]; };
    __device__ __forceinline__ Pre prefetch(const Unit& u, int wr, int fr) const { Pre p; const GAS float* GT = GATEOF_; asm volatile("" : "+s"(GT));
#pragma unroll
        for (int g = 0; g < 8; ++g) p.v[g] = GT[u.pm * 256 + (g >> 2) * 128 + wr * 64 + (g & 3) * 16 + fr]; return p; }
    __device__ __forceinline__ void operator()(const f32x4 (&acc)[2][2][4][2], const Unit& u, int wr, int wc, int fr, int fq, const Pre& pre) const {
        GAS unsigned char* Y = Y_; const GAS float* GATEOF = GATEOF_; asm volatile("" : "+s"(Y), "+s"(GATEOF));
        const int row0 = u.pm * 256 + wr * 64 + fr;
#pragma unroll
        for (int ai = 0; ai < 2; ++ai)
#pragma unroll
            for (int m = 0; m < 4; ++m) { const int row = row0 + ai * 128 + m * 16; const float g = pre.v[ai * 4 + m];
                u32x2 w[2];
#pragma unroll
                for (int bj = 0; bj < 2; ++bj) { const f32x4 v0 = acc[ai][bj][m][0] * g, v1 = acc[ai][bj][m][1] * g; w[bj].x = pk4_fp8(v0[0], v0[1], v0[2], v0[3]); w[bj].y = pk4_fp8(v1[0], v1[1], v1[2], v1[3]); }
                const auto s0 = __builtin_amdgcn_permlane16_swap(w[0].x, w[1].x, false, false), s1 = __builtin_amdgcn_permlane16_swap(w[0].y, w[1].y, false, false);
                *(GAS u32x4*)(Y + (size_t)row * 1024 + u.pn * 256 + wc * 64 + (fq & 1) * 32 + (fq >> 1) * 16) = (u32x4){s0[0], s1[0], s0[1], s1[1]}; }
    }
};

namespace att {
constexpr int KSLOT = 12288, VSLOT = 8192;
constexpr int L_K = 0, L_V = 2 * KSLOT, L_BIAS = L_V + 2 * VSLOT, L_WS = L_BIAS + 8192, L_OST = L_WS + 8 * 64 * 4, L_END = L_OST + 8 * 4096;
__device__ __forceinline__ int crow(int r, int hi) { return (r & 3) + 8 * (r >> 2) + 4 * hi; }
typedef short v4i16_t __attribute__((ext_vector_type(4)));
__device__ __forceinline__ s16x4 vtr(const LAS char* p) { return __builtin_bit_cast(s16x4, __builtin_amdgcn_ds_read_tr16_b64_v4i16((LAS v4i16_t*)p)); }

constexpr int NSL = 5;
constexpr int R_K = 0, R_V = NSL * KSLOT, R_WS = R_V + NSL * VSLOT, R_OST = R_WS + 8 * 64 * 4, R_END = R_OST + 8 * 4096;
static_assert(R_END <= RING_BYTES, "attention LDS");
__device__ __forceinline__ void glds16(const GAS void* gsrc, unsigned lds_dst) { unsigned keep;
    asm volatile("s_mov_b32 %0, m0\n\ts_mov_b32 m0, %2\n\ts_nop 0\n\tglobal_load_lds_dwordx4 %1, off\n\ts_mov_b32 m0, %0" : "=&s"(keep) : "v"(gsrc), "s"(lds_dst) : "memory"); }
__device__ __forceinline__ void glds16s(const GAS void* sbase, unsigned voff, unsigned lds_dst) { unsigned keep;
    asm volatile("s_mov_b32 %0, m0\n\ts_mov_b32 m0, %3\n\ts_nop 0\n\tglobal_load_lds_dwordx4 %1, %2\n\ts_mov_b32 m0, %0" : "=&s"(keep) : "v"(voff), "s"((unsigned long long)sbase), "s"(lds_dst) : "memory"); }
struct Tens2 { const GAS bf16* Q; int qp; const GAS bf16* K; int kp; const GAS bf16* KX; const GAS bf16* V; int vp; GAS bf16* O; const GAS float* BIASF; const GAS float* NRM; GAS float* OSS; };
template <int MODE>
__device__ __forceinline__ int attn_unit2(const int wave_, int b, int h, int qb, const Tens2& T, LAS char* shm, const int slbase, const bool have_pro, const int qb_next, bf16x8 (&qr)[6], const int tstart) {
    constexpr int DKS = MODE ? 6 : 5, DKH = 3;
    constexpr float THR = 8.f;
    int wid = wave_; asm volatile("" : "+s"(wid));
    int lane = (int)__builtin_amdgcn_mbcnt_hi(~0u, __builtin_amdgcn_mbcnt_lo(~0u, 0u)); asm volatile("" : "+v"(lane)); const int r32 = lane & 31, hi = lane >> 5;
    const long rowbase = (long)b * SEQ; const int q0 = qb * 256, qw0 = q0 + wid * 32;
    const int NT = (q0 + 256) / 64, tlast = qw0 / 64;
    const int NTE = NT - tstart;
    const GAS bf16* Qw = T.Q + (rowbase + qw0) * T.qp + h * (MODE ? 96 : 64);
    const GAS bf16* Kh = T.K + rowbase * T.kp + h * (MODE ? 128 : 64);
    const GAS bf16* Vh = T.V + rowbase * T.vp + h * (MODE ? 128 : 64);
    LAS float* wsf = (LAS float*)(shm + R_WS) + wid * 64;
    const unsigned koff = (unsigned)(lane * T.kp + wid * 8) * 2u;
    const unsigned xoff = MODE ? (unsigned)(lane * 32 + (wid & 3) * 8) * 2u : (unsigned)(lane * 8) * 2u;
    const unsigned voff = (unsigned)((16 * (wid & 3) + (lane >> 2)) * T.vp + (wid >> 2) * 32 + (lane & 3) * 8) * 2u;
    const GAS bf16* xbase = MODE ? T.KX + rowbase * 32 : T.KX + ((long)b * 8 + h) * SEQ * 8;
    const int xstep = MODE ? 64 * 32 : 64 * 8;
    const unsigned kdst_a = (unsigned)(uintptr_t)(shm + R_K) + (unsigned)wid * 1024u, xdst_a = (unsigned)(uintptr_t)(shm + R_K) + (unsigned)(8 + (MODE ? (wid & 3) : 0)) * 1024u, vdst_a = (unsigned)(uintptr_t)(shm + R_V) + (unsigned)wid * 1024u;
#define A2_DMA(t, slot) do { \
        glds16s((const GAS void*)(Kh + (long)(t) * 64 * T.kp), koff, (unsigned)__builtin_amdgcn_readfirstlane((int)(kdst_a + (slot) * KSLOT))); \
        glds16s((const GAS void*)(xbase + (long)(t) * xstep), xoff, (unsigned)__builtin_amdgcn_readfirstlane((int)(xdst_a + (slot) * KSLOT))); \
        glds16s((const GAS void*)(Vh + (long)(t) * 64 * T.vp), voff, (unsigned)__builtin_amdgcn_readfirstlane((int)(vdst_a + (slot) * VSLOT))); } while (0)
    float mhat = 0.f, lrun = 0.f; f32x16 o[2]; o[0] = f32x16{}; o[1] = f32x16{}; f32x16 negm = f32x16{};
    const LAS char* vp0 = shm + R_V + ((lane >> 4) & 1) * 32 + (lane & 3) * 8 + (4 * hi + ((lane & 15) >> 2)) * 64;
#define A3_SLOT(k) ((slbase + (k)) % NSL)
    if (!have_pro) { A2_DMA(NT - 1, A3_SLOT(0)); A2_DMA(NT - 2, A3_SLOT(1)); A2_DMA(NT - 3, A3_SLOT(2)); }
    if (!have_pro) {
#pragma unroll
        for (int d0 = 0; d0 < (MODE ? 6 : 4); ++d0) qr[d0] = *(const GAS bf16x8*)(Qw + (long)r32 * T.qp + d0 * 16 + hi * 8); }
    if (MODE == 0) { const short one = hi ? (short)0 : (short)0x3F80; qr[DKS - 1] = (bf16x8){one, one, one, 0, 0, 0, 0, 0}; }
#pragma unroll
    for (int d0 = 0; d0 < DKS; ++d0) asm volatile("" : "+v"(qr[d0]));
#define A3_KLOADH(slot, H) do { const LAS char* kb_ = shm + R_K + (slot) * KSLOT + r32 * 16; _Pragma("unroll") for (int d0 = (H) * DKH; d0 < ((H) ? DKS : DKH); ++d0) { const int off = (MODE == 0 && d0 == 4) ? 8 * 1024 : d0 * 2048 + hi * 1024; \
        kf[2 * (d0 - (H) * DKH)] = *(const LAS bf16x8*)(kb_ + off); kf[2 * (d0 - (H) * DKH) + 1] = *(const LAS bf16x8*)(kb_ + off + 512); } } while (0)
#define A3_VLOAD(slot) do { const LAS char* vp_ = vp0 + (slot) * VSLOT; _Pragma("unroll") for (int q = 0; q < 8; ++q) { vlo[q] = vtr(vp_ + (q >> 2) * 4096 + (q & 3) * 1024); vhh[q] = vtr(vp_ + (q >> 2) * 4096 + (q & 3) * 1024 + 512); } } while (0)
#define A3_QKH(H) do { if ((H) == 0) { c0 = negm; c1 = negm; } _Pragma("unroll") for (int d0 = (H) * DKH; d0 < ((H) ? DKS : DKH); ++d0) { c0 = __builtin_amdgcn_mfma_f32_32x32x16_bf16(kf[2 * (d0 - (H) * DKH)], qr[d0], c0, 0, 0, 0); c1 = __builtin_amdgcn_mfma_f32_32x32x16_bf16(kf[2 * (d0 - (H) * DKH) + 1], qr[d0], c1, 0, 0, 0); } } while (0)
#define A3_EXP() do { float ls_ = 0.f; _Pragma("unroll") for (int r = 0; r < 16; ++r) { pp0[r] = __builtin_amdgcn_exp2f(pp0[r]); pp1[r] = __builtin_amdgcn_exp2f(pp1[r]); ls_ += pp0[r] + pp1[r]; } lrun += ls_; u32x4 w_; \
        w_.x = cvt_pk_bf16(pp0[0], pp0[1]); w_.y = cvt_pk_bf16(pp0[2], pp0[3]); w_.z = cvt_pk_bf16(pp0[4], pp0[5]); w_.w = cvt_pk_bf16(pp0[6], pp0[7]); pa[0] = __builtin_bit_cast(bf16x8, w_); \
        w_.x = cvt_pk_bf16(pp0[8], pp0[9]); w_.y = cvt_pk_bf16(pp0[10], pp0[11]); w_.z = cvt_pk_bf16(pp0[12], pp0[13]); w_.w = cvt_pk_bf16(pp0[14], pp0[15]); pa[1] = __builtin_bit_cast(bf16x8, w_); \
        w_.x = cvt_pk_bf16(pp1[0], pp1[1]); w_.y = cvt_pk_bf16(pp1[2], pp1[3]); w_.z = cvt_pk_bf16(pp1[4], pp1[5]); w_.w = cvt_pk_bf16(pp1[6], pp1[7]); pa[2] = __builtin_bit_cast(bf16x8, w_); \
        w_.x = cvt_pk_bf16(pp1[8], pp1[9]); w_.y = cvt_pk_bf16(pp1[10], pp1[11]); w_.z = cvt_pk_bf16(pp1[12], pp1[13]); w_.w = cvt_pk_bf16(pp1[14], pp1[15]); pa[3] = __builtin_bit_cast(bf16x8, w_); } while (0)
#define A3_PV() do { _Pragma("unroll") for (int d0 = 0; d0 < 2; ++d0) _Pragma("unroll") for (int k = 0; k < 4; ++k) { const s16x4 lo_ = vlo[4 * d0 + k], hh_ = vhh[4 * d0 + k]; \
        const bf16x8 vf_ = (bf16x8){lo_[0], lo_[1], lo_[2], lo_[3], hh_[0], hh_[1], hh_[2], hh_[3]}; o[d0] = __builtin_amdgcn_mfma_f32_32x32x16_bf16(pa[k], vf_, o[d0], 0, 0, 0); } } while (0)
#define A3_ROWMAX(rm) do { float a_ = fmaxf(fmaxf(c0[0], c0[1]), c1[0]), b_ = fmaxf(fmaxf(c0[2], c0[3]), c1[1]); a_ = fmaxf(fmaxf(a_, c1[2]), c1[3]); \
        _Pragma("unroll") for (int r = 4; r < 16; r += 4) { a_ = fmaxf(fmaxf(a_, c0[r]), c0[r + 1]); b_ = fmaxf(fmaxf(b_, c0[r + 2]), c0[r + 3]); a_ = fmaxf(fmaxf(a_, c1[r]), c1[r + 1]); b_ = fmaxf(fmaxf(b_, c1[r + 2]), c1[r + 3]); } \
        rm = fmaxf(a_, b_); const auto rr_ = __builtin_amdgcn_permlane32_swap(__float_as_uint(rm), __float_as_uint(rm), false, false); rm = fmaxf(__uint_as_float(rr_[0]), __uint_as_float(rr_[1])); } while (0)
    int sl = A3_SLOT(0), sl3 = A3_SLOT(3);
    f32x16 pp0 = f32x16{}, pp1 = f32x16{}; bool pend = false; int pslot = 0;
    for (int i = 0; i < NTE; ++i) {
        const int t = NT - 1 - i;
        { const int ahead = NTE - 1 - i;
          if (ahead >= 2) asm volatile("s_waitcnt vmcnt(6)" ::: "memory"); else if (ahead == 1) asm volatile("s_waitcnt vmcnt(3)" ::: "memory"); else asm volatile("s_waitcnt vmcnt(0)" ::: "memory"); }
        __builtin_amdgcn_s_barrier(); asm volatile("" ::: "memory");
        if (i + 3 < NTE) A2_DMA(t - 3, sl3);
        if (i == NTE - 1 && qb_next >= 0) { const int NTn = 4 * qb_next + 4; A2_DMA(NTn - 1, A3_SLOT(NTE)); A2_DMA(NTn - 2, A3_SLOT(NTE + 1)); A2_DMA(NTn - 3, A3_SLOT(NTE + 2)); }
        if (t <= tlast) {
            bf16x8 kf[2 * DKH]; f32x16 c0, c1; float rm;
            A3_KLOADH(sl, 0);
            if (!pend) {
                A3_QKH(0); A3_KLOADH(sl, 1); A3_QKH(1);
                if (MODE == 0) { const int qrel = qw0 + r32 - 64 * t;
#pragma unroll
                    for (int r = 0; r < 16; ++r) { const int kv = crow(r, hi); if (kv > qrel) c0[r] = -INFINITY; if (kv + 32 > qrel) c1[r] = -INFINITY; } }
                A3_ROWMAX(rm);
                mhat = rm;
#pragma unroll
                for (int r = 0; r < 16; ++r) { c0[r] -= rm; c1[r] -= rm; negm[r] = -mhat; }
                pend = true;
            } else {
                s16x4 vlo[8], vhh[8]; bf16x8 pa[4];
                A3_QKH(0); A3_KLOADH(sl, 1);
                A3_VLOAD(pslot);
                A3_QKH(1);
                A3_EXP();
#pragma unroll
                for (int g_ = 0; g_ < 2 * DKS; ++g_) { __builtin_amdgcn_sched_group_barrier(0x008, 1, 0); __builtin_amdgcn_sched_group_barrier(0x002, 7, 0); }
                A3_PV();
                A3_ROWMAX(rm);
#pragma unroll
                for (int g_ = 0; g_ < 8; ++g_) { __builtin_amdgcn_sched_group_barrier(0x008, 1, 0); __builtin_amdgcn_sched_group_barrier(0x002, 3, 0); }
                if (__any(rm > THR)) {
                    const float dl = fmaxf(rm, 0.f); mhat += dl;
#pragma unroll
                    for (int r = 0; r < 16; ++r) { c0[r] -= dl; c1[r] -= dl; negm[r] = -mhat; }
                    const float f = __builtin_amdgcn_exp2f(-dl); lrun *= f;
                    if (hi == 0) wsf[r32] = f;
                    LDS_WAIT();
#pragma unroll
                    for (int g = 0; g < 4; ++g) { const f32x4 ff = *(const LAS f32x4*)(wsf + 8 * g + 4 * hi);
#pragma unroll
                        for (int j = 0; j < 4; ++j) { o[0][4 * g + j] *= ff[j]; o[1][4 * g + j] *= ff[j]; } }
                }
            }
            pp0 = c0; pp1 = c1; pslot = sl;
        }
        sl = (sl == NSL - 1) ? 0 : sl + 1; sl3 = (sl3 == NSL - 1) ? 0 : sl3 + 1;
    }
    if (qb_next >= 0) { const GAS bf16* Qn = T.Q + (rowbase + qb_next * 256 + wid * 32) * T.qp + h * (MODE ? 96 : 64);
#pragma unroll
        for (int d0 = 0; d0 < (MODE ? 6 : 4); ++d0) qr[d0] = *(const GAS bf16x8*)(Qn + (long)r32 * T.qp + d0 * 16 + hi * 8); }
    if (pend) { s16x4 vlo[8], vhh[8]; bf16x8 pa[4]; A3_VLOAD(pslot); A3_EXP(); A3_PV(); }
#undef A3_KLOADH
#undef A3_VLOAD
#undef A3_QKH
#undef A3_EXP
#undef A3_PV
#undef A3_ROWMAX
#undef A2_DMA
    lrun += __shfl_xor(lrun, 32);
    LDS_WAIT();
    if (hi == 0) wsf[32 + r32] = lrun;
    LDS_WAIT();
    float rli[16];
#pragma unroll
    for (int g = 0; g < 4; ++g) { const f32x4 ll = *(const LAS f32x4*)(wsf + 32 + 8 * g + 4 * hi);
#pragma unroll
        for (int j = 0; j < 4; ++j) rli[4 * g + j] = __builtin_amdgcn_rcpf(ll[j]); }
    GAS bf16* Ow = T.O + (rowbase + qw0) * 1024 + (MODE ? 0 : 512) + h * 64;
    { LAS bf16* stg = (LAS bf16*)(shm + R_OST) + wid * 2048;
#pragma unroll
      for (int r = 0; r < 16; ++r) { const int orow = crow(r, hi);
#pragma unroll
          for (int d0 = 0; d0 < 2; ++d0) stg[orow * 64 + d0 * 32 + r32] = (bf16)(cvt_pk_bf16(o[d0][r] * rli[r], 0.f) & 0xffffu); }
      LDS_WAIT();
#pragma unroll
      for (int i = 0; i < 4; ++i) { const int row = i * 8 + (lane >> 3), ch = lane & 7; const u32x4 v = *(const LAS u32x4*)(stg + row * 64 + ch * 8); *(GAS u32x4*)(Ow + (long)row * 1024 + ch * 8) = v;
          float sq = 0.f;
#pragma unroll
          for (int j = 0; j < 4; ++j) { const float a0 = __uint_as_float(v[j] << 16), a1 = __uint_as_float(v[j] & 0xffff0000u); sq += a0 * a0 + a1 * a1; }
          sq += __shfl_xor(sq, 1); sq += __shfl_xor(sq, 2); sq += __shfl_xor(sq, 4);
          if (ch == 0) T.OSS[(rowbase + qw0 + row) * 16 + (MODE ? 0 : 8) + h] = sq; } }
    if (qb_next < 0) { LDS_WAIT(); __builtin_amdgcn_s_barrier(); asm volatile("" ::: "memory"); }
    return A3_SLOT(NTE);
#undef A3_SLOT
}
}

struct Args { const void* in[21]; float* out; unsigned char* ws; int ph_lo, ph_hi; };

__device__ __forceinline__ void tr_item(const GAS float* __restrict__ W, int ldw, int Ksrc, const GAS float* __restrict__ gain, GAS bf16* __restrict__ WT, int ldk, int k0, int n0, int srccol, LAS float* scr, int lane) {
#pragma unroll 8
    for (int i = 0; i < 32; ++i) { const int kk = 2 * i + (lane >> 5); const int k = k0 + kk;
        float v = 0.f; if (srccol >= 0 && k < Ksrc) { v = __builtin_nontemporal_load(W + (size_t)k * ldw + srccol); if (gain) v *= gain[k]; }
        scr[kk * 33 + (lane & 31)] = v; }
    LDS_WAIT(); asm volatile("" ::: "memory");
    const int c = lane & 7;
#pragma unroll
    for (int j = 0; j < 4; ++j) { const int n = (lane >> 3) + 8 * j; const LAS float* s = scr + (8 * c) * 33 + n;
        u32x4 o; o.x = cvt_pk_bf16(s[0 * 33], s[1 * 33]); o.y = cvt_pk_bf16(s[2 * 33], s[3 * 33]); o.z = cvt_pk_bf16(s[4 * 33], s[5 * 33]); o.w = cvt_pk_bf16(s[6 * 33], s[7 * 33]);
        *(GAS u32x4*)(WT + (size_t)(n0 + n) * ldk + k0 + 8 * c) = o; }
    LDS_WAIT(); asm volatile("" ::: "memory");
}
__device__ __forceinline__ void tr_item64(const GAS float* __restrict__ W, int ldw, const GAS float* __restrict__ gain, GAS bf16* __restrict__ WT, int ldk, int k0, int n0src, int n0dst, LAS float* scr, int lane) {
    const int rr = lane >> 4, c4 = (lane & 15) * 4;
    f32x4 v[16];
#pragma unroll
    for (int i = 0; i < 16; ++i) v[i] = __builtin_nontemporal_load((const GAS f32x4*)(W + (size_t)(k0 + 4 * i + rr) * ldw + n0src + c4));
#pragma unroll
    for (int i = 0; i < 16; ++i) { const int k = 4 * i + rr; const float g = gain ? gain[k0 + k] : 1.f; LAS float* d = scr + k * 65 + c4;
        d[0] = v[i][0] * g; d[1] = v[i][1] * g; d[2] = v[i][2] * g; d[3] = v[i][3] * g; }
    LDS_WAIT(); asm volatile("" ::: "memory");
    const int kc = lane & 7;
#pragma unroll
    for (int j = 0; j < 8; ++j) { const int n = (lane >> 3) + 8 * j; const LAS float* sp = scr + (8 * kc) * 65 + n;
        u32x4 o; o.x = cvt_pk_bf16(sp[0 * 65], sp[1 * 65]); o.y = cvt_pk_bf16(sp[2 * 65], sp[3 * 65]); o.z = cvt_pk_bf16(sp[4 * 65], sp[5 * 65]); o.w = cvt_pk_bf16(sp[6 * 65], sp[7 * 65]);
        *(GAS u32x4*)(WT + (size_t)(n0dst + n) * ldk + k0 + 8 * kc) = o; }
    LDS_WAIT(); asm volatile("" ::: "memory");
}
__device__ __forceinline__ void tr_item64_f8(const GAS float* __restrict__ W, int ldw, const GAS float* __restrict__ gain, float scale, GAS unsigned char* __restrict__ WT8, int ldkB, int k0, int n0src, int n0dst, LAS float* scr, int lane) {
    const int rr = lane >> 4, c4 = (lane & 15) * 4;
    f32x4 v[16];
#pragma unroll
    for (int i = 0; i < 16; ++i) v[i] = __builtin_nontemporal_load((const GAS f32x4*)(W + (size_t)(k0 + 4 * i + rr) * ldw + n0src + c4));
#pragma unroll
    for (int i = 0; i < 16; ++i) { const int k = 4 * i + rr; const float g = (gain ? gain[k0 + k] : 1.f) * scale; LAS float* d = scr + k * 65 + c4;
        d[0] = v[i][0] * g; d[1] = v[i][1] * g; d[2] = v[i][2] * g; d[3] = v[i][3] * g; }
    LDS_WAIT(); asm volatile("" ::: "memory");
    const int kc = lane & 3;
#pragma unroll
    for (int j = 0; j < 4; ++j) { const int n = (lane >> 2) + 16 * j; const LAS float* sp = scr + (16 * kc) * 65 + n;
        u32x4 o; o.x = pk4_fp8(sp[0 * 65], sp[1 * 65], sp[2 * 65], sp[3 * 65]); o.y = pk4_fp8(sp[4 * 65], sp[5 * 65], sp[6 * 65], sp[7 * 65]); o.z = pk4_fp8(sp[8 * 65], sp[9 * 65], sp[10 * 65], sp[11 * 65]); o.w = pk4_fp8(sp[12 * 65], sp[13 * 65], sp[14 * 65], sp[15 * 65]);
        *(GAS u32x4*)(WT8 + (size_t)(n0dst + n) * ldkB + k0 + 16 * kc) = o; }
    LDS_WAIT(); asm volatile("" ::: "memory");
}
struct F8Item { const GAS float* W; int ldw; const GAS float* gain; GAS unsigned char* WT8; int ldkB, k0, n0src, n0dst; };
__device__ __forceinline__ void tr_load64(f32x4 (&v)[16], float (&gn)[16], const F8Item& I, int lane) {
    const int rr = lane >> 4, c4 = (lane & 15) * 4;
#pragma unroll
    for (int i = 0; i < 16; ++i) gn[i] = I.gain ? I.gain[I.k0 + 4 * i + rr] : 1.f;
#pragma unroll
    for (int i = 0; i < 16; ++i) v[i] = __builtin_nontemporal_load((const GAS f32x4*)(I.W + (size_t)(I.k0 + 4 * i + rr) * I.ldw + I.n0src + c4));
}
__device__ __forceinline__ void tr_finish64_f8(const f32x4 (&v)[16], const float (&gn)[16], const F8Item& I, float scale, LAS float* scr, int lane) {
    const int rr = lane >> 4, c4 = (lane & 15) * 4;
#pragma unroll
    for (int i = 0; i < 16; ++i) { const int k = 4 * i + rr; const float g = gn[i] * scale; LAS float* d = scr + k * 65 + c4;
        d[0] = v[i][0] * g; d[1] = v[i][1] * g; d[2] = v[i][2] * g; d[3] = v[i][3] * g; }
    LDS_WAIT(); asm volatile("" ::: "memory");
    const int kc = lane & 3;
#pragma unroll
    for (int j = 0; j < 4; ++j) { const int n = (lane >> 2) + 16 * j; const LAS float* sp = scr + (16 * kc) * 65 + n;
        u32x4 o; o.x = pk4_fp8(sp[0 * 65], sp[1 * 65], sp[2 * 65], sp[3 * 65]); o.y = pk4_fp8(sp[4 * 65], sp[5 * 65], sp[6 * 65], sp[7 * 65]); o.z = pk4_fp8(sp[8 * 65], sp[9 * 65], sp[10 * 65], sp[11 * 65]); o.w = pk4_fp8(sp[12 * 65], sp[13 * 65], sp[14 * 65], sp[15 * 65]);
        *(GAS u32x4*)(I.WT8 + (size_t)(I.n0dst + n) * I.ldkB + I.k0 + 16 * kc) = o; }
    LDS_WAIT(); asm volatile("" ::: "memory");
}
__device__ __forceinline__ int rope_dim(int p) { const int a = p >> 3, j = p & 7; return j < 4 ? 4 * a + j : 16 + 4 * a + (j - 4); }

#define LDP(i) ((void*)((((unsigned long long)(unsigned)__builtin_amdgcn_readfirstlane((int)(ARGP[i] >> 32))) << 32) | (unsigned long long)(unsigned)__builtin_amdgcn_readfirstlane((int)(unsigned)ARGP[i])))
#define ARGIN(i) ((const void*)LDP(i))
#define P_COS ((GAS float*)(ws + WS_COS))
#define P_SIN ((GAS float*)(ws + WS_SIN))
#define P_SSQ ((GAS float*)(ws + WS_SSQ))
#define P_FLOG ((GAS float*)(ws + WS_FLOG))
#define P_E01 ((GAS int*)(ws + WS_E01))
#define P_G01 ((GAS float*)(ws + WS_G01))
#define P_SLOT ((GAS int*)(ws + WS_SLOT))
#define P_TOKOF ((GAS int*)(ws + WS_TOKOF))
#define P_GATEOF ((GAS float*)(ws + WS_GATEOF))
#define P_CNT ((GAS int*)(ws + WS_CNT))
#define P_TSTART ((GAS int*)(ws + WS_TSTART))
#define P_RSTD ((GAS float*)(ws + WS_RSTD))
#define P_RSTDOF ((GAS float*)(ws + WS_RSTDOF))
#define P_KPE ((GAS bf16*)(ws + WS_KPE))
#define P_KAUG ((GAS bf16*)(ws + WS_KAUG))
#define P_BIASF ((GAS float*)(ws + WS_BIASF))
#define P_NRM ((GAS float*)(ws + WS_NRM))
#define P_WR_L(l) ((GAS bf16*)(ws + ((l) ? WS_W1 + 7 * MiB : WS_WR)))
#define P_XR ((GAS bf16*)(ws + WS_XR))
#define P_OSS ((GAS float*)(ws + WS_OSS))
#define P_RSTDX ((GAS float*)(ws + WS_RSTDX))
#define P_WIN_L(l) ((GAS bf16*)(ws + ((l) ? WS_W1 : WS_WIN)))
#define P_WUQ_L(l) ((GAS bf16*)(ws + ((l) ? WS_W1 + 4 * MiB : WS_WUQ)))
#define P_WUKV_L(l) ((GAS bf16*)(ws + ((l) ? WS_W1 + 4 * MiB + 512 * KiB : WS_WUKV)))
#define P_WOUT_L(l) ((GAS bf16*)(ws + ((l) ? WS_W1 + 5 * MiB : WS_WOUT)))
#define P_WGU_L(ll) ((GAS unsigned char*)(ws + WS_WGU + (size_t)((ll) & 1) * 32 * MiB))
#define P_WD_L(ll) ((GAS unsigned char*)(ws + WS_WD + (size_t)((ll) & 1) * 16 * MiB))
#define P_XN ((GAS bf16*)(ws + WS_XN))
#define P_FQKV ((GAS bf16*)(ws + WS_FQKV))
#define P_HH ((GAS bf16*)(ws + WS_FQKV))
#define P_LAT ((GAS bf16*)(ws + WS_LAT))
#define P_QM ((GAS bf16*)(ws + WS_QM))
#define P_KVM ((GAS bf16*)(ws + WS_KVM))
#define P_Y ((GAS bf16*)(ws + WS_Y))
#define IN(k) (lo <= (k) && (k) < hi_)
#if MK_ONE_LAUNCH
#define GRID_BAR() xcd_barrier(bar)
#else
#define GRID_BAR() do {} while (0)
#endif
#define SEAM(k) do { if (IN(k) && IN((k) + 1)) GRID_BAR(); } while (0)
#if MK_ONE_LAUNCH
#define GROUP_BAR() xcd_barrier(gbar)
#else
#define GROUP_BAR() do {} while (0)
#endif
#define SEAMG(k) do { if (IN(k) && IN((k) + 1)) GROUP_BAR(); } while (0)
__device__ __forceinline__ void conv_gu_item(int r, const GAS float* w_gate, const GAS float* w_up, const GAS float* ffn_norm, GAS unsigned char* WGU, LAS float* scr64, int lane) {
    const int e = r / 256, q = r % 256, kb = q / 16, nb = q % 16; const int n0 = nb * 64; const int ct = n0 >> 8, which = (n0 >> 7) & 1, jj = n0 & 127;
    const GAS float* src = (which ? w_up : w_gate) + (size_t)e * DM * DEXP;
    tr_item64_f8(src, DEXP, ffn_norm, WSCALE, WGU + (size_t)e * 1024 * 1024, DM, kb * 64, ct * 128 + jj, n0, scr64, lane);
}
__device__ __forceinline__ F8Item gu_item(int r, const GAS float* w_gate, const GAS float* w_up, const GAS float* ffn_norm, GAS unsigned char* WGU) {
    const int e = r / 256, q = r % 256, kb = q / 16, nb = q % 16; const int n0 = nb * 64; const int ct = n0 >> 8, which = (n0 >> 7) & 1, jj = n0 & 127;
    return F8Item{(which ? w_up : w_gate) + (size_t)e * DM * DEXP, DEXP, ffn_norm, WGU + (size_t)e * 1024 * 1024, DM, kb * 64, ct * 128 + jj, n0};
}
__device__ __forceinline__ F8Item d_item(int r, const GAS float* w_down, GAS unsigned char* WD) {
    const int e = r / 128, q = r % 128, kb = q / 16, nb = q % 16;
    return F8Item{w_down + (size_t)e * DEXP * DM, DM, nullptr, WD + (size_t)e * 1024 * 512, DEXP, kb * 64, nb * 64, nb * 64};
}
__device__ __forceinline__ void conv_d_item(int r, const GAS float* w_down, GAS unsigned char* WD, LAS float* scr64, int lane) {
    const int e = r / 128, q = r % 128, kb = q / 16, nb = q % 16;
    tr_item64_f8(w_down + (size_t)e * DEXP * DM, DM, nullptr, WSCALE, WD + (size_t)e * 1024 * 512, DEXP, kb * 64, nb * 64, nb * 64, scr64, lane);
}
__device__ __forceinline__ void conv_experts_l0(LAS unsigned char* lds0, const int wave0, const int G0, const int bx0) {
    unsigned ldsb_ = (unsigned)(uintptr_t)lds0; asm volatile("" : "+s"(ldsb_)); LAS unsigned char* lds = (LAS unsigned char*)(uintptr_t)ldsb_; volatile LAS unsigned long long* ARGP = (volatile LAS unsigned long long*)(lds + MISC_OFF + 768);
    int wave = wave0, G = G0, bx = bx0; asm volatile("" : "+s"(G), "+s"(bx), "+s"(wave)); const int lane = (int)__builtin_amdgcn_mbcnt_hi(~0u, __builtin_amdgcn_mbcnt_lo(~0u, 0u)); const int vcu = (bx % 8) * (G / 8) + bx / 8;
    GAS unsigned char* ws = (GAS unsigned char*)LDP(22);
    LAS float* scr64 = (LAS float*)(lds + wave * 16640);
    const GAS float* ffn_norm = (const GAS float*)ARGIN(12);
    const GAS float* w_gate = (const GAS float*)ARGIN(17); const GAS float* w_up = (const GAS float*)ARGIN(18); const GAS float* w_down = (const GAS float*)ARGIN(19);
    constexpr int J_GU = 16 * 16 * NEXP, J_D = 8 * 16 * NEXP;
    asm volatile("s_waitcnt vmcnt(0)" ::: "memory"); __syncthreads();
    static_assert(J_GU == 256 * 8 * 4 && J_D == 256 * 8 * 2, "six items per wave");
    const int it0 = vcu + G * wave;
    f32x4 va[16], vb[16]; float ga[16], gb[16];
    const F8Item I0 = gu_item(it0, w_gate, w_up, ffn_norm, P_WGU_L(0)); tr_load64(va, ga, I0, lane);
    const F8Item I1 = gu_item(it0 + G * 8, w_gate, w_up, ffn_norm, P_WGU_L(0)); tr_load64(vb, gb, I1, lane); tr_finish64_f8(va, ga, I0, WSCALE, scr64, lane);
    const F8Item I2 = gu_item(it0 + G * 16, w_gate, w_up, ffn_norm, P_WGU_L(0)); tr_load64(va, ga, I2, lane); tr_finish64_f8(vb, gb, I1, WSCALE, scr64, lane);
    const F8Item I3 = gu_item(it0 + G * 24, w_gate, w_up, ffn_norm, P_WGU_L(0)); tr_load64(vb, gb, I3, lane); tr_finish64_f8(va, ga, I2, WSCALE, scr64, lane);
    const F8Item I4 = d_item(it0 + G * 32 - J_GU, w_down, P_WD_L(0)); tr_load64(va, ga, I4, lane); tr_finish64_f8(vb, gb, I3, WSCALE, scr64, lane);
    const F8Item I5 = d_item(it0 + G * 40 - J_GU, w_down, P_WD_L(0)); tr_load64(vb, gb, I5, lane); tr_finish64_f8(va, ga, I4, WSCALE, scr64, lane);
    tr_finish64_f8(vb, gb, I5, WSCALE, scr64, lane);
    __syncthreads();
}
#define CONV_SLOT(k, sl) do { if constexpr (l == 0) { if (IN(P + (k)) && ((((bx0 % 8) * (G0 / 8) + bx0 / 8) >> 4) & 1) == (sl)) conv_experts_l0(lds0, wave0, G0, bx0); } } while (0)
template <int l>
__device__ __forceinline__ void layer_body(const int lo, const int hi_, LAS unsigned char* lds0, const int wave0, const int G0, const int bx0, const XcdBarrier& bar, const XcdBarrier& gbar) {
        const int P = 10 * l;
        if (IN(P)) for (int rep_ = 0; rep_ < (l == 0 ? NREP(0) : 1); ++rep_) {
            unsigned ldsb_ = (unsigned)(uintptr_t)lds0; asm volatile("" : "+s"(ldsb_)); LAS unsigned char* lds = (LAS unsigned char*)(uintptr_t)ldsb_; volatile LAS unsigned* MISC = (volatile LAS unsigned*)(lds + MISC_OFF); volatile LAS unsigned long long* ARGP = (volatile LAS unsigned long long*)(lds + MISC_OFF + 768); (void)MISC; int wave = wave0, G = G0, bx = bx0; asm volatile("" : "+s"(G), "+s"(bx), "+s"(wave)); const int lane = (int)__builtin_amdgcn_mbcnt_hi(~0u, __builtin_amdgcn_mbcnt_lo(~0u, 0u)); const int tid = wave * 64 + lane; const int vcu = (bx % 8) * (G / 8) + bx / 8; const int gw = vcu * 8 + wave, NGW = G * 8; (void)lane; (void)gw; (void)NGW; (void)vcu;
            GAS unsigned char* ws = (GAS unsigned char*)LDP(22); GAS float* out = (GAS float*)LDP(21); const GAS float* x_in = (const GAS float*)ARGIN(0); const GAS int* positions = (const GAS int*)ARGIN(1);
            if constexpr (l == 0) {
                LAS float* scr = (LAS float*)(lds + wave * 16640);
                constexpr int I_IN64 = 16 * 30, I_INS = 16 * 4, I_UQ = 4 * 24, I_UKV = 2 * 16, J_OUT = 16 * 16;
                constexpr int NITEMS = I_IN64 + I_INS + I_UQ + I_UKV + J_OUT;
                for (int it = vcu + G * wave; it < NLAYER * NITEMS; it += NGW) {
                    const int lw = it / NITEMS; int r = it % NITEMS; const int j = lane & 31;
                    if (r < I_IN64 + I_INS) { const GAS float* attn_norm = (const GAS float*)ARGIN(2) + (size_t)lw * DM; const GAS float* w_in = (const GAS float*)ARGIN(3) + (size_t)lw * DM * INW;
                        if (r < I_IN64) { const int kb = r / 30, q = r % 30, t = q < 6 ? q : q + 2; tr_item64(w_in, INW, attn_norm, P_WIN_L(lw), DM, kb * 64, t < 6 ? 64 * t : 416 + 64 * (t - 8), 64 * t, scr, lane); continue; }
                        r -= I_IN64; const int kb = r / 4, nb = 12 + r % 4; const int n = nb * 32 + j; int sc;
                        if (n < 416) sc = 384 + rope_dim(n - 384); else if (n < 424) sc = 1952 + (n - 416); else sc = -1;
                        tr_item(w_in, INW, DM, attn_norm, P_WIN_L(lw), DM, kb * 64, nb * 32, sc, scr, lane); continue; } r -= I_IN64 + I_INS;
                    if (r < I_UQ) { const GAS float* q_norm = (const GAS float*)ARGIN(5) + (size_t)lw * 256; const GAS float* w_uq = (const GAS float*)ARGIN(6) + (size_t)lw * 256 * 768;
                        const int kb = r / 24, nb = r % 24; const int n = nb * 32 + j; const int hh = n / 96, d = n % 96; const int sc = d < 64 ? n : hh * 96 + 64 + rope_dim(d - 64);
                        tr_item(w_uq, 768, 256, q_norm, P_WUQ_L(lw), 256, kb * 64, nb * 32, sc, scr, lane); continue; } r -= I_UQ;
                    if (r < I_UKV) { const GAS float* kv_norm = (const GAS float*)ARGIN(7) + (size_t)lw * 128; const GAS float* w_ukv = (const GAS float*)ARGIN(8) + (size_t)lw * 128 * 1024;
                        const int kb = r / 16, nb = r % 16; tr_item64(w_ukv, 1024, kv_norm, P_WUKV_L(lw), 256, kb * 64, nb * 64, nb * 64, scr, lane); continue; } r -= I_UKV;
                    { const GAS float* mla_on = (const GAS float*)ARGIN(9) + (size_t)lw * 512; const GAS float* fox_on = (const GAS float*)ARGIN(10) + (size_t)lw * 512; const GAS float* w_out = (const GAS float*)ARGIN(11) + (size_t)lw * DM * DM;
                        const int kb = r / 16, nb = r % 16; const GAS float* gn = kb < 8 ? mla_on : fox_on - 512; tr_item64(w_out, DM, gn, P_WOUT_L(lw), DM, kb * 64, nb * 64, nb * 64, scr, lane); }
                }
                for (int lw = 0; lw < NLAYER; ++lw) { const GAS float* ffn_norm = (const GAS float*)ARGIN(12) + (size_t)lw * DM; const GAS float* w_rg = (const GAS float*)ARGIN(13) + (size_t)lw * DM * 4; const GAS float* w_re = (const GAS float*)ARGIN(15) + (size_t)lw * DM * 32;
                  for (int idx = bx * 512 + tid; idx < 2 * 48 * 520; idx += G * 512) { const int half = idx / (48 * 520), r = idx % (48 * 520), c = r / 520, kk = r % 520; const int k = half * 512 + kk;
                      float w = 0.f; if (c < 36 && kk < 512) w = ffn_norm[k] * (c < 4 ? w_rg[k * 4 + c] : w_re[k * 32 + (c - 4)]);
                      const unsigned h16 = cvt_pk_bf16(w, 0.f) & 0xffffu; const unsigned l16 = cvt_pk_bf16(w - __uint_as_float(h16 << 16), 0.f) & 0xffffu;
                      P_WR_L(lw)[(size_t)(half * 2 + 0) * 48 * 520 + r] = (bf16)h16; P_WR_L(lw)[(size_t)(half * 2 + 1) * 48 * 520 + r] = (bf16)l16; } }
            }
            const GAS float* fin = (const GAS float*)ARGIN(20);
            for (int mb = vcu * 128 + wave * 16; mb < vcu * 128 + wave * 16 + 16; mb += 4) {
                f32x4 v[4][4]; int s0[4], s1[4];
                if (l > 0) {
#pragma unroll
                    for (int r = 0; r < 4; ++r) { s0[r] = P_SLOT[2 * (mb + r)]; s1[r] = P_SLOT[2 * (mb + r) + 1]; }
                }
#pragma unroll
                for (int r = 0; r < 4; ++r) {
                    if (l == 0) { const GAS float* xr = x_in + (size_t)(mb + r) * DM;
#pragma unroll
                        for (int j = 0; j < 4; ++j) v[r][j] = __builtin_nontemporal_load((const GAS f32x4*)(xr + 4 * lane + 256 * j)); }
                    else { const GAS bf16* xr = P_XR + (size_t)(mb + r) * DM;
#pragma unroll
                        for (int j = 0; j < 4; ++j) { const u32x2 w = __builtin_nontemporal_load((const GAS u32x2*)(xr + 4 * lane + 256 * j)); v[r][j] = (f32x4){__uint_as_float(w.x << 16), __uint_as_float(w.x & 0xffff0000u), __uint_as_float(w.y << 16), __uint_as_float(w.y & 0xffff0000u)}; } } }
                if (l > 0) {
#pragma unroll
                    for (int r = 0; r < 4; ++r)
#pragma unroll
                        for (int j = 0; j < 4; ++j) { const int a = __builtin_nontemporal_load((const GAS int*)((const GAS unsigned char*)P_Y + (size_t)s0[r] * 1024 + 4 * lane + 256 * j)), c = __builtin_nontemporal_load((const GAS int*)((const GAS unsigned char*)P_Y + (size_t)s1[r] * 1024 + 4 * lane + 256 * j));
                            const f32x2 a0 = __builtin_amdgcn_cvt_pk_f32_fp8(a, false), a1 = __builtin_amdgcn_cvt_pk_f32_fp8(a, true), c0 = __builtin_amdgcn_cvt_pk_f32_fp8(c, false), c1 = __builtin_amdgcn_cvt_pk_f32_fp8(c, true);
                            v[r][j][0] += (a0[0] + c0[0]) * WSCALE_INV; v[r][j][1] += (a0[1] + c0[1]) * WSCALE_INV; v[r][j][2] += (a1[0] + c1[0]) * WSCALE_INV; v[r][j][3] += (a1[1] + c1[1]) * WSCALE_INV; }
                }
                float ss[4];
#pragma unroll
                for (int r = 0; r < 4; ++r) { float s = 0.f;
#pragma unroll
                    for (int j = 0; j < 4; ++j) s += (v[r][j][0] * v[r][j][0] + v[r][j][1] * v[r][j][1]) + (v[r][j][2] * v[r][j][2] + v[r][j][3] * v[r][j][3]);
                    ss[r] = s; }
#pragma unroll
                for (int o = 1; o < 64; o <<= 1) {
#pragma unroll
                    for (int r = 0; r < 4; ++r) ss[r] += __shfl_xor(ss[r], o); }
#pragma unroll
                for (int r = 0; r < 4; ++r) { const int m = mb + r; const float rstd = rsqrtf(ss[r] * (1.f / DM) + EPS);
                    if (l < NLAYER) {
#pragma unroll
                        for (int jp = 0; jp < 2; ++jp) {
                            u32x2 w0, w1; w0.x = cvt_pk_bf16(v[r][2 * jp][0], v[r][2 * jp][1]); w0.y = cvt_pk_bf16(v[r][2 * jp][2], v[r][2 * jp][3]); w1.x = cvt_pk_bf16(v[r][2 * jp + 1][0], v[r][2 * jp + 1][1]); w1.y = cvt_pk_bf16(v[r][2 * jp + 1][2], v[r][2 * jp + 1][3]);
                            const bool od = lane & 1; const u32x2 give = od ? w0 : w1;
                            u32x2 got; got.x = (unsigned)__builtin_amdgcn_update_dpp(0, (int)give.x, 0xB1, 0xf, 0xf, false); got.y = (unsigned)__builtin_amdgcn_update_dpp(0, (int)give.y, 0xB1, 0xf, 0xf, false);
                            const u32x4 o = od ? (u32x4){got.x, got.y, w1.x, w1.y} : (u32x4){w0.x, w0.y, got.x, got.y};
                            *(GAS u32x4*)(P_XR + (size_t)m * DM + 8 * (lane >> 1) + 256 * (2 * jp + (lane & 1))) = o; }
                        if (lane == 0) P_RSTDX[m] = rstd;
                    } else {
#pragma unroll
                        for (int j = 0; j < 4; ++j) { const f32x4 g = *(const GAS f32x4*)(fin + 4 * lane + 256 * j); __builtin_nontemporal_store(v[r][j] * rstd * g, (GAS f32x4*)(out + (size_t)m * DM + 4 * lane + 256 * j)); }
                    }
                }
            }
        }
        if constexpr (l == NLAYER) return;
        SEAM(P);
        if (IN(P + 1)) for (int rep_ = 0; rep_ < ((l == 0 || 1 != 5) ? NREP(1) : 1); ++rep_) {
            unsigned ldsb_ = (unsigned)(uintptr_t)lds0; asm volatile("" : "+s"(ldsb_)); LAS unsigned char* lds = (LAS unsigned char*)(uintptr_t)ldsb_; volatile LAS unsigned* MISC = (volatile LAS unsigned*)(lds + MISC_OFF); volatile LAS unsigned long long* ARGP = (volatile LAS unsigned long long*)(lds + MISC_OFF + 768); (void)MISC; int wave = wave0, G = G0, bx = bx0; asm volatile("" : "+s"(G), "+s"(bx), "+s"(wave)); const int lane = (int)__builtin_amdgcn_mbcnt_hi(~0u, __builtin_amdgcn_mbcnt_lo(~0u, 0u)); const int tid = wave * 64 + lane; const int vcu = (bx % 8) * (G / 8) + bx / 8; const int gw = vcu * 8 + wave, NGW = G * 8; (void)lane; (void)gw; (void)NGW; (void)vcu;
            GAS unsigned char* ws = (GAS unsigned char*)LDP(22); GAS float* out = (GAS float*)LDP(21); const GAS float* x_in = (const GAS float*)ARGIN(0); (void)out; (void)x_in; (void)ws;
            BatchOrder S{INP / 256, vcu, (const GAS char*)P_XR, (const GAS char*)P_WIN_L(l), (size_t)256 * DM * 2, (size_t)256 * DM * 2};
            EpiWin E{P_LAT, P_FQKV, P_KPE, P_FLOG, P_SSQ, P_COS, P_SIN, P_RSTDX};
            pg8::gemm_phase<EpiWin, BatchOrder, true, false>(tid, lds, DM * 2, DM * 2, DM * 2, S, E, nullptr);
        }
        SEAMG(P + 1);
        if (IN(P + 2)) for (int rep_ = 0; rep_ < ((l == 0 || 2 != 5) ? NREP(2) : 1); ++rep_) {
            unsigned ldsb_ = (unsigned)(uintptr_t)lds0; asm volatile("" : "+s"(ldsb_)); LAS unsigned char* lds = (LAS unsigned char*)(uintptr_t)ldsb_; volatile LAS unsigned* MISC = (volatile LAS unsigned*)(lds + MISC_OFF); volatile LAS unsigned long long* ARGP = (volatile LAS unsigned long long*)(lds + MISC_OFF + 768); (void)MISC; int wave = wave0, G = G0, bx = bx0; asm volatile("" : "+s"(G), "+s"(bx), "+s"(wave)); const int lane = (int)__builtin_amdgcn_mbcnt_hi(~0u, __builtin_amdgcn_mbcnt_lo(~0u, 0u)); const int tid = wave * 64 + lane; const int vcu = (bx % 8) * (G / 8) + bx / 8; const int gw = vcu * 8 + wave, NGW = G * 8; (void)lane; (void)gw; (void)NGW; (void)vcu;
            GAS unsigned char* ws = (GAS unsigned char*)LDP(22); GAS float* out = (GAS float*)LDP(21); const GAS float* x_in = (const GAS float*)ARGIN(0); (void)out; (void)x_in; (void)ws;
            {
                const int sq = vcu >> 1, hf = vcu & 1; const int b = sq >> 3, h = sq & 7; const float bf = ((const GAS float*)ARGIN(4))[l * 8 + h];
                const GAS float* fl = P_FLOG + ((size_t)b * SEQ + hf * 1024 + 2 * tid) * 8 + h;
                float lf[2], lg[2] = {0.f, 0.f};
#pragma unroll
                for (int e = 0; e < 2; ++e) { const float f = fl[e * 8] + bf; lf[e] = fminf(f, 0.f) - log1pf(expf(-fabsf(f))); }
                if (hf) {
#pragma unroll
                    for (int e = 0; e < 2; ++e) { const float f = fl[e * 8 - 1024 * 8] + bf; lg[e] = fminf(f, 0.f) - log1pf(expf(-fabsf(f))); } }
                const double s2 = (double)lf[0] + (double)lf[1];
                double incl = s2, first = (double)lg[0] + (double)lg[1];
#pragma unroll
                for (int o = 1; o < 64; o <<= 1) { const double t = __shfl_up(incl, o); if (lane >= o) incl += t; first += __shfl_xor(first, o); }
                LAS double* wtot = (LAS double*)lds;
                if (lane == 63) wtot[wave] = incl;
                if (lane == 0) wtot[8 + wave] = first;
                __syncthreads();
                double c = incl - s2;
                for (int w = 0; w < wave; ++w) c += wtot[w];
                if (hf) { for (int w = 0; w < 8; ++w) c += wtot[8 + w]; }
                const size_t t0 = ((size_t)b * 8 + h) * SEQ + hf * 1024 + 2 * tid;
                GAS u32x4* ka = (GAS u32x4*)(P_KAUG + t0 * 8);
                float xs[2];
#pragma unroll
                for (int e = 0; e < 2; ++e) { c += (double)lf[e]; const float x = (float)(-c * 1.4426950408889634); xs[e] = x;
                    const unsigned h16 = cvt_pk_bf16(x, 0.f) & 0xffffu; const float r1 = x - __uint_as_float(h16 << 16); const unsigned m16 = cvt_pk_bf16(r1, 0.f) & 0xffffu; const float r2 = r1 - __uint_as_float(m16 << 16); const unsigned l16 = cvt_pk_bf16(r2, 0.f) & 0xffffu;
                    ka[e] = (u32x4){h16 | (m16 << 16), l16, 0u, 0u}; P_BIASF[t0 + e] = x; }
                float qn = 0.f, kn = 0.f, xdm = INFINITY;
                { const GAS bf16* fqp = P_FQKV + ((size_t)b * SEQ + hf * 1024 + 2 * tid) * 512 + h * 64; const GAS bf16* fkp = fqp + (size_t)NTOK * 512;
#pragma unroll
                  for (int e = 0; e < 2; ++e) { float sq_ = 0.f, sk = 0.f, dd = 0.f;
#pragma unroll
                      for (int c8 = 0; c8 < 8; ++c8) { const u32x4 a = *(const GAS u32x4*)(fqp + e * 512 + c8 * 8), k4 = *(const GAS u32x4*)(fkp + e * 512 + c8 * 8);
#pragma unroll
                          for (int j = 0; j < 4; ++j) { const float a0 = __uint_as_float(a[j] << 16), a1 = __uint_as_float(a[j] & 0xffff0000u), k0 = __uint_as_float(k4[j] << 16), k1 = __uint_as_float(k4[j] & 0xffff0000u);
                              sq_ += a0 * a0 + a1 * a1; sk += k0 * k0 + k1 * k1; dd += a0 * k0 + a1 * k1; } }
                      qn = fmaxf(qn, sq_); kn = fmaxf(kn, sk); xdm = fminf(xdm, xs[e] + dd); } }
#pragma unroll
                for (int o = 1; o < 64; o <<= 1) { qn = fmaxf(qn, __shfl_xor(qn, o)); kn = fmaxf(kn, __shfl_xor(kn, o)); xdm = fminf(xdm, __shfl_xor(xdm, o)); }
                LAS float* knw = (LAS float*)(lds + 256);
                if (lane == 0) { knw[wave] = kn; knw[8 + wave] = qn; knw[16 + wave] = xdm; }
                __syncthreads();
                if (tid < 4) { P_NRM[sq * 32 + hf * 4 + tid] = sqrtf(fmaxf(knw[8 + 2 * tid], knw[8 + 2 * tid + 1])); P_NRM[sq * 32 + 16 + hf * 4 + tid] = fminf(knw[16 + 2 * tid], knw[16 + 2 * tid + 1]); }
                if (tid == 4) { float m = knw[0]; for (int w = 1; w < 8; ++w) m = fmaxf(m, knw[w]); P_NRM[sq * 32 + 8 + hf] = sqrtf(m); }
                __syncthreads();
            }
            UpOrder S{vcu, (const GAS char*)P_LAT, (const GAS char*)P_WUQ_L(l), (const GAS char*)P_WUKV_L(l)};
            EpiUp E{P_QM, P_KVM, P_SSQ, P_COS, P_SIN};
            pg8::gemm_phase<EpiUp, UpOrder, true, false, false, false, true>(tid, lds, 256 * 2, 512 * 2, 256 * 2, S, E, nullptr);
        }
        SEAMG(P + 2);
        CONV_SLOT(3, 0);
        if (IN(P + 3)) for (int rep_ = 0; rep_ < ((l == 0 || 3 != 5) ? NREP(3) : 1); ++rep_) {
            unsigned ldsb_ = (unsigned)(uintptr_t)lds0; asm volatile("" : "+s"(ldsb_)); LAS unsigned char* lds = (LAS unsigned char*)(uintptr_t)ldsb_; volatile LAS unsigned* MISC = (volatile LAS unsigned*)(lds + MISC_OFF); volatile LAS unsigned long long* ARGP = (volatile LAS unsigned long long*)(lds + MISC_OFF + 768); (void)MISC; int wave = wave0, G = G0, bx = bx0; asm volatile("" : "+s"(G), "+s"(bx), "+s"(wave)); const int lane = (int)__builtin_amdgcn_mbcnt_hi(~0u, __builtin_amdgcn_mbcnt_lo(~0u, 0u)); const int tid = wave * 64 + lane; const int vcu = (bx % 8) * (G / 8) + bx / 8; const int gw = vcu * 8 + wave, NGW = G * 8; (void)lane; (void)gw; (void)NGW; (void)vcu;
            GAS unsigned char* ws = (GAS unsigned char*)LDP(22); GAS float* out = (GAS float*)LDP(21); const GAS float* x_in = (const GAS float*)ARGIN(0); (void)out; (void)x_in; (void)ws;
            GAS bf16* O = P_XN;
            const int b = vcu >> 4, hh = (vcu & 15) >> 1, sub = vcu & 1;
            const att::Tens2 TM{P_QM, 768, P_KVM, 1024, P_KPE, P_KVM + 64, 1024, O, nullptr, nullptr, P_OSS};
            const att::Tens2 TF{P_FQKV, 512, P_FQKV + (size_t)NTOK * 512, 512, P_KAUG, P_FQKV + (size_t)2 * NTOK * 512, 512, O, P_BIASF, P_NRM, P_OSS};
#define QB_OF(i) ((((i) & 1) ? 7 - (2 * sub + ((i) >> 1)) : (2 * sub + ((i) >> 1))))
            int ts0, ts1, ts2, ts3;
            { const GAS float* bs = P_BIASF + ((long)b * 8 + hh) * SEQ; const GAS float* nr = P_NRM + (b * 8 + hh) * 32; const float kmx = fmaxf(nr[8], nr[9]);
#define FOX_TS(i, dst) do { const int qb_ = QB_OF(i), NT_ = 4 * qb_ + 4; const float Z_ = nr[qb_] * kmx * 1.001f + 0.01f; const float bend_ = bs[(lane < NT_ ? lane : NT_ - 1) * 64 + 63]; \
                  const bool skip_ = (lane < NT_ - 4) && (Z_ + bend_ - nr[16 + qb_] < -32.f); dst = __builtin_popcountll(__ballot(skip_)); } while (0)
              FOX_TS(0, ts0); FOX_TS(1, ts1); FOX_TS(2, ts2); FOX_TS(3, ts3);
#undef FOX_TS
            }
            if (wave >= 4) __builtin_amdgcn_s_setprio(1);
            bf16x8 qreg[6];
            { int sb = 0; for (int i = 0; i < 4; ++i) sb = att::attn_unit2<1>(wave, b, hh, QB_OF(i), TM, (LAS char*)lds, sb, i > 0, i < 3 ? QB_OF(i + 1) : -1, qreg, 0); }
            if constexpr (l == 0) { if ((b & 1) == 1) { __builtin_amdgcn_s_setprio(0); conv_experts_l0(lds0, wave0, G0, bx0); if (wave >= 4) __builtin_amdgcn_s_setprio(1); } }
            { int sb = 0; for (int i = 0; i < 4; ++i) { const int ts = i == 0 ? ts0 : i == 1 ? ts1 : i == 2 ? ts2 : ts3; sb = att::attn_unit2<0>(wave, b, hh, QB_OF(i), TF, (LAS char*)lds, sb, i > 0, i < 3 ? QB_OF(i + 1) : -1, qreg, ts); } }
#undef QB_OF
            __builtin_amdgcn_s_setprio(0);
        }
        SEAMG(P + 3);
        if (IN(P + 5)) for (int rep_ = 0; rep_ < ((l == 0 || 5 != 5) ? NREP(5) : 1); ++rep_) {
            unsigned ldsb_ = (unsigned)(uintptr_t)lds0; asm volatile("" : "+s"(ldsb_)); LAS unsigned char* lds = (LAS unsigned char*)(uintptr_t)ldsb_; volatile LAS unsigned* MISC = (volatile LAS unsigned*)(lds + MISC_OFF); volatile LAS unsigned long long* ARGP = (volatile LAS unsigned long long*)(lds + MISC_OFF + 768); (void)MISC; int wave = wave0, G = G0, bx = bx0; asm volatile("" : "+s"(G), "+s"(bx), "+s"(wave)); const int lane = (int)__builtin_amdgcn_mbcnt_hi(~0u, __builtin_amdgcn_mbcnt_lo(~0u, 0u)); const int tid = wave * 64 + lane; const int vcu = (bx % 8) * (G / 8) + bx / 8; const int gw = vcu * 8 + wave, NGW = G * 8; (void)lane; (void)gw; (void)NGW; (void)vcu;
            GAS unsigned char* ws = (GAS unsigned char*)LDP(22); GAS float* out = (GAS float*)LDP(21); const GAS float* x_in = (const GAS float*)ARGIN(0); (void)out; (void)x_in; (void)ws;
            BatchOrder S{DM / 256, vcu, (const GAS char*)P_XN, (const GAS char*)P_WOUT_L(l), (size_t)256 * DM * 2, (size_t)256 * DM * 2};
            EpiOut<false> E{x_in, P_XR};
            LAS f32x2* scl = (LAS f32x2*)(lds + pg8::STAGE_BYTES);
            { Unit u_; if (S.next(tid >> 8, u_)) { const GAS float* op = P_OSS + ((size_t)u_.pm * 256 + (tid & 255)) * 16;
                  const f32x4 a0 = *(const GAS f32x4*)op, a1 = *(const GAS f32x4*)(op + 4), c0 = *(const GAS f32x4*)(op + 8), c1 = *(const GAS f32x4*)(op + 12);
                  const float sm = ((a0[0] + a0[1]) + (a0[2] + a0[3])) + ((a1[0] + a1[1]) + (a1[2] + a1[3])), sf = ((c0[0] + c0[1]) + (c0[2] + c0[3])) + ((c1[0] + c1[1]) + (c1[2] + c1[3]));
                  const float rm_ = rsqrtf(sm * (1.f / 512.f) + EPS), rf_ = rsqrtf(sf * (1.f / 512.f) + EPS);
                  scl[tid] = (f32x2){rm_ / rf_, rf_}; } }
            __syncthreads();
            pg8::gemm_phase<EpiOut<false>, BatchOrder, true, false, false, true>(tid, lds, DM * 2, DM * 2, DM * 2, S, E, nullptr, scl);
        }
        SEAMG(P + 5);
        if (IN(P + 6)) for (int rep_ = 0; rep_ < ((l == 0 || 6 != 5) ? NREP(6) : 1); ++rep_) {
            unsigned ldsb_ = (unsigned)(uintptr_t)lds0; asm volatile("" : "+s"(ldsb_)); LAS unsigned char* lds = (LAS unsigned char*)(uintptr_t)ldsb_; volatile LAS unsigned* MISC = (volatile LAS unsigned*)(lds + MISC_OFF); volatile LAS unsigned long long* ARGP = (volatile LAS unsigned long long*)(lds + MISC_OFF + 768); (void)MISC; int wave = wave0, G = G0, bx = bx0; asm volatile("" : "+s"(G), "+s"(bx), "+s"(wave)); const int lane = (int)__builtin_amdgcn_mbcnt_hi(~0u, __builtin_amdgcn_mbcnt_lo(~0u, 0u)); const int tid = wave * 64 + lane; const int vcu = (bx % 8) * (G / 8) + bx / 8; const int gw = vcu * 8 + wave, NGW = G * 8; (void)lane; (void)gw; (void)NGW; (void)vcu;
            GAS unsigned char* ws = (GAS unsigned char*)LDP(22); GAS float* out = (GAS float*)LDP(21); const GAS float* x_in = (const GAS float*)ARGIN(0); (void)out; (void)x_in; (void)ws;
            GAS bf16* H2 = P_XN;
            LAS bf16* WT = (LAS bf16*)lds;
            LAS float* LG = (LAS float*)(lds + 99840) + wave * 576;
            const GAS float* b_rg = (const GAS float*)ARGIN(14) + l * 4; const GAS float* b_re = (const GAS float*)ARGIN(16) + l * 32;
            if (tid < 32) MISC[64 + tid] = 0u;
            const int r16 = lane & 15, g4 = lane >> 4;
            const int m0 = vcu * 128 + wave * 16;
            const GAS bf16* xrow = P_XR + (size_t)(m0 + r16) * DM + 8 * g4;
            f32x4 acc3[3]; acc3[0] = (f32x4){0.f, 0.f, 0.f, 0.f}; acc3[1] = acc3[0]; acc3[2] = acc3[0];
            float ssq = 0.f;
            for (int half = 0; half < 2; ++half) {
                __syncthreads();
                for (int idx = tid; idx < 2 * 48 * 520 / 8; idx += 512) *(LAS u32x4*)(WT + 8 * idx) = *(const GAS u32x4*)(P_WR_L(l) + (size_t)half * 2 * 48 * 520 + 8 * idx);
                __syncthreads();
                for (int s8 = 0; s8 < 16; s8 += 8) {
                    bf16x8 xv[8];
#pragma unroll
                    for (int u = 0; u < 8; ++u) xv[u] = *(const GAS bf16x8*)(xrow + half * 512 + 32 * (s8 + u));
                    u32x2 hwp = {0u, 0u};
#pragma unroll
                    for (int u = 0; u < 8; ++u) {
                        const u32x4 xw = __builtin_bit_cast(u32x4, xv[u]); float xf[8];
#pragma unroll
                        for (int j = 0; j < 4; ++j) { xf[2 * j] = __uint_as_float(xw[j] << 16); xf[2 * j + 1] = __uint_as_float(xw[j] & 0xffff0000u); }
                        u32x2 hw; hw.x = pk4_fp8(xf[0], xf[1], xf[2], xf[3]); hw.y = pk4_fp8(xf[4], xf[5], xf[6], xf[7]);
                        if (u & 1) {
                            const auto s0 = __builtin_amdgcn_permlane16_swap(hwp.x, hw.x, false, false), s1 = __builtin_amdgcn_permlane16_swap(hwp.y, hw.y, false, false);
                            *(GAS u32x4*)((GAS unsigned char*)H2 + (size_t)(m0 + r16) * DM + half * 512 + 32 * (s8 + u - 1 + (g4 & 1)) + 16 * (g4 >> 1)) = (u32x4){s0[0], s1[0], s0[1], s1[1]};
                        } else hwp = hw;
#pragma unroll
                        for (int j = 0; j < 8; ++j) ssq += xf[j] * xf[j];
                        const LAS bf16* wk = WT + r16 * 520 + 32 * (s8 + u) + 8 * g4;
#pragma unroll
                        for (int ct = 0; ct < 3; ++ct) { const bf16x8 bh = *(const LAS bf16x8*)(wk + ct * 16 * 520), bl = *(const LAS bf16x8*)(wk + (48 + ct * 16) * 520);
                            acc3[ct] = __builtin_amdgcn_mfma_f32_16x16x32_bf16(xv[u], bh, acc3[ct], 0, 0, 0); acc3[ct] = __builtin_amdgcn_mfma_f32_16x16x32_bf16(xv[u], bl, acc3[ct], 0, 0, 0); }
                    }
                }
            }
            ssq += __shfl_xor(ssq, 16); ssq += __shfl_xor(ssq, 32);
            const float rstd = rsqrtf(ssq * (1.f / DM) + EPS);
#pragma unroll
            for (int ct = 0; ct < 3; ++ct) { const int c = 16 * ct + r16; if (c < 36) {
#pragma unroll
                for (int rg = 0; rg < 4; ++rg) LG[(4 * g4 + rg) * 36 + c] = acc3[ct][rg]; } }
            LDS_WAIT();
            if (lane < 16) {
                const int m = m0 + lane; const LAS float* lg = LG + lane * 36;
                float gl[4];
#pragma unroll
                for (int g = 0; g < 4; ++g) gl[g] = lg[g] * rstd + b_rg[g];
                int gi = 0; float gm = gl[0];
#pragma unroll
                for (int g = 1; g < 4; ++g) if (gl[g] > gm) { gm = gl[g]; gi = g; }
                float gs = 0.f;
#pragma unroll
                for (int g = 0; g < 4; ++g) gs += __expf(gl[g] - gm);
                const float gval = 1.f / gs;
                float el[8];
#pragma unroll
                for (int j = 0; j < 8; ++j) el[j] = lg[4 + 8 * gi + j] * rstd + b_re[8 * gi + j];
                int i0 = 0; float mx0 = el[0];
#pragma unroll
                for (int j = 1; j < 8; ++j) if (el[j] > mx0) { mx0 = el[j]; i0 = j; }
                int i1 = -1; float mx1 = -INFINITY;
#pragma unroll
                for (int j = 0; j < 8; ++j) if (j != i0 && el[j] > mx1) { mx1 = el[j]; i1 = j; }
                const float e1 = __expf(mx1 - mx0); const float g0 = gval / (1.f + e1), g1 = gval * e1 / (1.f + e1);
                const int ea = gi * 8 + i0, eb = gi * 8 + i1; P_E01[2 * m] = ea; P_E01[2 * m + 1] = eb; P_G01[2 * m] = g0; P_G01[2 * m + 1] = g1; P_RSTD[m] = rstd;
                __hip_atomic_fetch_add((LAS unsigned*)(lds + MISC_OFF) + 64 + ea, 1u, __ATOMIC_RELAXED, __HIP_MEMORY_SCOPE_WORKGROUP); __hip_atomic_fetch_add((LAS unsigned*)(lds + MISC_OFF) + 64 + eb, 1u, __ATOMIC_RELAXED, __HIP_MEMORY_SCOPE_WORKGROUP);
            }
            __syncthreads();
            if (tid < 32) P_CNT[vcu * 32 + tid] = (int)MISC[64 + tid];
        }
        SEAM(P + 6);
        if (IN(P + 7)) for (int rep_ = 0; rep_ < ((l == 0 || 7 != 5) ? NREP(7) : 1); ++rep_) {
            unsigned ldsb_ = (unsigned)(uintptr_t)lds0; asm volatile("" : "+s"(ldsb_)); LAS unsigned char* lds = (LAS unsigned char*)(uintptr_t)ldsb_; volatile LAS unsigned* MISC = (volatile LAS unsigned*)(lds + MISC_OFF); volatile LAS unsigned long long* ARGP = (volatile LAS unsigned long long*)(lds + MISC_OFF + 768); (void)MISC; int wave = wave0, G = G0, bx = bx0; asm volatile("" : "+s"(G), "+s"(bx), "+s"(wave)); const int lane = (int)__builtin_amdgcn_mbcnt_hi(~0u, __builtin_amdgcn_mbcnt_lo(~0u, 0u)); const int tid = wave * 64 + lane; const int vcu = (bx % 8) * (G / 8) + bx / 8; const int gw = vcu * 8 + wave, NGW = G * 8; (void)lane; (void)gw; (void)NGW; (void)vcu;
            GAS unsigned char* ws = (GAS unsigned char*)LDP(22); GAS float* out = (GAS float*)LDP(21); const GAS float* x_in = (const GAS float*)ARGIN(0); (void)out; (void)x_in; (void)ws;
            LAS int* cnt_all = (LAS int*)lds;
            LAS int* pre_e = (LAS int*)(lds + 32768);
            LAS int* tot_e = pre_e + 32;
            LAS int* pst = pre_e + 64;
            LAS int* eL = pre_e + 128;
            for (int i = tid; i < 256 * 32; i += 512) cnt_all[i] = P_CNT[i];
            if (tid < 256) eL[tid] = P_E01[vcu * 256 + tid];
            __syncthreads();
            { LAS int* part = pre_e + 512;
              const int e = tid & 31, p = tid >> 5; int pre = 0, tot = 0;
#pragma unroll
              for (int j = 0; j < 16; ++j) { const int w = p * 16 + j; const int c = cnt_all[w * 32 + e]; pre += (w < vcu) ? c : 0; tot += c; }
              part[(p * 2) * 32 + e] = pre; part[(p * 2 + 1) * 32 + e] = tot; }
            __syncthreads();
            if (tid < 32) { LAS int* part = pre_e + 512; int pre = 0, tot = 0;
#pragma unroll
                for (int p = 0; p < 16; ++p) { pre += part[(p * 2) * 32 + tid]; tot += part[(p * 2 + 1) * 32 + tid]; } pre_e[tid] = pre; tot_e[tid] = tot; }
            __syncthreads();
            if (tid == 0) { int acc = 0; for (int e = 0; e < 32; ++e) { pst[e] = acc; acc += (tot_e[e] + 255) / 256 * 256; } pst[32] = acc; }
            __syncthreads();
            if (vcu == 0 && tid <= 32) P_TSTART[tid] = pst[tid] / 256;
            { LAS int* hist = pre_e + 2048;
              if (tid < 128) hist[tid] = 0;
              __syncthreads();
              int e = 0, rin = 0;
              if (tid < 256) { e = eL[tid]; unsigned long long mym = 0ull;
                  for (int x = 0; x < 32; ++x) { const unsigned long long bm = __ballot(e == x); if (e == x) mym = bm; }
                  rin = __builtin_popcountll(mym & ((1ull << lane) - 1ull));
                  if (rin == 0) hist[wave * 32 + e] = __builtin_popcountll(mym); }
              __syncthreads();
              if (tid < 256) { int r = rin; for (int w = 0; w < wave; ++w) r += hist[w * 32 + e];
                  const int slot = pst[e] + pre_e[e] + r; const int tok = vcu * 128 + (tid >> 1);
                  P_SLOT[vcu * 256 + tid] = slot; P_TOKOF[slot] = tok; P_GATEOF[slot] = P_G01[vcu * 256 + tid]; P_RSTDOF[slot] = P_RSTD[tok]; } }
            if (vcu < 32) { const int e = vcu; for (int s = pst[e] + tot_e[e] + tid; s < pst[e + 1]; s += 512) { P_TOKOF[s] = 0; P_GATEOF[s] = 0.f; P_RSTDOF[s] = 0.f; } }
            __syncthreads();
        }
        SEAM(P + 7);
        if (IN(P + 8)) for (int rep_ = 0; rep_ < ((l == 0 || 8 != 5) ? NREP(8) : 1); ++rep_) {
            unsigned ldsb_ = (unsigned)(uintptr_t)lds0; asm volatile("" : "+s"(ldsb_)); LAS unsigned char* lds = (LAS unsigned char*)(uintptr_t)ldsb_; volatile LAS unsigned* MISC = (volatile LAS unsigned*)(lds + MISC_OFF); volatile LAS unsigned long long* ARGP = (volatile LAS unsigned long long*)(lds + MISC_OFF + 768); (void)MISC; int wave = wave0, G = G0, bx = bx0; asm volatile("" : "+s"(G), "+s"(bx), "+s"(wave)); const int lane = (int)__builtin_amdgcn_mbcnt_hi(~0u, __builtin_amdgcn_mbcnt_lo(~0u, 0u)); const int tid = wave * 64 + lane; const int vcu = (bx % 8) * (G / 8) + bx / 8; const int gw = vcu * 8 + wave, NGW = G * 8; (void)lane; (void)gw; (void)NGW; (void)vcu;
            GAS unsigned char* ws = (GAS unsigned char*)LDP(22); GAS float* out = (GAS float*)LDP(21); const GAS float* x_in = (const GAS float*)ARGIN(0); (void)out; (void)x_in; (void)ws;
            volatile LAS int* TS = (volatile LAS int*)(MISC + 128);
            if (tid <= 32) TS[tid] = P_TSTART[tid];
            __syncthreads();
            MoeOrder S{G, vcu, TS, (const GAS char*)P_XN, (const GAS char*)P_WGU_L(l), 0, (size_t)1024 * 1024, (size_t)256 * 1024};
            EpiGU E{(GAS unsigned char*)P_HH, P_RSTDOF};
            pg8::gemm_phase<EpiGU, MoeOrder, true, true, true>(tid, lds, DM, DM, DM, S, E, P_TOKOF);
            if constexpr (l + 1 < NLAYER) {
                const int U = (int)TS[32] * 4, rem = U & 255; const int nidle = rem ? 256 - rem : 256, rk = rem ? vcu - rem : vcu;
                if (rk >= 0) { LAS float* scr64 = (LAS float*)(lds + wave * 16640);
                    const GAS float* w_gate = (const GAS float*)ARGIN(17) + (size_t)(l + 1) * NEXP * DM * DEXP; const GAS float* w_up = (const GAS float*)ARGIN(18) + (size_t)(l + 1) * NEXP * DM * DEXP; const GAS float* ffn1 = (const GAS float*)ARGIN(12) + (size_t)(l + 1) * DM;
                    for (int it = rk * 8 + wave; it < 16 * 16 * NEXP; it += nidle * 8) conv_gu_item(it, w_gate, w_up, ffn1, P_WGU_L(l + 1), scr64, lane); }
            }
        }
        SEAM(P + 8);
        if (IN(P + 9)) for (int rep_ = 0; rep_ < ((l == 0 || 9 != 5) ? NREP(9) : 1); ++rep_) {
            unsigned ldsb_ = (unsigned)(uintptr_t)lds0; asm volatile("" : "+s"(ldsb_)); LAS unsigned char* lds = (LAS unsigned char*)(uintptr_t)ldsb_; volatile LAS unsigned* MISC = (volatile LAS unsigned*)(lds + MISC_OFF); volatile LAS unsigned long long* ARGP = (volatile LAS unsigned long long*)(lds + MISC_OFF + 768); (void)MISC; int wave = wave0, G = G0, bx = bx0; asm volatile("" : "+s"(G), "+s"(bx), "+s"(wave)); const int lane = (int)__builtin_amdgcn_mbcnt_hi(~0u, __builtin_amdgcn_mbcnt_lo(~0u, 0u)); const int tid = wave * 64 + lane; const int vcu = (bx % 8) * (G / 8) + bx / 8; const int gw = vcu * 8 + wave, NGW = G * 8; (void)lane; (void)gw; (void)NGW; (void)vcu;
            GAS unsigned char* ws = (GAS unsigned char*)LDP(22); GAS float* out = (GAS float*)LDP(21); const GAS float* x_in = (const GAS float*)ARGIN(0); (void)out; (void)x_in; (void)ws;
            volatile LAS int* TS = (volatile LAS int*)(MISC + 128);
            if (tid <= 32) TS[tid] = P_TSTART[tid];
            __syncthreads();
            MoeOrder S{G, vcu, TS, (const GAS char*)P_HH, (const GAS char*)P_WD_L(l), (size_t)256 * 512, (size_t)1024 * 512, (size_t)256 * 512};
            EpiDown E{(GAS unsigned char*)P_Y, P_GATEOF};
            pg8::gemm_phase<EpiDown, MoeOrder, true, false, true>(tid, lds, DEXP, DEXP, DEXP, S, E, nullptr);
            if constexpr (l + 1 < NLAYER) {
                const int U = (int)TS[32] * 4, rem = U & 255; const int nidle = rem ? 256 - rem : 256, rk = rem ? vcu - rem : vcu;
                if (rk >= 0) { LAS float* scr64 = (LAS float*)(lds + wave * 16640);
                    const GAS float* w_down = (const GAS float*)ARGIN(19) + (size_t)(l + 1) * NEXP * DEXP * DM;
                    for (int it = rk * 8 + wave; it < 8 * 16 * NEXP; it += nidle * 8) conv_d_item(it, w_down, P_WD_L(l + 1), scr64, lane); }
            }
        }
        SEAM(P + 9);
}

__global__ void __launch_bounds__(512, 2) fwd(Args args) {
    extern __shared__ __attribute__((aligned(16))) unsigned char lds_raw[];
    LAS unsigned char* lds0 = (LAS unsigned char*)lds_raw;
    const int tid0 = threadIdx.x; const int wave0 = __builtin_amdgcn_readfirstlane(tid0 >> 6);
    const int G0 = gridDim.x; const int bx0 = blockIdx.x;
    { volatile LAS unsigned* MISC = (volatile LAS unsigned*)(lds0 + MISC_OFF); const int tid = tid0;
    for (int u = tid; u < 256; u += 512) MISC[u] = 0u;
    __syncthreads();
    volatile LAS unsigned long long* ARGP = (volatile LAS unsigned long long*)(lds0 + MISC_OFF + 768);
    if (tid < 21) ARGP[tid] = (unsigned long long)args.in[tid];
    if (tid == 21) ARGP[21] = (unsigned long long)args.out;
    if (tid == 22) ARGP[22] = (unsigned long long)args.ws;
    __syncthreads(); }
#if MK_ONE_LAUNCH
    XcdBarrier bar = xcd_barrier_post((unsigned*)(args.ws + WS_CTL) + CW_BAR, (volatile LAS unsigned*)(lds0 + MISC_OFF) + 8, gridDim.x);
    const int vcu0 = (bx0 % 8) * (G0 / 8) + bx0 / 8;
    XcdBarrier gbar = xcd_barrier_post((unsigned*)(args.ws + WS_CTL) + CW_BAR + (1 + (vcu0 >> 4)) * XCD_BAR_WORDS, (volatile LAS unsigned*)(lds0 + MISC_OFF) + 12, 16u);
#else
    XcdBarrier bar; bar.bar = nullptr; bar.x = 0; bar.st = nullptr; bar.n = 0;
    XcdBarrier gbar = bar;
#endif
    const int lo = args.ph_lo, hi_ = args.ph_hi;
    if (IN(0)) {
        const GAS int* positions = (const GAS int*)args.in[1]; GAS float* COSp = (GAS float*)(args.ws + WS_COS); GAS float* SINp = (GAS float*)(args.ws + WS_SIN);
        for (int i = bx0 * 512 + tid0; i < NTOK * 16; i += G0 * 512) { const int tk = i >> 4, fi = i & 15;
            const double invrev = exp2(-(double)fi * (13.287712379549449 / 16.0)) * 0.15915494309189535; const double rev = (double)positions[tk] * invrev; const float fr = (float)(rev - rint(rev));
            COSp[i] = __builtin_amdgcn_cosf(fr); SINp[i] = __builtin_amdgcn_sinf(fr); }
    }
    layer_body<0>(lo, hi_, lds0, wave0, G0, bx0, bar, gbar);
    layer_body<1>(lo, hi_, lds0, wave0, G0, bx0, bar, gbar);
    layer_body<2>(lo, hi_, lds0, wave0, G0, bx0, bar, gbar);
}

extern "C" void kernel_launch(void* const* d_in, const int* in_sizes, int n_in, void* d_out, int out_size, void* d_ws, size_t ws_size, hipStream_t stream) {
    static int grid = 0;
    if (grid == 0) {
        if (n_in != 21 || out_size != NTOK * DM || ws_size < WS_END) { fprintf(stderr, "kernel_launch: unexpected shapes (n_in %d out %d ws %zu)\n", n_in, out_size, ws_size); grid = -1; return; }
        int dev = 0, cus = 0;
        if (hipGetDevice(&dev) != hipSuccess || hipDeviceGetAttribute(&cus, hipDeviceAttributeMultiprocessorCount, dev) != hipSuccess) { grid = -1; return; }
        if (hipFuncSetAttribute((const void*)fwd, hipFuncAttributeMaxDynamicSharedMemorySize, LDS_BYTES) != hipSuccess) { fprintf(stderr, "kernel_launch: hipFuncSetAttribute failed\n"); grid = -1; return; }
        int per_cu = 0;
        if (hipOccupancyMaxActiveBlocksPerMultiprocessor(&per_cu, (const void*)fwd, 512, LDS_BYTES) != hipSuccess || per_cu < 1) fprintf(stderr, "kernel_launch: occupancy query says %d\n", per_cu);
        (void)hipGetLastError();
        grid = cus;
        if (grid != 256) { fprintf(stderr, "kernel_launch: built for 256 CUs, got %d\n", grid); grid = -1; return; }
    }
    if (grid < 0) return;
    if (hipMemsetAsync((char*)d_ws + WS_CTL, 0, CTL_ZERO_BYTES, stream) != hipSuccess) return;
    Args a{};
    for (int i = 0; i < 21; ++i) a.in[i] = d_in[i];
    a.out = (float*)d_out; a.ws = (unsigned char*)d_ws;
#if MK_ONE_LAUNCH
    a.ph_lo = 0; a.ph_hi = 21;
    hipLaunchKernelGGL(fwd, dim3(grid), dim3(512), LDS_BYTES, stream, a);
#else
    for (int p = 0; p <= 20; ++p) { a.ph_lo = p; a.ph_hi = p + 1; hipLaunchKernelGGL(fwd, dim3(grid), dim3(512), LDS_BYTES, stream, a); }
#endif
}
```

```cpp
#include <hip/hip_runtime.h>
#include <cstdio>
#include <cstdint>

#ifndef PROBE_PHASE
#define PROBE_PHASE -1
#endif
#ifndef PROBE_LAYER
#define PROBE_LAYER -1
#endif
#define NREP(k) (((PROBE_PHASE) == (k) && ((PROBE_LAYER) < 0 || (PROBE_LAYER) == l)) ? 2 : 1)
#ifndef MK_ONE_LAUNCH
#define MK_ONE_LAUNCH 1
#endif

#define LAS __attribute__((address_space(3)))
#define GAS __attribute__((address_space(1)))
typedef unsigned short bf16;
typedef short bf16x8 __attribute__((ext_vector_type(8)));
typedef short s16x4 __attribute__((ext_vector_type(4)));
typedef float f32x4 __attribute__((ext_vector_type(4)));
typedef float f32x2 __attribute__((ext_vector_type(2)));
typedef float f32x16 __attribute__((ext_vector_type(16)));
typedef unsigned u32x4 __attribute__((ext_vector_type(4)));
typedef unsigned u32x2 __attribute__((ext_vector_type(2)));

constexpr int NB = 16, SEQ = 2048, DM = 1024, NTOK = NB * SEQ, NLAYER = 2;
constexpr int INW = 1960, INP = 2048;
constexpr int NEXP = 32, DEXP = 512;
constexpr int MAXSLOT = 73728;
constexpr float EPS = 1e-6f;
constexpr float WSCALE = 64.f, WSCALE_INV = 1.f / 64.f;
constexpr float LOG2E = 1.4426950408889634f;
constexpr float C2F = 0.125f * LOG2E;
constexpr float C2M = 0.10206207261596575f * LOG2E;

constexpr size_t MiB = 1u << 20, KiB = 1u << 10;
constexpr size_t WS_CTL = 0, CTL_ZERO_BYTES = 256 * KiB;
constexpr size_t WS_COS = 1 * MiB, WS_SIN = 3 * MiB;
constexpr size_t WS_SSQ = 5 * MiB;
constexpr size_t WS_FLOG = 6 * MiB;
constexpr size_t WS_E01 = 8 * MiB;
constexpr size_t WS_G01 = 8 * MiB + 256 * KiB;
constexpr size_t WS_SLOT = 8 * MiB + 512 * KiB;
constexpr size_t WS_TOKOF = 8 * MiB + 768 * KiB;
constexpr size_t WS_GATEOF = 9 * MiB + 256 * KiB;
constexpr size_t WS_CNT = 9 * MiB + 768 * KiB;
constexpr size_t WS_TSTART = 9 * MiB + 800 * KiB;
constexpr size_t WS_RSTD = 9 * MiB + 832 * KiB;
constexpr size_t WS_RSTDOF = 7 * MiB;
constexpr size_t WS_KPE = 10 * MiB;
constexpr size_t WS_KAUG = 10 * MiB + 2 * MiB;
constexpr size_t WS_WIN = 16 * MiB;
constexpr size_t WS_WUQ = 20 * MiB;
constexpr size_t WS_WUKV = 20 * MiB + 512 * KiB;
constexpr size_t WS_WOUT = 21 * MiB;
constexpr size_t WS_WGU = 24 * MiB;
constexpr size_t WS_WD = 88 * MiB;
constexpr size_t WS_XN = 120 * MiB;
constexpr size_t WS_FQKV = 184 * MiB;
constexpr size_t WS_LAT = 280 * MiB;
constexpr size_t WS_QM = 312 * MiB;
constexpr size_t WS_KVM = 360 * MiB;
constexpr size_t WS_Y = 280 * MiB;
constexpr size_t WS_BIASF = 424 * MiB;
constexpr size_t WS_NRM = 425 * MiB;
constexpr size_t WS_WR = 426 * MiB;
constexpr size_t WS_XR = 427 * MiB;
constexpr size_t WS_OSS = 491 * MiB;
constexpr size_t WS_RSTDX = 493 * MiB;
constexpr size_t WS_W1 = 494 * MiB;
constexpr size_t WS_END = 502 * MiB;
static_assert(WS_Y + (size_t)MAXSLOT * 1024 * 2 <= WS_END, "Y fits");
static_assert(WS_FQKV + (size_t)MAXSLOT * 512 * 2 <= WS_LAT, "HH fits");

constexpr int CW_BAR = 1024;
static_assert((size_t)(CW_BAR + 17 * 3456) * 4 <= CTL_ZERO_BYTES, "barrier words inside the zeroed control block");

constexpr int RING_BYTES = 147456;
constexpr int MISC_OFF = RING_BYTES;
constexpr int LDS_BYTES = RING_BYTES + 1024;

typedef __bf16 bf16x2_t __attribute__((ext_vector_type(2)));
__device__ __forceinline__ unsigned cvt_pk_bf16(float lo, float hi) { const f32x2 v = {lo, hi}; const bf16x2_t b = __builtin_convertvector(v, bf16x2_t); return __builtin_bit_cast(unsigned, b); }
__device__ __forceinline__ float bf2f(unsigned short b) { return __uint_as_float((unsigned)b << 16); }
__device__ __forceinline__ float wave_sum(float v) {
#pragma unroll
    for (int o = 1; o < 64; o <<= 1) v += __shfl_xor(v, o);
    return v;
}
__device__ __forceinline__ unsigned pk4_fp8(float a, float b, float c, float d) { int w = 0; w = __builtin_amdgcn_cvt_pk_fp8_f32(a, b, w, false); w = __builtin_amdgcn_cvt_pk_fp8_f32(c, d, w, true); return (unsigned)w; }
#define LDS_WAIT() asm volatile("s_waitcnt lgkmcnt(0)" ::: "memory")

#define XB_TMO      128
#define XB_XCNT(j)  (256  + 64 * (j))
#define XB_XSUB(j)  (1280 + 64 * (j))
#define XB_XGEN(j)  (2304 + 64 * (j))
#define XB_TOP      3328
#define XB_TOPGEN   3392
#define XCD_BAR_WORDS 3456
#define XB_SPIN_CAP (1u << 18)
__device__ __forceinline__ unsigned xb_ld(unsigned* p)              { return __hip_atomic_load(p, __ATOMIC_RELAXED, __HIP_MEMORY_SCOPE_AGENT); }
__device__ __forceinline__ unsigned xb_add(unsigned* p, unsigned v) { return __hip_atomic_fetch_add(p, v, __ATOMIC_RELAXED, __HIP_MEMORY_SCOPE_AGENT); }
__device__ __forceinline__ unsigned xb_xcc_id() { return (unsigned)__builtin_amdgcn_s_getreg((3 << 11) | 20) & 0xFu; }
#define XB_SPIN(cond, bar) do { unsigned _sp = 0; while (cond) { __builtin_amdgcn_s_sleep(1); \
    if ((++_sp & 255u) == 0u) { if (xb_ld(&(bar)[XB_TMO])) break; if (_sp > XB_SPIN_CAP) { atomicAdd(&(bar)[XB_TMO], 1u); break; } } } } while (0)
struct XcdBarrier { unsigned* bar; unsigned x; volatile LAS unsigned* st; unsigned n; };
__device__ __forceinline__ XcdBarrier xcd_barrier_post(unsigned* bar, volatile LAS unsigned* st, unsigned n) {
    XcdBarrier b; b.bar = bar; b.x = xb_xcc_id(); b.st = st; b.n = n;
    if (threadIdx.x == 0) (void)xb_add(&bar[XB_XCNT(b.x)], 1u);
    return b;
}
__device__ __forceinline__ void xcd_barrier_complete(unsigned* bar, unsigned x, unsigned G, unsigned& nloc, unsigned& nx) {
    unsigned sum, cnt, mine, sp = 0u;
    for (;;) {
        sum = 0u; cnt = 0u; mine = 0u;
#pragma unroll
        for (unsigned j = 0; j < 16; ++j) { const unsigned c = xb_ld(&bar[XB_XCNT(j)]); sum += c; cnt += (c > 0u) ? 1u : 0u; mine = (j == x) ? c : mine; }
        if (sum == G) break;
        __builtin_amdgcn_s_sleep(1);
        if ((++sp & 255u) == 0u) { if (xb_ld(&bar[XB_TMO])) break; if (sp > XB_SPIN_CAP) { atomicAdd(&bar[XB_TMO], 1u); break; } }
    }
    nloc = mine > 0u ? mine : 1u; nx = cnt > 0u ? cnt : 1u;
}
__device__ __forceinline__ void xcd_barrier(const XcdBarrier& b) {
    asm volatile("s_waitcnt vmcnt(0)" ::: "memory");
    __syncthreads();
    if (threadIdx.x == 0) {
        unsigned* bar = b.bar;
        __builtin_amdgcn_s_waitcnt(0);
        unsigned nloc = b.st[0], nx = b.st[1];
        if (nloc == 0u) { xcd_barrier_complete(bar, b.x, b.n, nloc, nx); b.st[0] = nloc; b.st[1] = nx; }
        const unsigned old = xb_add(&bar[XB_XSUB(b.x)], 1u);
        const unsigned gen = old / nloc;
        if (old + 1u == (gen + 1u) * nloc) {
            __builtin_amdgcn_fence(__ATOMIC_RELEASE, "agent");
            asm volatile("s_waitcnt vmcnt(0)" ::: "memory");
            const unsigned og = xb_add(&bar[XB_TOP], 1u);
            const unsigned tg = og / nx;
            if (og + 1u == (tg + 1u) * nx) xb_add(&bar[XB_TOPGEN], 1u);
            else XB_SPIN(xb_ld(&bar[XB_TOPGEN]) == tg, bar);
            __builtin_amdgcn_fence(__ATOMIC_ACQUIRE, "agent");
            xb_add(&bar[XB_XGEN(b.x)], 1u);
            asm volatile("s_waitcnt vmcnt(0)" ::: "memory");
        } else {
            XB_SPIN(xb_ld(&bar[XB_XGEN(b.x)]) == gen, bar);
            __builtin_amdgcn_fence(__ATOMIC_ACQUIRE, "agent");
            asm volatile("s_waitcnt vmcnt(0)" ::: "memory");
        }
    }
    __syncthreads();
}

namespace pg8 {
constexpr int BM = 256, BK = 64, HALF = 128, HTB = HALF * BK * 2, STAGE_BYTES = 8 * HTB;
typedef int v4i32_t __attribute__((ext_vector_type(4)));
typedef int v8i32_t __attribute__((ext_vector_type(8)));
__host__ __device__ __forceinline__ int lds_byte(int r, int c) { const int st = (r >> 4) * 2 + (c >> 5), rr = r & 15, cc = c & 31, ob = rr * 64 + cc * 2; return st * 1024 + (ob ^ (((ob >> 9) & 1) << 5)); }
__host__ __device__ __forceinline__ void stage_rc(int b, int& R, int& C) { const int st = b / 1024, sb = b % 1024, swz = sb ^ (((sb >> 9) & 1) << 5); R = (st >> 1) * 16 + swz / 64; C = (st & 1) * 32 + (swz % 64) / 2; }
__host__ __device__ __forceinline__ int perm32(int rho) { const int n = rho >> 4, i = rho & 15; return 8 * (i >> 2) + 4 * n + (i & 3); }

struct Unit { const GAS char* a; const GAS char* b; int pm, pn, e; };

template <int N> __device__ __forceinline__ void wait_vm() { asm volatile("s_waitcnt vmcnt(%0)" :: "n"(N) : "memory"); }
template <class Epi, class Sched, bool ALIGN_EPI, bool GATHER, bool FP8 = false, bool MIDSCALE = false, bool VARK = false>
__device__ __forceinline__ void gemm_phase(const int tid, LAS unsigned char* lds, const int Kb, const int ldaB, const int ldbB, const Sched& S, const Epi& E, const GAS int* __restrict__ tokof, const LAS f32x2* scl = nullptr) {
    const int wid = __builtin_amdgcn_readfirstlane(tid >> 6), lane = tid & 63, wr = wid >> 2, wc = wid & 3, fr = lane & 15, fq = lane >> 4;
    const int nt = Kb / 128;
    unsigned voffA[2], voffB[2]; int RA[2], CA2[2];
#pragma unroll
    for (int i = 0; i < 2; ++i) { int R, C; stage_rc(tid * 16 + i * 8192, R, C); const int Rb = Epi::WIDE ? (64 * (R >> 5) + perm32(R & 31)) : Epi::PERM ? ((R & ~31) + perm32(R & 31)) : R;
        voffA[i] = (unsigned)(R * ldaB + C * 2); voffB[i] = (unsigned)(Rb * ldbB + C * 2); RA[i] = R; CA2[i] = C * 2; }
    const size_t kstep = (size_t)(BK * 2);
    const size_t hstepA = GATHER ? 0 : (size_t)HALF * ldaB;
    const size_t hstepB = (size_t)(Epi::WIDE ? 32 : HALF) * ldbB;
    const unsigned ldsw = (unsigned)wid * 1024u;
    const int aoff = lds_byte(wr * 64 + fr, fq * 8), boff = lds_byte(wc * 32 + fr, fq * 8);
    unsigned gcur[2][2], gnxt[2][2];
    const int scl8 = 0x7F7F7F7F;
#define PG8_SA(b, h) (((b) * 2 + (h)) * HTB)
#define PG8_SB(b, h) ((4 + (b) * 2 + (h)) * HTB)
#define PG8_STAGE(bufoff, gbase, voff) do { const unsigned long long gb_ = (unsigned long long)(gbase); const unsigned lbase_ = (unsigned)__builtin_amdgcn_readfirstlane((int)((unsigned)(uintptr_t)lds + (unsigned)(bufoff) + ldsw)); \
        _Pragma("unroll") for (int _i = 0; _i < 2; ++_i) { unsigned keep_; \
            asm volatile("s_mov_b32 %0, m0\n\ts_mov_b32 m0, %3\n\ts_nop 0\n\tglobal_load_lds_dwordx4 %1, %2\n\ts_mov_b32 m0, %0" : "=&s"(keep_) : "v"((voff)[_i]), "s"(gb_), "s"(lbase_ + (unsigned)(_i * 8192)) : "memory"); } } while (0)
#define PG8_STAGE_A(bufoff, base, h, nx) do { if constexpr (GATHER) { unsigned _v[2]; _v[0] = (nx) ? gnxt[h][0] : gcur[h][0]; _v[1] = (nx) ? gnxt[h][1] : gcur[h][1]; PG8_STAGE(bufoff, base, _v); } \
        else { PG8_STAGE(bufoff, (base) + (h) * hstepA, voffA); } } while (0)
#define PG8_LDA(dst, b, h) do { _Pragma("unroll") for (int m = 0; m < 4; ++m) _Pragma("unroll") for (int k = 0; k < 2; ++k) dst[m][k] = *(const LAS bf16x8*)(lds + PG8_SA(b, h) + aoff + m * 2048 + k * 1024); } while (0)
#define PG8_LDB(dst, b, h) do { _Pragma("unroll") for (int n = 0; n < 2; ++n) _Pragma("unroll") for (int k = 0; k < 2; ++k) dst[n][k] = *(const LAS bf16x8*)(lds + PG8_SB(b, h) + boff + n * 2048 + k * 1024); } while (0)
#define PG8_MMA(ai, bj, At, Bt) do { __builtin_amdgcn_s_setprio(1); if constexpr (FP8) { _Pragma("unroll") for (int m = 0; m < 4; ++m) _Pragma("unroll") for (int n = 0; n < 2; ++n) { \
        const v8i32_t b8_ = __builtin_shufflevector(__builtin_bit_cast(v4i32_t, Bt[n][0]), __builtin_bit_cast(v4i32_t, Bt[n][1]), 0, 1, 2, 3, 4, 5, 6, 7), a8_ = __builtin_shufflevector(__builtin_bit_cast(v4i32_t, At[m][0]), __builtin_bit_cast(v4i32_t, At[m][1]), 0, 1, 2, 3, 4, 5, 6, 7); \
        asm volatile("s_nop 1\n\tv_mfma_scale_f32_16x16x128_f8f6f4 %0, %1, %2, %0, %3, %3 op_sel_hi:[0,0,0]" : "+v"(acc[ai][bj][m][n]) : "v"(b8_), "v"(a8_), "v"(scl8)); } } \
      else { _Pragma("unroll") for (int m = 0; m < 4; ++m) _Pragma("unroll") for (int n = 0; n < 2; ++n) _Pragma("unroll") for (int k = 0; k < 2; ++k) \
        acc[ai][bj][m][n] = __builtin_amdgcn_mfma_f32_16x16x32_bf16(Bt[n][k], At[m][k], acc[ai][bj][m][n], 0, 0, 0); } __builtin_amdgcn_s_setprio(0); } while (0)
#define PG8_MMA_Z(ai, bj, At, Bt) do { __builtin_amdgcn_s_setprio(1); if constexpr (FP8) { _Pragma("unroll") for (int m = 0; m < 4; ++m) _Pragma("unroll") for (int n = 0; n < 2; ++n) { \
        const v8i32_t b8_ = __builtin_shufflevector(__builtin_bit_cast(v4i32_t, Bt[n][0]), __builtin_bit_cast(v4i32_t, Bt[n][1]), 0, 1, 2, 3, 4, 5, 6, 7), a8_ = __builtin_shufflevector(__builtin_bit_cast(v4i32_t, At[m][0]), __builtin_bit_cast(v4i32_t, At[m][1]), 0, 1, 2, 3, 4, 5, 6, 7); \
        asm volatile("s_nop 1\n\tv_mfma_scale_f32_16x16x128_f8f6f4 %0, %1, %2, 0, %3, %3 op_sel_hi:[0,0,0]" : "=&v"(acc[ai][bj][m][n]) : "v"(b8_), "v"(a8_), "v"(scl8)); } } \
      __builtin_amdgcn_s_setprio(0); } while (0)
#define PG8_WAIT_V(n) asm volatile("s_waitcnt vmcnt(" #n ")" ::: "memory")
#define PG8_WAIT_L(n) asm volatile("s_waitcnt lgkmcnt(" #n ")" ::: "memory")
#define PG8_BAR __builtin_amdgcn_s_barrier()
#define PG8_SCHED __builtin_amdgcn_sched_barrier(0)
#define PG8_GLOAD(dst, u) do { if constexpr (GATHER) { _Pragma("unroll") for (int _h = 0; _h < 2; ++_h) _Pragma("unroll") for (int _i = 0; _i < 2; ++_i) \
        dst[_h][_i] = (unsigned)tokof[(u).pm * BM + _h * HALF + RA[_i]] * (unsigned)ldaB + (unsigned)CA2[_i]; } } while (0)
    Unit cur, nxt; int ui = 0;
    if (!S.next(0, cur)) return;
    PG8_GLOAD(gcur, cur);
    typename Epi::Pre pre = E.prefetch(cur, wr, fr);
    f32x4 acc[2][2][4][2];
#pragma unroll
    for (int a = 0; a < 2; ++a)
#pragma unroll
        for (int b = 0; b < 2; ++b)
#pragma unroll
            for (int m = 0; m < 4; ++m)
#pragma unroll
                for (int n = 0; n < 2; ++n) acc[a][b][m][n] = (f32x4){0.f, 0.f, 0.f, 0.f};
    bf16x8 At[4][2], B0[2][2], B1[2][2];
    const GAS char* cA = cur.a; const GAS char* cB = cur.b;
    PG8_STAGE(PG8_SB(0, 0), cB, voffB); PG8_STAGE(PG8_SB(0, 1), cB + hstepB, voffB); PG8_STAGE_A(PG8_SA(0, 0), cA, 0, false); PG8_STAGE_A(PG8_SA(0, 1), cA, 1, false);
    if (wr == 1) PG8_BAR;
    PG8_WAIT_V(2); PG8_BAR;
    PG8_STAGE(PG8_SB(1, 0), cB + kstep, voffB); PG8_STAGE_A(PG8_SA(1, 0), cA + kstep, 0, false); PG8_STAGE(PG8_SB(1, 1), cB + hstepB + kstep, voffB);
    PG8_WAIT_V(6); PG8_BAR;
    bool fresh = false;
    for (;;) {
        const bool has_next = S.next(ui + 1, nxt);
        if constexpr (GATHER) { if (has_next) { PG8_GLOAD(gnxt, nxt); } else { _Pragma("unroll") for (int _h = 0; _h < 2; ++_h) _Pragma("unroll") for (int _i = 0; _i < 2; ++_i) gnxt[_h][_i] = gcur[_h][_i]; } }
        const GAS char* nA = has_next ? nxt.a : cA; const GAS char* nB = has_next ? nxt.b : cB;
        const int ntu = VARK ? (cur.e ? nt / 2 : nt) : nt;
#pragma nounroll
        for (int t = 0; t < ntu; t += 2) {
            const bool last = (t == ntu - 2);
            const GAS char* a1 = cA + (size_t)(t + 1) * kstep;
            const GAS char* a2 = last ? nA : cA + (size_t)(t + 2) * kstep; const GAS char* b2 = last ? nB : cB + (size_t)(t + 2) * kstep;
            const GAS char* a3 = a2 + kstep; const GAS char* b3 = b2 + kstep;
            const bool fe = fresh; fresh = false;
            if constexpr (MIDSCALE) { if (t == nt / 2) {
#pragma unroll
                for (int ai = 0; ai < 2; ++ai)
#pragma unroll
                    for (int m = 0; m < 4; ++m) { const float r_ = scl[ui * 256 + ai * 128 + wr * 64 + m * 16 + fr][0];
#pragma unroll
                        for (int bj = 0; bj < 2; ++bj)
#pragma unroll
                            for (int n = 0; n < 2; ++n) acc[ai][bj][m][n] *= r_; } } }
            PG8_LDB(B0, 0, 0); PG8_LDB(B1, 0, 1); PG8_SCHED; PG8_LDA(At, 0, 0); PG8_STAGE_A(PG8_SA(1, 1), a1, 1, false);
            if (fe) wait_vm<8 + Epi::NST>(); else PG8_WAIT_V(8); PG8_WAIT_L(0); PG8_BAR; if (FP8 && t == 0) { PG8_MMA_Z(0, 0, At, B0); PG8_MMA_Z(0, 1, At, B1); } else { PG8_MMA(0, 0, At, B0); PG8_MMA(0, 1, At, B1); } PG8_BAR; PG8_SCHED;
            PG8_LDA(At, 0, 1); PG8_STAGE(PG8_SB(0, 0), b2, voffB); PG8_STAGE(PG8_SB(0, 1), b2 + hstepB, voffB); PG8_STAGE_A(PG8_SA(0, 0), a2, 0, last);
            if (fe) wait_vm<8 + Epi::NST>(); else PG8_WAIT_V(8); PG8_WAIT_L(0); PG8_BAR; if (FP8 && t == 0) { PG8_MMA_Z(1, 0, At, B0); PG8_MMA_Z(1, 1, At, B1); } else { PG8_MMA(1, 0, At, B0); PG8_MMA(1, 1, At, B1); } PG8_BAR; PG8_SCHED;
            PG8_LDB(B0, 1, 0); PG8_LDB(B1, 1, 1); PG8_SCHED; PG8_LDA(At, 1, 0); PG8_STAGE_A(PG8_SA(0, 1), a2, 1, last);
            PG8_WAIT_V(8); PG8_WAIT_L(0); PG8_BAR; PG8_MMA(0, 0, At, B0); PG8_MMA(0, 1, At, B1); PG8_BAR; PG8_SCHED;
            PG8_LDA(At, 1, 1); PG8_STAGE(PG8_SB(1, 0), b3, voffB); PG8_STAGE(PG8_SB(1, 1), b3 + hstepB, voffB); PG8_STAGE_A(PG8_SA(1, 0), a3, 0, last);
            PG8_WAIT_V(8); PG8_WAIT_L(0); PG8_BAR; PG8_MMA(1, 0, At, B0); PG8_MMA(1, 1, At, B1); PG8_BAR; PG8_SCHED;
        }
        if constexpr (ALIGN_EPI) { if (wr == 0) PG8_BAR; }
        if constexpr (FP8) {
            asm volatile("s_nop 15\n\ts_nop 15" ::: "memory");
#pragma unroll
            for (int a = 0; a < 2; ++a)
#pragma unroll
                for (int b = 0; b < 2; ++b)
                    asm volatile("" : "+v"(acc[a][b][0][0]), "+v"(acc[a][b][0][1]), "+v"(acc[a][b][1][0]), "+v"(acc[a][b][1][1]), "+v"(acc[a][b][2][0]), "+v"(acc[a][b][2][1]), "+v"(acc[a][b][3][0]), "+v"(acc[a][b][3][1])); }
        if constexpr (MIDSCALE) E(acc, cur, wr, wc, fr, fq, scl + ui * 256); else E(acc, cur, wr, wc, fr, fq, pre);
        if (!has_next) break;
        pre = E.prefetch(nxt, wr, fr);
        if constexpr (FP8) {
#pragma unroll
            for (int a = 0; a < 2; ++a)
#pragma unroll
                for (int b = 0; b < 2; ++b)
                    asm volatile("" : "=v"(acc[a][b][0][0]), "=v"(acc[a][b][0][1]), "=v"(acc[a][b][1][0]), "=v"(acc[a][b][1][1]), "=v"(acc[a][b][2][0]), "=v"(acc[a][b][2][1]), "=v"(acc[a][b][3][0]), "=v"(acc[a][b][3][1]));
        } else {
#pragma unroll
            for (int a = 0; a < 2; ++a)
#pragma unroll
                for (int b = 0; b < 2; ++b)
#pragma unroll
                    for (int m = 0; m < 4; ++m)
#pragma unroll
                        for (int n = 0; n < 2; ++n) acc[a][b][m][n] = (f32x4){0.f, 0.f, 0.f, 0.f};
        }
        cur = nxt; cA = nA; cB = nB; ++ui; fresh = true;
        if constexpr (GATHER) { _Pragma("unroll") for (int _h = 0; _h < 2; ++_h) _Pragma("unroll") for (int _i = 0; _i < 2; ++_i) gcur[_h][_i] = gnxt[_h][_i]; }
        if constexpr (ALIGN_EPI) { if (wr == 1) PG8_BAR; }
    }
    PG8_WAIT_V(0);
    if constexpr (!ALIGN_EPI) { if (wr == 0) PG8_BAR; }
    PG8_BAR;
#undef PG8_SA
#undef PG8_SB
#undef PG8_STAGE
#undef PG8_STAGE_A
#undef PG8_LDA
#undef PG8_LDB
#undef PG8_MMA
#undef PG8_MMA_Z
#undef PG8_WAIT_V
#undef PG8_WAIT_L
#undef PG8_BAR
#undef PG8_SCHED
#undef PG8_GLOAD
}
}
using pg8::Unit;

struct BatchOrder {
    int nN, v; const GAS char* A; const GAS char* B; size_t aT, bT;
    __device__ __forceinline__ bool next(int i, Unit& u) const {
        const int uu = i * 16 + (v & 15); if (uu >= 8 * nN) return false;
        u.pm = __builtin_amdgcn_readfirstlane((v >> 4) * 8 + uu / nN); u.pn = __builtin_amdgcn_readfirstlane(uu % nN); u.e = 0;
        u.a = A + (size_t)u.pm * aT; u.b = B + (size_t)u.pn * bT; return true;
    }
};
struct UpOrder {
    int v; const GAS char* LATp; const GAS char* Wq; const GAS char* Wkv;
    __device__ __forceinline__ bool next(int i, Unit& u) const {
        const int j = v & 15; const bool hi = j >= 8; if (i >= (hi ? 4 : 3)) return false;
        const bool kv = hi ? (i < 3) : (i == 2); u.pn = __builtin_amdgcn_readfirstlane(hi ? (kv ? 1 + i : 2) : (kv ? 0 : i)); u.e = __builtin_amdgcn_readfirstlane(kv ? 1 : 0); u.pm = __builtin_amdgcn_readfirstlane((v >> 4) * 8 + (j & 7));
        u.a = LATp + (size_t)u.pm * 256 * 512 * 2 + (u.e ? 512 : 0);
        u.b = (u.e ? Wkv : Wq) + (size_t)u.pn * 256 * 256 * 2; return true;
    }
};
struct MoeOrder {
    int G, c; const volatile LAS int* TS; const GAS char* A; const GAS char* W; size_t aT  , wE  , wT  ;
    __device__ __forceinline__ bool next(int i, Unit& u) const {
        const int L = i * G + c; const int ntile = __builtin_amdgcn_readfirstlane(TS[32]); if (L >= ntile * 4) return false;
        const int rt = L >> 2, ct = L & 3;
        const int ln_ = (int)__builtin_amdgcn_mbcnt_hi(~0u, __builtin_amdgcn_mbcnt_lo(~0u, 0u)); const int tsv_ = TS[ln_ & 31];
        const int e = __builtin_popcountll(__ballot(ln_ >= 1 && ln_ < 32 && tsv_ <= rt));
        u.pm = rt; u.pn = ct; u.e = e; u.a = A + (size_t)rt * aT; u.b = W + (size_t)e * wE + (size_t)ct * wT; return true;
    }
};

__device__ __forceinline__ u32x4 pack8(f32x4 v0, f32x4 v1) { u32x4 w; w.x = cvt_pk_bf16(v0[0], v0[1]); w.y = cvt_pk_bf16(v0[2], v0[3]); w.z = cvt_pk_bf16(v1[0], v1[1]); w.w = cvt_pk_bf16(v1[2], v1[3]); return w; }

__device__ __forceinline__ void wide_store(GAS bf16* p, long dB, bool lo, u32x4 X, u32x4 Y) {
    u32x4 Yr;
#pragma unroll
    for (int j = 0; j < 4; ++j) Yr[j] = (unsigned)__builtin_amdgcn_update_dpp(0, (int)Y[j], 0x128, 0xf, 0xf, false);
    u32x4 A, B;
#pragma unroll
    for (int j = 0; j < 4; ++j) { A[j] = lo ? X[j] : Yr[j]; B[j] = lo ? Yr[j] : X[j]; }
    *(GAS u32x4*)p = A; *(GAS u32x4*)(p + dB) = B;
}

struct EpiWin {
    static constexpr int NST = 16;
    static constexpr bool PERM = true, WIDE = true;
    GAS bf16* LAT_; GAS bf16* FQKV_; GAS bf16* KPE_; GAS float* FLOG_; GAS float* SSQ_; const GAS float* COS_; const GAS float* SIN_; const GAS float* RSX_;
    struct Pre { float v[8]; };
    __device__ __forceinline__ Pre prefetch(const Unit& u, int wr, int fr) const { Pre p; const GAS float* RSX = RSX_; asm volatile("" : "+s"(RSX));
#pragma unroll
        for (int g = 0; g < 8; ++g) p.v[g] = RSX[u.pm * 256 + (g >> 2) * 128 + wr * 64 + (g & 3) * 16 + fr]; return p; }
    __device__ __forceinline__ void operator()(f32x4 (&acc)[2][2][4][2], const Unit& u, int wr, int wc, int fr, int fq, const Pre& pre) const {
        GAS bf16* LAT = LAT_; GAS bf16* FQKV = FQKV_; GAS bf16* KPE = KPE_; GAS float* FLOG = FLOG_; GAS float* SSQ = SSQ_; const GAS float* COS = COS_; const GAS float* SIN = SIN_; const GAS float* RSX = RSX_;
        asm volatile("" : "+s"(LAT), "+s"(FQKV), "+s"(KPE), "+s"(FLOG), "+s"(SSQ), "+s"(COS), "+s"(SIN), "+s"(RSX));
        {
#pragma unroll
            for (int ai = 0; ai < 2; ++ai)
#pragma unroll
                for (int m = 0; m < 4; ++m) { const float rs_ = pre.v[ai * 4 + m];
#pragma unroll
                    for (int bj = 0; bj < 2; ++bj)
#pragma unroll
                        for (int n = 0; n < 2; ++n) acc[ai][bj][m][n] *= rs_; } }
        const int row0 = u.pm * 256 + wr * 64 + fr; const int pn = u.pn;
        const bool lo = fr < 8; const int roww = u.pm * 256 + wr * 64 + (fr & 7), colw = wc * 64 + (fr >> 3) * 32 + 8 * fq; const long dB = 8 * 512 + (lo ? 32 : -32);
        if (pn >= 2) {
            const int ti = pn >> 1; GAS bf16* dst = FQKV + (size_t)(ti - 1) * NTOK * 512 + (pn & 1) * 256 + colw; const float sc = (ti == 1) ? C2F : 1.f;
#pragma unroll
            for (int ai = 0; ai < 2; ++ai)
#pragma unroll
                for (int m = 0; m < 4; ++m) wide_store(dst + (size_t)(roww + ai * 128 + m * 16) * 512, dB, lo, pack8(acc[ai][0][m][0] * sc, acc[ai][0][m][1] * sc), pack8(acc[ai][1][m][0] * sc, acc[ai][1][m][1] * sc));
        } else {
#pragma unroll
            for (int ai = 0; ai < 2; ++ai)
#pragma unroll
                for (int m = 0; m < 4; ++m) { const int row = row0 + ai * 128 + m * 16;
                    if (pn == 0 || wc != 2) wide_store(LAT + (size_t)(roww + ai * 128 + m * 16) * 512 + pn * 256 + colw, dB, lo, pack8(acc[ai][0][m][0], acc[ai][0][m][1]), pack8(acc[ai][1][m][0], acc[ai][1][m][1]));
                    float s = 0.f;
                    if (pn == 0 || wc < 2) {
#pragma unroll
                        for (int bj = 0; bj < 2; ++bj)
#pragma unroll
                            for (int n = 0; n < 2; ++n) { const f32x4 x = acc[ai][bj][m][n]; s += (x[0] * x[0] + x[1] * x[1]) + (x[2] * x[2] + x[3] * x[3]); }
                    }
                    s += __shfl_xor(s, 16); s += __shfl_xor(s, 32);
                    if (fq == 0) SSQ[(size_t)row * 8 + pn * 4 + wc] = s;
                    }
            if (pn == 1 && wc == 2) {
#pragma unroll
                for (int ai = 0; ai < 2; ++ai)
#pragma unroll
                    for (int m = 0; m < 4; ++m) { const int row = row0 + ai * 128 + m * 16;
                        const f32x4 c = *(const GAS f32x4*)(COS + (size_t)row * 16 + 4 * fq), sn = *(const GAS f32x4*)(SIN + (size_t)row * 16 + 4 * fq);
                        const f32x4 x1 = acc[ai][0][m][0], x2 = acc[ai][0][m][1];
                        *(GAS u32x4*)(KPE + (size_t)row * 32 + 8 * fq) = pack8(x1 * c - x2 * sn, x1 * sn + x2 * c);
                        }
            }
            if (pn == 1 && wc == 2 && fq == 0) {
#pragma unroll
                for (int ai = 0; ai < 2; ++ai)
#pragma unroll
                    for (int m = 0; m < 4; ++m) { const int row = row0 + ai * 128 + m * 16; *(GAS f32x4*)(FLOG + (size_t)row * 8) = acc[ai][1][m][0]; *(GAS f32x4*)(FLOG + (size_t)row * 8 + 4) = acc[ai][1][m][1]; }
            }
        }
    }
};
struct EpiUp {
    static constexpr int NST = 16;
    static constexpr bool PERM = true, WIDE = true;
    GAS bf16* QM_; GAS bf16* KVM_; const GAS float* SSQ_; const GAS float* COS_; const GAS float* SIN_;
    struct Pre { f32x4 v[8]; };
    __device__ __forceinline__ Pre prefetch(const Unit& u, int wr, int fr) const { Pre p; const GAS float* SSQ = SSQ_; asm volatile("" : "+s"(SSQ)); const int off = u.e ? 4 : 0;
#pragma unroll
        for (int g = 0; g < 8; ++g) p.v[g] = *(const GAS f32x4*)(SSQ + (size_t)(u.pm * 256 + (g >> 2) * 128 + wr * 64 + (g & 3) * 16 + fr) * 8 + off); return p; }
    __device__ __forceinline__ void operator()(const f32x4 (&acc)[2][2][4][2], const Unit& u, int wr, int wc, int fr, int fq, const Pre& pre) const {
        GAS bf16* QM = QM_; GAS bf16* KVM = KVM_; const GAS float* SSQ = SSQ_; const GAS float* COS = COS_; const GAS float* SIN = SIN_;
        asm volatile("" : "+s"(QM), "+s"(KVM), "+s"(SSQ), "+s"(COS), "+s"(SIN));
        const int row0 = u.pm * 256 + wr * 64 + fr; const int pn = u.pn; const bool kv = u.e != 0;
        const bool lo = fr < 8; const int roww = u.pm * 256 + wr * 64 + (fr & 7), colw = pn * 256 + wc * 64 + (fr >> 3) * 32 + 8 * fq;
#pragma unroll
        for (int ai = 0; ai < 2; ++ai)
#pragma unroll
            for (int m = 0; m < 4; ++m) { const int row = row0 + ai * 128 + m * 16;
                const f32x4 sq = pre.v[ai * 4 + m];
                const float ss = (sq[0] + sq[1]) + (sq[2] + sq[3]);
                if (kv) {
                    const float rs = rsqrtf(ss * (1.f / 128.f) + EPS);
                    wide_store(KVM + (size_t)(roww + ai * 128 + m * 16) * 1024 + colw, 8 * 1024 + (lo ? 32 : -32), lo, pack8(acc[ai][0][m][0] * rs, acc[ai][0][m][1] * rs), pack8(acc[ai][1][m][0] * rs, acc[ai][1][m][1] * rs));
                } else {
                    const float rs = rsqrtf(ss * (1.f / 256.f) + EPS) * C2M;
                    const f32x4 c = *(const GAS f32x4*)(COS + (size_t)row * 16 + 4 * fq), sn = *(const GAS f32x4*)(SIN + (size_t)row * 16 + 4 * fq);
                    u32x4 XY[2];
#pragma unroll
                    for (int bj = 0; bj < 2; ++bj) { f32x4 v0 = acc[ai][bj][m][0] * rs, v1 = acc[ai][bj][m][1] * rs;
                        const int G = 8 * pn + 2 * wc + bj;
                        if (G % 3 == 2) { const f32x4 x1 = v0, x2 = v1; v0 = x1 * c - x2 * sn; v1 = x1 * sn + x2 * c; }
                        XY[bj] = pack8(v0, v1); }
                    wide_store(QM + (size_t)(roww + ai * 128 + m * 16) * 768 + colw, 8 * 768 + (lo ? 32 : -32), lo, XY[0], XY[1]);
                }

            }
    }
};
template <bool RES_F32> struct EpiOut {
    static constexpr int NST = 16;
    static constexpr bool PERM = true, WIDE = true;
    const GAS float* resf_; GAS bf16* xr_;
    struct Pre {}; __device__ __forceinline__ Pre prefetch(const Unit&, int, int) const { return Pre{}; }
    __device__ __forceinline__ void operator()(const f32x4 (&acc)[2][2][4][2], const Unit& u, int wr, int wc, int fr, int fq, const LAS f32x2* scl) const {
        const GAS float* resf = resf_; GAS bf16* xr = xr_; asm volatile("" : "+s"(resf), "+s"(xr));
        const int row0 = u.pm * 256 + wr * 64 + fr, col0 = u.pn * 256 + wc * 64 + 8 * fq;
        const bool lo = fr < 8; const int roww = u.pm * 256 + wr * 64 + (fr & 7), colw = u.pn * 256 + wc * 64 + (fr >> 3) * 32 + 8 * fq;
#pragma unroll
        for (int ai = 0; ai < 2; ++ai)
#pragma unroll
            for (int m = 0; m < 4; ++m) { const size_t off = (size_t)(row0 + ai * 128 + m * 16) * DM + col0; const float sh = scl[ai * 128 + wr * 64 + m * 16 + fr][1];
                u32x4 XY[2];
#pragma unroll
                for (int bj = 0; bj < 2; ++bj) { f32x4 r0, r1;
                    if constexpr (RES_F32) { r0 = *(const GAS f32x4*)(resf + off + bj * 32); r1 = *(const GAS f32x4*)(resf + off + bj * 32 + 4); }
                    else { const u32x4 w = *(const GAS u32x4*)(xr + off + bj * 32);
                        r0 = (f32x4){__uint_as_float(w.x << 16), __uint_as_float(w.x & 0xffff0000u), __uint_as_float(w.y << 16), __uint_as_float(w.y & 0xffff0000u)};
                        r1 = (f32x4){__uint_as_float(w.z << 16), __uint_as_float(w.z & 0xffff0000u), __uint_as_float(w.w << 16), __uint_as_float(w.w & 0xffff0000u)}; }
                    XY[bj] = pack8(r0 + acc[ai][bj][m][0] * sh, r1 + acc[ai][bj][m][1] * sh); }
                wide_store(xr + (size_t)(roww + ai * 128 + m * 16) * DM + colw, 8 * DM + (lo ? 32 : -32), lo, XY[0], XY[1]); }
    }
};
struct EpiGU {
    static constexpr int NST = 4;
    static constexpr bool PERM = true, WIDE = false;
    GAS unsigned char* HH_; const GAS float* RS_;
    struct Pre { float v[8]; };
    __device__ __forceinline__ Pre prefetch(const Unit& u, int wr, int fr) const { Pre p; const GAS float* RS = RS_; asm volatile("" : "+s"(RS));
#pragma unroll
        for (int g = 0; g < 8; ++g) p.v[g] = RS[u.pm * 256 + (g >> 2) * 128 + wr * 64 + (g & 3) * 16 + fr]; return p; }
    __device__ __forceinline__ void operator()(const f32x4 (&acc)[2][2][4][2], const Unit& u, int wr, int wc, int fr, int fq, const Pre& pre) const {
        GAS unsigned char* HH = HH_; const GAS float* RS = RS_; asm volatile("" : "+s"(HH), "+s"(RS));
        const int row0 = u.pm * 256 + wr * 64 + fr;
#pragma unroll
        for (int ai = 0; ai < 2; ++ai)
#pragma unroll
            for (int mp = 0; mp < 2; ++mp) {
                u32x2 w[2];
#pragma unroll
                for (int q = 0; q < 2; ++q) { const int m = 2 * mp + q; const float rs = pre.v[ai * 4 + m] * WSCALE_INV;
                    f32x4 h[2];
#pragma unroll
                    for (int n = 0; n < 2; ++n) { const f32x4 g = acc[ai][0][m][n] * rs, up = acc[ai][1][m][n] * rs;
#pragma unroll
                        for (int j = 0; j < 4; ++j) { const float sg = __builtin_amdgcn_rcpf(1.f + __builtin_amdgcn_exp2f(-g[j] * LOG2E)); h[n][j] = g[j] * sg * up[j]; } }
                    w[q].x = pk4_fp8(h[0][0], h[0][1], h[0][2], h[0][3]); w[q].y = pk4_fp8(h[1][0], h[1][1], h[1][2], h[1][3]); }
                const auto s0 = __builtin_amdgcn_permlane16_swap(w[0].x, w[1].x, false, false), s1 = __builtin_amdgcn_permlane16_swap(w[0].y, w[1].y, false, false);
                *(GAS u32x4*)(HH + (size_t)(row0 + ai * 128 + (2 * mp + (fq & 1)) * 16) * 512 + u.pn * 128 + wc * 32 + (fq >> 1) * 16) = (u32x4){s0[0], s1[0], s0[1], s1[1]}; }
    }
};
struct EpiDown {
    static constexpr int NST = 8;
    static constexpr bool PERM = true, WIDE = true;
    GAS unsigned char* Y_; const GAS float* GATEOF_;
    struct Pre { float v[8]; };
    __device__ __forceinline__ Pre prefetch(const Unit& u, int wr, int fr) const { Pre p; const GAS float* GT = GATEOF_; asm volatile("" : "+s"(GT));
#pragma unroll
        for (int g = 0; g < 8; ++g) p.v[g] = GT[u.pm * 256 + (g >> 2) * 128 + wr * 64 + (g & 3) * 16 + fr]; return p; }
    __device__ __forceinline__ void operator()(const f32x4 (&acc)[2][2][4][2], const Unit& u, int wr, int wc, int fr, int fq, const Pre& pre) const {
        GAS unsigned char* Y = Y_; const GAS float* GATEOF = GATEOF_; asm volatile("" : "+s"(Y), "+s"(GATEOF));
        const int row0 = u.pm * 256 + wr * 64 + fr;
#pragma unroll
        for (int ai = 0; ai < 2; ++ai)
#pragma unroll
            for (int m = 0; m < 4; ++m) { const int row = row0 + ai * 128 + m * 16; const float g = pre.v[ai * 4 + m];
                u32x2 w[2];
#pragma unroll
                for (int bj = 0; bj < 2; ++bj) { const f32x4 v0 = acc[ai][bj][m][0] * g, v1 = acc[ai][bj][m][1] * g; w[bj].x = pk4_fp8(v0[0], v0[1], v0[2], v0[3]); w[bj].y = pk4_fp8(v1[0], v1[1], v1[2], v1[3]); }
                const auto s0 = __builtin_amdgcn_permlane16_swap(w[0].x, w[1].x, false, false), s1 = __builtin_amdgcn_permlane16_swap(w[0].y, w[1].y, false, false);
                *(GAS u32x4*)(Y + (size_t)row * 1024 + u.pn * 256 + wc * 64 + (fq & 1) * 32 + (fq >> 1) * 16) = (u32x4){s0[0], s1[0], s0[1], s1[1]}; }
    }
};

namespace att {
constexpr int KSLOT = 12288, VSLOT = 8192;
constexpr int L_K = 0, L_V = 2 * KSLOT, L_BIAS = L_V + 2 * VSLOT, L_WS = L_BIAS + 8192, L_OST = L_WS + 8 * 64 * 4, L_END = L_OST + 8 * 4096;
__device__ __forceinline__ int crow(int r, int hi) { return (r & 3) + 8 * (r >> 2) + 4 * hi; }
typedef short v4i16_t __attribute__((ext_vector_type(4)));
__device__ __forceinline__ s16x4 vtr(const LAS char* p) { return __builtin_bit_cast(s16x4, __builtin_amdgcn_ds_read_tr16_b64_v4i16((LAS v4i16_t*)p)); }

constexpr int NSL = 5;
constexpr int R_K = 0, R_V = NSL * KSLOT, R_WS = R_V + NSL * VSLOT, R_OST = R_WS + 8 * 64 * 4, R_END = R_OST + 8 * 4096;
static_assert(R_END <= RING_BYTES, "attention LDS");
__device__ __forceinline__ void glds16(const GAS void* gsrc, unsigned lds_dst) { unsigned keep;
    asm volatile("s_mov_b32 %0, m0\n\ts_mov_b32 m0, %2\n\ts_nop 0\n\tglobal_load_lds_dwordx4 %1, off\n\ts_mov_b32 m0, %0" : "=&s"(keep) : "v"(gsrc), "s"(lds_dst) : "memory"); }
__device__ __forceinline__ void glds16s(const GAS void* sbase, unsigned voff, unsigned lds_dst) { unsigned keep;
    asm volatile("s_mov_b32 %0, m0\n\ts_mov_b32 m0, %3\n\ts_nop 0\n\tglobal_load_lds_dwordx4 %1, %2\n\ts_mov_b32 m0, %0" : "=&s"(keep) : "v"(voff), "s"((unsigned long long)sbase), "s"(lds_dst) : "memory"); }
struct Tens2 { const GAS bf16* Q; int qp; const GAS bf16* K; int kp; const GAS bf16* KX; const GAS bf16* V; int vp; GAS bf16* O; const GAS float* BIASF; const GAS float* NRM; GAS float* OSS; };
template <int MODE>
__device__ __forceinline__ int attn_unit2(const int wave_, int b, int h, int qb, const Tens2& T, LAS char* shm, const int slbase, const bool have_pro, const int qb_next, bf16x8 (&qr)[6], const int tstart) {
    constexpr int DKS = MODE ? 6 : 5, DKH = 3;
    constexpr float THR = 8.f;
    int wid = wave_; asm volatile("" : "+s"(wid));
    int lane = (int)__builtin_amdgcn_mbcnt_hi(~0u, __builtin_amdgcn_mbcnt_lo(~0u, 0u)); asm volatile("" : "+v"(lane)); const int r32 = lane & 31, hi = lane >> 5;
    const long rowbase = (long)b * SEQ; const int q0 = qb * 256, qw0 = q0 + wid * 32;
    const int NT = (q0 + 256) / 64, tlast = qw0 / 64;
    const int NTE = NT - tstart;
    const GAS bf16* Qw = T.Q + (rowbase + qw0) * T.qp + h * (MODE ? 96 : 64);
    const GAS bf16* Kh = T.K + rowbase * T.kp + h * (MODE ? 128 : 64);
    const GAS bf16* Vh = T.V + rowbase * T.vp + h * (MODE ? 128 : 64);
    LAS float* wsf = (LAS float*)(shm + R_WS) + wid * 64;
    const unsigned koff = (unsigned)(lane * T.kp + wid * 8) * 2u;
    const unsigned xoff = MODE ? (unsigned)(lane * 32 + (wid & 3) * 8) * 2u : (unsigned)(lane * 8) * 2u;
    const unsigned voff = (unsigned)((16 * (wid & 3) + (lane >> 2)) * T.vp + (wid >> 2) * 32 + (lane & 3) * 8) * 2u;
    const GAS bf16* xbase = MODE ? T.KX + rowbase * 32 : T.KX + ((long)b * 8 + h) * SEQ * 8;
    const int xstep = MODE ? 64 * 32 : 64 * 8;
    const unsigned kdst_a = (unsigned)(uintptr_t)(shm + R_K) + (unsigned)wid * 1024u, xdst_a = (unsigned)(uintptr_t)(shm + R_K) + (unsigned)(8 + (MODE ? (wid & 3) : 0)) * 1024u, vdst_a = (unsigned)(uintptr_t)(shm + R_V) + (unsigned)wid * 1024u;
#define A2_DMA(t, slot) do { \
        glds16s((const GAS void*)(Kh + (long)(t) * 64 * T.kp), koff, (unsigned)__builtin_amdgcn_readfirstlane((int)(kdst_a + (slot) * KSLOT))); \
        glds16s((const GAS void*)(xbase + (long)(t) * xstep), xoff, (unsigned)__builtin_amdgcn_readfirstlane((int)(xdst_a + (slot) * KSLOT))); \
        glds16s((const GAS void*)(Vh + (long)(t) * 64 * T.vp), voff, (unsigned)__builtin_amdgcn_readfirstlane((int)(vdst_a + (slot) * VSLOT))); } while (0)
    float mhat = 0.f, lrun = 0.f; f32x16 o[2]; o[0] = f32x16{}; o[1] = f32x16{}; f32x16 negm = f32x16{};
    const LAS char* vp0 = shm + R_V + ((lane >> 4) & 1) * 32 + (lane & 3) * 8 + (4 * hi + ((lane & 15) >> 2)) * 64;
#define A3_SLOT(k) ((slbase + (k)) % NSL)
    if (!have_pro) { A2_DMA(NT - 1, A3_SLOT(0)); A2_DMA(NT - 2, A3_SLOT(1)); A2_DMA(NT - 3, A3_SLOT(2)); }
    if (!have_pro) {
#pragma unroll
        for (int d0 = 0; d0 < (MODE ? 6 : 4); ++d0) qr[d0] = *(const GAS bf16x8*)(Qw + (long)r32 * T.qp + d0 * 16 + hi * 8); }
    if (MODE == 0) { const short one = hi ? (short)0 : (short)0x3F80; qr[DKS - 1] = (bf16x8){one, one, one, 0, 0, 0, 0, 0}; }
#pragma unroll
    for (int d0 = 0; d0 < DKS; ++d0) asm volatile("" : "+v"(qr[d0]));
#define A3_KLOADH(slot, H) do { const LAS char* kb_ = shm + R_K + (slot) * KSLOT + r32 * 16; _Pragma("unroll") for (int d0 = (H) * DKH; d0 < ((H) ? DKS : DKH); ++d0) { const int off = (MODE == 0 && d0 == 4) ? 8 * 1024 : d0 * 2048 + hi * 1024; \
        kf[2 * (d0 - (H) * DKH)] = *(const LAS bf16x8*)(kb_ + off); kf[2 * (d0 - (H) * DKH) + 1] = *(const LAS bf16x8*)(kb_ + off + 512); } } while (0)
#define A3_VLOAD(slot) do { const LAS char* vp_ = vp0 + (slot) * VSLOT; _Pragma("unroll") for (int q = 0; q < 8; ++q) { vlo[q] = vtr(vp_ + (q >> 2) * 4096 + (q & 3) * 1024); vhh[q] = vtr(vp_ + (q >> 2) * 4096 + (q & 3) * 1024 + 512); } } while (0)
#define A3_QKH(H) do { if ((H) == 0) { c0 = negm; c1 = negm; } _Pragma("unroll") for (int d0 = (H) * DKH; d0 < ((H) ? DKS : DKH); ++d0) { c0 = __builtin_amdgcn_mfma_f32_32x32x16_bf16(kf[2 * (d0 - (H) * DKH)], qr[d0], c0, 0, 0, 0); c1 = __builtin_amdgcn_mfma_f32_32x32x16_bf16(kf[2 * (d0 - (H) * DKH) + 1], qr[d0], c1, 0, 0, 0); } } while (0)
#define A3_EXP() do { float ls_ = 0.f; _Pragma("unroll") for (int r = 0; r < 16; ++r) { pp0[r] = __builtin_amdgcn_exp2f(pp0[r]); pp1[r] = __builtin_amdgcn_exp2f(pp1[r]); ls_ += pp0[r] + pp1[r]; } lrun += ls_; u32x4 w_; \
        w_.x = cvt_pk_bf16(pp0[0], pp0[1]); w_.y = cvt_pk_bf16(pp0[2], pp0[3]); w_.z = cvt_pk_bf16(pp0[4], pp0[5]); w_.w = cvt_pk_bf16(pp0[6], pp0[7]); pa[0] = __builtin_bit_cast(bf16x8, w_); \
        w_.x = cvt_pk_bf16(pp0[8], pp0[9]); w_.y = cvt_pk_bf16(pp0[10], pp0[11]); w_.z = cvt_pk_bf16(pp0[12], pp0[13]); w_.w = cvt_pk_bf16(pp0[14], pp0[15]); pa[1] = __builtin_bit_cast(bf16x8, w_); \
        w_.x = cvt_pk_bf16(pp1[0], pp1[1]); w_.y = cvt_pk_bf16(pp1[2], pp1[3]); w_.z = cvt_pk_bf16(pp1[4], pp1[5]); w_.w = cvt_pk_bf16(pp1[6], pp1[7]); pa[2] = __builtin_bit_cast(bf16x8, w_); \
        w_.x = cvt_pk_bf16(pp1[8], pp1[9]); w_.y = cvt_pk_bf16(pp1[10], pp1[11]); w_.z = cvt_pk_bf16(pp1[12], pp1[13]); w_.w = cvt_pk_bf16(pp1[14], pp1[15]); pa[3] = __builtin_bit_cast(bf16x8, w_); } while (0)
#define A3_PV() do { _Pragma("unroll") for (int d0 = 0; d0 < 2; ++d0) _Pragma("unroll") for (int k = 0; k < 4; ++k) { const s16x4 lo_ = vlo[4 * d0 + k], hh_ = vhh[4 * d0 + k]; \
        const bf16x8 vf_ = (bf16x8){lo_[0], lo_[1], lo_[2], lo_[3], hh_[0], hh_[1], hh_[2], hh_[3]}; o[d0] = __builtin_amdgcn_mfma_f32_32x32x16_bf16(pa[k], vf_, o[d0], 0, 0, 0); } } while (0)
#define A3_ROWMAX(rm) do { float a_ = fmaxf(fmaxf(c0[0], c0[1]), c1[0]), b_ = fmaxf(fmaxf(c0[2], c0[3]), c1[1]); a_ = fmaxf(fmaxf(a_, c1[2]), c1[3]); \
        _Pragma("unroll") for (int r = 4; r < 16; r += 4) { a_ = fmaxf(fmaxf(a_, c0[r]), c0[r + 1]); b_ = fmaxf(fmaxf(b_, c0[r + 2]), c0[r + 3]); a_ = fmaxf(fmaxf(a_, c1[r]), c1[r + 1]); b_ = fmaxf(fmaxf(b_, c1[r + 2]), c1[r + 3]); } \
        rm = fmaxf(a_, b_); const auto rr_ = __builtin_amdgcn_permlane32_swap(__float_as_uint(rm), __float_as_uint(rm), false, false); rm = fmaxf(__uint_as_float(rr_[0]), __uint_as_float(rr_[1])); } while (0)
    int sl = A3_SLOT(0), sl3 = A3_SLOT(3);
    f32x16 pp0 = f32x16{}, pp1 = f32x16{}; bool pend = false; int pslot = 0;
    for (int i = 0; i < NTE; ++i) {
        const int t = NT - 1 - i;
        { const int ahead = NTE - 1 - i;
          if (ahead >= 2) asm volatile("s_waitcnt vmcnt(6)" ::: "memory"); else if (ahead == 1) asm volatile("s_waitcnt vmcnt(3)" ::: "memory"); else asm volatile("s_waitcnt vmcnt(0)" ::: "memory"); }
        __builtin_amdgcn_s_barrier(); asm volatile("" ::: "memory");
        if (i + 3 < NTE) A2_DMA(t - 3, sl3);
        if (i == NTE - 1 && qb_next >= 0) { const int NTn = 4 * qb_next + 4; A2_DMA(NTn - 1, A3_SLOT(NTE)); A2_DMA(NTn - 2, A3_SLOT(NTE + 1)); A2_DMA(NTn - 3, A3_SLOT(NTE + 2)); }
        if (t <= tlast) {
            bf16x8 kf[2 * DKH]; f32x16 c0, c1; float rm;
            A3_KLOADH(sl, 0);
            if (!pend) {
                A3_QKH(0); A3_KLOADH(sl, 1); A3_QKH(1);
                if (MODE == 0) { const int qrel = qw0 + r32 - 64 * t;
#pragma unroll
                    for (int r = 0; r < 16; ++r) { const int kv = crow(r, hi); if (kv > qrel) c0[r] = -INFINITY; if (kv + 32 > qrel) c1[r] = -INFINITY; } }
                A3_ROWMAX(rm);
                mhat = rm;
#pragma unroll
                for (int r = 0; r < 16; ++r) { c0[r] -= rm; c1[r] -= rm; negm[r] = -mhat; }
                pend = true;
            } else {
                s16x4 vlo[8], vhh[8]; bf16x8 pa[4];
                A3_QKH(0); A3_KLOADH(sl, 1);
                A3_VLOAD(pslot);
                A3_QKH(1);
                A3_EXP();
#pragma unroll
                for (int g_ = 0; g_ < 2 * DKS; ++g_) { __builtin_amdgcn_sched_group_barrier(0x008, 1, 0); __builtin_amdgcn_sched_group_barrier(0x002, 7, 0); }
                A3_PV();
                A3_ROWMAX(rm);
#pragma unroll
                for (int g_ = 0; g_ < 8; ++g_) { __builtin_amdgcn_sched_group_barrier(0x008, 1, 0); __builtin_amdgcn_sched_group_barrier(0x002, 3, 0); }
                if (__any(rm > THR)) {
                    const float dl = fmaxf(rm, 0.f); mhat += dl;
#pragma unroll
                    for (int r = 0; r < 16; ++r) { c0[r] -= dl; c1[r] -= dl; negm[r] = -mhat; }
                    const float f = __builtin_amdgcn_exp2f(-dl); lrun *= f;
                    if (hi == 0) wsf[r32] = f;
                    LDS_WAIT();
#pragma unroll
                    for (int g = 0; g < 4; ++g) { const f32x4 ff = *(const LAS f32x4*)(wsf + 8 * g + 4 * hi);
#pragma unroll
                        for (int j = 0; j < 4; ++j) { o[0][4 * g + j] *= ff[j]; o[1][4 * g + j] *= ff[j]; } }
                }
            }
            pp0 = c0; pp1 = c1; pslot = sl;
        }
        sl = (sl == NSL - 1) ? 0 : sl + 1; sl3 = (sl3 == NSL - 1) ? 0 : sl3 + 1;
    }
    if (qb_next >= 0) { const GAS bf16* Qn = T.Q + (rowbase + qb_next * 256 + wid * 32) * T.qp + h * (MODE ? 96 : 64);
#pragma unroll
        for (int d0 = 0; d0 < (MODE ? 6 : 4); ++d0) qr[d0] = *(const GAS bf16x8*)(Qn + (long)r32 * T.qp + d0 * 16 + hi * 8); }
    if (pend) { s16x4 vlo[8], vhh[8]; bf16x8 pa[4]; A3_VLOAD(pslot); A3_EXP(); A3_PV(); }
#undef A3_KLOADH
#undef A3_VLOAD
#undef A3_QKH
#undef A3_EXP
#undef A3_PV
#undef A3_ROWMAX
#undef A2_DMA
    lrun += __shfl_xor(lrun, 32);
    LDS_WAIT();
    if (hi == 0) wsf[32 + r32] = lrun;
    LDS_WAIT();
    float rli[16];
#pragma unroll
    for (int g = 0; g < 4; ++g) { const f32x4 ll = *(const LAS f32x4*)(wsf + 32 + 8 * g + 4 * hi);
#pragma unroll
        for (int j = 0; j < 4; ++j) rli[4 * g + j] = __builtin_amdgcn_rcpf(ll[j]); }
    GAS bf16* Ow = T.O + (rowbase + qw0) * 1024 + (MODE ? 0 : 512) + h * 64;
    { LAS bf16* stg = (LAS bf16*)(shm + R_OST) + wid * 2048;
#pragma unroll
      for (int r = 0; r < 16; ++r) { const int orow = crow(r, hi);
#pragma unroll
          for (int d0 = 0; d0 < 2; ++d0) stg[orow * 64 + d0 * 32 + r32] = (bf16)(cvt_pk_bf16(o[d0][r] * rli[r], 0.f) & 0xffffu); }
      LDS_WAIT();
#pragma unroll
      for (int i = 0; i < 4; ++i) { const int row = i * 8 + (lane >> 3), ch = lane & 7; const u32x4 v = *(const LAS u32x4*)(stg + row * 64 + ch * 8); *(GAS u32x4*)(Ow + (long)row * 1024 + ch * 8) = v;
          float sq = 0.f;
#pragma unroll
          for (int j = 0; j < 4; ++j) { const float a0 = __uint_as_float(v[j] << 16), a1 = __uint_as_float(v[j] & 0xffff0000u); sq += a0 * a0 + a1 * a1; }
          sq += __shfl_xor(sq, 1); sq += __shfl_xor(sq, 2); sq += __shfl_xor(sq, 4);
          if (ch == 0) T.OSS[(rowbase + qw0 + row) * 16 + (MODE ? 0 : 8) + h] = sq; } }
    if (qb_next < 0) { LDS_WAIT(); __builtin_amdgcn_s_barrier(); asm volatile("" ::: "memory"); }
    return A3_SLOT(NTE);
#undef A3_SLOT
}
}

struct Args { const void* in[21]; float* out; unsigned char* ws; int ph_lo, ph_hi; };

__device__ __forceinline__ void tr_item(const GAS float* __restrict__ W, int ldw, int Ksrc, const GAS float* __restrict__ gain, GAS bf16* __restrict__ WT, int ldk, int k0, int n0, int srccol, LAS float* scr, int lane) {
#pragma unroll 8
    for (int i = 0; i < 32; ++i) { const int kk = 2 * i + (lane >> 5); const int k = k0 + kk;
        float v = 0.f; if (srccol >= 0 && k < Ksrc) { v = __builtin_nontemporal_load(W + (size_t)k * ldw + srccol); if (gain) v *= gain[k]; }
        scr[kk * 33 + (lane & 31)] = v; }
    LDS_WAIT(); asm volatile("" ::: "memory");
    const int c = lane & 7;
#pragma unroll
    for (int j = 0; j < 4; ++j) { const int n = (lane >> 3) + 8 * j; const LAS float* s = scr + (8 * c) * 33 + n;
        u32x4 o; o.x = cvt_pk_bf16(s[0 * 33], s[1 * 33]); o.y = cvt_pk_bf16(s[2 * 33], s[3 * 33]); o.z = cvt_pk_bf16(s[4 * 33], s[5 * 33]); o.w = cvt_pk_bf16(s[6 * 33], s[7 * 33]);
        *(GAS u32x4*)(WT + (size_t)(n0 + n) * ldk + k0 + 8 * c) = o; }
    LDS_WAIT(); asm volatile("" ::: "memory");
}
__device__ __forceinline__ void tr_item64(const GAS float* __restrict__ W, int ldw, const GAS float* __restrict__ gain, GAS bf16* __restrict__ WT, int ldk, int k0, int n0src, int n0dst, LAS float* scr, int lane) {
    const int rr = lane >> 4, c4 = (lane & 15) * 4;
    f32x4 v[16];
#pragma unroll
    for (int i = 0; i < 16; ++i) v[i] = __builtin_nontemporal_load((const GAS f32x4*)(W + (size_t)(k0 + 4 * i + rr) * ldw + n0src + c4));
#pragma unroll
    for (int i = 0; i < 16; ++i) { const int k = 4 * i + rr; const float g = gain ? gain[k0 + k] : 1.f; LAS float* d = scr + k * 65 + c4;
        d[0] = v[i][0] * g; d[1] = v[i][1] * g; d[2] = v[i][2] * g; d[3] = v[i][3] * g; }
    LDS_WAIT(); asm volatile("" ::: "memory");
    const int kc = lane & 7;
#pragma unroll
    for (int j = 0; j < 8; ++j) { const int n = (lane >> 3) + 8 * j; const LAS float* sp = scr + (8 * kc) * 65 + n;
        u32x4 o; o.x = cvt_pk_bf16(sp[0 * 65], sp[1 * 65]); o.y = cvt_pk_bf16(sp[2 * 65], sp[3 * 65]); o.z = cvt_pk_bf16(sp[4 * 65], sp[5 * 65]); o.w = cvt_pk_bf16(sp[6 * 65], sp[7 * 65]);
        *(GAS u32x4*)(WT + (size_t)(n0dst + n) * ldk + k0 + 8 * kc) = o; }
    LDS_WAIT(); asm volatile("" ::: "memory");
}
__device__ __forceinline__ void tr_item64_f8(const GAS float* __restrict__ W, int ldw, const GAS float* __restrict__ gain, float scale, GAS unsigned char* __restrict__ WT8, int ldkB, int k0, int n0src, int n0dst, LAS float* scr, int lane) {
    const int rr = lane >> 4, c4 = (lane & 15) * 4;
    f32x4 v[16];
#pragma unroll
    for (int i = 0; i < 16; ++i) v[i] = __builtin_nontemporal_load((const GAS f32x4*)(W + (size_t)(k0 + 4 * i + rr) * ldw + n0src + c4));
#pragma unroll
    for (int i = 0; i < 16; ++i) { const int k = 4 * i + rr; const float g = (gain ? gain[k0 + k] : 1.f) * scale; LAS float* d = scr + k * 65 + c4;
        d[0] = v[i][0] * g; d[1] = v[i][1] * g; d[2] = v[i][2] * g; d[3] = v[i][3] * g; }
    LDS_WAIT(); asm volatile("" ::: "memory");
    const int kc = lane & 3;
#pragma unroll
    for (int j = 0; j < 4; ++j) { const int n = (lane >> 2) + 16 * j; const LAS float* sp = scr + (16 * kc) * 65 + n;
        u32x4 o; o.x = pk4_fp8(sp[0 * 65], sp[1 * 65], sp[2 * 65], sp[3 * 65]); o.y = pk4_fp8(sp[4 * 65], sp[5 * 65], sp[6 * 65], sp[7 * 65]); o.z = pk4_fp8(sp[8 * 65], sp[9 * 65], sp[10 * 65], sp[11 * 65]); o.w = pk4_fp8(sp[12 * 65], sp[13 * 65], sp[14 * 65], sp[15 * 65]);
        *(GAS u32x4*)(WT8 + (size_t)(n0dst + n) * ldkB + k0 + 16 * kc) = o; }
    LDS_WAIT(); asm volatile("" ::: "memory");
}
struct F8Item { const GAS float* W; int ldw; const GAS float* gain; GAS unsigned char* WT8; int ldkB, k0, n0src, n0dst; };
__device__ __forceinline__ void tr_load64(f32x4 (&v)[16], const F8Item& I, int lane) {
    const int rr = lane >> 4, c4 = (lane & 15) * 4;
#pragma unroll
    for (int i = 0; i < 16; ++i) v[i] = __builtin_nontemporal_load((const GAS f32x4*)(I.W + (size_t)(I.k0 + 4 * i + rr) * I.ldw + I.n0src + c4));
}
__device__ __forceinline__ void tr_finish64_f8(const f32x4 (&v)[16], const float (&gn)[16], const F8Item& I, float scale, LAS float* scr, int lane) {
    const int rr = lane >> 4, c4 = (lane & 15) * 4;
#pragma unroll
    for (int i = 0; i < 16; ++i) { const int k = 4 * i + rr; const float g = (I.gain ? gn[i] : 1.f) * scale; LAS float* d = scr + k * 65 + c4;
        d[0] = v[i][0] * g; d[1] = v[i][1] * g; d[2] = v[i][2] * g; d[3] = v[i][3] * g; }
    LDS_WAIT(); asm volatile("" ::: "memory");
    const int kc = lane & 3;
#pragma unroll
    for (int j = 0; j < 4; ++j) { const int n = (lane >> 2) + 16 * j; const LAS float* sp = scr + (16 * kc) * 65 + n;
        u32x4 o; o.x = pk4_fp8(sp[0 * 65], sp[1 * 65], sp[2 * 65], sp[3 * 65]); o.y = pk4_fp8(sp[4 * 65], sp[5 * 65], sp[6 * 65], sp[7 * 65]); o.z = pk4_fp8(sp[8 * 65], sp[9 * 65], sp[10 * 65], sp[11 * 65]); o.w = pk4_fp8(sp[12 * 65], sp[13 * 65], sp[14 * 65], sp[15 * 65]);
        *(GAS u32x4*)(I.WT8 + (size_t)(I.n0dst + n) * I.ldkB + I.k0 + 16 * kc) = o; }
    LDS_WAIT(); asm volatile("" ::: "memory");
}
__device__ __forceinline__ int rope_dim(int p) { const int a = p >> 3, j = p & 7; return j < 4 ? 4 * a + j : 16 + 4 * a + (j - 4); }

#define LDP(i) ((void*)((((unsigned long long)(unsigned)__builtin_amdgcn_readfirstlane((int)(ARGP[i] >> 32))) << 32) | (unsigned long long)(unsigned)__builtin_amdgcn_readfirstlane((int)(unsigned)ARGP[i])))
#define ARGIN(i) ((const void*)LDP(i))
#define P_COS ((GAS float*)(ws + WS_COS))
#define P_SIN ((GAS float*)(ws + WS_SIN))
#define P_SSQ ((GAS float*)(ws + WS_SSQ))
#define P_FLOG ((GAS float*)(ws + WS_FLOG))
#define P_E01 ((GAS int*)(ws + WS_E01))
#define P_G01 ((GAS float*)(ws + WS_G01))
#define P_SLOT ((GAS int*)(ws + WS_SLOT))
#define P_TOKOF ((GAS int*)(ws + WS_TOKOF))
#define P_GATEOF ((GAS float*)(ws + WS_GATEOF))
#define P_CNT ((GAS int*)(ws + WS_CNT))
#define P_TSTART ((GAS int*)(ws + WS_TSTART))
#define P_RSTD ((GAS float*)(ws + WS_RSTD))
#define P_RSTDOF ((GAS float*)(ws + WS_RSTDOF))
#define P_KPE ((GAS bf16*)(ws + WS_KPE))
#define P_KAUG ((GAS bf16*)(ws + WS_KAUG))
#define P_BIASF ((GAS float*)(ws + WS_BIASF))
#define P_NRM ((GAS float*)(ws + WS_NRM))
#define P_WR_L(l) ((GAS bf16*)(ws + ((l) ? WS_W1 + 7 * MiB : WS_WR)))
#define P_XR ((GAS bf16*)(ws + WS_XR))
#define P_OSS ((GAS float*)(ws + WS_OSS))
#define P_RSTDX ((GAS float*)(ws + WS_RSTDX))
#define P_WIN_L(l) ((GAS bf16*)(ws + ((l) ? WS_W1 : WS_WIN)))
#define P_WUQ_L(l) ((GAS bf16*)(ws + ((l) ? WS_W1 + 4 * MiB : WS_WUQ)))
#define P_WUKV_L(l) ((GAS bf16*)(ws + ((l) ? WS_W1 + 4 * MiB + 512 * KiB : WS_WUKV)))
#define P_WOUT_L(l) ((GAS bf16*)(ws + ((l) ? WS_W1 + 5 * MiB : WS_WOUT)))
#define P_WGU_L(ll) ((GAS unsigned char*)(ws + WS_WGU + (size_t)((ll) & 1) * 32 * MiB))
#define P_WD_L(ll) ((GAS unsigned char*)(ws + WS_WD + (size_t)((ll) & 1) * 16 * MiB))
#define P_XN ((GAS bf16*)(ws + WS_XN))
#define P_FQKV ((GAS bf16*)(ws + WS_FQKV))
#define P_HH ((GAS bf16*)(ws + WS_FQKV))
#define P_LAT ((GAS bf16*)(ws + WS_LAT))
#define P_QM ((GAS bf16*)(ws + WS_QM))
#define P_KVM ((GAS bf16*)(ws + WS_KVM))
#define P_Y ((GAS bf16*)(ws + WS_Y))
#define IN(k) (lo <= (k) && (k) < hi_)
#if MK_ONE_LAUNCH
#define GRID_BAR() xcd_barrier(bar)
#else
#define GRID_BAR() do {} while (0)
#endif
#define SEAM(k) do { if (IN(k) && IN((k) + 1)) GRID_BAR(); } while (0)
#if MK_ONE_LAUNCH
#define GROUP_BAR() xcd_barrier(gbar)
#else
#define GROUP_BAR() do {} while (0)
#endif
#define SEAMG(k) do { if (IN(k) && IN((k) + 1)) GROUP_BAR(); } while (0)
__device__ __forceinline__ void conv_gu_item(int r, const GAS float* w_gate, const GAS float* w_up, const GAS float* ffn_norm, GAS unsigned char* WGU, LAS float* scr64, int lane) {
    const int e = r / 256, q = r % 256, kb = q / 16, nb = q % 16; const int n0 = nb * 64; const int ct = n0 >> 8, which = (n0 >> 7) & 1, jj = n0 & 127;
    const GAS float* src = (which ? w_up : w_gate) + (size_t)e * DM * DEXP;
    tr_item64_f8(src, DEXP, ffn_norm, WSCALE, WGU + (size_t)e * 1024 * 1024, DM, kb * 64, ct * 128 + jj, n0, scr64, lane);
}
__device__ __forceinline__ F8Item gu_item(int r, const GAS float* w_gate, const GAS float* w_up, const GAS float* ffn_norm, GAS unsigned char* WGU) {
    const int e = r / 256, q = r % 256, kb = q / 16, nb = q % 16; const int n0 = nb * 64; const int ct = n0 >> 8, which = (n0 >> 7) & 1, jj = n0 & 127;
    return F8Item{(which ? w_up : w_gate) + (size_t)e * DM * DEXP, DEXP, ffn_norm, WGU + (size_t)e * 1024 * 1024, DM, kb * 64, ct * 128 + jj, n0};
}
__device__ __forceinline__ F8Item d_item(int r, const GAS float* w_down, GAS unsigned char* WD) {
    const int e = r / 128, q = r % 128, kb = q / 16, nb = q % 16;
    return F8Item{w_down + (size_t)e * DEXP * DM, DM, nullptr, WD + (size_t)e * 1024 * 512, DEXP, kb * 64, nb * 64, nb * 64};
}
__device__ __forceinline__ void conv_d_item(int r, const GAS float* w_down, GAS unsigned char* WD, LAS float* scr64, int lane) {
    const int e = r / 128, q = r % 128, kb = q / 16, nb = q % 16;
    tr_item64_f8(w_down + (size_t)e * DEXP * DM, DM, nullptr, WSCALE, WD + (size_t)e * 1024 * 512, DEXP, kb * 64, nb * 64, nb * 64, scr64, lane);
}
template <int LW, int GU0, int NGU, int D0, int ND>
__device__ __forceinline__ void conv_experts(LAS unsigned char* lds0, const int wave0, const int G0, const int bx0) {
    unsigned ldsb_ = (unsigned)(uintptr_t)lds0; asm volatile("" : "+s"(ldsb_)); LAS unsigned char* lds = (LAS unsigned char*)(uintptr_t)ldsb_; volatile LAS unsigned long long* ARGP = (volatile LAS unsigned long long*)(lds + MISC_OFF + 768);
    int wave = wave0, G = G0, bx = bx0; asm volatile("" : "+s"(G), "+s"(bx), "+s"(wave)); const int lane = (int)__builtin_amdgcn_mbcnt_hi(~0u, __builtin_amdgcn_mbcnt_lo(~0u, 0u)); const int vcu = (bx % 8) * (G / 8) + bx / 8;
    GAS unsigned char* ws = (GAS unsigned char*)LDP(22);
    LAS float* scr64 = (LAS float*)(lds + wave * 16640);
    const GAS float* ffn_norm = (const GAS float*)ARGIN(12) + (size_t)LW * DM;
    const GAS float* w_gate = (const GAS float*)ARGIN(17) + (size_t)LW * NEXP * DM * DEXP; const GAS float* w_up = (const GAS float*)ARGIN(18) + (size_t)LW * NEXP * DM * DEXP; const GAS float* w_down = (const GAS float*)ARGIN(19) + (size_t)LW * NEXP * DEXP * DM;
    asm volatile("s_waitcnt vmcnt(0)" ::: "memory"); __syncthreads();
    const int it0 = vcu + G * wave;
    constexpr int NI = NGU + ND;
    static_assert(GU0 % 256 == 0 && D0 % 128 == 0, "item ranges start at expert boundaries");
    f32x4 va[16], vb[16]; float gg[16]; F8Item Ia, Ib;
#pragma unroll
    for (int i = 0; i < 16; ++i) gg[i] = ffn_norm[(vcu >> 4) * 64 + 4 * i + (lane >> 4)];
    auto item = [&](int k) { return k < NGU ? gu_item(GU0 + it0 + G * 8 * k, w_gate, w_up, ffn_norm, P_WGU_L(LW)) : d_item(D0 + it0 + G * 8 * (k - NGU), w_down, P_WD_L(LW)); };
    Ia = item(0); tr_load64(va, Ia, lane);
#pragma unroll
    for (int k = 0; k < NI; k += 2) {
        if (k + 1 < NI) { Ib = item(k + 1); tr_load64(vb, Ib, lane); }
        tr_finish64_f8(va, gg, Ia, WSCALE, scr64, lane);
        if (k + 1 < NI) { if (k + 2 < NI) { Ia = item(k + 2); tr_load64(va, Ia, lane); } tr_finish64_f8(vb, gg, Ib, WSCALE, scr64, lane); }
    }
    __syncthreads();
}
constexpr int TAIL_GU = 4096, TAIL_D = 2048;
#define CONV_HERE() do { if constexpr (l == 0) conv_experts<0, 0, 4, 0, 2>(lds0, wave0, G0, bx0); else conv_experts<1, TAIL_GU, (8192 - TAIL_GU) / 2048, TAIL_D, (4096 - TAIL_D) / 2048>(lds0, wave0, G0, bx0); } while (0)
#define CONV_SLOT(k, sl) do { if (IN(P + (k)) && ((((bx0 % 8) * (G0 / 8) + bx0 / 8) >> 4) & 1) == (sl)) CONV_HERE(); } while (0)
template <int l>
__device__ __forceinline__ void layer_body(const int lo, const int hi_, LAS unsigned char* lds0, const int wave0, const int G0, const int bx0, const XcdBarrier& bar, const XcdBarrier& gbar) {
        const int P = 10 * l;
        if (IN(P)) for (int rep_ = 0; rep_ < (l == 0 ? NREP(0) : 1); ++rep_) {
            unsigned ldsb_ = (unsigned)(uintptr_t)lds0; asm volatile("" : "+s"(ldsb_)); LAS unsigned char* lds = (LAS unsigned char*)(uintptr_t)ldsb_; volatile LAS unsigned* MISC = (volatile LAS unsigned*)(lds + MISC_OFF); volatile LAS unsigned long long* ARGP = (volatile LAS unsigned long long*)(lds + MISC_OFF + 768); (void)MISC; int wave = wave0, G = G0, bx = bx0; asm volatile("" : "+s"(G), "+s"(bx), "+s"(wave)); const int lane = (int)__builtin_amdgcn_mbcnt_hi(~0u, __builtin_amdgcn_mbcnt_lo(~0u, 0u)); const int tid = wave * 64 + lane; const int vcu = (bx % 8) * (G / 8) + bx / 8; const int gw = vcu * 8 + wave, NGW = G * 8; (void)lane; (void)gw; (void)NGW; (void)vcu;
            GAS unsigned char* ws = (GAS unsigned char*)LDP(22); GAS float* out = (GAS float*)LDP(21); const GAS float* x_in = (const GAS float*)ARGIN(0); const GAS int* positions = (const GAS int*)ARGIN(1);
            if constexpr (l == 0) {
                LAS float* scr = (LAS float*)(lds + wave * 16640);
                constexpr int I_IN64 = 16 * 30, I_INS = 16 * 4, I_UQ = 4 * 24, I_UKV = 2 * 16, J_OUT = 16 * 16;
                constexpr int NITEMS = I_IN64 + I_INS + I_UQ + I_UKV + J_OUT;
                for (int it = vcu + G * wave; it < NLAYER * NITEMS; it += NGW) {
                    const int lw = it / NITEMS; int r = it % NITEMS; const int j = lane & 31;
                    if (r < I_IN64 + I_INS) { const GAS float* attn_norm = (const GAS float*)ARGIN(2) + (size_t)lw * DM; const GAS float* w_in = (const GAS float*)ARGIN(3) + (size_t)lw * DM * INW;
                        if (r < I_IN64) { const int kb = r / 30, q = r % 30, t = q < 6 ? q : q + 2; tr_item64(w_in, INW, attn_norm, P_WIN_L(lw), DM, kb * 64, t < 6 ? 64 * t : 416 + 64 * (t - 8), 64 * t, scr, lane); continue; }
                        r -= I_IN64; const int kb = r / 4, nb = 12 + r % 4; const int n = nb * 32 + j; int sc;
                        if (n < 416) sc = 384 + rope_dim(n - 384); else if (n < 424) sc = 1952 + (n - 416); else sc = -1;
                        tr_item(w_in, INW, DM, attn_norm, P_WIN_L(lw), DM, kb * 64, nb * 32, sc, scr, lane); continue; } r -= I_IN64 + I_INS;
                    if (r < I_UQ) { const GAS float* q_norm = (const GAS float*)ARGIN(5) + (size_t)lw * 256; const GAS float* w_uq = (const GAS float*)ARGIN(6) + (size_t)lw * 256 * 768;
                        const int kb = r / 24, nb = r % 24; const int n = nb * 32 + j; const int hh = n / 96, d = n % 96; const int sc = d < 64 ? n : hh * 96 + 64 + rope_dim(d - 64);
                        tr_item(w_uq, 768, 256, q_norm, P_WUQ_L(lw), 256, kb * 64, nb * 32, sc, scr, lane); continue; } r -= I_UQ;
                    if (r < I_UKV) { const GAS float* kv_norm = (const GAS float*)ARGIN(7) + (size_t)lw * 128; const GAS float* w_ukv = (const GAS float*)ARGIN(8) + (size_t)lw * 128 * 1024;
                        const int kb = r / 16, nb = r % 16; tr_item64(w_ukv, 1024, kv_norm, P_WUKV_L(lw), 256, kb * 64, nb * 64, nb * 64, scr, lane); continue; } r -= I_UKV;
                    { const GAS float* mla_on = (const GAS float*)ARGIN(9) + (size_t)lw * 512; const GAS float* fox_on = (const GAS float*)ARGIN(10) + (size_t)lw * 512; const GAS float* w_out = (const GAS float*)ARGIN(11) + (size_t)lw * DM * DM;
                        const int kb = r / 16, nb = r % 16; const GAS float* gn = kb < 8 ? mla_on : fox_on - 512; tr_item64(w_out, DM, gn, P_WOUT_L(lw), DM, kb * 64, nb * 64, nb * 64, scr, lane); }
                }
                for (int lw = 0; lw < NLAYER; ++lw) { const GAS float* ffn_norm = (const GAS float*)ARGIN(12) + (size_t)lw * DM; const GAS float* w_rg = (const GAS float*)ARGIN(13) + (size_t)lw * DM * 4; const GAS float* w_re = (const GAS float*)ARGIN(15) + (size_t)lw * DM * 32;
                  for (int idx = bx * 512 + tid; idx < 2 * 48 * 520; idx += G * 512) { const int half = idx / (48 * 520), r = idx % (48 * 520), c = r / 520, kk = r % 520; const int k = half * 512 + kk;
                      float w = 0.f; if (c < 36 && kk < 512) w = ffn_norm[k] * (c < 4 ? w_rg[k * 4 + c] : w_re[k * 32 + (c - 4)]);
                      const unsigned h16 = cvt_pk_bf16(w, 0.f) & 0xffffu; const unsigned l16 = cvt_pk_bf16(w - __uint_as_float(h16 << 16), 0.f) & 0xffffu;
                      P_WR_L(lw)[(size_t)(half * 2 + 0) * 48 * 520 + r] = (bf16)h16; P_WR_L(lw)[(size_t)(half * 2 + 1) * 48 * 520 + r] = (bf16)l16; } }
            }
            const GAS float* fin = (const GAS float*)ARGIN(20);
            if constexpr (l > 0 && l < NLAYER) {
                for (int mb = vcu * 128 + wave * 16; mb < vcu * 128 + wave * 16 + 16; mb += 4) {
                    u32x4 xw[4][2]; u32x2 ya[4][2], yc[4][2]; int s0[4], s1[4];
#pragma unroll
                    for (int r = 0; r < 4; ++r) { s0[r] = P_SLOT[2 * (mb + r)]; s1[r] = P_SLOT[2 * (mb + r) + 1]; }
#pragma unroll
                    for (int r = 0; r < 4; ++r)
#pragma unroll
                        for (int j = 0; j < 2; ++j) xw[r][j] = __builtin_nontemporal_load((const GAS u32x4*)(P_XR + (size_t)(mb + r) * DM + 8 * lane + 512 * j));
#pragma unroll
                    for (int r = 0; r < 4; ++r)
#pragma unroll
                        for (int j = 0; j < 2; ++j) { ya[r][j] = __builtin_nontemporal_load((const GAS u32x2*)((const GAS unsigned char*)P_Y + (size_t)s0[r] * 1024 + 8 * lane + 512 * j)); yc[r][j] = __builtin_nontemporal_load((const GAS u32x2*)((const GAS unsigned char*)P_Y + (size_t)s1[r] * 1024 + 8 * lane + 512 * j)); }
                    float v[4][2][8], ss[4];
#pragma unroll
                    for (int r = 0; r < 4; ++r) { float s_ = 0.f;
#pragma unroll
                        for (int j = 0; j < 2; ++j)
#pragma unroll
                            for (int h = 0; h < 2; ++h) { const unsigned wA = xw[r][j][2 * h], wB = xw[r][j][2 * h + 1]; const int a = (int)ya[r][j][h], c = (int)yc[r][j][h];
                                const f32x2 a0 = __builtin_amdgcn_cvt_pk_f32_fp8(a, false), a1 = __builtin_amdgcn_cvt_pk_f32_fp8(a, true), c0 = __builtin_amdgcn_cvt_pk_f32_fp8(c, false), c1 = __builtin_amdgcn_cvt_pk_f32_fp8(c, true);
                                float* o = &v[r][j][4 * h];
                                o[0] = __uint_as_float(wA << 16) + (a0[0] + c0[0]) * WSCALE_INV; o[1] = __uint_as_float(wA & 0xffff0000u) + (a0[1] + c0[1]) * WSCALE_INV; o[2] = __uint_as_float(wB << 16) + (a1[0] + c1[0]) * WSCALE_INV; o[3] = __uint_as_float(wB & 0xffff0000u) + (a1[1] + c1[1]) * WSCALE_INV;
                                s_ += (o[0] * o[0] + o[1] * o[1]) + (o[2] * o[2] + o[3] * o[3]); }
                        ss[r] = s_; }
#pragma unroll
                    for (int o = 1; o < 64; o <<= 1) {
#pragma unroll
                        for (int r = 0; r < 4; ++r) ss[r] += __shfl_xor(ss[r], o); }
#pragma unroll
                    for (int r = 0; r < 4; ++r) { const int m = mb + r;
#pragma unroll
                        for (int j = 0; j < 2; ++j) { u32x4 w; w.x = cvt_pk_bf16(v[r][j][0], v[r][j][1]); w.y = cvt_pk_bf16(v[r][j][2], v[r][j][3]); w.z = cvt_pk_bf16(v[r][j][4], v[r][j][5]); w.w = cvt_pk_bf16(v[r][j][6], v[r][j][7]); *(GAS u32x4*)(P_XR + (size_t)m * DM + 8 * lane + 512 * j) = w; }
                        if (lane == 0) P_RSTDX[m] = rsqrtf(ss[r] * (1.f / DM) + EPS); }
                }
            } else
            for (int mb = vcu * 128 + wave * 16; mb < vcu * 128 + wave * 16 + 16; mb += 4) {
                f32x4 v[4][4]; int s0[4], s1[4];
                if (l > 0) {
#pragma unroll
                    for (int r = 0; r < 4; ++r) { s0[r] = P_SLOT[2 * (mb + r)]; s1[r] = P_SLOT[2 * (mb + r) + 1]; }
                }
#pragma unroll
                for (int r = 0; r < 4; ++r) {
                    if (l == 0) { const GAS float* xr = x_in + (size_t)(mb + r) * DM;
#pragma unroll
                        for (int j = 0; j < 4; ++j) v[r][j] = __builtin_nontemporal_load((const GAS f32x4*)(xr + 4 * lane + 256 * j)); }
                    else { const GAS bf16* xr = P_XR + (size_t)(mb + r) * DM;
#pragma unroll
                        for (int j = 0; j < 4; ++j) { const u32x2 w = __builtin_nontemporal_load((const GAS u32x2*)(xr + 4 * lane + 256 * j)); v[r][j] = (f32x4){__uint_as_float(w.x << 16), __uint_as_float(w.x & 0xffff0000u), __uint_as_float(w.y << 16), __uint_as_float(w.y & 0xffff0000u)}; } } }
                if (l > 0) {
#pragma unroll
                    for (int r = 0; r < 4; ++r)
#pragma unroll
                        for (int j = 0; j < 4; ++j) { const int a = __builtin_nontemporal_load((const GAS int*)((const GAS unsigned char*)P_Y + (size_t)s0[r] * 1024 + 4 * lane + 256 * j)), c = __builtin_nontemporal_load((const GAS int*)((const GAS unsigned char*)P_Y + (size_t)s1[r] * 1024 + 4 * lane + 256 * j));
                            const f32x2 a0 = __builtin_amdgcn_cvt_pk_f32_fp8(a, false), a1 = __builtin_amdgcn_cvt_pk_f32_fp8(a, true), c0 = __builtin_amdgcn_cvt_pk_f32_fp8(c, false), c1 = __builtin_amdgcn_cvt_pk_f32_fp8(c, true);
                            v[r][j][0] += (a0[0] + c0[0]) * WSCALE_INV; v[r][j][1] += (a0[1] + c0[1]) * WSCALE_INV; v[r][j][2] += (a1[0] + c1[0]) * WSCALE_INV; v[r][j][3] += (a1[1] + c1[1]) * WSCALE_INV; }
                }
                float ss[4];
#pragma unroll
                for (int r = 0; r < 4; ++r) { float s = 0.f;
#pragma unroll
                    for (int j = 0; j < 4; ++j) s += (v[r][j][0] * v[r][j][0] + v[r][j][1] * v[r][j][1]) + (v[r][j][2] * v[r][j][2] + v[r][j][3] * v[r][j][3]);
                    ss[r] = s; }
#pragma unroll
                for (int o = 1; o < 64; o <<= 1) {
#pragma unroll
                    for (int r = 0; r < 4; ++r) ss[r] += __shfl_xor(ss[r], o); }
#pragma unroll
                for (int r = 0; r < 4; ++r) { const int m = mb + r; const float rstd = rsqrtf(ss[r] * (1.f / DM) + EPS);
                    if (l < NLAYER) {
#pragma unroll
                        for (int jp = 0; jp < 2; ++jp) {
                            u32x2 w0, w1; w0.x = cvt_pk_bf16(v[r][2 * jp][0], v[r][2 * jp][1]); w0.y = cvt_pk_bf16(v[r][2 * jp][2], v[r][2 * jp][3]); w1.x = cvt_pk_bf16(v[r][2 * jp + 1][0], v[r][2 * jp + 1][1]); w1.y = cvt_pk_bf16(v[r][2 * jp + 1][2], v[r][2 * jp + 1][3]);
                            const bool od = lane & 1; const u32x2 give = od ? w0 : w1;
                            u32x2 got; got.x = (unsigned)__builtin_amdgcn_update_dpp(0, (int)give.x, 0xB1, 0xf, 0xf, false); got.y = (unsigned)__builtin_amdgcn_update_dpp(0, (int)give.y, 0xB1, 0xf, 0xf, false);
                            const u32x4 o = od ? (u32x4){got.x, got.y, w1.x, w1.y} : (u32x4){w0.x, w0.y, got.x, got.y};
                            *(GAS u32x4*)(P_XR + (size_t)m * DM + 8 * (lane >> 1) + 256 * (2 * jp + (lane & 1))) = o; }
                        if (lane == 0) P_RSTDX[m] = rstd;
                    } else {
#pragma unroll
                        for (int j = 0; j < 4; ++j) { const f32x4 g = *(const GAS f32x4*)(fin + 4 * lane + 256 * j); __builtin_nontemporal_store(v[r][j] * rstd * g, (GAS f32x4*)(out + (size_t)m * DM + 4 * lane + 256 * j)); }
                    }
                }
            }
        }
        if constexpr (l == NLAYER) return;
        SEAM(P);
        if (IN(P + 1)) for (int rep_ = 0; rep_ < ((l == 0 || 1 != 5) ? NREP(1) : 1); ++rep_) {
            unsigned ldsb_ = (unsigned)(uintptr_t)lds0; asm volatile("" : "+s"(ldsb_)); LAS unsigned char* lds = (LAS unsigned char*)(uintptr_t)ldsb_; volatile LAS unsigned* MISC = (volatile LAS unsigned*)(lds + MISC_OFF); volatile LAS unsigned long long* ARGP = (volatile LAS unsigned long long*)(lds + MISC_OFF + 768); (void)MISC; int wave = wave0, G = G0, bx = bx0; asm volatile("" : "+s"(G), "+s"(bx), "+s"(wave)); const int lane = (int)__builtin_amdgcn_mbcnt_hi(~0u, __builtin_amdgcn_mbcnt_lo(~0u, 0u)); const int tid = wave * 64 + lane; const int vcu = (bx % 8) * (G / 8) + bx / 8; const int gw = vcu * 8 + wave, NGW = G * 8; (void)lane; (void)gw; (void)NGW; (void)vcu;
            GAS unsigned char* ws = (GAS unsigned char*)LDP(22); GAS float* out = (GAS float*)LDP(21); const GAS float* x_in = (const GAS float*)ARGIN(0); (void)out; (void)x_in; (void)ws;
            BatchOrder S{INP / 256, vcu, (const GAS char*)P_XR, (const GAS char*)P_WIN_L(l), (size_t)256 * DM * 2, (size_t)256 * DM * 2};
            EpiWin E{P_LAT, P_FQKV, P_KPE, P_FLOG, P_SSQ, P_COS, P_SIN, P_RSTDX};
            pg8::gemm_phase<EpiWin, BatchOrder, true, false>(tid, lds, DM * 2, DM * 2, DM * 2, S, E, nullptr);
        }
        SEAMG(P + 1);
        if (IN(P + 2)) for (int rep_ = 0; rep_ < ((l == 0 || 2 != 5) ? NREP(2) : 1); ++rep_) {
            unsigned ldsb_ = (unsigned)(uintptr_t)lds0; asm volatile("" : "+s"(ldsb_)); LAS unsigned char* lds = (LAS unsigned char*)(uintptr_t)ldsb_; volatile LAS unsigned* MISC = (volatile LAS unsigned*)(lds + MISC_OFF); volatile LAS unsigned long long* ARGP = (volatile LAS unsigned long long*)(lds + MISC_OFF + 768); (void)MISC; int wave = wave0, G = G0, bx = bx0; asm volatile("" : "+s"(G), "+s"(bx), "+s"(wave)); const int lane = (int)__builtin_amdgcn_mbcnt_hi(~0u, __builtin_amdgcn_mbcnt_lo(~0u, 0u)); const int tid = wave * 64 + lane; const int vcu = (bx % 8) * (G / 8) + bx / 8; const int gw = vcu * 8 + wave, NGW = G * 8; (void)lane; (void)gw; (void)NGW; (void)vcu;
            GAS unsigned char* ws = (GAS unsigned char*)LDP(22); GAS float* out = (GAS float*)LDP(21); const GAS float* x_in = (const GAS float*)ARGIN(0); (void)out; (void)x_in; (void)ws;
            {
                const int sq = vcu >> 1, hf = vcu & 1; const int b = sq >> 3, h = sq & 7; const float bf = ((const GAS float*)ARGIN(4))[l * 8 + h];
                const GAS float* fl = P_FLOG + ((size_t)b * SEQ + hf * 1024 + 2 * tid) * 8 + h;
                float lf[2], lg[2] = {0.f, 0.f};
#pragma unroll
                for (int e = 0; e < 2; ++e) { const float f = fl[e * 8] + bf; lf[e] = fminf(f, 0.f) - log1pf(expf(-fabsf(f))); }
                if (hf) {
#pragma unroll
                    for (int e = 0; e < 2; ++e) { const float f = fl[e * 8 - 1024 * 8] + bf; lg[e] = fminf(f, 0.f) - log1pf(expf(-fabsf(f))); } }
                const double s2 = (double)lf[0] + (double)lf[1];
                double incl = s2, first = (double)lg[0] + (double)lg[1];
#pragma unroll
                for (int o = 1; o < 64; o <<= 1) { const double t = __shfl_up(incl, o); if (lane >= o) incl += t; first += __shfl_xor(first, o); }
                LAS double* wtot = (LAS double*)lds;
                if (lane == 63) wtot[wave] = incl;
                if (lane == 0) wtot[8 + wave] = first;
                __syncthreads();
                double c = incl - s2;
                for (int w = 0; w < wave; ++w) c += wtot[w];
                if (hf) { for (int w = 0; w < 8; ++w) c += wtot[8 + w]; }
                const size_t t0 = ((size_t)b * 8 + h) * SEQ + hf * 1024 + 2 * tid;
                GAS u32x4* ka = (GAS u32x4*)(P_KAUG + t0 * 8);
                float xs[2];
#pragma unroll
                for (int e = 0; e < 2; ++e) { c += (double)lf[e]; const float x = (float)(-c * 1.4426950408889634); xs[e] = x;
                    const unsigned h16 = cvt_pk_bf16(x, 0.f) & 0xffffu; const float r1 = x - __uint_as_float(h16 << 16); const unsigned m16 = cvt_pk_bf16(r1, 0.f) & 0xffffu; const float r2 = r1 - __uint_as_float(m16 << 16); const unsigned l16 = cvt_pk_bf16(r2, 0.f) & 0xffffu;
                    ka[e] = (u32x4){h16 | (m16 << 16), l16, 0u, 0u}; P_BIASF[t0 + e] = x; }
                float qn = 0.f, kn = 0.f, xdm = INFINITY;
                { const GAS bf16* fqp = P_FQKV + ((size_t)b * SEQ + hf * 1024 + 2 * tid) * 512 + h * 64; const GAS bf16* fkp = fqp + (size_t)NTOK * 512;
#pragma unroll
                  for (int e = 0; e < 2; ++e) { float sq_ = 0.f, sk = 0.f, dd = 0.f;
#pragma unroll
                      for (int c8 = 0; c8 < 8; ++c8) { const u32x4 a = *(const GAS u32x4*)(fqp + e * 512 + c8 * 8), k4 = *(const GAS u32x4*)(fkp + e * 512 + c8 * 8);
#pragma unroll
                          for (int j = 0; j < 4; ++j) { const float a0 = __uint_as_float(a[j] << 16), a1 = __uint_as_float(a[j] & 0xffff0000u), k0 = __uint_as_float(k4[j] << 16), k1 = __uint_as_float(k4[j] & 0xffff0000u);
                              sq_ += a0 * a0 + a1 * a1; sk += k0 * k0 + k1 * k1; dd += a0 * k0 + a1 * k1; } }
                      qn = fmaxf(qn, sq_); kn = fmaxf(kn, sk); xdm = fminf(xdm, xs[e] + dd); } }
#pragma unroll
                for (int o = 1; o < 64; o <<= 1) { qn = fmaxf(qn, __shfl_xor(qn, o)); kn = fmaxf(kn, __shfl_xor(kn, o)); xdm = fminf(xdm, __shfl_xor(xdm, o)); }
                LAS float* knw = (LAS float*)(lds + 256);
                if (lane == 0) { knw[wave] = kn; knw[8 + wave] = qn; knw[16 + wave] = xdm; }
                __syncthreads();
                if (tid < 4) { P_NRM[sq * 32 + hf * 4 + tid] = sqrtf(fmaxf(knw[8 + 2 * tid], knw[8 + 2 * tid + 1])); P_NRM[sq * 32 + 16 + hf * 4 + tid] = fminf(knw[16 + 2 * tid], knw[16 + 2 * tid + 1]); }
                if (tid == 4) { float m = knw[0]; for (int w = 1; w < 8; ++w) m = fmaxf(m, knw[w]); P_NRM[sq * 32 + 8 + hf] = sqrtf(m); }
                __syncthreads();
            }
            UpOrder S{vcu, (const GAS char*)P_LAT, (const GAS char*)P_WUQ_L(l), (const GAS char*)P_WUKV_L(l)};
            EpiUp E{P_QM, P_KVM, P_SSQ, P_COS, P_SIN};
            pg8::gemm_phase<EpiUp, UpOrder, true, false, false, false, true>(tid, lds, 256 * 2, 512 * 2, 256 * 2, S, E, nullptr);
        }
        SEAMG(P + 2);
        CONV_SLOT(3, 0);
        if (IN(P + 3)) for (int rep_ = 0; rep_ < ((l == 0 || 3 != 5) ? NREP(3) : 1); ++rep_) {
            unsigned ldsb_ = (unsigned)(uintptr_t)lds0; asm volatile("" : "+s"(ldsb_)); LAS unsigned char* lds = (LAS unsigned char*)(uintptr_t)ldsb_; volatile LAS unsigned* MISC = (volatile LAS unsigned*)(lds + MISC_OFF); volatile LAS unsigned long long* ARGP = (volatile LAS unsigned long long*)(lds + MISC_OFF + 768); (void)MISC; int wave = wave0, G = G0, bx = bx0; asm volatile("" : "+s"(G), "+s"(bx), "+s"(wave)); const int lane = (int)__builtin_amdgcn_mbcnt_hi(~0u, __builtin_amdgcn_mbcnt_lo(~0u, 0u)); const int tid = wave * 64 + lane; const int vcu = (bx % 8) * (G / 8) + bx / 8; const int gw = vcu * 8 + wave, NGW = G * 8; (void)lane; (void)gw; (void)NGW; (void)vcu;
            GAS unsigned char* ws = (GAS unsigned char*)LDP(22); GAS float* out = (GAS float*)LDP(21); const GAS float* x_in = (const GAS float*)ARGIN(0); (void)out; (void)x_in; (void)ws;
            GAS bf16* O = P_XN;
            const int b = vcu >> 4, hh = (vcu & 15) >> 1, sub = vcu & 1;
            const att::Tens2 TM{P_QM, 768, P_KVM, 1024, P_KPE, P_KVM + 64, 1024, O, nullptr, nullptr, P_OSS};
            const att::Tens2 TF{P_FQKV, 512, P_FQKV + (size_t)NTOK * 512, 512, P_KAUG, P_FQKV + (size_t)2 * NTOK * 512, 512, O, P_BIASF, P_NRM, P_OSS};
#define QB_OF(i) ((((i) & 1) ? 7 - (2 * sub + ((i) >> 1)) : (2 * sub + ((i) >> 1))))
            int ts0, ts1, ts2, ts3;
            { const GAS float* bs = P_BIASF + ((long)b * 8 + hh) * SEQ; const GAS float* nr = P_NRM + (b * 8 + hh) * 32; const float kmx = fmaxf(nr[8], nr[9]);
#define FOX_TS(i, dst) do { const int qb_ = QB_OF(i), NT_ = 4 * qb_ + 4; const float Z_ = nr[qb_] * kmx * 1.001f + 0.01f; const float bend_ = bs[(lane < NT_ ? lane : NT_ - 1) * 64 + 63]; \
                  const bool skip_ = (lane < NT_ - 4) && (Z_ + bend_ - nr[16 + qb_] < -32.f); dst = __builtin_popcountll(__ballot(skip_)); } while (0)
              FOX_TS(0, ts0); FOX_TS(1, ts1); FOX_TS(2, ts2); FOX_TS(3, ts3);
#undef FOX_TS
            }
            if (wave >= 4) __builtin_amdgcn_s_setprio(1);
            bf16x8 qreg[6];
            { int sb = 0; for (int i = 0; i < 4; ++i) sb = att::attn_unit2<1>(wave, b, hh, QB_OF(i), TM, (LAS char*)lds, sb, i > 0, i < 3 ? QB_OF(i + 1) : -1, qreg, 0); }
            if ((b & 1) == 1) { __builtin_amdgcn_s_setprio(0); CONV_HERE(); if (wave >= 4) __builtin_amdgcn_s_setprio(1); }
            { int sb = 0; for (int i = 0; i < 4; ++i) { const int ts = i == 0 ? ts0 : i == 1 ? ts1 : i == 2 ? ts2 : ts3; sb = att::attn_unit2<0>(wave, b, hh, QB_OF(i), TF, (LAS char*)lds, sb, i > 0, i < 3 ? QB_OF(i + 1) : -1, qreg, ts); } }
#undef QB_OF
            __builtin_amdgcn_s_setprio(0);
        }
        SEAMG(P + 3);
        if (IN(P + 5)) for (int rep_ = 0; rep_ < ((l == 0 || 5 != 5) ? NREP(5) : 1); ++rep_) {
            unsigned ldsb_ = (unsigned)(uintptr_t)lds0; asm volatile("" : "+s"(ldsb_)); LAS unsigned char* lds = (LAS unsigned char*)(uintptr_t)ldsb_; volatile LAS unsigned* MISC = (volatile LAS unsigned*)(lds + MISC_OFF); volatile LAS unsigned long long* ARGP = (volatile LAS unsigned long long*)(lds + MISC_OFF + 768); (void)MISC; int wave = wave0, G = G0, bx = bx0; asm volatile("" : "+s"(G), "+s"(bx), "+s"(wave)); const int lane = (int)__builtin_amdgcn_mbcnt_hi(~0u, __builtin_amdgcn_mbcnt_lo(~0u, 0u)); const int tid = wave * 64 + lane; const int vcu = (bx % 8) * (G / 8) + bx / 8; const int gw = vcu * 8 + wave, NGW = G * 8; (void)lane; (void)gw; (void)NGW; (void)vcu;
            GAS unsigned char* ws = (GAS unsigned char*)LDP(22); GAS float* out = (GAS float*)LDP(21); const GAS float* x_in = (const GAS float*)ARGIN(0); (void)out; (void)x_in; (void)ws;
            BatchOrder S{DM / 256, vcu, (const GAS char*)P_XN, (const GAS char*)P_WOUT_L(l), (size_t)256 * DM * 2, (size_t)256 * DM * 2};
            EpiOut<false> E{x_in, P_XR};
            LAS f32x2* scl = (LAS f32x2*)(lds + pg8::STAGE_BYTES);
            { Unit u_; if (S.next(tid >> 8, u_)) { const GAS float* op = P_OSS + ((size_t)u_.pm * 256 + (tid & 255)) * 16;
                  const f32x4 a0 = *(const GAS f32x4*)op, a1 = *(const GAS f32x4*)(op + 4), c0 = *(const GAS f32x4*)(op + 8), c1 = *(const GAS f32x4*)(op + 12);
                  const float sm = ((a0[0] + a0[1]) + (a0[2] + a0[3])) + ((a1[0] + a1[1]) + (a1[2] + a1[3])), sf = ((c0[0] + c0[1]) + (c0[2] + c0[3])) + ((c1[0] + c1[1]) + (c1[2] + c1[3]));
                  const float rm_ = rsqrtf(sm * (1.f / 512.f) + EPS), rf_ = rsqrtf(sf * (1.f / 512.f) + EPS);
                  scl[tid] = (f32x2){rm_ / rf_, rf_}; } }
            __syncthreads();
            pg8::gemm_phase<EpiOut<false>, BatchOrder, true, false, false, true>(tid, lds, DM * 2, DM * 2, DM * 2, S, E, nullptr, scl);
        }
        SEAMG(P + 5);
        if (IN(P + 6)) for (int rep_ = 0; rep_ < ((l == 0 || 6 != 5) ? NREP(6) : 1); ++rep_) {
            unsigned ldsb_ = (unsigned)(uintptr_t)lds0; asm volatile("" : "+s"(ldsb_)); LAS unsigned char* lds = (LAS unsigned char*)(uintptr_t)ldsb_; volatile LAS unsigned* MISC = (volatile LAS unsigned*)(lds + MISC_OFF); volatile LAS unsigned long long* ARGP = (volatile LAS unsigned long long*)(lds + MISC_OFF + 768); (void)MISC; int wave = wave0, G = G0, bx = bx0; asm volatile("" : "+s"(G), "+s"(bx), "+s"(wave)); const int lane = (int)__builtin_amdgcn_mbcnt_hi(~0u, __builtin_amdgcn_mbcnt_lo(~0u, 0u)); const int tid = wave * 64 + lane; const int vcu = (bx % 8) * (G / 8) + bx / 8; const int gw = vcu * 8 + wave, NGW = G * 8; (void)lane; (void)gw; (void)NGW; (void)vcu;
            GAS unsigned char* ws = (GAS unsigned char*)LDP(22); GAS float* out = (GAS float*)LDP(21); const GAS float* x_in = (const GAS float*)ARGIN(0); (void)out; (void)x_in; (void)ws;
            GAS bf16* H2 = P_XN;
            LAS bf16* WT = (LAS bf16*)lds;
            LAS float* LG = (LAS float*)(lds + 99840) + wave * 576;
            const GAS float* b_rg = (const GAS float*)ARGIN(14) + l * 4; const GAS float* b_re = (const GAS float*)ARGIN(16) + l * 32;
            if (tid < 32) MISC[64 + tid] = 0u;
            const int r16 = lane & 15, g4 = lane >> 4;
            const int m0 = vcu * 128 + wave * 16;
            const GAS bf16* xrow = P_XR + (size_t)(m0 + r16) * DM + 8 * g4;
            f32x4 acc3[3]; acc3[0] = (f32x4){0.f, 0.f, 0.f, 0.f}; acc3[1] = acc3[0]; acc3[2] = acc3[0];
            float ssq = 0.f;
            for (int half = 0; half < 2; ++half) {
                __syncthreads();
                for (int idx = tid; idx < 2 * 48 * 520 / 8; idx += 512) *(LAS u32x4*)(WT + 8 * idx) = *(const GAS u32x4*)(P_WR_L(l) + (size_t)half * 2 * 48 * 520 + 8 * idx);
                __syncthreads();
                for (int s8 = 0; s8 < 16; s8 += 8) {
                    bf16x8 xv[8];
#pragma unroll
                    for (int u = 0; u < 8; ++u) xv[u] = *(const GAS bf16x8*)(xrow + half * 512 + 32 * (s8 + u));
                    u32x2 hwp = {0u, 0u};
#pragma unroll
                    for (int u = 0; u < 8; ++u) {
                        const u32x4 xw = __builtin_bit_cast(u32x4, xv[u]); float xf[8];
#pragma unroll
                        for (int j = 0; j < 4; ++j) { xf[2 * j] = __uint_as_float(xw[j] << 16); xf[2 * j + 1] = __uint_as_float(xw[j] & 0xffff0000u); }
                        u32x2 hw; hw.x = pk4_fp8(xf[0], xf[1], xf[2], xf[3]); hw.y = pk4_fp8(xf[4], xf[5], xf[6], xf[7]);
                        if (u & 1) {
                            const auto s0 = __builtin_amdgcn_permlane16_swap(hwp.x, hw.x, false, false), s1 = __builtin_amdgcn_permlane16_swap(hwp.y, hw.y, false, false);
                            *(GAS u32x4*)((GAS unsigned char*)H2 + (size_t)(m0 + r16) * DM + half * 512 + 32 * (s8 + u - 1 + (g4 & 1)) + 16 * (g4 >> 1)) = (u32x4){s0[0], s1[0], s0[1], s1[1]};
                        } else hwp = hw;
#pragma unroll
                        for (int j = 0; j < 8; ++j) ssq += xf[j] * xf[j];
                        const LAS bf16* wk = WT + r16 * 520 + 32 * (s8 + u) + 8 * g4;
#pragma unroll
                        for (int ct = 0; ct < 3; ++ct) { const bf16x8 bh = *(const LAS bf16x8*)(wk + ct * 16 * 520), bl = *(const LAS bf16x8*)(wk + (48 + ct * 16) * 520);
                            acc3[ct] = __builtin_amdgcn_mfma_f32_16x16x32_bf16(xv[u], bh, acc3[ct], 0, 0, 0); acc3[ct] = __builtin_amdgcn_mfma_f32_16x16x32_bf16(xv[u], bl, acc3[ct], 0, 0, 0); }
                    }
                }
            }
            ssq += __shfl_xor(ssq, 16); ssq += __shfl_xor(ssq, 32);
            const float rstd = rsqrtf(ssq * (1.f / DM) + EPS);
#pragma unroll
            for (int ct = 0; ct < 3; ++ct) { const int c = 16 * ct + r16; if (c < 36) {
#pragma unroll
                for (int rg = 0; rg < 4; ++rg) LG[(4 * g4 + rg) * 36 + c] = acc3[ct][rg]; } }
            LDS_WAIT();
            if (lane < 16) {
                const int m = m0 + lane; const LAS float* lg = LG + lane * 36;
                float gl[4];
#pragma unroll
                for (int g = 0; g < 4; ++g) gl[g] = lg[g] * rstd + b_rg[g];
                int gi = 0; float gm = gl[0];
#pragma unroll
                for (int g = 1; g < 4; ++g) if (gl[g] > gm) { gm = gl[g]; gi = g; }
                float gs = 0.f;
#pragma unroll
                for (int g = 0; g < 4; ++g) gs += __expf(gl[g] - gm);
                const float gval = 1.f / gs;
                float el[8];
#pragma unroll
                for (int j = 0; j < 8; ++j) el[j] = lg[4 + 8 * gi + j] * rstd + b_re[8 * gi + j];
                int i0 = 0; float mx0 = el[0];
#pragma unroll
                for (int j = 1; j < 8; ++j) if (el[j] > mx0) { mx0 = el[j]; i0 = j; }
                int i1 = -1; float mx1 = -INFINITY;
#pragma unroll
                for (int j = 0; j < 8; ++j) if (j != i0 && el[j] > mx1) { mx1 = el[j]; i1 = j; }
                const float e1 = __expf(mx1 - mx0); const float g0 = gval / (1.f + e1), g1 = gval * e1 / (1.f + e1);
                const int ea = gi * 8 + i0, eb = gi * 8 + i1; P_E01[2 * m] = ea; P_E01[2 * m + 1] = eb; P_G01[2 * m] = g0; P_G01[2 * m + 1] = g1; P_RSTD[m] = rstd;
                __hip_atomic_fetch_add((LAS unsigned*)(lds + MISC_OFF) + 64 + ea, 1u, __ATOMIC_RELAXED, __HIP_MEMORY_SCOPE_WORKGROUP); __hip_atomic_fetch_add((LAS unsigned*)(lds + MISC_OFF) + 64 + eb, 1u, __ATOMIC_RELAXED, __HIP_MEMORY_SCOPE_WORKGROUP);
            }
            __syncthreads();
            if (tid < 32) P_CNT[vcu * 32 + tid] = (int)MISC[64 + tid];
        }
        SEAM(P + 6);
        if (IN(P + 7)) for (int rep_ = 0; rep_ < ((l == 0 || 7 != 5) ? NREP(7) : 1); ++rep_) {
            unsigned ldsb_ = (unsigned)(uintptr_t)lds0; asm volatile("" : "+s"(ldsb_)); LAS unsigned char* lds = (LAS unsigned char*)(uintptr_t)ldsb_; volatile LAS unsigned* MISC = (volatile LAS unsigned*)(lds + MISC_OFF); volatile LAS unsigned long long* ARGP = (volatile LAS unsigned long long*)(lds + MISC_OFF + 768); (void)MISC; int wave = wave0, G = G0, bx = bx0; asm volatile("" : "+s"(G), "+s"(bx), "+s"(wave)); const int lane = (int)__builtin_amdgcn_mbcnt_hi(~0u, __builtin_amdgcn_mbcnt_lo(~0u, 0u)); const int tid = wave * 64 + lane; const int vcu = (bx % 8) * (G / 8) + bx / 8; const int gw = vcu * 8 + wave, NGW = G * 8; (void)lane; (void)gw; (void)NGW; (void)vcu;
            GAS unsigned char* ws = (GAS unsigned char*)LDP(22); GAS float* out = (GAS float*)LDP(21); const GAS float* x_in = (const GAS float*)ARGIN(0); (void)out; (void)x_in; (void)ws;
            LAS int* cnt_all = (LAS int*)lds;
            LAS int* pre_e = (LAS int*)(lds + 32768);
            LAS int* tot_e = pre_e + 32;
            LAS int* pst = pre_e + 64;
            LAS int* eL = pre_e + 128;
            for (int i = tid; i < 256 * 32; i += 512) cnt_all[i] = P_CNT[i];
            if (tid < 256) eL[tid] = P_E01[vcu * 256 + tid];
            __syncthreads();
            { LAS int* part = pre_e + 512;
              const int e = tid & 31, p = tid >> 5; int pre = 0, tot = 0;
#pragma unroll
              for (int j = 0; j < 16; ++j) { const int w = p * 16 + j; const int c = cnt_all[w * 32 + e]; pre += (w < vcu) ? c : 0; tot += c; }
              part[(p * 2) * 32 + e] = pre; part[(p * 2 + 1) * 32 + e] = tot; }
            __syncthreads();
            if (tid < 32) { LAS int* part = pre_e + 512; int pre = 0, tot = 0;
#pragma unroll
                for (int p = 0; p < 16; ++p) { pre += part[(p * 2) * 32 + tid]; tot += part[(p * 2 + 1) * 32 + tid]; } pre_e[tid] = pre; tot_e[tid] = tot; }
            __syncthreads();
            if (tid == 0) { int acc = 0; for (int e = 0; e < 32; ++e) { pst[e] = acc; acc += (tot_e[e] + 255) / 256 * 256; } pst[32] = acc; }
            __syncthreads();
            if (vcu == 0 && tid <= 32) P_TSTART[tid] = pst[tid] / 256;
            { LAS int* hist = pre_e + 2048;
              if (tid < 128) hist[tid] = 0;
              __syncthreads();
              int e = 0, rin = 0;
              if (tid < 256) { e = eL[tid]; unsigned long long mym = 0ull;
                  for (int x = 0; x < 32; ++x) { const unsigned long long bm = __ballot(e == x); if (e == x) mym = bm; }
                  rin = __builtin_popcountll(mym & ((1ull << lane) - 1ull));
                  if (rin == 0) hist[wave * 32 + e] = __builtin_popcountll(mym); }
              __syncthreads();
              if (tid < 256) { int r = rin; for (int w = 0; w < wave; ++w) r += hist[w * 32 + e];
                  const int slot = pst[e] + pre_e[e] + r; const int tok = vcu * 128 + (tid >> 1);
                  P_SLOT[vcu * 256 + tid] = slot; P_TOKOF[slot] = tok; P_GATEOF[slot] = P_G01[vcu * 256 + tid]; P_RSTDOF[slot] = P_RSTD[tok]; } }
            if (vcu < 32) { const int e = vcu; for (int s = pst[e] + tot_e[e] + tid; s < pst[e + 1]; s += 512) { P_TOKOF[s] = 0; P_GATEOF[s] = 0.f; P_RSTDOF[s] = 0.f; } }
            __syncthreads();
        }
        SEAM(P + 7);
        if (IN(P + 8)) for (int rep_ = 0; rep_ < ((l == 0 || 8 != 5) ? NREP(8) : 1); ++rep_) {
            unsigned ldsb_ = (unsigned)(uintptr_t)lds0; asm volatile("" : "+s"(ldsb_)); LAS unsigned char* lds = (LAS unsigned char*)(uintptr_t)ldsb_; volatile LAS unsigned* MISC = (volatile LAS unsigned*)(lds + MISC_OFF); volatile LAS unsigned long long* ARGP = (volatile LAS unsigned long long*)(lds + MISC_OFF + 768); (void)MISC; int wave = wave0, G = G0, bx = bx0; asm volatile("" : "+s"(G), "+s"(bx), "+s"(wave)); const int lane = (int)__builtin_amdgcn_mbcnt_hi(~0u, __builtin_amdgcn_mbcnt_lo(~0u, 0u)); const int tid = wave * 64 + lane; const int vcu = (bx % 8) * (G / 8) + bx / 8; const int gw = vcu * 8 + wave, NGW = G * 8; (void)lane; (void)gw; (void)NGW; (void)vcu;
            GAS unsigned char* ws = (GAS unsigned char*)LDP(22); GAS float* out = (GAS float*)LDP(21); const GAS float* x_in = (const GAS float*)ARGIN(0); (void)out; (void)x_in; (void)ws;
            volatile LAS int* TS = (volatile LAS int*)(MISC + 128);
            if (tid <= 32) TS[tid] = P_TSTART[tid];
            __syncthreads();
            MoeOrder S{G, vcu, TS, (const GAS char*)P_XN, (const GAS char*)P_WGU_L(l), 0, (size_t)1024 * 1024, (size_t)256 * 1024};
            EpiGU E{(GAS unsigned char*)P_HH, P_RSTDOF};
            pg8::gemm_phase<EpiGU, MoeOrder, true, true, true>(tid, lds, DM, DM, DM, S, E, P_TOKOF);
            if constexpr (l + 1 < NLAYER) {
                const int U = (int)TS[32] * 4, rem = U & 255; const int nidle = rem ? 256 - rem : 256, rk = rem ? vcu - rem : vcu;
                if (rk >= 0) { LAS float* scr64 = (LAS float*)(lds + wave * 16640);
                    const GAS float* w_gate = (const GAS float*)ARGIN(17) + (size_t)(l + 1) * NEXP * DM * DEXP; const GAS float* w_up = (const GAS float*)ARGIN(18) + (size_t)(l + 1) * NEXP * DM * DEXP; const GAS float* ffn1 = (const GAS float*)ARGIN(12) + (size_t)(l + 1) * DM;
                    for (int it = rk * 8 + wave; it < TAIL_GU; it += nidle * 8) conv_gu_item(it, w_gate, w_up, ffn1, P_WGU_L(l + 1), scr64, lane); }
            }
        }
        SEAM(P + 8);
        if (IN(P + 9)) for (int rep_ = 0; rep_ < ((l == 0 || 9 != 5) ? NREP(9) : 1); ++rep_) {
            unsigned ldsb_ = (unsigned)(uintptr_t)lds0; asm volatile("" : "+s"(ldsb_)); LAS unsigned char* lds = (LAS unsigned char*)(uintptr_t)ldsb_; volatile LAS unsigned* MISC = (volatile LAS unsigned*)(lds + MISC_OFF); volatile LAS unsigned long long* ARGP = (volatile LAS unsigned long long*)(lds + MISC_OFF + 768); (void)MISC; int wave = wave0, G = G0, bx = bx0; asm volatile("" : "+s"(G), "+s"(bx), "+s"(wave)); const int lane = (int)__builtin_amdgcn_mbcnt_hi(~0u, __builtin_amdgcn_mbcnt_lo(~0u, 0u)); const int tid = wave * 64 + lane; const int vcu = (bx % 8) * (G / 8) + bx / 8; const int gw = vcu * 8 + wave, NGW = G * 8; (void)lane; (void)gw; (void)NGW; (void)vcu;
            GAS unsigned char* ws = (GAS unsigned char*)LDP(22); GAS float* out = (GAS float*)LDP(21); const GAS float* x_in = (const GAS float*)ARGIN(0); (void)out; (void)x_in; (void)ws;
            volatile LAS int* TS = (volatile LAS int*)(MISC + 128);
            if (tid <= 32) TS[tid] = P_TSTART[tid];
            __syncthreads();
            MoeOrder S{G, vcu, TS, (const GAS char*)P_HH, (const GAS char*)P_WD_L(l), (size_t)256 * 512, (size_t)1024 * 512, (size_t)256 * 512};
            EpiDown E{(GAS unsigned char*)P_Y, P_GATEOF};
            pg8::gemm_phase<EpiDown, MoeOrder, true, false, true>(tid, lds, DEXP, DEXP, DEXP, S, E, nullptr);
            if constexpr (l + 1 < NLAYER) {
                const int U = (int)TS[32] * 4, rem = U & 255; const int nidle = rem ? 256 - rem : 256, rk = rem ? vcu - rem : vcu;
                if (rk >= 0) { LAS float* scr64 = (LAS float*)(lds + wave * 16640);
                    const GAS float* w_down = (const GAS float*)ARGIN(19) + (size_t)(l + 1) * NEXP * DEXP * DM;
                    for (int it = rk * 8 + wave; it < TAIL_D; it += nidle * 8) conv_d_item(it, w_down, P_WD_L(l + 1), scr64, lane); }
            }
        }
        SEAM(P + 9);
}

__global__ void __launch_bounds__(512, 2) fwd(Args args) {
    extern __shared__ __attribute__((aligned(16))) unsigned char lds_raw[];
    LAS unsigned char* lds0 = (LAS unsigned char*)lds_raw;
    const int tid0 = threadIdx.x; const int wave0 = __builtin_amdgcn_readfirstlane(tid0 >> 6);
    const int G0 = gridDim.x; const int bx0 = blockIdx.x;
    { volatile LAS unsigned* MISC = (volatile LAS unsigned*)(lds0 + MISC_OFF); const int tid = tid0;
    for (int u = tid; u < 256; u += 512) MISC[u] = 0u;
    __syncthreads();
    volatile LAS unsigned long long* ARGP = (volatile LAS unsigned long long*)(lds0 + MISC_OFF + 768);
    if (tid < 21) ARGP[tid] = (unsigned long long)args.in[tid];
    if (tid == 21) ARGP[21] = (unsigned long long)args.out;
    if (tid == 22) ARGP[22] = (unsigned long long)args.ws;
    __syncthreads(); }
#if MK_ONE_LAUNCH
    XcdBarrier bar = xcd_barrier_post((unsigned*)(args.ws + WS_CTL) + CW_BAR, (volatile LAS unsigned*)(lds0 + MISC_OFF) + 8, gridDim.x);
    const int vcu0 = (bx0 % 8) * (G0 / 8) + bx0 / 8;
    XcdBarrier gbar = xcd_barrier_post((unsigned*)(args.ws + WS_CTL) + CW_BAR + (1 + (vcu0 >> 4)) * XCD_BAR_WORDS, (volatile LAS unsigned*)(lds0 + MISC_OFF) + 12, 16u);
#else
    XcdBarrier bar; bar.bar = nullptr; bar.x = 0; bar.st = nullptr; bar.n = 0;
    XcdBarrier gbar = bar;
#endif
    const int lo = args.ph_lo, hi_ = args.ph_hi;
    if (IN(0)) {
        const GAS int* positions = (const GAS int*)args.in[1]; GAS float* COSp = (GAS float*)(args.ws + WS_COS); GAS float* SINp = (GAS float*)(args.ws + WS_SIN);
        for (int i = bx0 * 512 + tid0; i < NTOK * 16; i += G0 * 512) { const int tk = i >> 4, fi = i & 15;
            const double invrev = exp2(-(double)fi * (13.287712379549449 / 16.0)) * 0.15915494309189535; const double rev = (double)positions[tk] * invrev; const float fr = (float)(rev - rint(rev));
            COSp[i] = __builtin_amdgcn_cosf(fr); SINp[i] = __builtin_amdgcn_sinf(fr); }
    }
    layer_body<0>(lo, hi_, lds0, wave0, G0, bx0, bar, gbar);
    layer_body<1>(lo, hi_, lds0, wave0, G0, bx0, bar, gbar);
    layer_body<2>(lo, hi_, lds0, wave0, G0, bx0, bar, gbar);
}

extern "C" void kernel_launch(void* const* d_in, const int* in_sizes, int n_in, void* d_out, int out_size, void* d_ws, size_t ws_size, hipStream_t stream) {
    static int grid = 0;
    if (grid == 0) {
        if (n_in != 21 || out_size != NTOK * DM || ws_size < WS_END) { fprintf(stderr, "kernel_launch: unexpected shapes (n_in %d out %d ws %zu)\n", n_in, out_size, ws_size); grid = -1; return; }
        int dev = 0, cus = 0;
        if (hipGetDevice(&dev) != hipSuccess || hipDeviceGetAttribute(&cus, hipDeviceAttributeMultiprocessorCount, dev) != hipSuccess) { grid = -1; return; }
        if (hipFuncSetAttribute((const void*)fwd, hipFuncAttributeMaxDynamicSharedMemorySize, LDS_BYTES) != hipSuccess) { fprintf(stderr, "kernel_launch: hipFuncSetAttribute failed\n"); grid = -1; return; }
        int per_cu = 0;
        if (hipOccupancyMaxActiveBlocksPerMultiprocessor(&per_cu, (const void*)fwd, 512, LDS_BYTES) != hipSuccess || per_cu < 1) fprintf(stderr, "kernel_launch: occupancy query says %d\n", per_cu);
        (void)hipGetLastError();
        grid = cus;
        if (grid != 256) { fprintf(stderr, "kernel_launch: built for 256 CUs, got %d\n", grid); grid = -1; return; }
    }
    if (grid < 0) return;
    if (hipMemsetAsync((char*)d_ws + WS_CTL, 0, CTL_ZERO_BYTES, stream) != hipSuccess) return;
    Args a{};
    for (int i = 0; i < 21; ++i) a.in[i] = d_in[i];
    a.out = (float*)d_out; a.ws = (unsigned char*)d_ws;
#if MK_ONE_LAUNCH
    a.ph_lo = 0; a.ph_hi = 21;
    hipLaunchKernelGGL(fwd, dim3(grid), dim3(512), LDS_BYTES, stream, a);
#else
    for (int p = 0; p <= 20; ++p) { a.ph_lo = p; a.ph_hi = p + 1; hipLaunchKernelGGL(fwd, dim3(grid), dim3(512), LDS_BYTES, stream, a); }
#endif
}
```

```cpp
#include <hip/hip_runtime.h>
#include <cstdio>
#include <cstdint>

#ifndef PROBE_PHASE
#define PROBE_PHASE -1
#endif
#ifndef PROBE_LAYER
#define PROBE_LAYER -1
#endif
#define NREP(k) (((PROBE_PHASE) == (k) && ((PROBE_LAYER) < 0 || (PROBE_LAYER) == l)) ? 2 : 1)
#ifndef MK_ONE_LAUNCH
#define MK_ONE_LAUNCH 1
#endif

#define LAS __attribute__((address_space(3)))
#define GAS __attribute__((address_space(1)))
typedef unsigned short bf16;
typedef short bf16x8 __attribute__((ext_vector_type(8)));
typedef short s16x4 __attribute__((ext_vector_type(4)));
typedef float f32x4 __attribute__((ext_vector_type(4)));
typedef float f32x2 __attribute__((ext_vector_type(2)));
typedef float f32x16 __attribute__((ext_vector_type(16)));
typedef unsigned u32x4 __attribute__((ext_vector_type(4)));
typedef unsigned u32x2 __attribute__((ext_vector_type(2)));

constexpr int NB = 16, SEQ = 2048, DM = 1024, NTOK = NB * SEQ, NLAYER = 2;
constexpr int INW = 1960, INP = 2048;
constexpr int NEXP = 32, DEXP = 512;
constexpr int MAXSLOT = 73728;
constexpr float EPS = 1e-6f;
constexpr float WSCALE = 64.f, WSCALE_INV = 1.f / 64.f;
constexpr float LOG2E = 1.4426950408889634f;
constexpr float C2F = 0.125f * LOG2E;
constexpr float C2M = 0.10206207261596575f * LOG2E;

constexpr size_t MiB = 1u << 20, KiB = 1u << 10;
constexpr size_t WS_CTL = 0, CTL_ZERO_BYTES = 256 * KiB;
constexpr size_t WS_COS = 1 * MiB, WS_SIN = 3 * MiB;
constexpr size_t WS_SSQ = 5 * MiB;
constexpr size_t WS_FLOG = 6 * MiB;
constexpr size_t WS_E01 = 8 * MiB;
constexpr size_t WS_G01 = 8 * MiB + 256 * KiB;
constexpr size_t WS_SLOT = 8 * MiB + 512 * KiB;
constexpr size_t WS_TOKOF = 8 * MiB + 768 * KiB;
constexpr size_t WS_GATEOF = 9 * MiB + 256 * KiB;
constexpr size_t WS_CNT = 9 * MiB + 768 * KiB;
constexpr size_t WS_TSTART = 9 * MiB + 800 * KiB;
constexpr size_t WS_RSTD = 9 * MiB + 832 * KiB;
constexpr size_t WS_RSTDOF = 7 * MiB;
constexpr size_t WS_KPE = 10 * MiB;
constexpr size_t WS_KAUG = 10 * MiB + 2 * MiB;
constexpr size_t WS_WIN = 16 * MiB;
constexpr size_t WS_WUQ = 20 * MiB;
constexpr size_t WS_WUKV = 20 * MiB + 512 * KiB;
constexpr size_t WS_WOUT = 21 * MiB;
constexpr size_t WS_WGU = 24 * MiB;
constexpr size_t WS_WD = 88 * MiB;
constexpr size_t WS_XN = 120 * MiB;
constexpr size_t WS_FQKV = 184 * MiB;
constexpr size_t WS_LAT = 280 * MiB;
constexpr size_t WS_QM = 312 * MiB;
constexpr size_t WS_KVM = 360 * MiB;
constexpr size_t WS_Y = 280 * MiB;
constexpr size_t WS_BIASF = 424 * MiB;
constexpr size_t WS_NRM = 425 * MiB;
constexpr size_t WS_WR = 426 * MiB;
constexpr size_t WS_XR = 427 * MiB;
constexpr size_t WS_OSS = 491 * MiB;
constexpr size_t WS_RSTDX = 493 * MiB;
constexpr size_t WS_W1 = 494 * MiB;
constexpr size_t WS_END = 502 * MiB;
static_assert(WS_Y + (size_t)MAXSLOT * 1024 * 2 <= WS_END, "Y fits");
static_assert(WS_FQKV + (size_t)MAXSLOT * 512 * 2 <= WS_LAT, "HH fits");

constexpr int CW_BAR = 1024;
static_assert((size_t)(CW_BAR + 17 * 3456) * 4 <= CTL_ZERO_BYTES, "barrier words inside the zeroed control block");

constexpr int RING_BYTES = 147456;
constexpr int MISC_OFF = RING_BYTES;
constexpr int LDS_BYTES = RING_BYTES + 1024;

typedef __bf16 bf16x2_t __attribute__((ext_vector_type(2)));
__device__ __forceinline__ unsigned cvt_pk_bf16(float lo, float hi) { const f32x2 v = {lo, hi}; const bf16x2_t b = __builtin_convertvector(v, bf16x2_t); return __builtin_bit_cast(unsigned, b); }
__device__ __forceinline__ float bf2f(unsigned short b) { return __uint_as_float((unsigned)b << 16); }
__device__ __forceinline__ float wave_sum(float v) {
#pragma unroll
    for (int o = 1; o < 64; o <<= 1) v += __shfl_xor(v, o);
    return v;
}
__device__ __forceinline__ unsigned pk4_fp8(float a, float b, float c, float d) { int w = 0; w = __builtin_amdgcn_cvt_pk_fp8_f32(a, b, w, false); w = __builtin_amdgcn_cvt_pk_fp8_f32(c, d, w, true); return (unsigned)w; }
#define LDS_WAIT() asm volatile("s_waitcnt lgkmcnt(0)" ::: "memory")

#define XB_TMO      128
#define XB_XCNT(j)  (256  + 64 * (j))
#define XB_XSUB(j)  (1280 + 64 * (j))
#define XB_XGEN(j)  (2304 + 64 * (j))
#define XB_TOP      3328
#define XB_TOPGEN   3392
#define XCD_BAR_WORDS 3456
#define XB_SPIN_CAP (1u << 18)
__device__ __forceinline__ unsigned xb_ld(unsigned* p)              { return __hip_atomic_load(p, __ATOMIC_RELAXED, __HIP_MEMORY_SCOPE_AGENT); }
__device__ __forceinline__ unsigned xb_add(unsigned* p, unsigned v) { return __hip_atomic_fetch_add(p, v, __ATOMIC_RELAXED, __HIP_MEMORY_SCOPE_AGENT); }
__device__ __forceinline__ unsigned xb_xcc_id() { return (unsigned)__builtin_amdgcn_s_getreg((3 << 11) | 20) & 0xFu; }
#define XB_SPIN(cond, bar) do { unsigned _sp = 0; while (cond) { __builtin_amdgcn_s_sleep(1); \
    if ((++_sp & 255u) == 0u) { if (xb_ld(&(bar)[XB_TMO])) break; if (_sp > XB_SPIN_CAP) { atomicAdd(&(bar)[XB_TMO], 1u); break; } } } } while (0)
struct XcdBarrier { unsigned* bar; unsigned x; volatile LAS unsigned* st; unsigned n; };
__device__ __forceinline__ XcdBarrier xcd_barrier_post(unsigned* bar, volatile LAS unsigned* st, unsigned n) {
    XcdBarrier b; b.bar = bar; b.x = xb_xcc_id(); b.st = st; b.n = n;
    if (threadIdx.x == 0) (void)xb_add(&bar[XB_XCNT(b.x)], 1u);
    return b;
}
__device__ __forceinline__ void xcd_barrier_complete(unsigned* bar, unsigned x, unsigned G, unsigned& nloc, unsigned& nx) {
    unsigned sum, cnt, mine, sp = 0u;
    for (;;) {
        sum = 0u; cnt = 0u; mine = 0u;
#pragma unroll
        for (unsigned j = 0; j < 16; ++j) { const unsigned c = xb_ld(&bar[XB_XCNT(j)]); sum += c; cnt += (c > 0u) ? 1u : 0u; mine = (j == x) ? c : mine; }
        if (sum == G) break;
        __builtin_amdgcn_s_sleep(1);
        if ((++sp & 255u) == 0u) { if (xb_ld(&bar[XB_TMO])) break; if (sp > XB_SPIN_CAP) { atomicAdd(&bar[XB_TMO], 1u); break; } }
    }
    nloc = mine > 0u ? mine : 1u; nx = cnt > 0u ? cnt : 1u;
}
__device__ __forceinline__ void xcd_barrier(const XcdBarrier& b) {
    asm volatile("s_waitcnt vmcnt(0)" ::: "memory");
    __syncthreads();
    if (threadIdx.x == 0) {
        unsigned* bar = b.bar;
        __builtin_amdgcn_s_waitcnt(0);
        unsigned nloc = b.st[0], nx = b.st[1];
        if (nloc == 0u) { xcd_barrier_complete(bar, b.x, b.n, nloc, nx); b.st[0] = nloc; b.st[1] = nx; }
        const unsigned old = xb_add(&bar[XB_XSUB(b.x)], 1u);
        const unsigned gen = old / nloc;
        if (old + 1u == (gen + 1u) * nloc) {
            if (nx > 1u) { __builtin_amdgcn_fence(__ATOMIC_RELEASE, "agent");
                asm volatile("s_waitcnt vmcnt(0)" ::: "memory");
                const unsigned og = xb_add(&bar[XB_TOP], 1u);
                const unsigned tg = og / nx;
                if (og + 1u == (tg + 1u) * nx) xb_add(&bar[XB_TOPGEN], 1u);
                else XB_SPIN(xb_ld(&bar[XB_TOPGEN]) == tg, bar); }
            xb_add(&bar[XB_XGEN(b.x)], 1u);
            __builtin_amdgcn_fence(__ATOMIC_ACQUIRE, "agent");
            asm volatile("s_waitcnt vmcnt(0)" ::: "memory");
        } else {
            __builtin_amdgcn_fence(__ATOMIC_ACQUIRE, "agent");
            XB_SPIN(xb_ld(&bar[XB_XGEN(b.x)]) == gen, bar);
            asm volatile("s_waitcnt vmcnt(0)" ::: "memory");
        }
    }
    __syncthreads();
}

namespace pg8 {
constexpr int BM = 256, BK = 64, HALF = 128, HTB = HALF * BK * 2, STAGE_BYTES = 8 * HTB;
typedef int v4i32_t __attribute__((ext_vector_type(4)));
typedef int v8i32_t __attribute__((ext_vector_type(8)));
__host__ __device__ __forceinline__ int lds_byte(int r, int c) { const int st = (r >> 4) * 2 + (c >> 5), rr = r & 15, cc = c & 31, ob = rr * 64 + cc * 2; return st * 1024 + (ob ^ (((ob >> 9) & 1) << 5)); }
__host__ __device__ __forceinline__ void stage_rc(int b, int& R, int& C) { const int st = b / 1024, sb = b % 1024, swz = sb ^ (((sb >> 9) & 1) << 5); R = (st >> 1) * 16 + swz / 64; C = (st & 1) * 32 + (swz % 64) / 2; }
__host__ __device__ __forceinline__ int perm32(int rho) { const int n = rho >> 4, i = rho & 15; return 8 * (i >> 2) + 4 * n + (i & 3); }

struct Unit { const GAS char* a; const GAS char* b; int pm, pn, e; };

template <int N> __device__ __forceinline__ void wait_vm() { asm volatile("s_waitcnt vmcnt(%0)" :: "n"(N) : "memory"); }
template <class Epi, class Sched, bool ALIGN_EPI, bool GATHER, bool FP8 = false, bool MIDSCALE = false, bool VARK = false>
__device__ __forceinline__ void gemm_phase(const int tid, LAS unsigned char* lds, const int Kb, const int ldaB, const int ldbB, const Sched& S, const Epi& E, const GAS int* __restrict__ tokof, const LAS f32x2* scl = nullptr) {
    const int wid = __builtin_amdgcn_readfirstlane(tid >> 6), lane = tid & 63, wr = wid >> 2, wc = wid & 3, fr = lane & 15, fq = lane >> 4;
    const int nt = Kb / 128;
    unsigned voffA[2], voffB[2]; int RA[2], CA2[2];
#pragma unroll
    for (int i = 0; i < 2; ++i) { int R, C; stage_rc(tid * 16 + i * 8192, R, C); const int Rb = Epi::WIDE ? (64 * (R >> 5) + perm32(R & 31)) : Epi::PERM ? ((R & ~31) + perm32(R & 31)) : R;
        voffA[i] = (unsigned)(R * ldaB + C * 2); voffB[i] = (unsigned)(Rb * ldbB + C * 2); RA[i] = R; CA2[i] = C * 2; }
    const size_t kstep = (size_t)(BK * 2);
    const size_t hstepA = GATHER ? 0 : (size_t)HALF * ldaB;
    const size_t hstepB = (size_t)(Epi::WIDE ? 32 : HALF) * ldbB;
    const unsigned ldsw = (unsigned)wid * 1024u;
    const int aoff = lds_byte(wr * 64 + fr, fq * 8), boff = lds_byte(wc * 32 + fr, fq * 8);
    unsigned gcur[2][2], gnxt[2][2];
    const int scl8 = 0x7F7F7F7F;
#define PG8_SA(b, h) (((b) * 2 + (h)) * HTB)
#define PG8_SB(b, h) ((4 + (b) * 2 + (h)) * HTB)
#define PG8_STAGE(bufoff, gbase, voff) do { const unsigned long long gb_ = (unsigned long long)(gbase); const unsigned lbase_ = (unsigned)__builtin_amdgcn_readfirstlane((int)((unsigned)(uintptr_t)lds + (unsigned)(bufoff) + ldsw)); \
        _Pragma("unroll") for (int _i = 0; _i < 2; ++_i) { unsigned keep_; \
            asm volatile("s_mov_b32 %0, m0\n\ts_mov_b32 m0, %3\n\ts_nop 0\n\tglobal_load_lds_dwordx4 %1, %2\n\ts_mov_b32 m0, %0" : "=&s"(keep_) : "v"((voff)[_i]), "s"(gb_), "s"(lbase_ + (unsigned)(_i * 8192)) : "memory"); } } while (0)
#define PG8_STAGE_A(bufoff, base, h, nx) do { if constexpr (GATHER) { unsigned _v[2]; _v[0] = (nx) ? gnxt[h][0] : gcur[h][0]; _v[1] = (nx) ? gnxt[h][1] : gcur[h][1]; PG8_STAGE(bufoff, base, _v); } \
        else { PG8_STAGE(bufoff, (base) + (h) * hstepA, voffA); } } while (0)
#define PG8_LDA(dst, b, h) do { _Pragma("unroll") for (int m = 0; m < 4; ++m) _Pragma("unroll") for (int k = 0; k < 2; ++k) dst[m][k] = *(const LAS bf16x8*)(lds + PG8_SA(b, h) + aoff + m * 2048 + k * 1024); } while (0)
#define PG8_LDB(dst, b, h) do { _Pragma("unroll") for (int n = 0; n < 2; ++n) _Pragma("unroll") for (int k = 0; k < 2; ++k) dst[n][k] = *(const LAS bf16x8*)(lds + PG8_SB(b, h) + boff + n * 2048 + k * 1024); } while (0)
#define PG8_MMA(ai, bj, At, Bt) do { __builtin_amdgcn_s_setprio(1); if constexpr (FP8) { _Pragma("unroll") for (int m = 0; m < 4; ++m) _Pragma("unroll") for (int n = 0; n < 2; ++n) { \
        const v8i32_t b8_ = __builtin_shufflevector(__builtin_bit_cast(v4i32_t, Bt[n][0]), __builtin_bit_cast(v4i32_t, Bt[n][1]), 0, 1, 2, 3, 4, 5, 6, 7), a8_ = __builtin_shufflevector(__builtin_bit_cast(v4i32_t, At[m][0]), __builtin_bit_cast(v4i32_t, At[m][1]), 0, 1, 2, 3, 4, 5, 6, 7); \
        asm volatile("s_nop 1\n\tv_mfma_scale_f32_16x16x128_f8f6f4 %0, %1, %2, %0, %3, %3 op_sel_hi:[0,0,0]" : "+v"(acc[ai][bj][m][n]) : "v"(b8_), "v"(a8_), "v"(scl8)); } } \
      else { _Pragma("unroll") for (int m = 0; m < 4; ++m) _Pragma("unroll") for (int n = 0; n < 2; ++n) _Pragma("unroll") for (int k = 0; k < 2; ++k) \
        acc[ai][bj][m][n] = __builtin_amdgcn_mfma_f32_16x16x32_bf16(Bt[n][k], At[m][k], acc[ai][bj][m][n], 0, 0, 0); } __builtin_amdgcn_s_setprio(0); } while (0)
#define PG8_MMA_Z(ai, bj, At, Bt) do { __builtin_amdgcn_s_setprio(1); if constexpr (FP8) { _Pragma("unroll") for (int m = 0; m < 4; ++m) _Pragma("unroll") for (int n = 0; n < 2; ++n) { \
        const v8i32_t b8_ = __builtin_shufflevector(__builtin_bit_cast(v4i32_t, Bt[n][0]), __builtin_bit_cast(v4i32_t, Bt[n][1]), 0, 1, 2, 3, 4, 5, 6, 7), a8_ = __builtin_shufflevector(__builtin_bit_cast(v4i32_t, At[m][0]), __builtin_bit_cast(v4i32_t, At[m][1]), 0, 1, 2, 3, 4, 5, 6, 7); \
        asm volatile("s_nop 1\n\tv_mfma_scale_f32_16x16x128_f8f6f4 %0, %1, %2, 0, %3, %3 op_sel_hi:[0,0,0]" : "=&v"(acc[ai][bj][m][n]) : "v"(b8_), "v"(a8_), "v"(scl8)); } } \
      __builtin_amdgcn_s_setprio(0); } while (0)
#define PG8_WAIT_V(n) asm volatile("s_waitcnt vmcnt(" #n ")" ::: "memory")
#define PG8_WAIT_L(n) asm volatile("s_waitcnt lgkmcnt(" #n ")" ::: "memory")
#define PG8_BAR __builtin_amdgcn_s_barrier()
#define PG8_SCHED __builtin_amdgcn_sched_barrier(0)
#define PG8_GLOAD(dst, u) do { if constexpr (GATHER) { _Pragma("unroll") for (int _h = 0; _h < 2; ++_h) _Pragma("unroll") for (int _i = 0; _i < 2; ++_i) \
        dst[_h][_i] = (unsigned)tokof[(u).pm * BM + _h * HALF + RA[_i]] * (unsigned)ldaB + (unsigned)CA2[_i]; } } while (0)
    Unit cur, nxt; int ui = 0;
    if (!S.next(0, cur)) return;
    PG8_GLOAD(gcur, cur);
    typename Epi::Pre pre = E.prefetch(cur, wr, fr);
    f32x4 acc[2][2][4][2];
#pragma unroll
    for (int a = 0; a < 2; ++a)
#pragma unroll
        for (int b = 0; b < 2; ++b)
#pragma unroll
            for (int m = 0; m < 4; ++m)
#pragma unroll
                for (int n = 0; n < 2; ++n) acc[a][b][m][n] = (f32x4){0.f, 0.f, 0.f, 0.f};
    bf16x8 At[4][2], B0[2][2], B1[2][2];
    const GAS char* cA = cur.a; const GAS char* cB = cur.b;
    PG8_STAGE(PG8_SB(0, 0), cB, voffB); PG8_STAGE(PG8_SB(0, 1), cB + hstepB, voffB); PG8_STAGE_A(PG8_SA(0, 0), cA, 0, false); PG8_STAGE_A(PG8_SA(0, 1), cA, 1, false);
    if (wr == 1) PG8_BAR;
    PG8_WAIT_V(2); PG8_BAR;
    PG8_STAGE(PG8_SB(1, 0), cB + kstep, voffB); PG8_STAGE_A(PG8_SA(1, 0), cA + kstep, 0, false); PG8_STAGE(PG8_SB(1, 1), cB + hstepB + kstep, voffB);
    PG8_WAIT_V(6); PG8_BAR;
    bool fresh = false;
    for (;;) {
        const bool has_next = S.next(ui + 1, nxt);
        if constexpr (GATHER) { if (has_next) { PG8_GLOAD(gnxt, nxt); } else { _Pragma("unroll") for (int _h = 0; _h < 2; ++_h) _Pragma("unroll") for (int _i = 0; _i < 2; ++_i) gnxt[_h][_i] = gcur[_h][_i]; } }
        const GAS char* nA = has_next ? nxt.a : cA; const GAS char* nB = has_next ? nxt.b : cB;
        const int ntu = VARK ? (cur.e ? nt / 2 : nt) : nt;
#pragma nounroll
        for (int t = 0; t < ntu; t += 2) {
            const bool last = (t == ntu - 2);
            const GAS char* a1 = cA + (size_t)(t + 1) * kstep;
            const GAS char* a2 = last ? nA : cA + (size_t)(t + 2) * kstep; const GAS char* b2 = last ? nB : cB + (size_t)(t + 2) * kstep;
            const GAS char* a3 = a2 + kstep; const GAS char* b3 = b2 + kstep;
            const bool fe = fresh; fresh = false;
            if constexpr (MIDSCALE) { if (t == nt / 2) {
#pragma unroll
                for (int ai = 0; ai < 2; ++ai)
#pragma unroll
                    for (int m = 0; m < 4; ++m) { const float r_ = scl[ui * 256 + ai * 128 + wr * 64 + m * 16 + fr][0];
#pragma unroll
                        for (int bj = 0; bj < 2; ++bj)
#pragma unroll
                            for (int n = 0; n < 2; ++n) acc[ai][bj][m][n] *= r_; } } }
            PG8_LDB(B0, 0, 0); PG8_LDB(B1, 0, 1); PG8_SCHED; PG8_LDA(At, 0, 0); PG8_STAGE_A(PG8_SA(1, 1), a1, 1, false);
            if (fe) wait_vm<8 + Epi::NST>(); else PG8_WAIT_V(8); PG8_WAIT_L(0); PG8_BAR; if (FP8 && t == 0) { PG8_MMA_Z(0, 0, At, B0); PG8_MMA_Z(0, 1, At, B1); } else { PG8_MMA(0, 0, At, B0); PG8_MMA(0, 1, At, B1); } PG8_BAR; PG8_SCHED;
            PG8_LDA(At, 0, 1); PG8_STAGE(PG8_SB(0, 0), b2, voffB); PG8_STAGE(PG8_SB(0, 1), b2 + hstepB, voffB); PG8_STAGE_A(PG8_SA(0, 0), a2, 0, last);
            if (fe) wait_vm<8 + Epi::NST>(); else PG8_WAIT_V(8); PG8_WAIT_L(0); PG8_BAR; if (FP8 && t == 0) { PG8_MMA_Z(1, 0, At, B0); PG8_MMA_Z(1, 1, At, B1); } else { PG8_MMA(1, 0, At, B0); PG8_MMA(1, 1, At, B1); } PG8_BAR; PG8_SCHED;
            PG8_LDB(B0, 1, 0); PG8_LDB(B1, 1, 1); PG8_SCHED; PG8_LDA(At, 1, 0); PG8_STAGE_A(PG8_SA(0, 1), a2, 1, last);
            PG8_WAIT_V(8); PG8_WAIT_L(0); PG8_BAR; PG8_MMA(0, 0, At, B0); PG8_MMA(0, 1, At, B1); PG8_BAR; PG8_SCHED;
            PG8_LDA(At, 1, 1); PG8_STAGE(PG8_SB(1, 0), b3, voffB); PG8_STAGE(PG8_SB(1, 1), b3 + hstepB, voffB); PG8_STAGE_A(PG8_SA(1, 0), a3, 0, last);
            PG8_WAIT_V(8); PG8_WAIT_L(0); PG8_BAR; PG8_MMA(1, 0, At, B0); PG8_MMA(1, 1, At, B1); PG8_BAR; PG8_SCHED;
        }
        if constexpr (ALIGN_EPI) { if (wr == 0) PG8_BAR; }
        if constexpr (FP8) {
            asm volatile("s_nop 15\n\ts_nop 15" ::: "memory");
#pragma unroll
            for (int a = 0; a < 2; ++a)
#pragma unroll
                for (int b = 0; b < 2; ++b)
                    asm volatile("" : "+v"(acc[a][b][0][0]), "+v"(acc[a][b][0][1]), "+v"(acc[a][b][1][0]), "+v"(acc[a][b][1][1]), "+v"(acc[a][b][2][0]), "+v"(acc[a][b][2][1]), "+v"(acc[a][b][3][0]), "+v"(acc[a][b][3][1])); }
        if constexpr (MIDSCALE) E(acc, cur, wr, wc, fr, fq, scl + ui * 256); else E(acc, cur, wr, wc, fr, fq, pre);
        if (!has_next) break;
        pre = E.prefetch(nxt, wr, fr);
        if constexpr (FP8) {
#pragma unroll
            for (int a = 0; a < 2; ++a)
#pragma unroll
                for (int b = 0; b < 2; ++b)
                    asm volatile("" : "=v"(acc[a][b][0][0]), "=v"(acc[a][b][0][1]), "=v"(acc[a][b][1][0]), "=v"(acc[a][b][1][1]), "=v"(acc[a][b][2][0]), "=v"(acc[a][b][2][1]), "=v"(acc[a][b][3][0]), "=v"(acc[a][b][3][1]));
        } else {
#pragma unroll
            for (int a = 0; a < 2; ++a)
#pragma unroll
                for (int b = 0; b < 2; ++b)
#pragma unroll
                    for (int m = 0; m < 4; ++m)
#pragma unroll
                        for (int n = 0; n < 2; ++n) acc[a][b][m][n] = (f32x4){0.f, 0.f, 0.f, 0.f};
        }
        cur = nxt; cA = nA; cB = nB; ++ui; fresh = true;
        if constexpr (GATHER) { _Pragma("unroll") for (int _h = 0; _h < 2; ++_h) _Pragma("unroll") for (int _i = 0; _i < 2; ++_i) gcur[_h][_i] = gnxt[_h][_i]; }
        if constexpr (ALIGN_EPI) { if (wr == 1) PG8_BAR; }
    }
    PG8_WAIT_V(0);
    if constexpr (!ALIGN_EPI) { if (wr == 0) PG8_BAR; }
    PG8_BAR;
#undef PG8_SA
#undef PG8_SB
#undef PG8_STAGE
#undef PG8_STAGE_A
#undef PG8_LDA
#undef PG8_LDB
#undef PG8_MMA
#undef PG8_MMA_Z
#undef PG8_WAIT_V
#undef PG8_WAIT_L
#undef PG8_BAR
#undef PG8_SCHED
#undef PG8_GLOAD
}
}
using pg8::Unit;

struct BatchOrder {
    int nN, v; const GAS char* A; const GAS char* B; size_t aT, bT;
    __device__ __forceinline__ bool next(int i, Unit& u) const {
        const int uu = i * 16 + (v & 15); if (uu >= 8 * nN) return false;
        const int j_ = v & 15; const int pml_ = (nN == 8) ? 4 * (i >> 1) + (j_ >> 2) : uu / nN, pnl_ = (nN == 8) ? 4 * (i & 1) + (j_ & 3) : uu % nN;
        u.pm = __builtin_amdgcn_readfirstlane((v >> 4) * 8 + pml_); u.pn = __builtin_amdgcn_readfirstlane(pnl_); u.e = 0;
        u.a = A + (size_t)u.pm * aT; u.b = B + (size_t)u.pn * bT; return true;
    }
};
struct UpOrder {
    int v; const GAS char* LATp; const GAS char* Wq; const GAS char* Wkv;
    __device__ __forceinline__ bool next(int i, Unit& u) const {
        const int j = v & 15; const bool hi = j >= 8; if (i >= (hi ? 4 : 3)) return false;
        const bool kv = hi ? (i < 3) : (i == 2); u.pn = __builtin_amdgcn_readfirstlane(hi ? (kv ? 1 + i : 2) : (kv ? 0 : i)); u.e = __builtin_amdgcn_readfirstlane(kv ? 1 : 0); u.pm = __builtin_amdgcn_readfirstlane((v >> 4) * 8 + (j & 7));
        u.a = LATp + (size_t)u.pm * 256 * 512 * 2 + (u.e ? 512 : 0);
        u.b = (u.e ? Wkv : Wq) + (size_t)u.pn * 256 * 256 * 2; return true;
    }
};
struct MoeOrder {
    int G, c; const volatile LAS int* TS; const GAS char* A; const GAS char* W; size_t aT  , wE  , wT  ;
    __device__ __forceinline__ bool next(int i, Unit& u) const {
        const int L = i * G + c; const int ntile = __builtin_amdgcn_readfirstlane(TS[32]); if (L >= ntile * 4) return false;
        const int rt = L >> 2, ct = L & 3;
        const int ln_ = (int)__builtin_amdgcn_mbcnt_hi(~0u, __builtin_amdgcn_mbcnt_lo(~0u, 0u)); const int tsv_ = TS[ln_ & 31];
        const int e = __builtin_popcountll(__ballot(ln_ >= 1 && ln_ < 32 && tsv_ <= rt));
        u.pm = rt; u.pn = ct; u.e = e; u.a = A + (size_t)rt * aT; u.b = W + (size_t)e * wE + (size_t)ct * wT; return true;
    }
};

__device__ __forceinline__ u32x4 pack8(f32x4 v0, f32x4 v1) { u32x4 w; w.x = cvt_pk_bf16(v0[0], v0[1]); w.y = cvt_pk_bf16(v0[2], v0[3]); w.z = cvt_pk_bf16(v1[0], v1[1]); w.w = cvt_pk_bf16(v1[2], v1[3]); return w; }

__device__ __forceinline__ void wide_store(GAS bf16* p, long dB, bool lo, u32x4 X, u32x4 Y) {
    u32x4 Yr;
#pragma unroll
    for (int j = 0; j < 4; ++j) Yr[j] = (unsigned)__builtin_amdgcn_update_dpp(0, (int)Y[j], 0x128, 0xf, 0xf, false);
    u32x4 A, B;
#pragma unroll
    for (int j = 0; j < 4; ++j) { A[j] = lo ? X[j] : Yr[j]; B[j] = lo ? Yr[j] : X[j]; }
    *(GAS u32x4*)p = A; *(GAS u32x4*)(p + dB) = B;
}

struct EpiWin {
    static constexpr int NST = 16;
    static constexpr bool PERM = true, WIDE = true;
    GAS bf16* LAT_; GAS bf16* FQKV_; GAS bf16* KPE_; GAS float* FLOG_; GAS float* SSQ_; const GAS float* COS_; const GAS float* SIN_; const GAS float* RSX_;
    struct Pre { float v[8]; };
    __device__ __forceinline__ Pre prefetch(const Unit& u, int wr, int fr) const { Pre p; const GAS float* RSX = RSX_; asm volatile("" : "+s"(RSX));
#pragma unroll
        for (int g = 0; g < 8; ++g) p.v[g] = RSX[u.pm * 256 + (g >> 2) * 128 + wr * 64 + (g & 3) * 16 + fr]; return p; }
    __device__ __forceinline__ void operator()(f32x4 (&acc)[2][2][4][2], const Unit& u, int wr, int wc, int fr, int fq, const Pre& pre) const {
        GAS bf16* LAT = LAT_; GAS bf16* FQKV = FQKV_; GAS bf16* KPE = KPE_; GAS float* FLOG = FLOG_; GAS float* SSQ = SSQ_; const GAS float* COS = COS_; const GAS float* SIN = SIN_; const GAS float* RSX = RSX_;
        asm volatile("" : "+s"(LAT), "+s"(FQKV), "+s"(KPE), "+s"(FLOG), "+s"(SSQ), "+s"(COS), "+s"(SIN), "+s"(RSX));
        {
#pragma unroll
            for (int ai = 0; ai < 2; ++ai)
#pragma unroll
                for (int m = 0; m < 4; ++m) { const float rs_ = pre.v[ai * 4 + m];
#pragma unroll
                    for (int bj = 0; bj < 2; ++bj)
#pragma unroll
                        for (int n = 0; n < 2; ++n) acc[ai][bj][m][n] *= rs_; } }
        const int row0 = u.pm * 256 + wr * 64 + fr; const int pn = u.pn;
        const bool lo = fr < 8; const int roww = u.pm * 256 + wr * 64 + (fr & 7), colw = wc * 64 + (fr >> 3) * 32 + 8 * fq; const long dB = 8 * 512 + (lo ? 32 : -32);
        if (pn >= 2) {
            const int ti = pn >> 1; GAS bf16* dst = FQKV + (size_t)(ti - 1) * NTOK * 512 + (pn & 1) * 256 + colw; const float sc = (ti == 1) ? C2F : 1.f;
#pragma unroll
            for (int ai = 0; ai < 2; ++ai)
#pragma unroll
                for (int m = 0; m < 4; ++m) wide_store(dst + (size_t)(roww + ai * 128 + m * 16) * 512, dB, lo, pack8(acc[ai][0][m][0] * sc, acc[ai][0][m][1] * sc), pack8(acc[ai][1][m][0] * sc, acc[ai][1][m][1] * sc));
        } else {
#pragma unroll
            for (int ai = 0; ai < 2; ++ai)
#pragma unroll
                for (int m = 0; m < 4; ++m) { const int row = row0 + ai * 128 + m * 16;
                    if (pn == 0 || wc != 2) wide_store(LAT + (size_t)(roww + ai * 128 + m * 16) * 512 + pn * 256 + colw, dB, lo, pack8(acc[ai][0][m][0], acc[ai][0][m][1]), pack8(acc[ai][1][m][0], acc[ai][1][m][1]));
                    float s = 0.f;
                    if (pn == 0 || wc < 2) {
#pragma unroll
                        for (int bj = 0; bj < 2; ++bj)
#pragma unroll
                            for (int n = 0; n < 2; ++n) { const f32x4 x = acc[ai][bj][m][n]; s += (x[0] * x[0] + x[1] * x[1]) + (x[2] * x[2] + x[3] * x[3]); }
                    }
                    s += __shfl_xor(s, 16); s += __shfl_xor(s, 32);
                    if (fq == 0) SSQ[(size_t)row * 8 + pn * 4 + wc] = s;
                    }
            if (pn == 1 && wc == 2) {
#pragma unroll
                for (int ai = 0; ai < 2; ++ai)
#pragma unroll
                    for (int m = 0; m < 4; ++m) { const int row = row0 + ai * 128 + m * 16;
                        const f32x4 c = *(const GAS f32x4*)(COS + (size_t)row * 16 + 4 * fq), sn = *(const GAS f32x4*)(SIN + (size_t)row * 16 + 4 * fq);
                        const f32x4 x1 = acc[ai][0][m][0], x2 = acc[ai][0][m][1];
                        *(GAS u32x4*)(KPE + (size_t)row * 32 + 8 * fq) = pack8(x1 * c - x2 * sn, x1 * sn + x2 * c);
                        }
            }
            if (pn == 1 && wc == 2 && fq == 0) {
#pragma unroll
                for (int ai = 0; ai < 2; ++ai)
#pragma unroll
                    for (int m = 0; m < 4; ++m) { const int row = row0 + ai * 128 + m * 16; *(GAS f32x4*)(FLOG + (size_t)row * 8) = acc[ai][1][m][0]; *(GAS f32x4*)(FLOG + (size_t)row * 8 + 4) = acc[ai][1][m][1]; }
            }
        }
    }
};
struct EpiUp {
    static constexpr int NST = 16;
    static constexpr bool PERM = true, WIDE = true;
    GAS bf16* QM_; GAS bf16* KVM_; const GAS float* SSQ_; const GAS float* COS_; const GAS float* SIN_;
    struct Pre { f32x4 v[8]; };
    __device__ __forceinline__ Pre prefetch(const Unit& u, int wr, int fr) const { Pre p; const GAS float* SSQ = SSQ_; asm volatile("" : "+s"(SSQ)); const int off = u.e ? 4 : 0;
#pragma unroll
        for (int g = 0; g < 8; ++g) p.v[g] = *(const GAS f32x4*)(SSQ + (size_t)(u.pm * 256 + (g >> 2) * 128 + wr * 64 + (g & 3) * 16 + fr) * 8 + off); return p; }
    __device__ __forceinline__ void operator()(const f32x4 (&acc)[2][2][4][2], const Unit& u, int wr, int wc, int fr, int fq, const Pre& pre) const {
        GAS bf16* QM = QM_; GAS bf16* KVM = KVM_; const GAS float* SSQ = SSQ_; const GAS float* COS = COS_; const GAS float* SIN = SIN_;
        asm volatile("" : "+s"(QM), "+s"(KVM), "+s"(SSQ), "+s"(COS), "+s"(SIN));
        const int row0 = u.pm * 256 + wr * 64 + fr; const int pn = u.pn; const bool kv = u.e != 0;
        const bool lo = fr < 8; const int roww = u.pm * 256 + wr * 64 + (fr & 7), colw = pn * 256 + wc * 64 + (fr >> 3) * 32 + 8 * fq;
        float ssv[8];
#pragma unroll
        for (int g = 0; g < 8; ++g) { const f32x4 sq = pre.v[g]; ssv[g] = (sq[0] + sq[1]) + (sq[2] + sq[3]); }
        if (kv) {
#pragma unroll
            for (int ai = 0; ai < 2; ++ai)
#pragma unroll
                for (int m = 0; m < 4; ++m) { const float rs = rsqrtf(ssv[ai * 4 + m] * (1.f / 128.f) + EPS);
                    wide_store(KVM + (size_t)(roww + ai * 128 + m * 16) * 1024 + colw, 8 * 1024 + (lo ? 32 : -32), lo, pack8(acc[ai][0][m][0] * rs, acc[ai][0][m][1] * rs), pack8(acc[ai][1][m][0] * rs, acc[ai][1][m][1] * rs)); }
        } else {
            const int gm = (8 * pn + 2 * wc) % 3;
            f32x4 cw[8], sw[8];
            if (gm != 0) {
#pragma unroll
                for (int g = 0; g < 8; ++g) { const int row = row0 + (g >> 2) * 128 + (g & 3) * 16; cw[g] = *(const GAS f32x4*)(COS + (size_t)row * 16 + 4 * fq); sw[g] = *(const GAS f32x4*)(SIN + (size_t)row * 16 + 4 * fq); }
            }
#pragma unroll
            for (int ai = 0; ai < 2; ++ai)
#pragma unroll
                for (int m = 0; m < 4; ++m) { const float rs = rsqrtf(ssv[ai * 4 + m] * (1.f / 256.f) + EPS) * C2M;
                    u32x4 XY[2];
#pragma unroll
                    for (int bj = 0; bj < 2; ++bj) { f32x4 v0 = acc[ai][bj][m][0] * rs, v1 = acc[ai][bj][m][1] * rs;
                        if (gm == 2 - bj) { const f32x4 c = cw[ai * 4 + m], sn = sw[ai * 4 + m]; const f32x4 x1 = v0, x2 = v1; v0 = x1 * c - x2 * sn; v1 = x1 * sn + x2 * c; }
                        XY[bj] = pack8(v0, v1); }
                    wide_store(QM + (size_t)(roww + ai * 128 + m * 16) * 768 + colw, 8 * 768 + (lo ? 32 : -32), lo, XY[0], XY[1]); }
        }
    }
};
template <bool RES_F32> struct EpiOut {
    static constexpr int NST = 16;
    static constexpr bool PERM = true, WIDE = true;
    const GAS float* resf_; GAS bf16* xr_;
    struct Pre {}; __device__ __forceinline__ Pre prefetch(const Unit&, int, int) const { return Pre{}; }
    __device__ __forceinline__ void operator()(const f32x4 (&acc)[2][2][4][2], const Unit& u, int wr, int wc, int fr, int fq, const LAS f32x2* scl) const {
        const GAS float* resf = resf_; GAS bf16* xr = xr_; asm volatile("" : "+s"(resf), "+s"(xr));
        const int row0 = u.pm * 256 + wr * 64 + fr, col0 = u.pn * 256 + wc * 64 + 8 * fq;
        const bool lo = fr < 8; const int roww = u.pm * 256 + wr * 64 + (fr & 7), colw = u.pn * 256 + wc * 64 + (fr >> 3) * 32 + 8 * fq;
#pragma unroll
        for (int ai = 0; ai < 2; ++ai)
#pragma unroll
            for (int m = 0; m < 4; ++m) { const size_t off = (size_t)(row0 + ai * 128 + m * 16) * DM + col0; const float sh = scl[ai * 128 + wr * 64 + m * 16 + fr][1];
                u32x4 XY[2];
#pragma unroll
                for (int bj = 0; bj < 2; ++bj) { f32x4 r0, r1;
                    if constexpr (RES_F32) { r0 = *(const GAS f32x4*)(resf + off + bj * 32); r1 = *(const GAS f32x4*)(resf + off + bj * 32 + 4); }
                    else { const u32x4 w = *(const GAS u32x4*)(xr + off + bj * 32);
                        r0 = (f32x4){__uint_as_float(w.x << 16), __uint_as_float(w.x & 0xffff0000u), __uint_as_float(w.y << 16), __uint_as_float(w.y & 0xffff0000u)};
                        r1 = (f32x4){__uint_as_float(w.z << 16), __uint_as_float(w.z & 0xffff0000u), __uint_as_float(w.w << 16), __uint_as_float(w.w & 0xffff0000u)}; }
                    XY[bj] = pack8(r0 + acc[ai][bj][m][0] * sh, r1 + acc[ai][bj][m][1] * sh); }
                wide_store(xr + (size_t)(roww + ai * 128 + m * 16) * DM + colw, 8 * DM + (lo ? 32 : -32), lo, XY[0], XY[1]); }
    }
};
struct EpiGU {
    static constexpr int NST = 4;
    static constexpr bool PERM = true, WIDE = false;
    GAS unsigned char* HH_; const GAS float* RS_;
    struct Pre { float v[8]; };
    __device__ __forceinline__ Pre prefetch(const Unit& u, int wr, int fr) const { Pre p; const GAS float* RS = RS_; asm volatile("" : "+s"(RS));
#pragma unroll
        for (int g = 0; g < 8; ++g) p.v[g] = RS[u.pm * 256 + (g >> 2) * 128 + wr * 64 + (g & 3) * 16 + fr]; return p; }
    __device__ __forceinline__ void operator()(const f32x4 (&acc)[2][2][4][2], const Unit& u, int wr, int wc, int fr, int fq, const Pre& pre) const {
        GAS unsigned char* HH = HH_; const GAS float* RS = RS_; asm volatile("" : "+s"(HH), "+s"(RS));
        const int row0 = u.pm * 256 + wr * 64 + fr;
#pragma unroll
        for (int ai = 0; ai < 2; ++ai)
#pragma unroll
            for (int mp = 0; mp < 2; ++mp) {
                u32x2 w[2];
#pragma unroll
                for (int q = 0; q < 2; ++q) { const int m = 2 * mp + q; const float rs = pre.v[ai * 4 + m] * WSCALE_INV; const float k1 = -rs * LOG2E, rs2 = rs * rs;
                    f32x4 h[2];
#pragma unroll
                    for (int n = 0; n < 2; ++n) { const f32x4 tg = acc[ai][0][m][n] * k1, gu = acc[ai][0][m][n] * acc[ai][1][m][n];
#pragma unroll
                        for (int j = 0; j < 4; ++j) h[n][j] = gu[j] * (rs2 * __builtin_amdgcn_rcpf(1.f + __builtin_amdgcn_exp2f(tg[j]))); }
                    w[q].x = pk4_fp8(h[0][0], h[0][1], h[0][2], h[0][3]); w[q].y = pk4_fp8(h[1][0], h[1][1], h[1][2], h[1][3]); }
                const auto s0 = __builtin_amdgcn_permlane16_swap(w[0].x, w[1].x, false, false), s1 = __builtin_amdgcn_permlane16_swap(w[0].y, w[1].y, false, false);
                *(GAS u32x4*)(HH + (size_t)(row0 + ai * 128 + (2 * mp + (fq & 1)) * 16) * 512 + u.pn * 128 + wc * 32 + (fq >> 1) * 16) = (u32x4){s0[0], s1[0], s0[1], s1[1]}; }
    }
};
struct EpiDown {
    static constexpr int NST = 8;
    static constexpr bool PERM = true, WIDE = true;
    GAS unsigned char* Y_; const GAS float* GATEOF_;
    struct Pre { float v[8]; };
    __device__ __forceinline__ Pre prefetch(const Unit& u, int wr, int fr) const { Pre p; const GAS float* GT = GATEOF_; asm volatile("" : "+s"(GT));
#pragma unroll
        for (int g = 0; g < 8; ++g) p.v[g] = GT[u.pm * 256 + (g >> 2) * 128 + wr * 64 + (g & 3) * 16 + fr]; return p; }
    __device__ __forceinline__ void operator()(const f32x4 (&acc)[2][2][4][2], const Unit& u, int wr, int wc, int fr, int fq, const Pre& pre) const {
        GAS unsigned char* Y = Y_; const GAS float* GATEOF = GATEOF_; asm volatile("" : "+s"(Y), "+s"(GATEOF));
        const int row0 = u.pm * 256 + wr * 64 + fr;
#pragma unroll
        for (int ai = 0; ai < 2; ++ai)
#pragma unroll
            for (int m = 0; m < 4; ++m) { const int row = row0 + ai * 128 + m * 16; const float g = pre.v[ai * 4 + m];
                u32x2 w[2];
#pragma unroll
                for (int bj = 0; bj < 2; ++bj) { const f32x4 v0 = acc[ai][bj][m][0] * g, v1 = acc[ai][bj][m][1] * g; w[bj].x = pk4_fp8(v0[0], v0[1], v0[2], v0[3]); w[bj].y = pk4_fp8(v1[0], v1[1], v1[2], v1[3]); }
                const auto s0 = __builtin_amdgcn_permlane16_swap(w[0].x, w[1].x, false, false), s1 = __builtin_amdgcn_permlane16_swap(w[0].y, w[1].y, false, false);
                *(GAS u32x4*)(Y + (size_t)row * 1024 + u.pn * 256 + wc * 64 + (fq & 1) * 32 + (fq >> 1) * 16) = (u32x4){s0[0], s1[0], s0[1], s1[1]}; }
    }
};

struct TTrue { static constexpr bool value = true; }; struct TFalse { static constexpr bool value = false; };
namespace att {
constexpr int KSLOT = 12288, VSLOT = 8192;
constexpr int L_K = 0, L_V = 2 * KSLOT, L_BIAS = L_V + 2 * VSLOT, L_WS = L_BIAS + 8192, L_OST = L_WS + 8 * 64 * 4, L_END = L_OST + 8 * 4096;
__device__ __forceinline__ int crow(int r, int hi) { return (r & 3) + 8 * (r >> 2) + 4 * hi; }
typedef short v4i16_t __attribute__((ext_vector_type(4)));
__device__ __forceinline__ s16x4 vtr(const LAS char* p) { return __builtin_bit_cast(s16x4, __builtin_amdgcn_ds_read_tr16_b64_v4i16((LAS v4i16_t*)p)); }

constexpr int NSL = 5;
constexpr int R_K = 0, R_V = NSL * KSLOT, R_WS = R_V + NSL * VSLOT, R_OST = R_WS + 8 * 64 * 4, R_END = R_OST + 8 * 4096;
static_assert(R_END <= RING_BYTES, "attention LDS");
__device__ __forceinline__ void glds16(const GAS void* gsrc, unsigned lds_dst) { unsigned keep;
    asm volatile("s_mov_b32 %0, m0\n\ts_mov_b32 m0, %2\n\ts_nop 0\n\tglobal_load_lds_dwordx4 %1, off\n\ts_mov_b32 m0, %0" : "=&s"(keep) : "v"(gsrc), "s"(lds_dst) : "memory"); }
__device__ __forceinline__ void glds16s(const GAS void* sbase, unsigned voff, unsigned lds_dst) { unsigned keep;
    asm volatile("s_mov_b32 %0, m0\n\ts_mov_b32 m0, %3\n\ts_nop 0\n\tglobal_load_lds_dwordx4 %1, %2\n\ts_mov_b32 m0, %0" : "=&s"(keep) : "v"(voff), "s"((unsigned long long)sbase), "s"(lds_dst) : "memory"); }
struct Tens2 { const GAS bf16* Q; int qp; const GAS bf16* K; int kp; const GAS bf16* KX; const GAS bf16* V; int vp; GAS bf16* O; const GAS float* BIASF; const GAS float* NRM; GAS float* OSS; };
template <int MODE>
__device__ __forceinline__ int attn_unit2(const int wave_, int b, int h, int qb, const Tens2& T, LAS char* shm, const int slbase, const bool have_pro, const int qb_next, bf16x8 (&qr)[6], const int tstart) {
    constexpr int DKS = MODE ? 6 : 5, DKH = 3;
    constexpr float THR = 8.f;
    int wid = wave_; asm volatile("" : "+s"(wid));
    unsigned z0_ = 0u; asm volatile("" : "+s"(z0_));
    int lane = (int)__builtin_amdgcn_mbcnt_hi(~0u, __builtin_amdgcn_mbcnt_lo(~0u, z0_)); const int r32 = lane & 31, hi = lane >> 5;
    const long rowbase = (long)b * SEQ; const int q0 = qb * 256, qw0 = q0 + wid * 32;
    const int NT = (q0 + 256) / 64, tlast = qw0 / 64;
    const int NTE = NT - tstart;
    const GAS bf16* Qw = T.Q + (rowbase + qw0) * T.qp + h * (MODE ? 96 : 64);
    const GAS bf16* Kh = T.K + rowbase * T.kp + h * (MODE ? 128 : 64);
    const GAS bf16* Vh = T.V + rowbase * T.vp + h * (MODE ? 128 : 64);
    LAS float* wsf = (LAS float*)(shm + R_WS) + wid * 64;
    const GAS bf16* xbase = MODE ? T.KX + rowbase * 32 : T.KX + ((long)b * 8 + h) * SEQ * 8;
    const int xstep = MODE ? 64 * 32 : 64 * 8;
    const unsigned kdst_a = (unsigned)(uintptr_t)(shm + R_K) + (unsigned)wid * 1024u, xdst_a = (unsigned)(uintptr_t)(shm + R_K) + (unsigned)(8 + (MODE ? (wid & 3) : 0)) * 1024u, vdst_a = (unsigned)(uintptr_t)(shm + R_V) + (unsigned)wid * 1024u;
    const unsigned koff = (unsigned)(lane * T.kp + wid * 8) * 2u;
    const unsigned xoff = MODE ? (unsigned)(lane * 32 + (wid & 3) * 8) * 2u : (unsigned)(lane * 8) * 2u;
    const unsigned voff = (unsigned)((16 * (wid & 3) + (lane >> 2)) * T.vp + (wid >> 2) * 32 + (lane & 3) * 8) * 2u;
#define A2_DMA(t, slot) do { \
        glds16s((const GAS void*)(Kh + (long)(t) * 64 * T.kp), koff, (unsigned)__builtin_amdgcn_readfirstlane((int)(kdst_a + (slot) * KSLOT))); \
        glds16s((const GAS void*)(xbase + (long)(t) * xstep), xoff, (unsigned)__builtin_amdgcn_readfirstlane((int)(xdst_a + (slot) * KSLOT))); \
        glds16s((const GAS void*)(Vh + (long)(t) * 64 * T.vp), voff, (unsigned)__builtin_amdgcn_readfirstlane((int)(vdst_a + (slot) * VSLOT))); } while (0)
    constexpr bool SUMM = false;
    const LAS char* vp0 = shm + R_V + ((lane >> 4) & 1) * 32 + (lane & 3) * 8 + (4 * hi + ((lane & 15) >> 2)) * 64;
    float mhat = 0.f, lrun = 0.f; f32x16 o[2]; o[0] = f32x16{}; o[1] = f32x16{};
    bf16x8 qaug;
    auto set_ref = [&](const float mh_) { const float nm_ = -mh_; const unsigned h16_ = cvt_pk_bf16(nm_, 0.f) & 0xffffu; const float r1_ = nm_ - __uint_as_float(h16_ << 16); const unsigned m16_ = cvt_pk_bf16(r1_, 0.f) & 0xffffu; const float r2_ = r1_ - __uint_as_float(m16_ << 16); const unsigned l16_ = cvt_pk_bf16(r2_, 0.f) & 0xffffu;
        const bf16x8 z_ = (bf16x8){0, 0, 0, 0, 0, 0, 0, 0};
        if (MODE == 0) qaug = hi ? z_ : (bf16x8){(short)0x3F80, (short)0x3F80, (short)0x3F80, (short)h16_, (short)m16_, (short)l16_, 0, 0};
        else qaug = hi ? z_ : (bf16x8){(short)h16_, (short)m16_, (short)l16_, 0, 0, 0, 0, 0}; };
    set_ref(0.f);
    f32x16 lsum = f32x16{}; const bf16x8 ones = (bf16x8){(short)0x3F80, (short)0x3F80, (short)0x3F80, (short)0x3F80, (short)0x3F80, (short)0x3F80, (short)0x3F80, (short)0x3F80};
#define A3_SLOT(k) ((slbase + (k)) % NSL)
    if (!have_pro) { A2_DMA(NT - 1, A3_SLOT(0)); A2_DMA(NT - 2, A3_SLOT(1)); A2_DMA(NT - 3, A3_SLOT(2)); }
    if (!have_pro) {
#pragma unroll
        for (int d0 = 0; d0 < (MODE ? 6 : 4); ++d0) qr[d0] = *(const GAS bf16x8*)(Qw + (long)r32 * T.qp + d0 * 16 + hi * 8); }
#pragma unroll
    for (int d0 = 0; d0 < (MODE ? 6 : 4); ++d0) asm volatile("" : "+v"(qr[d0]));
#define A3_KLOADH(slot, H) do { const LAS char* kb_ = shm + R_K + (slot) * KSLOT + r32 * 16; _Pragma("unroll") for (int d0 = (H) * DKH; d0 < ((H) ? DKS : DKH); ++d0) { const int off = (MODE == 0 && d0 == 4) ? 8 * 1024 : d0 * 2048 + hi * 1024; \
        kf[2 * (d0 - (H) * DKH)] = *(const LAS bf16x8*)(kb_ + off); kf[2 * (d0 - (H) * DKH) + 1] = *(const LAS bf16x8*)(kb_ + off + 512); } } while (0)
#define A3_VLOAD(slot) do { const LAS char* vp_ = vp0 + (slot) * VSLOT; _Pragma("unroll") for (int q = 0; q < 8; ++q) { vlo[q] = vtr(vp_ + (q >> 2) * 4096 + (q & 3) * 1024); vhh[q] = vtr(vp_ + (q >> 2) * 4096 + (q & 3) * 1024 + 512); } } while (0)
#define A3_QKH(H) do { if ((H) == 0) { c0 = f32x16{}; c1 = f32x16{}; } _Pragma("unroll") for (int d0 = (H) * DKH; d0 < ((H) ? DKS : DKH); ++d0) { const bf16x8 qf_ = (MODE == 0 && d0 == DKS - 1) ? qaug : qr[d0]; c0 = __builtin_amdgcn_mfma_f32_32x32x16_bf16(kf[2 * (d0 - (H) * DKH)], qf_, c0, 0, 0, 0); c1 = __builtin_amdgcn_mfma_f32_32x32x16_bf16(kf[2 * (d0 - (H) * DKH) + 1], qf_, c1, 0, 0, 0); } \
        if (MODE == 1 && (H) == 1) { c0 = __builtin_amdgcn_mfma_f32_32x32x16_bf16(ones, qaug, c0, 0, 0, 0); c1 = __builtin_amdgcn_mfma_f32_32x32x16_bf16(ones, qaug, c1, 0, 0, 0); } } while (0)
#define A3_EXP() do { float ls_ = 0.f; _Pragma("unroll") for (int r = 0; r < 16; ++r) { pp0[r] = __builtin_amdgcn_exp2f(pp0[r]); pp1[r] = __builtin_amdgcn_exp2f(pp1[r]); if constexpr (!SUMM) ls_ += pp0[r] + pp1[r]; } lrun += ls_; u32x4 w_; \
        w_.x = cvt_pk_bf16(pp0[0], pp0[1]); w_.y = cvt_pk_bf16(pp0[2], pp0[3]); w_.z = cvt_pk_bf16(pp0[4], pp0[5]); w_.w = cvt_pk_bf16(pp0[6], pp0[7]); pa[0] = __builtin_bit_cast(bf16x8, w_); \
        w_.x = cvt_pk_bf16(pp0[8], pp0[9]); w_.y = cvt_pk_bf16(pp0[10], pp0[11]); w_.z = cvt_pk_bf16(pp0[12], pp0[13]); w_.w = cvt_pk_bf16(pp0[14], pp0[15]); pa[1] = __builtin_bit_cast(bf16x8, w_); \
        w_.x = cvt_pk_bf16(pp1[0], pp1[1]); w_.y = cvt_pk_bf16(pp1[2], pp1[3]); w_.z = cvt_pk_bf16(pp1[4], pp1[5]); w_.w = cvt_pk_bf16(pp1[6], pp1[7]); pa[2] = __builtin_bit_cast(bf16x8, w_); \
        w_.x = cvt_pk_bf16(pp1[8], pp1[9]); w_.y = cvt_pk_bf16(pp1[10], pp1[11]); w_.z = cvt_pk_bf16(pp1[12], pp1[13]); w_.w = cvt_pk_bf16(pp1[14], pp1[15]); pa[3] = __builtin_bit_cast(bf16x8, w_); } while (0)
#define A3_PV() do { _Pragma("unroll") for (int d0 = 0; d0 < 2; ++d0) _Pragma("unroll") for (int k = 0; k < 4; ++k) { const s16x4 lo_ = vlo[4 * d0 + k], hh_ = vhh[4 * d0 + k]; \
        const bf16x8 vf_ = (bf16x8){lo_[0], lo_[1], lo_[2], lo_[3], hh_[0], hh_[1], hh_[2], hh_[3]}; o[d0] = __builtin_amdgcn_mfma_f32_32x32x16_bf16(pa[k], vf_, o[d0], 0, 0, 0); } \
        if constexpr (SUMM) { _Pragma("unroll") for (int k = 0; k < 4; ++k) lsum = __builtin_amdgcn_mfma_f32_32x32x16_bf16(pa[k], ones, lsum, 0, 0, 0); } } while (0)
#define A3_ROWMAX(rm) do { float a_ = fmaxf(fmaxf(c0[0], c0[1]), c1[0]), b_ = fmaxf(fmaxf(c0[2], c0[3]), c1[1]); a_ = fmaxf(fmaxf(a_, c1[2]), c1[3]); \
        _Pragma("unroll") for (int r = 4; r < 16; r += 4) { a_ = fmaxf(fmaxf(a_, c0[r]), c0[r + 1]); b_ = fmaxf(fmaxf(b_, c0[r + 2]), c0[r + 3]); a_ = fmaxf(fmaxf(a_, c1[r]), c1[r + 1]); b_ = fmaxf(fmaxf(b_, c1[r + 2]), c1[r + 3]); } \
        rm = fmaxf(a_, b_); const auto rr_ = __builtin_amdgcn_permlane32_swap(__float_as_uint(rm), __float_as_uint(rm), false, false); rm = fmaxf(__uint_as_float(rr_[0]), __uint_as_float(rr_[1])); } while (0)
    int sl = A3_SLOT(0), sl3 = A3_SLOT(3);
    f32x16 pp0 = f32x16{}, pp1 = f32x16{}; bool pend = false; int pslot = 0;
#define A3_ISSUE(i_) do { if ((i_) + 3 < NTE) A2_DMA(NT - 1 - (i_) - 3, sl3); } while (0)
#define A3_NEXTUNIT() do { if (qb_next >= 0) { const int NTn = 4 * qb_next + 4; A2_DMA(NTn - 1, A3_SLOT(NTE)); A2_DMA(NTn - 2, A3_SLOT(NTE + 1)); A2_DMA(NTn - 3, A3_SLOT(NTE + 2)); } } while (0)
#define A3_MIDBAR() do { if constexpr (LATE) { if (i < NTE - 1) { if (i + 2 < NTE) asm volatile("s_waitcnt vmcnt(3)" ::: "memory"); else asm volatile("s_waitcnt vmcnt(0)" ::: "memory");        \
            __builtin_amdgcn_s_barrier(); asm volatile("" ::: "memory"); } } } while (0)
#define A3_LATEISSUE() do { if constexpr (LATE) { if (i < NTE - 1) { A3_ISSUE(i); if (i == NTE - 2) A3_NEXTUNIT(); } } } while (0)
    auto run = [&](auto late_c) {
    constexpr bool LATE = decltype(late_c)::value;
    for (int i = 0; i < NTE; ++i) {
        const int t = NT - 1 - i;
        if (!LATE || i == 0) {
            const int ahead = NTE - 1 - i;
            if (ahead >= 2) asm volatile("s_waitcnt vmcnt(6)" ::: "memory"); else if (ahead == 1) asm volatile("s_waitcnt vmcnt(3)" ::: "memory"); else asm volatile("s_waitcnt vmcnt(0)" ::: "memory");
            __builtin_amdgcn_s_barrier(); asm volatile("" ::: "memory");
            if constexpr (!LATE) { A3_ISSUE(i); if (i == NTE - 1) A3_NEXTUNIT(); }
        }
        if (t <= tlast) {
            bf16x8 kf[2 * DKH]; f32x16 c0, c1; float rm;
            A3_KLOADH(sl, 0);
            if (!pend) {
                A3_QKH(0); A3_KLOADH(sl, 1); A3_QKH(1);
                if (MODE == 0) { const int qrel = qw0 + r32 - 64 * t;
#pragma unroll
                    for (int r = 0; r < 16; ++r) { const int kv = crow(r, hi); if (kv > qrel) c0[r] = -INFINITY; if (kv + 32 > qrel) c1[r] = -INFINITY; } }
                A3_MIDBAR();
                A3_ROWMAX(rm);
                mhat = rm;
#pragma unroll
                for (int r = 0; r < 16; ++r) { c0[r] -= rm; c1[r] -= rm; }
                set_ref(mhat);
                pend = true;
            } else {
                s16x4 vlo[8], vhh[8]; bf16x8 pa[4];
                A3_QKH(0); A3_KLOADH(sl, 1);
                A3_VLOAD(pslot);
                A3_QKH(1);
                A3_EXP();
#pragma unroll
                for (int g_ = 0; g_ < 2 * DKS; ++g_) { __builtin_amdgcn_sched_group_barrier(0x008, 1, 0); __builtin_amdgcn_sched_group_barrier(0x002, 7, 0); }
                A3_MIDBAR();
                __builtin_amdgcn_s_setprio(1);
                A3_PV();
                A3_ROWMAX(rm);
#pragma unroll
                for (int g_ = 0; g_ < 8; ++g_) { __builtin_amdgcn_sched_group_barrier(0x008, 1, 0); __builtin_amdgcn_sched_group_barrier(0x002, 3, 0); }
                __builtin_amdgcn_s_setprio(0);
                if (__any(rm > THR)) {
                    const float dl = fmaxf(rm, 0.f); mhat += dl;
#pragma unroll
                    for (int r = 0; r < 16; ++r) { c0[r] -= dl; c1[r] -= dl; }
                    set_ref(mhat);
                    const float f = __builtin_amdgcn_exp2f(-dl); lrun *= f;
                    int ln2_ = lane; asm volatile("" : "+v"(ln2_)); LAS float* wsf_ = (LAS float*)(shm + R_WS) + wid * 64;
                    if ((ln2_ >> 5) == 0) wsf_[ln2_ & 31] = f;
                    LDS_WAIT();
#pragma unroll
                    for (int g = 0; g < 4; ++g) { const f32x4 ff = *(const LAS f32x4*)(wsf_ + 8 * g + 4 * (ln2_ >> 5));
#pragma unroll
                        for (int j = 0; j < 4; ++j) { o[0][4 * g + j] *= ff[j]; o[1][4 * g + j] *= ff[j]; if constexpr (SUMM) lsum[4 * g + j] *= ff[j]; } }
                }
            }
            pp0 = c0; pp1 = c1; pslot = sl;
        } else { A3_MIDBAR(); }
        A3_LATEISSUE();
        sl = (sl == NSL - 1) ? 0 : sl + 1; sl3 = (sl3 == NSL - 1) ? 0 : sl3 + 1;
    }
    };
    if (wid < 4) run(TFalse{}); else run(TTrue{});
#undef A3_ISSUE
#undef A3_NEXTUNIT
#undef A3_MIDBAR
#undef A3_LATEISSUE
    if (qb_next >= 0) { const GAS bf16* Qn = T.Q + (rowbase + qb_next * 256 + wid * 32) * T.qp + h * (MODE ? 96 : 64);
#pragma unroll
        for (int d0 = 0; d0 < (MODE ? 6 : 4); ++d0) qr[d0] = *(const GAS bf16x8*)(Qn + (long)r32 * T.qp + d0 * 16 + hi * 8); }
    if (pend) { s16x4 vlo[8], vhh[8]; bf16x8 pa[4]; A3_VLOAD(pslot); A3_EXP(); A3_PV(); }
#undef A3_KLOADH
#undef A3_VLOAD
#undef A3_QKH
#undef A3_EXP
#undef A3_PV
#undef A3_ROWMAX
#undef A2_DMA
    float rli[16];
    if constexpr (SUMM) {
#pragma unroll
        for (int r = 0; r < 16; ++r) rli[r] = __builtin_amdgcn_rcpf(lsum[r]);
    } else {
        { const auto sw_ = __builtin_amdgcn_permlane32_swap(__float_as_uint(lrun), __float_as_uint(lrun), false, false); lrun = __uint_as_float(sw_[0]) + __uint_as_float(sw_[1]); }
        LDS_WAIT();
        if (hi == 0) wsf[32 + r32] = lrun;
        LDS_WAIT();
#pragma unroll
        for (int g = 0; g < 4; ++g) { const f32x4 ll = *(const LAS f32x4*)(wsf + 32 + 8 * g + 4 * hi);
#pragma unroll
            for (int j = 0; j < 4; ++j) rli[4 * g + j] = __builtin_amdgcn_rcpf(ll[j]); }
    }
    GAS bf16* Ow = T.O + (rowbase + qw0) * 1024 + (MODE ? 0 : 512) + h * 64;
    { LAS bf16* stg = (LAS bf16*)(shm + R_OST) + wid * 2048;
#pragma unroll
      for (int r = 0; r < 16; ++r) { const int orow = crow(r, hi);
#pragma unroll
          for (int d0 = 0; d0 < 2; ++d0) stg[orow * 64 + d0 * 32 + r32] = (bf16)(cvt_pk_bf16(o[d0][r] * rli[r], 0.f) & 0xffffu); }
      LDS_WAIT();
#pragma unroll
      for (int i = 0; i < 4; ++i) { const int row = i * 8 + (lane >> 3), ch = lane & 7; const u32x4 v = *(const LAS u32x4*)(stg + row * 64 + ch * 8); *(GAS u32x4*)(Ow + (long)row * 1024 + ch * 8) = v;
          float sq = 0.f;
#pragma unroll
          for (int j = 0; j < 4; ++j) { const float a0 = __uint_as_float(v[j] << 16), a1 = __uint_as_float(v[j] & 0xffff0000u); sq += a0 * a0 + a1 * a1; }
          sq += __uint_as_float((unsigned)__builtin_amdgcn_update_dpp(0, (int)__float_as_uint(sq), 0xB1, 0xf, 0xf, false));
          sq += __uint_as_float((unsigned)__builtin_amdgcn_update_dpp(0, (int)__float_as_uint(sq), 0x4E, 0xf, 0xf, false));
          sq += __uint_as_float((unsigned)__builtin_amdgcn_update_dpp(0, (int)__float_as_uint(sq), 0x141, 0xf, 0xf, false));
          if (ch == 0) T.OSS[(rowbase + qw0 + row) * 16 + (MODE ? 0 : 8) + h] = sq; } }
    if (qb_next < 0) { LDS_WAIT(); __builtin_amdgcn_s_barrier(); asm volatile("" ::: "memory"); }
    return A3_SLOT(NTE);
#undef A3_SLOT
}
}

struct Args { const void* in[21]; float* out; unsigned char* ws; int ph_lo, ph_hi; };

__device__ __forceinline__ void tr_item(const GAS float* __restrict__ W, int ldw, int Ksrc, const GAS float* __restrict__ gain, GAS bf16* __restrict__ WT, int ldk, int k0, int n0, int srccol, LAS float* scr, int lane) {
#pragma unroll 8
    for (int i = 0; i < 32; ++i) { const int kk = 2 * i + (lane >> 5); const int k = k0 + kk;
        float v = 0.f; if (srccol >= 0 && k < Ksrc) { v = __builtin_nontemporal_load(W + (size_t)k * ldw + srccol); if (gain) v *= gain[k]; }
        scr[kk * 33 + (lane & 31)] = v; }
    LDS_WAIT(); asm volatile("" ::: "memory");
    const int c = lane & 7;
#pragma unroll
    for (int j = 0; j < 4; ++j) { const int n = (lane >> 3) + 8 * j; const LAS float* s = scr + (8 * c) * 33 + n;
        u32x4 o; o.x = cvt_pk_bf16(s[0 * 33], s[1 * 33]); o.y = cvt_pk_bf16(s[2 * 33], s[3 * 33]); o.z = cvt_pk_bf16(s[4 * 33], s[5 * 33]); o.w = cvt_pk_bf16(s[6 * 33], s[7 * 33]);
        *(GAS u32x4*)(WT + (size_t)(n0 + n) * ldk + k0 + 8 * c) = o; }
    LDS_WAIT(); asm volatile("" ::: "memory");
}
__device__ __forceinline__ void tr_item64(const GAS float* __restrict__ W, int ldw, const GAS float* __restrict__ gain, GAS bf16* __restrict__ WT, int ldk, int k0, int n0src, int n0dst, LAS float* scr, int lane) {
    const int rr = lane >> 4, c4 = (lane & 15) * 4;
    f32x4 v[16];
#pragma unroll
    for (int i = 0; i < 16; ++i) v[i] = __builtin_nontemporal_load((const GAS f32x4*)(W + (size_t)(k0 + 4 * i + rr) * ldw + n0src + c4));
#pragma unroll
    for (int i = 0; i < 16; ++i) { const int k = 4 * i + rr; const float g = gain ? gain[k0 + k] : 1.f; LAS float* d = scr + k * 65 + c4;
        d[0] = v[i][0] * g; d[1] = v[i][1] * g; d[2] = v[i][2] * g; d[3] = v[i][3] * g; }
    LDS_WAIT(); asm volatile("" ::: "memory");
    const int kc = lane & 7;
#pragma unroll
    for (int j = 0; j < 8; ++j) { const int n = (lane >> 3) + 8 * j; const LAS float* sp = scr + (8 * kc) * 65 + n;
        u32x4 o; o.x = cvt_pk_bf16(sp[0 * 65], sp[1 * 65]); o.y = cvt_pk_bf16(sp[2 * 65], sp[3 * 65]); o.z = cvt_pk_bf16(sp[4 * 65], sp[5 * 65]); o.w = cvt_pk_bf16(sp[6 * 65], sp[7 * 65]);
        *(GAS u32x4*)(WT + (size_t)(n0dst + n) * ldk + k0 + 8 * kc) = o; }
    LDS_WAIT(); asm volatile("" ::: "memory");
}
__device__ __forceinline__ void tr_item64_f8(const GAS float* __restrict__ W, int ldw, const GAS float* __restrict__ gain, float scale, GAS unsigned char* __restrict__ WT8, int ldkB, int k0, int n0src, int n0dst, LAS float* scr, int lane) {
    const int rr = lane >> 4, c4 = (lane & 15) * 4;
    f32x4 v[16];
#pragma unroll
    for (int i = 0; i < 16; ++i) v[i] = __builtin_nontemporal_load((const GAS f32x4*)(W + (size_t)(k0 + 4 * i + rr) * ldw + n0src + c4));
#pragma unroll
    for (int i = 0; i < 16; ++i) { const int k = 4 * i + rr; const float g = (gain ? gain[k0 + k] : 1.f) * scale; LAS float* d = scr + k * 65 + c4;
        d[0] = v[i][0] * g; d[1] = v[i][1] * g; d[2] = v[i][2] * g; d[3] = v[i][3] * g; }
    LDS_WAIT(); asm volatile("" ::: "memory");
    const int kc = lane & 3;
#pragma unroll
    for (int j = 0; j < 4; ++j) { const int n = (lane >> 2) + 16 * j; const LAS float* sp = scr + (16 * kc) * 65 + n;
        u32x4 o; o.x = pk4_fp8(sp[0 * 65], sp[1 * 65], sp[2 * 65], sp[3 * 65]); o.y = pk4_fp8(sp[4 * 65], sp[5 * 65], sp[6 * 65], sp[7 * 65]); o.z = pk4_fp8(sp[8 * 65], sp[9 * 65], sp[10 * 65], sp[11 * 65]); o.w = pk4_fp8(sp[12 * 65], sp[13 * 65], sp[14 * 65], sp[15 * 65]);
        *(GAS u32x4*)(WT8 + (size_t)(n0dst + n) * ldkB + k0 + 16 * kc) = o; }
    LDS_WAIT(); asm volatile("" ::: "memory");
}
struct F8Item { const GAS float* W; int ldw; const GAS float* gain; GAS unsigned char* WT8; int ldkB, k0, n0src, n0dst; };
__device__ __forceinline__ void tr_load64(f32x4 (&v)[16], const F8Item& I, int lane) {
    const int rr = lane >> 4, c4 = (lane & 15) * 4;
#pragma unroll
    for (int i = 0; i < 16; ++i) v[i] = __builtin_nontemporal_load((const GAS f32x4*)(I.W + (size_t)(I.k0 + 4 * i + rr) * I.ldw + I.n0src + c4));
}
__device__ __forceinline__ void tr_finish64_f8(const f32x4 (&v)[16], const float (&gn)[16], const F8Item& I, float scale, LAS float* scr, int lane) {
    const int rr = lane >> 4, c4 = (lane & 15) * 4;
#pragma unroll
    for (int i = 0; i < 16; ++i) { const int k = 4 * i + rr; const float g = (I.gain ? gn[i] : 1.f) * scale; LAS float* d = scr + k * 65 + c4;
        d[0] = v[i][0] * g; d[1] = v[i][1] * g; d[2] = v[i][2] * g; d[3] = v[i][3] * g; }
    LDS_WAIT(); asm volatile("" ::: "memory");
    const int kc = lane & 3;
#pragma unroll
    for (int j = 0; j < 4; ++j) { const int n = (lane >> 2) + 16 * j; const LAS float* sp = scr + (16 * kc) * 65 + n;
        u32x4 o; o.x = pk4_fp8(sp[0 * 65], sp[1 * 65], sp[2 * 65], sp[3 * 65]); o.y = pk4_fp8(sp[4 * 65], sp[5 * 65], sp[6 * 65], sp[7 * 65]); o.z = pk4_fp8(sp[8 * 65], sp[9 * 65], sp[10 * 65], sp[11 * 65]); o.w = pk4_fp8(sp[12 * 65], sp[13 * 65], sp[14 * 65], sp[15 * 65]);
        *(GAS u32x4*)(I.WT8 + (size_t)(I.n0dst + n) * I.ldkB + I.k0 + 16 * kc) = o; }
    LDS_WAIT(); asm volatile("" ::: "memory");
}
__device__ __forceinline__ int rope_dim(int p) { const int a = p >> 3, j = p & 7; return j < 4 ? 4 * a + j : 16 + 4 * a + (j - 4); }

#define LDP(i) ((void*)((((unsigned long long)(unsigned)__builtin_amdgcn_readfirstlane((int)(ARGP[i] >> 32))) << 32) | (unsigned long long)(unsigned)__builtin_amdgcn_readfirstlane((int)(unsigned)ARGP[i])))
#define ARGIN(i) ((const void*)LDP(i))
#define P_COS ((GAS float*)(ws + WS_COS))
#define P_SIN ((GAS float*)(ws + WS_SIN))
#define P_SSQ ((GAS float*)(ws + WS_SSQ))
#define P_FLOG ((GAS float*)(ws + WS_FLOG))
#define P_E01 ((GAS int*)(ws + WS_E01))
#define P_G01 ((GAS float*)(ws + WS_G01))
#define P_SLOT ((GAS int*)(ws + WS_SLOT))
#define P_TOKOF ((GAS int*)(ws + WS_TOKOF))
#define P_GATEOF ((GAS float*)(ws + WS_GATEOF))
#define P_CNT ((GAS int*)(ws + WS_CNT))
#define P_TSTART ((GAS int*)(ws + WS_TSTART))
#define P_RSTD ((GAS float*)(ws + WS_RSTD))
#define P_RSTDOF ((GAS float*)(ws + WS_RSTDOF))
#define P_KPE ((GAS bf16*)(ws + WS_KPE))
#define P_KAUG ((GAS bf16*)(ws + WS_KAUG))
#define P_BIASF ((GAS float*)(ws + WS_BIASF))
#define P_NRM ((GAS float*)(ws + WS_NRM))
#define P_WR_L(l) ((GAS bf16*)(ws + ((l) ? WS_W1 + 7 * MiB : WS_WR)))
#define P_XR ((GAS bf16*)(ws + WS_XR))
#define P_OSS ((GAS float*)(ws + WS_OSS))
#define P_RSTDX ((GAS float*)(ws + WS_RSTDX))
#define P_WIN_L(l) ((GAS bf16*)(ws + ((l) ? WS_W1 : WS_WIN)))
#define P_WUQ_L(l) ((GAS bf16*)(ws + ((l) ? WS_W1 + 4 * MiB : WS_WUQ)))
#define P_WUKV_L(l) ((GAS bf16*)(ws + ((l) ? WS_W1 + 4 * MiB + 512 * KiB : WS_WUKV)))
#define P_WOUT_L(l) ((GAS bf16*)(ws + ((l) ? WS_W1 + 5 * MiB : WS_WOUT)))
#define P_WGU_L(ll) ((GAS unsigned char*)(ws + WS_WGU + (size_t)((ll) & 1) * 32 * MiB))
#define P_WD_L(ll) ((GAS unsigned char*)(ws + WS_WD + (size_t)((ll) & 1) * 16 * MiB))
#define P_XN ((GAS bf16*)(ws + WS_XN))
#define P_FQKV ((GAS bf16*)(ws + WS_FQKV))
#define P_HH ((GAS bf16*)(ws + WS_FQKV))
#define P_LAT ((GAS bf16*)(ws + WS_LAT))
#define P_QM ((GAS bf16*)(ws + WS_QM))
#define P_KVM ((GAS bf16*)(ws + WS_KVM))
#define P_Y ((GAS bf16*)(ws + WS_Y))
#define IN(k) (lo <= (k) && (k) < hi_)
#if MK_ONE_LAUNCH
#define GRID_BAR() xcd_barrier(bar)
#else
#define GRID_BAR() do {} while (0)
#endif
#define SEAM(k) do { if (IN(k) && IN((k) + 1)) GRID_BAR(); } while (0)
#if MK_ONE_LAUNCH
#define GROUP_BAR() xcd_barrier(gbar)
#else
#define GROUP_BAR() do {} while (0)
#endif
#define SEAMG(k) do { if (IN(k) && IN((k) + 1)) GROUP_BAR(); } while (0)
__device__ __forceinline__ void conv_gu_item(int r, const GAS float* w_gate, const GAS float* w_up, const GAS float* ffn_norm, GAS unsigned char* WGU, LAS float* scr64, int lane) {
    const int e = r / 256, q = r % 256, kb = q / 16, nb = q % 16; const int n0 = nb * 64; const int ct = n0 >> 8, which = (n0 >> 7) & 1, jj = n0 & 127;
    const GAS float* src = (which ? w_up : w_gate) + (size_t)e * DM * DEXP;
    tr_item64_f8(src, DEXP, ffn_norm, WSCALE, WGU + (size_t)e * 1024 * 1024, DM, kb * 64, ct * 128 + jj, n0, scr64, lane);
}
__device__ __forceinline__ F8Item gu_item(int r, const GAS float* w_gate, const GAS float* w_up, const GAS float* ffn_norm, GAS unsigned char* WGU) {
    const int e = r / 256, q = r % 256, kb = q / 16, nb = q % 16; const int n0 = nb * 64; const int ct = n0 >> 8, which = (n0 >> 7) & 1, jj = n0 & 127;
    return F8Item{(which ? w_up : w_gate) + (size_t)e * DM * DEXP, DEXP, ffn_norm, WGU + (size_t)e * 1024 * 1024, DM, kb * 64, ct * 128 + jj, n0};
}
__device__ __forceinline__ F8Item d_item(int r, const GAS float* w_down, GAS unsigned char* WD) {
    const int e = r / 128, q = r % 128, kb = q / 16, nb = q % 16;
    return F8Item{w_down + (size_t)e * DEXP * DM, DM, nullptr, WD + (size_t)e * 1024 * 512, DEXP, kb * 64, nb * 64, nb * 64};
}
__device__ __forceinline__ void conv_d_item(int r, const GAS float* w_down, GAS unsigned char* WD, LAS float* scr64, int lane) {
    const int e = r / 128, q = r % 128, kb = q / 16, nb = q % 16;
    tr_item64_f8(w_down + (size_t)e * DEXP * DM, DM, nullptr, WSCALE, WD + (size_t)e * 1024 * 512, DEXP, kb * 64, nb * 64, nb * 64, scr64, lane);
}
template <int LW, int GU0, int NGU, int D0, int ND>
__device__ __forceinline__ void conv_experts(LAS unsigned char* lds0, const int wave0, const int G0, const int bx0) {
    unsigned ldsb_ = (unsigned)(uintptr_t)lds0; asm volatile("" : "+s"(ldsb_)); LAS unsigned char* lds = (LAS unsigned char*)(uintptr_t)ldsb_; volatile LAS unsigned long long* ARGP = (volatile LAS unsigned long long*)(lds + MISC_OFF + 768);
    int wave = wave0, G = G0, bx = bx0; asm volatile("" : "+s"(G), "+s"(bx), "+s"(wave)); int lane = (int)__builtin_amdgcn_mbcnt_hi(~0u, __builtin_amdgcn_mbcnt_lo(~0u, 0u)); asm volatile("" : "+v"(lane)); const int vcu = (bx % 8) * (G / 8) + bx / 8;
    GAS unsigned char* ws = (GAS unsigned char*)LDP(22);
    LAS float* scr64 = (LAS float*)(lds + wave * 16640);
    const GAS float* ffn_norm = (const GAS float*)ARGIN(12) + (size_t)LW * DM;
    const GAS float* w_gate = (const GAS float*)ARGIN(17) + (size_t)LW * NEXP * DM * DEXP; const GAS float* w_up = (const GAS float*)ARGIN(18) + (size_t)LW * NEXP * DM * DEXP; const GAS float* w_down = (const GAS float*)ARGIN(19) + (size_t)LW * NEXP * DEXP * DM;
    asm volatile("s_waitcnt vmcnt(0)" ::: "memory"); __syncthreads();
    const int it0 = vcu + G * wave;
    constexpr int NI = NGU + ND;
    static_assert(GU0 % 256 == 0 && D0 % 128 == 0, "item ranges start at expert boundaries");
    f32x4 va[16], vb[16]; float gg[16]; F8Item Ia, Ib;
#pragma unroll
    for (int i = 0; i < 16; ++i) gg[i] = ffn_norm[(vcu >> 4) * 64 + 4 * i + (lane >> 4)];
    auto item = [&](int k) { return k < NGU ? gu_item(GU0 + it0 + G * 8 * k, w_gate, w_up, ffn_norm, P_WGU_L(LW)) : d_item(D0 + it0 + G * 8 * (k - NGU), w_down, P_WD_L(LW)); };
    Ia = item(0); tr_load64(va, Ia, lane);
#pragma unroll
    for (int k = 0; k < NI; k += 2) {
        if (k + 1 < NI) { Ib = item(k + 1); tr_load64(vb, Ib, lane); }
        tr_finish64_f8(va, gg, Ia, WSCALE, scr64, lane);
        if (k + 1 < NI) { if (k + 2 < NI) { Ia = item(k + 2); tr_load64(va, Ia, lane); } tr_finish64_f8(vb, gg, Ib, WSCALE, scr64, lane); }
    }
    __syncthreads();
}
constexpr int TAIL_GU = 4096, TAIL_D = 2048;
#define CONV_HERE() do { if constexpr (l == 0) conv_experts<0, 0, 4, 0, 2>(lds0, wave0, G0, bx0); else conv_experts<1, TAIL_GU, (8192 - TAIL_GU) / 2048, TAIL_D, (4096 - TAIL_D) / 2048>(lds0, wave0, G0, bx0); } while (0)
#define CONV_SLOT(k, sl) do { if (IN(P + (k)) && ((((bx0 % 8) * (G0 / 8) + bx0 / 8) >> 4) & 1) == (sl)) CONV_HERE(); } while (0)
template <int l>
__device__ __forceinline__ void layer_body(const int lo, const int hi_, LAS unsigned char* lds0, const int wave0, const int G0, const int bx0, const XcdBarrier& bar, const XcdBarrier& gbar) {
        const int P = 10 * l;
        if (IN(P)) for (int rep_ = 0; rep_ < (l == 0 ? NREP(0) : 1); ++rep_) {
            unsigned ldsb_ = (unsigned)(uintptr_t)lds0; asm volatile("" : "+s"(ldsb_)); LAS unsigned char* lds = (LAS unsigned char*)(uintptr_t)ldsb_; volatile LAS unsigned* MISC = (volatile LAS unsigned*)(lds + MISC_OFF); volatile LAS unsigned long long* ARGP = (volatile LAS unsigned long long*)(lds + MISC_OFF + 768); (void)MISC; int wave = wave0, G = G0, bx = bx0; asm volatile("" : "+s"(G), "+s"(bx), "+s"(wave)); const int lane = (int)__builtin_amdgcn_mbcnt_hi(~0u, __builtin_amdgcn_mbcnt_lo(~0u, 0u)); const int tid = wave * 64 + lane; const int vcu = (bx % 8) * (G / 8) + bx / 8; const int gw = vcu * 8 + wave, NGW = G * 8; (void)lane; (void)gw; (void)NGW; (void)vcu;
            GAS unsigned char* ws = (GAS unsigned char*)LDP(22); GAS float* out = (GAS float*)LDP(21); const GAS float* x_in = (const GAS float*)ARGIN(0); const GAS int* positions = (const GAS int*)ARGIN(1);
            if constexpr (l == 0) {
                LAS float* scr = (LAS float*)(lds + wave * 16640);
                constexpr int I_IN64 = 16 * 30, I_INS = 16 * 4, I_UQ = 4 * 24, I_UKV = 2 * 16, J_OUT = 16 * 16;
                constexpr int NITEMS = I_IN64 + I_INS + I_UQ + I_UKV + J_OUT;
                for (int it = vcu + G * wave; it < NLAYER * NITEMS; it += NGW) {
                    const int lw = it / NITEMS; int r = it % NITEMS; const int j = lane & 31;
                    if (r < I_IN64 + I_INS) { const GAS float* attn_norm = (const GAS float*)ARGIN(2) + (size_t)lw * DM; const GAS float* w_in = (const GAS float*)ARGIN(3) + (size_t)lw * DM * INW;
                        if (r < I_IN64) { const int kb = r / 30, q = r % 30, t = q < 6 ? q : q + 2; tr_item64(w_in, INW, attn_norm, P_WIN_L(lw), DM, kb * 64, t < 6 ? 64 * t : 416 + 64 * (t - 8), 64 * t, scr, lane); continue; }
                        r -= I_IN64; const int kb = r / 4, nb = 12 + r % 4; const int n = nb * 32 + j; int sc;
                        if (n < 416) sc = 384 + rope_dim(n - 384); else if (n < 424) sc = 1952 + (n - 416); else sc = -1;
                        tr_item(w_in, INW, DM, attn_norm, P_WIN_L(lw), DM, kb * 64, nb * 32, sc, scr, lane); continue; } r -= I_IN64 + I_INS;
                    if (r < I_UQ) { const GAS float* q_norm = (const GAS float*)ARGIN(5) + (size_t)lw * 256; const GAS float* w_uq = (const GAS float*)ARGIN(6) + (size_t)lw * 256 * 768;
                        const int kb = r / 24, nb = r % 24; const int n = nb * 32 + j; const int hh = n / 96, d = n % 96; const int sc = d < 64 ? n : hh * 96 + 64 + rope_dim(d - 64);
                        tr_item(w_uq, 768, 256, q_norm, P_WUQ_L(lw), 256, kb * 64, nb * 32, sc, scr, lane); continue; } r -= I_UQ;
                    if (r < I_UKV) { const GAS float* kv_norm = (const GAS float*)ARGIN(7) + (size_t)lw * 128; const GAS float* w_ukv = (const GAS float*)ARGIN(8) + (size_t)lw * 128 * 1024;
                        const int kb = r / 16, nb = r % 16; tr_item64(w_ukv, 1024, kv_norm, P_WUKV_L(lw), 256, kb * 64, nb * 64, nb * 64, scr, lane); continue; } r -= I_UKV;
                    { const GAS float* mla_on = (const GAS float*)ARGIN(9) + (size_t)lw * 512; const GAS float* fox_on = (const GAS float*)ARGIN(10) + (size_t)lw * 512; const GAS float* w_out = (const GAS float*)ARGIN(11) + (size_t)lw * DM * DM;
                        const int kb = r / 16, nb = r % 16; const GAS float* gn = kb < 8 ? mla_on : fox_on - 512; tr_item64(w_out, DM, gn, P_WOUT_L(lw), DM, kb * 64, nb * 64, nb * 64, scr, lane); }
                }
                for (int lw = 0; lw < NLAYER; ++lw) { const GAS float* ffn_norm = (const GAS float*)ARGIN(12) + (size_t)lw * DM; const GAS float* w_rg = (const GAS float*)ARGIN(13) + (size_t)lw * DM * 4; const GAS float* w_re = (const GAS float*)ARGIN(15) + (size_t)lw * DM * 32;
                  for (int idx = bx * 512 + tid; idx < 2 * 48 * 520; idx += G * 512) { const int half = idx / (48 * 520), r = idx % (48 * 520), c = r / 520, kk = r % 520; const int k = half * 512 + kk;
                      float w = 0.f; if (c < 36 && kk < 512) w = ffn_norm[k] * (c < 4 ? w_rg[k * 4 + c] : w_re[k * 32 + (c - 4)]);
                      const unsigned h16 = cvt_pk_bf16(w, 0.f) & 0xffffu; const unsigned l16 = cvt_pk_bf16(w - __uint_as_float(h16 << 16), 0.f) & 0xffffu;
                      P_WR_L(lw)[(size_t)(half * 2 + 0) * 48 * 520 + r] = (bf16)h16; P_WR_L(lw)[(size_t)(half * 2 + 1) * 48 * 520 + r] = (bf16)l16; } }
            }
            const GAS float* fin = (const GAS float*)ARGIN(20);
            if constexpr (l > 0 && l < NLAYER) {
                for (int mb = vcu * 128 + wave * 16; mb < vcu * 128 + wave * 16 + 16; mb += 4) {
                    u32x4 xw[4][2]; u32x2 ya[4][2], yc[4][2]; int s0[4], s1[4];
#pragma unroll
                    for (int r = 0; r < 4; ++r) { s0[r] = P_SLOT[2 * (mb + r)]; s1[r] = P_SLOT[2 * (mb + r) + 1]; }
#pragma unroll
                    for (int r = 0; r < 4; ++r)
#pragma unroll
                        for (int j = 0; j < 2; ++j) xw[r][j] = __builtin_nontemporal_load((const GAS u32x4*)(P_XR + (size_t)(mb + r) * DM + 8 * lane + 512 * j));
#pragma unroll
                    for (int r = 0; r < 4; ++r)
#pragma unroll
                        for (int j = 0; j < 2; ++j) { ya[r][j] = __builtin_nontemporal_load((const GAS u32x2*)((const GAS unsigned char*)P_Y + (size_t)s0[r] * 1024 + 8 * lane + 512 * j)); yc[r][j] = __builtin_nontemporal_load((const GAS u32x2*)((const GAS unsigned char*)P_Y + (size_t)s1[r] * 1024 + 8 * lane + 512 * j)); }
                    float v[4][2][8], ss[4];
#pragma unroll
                    for (int r = 0; r < 4; ++r) { float s_ = 0.f;
#pragma unroll
                        for (int j = 0; j < 2; ++j)
#pragma unroll
                            for (int h = 0; h < 2; ++h) { const unsigned wA = xw[r][j][2 * h], wB = xw[r][j][2 * h + 1]; const int a = (int)ya[r][j][h], c = (int)yc[r][j][h];
                                const f32x2 a0 = __builtin_amdgcn_cvt_pk_f32_fp8(a, false), a1 = __builtin_amdgcn_cvt_pk_f32_fp8(a, true), c0 = __builtin_amdgcn_cvt_pk_f32_fp8(c, false), c1 = __builtin_amdgcn_cvt_pk_f32_fp8(c, true);
                                float* o = &v[r][j][4 * h];
                                o[0] = __uint_as_float(wA << 16) + (a0[0] + c0[0]) * WSCALE_INV; o[1] = __uint_as_float(wA & 0xffff0000u) + (a0[1] + c0[1]) * WSCALE_INV; o[2] = __uint_as_float(wB << 16) + (a1[0] + c1[0]) * WSCALE_INV; o[3] = __uint_as_float(wB & 0xffff0000u) + (a1[1] + c1[1]) * WSCALE_INV;
                                s_ += (o[0] * o[0] + o[1] * o[1]) + (o[2] * o[2] + o[3] * o[3]); }
                        ss[r] = s_; }
#pragma unroll
                    for (int o = 1; o < 64; o <<= 1) {
#pragma unroll
                        for (int r = 0; r < 4; ++r) ss[r] += __shfl_xor(ss[r], o); }
#pragma unroll
                    for (int r = 0; r < 4; ++r) { const int m = mb + r;
#pragma unroll
                        for (int j = 0; j < 2; ++j) { u32x4 w; w.x = cvt_pk_bf16(v[r][j][0], v[r][j][1]); w.y = cvt_pk_bf16(v[r][j][2], v[r][j][3]); w.z = cvt_pk_bf16(v[r][j][4], v[r][j][5]); w.w = cvt_pk_bf16(v[r][j][6], v[r][j][7]); *(GAS u32x4*)(P_XR + (size_t)m * DM + 8 * lane + 512 * j) = w; }
                        if (lane == 0) P_RSTDX[m] = rsqrtf(ss[r] * (1.f / DM) + EPS); }
                }
            } else {
            f32x4 gf_[4];
            if (l == NLAYER) {
#pragma unroll
                for (int j = 0; j < 4; ++j) gf_[j] = *(const GAS f32x4*)(fin + 4 * lane + 256 * j); }
            constexpr int RB = (l == 0) ? 8 : 4;
            for (int mb = vcu * 128 + wave * 16; mb < vcu * 128 + wave * 16 + 16; mb += RB) {
                f32x4 v[RB][4]; int s0[RB], s1[RB];
                if (l > 0) {
#pragma unroll
                    for (int r = 0; r < RB; ++r) { s0[r] = P_SLOT[2 * (mb + r)]; s1[r] = P_SLOT[2 * (mb + r) + 1]; }
                }
#pragma unroll
                for (int r = 0; r < RB; ++r) {
                    if (l == 0) { const GAS float* xr = x_in + (size_t)(mb + r) * DM;
#pragma unroll
                        for (int j = 0; j < 4; ++j) v[r][j] = __builtin_nontemporal_load((const GAS f32x4*)(xr + 4 * lane + 256 * j)); }
                    else { const GAS bf16* xr = P_XR + (size_t)(mb + r) * DM;
#pragma unroll
                        for (int j = 0; j < 4; ++j) { const u32x2 w = __builtin_nontemporal_load((const GAS u32x2*)(xr + 4 * lane + 256 * j)); v[r][j] = (f32x4){__uint_as_float(w.x << 16), __uint_as_float(w.x & 0xffff0000u), __uint_as_float(w.y << 16), __uint_as_float(w.y & 0xffff0000u)}; } } }
                if (l > 0) {
#pragma unroll
                    for (int r = 0; r < RB; ++r)
#pragma unroll
                        for (int j = 0; j < 4; ++j) { const int a = __builtin_nontemporal_load((const GAS int*)((const GAS unsigned char*)P_Y + (size_t)s0[r] * 1024 + 4 * lane + 256 * j)), c = __builtin_nontemporal_load((const GAS int*)((const GAS unsigned char*)P_Y + (size_t)s1[r] * 1024 + 4 * lane + 256 * j));
                            const f32x2 a0 = __builtin_amdgcn_cvt_pk_f32_fp8(a, false), a1 = __builtin_amdgcn_cvt_pk_f32_fp8(a, true), c0 = __builtin_amdgcn_cvt_pk_f32_fp8(c, false), c1 = __builtin_amdgcn_cvt_pk_f32_fp8(c, true);
                            v[r][j][0] += (a0[0] + c0[0]) * WSCALE_INV; v[r][j][1] += (a0[1] + c0[1]) * WSCALE_INV; v[r][j][2] += (a1[0] + c1[0]) * WSCALE_INV; v[r][j][3] += (a1[1] + c1[1]) * WSCALE_INV; }
                }
                float ss[RB];
#pragma unroll
                for (int r = 0; r < RB; ++r) { float s = 0.f;
#pragma unroll
                    for (int j = 0; j < 4; ++j) s += (v[r][j][0] * v[r][j][0] + v[r][j][1] * v[r][j][1]) + (v[r][j][2] * v[r][j][2] + v[r][j][3] * v[r][j][3]);
                    ss[r] = s; }
#pragma unroll
                for (int o = 1; o < 64; o <<= 1) {
#pragma unroll
                    for (int r = 0; r < RB; ++r) ss[r] += __shfl_xor(ss[r], o); }
#pragma unroll
                for (int r = 0; r < RB; ++r) { const int m = mb + r; const float rstd = rsqrtf(ss[r] * (1.f / DM) + EPS);
                    if (l < NLAYER) {
#pragma unroll
                        for (int jp = 0; jp < 2; ++jp) {
                            u32x2 w0, w1; w0.x = cvt_pk_bf16(v[r][2 * jp][0], v[r][2 * jp][1]); w0.y = cvt_pk_bf16(v[r][2 * jp][2], v[r][2 * jp][3]); w1.x = cvt_pk_bf16(v[r][2 * jp + 1][0], v[r][2 * jp + 1][1]); w1.y = cvt_pk_bf16(v[r][2 * jp + 1][2], v[r][2 * jp + 1][3]);
                            const bool od = lane & 1; const u32x2 give = od ? w0 : w1;
                            u32x2 got; got.x = (unsigned)__builtin_amdgcn_update_dpp(0, (int)give.x, 0xB1, 0xf, 0xf, false); got.y = (unsigned)__builtin_amdgcn_update_dpp(0, (int)give.y, 0xB1, 0xf, 0xf, false);
                            const u32x4 o = od ? (u32x4){got.x, got.y, w1.x, w1.y} : (u32x4){w0.x, w0.y, got.x, got.y};
                            *(GAS u32x4*)(P_XR + (size_t)m * DM + 8 * (lane >> 1) + 256 * (2 * jp + (lane & 1))) = o; }
                        if (lane == 0) P_RSTDX[m] = rstd;
                    } else {
#pragma unroll
                        for (int j = 0; j < 4; ++j) __builtin_nontemporal_store(v[r][j] * rstd * gf_[j], (GAS f32x4*)(out + (size_t)m * DM + 4 * lane + 256 * j));
                    }
                }
            }
            }
        }
        if constexpr (l == NLAYER) return;
        SEAM(P);
        if (IN(P + 1)) for (int rep_ = 0; rep_ < ((l == 0 || 1 != 5) ? NREP(1) : 1); ++rep_) {
            unsigned ldsb_ = (unsigned)(uintptr_t)lds0; asm volatile("" : "+s"(ldsb_)); LAS unsigned char* lds = (LAS unsigned char*)(uintptr_t)ldsb_; volatile LAS unsigned* MISC = (volatile LAS unsigned*)(lds + MISC_OFF); volatile LAS unsigned long long* ARGP = (volatile LAS unsigned long long*)(lds + MISC_OFF + 768); (void)MISC; int wave = wave0, G = G0, bx = bx0; asm volatile("" : "+s"(G), "+s"(bx), "+s"(wave)); const int lane = (int)__builtin_amdgcn_mbcnt_hi(~0u, __builtin_amdgcn_mbcnt_lo(~0u, 0u)); const int tid = wave * 64 + lane; const int vcu = (bx % 8) * (G / 8) + bx / 8; const int gw = vcu * 8 + wave, NGW = G * 8; (void)lane; (void)gw; (void)NGW; (void)vcu;
            GAS unsigned char* ws = (GAS unsigned char*)LDP(22); GAS float* out = (GAS float*)LDP(21); const GAS float* x_in = (const GAS float*)ARGIN(0); (void)out; (void)x_in; (void)ws;
            BatchOrder S{INP / 256, vcu, (const GAS char*)P_XR, (const GAS char*)P_WIN_L(l), (size_t)256 * DM * 2, (size_t)256 * DM * 2};
            EpiWin E{P_LAT, P_FQKV, P_KPE, P_FLOG, P_SSQ, P_COS, P_SIN, P_RSTDX};
            pg8::gemm_phase<EpiWin, BatchOrder, true, false>(tid, lds, DM * 2, DM * 2, DM * 2, S, E, nullptr);
        }
        SEAMG(P + 1);
        if (IN(P + 2)) for (int rep_ = 0; rep_ < ((l == 0 || 2 != 5) ? NREP(2) : 1); ++rep_) {
            unsigned ldsb_ = (unsigned)(uintptr_t)lds0; asm volatile("" : "+s"(ldsb_)); LAS unsigned char* lds = (LAS unsigned char*)(uintptr_t)ldsb_; volatile LAS unsigned* MISC = (volatile LAS unsigned*)(lds + MISC_OFF); volatile LAS unsigned long long* ARGP = (volatile LAS unsigned long long*)(lds + MISC_OFF + 768); (void)MISC; int wave = wave0, G = G0, bx = bx0; asm volatile("" : "+s"(G), "+s"(bx), "+s"(wave)); const int lane = (int)__builtin_amdgcn_mbcnt_hi(~0u, __builtin_amdgcn_mbcnt_lo(~0u, 0u)); const int tid = wave * 64 + lane; const int vcu = (bx % 8) * (G / 8) + bx / 8; const int gw = vcu * 8 + wave, NGW = G * 8; (void)lane; (void)gw; (void)NGW; (void)vcu;
            GAS unsigned char* ws = (GAS unsigned char*)LDP(22); GAS float* out = (GAS float*)LDP(21); const GAS float* x_in = (const GAS float*)ARGIN(0); (void)out; (void)x_in; (void)ws;
            {
                const int sq = vcu >> 1, hf = vcu & 1; const int b = sq >> 3, h = sq & 7; const float bf = ((const GAS float*)ARGIN(4))[l * 8 + h];
                const GAS float* fl = P_FLOG + ((size_t)b * SEQ + hf * 1024 + 2 * tid) * 8 + h;
                float lf[2], lg[2] = {0.f, 0.f};
                float fr0[2], fr1[2] = {0.f, 0.f};
#pragma unroll
                for (int e = 0; e < 2; ++e) fr0[e] = fl[e * 8];
                if (hf) {
#pragma unroll
                    for (int e = 0; e < 2; ++e) fr1[e] = fl[e * 8 - 1024 * 8]; }
                u32x4 qa_[8][2], kk_[8][2];
                { const GAS bf16* fqp = P_FQKV + ((size_t)b * SEQ + hf * 1024 + wave * 128 + (lane >> 2)) * 512 + h * 64 + (lane & 3) * 16; const GAS bf16* fkp = fqp + (size_t)NTOK * 512;
#pragma unroll
                  for (int k = 0; k < 8; ++k)
#pragma unroll
                      for (int c8 = 0; c8 < 2; ++c8) { qa_[k][c8] = *(const GAS u32x4*)(fqp + k * 16 * 512 + c8 * 8); kk_[k][c8] = *(const GAS u32x4*)(fkp + k * 16 * 512 + c8 * 8); } }
#pragma unroll
                for (int e = 0; e < 2; ++e) { const float f = fr0[e] + bf; lf[e] = fminf(f, 0.f) - log1pf(expf(-fabsf(f))); }
                if (hf) {
#pragma unroll
                    for (int e = 0; e < 2; ++e) { const float f = fr1[e] + bf; lg[e] = fminf(f, 0.f) - log1pf(expf(-fabsf(f))); } }
                const double s2 = (double)lf[0] + (double)lf[1];
                double incl = s2, first = (double)lg[0] + (double)lg[1];
#pragma unroll
                for (int o = 1; o < 64; o <<= 1) { const double t = __shfl_up(incl, o); if (lane >= o) incl += t; first += __shfl_xor(first, o); }
                LAS double* wtot = (LAS double*)lds;
                if (lane == 63) wtot[wave] = incl;
                if (lane == 0) wtot[8 + wave] = first;
                __syncthreads();
                double c = incl - s2;
                for (int w = 0; w < wave; ++w) c += wtot[w];
                if (hf) { for (int w = 0; w < 8; ++w) c += wtot[8 + w]; }
                const size_t t0 = ((size_t)b * 8 + h) * SEQ + hf * 1024 + 2 * tid;
                GAS u32x4* ka = (GAS u32x4*)(P_KAUG + t0 * 8);
                float xs[2];
#pragma unroll
                for (int e = 0; e < 2; ++e) { c += (double)lf[e]; const float x = (float)(-c * 1.4426950408889634); xs[e] = x;
                    const unsigned h16 = cvt_pk_bf16(x, 0.f) & 0xffffu; const float r1 = x - __uint_as_float(h16 << 16); const unsigned m16 = cvt_pk_bf16(r1, 0.f) & 0xffffu; const float r2 = r1 - __uint_as_float(m16 << 16); const unsigned l16 = cvt_pk_bf16(r2, 0.f) & 0xffffu;
                    ka[e] = (u32x4){h16 | (m16 << 16), l16 | (0x3F80u << 16), 0x3F80u | (0x3F80u << 16), 0u};     P_BIASF[t0 + e] = x; }
                float qn = 0.f, kn = 0.f, xdm = INFINITY;
                {
#pragma unroll
                  for (int k = 0; k < 8; ++k) { float sq_ = 0.f, sk = 0.f, dd = 0.f;
#pragma unroll
                      for (int c8 = 0; c8 < 2; ++c8) { const u32x4 a = qa_[k][c8], k4 = kk_[k][c8];
#pragma unroll
                          for (int j = 0; j < 4; ++j) { const float a0 = __uint_as_float(a[j] << 16), a1 = __uint_as_float(a[j] & 0xffff0000u), k0 = __uint_as_float(k4[j] << 16), k1 = __uint_as_float(k4[j] & 0xffff0000u);
                              sq_ += a0 * a0 + a1 * a1; sk += k0 * k0 + k1 * k1; dd += a0 * k0 + a1 * k1; } }
                      sq_ += __int_as_float(__builtin_amdgcn_update_dpp(0, __float_as_int(sq_), 0xB1, 0xf, 0xf, false)); sk += __int_as_float(__builtin_amdgcn_update_dpp(0, __float_as_int(sk), 0xB1, 0xf, 0xf, false)); dd += __int_as_float(__builtin_amdgcn_update_dpp(0, __float_as_int(dd), 0xB1, 0xf, 0xf, false));
                      sq_ += __int_as_float(__builtin_amdgcn_update_dpp(0, __float_as_int(sq_), 0x4E, 0xf, 0xf, false)); sk += __int_as_float(__builtin_amdgcn_update_dpp(0, __float_as_int(sk), 0x4E, 0xf, 0xf, false)); dd += __int_as_float(__builtin_amdgcn_update_dpp(0, __float_as_int(dd), 0x4E, 0xf, 0xf, false));
                      const int src_ = 8 * k + (lane >> 3); const float x0_ = __shfl(xs[0], src_), x1_ = __shfl(xs[1], src_); const float xr_ = (lane & 4) ? x1_ : x0_;
                      qn = fmaxf(qn, sq_); kn = fmaxf(kn, sk); xdm = fminf(xdm, xr_ + dd); } }
#pragma unroll
                for (int o = 1; o < 64; o <<= 1) { qn = fmaxf(qn, __shfl_xor(qn, o)); kn = fmaxf(kn, __shfl_xor(kn, o)); xdm = fminf(xdm, __shfl_xor(xdm, o)); }
                LAS float* knw = (LAS float*)(lds + 256);
                if (lane == 0) { knw[wave] = kn; knw[8 + wave] = qn; knw[16 + wave] = xdm; }
                __syncthreads();
                if (tid < 4) { P_NRM[sq * 32 + hf * 4 + tid] = sqrtf(fmaxf(knw[8 + 2 * tid], knw[8 + 2 * tid + 1])); P_NRM[sq * 32 + 16 + hf * 4 + tid] = fminf(knw[16 + 2 * tid], knw[16 + 2 * tid + 1]); }
                if (tid == 4) { float m = knw[0]; for (int w = 1; w < 8; ++w) m = fmaxf(m, knw[w]); P_NRM[sq * 32 + 8 + hf] = sqrtf(m); }
                __syncthreads();
            }
            UpOrder S{vcu, (const GAS char*)P_LAT, (const GAS char*)P_WUQ_L(l), (const GAS char*)P_WUKV_L(l)};
            EpiUp E{P_QM, P_KVM, P_SSQ, P_COS, P_SIN};
            pg8::gemm_phase<EpiUp, UpOrder, true, false, false, false, true>(tid, lds, 256 * 2, 512 * 2, 256 * 2, S, E, nullptr);
        }
        SEAMG(P + 2);
        CONV_SLOT(3, 0);
        if (IN(P + 3)) for (int rep_ = 0; rep_ < ((l == 0 || 3 != 5) ? NREP(3) : 1); ++rep_) {
            unsigned ldsb_ = (unsigned)(uintptr_t)lds0; asm volatile("" : "+s"(ldsb_)); LAS unsigned char* lds = (LAS unsigned char*)(uintptr_t)ldsb_; volatile LAS unsigned* MISC = (volatile LAS unsigned*)(lds + MISC_OFF); volatile LAS unsigned long long* ARGP = (volatile LAS unsigned long long*)(lds + MISC_OFF + 768); (void)MISC; int wave = wave0, G = G0, bx = bx0; asm volatile("" : "+s"(G), "+s"(bx), "+s"(wave)); const int lane = (int)__builtin_amdgcn_mbcnt_hi(~0u, __builtin_amdgcn_mbcnt_lo(~0u, 0u)); const int tid = wave * 64 + lane; const int vcu = (bx % 8) * (G / 8) + bx / 8; const int gw = vcu * 8 + wave, NGW = G * 8; (void)lane; (void)gw; (void)NGW; (void)vcu;
            GAS unsigned char* ws = (GAS unsigned char*)LDP(22); GAS float* out = (GAS float*)LDP(21); const GAS float* x_in = (const GAS float*)ARGIN(0); (void)out; (void)x_in; (void)ws;
            GAS bf16* O = P_XN;
            const int b = vcu >> 4, hh = (vcu & 15) >> 1, sub = vcu & 1;
            const att::Tens2 TM{P_QM, 768, P_KVM, 1024, P_KPE, P_KVM + 64, 1024, O, nullptr, nullptr, P_OSS};
            const att::Tens2 TF{P_FQKV, 512, P_FQKV + (size_t)NTOK * 512, 512, P_KAUG, P_FQKV + (size_t)2 * NTOK * 512, 512, O, P_BIASF, P_NRM, P_OSS};
#define QB_OF(i) ((((i) & 1) ? 7 - (2 * sub + ((i) >> 1)) : (2 * sub + ((i) >> 1))))
            int ts0, ts1, ts2, ts3;
            { const GAS float* bs = P_BIASF + ((long)b * 8 + hh) * SEQ; const GAS float* nr = P_NRM + (b * 8 + hh) * 32; const float kmx = fmaxf(nr[8], nr[9]);
#define FOX_TS(i, dst) do { const int qb_ = QB_OF(i), NT_ = 4 * qb_ + 4; const float Z_ = nr[qb_] * kmx * 1.001f + 0.01f; const float bend_ = bs[(lane < NT_ ? lane : NT_ - 1) * 64 + 63]; \
                  const bool skip_ = (lane < NT_ - 4) && (Z_ + bend_ - nr[16 + qb_] < -32.f); dst = __builtin_popcountll(__ballot(skip_)); } while (0)
              FOX_TS(0, ts0); FOX_TS(1, ts1); FOX_TS(2, ts2); FOX_TS(3, ts3);
#undef FOX_TS
            }
            bf16x8 qreg[6];
            { int sb = 0; for (int i = 0; i < 4; ++i) sb = att::attn_unit2<1>(wave, b, hh, QB_OF(i), TM, (LAS char*)lds, sb, i > 0, i < 3 ? QB_OF(i + 1) : -1, qreg, 0); }
#pragma unroll
            for (int d0 = 0; d0 < 6; ++d0) asm volatile("" : "=v"(qreg[d0]));
            if ((b & 1) == 1) { __builtin_amdgcn_s_setprio(0); CONV_HERE(); }
            { int sb = 0; for (int i = 0; i < 4; ++i) { const int ts = i == 0 ? ts0 : i == 1 ? ts1 : i == 2 ? ts2 : ts3; sb = att::attn_unit2<0>(wave, b, hh, QB_OF(i), TF, (LAS char*)lds, sb, i > 0, i < 3 ? QB_OF(i + 1) : -1, qreg, ts); } }
#undef QB_OF
            __builtin_amdgcn_s_setprio(0);
        }
        SEAMG(P + 3);
        if (IN(P + 5)) for (int rep_ = 0; rep_ < ((l == 0 || 5 != 5) ? NREP(5) : 1); ++rep_) {
            unsigned ldsb_ = (unsigned)(uintptr_t)lds0; asm volatile("" : "+s"(ldsb_)); LAS unsigned char* lds = (LAS unsigned char*)(uintptr_t)ldsb_; volatile LAS unsigned* MISC = (volatile LAS unsigned*)(lds + MISC_OFF); volatile LAS unsigned long long* ARGP = (volatile LAS unsigned long long*)(lds + MISC_OFF + 768); (void)MISC; int wave = wave0, G = G0, bx = bx0; asm volatile("" : "+s"(G), "+s"(bx), "+s"(wave)); const int lane = (int)__builtin_amdgcn_mbcnt_hi(~0u, __builtin_amdgcn_mbcnt_lo(~0u, 0u)); const int tid = wave * 64 + lane; const int vcu = (bx % 8) * (G / 8) + bx / 8; const int gw = vcu * 8 + wave, NGW = G * 8; (void)lane; (void)gw; (void)NGW; (void)vcu;
            GAS unsigned char* ws = (GAS unsigned char*)LDP(22); GAS float* out = (GAS float*)LDP(21); const GAS float* x_in = (const GAS float*)ARGIN(0); (void)out; (void)x_in; (void)ws;
            BatchOrder S{DM / 256, vcu, (const GAS char*)P_XN, (const GAS char*)P_WOUT_L(l), (size_t)256 * DM * 2, (size_t)256 * DM * 2};
            EpiOut<false> E{x_in, P_XR};
            LAS f32x2* scl = (LAS f32x2*)(lds + pg8::STAGE_BYTES);
            { Unit u_; if (S.next(tid >> 8, u_)) { const GAS float* op = P_OSS + ((size_t)u_.pm * 256 + (tid & 255)) * 16;
                  const f32x4 a0 = *(const GAS f32x4*)op, a1 = *(const GAS f32x4*)(op + 4), c0 = *(const GAS f32x4*)(op + 8), c1 = *(const GAS f32x4*)(op + 12);
                  const float sm = ((a0[0] + a0[1]) + (a0[2] + a0[3])) + ((a1[0] + a1[1]) + (a1[2] + a1[3])), sf = ((c0[0] + c0[1]) + (c0[2] + c0[3])) + ((c1[0] + c1[1]) + (c1[2] + c1[3]));
                  const float rm_ = rsqrtf(sm * (1.f / 512.f) + EPS), rf_ = rsqrtf(sf * (1.f / 512.f) + EPS);
                  scl[tid] = (f32x2){rm_ / rf_, rf_}; } }
            __syncthreads();
            pg8::gemm_phase<EpiOut<false>, BatchOrder, true, false, false, true>(tid, lds, DM * 2, DM * 2, DM * 2, S, E, nullptr, scl);
        }
        SEAMG(P + 5);
        if (IN(P + 6)) for (int rep_ = 0; rep_ < ((l == 0 || 6 != 5) ? NREP(6) : 1); ++rep_) {
            unsigned ldsb_ = (unsigned)(uintptr_t)lds0; asm volatile("" : "+s"(ldsb_)); LAS unsigned char* lds = (LAS unsigned char*)(uintptr_t)ldsb_; volatile LAS unsigned* MISC = (volatile LAS unsigned*)(lds + MISC_OFF); volatile LAS unsigned long long* ARGP = (volatile LAS unsigned long long*)(lds + MISC_OFF + 768); (void)MISC; int wave = wave0, G = G0, bx = bx0; asm volatile("" : "+s"(G), "+s"(bx), "+s"(wave)); const int lane = (int)__builtin_amdgcn_mbcnt_hi(~0u, __builtin_amdgcn_mbcnt_lo(~0u, 0u)); const int tid = wave * 64 + lane; const int vcu = (bx % 8) * (G / 8) + bx / 8; const int gw = vcu * 8 + wave, NGW = G * 8; (void)lane; (void)gw; (void)NGW; (void)vcu;
            GAS unsigned char* ws = (GAS unsigned char*)LDP(22); GAS float* out = (GAS float*)LDP(21); const GAS float* x_in = (const GAS float*)ARGIN(0); (void)out; (void)x_in; (void)ws;
            GAS bf16* H2 = P_XN;
            LAS bf16* WT = (LAS bf16*)lds;
            LAS float* LG = (LAS float*)(lds + 99840) + wave * 576;
            const GAS float* b_rg = (const GAS float*)ARGIN(14) + l * 4; const GAS float* b_re = (const GAS float*)ARGIN(16) + l * 32;
            if (tid < 32) MISC[64 + tid] = 0u;
            const int r16 = lane & 15, g4 = lane >> 4;
            const int m0 = vcu * 128 + wave * 16;
            const GAS bf16* xrow = P_XR + (size_t)(m0 + r16) * DM + 8 * g4;
            f32x4 acc3[3]; acc3[0] = (f32x4){0.f, 0.f, 0.f, 0.f}; acc3[1] = acc3[0]; acc3[2] = acc3[0];
            float ssq = 0.f;
            for (int half = 0; half < 2; ++half) {
                __syncthreads();
                { constexpr int NV = 2 * 48 * 520 / 8, NK = (NV + 511) / 512;
                  u32x4 tw_[NK];
#pragma unroll
                  for (int k = 0; k < NK; ++k) { const int idx = tid + 512 * k; if (idx < NV) tw_[k] = *(const GAS u32x4*)(P_WR_L(l) + (size_t)half * 2 * 48 * 520 + 8 * idx); }
#pragma unroll
                  for (int k = 0; k < NK; ++k) { const int idx = tid + 512 * k; if (idx < NV) *(LAS u32x4*)(WT + 8 * idx) = tw_[k]; } }
                __syncthreads();
                for (int s8 = 0; s8 < 16; s8 += 8) {
                    bf16x8 xv[8];
#pragma unroll
                    for (int u = 0; u < 8; ++u) xv[u] = *(const GAS bf16x8*)(xrow + half * 512 + 32 * (s8 + u));
                    u32x2 hwp = {0u, 0u};
#pragma unroll
                    for (int u = 0; u < 8; ++u) {
                        const u32x4 xw = __builtin_bit_cast(u32x4, xv[u]); float xf[8];
#pragma unroll
                        for (int j = 0; j < 4; ++j) { xf[2 * j] = __uint_as_float(xw[j] << 16); xf[2 * j + 1] = __uint_as_float(xw[j] & 0xffff0000u); }
                        u32x2 hw; hw.x = pk4_fp8(xf[0], xf[1], xf[2], xf[3]); hw.y = pk4_fp8(xf[4], xf[5], xf[6], xf[7]);
                        if (u & 1) {
                            const auto s0 = __builtin_amdgcn_permlane16_swap(hwp.x, hw.x, false, false), s1 = __builtin_amdgcn_permlane16_swap(hwp.y, hw.y, false, false);
                            *(GAS u32x4*)((GAS unsigned char*)H2 + (size_t)(m0 + r16) * DM + half * 512 + 32 * (s8 + u - 1 + (g4 & 1)) + 16 * (g4 >> 1)) = (u32x4){s0[0], s1[0], s0[1], s1[1]};
                        } else hwp = hw;
#pragma unroll
                        for (int j = 0; j < 8; ++j) ssq += xf[j] * xf[j];
                        const LAS bf16* wk = WT + r16 * 520 + 32 * (s8 + u) + 8 * g4;
#pragma unroll
                        for (int ct = 0; ct < 3; ++ct) { const bf16x8 bh = *(const LAS bf16x8*)(wk + ct * 16 * 520), bl = *(const LAS bf16x8*)(wk + (48 + ct * 16) * 520);
                            acc3[ct] = __builtin_amdgcn_mfma_f32_16x16x32_bf16(xv[u], bh, acc3[ct], 0, 0, 0); acc3[ct] = __builtin_amdgcn_mfma_f32_16x16x32_bf16(xv[u], bl, acc3[ct], 0, 0, 0); }
                    }
                }
            }
            ssq += __shfl_xor(ssq, 16); ssq += __shfl_xor(ssq, 32);
            const float rstd = rsqrtf(ssq * (1.f / DM) + EPS);
#pragma unroll
            for (int ct = 0; ct < 3; ++ct) { const int c = 16 * ct + r16; if (c < 36) {
#pragma unroll
                for (int rg = 0; rg < 4; ++rg) LG[(4 * g4 + rg) * 36 + c] = acc3[ct][rg]; } }
            LDS_WAIT();
            if (lane < 16) {
                const int m = m0 + lane; const LAS float* lg = LG + lane * 36;
                float gl[4];
#pragma unroll
                for (int g = 0; g < 4; ++g) gl[g] = lg[g] * rstd + b_rg[g];
                int gi = 0; float gm = gl[0];
#pragma unroll
                for (int g = 1; g < 4; ++g) if (gl[g] > gm) { gm = gl[g]; gi = g; }
                float gs = 0.f;
#pragma unroll
                for (int g = 0; g < 4; ++g) gs += __expf(gl[g] - gm);
                const float gval = 1.f / gs;
                float el[8];
#pragma unroll
                for (int j = 0; j < 8; ++j) el[j] = lg[4 + 8 * gi + j] * rstd + b_re[8 * gi + j];
                int i0 = 0; float mx0 = el[0];
#pragma unroll
                for (int j = 1; j < 8; ++j) if (el[j] > mx0) { mx0 = el[j]; i0 = j; }
                int i1 = -1; float mx1 = -INFINITY;
#pragma unroll
                for (int j = 0; j < 8; ++j) if (j != i0 && el[j] > mx1) { mx1 = el[j]; i1 = j; }
                const float e1 = __expf(mx1 - mx0); const float g0 = gval / (1.f + e1), g1 = gval * e1 / (1.f + e1);
                const int ea = gi * 8 + i0, eb = gi * 8 + i1; P_E01[2 * m] = ea; P_E01[2 * m + 1] = eb; P_G01[2 * m] = g0; P_G01[2 * m + 1] = g1; P_RSTD[m] = rstd;
                __hip_atomic_fetch_add((LAS unsigned*)(lds + MISC_OFF) + 64 + ea, 1u, __ATOMIC_RELAXED, __HIP_MEMORY_SCOPE_WORKGROUP); __hip_atomic_fetch_add((LAS unsigned*)(lds + MISC_OFF) + 64 + eb, 1u, __ATOMIC_RELAXED, __HIP_MEMORY_SCOPE_WORKGROUP);
            }
            __syncthreads();
            if (tid < 32) P_CNT[vcu * 32 + tid] = (int)MISC[64 + tid];
        }
        SEAM(P + 6);
        if (IN(P + 7)) for (int rep_ = 0; rep_ < ((l == 0 || 7 != 5) ? NREP(7) : 1); ++rep_) {
            unsigned ldsb_ = (unsigned)(uintptr_t)lds0; asm volatile("" : "+s"(ldsb_)); LAS unsigned char* lds = (LAS unsigned char*)(uintptr_t)ldsb_; volatile LAS unsigned* MISC = (volatile LAS unsigned*)(lds + MISC_OFF); volatile LAS unsigned long long* ARGP = (volatile LAS unsigned long long*)(lds + MISC_OFF + 768); (void)MISC; int wave = wave0, G = G0, bx = bx0; asm volatile("" : "+s"(G), "+s"(bx), "+s"(wave)); const int lane = (int)__builtin_amdgcn_mbcnt_hi(~0u, __builtin_amdgcn_mbcnt_lo(~0u, 0u)); const int tid = wave * 64 + lane; const int vcu = (bx % 8) * (G / 8) + bx / 8; const int gw = vcu * 8 + wave, NGW = G * 8; (void)lane; (void)gw; (void)NGW; (void)vcu;
            GAS unsigned char* ws = (GAS unsigned char*)LDP(22); GAS float* out = (GAS float*)LDP(21); const GAS float* x_in = (const GAS float*)ARGIN(0); (void)out; (void)x_in; (void)ws;
            LAS int* cnt_all = (LAS int*)lds;
            LAS int* pre_e = (LAS int*)(lds + 32768);
            LAS int* tot_e = pre_e + 32;
            LAS int* pst = pre_e + 64;
            LAS int* eL = pre_e + 128;
            { int tc_[16];
#pragma unroll
              for (int k = 0; k < 16; ++k) tc_[k] = P_CNT[tid + 512 * k];
#pragma unroll
              for (int k = 0; k < 16; ++k) cnt_all[tid + 512 * k] = tc_[k]; }
            float gv_ = 0.f, rv_ = 0.f;
            if (tid < 256) { eL[tid] = P_E01[vcu * 256 + tid]; gv_ = P_G01[vcu * 256 + tid]; rv_ = P_RSTD[vcu * 128 + (tid >> 1)]; }
            __syncthreads();
            { LAS int* part = pre_e + 512;
              const int e = tid & 31, p = tid >> 5; int pre = 0, tot = 0;
#pragma unroll
              for (int j = 0; j < 16; ++j) { const int w = p * 16 + j; const int c = cnt_all[w * 32 + e]; pre += (w < vcu) ? c : 0; tot += c; }
              part[(p * 2) * 32 + e] = pre; part[(p * 2 + 1) * 32 + e] = tot; }
            __syncthreads();
            if (tid < 32) { LAS int* part = pre_e + 512; int pre = 0, tot = 0;
#pragma unroll
                for (int p = 0; p < 16; ++p) { pre += part[(p * 2) * 32 + tid]; tot += part[(p * 2 + 1) * 32 + tid]; } pre_e[tid] = pre; tot_e[tid] = tot;
                const int pad = (tot + 255) & ~255; int inc = pad;
#pragma unroll
                for (int o = 1; o < 32; o <<= 1) { const int t = __shfl_up(inc, o); if (tid >= o) inc += t; }
                pst[tid] = inc - pad; if (tid == 31) pst[32] = inc; }
            __syncthreads();
            if (vcu == 0 && tid <= 32) P_TSTART[tid] = pst[tid] / 256;
            { LAS int* hist = pre_e + 2048;
              if (tid < 128) hist[tid] = 0;
              __syncthreads();
              int e = 0, rin = 0;
              if (tid < 256) { e = eL[tid]; unsigned long long mym = 0ull;
                  for (int x = 0; x < 32; ++x) { const unsigned long long bm = __ballot(e == x); if (e == x) mym = bm; }
                  rin = __builtin_popcountll(mym & ((1ull << lane) - 1ull));
                  if (rin == 0) hist[wave * 32 + e] = __builtin_popcountll(mym); }
              __syncthreads();
              if (tid < 256) { int r = rin; for (int w = 0; w < wave; ++w) r += hist[w * 32 + e];
                  const int slot = pst[e] + pre_e[e] + r; const int tok = vcu * 128 + (tid >> 1);
                  P_SLOT[vcu * 256 + tid] = slot; P_TOKOF[slot] = tok; P_GATEOF[slot] = gv_; P_RSTDOF[slot] = rv_; } }
            if (vcu < 32) { const int e = vcu; for (int s = pst[e] + tot_e[e] + tid; s < pst[e + 1]; s += 512) { P_TOKOF[s] = 0; P_GATEOF[s] = 0.f; P_RSTDOF[s] = 0.f; } }
            __syncthreads();
        }
        SEAM(P + 7);
        if (IN(P + 8)) for (int rep_ = 0; rep_ < ((l == 0 || 8 != 5) ? NREP(8) : 1); ++rep_) {
            unsigned ldsb_ = (unsigned)(uintptr_t)lds0; asm volatile("" : "+s"(ldsb_)); LAS unsigned char* lds = (LAS unsigned char*)(uintptr_t)ldsb_; volatile LAS unsigned* MISC = (volatile LAS unsigned*)(lds + MISC_OFF); volatile LAS unsigned long long* ARGP = (volatile LAS unsigned long long*)(lds + MISC_OFF + 768); (void)MISC; int wave = wave0, G = G0, bx = bx0; asm volatile("" : "+s"(G), "+s"(bx), "+s"(wave)); const int lane = (int)__builtin_amdgcn_mbcnt_hi(~0u, __builtin_amdgcn_mbcnt_lo(~0u, 0u)); const int tid = wave * 64 + lane; const int vcu = (bx % 8) * (G / 8) + bx / 8; const int gw = vcu * 8 + wave, NGW = G * 8; (void)lane; (void)gw; (void)NGW; (void)vcu;
            GAS unsigned char* ws = (GAS unsigned char*)LDP(22); GAS float* out = (GAS float*)LDP(21); const GAS float* x_in = (const GAS float*)ARGIN(0); (void)out; (void)x_in; (void)ws;
            volatile LAS int* TS = (volatile LAS int*)(MISC + 128);
            if (tid <= 32) TS[tid] = P_TSTART[tid];
            __syncthreads();
            MoeOrder S{G, vcu, TS, (const GAS char*)P_XN, (const GAS char*)P_WGU_L(l), 0, (size_t)1024 * 1024, (size_t)256 * 1024};
            EpiGU E{(GAS unsigned char*)P_HH, P_RSTDOF};
            pg8::gemm_phase<EpiGU, MoeOrder, true, true, true>(tid, lds, DM, DM, DM, S, E, P_TOKOF);
            if constexpr (l + 1 < NLAYER) {
                const int U = (int)TS[32] * 4, rem = U & 255; const int nidle = rem ? 256 - rem : 256, rk = rem ? vcu - rem : vcu;
                if (rk >= 0) { LAS float* scr64 = (LAS float*)(lds + wave * 16640);
                    const GAS float* w_gate = (const GAS float*)ARGIN(17) + (size_t)(l + 1) * NEXP * DM * DEXP; const GAS float* w_up = (const GAS float*)ARGIN(18) + (size_t)(l + 1) * NEXP * DM * DEXP; const GAS float* ffn1 = (const GAS float*)ARGIN(12) + (size_t)(l + 1) * DM;
                    for (int it = rk * 8 + wave; it < TAIL_GU; it += nidle * 8) conv_gu_item(it, w_gate, w_up, ffn1, P_WGU_L(l + 1), scr64, lane); }
            }
        }
        SEAM(P + 8);
        if (IN(P + 9)) for (int rep_ = 0; rep_ < ((l == 0 || 9 != 5) ? NREP(9) : 1); ++rep_) {
            unsigned ldsb_ = (unsigned)(uintptr_t)lds0; asm volatile("" : "+s"(ldsb_)); LAS unsigned char* lds = (LAS unsigned char*)(uintptr_t)ldsb_; volatile LAS unsigned* MISC = (volatile LAS unsigned*)(lds + MISC_OFF); volatile LAS unsigned long long* ARGP = (volatile LAS unsigned long long*)(lds + MISC_OFF + 768); (void)MISC; int wave = wave0, G = G0, bx = bx0; asm volatile("" : "+s"(G), "+s"(bx), "+s"(wave)); const int lane = (int)__builtin_amdgcn_mbcnt_hi(~0u, __builtin_amdgcn_mbcnt_lo(~0u, 0u)); const int tid = wave * 64 + lane; const int vcu = (bx % 8) * (G / 8) + bx / 8; const int gw = vcu * 8 + wave, NGW = G * 8; (void)lane; (void)gw; (void)NGW; (void)vcu;
            GAS unsigned char* ws = (GAS unsigned char*)LDP(22); GAS float* out = (GAS float*)LDP(21); const GAS float* x_in = (const GAS float*)ARGIN(0); (void)out; (void)x_in; (void)ws;
            volatile LAS int* TS = (volatile LAS int*)(MISC + 128);
            if (tid <= 32) TS[tid] = P_TSTART[tid];
            __syncthreads();
            MoeOrder S{G, vcu, TS, (const GAS char*)P_HH, (const GAS char*)P_WD_L(l), (size_t)256 * 512, (size_t)1024 * 512, (size_t)256 * 512};
            EpiDown E{(GAS unsigned char*)P_Y, P_GATEOF};
            pg8::gemm_phase<EpiDown, MoeOrder, true, false, true>(tid, lds, DEXP, DEXP, DEXP, S, E, nullptr);
            if constexpr (l + 1 < NLAYER) {
                const int U = (int)TS[32] * 4, rem = U & 255; const int nidle = rem ? 256 - rem : 256, rk = rem ? vcu - rem : vcu;
                if (rk >= 0) { LAS float* scr64 = (LAS float*)(lds + wave * 16640);
                    const GAS float* w_down = (const GAS float*)ARGIN(19) + (size_t)(l + 1) * NEXP * DEXP * DM;
                    for (int it = rk * 8 + wave; it < TAIL_D; it += nidle * 8) conv_d_item(it, w_down, P_WD_L(l + 1), scr64, lane); }
            }
        }
        SEAM(P + 9);
}

__global__ void __launch_bounds__(512, 2) fwd(Args args) {
    extern __shared__ __attribute__((aligned(16))) unsigned char lds_raw[];
    LAS unsigned char* lds0 = (LAS unsigned char*)lds_raw;
    const int tid0 = threadIdx.x; const int wave0 = __builtin_amdgcn_readfirstlane(tid0 >> 6);
    const int G0 = gridDim.x; const int bx0 = blockIdx.x;
    { volatile LAS unsigned* MISC = (volatile LAS unsigned*)(lds0 + MISC_OFF); const int tid = tid0;
    for (int u = tid; u < 256; u += 512) MISC[u] = 0u;
    __syncthreads();
    volatile LAS unsigned long long* ARGP = (volatile LAS unsigned long long*)(lds0 + MISC_OFF + 768);
    if (tid < 21) ARGP[tid] = (unsigned long long)args.in[tid];
    if (tid == 21) ARGP[21] = (unsigned long long)args.out;
    if (tid == 22) ARGP[22] = (unsigned long long)args.ws;
    __syncthreads(); }
#if MK_ONE_LAUNCH
    XcdBarrier bar = xcd_barrier_post((unsigned*)(args.ws + WS_CTL) + CW_BAR, (volatile LAS unsigned*)(lds0 + MISC_OFF) + 8, gridDim.x);
    const int vcu0 = (bx0 % 8) * (G0 / 8) + bx0 / 8;
    XcdBarrier gbar = xcd_barrier_post((unsigned*)(args.ws + WS_CTL) + CW_BAR + (1 + (vcu0 >> 4)) * XCD_BAR_WORDS, (volatile LAS unsigned*)(lds0 + MISC_OFF) + 12, 16u);
#else
    XcdBarrier bar; bar.bar = nullptr; bar.x = 0; bar.st = nullptr; bar.n = 0;
    XcdBarrier gbar = bar;
#endif
    const int lo = args.ph_lo, hi_ = args.ph_hi;
    if (IN(0)) {
        const GAS int* positions = (const GAS int*)args.in[1]; GAS float* COSp = (GAS float*)(args.ws + WS_COS); GAS float* SINp = (GAS float*)(args.ws + WS_SIN);
        for (int i = bx0 * 512 + tid0; i < NTOK * 16; i += G0 * 512) { const int tk = i >> 4, fi = i & 15;
            const double invrev = exp2(-(double)fi * (13.287712379549449 / 16.0)) * 0.15915494309189535; const double rev = (double)positions[tk] * invrev; const float fr = (float)(rev - rint(rev));
            COSp[i] = __builtin_amdgcn_cosf(fr); SINp[i] = __builtin_amdgcn_sinf(fr); }
    }
    layer_body<0>(lo, hi_, lds0, wave0, G0, bx0, bar, gbar);
    layer_body<1>(lo, hi_, lds0, wave0, G0, bx0, bar, gbar);
    layer_body<2>(lo, hi_, lds0, wave0, G0, bx0, bar, gbar);
}

extern "C" void kernel_launch(void* const* d_in, const int* in_sizes, int n_in, void* d_out, int out_size, void* d_ws, size_t ws_size, hipStream_t stream) {
    static int grid = 0;
    if (grid == 0) {
        if (n_in != 21 || out_size != NTOK * DM || ws_size < WS_END) { fprintf(stderr, "kernel_launch: unexpected shapes (n_in %d out %d ws %zu)\n", n_in, out_size, ws_size); grid = -1; return; }
        int dev = 0, cus = 0;
        if (hipGetDevice(&dev) != hipSuccess || hipDeviceGetAttribute(&cus, hipDeviceAttributeMultiprocessorCount, dev) != hipSuccess) { grid = -1; return; }
        if (hipFuncSetAttribute((const void*)fwd, hipFuncAttributeMaxDynamicSharedMemorySize, LDS_BYTES) != hipSuccess) { fprintf(stderr, "kernel_launch: hipFuncSetAttribute failed\n"); grid = -1; return; }
        int per_cu = 0;
        if (hipOccupancyMaxActiveBlocksPerMultiprocessor(&per_cu, (const void*)fwd, 512, LDS_BYTES) != hipSuccess || per_cu < 1) fprintf(stderr, "kernel_launch: occupancy query says %d\n", per_cu);
        (void)hipGetLastError();
        grid = cus;
        if (grid != 256) { fprintf(stderr, "kernel_launch: built for 256 CUs, got %d\n", grid); grid = -1; return; }
    }
    if (grid < 0) return;
    if (hipMemsetAsync((char*)d_ws + WS_CTL, 0, CTL_ZERO_BYTES, stream) != hipSuccess) return;
    Args a{};
    for (int i = 0; i < 21; ++i) a.in[i] = d_in[i];
    a.out = (float*)d_out; a.ws = (unsigned char*)d_ws;
#if MK_ONE_LAUNCH
    a.ph_lo = 0; a.ph_hi = 21;
    hipLaunchKernelGGL(fwd, dim3(grid), dim3(512), LDS_BYTES, stream, a);
#else
    for (int p = 0; p <= 20; ++p) { a.ph_lo = p; a.ph_hi = p + 1; hipLaunchKernelGGL(fwd, dim3(grid), dim3(512), LDS_BYTES, stream, a); }
#endif
}
```
